# Optimizing an MI355X kernel written in HIP

```python
import math
import jax
import jax.numpy as jnp
from jax import lax
import numpy as np

D_MODEL = 1024
BATCH = 16
SEQ = 2048
DEPTH = 4
DEC_BATCH = 128
DEC_SEQ = 8
PAST_LEN = 8192
PAGE_SIZE = 128

N_MIXERS = 3
N_RWKV = (DEPTH + 2) // 3
N_MLA = (DEPTH + 1) // 3
N_MAMBA = DEPTH // 3

RW_HEAD = 64
RW_HEADS = D_MODEL // RW_HEAD
RW_DECAY_LORA = 64
RW_AAA_LORA = 64
RW_MV_LORA = 32
RW_GATE_LORA = 160
RW_LNX_EPS = 64e-5

MLA_HEADS = 16
MLA_Q_LORA = 512
MLA_KV_LORA = 256
MLA_NOPE = 64
MLA_ROPE = 32
MLA_V = 64
MLA_SCALE = 1.0 / math.sqrt(MLA_NOPE + MLA_ROPE)
ROPE_THETA = 10000.0
Q_BLOCK = 128

MB_INNER = 2 * D_MODEL
MB_HEAD = 64
MB_HEADS = MB_INNER // MB_HEAD
MB_GROUPS = 4
MB_STATE = 128
MB_CONV = 4
MB_CONV_DIM = MB_INNER + 2 * MB_GROUPS * MB_STATE
MB_IN_DIM = MB_INNER + MB_CONV_DIM + MB_HEADS
MB_CHUNK = 128

FFN_HIDDEN = 4 * D_MODEL
NORM_EPS = 1e-6
F32 = jnp.float32

kernel_name = 'hybrid_rwkv7_mla_mamba2_decode_step'


def rmsnorm(x, g):
    xf = x.astype(F32)
    y = xf * lax.rsqrt(jnp.mean(xf * xf, axis=-1, keepdims=True) + NORM_EPS)
    return (y * g.astype(F32)).astype(x.dtype)


def rope(x, pos):
    half = MLA_ROPE // 2
    inv = ROPE_THETA ** (-jnp.arange(half, dtype=F32) / half)
    ang = pos.astype(F32)[:, None] * inv[None, :]
    shape = (pos.shape[0],) + (1,) * (x.ndim - 3) + (half,)
    cos = jnp.cos(ang).reshape(shape).astype(x.dtype)
    sin = jnp.sin(ang).reshape(shape).astype(x.dtype)
    x1, x2 = x[..., :half], x[..., half:]
    return jnp.concatenate([x1 * cos - x2 * sin, x2 * cos + x1 * sin], axis=-1)


def sqrelu_ffn(x, w1, w2):
    return jnp.square(jax.nn.relu(x @ w1)) @ w2


def _wkv_step(S, inp):
    r_t, w_t, k_t, v_t, a_t, b_t = inp
    sa = jnp.einsum('bhij,bhj->bhi', S, a_t)
    S = S * w_t[:, :, None, :] + sa[..., None] * b_t[:, :, None, :] + v_t[..., None] * k_t[:, :, None, :]
    return S, jnp.einsum('bhij,bhj->bhi', S, r_t)


def rwkv_mix(x, shift, wkv, v_first, vres, mu, w_rkv, w0, w1, w2, a0, a1, a2,
             g1, g2, k_k, k_a, r_k, lnx_w, lnx_b, w_o):
    b, t, c = x.shape
    hd = (b, t, RW_HEADS, RW_HEAD)
    x_prev = jnp.concatenate([shift[:, None].astype(x.dtype), x[:, :-1]], axis=1)
    xm = x[None] + (x_prev - x)[None] * mu[:, None, None, :]
    rkv = jnp.einsum('pbtc,pcd->pbtd', xm[:3], w_rkv)
    r, k, v = rkv[0], rkv[1], rkv[2]
    w_log = -jax.nn.softplus(-(w0 + jnp.tanh(xm[3] @ w1) @ w2)) - 0.5
    decay = jnp.exp(-jnp.exp(w_log.astype(F32)))
    if vres is None:
        v_first = v
    else:
        v0, v1, v2 = vres
        v = v + (v_first - v) * jax.nn.sigmoid(v0 + (xm[2] @ v1) @ v2)
    a = jax.nn.sigmoid(a0 + (xm[4] @ a1) @ a2)
    g = jax.nn.sigmoid(xm[5] @ g1) @ g2
    kk = (k * k_k).reshape(hd).astype(F32)
    kk = kk / jnp.maximum(jnp.linalg.norm(kk, axis=-1, keepdims=True), 1e-12)
    k = k * (1.0 + (a - 1.0) * k_a)
    rh, kh, vh, ah = [z.reshape(hd).astype(F32) for z in (r, k, v, a)]
    seq = tuple(jnp.moveaxis(z, 1, 0) for z in (rh, decay.reshape(hd), kh, vh, -kk, kk * ah))
    S, y = lax.scan(_wkv_step, wkv.astype(F32), seq)
    y = jnp.moveaxis(y, 0, 1)
    mean = jnp.mean(y, axis=-1, keepdims=True)
    var = jnp.mean(jnp.square(y - mean), axis=-1, keepdims=True)
    y = (y - mean) * lax.rsqrt(var + RW_LNX_EPS) * lnx_w.reshape(RW_HEADS, RW_HEAD) \
        + lnx_b.reshape(RW_HEADS, RW_HEAD)
    y = y + jnp.sum(rh * kh * r_k, axis=-1, keepdims=True) * vh
    out = (y.reshape(b, t, c).astype(x.dtype) * g) @ w_o
    return out, S, x[:, -1], v_first


def mla_project(x, pos, w_in, q_norm, kv_norm, w_uq, qn_norm, qr_norm, kr_norm):
    h = x @ w_in
    q_a = h[..., :MLA_Q_LORA]
    c_raw = h[..., MLA_Q_LORA:MLA_Q_LORA + MLA_KV_LORA]
    kp_raw = h[..., MLA_Q_LORA + MLA_KV_LORA:]
    q = jnp.einsum('btl,lhd->bthd', rmsnorm(q_a, q_norm), w_uq)
    q_nope = rmsnorm(q[..., :MLA_NOPE], qn_norm)
    q_pe = rope(rmsnorm(q[..., MLA_NOPE:], qr_norm), pos)
    c = rmsnorm(c_raw, kv_norm)
    k_pe = rope(rmsnorm(kp_raw, kr_norm), pos)
    return q_nope, q_pe, c, k_pe


def mla_keys(c, w_uk, kn_norm):
    return rmsnorm(jnp.einsum('...r,rhd->...hd', c, w_uk), kn_norm)


def mla_attend(q_nope, q_pe, k_nope, k_pe, c, mask, w_uv):
    s = jnp.einsum('bqhd,bkhd->bhqk', q_nope, k_nope) + jnp.einsum('bqhd,bkd->bhqk', q_pe, k_pe)
    s = jnp.where(mask, s.astype(F32) * MLA_SCALE, -jnp.inf)
    p = jax.nn.softmax(s, axis=-1).astype(c.dtype)
    o_lat = jnp.einsum('bhqk,bkr->bqhr', p, c)
    return jnp.einsum('bqhr,rhd->bqhd', o_lat, w_uv)


def mla_prompt(x, w_in, q_norm, kv_norm, w_uq, w_uk, w_uv, qn_norm, qr_norm, kn_norm, kr_norm, w_o):
    b, t, _ = x.shape
    pos = jnp.arange(t)
    qn, qp, c, kp = mla_project(x, pos, w_in, q_norm, kv_norm, w_uq, qn_norm, qr_norm, kr_norm)
    kn = mla_keys(c, w_uk, kn_norm)
    nb = t // Q_BLOCK
    qn_b = jnp.swapaxes(qn.reshape(b, nb, Q_BLOCK, MLA_HEADS, MLA_NOPE), 0, 1)
    qp_b = jnp.swapaxes(qp.reshape(b, nb, Q_BLOCK, MLA_HEADS, MLA_ROPE), 0, 1)
    kpos = jnp.arange(t)

    def block(args):
        qn_i, qp_i, i = args
        qpos = i * Q_BLOCK + jnp.arange(Q_BLOCK)
        return mla_attend(qn_i, qp_i, kn, kp, c, kpos[None, :] <= qpos[:, None], w_uv)

    o = lax.map(block, (qn_b, qp_b, jnp.arange(nb)))
    o = jnp.swapaxes(o, 0, 1).reshape(b, t, MLA_HEADS * MLA_V)
    return o @ w_o, c, kp


def mla_sample(x, pool_c, pool_kp, page_table, w_in, q_norm, kv_norm, w_uq, w_uk, w_uv,
               qn_norm, qr_norm, kn_norm, kr_norm, w_o):
    b, t, _ = x.shape
    pos = PAST_LEN + jnp.arange(t)
    qn, qp, c, kp = mla_project(x, pos, w_in, q_norm, kv_norm, w_uq, qn_norm, qr_norm, kr_norm)
    n_past = page_table.shape[1] * PAGE_SIZE
    mask = jnp.concatenate([jnp.ones((t, n_past), bool), jnp.tril(jnp.ones((t, t), bool))], axis=1)

    def one_seq(args):
        pt, qn_s, qp_s, c_s, kp_s = args
        c_all = jnp.concatenate([pool_c[pt].reshape(n_past, MLA_KV_LORA), c_s.astype(pool_c.dtype)], axis=0)
        kp_all = jnp.concatenate([pool_kp[pt].reshape(n_past, MLA_ROPE), kp_s.astype(pool_kp.dtype)], axis=0)
        kn_all = mla_keys(c_all, w_uk, kn_norm)
        return mla_attend(qn_s[None], qp_s[None], kn_all[None], kp_all[None], c_all[None], mask, w_uv)[0]

    o = lax.map(one_seq, (page_table, qn, qp, c, kp))
    return o.reshape(b, t, MLA_HEADS * MLA_V) @ w_o, c, kp


def ssd_scan(xh, dt, A, Bm, Cm, h0, chunk):
    b, t = xh.shape[0], xh.shape[1]
    nc = t // chunk
    r = MB_HEADS // MB_GROUPS

    def to_chunks(z):
        return jnp.moveaxis(z.reshape((b, nc, chunk) + z.shape[2:]), 1, 0)

    xc = to_chunks(xh.astype(F32).reshape(b, t, MB_GROUPS, r, MB_HEAD))
    dtc = to_chunks(dt.astype(F32).reshape(b, t, MB_GROUPS, r))
    Bc = to_chunks(Bm.astype(F32))
    Cc = to_chunks(Cm.astype(F32))
    a_gr = A.reshape(MB_GROUPS, r)
    causal = jnp.tril(jnp.ones((chunk, chunk), bool))[None, :, :, None, None]

    def step(h, inp):
        x_q, dt_q, b_q, c_q = inp
        acum = jnp.cumsum(dt_q * a_gr, axis=1)
        seg = acum[:, :, None] - acum[:, None, :]
        lmat = jnp.exp(jnp.where(causal, seg, -jnp.inf))
        xdt = x_q * dt_q[..., None]
        cb = jnp.einsum('bign,bjgn->bijg', c_q, b_q)
        y = jnp.einsum('bijgr,bjgrp->bigrp', cb[..., None] * lmat, xdt)
        y = y + jnp.einsum('bign,bgrpn->bigrp', c_q, h) * jnp.exp(acum)[..., None]
        to_end = jnp.exp(acum[:, -1:] - acum)
        h = h * jnp.exp(acum[:, -1])[..., None, None] \
            + jnp.einsum('bjgn,bjgrp->bgrpn', b_q, xdt * to_end[..., None])
        return h, y

    h, ys = lax.scan(step, h0.astype(F32).reshape(b, MB_GROUPS, r, MB_HEAD, MB_STATE), (xc, dtc, Bc, Cc))
    y = jnp.moveaxis(ys, 0, 1).reshape(b, t, MB_HEADS, MB_HEAD)
    return y, h.reshape(b, MB_HEADS, MB_HEAD, MB_STATE)


def mamba_mix(x, conv_state, ssm_state, w_in, conv_w, conv_b, dt_bias, a_log, d_skip, norm_w, w_o):
    b, t, _ = x.shape
    zxbcdt = x @ w_in
    z = zxbcdt[..., :MB_INNER]
    xbc = zxbcdt[..., MB_INNER:MB_INNER + MB_CONV_DIM]
    dt_raw = zxbcdt[..., MB_INNER + MB_CONV_DIM:]
    xpad = jnp.concatenate([conv_state.astype(xbc.dtype), xbc], axis=1)
    conv = conv_b + sum(xpad[:, j:j + t] * conv_w[j] for j in range(MB_CONV))
    xbc = jax.nn.silu(conv)
    new_conv = xpad[:, t:]
    gn = MB_GROUPS * MB_STATE
    xs = xbc[..., :MB_INNER].reshape(b, t, MB_HEADS, MB_HEAD)
    Bm = xbc[..., MB_INNER:MB_INNER + gn].reshape(b, t, MB_GROUPS, MB_STATE)
    Cm = xbc[..., MB_INNER + gn:].reshape(b, t, MB_GROUPS, MB_STATE)
    dt = jax.nn.softplus(dt_raw.astype(F32) + dt_bias.astype(F32))
    A = -jnp.exp(a_log.astype(F32))
    y, h = ssd_scan(xs, dt, A, Bm, Cm, ssm_state, math.gcd(t, MB_CHUNK))
    y = y + d_skip.astype(F32)[:, None] * xs.astype(F32)
    yz = (y.reshape(b, t, MB_INNER) * jax.nn.silu(z.astype(F32))).reshape(b, t, MB_GROUPS, MB_INNER // MB_GROUPS)
    yz = rmsnorm(yz, norm_w.reshape(MB_GROUPS, MB_INNER // MB_GROUPS)).reshape(b, t, MB_INNER)
    return yz.astype(x.dtype) @ w_o, new_conv, h


def setup_inputs(seed: int = 0) -> dict:
    key = jax.random.key(seed)
    ks = iter(jax.random.split(key, 64))
    C = D_MODEL
    n_pages = PAST_LEN // PAGE_SIZE
    n_pool = (DEC_BATCH * n_pages * 5) // 4
    nv = max(N_RWKV - 1, 0)

    def nrm(shape, scale):
        return scale * jax.random.normal(next(ks), shape, F32)

    def gain(shape):
        return 1.0 + 0.02 * jax.random.normal(next(ks), shape, F32)

    def unif(shape, lo, hi):
        return jax.random.uniform(next(ks), shape, F32, lo, hi)

    dt0 = jnp.exp(unif((N_MAMBA, MB_HEADS), math.log(1e-3), math.log(1e-1)))
    page_table = jax.random.permutation(next(ks), n_pool)[:DEC_BATCH * n_pages]
    page_table = page_table.reshape(DEC_BATCH, n_pages).astype(jnp.int32)
    return {
        'x_prompt': nrm((BATCH, SEQ, C), 1.0),
        'x_sample': nrm((DEC_BATCH, DEC_SEQ, C), 1.0),
        'cache_mla_ckv': nrm((N_MLA, n_pool, PAGE_SIZE, MLA_KV_LORA), 1.0),
        'cache_mla_kpe': nrm((N_MLA, n_pool, PAGE_SIZE, MLA_ROPE), 1.0),
        'state_rwkv_wkv': nrm((N_RWKV, DEC_BATCH, RW_HEADS, RW_HEAD, RW_HEAD), 0.5),
        'state_rwkv_shift': nrm((N_RWKV, DEC_BATCH, C), 1.0),
        'state_ssm': nrm((N_MAMBA, DEC_BATCH, MB_HEADS, MB_HEAD, MB_STATE), 0.5),
        'state_conv': nrm((N_MAMBA, DEC_BATCH, MB_CONV - 1, MB_CONV_DIM), 1.0),
        'page_table': page_table,
        'norm_mix': gain((DEPTH, C)),
        'norm_ffn': gain((DEPTH, C)),
        'ffn_w1': nrm((DEPTH, C, FFN_HIDDEN), C ** -0.5),
        'ffn_w2': nrm((DEPTH, FFN_HIDDEN, C), FFN_HIDDEN ** -0.5),
        'rwkv_mu': unif((N_RWKV, 6, C), 0.0, 1.0),
        'rwkv_w_rkv': nrm((N_RWKV, 3, C, C), C ** -0.5),
        'rwkv_w0': unif((N_RWKV, C), -6.0, 1.0),
        'rwkv_w1': nrm((N_RWKV, C, RW_DECAY_LORA), C ** -0.5),
        'rwkv_w2': nrm((N_RWKV, RW_DECAY_LORA, C), 0.1 * RW_DECAY_LORA ** -0.5),
        'rwkv_a0': nrm((N_RWKV, C), 0.1),
        'rwkv_a1': nrm((N_RWKV, C, RW_AAA_LORA), C ** -0.5),
        'rwkv_a2': nrm((N_RWKV, RW_AAA_LORA, C), 0.1 * RW_AAA_LORA ** -0.5),
        'rwkv_v0': nrm((nv, C), 0.1),
        'rwkv_v1': nrm((nv, C, RW_MV_LORA), C ** -0.5),
        'rwkv_v2': nrm((nv, RW_MV_LORA, C), 0.1 * RW_MV_LORA ** -0.5),
        'rwkv_g1': nrm((N_RWKV, C, RW_GATE_LORA), C ** -0.5),
        'rwkv_g2': nrm((N_RWKV, RW_GATE_LORA, C), RW_GATE_LORA ** -0.5),
        'rwkv_k_k': 0.85 + nrm((N_RWKV, C), 0.05),
        'rwkv_k_a': 1.0 + nrm((N_RWKV, C), 0.05),
        'rwkv_r_k': nrm((N_RWKV, RW_HEADS, RW_HEAD), 0.1),
        'rwkv_lnx_w': gain((N_RWKV, C)),
        'rwkv_lnx_b': nrm((N_RWKV, C), 0.01),
        'rwkv_w_o': nrm((N_RWKV, C, C), C ** -0.5),
        'mla_w_in': nrm((N_MLA, C, MLA_Q_LORA + MLA_KV_LORA + MLA_ROPE), C ** -0.5),
        'mla_q_norm': gain((N_MLA, MLA_Q_LORA)),
        'mla_kv_norm': gain((N_MLA, MLA_KV_LORA)),
        'mla_w_uq': nrm((N_MLA, MLA_Q_LORA, MLA_HEADS, MLA_NOPE + MLA_ROPE), MLA_Q_LORA ** -0.5),
        'mla_w_uk': nrm((N_MLA, MLA_KV_LORA, MLA_HEADS, MLA_NOPE), MLA_KV_LORA ** -0.5),
        'mla_w_uv': nrm((N_MLA, MLA_KV_LORA, MLA_HEADS, MLA_V), MLA_KV_LORA ** -0.5),
        'mla_qn_norm': gain((N_MLA, MLA_NOPE)),
        'mla_qr_norm': gain((N_MLA, MLA_ROPE)),
        'mla_kn_norm': gain((N_MLA, MLA_NOPE)),
        'mla_kr_norm': gain((N_MLA, MLA_ROPE)),
        'mla_w_o': nrm((N_MLA, MLA_HEADS * MLA_V, C), (MLA_HEADS * MLA_V) ** -0.5),
        'mamba_w_in': nrm((N_MAMBA, C, MB_IN_DIM), C ** -0.5),
        'mamba_conv_w': nrm((N_MAMBA, MB_CONV, MB_CONV_DIM), MB_CONV ** -0.5),
        'mamba_conv_b': nrm((N_MAMBA, MB_CONV_DIM), 0.01),
        'mamba_dt_bias': dt0 + jnp.log(-jnp.expm1(-dt0)),
        'mamba_a_log': jnp.log(unif((N_MAMBA, MB_HEADS), 1.0, 16.0)),
        'mamba_d': 1.0 + nrm((N_MAMBA, MB_HEADS), 0.1),
        'mamba_norm': gain((N_MAMBA, MB_INNER)),
        'mamba_w_o': nrm((N_MAMBA, MB_INNER, C), MB_INNER ** -0.5),
    }


def reference(x_prompt, x_sample, cache_mla_ckv, cache_mla_kpe, state_rwkv_wkv, state_rwkv_shift,
              state_ssm, state_conv, page_table, norm_mix, norm_ffn, ffn_w1, ffn_w2,
              rwkv_mu, rwkv_w_rkv, rwkv_w0, rwkv_w1, rwkv_w2, rwkv_a0, rwkv_a1, rwkv_a2,
              rwkv_v0, rwkv_v1, rwkv_v2, rwkv_g1, rwkv_g2, rwkv_k_k, rwkv_k_a, rwkv_r_k,
              rwkv_lnx_w, rwkv_lnx_b, rwkv_w_o, mla_w_in, mla_q_norm, mla_kv_norm, mla_w_uq,
              mla_w_uk, mla_w_uv, mla_qn_norm, mla_qr_norm, mla_kn_norm, mla_kr_norm, mla_w_o,
              mamba_w_in, mamba_conv_w, mamba_conv_b, mamba_dt_bias, mamba_a_log, mamba_d,
              mamba_norm, mamba_w_o):
    bp = x_prompt.shape[0]
    hp, hs = x_prompt, x_sample
    vf_p, vf_s = None, None
    ckv_p, kpe_p, ckv_s, kpe_s = [], [], [], []
    wkv_p, sh_p, wkv_s, sh_s = [], [], [], []
    ssm_p, conv_p, ssm_s, conv_s = [], [], [], []
    for i in range(DEPTH):
        kind, j = i % N_MIXERS, i // N_MIXERS
        xp = rmsnorm(hp, norm_mix[i])
        xs = rmsnorm(hs, norm_mix[i])
        if kind == 0:
            rw = (rwkv_mu[j], rwkv_w_rkv[j], rwkv_w0[j], rwkv_w1[j], rwkv_w2[j], rwkv_a0[j],
                  rwkv_a1[j], rwkv_a2[j], rwkv_g1[j], rwkv_g2[j], rwkv_k_k[j], rwkv_k_a[j],
                  rwkv_r_k[j], rwkv_lnx_w[j], rwkv_lnx_b[j], rwkv_w_o[j])
            vres = None if j == 0 else (rwkv_v0[j - 1], rwkv_v1[j - 1], rwkv_v2[j - 1])
            op, s_p, l_p, vf_p = rwkv_mix(xp, jnp.zeros((bp, D_MODEL), xp.dtype),
                                          jnp.zeros((bp, RW_HEADS, RW_HEAD, RW_HEAD), F32),
                                          vf_p, vres, *rw)
            os_, s_s, l_s, vf_s = rwkv_mix(xs, state_rwkv_shift[j], state_rwkv_wkv[j], vf_s, vres, *rw)
            wkv_p.append(s_p); sh_p.append(l_p); wkv_s.append(s_s); sh_s.append(l_s)
        elif kind == 1:
            ml = (mla_w_in[j], mla_q_norm[j], mla_kv_norm[j], mla_w_uq[j], mla_w_uk[j], mla_w_uv[j],
                  mla_qn_norm[j], mla_qr_norm[j], mla_kn_norm[j], mla_kr_norm[j], mla_w_o[j])
            op, c_p, k_p = mla_prompt(xp, *ml)
            os_, c_s, k_s = mla_sample(xs, cache_mla_ckv[j], cache_mla_kpe[j], page_table, *ml)
            ckv_p.append(c_p); kpe_p.append(k_p); ckv_s.append(c_s); kpe_s.append(k_s)
        else:
            mb = (mamba_w_in[j], mamba_conv_w[j], mamba_conv_b[j], mamba_dt_bias[j],
                  mamba_a_log[j], mamba_d[j], mamba_norm[j], mamba_w_o[j])
            op, cv_p, h_p = mamba_mix(xp, jnp.zeros((bp, MB_CONV - 1, MB_CONV_DIM), xp.dtype),
                                      jnp.zeros((bp, MB_HEADS, MB_HEAD, MB_STATE), F32), *mb)
            os_, cv_s, h_s = mamba_mix(xs, state_conv[j], state_ssm[j], *mb)
            ssm_p.append(h_p); conv_p.append(cv_p); ssm_s.append(h_s); conv_s.append(cv_s)
        hp = hp + op.astype(hp.dtype)
        hs = hs + os_.astype(hs.dtype)
        hp = hp + sqrelu_ffn(rmsnorm(hp, norm_ffn[i]), ffn_w1[i], ffn_w2[i]).astype(hp.dtype)
        hs = hs + sqrelu_ffn(rmsnorm(hs, norm_ffn[i]), ffn_w1[i], ffn_w2[i]).astype(hs.dtype)
    return (hp, hs,
            jnp.stack(ckv_p), jnp.stack(kpe_p), jnp.stack(ckv_s), jnp.stack(kpe_s),
            jnp.stack(wkv_p), jnp.stack(sh_p), jnp.stack(wkv_s), jnp.stack(sh_s),
            jnp.stack(ssm_p), jnp.stack(conv_p), jnp.stack(ssm_s), jnp.stack(conv_s))
```

```cpp
#include <hip/hip_runtime.h>
#include <cstdio>
#include <math.h>
#include <stdint.h>
#include <stddef.h>
#ifdef CPU_EMU
#define DEV inline
#else
#define DEV __device__ __forceinline__
#endif

namespace cfg {
#ifdef CFG_SMALL
constexpr int D = 128, BATCH = 2, SEQ = 32, DEPTH = 4, DB = 3, DS = 8, PAST = 64, PAGE = 16;
constexpr int RW_DL = 16, RW_AL = 16, RW_VL = 8, RW_GL = 24;
constexpr int MH = 2, QL = 64, KVL = 32;
constexpr int MB_GROUPS = 2;
#else
constexpr int D = 1024, BATCH = 16, SEQ = 2048, DEPTH = 4, DB = 128, DS = 8, PAST = 8192, PAGE = 128;
constexpr int RW_DL = 64, RW_AL = 64, RW_VL = 32, RW_GL = 160;
constexpr int MH = 16, QL = 512, KVL = 256;
constexpr int MB_GROUPS = 4;
#endif
constexpr int N_RWKV = (DEPTH + 2) / 3, N_MLA = (DEPTH + 1) / 3, N_MAMBA = DEPTH / 3;
constexpr int RH = 64, RHEADS = D / RH;
constexpr int NOPE = 64, ROPE = 32, VD = 64, QD = NOPE + ROPE;
constexpr int MLA_IN = QL + KVL + ROPE;
constexpr int MB_INNER = 2 * D, MB_HEAD = 64, MB_HEADS = MB_INNER / MB_HEAD, MB_STATE = 128, MB_CONV = 4;
constexpr int MB_GN = MB_GROUPS * MB_STATE;
constexpr int MB_CD = MB_INNER + 2 * MB_GN, MB_IN = MB_INNER + MB_CD + MB_HEADS;
constexpr int FFN = 4 * D;
constexpr int NPAGES = PAST / PAGE, NPOOL = (DB * NPAGES * 5) / 4;
constexpr int MP = BATCH * SEQ, MS = DB * DS, MTOT = MP + MS, NSEQ = BATCH + DB;
constexpr int KTOT = PAST + DS;
constexpr float NORM_EPS = 1e-6f, LNX_EPS = 64e-5f;
constexpr size_t O_YP = 0;
constexpr size_t O_YS = O_YP + (size_t)MP * D;
constexpr size_t O_CKVP = O_YS + (size_t)MS * D;
constexpr size_t O_KPEP = O_CKVP + (size_t)N_MLA * MP * KVL;
constexpr size_t O_CKVS = O_KPEP + (size_t)N_MLA * MP * ROPE;
constexpr size_t O_KPES = O_CKVS + (size_t)N_MLA * MS * KVL;
constexpr size_t O_WKVP = O_KPES + (size_t)N_MLA * MS * ROPE;
constexpr size_t O_SHP = O_WKVP + (size_t)N_RWKV * BATCH * RHEADS * RH * RH;
constexpr size_t O_WKVS = O_SHP + (size_t)N_RWKV * BATCH * D;
constexpr size_t O_SHS = O_WKVS + (size_t)N_RWKV * DB * RHEADS * RH * RH;
constexpr size_t O_SSMP = O_SHS + (size_t)N_RWKV * DB * D;
constexpr size_t O_CONVP = O_SSMP + (size_t)N_MAMBA * BATCH * MB_HEADS * MB_HEAD * MB_STATE;
constexpr size_t O_SSMS = O_CONVP + (size_t)N_MAMBA * BATCH * (MB_CONV - 1) * MB_CD;
constexpr size_t O_CONVS = O_SSMS + (size_t)N_MAMBA * DB * MB_HEADS * MB_HEAD * MB_STATE;
constexpr size_t O_END = O_CONVS + (size_t)N_MAMBA * DB * (MB_CONV - 1) * MB_CD;
}

struct Ctx {
    const float* in[51];
    const int* page_table;
    float* out;
    float *x, *xn, *vf;
    float* xm[6];
    float *r, *k, *v, *wpre, *apre, *vpre, *g, *hw, *ha, *hv, *hg, *ka, *kb, *y, *yo;
    float *hmid;
    float *mh, *qan, *q, *c, *kp, *knr, *vv, *ao, *sc, *olat;
    float *zx, *xbc, *dt, *my, *yzn;
};

DEV int row_t(int m) { return m < cfg::MP ? m % cfg::SEQ : (m - cfg::MP) % cfg::DS; }
DEV int row_seq(int m) { return m < cfg::MP ? m / cfg::SEQ : cfg::BATCH + (m - cfg::MP) / cfg::DS; }
DEV int seq_row0(int sq) { return sq < cfg::BATCH ? sq * cfg::SEQ : cfg::MP + (sq - cfg::BATCH) * cfg::DS; }
DEV int seq_len(int sq) { return sq < cfg::BATCH ? cfg::SEQ : cfg::DS; }
DEV float sigmoidf_(float x) { return 1.0f / (1.0f + expf(-x)); }
DEV float softplusf_(float x) { return x > 20.f ? x : log1pf(expf(x)); }
DEV float siluf_(float x) { return x * sigmoidf_(x); }

enum { I_XP = 0, I_XS, I_CKV, I_KPE, I_WKV, I_SHIFT, I_SSM, I_CONV, I_PT, I_NMIX, I_NFFN, I_FW1, I_FW2, I_MU, I_WRKV, I_W0, I_W1, I_W2, I_A0, I_A1, I_A2,
       I_V0, I_V1, I_V2, I_G1, I_G2, I_KK, I_KA, I_RK, I_LNW, I_LNB, I_RWO, I_MWIN, I_QNORM, I_KVNORM, I_WUQ, I_WUK, I_WUV, I_QNN, I_QRN, I_KNN, I_KRN, I_MWO,
       I_BWIN, I_CONVW, I_CONVB, I_DTB, I_ALOG, I_BD, I_BNORM, I_BWO };

#define UNROLL _Pragma("unroll")
#define GSL(i, n) for (size_t i = gtid; i < (size_t)(n); i += gsz)

DEV void ph_copy_x(const Ctx& c, int, size_t gtid, size_t gsz) {
    using namespace cfg;
    GSL(i, (size_t)MTOT * D) c.x[i] = i < (size_t)MP * D ? c.in[I_XP][i] : c.in[I_XS][i - (size_t)MP * D];
}
DEV void rmsnorm_rows(const float* x, const float* gain, float* xn, size_t gtid, size_t gsz) {
    using namespace cfg;
    GSL(m, MTOT) {
        const float* xr = x + m * D; float ss = 0.f;
        for (int i = 0; i < D; ++i) ss += xr[i] * xr[i];
        const float rs = 1.0f / sqrtf(ss / D + NORM_EPS);
        for (int i = 0; i < D; ++i) xn[m * D + i] = xr[i] * rs * gain[i];
    }
}
DEV void ph_norm_mix(const Ctx& c, int l, size_t gtid, size_t gsz) { rmsnorm_rows(c.x, c.in[I_NMIX] + l * cfg::D, c.xn, gtid, gsz); }
DEV void ph_norm_ffn(const Ctx& c, int l, size_t gtid, size_t gsz) { rmsnorm_rows(c.x, c.in[I_NFFN] + l * cfg::D, c.xn, gtid, gsz); }

DEV void ph_rw_mix(const Ctx& c, int l, size_t gtid, size_t gsz) {
    using namespace cfg; const int j = l / 3;
    GSL(i, (size_t)MTOT * D) {
        const int m = (int)(i / D), ch = (int)(i % D), t = row_t(m), sq = row_seq(m);
        const float xc = c.xn[i];
        float xp;
        if (t > 0) xp = c.xn[i - D];
        else xp = sq < BATCH ? 0.f : c.in[I_SHIFT][((size_t)j * DB + (sq - BATCH)) * D + ch];
        for (int p = 0; p < 6; ++p) c.xm[p][i] = xc + (xp - xc) * c.in[I_MU][((size_t)j * 6 + p) * D + ch];
        if (t == seq_len(sq) - 1) {
            if (sq < BATCH) c.out[O_SHP + ((size_t)j * BATCH + sq) * D + ch] = xc;
            else c.out[O_SHS + ((size_t)j * DB + (sq - BATCH)) * D + ch] = xc;
        }
    }
}
DEV void ph_rw_prep(const Ctx& c, int l, size_t gtid, size_t gsz) {
    using namespace cfg; const int j = l / 3;
    GSL(i, (size_t)MTOT * RHEADS) {
        const int m = (int)(i / RHEADS), h = (int)(i % RHEADS);
        const size_t o = (size_t)m * D + h * RH;
        float nn = 0.f;
        for (int e = 0; e < RH; ++e) { const float kk = c.k[o + e] * c.in[I_KK][j * D + h * RH + e]; nn += kk * kk; }
        const float inv = 1.0f / fmaxf(sqrtf(nn), 1e-12f);
        for (int e = 0; e < RH; ++e) {
            const int ch = h * RH + e;
            const float wl = -softplusf_(-(c.in[I_W0][j * D + ch] + c.wpre[o + e])) - 0.5f;
            const float decay = expf(-expf(wl));
            float vv = c.v[o + e];
            if (j == 0) c.vf[o + e] = vv;
            else vv = vv + (c.vf[o + e] - vv) * sigmoidf_(c.in[I_V0][(j - 1) * D + ch] + c.vpre[o + e]);
            const float a = sigmoidf_(c.in[I_A0][j * D + ch] + c.apre[o + e]);
            const float k0 = c.k[o + e];
            const float kk = k0 * c.in[I_KK][j * D + ch] * inv;
            c.k[o + e] = k0 * (1.0f + (a - 1.0f) * c.in[I_KA][j * D + ch]);
            c.v[o + e] = vv;
            c.wpre[o + e] = decay;
            c.ka[o + e] = -kk;
            c.kb[o + e] = kk * a;
        }
    }
}
DEV void ph_rw_scan(const Ctx& c, int l, size_t gtid, size_t gsz) {
    using namespace cfg; const int j = l / 3;
    GSL(i, (size_t)NSEQ * RHEADS * RH) {
        const int sq = (int)(i / (RHEADS * RH)), h = (int)(i / RH) % RHEADS, vi = (int)(i % RH);
        float S[RH];
        if (sq < BATCH) { UNROLL for (int e = 0; e < RH; ++e) S[e] = 0.f; }
        else { const float* s0 = c.in[I_WKV] + ((((size_t)j * DB + (sq - BATCH)) * RHEADS + h) * RH + vi) * RH; UNROLL for (int e = 0; e < RH; ++e) S[e] = s0[e]; }
        const int m0 = seq_row0(sq), T = seq_len(sq);
        for (int t = 0; t < T; ++t) {
            const size_t o = (size_t)(m0 + t) * D + h * RH;
            float sa = 0.f;
            UNROLL for (int e = 0; e < RH; ++e) sa += S[e] * c.ka[o + e];
            const float vt = c.v[o + vi]; float yy = 0.f;
            UNROLL for (int e = 0; e < RH; ++e) { S[e] = S[e] * c.wpre[o + e] + sa * c.kb[o + e] + vt * c.k[o + e]; yy += S[e] * c.r[o + e]; }
            c.y[o + vi] = yy;
        }
        float* so = sq < BATCH ? c.out + O_WKVP + ((((size_t)j * BATCH + sq) * RHEADS + h) * RH + vi) * RH
                               : c.out + O_WKVS + ((((size_t)j * DB + (sq - BATCH)) * RHEADS + h) * RH + vi) * RH;
        UNROLL for (int e = 0; e < RH; ++e) so[e] = S[e];
    }
}
DEV void ph_rw_post(const Ctx& c, int l, size_t gtid, size_t gsz) {
    using namespace cfg; const int j = l / 3;
    GSL(i, (size_t)MTOT * RHEADS) {
        const int m = (int)(i / RHEADS), h = (int)(i % RHEADS);
        const size_t o = (size_t)m * D + h * RH;
        float mean = 0.f; for (int e = 0; e < RH; ++e) mean += c.y[o + e]; mean /= RH;
        float var = 0.f; for (int e = 0; e < RH; ++e) { const float d = c.y[o + e] - mean; var += d * d; } var /= RH;
        const float rs = 1.0f / sqrtf(var + LNX_EPS);
        float bonus = 0.f; for (int e = 0; e < RH; ++e) bonus += c.r[o + e] * c.k[o + e] * c.in[I_RK][(size_t)j * D + h * RH + e];
        for (int e = 0; e < RH; ++e) {
            const int ch = h * RH + e;
            const float yn = (c.y[o + e] - mean) * rs * c.in[I_LNW][j * D + ch] + c.in[I_LNB][j * D + ch];
            c.yo[o + e] = (yn + bonus * c.v[o + e]) * c.g[o + e];
        }
    }
}

DEV void rope_apply(const float* xin, float* xout, int pos) {
    using namespace cfg; const int half = ROPE / 2;
    UNROLL for (int i = 0; i < half; ++i) {
        const float inv = exp2f(-(float)i * (13.287712379549449f / half));
        const float ang = (float)pos * inv;
        const float kq = rintf(ang * 0.15915494309189535f);
        float rr = fmaf(-kq, 6.28125f, ang); rr = fmaf(-kq, 1.9353071795864769e-3f, rr);
        const float cs = __cosf(rr), sn = __sinf(rr);
        const float x1 = xin[i], x2 = xin[i + half];
        xout[i] = x1 * cs - x2 * sn; xout[i + half] = x2 * cs + x1 * sn;
    }
}
DEV int row_pos(int m) { return m < cfg::MP ? m % cfg::SEQ : cfg::PAST + (m - cfg::MP) % cfg::DS; }
DEV void ph_mla_norm1(const Ctx& c, int l, size_t gtid, size_t gsz) {
    using namespace cfg; const int j = l / 3;
    GSL(m, MTOT) {
        const float* h = c.mh + m * MLA_IN;
        float ss = 0.f; for (int i = 0; i < QL; ++i) ss += h[i] * h[i];
        float rs = 1.0f / sqrtf(ss / QL + NORM_EPS);
        for (int i = 0; i < QL; ++i) c.qan[m * QL + i] = h[i] * rs * c.in[I_QNORM][j * QL + i];
        ss = 0.f; for (int i = 0; i < KVL; ++i) ss += h[QL + i] * h[QL + i];
        rs = 1.0f / sqrtf(ss / KVL + NORM_EPS);
        float* co = m < (size_t)MP ? c.out + O_CKVP + ((size_t)j * MP + m) * KVL : c.out + O_CKVS + ((size_t)j * MS + (m - MP)) * KVL;
        for (int i = 0; i < KVL; ++i) { const float v = h[QL + i] * rs * c.in[I_KVNORM][j * KVL + i]; c.c[m * KVL + i] = v; co[i] = v; }
        ss = 0.f; UNROLL for (int i = 0; i < ROPE; ++i) ss += h[QL + KVL + i] * h[QL + KVL + i];
        rs = 1.0f / sqrtf(ss / ROPE + NORM_EPS);
        float tmp[ROPE], ro[ROPE];
        UNROLL for (int i = 0; i < ROPE; ++i) tmp[i] = h[QL + KVL + i] * rs * c.in[I_KRN][j * ROPE + i];
        rope_apply(tmp, ro, row_pos((int)m));
        float* ko = m < (size_t)MP ? c.out + O_KPEP + ((size_t)j * MP + m) * ROPE : c.out + O_KPES + ((size_t)j * MS + (m - MP)) * ROPE;
        UNROLL for (int i = 0; i < ROPE; ++i) { c.kp[m * ROPE + i] = ro[i]; ko[i] = ro[i]; }
    }
}
DEV void ph_mla_norm2(const Ctx& c, int l, size_t gtid, size_t gsz) {
    using namespace cfg; const int j = l / 3;
    GSL(i, (size_t)MTOT * MH) {
        const int m = (int)(i / MH), h = (int)(i % MH);
        float* q = c.q + (size_t)m * MH * QD + h * QD;
        float ss = 0.f; UNROLL for (int e = 0; e < NOPE; ++e) ss += q[e] * q[e];
        float rs = 1.0f / sqrtf(ss / NOPE + NORM_EPS);
        UNROLL for (int e = 0; e < NOPE; ++e) q[e] = q[e] * rs * c.in[I_QNN][j * NOPE + e];
        ss = 0.f; UNROLL for (int e = 0; e < ROPE; ++e) ss += q[NOPE + e] * q[NOPE + e];
        rs = 1.0f / sqrtf(ss / ROPE + NORM_EPS);
        float tmp[ROPE], ro[ROPE];
        UNROLL for (int e = 0; e < ROPE; ++e) tmp[e] = q[NOPE + e] * rs * c.in[I_QRN][j * ROPE + e];
        rope_apply(tmp, ro, row_pos(m));
        UNROLL for (int e = 0; e < ROPE; ++e) q[NOPE + e] = ro[e];
        float* kn = c.knr + (size_t)m * MH * NOPE + h * NOPE;
        ss = 0.f; UNROLL for (int e = 0; e < NOPE; ++e) ss += kn[e] * kn[e];
        rs = 1.0f / sqrtf(ss / NOPE + NORM_EPS);
        UNROLL for (int e = 0; e < NOPE; ++e) kn[e] = kn[e] * rs * c.in[I_KNN][j * NOPE + e];
    }
}
DEV void ph_mla_attn_prompt(const Ctx& c, int, size_t gtid, size_t gsz) {
    using namespace cfg; const float scale = 1.0f / sqrtf((float)QD);
    GSL(i, (size_t)MP * MH) {
        const int m = (int)(i / MH), h = (int)(i % MH), t = m % SEQ, m0 = m - t;
        const float* q = c.q + (size_t)m * MH * QD + h * QD;
        float mx = -INFINITY, den = 0.f, acc[VD];
        UNROLL for (int e = 0; e < VD; ++e) acc[e] = 0.f;
        for (int kx = 0; kx <= t; ++kx) {
            const int mk = m0 + kx;
            const float* kn = c.knr + (size_t)mk * MH * NOPE + h * NOPE; const float* kp = c.kp + (size_t)mk * ROPE;
            float s = 0.f;
            UNROLL for (int e = 0; e < NOPE; ++e) s += q[e] * kn[e];
            UNROLL for (int e = 0; e < ROPE; ++e) s += q[NOPE + e] * kp[e];
            s *= scale;
            const float nm = fmaxf(mx, s), corr = expf(mx - nm), p = expf(s - nm);
            den = den * corr + p;
            const float* v = c.vv + (size_t)mk * MH * VD + h * VD;
            UNROLL for (int e = 0; e < VD; ++e) acc[e] = acc[e] * corr + p * v[e];
            mx = nm;
        }
        UNROLL for (int e = 0; e < VD; ++e) c.ao[(size_t)m * MH * VD + h * VD + e] = acc[e] / den;
    }
}
DEV const float* smp_c(const Ctx& c, int j, int s, int pos) {
    using namespace cfg;
    if (pos < PAST) { const int pg = c.page_table[s * NPAGES + pos / PAGE]; return c.in[I_CKV] + (((size_t)j * NPOOL + pg) * PAGE + pos % PAGE) * KVL; }
    return c.c + (size_t)(MP + s * DS + (pos - PAST)) * KVL;
}
DEV const float* smp_kp(const Ctx& c, int j, int s, int pos) {
    using namespace cfg;
    if (pos < PAST) { const int pg = c.page_table[s * NPAGES + pos / PAGE]; return c.in[I_KPE] + (((size_t)j * NPOOL + pg) * PAGE + pos % PAGE) * ROPE; }
    return c.kp + (size_t)(MP + s * DS + (pos - PAST)) * ROPE;
}
DEV void ph_mla_score_sample(const Ctx& c, int l, size_t gtid, size_t gsz) {
    using namespace cfg; const int j = l / 3; const float scale = 1.0f / sqrtf((float)QD);
    GSL(i, (size_t)DB * KTOT * MH) {
        const int pos = (int)(i % KTOT), h = (int)((i / KTOT) % MH), s = (int)(i / ((size_t)MH * KTOT));
        const float* cl = smp_c(c, j, s, pos); const float* kp = smp_kp(c, j, s, pos);
        float kn[NOPE];
        UNROLL for (int e = 0; e < NOPE; ++e) kn[e] = 0.f;
        const float* wuk = c.in[I_WUK] + (size_t)j * KVL * MH * NOPE;
        for (int r = 0; r < KVL; ++r) { const float cv = cl[r]; const float* w = wuk + ((size_t)r * MH + h) * NOPE; UNROLL for (int e = 0; e < NOPE; ++e) kn[e] += cv * w[e]; }
        float ss = 0.f; UNROLL for (int e = 0; e < NOPE; ++e) ss += kn[e] * kn[e];
        const float rs = 1.0f / sqrtf(ss / NOPE + NORM_EPS);
        UNROLL for (int e = 0; e < NOPE; ++e) kn[e] = kn[e] * rs * c.in[I_KNN][j * NOPE + e];
        for (int qi = 0; qi < DS; ++qi) {
            const float* q = c.q + (size_t)(MP + s * DS + qi) * MH * QD + h * QD;
            float sc = 0.f;
            UNROLL for (int e = 0; e < NOPE; ++e) sc += q[e] * kn[e];
            UNROLL for (int e = 0; e < ROPE; ++e) sc += q[NOPE + e] * kp[e];
            const bool ok = pos < PAST || (pos - PAST) <= qi;
            c.sc[(((size_t)s * MH + h) * DS + qi) * KTOT + pos] = ok ? sc * scale : -INFINITY;
        }
    }
}
DEV void ph_mla_softmax_sample(const Ctx& c, int, size_t gtid, size_t gsz) {
    using namespace cfg;
    GSL(i, (size_t)DB * MH * DS) {
        float* sc = c.sc + i * KTOT;
        float mx = -INFINITY; for (int p = 0; p < KTOT; ++p) mx = fmaxf(mx, sc[p]);
        float den = 0.f; for (int p = 0; p < KTOT; ++p) den += expf(sc[p] - mx);
        const float inv = 1.0f / den;
        for (int p = 0; p < KTOT; ++p) sc[p] = expf(sc[p] - mx) * inv;
    }
}
DEV void ph_mla_pv_sample(const Ctx& c, int l, size_t gtid, size_t gsz) {
    using namespace cfg; const int j = l / 3;
    GSL(i, (size_t)DB * MH * DS * KVL) {
        const int r = (int)(i % KVL); const size_t row = i / KVL; const int s = (int)(row / (MH * DS));
        const float* p = c.sc + row * KTOT; float acc = 0.f;
        for (int pos = 0; pos < KTOT; ++pos) acc += p[pos] * smp_c(c, j, s, pos)[r];
        c.olat[i] = acc;
    }
}
DEV void ph_mla_out_sample(const Ctx& c, int l, size_t gtid, size_t gsz) {
    using namespace cfg; const int j = l / 3;
    GSL(i, (size_t)MS * MH * VD) {
        const int e = (int)(i % VD), h = (int)((i / VD) % MH), ms = (int)(i / (MH * VD)), s = ms / DS, qi = ms % DS;
        const float* ol = c.olat + (((size_t)s * MH + h) * DS + qi) * KVL;
        const float* wuv = c.in[I_WUV] + (size_t)j * KVL * MH * VD;
        float acc = 0.f;
        for (int r = 0; r < KVL; ++r) acc += ol[r] * wuv[((size_t)r * MH + h) * VD + e];
        c.ao[(size_t)(MP + ms) * MH * VD + h * VD + e] = acc;
    }
}

DEV float mb_xpad(const Ctx& c, int j, int m, int sq, int tt, int ch) {
    using namespace cfg;
    if (tt < MB_CONV - 1) return sq < BATCH ? 0.f : c.in[I_CONV][(((size_t)j * DB + (sq - BATCH)) * (MB_CONV - 1) + tt) * MB_CD + ch];
    (void)m; return c.zx[(size_t)(seq_row0(sq) + tt - (MB_CONV - 1)) * MB_IN + MB_INNER + ch];
}
DEV void ph_mb_conv(const Ctx& c, int l, size_t gtid, size_t gsz) {
    using namespace cfg; const int j = l / 3;
    GSL(i, (size_t)MTOT * MB_CD) {
        const int m = (int)(i / MB_CD), ch = (int)(i % MB_CD), t = row_t(m), sq = row_seq(m), T = seq_len(sq);
        float acc = c.in[I_CONVB][j * MB_CD + ch];
        for (int jj = 0; jj < MB_CONV; ++jj) acc += mb_xpad(c, j, m, sq, t + jj, ch) * c.in[I_CONVW][((size_t)j * MB_CONV + jj) * MB_CD + ch];
        c.xbc[i] = siluf_(acc);
        if (t < MB_CONV - 1) {
            const float v = mb_xpad(c, j, m, sq, T + t, ch);
            if (sq < BATCH) c.out[O_CONVP + (((size_t)j * BATCH + sq) * (MB_CONV - 1) + t) * MB_CD + ch] = v;
            else c.out[O_CONVS + (((size_t)j * DB + (sq - BATCH)) * (MB_CONV - 1) + t) * MB_CD + ch] = v;
        }
    }
}
DEV void ph_mb_dt(const Ctx& c, int l, size_t gtid, size_t gsz) {
    using namespace cfg; const int j = l / 3;
    GSL(i, (size_t)MTOT * MB_HEADS) {
        const int m = (int)(i / MB_HEADS), h = (int)(i % MB_HEADS);
        c.dt[i] = softplusf_(c.zx[(size_t)m * MB_IN + MB_INNER + MB_CD + h] + c.in[I_DTB][j * MB_HEADS + h]);
    }
}
DEV void ph_mb_scan(const Ctx& c, int l, size_t gtid, size_t gsz) {
    using namespace cfg; const int j = l / 3;
    GSL(i, (size_t)NSEQ * MB_HEADS * MB_HEAD) {
        const int p = (int)(i % MB_HEAD), h = (int)((i / MB_HEAD) % MB_HEADS), sq = (int)(i / (MB_HEADS * MB_HEAD));
        const int g = h / (MB_HEADS / MB_GROUPS);
        float hs[MB_STATE];
        if (sq < BATCH) { UNROLL for (int n = 0; n < MB_STATE; ++n) hs[n] = 0.f; }
        else { const float* s0 = c.in[I_SSM] + ((((size_t)j * DB + (sq - BATCH)) * MB_HEADS + h) * MB_HEAD + p) * MB_STATE; UNROLL for (int n = 0; n < MB_STATE; ++n) hs[n] = s0[n]; }
        const float A = -expf(c.in[I_ALOG][j * MB_HEADS + h]), dsk = c.in[I_BD][j * MB_HEADS + h];
        const int m0 = seq_row0(sq), T = seq_len(sq);
        for (int t = 0; t < T; ++t) {
            const size_t m = (size_t)(m0 + t);
            const float dtv = c.dt[m * MB_HEADS + h], dA = expf(dtv * A);
            const float xv = c.xbc[m * MB_CD + h * MB_HEAD + p], xdt = xv * dtv;
            const float* Bm = c.xbc + m * MB_CD + MB_INNER + g * MB_STATE; const float* Cm = Bm + MB_GN;
            float yy = 0.f;
            UNROLL for (int n = 0; n < MB_STATE; ++n) { hs[n] = hs[n] * dA + xdt * Bm[n]; yy += Cm[n] * hs[n]; }
            c.my[m * MB_INNER + h * MB_HEAD + p] = yy + dsk * xv;
        }
        float* so = sq < BATCH ? c.out + O_SSMP + ((((size_t)j * BATCH + sq) * MB_HEADS + h) * MB_HEAD + p) * MB_STATE
                               : c.out + O_SSMS + ((((size_t)j * DB + (sq - BATCH)) * MB_HEADS + h) * MB_HEAD + p) * MB_STATE;
        UNROLL for (int n = 0; n < MB_STATE; ++n) so[n] = hs[n];
    }
}
DEV void ph_mb_gate(const Ctx& c, int l, size_t gtid, size_t gsz) {
    using namespace cfg; const int j = l / 3; constexpr int GW = MB_INNER / MB_GROUPS;
    GSL(i, (size_t)MTOT * MB_GROUPS) {
        const int m = (int)(i / MB_GROUPS), g = (int)(i % MB_GROUPS);
        float ss = 0.f;
        for (int e = 0; e < GW; ++e) { const float v = c.my[(size_t)m * MB_INNER + g * GW + e] * siluf_(c.zx[(size_t)m * MB_IN + g * GW + e]); ss += v * v; }
        const float rs = 1.0f / sqrtf(ss / GW + NORM_EPS);
        for (int e = 0; e < GW; ++e) {
            const float v = c.my[(size_t)m * MB_INNER + g * GW + e] * siluf_(c.zx[(size_t)m * MB_IN + g * GW + e]);
            c.yzn[(size_t)m * MB_INNER + g * GW + e] = v * rs * c.in[I_BNORM][j * MB_INNER + g * GW + e];
        }
    }
}
typedef short bf16x8_t __attribute__((ext_vector_type(8)));
typedef float f32x4_t __attribute__((ext_vector_type(4)));
__device__ __forceinline__ unsigned short f2bf(float f) { unsigned u = __float_as_uint(f); u += 0x7fffu + ((u >> 16) & 1u); return (unsigned short)(u >> 16); }

template <int ACT, bool ACC>
__global__ void __launch_bounds__(256) gemm_naive(const float* __restrict__ A, int lda, const float* __restrict__ B, int ldb, float* C, int ldc, int M, int N, int K) {
    __shared__ __attribute__((aligned(16))) unsigned short As[128][40];
    __shared__ __attribute__((aligned(16))) unsigned short Bs[128][40];
    const int bm = blockIdx.y * 128, bn = blockIdx.x * 128;
    const int tid = threadIdx.x, wave = tid >> 6, lane = tid & 63, wr = wave >> 1, wc = wave & 1, fr = lane & 15, fq = lane >> 4;
    f32x4_t acc[4][4];
#pragma unroll
    for (int i = 0; i < 4; ++i)
#pragma unroll
        for (int j = 0; j < 4; ++j) acc[i][j] = (f32x4_t){0.f, 0.f, 0.f, 0.f};
    for (int k0 = 0; k0 < K; k0 += 32) {
#pragma unroll
        for (int it = 0; it < 4; ++it) {
            const int idx = tid + it * 256, row = idx >> 3, c4 = idx & 7, gm = bm + row;
            float4 v = make_float4(0.f, 0.f, 0.f, 0.f);
            if (gm < M) v = *(const float4*)(A + (size_t)gm * lda + k0 + c4 * 4);
            uint2 w; w.x = (unsigned)f2bf(v.x) | ((unsigned)f2bf(v.y) << 16); w.y = (unsigned)f2bf(v.z) | ((unsigned)f2bf(v.w) << 16);
            *(uint2*)&As[row][c4 * 4] = w;
        }
#pragma unroll
        for (int it = 0; it < 4; ++it) {
            const int idx = tid + it * 256, kr = idx >> 5, n4 = idx & 31, gn = bn + n4 * 4;
            float4 v = make_float4(0.f, 0.f, 0.f, 0.f);
            if (gn < N) v = *(const float4*)(B + (size_t)(k0 + kr) * ldb + gn);
            Bs[n4 * 4 + 0][kr] = f2bf(v.x); Bs[n4 * 4 + 1][kr] = f2bf(v.y); Bs[n4 * 4 + 2][kr] = f2bf(v.z); Bs[n4 * 4 + 3][kr] = f2bf(v.w);
        }
        __syncthreads();
        bf16x8_t a[4], b[4];
#pragma unroll
        for (int i = 0; i < 4; ++i) a[i] = *(const bf16x8_t*)&As[wr * 64 + i * 16 + fr][fq * 8];
#pragma unroll
        for (int j = 0; j < 4; ++j) b[j] = *(const bf16x8_t*)&Bs[wc * 64 + j * 16 + fr][fq * 8];
#pragma unroll
        for (int i = 0; i < 4; ++i)
#pragma unroll
            for (int j = 0; j < 4; ++j) acc[i][j] = __builtin_amdgcn_mfma_f32_16x16x32_bf16(a[i], b[j], acc[i][j], 0, 0, 0);
        __syncthreads();
    }
#pragma unroll
    for (int i = 0; i < 4; ++i)
#pragma unroll
        for (int j = 0; j < 4; ++j)
#pragma unroll
            for (int e = 0; e < 4; ++e) {
                const int row = bm + wr * 64 + i * 16 + fq * 4 + e, col = bn + wc * 64 + j * 16 + fr;
                if (row < M && col < N) {
                    float v = acc[i][j][e];
                    if (ACT == 1) v = tanhf(v); else if (ACT == 2) v = 1.0f / (1.0f + expf(-v)); else if (ACT == 3) v = v > 0.f ? v * v : 0.f;
                    float* cp = C + (size_t)row * ldc + col; *cp = ACC ? *cp + v : v;
                }
            }
}
#define DEF_K(ph) __global__ void __launch_bounds__(256) g_##ph(Ctx c, int l) { ph(c, l, (size_t)blockIdx.x * 256 + threadIdx.x, (size_t)gridDim.x * 256); }
DEF_K(ph_copy_x) DEF_K(ph_norm_mix) DEF_K(ph_norm_ffn) DEF_K(ph_rw_mix) DEF_K(ph_rw_prep) DEF_K(ph_rw_scan) DEF_K(ph_rw_post)
DEF_K(ph_mla_norm1) DEF_K(ph_mla_norm2) DEF_K(ph_mla_attn_prompt) DEF_K(ph_mla_score_sample) DEF_K(ph_mla_softmax_sample) DEF_K(ph_mla_pv_sample) DEF_K(ph_mla_out_sample)
DEF_K(ph_mb_conv) DEF_K(ph_mb_dt) DEF_K(ph_mb_scan) DEF_K(ph_mb_gate)

#ifdef CPU_EMU
template <int ACT, bool ACC>
static void gemm_any(const float* A, int lda, const float* B, int ldb, float* C, int ldc, int M, int N, int K) {
    for (int m = 0; m < M; ++m)
        for (int n = 0; n < N; ++n) {
            double acc = 0.0;
            for (int k = 0; k < K; ++k) acc += (double)A[(size_t)m * lda + k] * (double)B[(size_t)k * ldb + n];
            float v = (float)acc;
            if (ACT == 1) v = tanhf(v); else if (ACT == 2) v = 1.0f / (1.0f + expf(-v)); else if (ACT == 3) { v = v > 0.f ? v * v : 0.f; }
            float* cp = C + (size_t)m * ldc + n; *cp = ACC ? *cp + v : v;
        }
}
#define RUN(ph, l, n) ph(c, l, 0, 1)
#define GEMM(ACT, ACC, A, lda, B, ldb, C, ldc, M, N, K) gemm_any<ACT, ACC>(A, lda, B, ldb, C, ldc, M, N, K)
#else
#define RUN(ph, l, n) g_##ph<<<(unsigned)((((size_t)(n) + 255) / 256) < 65536 * 16 ? (((size_t)(n) + 255) / 256) : 65536 * 16), 256, 0, stream>>>(c, l)
#define GEMM(ACT, ACC, A, lda, B, ldb, C, ldc, M, N, K) gemm_naive<ACT, ACC><<<dim3(((N) + 127) / 128, ((M) + 127) / 128), 256, 0, stream>>>(A, lda, B, ldb, C, ldc, M, N, K)
#endif

struct Bump { char* p; size_t off; float* f(size_t n) { float* r = (float*)(p + off); off += ((n * 4 + 255) / 256) * 256; return r; } };

static size_t setup_ctx(Ctx& c, void* const* d_in, void* d_out, void* d_ws) {
    using namespace cfg;
    for (int i = 0; i < 51; ++i) c.in[i] = (const float*)d_in[i];
    c.page_table = (const int*)d_in[I_PT];
    c.out = (float*)d_out; c.x = c.out;
    Bump b{(char*)d_ws, 4096 * 4};
    const size_t MD = (size_t)MTOT * D;
    c.xn = b.f(MD); c.vf = b.f(MD);
    const size_t base = b.off;
    for (int p = 0; p < 6; ++p) c.xm[p] = b.f(MD);
    c.r = b.f(MD); c.k = b.f(MD); c.v = b.f(MD); c.wpre = b.f(MD); c.apre = b.f(MD); c.vpre = b.f(MD); c.g = b.f(MD);
    c.hw = b.f((size_t)MTOT * RW_DL); c.ha = b.f((size_t)MTOT * RW_AL); c.hv = b.f((size_t)MTOT * RW_VL); c.hg = b.f((size_t)MTOT * RW_GL);
    c.ka = b.f(MD); c.kb = b.f(MD); c.y = c.xm[0]; c.yo = c.xm[1];
    size_t hi = b.off;
    b.off = base;
    c.mh = b.f((size_t)MTOT * MLA_IN); c.qan = b.f((size_t)MTOT * QL); c.q = b.f((size_t)MTOT * MH * QD); c.c = b.f((size_t)MTOT * KVL); c.kp = b.f((size_t)MTOT * ROPE);
    c.knr = b.f((size_t)MTOT * MH * NOPE); c.vv = b.f((size_t)MTOT * MH * VD); c.ao = b.f((size_t)MTOT * MH * VD);
    c.sc = b.f((size_t)DB * MH * DS * KTOT); c.olat = b.f((size_t)DB * MH * DS * KVL);
    if (b.off > hi) hi = b.off;
    b.off = base;
    c.zx = b.f((size_t)MTOT * MB_IN); c.xbc = b.f((size_t)MTOT * MB_CD); c.dt = b.f((size_t)MTOT * MB_HEADS); c.my = b.f((size_t)MTOT * MB_INNER); c.yzn = b.f((size_t)MTOT * MB_INNER);
    if (b.off > hi) hi = b.off;
    b.off = hi;
    c.hmid = b.f((size_t)MTOT * FFN);
    return b.off;
}

#ifdef CPU_EMU
static void run_forward(const Ctx& c) {
#else
static void run_forward(const Ctx& c, hipStream_t stream) {
#endif
    using namespace cfg;
    RUN(ph_copy_x, 0, (size_t)MTOT * D);
    for (int l = 0; l < DEPTH; ++l) {
        const int kind = l % 3, j = l / 3;
        RUN(ph_norm_mix, l, MTOT);
        if (kind == 0) {
            RUN(ph_rw_mix, l, (size_t)MTOT * D);
            const float* W = c.in[I_WRKV] + (size_t)j * 3 * D * D;
            GEMM(0, false, c.xm[0], D, W, D, c.r, D, MTOT, D, D);
            GEMM(0, false, c.xm[1], D, W + (size_t)D * D, D, c.k, D, MTOT, D, D);
            GEMM(0, false, c.xm[2], D, W + (size_t)2 * D * D, D, c.v, D, MTOT, D, D);
            GEMM(1, false, c.xm[3], D, c.in[I_W1] + (size_t)j * D * RW_DL, RW_DL, c.hw, RW_DL, MTOT, RW_DL, D);
            GEMM(0, false, c.hw, RW_DL, c.in[I_W2] + (size_t)j * RW_DL * D, D, c.wpre, D, MTOT, D, RW_DL);
            GEMM(0, false, c.xm[4], D, c.in[I_A1] + (size_t)j * D * RW_AL, RW_AL, c.ha, RW_AL, MTOT, RW_AL, D);
            GEMM(0, false, c.ha, RW_AL, c.in[I_A2] + (size_t)j * RW_AL * D, D, c.apre, D, MTOT, D, RW_AL);
            if (j > 0) {
                GEMM(0, false, c.xm[2], D, c.in[I_V1] + (size_t)(j - 1) * D * RW_VL, RW_VL, c.hv, RW_VL, MTOT, RW_VL, D);
                GEMM(0, false, c.hv, RW_VL, c.in[I_V2] + (size_t)(j - 1) * RW_VL * D, D, c.vpre, D, MTOT, D, RW_VL);
            }
            GEMM(2, false, c.xm[5], D, c.in[I_G1] + (size_t)j * D * RW_GL, RW_GL, c.hg, RW_GL, MTOT, RW_GL, D);
            GEMM(0, false, c.hg, RW_GL, c.in[I_G2] + (size_t)j * RW_GL * D, D, c.g, D, MTOT, D, RW_GL);
            RUN(ph_rw_prep, l, (size_t)MTOT * RHEADS);
            RUN(ph_rw_scan, l, (size_t)NSEQ * RHEADS * RH);
            RUN(ph_rw_post, l, (size_t)MTOT * RHEADS);
            GEMM(0, true, c.yo, D, c.in[I_RWO] + (size_t)j * D * D, D, c.x, D, MTOT, D, D);
        } else if (kind == 1) {
            GEMM(0, false, c.xn, D, c.in[I_MWIN] + (size_t)j * D * MLA_IN, MLA_IN, c.mh, MLA_IN, MTOT, MLA_IN, D);
            RUN(ph_mla_norm1, l, MTOT);
            GEMM(0, false, c.qan, QL, c.in[I_WUQ] + (size_t)j * QL * MH * QD, MH * QD, c.q, MH * QD, MTOT, MH * QD, QL);
            GEMM(0, false, c.c, KVL, c.in[I_WUK] + (size_t)j * KVL * MH * NOPE, MH * NOPE, c.knr, MH * NOPE, MTOT, MH * NOPE, KVL);
            GEMM(0, false, c.c, KVL, c.in[I_WUV] + (size_t)j * KVL * MH * VD, MH * VD, c.vv, MH * VD, MTOT, MH * VD, KVL);
            RUN(ph_mla_norm2, l, (size_t)MTOT * MH);
            RUN(ph_mla_attn_prompt, l, (size_t)MP * MH);
            RUN(ph_mla_score_sample, l, (size_t)DB * KTOT * MH);
            RUN(ph_mla_softmax_sample, l, (size_t)DB * MH * DS);
            RUN(ph_mla_pv_sample, l, (size_t)DB * MH * DS * KVL);
            RUN(ph_mla_out_sample, l, (size_t)MS * MH * VD);
            GEMM(0, true, c.ao, MH * VD, c.in[I_MWO] + (size_t)j * MH * VD * D, D, c.x, D, MTOT, D, MH * VD);
        } else {
            GEMM(0, false, c.xn, D, c.in[I_BWIN] + (size_t)j * D * MB_IN, MB_IN, c.zx, MB_IN, MTOT, MB_IN, D);
            RUN(ph_mb_conv, l, (size_t)MTOT * MB_CD);
            RUN(ph_mb_dt, l, (size_t)MTOT * MB_HEADS);
            RUN(ph_mb_scan, l, (size_t)NSEQ * MB_HEADS * MB_HEAD);
            RUN(ph_mb_gate, l, (size_t)MTOT * MB_GROUPS);
            GEMM(0, true, c.yzn, MB_INNER, c.in[I_BWO] + (size_t)j * MB_INNER * D, D, c.x, D, MTOT, D, MB_INNER);
        }
        RUN(ph_norm_ffn, l, MTOT);
        GEMM(3, false, c.xn, D, c.in[I_FW1] + (size_t)l * D * FFN, FFN, c.hmid, FFN, MTOT, FFN, D);
        GEMM(0, true, c.hmid, FFN, c.in[I_FW2] + (size_t)l * FFN * D, D, c.x, D, MTOT, D, FFN);
    }
}
extern "C" void kernel_launch(void* const* d_in, const int* in_sizes, int n_in, void* d_out, int out_size, void* d_ws, size_t ws_size, hipStream_t stream) {
    Ctx c{};
    const size_t used = setup_ctx(c, d_in, d_out, d_ws);
    if (used > ws_size || n_in != 51) { fprintf(stderr, "workspace too small: need %zu have %zu (n_in %d)\n", used, ws_size, n_in); return; }
    run_forward(c, stream);
}
```

```cpp
#include <hip/hip_runtime.h>
#include <cstdio>
#include <math.h>
#include <stdint.h>
#include <stddef.h>
#ifdef CPU_EMU
#define DEV inline
#else
#define DEV __device__ __forceinline__
#endif

namespace cfg {
#ifdef CFG_SMALL
constexpr int D = 128, BATCH = 2, SEQ = 32, DEPTH = 4, DB = 3, DS = 8, PAST = 64, PAGE = 16;
constexpr int RW_DL = 16, RW_AL = 16, RW_VL = 8, RW_GL = 24;
constexpr int MH = 2, QL = 64, KVL = 32;
constexpr int MB_GROUPS = 2;
#else
constexpr int D = 1024, BATCH = 16, SEQ = 2048, DEPTH = 4, DB = 128, DS = 8, PAST = 8192, PAGE = 128;
constexpr int RW_DL = 64, RW_AL = 64, RW_VL = 32, RW_GL = 160;
constexpr int MH = 16, QL = 512, KVL = 256;
constexpr int MB_GROUPS = 4;
#endif
constexpr int N_RWKV = (DEPTH + 2) / 3, N_MLA = (DEPTH + 1) / 3, N_MAMBA = DEPTH / 3;
constexpr int RH = 64, RHEADS = D / RH;
constexpr int NOPE = 64, ROPE = 32, VD = 64, QD = NOPE + ROPE;
constexpr int MLA_IN = QL + KVL + ROPE;
constexpr int MB_INNER = 2 * D, MB_HEAD = 64, MB_HEADS = MB_INNER / MB_HEAD, MB_STATE = 128, MB_CONV = 4;
constexpr int MB_GN = MB_GROUPS * MB_STATE;
constexpr int MB_CD = MB_INNER + 2 * MB_GN, MB_IN = MB_INNER + MB_CD + MB_HEADS;
constexpr int FFN = 4 * D;
constexpr int NPAGES = PAST / PAGE, NPOOL = (DB * NPAGES * 5) / 4;
constexpr int MP = BATCH * SEQ, MS = DB * DS, MTOT = MP + MS, NSEQ = BATCH + DB;
constexpr int KTOT = PAST + DS;
constexpr float NORM_EPS = 1e-6f, LNX_EPS = 64e-5f;
constexpr size_t O_YP = 0;
constexpr size_t O_YS = O_YP + (size_t)MP * D;
constexpr size_t O_CKVP = O_YS + (size_t)MS * D;
constexpr size_t O_KPEP = O_CKVP + (size_t)N_MLA * MP * KVL;
constexpr size_t O_CKVS = O_KPEP + (size_t)N_MLA * MP * ROPE;
constexpr size_t O_KPES = O_CKVS + (size_t)N_MLA * MS * KVL;
constexpr size_t O_WKVP = O_KPES + (size_t)N_MLA * MS * ROPE;
constexpr size_t O_SHP = O_WKVP + (size_t)N_RWKV * BATCH * RHEADS * RH * RH;
constexpr size_t O_WKVS = O_SHP + (size_t)N_RWKV * BATCH * D;
constexpr size_t O_SHS = O_WKVS + (size_t)N_RWKV * DB * RHEADS * RH * RH;
constexpr size_t O_SSMP = O_SHS + (size_t)N_RWKV * DB * D;
constexpr size_t O_CONVP = O_SSMP + (size_t)N_MAMBA * BATCH * MB_HEADS * MB_HEAD * MB_STATE;
constexpr size_t O_SSMS = O_CONVP + (size_t)N_MAMBA * BATCH * (MB_CONV - 1) * MB_CD;
constexpr size_t O_CONVS = O_SSMS + (size_t)N_MAMBA * DB * MB_HEADS * MB_HEAD * MB_STATE;
constexpr size_t O_END = O_CONVS + (size_t)N_MAMBA * DB * (MB_CONV - 1) * MB_CD;
}

struct Ctx {
    const float* in[51];
    const int* page_table;
    float* out;
    float *x, *xn, *vf;
    float* xm[6];
    float *r, *k, *v, *wpre, *apre, *vpre, *g, *hw, *ha, *hv, *hg, *ka, *kb, *y, *yo;
    float *hmid;
    float *mh, *qan, *q, *c, *kp, *knr, *vv, *ao, *sc, *olat;
    float *zx, *xbc, *dt, *my, *yzn;
};

DEV int row_t(int m) { return m < cfg::MP ? m % cfg::SEQ : (m - cfg::MP) % cfg::DS; }
DEV int row_seq(int m) { return m < cfg::MP ? m / cfg::SEQ : cfg::BATCH + (m - cfg::MP) / cfg::DS; }
DEV int seq_row0(int sq) { return sq < cfg::BATCH ? sq * cfg::SEQ : cfg::MP + (sq - cfg::BATCH) * cfg::DS; }
DEV int seq_len(int sq) { return sq < cfg::BATCH ? cfg::SEQ : cfg::DS; }
DEV float sigmoidf_(float x) { return 1.0f / (1.0f + expf(-x)); }
DEV float softplusf_(float x) { return x > 20.f ? x : log1pf(expf(x)); }
DEV float siluf_(float x) { return x * sigmoidf_(x); }

enum { I_XP = 0, I_XS, I_CKV, I_KPE, I_WKV, I_SHIFT, I_SSM, I_CONV, I_PT, I_NMIX, I_NFFN, I_FW1, I_FW2, I_MU, I_WRKV, I_W0, I_W1, I_W2, I_A0, I_A1, I_A2,
       I_V0, I_V1, I_V2, I_G1, I_G2, I_KK, I_KA, I_RK, I_LNW, I_LNB, I_RWO, I_MWIN, I_QNORM, I_KVNORM, I_WUQ, I_WUK, I_WUV, I_QNN, I_QRN, I_KNN, I_KRN, I_MWO,
       I_BWIN, I_CONVW, I_CONVB, I_DTB, I_ALOG, I_BD, I_BNORM, I_BWO };

#define UNROLL _Pragma("unroll")
#define GSL(i, n) for (size_t i = gtid; i < (size_t)(n); i += gsz)

DEV void ph_copy_x(const Ctx& c, int, size_t gtid, size_t gsz) {
    using namespace cfg;
    GSL(i, (size_t)MTOT * D) c.x[i] = i < (size_t)MP * D ? c.in[I_XP][i] : c.in[I_XS][i - (size_t)MP * D];
}
DEV void rmsnorm_rows(const float* x, const float* gain, float* xn, size_t gtid, size_t gsz) {
    using namespace cfg;
    GSL(m, MTOT) {
        const float* xr = x + m * D; float ss = 0.f;
        for (int i = 0; i < D; ++i) ss += xr[i] * xr[i];
        const float rs = 1.0f / sqrtf(ss / D + NORM_EPS);
        for (int i = 0; i < D; ++i) xn[m * D + i] = xr[i] * rs * gain[i];
    }
}
DEV void ph_norm_mix(const Ctx& c, int l, size_t gtid, size_t gsz) { rmsnorm_rows(c.x, c.in[I_NMIX] + l * cfg::D, c.xn, gtid, gsz); }
DEV void ph_norm_ffn(const Ctx& c, int l, size_t gtid, size_t gsz) { rmsnorm_rows(c.x, c.in[I_NFFN] + l * cfg::D, c.xn, gtid, gsz); }

DEV void ph_rw_mix(const Ctx& c, int l, size_t gtid, size_t gsz) {
    using namespace cfg; const int j = l / 3;
    GSL(i, (size_t)MTOT * D) {
        const int m = (int)(i / D), ch = (int)(i % D), t = row_t(m), sq = row_seq(m);
        const float xc = c.xn[i];
        float xp;
        if (t > 0) xp = c.xn[i - D];
        else xp = sq < BATCH ? 0.f : c.in[I_SHIFT][((size_t)j * DB + (sq - BATCH)) * D + ch];
        for (int p = 0; p < 6; ++p) c.xm[p][i] = xc + (xp - xc) * c.in[I_MU][((size_t)j * 6 + p) * D + ch];
        if (t == seq_len(sq) - 1) {
            if (sq < BATCH) c.out[O_SHP + ((size_t)j * BATCH + sq) * D + ch] = xc;
            else c.out[O_SHS + ((size_t)j * DB + (sq - BATCH)) * D + ch] = xc;
        }
    }
}
DEV void ph_rw_prep(const Ctx& c, int l, size_t gtid, size_t gsz) {
    using namespace cfg; const int j = l / 3;
    GSL(i, (size_t)MTOT * RHEADS) {
        const int m = (int)(i / RHEADS), h = (int)(i % RHEADS);
        const size_t o = (size_t)m * D + h * RH;
        float nn = 0.f;
        for (int e = 0; e < RH; ++e) { const float kk = c.k[o + e] * c.in[I_KK][j * D + h * RH + e]; nn += kk * kk; }
        const float inv = 1.0f / fmaxf(sqrtf(nn), 1e-12f);
        for (int e = 0; e < RH; ++e) {
            const int ch = h * RH + e;
            const float wl = -softplusf_(-(c.in[I_W0][j * D + ch] + c.wpre[o + e])) - 0.5f;
            const float decay = expf(-expf(wl));
            float vv = c.v[o + e];
            if (j == 0) c.vf[o + e] = vv;
            else vv = vv + (c.vf[o + e] - vv) * sigmoidf_(c.in[I_V0][(j - 1) * D + ch] + c.vpre[o + e]);
            const float a = sigmoidf_(c.in[I_A0][j * D + ch] + c.apre[o + e]);
            const float k0 = c.k[o + e];
            const float kk = k0 * c.in[I_KK][j * D + ch] * inv;
            c.k[o + e] = k0 * (1.0f + (a - 1.0f) * c.in[I_KA][j * D + ch]);
            c.v[o + e] = vv;
            c.wpre[o + e] = decay;
            c.ka[o + e] = -kk;
            c.kb[o + e] = kk * a;
        }
    }
}
DEV void ph_rw_scan(const Ctx& c, int l, size_t gtid, size_t gsz) {
    using namespace cfg; const int j = l / 3;
    GSL(i, (size_t)NSEQ * RHEADS * RH) {
        const int sq = (int)(i / (RHEADS * RH)), h = (int)(i / RH) % RHEADS, vi = (int)(i % RH);
        float S[RH];
        if (sq < BATCH) { UNROLL for (int e = 0; e < RH; ++e) S[e] = 0.f; }
        else { const float* s0 = c.in[I_WKV] + ((((size_t)j * DB + (sq - BATCH)) * RHEADS + h) * RH + vi) * RH; UNROLL for (int e = 0; e < RH; ++e) S[e] = s0[e]; }
        const int m0 = seq_row0(sq), T = seq_len(sq);
        for (int t = 0; t < T; ++t) {
            const size_t o = (size_t)(m0 + t) * D + h * RH;
            float sa = 0.f;
            UNROLL for (int e = 0; e < RH; ++e) sa += S[e] * c.ka[o + e];
            const float vt = c.v[o + vi]; float yy = 0.f;
            UNROLL for (int e = 0; e < RH; ++e) { S[e] = S[e] * c.wpre[o + e] + sa * c.kb[o + e] + vt * c.k[o + e]; yy += S[e] * c.r[o + e]; }
            c.y[o + vi] = yy;
        }
        float* so = sq < BATCH ? c.out + O_WKVP + ((((size_t)j * BATCH + sq) * RHEADS + h) * RH + vi) * RH
                               : c.out + O_WKVS + ((((size_t)j * DB + (sq - BATCH)) * RHEADS + h) * RH + vi) * RH;
        UNROLL for (int e = 0; e < RH; ++e) so[e] = S[e];
    }
}
DEV void ph_rw_post(const Ctx& c, int l, size_t gtid, size_t gsz) {
    using namespace cfg; const int j = l / 3;
    GSL(i, (size_t)MTOT * RHEADS) {
        const int m = (int)(i / RHEADS), h = (int)(i % RHEADS);
        const size_t o = (size_t)m * D + h * RH;
        float mean = 0.f; for (int e = 0; e < RH; ++e) mean += c.y[o + e]; mean /= RH;
        float var = 0.f; for (int e = 0; e < RH; ++e) { const float d = c.y[o + e] - mean; var += d * d; } var /= RH;
        const float rs = 1.0f / sqrtf(var + LNX_EPS);
        float bonus = 0.f; for (int e = 0; e < RH; ++e) bonus += c.r[o + e] * c.k[o + e] * c.in[I_RK][(size_t)j * D + h * RH + e];
        for (int e = 0; e < RH; ++e) {
            const int ch = h * RH + e;
            const float yn = (c.y[o + e] - mean) * rs * c.in[I_LNW][j * D + ch] + c.in[I_LNB][j * D + ch];
            c.yo[o + e] = (yn + bonus * c.v[o + e]) * c.g[o + e];
        }
    }
}

DEV void rope_apply(const float* xin, float* xout, int pos) {
    using namespace cfg; const int half = ROPE / 2;
    UNROLL for (int i = 0; i < half; ++i) {
        const float inv = exp2f(-(float)i * (13.287712379549449f / half));
        const float ang = (float)pos * inv;
        const float kq = rintf(ang * 0.15915494309189535f);
        float rr = fmaf(-kq, 6.28125f, ang); rr = fmaf(-kq, 1.9353071795864769e-3f, rr);
        const float cs = __cosf(rr), sn = __sinf(rr);
        const float x1 = xin[i], x2 = xin[i + half];
        xout[i] = x1 * cs - x2 * sn; xout[i + half] = x2 * cs + x1 * sn;
    }
}
DEV int row_pos(int m) { return m < cfg::MP ? m % cfg::SEQ : cfg::PAST + (m - cfg::MP) % cfg::DS; }
DEV void ph_mla_norm1(const Ctx& c, int l, size_t gtid, size_t gsz) {
    using namespace cfg; const int j = l / 3;
    GSL(m, MTOT) {
        const float* h = c.mh + m * MLA_IN;
        float ss = 0.f; for (int i = 0; i < QL; ++i) ss += h[i] * h[i];
        float rs = 1.0f / sqrtf(ss / QL + NORM_EPS);
        for (int i = 0; i < QL; ++i) c.qan[m * QL + i] = h[i] * rs * c.in[I_QNORM][j * QL + i];
        ss = 0.f; for (int i = 0; i < KVL; ++i) ss += h[QL + i] * h[QL + i];
        rs = 1.0f / sqrtf(ss / KVL + NORM_EPS);
        float* co = m < (size_t)MP ? c.out + O_CKVP + ((size_t)j * MP + m) * KVL : c.out + O_CKVS + ((size_t)j * MS + (m - MP)) * KVL;
        for (int i = 0; i < KVL; ++i) { const float v = h[QL + i] * rs * c.in[I_KVNORM][j * KVL + i]; c.c[m * KVL + i] = v; co[i] = v; }
        ss = 0.f; UNROLL for (int i = 0; i < ROPE; ++i) ss += h[QL + KVL + i] * h[QL + KVL + i];
        rs = 1.0f / sqrtf(ss / ROPE + NORM_EPS);
        float tmp[ROPE], ro[ROPE];
        UNROLL for (int i = 0; i < ROPE; ++i) tmp[i] = h[QL + KVL + i] * rs * c.in[I_KRN][j * ROPE + i];
        rope_apply(tmp, ro, row_pos((int)m));
        float* ko = m < (size_t)MP ? c.out + O_KPEP + ((size_t)j * MP + m) * ROPE : c.out + O_KPES + ((size_t)j * MS + (m - MP)) * ROPE;
        UNROLL for (int i = 0; i < ROPE; ++i) { c.kp[m * ROPE + i] = ro[i]; ko[i] = ro[i]; }
    }
}
DEV void ph_mla_norm2(const Ctx& c, int l, size_t gtid, size_t gsz) {
    using namespace cfg; const int j = l / 3;
    GSL(i, (size_t)MTOT * MH) {
        const int m = (int)(i / MH), h = (int)(i % MH);
        float* q = c.q + (size_t)m * MH * QD + h * QD;
        float ss = 0.f; UNROLL for (int e = 0; e < NOPE; ++e) ss += q[e] * q[e];
        float rs = 1.0f / sqrtf(ss / NOPE + NORM_EPS);
        UNROLL for (int e = 0; e < NOPE; ++e) q[e] = q[e] * rs * c.in[I_QNN][j * NOPE + e];
        ss = 0.f; UNROLL for (int e = 0; e < ROPE; ++e) ss += q[NOPE + e] * q[NOPE + e];
        rs = 1.0f / sqrtf(ss / ROPE + NORM_EPS);
        float tmp[ROPE], ro[ROPE];
        UNROLL for (int e = 0; e < ROPE; ++e) tmp[e] = q[NOPE + e] * rs * c.in[I_QRN][j * ROPE + e];
        rope_apply(tmp, ro, row_pos(m));
        UNROLL for (int e = 0; e < ROPE; ++e) q[NOPE + e] = ro[e];
        float* kn = c.knr + (size_t)m * MH * NOPE + h * NOPE;
        ss = 0.f; UNROLL for (int e = 0; e < NOPE; ++e) ss += kn[e] * kn[e];
        rs = 1.0f / sqrtf(ss / NOPE + NORM_EPS);
        UNROLL for (int e = 0; e < NOPE; ++e) kn[e] = kn[e] * rs * c.in[I_KNN][j * NOPE + e];
    }
}
DEV void ph_mla_attn_prompt(const Ctx& c, int, size_t gtid, size_t gsz) {
    using namespace cfg; const float scale = 1.0f / sqrtf((float)QD);
    GSL(i, (size_t)MP * MH) {
        const int m = (int)(i / MH), h = (int)(i % MH), t = m % SEQ, m0 = m - t;
        const float* q = c.q + (size_t)m * MH * QD + h * QD;
        float mx = -INFINITY, den = 0.f, acc[VD];
        UNROLL for (int e = 0; e < VD; ++e) acc[e] = 0.f;
        for (int kx = 0; kx <= t; ++kx) {
            const int mk = m0 + kx;
            const float* kn = c.knr + (size_t)mk * MH * NOPE + h * NOPE; const float* kp = c.kp + (size_t)mk * ROPE;
            float s = 0.f;
            UNROLL for (int e = 0; e < NOPE; ++e) s += q[e] * kn[e];
            UNROLL for (int e = 0; e < ROPE; ++e) s += q[NOPE + e] * kp[e];
            s *= scale;
            const float nm = fmaxf(mx, s), corr = expf(mx - nm), p = expf(s - nm);
            den = den * corr + p;
            const float* v = c.vv + (size_t)mk * MH * VD + h * VD;
            UNROLL for (int e = 0; e < VD; ++e) acc[e] = acc[e] * corr + p * v[e];
            mx = nm;
        }
        UNROLL for (int e = 0; e < VD; ++e) c.ao[(size_t)m * MH * VD + h * VD + e] = acc[e] / den;
    }
}
DEV const float* smp_c(const Ctx& c, int j, int s, int pos) {
    using namespace cfg;
    if (pos < PAST) { const int pg = c.page_table[s * NPAGES + pos / PAGE]; return c.in[I_CKV] + (((size_t)j * NPOOL + pg) * PAGE + pos % PAGE) * KVL; }
    return c.c + (size_t)(MP + s * DS + (pos - PAST)) * KVL;
}
DEV const float* smp_kp(const Ctx& c, int j, int s, int pos) {
    using namespace cfg;
    if (pos < PAST) { const int pg = c.page_table[s * NPAGES + pos / PAGE]; return c.in[I_KPE] + (((size_t)j * NPOOL + pg) * PAGE + pos % PAGE) * ROPE; }
    return c.kp + (size_t)(MP + s * DS + (pos - PAST)) * ROPE;
}
DEV void ph_mla_score_sample(const Ctx& c, int l, size_t gtid, size_t gsz) {
    using namespace cfg; const int j = l / 3; const float scale = 1.0f / sqrtf((float)QD);
    GSL(i, (size_t)DB * KTOT * MH) {
        const int pos = (int)(i % KTOT), h = (int)((i / KTOT) % MH), s = (int)(i / ((size_t)MH * KTOT));
        const float* cl = smp_c(c, j, s, pos); const float* kp = smp_kp(c, j, s, pos);
        float kn[NOPE];
        UNROLL for (int e = 0; e < NOPE; ++e) kn[e] = 0.f;
        const float* wuk = c.in[I_WUK] + (size_t)j * KVL * MH * NOPE;
        for (int r = 0; r < KVL; ++r) { const float cv = cl[r]; const float* w = wuk + ((size_t)r * MH + h) * NOPE; UNROLL for (int e = 0; e < NOPE; ++e) kn[e] += cv * w[e]; }
        float ss = 0.f; UNROLL for (int e = 0; e < NOPE; ++e) ss += kn[e] * kn[e];
        const float rs = 1.0f / sqrtf(ss / NOPE + NORM_EPS);
        UNROLL for (int e = 0; e < NOPE; ++e) kn[e] = kn[e] * rs * c.in[I_KNN][j * NOPE + e];
        for (int qi = 0; qi < DS; ++qi) {
            const float* q = c.q + (size_t)(MP + s * DS + qi) * MH * QD + h * QD;
            float sc = 0.f;
            UNROLL for (int e = 0; e < NOPE; ++e) sc += q[e] * kn[e];
            UNROLL for (int e = 0; e < ROPE; ++e) sc += q[NOPE + e] * kp[e];
            const bool ok = pos < PAST || (pos - PAST) <= qi;
            c.sc[(((size_t)s * MH + h) * DS + qi) * KTOT + pos] = ok ? sc * scale : -INFINITY;
        }
    }
}
DEV void ph_mla_softmax_sample(const Ctx& c, int, size_t gtid, size_t gsz) {
    using namespace cfg;
    GSL(i, (size_t)DB * MH * DS) {
        float* sc = c.sc + i * KTOT;
        float mx = -INFINITY; for (int p = 0; p < KTOT; ++p) mx = fmaxf(mx, sc[p]);
        float den = 0.f; for (int p = 0; p < KTOT; ++p) den += expf(sc[p] - mx);
        const float inv = 1.0f / den;
        for (int p = 0; p < KTOT; ++p) sc[p] = expf(sc[p] - mx) * inv;
    }
}
DEV void ph_mla_pv_sample(const Ctx& c, int l, size_t gtid, size_t gsz) {
    using namespace cfg; const int j = l / 3;
    GSL(i, (size_t)DB * MH * DS * KVL) {
        const int r = (int)(i % KVL); const size_t row = i / KVL; const int s = (int)(row / (MH * DS));
        const float* p = c.sc + row * KTOT; float acc = 0.f;
        for (int pos = 0; pos < KTOT; ++pos) acc += p[pos] * smp_c(c, j, s, pos)[r];
        c.olat[i] = acc;
    }
}
DEV void ph_mla_out_sample(const Ctx& c, int l, size_t gtid, size_t gsz) {
    using namespace cfg; const int j = l / 3;
    GSL(i, (size_t)MS * MH * VD) {
        const int e = (int)(i % VD), h = (int)((i / VD) % MH), ms = (int)(i / (MH * VD)), s = ms / DS, qi = ms % DS;
        const float* ol = c.olat + (((size_t)s * MH + h) * DS + qi) * KVL;
        const float* wuv = c.in[I_WUV] + (size_t)j * KVL * MH * VD;
        float acc = 0.f;
        for (int r = 0; r < KVL; ++r) acc += ol[r] * wuv[((size_t)r * MH + h) * VD + e];
        c.ao[(size_t)(MP + ms) * MH * VD + h * VD + e] = acc;
    }
}

DEV float mb_xpad(const Ctx& c, int j, int m, int sq, int tt, int ch) {
    using namespace cfg;
    if (tt < MB_CONV - 1) return sq < BATCH ? 0.f : c.in[I_CONV][(((size_t)j * DB + (sq - BATCH)) * (MB_CONV - 1) + tt) * MB_CD + ch];
    (void)m; return c.zx[(size_t)(seq_row0(sq) + tt - (MB_CONV - 1)) * MB_IN + MB_INNER + ch];
}
DEV void ph_mb_conv(const Ctx& c, int l, size_t gtid, size_t gsz) {
    using namespace cfg; const int j = l / 3;
    GSL(i, (size_t)MTOT * MB_CD) {
        const int m = (int)(i / MB_CD), ch = (int)(i % MB_CD), t = row_t(m), sq = row_seq(m), T = seq_len(sq);
        float acc = c.in[I_CONVB][j * MB_CD + ch];
        for (int jj = 0; jj < MB_CONV; ++jj) acc += mb_xpad(c, j, m, sq, t + jj, ch) * c.in[I_CONVW][((size_t)j * MB_CONV + jj) * MB_CD + ch];
        c.xbc[i] = siluf_(acc);
        if (t < MB_CONV - 1) {
            const float v = mb_xpad(c, j, m, sq, T + t, ch);
            if (sq < BATCH) c.out[O_CONVP + (((size_t)j * BATCH + sq) * (MB_CONV - 1) + t) * MB_CD + ch] = v;
            else c.out[O_CONVS + (((size_t)j * DB + (sq - BATCH)) * (MB_CONV - 1) + t) * MB_CD + ch] = v;
        }
    }
}
DEV void ph_mb_dt(const Ctx& c, int l, size_t gtid, size_t gsz) {
    using namespace cfg; const int j = l / 3;
    GSL(i, (size_t)MTOT * MB_HEADS) {
        const int m = (int)(i / MB_HEADS), h = (int)(i % MB_HEADS);
        c.dt[i] = softplusf_(c.zx[(size_t)m * MB_IN + MB_INNER + MB_CD + h] + c.in[I_DTB][j * MB_HEADS + h]);
    }
}
DEV void ph_mb_scan(const Ctx& c, int l, size_t gtid, size_t gsz) {
    using namespace cfg; const int j = l / 3;
    GSL(i, (size_t)NSEQ * MB_HEADS * MB_HEAD) {
        const int p = (int)(i % MB_HEAD), h = (int)((i / MB_HEAD) % MB_HEADS), sq = (int)(i / (MB_HEADS * MB_HEAD));
        const int g = h / (MB_HEADS / MB_GROUPS);
        float hs[MB_STATE];
        if (sq < BATCH) { UNROLL for (int n = 0; n < MB_STATE; ++n) hs[n] = 0.f; }
        else { const float* s0 = c.in[I_SSM] + ((((size_t)j * DB + (sq - BATCH)) * MB_HEADS + h) * MB_HEAD + p) * MB_STATE; UNROLL for (int n = 0; n < MB_STATE; ++n) hs[n] = s0[n]; }
        const float A = -expf(c.in[I_ALOG][j * MB_HEADS + h]), dsk = c.in[I_BD][j * MB_HEADS + h];
        const int m0 = seq_row0(sq), T = seq_len(sq);
        for (int t = 0; t < T; ++t) {
            const size_t m = (size_t)(m0 + t);
            const float dtv = c.dt[m * MB_HEADS + h], dA = expf(dtv * A);
            const float xv = c.xbc[m * MB_CD + h * MB_HEAD + p], xdt = xv * dtv;
            const float* Bm = c.xbc + m * MB_CD + MB_INNER + g * MB_STATE; const float* Cm = Bm + MB_GN;
            float yy = 0.f;
            UNROLL for (int n = 0; n < MB_STATE; ++n) { hs[n] = hs[n] * dA + xdt * Bm[n]; yy += Cm[n] * hs[n]; }
            c.my[m * MB_INNER + h * MB_HEAD + p] = yy + dsk * xv;
        }
        float* so = sq < BATCH ? c.out + O_SSMP + ((((size_t)j * BATCH + sq) * MB_HEADS + h) * MB_HEAD + p) * MB_STATE
                               : c.out + O_SSMS + ((((size_t)j * DB + (sq - BATCH)) * MB_HEADS + h) * MB_HEAD + p) * MB_STATE;
        UNROLL for (int n = 0; n < MB_STATE; ++n) so[n] = hs[n];
    }
}
DEV void ph_mb_gate(const Ctx& c, int l, size_t gtid, size_t gsz) {
    using namespace cfg; const int j = l / 3; constexpr int GW = MB_INNER / MB_GROUPS;
    GSL(i, (size_t)MTOT * MB_GROUPS) {
        const int m = (int)(i / MB_GROUPS), g = (int)(i % MB_GROUPS);
        float ss = 0.f;
        for (int e = 0; e < GW; ++e) { const float v = c.my[(size_t)m * MB_INNER + g * GW + e] * siluf_(c.zx[(size_t)m * MB_IN + g * GW + e]); ss += v * v; }
        const float rs = 1.0f / sqrtf(ss / GW + NORM_EPS);
        for (int e = 0; e < GW; ++e) {
            const float v = c.my[(size_t)m * MB_INNER + g * GW + e] * siluf_(c.zx[(size_t)m * MB_IN + g * GW + e]);
            c.yzn[(size_t)m * MB_INNER + g * GW + e] = v * rs * c.in[I_BNORM][j * MB_INNER + g * GW + e];
        }
    }
}
typedef short bf16x8_t __attribute__((ext_vector_type(8)));
typedef float f32x4_t __attribute__((ext_vector_type(4)));
__device__ __forceinline__ unsigned short f2bf(float f) { unsigned u = __float_as_uint(f); u += 0x7fffu + ((u >> 16) & 1u); return (unsigned short)(u >> 16); }
#define XB_TMO      128
#define XB_XCNT(j)  (256  + 64 * (j))
#define XB_XSUB(j)  (1280 + 64 * (j))
#define XB_XGEN(j)  (2304 + 64 * (j))
#define XB_TOP      3328
#define XB_TOPGEN   3392
#define XCD_BAR_WORDS 3456
#define XB_SPIN_CAP (1u << 25)
#define LAS __attribute__((address_space(3)))

__device__ __forceinline__ unsigned xb_ld(unsigned* p)              { return __hip_atomic_load(p, __ATOMIC_RELAXED, __HIP_MEMORY_SCOPE_AGENT); }
__device__ __forceinline__ unsigned xb_add(unsigned* p, unsigned v) { return __hip_atomic_fetch_add(p, v, __ATOMIC_RELAXED, __HIP_MEMORY_SCOPE_AGENT); }
__device__ __forceinline__ unsigned xb_xcc_id() { return (unsigned)__builtin_amdgcn_s_getreg((3 << 11) | 20) & 0xFu; }
#define XB_SPIN(cond, bar) do { unsigned _sp = 0; while (cond) { __builtin_amdgcn_s_sleep(1); \
    if ((++_sp & 255u) == 0u) { if (xb_ld(&(bar)[XB_TMO])) break; if (_sp > XB_SPIN_CAP) { atomicAdd(&(bar)[XB_TMO], 1u); break; } } } } while (0)

struct XcdBarrier {
    unsigned* bar; unsigned x;
    volatile LAS unsigned* st;
};

__device__ __forceinline__ XcdBarrier xcd_barrier_post(unsigned* bar, volatile LAS unsigned* st) {
    XcdBarrier b; b.bar = bar; b.x = xb_xcc_id(); b.st = st;
    if (threadIdx.x == 0) (void)xb_add(&bar[XB_XCNT(b.x)], 1u);
    return b;
}
__device__ __forceinline__ void xcd_barrier_complete(unsigned* bar, unsigned x, unsigned& nloc, unsigned& nx) {
    const unsigned G = gridDim.x * gridDim.y * gridDim.z;
    unsigned sum, cnt, mine, sp = 0u;
    for (;;) {
        sum = 0u; cnt = 0u; mine = 0u;
#pragma unroll
        for (unsigned j = 0; j < 16; ++j) { const unsigned c = xb_ld(&bar[XB_XCNT(j)]); sum += c; cnt += (c > 0u) ? 1u : 0u; mine = (j == x) ? c : mine; }
        if (sum == G) break;
        __builtin_amdgcn_s_sleep(1);
        if ((++sp & 255u) == 0u) { if (xb_ld(&bar[XB_TMO])) break; if (sp > XB_SPIN_CAP) { atomicAdd(&bar[XB_TMO], 1u); break; } }
    }
    nloc = mine > 0u ? mine : 1u; nx = cnt > 0u ? cnt : 1u;
}

__device__ __forceinline__ void xcd_barrier(const XcdBarrier& b) {
    asm volatile("s_waitcnt vmcnt(0)" ::: "memory");
    __syncthreads();
    if (threadIdx.x == 0) {
        unsigned* bar = b.bar;
        __builtin_amdgcn_s_waitcnt(0);
        unsigned nloc = b.st[0], nx = b.st[1];
        if (nloc == 0u) { xcd_barrier_complete(bar, b.x, nloc, nx); b.st[0] = nloc; b.st[1] = nx; }
        const unsigned old = xb_add(&bar[XB_XSUB(b.x)], 1u);
        const unsigned gen = old / nloc;
        if (old + 1u == (gen + 1u) * nloc) {
            __builtin_amdgcn_fence(__ATOMIC_RELEASE, "agent");
            asm volatile("s_waitcnt vmcnt(0)" ::: "memory");
            const unsigned og = xb_add(&bar[XB_TOP], 1u);
            const unsigned tg = og / nx;
            if (og + 1u == (tg + 1u) * nx) xb_add(&bar[XB_TOPGEN], 1u);
            else XB_SPIN(xb_ld(&bar[XB_TOPGEN]) == tg, bar);
            __builtin_amdgcn_fence(__ATOMIC_ACQUIRE, "agent");
            xb_add(&bar[XB_XGEN(b.x)], 1u);
            asm volatile("s_waitcnt vmcnt(0)" ::: "memory");
        } else {
            XB_SPIN(xb_ld(&bar[XB_XGEN(b.x)]) == gen, bar);
            __builtin_amdgcn_fence(__ATOMIC_ACQUIRE, "agent");
            asm volatile("s_waitcnt vmcnt(0)" ::: "memory");
        }
    }
    __syncthreads();
}

struct Bump { char* p; size_t off; float* f(size_t n) { float* r = (float*)(p + off); off += ((n * 4 + 255) / 256) * 256; return r; } };

static size_t setup_ctx(Ctx& c, void* const* d_in, void* d_out, void* d_ws) {
    using namespace cfg;
    for (int i = 0; i < 51; ++i) c.in[i] = (const float*)d_in[i];
    c.page_table = (const int*)d_in[I_PT];
    c.out = (float*)d_out; c.x = c.out;
    Bump b{(char*)d_ws, 4096 * 4};
    const size_t MD = (size_t)MTOT * D;
    c.xn = b.f(MD); c.vf = b.f(MD);
    const size_t base = b.off;
    for (int p = 0; p < 6; ++p) c.xm[p] = b.f(MD);
    c.r = b.f(MD); c.k = b.f(MD); c.v = b.f(MD); c.wpre = b.f(MD); c.apre = b.f(MD); c.vpre = b.f(MD); c.g = b.f(MD);
    c.hw = b.f((size_t)MTOT * RW_DL); c.ha = b.f((size_t)MTOT * RW_AL); c.hv = b.f((size_t)MTOT * RW_VL); c.hg = b.f((size_t)MTOT * RW_GL);
    c.ka = b.f(MD); c.kb = b.f(MD); c.y = c.xm[0]; c.yo = c.xm[1];
    size_t hi = b.off;
    b.off = base;
    c.mh = b.f((size_t)MTOT * MLA_IN); c.qan = b.f((size_t)MTOT * QL); c.q = b.f((size_t)MTOT * MH * QD); c.c = b.f((size_t)MTOT * KVL); c.kp = b.f((size_t)MTOT * ROPE);
    c.knr = b.f((size_t)MTOT * MH * NOPE); c.vv = b.f((size_t)MTOT * MH * VD); c.ao = b.f((size_t)MTOT * MH * VD);
    c.sc = b.f((size_t)DB * MH * DS * KTOT); c.olat = b.f((size_t)DB * MH * DS * KVL);
    if (b.off > hi) hi = b.off;
    b.off = base;
    c.zx = b.f((size_t)MTOT * MB_IN); c.xbc = b.f((size_t)MTOT * MB_CD); c.dt = b.f((size_t)MTOT * MB_HEADS); c.my = b.f((size_t)MTOT * MB_INNER); c.yzn = b.f((size_t)MTOT * MB_INNER);
    if (b.off > hi) hi = b.off;
    b.off = hi;
    c.hmid = b.f((size_t)MTOT * FFN);
    return b.off;
}

__device__ __forceinline__ unsigned tid_now() { unsigned t = threadIdx.x; asm volatile("" : "+v"(t)); return t; }
namespace pg8 {
#define PG8_LAS __attribute__((address_space(3)))
typedef unsigned short bf16_t;
typedef short bf16x8 __attribute__((ext_vector_type(8)));
typedef float f32x4 __attribute__((ext_vector_type(4)));
typedef float f32x2 __attribute__((ext_vector_type(2)));
typedef unsigned u32x4 __attribute__((ext_vector_type(4)));
typedef unsigned u32x2 __attribute__((ext_vector_type(2)));
constexpr int BM = 256, BK = 64, HALF = 128, HTB = HALF * BK * 2  , STAGE_BYTES = 8 * HTB, NXCD = 8, WGM = 8;

__host__ __device__ __forceinline__ int lds_byte(int r, int c) { const int st = (r >> 4) * 2 + (c >> 5), rr = r & 15, cc = c & 31, ob = rr * 64 + cc * 2; return st * 1024 + (ob ^ (((ob >> 9) & 1) << 5)); }
__host__ __device__ __forceinline__ void stage_rc(int b, int& R, int& C) { const int st = b / 1024, sb = b % 1024, swz = sb ^ (((sb >> 9) & 1) << 5); R = (st >> 1) * 16 + swz / 64; C = (st & 1) * 32 + (swz % 64) / 2; }
__host__ __device__ __forceinline__ int perm32(int rho) { const int n = rho >> 4, i = rho & 15; return 8 * (i >> 2) + 4 * n + (i & 3); }
__device__ __forceinline__ unsigned cvt_pk_bf16(float lo, float hi) { unsigned r; asm volatile("v_cvt_pk_bf16_f32 %0, %1, %2" : "=v"(r) : "v"(lo), "v"(hi)); return r; }

struct Unit { int pm, pn, k0, nt, asel, part; };
struct Gemm { const bf16_t* A; const bf16_t* Bt; int lda, ldb; size_t asel_stride; };

struct NoSel { __device__ static __forceinline__ int sel(int) { return 0; } };
template <class ASEL = NoSel>
struct Order {
    int nMp, nMs, nN, nwgP, nwgS, G, c, K, ksplit;
    __device__ __forceinline__ void init(int nMp_, int nMs_, int nN_, int K_, int ksplit_, int G_, int c_) { nMp = nMp_; nMs = nMs_; nN = nN_; nwgP = nMp * nN; K = K_; ksplit = ksplit_; nwgS = nMs * nN * ksplit; G = G_; c = c_; }
    __device__ __forceinline__ bool next(int i, Unit& u) const {
        const long L = (long)i * G + c;
        if (L < nwgP) {
            int wgid = (int)L; { const int q = nwgP / NXCD, r = nwgP % NXCD, xcd = wgid % NXCD, off = wgid / NXCD; wgid = (xcd < r ? xcd * (q + 1) : r * (q + 1) + (xcd - r) * q) + off; }
            const int nig = WGM * nN, gid = wgid / nig, fm = gid * WGM, gsz = (nMp - fm) < WGM ? (nMp - fm) : WGM;
            u.pm = fm + ((wgid % nig) % gsz); u.pn = (wgid % nig) / gsz; u.k0 = 0; u.nt = K / BK; u.part = 0; u.asel = ASEL::sel(u.pn); return true;
        }
        const long Ls = L - nwgP; if (Ls >= nwgS) return false;
        const int sub = (int)(Ls % ksplit), t = (int)(Ls / ksplit);
        u.pm = nMp + t % nMs; u.pn = t / nMs; u.nt = K / BK / ksplit; u.k0 = sub * u.nt * BK; u.part = ksplit > 1 ? 1 : 0; u.asel = ASEL::sel(u.pn); return true;
    }
};

template <class Epi, class Sched>
__device__ __forceinline__ void gemm_phase(PG8_LAS unsigned char* lds, const Gemm g, const Sched& S, const Epi& E) {
    const int tid = (int)tid_now(), wid = __builtin_amdgcn_readfirstlane(tid >> 6), lane = tid & 63, wr = wid >> 2, wc = wid & 3, fr = lane & 15, fq = lane >> 4;
    unsigned voffA[2], voffB[2];
#pragma unroll
    for (int i = 0; i < 2; ++i) { int R, C; stage_rc(tid * 16 + i * 8192, R, C); const int Rb = Epi::PERM ? ((R & ~31) + perm32(R & 31)) : R;
        voffA[i] = (unsigned)(R * g.lda + C) * 2u; voffB[i] = (unsigned)(Rb * g.ldb + C) * 2u; }
    const size_t kstep = (size_t)(BK * 2);
    const size_t hstepA = (size_t)HALF * g.lda * 2, hstepB = (size_t)HALF * g.ldb * 2;
    const unsigned ldsw = (unsigned)wid * 1024u;
    const int aoff = lds_byte(wr * 64 + fr, fq * 8), boff = lds_byte(wc * 32 + fr, fq * 8);
#define PG8_SA(b, h) (((b) * 2 + (h)) * HTB)
#define PG8_SB(b, h) ((4 + (b) * 2 + (h)) * HTB)
#define PG8_STAGE(bufoff, gbase, voff) do { _Pragma("unroll") for (int _i = 0; _i < 2; ++_i) \
        __builtin_amdgcn_global_load_lds((const unsigned*)((const char*)(gbase) + (voff)[_i]), (PG8_LAS unsigned*)(lds + (bufoff) + ldsw + _i * 8192), 16, 0, 0); } while (0)
#define PG8_LDA(dst, b, h) do { _Pragma("unroll") for (int m = 0; m < 4; ++m) _Pragma("unroll") for (int k = 0; k < 2; ++k) dst[m][k] = *(const PG8_LAS bf16x8*)(lds + PG8_SA(b, h) + aoff + m * 2048 + k * 1024); } while (0)
#define PG8_LDB(dst, b, h) do { _Pragma("unroll") for (int n = 0; n < 2; ++n) _Pragma("unroll") for (int k = 0; k < 2; ++k) dst[n][k] = *(const PG8_LAS bf16x8*)(lds + PG8_SB(b, h) + boff + n * 2048 + k * 1024); } while (0)
#define PG8_MMA(ai, bj, At, Bt) do { __builtin_amdgcn_s_setprio(1); _Pragma("unroll") for (int m = 0; m < 4; ++m) _Pragma("unroll") for (int n = 0; n < 2; ++n) _Pragma("unroll") for (int k = 0; k < 2; ++k) \
        acc[ai][bj][m][n] = __builtin_amdgcn_mfma_f32_16x16x32_bf16(Bt[n][k], At[m][k], acc[ai][bj][m][n], 0, 0, 0); __builtin_amdgcn_s_setprio(0); } while (0)
#define PG8_WAIT_V(n) asm volatile("s_waitcnt vmcnt(" #n ")" ::: "memory")
#define PG8_WAIT_L(n) asm volatile("s_waitcnt lgkmcnt(" #n ")" ::: "memory")
#define PG8_BAR __builtin_amdgcn_s_barrier()
#define PG8_SCHED __builtin_amdgcn_sched_barrier(0)
#define PG8_ABASE(u) ((const char*)g.A + ((size_t)(u).asel * g.asel_stride + (size_t)(u).pm * BM * g.lda + (u).k0) * 2)
#define PG8_BBASE(u) ((const char*)g.Bt + ((size_t)(u).pn * BM * g.ldb + (u).k0) * 2)
    Unit cur, nxt; int ui = 0;
    if (!S.next(0, cur)) return;
    f32x4 acc[2][2][4][2];
#pragma unroll
    for (int a = 0; a < 2; ++a)
#pragma unroll
        for (int b = 0; b < 2; ++b)
#pragma unroll
            for (int m = 0; m < 4; ++m)
#pragma unroll
                for (int n = 0; n < 2; ++n) acc[a][b][m][n] = (f32x4){0.f, 0.f, 0.f, 0.f};
    bf16x8 At[4][2], B0[2][2], B1[2][2];
    const char* cA = PG8_ABASE(cur); const char* cB = PG8_BBASE(cur);
    PG8_STAGE(PG8_SB(0, 0), cB, voffB); PG8_STAGE(PG8_SA(0, 0), cA, voffA); PG8_STAGE(PG8_SB(0, 1), cB + hstepB, voffB); PG8_STAGE(PG8_SA(0, 1), cA + hstepA, voffA);
    if (wr == 1) PG8_BAR;
    PG8_WAIT_V(4); PG8_BAR;
    PG8_STAGE(PG8_SB(1, 0), cB + kstep, voffB); PG8_STAGE(PG8_SA(1, 0), cA + kstep, voffA); PG8_STAGE(PG8_SB(1, 1), cB + hstepB + kstep, voffB);
    PG8_WAIT_V(6); PG8_BAR;
    for (;;) {
        const bool has_next = S.next(ui + 1, nxt);
        const char* nA = has_next ? PG8_ABASE(nxt) : cA; const char* nB = has_next ? PG8_BBASE(nxt) : cB;
        const int nt = cur.nt;
        for (int t = 0; t < nt; t += 2) {
            const bool last = (t == nt - 2);
            const char* a1 = cA + (size_t)(t + 1) * kstep;
            const char* a2 = last ? nA : cA + (size_t)(t + 2) * kstep; const char* b2 = last ? nB : cB + (size_t)(t + 2) * kstep;
            const char* a3 = a2 + kstep; const char* b3 = b2 + kstep;
            PG8_LDB(B0, 0, 0); PG8_SCHED; PG8_LDA(At, 0, 0); PG8_STAGE(PG8_SA(1, 1), a1 + hstepA, voffA);
            PG8_WAIT_L(8); PG8_BAR; PG8_WAIT_L(0); PG8_MMA(0, 0, At, B0); PG8_BAR; PG8_SCHED;
            PG8_LDB(B1, 0, 1); PG8_STAGE(PG8_SB(0, 0), b2, voffB);
            PG8_BAR; PG8_WAIT_L(0); PG8_MMA(0, 1, At, B1); PG8_BAR;
            PG8_LDA(At, 0, 1); PG8_STAGE(PG8_SA(0, 0), a2, voffA);
            PG8_BAR; PG8_WAIT_L(0); PG8_MMA(1, 0, At, B0); PG8_BAR; PG8_SCHED;
            PG8_STAGE(PG8_SB(0, 1), b2 + hstepB, voffB);
            PG8_WAIT_V(6); PG8_BAR; PG8_MMA(1, 1, At, B1); PG8_BAR;
            PG8_LDB(B0, 1, 0); PG8_SCHED; PG8_LDA(At, 1, 0); PG8_STAGE(PG8_SA(0, 1), a2 + hstepA, voffA);
            PG8_WAIT_L(8); PG8_BAR; PG8_WAIT_L(0); PG8_MMA(0, 0, At, B0); PG8_BAR; PG8_SCHED;
            PG8_LDB(B1, 1, 1); PG8_STAGE(PG8_SB(1, 0), b3, voffB);
            PG8_BAR; PG8_WAIT_L(0); PG8_MMA(0, 1, At, B1); PG8_BAR;
            PG8_LDA(At, 1, 1); PG8_STAGE(PG8_SA(1, 0), a3, voffA);
            PG8_BAR; PG8_WAIT_L(0); PG8_MMA(1, 0, At, B0); PG8_BAR; PG8_SCHED;
            PG8_STAGE(PG8_SB(1, 1), b3 + hstepB, voffB);
            PG8_WAIT_V(6); PG8_BAR; PG8_MMA(1, 1, At, B1); PG8_BAR;
        }
        E(acc, cur, wr, wc, fr, fq);
        if (!has_next) break;
#pragma unroll
        for (int a = 0; a < 2; ++a)
#pragma unroll
            for (int b = 0; b < 2; ++b)
#pragma unroll
                for (int m = 0; m < 4; ++m)
#pragma unroll
                    for (int n = 0; n < 2; ++n) acc[a][b][m][n] = (f32x4){0.f, 0.f, 0.f, 0.f};
        cur = nxt; cA = nA; cB = nB; ++ui;
    }
    PG8_WAIT_V(0);
    if (wr == 0) PG8_BAR;
    PG8_BAR;
#undef PG8_SA
#undef PG8_SB
#undef PG8_STAGE
#undef PG8_LDA
#undef PG8_LDB
#undef PG8_MMA
#undef PG8_WAIT_V
#undef PG8_WAIT_L
#undef PG8_BAR
#undef PG8_SCHED
#undef PG8_ABASE
#undef PG8_BBASE
}

struct EpiAccF32 {
    static constexpr bool PERM = false;
    float* C; int ldc; float* slab; int pm0, nMs, ksplit;
    __device__ __forceinline__ void operator()(const f32x4 (&acc)[2][2][4][2], const Unit& u, int wr, int wc, int fr, int fq) const {
        if (u.part) {
            float* sl = slab + ((size_t)((u.pn * nMs + (u.pm - pm0)) * ksplit + u.k0 / (u.nt * BK)) * BM + wr * 64 + fr) * BM + wc * 32 + 4 * fq;
#pragma unroll
            for (int ai = 0; ai < 2; ++ai)
#pragma unroll
                for (int m = 0; m < 4; ++m) { float* rowp = sl + (size_t)(ai * HALF + m * 16) * BM;
#pragma unroll
                    for (int bj = 0; bj < 2; ++bj)
#pragma unroll
                        for (int n = 0; n < 2; ++n) *(f32x4*)(rowp + bj * HALF + n * 16) = acc[ai][bj][m][n]; }
        } else {
            const int row0 = u.pm * BM + wr * 64 + fr, col0 = u.pn * BM + wc * 32 + 4 * fq;
#pragma unroll
            for (int ai = 0; ai < 2; ++ai)
#pragma unroll
                for (int m2 = 0; m2 < 4; m2 += 2) {
                    f32x4 t[2][2][2];
#pragma unroll
                    for (int mm = 0; mm < 2; ++mm) { const float* rowp = C + (size_t)(row0 + ai * HALF + (m2 + mm) * 16) * ldc + col0;
#pragma unroll
                        for (int bj = 0; bj < 2; ++bj)
#pragma unroll
                            for (int n = 0; n < 2; ++n) t[mm][bj][n] = *(const f32x4*)(rowp + bj * HALF + n * 16); }
#pragma unroll
                    for (int mm = 0; mm < 2; ++mm) { float* rowp = C + (size_t)(row0 + ai * HALF + (m2 + mm) * 16) * ldc + col0;
#pragma unroll
                        for (int bj = 0; bj < 2; ++bj)
#pragma unroll
                            for (int n = 0; n < 2; ++n) *(f32x4*)(rowp + bj * HALF + n * 16) = t[mm][bj][n] + acc[ai][bj][m2 + mm][n]; }
                }
        }
    }
};
struct EpiF32 {
    static constexpr bool PERM = false;
    float* C; int ldc; int ncols;
    __device__ __forceinline__ void operator()(const f32x4 (&acc)[2][2][4][2], const Unit& u, int wr, int wc, int fr, int fq) const {
        const int row0 = u.pm * BM + wr * 64 + fr, col0 = u.pn * BM + wc * 32 + 4 * fq;
#pragma unroll
        for (int ai = 0; ai < 2; ++ai)
#pragma unroll
            for (int m = 0; m < 4; ++m) { float* rowp = C + (size_t)(row0 + ai * HALF + m * 16) * ldc + col0;
#pragma unroll
                for (int bj = 0; bj < 2; ++bj)
#pragma unroll
                    for (int n = 0; n < 2; ++n) if (col0 + bj * HALF + n * 16 < ncols) *(f32x4*)(rowp + bj * HALF + n * 16) = acc[ai][bj][m][n]; }
    }
};
template <int ACT> struct EpiBf16 {
    static constexpr bool PERM = true;
    bf16_t* O; int ldc;
    __device__ __forceinline__ void operator()(const f32x4 (&acc)[2][2][4][2], const Unit& u, int wr, int wc, int fr, int fq) const {
        const int row0 = u.pm * BM + wr * 64 + fr, col0 = u.pn * BM + wc * 32 + 8 * fq;
#pragma unroll
        for (int ai = 0; ai < 2; ++ai)
#pragma unroll
            for (int m = 0; m < 4; ++m) { bf16_t* rowp = O + (size_t)(row0 + ai * HALF + m * 16) * ldc + col0;
#pragma unroll
                for (int bj = 0; bj < 2; ++bj) { f32x4 v0 = acc[ai][bj][m][0], v1 = acc[ai][bj][m][1];
                    if (ACT == 3) {
#pragma unroll
                        for (int j = 0; j < 4; ++j) { const float a = fmaxf(v0[j], 0.f), b = fmaxf(v1[j], 0.f); v0[j] = a * a; v1[j] = b * b; } }
                    u32x4 w; w.x = cvt_pk_bf16(v0[0], v0[1]); w.y = cvt_pk_bf16(v0[2], v0[3]); w.z = cvt_pk_bf16(v1[0], v1[1]); w.w = cvt_pk_bf16(v1[2], v1[3]);
                    *(u32x4*)(rowp + bj * HALF) = w; } }
    }
};
}
typedef pg8::bf16_t bf16_t;
#define LDSP __attribute__((address_space(3)))
struct Fast {
    bf16_t *xnb, *hmidb;
    bf16_t *w1t, *w2t;
    float* slab;
};
__device__ __forceinline__ unsigned pk2bf(float lo, float hi) { return pg8::cvt_pk_bf16(lo, hi); }
__device__ __forceinline__ float wave_sum64(float v) {
#pragma unroll
    for (int o = 1; o < 64; o <<= 1) v += __shfl_xor(v, o);
    return v;
}
__device__ __forceinline__ void tr_item(const float* __restrict__ W, int ldw, int K, bf16_t* WT, int nvalid, const float* __restrict__ kscale, LDSP float* scr, int item, int nblk, int lane) {
    const int kb = item / nblk, nb = item % nblk, k0 = 64 * kb, n0 = 32 * nb;
    const bool ok = n0 < nvalid;
#pragma unroll
    for (int i = 0; i < 8; ++i) { const int kk = 8 * i + (lane >> 3), nn = 4 * (lane & 7); pg8::f32x4 v = ok ? *(const pg8::f32x4*)(W + (size_t)(k0 + kk) * ldw + n0 + nn) : (pg8::f32x4){0.f, 0.f, 0.f, 0.f};
        if (kscale) v = v * kscale[k0 + kk];
        scr[kk * 33 + nn] = v[0]; scr[kk * 33 + nn + 1] = v[1]; scr[kk * 33 + nn + 2] = v[2]; scr[kk * 33 + nn + 3] = v[3]; }
    asm volatile("s_waitcnt lgkmcnt(0)" ::: "memory");
    const int c = lane & 7;
#pragma unroll
    for (int j = 0; j < 4; ++j) { const int n = (lane >> 3) + 8 * j; const LDSP float* s = scr + (8 * c) * 33 + n;
        pg8::u32x4 o; o.x = pk2bf(s[0 * 33], s[1 * 33]); o.y = pk2bf(s[2 * 33], s[3 * 33]); o.z = pk2bf(s[4 * 33], s[5 * 33]); o.w = pk2bf(s[6 * 33], s[7 * 33]);
        *(pg8::u32x4*)(WT + (size_t)(n0 + n) * K + k0 + 8 * c) = o; }
    asm volatile("s_waitcnt lgkmcnt(0)" ::: "memory");
}
__device__ __forceinline__ void tr_weight(const float* W, int K, int N, int npad, bf16_t* WT, const float* kscale, LDSP float* scr, int gw, int ngw, int lane) {
    const int nblk = npad / 32, items = (K / 64) * nblk;
    for (int it = gw; it < items; it += ngw) tr_item(W, N, K, WT, N, kscale, scr, it, nblk, lane);
}
__device__ __forceinline__ pg8::f32x4 slab_sum(const float* __restrict__ slab, int ksplit, int m, int q, int lane) {
    using namespace cfg; const int rs = m - MP, pms = rs >> 8, row = rs & 255;
    const float* p = slab + ((size_t)((q * (MS / 256) + pms) * ksplit) * 256 + row) * 256 + 4 * lane;
    pg8::f32x4 s = {0.f, 0.f, 0.f, 0.f};
    for (int k = 0; k < ksplit; ++k) s = s + *(const pg8::f32x4*)(p + (size_t)k * 65536);
    return s;
}
__device__ __forceinline__ void norm_rows_bf16(float* __restrict__ x, const float* __restrict__ gain, bf16_t* xn, const float* __restrict__ slab, int ksplit, int gw, int ngw, int lane) {
    using namespace cfg;
    pg8::f32x4 gv[4];
#pragma unroll
    for (int j = 0; j < 4; ++j) gv[j] = *(const pg8::f32x4*)(gain + 4 * lane + 256 * j);
    for (int m = gw; m < MTOT; m += ngw) {
        float* xr = x + (size_t)m * D; pg8::f32x4 v[4]; float s = 0.f;
#pragma unroll
        for (int j = 0; j < 4; ++j) { v[j] = *(const pg8::f32x4*)(xr + 4 * lane + 256 * j);
            if (ksplit > 1 && m >= MP) { v[j] = v[j] + slab_sum(slab, ksplit, m, j, lane); *(pg8::f32x4*)(xr + 4 * lane + 256 * j) = v[j]; }
            s += (v[j][0] * v[j][0] + v[j][1] * v[j][1]) + (v[j][2] * v[j][2] + v[j][3] * v[j][3]); }
        const float rs = 1.0f / sqrtf(wave_sum64(s) * (1.0f / D) + NORM_EPS);
#pragma unroll
        for (int j = 0; j < 4; ++j) { pg8::u32x2 o; o.x = pk2bf(v[j][0] * rs * gv[j][0], v[j][1] * rs * gv[j][1]); o.y = pk2bf(v[j][2] * rs * gv[j][2], v[j][3] * rs * gv[j][3]);
            *(pg8::u32x2*)(xn + (size_t)m * D + 4 * lane + 256 * j) = o; }
    }
}

__device__ __forceinline__ void fold_sample_rows(float* __restrict__ x, const float* __restrict__ slab, int ksplit, int gw, int ngw, int lane) {
    using namespace cfg;
    for (int m = MP + gw; m < MTOT; m += ngw) {
#pragma unroll
        for (int j = 0; j < 4; ++j) { float* p = x + (size_t)m * D + 4 * lane + 256 * j; *(pg8::f32x4*)p = *(const pg8::f32x4*)p + slab_sum(slab, ksplit, m, j, lane); }
    }
}
struct FastMla {
    float* mh;
    bf16_t *qan, *cb, *kpb;
    bf16_t *qraw, *kvraw;
    bf16_t *qf, *knb, *aob, *vT, *qs;
    float *opart, *lpart;
    bf16_t *wint, *wuqt, *wukvt, *wot;
};
__device__ __forceinline__ void rope_cs(int pos, int i, float& cs, float& sn) {
    const float inv = exp2f(-(float)i * (13.287712379549449f / 16.0f));
    const float ang = (float)pos * inv, kq = rintf(ang * 0.15915494309189535f);
    float rr = fmaf(-kq, 6.28125f, ang); rr = fmaf(-kq, 1.9353071795864769e-3f, rr);
    cs = __cosf(rr); sn = __sinf(rr);
}
__device__ __forceinline__ float bf2f(unsigned short b) { return __uint_as_float(((unsigned)b) << 16); }
__device__ __forceinline__ void mla_norm1_fast(const Ctx& c, const FastMla& fm, int j, int gw, int ngw, int lane) {
    using namespace cfg;
    for (int m = gw; m < MTOT; m += ngw) {
        const float* h = fm.mh + (size_t)m * 1024;
        pg8::f32x4 qv[2]; float s = 0.f;
#pragma unroll
        for (int t = 0; t < 2; ++t) { qv[t] = *(const pg8::f32x4*)(h + 4 * lane + 256 * t); s += (qv[t][0] * qv[t][0] + qv[t][1] * qv[t][1]) + (qv[t][2] * qv[t][2] + qv[t][3] * qv[t][3]); }
        const float rq = 1.0f / sqrtf(wave_sum64(s) * (1.0f / QL) + NORM_EPS);
#pragma unroll
        for (int t = 0; t < 2; ++t) { const pg8::f32x4 g = *(const pg8::f32x4*)(c.in[I_QNORM] + j * QL + 4 * lane + 256 * t);
            pg8::u32x2 o; o.x = pk2bf(qv[t][0] * rq * g[0], qv[t][1] * rq * g[1]); o.y = pk2bf(qv[t][2] * rq * g[2], qv[t][3] * rq * g[3]);
            *(pg8::u32x2*)(fm.qan + (size_t)m * QL + 4 * lane + 256 * t) = o; }
        const pg8::f32x4 cv = *(const pg8::f32x4*)(h + QL + 4 * lane);
        const float rc = 1.0f / sqrtf(wave_sum64((cv[0] * cv[0] + cv[1] * cv[1]) + (cv[2] * cv[2] + cv[3] * cv[3])) * (1.0f / KVL) + NORM_EPS);
        const pg8::f32x4 gc = *(const pg8::f32x4*)(c.in[I_KVNORM] + j * KVL + 4 * lane);
        const pg8::f32x4 cn = {cv[0] * rc * gc[0], cv[1] * rc * gc[1], cv[2] * rc * gc[2], cv[3] * rc * gc[3]};
        float* co = m < MP ? c.out + O_CKVP + ((size_t)j * MP + m) * KVL : c.out + O_CKVS + ((size_t)j * MS + (m - MP)) * KVL;
        *(pg8::f32x4*)(co + 4 * lane) = cn; *(pg8::f32x4*)(c.c + (size_t)m * KVL + 4 * lane) = cn;
        { pg8::u32x2 o; o.x = pk2bf(cn[0], cn[1]); o.y = pk2bf(cn[2], cn[3]); *(pg8::u32x2*)(fm.cb + (size_t)m * KVL + 4 * lane) = o; }
        const float kv = lane < ROPE ? h[QL + KVL + lane] : 0.f;
        const float rk = 1.0f / sqrtf(wave_sum64(kv * kv) * (1.0f / ROPE) + NORM_EPS);
        const float kn = kv * rk * (lane < ROPE ? c.in[I_KRN][j * ROPE + lane] : 0.f);
        const float other = __shfl_xor(kn, 16);
        float cs, sn; rope_cs(row_pos(m), lane & 15, cs, sn);
        const float ro = lane < 16 ? kn * cs - other * sn : kn * cs + other * sn;
        if (lane < ROPE) {
            float* ko = m < MP ? c.out + O_KPEP + ((size_t)j * MP + m) * ROPE : c.out + O_KPES + ((size_t)j * MS + (m - MP)) * ROPE;
            ko[lane] = ro; c.kp[(size_t)m * ROPE + lane] = ro;
            fm.kpb[(size_t)m * ROPE + lane] = (bf16_t)(pk2bf(ro, 0.f) & 0xffffu);
        }
    }
}
__device__ __forceinline__ void mla_norm2_fast(const Ctx& c, const FastMla& fm, int j, int gw, int ngw, int lane) {
    using namespace cfg;
    const int hd = lane >> 2, qt = lane & 3;
    const float QSC = 0.10206207261596575f * 1.4426950408889634f;
    for (int m = gw; m < MTOT; m += ngw) {
        const bf16_t* qr = fm.qraw + (size_t)m * (MH * QD) + hd * QD;
        float v[16]; float s = 0.f;
        { const pg8::u32x4 a = *(const pg8::u32x4*)(qr + 16 * qt), b = *(const pg8::u32x4*)(qr + 16 * qt + 8); const unsigned w[8] = {a.x, a.y, a.z, a.w, b.x, b.y, b.z, b.w};
#pragma unroll
          for (int i = 0; i < 8; ++i) { v[2 * i] = __uint_as_float(w[i] << 16); v[2 * i + 1] = __uint_as_float(w[i] & 0xffff0000u); } }
#pragma unroll
        for (int i = 0; i < 16; ++i) s += v[i] * v[i];
        s += __shfl_xor(s, 1); s += __shfl_xor(s, 2);
        float rs = 1.0f / sqrtf(s * (1.0f / NOPE) + NORM_EPS);
        bf16_t* qo = fm.qf + (size_t)m * (MH * QD) + hd * QD; float* qo32 = c.q + (size_t)m * (MH * QD) + hd * QD;
        { unsigned w[8], w2[8];
#pragma unroll
          for (int i = 0; i < 8; ++i) { const float a = v[2 * i] * rs * c.in[I_QNN][j * NOPE + 16 * qt + 2 * i], b = v[2 * i + 1] * rs * c.in[I_QNN][j * NOPE + 16 * qt + 2 * i + 1];
              w[i] = pk2bf(a * QSC, b * QSC); qo32[16 * qt + 2 * i] = a; qo32[16 * qt + 2 * i + 1] = b;
              w2[i] = pk2bf(a * QSC * c.in[I_KNN][j * NOPE + 16 * qt + 2 * i], b * QSC * c.in[I_KNN][j * NOPE + 16 * qt + 2 * i + 1]); }
          *(pg8::u32x4*)(qo + 16 * qt) = (pg8::u32x4){w[0], w[1], w[2], w[3]}; *(pg8::u32x4*)(qo + 16 * qt + 8) = (pg8::u32x4){w[4], w[5], w[6], w[7]};
          if (m >= MP) { bf16_t* q2 = fm.qs + (size_t)(m - MP) * (MH * QD) + hd * QD;
              *(pg8::u32x4*)(q2 + 16 * qt) = (pg8::u32x4){w2[0], w2[1], w2[2], w2[3]}; *(pg8::u32x4*)(q2 + 16 * qt + 8) = (pg8::u32x4){w2[4], w2[5], w2[6], w2[7]}; } }
        float r8[8]; s = 0.f;
        { const pg8::u32x4 a = *(const pg8::u32x4*)(qr + NOPE + 8 * qt); const unsigned w[4] = {a.x, a.y, a.z, a.w};
#pragma unroll
          for (int i = 0; i < 4; ++i) { r8[2 * i] = __uint_as_float(w[i] << 16); r8[2 * i + 1] = __uint_as_float(w[i] & 0xffff0000u); } }
#pragma unroll
        for (int i = 0; i < 8; ++i) s += r8[i] * r8[i];
        s += __shfl_xor(s, 1); s += __shfl_xor(s, 2);
        rs = 1.0f / sqrtf(s * (1.0f / ROPE) + NORM_EPS);
        { unsigned w[4]; float o8[8];
#pragma unroll
          for (int i = 0; i < 8; ++i) { const float mine = r8[i] * rs * c.in[I_QRN][j * ROPE + 8 * qt + i]; const float oth = __shfl_xor(mine, 2);
              float cs, sn; rope_cs(row_pos(m), (8 * qt + i) & 15, cs, sn);
              o8[i] = qt < 2 ? mine * cs - oth * sn : mine * cs + oth * sn; qo32[NOPE + 8 * qt + i] = o8[i]; }
#pragma unroll
          for (int i = 0; i < 4; ++i) w[i] = pk2bf(o8[2 * i] * QSC, o8[2 * i + 1] * QSC);
          *(pg8::u32x4*)(qo + NOPE + 8 * qt) = (pg8::u32x4){w[0], w[1], w[2], w[3]};
          if (m >= MP) *(pg8::u32x4*)(fm.qs + (size_t)(m - MP) * (MH * QD) + hd * QD + NOPE + 8 * qt) = (pg8::u32x4){w[0], w[1], w[2], w[3]}; }
        const bf16_t* kr = fm.kvraw + (size_t)m * 2048 + hd * NOPE; s = 0.f;
        { const pg8::u32x4 a = *(const pg8::u32x4*)(kr + 16 * qt), b = *(const pg8::u32x4*)(kr + 16 * qt + 8); const unsigned w[8] = {a.x, a.y, a.z, a.w, b.x, b.y, b.z, b.w};
#pragma unroll
          for (int i = 0; i < 8; ++i) { v[2 * i] = __uint_as_float(w[i] << 16); v[2 * i + 1] = __uint_as_float(w[i] & 0xffff0000u); } }
#pragma unroll
        for (int i = 0; i < 16; ++i) s += v[i] * v[i];
        s += __shfl_xor(s, 1); s += __shfl_xor(s, 2);
        rs = 1.0f / sqrtf(s * (1.0f / NOPE) + NORM_EPS);
        bf16_t* ko = fm.knb + (size_t)m * (MH * NOPE) + hd * NOPE;
        { unsigned w[8];
#pragma unroll
          for (int i = 0; i < 8; ++i) { const float a = v[2 * i] * rs * c.in[I_KNN][j * NOPE + 16 * qt + 2 * i], b = v[2 * i + 1] * rs * c.in[I_KNN][j * NOPE + 16 * qt + 2 * i + 1];
              w[i] = pk2bf(a, b); }
          *(pg8::u32x4*)(ko + 16 * qt) = (pg8::u32x4){w[0], w[1], w[2], w[3]}; *(pg8::u32x4*)(ko + 16 * qt + 8) = (pg8::u32x4){w[4], w[5], w[6], w[7]}; }
    }
}
__device__ __forceinline__ void cvt_f32_bf16(const float* __restrict__ s, bf16_t* d, size_t n, size_t gtid, size_t gsz) {
    for (size_t i = gtid * 4; i < n; i += gsz * 4) { const pg8::f32x4 v = *(const pg8::f32x4*)(s + i); pg8::u32x2 o; o.x = pk2bf(v[0], v[1]); o.y = pk2bf(v[2], v[3]); *(pg8::u32x2*)(d + i) = o; }
}
typedef float f32x16_t __attribute__((ext_vector_type(16)));
typedef pg8::bf16x8 bf16x8v;
constexpr int AT_KROW = 208, AT_VROW = 136, AT_KBUF = 64 * AT_KROW, AT_VBUF = 64 * AT_VROW, AT_LDS = 2 * AT_KBUF + 2 * AT_VBUF;
__device__ __forceinline__ void attn_prompt_fast(const bf16_t* __restrict__ qf, const bf16_t* __restrict__ knb, const bf16_t* __restrict__ kpb, const bf16_t* __restrict__ vT, bf16_t* aob, LDSP unsigned char* lds) {
    using namespace cfg;
    const int tid = (int)tid_now(), w = __builtin_amdgcn_readfirstlane(tid >> 6), lane = tid & 63, l31 = lane & 31, h5 = lane >> 5;
    for (int it = blockIdx.x; it < BATCH * MH * 4; it += gridDim.x) {
        const int bh = it >> 2, pr = it & 3, b = bh / MH, h = bh % MH;
        for (int half = 0; half < 2; ++half) {
            const int qb = half ? 7 - pr : pr, q0 = 256 * qb, nt = 4 * qb + 4;
            const int qg = q0 + 32 * w + l31;
            const size_t mrow = (size_t)b * SEQ + qg;
            bf16x8v qfr[6];
#pragma unroll
            for (int s = 0; s < 6; ++s) qfr[s] = *(const bf16x8v*)(qf + mrow * (MH * QD) + h * QD + 16 * s + 8 * h5);
            f32x16_t O[2];
#pragma unroll
            for (int db = 0; db < 2; ++db)
#pragma unroll
                for (int r = 0; r < 16; ++r) O[db][r] = 0.f;
            float mrun = -1e30f, lrun = 0.f;
            pg8::u32x4 rk, rp, rv;
            const int kkey = tid >> 3, kc8 = tid & 7, pkey = tid >> 2, pc4 = tid & 3;
#define AT_LOAD(t) do { const size_t mk = (size_t)b * SEQ + 64 * (t); \
                rk = *(const pg8::u32x4*)(knb + (mk + kkey) * (MH * NOPE) + h * NOPE + kc8 * 8); \
                if (tid < 256) rp = *(const pg8::u32x4*)(kpb + (mk + pkey) * ROPE + pc4 * 8); \
                rv = *(const pg8::u32x4*)(vT + (size_t)(h * VD + kkey) * MTOT + mk + kc8 * 8); } while (0)
#define AT_STORE(buf) do { LDSP unsigned char* kb_ = lds + (buf) * AT_KBUF; LDSP unsigned char* vb_ = lds + 2 * AT_KBUF + (buf) * AT_VBUF; \
                *(LDSP pg8::u32x4*)(kb_ + kkey * AT_KROW + kc8 * 16) = rk; \
                if (tid < 256) *(LDSP pg8::u32x4*)(kb_ + pkey * AT_KROW + 128 + pc4 * 16) = rp; \
                *(LDSP pg8::u32x2*)(vb_ + kkey * AT_VROW + kc8 * 16) = (pg8::u32x2){rv.x, rv.y}; *(LDSP pg8::u32x2*)(vb_ + kkey * AT_VROW + kc8 * 16 + 8) = (pg8::u32x2){rv.z, rv.w}; } while (0)
            AT_LOAD(0); AT_STORE(0);
            __syncthreads();
            for (int t = 0; t < nt; ++t) {
                if (t + 1 < nt) AT_LOAD(t + 1);
                if (64 * t <= q0 + 32 * w + 31) {
                    const LDSP unsigned char* kb_ = lds + (t & 1) * AT_KBUF; const LDSP unsigned char* vb_ = lds + 2 * AT_KBUF + (t & 1) * AT_VBUF;
                    f32x16_t S[2];
#pragma unroll
                    for (int kb = 0; kb < 2; ++kb)
#pragma unroll
                        for (int r = 0; r < 16; ++r) S[kb][r] = 0.f;
#pragma unroll
                    for (int s = 0; s < 6; ++s)
#pragma unroll
                        for (int kb = 0; kb < 2; ++kb) {
                            const bf16x8v a = *(const LDSP bf16x8v*)(kb_ + (32 * kb + l31) * AT_KROW + (16 * s + 8 * h5) * 2);
                            S[kb] = __builtin_amdgcn_mfma_f32_32x32x16_bf16(a, qfr[s], S[kb], 0, 0, 0);
                        }
                    if (64 * t + 63 > q0 + 32 * w) {
#pragma unroll
                        for (int kb = 0; kb < 2; ++kb)
#pragma unroll
                            for (int r = 0; r < 16; ++r) { const int key = 64 * t + 32 * kb + (r & 3) + 8 * (r >> 2) + 4 * h5; if (key > qg) S[kb][r] = -1e30f; }
                    }
                    float mt = -1e30f;
#pragma unroll
                    for (int kb = 0; kb < 2; ++kb)
#pragma unroll
                        for (int r = 0; r < 16; ++r) mt = fmaxf(mt, S[kb][r]);
                    mt = fmaxf(mt, __shfl_xor(mt, 32));
                    const float mnew = fmaxf(mrun, mt), alpha = exp2f(mrun - mnew);
                    float ls = 0.f;
#pragma unroll
                    for (int kb = 0; kb < 2; ++kb)
#pragma unroll
                        for (int r = 0; r < 16; ++r) { const float p = exp2f(S[kb][r] - mnew); S[kb][r] = p; ls += p; }
                    lrun = lrun * alpha + ls; mrun = mnew;
#pragma unroll
                    for (int db = 0; db < 2; ++db)
#pragma unroll
                        for (int r = 0; r < 16; ++r) O[db][r] *= alpha;
#pragma unroll
                    for (int kb = 0; kb < 2; ++kb)
#pragma unroll
                        for (int s = 0; s < 2; ++s) {
                            pg8::u32x4 pw; pw.x = pk2bf(S[kb][8 * s + 0], S[kb][8 * s + 1]); pw.y = pk2bf(S[kb][8 * s + 2], S[kb][8 * s + 3]); pw.z = pk2bf(S[kb][8 * s + 4], S[kb][8 * s + 5]); pw.w = pk2bf(S[kb][8 * s + 6], S[kb][8 * s + 7]);
                            const bf16x8v pf = __builtin_bit_cast(bf16x8v, pw);
#pragma unroll
                            for (int db = 0; db < 2; ++db) {
                                const LDSP unsigned char* vp = vb_ + (32 * db + l31) * AT_VROW + (32 * kb + 16 * s + 4 * h5) * 2;
                                const pg8::u32x2 v0 = *(const LDSP pg8::u32x2*)vp, v1 = *(const LDSP pg8::u32x2*)(vp + 16);
                                const bf16x8v a = __builtin_bit_cast(bf16x8v, (pg8::u32x4){v0.x, v0.y, v1.x, v1.y});
                                O[db] = __builtin_amdgcn_mfma_f32_32x32x16_bf16(a, pf, O[db], 0, 0, 0);
                            }
                        }
                }
                if (t + 1 < nt) AT_STORE((t + 1) & 1);
                __syncthreads();
            }
#undef AT_LOAD
#undef AT_STORE
            const float inv = 1.0f / (lrun + __shfl_xor(lrun, 32));
            bf16_t* orow = aob + mrow * (MH * VD) + h * VD;
#pragma unroll
            for (int db = 0; db < 2; ++db)
#pragma unroll
                for (int g = 0; g < 4; ++g) { pg8::u32x2 o; o.x = pk2bf(O[db][4 * g] * inv, O[db][4 * g + 1] * inv); o.y = pk2bf(O[db][4 * g + 2] * inv, O[db][4 * g + 3] * inv);
                    *(pg8::u32x2*)(orow + 32 * db + 8 * g + 4 * h5) = o; }
        }
    }
}
constexpr int SD_CROW = 528, SD_WROW = 528, SD_PROW = 272;
constexpr int SD_CIMG = 0, SD_CIMG_SZ = 128 * SD_CROW;
constexpr int SD_WBUF = SD_CIMG + SD_CIMG_SZ, SD_WBUF_SZ = 32 * 1040;
constexpr int SD_XCH = SD_WBUF + 2 * SD_WBUF_SZ, SD_XCH_SZ = 4 * 5 * 64 * 4;
constexpr int SD_PIMG = SD_XCH + 2 * SD_XCH_SZ, SD_PIMG_SZ = 32 * SD_PROW;
constexpr int SD_END = SD_PIMG + 2 * SD_PIMG_SZ;
typedef short s16x4 __attribute__((ext_vector_type(4)));
#define MFMA32(a, b, c) __builtin_amdgcn_mfma_f32_32x32x16_bf16(a, b, c, 0, 0, 0)

__device__ __forceinline__ float mla_b2_bound(const Ctx& c, int j, int lane) {
    using namespace cfg;
    float gq = fabsf(c.in[I_QNN][j * NOPE + lane]), gk = fabsf(c.in[I_KNN][j * NOPE + lane]), gqr = fabsf(c.in[I_QRN][j * ROPE + (lane & 31)]), gkr = fabsf(c.in[I_KRN][j * ROPE + (lane & 31)]);
#pragma unroll
    for (int o = 1; o < 64; o <<= 1) { gq = fmaxf(gq, __shfl_xor(gq, o)); gk = fmaxf(gk, __shfl_xor(gk, o)); gqr = fmaxf(gqr, __shfl_xor(gqr, o)); gkr = fmaxf(gkr, __shfl_xor(gkr, o)); }
    return (64.f * gq * gk + 32.f * gqr * gkr) * (0.10206207261596575f * 1.4426950408889634f);
}

__device__ __forceinline__ void sd_pv_core(const int G, f32x16_t& Og, f32x16_t& Lacc, LDSP unsigned char* lds, int w, int lane, int l31, int h5) {
    asm volatile("" : "+v"(lane)); l31 = lane & 31; h5 = lane >> 5;
    const LDSP unsigned char* pimg = lds + SD_PIMG + (G & 1) * SD_PIMG_SZ;
    const unsigned onesw = (l31 == G) ? 0x3F803F80u : 0u;
    const bf16x8v onesv = __builtin_bit_cast(bf16x8v, (pg8::u32x4){onesw, onesw, onesw, onesw});
#pragma unroll
    for (int sp = 0; sp < 8; ++sp) {
        const bf16x8v a = *(const LDSP bf16x8v*)(pimg + l31 * SD_PROW + (16 * sp + 8 * h5) * 2);
        const int key0 = 16 * sp + 8 * h5 + ((lane & 15) >> 2), col = 32 * w + 16 * ((lane >> 4) & 1) + 4 * (lane & 3);
        const s16x4 t0 = __builtin_amdgcn_ds_read_tr16_b64_v4i16((LDSP s16x4*)(lds + SD_CIMG + key0 * SD_CROW + col * 2));
        const s16x4 t1 = __builtin_amdgcn_ds_read_tr16_b64_v4i16((LDSP s16x4*)(lds + SD_CIMG + (key0 + 4) * SD_CROW + col * 2));
        const bf16x8v b = (bf16x8v){t0[0], t0[1], t0[2], t0[3], t1[0], t1[1], t1[2], t1[3]};
        Og = MFMA32(a, b, Og);
        if (sp == w) Lacc = MFMA32(a, onesv, Lacc);
        if (sp & 1) __builtin_amdgcn_sched_barrier(0);
    }
}

__device__ __forceinline__ void sd_pv(const int G, f32x16_t& Og, f32x16_t& Lacc, LDSP unsigned char* lds, int w, int lane, int l31, int h5) {
    sd_pv_core(G, Og, Lacc, lds, w, lane, l31, h5);
#if defined(PROBE_DUP) && (PROBE_DUP & (1 << 21))
    f32x16_t D0, D1;
#pragma unroll
    for (int r = 0; r < 16; ++r) { D0[r] = 0.f; D1[r] = 0.f; }
    sd_pv_core(G, D0, D1, lds, w, lane, l31, h5); asm volatile("" :: "v"(D0), "v"(D1));
#endif
}
#define SD_WLOAD(h, buf) do { const char* wsrc_ = (const char*)(fm.wukvt + (size_t)(h) * NOPE * KVL); int ln_ = lane; asm volatile("" : "+v"(ln_)); _Pragma("unroll") for (int k = 0; k < 4; ++k) { \
        const unsigned voff_ = (unsigned)(((4 * w + k) + 32 * (ln_ >> 5)) * KVL + (ln_ & 31) * 8) * 2u; \
        __builtin_amdgcn_global_load_lds((const unsigned*)(wsrc_ + voff_), (LDSP unsigned*)(lds + SD_WBUF + (buf) * SD_WBUF_SZ + (4 * w + k) * 1040), 16, 0, 0); } } while (0)
template <int G>
__device__ __forceinline__ void sd_group(const FastMla& fm, const bf16_t* __restrict__ qs, const int s, LDSP unsigned char* lds, const int w, const int lane, const int l31_, const int h5_, const int kb, const int dh,
                                         const bf16x8v (&cfr)[16], const bf16x8v (&kpfr)[2], bf16x8v (&qn)[2], bf16x8v (&qp)[2], f32x16_t (&O)[4], f32x16_t& Lacc, const float B2) {
    using namespace cfg;
        _Pragma("unroll 1") for (int hh = 0; hh < 4; ++hh) {
            const int h = 4 * G + hh;
            int lane_ = lane; asm volatile("" : "+v"(lane_)); const int l31 = lane_ & 31, h5 = lane_ >> 5;
            if (h + 1 < MH) SD_WLOAD(h + 1, (h + 1) & 1);
#if defined(PROBE_DUP) && (PROBE_DUP & (1 << 22))
            if (h + 1 < MH) SD_WLOAD(h + 1, (h + 1) & 1);
#endif
            const bf16x8v qn0 = qn[0], qn1 = qn[1], qp0 = qp[0], qp1 = qp[1];
            { const int hn = (h + 1) & (MH - 1); const bf16_t* qrow = qs + ((size_t)(s * DS + (l31 & 7)) * MH + hn) * QD;
#pragma unroll
              for (int s_ = 0; s_ < 2; ++s_) { const int d0 = 32 * dh + 16 * s_ + 4 * h5; pg8::u32x2 a = *(const pg8::u32x2*)(qrow + d0), b = *(const pg8::u32x2*)(qrow + d0 + 8);
                  if (l31 >= 8) { a = (pg8::u32x2){0u, 0u}; b = a; }
                  qn[s_] = __builtin_bit_cast(bf16x8v, (pg8::u32x4){a.x, a.y, b.x, b.y});
                  pg8::u32x4 e = *(const pg8::u32x4*)(qrow + NOPE + 16 * s_ + 8 * h5); if (l31 >= 8) e = (pg8::u32x4){0u, 0u, 0u, 0u};
                  qp[s_] = __builtin_bit_cast(bf16x8v, e); } }
            f32x16_t KN;
#pragma unroll
            for (int r = 0; r < 16; ++r) KN[r] = 0.f;
            { const LDSP unsigned char* wb = lds + SD_WBUF + (h & 1) * SD_WBUF_SZ + l31 * 1040 + dh * 512 + h5 * 16;
#pragma unroll
              for (int s_ = 0; s_ < 16; ++s_) { const bf16x8v a = *(const LDSP bf16x8v*)(wb + 32 * s_); KN = MFMA32(a, cfr[s_], KN); if ((s_ & 3) == 3) __builtin_amdgcn_sched_barrier(0); } }
#if defined(PROBE_DUP) && (PROBE_DUP & (1 << 19))
            { const LDSP unsigned char* wb = lds + SD_WBUF + (h & 1) * SD_WBUF_SZ + l31 * 1040 + dh * 512 + h5 * 16;
#pragma unroll
              for (int s_ = 0; s_ < 16; ++s_) { const bf16x8v a = *(const LDSP bf16x8v*)(wb + 32 * s_); KN = MFMA32(a, cfr[s_], KN); if ((s_ & 3) == 3) __builtin_amdgcn_sched_barrier(0); }
#pragma unroll
              for (int r = 0; r < 16; ++r) KN[r] *= 0.5f; }
#endif
            float ssq = 0.f;
#pragma unroll
            for (int r = 0; r < 16; ++r) ssq += KN[r] * KN[r];
            ssq += __shfl_xor(ssq, 32);
            {
            f32x16_t S;
#pragma unroll
            for (int r = 0; r < 16; ++r) S[r] = 0.f;
#pragma unroll
            for (int s_ = 0; s_ < 2; ++s_) { const bf16x8v kf = __builtin_bit_cast(bf16x8v, (pg8::u32x4){pk2bf(KN[8 * s_], KN[8 * s_ + 1]), pk2bf(KN[8 * s_ + 2], KN[8 * s_ + 3]), pk2bf(KN[8 * s_ + 4], KN[8 * s_ + 5]), pk2bf(KN[8 * s_ + 6], KN[8 * s_ + 7])});
                S = MFMA32(s_ == 0 ? qn0 : qn1, kf, S); }
            LDSP float* xch = (LDSP float*)(lds + SD_XCH + (h & 1) * SD_XCH_SZ) + kb * 320;
            if (dh == 1) { xch[lane_] = S[0]; xch[64 + lane_] = S[1]; xch[128 + lane_] = S[2]; xch[192 + lane_] = S[3]; xch[256 + lane_] = ssq; }
            asm volatile("s_waitcnt vmcnt(0)" ::: "memory");
            __syncthreads();
            if (dh == 0) {
                const float rstd = __builtin_amdgcn_rsqf((ssq + xch[256 + lane_]) * (1.0f / NOPE) + NORM_EPS);
                f32x16_t T;
#pragma unroll
                for (int r = 0; r < 16; ++r) T[r] = 0.f;
                T[0] = (S[0] + xch[lane_]) * rstd; T[1] = (S[1] + xch[64 + lane_]) * rstd; T[2] = (S[2] + xch[128 + lane_]) * rstd; T[3] = (S[3] + xch[192 + lane_]) * rstd;
                T = MFMA32(qp0, kpfr[0], T); T = MFMA32(qp1, kpfr[1], T);
                LDSP bf16_t* prow = (LDSP bf16_t*)(lds + SD_PIMG + (G & 1) * SD_PIMG_SZ + (hh * 8 + 4 * h5) * SD_PROW) + 32 * kb + l31;
#pragma unroll
                for (int q = 0; q < 4; ++q) prow[q * (SD_PROW / 2)] = (bf16_t)(pk2bf(exp2f(T[q] - B2), 0.f) & 0xffffu);
            }
            }
        }
        if (G > 0) sd_pv(G > 0 ? G - 1 : 0, O[G > 0 ? G - 1 : 0], Lacc, lds, w, lane, l31_, h5_);
}

__device__ __forceinline__ void mla_sample_decode(const Ctx& c, const FastMla& fm, const bf16_t* __restrict__ qs, float* opart, float* lpart, int j, LDSP unsigned char* lds) {
    using namespace cfg;
    const int tid = (int)tid_now(), tid_ = tid, w = __builtin_amdgcn_readfirstlane(tid >> 6), lane = tid & 63, l31 = lane & 31, h5 = lane >> 5, kb = w & 3, dh = w >> 2;
    const float* ckv = c.in[I_CKV] + (size_t)j * NPOOL * PAGE * KVL; const float* kpe = c.in[I_KPE] + (size_t)j * NPOOL * PAGE * ROPE;
    const float B2 = mla_b2_bound(c, j, lane);
    for (int it = blockIdx.x; it < DB * 2; it += gridDim.x) {
        const int s = it >> 1, hf = it & 1;
        f32x16_t O[4], Lacc;
#pragma unroll
        for (int r = 0; r < 16; ++r) { O[0][r] = 0.f; O[1][r] = 0.f; O[2][r] = 0.f; O[3][r] = 0.f; Lacc[r] = 0.f; }
        bf16x8v qn[2], qp[2];
        { const bf16_t* qrow = qs + ((size_t)(s * DS + (l31 & 7)) * MH + 0) * QD;
#pragma unroll
          for (int s_ = 0; s_ < 2; ++s_) { const int d0 = 32 * dh + 16 * s_ + 4 * h5; pg8::u32x2 a = *(const pg8::u32x2*)(qrow + d0), b = *(const pg8::u32x2*)(qrow + d0 + 8);
              if (l31 >= 8) { a = (pg8::u32x2){0u, 0u}; b = a; }
              qn[s_] = __builtin_bit_cast(bf16x8v, (pg8::u32x4){a.x, a.y, b.x, b.y});
              pg8::u32x4 e = *(const pg8::u32x4*)(qrow + NOPE + 16 * s_ + 8 * h5); if (l31 >= 8) e = (pg8::u32x4){0u, 0u, 0u, 0u};
              qp[s_] = __builtin_bit_cast(bf16x8v, e); } }
        for (int pi = 0; pi < NPAGES / 2; ++pi) {
            const int pg = __builtin_amdgcn_readfirstlane(c.page_table[s * NPAGES + hf * (NPAGES / 2) + pi]);
            __syncthreads();
            { const char* src = (const char*)(ckv + (size_t)pg * PAGE * KVL); int tid = tid_; asm volatile("" : "+v"(tid));
              pg8::f32x4 v[16];
#pragma unroll
              for (int k = 0; k < 16; ++k) v[k] = *(const pg8::f32x4*)(src + (size_t)k * 8192 + (unsigned)tid * 16u);
#pragma unroll
              for (int k = 0; k < 16; ++k) { pg8::u32x2 o; o.x = pk2bf(v[k][0], v[k][1]); o.y = pk2bf(v[k][2], v[k][3]);
                  *(LDSP pg8::u32x2*)(lds + SD_CIMG + ((tid >> 6) + 8 * k) * SD_CROW + (tid & 63) * 8) = o; } }
#if defined(PROBE_DUP) && (PROBE_DUP & (1 << 20))
            { const char* src = (const char*)(ckv + (size_t)pg * PAGE * KVL); int tid = tid_; asm volatile("" : "+v"(tid));
              pg8::f32x4 v[16];
#pragma unroll
              for (int k = 0; k < 16; ++k) v[k] = *(const pg8::f32x4*)(src + (size_t)k * 8192 + (unsigned)tid * 16u);
#pragma unroll
              for (int k = 0; k < 16; ++k) { pg8::u32x2 o; o.x = pk2bf(v[k][0], v[k][1]); o.y = pk2bf(v[k][2], v[k][3]);
                  *(LDSP pg8::u32x2*)(lds + SD_CIMG + ((tid >> 6) + 8 * k) * SD_CROW + (tid & 63) * 8) = o; } }
#endif
            SD_WLOAD(0, 0);
            bf16x8v kpfr[2];
            if (dh == 0) {
#pragma unroll
                for (int s_ = 0; s_ < 2; ++s_) { const float* kp = kpe + ((size_t)pg * PAGE + 32 * kb + l31) * ROPE + 16 * s_ + 8 * h5; const pg8::f32x4 a = *(const pg8::f32x4*)kp, b = *(const pg8::f32x4*)(kp + 4);
                    kpfr[s_] = __builtin_bit_cast(bf16x8v, (pg8::u32x4){pk2bf(a[0], a[1]), pk2bf(a[2], a[3]), pk2bf(b[0], b[1]), pk2bf(b[2], b[3])}); }
            }
            asm volatile("s_waitcnt vmcnt(0)" ::: "memory");
            __syncthreads();
            bf16x8v cfr[16];
#pragma unroll
            for (int s_ = 0; s_ < 16; ++s_) cfr[s_] = *(const LDSP bf16x8v*)(lds + SD_CIMG + (32 * kb + l31) * SD_CROW + (16 * s_ + 8 * h5) * 2);
            sd_group<0>(fm, qs, s, lds, w, lane, l31, h5, kb, dh, cfr, kpfr, qn, qp, O, Lacc, B2);
            sd_group<1>(fm, qs, s, lds, w, lane, l31, h5, kb, dh, cfr, kpfr, qn, qp, O, Lacc, B2);
            sd_group<2>(fm, qs, s, lds, w, lane, l31, h5, kb, dh, cfr, kpfr, qn, qp, O, Lacc, B2);
            sd_group<3>(fm, qs, s, lds, w, lane, l31, h5, kb, dh, cfr, kpfr, qn, qp, O, Lacc, B2);
            __syncthreads();
            sd_pv(3, O[3], Lacc, lds, w, lane, l31, h5);
        }
        {float* op = opart + (size_t)it * (MH * DS) * KVL; int lo_ = lane; asm volatile("" : "+v"(lo_)); const int l31 = lo_ & 31, h5 = lo_ >> 5;
#pragma unroll
        for (int g = 0; g < 4; ++g)
#pragma unroll
            for (int r = 0; r < 16; ++r) op[(size_t)(32 * g + (r & 3) + 8 * (r >> 2) + 4 * h5) * KVL + 32 * w + l31] = O[g][r];
        __syncthreads();
        LDSP float* ltab = (LDSP float*)(lds + SD_XCH);
        if (l31 < 4) {
#pragma unroll
            for (int r = 0; r < 16; ++r) ltab[w * 128 + l31 * 32 + (r & 3) + 8 * (r >> 2) + 4 * h5] = Lacc[r];
        }
        __syncthreads();
        if (tid < 128) { float a = 0.f;
#pragma unroll
            for (int ww = 0; ww < 8; ++ww) a += ltab[ww * 128 + tid];
            lpart[(size_t)it * 128 + tid] = a; }
        }
    }
}

__device__ __forceinline__ void mla_sample_combine(const Ctx& c, const FastMla& fm, const float* __restrict__ opart, const float* __restrict__ lpart, int j, LDSP unsigned char* lds) {
    using namespace cfg;
    const int tid = (int)tid_now(), w = tid >> 6, lane = tid & 63, gw = blockIdx.x * 8 + w, ngw = gridDim.x * 8;
    const float B2 = mla_b2_bound(c, j, lane);
    LDSP float* ol = (LDSP float*)(lds + w * 8704); LDSP float* ptab = ol + 8 * KVL; LDSP float* lt = ptab + 64;
    const float* wuv = c.in[I_WUV] + (size_t)j * KVL * MH * VD;
    for (int item = gw; item < DB * MH; item += ngw) {
        const int s = item / MH, h = item % MH, q = lane >> 3, jn = lane & 7;
        const size_t rq = (size_t)MP + s * DS + q, rk = (size_t)MP + s * DS + jn;
        const bf16_t* qv = fm.qf + rq * (MH * QD) + h * QD; const bf16_t* kn = fm.knb + rk * (MH * NOPE) + h * NOPE; const bf16_t* kp = fm.kpb + rk * ROPE;
        float sc = 0.f;
#pragma unroll
        for (int d8 = 0; d8 < QD / 8; ++d8) { const pg8::u32x4 a = *(const pg8::u32x4*)(qv + 8 * d8), b = d8 < NOPE / 8 ? *(const pg8::u32x4*)(kn + 8 * d8) : *(const pg8::u32x4*)(kp + 8 * (d8 - NOPE / 8));
            const unsigned aw[4] = {a.x, a.y, a.z, a.w}, bw[4] = {b.x, b.y, b.z, b.w};
#pragma unroll
            for (int e = 0; e < 4; ++e) sc += __uint_as_float(aw[e] << 16) * __uint_as_float(bw[e] << 16) + __uint_as_float(aw[e] & 0xffff0000u) * __uint_as_float(bw[e] & 0xffff0000u); }
        const float p = jn <= q ? exp2f(sc - B2) : 0.f;
        float ls = p; ls += __shfl_xor(ls, 1); ls += __shfl_xor(ls, 2); ls += __shfl_xor(ls, 4);
        ptab[lane] = p;
        if (jn == 0) lt[q] = ls + lpart[(size_t)(2 * s) * 128 + h * DS + q] + lpart[(size_t)(2 * s + 1) * 128 + h * DS + q];
        asm volatile("s_waitcnt lgkmcnt(0)" ::: "memory");
        float cn[DS][4];
#pragma unroll
        for (int jj = 0; jj < DS; ++jj)
#pragma unroll
            for (int k = 0; k < 4; ++k) cn[jj][k] = bf2f(fm.cb[((size_t)MP + s * DS + jj) * KVL + lane + 64 * k]);
#pragma unroll
        for (int qq = 0; qq < DS; ++qq)
#pragma unroll
            for (int k = 0; k < 4; ++k) { const int r = lane + 64 * k;
                float a = opart[((size_t)(2 * s) * 128 + h * DS + qq) * KVL + r] + opart[((size_t)(2 * s + 1) * 128 + h * DS + qq) * KVL + r];
#pragma unroll
                for (int jj = 0; jj < DS; ++jj) a += ptab[qq * 8 + jj] * cn[jj][k];
                ol[qq * KVL + r] = a; }
        asm volatile("s_waitcnt lgkmcnt(0)" ::: "memory");
        float acc[DS];
#pragma unroll
        for (int qq = 0; qq < DS; ++qq) acc[qq] = 0.f;
        for (int r = 0; r < KVL; ++r) { const float wv = wuv[((size_t)r * MH + h) * VD + lane];
#pragma unroll
            for (int qq = 0; qq < DS; ++qq) acc[qq] += ol[qq * KVL + r] * wv; }
#pragma unroll
        for (int qq = 0; qq < DS; ++qq) fm.aob[((size_t)MP + s * DS + qq) * (MH * VD) + h * VD + lane] = (bf16_t)(pk2bf(acc[qq] / lt[qq], 0.f) & 0xffffu);
        asm volatile("s_waitcnt lgkmcnt(0)" ::: "memory");
    }
}
struct FastRw {
    bf16_t* xm;
    bf16_t* rkv;
    bf16_t* hb;
    bf16_t* lu;
    float* vf;
    float* ops;
    bf16_t* yo;
    bf16_t *wrkvt, *lorat, *wot;
};
constexpr int RW_REC = 464;
constexpr int RW_CH = 32;
constexpr int RW_BUF = RW_CH * RW_REC * 4;
struct RwSel { __device__ static __forceinline__ int sel(int pn) { return pn < 12 ? (pn >> 2) : (pn == 15 ? 2 : pn - 9); } };

__device__ __forceinline__ void rw_mix_fast(const Ctx& c, const FastRw& fr, int l, int gw, int ngw, int lane) {
    using namespace cfg; const int j = l / 3;
    const float* gain = c.in[I_NMIX] + l * D;
    for (int m = gw; m < MTOT; m += ngw) {
        const int t = row_t(m), sq = row_seq(m);
        pg8::f32x4 xc[4], xp[4], gv[4]; float s = 0.f, sp = 0.f;
#pragma unroll
        for (int q = 0; q < 4; ++q) { gv[q] = *(const pg8::f32x4*)(gain + 4 * lane + 256 * q); xc[q] = *(const pg8::f32x4*)(c.x + (size_t)m * D + 4 * lane + 256 * q);
            s += (xc[q][0] * xc[q][0] + xc[q][1] * xc[q][1]) + (xc[q][2] * xc[q][2] + xc[q][3] * xc[q][3]); }
        if (t > 0) {
#pragma unroll
            for (int q = 0; q < 4; ++q) { xp[q] = *(const pg8::f32x4*)(c.x + (size_t)(m - 1) * D + 4 * lane + 256 * q); sp += (xp[q][0] * xp[q][0] + xp[q][1] * xp[q][1]) + (xp[q][2] * xp[q][2] + xp[q][3] * xp[q][3]); }
        }
        const float rs = 1.0f / sqrtf(wave_sum64(s) * (1.0f / D) + NORM_EPS), rsp = 1.0f / sqrtf(wave_sum64(sp) * (1.0f / D) + NORM_EPS);
#pragma unroll
        for (int q = 0; q < 4; ++q) {
#pragma unroll
            for (int e = 0; e < 4; ++e) xc[q][e] = xc[q][e] * rs * gv[q][e];
            if (t > 0) {
#pragma unroll
                for (int e = 0; e < 4; ++e) xp[q][e] = xp[q][e] * rsp * gv[q][e];
            } else if (sq < BATCH) xp[q] = (pg8::f32x4){0.f, 0.f, 0.f, 0.f};
            else xp[q] = *(const pg8::f32x4*)(c.in[I_SHIFT] + ((size_t)j * DB + (sq - BATCH)) * D + 4 * lane + 256 * q);
        }
        if (t == seq_len(sq) - 1) {
            float* so = sq < BATCH ? c.out + O_SHP + ((size_t)j * BATCH + sq) * D : c.out + O_SHS + ((size_t)j * DB + (sq - BATCH)) * D;
#pragma unroll
            for (int q = 0; q < 4; ++q) *(pg8::f32x4*)(so + 4 * lane + 256 * q) = xc[q];
        }
#pragma unroll
        for (int p = 0; p < 6; ++p)
#pragma unroll
            for (int q = 0; q < 4; ++q) { const pg8::f32x4 mu = *(const pg8::f32x4*)(c.in[I_MU] + ((size_t)j * 6 + p) * D + 4 * lane + 256 * q);
                pg8::u32x2 o; o.x = pk2bf(xc[q][0] + (xp[q][0] - xc[q][0]) * mu[0], xc[q][1] + (xp[q][1] - xc[q][1]) * mu[1]); o.y = pk2bf(xc[q][2] + (xp[q][2] - xc[q][2]) * mu[2], xc[q][3] + (xp[q][3] - xc[q][3]) * mu[3]);
                *(pg8::u32x2*)(fr.xm + ((size_t)p * MTOT + m) * D + 4 * lane + 256 * q) = o; }
        if (lane < 32) *(unsigned*)(fr.hb + (size_t)m * 384 + 320 + 2 * lane) = 0u;
    }
}
struct EpiRwkv {
    static constexpr bool PERM = true;
    bf16_t* rkv; bf16_t* hb;
    __device__ __forceinline__ void operator()(const pg8::f32x4 (&acc)[2][2][4][2], const pg8::Unit& u, int wr, int wc, int fr, int fq) const {
        using namespace pg8;
        const int row0 = u.pm * BM + wr * 64 + fr, cl0 = wc * 32 + 8 * fq;
        const int pn = u.pn;
        bf16_t* base; int ldc, coff, nvalid, act = 0;
        if (pn < 12) { base = rkv; ldc = 3072; coff = pn * 256; nvalid = 256; }
        else { base = hb; ldc = 384; if (pn == 12) { coff = 0; nvalid = 64; act = 1; } else if (pn == 13) { coff = 64; nvalid = 64; } else if (pn == 14) { coff = 128; nvalid = 160; act = 2; } else { coff = 288; nvalid = 32; } }
#pragma unroll
        for (int ai = 0; ai < 2; ++ai)
#pragma unroll
            for (int m = 0; m < 4; ++m) { bf16_t* rowp = base + (size_t)(row0 + ai * HALF + m * 16) * ldc + coff;
#pragma unroll
                for (int bj = 0; bj < 2; ++bj) { const int cl = cl0 + bj * HALF; if (cl >= nvalid) continue;
                    f32x4 v0 = acc[ai][bj][m][0], v1 = acc[ai][bj][m][1];
                    if (act == 1) {
#pragma unroll
                        for (int e = 0; e < 4; ++e) { v0[e] = tanhf(v0[e]); v1[e] = tanhf(v1[e]); } }
                    else if (act == 2) {
#pragma unroll
                        for (int e = 0; e < 4; ++e) { v0[e] = 1.0f / (1.0f + __expf(-v0[e])); v1[e] = 1.0f / (1.0f + __expf(-v1[e])); } }
                    u32x4 w; w.x = cvt_pk_bf16(v0[0], v0[1]); w.y = cvt_pk_bf16(v0[2], v0[3]); w.z = cvt_pk_bf16(v1[0], v1[1]); w.w = cvt_pk_bf16(v1[2], v1[3]);
                    *(u32x4*)(rowp + cl) = w; } }
    }
};
__device__ __forceinline__ void rw_build_lorat(const Ctx& c, bf16_t* lorat, int j, size_t gtid, size_t gsz) {
    using namespace cfg;
    for (size_t i = gtid; i < (size_t)4096 * 384; i += gsz) {
        const int n = (int)(i / 384), k = (int)(i % 384), grp = n >> 10, ch = n & 1023; float v = 0.f;
        if (grp == 0 && k < 64) v = c.in[I_W2][((size_t)j * RW_DL + k) * D + ch];
        else if (grp == 1 && k >= 64 && k < 128) v = c.in[I_A2][((size_t)j * RW_AL + (k - 64)) * D + ch];
        else if (grp == 2 && k >= 128 && k < 288) v = c.in[I_G2][((size_t)j * RW_GL + (k - 128)) * D + ch];
        else if (grp == 3 && k >= 288 && k < 320 && j > 0) v = c.in[I_V2][((size_t)(j - 1) * RW_VL + (k - 288)) * D + ch];
        lorat[i] = (bf16_t)(pk2bf(v, 0.f) & 0xffffu);
    }
}
__device__ __forceinline__ size_t rw_rec_base(int sq, int h) {
    using namespace cfg;
    return sq < BATCH ? ((size_t)sq * RHEADS + h) * SEQ : (size_t)MP * RHEADS + ((size_t)(sq - BATCH) * RHEADS + h) * DS;
}
__device__ __forceinline__ void rw_prep_fast(const Ctx& c, const FastRw& fr, int l, int gw, int ngw, int lane) {
    using namespace cfg; const int j = l / 3;
    for (int it = gw; it < MTOT * RHEADS; it += ngw) {
        const int m = it / RHEADS, h = it % RHEADS, ch = h * RH + lane;
        const bf16_t* rk = fr.rkv + (size_t)m * 3072 + ch; const bf16_t* lu = fr.lu + (size_t)m * 4096 + ch;
        const float r = bf2f(rk[0]), k0 = bf2f(rk[1024]); float v = bf2f(rk[2048]);
        const float wpre = bf2f(lu[0]), apre = bf2f(lu[1024]), gg = bf2f(lu[2048]), vpre = bf2f(lu[3072]);
        const float wl = -softplusf_(-(c.in[I_W0][j * D + ch] + wpre)) - 0.5f;
        const float w = expf(-expf(wl));
        if (j == 0) fr.vf[(size_t)m * D + ch] = v;
        else v = v + (fr.vf[(size_t)m * D + ch] - v) * sigmoidf_(c.in[I_V0][(j - 1) * D + ch] + vpre);
        const float a = sigmoidf_(c.in[I_A0][j * D + ch] + apre);
        float kk = k0 * c.in[I_KK][j * D + ch];
        const float nn = wave_sum64(kk * kk);
        kk *= 1.0f / fmaxf(sqrtf(nn), 1e-12f);
        const float k2 = k0 * (1.0f + (a - 1.0f) * c.in[I_KA][j * D + ch]);
        const float bo = kk * a;
        const float br = wave_sum64(bo * r), kr = wave_sum64(k2 * r), bonus = wave_sum64(r * k2 * c.in[I_RK][(size_t)j * D + ch]);
        const int sq = row_seq(m), t = row_t(m);
        float* rec = fr.ops + (rw_rec_base(sq, h) + t) * RW_REC;
        rec[lane] = -kk; rec[64 + lane] = w * r; rec[128 + lane] = w; rec[192 + lane] = bo; rec[256 + lane] = k2; rec[320 + lane] = v; rec[384 + lane] = gg;
        if (lane == 0) { rec[448] = br; rec[449] = kr; rec[450] = bonus; }
    }
}
template <int CTRL> __device__ __forceinline__ float dppf(float v) { return __int_as_float(__builtin_amdgcn_update_dpp(0, __float_as_int(v), CTRL, 0xF, 0xF, true)); }
__device__ __forceinline__ float red16(float x) { x += dppf<0xB1>(x); x += dppf<0x4E>(x); x += dppf<0x124>(x); x += dppf<0x128>(x); return x; }
__device__ __forceinline__ void rw_scan_fast(const Ctx& c, const FastRw& fr, int l, LDSP unsigned char* lds) {
    using namespace cfg; const int j = l / 3;
    const int tid = (int)tid_now(), w = __builtin_amdgcn_readfirstlane(tid >> 6), lane = tid & 63, cs = lane & 15, rp = 4 * w + (lane >> 4);
    LDSP float* ybuf = (LDSP float*)(lds + 2 * RW_BUF);
    for (int chain = blockIdx.x; chain < NSEQ * RHEADS; chain += gridDim.x) {
        const int sq = chain / RHEADS, h = chain % RHEADS, T = seq_len(sq), m0 = seq_row0(sq);
        const char* src = (const char*)(fr.ops + rw_rec_base(sq, h) * RW_REC);
        pg8::f32x4 S0, S1;
        if (sq < BATCH) { S0 = (pg8::f32x4){0.f, 0.f, 0.f, 0.f}; S1 = S0; }
        else { const float* s0 = c.in[I_WKV] + ((((size_t)j * DB + (sq - BATCH)) * RHEADS + h) * RH + 2 * rp) * RH + 4 * cs; S0 = *(const pg8::f32x4*)s0; S1 = *(const pg8::f32x4*)(s0 + RH); }
        const int nch = (T + RW_CH - 1) / RW_CH;
#define RW_DMA(n, buf) do { const int nb_ = ((T - (n) * RW_CH < RW_CH ? T - (n) * RW_CH : RW_CH) * RW_REC * 4 + 1023) >> 10; \
            for (int q_ = w; q_ < nb_; q_ += 8) __builtin_amdgcn_global_load_lds((const unsigned*)(src + (size_t)(n) * RW_BUF + (size_t)q_ * 1024 + (unsigned)lane * 16u), (LDSP unsigned*)(lds + (buf) * RW_BUF + q_ * 1024), 16, 0, 0); } while (0)
        __syncthreads();
        RW_DMA(0, 0);
        asm volatile("s_waitcnt vmcnt(0)" ::: "memory");
        __syncthreads();
        for (int n = 0; n < nch; ++n) {
            if (n + 1 < nch) RW_DMA(n + 1, (n + 1) & 1);
            const int tn = T - n * RW_CH < RW_CH ? T - n * RW_CH : RW_CH;
            const LDSP unsigned char* bufp = lds + (n & 1) * RW_BUF;
            for (int t = 0; t < tn; ++t) {
                const LDSP unsigned char* rec = bufp + t * (RW_REC * 4);
                const pg8::f32x4 A = *(const LDSP pg8::f32x4*)(rec + cs * 16), WR = *(const LDSP pg8::f32x4*)(rec + 256 + cs * 16), W = *(const LDSP pg8::f32x4*)(rec + 512 + cs * 16),
                                 B = *(const LDSP pg8::f32x4*)(rec + 768 + cs * 16), K = *(const LDSP pg8::f32x4*)(rec + 1024 + cs * 16);
                const pg8::f32x2 V2 = *(const LDSP pg8::f32x2*)(rec + 1280 + rp * 8), SC = *(const LDSP pg8::f32x2*)(rec + 1792);
                float sa0 = (S0[0] * A[0] + S0[1] * A[1]) + (S0[2] * A[2] + S0[3] * A[3]), y0 = (S0[0] * WR[0] + S0[1] * WR[1]) + (S0[2] * WR[2] + S0[3] * WR[3]);
                float sa1 = (S1[0] * A[0] + S1[1] * A[1]) + (S1[2] * A[2] + S1[3] * A[3]), y1 = (S1[0] * WR[0] + S1[1] * WR[1]) + (S1[2] * WR[2] + S1[3] * WR[3]);
                sa0 = red16(sa0); sa1 = red16(sa1); y0 = red16(y0); y1 = red16(y1);
                S0 = S0 * W + sa0 * B + V2[0] * K; S1 = S1 * W + sa1 * B + V2[1] * K;
                if (cs == 0) *(LDSP pg8::f32x2*)(ybuf + t * RH + 2 * rp) = (pg8::f32x2){y0 + sa0 * SC[0] + V2[0] * SC[1], y1 + sa1 * SC[0] + V2[1] * SC[1]};
            }
            asm volatile("s_waitcnt vmcnt(0)" ::: "memory");
            __syncthreads();
            for (int t = w; t < tn; t += 8) {
                const LDSP float* rec = (const LDSP float*)(bufp + t * (RW_REC * 4));
                const float y = ybuf[t * RH + lane], mean = wave_sum64(y) * (1.0f / RH), d = y - mean, var = wave_sum64(d * d) * (1.0f / RH);
                const int ch = h * RH + lane;
                const float yn = d * (1.0f / sqrtf(var + LNX_EPS)) * c.in[I_LNW][j * D + ch] + c.in[I_LNB][j * D + ch];
                const float o = (yn + rec[450] * rec[320 + lane]) * rec[384 + lane];
                fr.yo[(size_t)(m0 + n * RW_CH + t) * D + ch] = (bf16_t)(pk2bf(o, 0.f) & 0xffffu);
            }
            __syncthreads();
        }
#undef RW_DMA
        float* so = (sq < BATCH ? c.out + O_WKVP + (((size_t)j * BATCH + sq) * RHEADS + h) * RH * RH : c.out + O_WKVS + (((size_t)j * DB + (sq - BATCH)) * RHEADS + h) * RH * RH) + (size_t)(2 * rp) * RH + 4 * cs;
        *(pg8::f32x4*)so = S0; *(pg8::f32x4*)(so + RH) = S1;
    }
}
__device__ __forceinline__ float fsigmoid(float x) { return __builtin_amdgcn_rcpf(1.0f + __expf(-x)); }
__device__ __forceinline__ float fsoftplus(float x) { return x > 20.f ? x : __logf(1.0f + __expf(x)); }
__device__ __forceinline__ float rdl(float v, int l) { return __int_as_float(__builtin_amdgcn_readlane(__float_as_int(v), l)); }
__device__ __forceinline__ float wsum_dpp(float x) {
    x = red16(x);
    return (rdl(x, 0) + rdl(x, 16)) + (rdl(x, 32) + rdl(x, 48));
}

__device__ __forceinline__ void red16x4(float& a, float& b, float& c, float& d) {
    asm volatile("s_nop 1\n"
        "v_add_f32_dpp %0, %0, %0 quad_perm:[1,0,3,2] row_mask:0xf bank_mask:0xf\n" "v_add_f32_dpp %1, %1, %1 quad_perm:[1,0,3,2] row_mask:0xf bank_mask:0xf\n"
        "v_add_f32_dpp %2, %2, %2 quad_perm:[1,0,3,2] row_mask:0xf bank_mask:0xf\n" "v_add_f32_dpp %3, %3, %3 quad_perm:[1,0,3,2] row_mask:0xf bank_mask:0xf\n"
        "v_add_f32_dpp %0, %0, %0 quad_perm:[2,3,0,1] row_mask:0xf bank_mask:0xf\n" "v_add_f32_dpp %1, %1, %1 quad_perm:[2,3,0,1] row_mask:0xf bank_mask:0xf\n"
        "v_add_f32_dpp %2, %2, %2 quad_perm:[2,3,0,1] row_mask:0xf bank_mask:0xf\n" "v_add_f32_dpp %3, %3, %3 quad_perm:[2,3,0,1] row_mask:0xf bank_mask:0xf\n"
        "v_add_f32_dpp %0, %0, %0 row_ror:4 row_mask:0xf bank_mask:0xf\n" "v_add_f32_dpp %1, %1, %1 row_ror:4 row_mask:0xf bank_mask:0xf\n"
        "v_add_f32_dpp %2, %2, %2 row_ror:4 row_mask:0xf bank_mask:0xf\n" "v_add_f32_dpp %3, %3, %3 row_ror:4 row_mask:0xf bank_mask:0xf\n"
        "v_add_f32_dpp %0, %0, %0 row_ror:8 row_mask:0xf bank_mask:0xf\n" "v_add_f32_dpp %1, %1, %1 row_ror:8 row_mask:0xf bank_mask:0xf\n"
        "v_add_f32_dpp %2, %2, %2 row_ror:8 row_mask:0xf bank_mask:0xf\n" "v_add_f32_dpp %3, %3, %3 row_ror:8 row_mask:0xf bank_mask:0xf\n"
        "s_nop 1"
        : "+v"(a), "+v"(b), "+v"(c), "+v"(d));
}
struct RwOp { pg8::f32x4 A, WR, W, B, K; pg8::f32x2 V2, SC; };
__device__ __forceinline__ void rw_ldop(RwOp& o, const LDSP unsigned char* rec, int cs, int rp) {
    o.A = *(const LDSP pg8::f32x4*)(rec + cs * 16); o.WR = *(const LDSP pg8::f32x4*)(rec + 256 + cs * 16); o.W = *(const LDSP pg8::f32x4*)(rec + 512 + cs * 16);
    o.B = *(const LDSP pg8::f32x4*)(rec + 768 + cs * 16); o.K = *(const LDSP pg8::f32x4*)(rec + 1024 + cs * 16);
    o.V2 = *(const LDSP pg8::f32x2*)(rec + 1280 + rp * 8); o.SC = *(const LDSP pg8::f32x2*)(rec + 1792);
}
__device__ __forceinline__ float fma_s(float a, float b, float c) { float d; asm("v_fma_f32 %0, %1, %2, %3" : "=v"(d) : "v"(a), "v"(b), "v"(c)); return d; }
__device__ __forceinline__ float mul_s(float a, float b) { float d; asm("v_mul_f32 %0, %1, %2" : "=v"(d) : "v"(a), "v"(b)); return d; }
__device__ __forceinline__ void rw_step(pg8::f32x4& S0, pg8::f32x4& S1, const RwOp& o, LDSP float* yrow, bool wr) {
    float sa0 = fma_s(S0[3], o.A[3], fma_s(S0[2], o.A[2], fma_s(S0[1], o.A[1], mul_s(S0[0], o.A[0]))));
    float sa1 = fma_s(S1[3], o.A[3], fma_s(S1[2], o.A[2], fma_s(S1[1], o.A[1], mul_s(S1[0], o.A[0]))));
    float y0 = fma_s(S0[3], o.WR[3], fma_s(S0[2], o.WR[2], fma_s(S0[1], o.WR[1], mul_s(S0[0], o.WR[0]))));
    float y1 = fma_s(S1[3], o.WR[3], fma_s(S1[2], o.WR[2], fma_s(S1[1], o.WR[1], mul_s(S1[0], o.WR[0]))));
    float t0[4], t1[4];
#pragma unroll
    for (int e = 0; e < 4; ++e) { t0[e] = fma_s(o.K[e], o.V2[0], mul_s(S0[e], o.W[e])); t1[e] = fma_s(o.K[e], o.V2[1], mul_s(S1[e], o.W[e])); }
    red16x4(sa0, sa1, y0, y1);
#pragma unroll
    for (int e = 0; e < 4; ++e) { S0[e] = fma_s(o.B[e], sa0, t0[e]); S1[e] = fma_s(o.B[e], sa1, t1[e]); }
    if (wr) *(LDSP pg8::f32x2*)yrow = (pg8::f32x2){fma_s(o.V2[0], o.SC[1], fma_s(sa0, o.SC[0], y0)), fma_s(o.V2[1], o.SC[1], fma_s(sa1, o.SC[0], y1))};
}
struct RwIn { unsigned short r, k, v, wp, ap, g, vp; float vf; };
template <int J>
__device__ __forceinline__ void rw_scan_fused(const Ctx& c, const FastRw& fr, LDSP unsigned char* lds) {
    using namespace cfg; constexpr int j = J;
    const int tid = (int)tid_now(), w = __builtin_amdgcn_readfirstlane(tid >> 6), lane = tid & 63, cs = lane & 15, rp = 4 * w + (lane >> 4);
    LDSP float* ybuf = (LDSP float*)(lds + 2 * RW_BUF);
    for (int chain = blockIdx.x; chain < NSEQ * RHEADS; chain += gridDim.x) {
        const int sq = chain / RHEADS, h = chain % RHEADS, T = seq_len(sq), m0 = seq_row0(sq), ch = h * RH + lane;
        const float p_w0 = c.in[I_W0][j * D + ch], p_a0 = c.in[I_A0][j * D + ch], p_kk = c.in[I_KK][j * D + ch], p_ka = c.in[I_KA][j * D + ch], p_rk = c.in[I_RK][(size_t)j * D + ch],
                    p_lnw = c.in[I_LNW][j * D + ch], p_lnb = c.in[I_LNB][j * D + ch], p_v0 = j > 0 ? c.in[I_V0][(j - 1) * D + ch] : 0.f;
        pg8::f32x4 S0, S1;
        if (sq < BATCH) { S0 = (pg8::f32x4){0.f, 0.f, 0.f, 0.f}; S1 = S0; }
        else { const float* s0 = c.in[I_WKV] + ((((size_t)j * DB + (sq - BATCH)) * RHEADS + h) * RH + 2 * rp) * RH + 4 * cs; S0 = *(const pg8::f32x4*)s0; S1 = *(const pg8::f32x4*)(s0 + RH); }
        const int nch = (T + RW_CH - 1) / RW_CH;
        RwIn in[4];
#define RW_LOADIN(n) do { _Pragma("unroll") for (int q = 0; q < 4; ++q) { const int t_ = (n) * RW_CH + 4 * w + q; if (t_ < T) { const size_t m_ = (size_t)(m0 + t_); \
                const bf16_t* rk_ = fr.rkv + m_ * 3072 + ch; const bf16_t* lu_ = fr.lu + m_ * 4096 + ch; \
                in[q].r = rk_[0]; in[q].k = rk_[1024]; in[q].v = rk_[2048]; in[q].wp = lu_[0]; in[q].ap = lu_[1024]; in[q].g = lu_[2048]; in[q].vp = lu_[3072]; \
                in[q].vf = j > 0 ? fr.vf[m_ * D + ch] : 0.f; } } } while (0)
#define RW_PREP(n, buf) do { _Pragma("unroll") for (int q = 0; q < 4; ++q) { const int tl_ = 4 * w + q, t_ = (n) * RW_CH + tl_; if (t_ < T) { \
                const float r_ = bf2f(in[q].r), k0_ = bf2f(in[q].k); float v_ = bf2f(in[q].v); \
                const float wl_ = -fsoftplus(-(p_w0 + bf2f(in[q].wp))) - 0.5f, w_ = __expf(-__expf(wl_)); \
                if (j == 0) fr.vf[(size_t)(m0 + t_) * D + ch] = v_; else v_ = v_ + (in[q].vf - v_) * fsigmoid(p_v0 + bf2f(in[q].vp)); \
                const float a_ = fsigmoid(p_a0 + bf2f(in[q].ap)); float kk_ = k0_ * p_kk; \
                const float k2_ = k0_ * (1.0f + (a_ - 1.0f) * p_ka); \
                float n_ = red16(kk_ * kk_), e1_ = red16(r_ * k2_ * p_rk), e2_ = red16(k2_ * r_); \
                n_ = (rdl(n_, 0) + rdl(n_, 16)) + (rdl(n_, 32) + rdl(n_, 48)); e1_ = (rdl(e1_, 0) + rdl(e1_, 16)) + (rdl(e1_, 32) + rdl(e1_, 48)); e2_ = (rdl(e2_, 0) + rdl(e2_, 16)) + (rdl(e2_, 32) + rdl(e2_, 48)); \
                kk_ *= __builtin_amdgcn_rcpf(fmaxf(__builtin_amdgcn_sqrtf(n_), 1e-12f)); const float bo_ = kk_ * a_; const float e3_ = wsum_dpp(bo_ * r_); \
                LDSP float* rec_ = (LDSP float*)(lds + (buf) * RW_BUF + tl_ * (RW_REC * 4)); \
                rec_[lane] = -kk_; rec_[64 + lane] = w_ * r_; rec_[128 + lane] = w_; rec_[192 + lane] = bo_; rec_[256 + lane] = k2_; rec_[320 + lane] = v_; rec_[384 + lane] = bf2f(in[q].g); \
                if (lane == 0) { rec_[448] = e3_; rec_[449] = e2_; rec_[450] = e1_; } } } } while (0)
        __syncthreads();
        RW_LOADIN(0); RW_PREP(0, 0);
        __syncthreads();
        for (int n = 0; n < nch; ++n) {
            if (n + 1 < nch) RW_LOADIN(n + 1);
            const int tn = T - n * RW_CH < RW_CH ? T - n * RW_CH : RW_CH;
            const LDSP unsigned char* bufp = lds + (n & 1) * RW_BUF;
#if defined(PROBE_DUP) && (PROBE_DUP & (1 << 17))
            { RwOp o0, o1; rw_ldop(o0, bufp, cs, rp); pg8::f32x4 T0 = S0, T1 = S1;
              for (int t = 0; t < tn; t += 2) {
                  rw_ldop(o1, bufp + (t + 1) * (RW_REC * 4), cs, rp);
                  rw_step(T0, T1, o0, ybuf + t * RH + 2 * rp, cs == 0);
                  rw_ldop(o0, bufp + (t + 2 < tn ? t + 2 : t) * (RW_REC * 4), cs, rp);
                  rw_step(T0, T1, o1, ybuf + (t + 1) * RH + 2 * rp, cs == 0);
              } asm volatile("" :: "v"(T0), "v"(T1)); }
#endif
            { RwOp o0, o1; rw_ldop(o0, bufp, cs, rp);
              for (int t = 0; t < tn; t += 2) {
                  rw_ldop(o1, bufp + (t + 1) * (RW_REC * 4), cs, rp);
                  rw_step(S0, S1, o0, ybuf + t * RH + 2 * rp, cs == 0);
                  rw_ldop(o0, bufp + (t + 2 < tn ? t + 2 : t) * (RW_REC * 4), cs, rp);
                  rw_step(S0, S1, o1, ybuf + (t + 1) * RH + 2 * rp, cs == 0);
              } }
            if (n + 1 < nch) RW_PREP(n + 1, (n + 1) & 1);
#if defined(PROBE_DUP) && (PROBE_DUP & (1 << 18))
            if (n + 1 < nch) RW_PREP(n + 1, (n + 1) & 1);
#endif
            __syncthreads();
            for (int t = w; t < tn; t += 8) {
                const LDSP float* rec = (const LDSP float*)(bufp + t * (RW_REC * 4));
                const float y = ybuf[t * RH + lane], mean = wsum_dpp(y) * (1.0f / RH), d = y - mean, var = wsum_dpp(d * d) * (1.0f / RH);
                const float yn = d * __builtin_amdgcn_rsqf(var + LNX_EPS) * p_lnw + p_lnb;
                const float o = (yn + rec[450] * rec[320 + lane]) * rec[384 + lane];
                fr.yo[(size_t)(m0 + n * RW_CH + t) * D + ch] = (bf16_t)(pk2bf(o, 0.f) & 0xffffu);
            }
            __syncthreads();
        }
#undef RW_LOADIN
#undef RW_PREP
        float* so = (sq < BATCH ? c.out + O_WKVP + (((size_t)j * BATCH + sq) * RHEADS + h) * RH * RH : c.out + O_WKVS + (((size_t)j * DB + (sq - BATCH)) * RHEADS + h) * RH * RH) + (size_t)(2 * rp) * RH + 4 * cs;
        *(pg8::f32x4*)so = S0; *(pg8::f32x4*)(so + RH) = S1;
    }
}
struct FastMb {
    bf16_t* zb;
    bf16_t* xbcr;
    float* dtraw;
    bf16_t* xbcb;
    float* dt;
    float* y;
    bf16_t* yzn;
    bf16_t *wbint, *wbot;
};
struct EpiMamba {
    static constexpr bool PERM = true;
    bf16_t* zb; bf16_t* xbcr; float* dtraw;
    __device__ __forceinline__ void operator()(const pg8::f32x4 (&acc)[2][2][4][2], const pg8::Unit& u, int wr, int wc, int fr, int fq) const {
        using namespace pg8;
        const int row0 = u.pm * BM + wr * 64 + fr, cl0 = wc * 32 + 8 * fq, pn = u.pn;
        if (pn < 20) {
            bf16_t* base = pn < 8 ? zb : xbcr; const int ldc = pn < 8 ? 2048 : 3072, coff = pn < 8 ? pn * 256 : (pn - 8) * 256;
#pragma unroll
            for (int ai = 0; ai < 2; ++ai)
#pragma unroll
                for (int m = 0; m < 4; ++m) { bf16_t* rowp = base + (size_t)(row0 + ai * HALF + m * 16) * ldc + coff + cl0;
#pragma unroll
                    for (int bj = 0; bj < 2; ++bj) { const f32x4 v0 = acc[ai][bj][m][0], v1 = acc[ai][bj][m][1];
                        u32x4 w; w.x = cvt_pk_bf16(v0[0], v0[1]); w.y = cvt_pk_bf16(v0[2], v0[3]); w.z = cvt_pk_bf16(v1[0], v1[1]); w.w = cvt_pk_bf16(v1[2], v1[3]);
                        *(u32x4*)(rowp + bj * HALF) = w; } }
        } else if (cl0 < 32) {
#pragma unroll
            for (int ai = 0; ai < 2; ++ai)
#pragma unroll
                for (int m = 0; m < 4; ++m) { float* rowp = dtraw + (size_t)(row0 + ai * HALF + m * 16) * 32 + cl0;
                    *(f32x4*)rowp = acc[ai][0][m][0]; *(f32x4*)(rowp + 4) = acc[ai][0][m][1]; }
        }
    }
};
__device__ __forceinline__ void mb_conv_fast(const Ctx& c, const FastMb& fb, int l, size_t gtid, size_t gsz, bool write_f32) {
    using namespace cfg; const int j = l / 3; constexpr int NB = MB_CD / 8, TB = 8;
    for (size_t i = gtid; i < (size_t)(MTOT / TB) * NB; i += gsz) {
        const int mb = (int)(i / NB) * TB, cb = (int)(i % NB) * 8, t0 = row_t(mb), sq = row_seq(mb), T = seq_len(sq);
        float wt[MB_CONV][8], bias[8], win[MB_CONV][8];
#pragma unroll
        for (int e = 0; e < 8; ++e) bias[e] = c.in[I_CONVB][j * MB_CD + cb + e];
#pragma unroll
        for (int jj = 0; jj < MB_CONV; ++jj)
#pragma unroll
            for (int e = 0; e < 8; ++e) wt[jj][e] = c.in[I_CONVW][((size_t)j * MB_CONV + jj) * MB_CD + cb + e];
#pragma unroll
        for (int jj = 0; jj < MB_CONV - 1; ++jj) {
            const int tt = t0 + jj - (MB_CONV - 1);
            if (tt >= 0) { const pg8::u32x4 raw = *(const pg8::u32x4*)(fb.xbcr + (size_t)(mb + jj - (MB_CONV - 1)) * MB_CD + cb); const unsigned wv[4] = {raw.x, raw.y, raw.z, raw.w};
#pragma unroll
                for (int q = 0; q < 4; ++q) { win[jj][2 * q] = __uint_as_float(wv[q] << 16); win[jj][2 * q + 1] = __uint_as_float(wv[q] & 0xffff0000u); } }
            else if (sq >= BATCH) { const float* st = c.in[I_CONV] + (((size_t)j * DB + (sq - BATCH)) * (MB_CONV - 1) + (tt + MB_CONV - 1)) * MB_CD + cb;
#pragma unroll
                for (int e = 0; e < 8; ++e) win[jj][e] = st[e]; }
            else {
#pragma unroll
                for (int e = 0; e < 8; ++e) win[jj][e] = 0.f; }
        }
#pragma unroll
        for (int tb = 0; tb < TB; ++tb) {
            const int m = mb + tb, t = t0 + tb;
            { const pg8::u32x4 raw = *(const pg8::u32x4*)(fb.xbcr + (size_t)m * MB_CD + cb); const unsigned wv[4] = {raw.x, raw.y, raw.z, raw.w};
#pragma unroll
              for (int q = 0; q < 4; ++q) { win[3][2 * q] = __uint_as_float(wv[q] << 16); win[3][2 * q + 1] = __uint_as_float(wv[q] & 0xffff0000u); } }
            if (t >= T - (MB_CONV - 1)) {
                float* so = (sq < BATCH ? c.out + O_CONVP + (((size_t)j * BATCH + sq) * (MB_CONV - 1) + (t - (T - (MB_CONV - 1)))) * MB_CD
                                        : c.out + O_CONVS + (((size_t)j * DB + (sq - BATCH)) * (MB_CONV - 1) + (t - (T - (MB_CONV - 1)))) * MB_CD) + cb;
#pragma unroll
                for (int e = 0; e < 8; ++e) so[e] = win[3][e];
            }
            unsigned w[4];
#pragma unroll
            for (int q = 0; q < 4; ++q) {
                float a0 = bias[2 * q], a1 = bias[2 * q + 1];
#pragma unroll
                for (int jj = 0; jj < MB_CONV; ++jj) { a0 += win[jj][2 * q] * wt[jj][2 * q]; a1 += win[jj][2 * q + 1] * wt[jj][2 * q + 1]; }
                a0 = a0 * __builtin_amdgcn_rcpf(1.0f + __expf(-a0)); a1 = a1 * __builtin_amdgcn_rcpf(1.0f + __expf(-a1));
                w[q] = pk2bf(a0, a1); if (write_f32) { c.xbc[(size_t)m * MB_CD + cb + 2 * q] = a0; c.xbc[(size_t)m * MB_CD + cb + 2 * q + 1] = a1; } }
            *(pg8::u32x4*)(fb.xbcb + (size_t)m * MB_CD + cb) = (pg8::u32x4){w[0], w[1], w[2], w[3]};
#pragma unroll
            for (int jj = 0; jj < MB_CONV - 1; ++jj)
#pragma unroll
                for (int e = 0; e < 8; ++e) win[jj][e] = win[jj + 1][e];
        }
    }
    for (size_t i = gtid; i < (size_t)MTOT * MB_HEADS; i += gsz) {
        const float v = softplusf_(fb.dtraw[i] + c.in[I_DTB][j * MB_HEADS + (int)(i % MB_HEADS)]);
        fb.dt[i] = v; if (write_f32) c.dt[i] = v;
    }
}
__device__ __forceinline__ void mb_gate_fast(const Ctx& c, const FastMb& fb, const float* __restrict__ y, int l, int gw, int ngw, int lane) {
    using namespace cfg; const int j = l / 3; constexpr int GW_ = MB_INNER / MB_GROUPS;
    for (int it = gw; it < MTOT * MB_GROUPS; it += ngw) {
        const int m = it / MB_GROUPS, g = it % MB_GROUPS; const size_t o = (size_t)m * MB_INNER + g * GW_ + 8 * lane;
        const pg8::f32x4 y0 = *(const pg8::f32x4*)(y + o), y1 = *(const pg8::f32x4*)(y + o + 4); const pg8::u32x4 zr = *(const pg8::u32x4*)(fb.zb + o);
        const unsigned zw[4] = {zr.x, zr.y, zr.z, zr.w}; float v[8]; float s = 0.f;
#pragma unroll
        for (int q = 0; q < 4; ++q) { const float z0 = __uint_as_float(zw[q] << 16), z1 = __uint_as_float(zw[q] & 0xffff0000u);
            v[2 * q] = (q < 2 ? y0[2 * q] : y1[2 * q - 4]) * siluf_(z0); v[2 * q + 1] = (q < 2 ? y0[2 * q + 1] : y1[2 * q - 3]) * siluf_(z1); s += v[2 * q] * v[2 * q] + v[2 * q + 1] * v[2 * q + 1]; }
        const float rs = 1.0f / sqrtf(wave_sum64(s) * (1.0f / GW_) + NORM_EPS);
        const float* nw = c.in[I_BNORM] + j * MB_INNER + g * GW_ + 8 * lane; unsigned w[4];
#pragma unroll
        for (int q = 0; q < 4; ++q) w[q] = pk2bf(v[2 * q] * rs * nw[2 * q], v[2 * q + 1] * rs * nw[2 * q + 1]);
        *(pg8::u32x4*)(fb.yzn + o) = (pg8::u32x4){w[0], w[1], w[2], w[3]};
    }
}
constexpr int SS_XR = 144, SS_BR = 272;
constexpr int SS_XIM = 0, SS_XSM = SS_XIM + 128 * SS_XR, SS_BIM = SS_XSM + 128 * SS_XR, SS_CIM = SS_BIM + 128 * SS_BR, SS_MTM = SS_CIM + 128 * SS_BR, SS_HBM = SS_MTM + 128 * SS_BR, SS_TAB = SS_HBM + 128 * SS_XR, SS_END = SS_TAB + 2048;
__device__ __forceinline__ bf16x8v ss_trfrag(const LDSP unsigned char* img, int rowstride, int k0, int col0, int lane) {
    const int r0 = k0 + 8 * (lane >> 5) + ((lane & 15) >> 2), cc = col0 + 16 * ((lane >> 4) & 1) + 4 * (lane & 3);
    const s16x4 t0 = __builtin_amdgcn_ds_read_tr16_b64_v4i16((LDSP s16x4*)(img + r0 * rowstride + cc * 2));
    const s16x4 t1 = __builtin_amdgcn_ds_read_tr16_b64_v4i16((LDSP s16x4*)(img + (r0 + 4) * rowstride + cc * 2));
    return (bf16x8v){t0[0], t0[1], t0[2], t0[3], t1[0], t1[1], t1[2], t1[3]};
}
__device__ __forceinline__ void mb_ssd_prompt(const Ctx& c, const FastMb& fb, int l, LDSP unsigned char* lds) {
    using namespace cfg; const int j = l / 3;
    const int tid = (int)tid_now(), w = __builtin_amdgcn_readfirstlane(tid >> 6), lane = tid & 63, l31 = lane & 31, h5 = lane >> 5;
    LDSP float* tab = (LDSP float*)(lds + SS_TAB);
    for (int chain = blockIdx.x; chain < BATCH * MB_HEADS; chain += gridDim.x) {
        const int b = chain / MB_HEADS, hd = chain % MB_HEADS, g = hd / (MB_HEADS / MB_GROUPS);
        const float Ah = -expf(c.in[I_ALOG][j * MB_HEADS + hd]), Dh = c.in[I_BD][j * MB_HEADS + hd];
        f32x16_t H;
#pragma unroll
        for (int r = 0; r < 16; ++r) H[r] = 0.f;
        pg8::u32x4 nx[2], nB[4], nC[4]; float ndt = 0.f;
#define SS_LOAD(ck_) do { const size_t mm_ = (size_t)b * SEQ + 128 * (ck_); int tq_ = tid; asm volatile("" : "+v"(tq_)); \
            _Pragma("unroll") for (int q = 0; q < 2; ++q) { const int ci = tq_ + 512 * q; nx[q] = *(const pg8::u32x4*)(fb.xbcb + (mm_ + (ci >> 3)) * MB_CD + hd * MB_HEAD + (ci & 7) * 8); } \
            _Pragma("unroll") for (int q = 0; q < 4; ++q) { const int ci = tq_ + 512 * q; const bf16_t* rowp = fb.xbcb + (mm_ + (ci >> 4)) * MB_CD + MB_INNER + g * MB_STATE + (ci & 15) * 8; \
                nB[q] = *(const pg8::u32x4*)rowp; nC[q] = *(const pg8::u32x4*)(rowp + MB_GN); } \
            if (tq_ < 128) ndt = fb.dt[(mm_ + tq_) * MB_HEADS + hd]; } while (0)
        SS_LOAD(0);
        for (int ck = 0; ck < SEQ / 128; ++ck) {
            const size_t m0 = (size_t)b * SEQ + 128 * ck;
            int tl = tid; asm volatile("" : "+v"(tl));
            pg8::u32x4 xr[2];
#pragma unroll
            for (int q = 0; q < 2; ++q) { const int ci = tl + 512 * q; xr[q] = nx[q];
                *(LDSP pg8::u32x2*)(lds + SS_XIM + (ci >> 3) * SS_XR + (ci & 7) * 16) = (pg8::u32x2){xr[q].x, xr[q].y}; *(LDSP pg8::u32x2*)(lds + SS_XIM + (ci >> 3) * SS_XR + (ci & 7) * 16 + 8) = (pg8::u32x2){xr[q].z, xr[q].w}; }
#pragma unroll
            for (int q = 0; q < 4; ++q) { const int ci = tl + 512 * q;
                *(LDSP pg8::u32x4*)(lds + SS_BIM + (ci >> 4) * SS_BR + (ci & 15) * 16) = nB[q];
                *(LDSP pg8::u32x4*)(lds + SS_CIM + (ci >> 4) * SS_BR + (ci & 15) * 16) = nC[q]; }
            if (tl < 128) { tab[128 + tl] = ndt; tab[384 + tl] = ndt * Ah; }
            if (ck + 1 < SEQ / 128) SS_LOAD(ck + 1);
            __syncthreads();
            if (w == 0) {
                const float v0 = tab[384 + 2 * lane], v1 = tab[384 + 2 * lane + 1]; float s = v0 + v1;
#pragma unroll
                for (int o = 1; o < 64; o <<= 1) { const float u = __shfl_up(s, o); if (lane >= o) s += u; }
                tab[2 * lane] = s - v1; tab[2 * lane + 1] = s;
            }
            __syncthreads();
            const float alast = tab[127];
#pragma unroll
            for (int q = 0; q < 2; ++q) { const int ci = tl + 512 * q, row = ci >> 3; const float sc = __expf(alast - tab[row]) * tab[128 + row]; const unsigned xw[4] = {xr[q].x, xr[q].y, xr[q].z, xr[q].w}; unsigned ow[4];
#pragma unroll
                for (int e = 0; e < 4; ++e) ow[e] = pk2bf(__uint_as_float(xw[e] << 16) * sc, __uint_as_float(xw[e] & 0xffff0000u) * sc);
                *(LDSP pg8::u32x2*)(lds + SS_XSM + row * SS_XR + (ci & 7) * 16) = (pg8::u32x2){ow[0], ow[1]}; *(LDSP pg8::u32x2*)(lds + SS_XSM + row * SS_XR + (ci & 7) * 16 + 8) = (pg8::u32x2){ow[2], ow[3]}; }
            { int ln = lane; asm volatile("" : "+v"(ln)); const int a31 = ln & 31, a5 = ln >> 5;
              for (int tt = w; tt < 10; tt += 8) {
                int ib = tt < 1 ? 0 : (tt < 3 ? 1 : (tt < 6 ? 2 : 3)); const int jb = tt - (ib * (ib + 1)) / 2;
                f32x16_t ST;
#pragma unroll
                for (int r = 0; r < 16; ++r) ST[r] = 0.f;
#pragma unroll
                for (int s = 0; s < 8; ++s) { const bf16x8v a = *(const LDSP bf16x8v*)(lds + SS_BIM + (32 * jb + a31) * SS_BR + (16 * s + 8 * a5) * 2), bb = *(const LDSP bf16x8v*)(lds + SS_CIM + (32 * ib + a31) * SS_BR + (16 * s + 8 * a5) * 2);
                    ST = MFMA32(a, bb, ST); }
                const float ai = tab[32 * ib + a31];
#pragma unroll
                for (int g4 = 0; g4 < 4; ++g4) { const int jr = 32 * jb + 8 * g4 + 4 * a5; const pg8::f32x4 aj = *(const LDSP pg8::f32x4*)(tab + jr), dj = *(const LDSP pg8::f32x4*)(tab + 128 + jr);
#pragma unroll
                    for (int e = 0; e < 4; ++e) { const int jj = jr + e, ii = 32 * ib + a31; const float mv = jj <= ii ? ST[4 * g4 + e] * __expf(ai - aj[e]) * dj[e] : 0.f;
                        *(LDSP bf16_t*)(lds + SS_MTM + jj * SS_BR + ii * 2) = (bf16_t)(pk2bf(mv, 0.f) & 0xffffu); } }
              }
              const int nb = w >> 1, pb = w & 1;
#pragma unroll
              for (int r = 0; r < 16; ++r) *(LDSP bf16_t*)(lds + SS_HBM + (32 * nb + (r & 3) + 8 * (r >> 2) + 4 * a5) * SS_XR + (32 * pb + a31) * 2) = (bf16_t)(pk2bf(H[r], 0.f) & 0xffffu);
            }
            __syncthreads();
            { int ln = lane; asm volatile("" : "+v"(ln)); const int a31 = ln & 31, a5 = ln >> 5;
              const int pb = w & 1, ib = w >> 1, nb = w >> 1;
              f32x16_t Y;
#pragma unroll
              for (int r = 0; r < 16; ++r) Y[r] = 0.f;
#pragma unroll
              for (int s = 0; s < 8; ++s) { const bf16x8v a = ss_trfrag(lds + SS_HBM, SS_XR, 16 * s, 32 * pb, ln), bb = *(const LDSP bf16x8v*)(lds + SS_CIM + (32 * ib + a31) * SS_BR + (16 * s + 8 * a5) * 2);
                  Y = MFMA32(a, bb, Y); if (s & 1) __builtin_amdgcn_sched_barrier(0); }
              const float ei = __expf(tab[32 * ib + a31]);
#pragma unroll
              for (int r = 0; r < 16; ++r) Y[r] *= ei;
              for (int s = 0; s < 2 * (ib + 1); ++s) { const bf16x8v a = ss_trfrag(lds + SS_XIM, SS_XR, 16 * s, 32 * pb, ln), bb = ss_trfrag(lds + SS_MTM, SS_BR, 16 * s, 32 * ib, ln);
                  Y = MFMA32(a, bb, Y); }
              { const size_t mrow = m0 + 32 * ib + a31; float* yrow = fb.y + mrow * MB_INNER + hd * MB_HEAD + 32 * pb + 4 * a5;
#pragma unroll
                for (int g4 = 0; g4 < 4; ++g4) { const pg8::u32x2 xv = *(const LDSP pg8::u32x2*)(lds + SS_XIM + (32 * ib + a31) * SS_XR + (32 * pb + 8 * g4 + 4 * a5) * 2);
                    pg8::f32x4 o; o[0] = Y[4 * g4] + Dh * __uint_as_float(xv.x << 16); o[1] = Y[4 * g4 + 1] + Dh * __uint_as_float(xv.x & 0xffff0000u); o[2] = Y[4 * g4 + 2] + Dh * __uint_as_float(xv.y << 16); o[3] = Y[4 * g4 + 3] + Dh * __uint_as_float(xv.y & 0xffff0000u);
                    *(pg8::f32x4*)(yrow + 8 * g4) = o; } }
              const float dec = __expf(tab[127]);
#pragma unroll
              for (int r = 0; r < 16; ++r) H[r] *= dec;
#pragma unroll
              for (int s = 0; s < 8; ++s) { const bf16x8v a = ss_trfrag(lds + SS_BIM, SS_BR, 16 * s, 32 * nb, ln), bb = ss_trfrag(lds + SS_XSM, SS_XR, 16 * s, 32 * pb, ln);
                  H = MFMA32(a, bb, H); if (s & 1) __builtin_amdgcn_sched_barrier(0); }
            }
            __syncthreads();
        }
#undef SS_LOAD
        { const int nb = w >> 1, pb = w & 1; float* so = c.out + O_SSMP + (((size_t)j * BATCH + b) * MB_HEADS + hd) * MB_HEAD * MB_STATE;
#pragma unroll
          for (int r = 0; r < 16; ++r) so[(size_t)(32 * pb + l31) * MB_STATE + 32 * nb + (r & 3) + 8 * (r >> 2) + 4 * h5] = H[r]; }
    }
}
__device__ __forceinline__ void mb_scan_sample(const Ctx& c, const FastMb& fb, int l) {
    using namespace cfg; const int j = l / 3;
    const int tid = (int)tid_now(), p = tid >> 3, ns = tid & 7;
    for (int chain = blockIdx.x; chain < DB * MB_HEADS; chain += gridDim.x) {
        const int s = chain / MB_HEADS, hd = chain % MB_HEADS, g = hd / (MB_HEADS / MB_GROUPS);
        const float Ah = -expf(c.in[I_ALOG][j * MB_HEADS + hd]), Dh = c.in[I_BD][j * MB_HEADS + hd];
        const size_t so = ((((size_t)j * DB + s) * MB_HEADS + hd) * MB_HEAD + p) * MB_STATE + 16 * ns;
        float hs[16];
#pragma unroll
        for (int q = 0; q < 4; ++q) { const pg8::f32x4 v = *(const pg8::f32x4*)(c.in[I_SSM] + so + 4 * q); hs[4 * q] = v[0]; hs[4 * q + 1] = v[1]; hs[4 * q + 2] = v[2]; hs[4 * q + 3] = v[3]; }
        for (int t = 0; t < DS; ++t) {
            const size_t m = (size_t)MP + s * DS + t;
            const float dtv = fb.dt[m * MB_HEADS + hd], dA = expf(dtv * Ah), xv = bf2f(fb.xbcb[m * MB_CD + hd * MB_HEAD + p]), xdt = xv * dtv;
            const bf16_t* Bp = fb.xbcb + m * MB_CD + MB_INNER + g * MB_STATE + 16 * ns; const bf16_t* Cp = Bp + MB_GN;
            float yy = 0.f;
#pragma unroll
            for (int k = 0; k < 16; ++k) { hs[k] = hs[k] * dA + xdt * bf2f(Bp[k]); yy += bf2f(Cp[k]) * hs[k]; }
            yy += __shfl_xor(yy, 1); yy += __shfl_xor(yy, 2); yy += __shfl_xor(yy, 4);
            if (ns == 0) fb.y[m * MB_INNER + hd * MB_HEAD + p] = yy + Dh * xv;
        }
        float* oo = c.out + O_SSMS + so;
#pragma unroll
        for (int q = 0; q < 4; ++q) *(pg8::f32x4*)(oo + 4 * q) = (pg8::f32x4){hs[4 * q], hs[4 * q + 1], hs[4 * q + 2], hs[4 * q + 3]};
    }
}
constexpr int RC_RS = 144;
constexpr int RC_AT = 0, RC_RT = 4608, RC_BB = 9216, RC_KB = 13824, RC_BH = 18432, RC_KH = 23040, RC_VV = 27648, RC_UT = 32256, RC_GG = 36864;
constexpr int RC_SB = 41472;
constexpr int RC_NAK = 50688, RC_MRB = 53248, RC_MRK = 55808, RC_NS = 80;
constexpr int RC_NAB = 58368;
constexpr int RC_E = 62464;
constexpr int RC_YB = 70656;
constexpr int RC_GL = 78848, RC_BON = 79104, RC_VV2 = 79360, RC_GG2 = RC_VV2 + 4608, RC_END = RC_GG2 + 4608;
__device__ __forceinline__ bf16x8v rc_nat(const LDSP unsigned char* img, int stride, int row, int kofs) { return *(const LDSP bf16x8v*)(img + row * stride + kofs * 2); }
__device__ __forceinline__ int rc_row(int r, int h5) { return (r & 3) + 8 * (r >> 2) + 4 * h5; }
__device__ __forceinline__ void rc_st16(LDSP unsigned char* p, float v) { *(LDSP bf16_t*)p = (bf16_t)(pk2bf(v, 0.f) & 0xffffu); }


template <int S>
struct RcSub {
    static __device__ __forceinline__ void run(float (&acc)[32], const LDSP float* NAB, LDSP unsigned char* lds, int lane) {
        const float us = acc[S]; rc_st16(lds + RC_UT + S * RC_RS + lane * 2, us);
#pragma unroll
        for (int g4 = 0; g4 < 8; ++g4) { if (4 * g4 + 3 > S) { const pg8::f32x4 nv = *(const LDSP pg8::f32x4*)(NAB + S * 32 + 4 * g4);
#pragma unroll
            for (int e = 0; e < 4; ++e) { if (4 * g4 + e > S) acc[4 * g4 + e] = fmaf(nv[e], us, acc[4 * g4 + e]); } } }
        RcSub<S + 1>::run(acc, NAB, lds, lane);
    }
};
template <> struct RcSub<32> { static __device__ __forceinline__ void run(float (&)[32], const LDSP float*, LDSP unsigned char*, int) {} };

template <int J>
__device__ __forceinline__ void rw_scan_chunked(const Ctx& c, const FastRw& fr, LDSP unsigned char* lds) {
    using namespace cfg; constexpr int j = J;
    const int tid = (int)tid_now(), w = __builtin_amdgcn_readfirstlane(tid >> 6), lane = tid & 63, l31 = lane & 31, h5 = lane >> 5;
    LDSP float* Ef = (LDSP float*)(lds + RC_E); LDSP float* YB = (LDSP float*)(lds + RC_YB); LDSP float* GL = (LDSP float*)(lds + RC_GL); LDSP float* BON = (LDSP float*)(lds + RC_BON);
    LDSP float* NAB = (LDSP float*)(lds + RC_NAB);
    for (int chain = blockIdx.x; chain < NSEQ * RHEADS; chain += gridDim.x) {
        const int sq = chain / RHEADS, h = chain % RHEADS, T = seq_len(sq), m0 = seq_row0(sq), ch = h * RH + lane;
        const float p_w0 = c.in[I_W0][j * D + ch], p_a0 = c.in[I_A0][j * D + ch], p_kk = c.in[I_KK][j * D + ch], p_ka = c.in[I_KA][j * D + ch], p_rk = c.in[I_RK][(size_t)j * D + ch],
                    p_lnw = c.in[I_LNW][j * D + ch], p_lnb = c.in[I_LNB][j * D + ch], p_v0 = j > 0 ? c.in[I_V0][(j - 1) * D + ch] : 0.f;
        const int ib = (w >> 1) & 1, jb = w & 1;
        f32x16_t ST;
#pragma unroll
        for (int r = 0; r < 16; ++r) ST[r] = 0.f;
        if (w < 4 && sq >= BATCH) { const float* s0 = c.in[I_WKV] + (((size_t)j * DB + (sq - BATCH)) * RHEADS + h) * RH * RH;
#pragma unroll
            for (int r = 0; r < 16; ++r) ST[r] = s0[(size_t)(32 * ib + rc_row(r, h5)) * RH + 32 * jb + l31]; }
        const int nch = (T + 31) / 32;
        RwIn in[4];
#define RC_LOADIN(n) do { _Pragma("unroll") for (int q = 0; q < 4; ++q) { const int t_ = (n) * 32 + 4 * w + q; if (t_ < T) { const size_t m_ = (size_t)(m0 + t_); \
                const bf16_t* rk_ = fr.rkv + m_ * 3072 + ch; const bf16_t* lu_ = fr.lu + m_ * 4096 + ch; \
                in[q].r = rk_[0]; in[q].k = rk_[1024]; in[q].v = rk_[2048]; in[q].wp = lu_[0]; in[q].ap = lu_[1024]; in[q].g = lu_[2048]; in[q].vp = lu_[3072]; \
                in[q].vf = j > 0 ? fr.vf[m_ * D + ch] : 0.f; } } } while (0)
        __syncthreads();
        RC_LOADIN(0);
        for (int n = 0; n < nch; ++n) {
            const int tn = T - n * 32 < 32 ? T - n * 32 : 32;
            const int vvo = (n & 1) ? RC_VV2 : RC_VV, ggo = (n & 1) ? RC_GG2 : RC_GG, bno = (n & 1) ? 32 : 0;
            float q_r[4], q_k[4], q_a[4], q_b[4], q_e[4];
#pragma unroll
            for (int q = 0; q < 4; ++q) {
                const int tl = 4 * w + q, tg = n * 32 + tl;
                float r_ = 0.f, k2_ = 0.f, v_ = 0.f, a_ = 0.f, b_ = 0.f, e_ = 0.f, g_ = 0.f, bon_ = 0.f;
                if (tg < T) {
                    r_ = bf2f(in[q].r); const float k0_ = bf2f(in[q].k); v_ = bf2f(in[q].v);
                    e_ = 0.6065306597126334f * fsigmoid(p_w0 + bf2f(in[q].wp));
                    if (j == 0) fr.vf[(size_t)(m0 + tg) * D + ch] = v_; else v_ = v_ + (in[q].vf - v_) * fsigmoid(p_v0 + bf2f(in[q].vp));
                    const float as_ = fsigmoid(p_a0 + bf2f(in[q].ap)); float kk_ = k0_ * p_kk;
                    k2_ = k0_ * (1.0f + (as_ - 1.0f) * p_ka);
                    float n_ = red16(kk_ * kk_), e1_ = red16(r_ * k2_ * p_rk);
                    n_ = (rdl(n_, 0) + rdl(n_, 16)) + (rdl(n_, 32) + rdl(n_, 48)); bon_ = (rdl(e1_, 0) + rdl(e1_, 16)) + (rdl(e1_, 32) + rdl(e1_, 48));
                    kk_ *= __builtin_amdgcn_rcpf(fmaxf(__builtin_amdgcn_sqrtf(n_), 1e-12f));
                    a_ = -kk_; b_ = kk_ * as_; g_ = bf2f(in[q].g);
                }
                q_r[q] = r_; q_k[q] = k2_; q_a[q] = a_; q_b[q] = b_; q_e[q] = e_;
                Ef[tl * 64 + lane] = e_;
                rc_st16(lds + vvo + tl * RC_RS + lane * 2, v_); rc_st16(lds + ggo + tl * RC_RS + lane * 2, g_);
                if (lane == 0) BON[bno + tl] = bon_;
            }
            if (n + 1 < nch) RC_LOADIN(n + 1);
            if (w < 4) {
#pragma unroll
                for (int r = 0; r < 16; ++r) rc_st16(lds + RC_SB + (32 * ib + rc_row(r, h5)) * RC_RS + (32 * jb + l31) * 2, ST[r]);
            }
            __syncthreads();
            { float run = 0.f, base = 0.f;
#pragma unroll
              for (int s = 0; s < 32; ++s) { const float ev = Ef[s * 64 + lane]; if (s == 4 * w) base = run; run += ev; }
              const float cumL = run; float cum = base;
#pragma unroll
              for (int q = 0; q < 4; ++q) { const int tl = 4 * w + q; const float cprev = cum; cum += q_e[q];
                  const float gam = __expf(-cum), gamp = __expf(-cprev), ginv = __expf(cum), glr = __expf(cum - cumL);
                  rc_st16(lds + RC_AT + tl * RC_RS + lane * 2, q_a[q] * gamp); rc_st16(lds + RC_RT + tl * RC_RS + lane * 2, q_r[q] * gam);
                  rc_st16(lds + RC_BB + tl * RC_RS + lane * 2, q_b[q] * ginv); rc_st16(lds + RC_KB + tl * RC_RS + lane * 2, q_k[q] * ginv);
                  rc_st16(lds + RC_BH + tl * RC_RS + lane * 2, q_b[q] * glr); rc_st16(lds + RC_KH + tl * RC_RS + lane * 2, q_k[q] * glr); }
              if (w == 0) GL[lane] = __expf(-cumL); }
            __syncthreads();
            f32x16_t R1;
#pragma unroll
            for (int r = 0; r < 16; ++r) R1[r] = 0.f;
            { int ln = lane; asm volatile("" : "+v"(ln)); const int a31 = ln & 31, a5 = ln >> 5;
              if (w < 4) {
                  const int aoff = (w == 0) ? RC_BB : ((w < 2) ? RC_AT : RC_RT), boff = (w == 0) ? RC_AT : ((w & 1) ? RC_KB : RC_BB);
#pragma unroll
                  for (int ks = 0; ks < 4; ++ks) R1 = MFMA32(rc_nat(lds + aoff, RC_RS, a31, 16 * ks + 8 * a5), rc_nat(lds + boff, RC_RS, a31, 16 * ks + 8 * a5), R1);
#pragma unroll
                  for (int r = 0; r < 16; ++r) { const int rr = rc_row(r, a5), cc = a31;
                      if (w == 0) NAB[rr * 32 + cc] = (rr < cc) ? R1[r] : 0.f;
                      else { const bool keep = (w < 2) ? (cc < rr) : (cc <= rr); rc_st16(lds + (w == 1 ? RC_NAK : (w == 2 ? RC_MRB : RC_MRK)) + rr * RC_NS + cc * 2, keep ? R1[r] : 0.f); } }
              } else {
                  const int aoff = (w < 6) ? RC_AT : RC_RT, ibk = w & 1;
#pragma unroll
                  for (int ks = 0; ks < 4; ++ks) R1 = MFMA32(rc_nat(lds + aoff, RC_RS, a31, 16 * ks + 8 * a5), rc_nat(lds + RC_SB, RC_RS, 32 * ibk + a31, 16 * ks + 8 * a5), R1);
              } }
            __syncthreads();
            if (w == 4 || w == 5) { int ln = lane; asm volatile("" : "+v"(ln)); const int a31 = ln & 31, a5 = ln >> 5, ibk = w & 1;
#pragma unroll
                for (int ks = 0; ks < 2; ++ks) R1 = MFMA32(rc_nat(lds + RC_NAK, RC_NS, a31, 16 * ks + 8 * a5), ss_trfrag(lds + vvo, RC_RS, 16 * ks, 32 * ibk, ln), R1);
#pragma unroll
                for (int r = 0; r < 16; ++r) Ef[rc_row(r, a5) * 64 + 32 * ibk + a31] = R1[r]; }
            __syncthreads();
            if (w == 0) { float acc[32];
#pragma unroll
                for (int t = 0; t < 32; ++t) acc[t] = Ef[t * 64 + lane];
                RcSub<0>::run(acc, NAB, lds, lane); }
            __syncthreads();
            { int ln = lane; asm volatile("" : "+v"(ln)); const int a31 = ln & 31, a5 = ln >> 5;
              if (w >= 6) { const int ibk = w & 1;
#pragma unroll
                  for (int ks = 0; ks < 2; ++ks) { R1 = MFMA32(rc_nat(lds + RC_MRB, RC_NS, a31, 16 * ks + 8 * a5), ss_trfrag(lds + RC_UT, RC_RS, 16 * ks, 32 * ibk, ln), R1);
                                                   R1 = MFMA32(rc_nat(lds + RC_MRK, RC_NS, a31, 16 * ks + 8 * a5), ss_trfrag(lds + vvo, RC_RS, 16 * ks, 32 * ibk, ln), R1); }
#pragma unroll
                  for (int r = 0; r < 16; ++r) YB[rc_row(r, a5) * 64 + 32 * ibk + a31] = R1[r];
              } else if (w < 4) { const float gl = GL[32 * jb + a31];
#pragma unroll
                  for (int r = 0; r < 16; ++r) ST[r] *= gl;
#pragma unroll
                  for (int ks = 0; ks < 2; ++ks) { ST = MFMA32(ss_trfrag(lds + RC_UT, RC_RS, 16 * ks, 32 * ib, ln), ss_trfrag(lds + RC_BH, RC_RS, 16 * ks, 32 * jb, ln), ST);
                                                   ST = MFMA32(ss_trfrag(lds + vvo, RC_RS, 16 * ks, 32 * ib, ln), ss_trfrag(lds + RC_KH, RC_RS, 16 * ks, 32 * jb, ln), ST); } } }
            __syncthreads();
#pragma unroll
            for (int q = 0; q < 4; ++q) { const int tl = 4 * w + q; if (tl < tn) {
                const float y = YB[tl * 64 + lane], mean = wsum_dpp(y) * (1.0f / RH), d = y - mean, var = wsum_dpp(d * d) * (1.0f / RH);
                const float yn = d * __builtin_amdgcn_rsqf(var + LNX_EPS) * p_lnw + p_lnb;
                const float o = (yn + BON[bno + tl] * bf2f(*(const LDSP bf16_t*)(lds + vvo + tl * RC_RS + lane * 2))) * bf2f(*(const LDSP bf16_t*)(lds + ggo + tl * RC_RS + lane * 2));
                fr.yo[(size_t)(m0 + n * 32 + tl) * D + ch] = (bf16_t)(pk2bf(o, 0.f) & 0xffffu); } }
        }
#undef RC_LOADIN
        if (w < 4) { float* so = (sq < BATCH ? c.out + O_WKVP + (((size_t)j * BATCH + sq) * RHEADS + h) * RH * RH : c.out + O_WKVS + (((size_t)j * DB + (sq - BATCH)) * RHEADS + h) * RH * RH);
#pragma unroll
            for (int r = 0; r < 16; ++r) so[(size_t)(32 * ib + rc_row(r, h5)) * RH + 32 * jb + l31] = ST[r]; }
    }
}
template <int ACT, bool ACC>
__device__ __forceinline__ void gemm_dev(const float* __restrict__ A, int lda, const float* __restrict__ B, int ldb, float* C, int ldc, int M, int N, int K, unsigned short (*As)[40], unsigned short (*Bs)[40]) {
    const int tid = threadIdx.x, wave = tid >> 6, lane = tid & 63, wr = wave >> 1, wc = wave & 1, fr = lane & 15, fq = lane >> 4;
    const int ntn = (N + 127) / 128, ntm = (M + 127) / 128;
    for (int tile = blockIdx.x; tile < ntm * ntn; tile += gridDim.x) {
        const int bm = (tile / ntn) * 128, bn = (tile % ntn) * 128;
        f32x4_t acc[2][4];
#pragma unroll
        for (int i = 0; i < 2; ++i)
#pragma unroll
            for (int j = 0; j < 4; ++j) acc[i][j] = (f32x4_t){0.f, 0.f, 0.f, 0.f};
        for (int k0 = 0; k0 < K; k0 += 32) {
#pragma unroll
            for (int it = 0; it < 2; ++it) {
                const int idx = tid + it * 512, row = idx >> 3, c4 = idx & 7, gm = bm + row;
                float4 v = make_float4(0.f, 0.f, 0.f, 0.f);
                if (gm < M) v = *(const float4*)(A + (size_t)gm * lda + k0 + c4 * 4);
                uint2 w; w.x = (unsigned)f2bf(v.x) | ((unsigned)f2bf(v.y) << 16); w.y = (unsigned)f2bf(v.z) | ((unsigned)f2bf(v.w) << 16);
                *(uint2*)&As[row][c4 * 4] = w;
            }
#pragma unroll
            for (int it = 0; it < 2; ++it) {
                const int idx = tid + it * 512, kr = idx >> 5, n4 = idx & 31, gn = bn + n4 * 4;
                float4 v = make_float4(0.f, 0.f, 0.f, 0.f);
                if (gn < N) v = *(const float4*)(B + (size_t)(k0 + kr) * ldb + gn);
                Bs[n4 * 4 + 0][kr] = f2bf(v.x); Bs[n4 * 4 + 1][kr] = f2bf(v.y); Bs[n4 * 4 + 2][kr] = f2bf(v.z); Bs[n4 * 4 + 3][kr] = f2bf(v.w);
            }
            __syncthreads();
            bf16x8_t a[2], b[4];
#pragma unroll
            for (int i = 0; i < 2; ++i) a[i] = *(const bf16x8_t*)&As[wr * 32 + i * 16 + fr][fq * 8];
#pragma unroll
            for (int j = 0; j < 4; ++j) b[j] = *(const bf16x8_t*)&Bs[wc * 64 + j * 16 + fr][fq * 8];
#pragma unroll
            for (int i = 0; i < 2; ++i)
#pragma unroll
                for (int j = 0; j < 4; ++j) acc[i][j] = __builtin_amdgcn_mfma_f32_16x16x32_bf16(a[i], b[j], acc[i][j], 0, 0, 0);
            __syncthreads();
        }
#pragma unroll
        for (int i = 0; i < 2; ++i)
#pragma unroll
            for (int j = 0; j < 4; ++j)
#pragma unroll
                for (int e = 0; e < 4; ++e) {
                    const int row = bm + wr * 32 + i * 16 + fq * 4 + e, col = bn + wc * 64 + j * 16 + fr;
                    if (row < M && col < N) {
                        float v = acc[i][j][e];
                        if (ACT == 1) v = tanhf(v); else if (ACT == 2) v = 1.0f / (1.0f + expf(-v)); else if (ACT == 3) v = v > 0.f ? v * v : 0.f;
                        float* cp = C + (size_t)row * ldc + col; *cp = ACC ? *cp + v : v;
                    }
                }
    }
}

#define MRUN(ph, l) do { ph(c, l, gtid, gsz); xcd_barrier(bar); } while (0)
#define MGEMM(ACT, ACC, A, lda, B, ldb, C, ldc, M, N, K) do { gemm_dev<ACT, ACC>(A, lda, B, ldb, C, ldc, M, N, K, As, Bs); xcd_barrier(bar); } while (0)
#define KS_FFN 16
#define KS_1K 4
#define KS_MB 8
#ifndef ACC_KSPLIT
#define ACC_KSPLIT 1
#endif
#ifndef FFN_DOWN_KSPLIT
#define FFN_DOWN_KSPLIT 1
#endif
#define GBAR() xcd_barrier(bar)
#ifndef PROBE_DUP
#define PROBE_DUP 0
#endif
#define DUP(bit, ...) do { __VA_ARGS__; if (PROBE_DUP & (1 << (bit))) { GBAR(); __VA_ARGS__; } } while (0)
#define GTID_NOW() ((size_t)blockIdx.x * 512 + tid_now())
#define GSZ_NOW() ((size_t)gridDim.x * 512)
#define GW_NOW() ((int)(blockIdx.x * 8 + (tid_now() >> 6)))
#define NGW_NOW() ((int)(gridDim.x * 8))
#define LANE_NOW() ((int)(tid_now() & 63))
#undef MRUN
#undef MGEMM
#define MRUN(ph, l) do { ph(c, l, GTID_NOW(), GSZ_NOW()); xcd_barrier(bar); } while (0)
#define MGEMM(ACT, ACC, A, lda, B, ldb, C, ldc, M, N, K) do { gemm_dev<ACT, ACC>(A, lda, B, ldb, C, ldc, M, N, K, (unsigned short (*)[40])dynlds, (unsigned short (*)[40])(dynlds + 128 * 40 * 2)); xcd_barrier(bar); } while (0)
extern __shared__ __attribute__((aligned(16))) unsigned char dynlds[];

struct MegaArgs { Ctx c; Fast f; FastMla fm; FastRw fr; FastMb fb; unsigned* bar; };
constexpr int LDS_STAGE = 0, LDS_XB = 163840 - 64, LDS_BYTES = 163840;
static_assert(SD_END <= LDS_XB && SS_END <= LDS_XB && RC_END <= LDS_XB, "LDS map");

template <int L>
__device__ __forceinline__ void layer_mix_naive(const Ctx& c, const XcdBarrier& bar) {
    using namespace cfg;
    constexpr int l = L, kind = L % 3, j = L / 3;
    MRUN(ph_norm_mix, l);
    if constexpr (kind == 0) {
        MRUN(ph_rw_mix, l);
        const float* W = c.in[I_WRKV] + (size_t)j * 3 * D * D;
        MGEMM(0, false, c.xm[0], D, W, D, c.r, D, MTOT, D, D);
        MGEMM(0, false, c.xm[1], D, W + (size_t)D * D, D, c.k, D, MTOT, D, D);
        MGEMM(0, false, c.xm[2], D, W + (size_t)2 * D * D, D, c.v, D, MTOT, D, D);
        MGEMM(1, false, c.xm[3], D, c.in[I_W1] + (size_t)j * D * RW_DL, RW_DL, c.hw, RW_DL, MTOT, RW_DL, D);
        MGEMM(0, false, c.hw, RW_DL, c.in[I_W2] + (size_t)j * RW_DL * D, D, c.wpre, D, MTOT, D, RW_DL);
        MGEMM(0, false, c.xm[4], D, c.in[I_A1] + (size_t)j * D * RW_AL, RW_AL, c.ha, RW_AL, MTOT, RW_AL, D);
        MGEMM(0, false, c.ha, RW_AL, c.in[I_A2] + (size_t)j * RW_AL * D, D, c.apre, D, MTOT, D, RW_AL);
        if constexpr (j > 0) {
            MGEMM(0, false, c.xm[2], D, c.in[I_V1] + (size_t)(j - 1) * D * RW_VL, RW_VL, c.hv, RW_VL, MTOT, RW_VL, D);
            MGEMM(0, false, c.hv, RW_VL, c.in[I_V2] + (size_t)(j - 1) * RW_VL * D, D, c.vpre, D, MTOT, D, RW_VL);
        }
        MGEMM(2, false, c.xm[5], D, c.in[I_G1] + (size_t)j * D * RW_GL, RW_GL, c.hg, RW_GL, MTOT, RW_GL, D);
        MGEMM(0, false, c.hg, RW_GL, c.in[I_G2] + (size_t)j * RW_GL * D, D, c.g, D, MTOT, D, RW_GL);
        MRUN(ph_rw_prep, l); MRUN(ph_rw_scan, l); MRUN(ph_rw_post, l);
        MGEMM(0, true, c.yo, D, c.in[I_RWO] + (size_t)j * D * D, D, c.x, D, MTOT, D, D);
    } else if constexpr (kind == 1) {
        MGEMM(0, false, c.xn, D, c.in[I_MWIN] + (size_t)j * D * MLA_IN, MLA_IN, c.mh, MLA_IN, MTOT, MLA_IN, D);
        MRUN(ph_mla_norm1, l);
        MGEMM(0, false, c.qan, QL, c.in[I_WUQ] + (size_t)j * QL * MH * QD, MH * QD, c.q, MH * QD, MTOT, MH * QD, QL);
        MGEMM(0, false, c.c, KVL, c.in[I_WUK] + (size_t)j * KVL * MH * NOPE, MH * NOPE, c.knr, MH * NOPE, MTOT, MH * NOPE, KVL);
        MGEMM(0, false, c.c, KVL, c.in[I_WUV] + (size_t)j * KVL * MH * VD, MH * VD, c.vv, MH * VD, MTOT, MH * VD, KVL);
        MRUN(ph_mla_norm2, l); MRUN(ph_mla_attn_prompt, l); MRUN(ph_mla_score_sample, l); MRUN(ph_mla_softmax_sample, l); MRUN(ph_mla_pv_sample, l); MRUN(ph_mla_out_sample, l);
        MGEMM(0, true, c.ao, MH * VD, c.in[I_MWO] + (size_t)j * MH * VD * D, D, c.x, D, MTOT, D, MH * VD);
    } else {
        MGEMM(0, false, c.xn, D, c.in[I_BWIN] + (size_t)j * D * MB_IN, MB_IN, c.zx, MB_IN, MTOT, MB_IN, D);
        MRUN(ph_mb_conv, l); MRUN(ph_mb_dt, l); MRUN(ph_mb_scan, l); MRUN(ph_mb_gate, l);
        MGEMM(0, true, c.yzn, MB_INNER, c.in[I_BWO] + (size_t)j * MB_INNER * D, D, c.x, D, MTOT, D, MB_INNER);
    }
}


template <int L>
__device__ __forceinline__ void layer_rwkv_fast(const Ctx& c, const Fast& f, const FastRw& fr, const XcdBarrier& bar, LDSP unsigned char* lds) {
    using namespace cfg;
    constexpr int l = L, j = L / 3;
    if (L > 0) { fold_sample_rows(c.x, f.slab, KS_FFN, GW_NOW(), NGW_NOW(), LANE_NOW()); GBAR(); }
    DUP(9, rw_mix_fast(c, fr, l, GW_NOW(), NGW_NOW(), LANE_NOW()));
    GBAR();
    DUP(7, { pg8::Order<RwSel> S; S.init(MP / 256, MS / 256, 16, D, 1, gridDim.x, blockIdx.x);
      pg8::gemm_phase(lds, pg8::Gemm{fr.xm, fr.wrkvt + (size_t)j * 4096 * D, D, D, (size_t)MTOT * D}, S, EpiRwkv{fr.rkv, fr.hb}); });
    GBAR();
    DUP(26, { pg8::Order<> S; S.init(MP / 256, MS / 256, 16, 384, 1, gridDim.x, blockIdx.x);
      pg8::gemm_phase(lds, pg8::Gemm{fr.hb, fr.lorat + (size_t)j * 4096 * 384, 384, 384, 0}, S, pg8::EpiBf16<0>{fr.lu, 4096}); });
    GBAR();
    DUP(2, rw_scan_chunked<j>(c, fr, lds));
    GBAR();
    { pg8::Order<> S; S.init(MP / 256, MS / 256, 4, D, KS_1K, gridDim.x, blockIdx.x);
      pg8::gemm_phase(lds, pg8::Gemm{fr.yo, fr.wot + (size_t)j * D * D, D, D, 0}, S, pg8::EpiAccF32{c.x, D, f.slab, MP / 256, MS / 256, KS_1K}); }
    if (PROBE_DUP & (1 << 26)) { GBAR(); pg8::Order<> S; S.init(MP / 256, MS / 256, 4, D, KS_1K, gridDim.x, blockIdx.x);
      pg8::gemm_phase(lds, pg8::Gemm{fr.yo, fr.wot + (size_t)j * D * D, D, D, 0}, S, pg8::EpiAccF32{c.hmid, D, f.slab + (size_t)16 * 16 * 65536, MP / 256, MS / 256, KS_1K}); }
    GBAR();
}

__device__ __forceinline__ void layer_mamba_fast(const Ctx& c, const Fast& f, const FastMb& fb, const XcdBarrier& bar, LDSP unsigned char* lds) {
    using namespace cfg;
    constexpr int l = 2, j = 0;
    norm_rows_bf16(c.x, c.in[I_NMIX] + l * D, f.xnb, f.slab, KS_FFN, GW_NOW(), NGW_NOW(), LANE_NOW());
    GBAR();
    DUP(8, { pg8::Order<> S; S.init(MP / 256, MS / 256, 21, D, 1, gridDim.x, blockIdx.x);
      pg8::gemm_phase(lds, pg8::Gemm{f.xnb, fb.wbint, D, D, 0}, S, EpiMamba{fb.zb, fb.xbcr, fb.dtraw}); });
    GBAR();
    DUP(12, mb_conv_fast(c, fb, l, GTID_NOW(), GSZ_NOW(), false));
    GBAR();
    DUP(6, mb_ssd_prompt(c, fb, l, lds); mb_scan_sample(c, fb, l));
    GBAR();
    DUP(13, mb_gate_fast(c, fb, fb.y, l, GW_NOW(), NGW_NOW(), LANE_NOW()));
    GBAR();
    { pg8::Order<> S; S.init(MP / 256, MS / 256, 4, MB_INNER, KS_MB, gridDim.x, blockIdx.x);
      pg8::gemm_phase(lds, pg8::Gemm{fb.yzn, fb.wbot, MB_INNER, MB_INNER, 0}, S, pg8::EpiAccF32{c.x, D, f.slab, MP / 256, MS / 256, KS_MB}); }
    if (PROBE_DUP & (1 << 28)) { GBAR(); pg8::Order<> S; S.init(MP / 256, MS / 256, 4, MB_INNER, KS_MB, gridDim.x, blockIdx.x);
      pg8::gemm_phase(lds, pg8::Gemm{fb.yzn, fb.wbot, MB_INNER, MB_INNER, 0}, S, pg8::EpiAccF32{c.hmid, D, f.slab + (size_t)16 * 16 * 65536, MP / 256, MS / 256, KS_MB}); }
    GBAR();
}

__device__ __forceinline__ void layer_mla_fast(const Ctx& c, const Fast& f, const FastMla& fm, const XcdBarrier& bar, LDSP unsigned char* lds) {
    using namespace cfg;
    constexpr int l = 1, j = 0;
    norm_rows_bf16(c.x, c.in[I_NMIX] + l * D, f.xnb, f.slab, KS_FFN, GW_NOW(), NGW_NOW(), LANE_NOW());
    GBAR();
    DUP(27, { pg8::Order<> S; S.init(MP / 256, MS / 256, 4, D, 1, gridDim.x, blockIdx.x);
      pg8::gemm_phase(lds, pg8::Gemm{f.xnb, fm.wint, D, D, 0}, S, pg8::EpiF32{fm.mh, 1024, 1024}); });
    GBAR();
    DUP(14, mla_norm1_fast(c, fm, j, GW_NOW(), NGW_NOW(), LANE_NOW()));
    GBAR();
    DUP(27, { pg8::Order<> S; S.init(MP / 256, MS / 256, (MH * QD) / 256, QL, 1, gridDim.x, blockIdx.x);
      pg8::gemm_phase(lds, pg8::Gemm{fm.qan, fm.wuqt, QL, QL, 0}, S, pg8::EpiBf16<0>{fm.qraw, MH * QD}); }
    { pg8::Order<> S; S.init(MP / 256, MS / 256, 4, KVL, 1, gridDim.x, blockIdx.x);
      pg8::gemm_phase(lds, pg8::Gemm{fm.cb, fm.wukvt, KVL, KVL, 0}, S, pg8::EpiBf16<0>{fm.kvraw, 2048}); }
    { pg8::Order<> S; S.init(4, 0, MTOT / 256, KVL, 1, gridDim.x, blockIdx.x);
      pg8::gemm_phase(lds, pg8::Gemm{fm.wukvt + (size_t)1024 * KVL, fm.cb, KVL, KVL, 0}, S, pg8::EpiBf16<0>{fm.vT, MTOT}); });
    GBAR();
    DUP(15, mla_norm2_fast(c, fm, j, GW_NOW(), NGW_NOW(), LANE_NOW()));
    GBAR();
    DUP(5, attn_prompt_fast(fm.qf, fm.knb, fm.kpb, fm.vT, fm.aob, lds));
    __syncthreads();
    DUP(4, mla_sample_decode(c, fm, fm.qs, fm.opart, fm.lpart, j, lds));
    GBAR();
    DUP(16, mla_sample_combine(c, fm, fm.opart, fm.lpart, j, lds));
    GBAR();
    { pg8::Order<> S; S.init(MP / 256, MS / 256, 4, D, KS_1K, gridDim.x, blockIdx.x);
      pg8::gemm_phase(lds, pg8::Gemm{fm.aob, fm.wot, D, D, 0}, S, pg8::EpiAccF32{c.x, D, f.slab, MP / 256, MS / 256, KS_1K}); }
    if (PROBE_DUP & (1 << 27)) { GBAR(); pg8::Order<> S; S.init(MP / 256, MS / 256, 4, D, KS_1K, gridDim.x, blockIdx.x);
      pg8::gemm_phase(lds, pg8::Gemm{fm.aob, fm.wot, D, D, 0}, S, pg8::EpiAccF32{c.hmid, D, f.slab + (size_t)16 * 16 * 65536, MP / 256, MS / 256, KS_1K}); }
    GBAR();
}

template <int L>
__device__ __forceinline__ void layer_ffn_fast(const Ctx& c, const Fast& f, const XcdBarrier& bar, LDSP unsigned char* lds) {
    using namespace cfg;
    norm_rows_bf16(c.x, c.in[I_NFFN] + L * D, f.xnb, f.slab, (L % 3 == 2) ? KS_MB : KS_1K, GW_NOW(), NGW_NOW(), LANE_NOW());
    GBAR();
    DUP(0, { pg8::Order<> S; S.init(MP / 256, MS / 256, FFN / 256, D, 1, gridDim.x, blockIdx.x);
      pg8::gemm_phase(lds, pg8::Gemm{f.xnb, f.w1t + (size_t)L * FFN * D, D, D, 0}, S, pg8::EpiBf16<3>{f.hmidb, FFN}); });
    GBAR();
    { pg8::Order<> S; S.init(MP / 256, MS / 256, D / 256, FFN, (L == DEPTH - 1) ? 1 : KS_FFN, gridDim.x, blockIdx.x);
      pg8::gemm_phase(lds, pg8::Gemm{f.hmidb, f.w2t + (size_t)L * D * FFN, FFN, FFN, 0}, S, pg8::EpiAccF32{c.x, D, f.slab, MP / 256, MS / 256, (L == DEPTH - 1) ? 1 : KS_FFN}); }
    if (PROBE_DUP & (1 << 25)) { GBAR(); pg8::Order<> S; S.init(MP / 256, MS / 256, D / 256, FFN, (L == DEPTH - 1) ? 1 : KS_FFN, gridDim.x, blockIdx.x);
      pg8::gemm_phase(lds, pg8::Gemm{f.hmidb, f.w2t + (size_t)L * D * FFN, FFN, FFN, 0}, S, pg8::EpiAccF32{c.hmid, D, f.slab + (size_t)16 * 16 * 65536, MP / 256, MS / 256, (L == DEPTH - 1) ? 1 : KS_FFN}); }
    GBAR();
}

__global__ void __launch_bounds__(512, 2) mega10(MegaArgs a) {
    LDSP unsigned char* lds = (LDSP unsigned char*)dynlds;
    if (threadIdx.x < 4) ((LDSP unsigned*)(lds + LDS_XB))[threadIdx.x] = 0u;
    __syncthreads();
    XcdBarrier bar = xcd_barrier_post(a.bar, (volatile LAS unsigned*)(lds + LDS_XB));
    const Ctx& c = a.c; const Fast& f = a.f; const FastMla& fm = a.fm; const FastRw& fr = a.fr; const FastMb& fb = a.fb;
    using namespace cfg;
    DUP(10, {
        LDSP float* scr = (LDSP float*)(lds + LDS_STAGE) + (tid_now() >> 6) * (64 * 33);
        for (int l = 0; l < DEPTH; ++l) {
            tr_weight(c.in[I_FW1] + (size_t)l * D * FFN, D, FFN, FFN, f.w1t + (size_t)l * FFN * D, nullptr, scr, GW_NOW(), NGW_NOW(), LANE_NOW());
            tr_weight(c.in[I_FW2] + (size_t)l * FFN * D, FFN, D, D, f.w2t + (size_t)l * D * FFN, nullptr, scr, GW_NOW(), NGW_NOW(), LANE_NOW());
        }
        tr_weight(c.in[I_MWIN], D, MLA_IN, 1024, fm.wint, nullptr, scr, GW_NOW(), NGW_NOW(), LANE_NOW());
        tr_weight(c.in[I_WUQ], QL, MH * QD, MH * QD, fm.wuqt, nullptr, scr, GW_NOW(), NGW_NOW(), LANE_NOW());
        tr_weight(c.in[I_WUK], KVL, MH * NOPE, MH * NOPE, fm.wukvt, nullptr, scr, GW_NOW(), NGW_NOW(), LANE_NOW());
        tr_weight(c.in[I_WUV], KVL, MH * VD, MH * VD, fm.wukvt + (size_t)1024 * KVL, nullptr, scr, GW_NOW(), NGW_NOW(), LANE_NOW());
        tr_weight(c.in[I_MWO], MH * VD, D, D, fm.wot, nullptr, scr, GW_NOW(), NGW_NOW(), LANE_NOW());
        for (int j = 0; j < N_RWKV; ++j) {
            bf16_t* wt = fr.wrkvt + (size_t)j * 4096 * D;
            for (int p = 0; p < 3; ++p) tr_weight(c.in[I_WRKV] + ((size_t)j * 3 + p) * D * D, D, D, D, wt + (size_t)p * D * D, nullptr, scr, GW_NOW(), NGW_NOW(), LANE_NOW());
            tr_weight(c.in[I_W1] + (size_t)j * D * RW_DL, D, RW_DL, 256, wt + (size_t)3072 * D, nullptr, scr, GW_NOW(), NGW_NOW(), LANE_NOW());
            tr_weight(c.in[I_A1] + (size_t)j * D * RW_AL, D, RW_AL, 256, wt + (size_t)3328 * D, nullptr, scr, GW_NOW(), NGW_NOW(), LANE_NOW());
            tr_weight(c.in[I_G1] + (size_t)j * D * RW_GL, D, RW_GL, 256, wt + (size_t)3584 * D, nullptr, scr, GW_NOW(), NGW_NOW(), LANE_NOW());
            tr_weight(j > 0 ? c.in[I_V1] + (size_t)(j - 1) * D * RW_VL : c.in[I_W1], D, j > 0 ? RW_VL : 0, 256, wt + (size_t)3840 * D, nullptr, scr, GW_NOW(), NGW_NOW(), LANE_NOW());
            tr_weight(c.in[I_RWO] + (size_t)j * D * D, D, D, D, fr.wot + (size_t)j * D * D, nullptr, scr, GW_NOW(), NGW_NOW(), LANE_NOW());
            rw_build_lorat(c, fr.lorat + (size_t)j * 4096 * 384, j, GTID_NOW(), GSZ_NOW());
        }
        tr_weight(c.in[I_BWIN], D, MB_IN, 5376, fb.wbint, nullptr, scr, GW_NOW(), NGW_NOW(), LANE_NOW());
        tr_weight(c.in[I_BWO], MB_INNER, D, D, fb.wbot, nullptr, scr, GW_NOW(), NGW_NOW(), LANE_NOW());
        ph_copy_x(c, 0, GTID_NOW(), GSZ_NOW());
    });
    GBAR();
    layer_rwkv_fast<0>(c, f, fr, bar, lds); layer_ffn_fast<0>(c, f, bar, lds);
    layer_mla_fast(c, f, fm, bar, lds); layer_ffn_fast<1>(c, f, bar, lds);
    layer_mamba_fast(c, f, fb, bar, lds); layer_ffn_fast<2>(c, f, bar, lds);
    layer_rwkv_fast<3>(c, f, fr, bar, lds); layer_ffn_fast<3>(c, f, bar, lds);
}

extern "C" void kernel_launch(void* const* d_in, const int* in_sizes, int n_in, void* d_out, int out_size, void* d_ws, size_t ws_size, hipStream_t stream) {
    using namespace cfg;
    MegaArgs a{};
    size_t used = setup_ctx(a.c, d_in, d_out, d_ws);
    { Bump b{(char*)d_ws, (size_t)((char*)a.c.xm[0] - (char*)d_ws)}; FastRw& r = a.fr;
      r.xm = (bf16_t*)b.f((size_t)6 * MTOT * D / 2); r.rkv = (bf16_t*)b.f((size_t)MTOT * 3072 / 2); r.hb = (bf16_t*)b.f((size_t)MTOT * 384 / 2); r.lu = (bf16_t*)b.f((size_t)MTOT * 4096 / 2);
      r.ops = b.f((size_t)MTOT * RHEADS * RW_REC + 4096); r.yo = (bf16_t*)b.f((size_t)MTOT * D / 2); r.vf = a.c.vf;
      if (b.off > (size_t)((char*)a.c.hmid - (char*)d_ws) + (size_t)MTOT * FFN * 4) { fprintf(stderr, "RWKV overlay too large\n"); return; } }
    { Bump b{(char*)d_ws, used};
      a.f.xnb = (bf16_t*)b.f((size_t)MTOT * D / 2); a.f.hmidb = (bf16_t*)b.f((size_t)MTOT * FFN / 2);
      a.f.w1t = (bf16_t*)b.f((size_t)DEPTH * FFN * D / 2); a.f.w2t = (bf16_t*)b.f((size_t)DEPTH * FFN * D / 2); a.f.slab = b.f((size_t)2 * 16 * 16 * 65536);
      FastMla& m = a.fm;
      m.mh = b.f((size_t)MTOT * 1024); m.qan = (bf16_t*)b.f((size_t)MTOT * QL / 2); m.cb = (bf16_t*)b.f((size_t)MTOT * KVL / 2); m.kpb = (bf16_t*)b.f((size_t)MTOT * ROPE / 2);
      m.qraw = (bf16_t*)b.f((size_t)MTOT * 1536 / 2); m.kvraw = (bf16_t*)b.f((size_t)MTOT * 2048 / 2); m.qf = (bf16_t*)b.f((size_t)MTOT * 1536 / 2); m.knb = (bf16_t*)b.f((size_t)MTOT * 1024 / 2);
      m.aob = (bf16_t*)b.f((size_t)MTOT * 1024 / 2); m.vT = (bf16_t*)b.f((size_t)MTOT * 1024 / 2); m.qs = (bf16_t*)b.f((size_t)MS * 1536 / 2);
      m.opart = b.f((size_t)2 * DB * 128 * 256); m.lpart = b.f((size_t)2 * DB * 128);
      m.wint = (bf16_t*)b.f((size_t)1024 * 1024 / 2); m.wuqt = (bf16_t*)b.f((size_t)1536 * 512 / 2); m.wukvt = (bf16_t*)b.f((size_t)2048 * 256 / 2); m.wot = (bf16_t*)b.f((size_t)1024 * 1024 / 2);
      { FastMb& q = a.fb; q.zb = (bf16_t*)b.f((size_t)MTOT * 2048 / 2); q.xbcr = (bf16_t*)b.f((size_t)MTOT * 3072 / 2); q.dtraw = b.f((size_t)MTOT * 32); q.xbcb = (bf16_t*)b.f((size_t)MTOT * 3072 / 2);
        q.dt = b.f((size_t)MTOT * 32); q.y = a.c.my; q.yzn = (bf16_t*)b.f((size_t)MTOT * 2048 / 2); q.wbint = (bf16_t*)b.f((size_t)5376 * 1024 / 2); q.wbot = (bf16_t*)b.f((size_t)1024 * 2048 / 2); }
      a.fr.wrkvt = (bf16_t*)b.f((size_t)N_RWKV * 4096 * D / 2); a.fr.lorat = (bf16_t*)b.f((size_t)N_RWKV * 4096 * 384 / 2); a.fr.wot = (bf16_t*)b.f((size_t)N_RWKV * D * D / 2);
      used = b.off; }
    if (used > ws_size || n_in != 51) { fprintf(stderr, "workspace too small: need %zu have %zu (n_in %d)\n", used, ws_size, n_in); return; }
    a.bar = (unsigned*)d_ws;
    static int grid = 0;
    if (!grid) {
        int dev = 0, cus = 0, per_cu = 0;
        (void)hipGetDevice(&dev); (void)hipDeviceGetAttribute(&cus, hipDeviceAttributeMultiprocessorCount, dev);
        if (hipFuncSetAttribute((const void*)mega10, hipFuncAttributeMaxDynamicSharedMemorySize, LDS_BYTES) != hipSuccess) { fprintf(stderr, "hipFuncSetAttribute failed\n"); grid = -1; return; }
        (void)hipOccupancyMaxActiveBlocksPerMultiprocessor(&per_cu, (const void*)mega10, 512, LDS_BYTES);
        (void)hipGetLastError();
        grid = per_cu >= 1 ? (cus < 256 ? cus : 256) : -1;
    }
    if (grid <= 0) { fprintf(stderr, "kernel does not fit one workgroup per CU\n"); return; }
    (void)hipMemsetAsync(a.bar, 0, XCD_BAR_WORDS * sizeof(unsigned), stream);
    hipLaunchKernelGGL(mega10, dim3(grid), dim3(512), LDS_BYTES, stream, a);
}
```

```cpp
#include <hip/hip_runtime.h>
#include <cstdio>
#include <math.h>
#include <stdint.h>
#include <stddef.h>
#ifdef CPU_EMU
#define DEV inline
#else
#define DEV __device__ __forceinline__
#endif

namespace cfg {
#ifdef CFG_SMALL
constexpr int D = 128, BATCH = 2, SEQ = 32, DEPTH = 4, DB = 3, DS = 8, PAST = 64, PAGE = 16;
constexpr int RW_DL = 16, RW_AL = 16, RW_VL = 8, RW_GL = 24;
constexpr int MH = 2, QL = 64, KVL = 32;
constexpr int MB_GROUPS = 2;
#else
constexpr int D = 1024, BATCH = 16, SEQ = 2048, DEPTH = 4, DB = 128, DS = 8, PAST = 8192, PAGE = 128;
constexpr int RW_DL = 64, RW_AL = 64, RW_VL = 32, RW_GL = 160;
constexpr int MH = 16, QL = 512, KVL = 256;
constexpr int MB_GROUPS = 4;
#endif
constexpr int N_RWKV = (DEPTH + 2) / 3, N_MLA = (DEPTH + 1) / 3, N_MAMBA = DEPTH / 3;
constexpr int RH = 64, RHEADS = D / RH;
constexpr int NOPE = 64, ROPE = 32, VD = 64, QD = NOPE + ROPE;
constexpr int MLA_IN = QL + KVL + ROPE;
constexpr int MB_INNER = 2 * D, MB_HEAD = 64, MB_HEADS = MB_INNER / MB_HEAD, MB_STATE = 128, MB_CONV = 4;
constexpr int MB_GN = MB_GROUPS * MB_STATE;
constexpr int MB_CD = MB_INNER + 2 * MB_GN, MB_IN = MB_INNER + MB_CD + MB_HEADS;
constexpr int FFN = 4 * D;
constexpr int NPAGES = PAST / PAGE, NPOOL = (DB * NPAGES * 5) / 4;
constexpr int MP = BATCH * SEQ, MS = DB * DS, MTOT = MP + MS, NSEQ = BATCH + DB;
constexpr int KTOT = PAST + DS;
constexpr float NORM_EPS = 1e-6f, LNX_EPS = 64e-5f;
constexpr size_t O_YP = 0;
constexpr size_t O_YS = O_YP + (size_t)MP * D;
constexpr size_t O_CKVP = O_YS + (size_t)MS * D;
constexpr size_t O_KPEP = O_CKVP + (size_t)N_MLA * MP * KVL;
constexpr size_t O_CKVS = O_KPEP + (size_t)N_MLA * MP * ROPE;
constexpr size_t O_KPES = O_CKVS + (size_t)N_MLA * MS * KVL;
constexpr size_t O_WKVP = O_KPES + (size_t)N_MLA * MS * ROPE;
constexpr size_t O_SHP = O_WKVP + (size_t)N_RWKV * BATCH * RHEADS * RH * RH;
constexpr size_t O_WKVS = O_SHP + (size_t)N_RWKV * BATCH * D;
constexpr size_t O_SHS = O_WKVS + (size_t)N_RWKV * DB * RHEADS * RH * RH;
constexpr size_t O_SSMP = O_SHS + (size_t)N_RWKV * DB * D;
constexpr size_t O_CONVP = O_SSMP + (size_t)N_MAMBA * BATCH * MB_HEADS * MB_HEAD * MB_STATE;
constexpr size_t O_SSMS = O_CONVP + (size_t)N_MAMBA * BATCH * (MB_CONV - 1) * MB_CD;
constexpr size_t O_CONVS = O_SSMS + (size_t)N_MAMBA * DB * MB_HEADS * MB_HEAD * MB_STATE;
constexpr size_t O_END = O_CONVS + (size_t)N_MAMBA * DB * (MB_CONV - 1) * MB_CD;
}

struct Ctx {
    const float* in[51];
    const int* page_table;
    float* out;
    float *x, *xn, *vf;
    float* xm[6];
    float *r, *k, *v, *wpre, *apre, *vpre, *g, *hw, *ha, *hv, *hg, *ka, *kb, *y, *yo;
    float *hmid;
    float *mh, *qan, *q, *c, *kp, *knr, *vv, *ao, *sc, *olat;
    float *zx, *xbc, *dt, *my, *yzn;
};

DEV int row_t(int m) { return m < cfg::MP ? m % cfg::SEQ : (m - cfg::MP) % cfg::DS; }
DEV int row_seq(int m) { return m < cfg::MP ? m / cfg::SEQ : cfg::BATCH + (m - cfg::MP) / cfg::DS; }
DEV int seq_row0(int sq) { return sq < cfg::BATCH ? sq * cfg::SEQ : cfg::MP + (sq - cfg::BATCH) * cfg::DS; }
DEV int seq_len(int sq) { return sq < cfg::BATCH ? cfg::SEQ : cfg::DS; }
DEV float sigmoidf_(float x) { return 1.0f / (1.0f + expf(-x)); }
DEV float softplusf_(float x) { return x > 20.f ? x : log1pf(expf(x)); }
DEV float siluf_(float x) { return x * sigmoidf_(x); }

enum { I_XP = 0, I_XS, I_CKV, I_KPE, I_WKV, I_SHIFT, I_SSM, I_CONV, I_PT, I_NMIX, I_NFFN, I_FW1, I_FW2, I_MU, I_WRKV, I_W0, I_W1, I_W2, I_A0, I_A1, I_A2,
       I_V0, I_V1, I_V2, I_G1, I_G2, I_KK, I_KA, I_RK, I_LNW, I_LNB, I_RWO, I_MWIN, I_QNORM, I_KVNORM, I_WUQ, I_WUK, I_WUV, I_QNN, I_QRN, I_KNN, I_KRN, I_MWO,
       I_BWIN, I_CONVW, I_CONVB, I_DTB, I_ALOG, I_BD, I_BNORM, I_BWO };

#define UNROLL _Pragma("unroll")
#define GSL(i, n) for (size_t i = gtid; i < (size_t)(n); i += gsz)

DEV void ph_copy_x(const Ctx& c, int, size_t gtid, size_t gsz) {
    using namespace cfg;
    GSL(i, (size_t)MTOT * D) c.x[i] = i < (size_t)MP * D ? c.in[I_XP][i] : c.in[I_XS][i - (size_t)MP * D];
}
DEV void rmsnorm_rows(const float* x, const float* gain, float* xn, size_t gtid, size_t gsz) {
    using namespace cfg;
    GSL(m, MTOT) {
        const float* xr = x + m * D; float ss = 0.f;
        for (int i = 0; i < D; ++i) ss += xr[i] * xr[i];
        const float rs = 1.0f / sqrtf(ss / D + NORM_EPS);
        for (int i = 0; i < D; ++i) xn[m * D + i] = xr[i] * rs * gain[i];
    }
}
DEV void ph_norm_mix(const Ctx& c, int l, size_t gtid, size_t gsz) { rmsnorm_rows(c.x, c.in[I_NMIX] + l * cfg::D, c.xn, gtid, gsz); }
DEV void ph_norm_ffn(const Ctx& c, int l, size_t gtid, size_t gsz) { rmsnorm_rows(c.x, c.in[I_NFFN] + l * cfg::D, c.xn, gtid, gsz); }

DEV void ph_rw_mix(const Ctx& c, int l, size_t gtid, size_t gsz) {
    using namespace cfg; const int j = l / 3;
    GSL(i, (size_t)MTOT * D) {
        const int m = (int)(i / D), ch = (int)(i % D), t = row_t(m), sq = row_seq(m);
        const float xc = c.xn[i];
        float xp;
        if (t > 0) xp = c.xn[i - D];
        else xp = sq < BATCH ? 0.f : c.in[I_SHIFT][((size_t)j * DB + (sq - BATCH)) * D + ch];
        for (int p = 0; p < 6; ++p) c.xm[p][i] = xc + (xp - xc) * c.in[I_MU][((size_t)j * 6 + p) * D + ch];
        if (t == seq_len(sq) - 1) {
            if (sq < BATCH) c.out[O_SHP + ((size_t)j * BATCH + sq) * D + ch] = xc;
            else c.out[O_SHS + ((size_t)j * DB + (sq - BATCH)) * D + ch] = xc;
        }
    }
}
DEV void ph_rw_prep(const Ctx& c, int l, size_t gtid, size_t gsz) {
    using namespace cfg; const int j = l / 3;
    GSL(i, (size_t)MTOT * RHEADS) {
        const int m = (int)(i / RHEADS), h = (int)(i % RHEADS);
        const size_t o = (size_t)m * D + h * RH;
        float nn = 0.f;
        for (int e = 0; e < RH; ++e) { const float kk = c.k[o + e] * c.in[I_KK][j * D + h * RH + e]; nn += kk * kk; }
        const float inv = 1.0f / fmaxf(sqrtf(nn), 1e-12f);
        for (int e = 0; e < RH; ++e) {
            const int ch = h * RH + e;
            const float wl = -softplusf_(-(c.in[I_W0][j * D + ch] + c.wpre[o + e])) - 0.5f;
            const float decay = expf(-expf(wl));
            float vv = c.v[o + e];
            if (j == 0) c.vf[o + e] = vv;
            else vv = vv + (c.vf[o + e] - vv) * sigmoidf_(c.in[I_V0][(j - 1) * D + ch] + c.vpre[o + e]);
            const float a = sigmoidf_(c.in[I_A0][j * D + ch] + c.apre[o + e]);
            const float k0 = c.k[o + e];
            const float kk = k0 * c.in[I_KK][j * D + ch] * inv;
            c.k[o + e] = k0 * (1.0f + (a - 1.0f) * c.in[I_KA][j * D + ch]);
            c.v[o + e] = vv;
            c.wpre[o + e] = decay;
            c.ka[o + e] = -kk;
            c.kb[o + e] = kk * a;
        }
    }
}
DEV void ph_rw_scan(const Ctx& c, int l, size_t gtid, size_t gsz) {
    using namespace cfg; const int j = l / 3;
    GSL(i, (size_t)NSEQ * RHEADS * RH) {
        const int sq = (int)(i / (RHEADS * RH)), h = (int)(i / RH) % RHEADS, vi = (int)(i % RH);
        float S[RH];
        if (sq < BATCH) { UNROLL for (int e = 0; e < RH; ++e) S[e] = 0.f; }
        else { const float* s0 = c.in[I_WKV] + ((((size_t)j * DB + (sq - BATCH)) * RHEADS + h) * RH + vi) * RH; UNROLL for (int e = 0; e < RH; ++e) S[e] = s0[e]; }
        const int m0 = seq_row0(sq), T = seq_len(sq);
        for (int t = 0; t < T; ++t) {
            const size_t o = (size_t)(m0 + t) * D + h * RH;
            float sa = 0.f;
            UNROLL for (int e = 0; e < RH; ++e) sa += S[e] * c.ka[o + e];
            const float vt = c.v[o + vi]; float yy = 0.f;
            UNROLL for (int e = 0; e < RH; ++e) { S[e] = S[e] * c.wpre[o + e] + sa * c.kb[o + e] + vt * c.k[o + e]; yy += S[e] * c.r[o + e]; }
            c.y[o + vi] = yy;
        }
        float* so = sq < BATCH ? c.out + O_WKVP + ((((size_t)j * BATCH + sq) * RHEADS + h) * RH + vi) * RH
                               : c.out + O_WKVS + ((((size_t)j * DB + (sq - BATCH)) * RHEADS + h) * RH + vi) * RH;
        UNROLL for (int e = 0; e < RH; ++e) so[e] = S[e];
    }
}
DEV void ph_rw_post(const Ctx& c, int l, size_t gtid, size_t gsz) {
    using namespace cfg; const int j = l / 3;
    GSL(i, (size_t)MTOT * RHEADS) {
        const int m = (int)(i / RHEADS), h = (int)(i % RHEADS);
        const size_t o = (size_t)m * D + h * RH;
        float mean = 0.f; for (int e = 0; e < RH; ++e) mean += c.y[o + e]; mean /= RH;
        float var = 0.f; for (int e = 0; e < RH; ++e) { const float d = c.y[o + e] - mean; var += d * d; } var /= RH;
        const float rs = 1.0f / sqrtf(var + LNX_EPS);
        float bonus = 0.f; for (int e = 0; e < RH; ++e) bonus += c.r[o + e] * c.k[o + e] * c.in[I_RK][(size_t)j * D + h * RH + e];
        for (int e = 0; e < RH; ++e) {
            const int ch = h * RH + e;
            const float yn = (c.y[o + e] - mean) * rs * c.in[I_LNW][j * D + ch] + c.in[I_LNB][j * D + ch];
            c.yo[o + e] = (yn + bonus * c.v[o + e]) * c.g[o + e];
        }
    }
}

DEV void rope_apply(const float* xin, float* xout, int pos) {
    using namespace cfg; const int half = ROPE / 2;
    UNROLL for (int i = 0; i < half; ++i) {
        const float inv = exp2f(-(float)i * (13.287712379549449f / half));
        const float ang = (float)pos * inv;
        const float kq = rintf(ang * 0.15915494309189535f);
        float rr = fmaf(-kq, 6.28125f, ang); rr = fmaf(-kq, 1.9353071795864769e-3f, rr);
        const float cs = __cosf(rr), sn = __sinf(rr);
        const float x1 = xin[i], x2 = xin[i + half];
        xout[i] = x1 * cs - x2 * sn; xout[i + half] = x2 * cs + x1 * sn;
    }
}
DEV int row_pos(int m) { return m < cfg::MP ? m % cfg::SEQ : cfg::PAST + (m - cfg::MP) % cfg::DS; }
DEV void ph_mla_norm1(const Ctx& c, int l, size_t gtid, size_t gsz) {
    using namespace cfg; const int j = l / 3;
    GSL(m, MTOT) {
        const float* h = c.mh + m * MLA_IN;
        float ss = 0.f; for (int i = 0; i < QL; ++i) ss += h[i] * h[i];
        float rs = 1.0f / sqrtf(ss / QL + NORM_EPS);
        for (int i = 0; i < QL; ++i) c.qan[m * QL + i] = h[i] * rs * c.in[I_QNORM][j * QL + i];
        ss = 0.f; for (int i = 0; i < KVL; ++i) ss += h[QL + i] * h[QL + i];
        rs = 1.0f / sqrtf(ss / KVL + NORM_EPS);
        float* co = m < (size_t)MP ? c.out + O_CKVP + ((size_t)j * MP + m) * KVL : c.out + O_CKVS + ((size_t)j * MS + (m - MP)) * KVL;
        for (int i = 0; i < KVL; ++i) { const float v = h[QL + i] * rs * c.in[I_KVNORM][j * KVL + i]; c.c[m * KVL + i] = v; co[i] = v; }
        ss = 0.f; UNROLL for (int i = 0; i < ROPE; ++i) ss += h[QL + KVL + i] * h[QL + KVL + i];
        rs = 1.0f / sqrtf(ss / ROPE + NORM_EPS);
        float tmp[ROPE], ro[ROPE];
        UNROLL for (int i = 0; i < ROPE; ++i) tmp[i] = h[QL + KVL + i] * rs * c.in[I_KRN][j * ROPE + i];
        rope_apply(tmp, ro, row_pos((int)m));
        float* ko = m < (size_t)MP ? c.out + O_KPEP + ((size_t)j * MP + m) * ROPE : c.out + O_KPES + ((size_t)j * MS + (m - MP)) * ROPE;
        UNROLL for (int i = 0; i < ROPE; ++i) { c.kp[m * ROPE + i] = ro[i]; ko[i] = ro[i]; }
    }
}
DEV void ph_mla_norm2(const Ctx& c, int l, size_t gtid, size_t gsz) {
    using namespace cfg; const int j = l / 3;
    GSL(i, (size_t)MTOT * MH) {
        const int m = (int)(i / MH), h = (int)(i % MH);
        float* q = c.q + (size_t)m * MH * QD + h * QD;
        float ss = 0.f; UNROLL for (int e = 0; e < NOPE; ++e) ss += q[e] * q[e];
        float rs = 1.0f / sqrtf(ss / NOPE + NORM_EPS);
        UNROLL for (int e = 0; e < NOPE; ++e) q[e] = q[e] * rs * c.in[I_QNN][j * NOPE + e];
        ss = 0.f; UNROLL for (int e = 0; e < ROPE; ++e) ss += q[NOPE + e] * q[NOPE + e];
        rs = 1.0f / sqrtf(ss / ROPE + NORM_EPS);
        float tmp[ROPE], ro[ROPE];
        UNROLL for (int e = 0; e < ROPE; ++e) tmp[e] = q[NOPE + e] * rs * c.in[I_QRN][j * ROPE + e];
        rope_apply(tmp, ro, row_pos(m));
        UNROLL for (int e = 0; e < ROPE; ++e) q[NOPE + e] = ro[e];
        float* kn = c.knr + (size_t)m * MH * NOPE + h * NOPE;
        ss = 0.f; UNROLL for (int e = 0; e < NOPE; ++e) ss += kn[e] * kn[e];
        rs = 1.0f / sqrtf(ss / NOPE + NORM_EPS);
        UNROLL for (int e = 0; e < NOPE; ++e) kn[e] = kn[e] * rs * c.in[I_KNN][j * NOPE + e];
    }
}
DEV void ph_mla_attn_prompt(const Ctx& c, int, size_t gtid, size_t gsz) {
    using namespace cfg; const float scale = 1.0f / sqrtf((float)QD);
    GSL(i, (size_t)MP * MH) {
        const int m = (int)(i / MH), h = (int)(i % MH), t = m % SEQ, m0 = m - t;
        const float* q = c.q + (size_t)m * MH * QD + h * QD;
        float mx = -INFINITY, den = 0.f, acc[VD];
        UNROLL for (int e = 0; e < VD; ++e) acc[e] = 0.f;
        for (int kx = 0; kx <= t; ++kx) {
            const int mk = m0 + kx;
            const float* kn = c.knr + (size_t)mk * MH * NOPE + h * NOPE; const float* kp = c.kp + (size_t)mk * ROPE;
            float s = 0.f;
            UNROLL for (int e = 0; e < NOPE; ++e) s += q[e] * kn[e];
            UNROLL for (int e = 0; e < ROPE; ++e) s += q[NOPE + e] * kp[e];
            s *= scale;
            const float nm = fmaxf(mx, s), corr = expf(mx - nm), p = expf(s - nm);
            den = den * corr + p;
            const float* v = c.vv + (size_t)mk * MH * VD + h * VD;
            UNROLL for (int e = 0; e < VD; ++e) acc[e] = acc[e] * corr + p * v[e];
            mx = nm;
        }
        UNROLL for (int e = 0; e < VD; ++e) c.ao[(size_t)m * MH * VD + h * VD + e] = acc[e] / den;
    }
}
DEV const float* smp_c(const Ctx& c, int j, int s, int pos) {
    using namespace cfg;
    if (pos < PAST) { const int pg = c.page_table[s * NPAGES + pos / PAGE]; return c.in[I_CKV] + (((size_t)j * NPOOL + pg) * PAGE + pos % PAGE) * KVL; }
    return c.c + (size_t)(MP + s * DS + (pos - PAST)) * KVL;
}
DEV const float* smp_kp(const Ctx& c, int j, int s, int pos) {
    using namespace cfg;
    if (pos < PAST) { const int pg = c.page_table[s * NPAGES + pos / PAGE]; return c.in[I_KPE] + (((size_t)j * NPOOL + pg) * PAGE + pos % PAGE) * ROPE; }
    return c.kp + (size_t)(MP + s * DS + (pos - PAST)) * ROPE;
}
DEV void ph_mla_score_sample(const Ctx& c, int l, size_t gtid, size_t gsz) {
    using namespace cfg; const int j = l / 3; const float scale = 1.0f / sqrtf((float)QD);
    GSL(i, (size_t)DB * KTOT * MH) {
        const int pos = (int)(i % KTOT), h = (int)((i / KTOT) % MH), s = (int)(i / ((size_t)MH * KTOT));
        const float* cl = smp_c(c, j, s, pos); const float* kp = smp_kp(c, j, s, pos);
        float kn[NOPE];
        UNROLL for (int e = 0; e < NOPE; ++e) kn[e] = 0.f;
        const float* wuk = c.in[I_WUK] + (size_t)j * KVL * MH * NOPE;
        for (int r = 0; r < KVL; ++r) { const float cv = cl[r]; const float* w = wuk + ((size_t)r * MH + h) * NOPE; UNROLL for (int e = 0; e < NOPE; ++e) kn[e] += cv * w[e]; }
        float ss = 0.f; UNROLL for (int e = 0; e < NOPE; ++e) ss += kn[e] * kn[e];
        const float rs = 1.0f / sqrtf(ss / NOPE + NORM_EPS);
        UNROLL for (int e = 0; e < NOPE; ++e) kn[e] = kn[e] * rs * c.in[I_KNN][j * NOPE + e];
        for (int qi = 0; qi < DS; ++qi) {
            const float* q = c.q + (size_t)(MP + s * DS + qi) * MH * QD + h * QD;
            float sc = 0.f;
            UNROLL for (int e = 0; e < NOPE; ++e) sc += q[e] * kn[e];
            UNROLL for (int e = 0; e < ROPE; ++e) sc += q[NOPE + e] * kp[e];
            const bool ok = pos < PAST || (pos - PAST) <= qi;
            c.sc[(((size_t)s * MH + h) * DS + qi) * KTOT + pos] = ok ? sc * scale : -INFINITY;
        }
    }
}
DEV void ph_mla_softmax_sample(const Ctx& c, int, size_t gtid, size_t gsz) {
    using namespace cfg;
    GSL(i, (size_t)DB * MH * DS) {
        float* sc = c.sc + i * KTOT;
        float mx = -INFINITY; for (int p = 0; p < KTOT; ++p) mx = fmaxf(mx, sc[p]);
        float den = 0.f; for (int p = 0; p < KTOT; ++p) den += expf(sc[p] - mx);
        const float inv = 1.0f / den;
        for (int p = 0; p < KTOT; ++p) sc[p] = expf(sc[p] - mx) * inv;
    }
}
DEV void ph_mla_pv_sample(const Ctx& c, int l, size_t gtid, size_t gsz) {
    using namespace cfg; const int j = l / 3;
    GSL(i, (size_t)DB * MH * DS * KVL) {
        const int r = (int)(i % KVL); const size_t row = i / KVL; const int s = (int)(row / (MH * DS));
        const float* p = c.sc + row * KTOT; float acc = 0.f;
        for (int pos = 0; pos < KTOT; ++pos) acc += p[pos] * smp_c(c, j, s, pos)[r];
        c.olat[i] = acc;
    }
}
DEV void ph_mla_out_sample(const Ctx& c, int l, size_t gtid, size_t gsz) {
    using namespace cfg; const int j = l / 3;
    GSL(i, (size_t)MS * MH * VD) {
        const int e = (int)(i % VD), h = (int)((i / VD) % MH), ms = (int)(i / (MH * VD)), s = ms / DS, qi = ms % DS;
        const float* ol = c.olat + (((size_t)s * MH + h) * DS + qi) * KVL;
        const float* wuv = c.in[I_WUV] + (size_t)j * KVL * MH * VD;
        float acc = 0.f;
        for (int r = 0; r < KVL; ++r) acc += ol[r] * wuv[((size_t)r * MH + h) * VD + e];
        c.ao[(size_t)(MP + ms) * MH * VD + h * VD + e] = acc;
    }
}

DEV float mb_xpad(const Ctx& c, int j, int m, int sq, int tt, int ch) {
    using namespace cfg;
    if (tt < MB_CONV - 1) return sq < BATCH ? 0.f : c.in[I_CONV][(((size_t)j * DB + (sq - BATCH)) * (MB_CONV - 1) + tt) * MB_CD + ch];
    (void)m; return c.zx[(size_t)(seq_row0(sq) + tt - (MB_CONV - 1)) * MB_IN + MB_INNER + ch];
}
DEV void ph_mb_conv(const Ctx& c, int l, size_t gtid, size_t gsz) {
    using namespace cfg; const int j = l / 3;
    GSL(i, (size_t)MTOT * MB_CD) {
        const int m = (int)(i / MB_CD), ch = (int)(i % MB_CD), t = row_t(m), sq = row_seq(m), T = seq_len(sq);
        float acc = c.in[I_CONVB][j * MB_CD + ch];
        for (int jj = 0; jj < MB_CONV; ++jj) acc += mb_xpad(c, j, m, sq, t + jj, ch) * c.in[I_CONVW][((size_t)j * MB_CONV + jj) * MB_CD + ch];
        c.xbc[i] = siluf_(acc);
        if (t < MB_CONV - 1) {
            const float v = mb_xpad(c, j, m, sq, T + t, ch);
            if (sq < BATCH) c.out[O_CONVP + (((size_t)j * BATCH + sq) * (MB_CONV - 1) + t) * MB_CD + ch] = v;
            else c.out[O_CONVS + (((size_t)j * DB + (sq - BATCH)) * (MB_CONV - 1) + t) * MB_CD + ch] = v;
        }
    }
}
DEV void ph_mb_dt(const Ctx& c, int l, size_t gtid, size_t gsz) {
    using namespace cfg; const int j = l / 3;
    GSL(i, (size_t)MTOT * MB_HEADS) {
        const int m = (int)(i / MB_HEADS), h = (int)(i % MB_HEADS);
        c.dt[i] = softplusf_(c.zx[(size_t)m * MB_IN + MB_INNER + MB_CD + h] + c.in[I_DTB][j * MB_HEADS + h]);
    }
}
DEV void ph_mb_scan(const Ctx& c, int l, size_t gtid, size_t gsz) {
    using namespace cfg; const int j = l / 3;
    GSL(i, (size_t)NSEQ * MB_HEADS * MB_HEAD) {
        const int p = (int)(i % MB_HEAD), h = (int)((i / MB_HEAD) % MB_HEADS), sq = (int)(i / (MB_HEADS * MB_HEAD));
        const int g = h / (MB_HEADS / MB_GROUPS);
        float hs[MB_STATE];
        if (sq < BATCH) { UNROLL for (int n = 0; n < MB_STATE; ++n) hs[n] = 0.f; }
        else { const float* s0 = c.in[I_SSM] + ((((size_t)j * DB + (sq - BATCH)) * MB_HEADS + h) * MB_HEAD + p) * MB_STATE; UNROLL for (int n = 0; n < MB_STATE; ++n) hs[n] = s0[n]; }
        const float A = -expf(c.in[I_ALOG][j * MB_HEADS + h]), dsk = c.in[I_BD][j * MB_HEADS + h];
        const int m0 = seq_row0(sq), T = seq_len(sq);
        for (int t = 0; t < T; ++t) {
            const size_t m = (size_t)(m0 + t);
            const float dtv = c.dt[m * MB_HEADS + h], dA = expf(dtv * A);
            const float xv = c.xbc[m * MB_CD + h * MB_HEAD + p], xdt = xv * dtv;
            const float* Bm = c.xbc + m * MB_CD + MB_INNER + g * MB_STATE; const float* Cm = Bm + MB_GN;
            float yy = 0.f;
            UNROLL for (int n = 0; n < MB_STATE; ++n) { hs[n] = hs[n] * dA + xdt * Bm[n]; yy += Cm[n] * hs[n]; }
            c.my[m * MB_INNER + h * MB_HEAD + p] = yy + dsk * xv;
        }
        float* so = sq < BATCH ? c.out + O_SSMP + ((((size_t)j * BATCH + sq) * MB_HEADS + h) * MB_HEAD + p) * MB_STATE
                               : c.out + O_SSMS + ((((size_t)j * DB + (sq - BATCH)) * MB_HEADS + h) * MB_HEAD + p) * MB_STATE;
        UNROLL for (int n = 0; n < MB_STATE; ++n) so[n] = hs[n];
    }
}
DEV void ph_mb_gate(const Ctx& c, int l, size_t gtid, size_t gsz) {
    using namespace cfg; const int j = l / 3; constexpr int GW = MB_INNER / MB_GROUPS;
    GSL(i, (size_t)MTOT * MB_GROUPS) {
        const int m = (int)(i / MB_GROUPS), g = (int)(i % MB_GROUPS);
        float ss = 0.f;
        for (int e = 0; e < GW; ++e) { const float v = c.my[(size_t)m * MB_INNER + g * GW + e] * siluf_(c.zx[(size_t)m * MB_IN + g * GW + e]); ss += v * v; }
        const float rs = 1.0f / sqrtf(ss / GW + NORM_EPS);
        for (int e = 0; e < GW; ++e) {
            const float v = c.my[(size_t)m * MB_INNER + g * GW + e] * siluf_(c.zx[(size_t)m * MB_IN + g * GW + e]);
            c.yzn[(size_t)m * MB_INNER + g * GW + e] = v * rs * c.in[I_BNORM][j * MB_INNER + g * GW + e];
        }
    }
}
typedef short bf16x8_t __attribute__((ext_vector_type(8)));
typedef float f32x4_t __attribute__((ext_vector_type(4)));
__device__ __forceinline__ unsigned short f2bf(float f) { unsigned u = __float_as_uint(f); u += 0x7fffu + ((u >> 16) & 1u); return (unsigned short)(u >> 16); }
#define XB_TMO      128
#define XB_XCNT(j)  (256  + 64 * (j))
#define XB_XSUB(j)  (1280 + 64 * (j))
#define XB_XGEN(j)  (2304 + 64 * (j))
#define XB_TOP      3328
#define XB_TOPGEN   3392
#define XCD_BAR_WORDS 3456
#define XB_SPIN_CAP (1u << 25)
#define LAS __attribute__((address_space(3)))

__device__ __forceinline__ unsigned xb_ld(unsigned* p)              { return __hip_atomic_load(p, __ATOMIC_RELAXED, __HIP_MEMORY_SCOPE_AGENT); }
__device__ __forceinline__ unsigned xb_add(unsigned* p, unsigned v) { return __hip_atomic_fetch_add(p, v, __ATOMIC_RELAXED, __HIP_MEMORY_SCOPE_AGENT); }
__device__ __forceinline__ unsigned xb_xcc_id() { return (unsigned)__builtin_amdgcn_s_getreg((3 << 11) | 20) & 0xFu; }
#define XB_SPIN(cond, bar) do { unsigned _sp = 0; while (cond) { __builtin_amdgcn_s_sleep(1); \
    if ((++_sp & 255u) == 0u) { if (xb_ld(&(bar)[XB_TMO])) break; if (_sp > XB_SPIN_CAP) { atomicAdd(&(bar)[XB_TMO], 1u); break; } } } } while (0)

struct XcdBarrier {
    unsigned* bar; unsigned x;
    volatile LAS unsigned* st;
};

__device__ __forceinline__ XcdBarrier xcd_barrier_post(unsigned* bar, volatile LAS unsigned* st) {
    XcdBarrier b; b.bar = bar; b.x = xb_xcc_id(); b.st = st;
    if (threadIdx.x == 0) (void)xb_add(&bar[XB_XCNT(b.x)], 1u);
    return b;
}
__device__ __forceinline__ void xcd_barrier_complete(unsigned* bar, unsigned x, unsigned& nloc, unsigned& nx) {
    const unsigned G = gridDim.x * gridDim.y * gridDim.z;
    unsigned sum, cnt, mine, sp = 0u;
    for (;;) {
        sum = 0u; cnt = 0u; mine = 0u;
#pragma unroll
        for (unsigned j = 0; j < 16; ++j) { const unsigned c = xb_ld(&bar[XB_XCNT(j)]); sum += c; cnt += (c > 0u) ? 1u : 0u; mine = (j == x) ? c : mine; }
        if (sum == G) break;
        __builtin_amdgcn_s_sleep(1);
        if ((++sp & 255u) == 0u) { if (xb_ld(&bar[XB_TMO])) break; if (sp > XB_SPIN_CAP) { atomicAdd(&bar[XB_TMO], 1u); break; } }
    }
    nloc = mine > 0u ? mine : 1u; nx = cnt > 0u ? cnt : 1u;
}

__device__ __forceinline__ void xcd_barrier(const XcdBarrier& b) {
    asm volatile("s_waitcnt vmcnt(0)" ::: "memory");
    __syncthreads();
    if (threadIdx.x == 0) {
        unsigned* bar = b.bar;
        __builtin_amdgcn_s_waitcnt(0);
        unsigned nloc = b.st[0], nx = b.st[1];
        if (nloc == 0u) { xcd_barrier_complete(bar, b.x, nloc, nx); b.st[0] = nloc; b.st[1] = nx; }
        const unsigned old = xb_add(&bar[XB_XSUB(b.x)], 1u);
        const unsigned gen = old / nloc;
        if (old + 1u == (gen + 1u) * nloc) {
            __builtin_amdgcn_fence(__ATOMIC_RELEASE, "agent");
            asm volatile("s_waitcnt vmcnt(0)" ::: "memory");
            const unsigned og = xb_add(&bar[XB_TOP], 1u);
            const unsigned tg = og / nx;
            if (og + 1u == (tg + 1u) * nx) xb_add(&bar[XB_TOPGEN], 1u);
            else XB_SPIN(xb_ld(&bar[XB_TOPGEN]) == tg, bar);
            __builtin_amdgcn_fence(__ATOMIC_ACQUIRE, "agent");
            xb_add(&bar[XB_XGEN(b.x)], 1u);
            asm volatile("s_waitcnt vmcnt(0)" ::: "memory");
        } else {
            XB_SPIN(xb_ld(&bar[XB_XGEN(b.x)]) == gen, bar);
            __builtin_amdgcn_fence(__ATOMIC_ACQUIRE, "agent");
            asm volatile("s_waitcnt vmcnt(0)" ::: "memory");
        }
    }
    __syncthreads();
}

struct Bump { char* p; size_t off; float* f(size_t n) { float* r = (float*)(p + off); off += ((n * 4 + 255) / 256) * 256; return r; } };

static size_t setup_ctx(Ctx& c, void* const* d_in, void* d_out, void* d_ws) {
    using namespace cfg;
    for (int i = 0; i < 51; ++i) c.in[i] = (const float*)d_in[i];
    c.page_table = (const int*)d_in[I_PT];
    c.out = (float*)d_out; c.x = c.out;
    Bump b{(char*)d_ws, 4096 * 4};
    const size_t MD = (size_t)MTOT * D;
    c.xn = b.f(MD); c.vf = b.f(MD);
    const size_t base = b.off;
    for (int p = 0; p < 6; ++p) c.xm[p] = b.f(MD);
    c.r = b.f(MD); c.k = b.f(MD); c.v = b.f(MD); c.wpre = b.f(MD); c.apre = b.f(MD); c.vpre = b.f(MD); c.g = b.f(MD);
    c.hw = b.f((size_t)MTOT * RW_DL); c.ha = b.f((size_t)MTOT * RW_AL); c.hv = b.f((size_t)MTOT * RW_VL); c.hg = b.f((size_t)MTOT * RW_GL);
    c.ka = b.f(MD); c.kb = b.f(MD); c.y = c.xm[0]; c.yo = c.xm[1];
    size_t hi = b.off;
    b.off = base;
    c.mh = b.f((size_t)MTOT * MLA_IN); c.qan = b.f((size_t)MTOT * QL); c.q = b.f((size_t)MTOT * MH * QD); c.c = b.f((size_t)MTOT * KVL); c.kp = b.f((size_t)MTOT * ROPE);
    c.knr = b.f((size_t)MTOT * MH * NOPE); c.vv = b.f((size_t)MTOT * MH * VD); c.ao = b.f((size_t)MTOT * MH * VD);
    c.sc = b.f((size_t)DB * MH * DS * KTOT); c.olat = b.f((size_t)DB * MH * DS * KVL);
    if (b.off > hi) hi = b.off;
    b.off = base;
    c.zx = b.f((size_t)MTOT * MB_IN); c.xbc = b.f((size_t)MTOT * MB_CD); c.dt = b.f((size_t)MTOT * MB_HEADS); c.my = b.f((size_t)MTOT * MB_INNER); c.yzn = b.f((size_t)MTOT * MB_INNER);
    if (b.off > hi) hi = b.off;
    b.off = hi;
    c.hmid = b.f((size_t)MTOT * FFN);
    return b.off;
}

__device__ __forceinline__ unsigned tid_now() { unsigned t = threadIdx.x; asm volatile("" : "+v"(t)); return t; }
namespace pg8 {
#define PG8_LAS __attribute__((address_space(3)))
typedef unsigned short bf16_t;
typedef short bf16x8 __attribute__((ext_vector_type(8)));
typedef float f32x4 __attribute__((ext_vector_type(4)));
typedef float f32x2 __attribute__((ext_vector_type(2)));
typedef unsigned u32x4 __attribute__((ext_vector_type(4)));
typedef unsigned u32x2 __attribute__((ext_vector_type(2)));
constexpr int BM = 256, BK = 64, HALF = 128, HTB = HALF * BK * 2  , STAGE_BYTES = 8 * HTB, NXCD = 8, WGM = 8;

__host__ __device__ __forceinline__ int lds_byte(int r, int c) { const int st = (r >> 4) * 2 + (c >> 5), rr = r & 15, cc = c & 31, ob = rr * 64 + cc * 2; return st * 1024 + (ob ^ (((ob >> 9) & 1) << 5)); }
__host__ __device__ __forceinline__ void stage_rc(int b, int& R, int& C) { const int st = b / 1024, sb = b % 1024, swz = sb ^ (((sb >> 9) & 1) << 5); R = (st >> 1) * 16 + swz / 64; C = (st & 1) * 32 + (swz % 64) / 2; }
__host__ __device__ __forceinline__ int perm32(int rho) { const int n = rho >> 4, i = rho & 15; return 8 * (i >> 2) + 4 * n + (i & 3); }
__device__ __forceinline__ unsigned cvt_pk_bf16(float lo, float hi) { unsigned r; asm volatile("v_cvt_pk_bf16_f32 %0, %1, %2" : "=v"(r) : "v"(lo), "v"(hi)); return r; }

struct Unit { int pm, pn, k0, nt, asel, part; };
struct Gemm { const bf16_t* A; const bf16_t* Bt; int lda, ldb; size_t asel_stride; };

struct NoSel { __device__ static __forceinline__ int sel(int) { return 0; } };
template <class ASEL = NoSel>
struct Order {
    int nMp, nMs, nN, nwgP, nwgS, G, c, K, ksplit;
    __device__ __forceinline__ void init(int nMp_, int nMs_, int nN_, int K_, int ksplit_, int G_, int c_) { nMp = nMp_; nMs = nMs_; nN = nN_; nwgP = nMp * nN; K = K_; ksplit = ksplit_; nwgS = nMs * nN * ksplit; G = G_; c = c_; }
    __device__ __forceinline__ bool next(int i, Unit& u) const {
        const long L = (long)i * G + c;
        if (L < nwgP) {
            int wgid = (int)L; { const int q = nwgP / NXCD, r = nwgP % NXCD, xcd = wgid % NXCD, off = wgid / NXCD; wgid = (xcd < r ? xcd * (q + 1) : r * (q + 1) + (xcd - r) * q) + off; }
            const int nig = WGM * nN, gid = wgid / nig, fm = gid * WGM, gsz = (nMp - fm) < WGM ? (nMp - fm) : WGM;
            u.pm = fm + ((wgid % nig) % gsz); u.pn = (wgid % nig) / gsz; u.k0 = 0; u.nt = K / BK; u.part = 0; u.asel = ASEL::sel(u.pn); return true;
        }
        const long Ls = L - nwgP; if (Ls >= nwgS) return false;
        const int sub = (int)(Ls % ksplit), t = (int)(Ls / ksplit);
        u.pm = nMp + t % nMs; u.pn = t / nMs; u.nt = K / BK / ksplit; u.k0 = sub * u.nt * BK; u.part = ksplit > 1 ? 1 : 0; u.asel = ASEL::sel(u.pn); return true;
    }
};

template <class Epi, class Sched>
__device__ __forceinline__ void gemm_phase(PG8_LAS unsigned char* lds, const Gemm g, const Sched& S, const Epi& E) {
    const int tid = (int)tid_now(), wid = __builtin_amdgcn_readfirstlane(tid >> 6), lane = tid & 63, wr = wid >> 2, wc = wid & 3, fr = lane & 15, fq = lane >> 4;
    unsigned voffA[2], voffB[2];
#pragma unroll
    for (int i = 0; i < 2; ++i) { int R, C; stage_rc(tid * 16 + i * 8192, R, C); const int Rb = Epi::PERM ? ((R & ~31) + perm32(R & 31)) : R;
        voffA[i] = (unsigned)(R * g.lda + C) * 2u; voffB[i] = (unsigned)(Rb * g.ldb + C) * 2u; }
    const size_t kstep = (size_t)(BK * 2);
    const size_t hstepA = (size_t)HALF * g.lda * 2, hstepB = (size_t)HALF * g.ldb * 2;
    const unsigned ldsw = (unsigned)wid * 1024u;
    const int aoff = lds_byte(wr * 64 + fr, fq * 8), boff = lds_byte(wc * 32 + fr, fq * 8);
#define PG8_SA(b, h) (((b) * 2 + (h)) * HTB)
#define PG8_SB(b, h) ((4 + (b) * 2 + (h)) * HTB)
#define PG8_STAGE(bufoff, gbase, voff) do { _Pragma("unroll") for (int _i = 0; _i < 2; ++_i) \
        __builtin_amdgcn_global_load_lds((const unsigned*)((const char*)(gbase) + (voff)[_i]), (PG8_LAS unsigned*)(lds + (bufoff) + ldsw + _i * 8192), 16, 0, 0); } while (0)
#define PG8_LDA(dst, b, h) do { _Pragma("unroll") for (int m = 0; m < 4; ++m) _Pragma("unroll") for (int k = 0; k < 2; ++k) dst[m][k] = *(const PG8_LAS bf16x8*)(lds + PG8_SA(b, h) + aoff + m * 2048 + k * 1024); } while (0)
#define PG8_LDB(dst, b, h) do { _Pragma("unroll") for (int n = 0; n < 2; ++n) _Pragma("unroll") for (int k = 0; k < 2; ++k) dst[n][k] = *(const PG8_LAS bf16x8*)(lds + PG8_SB(b, h) + boff + n * 2048 + k * 1024); } while (0)
#define PG8_MMA(ai, bj, At, Bt) do { __builtin_amdgcn_s_setprio(1); _Pragma("unroll") for (int m = 0; m < 4; ++m) _Pragma("unroll") for (int n = 0; n < 2; ++n) _Pragma("unroll") for (int k = 0; k < 2; ++k) \
        acc[ai][bj][m][n] = __builtin_amdgcn_mfma_f32_16x16x32_bf16(Bt[n][k], At[m][k], acc[ai][bj][m][n], 0, 0, 0); __builtin_amdgcn_s_setprio(0); } while (0)
#define PG8_WAIT_V(n) asm volatile("s_waitcnt vmcnt(" #n ")" ::: "memory")
#define PG8_WAIT_L(n) asm volatile("s_waitcnt lgkmcnt(" #n ")" ::: "memory")
#define PG8_BAR __builtin_amdgcn_s_barrier()
#define PG8_SCHED __builtin_amdgcn_sched_barrier(0)
#define PG8_ABASE(u) ((const char*)g.A + ((size_t)(u).asel * g.asel_stride + (size_t)(u).pm * BM * g.lda + (u).k0) * 2)
#define PG8_BBASE(u) ((const char*)g.Bt + ((size_t)(u).pn * BM * g.ldb + (u).k0) * 2)
    Unit cur, nxt; int ui = 0;
    if (!S.next(0, cur)) return;
    f32x4 acc[2][2][4][2];
#pragma unroll
    for (int a = 0; a < 2; ++a)
#pragma unroll
        for (int b = 0; b < 2; ++b)
#pragma unroll
            for (int m = 0; m < 4; ++m)
#pragma unroll
                for (int n = 0; n < 2; ++n) acc[a][b][m][n] = (f32x4){0.f, 0.f, 0.f, 0.f};
    bf16x8 At[4][2], B0[2][2], B1[2][2];
    const char* cA = PG8_ABASE(cur); const char* cB = PG8_BBASE(cur);
    PG8_STAGE(PG8_SB(0, 0), cB, voffB); PG8_STAGE(PG8_SA(0, 0), cA, voffA); PG8_STAGE(PG8_SB(0, 1), cB + hstepB, voffB); PG8_STAGE(PG8_SA(0, 1), cA + hstepA, voffA);
    if (wr == 1) PG8_BAR;
    PG8_WAIT_V(4); PG8_BAR;
    PG8_STAGE(PG8_SB(1, 0), cB + kstep, voffB); PG8_STAGE(PG8_SA(1, 0), cA + kstep, voffA); PG8_STAGE(PG8_SB(1, 1), cB + hstepB + kstep, voffB);
    PG8_WAIT_V(6); PG8_BAR;
    for (;;) {
        const bool has_next = S.next(ui + 1, nxt);
        const char* nA = has_next ? PG8_ABASE(nxt) : cA; const char* nB = has_next ? PG8_BBASE(nxt) : cB;
        const int nt = cur.nt;
        for (int t = 0; t < nt; t += 2) {
            const bool last = (t == nt - 2);
            const char* a1 = cA + (size_t)(t + 1) * kstep;
            const char* a2 = last ? nA : cA + (size_t)(t + 2) * kstep; const char* b2 = last ? nB : cB + (size_t)(t + 2) * kstep;
            const char* a3 = a2 + kstep; const char* b3 = b2 + kstep;
            PG8_LDB(B0, 0, 0); PG8_SCHED; PG8_LDA(At, 0, 0); PG8_STAGE(PG8_SA(1, 1), a1 + hstepA, voffA);
            PG8_WAIT_L(8); PG8_BAR; PG8_WAIT_L(0); PG8_MMA(0, 0, At, B0); PG8_BAR; PG8_SCHED;
            PG8_LDB(B1, 0, 1); PG8_STAGE(PG8_SB(0, 0), b2, voffB);
            PG8_BAR; PG8_WAIT_L(0); PG8_MMA(0, 1, At, B1); PG8_BAR;
            PG8_LDA(At, 0, 1); PG8_STAGE(PG8_SA(0, 0), a2, voffA);
            PG8_BAR; PG8_WAIT_L(0); PG8_MMA(1, 0, At, B0); PG8_BAR; PG8_SCHED;
            PG8_STAGE(PG8_SB(0, 1), b2 + hstepB, voffB);
            PG8_WAIT_V(6); PG8_BAR; PG8_MMA(1, 1, At, B1); PG8_BAR;
            PG8_LDB(B0, 1, 0); PG8_SCHED; PG8_LDA(At, 1, 0); PG8_STAGE(PG8_SA(0, 1), a2 + hstepA, voffA);
            PG8_WAIT_L(8); PG8_BAR; PG8_WAIT_L(0); PG8_MMA(0, 0, At, B0); PG8_BAR; PG8_SCHED;
            PG8_LDB(B1, 1, 1); PG8_STAGE(PG8_SB(1, 0), b3, voffB);
            PG8_BAR; PG8_WAIT_L(0); PG8_MMA(0, 1, At, B1); PG8_BAR;
            PG8_LDA(At, 1, 1); PG8_STAGE(PG8_SA(1, 0), a3, voffA);
            PG8_BAR; PG8_WAIT_L(0); PG8_MMA(1, 0, At, B0); PG8_BAR; PG8_SCHED;
            PG8_STAGE(PG8_SB(1, 1), b3 + hstepB, voffB);
            PG8_WAIT_V(6); PG8_BAR; PG8_MMA(1, 1, At, B1); PG8_BAR;
        }
        E(acc, cur, wr, wc, fr, fq);
        if (!has_next) break;
#pragma unroll
        for (int a = 0; a < 2; ++a)
#pragma unroll
            for (int b = 0; b < 2; ++b)
#pragma unroll
                for (int m = 0; m < 4; ++m)
#pragma unroll
                    for (int n = 0; n < 2; ++n) acc[a][b][m][n] = (f32x4){0.f, 0.f, 0.f, 0.f};
        cur = nxt; cA = nA; cB = nB; ++ui;
    }
    PG8_WAIT_V(0);
    if (wr == 0) PG8_BAR;
    PG8_BAR;
#undef PG8_SA
#undef PG8_SB
#undef PG8_STAGE
#undef PG8_LDA
#undef PG8_LDB
#undef PG8_MMA
#undef PG8_WAIT_V
#undef PG8_WAIT_L
#undef PG8_BAR
#undef PG8_SCHED
#undef PG8_ABASE
#undef PG8_BBASE
}

struct EpiAccF32 {
    static constexpr bool PERM = false;
    float* C; int ldc; float* slab; int pm0, nMs, ksplit;
    __device__ __forceinline__ void operator()(const f32x4 (&acc)[2][2][4][2], const Unit& u, int wr, int wc, int fr, int fq) const {
        if (u.part) {
            float* sl = slab + ((size_t)((u.pn * nMs + (u.pm - pm0)) * ksplit + u.k0 / (u.nt * BK)) * BM + wr * 64 + fr) * BM + wc * 32 + 4 * fq;
#pragma unroll
            for (int ai = 0; ai < 2; ++ai)
#pragma unroll
                for (int m = 0; m < 4; ++m) { float* rowp = sl + (size_t)(ai * HALF + m * 16) * BM;
#pragma unroll
                    for (int bj = 0; bj < 2; ++bj)
#pragma unroll
                        for (int n = 0; n < 2; ++n) *(f32x4*)(rowp + bj * HALF + n * 16) = acc[ai][bj][m][n]; }
        } else {
            const int row0 = u.pm * BM + wr * 64 + fr, col0 = u.pn * BM + wc * 32 + 4 * fq;
#pragma unroll
            for (int ai = 0; ai < 2; ++ai)
#pragma unroll
                for (int m2 = 0; m2 < 4; m2 += 2) {
                    f32x4 t[2][2][2];
#pragma unroll
                    for (int mm = 0; mm < 2; ++mm) { const float* rowp = C + (size_t)(row0 + ai * HALF + (m2 + mm) * 16) * ldc + col0;
#pragma unroll
                        for (int bj = 0; bj < 2; ++bj)
#pragma unroll
                            for (int n = 0; n < 2; ++n) t[mm][bj][n] = *(const f32x4*)(rowp + bj * HALF + n * 16); }
#pragma unroll
                    for (int mm = 0; mm < 2; ++mm) { float* rowp = C + (size_t)(row0 + ai * HALF + (m2 + mm) * 16) * ldc + col0;
#pragma unroll
                        for (int bj = 0; bj < 2; ++bj)
#pragma unroll
                            for (int n = 0; n < 2; ++n) *(f32x4*)(rowp + bj * HALF + n * 16) = t[mm][bj][n] + acc[ai][bj][m2 + mm][n]; }
                }
        }
    }
};
struct EpiF32 {
    static constexpr bool PERM = false;
    float* C; int ldc; int ncols;
    __device__ __forceinline__ void operator()(const f32x4 (&acc)[2][2][4][2], const Unit& u, int wr, int wc, int fr, int fq) const {
        const int row0 = u.pm * BM + wr * 64 + fr, col0 = u.pn * BM + wc * 32 + 4 * fq;
#pragma unroll
        for (int ai = 0; ai < 2; ++ai)
#pragma unroll
            for (int m = 0; m < 4; ++m) { float* rowp = C + (size_t)(row0 + ai * HALF + m * 16) * ldc + col0;
#pragma unroll
                for (int bj = 0; bj < 2; ++bj)
#pragma unroll
                    for (int n = 0; n < 2; ++n) if (col0 + bj * HALF + n * 16 < ncols) *(f32x4*)(rowp + bj * HALF + n * 16) = acc[ai][bj][m][n]; }
    }
};
template <int ACT> struct EpiBf16 {
    static constexpr bool PERM = true;
    bf16_t* O; int ldc;
    __device__ __forceinline__ void operator()(const f32x4 (&acc)[2][2][4][2], const Unit& u, int wr, int wc, int fr, int fq) const {
        const int row0 = u.pm * BM + wr * 64 + fr, col0 = u.pn * BM + wc * 32 + 8 * fq;
#pragma unroll
        for (int ai = 0; ai < 2; ++ai)
#pragma unroll
            for (int m = 0; m < 4; ++m) { bf16_t* rowp = O + (size_t)(row0 + ai * HALF + m * 16) * ldc + col0;
#pragma unroll
                for (int bj = 0; bj < 2; ++bj) { f32x4 v0 = acc[ai][bj][m][0], v1 = acc[ai][bj][m][1];
                    if (ACT == 3) {
#pragma unroll
                        for (int j = 0; j < 4; ++j) { const float a = fmaxf(v0[j], 0.f), b = fmaxf(v1[j], 0.f); v0[j] = a * a; v1[j] = b * b; } }
                    u32x4 w; w.x = cvt_pk_bf16(v0[0], v0[1]); w.y = cvt_pk_bf16(v0[2], v0[3]); w.z = cvt_pk_bf16(v1[0], v1[1]); w.w = cvt_pk_bf16(v1[2], v1[3]);
                    *(u32x4*)(rowp + bj * HALF) = w; } }
    }
};
}
typedef pg8::bf16_t bf16_t;
#define LDSP __attribute__((address_space(3)))
struct Fast {
    bf16_t *xnb, *hmidb;
    bf16_t *w1t, *w2t;
    float* slab;
};
__device__ __forceinline__ unsigned pk2bf(float lo, float hi) { return pg8::cvt_pk_bf16(lo, hi); }
__device__ __forceinline__ float wave_sum64(float v) {
#pragma unroll
    for (int o = 1; o < 64; o <<= 1) v += __shfl_xor(v, o);
    return v;
}
__device__ __forceinline__ void tr_item(const float* __restrict__ W, int ldw, int K, bf16_t* WT, int nvalid, const float* __restrict__ kscale, LDSP float* scr, int item, int nblk, int lane) {
    const int kb = item / nblk, nb = item % nblk, k0 = 64 * kb, n0 = 32 * nb;
    const bool ok = n0 < nvalid;
#pragma unroll
    for (int i = 0; i < 8; ++i) { const int kk = 8 * i + (lane >> 3), nn = 4 * (lane & 7); pg8::f32x4 v = ok ? *(const pg8::f32x4*)(W + (size_t)(k0 + kk) * ldw + n0 + nn) : (pg8::f32x4){0.f, 0.f, 0.f, 0.f};
        if (kscale) v = v * kscale[k0 + kk];
        scr[kk * 33 + nn] = v[0]; scr[kk * 33 + nn + 1] = v[1]; scr[kk * 33 + nn + 2] = v[2]; scr[kk * 33 + nn + 3] = v[3]; }
    asm volatile("s_waitcnt lgkmcnt(0)" ::: "memory");
    const int c = lane & 7;
#pragma unroll
    for (int j = 0; j < 4; ++j) { const int n = (lane >> 3) + 8 * j; const LDSP float* s = scr + (8 * c) * 33 + n;
        pg8::u32x4 o; o.x = pk2bf(s[0 * 33], s[1 * 33]); o.y = pk2bf(s[2 * 33], s[3 * 33]); o.z = pk2bf(s[4 * 33], s[5 * 33]); o.w = pk2bf(s[6 * 33], s[7 * 33]);
        *(pg8::u32x4*)(WT + (size_t)(n0 + n) * K + k0 + 8 * c) = o; }
    asm volatile("s_waitcnt lgkmcnt(0)" ::: "memory");
}
__device__ __forceinline__ void tr_weight(const float* W, int K, int N, int npad, bf16_t* WT, const float* kscale, LDSP float* scr, int gw, int ngw, int lane) {
    const int nblk = npad / 32, items = (K / 64) * nblk;
    for (int it = gw; it < items; it += ngw) tr_item(W, N, K, WT, N, kscale, scr, it, nblk, lane);
}
__device__ __forceinline__ pg8::f32x4 slab_sum(const float* __restrict__ slab, int ksplit, int m, int q, int lane) {
    using namespace cfg; const int rs = m - MP, pms = rs >> 8, row = rs & 255;
    const float* p = slab + ((size_t)((q * (MS / 256) + pms) * ksplit) * 256 + row) * 256 + 4 * lane;
    pg8::f32x4 s = {0.f, 0.f, 0.f, 0.f};
    for (int k = 0; k < ksplit; ++k) s = s + *(const pg8::f32x4*)(p + (size_t)k * 65536);
    return s;
}
__device__ __forceinline__ void norm_rows_bf16(float* __restrict__ x, const float* __restrict__ gain, bf16_t* xn, const float* __restrict__ slab, int ksplit, int gw, int ngw, int lane) {
    using namespace cfg;
    pg8::f32x4 gv[4];
#pragma unroll
    for (int j = 0; j < 4; ++j) gv[j] = *(const pg8::f32x4*)(gain + 4 * lane + 256 * j);
    for (int m = gw; m < MTOT; m += ngw) {
        float* xr = x + (size_t)m * D; pg8::f32x4 v[4]; float s = 0.f;
#pragma unroll
        for (int j = 0; j < 4; ++j) { v[j] = *(const pg8::f32x4*)(xr + 4 * lane + 256 * j);
            if (ksplit > 1 && m >= MP) { v[j] = v[j] + slab_sum(slab, ksplit, m, j, lane); *(pg8::f32x4*)(xr + 4 * lane + 256 * j) = v[j]; }
            s += (v[j][0] * v[j][0] + v[j][1] * v[j][1]) + (v[j][2] * v[j][2] + v[j][3] * v[j][3]); }
        const float rs = 1.0f / sqrtf(wave_sum64(s) * (1.0f / D) + NORM_EPS);
#pragma unroll
        for (int j = 0; j < 4; ++j) { pg8::u32x2 o; o.x = pk2bf(v[j][0] * rs * gv[j][0], v[j][1] * rs * gv[j][1]); o.y = pk2bf(v[j][2] * rs * gv[j][2], v[j][3] * rs * gv[j][3]);
            *(pg8::u32x2*)(xn + (size_t)m * D + 4 * lane + 256 * j) = o; }
    }
}

__device__ __forceinline__ void fold_sample_rows(float* __restrict__ x, const float* __restrict__ slab, int ksplit, int gw, int ngw, int lane) {
    using namespace cfg;
    for (int m = MP + gw; m < MTOT; m += ngw) {
#pragma unroll
        for (int j = 0; j < 4; ++j) { float* p = x + (size_t)m * D + 4 * lane + 256 * j; *(pg8::f32x4*)p = *(const pg8::f32x4*)p + slab_sum(slab, ksplit, m, j, lane); }
    }
}
struct FastMla {
    float* mh;
    bf16_t *qan, *cb, *kpb;
    bf16_t *qraw, *kvraw;
    bf16_t *qf, *knb, *aob, *vT, *qs;
    float *opart, *lpart;
    bf16_t *wint, *wuqt, *wukvt, *wot;
};
__device__ __forceinline__ void rope_cs(int pos, int i, float& cs, float& sn) {
    const float inv = exp2f(-(float)i * (13.287712379549449f / 16.0f));
    const float ang = (float)pos * inv, kq = rintf(ang * 0.15915494309189535f);
    float rr = fmaf(-kq, 6.28125f, ang); rr = fmaf(-kq, 1.9353071795864769e-3f, rr);
    cs = __cosf(rr); sn = __sinf(rr);
}
__device__ __forceinline__ float bf2f(unsigned short b) { return __uint_as_float(((unsigned)b) << 16); }
__device__ __forceinline__ void mla_norm1_fast(const Ctx& c, const FastMla& fm, int j, int gw, int ngw, int lane) {
    using namespace cfg;
    for (int m = gw; m < MTOT; m += ngw) {
        const float* h = fm.mh + (size_t)m * 1024;
        pg8::f32x4 qv[2]; float s = 0.f;
#pragma unroll
        for (int t = 0; t < 2; ++t) { qv[t] = *(const pg8::f32x4*)(h + 4 * lane + 256 * t); s += (qv[t][0] * qv[t][0] + qv[t][1] * qv[t][1]) + (qv[t][2] * qv[t][2] + qv[t][3] * qv[t][3]); }
        const float rq = 1.0f / sqrtf(wave_sum64(s) * (1.0f / QL) + NORM_EPS);
#pragma unroll
        for (int t = 0; t < 2; ++t) { const pg8::f32x4 g = *(const pg8::f32x4*)(c.in[I_QNORM] + j * QL + 4 * lane + 256 * t);
            pg8::u32x2 o; o.x = pk2bf(qv[t][0] * rq * g[0], qv[t][1] * rq * g[1]); o.y = pk2bf(qv[t][2] * rq * g[2], qv[t][3] * rq * g[3]);
            *(pg8::u32x2*)(fm.qan + (size_t)m * QL + 4 * lane + 256 * t) = o; }
        const pg8::f32x4 cv = *(const pg8::f32x4*)(h + QL + 4 * lane);
        const float rc = 1.0f / sqrtf(wave_sum64((cv[0] * cv[0] + cv[1] * cv[1]) + (cv[2] * cv[2] + cv[3] * cv[3])) * (1.0f / KVL) + NORM_EPS);
        const pg8::f32x4 gc = *(const pg8::f32x4*)(c.in[I_KVNORM] + j * KVL + 4 * lane);
        const pg8::f32x4 cn = {cv[0] * rc * gc[0], cv[1] * rc * gc[1], cv[2] * rc * gc[2], cv[3] * rc * gc[3]};
        float* co = m < MP ? c.out + O_CKVP + ((size_t)j * MP + m) * KVL : c.out + O_CKVS + ((size_t)j * MS + (m - MP)) * KVL;
        *(pg8::f32x4*)(co + 4 * lane) = cn; *(pg8::f32x4*)(c.c + (size_t)m * KVL + 4 * lane) = cn;
        { pg8::u32x2 o; o.x = pk2bf(cn[0], cn[1]); o.y = pk2bf(cn[2], cn[3]); *(pg8::u32x2*)(fm.cb + (size_t)m * KVL + 4 * lane) = o; }
        const float kv = lane < ROPE ? h[QL + KVL + lane] : 0.f;
        const float rk = 1.0f / sqrtf(wave_sum64(kv * kv) * (1.0f / ROPE) + NORM_EPS);
        const float kn = kv * rk * (lane < ROPE ? c.in[I_KRN][j * ROPE + lane] : 0.f);
        const float other = __shfl_xor(kn, 16);
        float cs, sn; rope_cs(row_pos(m), lane & 15, cs, sn);
        const float ro = lane < 16 ? kn * cs - other * sn : kn * cs + other * sn;
        if (lane < ROPE) {
            float* ko = m < MP ? c.out + O_KPEP + ((size_t)j * MP + m) * ROPE : c.out + O_KPES + ((size_t)j * MS + (m - MP)) * ROPE;
            ko[lane] = ro; c.kp[(size_t)m * ROPE + lane] = ro;
            fm.kpb[(size_t)m * ROPE + lane] = (bf16_t)(pk2bf(ro, 0.f) & 0xffffu);
        }
    }
}
__device__ __forceinline__ void mla_norm2_fast(const Ctx& c, const FastMla& fm, int j, int gw, int ngw, int lane) {
    using namespace cfg;
    const int hd = lane >> 2, qt = lane & 3;
    const float QSC = 0.10206207261596575f * 1.4426950408889634f;
    for (int m = gw; m < MTOT; m += ngw) {
        const bf16_t* qr = fm.qraw + (size_t)m * (MH * QD) + hd * QD;
        float v[16]; float s = 0.f;
        { const pg8::u32x4 a = *(const pg8::u32x4*)(qr + 16 * qt), b = *(const pg8::u32x4*)(qr + 16 * qt + 8); const unsigned w[8] = {a.x, a.y, a.z, a.w, b.x, b.y, b.z, b.w};
#pragma unroll
          for (int i = 0; i < 8; ++i) { v[2 * i] = __uint_as_float(w[i] << 16); v[2 * i + 1] = __uint_as_float(w[i] & 0xffff0000u); } }
#pragma unroll
        for (int i = 0; i < 16; ++i) s += v[i] * v[i];
        s += __shfl_xor(s, 1); s += __shfl_xor(s, 2);
        float rs = 1.0f / sqrtf(s * (1.0f / NOPE) + NORM_EPS);
        bf16_t* qo = fm.qf + (size_t)m * (MH * QD) + hd * QD; float* qo32 = c.q + (size_t)m * (MH * QD) + hd * QD;
        { unsigned w[8], w2[8];
#pragma unroll
          for (int i = 0; i < 8; ++i) { const float a = v[2 * i] * rs * c.in[I_QNN][j * NOPE + 16 * qt + 2 * i], b = v[2 * i + 1] * rs * c.in[I_QNN][j * NOPE + 16 * qt + 2 * i + 1];
              w[i] = pk2bf(a * QSC, b * QSC); qo32[16 * qt + 2 * i] = a; qo32[16 * qt + 2 * i + 1] = b;
              w2[i] = pk2bf(a * QSC * c.in[I_KNN][j * NOPE + 16 * qt + 2 * i], b * QSC * c.in[I_KNN][j * NOPE + 16 * qt + 2 * i + 1]); }
          *(pg8::u32x4*)(qo + 16 * qt) = (pg8::u32x4){w[0], w[1], w[2], w[3]}; *(pg8::u32x4*)(qo + 16 * qt + 8) = (pg8::u32x4){w[4], w[5], w[6], w[7]};
          if (m >= MP) { bf16_t* q2 = fm.qs + (size_t)(m - MP) * (MH * QD) + hd * QD;
              *(pg8::u32x4*)(q2 + 16 * qt) = (pg8::u32x4){w2[0], w2[1], w2[2], w2[3]}; *(pg8::u32x4*)(q2 + 16 * qt + 8) = (pg8::u32x4){w2[4], w2[5], w2[6], w2[7]}; } }
        float r8[8]; s = 0.f;
        { const pg8::u32x4 a = *(const pg8::u32x4*)(qr + NOPE + 8 * qt); const unsigned w[4] = {a.x, a.y, a.z, a.w};
#pragma unroll
          for (int i = 0; i < 4; ++i) { r8[2 * i] = __uint_as_float(w[i] << 16); r8[2 * i + 1] = __uint_as_float(w[i] & 0xffff0000u); } }
#pragma unroll
        for (int i = 0; i < 8; ++i) s += r8[i] * r8[i];
        s += __shfl_xor(s, 1); s += __shfl_xor(s, 2);
        rs = 1.0f / sqrtf(s * (1.0f / ROPE) + NORM_EPS);
        { unsigned w[4]; float o8[8];
#pragma unroll
          for (int i = 0; i < 8; ++i) { const float mine = r8[i] * rs * c.in[I_QRN][j * ROPE + 8 * qt + i]; const float oth = __shfl_xor(mine, 2);
              float cs, sn; rope_cs(row_pos(m), (8 * qt + i) & 15, cs, sn);
              o8[i] = qt < 2 ? mine * cs - oth * sn : mine * cs + oth * sn; qo32[NOPE + 8 * qt + i] = o8[i]; }
#pragma unroll
          for (int i = 0; i < 4; ++i) w[i] = pk2bf(o8[2 * i] * QSC, o8[2 * i + 1] * QSC);
          *(pg8::u32x4*)(qo + NOPE + 8 * qt) = (pg8::u32x4){w[0], w[1], w[2], w[3]};
          if (m >= MP) *(pg8::u32x4*)(fm.qs + (size_t)(m - MP) * (MH * QD) + hd * QD + NOPE + 8 * qt) = (pg8::u32x4){w[0], w[1], w[2], w[3]}; }
        const bf16_t* kr = fm.kvraw + (size_t)m * 2048 + hd * NOPE; s = 0.f;
        { const pg8::u32x4 a = *(const pg8::u32x4*)(kr + 16 * qt), b = *(const pg8::u32x4*)(kr + 16 * qt + 8); const unsigned w[8] = {a.x, a.y, a.z, a.w, b.x, b.y, b.z, b.w};
#pragma unroll
          for (int i = 0; i < 8; ++i) { v[2 * i] = __uint_as_float(w[i] << 16); v[2 * i + 1] = __uint_as_float(w[i] & 0xffff0000u); } }
#pragma unroll
        for (int i = 0; i < 16; ++i) s += v[i] * v[i];
        s += __shfl_xor(s, 1); s += __shfl_xor(s, 2);
        rs = 1.0f / sqrtf(s * (1.0f / NOPE) + NORM_EPS);
        bf16_t* ko = fm.knb + (size_t)m * (MH * NOPE) + hd * NOPE;
        { unsigned w[8];
#pragma unroll
          for (int i = 0; i < 8; ++i) { const float a = v[2 * i] * rs * c.in[I_KNN][j * NOPE + 16 * qt + 2 * i], b = v[2 * i + 1] * rs * c.in[I_KNN][j * NOPE + 16 * qt + 2 * i + 1];
              w[i] = pk2bf(a, b); }
          *(pg8::u32x4*)(ko + 16 * qt) = (pg8::u32x4){w[0], w[1], w[2], w[3]}; *(pg8::u32x4*)(ko + 16 * qt + 8) = (pg8::u32x4){w[4], w[5], w[6], w[7]}; }
    }
}
__device__ __forceinline__ void cvt_f32_bf16(const float* __restrict__ s, bf16_t* d, size_t n, size_t gtid, size_t gsz) {
    for (size_t i = gtid * 4; i < n; i += gsz * 4) { const pg8::f32x4 v = *(const pg8::f32x4*)(s + i); pg8::u32x2 o; o.x = pk2bf(v[0], v[1]); o.y = pk2bf(v[2], v[3]); *(pg8::u32x2*)(d + i) = o; }
}
typedef float f32x16_t __attribute__((ext_vector_type(16)));
typedef pg8::bf16x8 bf16x8v;
constexpr int AT_KROW = 208, AT_VROW = 136, AT_KBUF = 64 * AT_KROW, AT_VBUF = 64 * AT_VROW, AT_LDS = 2 * AT_KBUF + 2 * AT_VBUF;
__device__ __forceinline__ void attn_prompt_fast(const bf16_t* __restrict__ qf, const bf16_t* __restrict__ knb, const bf16_t* __restrict__ kpb, const bf16_t* __restrict__ vT, bf16_t* aob, LDSP unsigned char* lds) {
    using namespace cfg;
    const int tid = (int)tid_now(), w = __builtin_amdgcn_readfirstlane(tid >> 6), lane = tid & 63, l31 = lane & 31, h5 = lane >> 5;
    for (int it = blockIdx.x; it < BATCH * MH * 4; it += gridDim.x) {
        const int bh = it >> 2, pr = it & 3, b = bh / MH, h = bh % MH;
        for (int half = 0; half < 2; ++half) {
            const int qb = half ? 7 - pr : pr, q0 = 256 * qb, nt = 4 * qb + 4;
            const int qg = q0 + 32 * w + l31;
            const size_t mrow = (size_t)b * SEQ + qg;
            bf16x8v qfr[6];
#pragma unroll
            for (int s = 0; s < 6; ++s) qfr[s] = *(const bf16x8v*)(qf + mrow * (MH * QD) + h * QD + 16 * s + 8 * h5);
            f32x16_t O[2];
#pragma unroll
            for (int db = 0; db < 2; ++db)
#pragma unroll
                for (int r = 0; r < 16; ++r) O[db][r] = 0.f;
            float mrun = -1e30f, lrun = 0.f;
            pg8::u32x4 rk, rp, rv;
            const int kkey = tid >> 3, kc8 = tid & 7, pkey = tid >> 2, pc4 = tid & 3;
#define AT_LOAD(t) do { const size_t mk = (size_t)b * SEQ + 64 * (t); \
                rk = *(const pg8::u32x4*)(knb + (mk + kkey) * (MH * NOPE) + h * NOPE + kc8 * 8); \
                if (tid < 256) rp = *(const pg8::u32x4*)(kpb + (mk + pkey) * ROPE + pc4 * 8); \
                rv = *(const pg8::u32x4*)(vT + (size_t)(h * VD + kkey) * MTOT + mk + kc8 * 8); } while (0)
#define AT_STORE(buf) do { LDSP unsigned char* kb_ = lds + (buf) * AT_KBUF; LDSP unsigned char* vb_ = lds + 2 * AT_KBUF + (buf) * AT_VBUF; \
                *(LDSP pg8::u32x4*)(kb_ + kkey * AT_KROW + kc8 * 16) = rk; \
                if (tid < 256) *(LDSP pg8::u32x4*)(kb_ + pkey * AT_KROW + 128 + pc4 * 16) = rp; \
                *(LDSP pg8::u32x2*)(vb_ + kkey * AT_VROW + kc8 * 16) = (pg8::u32x2){rv.x, rv.y}; *(LDSP pg8::u32x2*)(vb_ + kkey * AT_VROW + kc8 * 16 + 8) = (pg8::u32x2){rv.z, rv.w}; } while (0)
            AT_LOAD(0); AT_STORE(0);
            __syncthreads();
            for (int t = 0; t < nt; ++t) {
                if (t + 1 < nt) AT_LOAD(t + 1);
                if (64 * t <= q0 + 32 * w + 31) {
                    const LDSP unsigned char* kb_ = lds + (t & 1) * AT_KBUF; const LDSP unsigned char* vb_ = lds + 2 * AT_KBUF + (t & 1) * AT_VBUF;
                    f32x16_t S[2];
#pragma unroll
                    for (int kb = 0; kb < 2; ++kb)
#pragma unroll
                        for (int r = 0; r < 16; ++r) S[kb][r] = 0.f;
#pragma unroll
                    for (int s = 0; s < 6; ++s)
#pragma unroll
                        for (int kb = 0; kb < 2; ++kb) {
                            const bf16x8v a = *(const LDSP bf16x8v*)(kb_ + (32 * kb + l31) * AT_KROW + (16 * s + 8 * h5) * 2);
                            S[kb] = __builtin_amdgcn_mfma_f32_32x32x16_bf16(a, qfr[s], S[kb], 0, 0, 0);
                        }
                    if (64 * t + 63 > q0 + 32 * w) {
#pragma unroll
                        for (int kb = 0; kb < 2; ++kb)
#pragma unroll
                            for (int r = 0; r < 16; ++r) { const int key = 64 * t + 32 * kb + (r & 3) + 8 * (r >> 2) + 4 * h5; if (key > qg) S[kb][r] = -1e30f; }
                    }
                    float mt = -1e30f;
#pragma unroll
                    for (int kb = 0; kb < 2; ++kb)
#pragma unroll
                        for (int r = 0; r < 16; ++r) mt = fmaxf(mt, S[kb][r]);
                    mt = fmaxf(mt, __shfl_xor(mt, 32));
                    const float mnew = fmaxf(mrun, mt), alpha = exp2f(mrun - mnew);
                    float ls = 0.f;
#pragma unroll
                    for (int kb = 0; kb < 2; ++kb)
#pragma unroll
                        for (int r = 0; r < 16; ++r) { const float p = exp2f(S[kb][r] - mnew); S[kb][r] = p; ls += p; }
                    lrun = lrun * alpha + ls; mrun = mnew;
#pragma unroll
                    for (int db = 0; db < 2; ++db)
#pragma unroll
                        for (int r = 0; r < 16; ++r) O[db][r] *= alpha;
#pragma unroll
                    for (int kb = 0; kb < 2; ++kb)
#pragma unroll
                        for (int s = 0; s < 2; ++s) {
                            pg8::u32x4 pw; pw.x = pk2bf(S[kb][8 * s + 0], S[kb][8 * s + 1]); pw.y = pk2bf(S[kb][8 * s + 2], S[kb][8 * s + 3]); pw.z = pk2bf(S[kb][8 * s + 4], S[kb][8 * s + 5]); pw.w = pk2bf(S[kb][8 * s + 6], S[kb][8 * s + 7]);
                            const bf16x8v pf = __builtin_bit_cast(bf16x8v, pw);
#pragma unroll
                            for (int db = 0; db < 2; ++db) {
                                const LDSP unsigned char* vp = vb_ + (32 * db + l31) * AT_VROW + (32 * kb + 16 * s + 4 * h5) * 2;
                                const pg8::u32x2 v0 = *(const LDSP pg8::u32x2*)vp, v1 = *(const LDSP pg8::u32x2*)(vp + 16);
                                const bf16x8v a = __builtin_bit_cast(bf16x8v, (pg8::u32x4){v0.x, v0.y, v1.x, v1.y});
                                O[db] = __builtin_amdgcn_mfma_f32_32x32x16_bf16(a, pf, O[db], 0, 0, 0);
                            }
                        }
                }
                if (t + 1 < nt) AT_STORE((t + 1) & 1);
                __syncthreads();
            }
#undef AT_LOAD
#undef AT_STORE
            const float inv = 1.0f / (lrun + __shfl_xor(lrun, 32));
            bf16_t* orow = aob + mrow * (MH * VD) + h * VD;
#pragma unroll
            for (int db = 0; db < 2; ++db)
#pragma unroll
                for (int g = 0; g < 4; ++g) { pg8::u32x2 o; o.x = pk2bf(O[db][4 * g] * inv, O[db][4 * g + 1] * inv); o.y = pk2bf(O[db][4 * g + 2] * inv, O[db][4 * g + 3] * inv);
                    *(pg8::u32x2*)(orow + 32 * db + 8 * g + 4 * h5) = o; }
        }
    }
}
constexpr int SD_CROW = 528, SD_WROW = 528, SD_PROW = 272;
constexpr int SD_CIMG = 0, SD_CIMG_SZ = 128 * SD_CROW;
constexpr int SD_WBUF = SD_CIMG + SD_CIMG_SZ, SD_WBUF_SZ = 32 * 1040;
constexpr int SD_XCH = SD_WBUF + 2 * SD_WBUF_SZ, SD_XCH_SZ = 4 * 5 * 64 * 4;
constexpr int SD_PIMG = SD_XCH + 2 * SD_XCH_SZ, SD_PIMG_SZ = 32 * SD_PROW;
constexpr int SD_END = SD_PIMG + 2 * SD_PIMG_SZ;
typedef short s16x4 __attribute__((ext_vector_type(4)));
#define MFMA32(a, b, c) __builtin_amdgcn_mfma_f32_32x32x16_bf16(a, b, c, 0, 0, 0)

__device__ __forceinline__ float mla_b2_bound(const Ctx& c, int j, int lane) {
    using namespace cfg;
    float gq = fabsf(c.in[I_QNN][j * NOPE + lane]), gk = fabsf(c.in[I_KNN][j * NOPE + lane]), gqr = fabsf(c.in[I_QRN][j * ROPE + (lane & 31)]), gkr = fabsf(c.in[I_KRN][j * ROPE + (lane & 31)]);
#pragma unroll
    for (int o = 1; o < 64; o <<= 1) { gq = fmaxf(gq, __shfl_xor(gq, o)); gk = fmaxf(gk, __shfl_xor(gk, o)); gqr = fmaxf(gqr, __shfl_xor(gqr, o)); gkr = fmaxf(gkr, __shfl_xor(gkr, o)); }
    return (64.f * gq * gk + 32.f * gqr * gkr) * (0.10206207261596575f * 1.4426950408889634f);
}

__device__ __forceinline__ void sd_pv_core(const int G, f32x16_t& Og, f32x16_t& Lacc, LDSP unsigned char* lds, int w, int lane, int l31, int h5) {
    asm volatile("" : "+v"(lane)); l31 = lane & 31; h5 = lane >> 5;
    const LDSP unsigned char* pimg = lds + SD_PIMG + (G & 1) * SD_PIMG_SZ;
    const unsigned onesw = (l31 == G) ? 0x3F803F80u : 0u;
    const bf16x8v onesv = __builtin_bit_cast(bf16x8v, (pg8::u32x4){onesw, onesw, onesw, onesw});
#pragma unroll
    for (int sp = 0; sp < 8; ++sp) {
        const bf16x8v a = *(const LDSP bf16x8v*)(pimg + l31 * SD_PROW + (16 * sp + 8 * h5) * 2);
        const int key0 = 16 * sp + 8 * h5 + ((lane & 15) >> 2), col = 32 * w + 16 * ((lane >> 4) & 1) + 4 * (lane & 3);
        const s16x4 t0 = __builtin_amdgcn_ds_read_tr16_b64_v4i16((LDSP s16x4*)(lds + SD_CIMG + key0 * SD_CROW + col * 2));
        const s16x4 t1 = __builtin_amdgcn_ds_read_tr16_b64_v4i16((LDSP s16x4*)(lds + SD_CIMG + (key0 + 4) * SD_CROW + col * 2));
        const bf16x8v b = (bf16x8v){t0[0], t0[1], t0[2], t0[3], t1[0], t1[1], t1[2], t1[3]};
        Og = MFMA32(a, b, Og);
        if (sp == w) Lacc = MFMA32(a, onesv, Lacc);
        if (sp & 1) __builtin_amdgcn_sched_barrier(0);
    }
}

__device__ __forceinline__ void sd_pv(const int G, f32x16_t& Og, f32x16_t& Lacc, LDSP unsigned char* lds, int w, int lane, int l31, int h5) {
    sd_pv_core(G, Og, Lacc, lds, w, lane, l31, h5);
#if defined(PROBE_DUP) && (PROBE_DUP & (1 << 21))
    f32x16_t D0, D1;
#pragma unroll
    for (int r = 0; r < 16; ++r) { D0[r] = 0.f; D1[r] = 0.f; }
    sd_pv_core(G, D0, D1, lds, w, lane, l31, h5); asm volatile("" :: "v"(D0), "v"(D1));
#endif
}
#define SD_WLOAD(h, buf) do { const char* wsrc_ = (const char*)(fm.wukvt + (size_t)(h) * NOPE * KVL); int ln_ = lane; asm volatile("" : "+v"(ln_)); _Pragma("unroll") for (int k = 0; k < 4; ++k) { \
        const unsigned voff_ = (unsigned)(((4 * w + k) + 32 * (ln_ >> 5)) * KVL + (ln_ & 31) * 8) * 2u; \
        __builtin_amdgcn_global_load_lds((const unsigned*)(wsrc_ + voff_), (LDSP unsigned*)(lds + SD_WBUF + (buf) * SD_WBUF_SZ + (4 * w + k) * 1040), 16, 0, 0); } } while (0)
template <int G>
__device__ __forceinline__ void sd_group(const FastMla& fm, const bf16_t* __restrict__ qs, const int s, LDSP unsigned char* lds, const int w, const int lane, const int l31_, const int h5_, const int kb, const int dh,
                                         const bf16x8v (&cfr)[16], const bf16x8v (&kpfr)[2], bf16x8v (&qn)[2], bf16x8v (&qp)[2], f32x16_t (&O)[4], f32x16_t& Lacc, const float B2) {
    using namespace cfg;
        _Pragma("unroll 1") for (int hh = 0; hh < 4; ++hh) {
            const int h = 4 * G + hh;
            int lane_ = lane; asm volatile("" : "+v"(lane_)); const int l31 = lane_ & 31, h5 = lane_ >> 5;
            if (h + 1 < MH) SD_WLOAD(h + 1, (h + 1) & 1);
#if defined(PROBE_DUP) && (PROBE_DUP & (1 << 22))
            if (h + 1 < MH) SD_WLOAD(h + 1, (h + 1) & 1);
#endif
            const bf16x8v qn0 = qn[0], qn1 = qn[1], qp0 = qp[0], qp1 = qp[1];
            { const int hn = (h + 1) & (MH - 1); const bf16_t* qrow = qs + ((size_t)(s * DS + (l31 & 7)) * MH + hn) * QD;
#pragma unroll
              for (int s_ = 0; s_ < 2; ++s_) { const int d0 = 32 * dh + 16 * s_ + 4 * h5; pg8::u32x2 a = *(const pg8::u32x2*)(qrow + d0), b = *(const pg8::u32x2*)(qrow + d0 + 8);
                  if (l31 >= 8) { a = (pg8::u32x2){0u, 0u}; b = a; }
                  qn[s_] = __builtin_bit_cast(bf16x8v, (pg8::u32x4){a.x, a.y, b.x, b.y});
                  pg8::u32x4 e = *(const pg8::u32x4*)(qrow + NOPE + 16 * s_ + 8 * h5); if (l31 >= 8) e = (pg8::u32x4){0u, 0u, 0u, 0u};
                  qp[s_] = __builtin_bit_cast(bf16x8v, e); } }
            f32x16_t KN;
#pragma unroll
            for (int r = 0; r < 16; ++r) KN[r] = 0.f;
            { const LDSP unsigned char* wb = lds + SD_WBUF + (h & 1) * SD_WBUF_SZ + l31 * 1040 + dh * 512 + h5 * 16;
#pragma unroll
              for (int s_ = 0; s_ < 16; ++s_) { const bf16x8v a = *(const LDSP bf16x8v*)(wb + 32 * s_); KN = MFMA32(a, cfr[s_], KN); if ((s_ & 3) == 3) __builtin_amdgcn_sched_barrier(0); } }
#if defined(PROBE_DUP) && (PROBE_DUP & (1 << 19))
            { const LDSP unsigned char* wb = lds + SD_WBUF + (h & 1) * SD_WBUF_SZ + l31 * 1040 + dh * 512 + h5 * 16;
#pragma unroll
              for (int s_ = 0; s_ < 16; ++s_) { const bf16x8v a = *(const LDSP bf16x8v*)(wb + 32 * s_); KN = MFMA32(a, cfr[s_], KN); if ((s_ & 3) == 3) __builtin_amdgcn_sched_barrier(0); }
#pragma unroll
              for (int r = 0; r < 16; ++r) KN[r] *= 0.5f; }
#endif
            float ssq = 0.f;
#pragma unroll
            for (int r = 0; r < 16; ++r) ssq += KN[r] * KN[r];
            ssq += __shfl_xor(ssq, 32);
            {
            f32x16_t S;
#pragma unroll
            for (int r = 0; r < 16; ++r) S[r] = 0.f;
#pragma unroll
            for (int s_ = 0; s_ < 2; ++s_) { const bf16x8v kf = __builtin_bit_cast(bf16x8v, (pg8::u32x4){pk2bf(KN[8 * s_], KN[8 * s_ + 1]), pk2bf(KN[8 * s_ + 2], KN[8 * s_ + 3]), pk2bf(KN[8 * s_ + 4], KN[8 * s_ + 5]), pk2bf(KN[8 * s_ + 6], KN[8 * s_ + 7])});
                S = MFMA32(s_ == 0 ? qn0 : qn1, kf, S); }
            LDSP float* xch = (LDSP float*)(lds + SD_XCH + (h & 1) * SD_XCH_SZ) + kb * 320;
            if (dh == 1) { xch[lane_] = S[0]; xch[64 + lane_] = S[1]; xch[128 + lane_] = S[2]; xch[192 + lane_] = S[3]; xch[256 + lane_] = ssq; }
            asm volatile("s_waitcnt vmcnt(0)" ::: "memory");
            __syncthreads();
            if (dh == 0) {
                const float rstd = __builtin_amdgcn_rsqf((ssq + xch[256 + lane_]) * (1.0f / NOPE) + NORM_EPS);
                f32x16_t T;
#pragma unroll
                for (int r = 0; r < 16; ++r) T[r] = 0.f;
                T[0] = (S[0] + xch[lane_]) * rstd; T[1] = (S[1] + xch[64 + lane_]) * rstd; T[2] = (S[2] + xch[128 + lane_]) * rstd; T[3] = (S[3] + xch[192 + lane_]) * rstd;
                T = MFMA32(qp0, kpfr[0], T); T = MFMA32(qp1, kpfr[1], T);
                LDSP bf16_t* prow = (LDSP bf16_t*)(lds + SD_PIMG + (G & 1) * SD_PIMG_SZ + (hh * 8 + 4 * h5) * SD_PROW) + 32 * kb + l31;
#pragma unroll
                for (int q = 0; q < 4; ++q) prow[q * (SD_PROW / 2)] = (bf16_t)(pk2bf(exp2f(T[q] - B2), 0.f) & 0xffffu);
            }
            }
        }
        if (G > 0) sd_pv(G > 0 ? G - 1 : 0, O[G > 0 ? G - 1 : 0], Lacc, lds, w, lane, l31_, h5_);
}

__device__ __forceinline__ void mla_sample_decode(const Ctx& c, const FastMla& fm, const bf16_t* __restrict__ qs, float* opart, float* lpart, int j, LDSP unsigned char* lds) {
    using namespace cfg;
    const int tid = (int)tid_now(), tid_ = tid, w = __builtin_amdgcn_readfirstlane(tid >> 6), lane = tid & 63, l31 = lane & 31, h5 = lane >> 5, kb = w & 3, dh = w >> 2;
    const float* ckv = c.in[I_CKV] + (size_t)j * NPOOL * PAGE * KVL; const float* kpe = c.in[I_KPE] + (size_t)j * NPOOL * PAGE * ROPE;
    const float B2 = mla_b2_bound(c, j, lane);
    for (int it = blockIdx.x; it < DB * 2; it += gridDim.x) {
        const int s = it >> 1, hf = it & 1;
        f32x16_t O[4], Lacc;
#pragma unroll
        for (int r = 0; r < 16; ++r) { O[0][r] = 0.f; O[1][r] = 0.f; O[2][r] = 0.f; O[3][r] = 0.f; Lacc[r] = 0.f; }
        bf16x8v qn[2], qp[2];
        { const bf16_t* qrow = qs + ((size_t)(s * DS + (l31 & 7)) * MH + 0) * QD;
#pragma unroll
          for (int s_ = 0; s_ < 2; ++s_) { const int d0 = 32 * dh + 16 * s_ + 4 * h5; pg8::u32x2 a = *(const pg8::u32x2*)(qrow + d0), b = *(const pg8::u32x2*)(qrow + d0 + 8);
              if (l31 >= 8) { a = (pg8::u32x2){0u, 0u}; b = a; }
              qn[s_] = __builtin_bit_cast(bf16x8v, (pg8::u32x4){a.x, a.y, b.x, b.y});
              pg8::u32x4 e = *(const pg8::u32x4*)(qrow + NOPE + 16 * s_ + 8 * h5); if (l31 >= 8) e = (pg8::u32x4){0u, 0u, 0u, 0u};
              qp[s_] = __builtin_bit_cast(bf16x8v, e); } }
        for (int pi = 0; pi < NPAGES / 2; ++pi) {
            const int pg = __builtin_amdgcn_readfirstlane(c.page_table[s * NPAGES + hf * (NPAGES / 2) + pi]);
            __syncthreads();
            { const char* src = (const char*)(ckv + (size_t)pg * PAGE * KVL); int tid = tid_; asm volatile("" : "+v"(tid));
              pg8::f32x4 v[16];
#pragma unroll
              for (int k = 0; k < 16; ++k) v[k] = *(const pg8::f32x4*)(src + (size_t)k * 8192 + (unsigned)tid * 16u);
#pragma unroll
              for (int k = 0; k < 16; ++k) { pg8::u32x2 o; o.x = pk2bf(v[k][0], v[k][1]); o.y = pk2bf(v[k][2], v[k][3]);
                  *(LDSP pg8::u32x2*)(lds + SD_CIMG + ((tid >> 6) + 8 * k) * SD_CROW + (tid & 63) * 8) = o; } }
#if defined(PROBE_DUP) && (PROBE_DUP & (1 << 20))
            { const char* src = (const char*)(ckv + (size_t)pg * PAGE * KVL); int tid = tid_; asm volatile("" : "+v"(tid));
              pg8::f32x4 v[16];
#pragma unroll
              for (int k = 0; k < 16; ++k) v[k] = *(const pg8::f32x4*)(src + (size_t)k * 8192 + (unsigned)tid * 16u);
#pragma unroll
              for (int k = 0; k < 16; ++k) { pg8::u32x2 o; o.x = pk2bf(v[k][0], v[k][1]); o.y = pk2bf(v[k][2], v[k][3]);
                  *(LDSP pg8::u32x2*)(lds + SD_CIMG + ((tid >> 6) + 8 * k) * SD_CROW + (tid & 63) * 8) = o; } }
#endif
            SD_WLOAD(0, 0);
            bf16x8v kpfr[2];
            if (dh == 0) {
#pragma unroll
                for (int s_ = 0; s_ < 2; ++s_) { const float* kp = kpe + ((size_t)pg * PAGE + 32 * kb + l31) * ROPE + 16 * s_ + 8 * h5; const pg8::f32x4 a = *(const pg8::f32x4*)kp, b = *(const pg8::f32x4*)(kp + 4);
                    kpfr[s_] = __builtin_bit_cast(bf16x8v, (pg8::u32x4){pk2bf(a[0], a[1]), pk2bf(a[2], a[3]), pk2bf(b[0], b[1]), pk2bf(b[2], b[3])}); }
            }
            asm volatile("s_waitcnt vmcnt(0)" ::: "memory");
            __syncthreads();
            bf16x8v cfr[16];
#pragma unroll
            for (int s_ = 0; s_ < 16; ++s_) cfr[s_] = *(const LDSP bf16x8v*)(lds + SD_CIMG + (32 * kb + l31) * SD_CROW + (16 * s_ + 8 * h5) * 2);
            sd_group<0>(fm, qs, s, lds, w, lane, l31, h5, kb, dh, cfr, kpfr, qn, qp, O, Lacc, B2);
            sd_group<1>(fm, qs, s, lds, w, lane, l31, h5, kb, dh, cfr, kpfr, qn, qp, O, Lacc, B2);
            sd_group<2>(fm, qs, s, lds, w, lane, l31, h5, kb, dh, cfr, kpfr, qn, qp, O, Lacc, B2);
            sd_group<3>(fm, qs, s, lds, w, lane, l31, h5, kb, dh, cfr, kpfr, qn, qp, O, Lacc, B2);
            __syncthreads();
            sd_pv(3, O[3], Lacc, lds, w, lane, l31, h5);
        }
        {float* op = opart + (size_t)it * (MH * DS) * KVL; int lo_ = lane; asm volatile("" : "+v"(lo_)); const int l31 = lo_ & 31, h5 = lo_ >> 5;
#pragma unroll
        for (int g = 0; g < 4; ++g)
#pragma unroll
            for (int r = 0; r < 16; ++r) op[(size_t)(32 * g + (r & 3) + 8 * (r >> 2) + 4 * h5) * KVL + 32 * w + l31] = O[g][r];
        __syncthreads();
        LDSP float* ltab = (LDSP float*)(lds + SD_XCH);
        if (l31 < 4) {
#pragma unroll
            for (int r = 0; r < 16; ++r) ltab[w * 128 + l31 * 32 + (r & 3) + 8 * (r >> 2) + 4 * h5] = Lacc[r];
        }
        __syncthreads();
        if (tid < 128) { float a = 0.f;
#pragma unroll
            for (int ww = 0; ww < 8; ++ww) a += ltab[ww * 128 + tid];
            lpart[(size_t)it * 128 + tid] = a; }
        }
    }
}

__device__ __forceinline__ void mla_sample_combine(const Ctx& c, const FastMla& fm, const float* __restrict__ opart, const float* __restrict__ lpart, int j, LDSP unsigned char* lds) {
    using namespace cfg;
    const int tid = (int)tid_now(), w = tid >> 6, lane = tid & 63, gw = blockIdx.x * 8 + w, ngw = gridDim.x * 8;
    const float B2 = mla_b2_bound(c, j, lane);
    LDSP float* ol = (LDSP float*)(lds + w * 8704); LDSP float* ptab = ol + 8 * KVL; LDSP float* lt = ptab + 64;
    const float* wuv = c.in[I_WUV] + (size_t)j * KVL * MH * VD;
    for (int item = gw; item < DB * MH; item += ngw) {
        const int s = item / MH, h = item % MH, q = lane >> 3, jn = lane & 7;
        const size_t rq = (size_t)MP + s * DS + q, rk = (size_t)MP + s * DS + jn;
        const bf16_t* qv = fm.qf + rq * (MH * QD) + h * QD; const bf16_t* kn = fm.knb + rk * (MH * NOPE) + h * NOPE; const bf16_t* kp = fm.kpb + rk * ROPE;
        float sc = 0.f;
#pragma unroll
        for (int d8 = 0; d8 < QD / 8; ++d8) { const pg8::u32x4 a = *(const pg8::u32x4*)(qv + 8 * d8), b = d8 < NOPE / 8 ? *(const pg8::u32x4*)(kn + 8 * d8) : *(const pg8::u32x4*)(kp + 8 * (d8 - NOPE / 8));
            const unsigned aw[4] = {a.x, a.y, a.z, a.w}, bw[4] = {b.x, b.y, b.z, b.w};
#pragma unroll
            for (int e = 0; e < 4; ++e) sc += __uint_as_float(aw[e] << 16) * __uint_as_float(bw[e] << 16) + __uint_as_float(aw[e] & 0xffff0000u) * __uint_as_float(bw[e] & 0xffff0000u); }
        const float p = jn <= q ? exp2f(sc - B2) : 0.f;
        float ls = p; ls += __shfl_xor(ls, 1); ls += __shfl_xor(ls, 2); ls += __shfl_xor(ls, 4);
        ptab[lane] = p;
        if (jn == 0) lt[q] = ls + lpart[(size_t)(2 * s) * 128 + h * DS + q] + lpart[(size_t)(2 * s + 1) * 128 + h * DS + q];
        asm volatile("s_waitcnt lgkmcnt(0)" ::: "memory");
        float cn[DS][4];
#pragma unroll
        for (int jj = 0; jj < DS; ++jj)
#pragma unroll
            for (int k = 0; k < 4; ++k) cn[jj][k] = bf2f(fm.cb[((size_t)MP + s * DS + jj) * KVL + lane + 64 * k]);
#pragma unroll
        for (int qq = 0; qq < DS; ++qq)
#pragma unroll
            for (int k = 0; k < 4; ++k) { const int r = lane + 64 * k;
                float a = opart[((size_t)(2 * s) * 128 + h * DS + qq) * KVL + r] + opart[((size_t)(2 * s + 1) * 128 + h * DS + qq) * KVL + r];
#pragma unroll
                for (int jj = 0; jj < DS; ++jj) a += ptab[qq * 8 + jj] * cn[jj][k];
                ol[qq * KVL + r] = a; }
        asm volatile("s_waitcnt lgkmcnt(0)" ::: "memory");
        float acc[DS];
#pragma unroll
        for (int qq = 0; qq < DS; ++qq) acc[qq] = 0.f;
        for (int r = 0; r < KVL; ++r) { const float wv = wuv[((size_t)r * MH + h) * VD + lane];
#pragma unroll
            for (int qq = 0; qq < DS; ++qq) acc[qq] += ol[qq * KVL + r] * wv; }
#pragma unroll
        for (int qq = 0; qq < DS; ++qq) fm.aob[((size_t)MP + s * DS + qq) * (MH * VD) + h * VD + lane] = (bf16_t)(pk2bf(acc[qq] / lt[qq], 0.f) & 0xffffu);
        asm volatile("s_waitcnt lgkmcnt(0)" ::: "memory");
    }
}
struct FastRw {
    bf16_t* xm;
    bf16_t* rkv;
    bf16_t* hb;
    bf16_t* lu;
    float* vf;
    float* ops;
    bf16_t* yo;
    bf16_t *wrkvt, *lorat, *wot;
};
constexpr int RW_REC = 464;
constexpr int RW_CH = 32;
constexpr int RW_BUF = RW_CH * RW_REC * 4;
struct RwSel { __device__ static __forceinline__ int sel(int pn) { return pn < 12 ? (pn >> 2) : (pn == 15 ? 2 : pn - 9); } };

__device__ __forceinline__ void rw_mix_fast(const Ctx& c, const FastRw& fr, int l, int gw, int ngw, int lane) {
    using namespace cfg; const int j = l / 3;
    const float* gain = c.in[I_NMIX] + l * D;
    for (int m = gw; m < MTOT; m += ngw) {
        const int t = row_t(m), sq = row_seq(m);
        pg8::f32x4 xc[4], xp[4], gv[4]; float s = 0.f, sp = 0.f;
#pragma unroll
        for (int q = 0; q < 4; ++q) { gv[q] = *(const pg8::f32x4*)(gain + 4 * lane + 256 * q); xc[q] = *(const pg8::f32x4*)(c.x + (size_t)m * D + 4 * lane + 256 * q);
            s += (xc[q][0] * xc[q][0] + xc[q][1] * xc[q][1]) + (xc[q][2] * xc[q][2] + xc[q][3] * xc[q][3]); }
        if (t > 0) {
#pragma unroll
            for (int q = 0; q < 4; ++q) { xp[q] = *(const pg8::f32x4*)(c.x + (size_t)(m - 1) * D + 4 * lane + 256 * q); sp += (xp[q][0] * xp[q][0] + xp[q][1] * xp[q][1]) + (xp[q][2] * xp[q][2] + xp[q][3] * xp[q][3]); }
        }
        const float rs = 1.0f / sqrtf(wave_sum64(s) * (1.0f / D) + NORM_EPS), rsp = 1.0f / sqrtf(wave_sum64(sp) * (1.0f / D) + NORM_EPS);
#pragma unroll
        for (int q = 0; q < 4; ++q) {
#pragma unroll
            for (int e = 0; e < 4; ++e) xc[q][e] = xc[q][e] * rs * gv[q][e];
            if (t > 0) {
#pragma unroll
                for (int e = 0; e < 4; ++e) xp[q][e] = xp[q][e] * rsp * gv[q][e];
            } else if (sq < BATCH) xp[q] = (pg8::f32x4){0.f, 0.f, 0.f, 0.f};
            else xp[q] = *(const pg8::f32x4*)(c.in[I_SHIFT] + ((size_t)j * DB + (sq - BATCH)) * D + 4 * lane + 256 * q);
        }
        if (t == seq_len(sq) - 1) {
            float* so = sq < BATCH ? c.out + O_SHP + ((size_t)j * BATCH + sq) * D : c.out + O_SHS + ((size_t)j * DB + (sq - BATCH)) * D;
#pragma unroll
            for (int q = 0; q < 4; ++q) *(pg8::f32x4*)(so + 4 * lane + 256 * q) = xc[q];
        }
#pragma unroll
        for (int p = 0; p < 6; ++p)
#pragma unroll
            for (int q = 0; q < 4; ++q) { const pg8::f32x4 mu = *(const pg8::f32x4*)(c.in[I_MU] + ((size_t)j * 6 + p) * D + 4 * lane + 256 * q);
                pg8::u32x2 o; o.x = pk2bf(xc[q][0] + (xp[q][0] - xc[q][0]) * mu[0], xc[q][1] + (xp[q][1] - xc[q][1]) * mu[1]); o.y = pk2bf(xc[q][2] + (xp[q][2] - xc[q][2]) * mu[2], xc[q][3] + (xp[q][3] - xc[q][3]) * mu[3]);
                *(pg8::u32x2*)(fr.xm + ((size_t)p * MTOT + m) * D + 4 * lane + 256 * q) = o; }
        if (lane < 32) *(unsigned*)(fr.hb + (size_t)m * 384 + 320 + 2 * lane) = 0u;
    }
}
struct EpiRwkv {
    static constexpr bool PERM = true;
    bf16_t* rkv; bf16_t* hb;
    __device__ __forceinline__ void operator()(const pg8::f32x4 (&acc)[2][2][4][2], const pg8::Unit& u, int wr, int wc, int fr, int fq) const {
        using namespace pg8;
        const int row0 = u.pm * BM + wr * 64 + fr, cl0 = wc * 32 + 8 * fq;
        const int pn = u.pn;
        bf16_t* base; int ldc, coff, nvalid, act = 0;
        if (pn < 12) { base = rkv; ldc = 3072; coff = pn * 256; nvalid = 256; }
        else { base = hb; ldc = 384; if (pn == 12) { coff = 0; nvalid = 64; act = 1; } else if (pn == 13) { coff = 64; nvalid = 64; } else if (pn == 14) { coff = 128; nvalid = 160; act = 2; } else { coff = 288; nvalid = 32; } }
#pragma unroll
        for (int ai = 0; ai < 2; ++ai)
#pragma unroll
            for (int m = 0; m < 4; ++m) { bf16_t* rowp = base + (size_t)(row0 + ai * HALF + m * 16) * ldc + coff;
#pragma unroll
                for (int bj = 0; bj < 2; ++bj) { const int cl = cl0 + bj * HALF; if (cl >= nvalid) continue;
                    f32x4 v0 = acc[ai][bj][m][0], v1 = acc[ai][bj][m][1];
                    if (act == 1) {
#pragma unroll
                        for (int e = 0; e < 4; ++e) { v0[e] = tanhf(v0[e]); v1[e] = tanhf(v1[e]); } }
                    else if (act == 2) {
#pragma unroll
                        for (int e = 0; e < 4; ++e) { v0[e] = 1.0f / (1.0f + __expf(-v0[e])); v1[e] = 1.0f / (1.0f + __expf(-v1[e])); } }
                    u32x4 w; w.x = cvt_pk_bf16(v0[0], v0[1]); w.y = cvt_pk_bf16(v0[2], v0[3]); w.z = cvt_pk_bf16(v1[0], v1[1]); w.w = cvt_pk_bf16(v1[2], v1[3]);
                    *(u32x4*)(rowp + cl) = w; } }
    }
};
__device__ __forceinline__ void rw_build_lorat(const Ctx& c, bf16_t* lorat, int j, size_t gtid, size_t gsz) {
    using namespace cfg;
    for (size_t i = gtid; i < (size_t)4096 * 384; i += gsz) {
        const int n = (int)(i / 384), k = (int)(i % 384), grp = n >> 10, ch = n & 1023; float v = 0.f;
        if (grp == 0 && k < 64) v = c.in[I_W2][((size_t)j * RW_DL + k) * D + ch];
        else if (grp == 1 && k >= 64 && k < 128) v = c.in[I_A2][((size_t)j * RW_AL + (k - 64)) * D + ch];
        else if (grp == 2 && k >= 128 && k < 288) v = c.in[I_G2][((size_t)j * RW_GL + (k - 128)) * D + ch];
        else if (grp == 3 && k >= 288 && k < 320 && j > 0) v = c.in[I_V2][((size_t)(j - 1) * RW_VL + (k - 288)) * D + ch];
        lorat[i] = (bf16_t)(pk2bf(v, 0.f) & 0xffffu);
    }
}
__device__ __forceinline__ size_t rw_rec_base(int sq, int h) {
    using namespace cfg;
    return sq < BATCH ? ((size_t)sq * RHEADS + h) * SEQ : (size_t)MP * RHEADS + ((size_t)(sq - BATCH) * RHEADS + h) * DS;
}
__device__ __forceinline__ void rw_prep_fast(const Ctx& c, const FastRw& fr, int l, int gw, int ngw, int lane) {
    using namespace cfg; const int j = l / 3;
    for (int it = gw; it < MTOT * RHEADS; it += ngw) {
        const int m = it / RHEADS, h = it % RHEADS, ch = h * RH + lane;
        const bf16_t* rk = fr.rkv + (size_t)m * 3072 + ch; const bf16_t* lu = fr.lu + (size_t)m * 4096 + ch;
        const float r = bf2f(rk[0]), k0 = bf2f(rk[1024]); float v = bf2f(rk[2048]);
        const float wpre = bf2f(lu[0]), apre = bf2f(lu[1024]), gg = bf2f(lu[2048]), vpre = bf2f(lu[3072]);
        const float wl = -softplusf_(-(c.in[I_W0][j * D + ch] + wpre)) - 0.5f;
        const float w = expf(-expf(wl));
        if (j == 0) fr.vf[(size_t)m * D + ch] = v;
        else v = v + (fr.vf[(size_t)m * D + ch] - v) * sigmoidf_(c.in[I_V0][(j - 1) * D + ch] + vpre);
        const float a = sigmoidf_(c.in[I_A0][j * D + ch] + apre);
        float kk = k0 * c.in[I_KK][j * D + ch];
        const float nn = wave_sum64(kk * kk);
        kk *= 1.0f / fmaxf(sqrtf(nn), 1e-12f);
        const float k2 = k0 * (1.0f + (a - 1.0f) * c.in[I_KA][j * D + ch]);
        const float bo = kk * a;
        const float br = wave_sum64(bo * r), kr = wave_sum64(k2 * r), bonus = wave_sum64(r * k2 * c.in[I_RK][(size_t)j * D + ch]);
        const int sq = row_seq(m), t = row_t(m);
        float* rec = fr.ops + (rw_rec_base(sq, h) + t) * RW_REC;
        rec[lane] = -kk; rec[64 + lane] = w * r; rec[128 + lane] = w; rec[192 + lane] = bo; rec[256 + lane] = k2; rec[320 + lane] = v; rec[384 + lane] = gg;
        if (lane == 0) { rec[448] = br; rec[449] = kr; rec[450] = bonus; }
    }
}
template <int CTRL> __device__ __forceinline__ float dppf(float v) { return __int_as_float(__builtin_amdgcn_update_dpp(0, __float_as_int(v), CTRL, 0xF, 0xF, true)); }
__device__ __forceinline__ float red16(float x) { x += dppf<0xB1>(x); x += dppf<0x4E>(x); x += dppf<0x124>(x); x += dppf<0x128>(x); return x; }
__device__ __forceinline__ void rw_scan_fast(const Ctx& c, const FastRw& fr, int l, LDSP unsigned char* lds) {
    using namespace cfg; const int j = l / 3;
    const int tid = (int)tid_now(), w = __builtin_amdgcn_readfirstlane(tid >> 6), lane = tid & 63, cs = lane & 15, rp = 4 * w + (lane >> 4);
    LDSP float* ybuf = (LDSP float*)(lds + 2 * RW_BUF);
    for (int chain = blockIdx.x; chain < NSEQ * RHEADS; chain += gridDim.x) {
        const int sq = chain / RHEADS, h = chain % RHEADS, T = seq_len(sq), m0 = seq_row0(sq);
        const char* src = (const char*)(fr.ops + rw_rec_base(sq, h) * RW_REC);
        pg8::f32x4 S0, S1;
        if (sq < BATCH) { S0 = (pg8::f32x4){0.f, 0.f, 0.f, 0.f}; S1 = S0; }
        else { const float* s0 = c.in[I_WKV] + ((((size_t)j * DB + (sq - BATCH)) * RHEADS + h) * RH + 2 * rp) * RH + 4 * cs; S0 = *(const pg8::f32x4*)s0; S1 = *(const pg8::f32x4*)(s0 + RH); }
        const int nch = (T + RW_CH - 1) / RW_CH;
#define RW_DMA(n, buf) do { const int nb_ = ((T - (n) * RW_CH < RW_CH ? T - (n) * RW_CH : RW_CH) * RW_REC * 4 + 1023) >> 10; \
            for (int q_ = w; q_ < nb_; q_ += 8) __builtin_amdgcn_global_load_lds((const unsigned*)(src + (size_t)(n) * RW_BUF + (size_t)q_ * 1024 + (unsigned)lane * 16u), (LDSP unsigned*)(lds + (buf) * RW_BUF + q_ * 1024), 16, 0, 0); } while (0)
        __syncthreads();
        RW_DMA(0, 0);
        asm volatile("s_waitcnt vmcnt(0)" ::: "memory");
        __syncthreads();
        for (int n = 0; n < nch; ++n) {
            if (n + 1 < nch) RW_DMA(n + 1, (n + 1) & 1);
            const int tn = T - n * RW_CH < RW_CH ? T - n * RW_CH : RW_CH;
            const LDSP unsigned char* bufp = lds + (n & 1) * RW_BUF;
            for (int t = 0; t < tn; ++t) {
                const LDSP unsigned char* rec = bufp + t * (RW_REC * 4);
                const pg8::f32x4 A = *(const LDSP pg8::f32x4*)(rec + cs * 16), WR = *(const LDSP pg8::f32x4*)(rec + 256 + cs * 16), W = *(const LDSP pg8::f32x4*)(rec + 512 + cs * 16),
                                 B = *(const LDSP pg8::f32x4*)(rec + 768 + cs * 16), K = *(const LDSP pg8::f32x4*)(rec + 1024 + cs * 16);
                const pg8::f32x2 V2 = *(const LDSP pg8::f32x2*)(rec + 1280 + rp * 8), SC = *(const LDSP pg8::f32x2*)(rec + 1792);
                float sa0 = (S0[0] * A[0] + S0[1] * A[1]) + (S0[2] * A[2] + S0[3] * A[3]), y0 = (S0[0] * WR[0] + S0[1] * WR[1]) + (S0[2] * WR[2] + S0[3] * WR[3]);
                float sa1 = (S1[0] * A[0] + S1[1] * A[1]) + (S1[2] * A[2] + S1[3] * A[3]), y1 = (S1[0] * WR[0] + S1[1] * WR[1]) + (S1[2] * WR[2] + S1[3] * WR[3]);
                sa0 = red16(sa0); sa1 = red16(sa1); y0 = red16(y0); y1 = red16(y1);
                S0 = S0 * W + sa0 * B + V2[0] * K; S1 = S1 * W + sa1 * B + V2[1] * K;
                if (cs == 0) *(LDSP pg8::f32x2*)(ybuf + t * RH + 2 * rp) = (pg8::f32x2){y0 + sa0 * SC[0] + V2[0] * SC[1], y1 + sa1 * SC[0] + V2[1] * SC[1]};
            }
            asm volatile("s_waitcnt vmcnt(0)" ::: "memory");
            __syncthreads();
            for (int t = w; t < tn; t += 8) {
                const LDSP float* rec = (const LDSP float*)(bufp + t * (RW_REC * 4));
                const float y = ybuf[t * RH + lane], mean = wave_sum64(y) * (1.0f / RH), d = y - mean, var = wave_sum64(d * d) * (1.0f / RH);
                const int ch = h * RH + lane;
                const float yn = d * (1.0f / sqrtf(var + LNX_EPS)) * c.in[I_LNW][j * D + ch] + c.in[I_LNB][j * D + ch];
                const float o = (yn + rec[450] * rec[320 + lane]) * rec[384 + lane];
                fr.yo[(size_t)(m0 + n * RW_CH + t) * D + ch] = (bf16_t)(pk2bf(o, 0.f) & 0xffffu);
            }
            __syncthreads();
        }
#undef RW_DMA
        float* so = (sq < BATCH ? c.out + O_WKVP + (((size_t)j * BATCH + sq) * RHEADS + h) * RH * RH : c.out + O_WKVS + (((size_t)j * DB + (sq - BATCH)) * RHEADS + h) * RH * RH) + (size_t)(2 * rp) * RH + 4 * cs;
        *(pg8::f32x4*)so = S0; *(pg8::f32x4*)(so + RH) = S1;
    }
}
__device__ __forceinline__ float fsigmoid(float x) { return __builtin_amdgcn_rcpf(1.0f + __expf(-x)); }
__device__ __forceinline__ float fsoftplus(float x) { return x > 20.f ? x : __logf(1.0f + __expf(x)); }
__device__ __forceinline__ float rdl(float v, int l) { return __int_as_float(__builtin_amdgcn_readlane(__float_as_int(v), l)); }
__device__ __forceinline__ float wsum_dpp(float x) {
    x = red16(x);
    return (rdl(x, 0) + rdl(x, 16)) + (rdl(x, 32) + rdl(x, 48));
}

__device__ __forceinline__ void red16x4(float& a, float& b, float& c, float& d) {
    asm volatile("s_nop 1\n"
        "v_add_f32_dpp %0, %0, %0 quad_perm:[1,0,3,2] row_mask:0xf bank_mask:0xf\n" "v_add_f32_dpp %1, %1, %1 quad_perm:[1,0,3,2] row_mask:0xf bank_mask:0xf\n"
        "v_add_f32_dpp %2, %2, %2 quad_perm:[1,0,3,2] row_mask:0xf bank_mask:0xf\n" "v_add_f32_dpp %3, %3, %3 quad_perm:[1,0,3,2] row_mask:0xf bank_mask:0xf\n"
        "v_add_f32_dpp %0, %0, %0 quad_perm:[2,3,0,1] row_mask:0xf bank_mask:0xf\n" "v_add_f32_dpp %1, %1, %1 quad_perm:[2,3,0,1] row_mask:0xf bank_mask:0xf\n"
        "v_add_f32_dpp %2, %2, %2 quad_perm:[2,3,0,1] row_mask:0xf bank_mask:0xf\n" "v_add_f32_dpp %3, %3, %3 quad_perm:[2,3,0,1] row_mask:0xf bank_mask:0xf\n"
        "v_add_f32_dpp %0, %0, %0 row_ror:4 row_mask:0xf bank_mask:0xf\n" "v_add_f32_dpp %1, %1, %1 row_ror:4 row_mask:0xf bank_mask:0xf\n"
        "v_add_f32_dpp %2, %2, %2 row_ror:4 row_mask:0xf bank_mask:0xf\n" "v_add_f32_dpp %3, %3, %3 row_ror:4 row_mask:0xf bank_mask:0xf\n"
        "v_add_f32_dpp %0, %0, %0 row_ror:8 row_mask:0xf bank_mask:0xf\n" "v_add_f32_dpp %1, %1, %1 row_ror:8 row_mask:0xf bank_mask:0xf\n"
        "v_add_f32_dpp %2, %2, %2 row_ror:8 row_mask:0xf bank_mask:0xf\n" "v_add_f32_dpp %3, %3, %3 row_ror:8 row_mask:0xf bank_mask:0xf\n"
        "s_nop 1"
        : "+v"(a), "+v"(b), "+v"(c), "+v"(d));
}
struct RwOp { pg8::f32x4 A, WR, W, B, K; pg8::f32x2 V2, SC; };
__device__ __forceinline__ void rw_ldop(RwOp& o, const LDSP unsigned char* rec, int cs, int rp) {
    o.A = *(const LDSP pg8::f32x4*)(rec + cs * 16); o.WR = *(const LDSP pg8::f32x4*)(rec + 256 + cs * 16); o.W = *(const LDSP pg8::f32x4*)(rec + 512 + cs * 16);
    o.B = *(const LDSP pg8::f32x4*)(rec + 768 + cs * 16); o.K = *(const LDSP pg8::f32x4*)(rec + 1024 + cs * 16);
    o.V2 = *(const LDSP pg8::f32x2*)(rec + 1280 + rp * 8); o.SC = *(const LDSP pg8::f32x2*)(rec + 1792);
}
__device__ __forceinline__ float fma_s(float a, float b, float c) { float d; asm("v_fma_f32 %0, %1, %2, %3" : "=v"(d) : "v"(a), "v"(b), "v"(c)); return d; }
__device__ __forceinline__ float mul_s(float a, float b) { float d; asm("v_mul_f32 %0, %1, %2" : "=v"(d) : "v"(a), "v"(b)); return d; }
__device__ __forceinline__ void rw_step(pg8::f32x4& S0, pg8::f32x4& S1, const RwOp& o, LDSP float* yrow, bool wr) {
    float sa0 = fma_s(S0[3], o.A[3], fma_s(S0[2], o.A[2], fma_s(S0[1], o.A[1], mul_s(S0[0], o.A[0]))));
    float sa1 = fma_s(S1[3], o.A[3], fma_s(S1[2], o.A[2], fma_s(S1[1], o.A[1], mul_s(S1[0], o.A[0]))));
    float y0 = fma_s(S0[3], o.WR[3], fma_s(S0[2], o.WR[2], fma_s(S0[1], o.WR[1], mul_s(S0[0], o.WR[0]))));
    float y1 = fma_s(S1[3], o.WR[3], fma_s(S1[2], o.WR[2], fma_s(S1[1], o.WR[1], mul_s(S1[0], o.WR[0]))));
    float t0[4], t1[4];
#pragma unroll
    for (int e = 0; e < 4; ++e) { t0[e] = fma_s(o.K[e], o.V2[0], mul_s(S0[e], o.W[e])); t1[e] = fma_s(o.K[e], o.V2[1], mul_s(S1[e], o.W[e])); }
    red16x4(sa0, sa1, y0, y1);
#pragma unroll
    for (int e = 0; e < 4; ++e) { S0[e] = fma_s(o.B[e], sa0, t0[e]); S1[e] = fma_s(o.B[e], sa1, t1[e]); }
    if (wr) *(LDSP pg8::f32x2*)yrow = (pg8::f32x2){fma_s(o.V2[0], o.SC[1], fma_s(sa0, o.SC[0], y0)), fma_s(o.V2[1], o.SC[1], fma_s(sa1, o.SC[0], y1))};
}
struct RwIn { unsigned short r, k, v, wp, ap, g, vp; float vf; };
template <int J>
__device__ __forceinline__ void rw_scan_fused(const Ctx& c, const FastRw& fr, LDSP unsigned char* lds) {
    using namespace cfg; constexpr int j = J;
    const int tid = (int)tid_now(), w = __builtin_amdgcn_readfirstlane(tid >> 6), lane = tid & 63, cs = lane & 15, rp = 4 * w + (lane >> 4);
    LDSP float* ybuf = (LDSP float*)(lds + 2 * RW_BUF);
    for (int chain = blockIdx.x; chain < NSEQ * RHEADS; chain += gridDim.x) {
        const int sq = chain / RHEADS, h = chain % RHEADS, T = seq_len(sq), m0 = seq_row0(sq), ch = h * RH + lane;
        const float p_w0 = c.in[I_W0][j * D + ch], p_a0 = c.in[I_A0][j * D + ch], p_kk = c.in[I_KK][j * D + ch], p_ka = c.in[I_KA][j * D + ch], p_rk = c.in[I_RK][(size_t)j * D + ch],
                    p_lnw = c.in[I_LNW][j * D + ch], p_lnb = c.in[I_LNB][j * D + ch], p_v0 = j > 0 ? c.in[I_V0][(j - 1) * D + ch] : 0.f;
        pg8::f32x4 S0, S1;
        if (sq < BATCH) { S0 = (pg8::f32x4){0.f, 0.f, 0.f, 0.f}; S1 = S0; }
        else { const float* s0 = c.in[I_WKV] + ((((size_t)j * DB + (sq - BATCH)) * RHEADS + h) * RH + 2 * rp) * RH + 4 * cs; S0 = *(const pg8::f32x4*)s0; S1 = *(const pg8::f32x4*)(s0 + RH); }
        const int nch = (T + RW_CH - 1) / RW_CH;
        RwIn in[4];
#define RW_LOADIN(n) do { _Pragma("unroll") for (int q = 0; q < 4; ++q) { const int t_ = (n) * RW_CH + 4 * w + q; if (t_ < T) { const size_t m_ = (size_t)(m0 + t_); \
                const bf16_t* rk_ = fr.rkv + m_ * 3072 + ch; const bf16_t* lu_ = fr.lu + m_ * 4096 + ch; \
                in[q].r = rk_[0]; in[q].k = rk_[1024]; in[q].v = rk_[2048]; in[q].wp = lu_[0]; in[q].ap = lu_[1024]; in[q].g = lu_[2048]; in[q].vp = lu_[3072]; \
                in[q].vf = j > 0 ? fr.vf[m_ * D + ch] : 0.f; } } } while (0)
#define RW_PREP(n, buf) do { _Pragma("unroll") for (int q = 0; q < 4; ++q) { const int tl_ = 4 * w + q, t_ = (n) * RW_CH + tl_; if (t_ < T) { \
                const float r_ = bf2f(in[q].r), k0_ = bf2f(in[q].k); float v_ = bf2f(in[q].v); \
                const float wl_ = -fsoftplus(-(p_w0 + bf2f(in[q].wp))) - 0.5f, w_ = __expf(-__expf(wl_)); \
                if (j == 0) fr.vf[(size_t)(m0 + t_) * D + ch] = v_; else v_ = v_ + (in[q].vf - v_) * fsigmoid(p_v0 + bf2f(in[q].vp)); \
                const float a_ = fsigmoid(p_a0 + bf2f(in[q].ap)); float kk_ = k0_ * p_kk; \
                const float k2_ = k0_ * (1.0f + (a_ - 1.0f) * p_ka); \
                float n_ = red16(kk_ * kk_), e1_ = red16(r_ * k2_ * p_rk), e2_ = red16(k2_ * r_); \
                n_ = (rdl(n_, 0) + rdl(n_, 16)) + (rdl(n_, 32) + rdl(n_, 48)); e1_ = (rdl(e1_, 0) + rdl(e1_, 16)) + (rdl(e1_, 32) + rdl(e1_, 48)); e2_ = (rdl(e2_, 0) + rdl(e2_, 16)) + (rdl(e2_, 32) + rdl(e2_, 48)); \
                kk_ *= __builtin_amdgcn_rcpf(fmaxf(__builtin_amdgcn_sqrtf(n_), 1e-12f)); const float bo_ = kk_ * a_; const float e3_ = wsum_dpp(bo_ * r_); \
                LDSP float* rec_ = (LDSP float*)(lds + (buf) * RW_BUF + tl_ * (RW_REC * 4)); \
                rec_[lane] = -kk_; rec_[64 + lane] = w_ * r_; rec_[128 + lane] = w_; rec_[192 + lane] = bo_; rec_[256 + lane] = k2_; rec_[320 + lane] = v_; rec_[384 + lane] = bf2f(in[q].g); \
                if (lane == 0) { rec_[448] = e3_; rec_[449] = e2_; rec_[450] = e1_; } } } } while (0)
        __syncthreads();
        RW_LOADIN(0); RW_PREP(0, 0);
        __syncthreads();
        for (int n = 0; n < nch; ++n) {
            if (n + 1 < nch) RW_LOADIN(n + 1);
            const int tn = T - n * RW_CH < RW_CH ? T - n * RW_CH : RW_CH;
            const LDSP unsigned char* bufp = lds + (n & 1) * RW_BUF;
#if defined(PROBE_DUP) && (PROBE_DUP & (1 << 17))
            { RwOp o0, o1; rw_ldop(o0, bufp, cs, rp); pg8::f32x4 T0 = S0, T1 = S1;
              for (int t = 0; t < tn; t += 2) {
                  rw_ldop(o1, bufp + (t + 1) * (RW_REC * 4), cs, rp);
                  rw_step(T0, T1, o0, ybuf + t * RH + 2 * rp, cs == 0);
                  rw_ldop(o0, bufp + (t + 2 < tn ? t + 2 : t) * (RW_REC * 4), cs, rp);
                  rw_step(T0, T1, o1, ybuf + (t + 1) * RH + 2 * rp, cs == 0);
              } asm volatile("" :: "v"(T0), "v"(T1)); }
#endif
            { RwOp o0, o1; rw_ldop(o0, bufp, cs, rp);
              for (int t = 0; t < tn; t += 2) {
                  rw_ldop(o1, bufp + (t + 1) * (RW_REC * 4), cs, rp);
                  rw_step(S0, S1, o0, ybuf + t * RH + 2 * rp, cs == 0);
                  rw_ldop(o0, bufp + (t + 2 < tn ? t + 2 : t) * (RW_REC * 4), cs, rp);
                  rw_step(S0, S1, o1, ybuf + (t + 1) * RH + 2 * rp, cs == 0);
              } }
            if (n + 1 < nch) RW_PREP(n + 1, (n + 1) & 1);
#if defined(PROBE_DUP) && (PROBE_DUP & (1 << 18))
            if (n + 1 < nch) RW_PREP(n + 1, (n + 1) & 1);
#endif
            __syncthreads();
            for (int t = w; t < tn; t += 8) {
                const LDSP float* rec = (const LDSP float*)(bufp + t * (RW_REC * 4));
                const float y = ybuf[t * RH + lane], mean = wsum_dpp(y) * (1.0f / RH), d = y - mean, var = wsum_dpp(d * d) * (1.0f / RH);
                const float yn = d * __builtin_amdgcn_rsqf(var + LNX_EPS) * p_lnw + p_lnb;
                const float o = (yn + rec[450] * rec[320 + lane]) * rec[384 + lane];
                fr.yo[(size_t)(m0 + n * RW_CH + t) * D + ch] = (bf16_t)(pk2bf(o, 0.f) & 0xffffu);
            }
            __syncthreads();
        }
#undef RW_LOADIN
#undef RW_PREP
        float* so = (sq < BATCH ? c.out + O_WKVP + (((size_t)j * BATCH + sq) * RHEADS + h) * RH * RH : c.out + O_WKVS + (((size_t)j * DB + (sq - BATCH)) * RHEADS + h) * RH * RH) + (size_t)(2 * rp) * RH + 4 * cs;
        *(pg8::f32x4*)so = S0; *(pg8::f32x4*)(so + RH) = S1;
    }
}
struct FastMb {
    bf16_t* zb;
    bf16_t* xbcr;
    float* dtraw;
    bf16_t* xbcb;
    float* dt;
    float* y;
    bf16_t* yzn;
    bf16_t *wbint, *wbot;
};
struct EpiMamba {
    static constexpr bool PERM = true;
    bf16_t* zb; bf16_t* xbcr; float* dtraw;
    __device__ __forceinline__ void operator()(const pg8::f32x4 (&acc)[2][2][4][2], const pg8::Unit& u, int wr, int wc, int fr, int fq) const {
        using namespace pg8;
        const int row0 = u.pm * BM + wr * 64 + fr, cl0 = wc * 32 + 8 * fq, pn = u.pn;
        if (pn < 20) {
            bf16_t* base = pn < 8 ? zb : xbcr; const int ldc = pn < 8 ? 2048 : 3072, coff = pn < 8 ? pn * 256 : (pn - 8) * 256;
#pragma unroll
            for (int ai = 0; ai < 2; ++ai)
#pragma unroll
                for (int m = 0; m < 4; ++m) { bf16_t* rowp = base + (size_t)(row0 + ai * HALF + m * 16) * ldc + coff + cl0;
#pragma unroll
                    for (int bj = 0; bj < 2; ++bj) { const f32x4 v0 = acc[ai][bj][m][0], v1 = acc[ai][bj][m][1];
                        u32x4 w; w.x = cvt_pk_bf16(v0[0], v0[1]); w.y = cvt_pk_bf16(v0[2], v0[3]); w.z = cvt_pk_bf16(v1[0], v1[1]); w.w = cvt_pk_bf16(v1[2], v1[3]);
                        *(u32x4*)(rowp + bj * HALF) = w; } }
        } else if (cl0 < 32) {
#pragma unroll
            for (int ai = 0; ai < 2; ++ai)
#pragma unroll
                for (int m = 0; m < 4; ++m) { float* rowp = dtraw + (size_t)(row0 + ai * HALF + m * 16) * 32 + cl0;
                    *(f32x4*)rowp = acc[ai][0][m][0]; *(f32x4*)(rowp + 4) = acc[ai][0][m][1]; }
        }
    }
};
__device__ __forceinline__ void mb_conv_fast(const Ctx& c, const FastMb& fb, int l, size_t gtid, size_t gsz, bool write_f32) {
    using namespace cfg; const int j = l / 3; constexpr int NB = MB_CD / 8, TB = 8;
    for (size_t i = gtid; i < (size_t)(MTOT / TB) * NB; i += gsz) {
        const int mb = (int)(i / NB) * TB, cb = (int)(i % NB) * 8, t0 = row_t(mb), sq = row_seq(mb), T = seq_len(sq);
        float wt[MB_CONV][8], bias[8], win[MB_CONV][8];
#pragma unroll
        for (int e = 0; e < 8; ++e) bias[e] = c.in[I_CONVB][j * MB_CD + cb + e];
#pragma unroll
        for (int jj = 0; jj < MB_CONV; ++jj)
#pragma unroll
            for (int e = 0; e < 8; ++e) wt[jj][e] = c.in[I_CONVW][((size_t)j * MB_CONV + jj) * MB_CD + cb + e];
#pragma unroll
        for (int jj = 0; jj < MB_CONV - 1; ++jj) {
            const int tt = t0 + jj - (MB_CONV - 1);
            if (tt >= 0) { const pg8::u32x4 raw = *(const pg8::u32x4*)(fb.xbcr + (size_t)(mb + jj - (MB_CONV - 1)) * MB_CD + cb); const unsigned wv[4] = {raw.x, raw.y, raw.z, raw.w};
#pragma unroll
                for (int q = 0; q < 4; ++q) { win[jj][2 * q] = __uint_as_float(wv[q] << 16); win[jj][2 * q + 1] = __uint_as_float(wv[q] & 0xffff0000u); } }
            else if (sq >= BATCH) { const float* st = c.in[I_CONV] + (((size_t)j * DB + (sq - BATCH)) * (MB_CONV - 1) + (tt + MB_CONV - 1)) * MB_CD + cb;
#pragma unroll
                for (int e = 0; e < 8; ++e) win[jj][e] = st[e]; }
            else {
#pragma unroll
                for (int e = 0; e < 8; ++e) win[jj][e] = 0.f; }
        }
#pragma unroll
        for (int tb = 0; tb < TB; ++tb) {
            const int m = mb + tb, t = t0 + tb;
            { const pg8::u32x4 raw = *(const pg8::u32x4*)(fb.xbcr + (size_t)m * MB_CD + cb); const unsigned wv[4] = {raw.x, raw.y, raw.z, raw.w};
#pragma unroll
              for (int q = 0; q < 4; ++q) { win[3][2 * q] = __uint_as_float(wv[q] << 16); win[3][2 * q + 1] = __uint_as_float(wv[q] & 0xffff0000u); } }
            if (t >= T - (MB_CONV - 1)) {
                float* so = (sq < BATCH ? c.out + O_CONVP + (((size_t)j * BATCH + sq) * (MB_CONV - 1) + (t - (T - (MB_CONV - 1)))) * MB_CD
                                        : c.out + O_CONVS + (((size_t)j * DB + (sq - BATCH)) * (MB_CONV - 1) + (t - (T - (MB_CONV - 1)))) * MB_CD) + cb;
#pragma unroll
                for (int e = 0; e < 8; ++e) so[e] = win[3][e];
            }
            unsigned w[4];
#pragma unroll
            for (int q = 0; q < 4; ++q) {
                float a0 = bias[2 * q], a1 = bias[2 * q + 1];
#pragma unroll
                for (int jj = 0; jj < MB_CONV; ++jj) { a0 += win[jj][2 * q] * wt[jj][2 * q]; a1 += win[jj][2 * q + 1] * wt[jj][2 * q + 1]; }
                a0 = a0 * __builtin_amdgcn_rcpf(1.0f + __expf(-a0)); a1 = a1 * __builtin_amdgcn_rcpf(1.0f + __expf(-a1));
                w[q] = pk2bf(a0, a1); if (write_f32) { c.xbc[(size_t)m * MB_CD + cb + 2 * q] = a0; c.xbc[(size_t)m * MB_CD + cb + 2 * q + 1] = a1; } }
            *(pg8::u32x4*)(fb.xbcb + (size_t)m * MB_CD + cb) = (pg8::u32x4){w[0], w[1], w[2], w[3]};
#pragma unroll
            for (int jj = 0; jj < MB_CONV - 1; ++jj)
#pragma unroll
                for (int e = 0; e < 8; ++e) win[jj][e] = win[jj + 1][e];
        }
    }
    for (size_t i = gtid; i < (size_t)MTOT * MB_HEADS; i += gsz) {
        const float v = softplusf_(fb.dtraw[i] + c.in[I_DTB][j * MB_HEADS + (int)(i % MB_HEADS)]);
        fb.dt[i] = v; if (write_f32) c.dt[i] = v;
    }
}
__device__ __forceinline__ void mb_gate_fast(const Ctx& c, const FastMb& fb, const float* __restrict__ y, int l, int gw, int ngw, int lane) {
    using namespace cfg; const int j = l / 3; constexpr int GW_ = MB_INNER / MB_GROUPS;
    for (int it = gw; it < MTOT * MB_GROUPS; it += ngw) {
        const int m = it / MB_GROUPS, g = it % MB_GROUPS; const size_t o = (size_t)m * MB_INNER + g * GW_ + 8 * lane;
        const pg8::f32x4 y0 = *(const pg8::f32x4*)(y + o), y1 = *(const pg8::f32x4*)(y + o + 4); const pg8::u32x4 zr = *(const pg8::u32x4*)(fb.zb + o);
        const unsigned zw[4] = {zr.x, zr.y, zr.z, zr.w}; float v[8]; float s = 0.f;
#pragma unroll
        for (int q = 0; q < 4; ++q) { const float z0 = __uint_as_float(zw[q] << 16), z1 = __uint_as_float(zw[q] & 0xffff0000u);
            v[2 * q] = (q < 2 ? y0[2 * q] : y1[2 * q - 4]) * siluf_(z0); v[2 * q + 1] = (q < 2 ? y0[2 * q + 1] : y1[2 * q - 3]) * siluf_(z1); s += v[2 * q] * v[2 * q] + v[2 * q + 1] * v[2 * q + 1]; }
        const float rs = 1.0f / sqrtf(wave_sum64(s) * (1.0f / GW_) + NORM_EPS);
        const float* nw = c.in[I_BNORM] + j * MB_INNER + g * GW_ + 8 * lane; unsigned w[4];
#pragma unroll
        for (int q = 0; q < 4; ++q) w[q] = pk2bf(v[2 * q] * rs * nw[2 * q], v[2 * q + 1] * rs * nw[2 * q + 1]);
        *(pg8::u32x4*)(fb.yzn + o) = (pg8::u32x4){w[0], w[1], w[2], w[3]};
    }
}
constexpr int SS_XR = 144, SS_BR = 272;
constexpr int SS_XIM = 0, SS_XSM = SS_XIM + 128 * SS_XR, SS_BIM = SS_XSM + 128 * SS_XR, SS_CIM = SS_BIM + 128 * SS_BR, SS_MTM = SS_CIM + 128 * SS_BR, SS_HBM = SS_MTM + 128 * SS_BR, SS_TAB = SS_HBM + 128 * SS_XR, SS_END = SS_TAB + 2048;
__device__ __forceinline__ bf16x8v ss_trfrag(const LDSP unsigned char* img, int rowstride, int k0, int col0, int lane) {
    const int r0 = k0 + 8 * (lane >> 5) + ((lane & 15) >> 2), cc = col0 + 16 * ((lane >> 4) & 1) + 4 * (lane & 3);
    const s16x4 t0 = __builtin_amdgcn_ds_read_tr16_b64_v4i16((LDSP s16x4*)(img + r0 * rowstride + cc * 2));
    const s16x4 t1 = __builtin_amdgcn_ds_read_tr16_b64_v4i16((LDSP s16x4*)(img + (r0 + 4) * rowstride + cc * 2));
    return (bf16x8v){t0[0], t0[1], t0[2], t0[3], t1[0], t1[1], t1[2], t1[3]};
}
__device__ __forceinline__ void mb_ssd_prompt(const Ctx& c, const FastMb& fb, int l, LDSP unsigned char* lds) {
    using namespace cfg; const int j = l / 3;
    const int tid = (int)tid_now(), w = __builtin_amdgcn_readfirstlane(tid >> 6), lane = tid & 63, l31 = lane & 31, h5 = lane >> 5;
    LDSP float* tab = (LDSP float*)(lds + SS_TAB);
    for (int chain = blockIdx.x; chain < BATCH * MB_HEADS; chain += gridDim.x) {
        const int b = chain / MB_HEADS, hd = chain % MB_HEADS, g = hd / (MB_HEADS / MB_GROUPS);
        const float Ah = -expf(c.in[I_ALOG][j * MB_HEADS + hd]), Dh = c.in[I_BD][j * MB_HEADS + hd];
        f32x16_t H;
#pragma unroll
        for (int r = 0; r < 16; ++r) H[r] = 0.f;
        pg8::u32x4 nx[2], nB[4], nC[4]; float ndt = 0.f;
#define SS_LOAD(ck_) do { const size_t mm_ = (size_t)b * SEQ + 128 * (ck_); int tq_ = tid; asm volatile("" : "+v"(tq_)); \
            _Pragma("unroll") for (int q = 0; q < 2; ++q) { const int ci = tq_ + 512 * q; nx[q] = *(const pg8::u32x4*)(fb.xbcb + (mm_ + (ci >> 3)) * MB_CD + hd * MB_HEAD + (ci & 7) * 8); } \
            _Pragma("unroll") for (int q = 0; q < 4; ++q) { const int ci = tq_ + 512 * q; const bf16_t* rowp = fb.xbcb + (mm_ + (ci >> 4)) * MB_CD + MB_INNER + g * MB_STATE + (ci & 15) * 8; \
                nB[q] = *(const pg8::u32x4*)rowp; nC[q] = *(const pg8::u32x4*)(rowp + MB_GN); } \
            if (tq_ < 128) ndt = fb.dt[(mm_ + tq_) * MB_HEADS + hd]; } while (0)
        SS_LOAD(0);
        for (int ck = 0; ck < SEQ / 128; ++ck) {
            const size_t m0 = (size_t)b * SEQ + 128 * ck;
            int tl = tid; asm volatile("" : "+v"(tl));
            pg8::u32x4 xr[2];
#pragma unroll
            for (int q = 0; q < 2; ++q) { const int ci = tl + 512 * q; xr[q] = nx[q];
                *(LDSP pg8::u32x2*)(lds + SS_XIM + (ci >> 3) * SS_XR + (ci & 7) * 16) = (pg8::u32x2){xr[q].x, xr[q].y}; *(LDSP pg8::u32x2*)(lds + SS_XIM + (ci >> 3) * SS_XR + (ci & 7) * 16 + 8) = (pg8::u32x2){xr[q].z, xr[q].w}; }
#pragma unroll
            for (int q = 0; q < 4; ++q) { const int ci = tl + 512 * q;
                *(LDSP pg8::u32x4*)(lds + SS_BIM + (ci >> 4) * SS_BR + (ci & 15) * 16) = nB[q];
                *(LDSP pg8::u32x4*)(lds + SS_CIM + (ci >> 4) * SS_BR + (ci & 15) * 16) = nC[q]; }
            if (tl < 128) { tab[128 + tl] = ndt; tab[384 + tl] = ndt * Ah; }
            if (ck + 1 < SEQ / 128) SS_LOAD(ck + 1);
            __syncthreads();
            if (w == 0) {
                const float v0 = tab[384 + 2 * lane], v1 = tab[384 + 2 * lane + 1]; float s = v0 + v1;
#pragma unroll
                for (int o = 1; o < 64; o <<= 1) { const float u = __shfl_up(s, o); if (lane >= o) s += u; }
                tab[2 * lane] = s - v1; tab[2 * lane + 1] = s;
            }
            __syncthreads();
            const float alast = tab[127];
#pragma unroll
            for (int q = 0; q < 2; ++q) { const int ci = tl + 512 * q, row = ci >> 3; const float sc = __expf(alast - tab[row]) * tab[128 + row]; const unsigned xw[4] = {xr[q].x, xr[q].y, xr[q].z, xr[q].w}; unsigned ow[4];
#pragma unroll
                for (int e = 0; e < 4; ++e) ow[e] = pk2bf(__uint_as_float(xw[e] << 16) * sc, __uint_as_float(xw[e] & 0xffff0000u) * sc);
                *(LDSP pg8::u32x2*)(lds + SS_XSM + row * SS_XR + (ci & 7) * 16) = (pg8::u32x2){ow[0], ow[1]}; *(LDSP pg8::u32x2*)(lds + SS_XSM + row * SS_XR + (ci & 7) * 16 + 8) = (pg8::u32x2){ow[2], ow[3]}; }
            { int ln = lane; asm volatile("" : "+v"(ln)); const int a31 = ln & 31, a5 = ln >> 5;
              for (int tt = w; tt < 10; tt += 8) {
                int ib = tt < 1 ? 0 : (tt < 3 ? 1 : (tt < 6 ? 2 : 3)); const int jb = tt - (ib * (ib + 1)) / 2;
                f32x16_t ST;
#pragma unroll
                for (int r = 0; r < 16; ++r) ST[r] = 0.f;
#pragma unroll
                for (int s = 0; s < 8; ++s) { const bf16x8v a = *(const LDSP bf16x8v*)(lds + SS_BIM + (32 * jb + a31) * SS_BR + (16 * s + 8 * a5) * 2), bb = *(const LDSP bf16x8v*)(lds + SS_CIM + (32 * ib + a31) * SS_BR + (16 * s + 8 * a5) * 2);
                    ST = MFMA32(a, bb, ST); }
                const float ai = tab[32 * ib + a31];
#pragma unroll
                for (int g4 = 0; g4 < 4; ++g4) { const int jr = 32 * jb + 8 * g4 + 4 * a5; const pg8::f32x4 aj = *(const LDSP pg8::f32x4*)(tab + jr), dj = *(const LDSP pg8::f32x4*)(tab + 128 + jr);
#pragma unroll
                    for (int e = 0; e < 4; ++e) { const int jj = jr + e, ii = 32 * ib + a31; const float mv = jj <= ii ? ST[4 * g4 + e] * __expf(ai - aj[e]) * dj[e] : 0.f;
                        *(LDSP bf16_t*)(lds + SS_MTM + jj * SS_BR + ii * 2) = (bf16_t)(pk2bf(mv, 0.f) & 0xffffu); } }
              }
              const int nb = w >> 1, pb = w & 1;
#pragma unroll
              for (int r = 0; r < 16; ++r) *(LDSP bf16_t*)(lds + SS_HBM + (32 * nb + (r & 3) + 8 * (r >> 2) + 4 * a5) * SS_XR + (32 * pb + a31) * 2) = (bf16_t)(pk2bf(H[r], 0.f) & 0xffffu);
            }
            __syncthreads();
            { int ln = lane; asm volatile("" : "+v"(ln)); const int a31 = ln & 31, a5 = ln >> 5;
              const int pb = w & 1, ib = w >> 1, nb = w >> 1;
              f32x16_t Y;
#pragma unroll
              for (int r = 0; r < 16; ++r) Y[r] = 0.f;
#pragma unroll
              for (int s = 0; s < 8; ++s) { const bf16x8v a = ss_trfrag(lds + SS_HBM, SS_XR, 16 * s, 32 * pb, ln), bb = *(const LDSP bf16x8v*)(lds + SS_CIM + (32 * ib + a31) * SS_BR + (16 * s + 8 * a5) * 2);
                  Y = MFMA32(a, bb, Y); if (s & 1) __builtin_amdgcn_sched_barrier(0); }
              const float ei = __expf(tab[32 * ib + a31]);
#pragma unroll
              for (int r = 0; r < 16; ++r) Y[r] *= ei;
              for (int s = 0; s < 2 * (ib + 1); ++s) { const bf16x8v a = ss_trfrag(lds + SS_XIM, SS_XR, 16 * s, 32 * pb, ln), bb = ss_trfrag(lds + SS_MTM, SS_BR, 16 * s, 32 * ib, ln);
                  Y = MFMA32(a, bb, Y); }
              { const size_t mrow = m0 + 32 * ib + a31; float* yrow = fb.y + mrow * MB_INNER + hd * MB_HEAD + 32 * pb + 4 * a5;
#pragma unroll
                for (int g4 = 0; g4 < 4; ++g4) { const pg8::u32x2 xv = *(const LDSP pg8::u32x2*)(lds + SS_XIM + (32 * ib + a31) * SS_XR + (32 * pb + 8 * g4 + 4 * a5) * 2);
                    pg8::f32x4 o; o[0] = Y[4 * g4] + Dh * __uint_as_float(xv.x << 16); o[1] = Y[4 * g4 + 1] + Dh * __uint_as_float(xv.x & 0xffff0000u); o[2] = Y[4 * g4 + 2] + Dh * __uint_as_float(xv.y << 16); o[3] = Y[4 * g4 + 3] + Dh * __uint_as_float(xv.y & 0xffff0000u);
                    *(pg8::f32x4*)(yrow + 8 * g4) = o; } }
              const float dec = __expf(tab[127]);
#pragma unroll
              for (int r = 0; r < 16; ++r) H[r] *= dec;
#pragma unroll
              for (int s = 0; s < 8; ++s) { const bf16x8v a = ss_trfrag(lds + SS_BIM, SS_BR, 16 * s, 32 * nb, ln), bb = ss_trfrag(lds + SS_XSM, SS_XR, 16 * s, 32 * pb, ln);
                  H = MFMA32(a, bb, H); if (s & 1) __builtin_amdgcn_sched_barrier(0); }
            }
            __syncthreads();
        }
#undef SS_LOAD
        { const int nb = w >> 1, pb = w & 1; float* so = c.out + O_SSMP + (((size_t)j * BATCH + b) * MB_HEADS + hd) * MB_HEAD * MB_STATE;
#pragma unroll
          for (int r = 0; r < 16; ++r) so[(size_t)(32 * pb + l31) * MB_STATE + 32 * nb + (r & 3) + 8 * (r >> 2) + 4 * h5] = H[r]; }
    }
}
__device__ __forceinline__ void mb_scan_sample(const Ctx& c, const FastMb& fb, int l) {
    using namespace cfg; const int j = l / 3;
    const int tid = (int)tid_now(), p = tid >> 3, ns = tid & 7;
    pg8::f32x4 hn[4];
    { const int chain = blockIdx.x; if (chain < DB * MB_HEADS) { const size_t so = ((((size_t)j * DB + chain / MB_HEADS) * MB_HEADS + chain % MB_HEADS) * MB_HEAD + p) * MB_STATE + 16 * ns;
#pragma unroll
        for (int q = 0; q < 4; ++q) hn[q] = *(const pg8::f32x4*)(c.in[I_SSM] + so + 4 * q); } }
    for (int chain = blockIdx.x; chain < DB * MB_HEADS; chain += gridDim.x) {
        const int s = chain / MB_HEADS, hd = chain % MB_HEADS, g = hd / (MB_HEADS / MB_GROUPS);
        const float Ah = -expf(c.in[I_ALOG][j * MB_HEADS + hd]), Dh = c.in[I_BD][j * MB_HEADS + hd];
        const size_t so = ((((size_t)j * DB + s) * MB_HEADS + hd) * MB_HEAD + p) * MB_STATE + 16 * ns;
        float hs[16];
#pragma unroll
        for (int q = 0; q < 4; ++q) { hs[4 * q] = hn[q][0]; hs[4 * q + 1] = hn[q][1]; hs[4 * q + 2] = hn[q][2]; hs[4 * q + 3] = hn[q][3]; }
        { const int cn = chain + gridDim.x; if (cn < DB * MB_HEADS) { const size_t sn = ((((size_t)j * DB + cn / MB_HEADS) * MB_HEADS + cn % MB_HEADS) * MB_HEAD + p) * MB_STATE + 16 * ns;
#pragma unroll
            for (int q = 0; q < 4; ++q) hn[q] = *(const pg8::f32x4*)(c.in[I_SSM] + sn + 4 * q); } }
        float dtv[DS]; unsigned short xr[DS]; pg8::u32x4 Bq[DS][2], Cq[DS][2];
#pragma unroll
        for (int t = 0; t < DS; ++t) { const size_t m = (size_t)MP + s * DS + t; dtv[t] = fb.dt[m * MB_HEADS + hd]; xr[t] = fb.xbcb[m * MB_CD + hd * MB_HEAD + p];
            const bf16_t* Bp = fb.xbcb + m * MB_CD + MB_INNER + g * MB_STATE + 16 * ns; Bq[t][0] = *(const pg8::u32x4*)Bp; Bq[t][1] = *(const pg8::u32x4*)(Bp + 8);
            Cq[t][0] = *(const pg8::u32x4*)(Bp + MB_GN); Cq[t][1] = *(const pg8::u32x4*)(Bp + MB_GN + 8); }
#pragma unroll
        for (int t = 0; t < DS; ++t) {
            const size_t m = (size_t)MP + s * DS + t;
            const float dA = __expf(dtv[t] * Ah), xv = bf2f(xr[t]), xdt = xv * dtv[t];
            const unsigned bw[8] = {Bq[t][0].x, Bq[t][0].y, Bq[t][0].z, Bq[t][0].w, Bq[t][1].x, Bq[t][1].y, Bq[t][1].z, Bq[t][1].w};
            const unsigned cw[8] = {Cq[t][0].x, Cq[t][0].y, Cq[t][0].z, Cq[t][0].w, Cq[t][1].x, Cq[t][1].y, Cq[t][1].z, Cq[t][1].w};
            float yy = 0.f;
#pragma unroll
            for (int k = 0; k < 8; ++k) { hs[2 * k] = hs[2 * k] * dA + xdt * __uint_as_float(bw[k] << 16); hs[2 * k + 1] = hs[2 * k + 1] * dA + xdt * __uint_as_float(bw[k] & 0xffff0000u);
                yy += __uint_as_float(cw[k] << 16) * hs[2 * k] + __uint_as_float(cw[k] & 0xffff0000u) * hs[2 * k + 1]; }
            yy += __shfl_xor(yy, 1); yy += __shfl_xor(yy, 2); yy += __shfl_xor(yy, 4);
            if (ns == 0) fb.y[m * MB_INNER + hd * MB_HEAD + p] = yy + Dh * xv;
        }
        float* oo = c.out + O_SSMS + so;
#pragma unroll
        for (int q = 0; q < 4; ++q) *(pg8::f32x4*)(oo + 4 * q) = (pg8::f32x4){hs[4 * q], hs[4 * q + 1], hs[4 * q + 2], hs[4 * q + 3]};
    }
}
constexpr int RC_RS = 144;
constexpr int RC_AT = 0, RC_RT = 4608, RC_BB = 9216, RC_KB = 13824, RC_BH = 18432, RC_KH = 23040, RC_VV = 27648, RC_UT = 32256, RC_GG = 36864;
constexpr int RC_SB = 41472;
constexpr int RC_NAK = 50688, RC_MRB = 53248, RC_MRK = 55808, RC_NS = 80;
constexpr int RC_NAB = 58368;
constexpr int RC_E = 62464;
constexpr int RC_YB = 70656;
constexpr int RC_GL = 78848, RC_BON = 79104, RC_VV2 = 79360, RC_GG2 = RC_VV2 + 4608, RC_END0 = RC_GG2 + 4608;
constexpr int RC_WW = RC_END0, RC_WA = RC_WW + 64 * 144, RC_WG = RC_WA + 64 * 144, RC_WV = RC_WG + 64 * 336, RC_LUO = RC_WV + 64 * 80, RC_END = RC_LUO + 4 * 4608;
constexpr int RC_HB = RC_AT, RC_HBS = 784;
__device__ __forceinline__ bf16x8v rc_nat(const LDSP unsigned char* img, int stride, int row, int kofs) { return *(const LDSP bf16x8v*)(img + row * stride + kofs * 2); }
__device__ __forceinline__ int rc_row(int r, int h5) { return (r & 3) + 8 * (r >> 2) + 4 * h5; }
__device__ __forceinline__ void rc_st16(LDSP unsigned char* p, float v) { *(LDSP bf16_t*)p = (bf16_t)(pk2bf(v, 0.f) & 0xffffu); }


template <int S>
struct RcSub {
    static __device__ __forceinline__ void run(float (&acc)[32], const LDSP float* NAB, LDSP unsigned char* lds, int lane) {
        const float us = acc[S]; rc_st16(lds + RC_UT + S * RC_RS + lane * 2, us);
#pragma unroll
        for (int g4 = 0; g4 < 8; ++g4) { if (4 * g4 + 3 > S) { const pg8::f32x4 nv = *(const LDSP pg8::f32x4*)(NAB + S * 32 + 4 * g4);
#pragma unroll
            for (int e = 0; e < 4; ++e) { if (4 * g4 + e > S) acc[4 * g4 + e] = fmaf(nv[e], us, acc[4 * g4 + e]); } } }
        RcSub<S + 1>::run(acc, NAB, lds, lane);
    }
};
template <> struct RcSub<32> { static __device__ __forceinline__ void run(float (&)[32], const LDSP float*, LDSP unsigned char*, int) {} };

template <int J>
__device__ __forceinline__ void rw_scan_chunked(const Ctx& c, const FastRw& fr, LDSP unsigned char* lds) {
    using namespace cfg; constexpr int j = J;
    const int tid = (int)tid_now(), w = __builtin_amdgcn_readfirstlane(tid >> 6), lane = tid & 63, l31 = lane & 31, h5 = lane >> 5;
    LDSP float* Ef = (LDSP float*)(lds + RC_E); LDSP float* YB = (LDSP float*)(lds + RC_YB); LDSP float* GL = (LDSP float*)(lds + RC_GL); LDSP float* BON = (LDSP float*)(lds + RC_BON);
    LDSP float* NAB = (LDSP float*)(lds + RC_NAB);
    int hcur = -1;
    for (int chain = blockIdx.x; chain < NSEQ * RHEADS; chain += gridDim.x) {
        const int sq = chain / RHEADS, h = chain % RHEADS, T = seq_len(sq), m0 = seq_row0(sq), ch = h * RH + lane;
        const float p_w0 = c.in[I_W0][j * D + ch], p_a0 = c.in[I_A0][j * D + ch], p_kk = c.in[I_KK][j * D + ch], p_ka = c.in[I_KA][j * D + ch], p_rk = c.in[I_RK][(size_t)j * D + ch],
                    p_lnw = c.in[I_LNW][j * D + ch], p_lnb = c.in[I_LNB][j * D + ch], p_v0 = j > 0 ? c.in[I_V0][(j - 1) * D + ch] : 0.f;
        const int ib = (w >> 1) & 1, jb = w & 1;
        f32x16_t ST;
#pragma unroll
        for (int r = 0; r < 16; ++r) ST[r] = 0.f;
        if (w < 4 && sq >= BATCH) { const float* s0 = c.in[I_WKV] + (((size_t)j * DB + (sq - BATCH)) * RHEADS + h) * RH * RH;
#pragma unroll
            for (int r = 0; r < 16; ++r) ST[r] = s0[(size_t)(32 * ib + rc_row(r, h5)) * RH + 32 * jb + l31]; }
        const int nch = (T + 31) / 32;
        if (h != hcur) {
            __syncthreads();
            const bf16_t* lw = fr.lorat + (size_t)j * 4096 * 384;
            for (int ci = tid; ci < 64 * 8; ci += 512) { const int row = ci >> 3, c8 = ci & 7;
                *(LDSP pg8::u32x4*)(lds + RC_WW + row * 144 + c8 * 16) = *(const pg8::u32x4*)(lw + (size_t)(0 * 1024 + h * 64 + row) * 384 + 0 + c8 * 8);
                *(LDSP pg8::u32x4*)(lds + RC_WA + row * 144 + c8 * 16) = *(const pg8::u32x4*)(lw + (size_t)(1 * 1024 + h * 64 + row) * 384 + 64 + c8 * 8); }
            for (int ci = tid; ci < 64 * 20; ci += 512) { const int row = ci / 20, c20 = ci % 20;
                *(LDSP pg8::u32x4*)(lds + RC_WG + row * 336 + c20 * 16) = *(const pg8::u32x4*)(lw + (size_t)(2 * 1024 + h * 64 + row) * 384 + 128 + c20 * 8); }
            for (int ci = tid; ci < 64 * 4; ci += 512) { const int row = ci >> 2, c4 = ci & 3;
                *(LDSP pg8::u32x4*)(lds + RC_WV + row * 80 + c4 * 16) = *(const pg8::u32x4*)(lw + (size_t)(3 * 1024 + h * 64 + row) * 384 + 288 + c4 * 8); }
            hcur = h;
        }
        RwIn in[4]; pg8::u32x4 hbr[3];
#define RC_LOADIN(n) do { _Pragma("unroll") for (int q = 0; q < 4; ++q) { const int t_ = (n) * 32 + 4 * w + q; if (t_ < T) { const size_t m_ = (size_t)(m0 + t_); \
                const bf16_t* rk_ = fr.rkv + m_ * 3072 + ch; in[q].r = rk_[0]; in[q].k = rk_[1024]; in[q].v = rk_[2048]; \
                in[q].vf = j > 0 ? fr.vf[m_ * D + ch] : 0.f; } } \
            _Pragma("unroll") for (int k3 = 0; k3 < 3; ++k3) { const int ci_ = tid + 512 * k3, tk_ = ci_ / 48, t_ = (n) * 32 + tk_; \
                hbr[k3] = t_ < T ? *(const pg8::u32x4*)(fr.hb + (size_t)(m0 + t_) * 384 + (ci_ % 48) * 8) : (pg8::u32x4){0u, 0u, 0u, 0u}; } } while (0)
        __syncthreads();
        RC_LOADIN(0);
        for (int n = 0; n < nch; ++n) {
            const int tn = T - n * 32 < 32 ? T - n * 32 : 32;
            const int vvo = (n & 1) ? RC_VV2 : RC_VV, ggo = (n & 1) ? RC_GG2 : RC_GG, bno = (n & 1) ? 32 : 0;
#pragma unroll
            for (int k3 = 0; k3 < 3; ++k3) { const int ci_ = tid + 512 * k3; *(LDSP pg8::u32x4*)(lds + RC_HB + (ci_ / 48) * RC_HBS + (ci_ % 48) * 16) = hbr[k3]; }
            __syncthreads();
            { int ln = lane; asm volatile("" : "+v"(ln)); const int a31 = ln & 31, a5 = ln >> 5; const int grp = w >> 1, nb = w & 1;
              const int koff = grp == 0 ? 0 : (grp == 1 ? 64 : (grp == 2 ? 128 : 288)), nks = grp == 2 ? 10 : (grp == 3 ? 2 : 4);
              const int wof = grp == 0 ? RC_WW : (grp == 1 ? RC_WA : (grp == 2 ? RC_WG : RC_WV)), wst = grp == 2 ? 336 : (grp == 3 ? 80 : 144);
              f32x16_t LA;
#pragma unroll
              for (int r = 0; r < 16; ++r) LA[r] = 0.f;
              for (int ks = 0; ks < nks; ++ks) LA = MFMA32(rc_nat(lds + RC_HB, RC_HBS, a31, koff + 16 * ks + 8 * a5), rc_nat(lds + wof, wst, 32 * nb + a31, 16 * ks + 8 * a5), LA);
#pragma unroll
              for (int r = 0; r < 16; ++r) rc_st16(lds + RC_LUO + grp * 4608 + rc_row(r, a5) * RC_RS + (32 * nb + a31) * 2, LA[r]); }
            __syncthreads();
            float q_r[4], q_k[4], q_a[4], q_b[4], q_e[4];
#pragma unroll
            for (int q = 0; q < 4; ++q) {
                const int tl = 4 * w + q, tg = n * 32 + tl;
                float r_ = 0.f, k2_ = 0.f, v_ = 0.f, a_ = 0.f, b_ = 0.f, e_ = 0.f, g_ = 0.f, bon_ = 0.f;
                if (tg < T) {
                    r_ = bf2f(in[q].r); const float k0_ = bf2f(in[q].k); v_ = bf2f(in[q].v);
                    e_ = 0.6065306597126334f * fsigmoid(p_w0 + bf2f(*(const LDSP bf16_t*)(lds + RC_LUO + 0 * 4608 + tl * RC_RS + lane * 2)));
                    if (j == 0) fr.vf[(size_t)(m0 + tg) * D + ch] = v_; else v_ = v_ + (in[q].vf - v_) * fsigmoid(p_v0 + bf2f(*(const LDSP bf16_t*)(lds + RC_LUO + 3 * 4608 + tl * RC_RS + lane * 2)));
                    const float as_ = fsigmoid(p_a0 + bf2f(*(const LDSP bf16_t*)(lds + RC_LUO + 1 * 4608 + tl * RC_RS + lane * 2))); float kk_ = k0_ * p_kk;
                    k2_ = k0_ * (1.0f + (as_ - 1.0f) * p_ka);
                    float n_ = red16(kk_ * kk_), e1_ = red16(r_ * k2_ * p_rk);
                    n_ = (rdl(n_, 0) + rdl(n_, 16)) + (rdl(n_, 32) + rdl(n_, 48)); bon_ = (rdl(e1_, 0) + rdl(e1_, 16)) + (rdl(e1_, 32) + rdl(e1_, 48));
                    kk_ *= __builtin_amdgcn_rcpf(fmaxf(__builtin_amdgcn_sqrtf(n_), 1e-12f));
                    a_ = -kk_; b_ = kk_ * as_; g_ = bf2f(*(const LDSP bf16_t*)(lds + RC_LUO + 2 * 4608 + tl * RC_RS + lane * 2));
                }
                q_r[q] = r_; q_k[q] = k2_; q_a[q] = a_; q_b[q] = b_; q_e[q] = e_;
                Ef[tl * 64 + lane] = e_;
                rc_st16(lds + vvo + tl * RC_RS + lane * 2, v_); rc_st16(lds + ggo + tl * RC_RS + lane * 2, g_);
                if (lane == 0) BON[bno + tl] = bon_;
            }
            if (n + 1 < nch) RC_LOADIN(n + 1);
            if (w < 4) {
#pragma unroll
                for (int r = 0; r < 16; ++r) rc_st16(lds + RC_SB + (32 * ib + rc_row(r, h5)) * RC_RS + (32 * jb + l31) * 2, ST[r]);
            }
            __syncthreads();
            { float run = 0.f, base = 0.f;
#pragma unroll
              for (int s = 0; s < 32; ++s) { const float ev = Ef[s * 64 + lane]; if (s == 4 * w) base = run; run += ev; }
              const float cumL = run; float cum = base;
#pragma unroll
              for (int q = 0; q < 4; ++q) { const int tl = 4 * w + q; const float cprev = cum; cum += q_e[q];
                  const float gam = __expf(-cum), gamp = __expf(-cprev), ginv = __expf(cum), glr = __expf(cum - cumL);
                  rc_st16(lds + RC_AT + tl * RC_RS + lane * 2, q_a[q] * gamp); rc_st16(lds + RC_RT + tl * RC_RS + lane * 2, q_r[q] * gam);
                  rc_st16(lds + RC_BB + tl * RC_RS + lane * 2, q_b[q] * ginv); rc_st16(lds + RC_KB + tl * RC_RS + lane * 2, q_k[q] * ginv);
                  rc_st16(lds + RC_BH + tl * RC_RS + lane * 2, q_b[q] * glr); rc_st16(lds + RC_KH + tl * RC_RS + lane * 2, q_k[q] * glr); }
              if (w == 0) GL[lane] = __expf(-cumL); }
            __syncthreads();
            f32x16_t R1;
#pragma unroll
            for (int r = 0; r < 16; ++r) R1[r] = 0.f;
            { int ln = lane; asm volatile("" : "+v"(ln)); const int a31 = ln & 31, a5 = ln >> 5;
              if (w < 4) {
                  const int aoff = (w == 0) ? RC_BB : ((w < 2) ? RC_AT : RC_RT), boff = (w == 0) ? RC_AT : ((w & 1) ? RC_KB : RC_BB);
#pragma unroll
                  for (int ks = 0; ks < 4; ++ks) R1 = MFMA32(rc_nat(lds + aoff, RC_RS, a31, 16 * ks + 8 * a5), rc_nat(lds + boff, RC_RS, a31, 16 * ks + 8 * a5), R1);
#pragma unroll
                  for (int r = 0; r < 16; ++r) { const int rr = rc_row(r, a5), cc = a31;
                      if (w == 0) NAB[rr * 32 + cc] = (rr < cc) ? R1[r] : 0.f;
                      else { const bool keep = (w < 2) ? (cc < rr) : (cc <= rr); rc_st16(lds + (w == 1 ? RC_NAK : (w == 2 ? RC_MRB : RC_MRK)) + rr * RC_NS + cc * 2, keep ? R1[r] : 0.f); } }
              } else {
                  const int aoff = (w < 6) ? RC_AT : RC_RT, ibk = w & 1;
#pragma unroll
                  for (int ks = 0; ks < 4; ++ks) R1 = MFMA32(rc_nat(lds + aoff, RC_RS, a31, 16 * ks + 8 * a5), rc_nat(lds + RC_SB, RC_RS, 32 * ibk + a31, 16 * ks + 8 * a5), R1);
              } }
            __syncthreads();
            if (w == 4 || w == 5) { int ln = lane; asm volatile("" : "+v"(ln)); const int a31 = ln & 31, a5 = ln >> 5, ibk = w & 1;
#pragma unroll
                for (int ks = 0; ks < 2; ++ks) R1 = MFMA32(rc_nat(lds + RC_NAK, RC_NS, a31, 16 * ks + 8 * a5), ss_trfrag(lds + vvo, RC_RS, 16 * ks, 32 * ibk, ln), R1);
#pragma unroll
                for (int r = 0; r < 16; ++r) Ef[rc_row(r, a5) * 64 + 32 * ibk + a31] = R1[r]; }
            __syncthreads();
            if (w == 0) { float acc[32];
#pragma unroll
                for (int t = 0; t < 32; ++t) acc[t] = Ef[t * 64 + lane];
                RcSub<0>::run(acc, NAB, lds, lane); }
            __syncthreads();
            { int ln = lane; asm volatile("" : "+v"(ln)); const int a31 = ln & 31, a5 = ln >> 5;
              if (w >= 6) { const int ibk = w & 1;
#pragma unroll
                  for (int ks = 0; ks < 2; ++ks) { R1 = MFMA32(rc_nat(lds + RC_MRB, RC_NS, a31, 16 * ks + 8 * a5), ss_trfrag(lds + RC_UT, RC_RS, 16 * ks, 32 * ibk, ln), R1);
                                                   R1 = MFMA32(rc_nat(lds + RC_MRK, RC_NS, a31, 16 * ks + 8 * a5), ss_trfrag(lds + vvo, RC_RS, 16 * ks, 32 * ibk, ln), R1); }
#pragma unroll
                  for (int r = 0; r < 16; ++r) YB[rc_row(r, a5) * 64 + 32 * ibk + a31] = R1[r];
              } else if (w < 4) { const float gl = GL[32 * jb + a31];
#pragma unroll
                  for (int r = 0; r < 16; ++r) ST[r] *= gl;
#pragma unroll
                  for (int ks = 0; ks < 2; ++ks) { ST = MFMA32(ss_trfrag(lds + RC_UT, RC_RS, 16 * ks, 32 * ib, ln), ss_trfrag(lds + RC_BH, RC_RS, 16 * ks, 32 * jb, ln), ST);
                                                   ST = MFMA32(ss_trfrag(lds + vvo, RC_RS, 16 * ks, 32 * ib, ln), ss_trfrag(lds + RC_KH, RC_RS, 16 * ks, 32 * jb, ln), ST); } } }
            __syncthreads();
#pragma unroll
            for (int q = 0; q < 4; ++q) { const int tl = 4 * w + q; if (tl < tn) {
                const float y = YB[tl * 64 + lane], mean = wsum_dpp(y) * (1.0f / RH), d = y - mean, var = wsum_dpp(d * d) * (1.0f / RH);
                const float yn = d * __builtin_amdgcn_rsqf(var + LNX_EPS) * p_lnw + p_lnb;
                const float o = (yn + BON[bno + tl] * bf2f(*(const LDSP bf16_t*)(lds + vvo + tl * RC_RS + lane * 2))) * bf2f(*(const LDSP bf16_t*)(lds + ggo + tl * RC_RS + lane * 2));
                fr.yo[(size_t)(m0 + n * 32 + tl) * D + ch] = (bf16_t)(pk2bf(o, 0.f) & 0xffffu); } }
        }
#undef RC_LOADIN
        if (w < 4) { float* so = (sq < BATCH ? c.out + O_WKVP + (((size_t)j * BATCH + sq) * RHEADS + h) * RH * RH : c.out + O_WKVS + (((size_t)j * DB + (sq - BATCH)) * RHEADS + h) * RH * RH);
#pragma unroll
            for (int r = 0; r < 16; ++r) so[(size_t)(32 * ib + rc_row(r, h5)) * RH + 32 * jb + l31] = ST[r]; }
    }
}
template <int ACT, bool ACC>
__device__ __forceinline__ void gemm_dev(const float* __restrict__ A, int lda, const float* __restrict__ B, int ldb, float* C, int ldc, int M, int N, int K, unsigned short (*As)[40], unsigned short (*Bs)[40]) {
    const int tid = threadIdx.x, wave = tid >> 6, lane = tid & 63, wr = wave >> 1, wc = wave & 1, fr = lane & 15, fq = lane >> 4;
    const int ntn = (N + 127) / 128, ntm = (M + 127) / 128;
    for (int tile = blockIdx.x; tile < ntm * ntn; tile += gridDim.x) {
        const int bm = (tile / ntn) * 128, bn = (tile % ntn) * 128;
        f32x4_t acc[2][4];
#pragma unroll
        for (int i = 0; i < 2; ++i)
#pragma unroll
            for (int j = 0; j < 4; ++j) acc[i][j] = (f32x4_t){0.f, 0.f, 0.f, 0.f};
        for (int k0 = 0; k0 < K; k0 += 32) {
#pragma unroll
            for (int it = 0; it < 2; ++it) {
                const int idx = tid + it * 512, row = idx >> 3, c4 = idx & 7, gm = bm + row;
                float4 v = make_float4(0.f, 0.f, 0.f, 0.f);
                if (gm < M) v = *(const float4*)(A + (size_t)gm * lda + k0 + c4 * 4);
                uint2 w; w.x = (unsigned)f2bf(v.x) | ((unsigned)f2bf(v.y) << 16); w.y = (unsigned)f2bf(v.z) | ((unsigned)f2bf(v.w) << 16);
                *(uint2*)&As[row][c4 * 4] = w;
            }
#pragma unroll
            for (int it = 0; it < 2; ++it) {
                const int idx = tid + it * 512, kr = idx >> 5, n4 = idx & 31, gn = bn + n4 * 4;
                float4 v = make_float4(0.f, 0.f, 0.f, 0.f);
                if (gn < N) v = *(const float4*)(B + (size_t)(k0 + kr) * ldb + gn);
                Bs[n4 * 4 + 0][kr] = f2bf(v.x); Bs[n4 * 4 + 1][kr] = f2bf(v.y); Bs[n4 * 4 + 2][kr] = f2bf(v.z); Bs[n4 * 4 + 3][kr] = f2bf(v.w);
            }
            __syncthreads();
            bf16x8_t a[2], b[4];
#pragma unroll
            for (int i = 0; i < 2; ++i) a[i] = *(const bf16x8_t*)&As[wr * 32 + i * 16 + fr][fq * 8];
#pragma unroll
            for (int j = 0; j < 4; ++j) b[j] = *(const bf16x8_t*)&Bs[wc * 64 + j * 16 + fr][fq * 8];
#pragma unroll
            for (int i = 0; i < 2; ++i)
#pragma unroll
                for (int j = 0; j < 4; ++j) acc[i][j] = __builtin_amdgcn_mfma_f32_16x16x32_bf16(a[i], b[j], acc[i][j], 0, 0, 0);
            __syncthreads();
        }
#pragma unroll
        for (int i = 0; i < 2; ++i)
#pragma unroll
            for (int j = 0; j < 4; ++j)
#pragma unroll
                for (int e = 0; e < 4; ++e) {
                    const int row = bm + wr * 32 + i * 16 + fq * 4 + e, col = bn + wc * 64 + j * 16 + fr;
                    if (row < M && col < N) {
                        float v = acc[i][j][e];
                        if (ACT == 1) v = tanhf(v); else if (ACT == 2) v = 1.0f / (1.0f + expf(-v)); else if (ACT == 3) v = v > 0.f ? v * v : 0.f;
                        float* cp = C + (size_t)row * ldc + col; *cp = ACC ? *cp + v : v;
                    }
                }
    }
}

#define MRUN(ph, l) do { ph(c, l, gtid, gsz); xcd_barrier(bar); } while (0)
#define MGEMM(ACT, ACC, A, lda, B, ldb, C, ldc, M, N, K) do { gemm_dev<ACT, ACC>(A, lda, B, ldb, C, ldc, M, N, K, As, Bs); xcd_barrier(bar); } while (0)
#define KS_FFN 16
#define KS_1K 4
#define KS_MB 8
#ifndef ACC_KSPLIT
#define ACC_KSPLIT 1
#endif
#ifndef FFN_DOWN_KSPLIT
#define FFN_DOWN_KSPLIT 1
#endif
#define GBAR() xcd_barrier(bar)
#ifndef PROBE_DUP
#define PROBE_DUP 0
#endif
#define DUP(bit, ...) do { __VA_ARGS__; if (PROBE_DUP & (1 << (bit))) { GBAR(); __VA_ARGS__; } } while (0)
#define GTID_NOW() ((size_t)blockIdx.x * 512 + tid_now())
#define GSZ_NOW() ((size_t)gridDim.x * 512)
#define GW_NOW() ((int)(blockIdx.x * 8 + (tid_now() >> 6)))
#define NGW_NOW() ((int)(gridDim.x * 8))
#define LANE_NOW() ((int)(tid_now() & 63))
#undef MRUN
#undef MGEMM
#define MRUN(ph, l) do { ph(c, l, GTID_NOW(), GSZ_NOW()); xcd_barrier(bar); } while (0)
#define MGEMM(ACT, ACC, A, lda, B, ldb, C, ldc, M, N, K) do { gemm_dev<ACT, ACC>(A, lda, B, ldb, C, ldc, M, N, K, (unsigned short (*)[40])dynlds, (unsigned short (*)[40])(dynlds + 128 * 40 * 2)); xcd_barrier(bar); } while (0)
extern __shared__ __attribute__((aligned(16))) unsigned char dynlds[];

struct MegaArgs { Ctx c; Fast f; FastMla fm; FastRw fr; FastMb fb; unsigned* bar; };
constexpr int LDS_STAGE = 0, LDS_XB = 163840 - 64, LDS_BYTES = 163840;
static_assert(SD_END <= LDS_XB && SS_END <= LDS_XB && RC_END <= LDS_XB, "LDS map");

template <int L>
__device__ __forceinline__ void layer_mix_naive(const Ctx& c, const XcdBarrier& bar) {
    using namespace cfg;
    constexpr int l = L, kind = L % 3, j = L / 3;
    MRUN(ph_norm_mix, l);
    if constexpr (kind == 0) {
        MRUN(ph_rw_mix, l);
        const float* W = c.in[I_WRKV] + (size_t)j * 3 * D * D;
        MGEMM(0, false, c.xm[0], D, W, D, c.r, D, MTOT, D, D);
        MGEMM(0, false, c.xm[1], D, W + (size_t)D * D, D, c.k, D, MTOT, D, D);
        MGEMM(0, false, c.xm[2], D, W + (size_t)2 * D * D, D, c.v, D, MTOT, D, D);
        MGEMM(1, false, c.xm[3], D, c.in[I_W1] + (size_t)j * D * RW_DL, RW_DL, c.hw, RW_DL, MTOT, RW_DL, D);
        MGEMM(0, false, c.hw, RW_DL, c.in[I_W2] + (size_t)j * RW_DL * D, D, c.wpre, D, MTOT, D, RW_DL);
        MGEMM(0, false, c.xm[4], D, c.in[I_A1] + (size_t)j * D * RW_AL, RW_AL, c.ha, RW_AL, MTOT, RW_AL, D);
        MGEMM(0, false, c.ha, RW_AL, c.in[I_A2] + (size_t)j * RW_AL * D, D, c.apre, D, MTOT, D, RW_AL);
        if constexpr (j > 0) {
            MGEMM(0, false, c.xm[2], D, c.in[I_V1] + (size_t)(j - 1) * D * RW_VL, RW_VL, c.hv, RW_VL, MTOT, RW_VL, D);
            MGEMM(0, false, c.hv, RW_VL, c.in[I_V2] + (size_t)(j - 1) * RW_VL * D, D, c.vpre, D, MTOT, D, RW_VL);
        }
        MGEMM(2, false, c.xm[5], D, c.in[I_G1] + (size_t)j * D * RW_GL, RW_GL, c.hg, RW_GL, MTOT, RW_GL, D);
        MGEMM(0, false, c.hg, RW_GL, c.in[I_G2] + (size_t)j * RW_GL * D, D, c.g, D, MTOT, D, RW_GL);
        MRUN(ph_rw_prep, l); MRUN(ph_rw_scan, l); MRUN(ph_rw_post, l);
        MGEMM(0, true, c.yo, D, c.in[I_RWO] + (size_t)j * D * D, D, c.x, D, MTOT, D, D);
    } else if constexpr (kind == 1) {
        MGEMM(0, false, c.xn, D, c.in[I_MWIN] + (size_t)j * D * MLA_IN, MLA_IN, c.mh, MLA_IN, MTOT, MLA_IN, D);
        MRUN(ph_mla_norm1, l);
        MGEMM(0, false, c.qan, QL, c.in[I_WUQ] + (size_t)j * QL * MH * QD, MH * QD, c.q, MH * QD, MTOT, MH * QD, QL);
        MGEMM(0, false, c.c, KVL, c.in[I_WUK] + (size_t)j * KVL * MH * NOPE, MH * NOPE, c.knr, MH * NOPE, MTOT, MH * NOPE, KVL);
        MGEMM(0, false, c.c, KVL, c.in[I_WUV] + (size_t)j * KVL * MH * VD, MH * VD, c.vv, MH * VD, MTOT, MH * VD, KVL);
        MRUN(ph_mla_norm2, l); MRUN(ph_mla_attn_prompt, l); MRUN(ph_mla_score_sample, l); MRUN(ph_mla_softmax_sample, l); MRUN(ph_mla_pv_sample, l); MRUN(ph_mla_out_sample, l);
        MGEMM(0, true, c.ao, MH * VD, c.in[I_MWO] + (size_t)j * MH * VD * D, D, c.x, D, MTOT, D, MH * VD);
    } else {
        MGEMM(0, false, c.xn, D, c.in[I_BWIN] + (size_t)j * D * MB_IN, MB_IN, c.zx, MB_IN, MTOT, MB_IN, D);
        MRUN(ph_mb_conv, l); MRUN(ph_mb_dt, l); MRUN(ph_mb_scan, l); MRUN(ph_mb_gate, l);
        MGEMM(0, true, c.yzn, MB_INNER, c.in[I_BWO] + (size_t)j * MB_INNER * D, D, c.x, D, MTOT, D, MB_INNER);
    }
}


template <int L>
__device__ __forceinline__ void layer_rwkv_fast(const Ctx& c, const Fast& f, const FastRw& fr, const XcdBarrier& bar, LDSP unsigned char* lds) {
    using namespace cfg;
    constexpr int l = L, j = L / 3;
    if (L > 0) { fold_sample_rows(c.x, f.slab, KS_FFN, GW_NOW(), NGW_NOW(), LANE_NOW()); GBAR(); }
    DUP(9, rw_mix_fast(c, fr, l, GW_NOW(), NGW_NOW(), LANE_NOW()));
    GBAR();
    DUP(7, { pg8::Order<RwSel> S; S.init(MP / 256, MS / 256, 16, D, 1, gridDim.x, blockIdx.x);
      pg8::gemm_phase(lds, pg8::Gemm{fr.xm, fr.wrkvt + (size_t)j * 4096 * D, D, D, (size_t)MTOT * D}, S, EpiRwkv{fr.rkv, fr.hb}); });
    GBAR();
    DUP(2, rw_scan_chunked<j>(c, fr, lds));
    GBAR();
    { pg8::Order<> S; S.init(MP / 256, MS / 256, 4, D, KS_1K, gridDim.x, blockIdx.x);
      pg8::gemm_phase(lds, pg8::Gemm{fr.yo, fr.wot + (size_t)j * D * D, D, D, 0}, S, pg8::EpiAccF32{c.x, D, f.slab, MP / 256, MS / 256, KS_1K}); }
    if (PROBE_DUP & (1 << 26)) { GBAR(); pg8::Order<> S; S.init(MP / 256, MS / 256, 4, D, KS_1K, gridDim.x, blockIdx.x);
      pg8::gemm_phase(lds, pg8::Gemm{fr.yo, fr.wot + (size_t)j * D * D, D, D, 0}, S, pg8::EpiAccF32{c.hmid, D, f.slab + (size_t)16 * 16 * 65536, MP / 256, MS / 256, KS_1K}); }
    GBAR();
}

__device__ __forceinline__ void layer_mamba_fast(const Ctx& c, const Fast& f, const FastMb& fb, const XcdBarrier& bar, LDSP unsigned char* lds) {
    using namespace cfg;
    constexpr int l = 2, j = 0;
    norm_rows_bf16(c.x, c.in[I_NMIX] + l * D, f.xnb, f.slab, KS_FFN, GW_NOW(), NGW_NOW(), LANE_NOW());
    GBAR();
    DUP(8, { pg8::Order<> S; S.init(MP / 256, MS / 256, 21, D, 1, gridDim.x, blockIdx.x);
      pg8::gemm_phase(lds, pg8::Gemm{f.xnb, fb.wbint, D, D, 0}, S, EpiMamba{fb.zb, fb.xbcr, fb.dtraw}); });
    GBAR();
    DUP(12, mb_conv_fast(c, fb, l, GTID_NOW(), GSZ_NOW(), false));
    GBAR();
    DUP(6, mb_ssd_prompt(c, fb, l, lds); mb_scan_sample(c, fb, l));
    GBAR();
    DUP(13, mb_gate_fast(c, fb, fb.y, l, GW_NOW(), NGW_NOW(), LANE_NOW()));
    GBAR();
    { pg8::Order<> S; S.init(MP / 256, MS / 256, 4, MB_INNER, KS_MB, gridDim.x, blockIdx.x);
      pg8::gemm_phase(lds, pg8::Gemm{fb.yzn, fb.wbot, MB_INNER, MB_INNER, 0}, S, pg8::EpiAccF32{c.x, D, f.slab, MP / 256, MS / 256, KS_MB}); }
    if (PROBE_DUP & (1 << 28)) { GBAR(); pg8::Order<> S; S.init(MP / 256, MS / 256, 4, MB_INNER, KS_MB, gridDim.x, blockIdx.x);
      pg8::gemm_phase(lds, pg8::Gemm{fb.yzn, fb.wbot, MB_INNER, MB_INNER, 0}, S, pg8::EpiAccF32{c.hmid, D, f.slab + (size_t)16 * 16 * 65536, MP / 256, MS / 256, KS_MB}); }
    GBAR();
}

__device__ __forceinline__ void layer_mla_fast(const Ctx& c, const Fast& f, const FastMla& fm, const XcdBarrier& bar, LDSP unsigned char* lds) {
    using namespace cfg;
    constexpr int l = 1, j = 0;
    norm_rows_bf16(c.x, c.in[I_NMIX] + l * D, f.xnb, f.slab, KS_FFN, GW_NOW(), NGW_NOW(), LANE_NOW());
    GBAR();
    DUP(27, { pg8::Order<> S; S.init(MP / 256, MS / 256, 4, D, 1, gridDim.x, blockIdx.x);
      pg8::gemm_phase(lds, pg8::Gemm{f.xnb, fm.wint, D, D, 0}, S, pg8::EpiF32{fm.mh, 1024, 1024}); });
    GBAR();
    DUP(14, mla_norm1_fast(c, fm, j, GW_NOW(), NGW_NOW(), LANE_NOW()));
    GBAR();
    DUP(27, { pg8::Order<> S; S.init(MP / 256, MS / 256, (MH * QD) / 256, QL, 1, gridDim.x, blockIdx.x);
      pg8::gemm_phase(lds, pg8::Gemm{fm.qan, fm.wuqt, QL, QL, 0}, S, pg8::EpiBf16<0>{fm.qraw, MH * QD}); }
    { pg8::Order<> S; S.init(MP / 256, MS / 256, 4, KVL, 1, gridDim.x, blockIdx.x);
      pg8::gemm_phase(lds, pg8::Gemm{fm.cb, fm.wukvt, KVL, KVL, 0}, S, pg8::EpiBf16<0>{fm.kvraw, 2048}); }
    { pg8::Order<> S; S.init(4, 0, MTOT / 256, KVL, 1, gridDim.x, blockIdx.x);
      pg8::gemm_phase(lds, pg8::Gemm{fm.wukvt + (size_t)1024 * KVL, fm.cb, KVL, KVL, 0}, S, pg8::EpiBf16<0>{fm.vT, MTOT}); });
    GBAR();
    DUP(15, mla_norm2_fast(c, fm, j, GW_NOW(), NGW_NOW(), LANE_NOW()));
    GBAR();
    DUP(5, attn_prompt_fast(fm.qf, fm.knb, fm.kpb, fm.vT, fm.aob, lds));
    __syncthreads();
    DUP(4, mla_sample_decode(c, fm, fm.qs, fm.opart, fm.lpart, j, lds));
    GBAR();
    DUP(16, mla_sample_combine(c, fm, fm.opart, fm.lpart, j, lds));
    GBAR();
    { pg8::Order<> S; S.init(MP / 256, MS / 256, 4, D, KS_1K, gridDim.x, blockIdx.x);
      pg8::gemm_phase(lds, pg8::Gemm{fm.aob, fm.wot, D, D, 0}, S, pg8::EpiAccF32{c.x, D, f.slab, MP / 256, MS / 256, KS_1K}); }
    if (PROBE_DUP & (1 << 27)) { GBAR(); pg8::Order<> S; S.init(MP / 256, MS / 256, 4, D, KS_1K, gridDim.x, blockIdx.x);
      pg8::gemm_phase(lds, pg8::Gemm{fm.aob, fm.wot, D, D, 0}, S, pg8::EpiAccF32{c.hmid, D, f.slab + (size_t)16 * 16 * 65536, MP / 256, MS / 256, KS_1K}); }
    GBAR();
}

template <int L>
__device__ __forceinline__ void layer_ffn_fast(const Ctx& c, const Fast& f, const XcdBarrier& bar, LDSP unsigned char* lds) {
    using namespace cfg;
    norm_rows_bf16(c.x, c.in[I_NFFN] + L * D, f.xnb, f.slab, (L % 3 == 2) ? KS_MB : KS_1K, GW_NOW(), NGW_NOW(), LANE_NOW());
    GBAR();
    DUP(0, { pg8::Order<> S; S.init(MP / 256, MS / 256, FFN / 256, D, 1, gridDim.x, blockIdx.x);
      pg8::gemm_phase(lds, pg8::Gemm{f.xnb, f.w1t + (size_t)L * FFN * D, D, D, 0}, S, pg8::EpiBf16<3>{f.hmidb, FFN}); });
    GBAR();
    { pg8::Order<> S; S.init(MP / 256, MS / 256, D / 256, FFN, (L == DEPTH - 1) ? 1 : KS_FFN, gridDim.x, blockIdx.x);
      pg8::gemm_phase(lds, pg8::Gemm{f.hmidb, f.w2t + (size_t)L * D * FFN, FFN, FFN, 0}, S, pg8::EpiAccF32{c.x, D, f.slab, MP / 256, MS / 256, (L == DEPTH - 1) ? 1 : KS_FFN}); }
    if (PROBE_DUP & (1 << 25)) { GBAR(); pg8::Order<> S; S.init(MP / 256, MS / 256, D / 256, FFN, (L == DEPTH - 1) ? 1 : KS_FFN, gridDim.x, blockIdx.x);
      pg8::gemm_phase(lds, pg8::Gemm{f.hmidb, f.w2t + (size_t)L * D * FFN, FFN, FFN, 0}, S, pg8::EpiAccF32{c.hmid, D, f.slab + (size_t)16 * 16 * 65536, MP / 256, MS / 256, (L == DEPTH - 1) ? 1 : KS_FFN}); }
    GBAR();
}

__global__ void __launch_bounds__(512, 2) mega10(MegaArgs a) {
    LDSP unsigned char* lds = (LDSP unsigned char*)dynlds;
    if (threadIdx.x < 4) ((LDSP unsigned*)(lds + LDS_XB))[threadIdx.x] = 0u;
    __syncthreads();
    XcdBarrier bar = xcd_barrier_post(a.bar, (volatile LAS unsigned*)(lds + LDS_XB));
    const Ctx& c = a.c; const Fast& f = a.f; const FastMla& fm = a.fm; const FastRw& fr = a.fr; const FastMb& fb = a.fb;
    using namespace cfg;
    DUP(10, {
        LDSP float* scr = (LDSP float*)(lds + LDS_STAGE) + (tid_now() >> 6) * (64 * 33);
        for (int l = 0; l < DEPTH; ++l) {
            tr_weight(c.in[I_FW1] + (size_t)l * D * FFN, D, FFN, FFN, f.w1t + (size_t)l * FFN * D, nullptr, scr, GW_NOW(), NGW_NOW(), LANE_NOW());
            tr_weight(c.in[I_FW2] + (size_t)l * FFN * D, FFN, D, D, f.w2t + (size_t)l * D * FFN, nullptr, scr, GW_NOW(), NGW_NOW(), LANE_NOW());
        }
        tr_weight(c.in[I_MWIN], D, MLA_IN, 1024, fm.wint, nullptr, scr, GW_NOW(), NGW_NOW(), LANE_NOW());
        tr_weight(c.in[I_WUQ], QL, MH * QD, MH * QD, fm.wuqt, nullptr, scr, GW_NOW(), NGW_NOW(), LANE_NOW());
        tr_weight(c.in[I_WUK], KVL, MH * NOPE, MH * NOPE, fm.wukvt, nullptr, scr, GW_NOW(), NGW_NOW(), LANE_NOW());
        tr_weight(c.in[I_WUV], KVL, MH * VD, MH * VD, fm.wukvt + (size_t)1024 * KVL, nullptr, scr, GW_NOW(), NGW_NOW(), LANE_NOW());
        tr_weight(c.in[I_MWO], MH * VD, D, D, fm.wot, nullptr, scr, GW_NOW(), NGW_NOW(), LANE_NOW());
        for (int j = 0; j < N_RWKV; ++j) {
            bf16_t* wt = fr.wrkvt + (size_t)j * 4096 * D;
            for (int p = 0; p < 3; ++p) tr_weight(c.in[I_WRKV] + ((size_t)j * 3 + p) * D * D, D, D, D, wt + (size_t)p * D * D, nullptr, scr, GW_NOW(), NGW_NOW(), LANE_NOW());
            tr_weight(c.in[I_W1] + (size_t)j * D * RW_DL, D, RW_DL, 256, wt + (size_t)3072 * D, nullptr, scr, GW_NOW(), NGW_NOW(), LANE_NOW());
            tr_weight(c.in[I_A1] + (size_t)j * D * RW_AL, D, RW_AL, 256, wt + (size_t)3328 * D, nullptr, scr, GW_NOW(), NGW_NOW(), LANE_NOW());
            tr_weight(c.in[I_G1] + (size_t)j * D * RW_GL, D, RW_GL, 256, wt + (size_t)3584 * D, nullptr, scr, GW_NOW(), NGW_NOW(), LANE_NOW());
            tr_weight(j > 0 ? c.in[I_V1] + (size_t)(j - 1) * D * RW_VL : c.in[I_W1], D, j > 0 ? RW_VL : 0, 256, wt + (size_t)3840 * D, nullptr, scr, GW_NOW(), NGW_NOW(), LANE_NOW());
            tr_weight(c.in[I_RWO] + (size_t)j * D * D, D, D, D, fr.wot + (size_t)j * D * D, nullptr, scr, GW_NOW(), NGW_NOW(), LANE_NOW());
            rw_build_lorat(c, fr.lorat + (size_t)j * 4096 * 384, j, GTID_NOW(), GSZ_NOW());
        }
        tr_weight(c.in[I_BWIN], D, MB_IN, 5376, fb.wbint, nullptr, scr, GW_NOW(), NGW_NOW(), LANE_NOW());
        tr_weight(c.in[I_BWO], MB_INNER, D, D, fb.wbot, nullptr, scr, GW_NOW(), NGW_NOW(), LANE_NOW());
        ph_copy_x(c, 0, GTID_NOW(), GSZ_NOW());
    });
    GBAR();
    layer_rwkv_fast<0>(c, f, fr, bar, lds); layer_ffn_fast<0>(c, f, bar, lds);
    layer_mla_fast(c, f, fm, bar, lds); layer_ffn_fast<1>(c, f, bar, lds);
    layer_mamba_fast(c, f, fb, bar, lds); layer_ffn_fast<2>(c, f, bar, lds);
    layer_rwkv_fast<3>(c, f, fr, bar, lds); layer_ffn_fast<3>(c, f, bar, lds);
}

extern "C" void kernel_launch(void* const* d_in, const int* in_sizes, int n_in, void* d_out, int out_size, void* d_ws, size_t ws_size, hipStream_t stream) {
    using namespace cfg;
    MegaArgs a{};
    size_t used = setup_ctx(a.c, d_in, d_out, d_ws);
    { Bump b{(char*)d_ws, (size_t)((char*)a.c.xm[0] - (char*)d_ws)}; FastRw& r = a.fr;
      r.xm = (bf16_t*)b.f((size_t)6 * MTOT * D / 2); r.rkv = (bf16_t*)b.f((size_t)MTOT * 3072 / 2); r.hb = (bf16_t*)b.f((size_t)MTOT * 384 / 2); r.lu = (bf16_t*)b.f((size_t)MTOT * 4096 / 2);
      r.ops = b.f((size_t)MTOT * RHEADS * RW_REC + 4096); r.yo = (bf16_t*)b.f((size_t)MTOT * D / 2); r.vf = a.c.vf;
      if (b.off > (size_t)((char*)a.c.hmid - (char*)d_ws) + (size_t)MTOT * FFN * 4) { fprintf(stderr, "RWKV overlay too large\n"); return; } }
    { Bump b{(char*)d_ws, used};
      a.f.xnb = (bf16_t*)b.f((size_t)MTOT * D / 2); a.f.hmidb = (bf16_t*)b.f((size_t)MTOT * FFN / 2);
      a.f.w1t = (bf16_t*)b.f((size_t)DEPTH * FFN * D / 2); a.f.w2t = (bf16_t*)b.f((size_t)DEPTH * FFN * D / 2); a.f.slab = b.f((size_t)2 * 16 * 16 * 65536);
      FastMla& m = a.fm;
      m.mh = b.f((size_t)MTOT * 1024); m.qan = (bf16_t*)b.f((size_t)MTOT * QL / 2); m.cb = (bf16_t*)b.f((size_t)MTOT * KVL / 2); m.kpb = (bf16_t*)b.f((size_t)MTOT * ROPE / 2);
      m.qraw = (bf16_t*)b.f((size_t)MTOT * 1536 / 2); m.kvraw = (bf16_t*)b.f((size_t)MTOT * 2048 / 2); m.qf = (bf16_t*)b.f((size_t)MTOT * 1536 / 2); m.knb = (bf16_t*)b.f((size_t)MTOT * 1024 / 2);
      m.aob = (bf16_t*)b.f((size_t)MTOT * 1024 / 2); m.vT = (bf16_t*)b.f((size_t)MTOT * 1024 / 2); m.qs = (bf16_t*)b.f((size_t)MS * 1536 / 2);
      m.opart = b.f((size_t)2 * DB * 128 * 256); m.lpart = b.f((size_t)2 * DB * 128);
      m.wint = (bf16_t*)b.f((size_t)1024 * 1024 / 2); m.wuqt = (bf16_t*)b.f((size_t)1536 * 512 / 2); m.wukvt = (bf16_t*)b.f((size_t)2048 * 256 / 2); m.wot = (bf16_t*)b.f((size_t)1024 * 1024 / 2);
      { FastMb& q = a.fb; q.zb = (bf16_t*)b.f((size_t)MTOT * 2048 / 2); q.xbcr = (bf16_t*)b.f((size_t)MTOT * 3072 / 2); q.dtraw = b.f((size_t)MTOT * 32); q.xbcb = (bf16_t*)b.f((size_t)MTOT * 3072 / 2);
        q.dt = b.f((size_t)MTOT * 32); q.y = a.c.my; q.yzn = (bf16_t*)b.f((size_t)MTOT * 2048 / 2); q.wbint = (bf16_t*)b.f((size_t)5376 * 1024 / 2); q.wbot = (bf16_t*)b.f((size_t)1024 * 2048 / 2); }
      a.fr.wrkvt = (bf16_t*)b.f((size_t)N_RWKV * 4096 * D / 2); a.fr.lorat = (bf16_t*)b.f((size_t)N_RWKV * 4096 * 384 / 2); a.fr.wot = (bf16_t*)b.f((size_t)N_RWKV * D * D / 2);
      used = b.off; }
    if (used > ws_size || n_in != 51) { fprintf(stderr, "workspace too small: need %zu have %zu (n_in %d)\n", used, ws_size, n_in); return; }
    a.bar = (unsigned*)d_ws;
    static int grid = 0;
    if (!grid) {
        int dev = 0, cus = 0, per_cu = 0;
        (void)hipGetDevice(&dev); (void)hipDeviceGetAttribute(&cus, hipDeviceAttributeMultiprocessorCount, dev);
        if (hipFuncSetAttribute((const void*)mega10, hipFuncAttributeMaxDynamicSharedMemorySize, LDS_BYTES) != hipSuccess) { fprintf(stderr, "hipFuncSetAttribute failed\n"); grid = -1; return; }
        (void)hipOccupancyMaxActiveBlocksPerMultiprocessor(&per_cu, (const void*)mega10, 512, LDS_BYTES);
        (void)hipGetLastError();
        grid = per_cu >= 1 ? (cus < 256 ? cus : 256) : -1;
    }
    if (grid <= 0) { fprintf(stderr, "kernel does not fit one workgroup per CU\n"); return; }
    (void)hipMemsetAsync(a.bar, 0, XCD_BAR_WORDS * sizeof(unsigned), stream);
    hipLaunchKernelGGL(mega10, dim3(grid), dim3(512), LDS_BYTES, stream, a);
}
```

```cpp
#include <hip/hip_runtime.h>
#include <cstdio>
#include <math.h>
#include <stdint.h>
#include <stddef.h>
#ifdef CPU_EMU
#define DEV inline
#else
#define DEV __device__ __forceinline__
#endif

namespace cfg {
#ifdef CFG_SMALL
constexpr int D = 128, BATCH = 2, SEQ = 32, DEPTH = 4, DB = 3, DS = 8, PAST = 64, PAGE = 16;
constexpr int RW_DL = 16, RW_AL = 16, RW_VL = 8, RW_GL = 24;
constexpr int MH = 2, QL = 64, KVL = 32;
constexpr int MB_GROUPS = 2;
#else
constexpr int D = 1024, BATCH = 16, SEQ = 2048, DEPTH = 4, DB = 128, DS = 8, PAST = 8192, PAGE = 128;
constexpr int RW_DL = 64, RW_AL = 64, RW_VL = 32, RW_GL = 160;
constexpr int MH = 16, QL = 512, KVL = 256;
constexpr int MB_GROUPS = 4;
#endif
constexpr int N_RWKV = (DEPTH + 2) / 3, N_MLA = (DEPTH + 1) / 3, N_MAMBA = DEPTH / 3;
constexpr int RH = 64, RHEADS = D / RH;
constexpr int NOPE = 64, ROPE = 32, VD = 64, QD = NOPE + ROPE;
constexpr int MLA_IN = QL + KVL + ROPE;
constexpr int MB_INNER = 2 * D, MB_HEAD = 64, MB_HEADS = MB_INNER / MB_HEAD, MB_STATE = 128, MB_CONV = 4;
constexpr int MB_GN = MB_GROUPS * MB_STATE;
constexpr int MB_CD = MB_INNER + 2 * MB_GN, MB_IN = MB_INNER + MB_CD + MB_HEADS;
constexpr int FFN = 4 * D;
constexpr int NPAGES = PAST / PAGE, NPOOL = (DB * NPAGES * 5) / 4;
constexpr int MP = BATCH * SEQ, MS = DB * DS, MTOT = MP + MS, NSEQ = BATCH + DB;
constexpr int KTOT = PAST + DS;
constexpr float NORM_EPS = 1e-6f, LNX_EPS = 64e-5f;
constexpr size_t O_YP = 0;
constexpr size_t O_YS = O_YP + (size_t)MP * D;
constexpr size_t O_CKVP = O_YS + (size_t)MS * D;
constexpr size_t O_KPEP = O_CKVP + (size_t)N_MLA * MP * KVL;
constexpr size_t O_CKVS = O_KPEP + (size_t)N_MLA * MP * ROPE;
constexpr size_t O_KPES = O_CKVS + (size_t)N_MLA * MS * KVL;
constexpr size_t O_WKVP = O_KPES + (size_t)N_MLA * MS * ROPE;
constexpr size_t O_SHP = O_WKVP + (size_t)N_RWKV * BATCH * RHEADS * RH * RH;
constexpr size_t O_WKVS = O_SHP + (size_t)N_RWKV * BATCH * D;
constexpr size_t O_SHS = O_WKVS + (size_t)N_RWKV * DB * RHEADS * RH * RH;
constexpr size_t O_SSMP = O_SHS + (size_t)N_RWKV * DB * D;
constexpr size_t O_CONVP = O_SSMP + (size_t)N_MAMBA * BATCH * MB_HEADS * MB_HEAD * MB_STATE;
constexpr size_t O_SSMS = O_CONVP + (size_t)N_MAMBA * BATCH * (MB_CONV - 1) * MB_CD;
constexpr size_t O_CONVS = O_SSMS + (size_t)N_MAMBA * DB * MB_HEADS * MB_HEAD * MB_STATE;
constexpr size_t O_END = O_CONVS + (size_t)N_MAMBA * DB * (MB_CONV - 1) * MB_CD;
}

struct Ctx {
    const float* in[51];
    const int* page_table;
    float* out;
    float *x, *xn, *vf;
    float* xm[6];
    float *r, *k, *v, *wpre, *apre, *vpre, *g, *hw, *ha, *hv, *hg, *ka, *kb, *y, *yo;
    float *hmid;
    float *mh, *qan, *q, *c, *kp, *knr, *vv, *ao, *sc, *olat;
    float *zx, *xbc, *dt, *my, *yzn;
};

DEV int row_t(int m) { return m < cfg::MP ? m % cfg::SEQ : (m - cfg::MP) % cfg::DS; }
DEV int row_seq(int m) { return m < cfg::MP ? m / cfg::SEQ : cfg::BATCH + (m - cfg::MP) / cfg::DS; }
DEV int seq_row0(int sq) { return sq < cfg::BATCH ? sq * cfg::SEQ : cfg::MP + (sq - cfg::BATCH) * cfg::DS; }
DEV int seq_len(int sq) { return sq < cfg::BATCH ? cfg::SEQ : cfg::DS; }
DEV float sigmoidf_(float x) { return 1.0f / (1.0f + expf(-x)); }
DEV float softplusf_(float x) { return x > 20.f ? x : log1pf(expf(x)); }
DEV float siluf_(float x) { return x * sigmoidf_(x); }

enum { I_XP = 0, I_XS, I_CKV, I_KPE, I_WKV, I_SHIFT, I_SSM, I_CONV, I_PT, I_NMIX, I_NFFN, I_FW1, I_FW2, I_MU, I_WRKV, I_W0, I_W1, I_W2, I_A0, I_A1, I_A2,
       I_V0, I_V1, I_V2, I_G1, I_G2, I_KK, I_KA, I_RK, I_LNW, I_LNB, I_RWO, I_MWIN, I_QNORM, I_KVNORM, I_WUQ, I_WUK, I_WUV, I_QNN, I_QRN, I_KNN, I_KRN, I_MWO,
       I_BWIN, I_CONVW, I_CONVB, I_DTB, I_ALOG, I_BD, I_BNORM, I_BWO };

#define UNROLL _Pragma("unroll")
#define GSL(i, n) for (size_t i = gtid; i < (size_t)(n); i += gsz)

DEV void ph_copy_x(const Ctx& c, int, size_t gtid, size_t gsz) {
    using namespace cfg;
    GSL(i, (size_t)MTOT * D) c.x[i] = i < (size_t)MP * D ? c.in[I_XP][i] : c.in[I_XS][i - (size_t)MP * D];
}
DEV void rmsnorm_rows(const float* x, const float* gain, float* xn, size_t gtid, size_t gsz) {
    using namespace cfg;
    GSL(m, MTOT) {
        const float* xr = x + m * D; float ss = 0.f;
        for (int i = 0; i < D; ++i) ss += xr[i] * xr[i];
        const float rs = 1.0f / sqrtf(ss / D + NORM_EPS);
        for (int i = 0; i < D; ++i) xn[m * D + i] = xr[i] * rs * gain[i];
    }
}
DEV void ph_norm_mix(const Ctx& c, int l, size_t gtid, size_t gsz) { rmsnorm_rows(c.x, c.in[I_NMIX] + l * cfg::D, c.xn, gtid, gsz); }
DEV void ph_norm_ffn(const Ctx& c, int l, size_t gtid, size_t gsz) { rmsnorm_rows(c.x, c.in[I_NFFN] + l * cfg::D, c.xn, gtid, gsz); }

DEV void ph_rw_mix(const Ctx& c, int l, size_t gtid, size_t gsz) {
    using namespace cfg; const int j = l / 3;
    GSL(i, (size_t)MTOT * D) {
        const int m = (int)(i / D), ch = (int)(i % D), t = row_t(m), sq = row_seq(m);
        const float xc = c.xn[i];
        float xp;
        if (t > 0) xp = c.xn[i - D];
        else xp = sq < BATCH ? 0.f : c.in[I_SHIFT][((size_t)j * DB + (sq - BATCH)) * D + ch];
        for (int p = 0; p < 6; ++p) c.xm[p][i] = xc + (xp - xc) * c.in[I_MU][((size_t)j * 6 + p) * D + ch];
        if (t == seq_len(sq) - 1) {
            if (sq < BATCH) c.out[O_SHP + ((size_t)j * BATCH + sq) * D + ch] = xc;
            else c.out[O_SHS + ((size_t)j * DB + (sq - BATCH)) * D + ch] = xc;
        }
    }
}
DEV void ph_rw_prep(const Ctx& c, int l, size_t gtid, size_t gsz) {
    using namespace cfg; const int j = l / 3;
    GSL(i, (size_t)MTOT * RHEADS) {
        const int m = (int)(i / RHEADS), h = (int)(i % RHEADS);
        const size_t o = (size_t)m * D + h * RH;
        float nn = 0.f;
        for (int e = 0; e < RH; ++e) { const float kk = c.k[o + e] * c.in[I_KK][j * D + h * RH + e]; nn += kk * kk; }
        const float inv = 1.0f / fmaxf(sqrtf(nn), 1e-12f);
        for (int e = 0; e < RH; ++e) {
            const int ch = h * RH + e;
            const float wl = -softplusf_(-(c.in[I_W0][j * D + ch] + c.wpre[o + e])) - 0.5f;
            const float decay = expf(-expf(wl));
            float vv = c.v[o + e];
            if (j == 0) c.vf[o + e] = vv;
            else vv = vv + (c.vf[o + e] - vv) * sigmoidf_(c.in[I_V0][(j - 1) * D + ch] + c.vpre[o + e]);
            const float a = sigmoidf_(c.in[I_A0][j * D + ch] + c.apre[o + e]);
            const float k0 = c.k[o + e];
            const float kk = k0 * c.in[I_KK][j * D + ch] * inv;
            c.k[o + e] = k0 * (1.0f + (a - 1.0f) * c.in[I_KA][j * D + ch]);
            c.v[o + e] = vv;
            c.wpre[o + e] = decay;
            c.ka[o + e] = -kk;
            c.kb[o + e] = kk * a;
        }
    }
}
DEV void ph_rw_scan(const Ctx& c, int l, size_t gtid, size_t gsz) {
    using namespace cfg; const int j = l / 3;
    GSL(i, (size_t)NSEQ * RHEADS * RH) {
        const int sq = (int)(i / (RHEADS * RH)), h = (int)(i / RH) % RHEADS, vi = (int)(i % RH);
        float S[RH];
        if (sq < BATCH) { UNROLL for (int e = 0; e < RH; ++e) S[e] = 0.f; }
        else { const float* s0 = c.in[I_WKV] + ((((size_t)j * DB + (sq - BATCH)) * RHEADS + h) * RH + vi) * RH; UNROLL for (int e = 0; e < RH; ++e) S[e] = s0[e]; }
        const int m0 = seq_row0(sq), T = seq_len(sq);
        for (int t = 0; t < T; ++t) {
            const size_t o = (size_t)(m0 + t) * D + h * RH;
            float sa = 0.f;
            UNROLL for (int e = 0; e < RH; ++e) sa += S[e] * c.ka[o + e];
            const float vt = c.v[o + vi]; float yy = 0.f;
            UNROLL for (int e = 0; e < RH; ++e) { S[e] = S[e] * c.wpre[o + e] + sa * c.kb[o + e] + vt * c.k[o + e]; yy += S[e] * c.r[o + e]; }
            c.y[o + vi] = yy;
        }
        float* so = sq < BATCH ? c.out + O_WKVP + ((((size_t)j * BATCH + sq) * RHEADS + h) * RH + vi) * RH
                               : c.out + O_WKVS + ((((size_t)j * DB + (sq - BATCH)) * RHEADS + h) * RH + vi) * RH;
        UNROLL for (int e = 0; e < RH; ++e) so[e] = S[e];
    }
}
DEV void ph_rw_post(const Ctx& c, int l, size_t gtid, size_t gsz) {
    using namespace cfg; const int j = l / 3;
    GSL(i, (size_t)MTOT * RHEADS) {
        const int m = (int)(i / RHEADS), h = (int)(i % RHEADS);
        const size_t o = (size_t)m * D + h * RH;
        float mean = 0.f; for (int e = 0; e < RH; ++e) mean += c.y[o + e]; mean /= RH;
        float var = 0.f; for (int e = 0; e < RH; ++e) { const float d = c.y[o + e] - mean; var += d * d; } var /= RH;
        const float rs = 1.0f / sqrtf(var + LNX_EPS);
        float bonus = 0.f; for (int e = 0; e < RH; ++e) bonus += c.r[o + e] * c.k[o + e] * c.in[I_RK][(size_t)j * D + h * RH + e];
        for (int e = 0; e < RH; ++e) {
            const int ch = h * RH + e;
            const float yn = (c.y[o + e] - mean) * rs * c.in[I_LNW][j * D + ch] + c.in[I_LNB][j * D + ch];
            c.yo[o + e] = (yn + bonus * c.v[o + e]) * c.g[o + e];
        }
    }
}

DEV void rope_apply(const float* xin, float* xout, int pos) {
    using namespace cfg; const int half = ROPE / 2;
    UNROLL for (int i = 0; i < half; ++i) {
        const float inv = exp2f(-(float)i * (13.287712379549449f / half));
        const float ang = (float)pos * inv;
        const float kq = rintf(ang * 0.15915494309189535f);
        float rr = fmaf(-kq, 6.28125f, ang); rr = fmaf(-kq, 1.9353071795864769e-3f, rr);
        const float cs = __cosf(rr), sn = __sinf(rr);
        const float x1 = xin[i], x2 = xin[i + half];
        xout[i] = x1 * cs - x2 * sn; xout[i + half] = x2 * cs + x1 * sn;
    }
}
DEV int row_pos(int m) { return m < cfg::MP ? m % cfg::SEQ : cfg::PAST + (m - cfg::MP) % cfg::DS; }
DEV void ph_mla_norm1(const Ctx& c, int l, size_t gtid, size_t gsz) {
    using namespace cfg; const int j = l / 3;
    GSL(m, MTOT) {
        const float* h = c.mh + m * MLA_IN;
        float ss = 0.f; for (int i = 0; i < QL; ++i) ss += h[i] * h[i];
        float rs = 1.0f / sqrtf(ss / QL + NORM_EPS);
        for (int i = 0; i < QL; ++i) c.qan[m * QL + i] = h[i] * rs * c.in[I_QNORM][j * QL + i];
        ss = 0.f; for (int i = 0; i < KVL; ++i) ss += h[QL + i] * h[QL + i];
        rs = 1.0f / sqrtf(ss / KVL + NORM_EPS);
        float* co = m < (size_t)MP ? c.out + O_CKVP + ((size_t)j * MP + m) * KVL : c.out + O_CKVS + ((size_t)j * MS + (m - MP)) * KVL;
        for (int i = 0; i < KVL; ++i) { const float v = h[QL + i] * rs * c.in[I_KVNORM][j * KVL + i]; c.c[m * KVL + i] = v; co[i] = v; }
        ss = 0.f; UNROLL for (int i = 0; i < ROPE; ++i) ss += h[QL + KVL + i] * h[QL + KVL + i];
        rs = 1.0f / sqrtf(ss / ROPE + NORM_EPS);
        float tmp[ROPE], ro[ROPE];
        UNROLL for (int i = 0; i < ROPE; ++i) tmp[i] = h[QL + KVL + i] * rs * c.in[I_KRN][j * ROPE + i];
        rope_apply(tmp, ro, row_pos((int)m));
        float* ko = m < (size_t)MP ? c.out + O_KPEP + ((size_t)j * MP + m) * ROPE : c.out + O_KPES + ((size_t)j * MS + (m - MP)) * ROPE;
        UNROLL for (int i = 0; i < ROPE; ++i) { c.kp[m * ROPE + i] = ro[i]; ko[i] = ro[i]; }
    }
}
DEV void ph_mla_norm2(const Ctx& c, int l, size_t gtid, size_t gsz) {
    using namespace cfg; const int j = l / 3;
    GSL(i, (size_t)MTOT * MH) {
        const int m = (int)(i / MH), h = (int)(i % MH);
        float* q = c.q + (size_t)m * MH * QD + h * QD;
        float ss = 0.f; UNROLL for (int e = 0; e < NOPE; ++e) ss += q[e] * q[e];
        float rs = 1.0f / sqrtf(ss / NOPE + NORM_EPS);
        UNROLL for (int e = 0; e < NOPE; ++e) q[e] = q[e] * rs * c.in[I_QNN][j * NOPE + e];
        ss = 0.f; UNROLL for (int e = 0; e < ROPE; ++e) ss += q[NOPE + e] * q[NOPE + e];
        rs = 1.0f / sqrtf(ss / ROPE + NORM_EPS);
        float tmp[ROPE], ro[ROPE];
        UNROLL for (int e = 0; e < ROPE; ++e) tmp[e] = q[NOPE + e] * rs * c.in[I_QRN][j * ROPE + e];
        rope_apply(tmp, ro, row_pos(m));
        UNROLL for (int e = 0; e < ROPE; ++e) q[NOPE + e] = ro[e];
        float* kn = c.knr + (size_t)m * MH * NOPE + h * NOPE;
        ss = 0.f; UNROLL for (int e = 0; e < NOPE; ++e) ss += kn[e] * kn[e];
        rs = 1.0f / sqrtf(ss / NOPE + NORM_EPS);
        UNROLL for (int e = 0; e < NOPE; ++e) kn[e] = kn[e] * rs * c.in[I_KNN][j * NOPE + e];
    }
}
DEV void ph_mla_attn_prompt(const Ctx& c, int, size_t gtid, size_t gsz) {
    using namespace cfg; const float scale = 1.0f / sqrtf((float)QD);
    GSL(i, (size_t)MP * MH) {
        const int m = (int)(i / MH), h = (int)(i % MH), t = m % SEQ, m0 = m - t;
        const float* q = c.q + (size_t)m * MH * QD + h * QD;
        float mx = -INFINITY, den = 0.f, acc[VD];
        UNROLL for (int e = 0; e < VD; ++e) acc[e] = 0.f;
        for (int kx = 0; kx <= t; ++kx) {
            const int mk = m0 + kx;
            const float* kn = c.knr + (size_t)mk * MH * NOPE + h * NOPE; const float* kp = c.kp + (size_t)mk * ROPE;
            float s = 0.f;
            UNROLL for (int e = 0; e < NOPE; ++e) s += q[e] * kn[e];
            UNROLL for (int e = 0; e < ROPE; ++e) s += q[NOPE + e] * kp[e];
            s *= scale;
            const float nm = fmaxf(mx, s), corr = expf(mx - nm), p = expf(s - nm);
            den = den * corr + p;
            const float* v = c.vv + (size_t)mk * MH * VD + h * VD;
            UNROLL for (int e = 0; e < VD; ++e) acc[e] = acc[e] * corr + p * v[e];
            mx = nm;
        }
        UNROLL for (int e = 0; e < VD; ++e) c.ao[(size_t)m * MH * VD + h * VD + e] = acc[e] / den;
    }
}
DEV const float* smp_c(const Ctx& c, int j, int s, int pos) {
    using namespace cfg;
    if (pos < PAST) { const int pg = c.page_table[s * NPAGES + pos / PAGE]; return c.in[I_CKV] + (((size_t)j * NPOOL + pg) * PAGE + pos % PAGE) * KVL; }
    return c.c + (size_t)(MP + s * DS + (pos - PAST)) * KVL;
}
DEV const float* smp_kp(const Ctx& c, int j, int s, int pos) {
    using namespace cfg;
    if (pos < PAST) { const int pg = c.page_table[s * NPAGES + pos / PAGE]; return c.in[I_KPE] + (((size_t)j * NPOOL + pg) * PAGE + pos % PAGE) * ROPE; }
    return c.kp + (size_t)(MP + s * DS + (pos - PAST)) * ROPE;
}
DEV void ph_mla_score_sample(const Ctx& c, int l, size_t gtid, size_t gsz) {
    using namespace cfg; const int j = l / 3; const float scale = 1.0f / sqrtf((float)QD);
    GSL(i, (size_t)DB * KTOT * MH) {
        const int pos = (int)(i % KTOT), h = (int)((i / KTOT) % MH), s = (int)(i / ((size_t)MH * KTOT));
        const float* cl = smp_c(c, j, s, pos); const float* kp = smp_kp(c, j, s, pos);
        float kn[NOPE];
        UNROLL for (int e = 0; e < NOPE; ++e) kn[e] = 0.f;
        const float* wuk = c.in[I_WUK] + (size_t)j * KVL * MH * NOPE;
        for (int r = 0; r < KVL; ++r) { const float cv = cl[r]; const float* w = wuk + ((size_t)r * MH + h) * NOPE; UNROLL for (int e = 0; e < NOPE; ++e) kn[e] += cv * w[e]; }
        float ss = 0.f; UNROLL for (int e = 0; e < NOPE; ++e) ss += kn[e] * kn[e];
        const float rs = 1.0f / sqrtf(ss / NOPE + NORM_EPS);
        UNROLL for (int e = 0; e < NOPE; ++e) kn[e] = kn[e] * rs * c.in[I_KNN][j * NOPE + e];
        for (int qi = 0; qi < DS; ++qi) {
            const float* q = c.q + (size_t)(MP + s * DS + qi) * MH * QD + h * QD;
            float sc = 0.f;
            UNROLL for (int e = 0; e < NOPE; ++e) sc += q[e] * kn[e];
            UNROLL for (int e = 0; e < ROPE; ++e) sc += q[NOPE + e] * kp[e];
            const bool ok = pos < PAST || (pos - PAST) <= qi;
            c.sc[(((size_t)s * MH + h) * DS + qi) * KTOT + pos] = ok ? sc * scale : -INFINITY;
        }
    }
}
DEV void ph_mla_softmax_sample(const Ctx& c, int, size_t gtid, size_t gsz) {
    using namespace cfg;
    GSL(i, (size_t)DB * MH * DS) {
        float* sc = c.sc + i * KTOT;
        float mx = -INFINITY; for (int p = 0; p < KTOT; ++p) mx = fmaxf(mx, sc[p]);
        float den = 0.f; for (int p = 0; p < KTOT; ++p) den += expf(sc[p] - mx);
        const float inv = 1.0f / den;
        for (int p = 0; p < KTOT; ++p) sc[p] = expf(sc[p] - mx) * inv;
    }
}
DEV void ph_mla_pv_sample(const Ctx& c, int l, size_t gtid, size_t gsz) {
    using namespace cfg; const int j = l / 3;
    GSL(i, (size_t)DB * MH * DS * KVL) {
        const int r = (int)(i % KVL); const size_t row = i / KVL; const int s = (int)(row / (MH * DS));
        const float* p = c.sc + row * KTOT; float acc = 0.f;
        for (int pos = 0; pos < KTOT; ++pos) acc += p[pos] * smp_c(c, j, s, pos)[r];
        c.olat[i] = acc;
    }
}
DEV void ph_mla_out_sample(const Ctx& c, int l, size_t gtid, size_t gsz) {
    using namespace cfg; const int j = l / 3;
    GSL(i, (size_t)MS * MH * VD) {
        const int e = (int)(i % VD), h = (int)((i / VD) % MH), ms = (int)(i / (MH * VD)), s = ms / DS, qi = ms % DS;
        const float* ol = c.olat + (((size_t)s * MH + h) * DS + qi) * KVL;
        const float* wuv = c.in[I_WUV] + (size_t)j * KVL * MH * VD;
        float acc = 0.f;
        for (int r = 0; r < KVL; ++r) acc += ol[r] * wuv[((size_t)r * MH + h) * VD + e];
        c.ao[(size_t)(MP + ms) * MH * VD + h * VD + e] = acc;
    }
}

DEV float mb_xpad(const Ctx& c, int j, int m, int sq, int tt, int ch) {
    using namespace cfg;
    if (tt < MB_CONV - 1) return sq < BATCH ? 0.f : c.in[I_CONV][(((size_t)j * DB + (sq - BATCH)) * (MB_CONV - 1) + tt) * MB_CD + ch];
    (void)m; return c.zx[(size_t)(seq_row0(sq) + tt - (MB_CONV - 1)) * MB_IN + MB_INNER + ch];
}
DEV void ph_mb_conv(const Ctx& c, int l, size_t gtid, size_t gsz) {
    using namespace cfg; const int j = l / 3;
    GSL(i, (size_t)MTOT * MB_CD) {
        const int m = (int)(i / MB_CD), ch = (int)(i % MB_CD), t = row_t(m), sq = row_seq(m), T = seq_len(sq);
        float acc = c.in[I_CONVB][j * MB_CD + ch];
        for (int jj = 0; jj < MB_CONV; ++jj) acc += mb_xpad(c, j, m, sq, t + jj, ch) * c.in[I_CONVW][((size_t)j * MB_CONV + jj) * MB_CD + ch];
        c.xbc[i] = siluf_(acc);
        if (t < MB_CONV - 1) {
            const float v = mb_xpad(c, j, m, sq, T + t, ch);
            if (sq < BATCH) c.out[O_CONVP + (((size_t)j * BATCH + sq) * (MB_CONV - 1) + t) * MB_CD + ch] = v;
            else c.out[O_CONVS + (((size_t)j * DB + (sq - BATCH)) * (MB_CONV - 1) + t) * MB_CD + ch] = v;
        }
    }
}
DEV void ph_mb_dt(const Ctx& c, int l, size_t gtid, size_t gsz) {
    using namespace cfg; const int j = l / 3;
    GSL(i, (size_t)MTOT * MB_HEADS) {
        const int m = (int)(i / MB_HEADS), h = (int)(i % MB_HEADS);
        c.dt[i] = softplusf_(c.zx[(size_t)m * MB_IN + MB_INNER + MB_CD + h] + c.in[I_DTB][j * MB_HEADS + h]);
    }
}
DEV void ph_mb_scan(const Ctx& c, int l, size_t gtid, size_t gsz) {
    using namespace cfg; const int j = l / 3;
    GSL(i, (size_t)NSEQ * MB_HEADS * MB_HEAD) {
        const int p = (int)(i % MB_HEAD), h = (int)((i / MB_HEAD) % MB_HEADS), sq = (int)(i / (MB_HEADS * MB_HEAD));
        const int g = h / (MB_HEADS / MB_GROUPS);
        float hs[MB_STATE];
        if (sq < BATCH) { UNROLL for (int n = 0; n < MB_STATE; ++n) hs[n] = 0.f; }
        else { const float* s0 = c.in[I_SSM] + ((((size_t)j * DB + (sq - BATCH)) * MB_HEADS + h) * MB_HEAD + p) * MB_STATE; UNROLL for (int n = 0; n < MB_STATE; ++n) hs[n] = s0[n]; }
        const float A = -expf(c.in[I_ALOG][j * MB_HEADS + h]), dsk = c.in[I_BD][j * MB_HEADS + h];
        const int m0 = seq_row0(sq), T = seq_len(sq);
        for (int t = 0; t < T; ++t) {
            const size_t m = (size_t)(m0 + t);
            const float dtv = c.dt[m * MB_HEADS + h], dA = expf(dtv * A);
            const float xv = c.xbc[m * MB_CD + h * MB_HEAD + p], xdt = xv * dtv;
            const float* Bm = c.xbc + m * MB_CD + MB_INNER + g * MB_STATE; const float* Cm = Bm + MB_GN;
            float yy = 0.f;
            UNROLL for (int n = 0; n < MB_STATE; ++n) { hs[n] = hs[n] * dA + xdt * Bm[n]; yy += Cm[n] * hs[n]; }
            c.my[m * MB_INNER + h * MB_HEAD + p] = yy + dsk * xv;
        }
        float* so = sq < BATCH ? c.out + O_SSMP + ((((size_t)j * BATCH + sq) * MB_HEADS + h) * MB_HEAD + p) * MB_STATE
                               : c.out + O_SSMS + ((((size_t)j * DB + (sq - BATCH)) * MB_HEADS + h) * MB_HEAD + p) * MB_STATE;
        UNROLL for (int n = 0; n < MB_STATE; ++n) so[n] = hs[n];
    }
}
DEV void ph_mb_gate(const Ctx& c, int l, size_t gtid, size_t gsz) {
    using namespace cfg; const int j = l / 3; constexpr int GW = MB_INNER / MB_GROUPS;
    GSL(i, (size_t)MTOT * MB_GROUPS) {
        const int m = (int)(i / MB_GROUPS), g = (int)(i % MB_GROUPS);
        float ss = 0.f;
        for (int e = 0; e < GW; ++e) { const float v = c.my[(size_t)m * MB_INNER + g * GW + e] * siluf_(c.zx[(size_t)m * MB_IN + g * GW + e]); ss += v * v; }
        const float rs = 1.0f / sqrtf(ss / GW + NORM_EPS);
        for (int e = 0; e < GW; ++e) {
            const float v = c.my[(size_t)m * MB_INNER + g * GW + e] * siluf_(c.zx[(size_t)m * MB_IN + g * GW + e]);
            c.yzn[(size_t)m * MB_INNER + g * GW + e] = v * rs * c.in[I_BNORM][j * MB_INNER + g * GW + e];
        }
    }
}
typedef short bf16x8_t __attribute__((ext_vector_type(8)));
typedef float f32x4_t __attribute__((ext_vector_type(4)));
__device__ __forceinline__ unsigned short f2bf(float f) { unsigned u = __float_as_uint(f); u += 0x7fffu + ((u >> 16) & 1u); return (unsigned short)(u >> 16); }
#define XB_TMO      128
#define XB_XCNT(j)  (256  + 64 * (j))
#define XB_XSUB(j)  (1280 + 64 * (j))
#define XB_XGEN(j)  (2304 + 64 * (j))
#define XB_TOP      3328
#define XB_TOPGEN   3392
#define XCD_BAR_WORDS 3456
#define XB_SPIN_CAP (1u << 25)
#define LAS __attribute__((address_space(3)))

__device__ __forceinline__ unsigned xb_ld(unsigned* p)              { return __hip_atomic_load(p, __ATOMIC_RELAXED, __HIP_MEMORY_SCOPE_AGENT); }
__device__ __forceinline__ unsigned xb_add(unsigned* p, unsigned v) { return __hip_atomic_fetch_add(p, v, __ATOMIC_RELAXED, __HIP_MEMORY_SCOPE_AGENT); }
__device__ __forceinline__ unsigned xb_xcc_id() { return (unsigned)__builtin_amdgcn_s_getreg((3 << 11) | 20) & 0xFu; }
#define XB_SPIN(cond, bar) do { unsigned _sp = 0; while (cond) { __builtin_amdgcn_s_sleep(1); \
    if ((++_sp & 255u) == 0u) { if (xb_ld(&(bar)[XB_TMO])) break; if (_sp > XB_SPIN_CAP) { atomicAdd(&(bar)[XB_TMO], 1u); break; } } } } while (0)

struct XcdBarrier {
    unsigned* bar; unsigned x;
    volatile LAS unsigned* st;
};

__device__ __forceinline__ XcdBarrier xcd_barrier_post(unsigned* bar, volatile LAS unsigned* st) {
    XcdBarrier b; b.bar = bar; b.x = xb_xcc_id(); b.st = st;
    if (threadIdx.x == 0) (void)xb_add(&bar[XB_XCNT(b.x)], 1u);
    return b;
}
__device__ __forceinline__ void xcd_barrier_complete(unsigned* bar, unsigned x, unsigned& nloc, unsigned& nx) {
    const unsigned G = gridDim.x * gridDim.y * gridDim.z;
    unsigned sum, cnt, mine, sp = 0u;
    for (;;) {
        sum = 0u; cnt = 0u; mine = 0u;
#pragma unroll
        for (unsigned j = 0; j < 16; ++j) { const unsigned c = xb_ld(&bar[XB_XCNT(j)]); sum += c; cnt += (c > 0u) ? 1u : 0u; mine = (j == x) ? c : mine; }
        if (sum == G) break;
        __builtin_amdgcn_s_sleep(1);
        if ((++sp & 255u) == 0u) { if (xb_ld(&bar[XB_TMO])) break; if (sp > XB_SPIN_CAP) { atomicAdd(&bar[XB_TMO], 1u); break; } }
    }
    nloc = mine > 0u ? mine : 1u; nx = cnt > 0u ? cnt : 1u;
}

__device__ __forceinline__ void xcd_barrier(const XcdBarrier& b) {
    asm volatile("s_waitcnt vmcnt(0)" ::: "memory");
    __syncthreads();
    if (threadIdx.x == 0) {
        unsigned* bar = b.bar;
        __builtin_amdgcn_s_waitcnt(0);
        unsigned nloc = b.st[0], nx = b.st[1];
        if (nloc == 0u) { xcd_barrier_complete(bar, b.x, nloc, nx); b.st[0] = nloc; b.st[1] = nx; }
        const unsigned old = xb_add(&bar[XB_XSUB(b.x)], 1u);
        const unsigned gen = old / nloc;
        if (old + 1u == (gen + 1u) * nloc) {
            __builtin_amdgcn_fence(__ATOMIC_RELEASE, "agent");
            asm volatile("s_waitcnt vmcnt(0)" ::: "memory");
            const unsigned og = xb_add(&bar[XB_TOP], 1u);
            const unsigned tg = og / nx;
            if (og + 1u == (tg + 1u) * nx) xb_add(&bar[XB_TOPGEN], 1u);
            else XB_SPIN(xb_ld(&bar[XB_TOPGEN]) == tg, bar);
            __builtin_amdgcn_fence(__ATOMIC_ACQUIRE, "agent");
            xb_add(&bar[XB_XGEN(b.x)], 1u);
            asm volatile("s_waitcnt vmcnt(0)" ::: "memory");
        } else {
            XB_SPIN(xb_ld(&bar[XB_XGEN(b.x)]) == gen, bar);
            __builtin_amdgcn_fence(__ATOMIC_ACQUIRE, "agent");
            asm volatile("s_waitcnt vmcnt(0)" ::: "memory");
        }
    }
    __syncthreads();
}

struct Bump { char* p; size_t off; float* f(size_t n) { float* r = (float*)(p + off); off += ((n * 4 + 255) / 256) * 256; return r; } };

static size_t setup_ctx(Ctx& c, void* const* d_in, void* d_out, void* d_ws) {
    using namespace cfg;
    for (int i = 0; i < 51; ++i) c.in[i] = (const float*)d_in[i];
    c.page_table = (const int*)d_in[I_PT];
    c.out = (float*)d_out; c.x = c.out;
    Bump b{(char*)d_ws, 4096 * 4};
    const size_t MD = (size_t)MTOT * D;
    c.xn = b.f(MD); c.vf = b.f(MD);
    const size_t base = b.off;
    for (int p = 0; p < 6; ++p) c.xm[p] = b.f(MD);
    c.r = b.f(MD); c.k = b.f(MD); c.v = b.f(MD); c.wpre = b.f(MD); c.apre = b.f(MD); c.vpre = b.f(MD); c.g = b.f(MD);
    c.hw = b.f((size_t)MTOT * RW_DL); c.ha = b.f((size_t)MTOT * RW_AL); c.hv = b.f((size_t)MTOT * RW_VL); c.hg = b.f((size_t)MTOT * RW_GL);
    c.ka = b.f(MD); c.kb = b.f(MD); c.y = c.xm[0]; c.yo = c.xm[1];
    size_t hi = b.off;
    b.off = base;
    c.mh = b.f((size_t)MTOT * MLA_IN); c.qan = b.f((size_t)MTOT * QL); c.q = b.f((size_t)MTOT * MH * QD); c.c = b.f((size_t)MTOT * KVL); c.kp = b.f((size_t)MTOT * ROPE);
    c.knr = b.f((size_t)MTOT * MH * NOPE); c.vv = b.f((size_t)MTOT * MH * VD); c.ao = b.f((size_t)MTOT * MH * VD);
    c.sc = b.f((size_t)DB * MH * DS * KTOT); c.olat = b.f((size_t)DB * MH * DS * KVL);
    if (b.off > hi) hi = b.off;
    b.off = base;
    c.zx = b.f((size_t)MTOT * MB_IN); c.xbc = b.f((size_t)MTOT * MB_CD); c.dt = b.f((size_t)MTOT * MB_HEADS); c.my = b.f((size_t)MTOT * MB_INNER); c.yzn = b.f((size_t)MTOT * MB_INNER);
    if (b.off > hi) hi = b.off;
    b.off = hi;
    c.hmid = b.f((size_t)MTOT * FFN);
    return b.off;
}

__device__ __forceinline__ unsigned tid_now() { unsigned t = threadIdx.x; asm volatile("" : "+v"(t)); return t; }
namespace pg8 {
#define PG8_LAS __attribute__((address_space(3)))
typedef unsigned short bf16_t;
typedef short bf16x8 __attribute__((ext_vector_type(8)));
typedef float f32x4 __attribute__((ext_vector_type(4)));
typedef float f32x2 __attribute__((ext_vector_type(2)));
typedef unsigned u32x4 __attribute__((ext_vector_type(4)));
typedef unsigned u32x2 __attribute__((ext_vector_type(2)));
constexpr int BM = 256, BK = 64, HALF = 128, HTB = HALF * BK * 2  , STAGE_BYTES = 8 * HTB, NXCD = 8, WGM = 8;

__host__ __device__ __forceinline__ int lds_byte(int r, int c) { const int st = (r >> 4) * 2 + (c >> 5), rr = r & 15, cc = c & 31, ob = rr * 64 + cc * 2; return st * 1024 + (ob ^ (((ob >> 9) & 1) << 5)); }
__host__ __device__ __forceinline__ void stage_rc(int b, int& R, int& C) { const int st = b / 1024, sb = b % 1024, swz = sb ^ (((sb >> 9) & 1) << 5); R = (st >> 1) * 16 + swz / 64; C = (st & 1) * 32 + (swz % 64) / 2; }
__host__ __device__ __forceinline__ int perm32(int rho) { const int n = rho >> 4, i = rho & 15; return 8 * (i >> 2) + 4 * n + (i & 3); }
__device__ __forceinline__ unsigned cvt_pk_bf16(float lo, float hi) { unsigned r; asm volatile("v_cvt_pk_bf16_f32 %0, %1, %2" : "=v"(r) : "v"(lo), "v"(hi)); return r; }

struct Unit { int pm, pn, k0, nt, asel, part; };
struct Gemm { const bf16_t* A; const bf16_t* Bt; int lda, ldb; size_t asel_stride; };

struct NoSel { __device__ static __forceinline__ int sel(int) { return 0; } };
template <class ASEL = NoSel>
struct Order {
    int nMp, nMs, nN, nwgP, nwgS, G, c, K, ksplit;
    __device__ __forceinline__ void init(int nMp_, int nMs_, int nN_, int K_, int ksplit_, int G_, int c_) { nMp = nMp_; nMs = nMs_; nN = nN_; nwgP = nMp * nN; K = K_; ksplit = ksplit_; nwgS = nMs * nN * ksplit; G = G_; c = c_; }
    __device__ __forceinline__ bool next(int i, Unit& u) const {
        const long L = (long)i * G + c;
        if (L < nwgP) {
            int wgid = (int)L; { const int q = nwgP / NXCD, r = nwgP % NXCD, xcd = wgid % NXCD, off = wgid / NXCD; wgid = (xcd < r ? xcd * (q + 1) : r * (q + 1) + (xcd - r) * q) + off; }
            const int nig = WGM * nN, gid = wgid / nig, fm = gid * WGM, gsz = (nMp - fm) < WGM ? (nMp - fm) : WGM;
            u.pm = fm + ((wgid % nig) % gsz); u.pn = (wgid % nig) / gsz; u.k0 = 0; u.nt = K / BK; u.part = 0; u.asel = ASEL::sel(u.pn); return true;
        }
        const long Ls = L - nwgP; if (Ls >= nwgS) return false;
        const int sub = (int)(Ls % ksplit), t = (int)(Ls / ksplit);
        u.pm = nMp + t % nMs; u.pn = t / nMs; u.nt = K / BK / ksplit; u.k0 = sub * u.nt * BK; u.part = ksplit > 1 ? 1 : 0; u.asel = ASEL::sel(u.pn); return true;
    }
};

template <class Epi, class Sched>
__device__ __forceinline__ void gemm_phase(PG8_LAS unsigned char* lds, const Gemm g, const Sched& S, const Epi& E) {
    const int tid = (int)tid_now(), wid = __builtin_amdgcn_readfirstlane(tid >> 6), lane = tid & 63, wr = wid >> 2, wc = wid & 3, fr = lane & 15, fq = lane >> 4;
    unsigned voffA[2], voffB[2];
#pragma unroll
    for (int i = 0; i < 2; ++i) { int R, C; stage_rc(tid * 16 + i * 8192, R, C); const int Rb = Epi::PERM ? ((R & ~31) + perm32(R & 31)) : R;
        voffA[i] = (unsigned)(R * g.lda + C) * 2u; voffB[i] = (unsigned)(Rb * g.ldb + C) * 2u; }
    const size_t kstep = (size_t)(BK * 2);
    const size_t hstepA = (size_t)HALF * g.lda * 2, hstepB = (size_t)HALF * g.ldb * 2;
    const unsigned ldsw = (unsigned)wid * 1024u;
    const int aoff = lds_byte(wr * 64 + fr, fq * 8), boff = lds_byte(wc * 32 + fr, fq * 8);
#define PG8_SA(b, h) (((b) * 2 + (h)) * HTB)
#define PG8_SB(b, h) ((4 + (b) * 2 + (h)) * HTB)
#define PG8_STAGE(bufoff, gbase, voff) do { _Pragma("unroll") for (int _i = 0; _i < 2; ++_i) \
        __builtin_amdgcn_global_load_lds((const unsigned*)((const char*)(gbase) + (voff)[_i]), (PG8_LAS unsigned*)(lds + (bufoff) + ldsw + _i * 8192), 16, 0, 0); } while (0)
#define PG8_LDA(dst, b, h) do { _Pragma("unroll") for (int m = 0; m < 4; ++m) _Pragma("unroll") for (int k = 0; k < 2; ++k) dst[m][k] = *(const PG8_LAS bf16x8*)(lds + PG8_SA(b, h) + aoff + m * 2048 + k * 1024); } while (0)
#define PG8_LDB(dst, b, h) do { _Pragma("unroll") for (int n = 0; n < 2; ++n) _Pragma("unroll") for (int k = 0; k < 2; ++k) dst[n][k] = *(const PG8_LAS bf16x8*)(lds + PG8_SB(b, h) + boff + n * 2048 + k * 1024); } while (0)
#define PG8_MMA(ai, bj, At, Bt) do { __builtin_amdgcn_s_setprio(1); _Pragma("unroll") for (int m = 0; m < 4; ++m) _Pragma("unroll") for (int n = 0; n < 2; ++n) _Pragma("unroll") for (int k = 0; k < 2; ++k) \
        acc[ai][bj][m][n] = __builtin_amdgcn_mfma_f32_16x16x32_bf16(Bt[n][k], At[m][k], acc[ai][bj][m][n], 0, 0, 0); __builtin_amdgcn_s_setprio(0); } while (0)
#define PG8_WAIT_V(n) asm volatile("s_waitcnt vmcnt(" #n ")" ::: "memory")
#define PG8_WAIT_L(n) asm volatile("s_waitcnt lgkmcnt(" #n ")" ::: "memory")
#define PG8_BAR __builtin_amdgcn_s_barrier()
#define PG8_SCHED __builtin_amdgcn_sched_barrier(0)
#define PG8_ABASE(u) ((const char*)g.A + ((size_t)(u).asel * g.asel_stride + (size_t)(u).pm * BM * g.lda + (u).k0) * 2)
#define PG8_BBASE(u) ((const char*)g.Bt + ((size_t)(u).pn * BM * g.ldb + (u).k0) * 2)
    Unit cur, nxt; int ui = 0;
    if (!S.next(0, cur)) return;
    f32x4 acc[2][2][4][2];
#pragma unroll
    for (int a = 0; a < 2; ++a)
#pragma unroll
        for (int b = 0; b < 2; ++b)
#pragma unroll
            for (int m = 0; m < 4; ++m)
#pragma unroll
                for (int n = 0; n < 2; ++n) acc[a][b][m][n] = (f32x4){0.f, 0.f, 0.f, 0.f};
    bf16x8 At[4][2], B0[2][2], B1[2][2];
    const char* cA = PG8_ABASE(cur); const char* cB = PG8_BBASE(cur);
    PG8_STAGE(PG8_SB(0, 0), cB, voffB); PG8_STAGE(PG8_SA(0, 0), cA, voffA); PG8_STAGE(PG8_SB(0, 1), cB + hstepB, voffB); PG8_STAGE(PG8_SA(0, 1), cA + hstepA, voffA);
    if (wr == 1) PG8_BAR;
    PG8_WAIT_V(4); PG8_BAR;
    PG8_STAGE(PG8_SB(1, 0), cB + kstep, voffB); PG8_STAGE(PG8_SA(1, 0), cA + kstep, voffA); PG8_STAGE(PG8_SB(1, 1), cB + hstepB + kstep, voffB);
    PG8_WAIT_V(6); PG8_BAR;
    for (;;) {
        const bool has_next = S.next(ui + 1, nxt);
        const char* nA = has_next ? PG8_ABASE(nxt) : cA; const char* nB = has_next ? PG8_BBASE(nxt) : cB;
        const int nt = cur.nt;
        for (int t = 0; t < nt; t += 2) {
            const bool last = (t == nt - 2);
            const char* a1 = cA + (size_t)(t + 1) * kstep;
            const char* a2 = last ? nA : cA + (size_t)(t + 2) * kstep; const char* b2 = last ? nB : cB + (size_t)(t + 2) * kstep;
            const char* a3 = a2 + kstep; const char* b3 = b2 + kstep;
            PG8_LDB(B0, 0, 0); PG8_SCHED; PG8_LDA(At, 0, 0); PG8_STAGE(PG8_SA(1, 1), a1 + hstepA, voffA);
            PG8_WAIT_L(8); PG8_BAR; PG8_WAIT_L(0); PG8_MMA(0, 0, At, B0); PG8_BAR; PG8_SCHED;
            PG8_LDB(B1, 0, 1); PG8_STAGE(PG8_SB(0, 0), b2, voffB);
            PG8_BAR; PG8_WAIT_L(0); PG8_MMA(0, 1, At, B1); PG8_BAR;
            PG8_LDA(At, 0, 1); PG8_STAGE(PG8_SA(0, 0), a2, voffA);
            PG8_BAR; PG8_WAIT_L(0); PG8_MMA(1, 0, At, B0); PG8_BAR; PG8_SCHED;
            PG8_STAGE(PG8_SB(0, 1), b2 + hstepB, voffB);
            PG8_WAIT_V(6); PG8_BAR; PG8_MMA(1, 1, At, B1); PG8_BAR;
            PG8_LDB(B0, 1, 0); PG8_SCHED; PG8_LDA(At, 1, 0); PG8_STAGE(PG8_SA(0, 1), a2 + hstepA, voffA);
            PG8_WAIT_L(8); PG8_BAR; PG8_WAIT_L(0); PG8_MMA(0, 0, At, B0); PG8_BAR; PG8_SCHED;
            PG8_LDB(B1, 1, 1); PG8_STAGE(PG8_SB(1, 0), b3, voffB);
            PG8_BAR; PG8_WAIT_L(0); PG8_MMA(0, 1, At, B1); PG8_BAR;
            PG8_LDA(At, 1, 1); PG8_STAGE(PG8_SA(1, 0), a3, voffA);
            PG8_BAR; PG8_WAIT_L(0); PG8_MMA(1, 0, At, B0); PG8_BAR; PG8_SCHED;
            PG8_STAGE(PG8_SB(1, 1), b3 + hstepB, voffB);
            PG8_WAIT_V(6); PG8_BAR; PG8_MMA(1, 1, At, B1); PG8_BAR;
        }
        E(acc, cur, wr, wc, fr, fq);
        if (!has_next) break;
#pragma unroll
        for (int a = 0; a < 2; ++a)
#pragma unroll
            for (int b = 0; b < 2; ++b)
#pragma unroll
                for (int m = 0; m < 4; ++m)
#pragma unroll
                    for (int n = 0; n < 2; ++n) acc[a][b][m][n] = (f32x4){0.f, 0.f, 0.f, 0.f};
        cur = nxt; cA = nA; cB = nB; ++ui;
    }
    PG8_WAIT_V(0);
    if (wr == 0) PG8_BAR;
    PG8_BAR;
#undef PG8_SA
#undef PG8_SB
#undef PG8_STAGE
#undef PG8_LDA
#undef PG8_LDB
#undef PG8_MMA
#undef PG8_WAIT_V
#undef PG8_WAIT_L
#undef PG8_BAR
#undef PG8_SCHED
#undef PG8_ABASE
#undef PG8_BBASE
}

struct EpiAccF32 {
    static constexpr bool PERM = false;
    float* C; int ldc; float* slab; int pm0, nMs, ksplit;
    __device__ __forceinline__ void operator()(const f32x4 (&acc)[2][2][4][2], const Unit& u, int wr, int wc, int fr, int fq) const {
        if (u.part) {
            float* sl = slab + ((size_t)((u.pn * nMs + (u.pm - pm0)) * ksplit + u.k0 / (u.nt * BK)) * BM + wr * 64 + fr) * BM + wc * 32 + 4 * fq;
#pragma unroll
            for (int ai = 0; ai < 2; ++ai)
#pragma unroll
                for (int m = 0; m < 4; ++m) { float* rowp = sl + (size_t)(ai * HALF + m * 16) * BM;
#pragma unroll
                    for (int bj = 0; bj < 2; ++bj)
#pragma unroll
                        for (int n = 0; n < 2; ++n) *(f32x4*)(rowp + bj * HALF + n * 16) = acc[ai][bj][m][n]; }
        } else {
            const int row0 = u.pm * BM + wr * 64 + fr, col0 = u.pn * BM + wc * 32 + 4 * fq;
#pragma unroll
            for (int ai = 0; ai < 2; ++ai)
#pragma unroll
                for (int m2 = 0; m2 < 4; m2 += 2) {
                    f32x4 t[2][2][2];
#pragma unroll
                    for (int mm = 0; mm < 2; ++mm) { const float* rowp = C + (size_t)(row0 + ai * HALF + (m2 + mm) * 16) * ldc + col0;
#pragma unroll
                        for (int bj = 0; bj < 2; ++bj)
#pragma unroll
                            for (int n = 0; n < 2; ++n) t[mm][bj][n] = *(const f32x4*)(rowp + bj * HALF + n * 16); }
#pragma unroll
                    for (int mm = 0; mm < 2; ++mm) { float* rowp = C + (size_t)(row0 + ai * HALF + (m2 + mm) * 16) * ldc + col0;
#pragma unroll
                        for (int bj = 0; bj < 2; ++bj)
#pragma unroll
                            for (int n = 0; n < 2; ++n) *(f32x4*)(rowp + bj * HALF + n * 16) = t[mm][bj][n] + acc[ai][bj][m2 + mm][n]; }
                }
        }
    }
};
struct EpiF32 {
    static constexpr bool PERM = false;
    float* C; int ldc; int ncols;
    __device__ __forceinline__ void operator()(const f32x4 (&acc)[2][2][4][2], const Unit& u, int wr, int wc, int fr, int fq) const {
        const int row0 = u.pm * BM + wr * 64 + fr, col0 = u.pn * BM + wc * 32 + 4 * fq;
#pragma unroll
        for (int ai = 0; ai < 2; ++ai)
#pragma unroll
            for (int m = 0; m < 4; ++m) { float* rowp = C + (size_t)(row0 + ai * HALF + m * 16) * ldc + col0;
#pragma unroll
                for (int bj = 0; bj < 2; ++bj)
#pragma unroll
                    for (int n = 0; n < 2; ++n) if (col0 + bj * HALF + n * 16 < ncols) *(f32x4*)(rowp + bj * HALF + n * 16) = acc[ai][bj][m][n]; }
    }
};
template <int ACT> struct EpiBf16 {
    static constexpr bool PERM = true;
    bf16_t* O; int ldc;
    __device__ __forceinline__ void operator()(const f32x4 (&acc)[2][2][4][2], const Unit& u, int wr, int wc, int fr, int fq) const {
        const int row0 = u.pm * BM + wr * 64 + fr, col0 = u.pn * BM + wc * 32 + 8 * fq;
#pragma unroll
        for (int ai = 0; ai < 2; ++ai)
#pragma unroll
            for (int m = 0; m < 4; ++m) { bf16_t* rowp = O + (size_t)(row0 + ai * HALF + m * 16) * ldc + col0;
#pragma unroll
                for (int bj = 0; bj < 2; ++bj) { f32x4 v0 = acc[ai][bj][m][0], v1 = acc[ai][bj][m][1];
                    if (ACT == 3) {
#pragma unroll
                        for (int j = 0; j < 4; ++j) { const float a = fmaxf(v0[j], 0.f), b = fmaxf(v1[j], 0.f); v0[j] = a * a; v1[j] = b * b; } }
                    u32x4 w; w.x = cvt_pk_bf16(v0[0], v0[1]); w.y = cvt_pk_bf16(v0[2], v0[3]); w.z = cvt_pk_bf16(v1[0], v1[1]); w.w = cvt_pk_bf16(v1[2], v1[3]);
                    *(u32x4*)(rowp + bj * HALF) = w; } }
    }
};
}
typedef pg8::bf16_t bf16_t;
#define LDSP __attribute__((address_space(3)))
struct Fast {
    bf16_t *xnb, *hmidb;
    bf16_t *w1t, *w2t;
    float* slab;
};
__device__ __forceinline__ unsigned pk2bf(float lo, float hi) { return pg8::cvt_pk_bf16(lo, hi); }
__device__ __forceinline__ float wave_sum64(float v) {
#pragma unroll
    for (int o = 1; o < 64; o <<= 1) v += __shfl_xor(v, o);
    return v;
}
__device__ __forceinline__ void tr_item(const float* __restrict__ W, int ldw, int K, bf16_t* WT, int nvalid, const float* __restrict__ kscale, LDSP float* scr, int item, int nblk, int lane) {
    const int kb = item / nblk, nb = item % nblk, k0 = 64 * kb, n0 = 32 * nb;
    const bool ok = n0 < nvalid;
#pragma unroll
    for (int i = 0; i < 8; ++i) { const int kk = 8 * i + (lane >> 3), nn = 4 * (lane & 7); pg8::f32x4 v = ok ? *(const pg8::f32x4*)(W + (size_t)(k0 + kk) * ldw + n0 + nn) : (pg8::f32x4){0.f, 0.f, 0.f, 0.f};
        if (kscale) v = v * kscale[k0 + kk];
        scr[kk * 33 + nn] = v[0]; scr[kk * 33 + nn + 1] = v[1]; scr[kk * 33 + nn + 2] = v[2]; scr[kk * 33 + nn + 3] = v[3]; }
    asm volatile("s_waitcnt lgkmcnt(0)" ::: "memory");
    const int c = lane & 7;
#pragma unroll
    for (int j = 0; j < 4; ++j) { const int n = (lane >> 3) + 8 * j; const LDSP float* s = scr + (8 * c) * 33 + n;
        pg8::u32x4 o; o.x = pk2bf(s[0 * 33], s[1 * 33]); o.y = pk2bf(s[2 * 33], s[3 * 33]); o.z = pk2bf(s[4 * 33], s[5 * 33]); o.w = pk2bf(s[6 * 33], s[7 * 33]);
        *(pg8::u32x4*)(WT + (size_t)(n0 + n) * K + k0 + 8 * c) = o; }
    asm volatile("s_waitcnt lgkmcnt(0)" ::: "memory");
}
__device__ __forceinline__ void tr_weight(const float* W, int K, int N, int npad, bf16_t* WT, const float* kscale, LDSP float* scr, int gw, int ngw, int lane) {
    const int nblk = npad / 32, items = (K / 64) * nblk;
    for (int it = gw; it < items; it += ngw) tr_item(W, N, K, WT, N, kscale, scr, it, nblk, lane);
}
__device__ __forceinline__ pg8::f32x4 slab_sum(const float* __restrict__ slab, int ksplit, int m, int q, int lane) {
    using namespace cfg; const int rs = m - MP, pms = rs >> 8, row = rs & 255;
    const float* p = slab + ((size_t)((q * (MS / 256) + pms) * ksplit) * 256 + row) * 256 + 4 * lane;
    pg8::f32x4 s = {0.f, 0.f, 0.f, 0.f};
    for (int k = 0; k < ksplit; ++k) s = s + *(const pg8::f32x4*)(p + (size_t)k * 65536);
    return s;
}
__device__ __forceinline__ void norm_rows_bf16(float* __restrict__ x, const float* __restrict__ gain, bf16_t* xn, const float* __restrict__ slab, int ksplit, int gw, int ngw, int lane) {
    using namespace cfg;
    pg8::f32x4 gv[4];
#pragma unroll
    for (int j = 0; j < 4; ++j) gv[j] = *(const pg8::f32x4*)(gain + 4 * lane + 256 * j);
    for (int m = gw; m < MTOT; m += ngw) {
        float* xr = x + (size_t)m * D; pg8::f32x4 v[4]; float s = 0.f;
#pragma unroll
        for (int j = 0; j < 4; ++j) { v[j] = *(const pg8::f32x4*)(xr + 4 * lane + 256 * j);
            if (ksplit > 1 && m >= MP) { v[j] = v[j] + slab_sum(slab, ksplit, m, j, lane); *(pg8::f32x4*)(xr + 4 * lane + 256 * j) = v[j]; }
            s += (v[j][0] * v[j][0] + v[j][1] * v[j][1]) + (v[j][2] * v[j][2] + v[j][3] * v[j][3]); }
        const float rs = 1.0f / sqrtf(wave_sum64(s) * (1.0f / D) + NORM_EPS);
#pragma unroll
        for (int j = 0; j < 4; ++j) { pg8::u32x2 o; o.x = pk2bf(v[j][0] * rs * gv[j][0], v[j][1] * rs * gv[j][1]); o.y = pk2bf(v[j][2] * rs * gv[j][2], v[j][3] * rs * gv[j][3]);
            *(pg8::u32x2*)(xn + (size_t)m * D + 4 * lane + 256 * j) = o; }
    }
}

__device__ __forceinline__ void fold_sample_rows(float* __restrict__ x, const float* __restrict__ slab, int ksplit, int gw, int ngw, int lane) {
    using namespace cfg;
    for (int m = MP + gw; m < MTOT; m += ngw) {
#pragma unroll
        for (int j = 0; j < 4; ++j) { float* p = x + (size_t)m * D + 4 * lane + 256 * j; *(pg8::f32x4*)p = *(const pg8::f32x4*)p + slab_sum(slab, ksplit, m, j, lane); }
    }
}
struct FastMla {
    float* mh;
    bf16_t *qan, *cb, *kpb;
    bf16_t *qraw, *kvraw;
    bf16_t *qf, *knb, *aob, *vT, *qs;
    float *opart, *lpart;
    bf16_t *wint, *wuqt, *wukvt, *wot;
};
__device__ __forceinline__ void rope_cs(int pos, int i, float& cs, float& sn) {
    const float inv = exp2f(-(float)i * (13.287712379549449f / 16.0f));
    const float ang = (float)pos * inv, kq = rintf(ang * 0.15915494309189535f);
    float rr = fmaf(-kq, 6.28125f, ang); rr = fmaf(-kq, 1.9353071795864769e-3f, rr);
    cs = __cosf(rr); sn = __sinf(rr);
}
__device__ __forceinline__ float bf2f(unsigned short b) { return __uint_as_float(((unsigned)b) << 16); }
__device__ __forceinline__ void mla_norm1_fast(const Ctx& c, const FastMla& fm, int j, int gw, int ngw, int lane) {
    using namespace cfg;
    for (int m = gw; m < MTOT; m += ngw) {
        const float* h = fm.mh + (size_t)m * 1024;
        pg8::f32x4 qv[2]; float s = 0.f;
#pragma unroll
        for (int t = 0; t < 2; ++t) { qv[t] = *(const pg8::f32x4*)(h + 4 * lane + 256 * t); s += (qv[t][0] * qv[t][0] + qv[t][1] * qv[t][1]) + (qv[t][2] * qv[t][2] + qv[t][3] * qv[t][3]); }
        const float rq = 1.0f / sqrtf(wave_sum64(s) * (1.0f / QL) + NORM_EPS);
#pragma unroll
        for (int t = 0; t < 2; ++t) { const pg8::f32x4 g = *(const pg8::f32x4*)(c.in[I_QNORM] + j * QL + 4 * lane + 256 * t);
            pg8::u32x2 o; o.x = pk2bf(qv[t][0] * rq * g[0], qv[t][1] * rq * g[1]); o.y = pk2bf(qv[t][2] * rq * g[2], qv[t][3] * rq * g[3]);
            *(pg8::u32x2*)(fm.qan + (size_t)m * QL + 4 * lane + 256 * t) = o; }
        const pg8::f32x4 cv = *(const pg8::f32x4*)(h + QL + 4 * lane);
        const float rc = 1.0f / sqrtf(wave_sum64((cv[0] * cv[0] + cv[1] * cv[1]) + (cv[2] * cv[2] + cv[3] * cv[3])) * (1.0f / KVL) + NORM_EPS);
        const pg8::f32x4 gc = *(const pg8::f32x4*)(c.in[I_KVNORM] + j * KVL + 4 * lane);
        const pg8::f32x4 cn = {cv[0] * rc * gc[0], cv[1] * rc * gc[1], cv[2] * rc * gc[2], cv[3] * rc * gc[3]};
        float* co = m < MP ? c.out + O_CKVP + ((size_t)j * MP + m) * KVL : c.out + O_CKVS + ((size_t)j * MS + (m - MP)) * KVL;
        *(pg8::f32x4*)(co + 4 * lane) = cn; *(pg8::f32x4*)(c.c + (size_t)m * KVL + 4 * lane) = cn;
        { pg8::u32x2 o; o.x = pk2bf(cn[0], cn[1]); o.y = pk2bf(cn[2], cn[3]); *(pg8::u32x2*)(fm.cb + (size_t)m * KVL + 4 * lane) = o; }
        const float kv = lane < ROPE ? h[QL + KVL + lane] : 0.f;
        const float rk = 1.0f / sqrtf(wave_sum64(kv * kv) * (1.0f / ROPE) + NORM_EPS);
        const float kn = kv * rk * (lane < ROPE ? c.in[I_KRN][j * ROPE + lane] : 0.f);
        const float other = __shfl_xor(kn, 16);
        float cs, sn; rope_cs(row_pos(m), lane & 15, cs, sn);
        const float ro = lane < 16 ? kn * cs - other * sn : kn * cs + other * sn;
        if (lane < ROPE) {
            float* ko = m < MP ? c.out + O_KPEP + ((size_t)j * MP + m) * ROPE : c.out + O_KPES + ((size_t)j * MS + (m - MP)) * ROPE;
            ko[lane] = ro; c.kp[(size_t)m * ROPE + lane] = ro;
            fm.kpb[(size_t)m * ROPE + lane] = (bf16_t)(pk2bf(ro, 0.f) & 0xffffu);
        }
    }
}
__device__ __forceinline__ void mla_norm2_fast(const Ctx& c, const FastMla& fm, int j, int gw, int ngw, int lane) {
    using namespace cfg;
    const int hd = lane >> 2, qt = lane & 3;
    const float QSC = 0.10206207261596575f * 1.4426950408889634f;
    for (int m = gw; m < MTOT; m += ngw) {
        const bf16_t* qr = fm.qraw + (size_t)m * (MH * QD) + hd * QD;
        float v[16]; float s = 0.f;
        { const pg8::u32x4 a = *(const pg8::u32x4*)(qr + 16 * qt), b = *(const pg8::u32x4*)(qr + 16 * qt + 8); const unsigned w[8] = {a.x, a.y, a.z, a.w, b.x, b.y, b.z, b.w};
#pragma unroll
          for (int i = 0; i < 8; ++i) { v[2 * i] = __uint_as_float(w[i] << 16); v[2 * i + 1] = __uint_as_float(w[i] & 0xffff0000u); } }
#pragma unroll
        for (int i = 0; i < 16; ++i) s += v[i] * v[i];
        s += __shfl_xor(s, 1); s += __shfl_xor(s, 2);
        float rs = 1.0f / sqrtf(s * (1.0f / NOPE) + NORM_EPS);
        bf16_t* qo = fm.qf + (size_t)m * (MH * QD) + hd * QD; float* qo32 = c.q + (size_t)m * (MH * QD) + hd * QD;
        { unsigned w[8], w2[8];
#pragma unroll
          for (int i = 0; i < 8; ++i) { const float a = v[2 * i] * rs * c.in[I_QNN][j * NOPE + 16 * qt + 2 * i], b = v[2 * i + 1] * rs * c.in[I_QNN][j * NOPE + 16 * qt + 2 * i + 1];
              w[i] = pk2bf(a * QSC, b * QSC); qo32[16 * qt + 2 * i] = a; qo32[16 * qt + 2 * i + 1] = b;
              w2[i] = pk2bf(a * QSC * c.in[I_KNN][j * NOPE + 16 * qt + 2 * i], b * QSC * c.in[I_KNN][j * NOPE + 16 * qt + 2 * i + 1]); }
          *(pg8::u32x4*)(qo + 16 * qt) = (pg8::u32x4){w[0], w[1], w[2], w[3]}; *(pg8::u32x4*)(qo + 16 * qt + 8) = (pg8::u32x4){w[4], w[5], w[6], w[7]};
          if (m >= MP) { bf16_t* q2 = fm.qs + (size_t)(m - MP) * (MH * QD) + hd * QD;
              *(pg8::u32x4*)(q2 + 16 * qt) = (pg8::u32x4){w2[0], w2[1], w2[2], w2[3]}; *(pg8::u32x4*)(q2 + 16 * qt + 8) = (pg8::u32x4){w2[4], w2[5], w2[6], w2[7]}; } }
        float r8[8]; s = 0.f;
        { const pg8::u32x4 a = *(const pg8::u32x4*)(qr + NOPE + 8 * qt); const unsigned w[4] = {a.x, a.y, a.z, a.w};
#pragma unroll
          for (int i = 0; i < 4; ++i) { r8[2 * i] = __uint_as_float(w[i] << 16); r8[2 * i + 1] = __uint_as_float(w[i] & 0xffff0000u); } }
#pragma unroll
        for (int i = 0; i < 8; ++i) s += r8[i] * r8[i];
        s += __shfl_xor(s, 1); s += __shfl_xor(s, 2);
        rs = 1.0f / sqrtf(s * (1.0f / ROPE) + NORM_EPS);
        { unsigned w[4]; float o8[8];
#pragma unroll
          for (int i = 0; i < 8; ++i) { const float mine = r8[i] * rs * c.in[I_QRN][j * ROPE + 8 * qt + i]; const float oth = __shfl_xor(mine, 2);
              float cs, sn; rope_cs(row_pos(m), (8 * qt + i) & 15, cs, sn);
              o8[i] = qt < 2 ? mine * cs - oth * sn : mine * cs + oth * sn; qo32[NOPE + 8 * qt + i] = o8[i]; }
#pragma unroll
          for (int i = 0; i < 4; ++i) w[i] = pk2bf(o8[2 * i] * QSC, o8[2 * i + 1] * QSC);
          *(pg8::u32x4*)(qo + NOPE + 8 * qt) = (pg8::u32x4){w[0], w[1], w[2], w[3]};
          if (m >= MP) *(pg8::u32x4*)(fm.qs + (size_t)(m - MP) * (MH * QD) + hd * QD + NOPE + 8 * qt) = (pg8::u32x4){w[0], w[1], w[2], w[3]}; }
        const bf16_t* kr = fm.kvraw + (size_t)m * 2048 + hd * NOPE; s = 0.f;
        { const pg8::u32x4 a = *(const pg8::u32x4*)(kr + 16 * qt), b = *(const pg8::u32x4*)(kr + 16 * qt + 8); const unsigned w[8] = {a.x, a.y, a.z, a.w, b.x, b.y, b.z, b.w};
#pragma unroll
          for (int i = 0; i < 8; ++i) { v[2 * i] = __uint_as_float(w[i] << 16); v[2 * i + 1] = __uint_as_float(w[i] & 0xffff0000u); } }
#pragma unroll
        for (int i = 0; i < 16; ++i) s += v[i] * v[i];
        s += __shfl_xor(s, 1); s += __shfl_xor(s, 2);
        rs = 1.0f / sqrtf(s * (1.0f / NOPE) + NORM_EPS);
        bf16_t* ko = fm.knb + (size_t)m * (MH * NOPE) + hd * NOPE;
        { unsigned w[8];
#pragma unroll
          for (int i = 0; i < 8; ++i) { const float a = v[2 * i] * rs * c.in[I_KNN][j * NOPE + 16 * qt + 2 * i], b = v[2 * i + 1] * rs * c.in[I_KNN][j * NOPE + 16 * qt + 2 * i + 1];
              w[i] = pk2bf(a, b); }
          *(pg8::u32x4*)(ko + 16 * qt) = (pg8::u32x4){w[0], w[1], w[2], w[3]}; *(pg8::u32x4*)(ko + 16 * qt + 8) = (pg8::u32x4){w[4], w[5], w[6], w[7]}; }
    }
}
__device__ __forceinline__ void cvt_f32_bf16(const float* __restrict__ s, bf16_t* d, size_t n, size_t gtid, size_t gsz) {
    for (size_t i = gtid * 4; i < n; i += gsz * 4) { const pg8::f32x4 v = *(const pg8::f32x4*)(s + i); pg8::u32x2 o; o.x = pk2bf(v[0], v[1]); o.y = pk2bf(v[2], v[3]); *(pg8::u32x2*)(d + i) = o; }
}
typedef float f32x16_t __attribute__((ext_vector_type(16)));
typedef pg8::bf16x8 bf16x8v;
constexpr int AT_KROW = 208, AT_VROW = 136, AT_KBUF = 64 * AT_KROW, AT_VBUF = 64 * AT_VROW, AT_LDS = 2 * AT_KBUF + 2 * AT_VBUF;
__device__ __forceinline__ void attn_prompt_fast(const bf16_t* __restrict__ qf, const bf16_t* __restrict__ knb, const bf16_t* __restrict__ kpb, const bf16_t* __restrict__ vT, bf16_t* aob, LDSP unsigned char* lds) {
    using namespace cfg;
    const int tid = (int)tid_now(), w = __builtin_amdgcn_readfirstlane(tid >> 6), lane = tid & 63, l31 = lane & 31, h5 = lane >> 5;
    for (int it = blockIdx.x; it < BATCH * MH * 4; it += gridDim.x) {
        const int bh = it >> 2, pr = it & 3, b = bh / MH, h = bh % MH;
        for (int half = 0; half < 2; ++half) {
            const int qb = half ? 7 - pr : pr, q0 = 256 * qb, nt = 4 * qb + 4;
            const int qg = q0 + 32 * w + l31;
            const size_t mrow = (size_t)b * SEQ + qg;
            bf16x8v qfr[6];
#pragma unroll
            for (int s = 0; s < 6; ++s) qfr[s] = *(const bf16x8v*)(qf + mrow * (MH * QD) + h * QD + 16 * s + 8 * h5);
            f32x16_t O[2];
#pragma unroll
            for (int db = 0; db < 2; ++db)
#pragma unroll
                for (int r = 0; r < 16; ++r) O[db][r] = 0.f;
            float mrun = -1e30f, lrun = 0.f;
            pg8::u32x4 rk, rp, rv;
            const int kkey = tid >> 3, kc8 = tid & 7, pkey = tid >> 2, pc4 = tid & 3;
#define AT_LOAD(t) do { const size_t mk = (size_t)b * SEQ + 64 * (t); \
                rk = *(const pg8::u32x4*)(knb + (mk + kkey) * (MH * NOPE) + h * NOPE + kc8 * 8); \
                if (tid < 256) rp = *(const pg8::u32x4*)(kpb + (mk + pkey) * ROPE + pc4 * 8); \
                rv = *(const pg8::u32x4*)(vT + (size_t)(h * VD + kkey) * MTOT + mk + kc8 * 8); } while (0)
#define AT_STORE(buf) do { LDSP unsigned char* kb_ = lds + (buf) * AT_KBUF; LDSP unsigned char* vb_ = lds + 2 * AT_KBUF + (buf) * AT_VBUF; \
                *(LDSP pg8::u32x4*)(kb_ + kkey * AT_KROW + kc8 * 16) = rk; \
                if (tid < 256) *(LDSP pg8::u32x4*)(kb_ + pkey * AT_KROW + 128 + pc4 * 16) = rp; \
                *(LDSP pg8::u32x2*)(vb_ + kkey * AT_VROW + kc8 * 16) = (pg8::u32x2){rv.x, rv.y}; *(LDSP pg8::u32x2*)(vb_ + kkey * AT_VROW + kc8 * 16 + 8) = (pg8::u32x2){rv.z, rv.w}; } while (0)
            AT_LOAD(0); AT_STORE(0);
            __syncthreads();
            for (int t = 0; t < nt; ++t) {
                if (t + 1 < nt) AT_LOAD(t + 1);
                if (64 * t <= q0 + 32 * w + 31) {
                    const LDSP unsigned char* kb_ = lds + (t & 1) * AT_KBUF; const LDSP unsigned char* vb_ = lds + 2 * AT_KBUF + (t & 1) * AT_VBUF;
                    f32x16_t S[2];
#pragma unroll
                    for (int kb = 0; kb < 2; ++kb)
#pragma unroll
                        for (int r = 0; r < 16; ++r) S[kb][r] = 0.f;
#pragma unroll
                    for (int s = 0; s < 6; ++s)
#pragma unroll
                        for (int kb = 0; kb < 2; ++kb) {
                            const bf16x8v a = *(const LDSP bf16x8v*)(kb_ + (32 * kb + l31) * AT_KROW + (16 * s + 8 * h5) * 2);
                            S[kb] = __builtin_amdgcn_mfma_f32_32x32x16_bf16(a, qfr[s], S[kb], 0, 0, 0);
                        }
                    if (64 * t + 63 > q0 + 32 * w) {
#pragma unroll
                        for (int kb = 0; kb < 2; ++kb)
#pragma unroll
                            for (int r = 0; r < 16; ++r) { const int key = 64 * t + 32 * kb + (r & 3) + 8 * (r >> 2) + 4 * h5; if (key > qg) S[kb][r] = -1e30f; }
                    }
                    float mt = -1e30f;
#pragma unroll
                    for (int kb = 0; kb < 2; ++kb)
#pragma unroll
                        for (int r = 0; r < 16; ++r) mt = fmaxf(mt, S[kb][r]);
                    mt = fmaxf(mt, __shfl_xor(mt, 32));
                    const float mnew = fmaxf(mrun, mt), alpha = exp2f(mrun - mnew);
                    float ls = 0.f;
#pragma unroll
                    for (int kb = 0; kb < 2; ++kb)
#pragma unroll
                        for (int r = 0; r < 16; ++r) { const float p = exp2f(S[kb][r] - mnew); S[kb][r] = p; ls += p; }
                    lrun = lrun * alpha + ls; mrun = mnew;
#pragma unroll
                    for (int db = 0; db < 2; ++db)
#pragma unroll
                        for (int r = 0; r < 16; ++r) O[db][r] *= alpha;
#pragma unroll
                    for (int kb = 0; kb < 2; ++kb)
#pragma unroll
                        for (int s = 0; s < 2; ++s) {
                            pg8::u32x4 pw; pw.x = pk2bf(S[kb][8 * s + 0], S[kb][8 * s + 1]); pw.y = pk2bf(S[kb][8 * s + 2], S[kb][8 * s + 3]); pw.z = pk2bf(S[kb][8 * s + 4], S[kb][8 * s + 5]); pw.w = pk2bf(S[kb][8 * s + 6], S[kb][8 * s + 7]);
                            const bf16x8v pf = __builtin_bit_cast(bf16x8v, pw);
#pragma unroll
                            for (int db = 0; db < 2; ++db) {
                                const LDSP unsigned char* vp = vb_ + (32 * db + l31) * AT_VROW + (32 * kb + 16 * s + 4 * h5) * 2;
                                const pg8::u32x2 v0 = *(const LDSP pg8::u32x2*)vp, v1 = *(const LDSP pg8::u32x2*)(vp + 16);
                                const bf16x8v a = __builtin_bit_cast(bf16x8v, (pg8::u32x4){v0.x, v0.y, v1.x, v1.y});
                                O[db] = __builtin_amdgcn_mfma_f32_32x32x16_bf16(a, pf, O[db], 0, 0, 0);
                            }
                        }
                }
                if (t + 1 < nt) AT_STORE((t + 1) & 1);
                __syncthreads();
            }
#undef AT_LOAD
#undef AT_STORE
            const float inv = 1.0f / (lrun + __shfl_xor(lrun, 32));
            bf16_t* orow = aob + mrow * (MH * VD) + h * VD;
#pragma unroll
            for (int db = 0; db < 2; ++db)
#pragma unroll
                for (int g = 0; g < 4; ++g) { pg8::u32x2 o; o.x = pk2bf(O[db][4 * g] * inv, O[db][4 * g + 1] * inv); o.y = pk2bf(O[db][4 * g + 2] * inv, O[db][4 * g + 3] * inv);
                    *(pg8::u32x2*)(orow + 32 * db + 8 * g + 4 * h5) = o; }
        }
    }
}
constexpr int SD_CROW = 528, SD_WROW = 528, SD_PROW = 272;
constexpr int SD_CIMG = 0, SD_CIMG_SZ = 128 * SD_CROW;
constexpr int SD_WBUF = SD_CIMG + SD_CIMG_SZ, SD_WBUF_SZ = 32 * 1040;
constexpr int SD_XCH = SD_WBUF + 2 * SD_WBUF_SZ, SD_XCH_SZ = 4 * 5 * 64 * 4;
constexpr int SD_PIMG = SD_XCH + 2 * SD_XCH_SZ, SD_PIMG_SZ = 32 * SD_PROW;
constexpr int SD_END = SD_PIMG + 2 * SD_PIMG_SZ;
typedef short s16x4 __attribute__((ext_vector_type(4)));
#define MFMA32(a, b, c) __builtin_amdgcn_mfma_f32_32x32x16_bf16(a, b, c, 0, 0, 0)

__device__ __forceinline__ float mla_b2_bound(const Ctx& c, int j, int lane) {
    using namespace cfg;
    float gq = fabsf(c.in[I_QNN][j * NOPE + lane]), gk = fabsf(c.in[I_KNN][j * NOPE + lane]), gqr = fabsf(c.in[I_QRN][j * ROPE + (lane & 31)]), gkr = fabsf(c.in[I_KRN][j * ROPE + (lane & 31)]);
#pragma unroll
    for (int o = 1; o < 64; o <<= 1) { gq = fmaxf(gq, __shfl_xor(gq, o)); gk = fmaxf(gk, __shfl_xor(gk, o)); gqr = fmaxf(gqr, __shfl_xor(gqr, o)); gkr = fmaxf(gkr, __shfl_xor(gkr, o)); }
    return (64.f * gq * gk + 32.f * gqr * gkr) * (0.10206207261596575f * 1.4426950408889634f);
}

__device__ __forceinline__ void sd_pv_core(const int G, f32x16_t& Og, f32x16_t& Lacc, LDSP unsigned char* lds, int w, int lane, int l31, int h5) {
    asm volatile("" : "+v"(lane)); l31 = lane & 31; h5 = lane >> 5;
    const LDSP unsigned char* pimg = lds + SD_PIMG + (G & 1) * SD_PIMG_SZ;
    const unsigned onesw = (l31 == G) ? 0x3F803F80u : 0u;
    const bf16x8v onesv = __builtin_bit_cast(bf16x8v, (pg8::u32x4){onesw, onesw, onesw, onesw});
#pragma unroll
    for (int sp = 0; sp < 8; ++sp) {
        const bf16x8v a = *(const LDSP bf16x8v*)(pimg + l31 * SD_PROW + (16 * sp + 8 * h5) * 2);
        const int key0 = 16 * sp + 8 * h5 + ((lane & 15) >> 2), col = 32 * w + 16 * ((lane >> 4) & 1) + 4 * (lane & 3);
        const s16x4 t0 = __builtin_amdgcn_ds_read_tr16_b64_v4i16((LDSP s16x4*)(lds + SD_CIMG + key0 * SD_CROW + col * 2));
        const s16x4 t1 = __builtin_amdgcn_ds_read_tr16_b64_v4i16((LDSP s16x4*)(lds + SD_CIMG + (key0 + 4) * SD_CROW + col * 2));
        const bf16x8v b = (bf16x8v){t0[0], t0[1], t0[2], t0[3], t1[0], t1[1], t1[2], t1[3]};
        Og = MFMA32(a, b, Og);
        if (sp == w) Lacc = MFMA32(a, onesv, Lacc);
        if (sp & 1) __builtin_amdgcn_sched_barrier(0);
    }
}

__device__ __forceinline__ void sd_pv(const int G, f32x16_t& Og, f32x16_t& Lacc, LDSP unsigned char* lds, int w, int lane, int l31, int h5) {
    sd_pv_core(G, Og, Lacc, lds, w, lane, l31, h5);
#if defined(PROBE_DUP) && (PROBE_DUP & (1 << 21))
    f32x16_t D0, D1;
#pragma unroll
    for (int r = 0; r < 16; ++r) { D0[r] = 0.f; D1[r] = 0.f; }
    sd_pv_core(G, D0, D1, lds, w, lane, l31, h5); asm volatile("" :: "v"(D0), "v"(D1));
#endif
}
#define SD_WLOAD(h, buf) do { const char* wsrc_ = (const char*)(fm.wukvt + (size_t)(h) * NOPE * KVL); int ln_ = lane; asm volatile("" : "+v"(ln_)); _Pragma("unroll") for (int k = 0; k < 4; ++k) { \
        const unsigned voff_ = (unsigned)(((4 * w + k) + 32 * (ln_ >> 5)) * KVL + (ln_ & 31) * 8) * 2u; \
        __builtin_amdgcn_global_load_lds((const unsigned*)(wsrc_ + voff_), (LDSP unsigned*)(lds + SD_WBUF + (buf) * SD_WBUF_SZ + (4 * w + k) * 1040), 16, 0, 0); } } while (0)
template <int G>
__device__ __forceinline__ void sd_group(const FastMla& fm, const bf16_t* __restrict__ qs, const int s, LDSP unsigned char* lds, const int w, const int lane, const int l31_, const int h5_, const int kb, const int dh,
                                         const bf16x8v (&cfr)[16], const bf16x8v (&kpfr)[2], bf16x8v (&qn)[2], bf16x8v (&qp)[2], f32x16_t (&O)[4], f32x16_t& Lacc, const float B2) {
    using namespace cfg;
        _Pragma("unroll 1") for (int hh = 0; hh < 4; ++hh) {
            const int h = 4 * G + hh;
            int lane_ = lane; asm volatile("" : "+v"(lane_)); const int l31 = lane_ & 31, h5 = lane_ >> 5;
            if (h + 1 < MH) SD_WLOAD(h + 1, (h + 1) & 1);
#if defined(PROBE_DUP) && (PROBE_DUP & (1 << 22))
            if (h + 1 < MH) SD_WLOAD(h + 1, (h + 1) & 1);
#endif
            const bf16x8v qn0 = qn[0], qn1 = qn[1], qp0 = qp[0], qp1 = qp[1];
            { const int hn = (h + 1) & (MH - 1); const bf16_t* qrow = qs + ((size_t)(s * DS + (l31 & 7)) * MH + hn) * QD;
#pragma unroll
              for (int s_ = 0; s_ < 2; ++s_) { const int d0 = 32 * dh + 16 * s_ + 4 * h5; pg8::u32x2 a = *(const pg8::u32x2*)(qrow + d0), b = *(const pg8::u32x2*)(qrow + d0 + 8);
                  if (l31 >= 8) { a = (pg8::u32x2){0u, 0u}; b = a; }
                  qn[s_] = __builtin_bit_cast(bf16x8v, (pg8::u32x4){a.x, a.y, b.x, b.y});
                  pg8::u32x4 e = *(const pg8::u32x4*)(qrow + NOPE + 16 * s_ + 8 * h5); if (l31 >= 8) e = (pg8::u32x4){0u, 0u, 0u, 0u};
                  qp[s_] = __builtin_bit_cast(bf16x8v, e); } }
            f32x16_t KN;
#pragma unroll
            for (int r = 0; r < 16; ++r) KN[r] = 0.f;
            { const LDSP unsigned char* wb = lds + SD_WBUF + (h & 1) * SD_WBUF_SZ + l31 * 1040 + dh * 512 + h5 * 16;
#pragma unroll
              for (int s_ = 0; s_ < 16; ++s_) { const bf16x8v a = *(const LDSP bf16x8v*)(wb + 32 * s_); KN = MFMA32(a, cfr[s_], KN); if ((s_ & 3) == 3) __builtin_amdgcn_sched_barrier(0); } }
#if defined(PROBE_DUP) && (PROBE_DUP & (1 << 19))
            { const LDSP unsigned char* wb = lds + SD_WBUF + (h & 1) * SD_WBUF_SZ + l31 * 1040 + dh * 512 + h5 * 16;
#pragma unroll
              for (int s_ = 0; s_ < 16; ++s_) { const bf16x8v a = *(const LDSP bf16x8v*)(wb + 32 * s_); KN = MFMA32(a, cfr[s_], KN); if ((s_ & 3) == 3) __builtin_amdgcn_sched_barrier(0); }
#pragma unroll
              for (int r = 0; r < 16; ++r) KN[r] *= 0.5f; }
#endif
            float ssq = 0.f;
#pragma unroll
            for (int r = 0; r < 16; ++r) ssq += KN[r] * KN[r];
            ssq += __shfl_xor(ssq, 32);
            {
            f32x16_t S;
#pragma unroll
            for (int r = 0; r < 16; ++r) S[r] = 0.f;
#pragma unroll
            for (int s_ = 0; s_ < 2; ++s_) { const bf16x8v kf = __builtin_bit_cast(bf16x8v, (pg8::u32x4){pk2bf(KN[8 * s_], KN[8 * s_ + 1]), pk2bf(KN[8 * s_ + 2], KN[8 * s_ + 3]), pk2bf(KN[8 * s_ + 4], KN[8 * s_ + 5]), pk2bf(KN[8 * s_ + 6], KN[8 * s_ + 7])});
                S = MFMA32(s_ == 0 ? qn0 : qn1, kf, S); }
            LDSP float* xch = (LDSP float*)(lds + SD_XCH + (h & 1) * SD_XCH_SZ) + kb * 320;
            if (dh == 1) { xch[lane_] = S[0]; xch[64 + lane_] = S[1]; xch[128 + lane_] = S[2]; xch[192 + lane_] = S[3]; xch[256 + lane_] = ssq; }
            asm volatile("s_waitcnt vmcnt(0)" ::: "memory");
            __syncthreads();
            if (dh == 0) {
                const float rstd = __builtin_amdgcn_rsqf((ssq + xch[256 + lane_]) * (1.0f / NOPE) + NORM_EPS);
                f32x16_t T;
#pragma unroll
                for (int r = 0; r < 16; ++r) T[r] = 0.f;
                T[0] = (S[0] + xch[lane_]) * rstd; T[1] = (S[1] + xch[64 + lane_]) * rstd; T[2] = (S[2] + xch[128 + lane_]) * rstd; T[3] = (S[3] + xch[192 + lane_]) * rstd;
                T = MFMA32(qp0, kpfr[0], T); T = MFMA32(qp1, kpfr[1], T);
                LDSP bf16_t* prow = (LDSP bf16_t*)(lds + SD_PIMG + (G & 1) * SD_PIMG_SZ + (hh * 8 + 4 * h5) * SD_PROW) + 32 * kb + l31;
#pragma unroll
                for (int q = 0; q < 4; ++q) prow[q * (SD_PROW / 2)] = (bf16_t)(pk2bf(exp2f(T[q] - B2), 0.f) & 0xffffu);
            }
            }
        }
        if (G > 0) sd_pv(G > 0 ? G - 1 : 0, O[G > 0 ? G - 1 : 0], Lacc, lds, w, lane, l31_, h5_);
}

__device__ __forceinline__ void mla_sample_decode(const Ctx& c, const FastMla& fm, const bf16_t* __restrict__ qs, float* opart, float* lpart, int j, LDSP unsigned char* lds) {
    using namespace cfg;
    const int tid = (int)tid_now(), tid_ = tid, w = __builtin_amdgcn_readfirstlane(tid >> 6), lane = tid & 63, l31 = lane & 31, h5 = lane >> 5, kb = w & 3, dh = w >> 2;
    const float* ckv = c.in[I_CKV] + (size_t)j * NPOOL * PAGE * KVL; const float* kpe = c.in[I_KPE] + (size_t)j * NPOOL * PAGE * ROPE;
    const float B2 = mla_b2_bound(c, j, lane);
    for (int it = blockIdx.x; it < DB * 2; it += gridDim.x) {
        const int s = it >> 1, hf = it & 1;
        f32x16_t O[4], Lacc;
#pragma unroll
        for (int r = 0; r < 16; ++r) { O[0][r] = 0.f; O[1][r] = 0.f; O[2][r] = 0.f; O[3][r] = 0.f; Lacc[r] = 0.f; }
        bf16x8v qn[2], qp[2];
        { const bf16_t* qrow = qs + ((size_t)(s * DS + (l31 & 7)) * MH + 0) * QD;
#pragma unroll
          for (int s_ = 0; s_ < 2; ++s_) { const int d0 = 32 * dh + 16 * s_ + 4 * h5; pg8::u32x2 a = *(const pg8::u32x2*)(qrow + d0), b = *(const pg8::u32x2*)(qrow + d0 + 8);
              if (l31 >= 8) { a = (pg8::u32x2){0u, 0u}; b = a; }
              qn[s_] = __builtin_bit_cast(bf16x8v, (pg8::u32x4){a.x, a.y, b.x, b.y});
              pg8::u32x4 e = *(const pg8::u32x4*)(qrow + NOPE + 16 * s_ + 8 * h5); if (l31 >= 8) e = (pg8::u32x4){0u, 0u, 0u, 0u};
              qp[s_] = __builtin_bit_cast(bf16x8v, e); } }
        for (int pi = 0; pi < NPAGES / 2; ++pi) {
            const int pg = __builtin_amdgcn_readfirstlane(c.page_table[s * NPAGES + hf * (NPAGES / 2) + pi]);
            __syncthreads();
            { const char* src = (const char*)(ckv + (size_t)pg * PAGE * KVL); int tid = tid_; asm volatile("" : "+v"(tid));
              pg8::f32x4 v[16];
#pragma unroll
              for (int k = 0; k < 16; ++k) v[k] = *(const pg8::f32x4*)(src + (size_t)k * 8192 + (unsigned)tid * 16u);
#pragma unroll
              for (int k = 0; k < 16; ++k) { pg8::u32x2 o; o.x = pk2bf(v[k][0], v[k][1]); o.y = pk2bf(v[k][2], v[k][3]);
                  *(LDSP pg8::u32x2*)(lds + SD_CIMG + ((tid >> 6) + 8 * k) * SD_CROW + (tid & 63) * 8) = o; } }
#if defined(PROBE_DUP) && (PROBE_DUP & (1 << 20))
            { const char* src = (const char*)(ckv + (size_t)pg * PAGE * KVL); int tid = tid_; asm volatile("" : "+v"(tid));
              pg8::f32x4 v[16];
#pragma unroll
              for (int k = 0; k < 16; ++k) v[k] = *(const pg8::f32x4*)(src + (size_t)k * 8192 + (unsigned)tid * 16u);
#pragma unroll
              for (int k = 0; k < 16; ++k) { pg8::u32x2 o; o.x = pk2bf(v[k][0], v[k][1]); o.y = pk2bf(v[k][2], v[k][3]);
                  *(LDSP pg8::u32x2*)(lds + SD_CIMG + ((tid >> 6) + 8 * k) * SD_CROW + (tid & 63) * 8) = o; } }
#endif
            SD_WLOAD(0, 0);
            bf16x8v kpfr[2];
            if (dh == 0) {
#pragma unroll
                for (int s_ = 0; s_ < 2; ++s_) { const float* kp = kpe + ((size_t)pg * PAGE + 32 * kb + l31) * ROPE + 16 * s_ + 8 * h5; const pg8::f32x4 a = *(const pg8::f32x4*)kp, b = *(const pg8::f32x4*)(kp + 4);
                    kpfr[s_] = __builtin_bit_cast(bf16x8v, (pg8::u32x4){pk2bf(a[0], a[1]), pk2bf(a[2], a[3]), pk2bf(b[0], b[1]), pk2bf(b[2], b[3])}); }
            }
            asm volatile("s_waitcnt vmcnt(0)" ::: "memory");
            __syncthreads();
            bf16x8v cfr[16];
#pragma unroll
            for (int s_ = 0; s_ < 16; ++s_) cfr[s_] = *(const LDSP bf16x8v*)(lds + SD_CIMG + (32 * kb + l31) * SD_CROW + (16 * s_ + 8 * h5) * 2);
            sd_group<0>(fm, qs, s, lds, w, lane, l31, h5, kb, dh, cfr, kpfr, qn, qp, O, Lacc, B2);
            sd_group<1>(fm, qs, s, lds, w, lane, l31, h5, kb, dh, cfr, kpfr, qn, qp, O, Lacc, B2);
            sd_group<2>(fm, qs, s, lds, w, lane, l31, h5, kb, dh, cfr, kpfr, qn, qp, O, Lacc, B2);
            sd_group<3>(fm, qs, s, lds, w, lane, l31, h5, kb, dh, cfr, kpfr, qn, qp, O, Lacc, B2);
            __syncthreads();
            sd_pv(3, O[3], Lacc, lds, w, lane, l31, h5);
        }
        {float* op = opart + (size_t)it * (MH * DS) * KVL; int lo_ = lane; asm volatile("" : "+v"(lo_)); const int l31 = lo_ & 31, h5 = lo_ >> 5;
#pragma unroll
        for (int g = 0; g < 4; ++g)
#pragma unroll
            for (int r = 0; r < 16; ++r) op[(size_t)(32 * g + (r & 3) + 8 * (r >> 2) + 4 * h5) * KVL + 32 * w + l31] = O[g][r];
        __syncthreads();
        LDSP float* ltab = (LDSP float*)(lds + SD_XCH);
        if (l31 < 4) {
#pragma unroll
            for (int r = 0; r < 16; ++r) ltab[w * 128 + l31 * 32 + (r & 3) + 8 * (r >> 2) + 4 * h5] = Lacc[r];
        }
        __syncthreads();
        if (tid < 128) { float a = 0.f;
#pragma unroll
            for (int ww = 0; ww < 8; ++ww) a += ltab[ww * 128 + tid];
            lpart[(size_t)it * 128 + tid] = a; }
        }
    }
}

__device__ __forceinline__ void mla_sample_combine(const Ctx& c, const FastMla& fm, const float* __restrict__ opart, const float* __restrict__ lpart, int j, LDSP unsigned char* lds) {
    using namespace cfg;
    const int tid = (int)tid_now(), w = tid >> 6, lane = tid & 63, gw = blockIdx.x * 8 + w, ngw = gridDim.x * 8;
    const float B2 = mla_b2_bound(c, j, lane);
    LDSP float* ol = (LDSP float*)(lds + w * 8704); LDSP float* ptab = ol + 8 * KVL; LDSP float* lt = ptab + 64;
    const float* wuv = c.in[I_WUV] + (size_t)j * KVL * MH * VD;
    for (int item = gw; item < DB * MH; item += ngw) {
        const int s = item / MH, h = item % MH, q = lane >> 3, jn = lane & 7;
        const size_t rq = (size_t)MP + s * DS + q, rk = (size_t)MP + s * DS + jn;
        const bf16_t* qv = fm.qf + rq * (MH * QD) + h * QD; const bf16_t* kn = fm.knb + rk * (MH * NOPE) + h * NOPE; const bf16_t* kp = fm.kpb + rk * ROPE;
        float sc = 0.f;
#pragma unroll
        for (int d8 = 0; d8 < QD / 8; ++d8) { const pg8::u32x4 a = *(const pg8::u32x4*)(qv + 8 * d8), b = d8 < NOPE / 8 ? *(const pg8::u32x4*)(kn + 8 * d8) : *(const pg8::u32x4*)(kp + 8 * (d8 - NOPE / 8));
            const unsigned aw[4] = {a.x, a.y, a.z, a.w}, bw[4] = {b.x, b.y, b.z, b.w};
#pragma unroll
            for (int e = 0; e < 4; ++e) sc += __uint_as_float(aw[e] << 16) * __uint_as_float(bw[e] << 16) + __uint_as_float(aw[e] & 0xffff0000u) * __uint_as_float(bw[e] & 0xffff0000u); }
        const float p = jn <= q ? exp2f(sc - B2) : 0.f;
        float ls = p; ls += __shfl_xor(ls, 1); ls += __shfl_xor(ls, 2); ls += __shfl_xor(ls, 4);
        ptab[lane] = p;
        if (jn == 0) lt[q] = ls + lpart[(size_t)(2 * s) * 128 + h * DS + q] + lpart[(size_t)(2 * s + 1) * 128 + h * DS + q];
        asm volatile("s_waitcnt lgkmcnt(0)" ::: "memory");
        float cn[DS][4];
#pragma unroll
        for (int jj = 0; jj < DS; ++jj)
#pragma unroll
            for (int k = 0; k < 4; ++k) cn[jj][k] = bf2f(fm.cb[((size_t)MP + s * DS + jj) * KVL + lane + 64 * k]);
#pragma unroll
        for (int qq = 0; qq < DS; ++qq)
#pragma unroll
            for (int k = 0; k < 4; ++k) { const int r = lane + 64 * k;
                float a = opart[((size_t)(2 * s) * 128 + h * DS + qq) * KVL + r] + opart[((size_t)(2 * s + 1) * 128 + h * DS + qq) * KVL + r];
#pragma unroll
                for (int jj = 0; jj < DS; ++jj) a += ptab[qq * 8 + jj] * cn[jj][k];
                ol[qq * KVL + r] = a; }
        asm volatile("s_waitcnt lgkmcnt(0)" ::: "memory");
        float acc[DS];
#pragma unroll
        for (int qq = 0; qq < DS; ++qq) acc[qq] = 0.f;
        for (int r = 0; r < KVL; ++r) { const float wv = wuv[((size_t)r * MH + h) * VD + lane];
#pragma unroll
            for (int qq = 0; qq < DS; ++qq) acc[qq] += ol[qq * KVL + r] * wv; }
#pragma unroll
        for (int qq = 0; qq < DS; ++qq) fm.aob[((size_t)MP + s * DS + qq) * (MH * VD) + h * VD + lane] = (bf16_t)(pk2bf(acc[qq] / lt[qq], 0.f) & 0xffffu);
        asm volatile("s_waitcnt lgkmcnt(0)" ::: "memory");
    }
}
struct FastRw {
    bf16_t* xm;
    bf16_t* rkv;
    bf16_t* hb;
    bf16_t* lu;
    float* vf;
    float* ops;
    bf16_t* yo;
    bf16_t *wrkvt, *lorat, *wot;
};
constexpr int RW_REC = 464;
constexpr int RW_CH = 32;
constexpr int RW_BUF = RW_CH * RW_REC * 4;
struct RwSel { __device__ static __forceinline__ int sel(int pn) { return pn < 12 ? (pn >> 2) : (pn == 15 ? 2 : pn - 9); } };

__device__ __forceinline__ void rw_mix_fast(const Ctx& c, const FastRw& fr, int l, int gw, int ngw, int lane) {
    using namespace cfg; const int j = l / 3;
    const float* gain = c.in[I_NMIX] + l * D;
    for (int m = gw; m < MTOT; m += ngw) {
        const int t = row_t(m), sq = row_seq(m);
        pg8::f32x4 xc[4], xp[4], gv[4]; float s = 0.f, sp = 0.f;
#pragma unroll
        for (int q = 0; q < 4; ++q) { gv[q] = *(const pg8::f32x4*)(gain + 4 * lane + 256 * q); xc[q] = *(const pg8::f32x4*)(c.x + (size_t)m * D + 4 * lane + 256 * q);
            s += (xc[q][0] * xc[q][0] + xc[q][1] * xc[q][1]) + (xc[q][2] * xc[q][2] + xc[q][3] * xc[q][3]); }
        if (t > 0) {
#pragma unroll
            for (int q = 0; q < 4; ++q) { xp[q] = *(const pg8::f32x4*)(c.x + (size_t)(m - 1) * D + 4 * lane + 256 * q); sp += (xp[q][0] * xp[q][0] + xp[q][1] * xp[q][1]) + (xp[q][2] * xp[q][2] + xp[q][3] * xp[q][3]); }
        }
        const float rs = 1.0f / sqrtf(wave_sum64(s) * (1.0f / D) + NORM_EPS), rsp = 1.0f / sqrtf(wave_sum64(sp) * (1.0f / D) + NORM_EPS);
#pragma unroll
        for (int q = 0; q < 4; ++q) {
#pragma unroll
            for (int e = 0; e < 4; ++e) xc[q][e] = xc[q][e] * rs * gv[q][e];
            if (t > 0) {
#pragma unroll
                for (int e = 0; e < 4; ++e) xp[q][e] = xp[q][e] * rsp * gv[q][e];
            } else if (sq < BATCH) xp[q] = (pg8::f32x4){0.f, 0.f, 0.f, 0.f};
            else xp[q] = *(const pg8::f32x4*)(c.in[I_SHIFT] + ((size_t)j * DB + (sq - BATCH)) * D + 4 * lane + 256 * q);
        }
        if (t == seq_len(sq) - 1) {
            float* so = sq < BATCH ? c.out + O_SHP + ((size_t)j * BATCH + sq) * D : c.out + O_SHS + ((size_t)j * DB + (sq - BATCH)) * D;
#pragma unroll
            for (int q = 0; q < 4; ++q) *(pg8::f32x4*)(so + 4 * lane + 256 * q) = xc[q];
        }
#pragma unroll
        for (int p = 0; p < 6; ++p)
#pragma unroll
            for (int q = 0; q < 4; ++q) { const pg8::f32x4 mu = *(const pg8::f32x4*)(c.in[I_MU] + ((size_t)j * 6 + p) * D + 4 * lane + 256 * q);
                pg8::u32x2 o; o.x = pk2bf(xc[q][0] + (xp[q][0] - xc[q][0]) * mu[0], xc[q][1] + (xp[q][1] - xc[q][1]) * mu[1]); o.y = pk2bf(xc[q][2] + (xp[q][2] - xc[q][2]) * mu[2], xc[q][3] + (xp[q][3] - xc[q][3]) * mu[3]);
                *(pg8::u32x2*)(fr.xm + ((size_t)p * MTOT + m) * D + 4 * lane + 256 * q) = o; }
        if (lane < 32) *(unsigned*)(fr.hb + (size_t)m * 384 + 320 + 2 * lane) = 0u;
    }
}
struct EpiRwkv {
    static constexpr bool PERM = true;
    bf16_t* rkv; bf16_t* hb;
    __device__ __forceinline__ void operator()(const pg8::f32x4 (&acc)[2][2][4][2], const pg8::Unit& u, int wr, int wc, int fr, int fq) const {
        using namespace pg8;
        const int row0 = u.pm * BM + wr * 64 + fr, cl0 = wc * 32 + 8 * fq;
        const int pn = u.pn;
        bf16_t* base; int ldc, coff, nvalid, act = 0;
        if (pn < 12) { base = rkv; ldc = 3072; coff = pn * 256; nvalid = 256; }
        else { base = hb; ldc = 384; if (pn == 12) { coff = 0; nvalid = 64; act = 1; } else if (pn == 13) { coff = 64; nvalid = 64; } else if (pn == 14) { coff = 128; nvalid = 160; act = 2; } else { coff = 288; nvalid = 32; } }
#pragma unroll
        for (int ai = 0; ai < 2; ++ai)
#pragma unroll
            for (int m = 0; m < 4; ++m) { bf16_t* rowp = base + (size_t)(row0 + ai * HALF + m * 16) * ldc + coff;
#pragma unroll
                for (int bj = 0; bj < 2; ++bj) { const int cl = cl0 + bj * HALF; if (cl >= nvalid) continue;
                    f32x4 v0 = acc[ai][bj][m][0], v1 = acc[ai][bj][m][1];
                    if (act == 1) {
#pragma unroll
                        for (int e = 0; e < 4; ++e) { v0[e] = tanhf(v0[e]); v1[e] = tanhf(v1[e]); } }
                    else if (act == 2) {
#pragma unroll
                        for (int e = 0; e < 4; ++e) { v0[e] = 1.0f / (1.0f + __expf(-v0[e])); v1[e] = 1.0f / (1.0f + __expf(-v1[e])); } }
                    u32x4 w; w.x = cvt_pk_bf16(v0[0], v0[1]); w.y = cvt_pk_bf16(v0[2], v0[3]); w.z = cvt_pk_bf16(v1[0], v1[1]); w.w = cvt_pk_bf16(v1[2], v1[3]);
                    *(u32x4*)(rowp + cl) = w; } }
    }
};
__device__ __forceinline__ void rw_build_lorat(const Ctx& c, bf16_t* lorat, int j, size_t gtid, size_t gsz) {
    using namespace cfg;
    for (size_t i = gtid; i < (size_t)4096 * 384; i += gsz) {
        const int n = (int)(i / 384), k = (int)(i % 384), grp = n >> 10, ch = n & 1023; float v = 0.f;
        if (grp == 0 && k < 64) v = c.in[I_W2][((size_t)j * RW_DL + k) * D + ch];
        else if (grp == 1 && k >= 64 && k < 128) v = c.in[I_A2][((size_t)j * RW_AL + (k - 64)) * D + ch];
        else if (grp == 2 && k >= 128 && k < 288) v = c.in[I_G2][((size_t)j * RW_GL + (k - 128)) * D + ch];
        else if (grp == 3 && k >= 288 && k < 320 && j > 0) v = c.in[I_V2][((size_t)(j - 1) * RW_VL + (k - 288)) * D + ch];
        lorat[i] = (bf16_t)(pk2bf(v, 0.f) & 0xffffu);
    }
}
__device__ __forceinline__ size_t rw_rec_base(int sq, int h) {
    using namespace cfg;
    return sq < BATCH ? ((size_t)sq * RHEADS + h) * SEQ : (size_t)MP * RHEADS + ((size_t)(sq - BATCH) * RHEADS + h) * DS;
}
__device__ __forceinline__ void rw_prep_fast(const Ctx& c, const FastRw& fr, int l, int gw, int ngw, int lane) {
    using namespace cfg; const int j = l / 3;
    for (int it = gw; it < MTOT * RHEADS; it += ngw) {
        const int m = it / RHEADS, h = it % RHEADS, ch = h * RH + lane;
        const bf16_t* rk = fr.rkv + (size_t)m * 3072 + ch; const bf16_t* lu = fr.lu + (size_t)m * 4096 + ch;
        const float r = bf2f(rk[0]), k0 = bf2f(rk[1024]); float v = bf2f(rk[2048]);
        const float wpre = bf2f(lu[0]), apre = bf2f(lu[1024]), gg = bf2f(lu[2048]), vpre = bf2f(lu[3072]);
        const float wl = -softplusf_(-(c.in[I_W0][j * D + ch] + wpre)) - 0.5f;
        const float w = expf(-expf(wl));
        if (j == 0) fr.vf[(size_t)m * D + ch] = v;
        else v = v + (fr.vf[(size_t)m * D + ch] - v) * sigmoidf_(c.in[I_V0][(j - 1) * D + ch] + vpre);
        const float a = sigmoidf_(c.in[I_A0][j * D + ch] + apre);
        float kk = k0 * c.in[I_KK][j * D + ch];
        const float nn = wave_sum64(kk * kk);
        kk *= 1.0f / fmaxf(sqrtf(nn), 1e-12f);
        const float k2 = k0 * (1.0f + (a - 1.0f) * c.in[I_KA][j * D + ch]);
        const float bo = kk * a;
        const float br = wave_sum64(bo * r), kr = wave_sum64(k2 * r), bonus = wave_sum64(r * k2 * c.in[I_RK][(size_t)j * D + ch]);
        const int sq = row_seq(m), t = row_t(m);
        float* rec = fr.ops + (rw_rec_base(sq, h) + t) * RW_REC;
        rec[lane] = -kk; rec[64 + lane] = w * r; rec[128 + lane] = w; rec[192 + lane] = bo; rec[256 + lane] = k2; rec[320 + lane] = v; rec[384 + lane] = gg;
        if (lane == 0) { rec[448] = br; rec[449] = kr; rec[450] = bonus; }
    }
}
template <int CTRL> __device__ __forceinline__ float dppf(float v) { return __int_as_float(__builtin_amdgcn_update_dpp(0, __float_as_int(v), CTRL, 0xF, 0xF, true)); }
__device__ __forceinline__ float red16(float x) { x += dppf<0xB1>(x); x += dppf<0x4E>(x); x += dppf<0x124>(x); x += dppf<0x128>(x); return x; }
__device__ __forceinline__ void rw_scan_fast(const Ctx& c, const FastRw& fr, int l, LDSP unsigned char* lds) {
    using namespace cfg; const int j = l / 3;
    const int tid = (int)tid_now(), w = __builtin_amdgcn_readfirstlane(tid >> 6), lane = tid & 63, cs = lane & 15, rp = 4 * w + (lane >> 4);
    LDSP float* ybuf = (LDSP float*)(lds + 2 * RW_BUF);
    for (int chain = blockIdx.x; chain < NSEQ * RHEADS; chain += gridDim.x) {
        const int sq = chain / RHEADS, h = chain % RHEADS, T = seq_len(sq), m0 = seq_row0(sq);
        const char* src = (const char*)(fr.ops + rw_rec_base(sq, h) * RW_REC);
        pg8::f32x4 S0, S1;
        if (sq < BATCH) { S0 = (pg8::f32x4){0.f, 0.f, 0.f, 0.f}; S1 = S0; }
        else { const float* s0 = c.in[I_WKV] + ((((size_t)j * DB + (sq - BATCH)) * RHEADS + h) * RH + 2 * rp) * RH + 4 * cs; S0 = *(const pg8::f32x4*)s0; S1 = *(const pg8::f32x4*)(s0 + RH); }
        const int nch = (T + RW_CH - 1) / RW_CH;
#define RW_DMA(n, buf) do { const int nb_ = ((T - (n) * RW_CH < RW_CH ? T - (n) * RW_CH : RW_CH) * RW_REC * 4 + 1023) >> 10; \
            for (int q_ = w; q_ < nb_; q_ += 8) __builtin_amdgcn_global_load_lds((const unsigned*)(src + (size_t)(n) * RW_BUF + (size_t)q_ * 1024 + (unsigned)lane * 16u), (LDSP unsigned*)(lds + (buf) * RW_BUF + q_ * 1024), 16, 0, 0); } while (0)
        __syncthreads();
        RW_DMA(0, 0);
        asm volatile("s_waitcnt vmcnt(0)" ::: "memory");
        __syncthreads();
        for (int n = 0; n < nch; ++n) {
            if (n + 1 < nch) RW_DMA(n + 1, (n + 1) & 1);
            const int tn = T - n * RW_CH < RW_CH ? T - n * RW_CH : RW_CH;
            const LDSP unsigned char* bufp = lds + (n & 1) * RW_BUF;
            for (int t = 0; t < tn; ++t) {
                const LDSP unsigned char* rec = bufp + t * (RW_REC * 4);
                const pg8::f32x4 A = *(const LDSP pg8::f32x4*)(rec + cs * 16), WR = *(const LDSP pg8::f32x4*)(rec + 256 + cs * 16), W = *(const LDSP pg8::f32x4*)(rec + 512 + cs * 16),
                                 B = *(const LDSP pg8::f32x4*)(rec + 768 + cs * 16), K = *(const LDSP pg8::f32x4*)(rec + 1024 + cs * 16);
                const pg8::f32x2 V2 = *(const LDSP pg8::f32x2*)(rec + 1280 + rp * 8), SC = *(const LDSP pg8::f32x2*)(rec + 1792);
                float sa0 = (S0[0] * A[0] + S0[1] * A[1]) + (S0[2] * A[2] + S0[3] * A[3]), y0 = (S0[0] * WR[0] + S0[1] * WR[1]) + (S0[2] * WR[2] + S0[3] * WR[3]);
                float sa1 = (S1[0] * A[0] + S1[1] * A[1]) + (S1[2] * A[2] + S1[3] * A[3]), y1 = (S1[0] * WR[0] + S1[1] * WR[1]) + (S1[2] * WR[2] + S1[3] * WR[3]);
                sa0 = red16(sa0); sa1 = red16(sa1); y0 = red16(y0); y1 = red16(y1);
                S0 = S0 * W + sa0 * B + V2[0] * K; S1 = S1 * W + sa1 * B + V2[1] * K;
                if (cs == 0) *(LDSP pg8::f32x2*)(ybuf + t * RH + 2 * rp) = (pg8::f32x2){y0 + sa0 * SC[0] + V2[0] * SC[1], y1 + sa1 * SC[0] + V2[1] * SC[1]};
            }
            asm volatile("s_waitcnt vmcnt(0)" ::: "memory");
            __syncthreads();
            for (int t = w; t < tn; t += 8) {
                const LDSP float* rec = (const LDSP float*)(bufp + t * (RW_REC * 4));
                const float y = ybuf[t * RH + lane], mean = wave_sum64(y) * (1.0f / RH), d = y - mean, var = wave_sum64(d * d) * (1.0f / RH);
                const int ch = h * RH + lane;
                const float yn = d * (1.0f / sqrtf(var + LNX_EPS)) * c.in[I_LNW][j * D + ch] + c.in[I_LNB][j * D + ch];
                const float o = (yn + rec[450] * rec[320 + lane]) * rec[384 + lane];
                fr.yo[(size_t)(m0 + n * RW_CH + t) * D + ch] = (bf16_t)(pk2bf(o, 0.f) & 0xffffu);
            }
            __syncthreads();
        }
#undef RW_DMA
        float* so = (sq < BATCH ? c.out + O_WKVP + (((size_t)j * BATCH + sq) * RHEADS + h) * RH * RH : c.out + O_WKVS + (((size_t)j * DB + (sq - BATCH)) * RHEADS + h) * RH * RH) + (size_t)(2 * rp) * RH + 4 * cs;
        *(pg8::f32x4*)so = S0; *(pg8::f32x4*)(so + RH) = S1;
    }
}
__device__ __forceinline__ float fsigmoid(float x) { return __builtin_amdgcn_rcpf(1.0f + __expf(-x)); }
__device__ __forceinline__ float fsoftplus(float x) { return x > 20.f ? x : __logf(1.0f + __expf(x)); }
__device__ __forceinline__ float rdl(float v, int l) { return __int_as_float(__builtin_amdgcn_readlane(__float_as_int(v), l)); }
__device__ __forceinline__ float wsum_dpp(float x) {
    x = red16(x);
    return (rdl(x, 0) + rdl(x, 16)) + (rdl(x, 32) + rdl(x, 48));
}

__device__ __forceinline__ void red16x4(float& a, float& b, float& c, float& d) {
    asm volatile("s_nop 1\n"
        "v_add_f32_dpp %0, %0, %0 quad_perm:[1,0,3,2] row_mask:0xf bank_mask:0xf\n" "v_add_f32_dpp %1, %1, %1 quad_perm:[1,0,3,2] row_mask:0xf bank_mask:0xf\n"
        "v_add_f32_dpp %2, %2, %2 quad_perm:[1,0,3,2] row_mask:0xf bank_mask:0xf\n" "v_add_f32_dpp %3, %3, %3 quad_perm:[1,0,3,2] row_mask:0xf bank_mask:0xf\n"
        "v_add_f32_dpp %0, %0, %0 quad_perm:[2,3,0,1] row_mask:0xf bank_mask:0xf\n" "v_add_f32_dpp %1, %1, %1 quad_perm:[2,3,0,1] row_mask:0xf bank_mask:0xf\n"
        "v_add_f32_dpp %2, %2, %2 quad_perm:[2,3,0,1] row_mask:0xf bank_mask:0xf\n" "v_add_f32_dpp %3, %3, %3 quad_perm:[2,3,0,1] row_mask:0xf bank_mask:0xf\n"
        "v_add_f32_dpp %0, %0, %0 row_ror:4 row_mask:0xf bank_mask:0xf\n" "v_add_f32_dpp %1, %1, %1 row_ror:4 row_mask:0xf bank_mask:0xf\n"
        "v_add_f32_dpp %2, %2, %2 row_ror:4 row_mask:0xf bank_mask:0xf\n" "v_add_f32_dpp %3, %3, %3 row_ror:4 row_mask:0xf bank_mask:0xf\n"
        "v_add_f32_dpp %0, %0, %0 row_ror:8 row_mask:0xf bank_mask:0xf\n" "v_add_f32_dpp %1, %1, %1 row_ror:8 row_mask:0xf bank_mask:0xf\n"
        "v_add_f32_dpp %2, %2, %2 row_ror:8 row_mask:0xf bank_mask:0xf\n" "v_add_f32_dpp %3, %3, %3 row_ror:8 row_mask:0xf bank_mask:0xf\n"
        "s_nop 1"
        : "+v"(a), "+v"(b), "+v"(c), "+v"(d));
}
struct RwOp { pg8::f32x4 A, WR, W, B, K; pg8::f32x2 V2, SC; };
__device__ __forceinline__ void rw_ldop(RwOp& o, const LDSP unsigned char* rec, int cs, int rp) {
    o.A = *(const LDSP pg8::f32x4*)(rec + cs * 16); o.WR = *(const LDSP pg8::f32x4*)(rec + 256 + cs * 16); o.W = *(const LDSP pg8::f32x4*)(rec + 512 + cs * 16);
    o.B = *(const LDSP pg8::f32x4*)(rec + 768 + cs * 16); o.K = *(const LDSP pg8::f32x4*)(rec + 1024 + cs * 16);
    o.V2 = *(const LDSP pg8::f32x2*)(rec + 1280 + rp * 8); o.SC = *(const LDSP pg8::f32x2*)(rec + 1792);
}
__device__ __forceinline__ float fma_s(float a, float b, float c) { float d; asm("v_fma_f32 %0, %1, %2, %3" : "=v"(d) : "v"(a), "v"(b), "v"(c)); return d; }
__device__ __forceinline__ float mul_s(float a, float b) { float d; asm("v_mul_f32 %0, %1, %2" : "=v"(d) : "v"(a), "v"(b)); return d; }
__device__ __forceinline__ void rw_step(pg8::f32x4& S0, pg8::f32x4& S1, const RwOp& o, LDSP float* yrow, bool wr) {
    float sa0 = fma_s(S0[3], o.A[3], fma_s(S0[2], o.A[2], fma_s(S0[1], o.A[1], mul_s(S0[0], o.A[0]))));
    float sa1 = fma_s(S1[3], o.A[3], fma_s(S1[2], o.A[2], fma_s(S1[1], o.A[1], mul_s(S1[0], o.A[0]))));
    float y0 = fma_s(S0[3], o.WR[3], fma_s(S0[2], o.WR[2], fma_s(S0[1], o.WR[1], mul_s(S0[0], o.WR[0]))));
    float y1 = fma_s(S1[3], o.WR[3], fma_s(S1[2], o.WR[2], fma_s(S1[1], o.WR[1], mul_s(S1[0], o.WR[0]))));
    float t0[4], t1[4];
#pragma unroll
    for (int e = 0; e < 4; ++e) { t0[e] = fma_s(o.K[e], o.V2[0], mul_s(S0[e], o.W[e])); t1[e] = fma_s(o.K[e], o.V2[1], mul_s(S1[e], o.W[e])); }
    red16x4(sa0, sa1, y0, y1);
#pragma unroll
    for (int e = 0; e < 4; ++e) { S0[e] = fma_s(o.B[e], sa0, t0[e]); S1[e] = fma_s(o.B[e], sa1, t1[e]); }
    if (wr) *(LDSP pg8::f32x2*)yrow = (pg8::f32x2){fma_s(o.V2[0], o.SC[1], fma_s(sa0, o.SC[0], y0)), fma_s(o.V2[1], o.SC[1], fma_s(sa1, o.SC[0], y1))};
}
struct RwIn { unsigned short r, k, v, wp, ap, g, vp; float vf; };
template <int J>
__device__ __forceinline__ void rw_scan_fused(const Ctx& c, const FastRw& fr, LDSP unsigned char* lds) {
    using namespace cfg; constexpr int j = J;
    const int tid = (int)tid_now(), w = __builtin_amdgcn_readfirstlane(tid >> 6), lane = tid & 63, cs = lane & 15, rp = 4 * w + (lane >> 4);
    LDSP float* ybuf = (LDSP float*)(lds + 2 * RW_BUF);
    for (int chain = blockIdx.x; chain < NSEQ * RHEADS; chain += gridDim.x) {
        const int sq = chain / RHEADS, h = chain % RHEADS, T = seq_len(sq), m0 = seq_row0(sq), ch = h * RH + lane;
        const float p_w0 = c.in[I_W0][j * D + ch], p_a0 = c.in[I_A0][j * D + ch], p_kk = c.in[I_KK][j * D + ch], p_ka = c.in[I_KA][j * D + ch], p_rk = c.in[I_RK][(size_t)j * D + ch],
                    p_lnw = c.in[I_LNW][j * D + ch], p_lnb = c.in[I_LNB][j * D + ch], p_v0 = j > 0 ? c.in[I_V0][(j - 1) * D + ch] : 0.f;
        pg8::f32x4 S0, S1;
        if (sq < BATCH) { S0 = (pg8::f32x4){0.f, 0.f, 0.f, 0.f}; S1 = S0; }
        else { const float* s0 = c.in[I_WKV] + ((((size_t)j * DB + (sq - BATCH)) * RHEADS + h) * RH + 2 * rp) * RH + 4 * cs; S0 = *(const pg8::f32x4*)s0; S1 = *(const pg8::f32x4*)(s0 + RH); }
        const int nch = (T + RW_CH - 1) / RW_CH;
        RwIn in[4];
#define RW_LOADIN(n) do { _Pragma("unroll") for (int q = 0; q < 4; ++q) { const int t_ = (n) * RW_CH + 4 * w + q; if (t_ < T) { const size_t m_ = (size_t)(m0 + t_); \
                const bf16_t* rk_ = fr.rkv + m_ * 3072 + ch; const bf16_t* lu_ = fr.lu + m_ * 4096 + ch; \
                in[q].r = rk_[0]; in[q].k = rk_[1024]; in[q].v = rk_[2048]; in[q].wp = lu_[0]; in[q].ap = lu_[1024]; in[q].g = lu_[2048]; in[q].vp = lu_[3072]; \
                in[q].vf = j > 0 ? fr.vf[m_ * D + ch] : 0.f; } } } while (0)
#define RW_PREP(n, buf) do { _Pragma("unroll") for (int q = 0; q < 4; ++q) { const int tl_ = 4 * w + q, t_ = (n) * RW_CH + tl_; if (t_ < T) { \
                const float r_ = bf2f(in[q].r), k0_ = bf2f(in[q].k); float v_ = bf2f(in[q].v); \
                const float wl_ = -fsoftplus(-(p_w0 + bf2f(in[q].wp))) - 0.5f, w_ = __expf(-__expf(wl_)); \
                if (j == 0) fr.vf[(size_t)(m0 + t_) * D + ch] = v_; else v_ = v_ + (in[q].vf - v_) * fsigmoid(p_v0 + bf2f(in[q].vp)); \
                const float a_ = fsigmoid(p_a0 + bf2f(in[q].ap)); float kk_ = k0_ * p_kk; \
                const float k2_ = k0_ * (1.0f + (a_ - 1.0f) * p_ka); \
                float n_ = red16(kk_ * kk_), e1_ = red16(r_ * k2_ * p_rk), e2_ = red16(k2_ * r_); \
                n_ = (rdl(n_, 0) + rdl(n_, 16)) + (rdl(n_, 32) + rdl(n_, 48)); e1_ = (rdl(e1_, 0) + rdl(e1_, 16)) + (rdl(e1_, 32) + rdl(e1_, 48)); e2_ = (rdl(e2_, 0) + rdl(e2_, 16)) + (rdl(e2_, 32) + rdl(e2_, 48)); \
                kk_ *= __builtin_amdgcn_rcpf(fmaxf(__builtin_amdgcn_sqrtf(n_), 1e-12f)); const float bo_ = kk_ * a_; const float e3_ = wsum_dpp(bo_ * r_); \
                LDSP float* rec_ = (LDSP float*)(lds + (buf) * RW_BUF + tl_ * (RW_REC * 4)); \
                rec_[lane] = -kk_; rec_[64 + lane] = w_ * r_; rec_[128 + lane] = w_; rec_[192 + lane] = bo_; rec_[256 + lane] = k2_; rec_[320 + lane] = v_; rec_[384 + lane] = bf2f(in[q].g); \
                if (lane == 0) { rec_[448] = e3_; rec_[449] = e2_; rec_[450] = e1_; } } } } while (0)
        __syncthreads();
        RW_LOADIN(0); RW_PREP(0, 0);
        __syncthreads();
        for (int n = 0; n < nch; ++n) {
            if (n + 1 < nch) RW_LOADIN(n + 1);
            const int tn = T - n * RW_CH < RW_CH ? T - n * RW_CH : RW_CH;
            const LDSP unsigned char* bufp = lds + (n & 1) * RW_BUF;
#if defined(PROBE_DUP) && (PROBE_DUP & (1 << 17))
            { RwOp o0, o1; rw_ldop(o0, bufp, cs, rp); pg8::f32x4 T0 = S0, T1 = S1;
              for (int t = 0; t < tn; t += 2) {
                  rw_ldop(o1, bufp + (t + 1) * (RW_REC * 4), cs, rp);
                  rw_step(T0, T1, o0, ybuf + t * RH + 2 * rp, cs == 0);
                  rw_ldop(o0, bufp + (t + 2 < tn ? t + 2 : t) * (RW_REC * 4), cs, rp);
                  rw_step(T0, T1, o1, ybuf + (t + 1) * RH + 2 * rp, cs == 0);
              } asm volatile("" :: "v"(T0), "v"(T1)); }
#endif
            { RwOp o0, o1; rw_ldop(o0, bufp, cs, rp);
              for (int t = 0; t < tn; t += 2) {
                  rw_ldop(o1, bufp + (t + 1) * (RW_REC * 4), cs, rp);
                  rw_step(S0, S1, o0, ybuf + t * RH + 2 * rp, cs == 0);
                  rw_ldop(o0, bufp + (t + 2 < tn ? t + 2 : t) * (RW_REC * 4), cs, rp);
                  rw_step(S0, S1, o1, ybuf + (t + 1) * RH + 2 * rp, cs == 0);
              } }
            if (n + 1 < nch) RW_PREP(n + 1, (n + 1) & 1);
#if defined(PROBE_DUP) && (PROBE_DUP & (1 << 18))
            if (n + 1 < nch) RW_PREP(n + 1, (n + 1) & 1);
#endif
            __syncthreads();
            for (int t = w; t < tn; t += 8) {
                const LDSP float* rec = (const LDSP float*)(bufp + t * (RW_REC * 4));
                const float y = ybuf[t * RH + lane], mean = wsum_dpp(y) * (1.0f / RH), d = y - mean, var = wsum_dpp(d * d) * (1.0f / RH);
                const float yn = d * __builtin_amdgcn_rsqf(var + LNX_EPS) * p_lnw + p_lnb;
                const float o = (yn + rec[450] * rec[320 + lane]) * rec[384 + lane];
                fr.yo[(size_t)(m0 + n * RW_CH + t) * D + ch] = (bf16_t)(pk2bf(o, 0.f) & 0xffffu);
            }
            __syncthreads();
        }
#undef RW_LOADIN
#undef RW_PREP
        float* so = (sq < BATCH ? c.out + O_WKVP + (((size_t)j * BATCH + sq) * RHEADS + h) * RH * RH : c.out + O_WKVS + (((size_t)j * DB + (sq - BATCH)) * RHEADS + h) * RH * RH) + (size_t)(2 * rp) * RH + 4 * cs;
        *(pg8::f32x4*)so = S0; *(pg8::f32x4*)(so + RH) = S1;
    }
}
struct FastMb {
    bf16_t* zb;
    bf16_t* xbcr;
    float* dtraw;
    bf16_t* xbcb;
    float* dt;
    float* y;
    bf16_t* yzn;
    bf16_t *wbint, *wbot;
};
struct EpiMamba {
    static constexpr bool PERM = true;
    bf16_t* zb; bf16_t* xbcr; float* dtraw;
    __device__ __forceinline__ void operator()(const pg8::f32x4 (&acc)[2][2][4][2], const pg8::Unit& u, int wr, int wc, int fr, int fq) const {
        using namespace pg8;
        const int row0 = u.pm * BM + wr * 64 + fr, cl0 = wc * 32 + 8 * fq, pn = u.pn;
        if (pn < 20) {
            bf16_t* base = pn < 8 ? zb : xbcr; const int ldc = pn < 8 ? 2048 : 3072, coff = pn < 8 ? pn * 256 : (pn - 8) * 256;
#pragma unroll
            for (int ai = 0; ai < 2; ++ai)
#pragma unroll
                for (int m = 0; m < 4; ++m) { bf16_t* rowp = base + (size_t)(row0 + ai * HALF + m * 16) * ldc + coff + cl0;
#pragma unroll
                    for (int bj = 0; bj < 2; ++bj) { const f32x4 v0 = acc[ai][bj][m][0], v1 = acc[ai][bj][m][1];
                        u32x4 w; w.x = cvt_pk_bf16(v0[0], v0[1]); w.y = cvt_pk_bf16(v0[2], v0[3]); w.z = cvt_pk_bf16(v1[0], v1[1]); w.w = cvt_pk_bf16(v1[2], v1[3]);
                        *(u32x4*)(rowp + bj * HALF) = w; } }
        } else if (cl0 < 32) {
#pragma unroll
            for (int ai = 0; ai < 2; ++ai)
#pragma unroll
                for (int m = 0; m < 4; ++m) { float* rowp = dtraw + (size_t)(row0 + ai * HALF + m * 16) * 32 + cl0;
                    *(f32x4*)rowp = acc[ai][0][m][0]; *(f32x4*)(rowp + 4) = acc[ai][0][m][1]; }
        }
    }
};
__device__ __forceinline__ void mb_conv_fast(const Ctx& c, const FastMb& fb, int l, size_t gtid, size_t gsz, bool write_f32) {
    using namespace cfg; const int j = l / 3; constexpr int NB = MB_CD / 8, TB = 8;
    for (size_t i = gtid; i < (size_t)(MTOT / TB) * NB; i += gsz) {
        const int mb = (int)(i / NB) * TB, cb = (int)(i % NB) * 8, t0 = row_t(mb), sq = row_seq(mb), T = seq_len(sq);
        float wt[MB_CONV][8], bias[8], win[MB_CONV][8];
#pragma unroll
        for (int e = 0; e < 8; ++e) bias[e] = c.in[I_CONVB][j * MB_CD + cb + e];
#pragma unroll
        for (int jj = 0; jj < MB_CONV; ++jj)
#pragma unroll
            for (int e = 0; e < 8; ++e) wt[jj][e] = c.in[I_CONVW][((size_t)j * MB_CONV + jj) * MB_CD + cb + e];
#pragma unroll
        for (int jj = 0; jj < MB_CONV - 1; ++jj) {
            const int tt = t0 + jj - (MB_CONV - 1);
            if (tt >= 0) { const pg8::u32x4 raw = *(const pg8::u32x4*)(fb.xbcr + (size_t)(mb + jj - (MB_CONV - 1)) * MB_CD + cb); const unsigned wv[4] = {raw.x, raw.y, raw.z, raw.w};
#pragma unroll
                for (int q = 0; q < 4; ++q) { win[jj][2 * q] = __uint_as_float(wv[q] << 16); win[jj][2 * q + 1] = __uint_as_float(wv[q] & 0xffff0000u); } }
            else if (sq >= BATCH) { const float* st = c.in[I_CONV] + (((size_t)j * DB + (sq - BATCH)) * (MB_CONV - 1) + (tt + MB_CONV - 1)) * MB_CD + cb;
#pragma unroll
                for (int e = 0; e < 8; ++e) win[jj][e] = st[e]; }
            else {
#pragma unroll
                for (int e = 0; e < 8; ++e) win[jj][e] = 0.f; }
        }
#pragma unroll
        for (int tb = 0; tb < TB; ++tb) {
            const int m = mb + tb, t = t0 + tb;
            { const pg8::u32x4 raw = *(const pg8::u32x4*)(fb.xbcr + (size_t)m * MB_CD + cb); const unsigned wv[4] = {raw.x, raw.y, raw.z, raw.w};
#pragma unroll
              for (int q = 0; q < 4; ++q) { win[3][2 * q] = __uint_as_float(wv[q] << 16); win[3][2 * q + 1] = __uint_as_float(wv[q] & 0xffff0000u); } }
            if (t >= T - (MB_CONV - 1)) {
                float* so = (sq < BATCH ? c.out + O_CONVP + (((size_t)j * BATCH + sq) * (MB_CONV - 1) + (t - (T - (MB_CONV - 1)))) * MB_CD
                                        : c.out + O_CONVS + (((size_t)j * DB + (sq - BATCH)) * (MB_CONV - 1) + (t - (T - (MB_CONV - 1)))) * MB_CD) + cb;
#pragma unroll
                for (int e = 0; e < 8; ++e) so[e] = win[3][e];
            }
            unsigned w[4];
#pragma unroll
            for (int q = 0; q < 4; ++q) {
                float a0 = bias[2 * q], a1 = bias[2 * q + 1];
#pragma unroll
                for (int jj = 0; jj < MB_CONV; ++jj) { a0 += win[jj][2 * q] * wt[jj][2 * q]; a1 += win[jj][2 * q + 1] * wt[jj][2 * q + 1]; }
                a0 = a0 * __builtin_amdgcn_rcpf(1.0f + __expf(-a0)); a1 = a1 * __builtin_amdgcn_rcpf(1.0f + __expf(-a1));
                w[q] = pk2bf(a0, a1); if (write_f32) { c.xbc[(size_t)m * MB_CD + cb + 2 * q] = a0; c.xbc[(size_t)m * MB_CD + cb + 2 * q + 1] = a1; } }
            *(pg8::u32x4*)(fb.xbcb + (size_t)m * MB_CD + cb) = (pg8::u32x4){w[0], w[1], w[2], w[3]};
#pragma unroll
            for (int jj = 0; jj < MB_CONV - 1; ++jj)
#pragma unroll
                for (int e = 0; e < 8; ++e) win[jj][e] = win[jj + 1][e];
        }
    }
    for (size_t i = gtid; i < (size_t)MTOT * MB_HEADS; i += gsz) {
        const float v = softplusf_(fb.dtraw[i] + c.in[I_DTB][j * MB_HEADS + (int)(i % MB_HEADS)]);
        fb.dt[i] = v; if (write_f32) c.dt[i] = v;
    }
}
__device__ __forceinline__ void mb_gate_fast(const Ctx& c, const FastMb& fb, const float* __restrict__ y, int l, int gw, int ngw, int lane) {
    using namespace cfg; const int j = l / 3; constexpr int GW_ = MB_INNER / MB_GROUPS;
    for (int it = gw; it < MTOT * MB_GROUPS; it += ngw) {
        const int m = it / MB_GROUPS, g = it % MB_GROUPS; const size_t o = (size_t)m * MB_INNER + g * GW_ + 8 * lane;
        const pg8::f32x4 y0 = *(const pg8::f32x4*)(y + o), y1 = *(const pg8::f32x4*)(y + o + 4); const pg8::u32x4 zr = *(const pg8::u32x4*)(fb.zb + o);
        const unsigned zw[4] = {zr.x, zr.y, zr.z, zr.w}; float v[8]; float s = 0.f;
#pragma unroll
        for (int q = 0; q < 4; ++q) { const float z0 = __uint_as_float(zw[q] << 16), z1 = __uint_as_float(zw[q] & 0xffff0000u);
            v[2 * q] = (q < 2 ? y0[2 * q] : y1[2 * q - 4]) * siluf_(z0); v[2 * q + 1] = (q < 2 ? y0[2 * q + 1] : y1[2 * q - 3]) * siluf_(z1); s += v[2 * q] * v[2 * q] + v[2 * q + 1] * v[2 * q + 1]; }
        const float rs = 1.0f / sqrtf(wave_sum64(s) * (1.0f / GW_) + NORM_EPS);
        const float* nw = c.in[I_BNORM] + j * MB_INNER + g * GW_ + 8 * lane; unsigned w[4];
#pragma unroll
        for (int q = 0; q < 4; ++q) w[q] = pk2bf(v[2 * q] * rs * nw[2 * q], v[2 * q + 1] * rs * nw[2 * q + 1]);
        *(pg8::u32x4*)(fb.yzn + o) = (pg8::u32x4){w[0], w[1], w[2], w[3]};
    }
}
constexpr int SS_XR = 144, SS_BR = 272;
constexpr int SS_XIM = 0, SS_XSM = SS_XIM + 128 * SS_XR, SS_BIM = SS_XSM + 128 * SS_XR, SS_CIM = SS_BIM + 128 * SS_BR, SS_MTM = SS_CIM + 128 * SS_BR, SS_HBM = SS_MTM + 128 * SS_BR, SS_TAB = SS_HBM + 128 * SS_XR, SS_END = SS_TAB + 2048;
__device__ __forceinline__ bf16x8v ss_trfrag(const LDSP unsigned char* img, int rowstride, int k0, int col0, int lane) {
    const int r0 = k0 + 8 * (lane >> 5) + ((lane & 15) >> 2), cc = col0 + 16 * ((lane >> 4) & 1) + 4 * (lane & 3);
    const s16x4 t0 = __builtin_amdgcn_ds_read_tr16_b64_v4i16((LDSP s16x4*)(img + r0 * rowstride + cc * 2));
    const s16x4 t1 = __builtin_amdgcn_ds_read_tr16_b64_v4i16((LDSP s16x4*)(img + (r0 + 4) * rowstride + cc * 2));
    return (bf16x8v){t0[0], t0[1], t0[2], t0[3], t1[0], t1[1], t1[2], t1[3]};
}
__device__ __forceinline__ void mb_ssd_prompt(const Ctx& c, const FastMb& fb, int l, LDSP unsigned char* lds) {
    using namespace cfg; const int j = l / 3;
    const int tid = (int)tid_now(), w = __builtin_amdgcn_readfirstlane(tid >> 6), lane = tid & 63, l31 = lane & 31, h5 = lane >> 5;
    LDSP float* tab = (LDSP float*)(lds + SS_TAB);
    for (int chain = blockIdx.x; chain < BATCH * MB_HEADS; chain += gridDim.x) {
        const int b = chain / MB_HEADS, hd = chain % MB_HEADS, g = hd / (MB_HEADS / MB_GROUPS);
        const float Ah = -expf(c.in[I_ALOG][j * MB_HEADS + hd]), Dh = c.in[I_BD][j * MB_HEADS + hd];
        f32x16_t H;
#pragma unroll
        for (int r = 0; r < 16; ++r) H[r] = 0.f;
        pg8::u32x4 nx[2], nB[4], nC[4]; float ndt = 0.f;
#define SS_LOAD(ck_) do { const size_t mm_ = (size_t)b * SEQ + 128 * (ck_); int tq_ = tid; asm volatile("" : "+v"(tq_)); \
            _Pragma("unroll") for (int q = 0; q < 2; ++q) { const int ci = tq_ + 512 * q; nx[q] = *(const pg8::u32x4*)(fb.xbcb + (mm_ + (ci >> 3)) * MB_CD + hd * MB_HEAD + (ci & 7) * 8); } \
            _Pragma("unroll") for (int q = 0; q < 4; ++q) { const int ci = tq_ + 512 * q; const bf16_t* rowp = fb.xbcb + (mm_ + (ci >> 4)) * MB_CD + MB_INNER + g * MB_STATE + (ci & 15) * 8; \
                nB[q] = *(const pg8::u32x4*)rowp; nC[q] = *(const pg8::u32x4*)(rowp + MB_GN); } \
            if (tq_ < 128) ndt = fb.dt[(mm_ + tq_) * MB_HEADS + hd]; } while (0)
        SS_LOAD(0);
        for (int ck = 0; ck < SEQ / 128; ++ck) {
            const size_t m0 = (size_t)b * SEQ + 128 * ck;
            int tl = tid; asm volatile("" : "+v"(tl));
            pg8::u32x4 xr[2];
#pragma unroll
            for (int q = 0; q < 2; ++q) { const int ci = tl + 512 * q; xr[q] = nx[q];
                *(LDSP pg8::u32x2*)(lds + SS_XIM + (ci >> 3) * SS_XR + (ci & 7) * 16) = (pg8::u32x2){xr[q].x, xr[q].y}; *(LDSP pg8::u32x2*)(lds + SS_XIM + (ci >> 3) * SS_XR + (ci & 7) * 16 + 8) = (pg8::u32x2){xr[q].z, xr[q].w}; }
#pragma unroll
            for (int q = 0; q < 4; ++q) { const int ci = tl + 512 * q;
                *(LDSP pg8::u32x4*)(lds + SS_BIM + (ci >> 4) * SS_BR + (ci & 15) * 16) = nB[q];
                *(LDSP pg8::u32x4*)(lds + SS_CIM + (ci >> 4) * SS_BR + (ci & 15) * 16) = nC[q]; }
            if (tl < 128) { tab[128 + tl] = ndt; tab[384 + tl] = ndt * Ah; }
            if (ck + 1 < SEQ / 128) SS_LOAD(ck + 1);
            __syncthreads();
            if (w == 0) {
                const float v0 = tab[384 + 2 * lane], v1 = tab[384 + 2 * lane + 1]; float s = v0 + v1;
#pragma unroll
                for (int o = 1; o < 64; o <<= 1) { const float u = __shfl_up(s, o); if (lane >= o) s += u; }
                tab[2 * lane] = s - v1; tab[2 * lane + 1] = s;
            }
            __syncthreads();
            const float alast = tab[127];
#pragma unroll
            for (int q = 0; q < 2; ++q) { const int ci = tl + 512 * q, row = ci >> 3; const float sc = __expf(alast - tab[row]) * tab[128 + row]; const unsigned xw[4] = {xr[q].x, xr[q].y, xr[q].z, xr[q].w}; unsigned ow[4];
#pragma unroll
                for (int e = 0; e < 4; ++e) ow[e] = pk2bf(__uint_as_float(xw[e] << 16) * sc, __uint_as_float(xw[e] & 0xffff0000u) * sc);
                *(LDSP pg8::u32x2*)(lds + SS_XSM + row * SS_XR + (ci & 7) * 16) = (pg8::u32x2){ow[0], ow[1]}; *(LDSP pg8::u32x2*)(lds + SS_XSM + row * SS_XR + (ci & 7) * 16 + 8) = (pg8::u32x2){ow[2], ow[3]}; }
            { int ln = lane; asm volatile("" : "+v"(ln)); const int a31 = ln & 31, a5 = ln >> 5;
              for (int tt = w; tt < 10; tt += 8) {
                int ib = tt < 1 ? 0 : (tt < 3 ? 1 : (tt < 6 ? 2 : 3)); const int jb = tt - (ib * (ib + 1)) / 2;
                f32x16_t ST;
#pragma unroll
                for (int r = 0; r < 16; ++r) ST[r] = 0.f;
#pragma unroll
                for (int s = 0; s < 8; ++s) { const bf16x8v a = *(const LDSP bf16x8v*)(lds + SS_BIM + (32 * jb + a31) * SS_BR + (16 * s + 8 * a5) * 2), bb = *(const LDSP bf16x8v*)(lds + SS_CIM + (32 * ib + a31) * SS_BR + (16 * s + 8 * a5) * 2);
                    ST = MFMA32(a, bb, ST); }
                const float ai = tab[32 * ib + a31];
#pragma unroll
                for (int g4 = 0; g4 < 4; ++g4) { const int jr = 32 * jb + 8 * g4 + 4 * a5; const pg8::f32x4 aj = *(const LDSP pg8::f32x4*)(tab + jr), dj = *(const LDSP pg8::f32x4*)(tab + 128 + jr);
#pragma unroll
                    for (int e = 0; e < 4; ++e) { const int jj = jr + e, ii = 32 * ib + a31; const float mv = jj <= ii ? ST[4 * g4 + e] * __expf(ai - aj[e]) * dj[e] : 0.f;
                        *(LDSP bf16_t*)(lds + SS_MTM + jj * SS_BR + ii * 2) = (bf16_t)(pk2bf(mv, 0.f) & 0xffffu); } }
              }
              const int nb = w >> 1, pb = w & 1;
#pragma unroll
              for (int r = 0; r < 16; ++r) *(LDSP bf16_t*)(lds + SS_HBM + (32 * nb + (r & 3) + 8 * (r >> 2) + 4 * a5) * SS_XR + (32 * pb + a31) * 2) = (bf16_t)(pk2bf(H[r], 0.f) & 0xffffu);
            }
            __syncthreads();
            { int ln = lane; asm volatile("" : "+v"(ln)); const int a31 = ln & 31, a5 = ln >> 5;
              const int pb = w & 1, ib = w >> 1, nb = w >> 1;
              f32x16_t Y;
#pragma unroll
              for (int r = 0; r < 16; ++r) Y[r] = 0.f;
#pragma unroll
              for (int s = 0; s < 8; ++s) { const bf16x8v a = ss_trfrag(lds + SS_HBM, SS_XR, 16 * s, 32 * pb, ln), bb = *(const LDSP bf16x8v*)(lds + SS_CIM + (32 * ib + a31) * SS_BR + (16 * s + 8 * a5) * 2);
                  Y = MFMA32(a, bb, Y); if (s & 1) __builtin_amdgcn_sched_barrier(0); }
              const float ei = __expf(tab[32 * ib + a31]);
#pragma unroll
              for (int r = 0; r < 16; ++r) Y[r] *= ei;
              for (int s = 0; s < 2 * (ib + 1); ++s) { const bf16x8v a = ss_trfrag(lds + SS_XIM, SS_XR, 16 * s, 32 * pb, ln), bb = ss_trfrag(lds + SS_MTM, SS_BR, 16 * s, 32 * ib, ln);
                  Y = MFMA32(a, bb, Y); }
              { const size_t mrow = m0 + 32 * ib + a31; float* yrow = fb.y + mrow * MB_INNER + hd * MB_HEAD + 32 * pb + 4 * a5;
#pragma unroll
                for (int g4 = 0; g4 < 4; ++g4) { const pg8::u32x2 xv = *(const LDSP pg8::u32x2*)(lds + SS_XIM + (32 * ib + a31) * SS_XR + (32 * pb + 8 * g4 + 4 * a5) * 2);
                    pg8::f32x4 o; o[0] = Y[4 * g4] + Dh * __uint_as_float(xv.x << 16); o[1] = Y[4 * g4 + 1] + Dh * __uint_as_float(xv.x & 0xffff0000u); o[2] = Y[4 * g4 + 2] + Dh * __uint_as_float(xv.y << 16); o[3] = Y[4 * g4 + 3] + Dh * __uint_as_float(xv.y & 0xffff0000u);
                    *(pg8::f32x4*)(yrow + 8 * g4) = o; } }
              const float dec = __expf(tab[127]);
#pragma unroll
              for (int r = 0; r < 16; ++r) H[r] *= dec;
#pragma unroll
              for (int s = 0; s < 8; ++s) { const bf16x8v a = ss_trfrag(lds + SS_BIM, SS_BR, 16 * s, 32 * nb, ln), bb = ss_trfrag(lds + SS_XSM, SS_XR, 16 * s, 32 * pb, ln);
                  H = MFMA32(a, bb, H); if (s & 1) __builtin_amdgcn_sched_barrier(0); }
            }
            __syncthreads();
        }
#undef SS_LOAD
        { const int nb = w >> 1, pb = w & 1; float* so = c.out + O_SSMP + (((size_t)j * BATCH + b) * MB_HEADS + hd) * MB_HEAD * MB_STATE;
#pragma unroll
          for (int r = 0; r < 16; ++r) so[(size_t)(32 * pb + l31) * MB_STATE + 32 * nb + (r & 3) + 8 * (r >> 2) + 4 * h5] = H[r]; }
    }
}
__device__ __forceinline__ void mb_scan_sample(const Ctx& c, const FastMb& fb, int l) {
    using namespace cfg; const int j = l / 3;
    const int tid = (int)tid_now(), p = tid >> 3, ns = tid & 7;
    pg8::f32x4 hn[4];
    { const int chain = blockIdx.x; if (chain < DB * MB_HEADS) { const size_t so = ((((size_t)j * DB + chain / MB_HEADS) * MB_HEADS + chain % MB_HEADS) * MB_HEAD + p) * MB_STATE + 16 * ns;
#pragma unroll
        for (int q = 0; q < 4; ++q) hn[q] = *(const pg8::f32x4*)(c.in[I_SSM] + so + 4 * q); } }
    for (int chain = blockIdx.x; chain < DB * MB_HEADS; chain += gridDim.x) {
        const int s = chain / MB_HEADS, hd = chain % MB_HEADS, g = hd / (MB_HEADS / MB_GROUPS);
        const float Ah = -expf(c.in[I_ALOG][j * MB_HEADS + hd]), Dh = c.in[I_BD][j * MB_HEADS + hd];
        const size_t so = ((((size_t)j * DB + s) * MB_HEADS + hd) * MB_HEAD + p) * MB_STATE + 16 * ns;
        float hs[16];
#pragma unroll
        for (int q = 0; q < 4; ++q) { hs[4 * q] = hn[q][0]; hs[4 * q + 1] = hn[q][1]; hs[4 * q + 2] = hn[q][2]; hs[4 * q + 3] = hn[q][3]; }
        { const int cn = chain + gridDim.x; if (cn < DB * MB_HEADS) { const size_t sn = ((((size_t)j * DB + cn / MB_HEADS) * MB_HEADS + cn % MB_HEADS) * MB_HEAD + p) * MB_STATE + 16 * ns;
#pragma unroll
            for (int q = 0; q < 4; ++q) hn[q] = *(const pg8::f32x4*)(c.in[I_SSM] + sn + 4 * q); } }
        float dtv[DS]; unsigned short xr[DS]; pg8::u32x4 Bq[DS][2], Cq[DS][2];
#pragma unroll
        for (int t = 0; t < DS; ++t) { const size_t m = (size_t)MP + s * DS + t; dtv[t] = fb.dt[m * MB_HEADS + hd]; xr[t] = fb.xbcb[m * MB_CD + hd * MB_HEAD + p];
            const bf16_t* Bp = fb.xbcb + m * MB_CD + MB_INNER + g * MB_STATE + 16 * ns; Bq[t][0] = *(const pg8::u32x4*)Bp; Bq[t][1] = *(const pg8::u32x4*)(Bp + 8);
            Cq[t][0] = *(const pg8::u32x4*)(Bp + MB_GN); Cq[t][1] = *(const pg8::u32x4*)(Bp + MB_GN + 8); }
#pragma unroll
        for (int t = 0; t < DS; ++t) {
            const size_t m = (size_t)MP + s * DS + t;
            const float dA = __expf(dtv[t] * Ah), xv = bf2f(xr[t]), xdt = xv * dtv[t];
            const unsigned bw[8] = {Bq[t][0].x, Bq[t][0].y, Bq[t][0].z, Bq[t][0].w, Bq[t][1].x, Bq[t][1].y, Bq[t][1].z, Bq[t][1].w};
            const unsigned cw[8] = {Cq[t][0].x, Cq[t][0].y, Cq[t][0].z, Cq[t][0].w, Cq[t][1].x, Cq[t][1].y, Cq[t][1].z, Cq[t][1].w};
            float yy = 0.f;
#pragma unroll
            for (int k = 0; k < 8; ++k) { hs[2 * k] = hs[2 * k] * dA + xdt * __uint_as_float(bw[k] << 16); hs[2 * k + 1] = hs[2 * k + 1] * dA + xdt * __uint_as_float(bw[k] & 0xffff0000u);
                yy += __uint_as_float(cw[k] << 16) * hs[2 * k] + __uint_as_float(cw[k] & 0xffff0000u) * hs[2 * k + 1]; }
            yy += __shfl_xor(yy, 1); yy += __shfl_xor(yy, 2); yy += __shfl_xor(yy, 4);
            if (ns == 0) fb.y[m * MB_INNER + hd * MB_HEAD + p] = yy + Dh * xv;
        }
        float* oo = c.out + O_SSMS + so;
#pragma unroll
        for (int q = 0; q < 4; ++q) *(pg8::f32x4*)(oo + 4 * q) = (pg8::f32x4){hs[4 * q], hs[4 * q + 1], hs[4 * q + 2], hs[4 * q + 3]};
    }
}
constexpr int RC_RS = 144;
constexpr int RC_AT = 0, RC_RT = 4608, RC_BB = 9216, RC_KB = 13824, RC_BH = 18432, RC_KH = 23040, RC_VV = 27648, RC_UT = 32256, RC_GG = 36864;
constexpr int RC_SB = 41472;
constexpr int RC_NAK = 50688, RC_MRB = 53248, RC_MRK = 55808, RC_NS = 80;
constexpr int RC_NAB = 58368;
constexpr int RC_E = 62464;
constexpr int RC_YB = 70656;
constexpr int RC_GL = 78848, RC_BON = 79104, RC_VV2 = 79360, RC_GG2 = RC_VV2 + 4608, RC_END0 = RC_GG2 + 4608;
constexpr int RC_WW = RC_END0, RC_WA = RC_WW + 64 * 144, RC_WG = RC_WA + 64 * 144, RC_WV = RC_WG + 64 * 336, RC_LUO = RC_WV + 64 * 80, RC_END = RC_LUO + 4 * 4608;
constexpr int RC_HB = RC_AT, RC_HBS = 784;
__device__ __forceinline__ bf16x8v rc_nat(const LDSP unsigned char* img, int stride, int row, int kofs) { return *(const LDSP bf16x8v*)(img + row * stride + kofs * 2); }
__device__ __forceinline__ int rc_row(int r, int h5) { return (r & 3) + 8 * (r >> 2) + 4 * h5; }
__device__ __forceinline__ void rc_st16(LDSP unsigned char* p, float v) { *(LDSP bf16_t*)p = (bf16_t)(pk2bf(v, 0.f) & 0xffffu); }


template <int S>
struct RcSub {
    static __device__ __forceinline__ void run(float (&acc)[32], const LDSP float* NAB, LDSP unsigned char* lds, int lane) {
        const float us = acc[S]; rc_st16(lds + RC_UT + S * RC_RS + lane * 2, us);
#pragma unroll
        for (int g4 = 0; g4 < 8; ++g4) { if (4 * g4 + 3 > S) { const pg8::f32x4 nv = *(const LDSP pg8::f32x4*)(NAB + S * 32 + 4 * g4);
#pragma unroll
            for (int e = 0; e < 4; ++e) { if (4 * g4 + e > S) acc[4 * g4 + e] = fmaf(nv[e], us, acc[4 * g4 + e]); } } }
        RcSub<S + 1>::run(acc, NAB, lds, lane);
    }
};
template <> struct RcSub<32> { static __device__ __forceinline__ void run(float (&)[32], const LDSP float*, LDSP unsigned char*, int) {} };

template <int J>
__device__ __forceinline__ void rw_scan_chunked(const Ctx& c, const FastRw& fr, LDSP unsigned char* lds) {
    using namespace cfg; constexpr int j = J;
    const int tid = (int)tid_now(), w = __builtin_amdgcn_readfirstlane(tid >> 6), lane = tid & 63, l31 = lane & 31, h5 = lane >> 5;
    LDSP float* Ef = (LDSP float*)(lds + RC_E); LDSP float* YB = (LDSP float*)(lds + RC_YB); LDSP float* GL = (LDSP float*)(lds + RC_GL); LDSP float* BON = (LDSP float*)(lds + RC_BON);
    LDSP float* NAB = (LDSP float*)(lds + RC_NAB);
    int hcur = -1;
    for (int chain = blockIdx.x; chain < NSEQ * RHEADS; chain += gridDim.x) {
        const int sq = chain / RHEADS, h = chain % RHEADS, T = seq_len(sq), m0 = seq_row0(sq), ch = h * RH + lane;
        const float p_w0 = c.in[I_W0][j * D + ch], p_a0 = c.in[I_A0][j * D + ch], p_kk = c.in[I_KK][j * D + ch], p_ka = c.in[I_KA][j * D + ch], p_rk = c.in[I_RK][(size_t)j * D + ch],
                    p_lnw = c.in[I_LNW][j * D + ch], p_lnb = c.in[I_LNB][j * D + ch], p_v0 = j > 0 ? c.in[I_V0][(j - 1) * D + ch] : 0.f;
        const int ib = (w >> 1) & 1, jb = w & 1;
        f32x16_t ST;
#pragma unroll
        for (int r = 0; r < 16; ++r) ST[r] = 0.f;
        if (w < 4 && sq >= BATCH) { const float* s0 = c.in[I_WKV] + (((size_t)j * DB + (sq - BATCH)) * RHEADS + h) * RH * RH;
#pragma unroll
            for (int r = 0; r < 16; ++r) ST[r] = s0[(size_t)(32 * ib + rc_row(r, h5)) * RH + 32 * jb + l31]; }
        const int nch = (T + 31) / 32;
        if (h != hcur) {
            __syncthreads();
            const bf16_t* lw = fr.lorat + (size_t)j * 4096 * 384;
            for (int ci = tid; ci < 64 * 8; ci += 512) { const int row = ci >> 3, c8 = ci & 7;
                *(LDSP pg8::u32x4*)(lds + RC_WW + row * 144 + c8 * 16) = *(const pg8::u32x4*)(lw + (size_t)(0 * 1024 + h * 64 + row) * 384 + 0 + c8 * 8);
                *(LDSP pg8::u32x4*)(lds + RC_WA + row * 144 + c8 * 16) = *(const pg8::u32x4*)(lw + (size_t)(1 * 1024 + h * 64 + row) * 384 + 64 + c8 * 8); }
            for (int ci = tid; ci < 64 * 20; ci += 512) { const int row = ci / 20, c20 = ci % 20;
                *(LDSP pg8::u32x4*)(lds + RC_WG + row * 336 + c20 * 16) = *(const pg8::u32x4*)(lw + (size_t)(2 * 1024 + h * 64 + row) * 384 + 128 + c20 * 8); }
            for (int ci = tid; ci < 64 * 4; ci += 512) { const int row = ci >> 2, c4 = ci & 3;
                *(LDSP pg8::u32x4*)(lds + RC_WV + row * 80 + c4 * 16) = *(const pg8::u32x4*)(lw + (size_t)(3 * 1024 + h * 64 + row) * 384 + 288 + c4 * 8); }
            hcur = h;
        }
        RwIn in[4]; pg8::u32x4 hbr[3];
#define RC_LOADIN(n) do { _Pragma("unroll") for (int q = 0; q < 4; ++q) { const int t_ = (n) * 32 + 4 * w + q; if (t_ < T) { const size_t m_ = (size_t)(m0 + t_); \
                const bf16_t* rk_ = fr.rkv + m_ * 3072 + ch; in[q].r = rk_[0]; in[q].k = rk_[1024]; in[q].v = rk_[2048]; \
                in[q].vf = j > 0 ? fr.vf[m_ * D + ch] : 0.f; } } \
            _Pragma("unroll") for (int k3 = 0; k3 < 3; ++k3) { const int ci_ = tid + 512 * k3, tk_ = ci_ / 48, t_ = (n) * 32 + tk_; \
                hbr[k3] = t_ < T ? *(const pg8::u32x4*)(fr.hb + (size_t)(m0 + t_) * 384 + (ci_ % 48) * 8) : (pg8::u32x4){0u, 0u, 0u, 0u}; } } while (0)
#define RC_EPI_TOKEN(nn, tl) do { const int vv_ = ((nn) & 1) ? RC_VV2 : RC_VV, gg_ = ((nn) & 1) ? RC_GG2 : RC_GG, bn_ = ((nn) & 1) ? 32 : 0; \
                const float y_ = YB[(tl) * 64 + lane], mean_ = wsum_dpp(y_) * (1.0f / RH), d_ = y_ - mean_, var_ = wsum_dpp(d_ * d_) * (1.0f / RH); \
                const float yn_ = d_ * __builtin_amdgcn_rsqf(var_ + LNX_EPS) * p_lnw + p_lnb; \
                const float o_ = (yn_ + BON[bn_ + (tl)] * bf2f(*(const LDSP bf16_t*)(lds + vv_ + (tl) * RC_RS + lane * 2))) * bf2f(*(const LDSP bf16_t*)(lds + gg_ + (tl) * RC_RS + lane * 2)); \
                fr.yo[(size_t)(m0 + (nn) * 32 + (tl)) * D + ch] = (bf16_t)(pk2bf(o_, 0.f) & 0xffffu); } while (0)
        __syncthreads();
        RC_LOADIN(0);
        for (int n = 0; n < nch; ++n) {
            const int tn = T - n * 32 < 32 ? T - n * 32 : 32;
            const int vvo = (n & 1) ? RC_VV2 : RC_VV, ggo = (n & 1) ? RC_GG2 : RC_GG, bno = (n & 1) ? 32 : 0;
#pragma unroll
            for (int k3 = 0; k3 < 3; ++k3) { const int ci_ = tid + 512 * k3; *(LDSP pg8::u32x4*)(lds + RC_HB + (ci_ / 48) * RC_HBS + (ci_ % 48) * 16) = hbr[k3]; }
            __syncthreads();
            { int ln = lane; asm volatile("" : "+v"(ln)); const int a31 = ln & 31, a5 = ln >> 5; const int grp = w >> 1, nb = w & 1;
              const int koff = grp == 0 ? 0 : (grp == 1 ? 64 : (grp == 2 ? 128 : 288)), nks = grp == 2 ? 10 : (grp == 3 ? 2 : 4);
              const int wof = grp == 0 ? RC_WW : (grp == 1 ? RC_WA : (grp == 2 ? RC_WG : RC_WV)), wst = grp == 2 ? 336 : (grp == 3 ? 80 : 144);
              f32x16_t LA;
#pragma unroll
              for (int r = 0; r < 16; ++r) LA[r] = 0.f;
              for (int ks = 0; ks < nks; ++ks) LA = MFMA32(rc_nat(lds + RC_HB, RC_HBS, a31, koff + 16 * ks + 8 * a5), rc_nat(lds + wof, wst, 32 * nb + a31, 16 * ks + 8 * a5), LA);
#pragma unroll
              for (int r = 0; r < 16; ++r) rc_st16(lds + RC_LUO + grp * 4608 + rc_row(r, a5) * RC_RS + (32 * nb + a31) * 2, LA[r]); }
            __syncthreads();
            float q_r[4], q_k[4], q_a[4], q_b[4], q_e[4];
#pragma unroll
            for (int q = 0; q < 4; ++q) {
                const int tl = 4 * w + q, tg = n * 32 + tl;
                float r_ = 0.f, k2_ = 0.f, v_ = 0.f, a_ = 0.f, b_ = 0.f, e_ = 0.f, g_ = 0.f, bon_ = 0.f;
                if (tg < T) {
                    r_ = bf2f(in[q].r); const float k0_ = bf2f(in[q].k); v_ = bf2f(in[q].v);
                    e_ = 0.6065306597126334f * fsigmoid(p_w0 + bf2f(*(const LDSP bf16_t*)(lds + RC_LUO + 0 * 4608 + tl * RC_RS + lane * 2)));
                    if (j == 0) fr.vf[(size_t)(m0 + tg) * D + ch] = v_; else v_ = v_ + (in[q].vf - v_) * fsigmoid(p_v0 + bf2f(*(const LDSP bf16_t*)(lds + RC_LUO + 3 * 4608 + tl * RC_RS + lane * 2)));
                    const float as_ = fsigmoid(p_a0 + bf2f(*(const LDSP bf16_t*)(lds + RC_LUO + 1 * 4608 + tl * RC_RS + lane * 2))); float kk_ = k0_ * p_kk;
                    k2_ = k0_ * (1.0f + (as_ - 1.0f) * p_ka);
                    float n_ = red16(kk_ * kk_), e1_ = red16(r_ * k2_ * p_rk);
                    n_ = (rdl(n_, 0) + rdl(n_, 16)) + (rdl(n_, 32) + rdl(n_, 48)); bon_ = (rdl(e1_, 0) + rdl(e1_, 16)) + (rdl(e1_, 32) + rdl(e1_, 48));
                    kk_ *= __builtin_amdgcn_rcpf(fmaxf(__builtin_amdgcn_sqrtf(n_), 1e-12f));
                    a_ = -kk_; b_ = kk_ * as_; g_ = bf2f(*(const LDSP bf16_t*)(lds + RC_LUO + 2 * 4608 + tl * RC_RS + lane * 2));
                }
                q_r[q] = r_; q_k[q] = k2_; q_a[q] = a_; q_b[q] = b_; q_e[q] = e_;
                Ef[tl * 64 + lane] = e_;
                rc_st16(lds + vvo + tl * RC_RS + lane * 2, v_); rc_st16(lds + ggo + tl * RC_RS + lane * 2, g_);
                if (lane == 0) BON[bno + tl] = bon_;
            }
            if (n + 1 < nch) RC_LOADIN(n + 1);
            if (w < 4) {
#pragma unroll
                for (int r = 0; r < 16; ++r) rc_st16(lds + RC_SB + (32 * ib + rc_row(r, h5)) * RC_RS + (32 * jb + l31) * 2, ST[r]);
            }
            __syncthreads();
            { float run = 0.f, base = 0.f;
#pragma unroll
              for (int s = 0; s < 32; ++s) { const float ev = Ef[s * 64 + lane]; if (s == 4 * w) base = run; run += ev; }
              const float cumL = run; float cum = base;
#pragma unroll
              for (int q = 0; q < 4; ++q) { const int tl = 4 * w + q; const float cprev = cum; cum += q_e[q];
                  const float gam = __expf(-cum), gamp = __expf(-cprev), ginv = __expf(cum), glr = __expf(cum - cumL);
                  rc_st16(lds + RC_AT + tl * RC_RS + lane * 2, q_a[q] * gamp); rc_st16(lds + RC_RT + tl * RC_RS + lane * 2, q_r[q] * gam);
                  rc_st16(lds + RC_BB + tl * RC_RS + lane * 2, q_b[q] * ginv); rc_st16(lds + RC_KB + tl * RC_RS + lane * 2, q_k[q] * ginv);
                  rc_st16(lds + RC_BH + tl * RC_RS + lane * 2, q_b[q] * glr); rc_st16(lds + RC_KH + tl * RC_RS + lane * 2, q_k[q] * glr); }
              if (w == 0) GL[lane] = __expf(-cumL); }
            __syncthreads();
            f32x16_t R1;
#pragma unroll
            for (int r = 0; r < 16; ++r) R1[r] = 0.f;
            { int ln = lane; asm volatile("" : "+v"(ln)); const int a31 = ln & 31, a5 = ln >> 5;
              if (w < 4) {
                  const int aoff = (w == 0) ? RC_BB : ((w < 2) ? RC_AT : RC_RT), boff = (w == 0) ? RC_AT : ((w & 1) ? RC_KB : RC_BB);
#pragma unroll
                  for (int ks = 0; ks < 4; ++ks) R1 = MFMA32(rc_nat(lds + aoff, RC_RS, a31, 16 * ks + 8 * a5), rc_nat(lds + boff, RC_RS, a31, 16 * ks + 8 * a5), R1);
#pragma unroll
                  for (int r = 0; r < 16; ++r) { const int rr = rc_row(r, a5), cc = a31;
                      if (w == 0) NAB[rr * 32 + cc] = (rr < cc) ? R1[r] : 0.f;
                      else { const bool keep = (w < 2) ? (cc < rr) : (cc <= rr); rc_st16(lds + (w == 1 ? RC_NAK : (w == 2 ? RC_MRB : RC_MRK)) + rr * RC_NS + cc * 2, keep ? R1[r] : 0.f); } }
              } else {
                  const int aoff = (w < 6) ? RC_AT : RC_RT, ibk = w & 1;
#pragma unroll
                  for (int ks = 0; ks < 4; ++ks) R1 = MFMA32(rc_nat(lds + aoff, RC_RS, a31, 16 * ks + 8 * a5), rc_nat(lds + RC_SB, RC_RS, 32 * ibk + a31, 16 * ks + 8 * a5), R1);
              } }
            __syncthreads();
            if (w == 4 || w == 5) { int ln = lane; asm volatile("" : "+v"(ln)); const int a31 = ln & 31, a5 = ln >> 5, ibk = w & 1;
#pragma unroll
                for (int ks = 0; ks < 2; ++ks) R1 = MFMA32(rc_nat(lds + RC_NAK, RC_NS, a31, 16 * ks + 8 * a5), ss_trfrag(lds + vvo, RC_RS, 16 * ks, 32 * ibk, ln), R1);
#pragma unroll
                for (int r = 0; r < 16; ++r) Ef[rc_row(r, a5) * 64 + 32 * ibk + a31] = R1[r]; }
            __syncthreads();
            if (w > 0 && n > 0) { for (int tl = w - 1; tl < 32; tl += 7) RC_EPI_TOKEN(n - 1, tl); }
            if (w == 0) { float acc[32];
#pragma unroll
                for (int t = 0; t < 32; ++t) acc[t] = Ef[t * 64 + lane];
                RcSub<0>::run(acc, NAB, lds, lane); }
            __syncthreads();
            { int ln = lane; asm volatile("" : "+v"(ln)); const int a31 = ln & 31, a5 = ln >> 5;
              if (w >= 6) { const int ibk = w & 1;
#pragma unroll
                  for (int ks = 0; ks < 2; ++ks) { R1 = MFMA32(rc_nat(lds + RC_MRB, RC_NS, a31, 16 * ks + 8 * a5), ss_trfrag(lds + RC_UT, RC_RS, 16 * ks, 32 * ibk, ln), R1);
                                                   R1 = MFMA32(rc_nat(lds + RC_MRK, RC_NS, a31, 16 * ks + 8 * a5), ss_trfrag(lds + vvo, RC_RS, 16 * ks, 32 * ibk, ln), R1); }
#pragma unroll
                  for (int r = 0; r < 16; ++r) YB[rc_row(r, a5) * 64 + 32 * ibk + a31] = R1[r];
              } else if (w < 4) { const float gl = GL[32 * jb + a31];
#pragma unroll
                  for (int r = 0; r < 16; ++r) ST[r] *= gl;
#pragma unroll
                  for (int ks = 0; ks < 2; ++ks) { ST = MFMA32(ss_trfrag(lds + RC_UT, RC_RS, 16 * ks, 32 * ib, ln), ss_trfrag(lds + RC_BH, RC_RS, 16 * ks, 32 * jb, ln), ST);
                                                   ST = MFMA32(ss_trfrag(lds + vvo, RC_RS, 16 * ks, 32 * ib, ln), ss_trfrag(lds + RC_KH, RC_RS, 16 * ks, 32 * jb, ln), ST); } } }
            __syncthreads();
        }
        { const int nl = nch - 1, tnl = T - nl * 32 < 32 ? T - nl * 32 : 32; for (int tl = w; tl < tnl; tl += 8) RC_EPI_TOKEN(nl, tl); }
#undef RC_EPI_TOKEN
#undef RC_LOADIN
        if (w < 4) { float* so = (sq < BATCH ? c.out + O_WKVP + (((size_t)j * BATCH + sq) * RHEADS + h) * RH * RH : c.out + O_WKVS + (((size_t)j * DB + (sq - BATCH)) * RHEADS + h) * RH * RH);
#pragma unroll
            for (int r = 0; r < 16; ++r) so[(size_t)(32 * ib + rc_row(r, h5)) * RH + 32 * jb + l31] = ST[r]; }
    }
}
template <int ACT, bool ACC>
__device__ __forceinline__ void gemm_dev(const float* __restrict__ A, int lda, const float* __restrict__ B, int ldb, float* C, int ldc, int M, int N, int K, unsigned short (*As)[40], unsigned short (*Bs)[40]) {
    const int tid = threadIdx.x, wave = tid >> 6, lane = tid & 63, wr = wave >> 1, wc = wave & 1, fr = lane & 15, fq = lane >> 4;
    const int ntn = (N + 127) / 128, ntm = (M + 127) / 128;
    for (int tile = blockIdx.x; tile < ntm * ntn; tile += gridDim.x) {
        const int bm = (tile / ntn) * 128, bn = (tile % ntn) * 128;
        f32x4_t acc[2][4];
#pragma unroll
        for (int i = 0; i < 2; ++i)
#pragma unroll
            for (int j = 0; j < 4; ++j) acc[i][j] = (f32x4_t){0.f, 0.f, 0.f, 0.f};
        for (int k0 = 0; k0 < K; k0 += 32) {
#pragma unroll
            for (int it = 0; it < 2; ++it) {
                const int idx = tid + it * 512, row = idx >> 3, c4 = idx & 7, gm = bm + row;
                float4 v = make_float4(0.f, 0.f, 0.f, 0.f);
                if (gm < M) v = *(const float4*)(A + (size_t)gm * lda + k0 + c4 * 4);
                uint2 w; w.x = (unsigned)f2bf(v.x) | ((unsigned)f2bf(v.y) << 16); w.y = (unsigned)f2bf(v.z) | ((unsigned)f2bf(v.w) << 16);
                *(uint2*)&As[row][c4 * 4] = w;
            }
#pragma unroll
            for (int it = 0; it < 2; ++it) {
                const int idx = tid + it * 512, kr = idx >> 5, n4 = idx & 31, gn = bn + n4 * 4;
                float4 v = make_float4(0.f, 0.f, 0.f, 0.f);
                if (gn < N) v = *(const float4*)(B + (size_t)(k0 + kr) * ldb + gn);
                Bs[n4 * 4 + 0][kr] = f2bf(v.x); Bs[n4 * 4 + 1][kr] = f2bf(v.y); Bs[n4 * 4 + 2][kr] = f2bf(v.z); Bs[n4 * 4 + 3][kr] = f2bf(v.w);
            }
            __syncthreads();
            bf16x8_t a[2], b[4];
#pragma unroll
            for (int i = 0; i < 2; ++i) a[i] = *(const bf16x8_t*)&As[wr * 32 + i * 16 + fr][fq * 8];
#pragma unroll
            for (int j = 0; j < 4; ++j) b[j] = *(const bf16x8_t*)&Bs[wc * 64 + j * 16 + fr][fq * 8];
#pragma unroll
            for (int i = 0; i < 2; ++i)
#pragma unroll
                for (int j = 0; j < 4; ++j) acc[i][j] = __builtin_amdgcn_mfma_f32_16x16x32_bf16(a[i], b[j], acc[i][j], 0, 0, 0);
            __syncthreads();
        }
#pragma unroll
        for (int i = 0; i < 2; ++i)
#pragma unroll
            for (int j = 0; j < 4; ++j)
#pragma unroll
                for (int e = 0; e < 4; ++e) {
                    const int row = bm + wr * 32 + i * 16 + fq * 4 + e, col = bn + wc * 64 + j * 16 + fr;
                    if (row < M && col < N) {
                        float v = acc[i][j][e];
                        if (ACT == 1) v = tanhf(v); else if (ACT == 2) v = 1.0f / (1.0f + expf(-v)); else if (ACT == 3) v = v > 0.f ? v * v : 0.f;
                        float* cp = C + (size_t)row * ldc + col; *cp = ACC ? *cp + v : v;
                    }
                }
    }
}

#define MRUN(ph, l) do { ph(c, l, gtid, gsz); xcd_barrier(bar); } while (0)
#define MGEMM(ACT, ACC, A, lda, B, ldb, C, ldc, M, N, K) do { gemm_dev<ACT, ACC>(A, lda, B, ldb, C, ldc, M, N, K, As, Bs); xcd_barrier(bar); } while (0)
#define KS_FFN 16
#define KS_1K 4
#define KS_MB 8
#ifndef ACC_KSPLIT
#define ACC_KSPLIT 1
#endif
#ifndef FFN_DOWN_KSPLIT
#define FFN_DOWN_KSPLIT 1
#endif
#define GBAR() xcd_barrier(bar)
#ifndef PROBE_DUP
#define PROBE_DUP 0
#endif
#define DUP(bit, ...) do { __VA_ARGS__; if (PROBE_DUP & (1 << (bit))) { GBAR(); __VA_ARGS__; } } while (0)
#define GTID_NOW() ((size_t)blockIdx.x * 512 + tid_now())
#define GSZ_NOW() ((size_t)gridDim.x * 512)
#define GW_NOW() ((int)(blockIdx.x * 8 + (tid_now() >> 6)))
#define NGW_NOW() ((int)(gridDim.x * 8))
#define LANE_NOW() ((int)(tid_now() & 63))
#undef MRUN
#undef MGEMM
#define MRUN(ph, l) do { ph(c, l, GTID_NOW(), GSZ_NOW()); xcd_barrier(bar); } while (0)
#define MGEMM(ACT, ACC, A, lda, B, ldb, C, ldc, M, N, K) do { gemm_dev<ACT, ACC>(A, lda, B, ldb, C, ldc, M, N, K, (unsigned short (*)[40])dynlds, (unsigned short (*)[40])(dynlds + 128 * 40 * 2)); xcd_barrier(bar); } while (0)
extern __shared__ __attribute__((aligned(16))) unsigned char dynlds[];

struct MegaArgs { Ctx c; Fast f; FastMla fm; FastRw fr; FastMb fb; unsigned* bar; };
constexpr int LDS_STAGE = 0, LDS_XB = 163840 - 64, LDS_BYTES = 163840;
static_assert(SD_END <= LDS_XB && SS_END <= LDS_XB && RC_END <= LDS_XB, "LDS map");

template <int L>
__device__ __forceinline__ void layer_mix_naive(const Ctx& c, const XcdBarrier& bar) {
    using namespace cfg;
    constexpr int l = L, kind = L % 3, j = L / 3;
    MRUN(ph_norm_mix, l);
    if constexpr (kind == 0) {
        MRUN(ph_rw_mix, l);
        const float* W = c.in[I_WRKV] + (size_t)j * 3 * D * D;
        MGEMM(0, false, c.xm[0], D, W, D, c.r, D, MTOT, D, D);
        MGEMM(0, false, c.xm[1], D, W + (size_t)D * D, D, c.k, D, MTOT, D, D);
        MGEMM(0, false, c.xm[2], D, W + (size_t)2 * D * D, D, c.v, D, MTOT, D, D);
        MGEMM(1, false, c.xm[3], D, c.in[I_W1] + (size_t)j * D * RW_DL, RW_DL, c.hw, RW_DL, MTOT, RW_DL, D);
        MGEMM(0, false, c.hw, RW_DL, c.in[I_W2] + (size_t)j * RW_DL * D, D, c.wpre, D, MTOT, D, RW_DL);
        MGEMM(0, false, c.xm[4], D, c.in[I_A1] + (size_t)j * D * RW_AL, RW_AL, c.ha, RW_AL, MTOT, RW_AL, D);
        MGEMM(0, false, c.ha, RW_AL, c.in[I_A2] + (size_t)j * RW_AL * D, D, c.apre, D, MTOT, D, RW_AL);
        if constexpr (j > 0) {
            MGEMM(0, false, c.xm[2], D, c.in[I_V1] + (size_t)(j - 1) * D * RW_VL, RW_VL, c.hv, RW_VL, MTOT, RW_VL, D);
            MGEMM(0, false, c.hv, RW_VL, c.in[I_V2] + (size_t)(j - 1) * RW_VL * D, D, c.vpre, D, MTOT, D, RW_VL);
        }
        MGEMM(2, false, c.xm[5], D, c.in[I_G1] + (size_t)j * D * RW_GL, RW_GL, c.hg, RW_GL, MTOT, RW_GL, D);
        MGEMM(0, false, c.hg, RW_GL, c.in[I_G2] + (size_t)j * RW_GL * D, D, c.g, D, MTOT, D, RW_GL);
        MRUN(ph_rw_prep, l); MRUN(ph_rw_scan, l); MRUN(ph_rw_post, l);
        MGEMM(0, true, c.yo, D, c.in[I_RWO] + (size_t)j * D * D, D, c.x, D, MTOT, D, D);
    } else if constexpr (kind == 1) {
        MGEMM(0, false, c.xn, D, c.in[I_MWIN] + (size_t)j * D * MLA_IN, MLA_IN, c.mh, MLA_IN, MTOT, MLA_IN, D);
        MRUN(ph_mla_norm1, l);
        MGEMM(0, false, c.qan, QL, c.in[I_WUQ] + (size_t)j * QL * MH * QD, MH * QD, c.q, MH * QD, MTOT, MH * QD, QL);
        MGEMM(0, false, c.c, KVL, c.in[I_WUK] + (size_t)j * KVL * MH * NOPE, MH * NOPE, c.knr, MH * NOPE, MTOT, MH * NOPE, KVL);
        MGEMM(0, false, c.c, KVL, c.in[I_WUV] + (size_t)j * KVL * MH * VD, MH * VD, c.vv, MH * VD, MTOT, MH * VD, KVL);
        MRUN(ph_mla_norm2, l); MRUN(ph_mla_attn_prompt, l); MRUN(ph_mla_score_sample, l); MRUN(ph_mla_softmax_sample, l); MRUN(ph_mla_pv_sample, l); MRUN(ph_mla_out_sample, l);
        MGEMM(0, true, c.ao, MH * VD, c.in[I_MWO] + (size_t)j * MH * VD * D, D, c.x, D, MTOT, D, MH * VD);
    } else {
        MGEMM(0, false, c.xn, D, c.in[I_BWIN] + (size_t)j * D * MB_IN, MB_IN, c.zx, MB_IN, MTOT, MB_IN, D);
        MRUN(ph_mb_conv, l); MRUN(ph_mb_dt, l); MRUN(ph_mb_scan, l); MRUN(ph_mb_gate, l);
        MGEMM(0, true, c.yzn, MB_INNER, c.in[I_BWO] + (size_t)j * MB_INNER * D, D, c.x, D, MTOT, D, MB_INNER);
    }
}


template <int L>
__device__ __forceinline__ void layer_rwkv_fast(const Ctx& c, const Fast& f, const FastRw& fr, const XcdBarrier& bar, LDSP unsigned char* lds) {
    using namespace cfg;
    constexpr int l = L, j = L / 3;
    if (L > 0) { fold_sample_rows(c.x, f.slab, KS_FFN, GW_NOW(), NGW_NOW(), LANE_NOW()); GBAR(); }
    DUP(9, rw_mix_fast(c, fr, l, GW_NOW(), NGW_NOW(), LANE_NOW()));
    GBAR();
    DUP(7, { pg8::Order<RwSel> S; S.init(MP / 256, MS / 256, 16, D, 1, gridDim.x, blockIdx.x);
      pg8::gemm_phase(lds, pg8::Gemm{fr.xm, fr.wrkvt + (size_t)j * 4096 * D, D, D, (size_t)MTOT * D}, S, EpiRwkv{fr.rkv, fr.hb}); });
    GBAR();
    DUP(2, rw_scan_chunked<j>(c, fr, lds));
    GBAR();
    { pg8::Order<> S; S.init(MP / 256, MS / 256, 4, D, KS_1K, gridDim.x, blockIdx.x);
      pg8::gemm_phase(lds, pg8::Gemm{fr.yo, fr.wot + (size_t)j * D * D, D, D, 0}, S, pg8::EpiAccF32{c.x, D, f.slab, MP / 256, MS / 256, KS_1K}); }
    if (PROBE_DUP & (1 << 26)) { GBAR(); pg8::Order<> S; S.init(MP / 256, MS / 256, 4, D, KS_1K, gridDim.x, blockIdx.x);
      pg8::gemm_phase(lds, pg8::Gemm{fr.yo, fr.wot + (size_t)j * D * D, D, D, 0}, S, pg8::EpiAccF32{c.hmid, D, f.slab + (size_t)16 * 16 * 65536, MP / 256, MS / 256, KS_1K}); }
    GBAR();
}

__device__ __forceinline__ void layer_mamba_fast(const Ctx& c, const Fast& f, const FastMb& fb, const XcdBarrier& bar, LDSP unsigned char* lds) {
    using namespace cfg;
    constexpr int l = 2, j = 0;
    norm_rows_bf16(c.x, c.in[I_NMIX] + l * D, f.xnb, f.slab, KS_FFN, GW_NOW(), NGW_NOW(), LANE_NOW());
    GBAR();
    DUP(8, { pg8::Order<> S; S.init(MP / 256, MS / 256, 21, D, 1, gridDim.x, blockIdx.x);
      pg8::gemm_phase(lds, pg8::Gemm{f.xnb, fb.wbint, D, D, 0}, S, EpiMamba{fb.zb, fb.xbcr, fb.dtraw}); });
    GBAR();
    DUP(12, mb_conv_fast(c, fb, l, GTID_NOW(), GSZ_NOW(), false));
    GBAR();
    DUP(6, mb_ssd_prompt(c, fb, l, lds); mb_scan_sample(c, fb, l));
    GBAR();
    DUP(13, mb_gate_fast(c, fb, fb.y, l, GW_NOW(), NGW_NOW(), LANE_NOW()));
    GBAR();
    { pg8::Order<> S; S.init(MP / 256, MS / 256, 4, MB_INNER, KS_MB, gridDim.x, blockIdx.x);
      pg8::gemm_phase(lds, pg8::Gemm{fb.yzn, fb.wbot, MB_INNER, MB_INNER, 0}, S, pg8::EpiAccF32{c.x, D, f.slab, MP / 256, MS / 256, KS_MB}); }
    if (PROBE_DUP & (1 << 28)) { GBAR(); pg8::Order<> S; S.init(MP / 256, MS / 256, 4, MB_INNER, KS_MB, gridDim.x, blockIdx.x);
      pg8::gemm_phase(lds, pg8::Gemm{fb.yzn, fb.wbot, MB_INNER, MB_INNER, 0}, S, pg8::EpiAccF32{c.hmid, D, f.slab + (size_t)16 * 16 * 65536, MP / 256, MS / 256, KS_MB}); }
    GBAR();
}

__device__ __forceinline__ void layer_mla_fast(const Ctx& c, const Fast& f, const FastMla& fm, const XcdBarrier& bar, LDSP unsigned char* lds) {
    using namespace cfg;
    constexpr int l = 1, j = 0;
    norm_rows_bf16(c.x, c.in[I_NMIX] + l * D, f.xnb, f.slab, KS_FFN, GW_NOW(), NGW_NOW(), LANE_NOW());
    GBAR();
    DUP(27, { pg8::Order<> S; S.init(MP / 256, MS / 256, 4, D, 1, gridDim.x, blockIdx.x);
      pg8::gemm_phase(lds, pg8::Gemm{f.xnb, fm.wint, D, D, 0}, S, pg8::EpiF32{fm.mh, 1024, 1024}); });
    GBAR();
    DUP(14, mla_norm1_fast(c, fm, j, GW_NOW(), NGW_NOW(), LANE_NOW()));
    GBAR();
    DUP(27, { pg8::Order<> S; S.init(MP / 256, MS / 256, (MH * QD) / 256, QL, 1, gridDim.x, blockIdx.x);
      pg8::gemm_phase(lds, pg8::Gemm{fm.qan, fm.wuqt, QL, QL, 0}, S, pg8::EpiBf16<0>{fm.qraw, MH * QD}); }
    { pg8::Order<> S; S.init(MP / 256, MS / 256, 4, KVL, 1, gridDim.x, blockIdx.x);
      pg8::gemm_phase(lds, pg8::Gemm{fm.cb, fm.wukvt, KVL, KVL, 0}, S, pg8::EpiBf16<0>{fm.kvraw, 2048}); }
    { pg8::Order<> S; S.init(4, 0, MTOT / 256, KVL, 1, gridDim.x, blockIdx.x);
      pg8::gemm_phase(lds, pg8::Gemm{fm.wukvt + (size_t)1024 * KVL, fm.cb, KVL, KVL, 0}, S, pg8::EpiBf16<0>{fm.vT, MTOT}); });
    GBAR();
    DUP(15, mla_norm2_fast(c, fm, j, GW_NOW(), NGW_NOW(), LANE_NOW()));
    GBAR();
    DUP(5, attn_prompt_fast(fm.qf, fm.knb, fm.kpb, fm.vT, fm.aob, lds));
    __syncthreads();
    DUP(4, mla_sample_decode(c, fm, fm.qs, fm.opart, fm.lpart, j, lds));
    GBAR();
    DUP(16, mla_sample_combine(c, fm, fm.opart, fm.lpart, j, lds));
    GBAR();
    { pg8::Order<> S; S.init(MP / 256, MS / 256, 4, D, KS_1K, gridDim.x, blockIdx.x);
      pg8::gemm_phase(lds, pg8::Gemm{fm.aob, fm.wot, D, D, 0}, S, pg8::EpiAccF32{c.x, D, f.slab, MP / 256, MS / 256, KS_1K}); }
    if (PROBE_DUP & (1 << 27)) { GBAR(); pg8::Order<> S; S.init(MP / 256, MS / 256, 4, D, KS_1K, gridDim.x, blockIdx.x);
      pg8::gemm_phase(lds, pg8::Gemm{fm.aob, fm.wot, D, D, 0}, S, pg8::EpiAccF32{c.hmid, D, f.slab + (size_t)16 * 16 * 65536, MP / 256, MS / 256, KS_1K}); }
    GBAR();
}

template <int L>
__device__ __forceinline__ void layer_ffn_fast(const Ctx& c, const Fast& f, const XcdBarrier& bar, LDSP unsigned char* lds) {
    using namespace cfg;
    norm_rows_bf16(c.x, c.in[I_NFFN] + L * D, f.xnb, f.slab, (L % 3 == 2) ? KS_MB : KS_1K, GW_NOW(), NGW_NOW(), LANE_NOW());
    GBAR();
    DUP(0, { pg8::Order<> S; S.init(MP / 256, MS / 256, FFN / 256, D, 1, gridDim.x, blockIdx.x);
      pg8::gemm_phase(lds, pg8::Gemm{f.xnb, f.w1t + (size_t)L * FFN * D, D, D, 0}, S, pg8::EpiBf16<3>{f.hmidb, FFN}); });
    GBAR();
    { pg8::Order<> S; S.init(MP / 256, MS / 256, D / 256, FFN, (L == DEPTH - 1) ? 1 : KS_FFN, gridDim.x, blockIdx.x);
      pg8::gemm_phase(lds, pg8::Gemm{f.hmidb, f.w2t + (size_t)L * D * FFN, FFN, FFN, 0}, S, pg8::EpiAccF32{c.x, D, f.slab, MP / 256, MS / 256, (L == DEPTH - 1) ? 1 : KS_FFN}); }
    if (PROBE_DUP & (1 << 25)) { GBAR(); pg8::Order<> S; S.init(MP / 256, MS / 256, D / 256, FFN, (L == DEPTH - 1) ? 1 : KS_FFN, gridDim.x, blockIdx.x);
      pg8::gemm_phase(lds, pg8::Gemm{f.hmidb, f.w2t + (size_t)L * D * FFN, FFN, FFN, 0}, S, pg8::EpiAccF32{c.hmid, D, f.slab + (size_t)16 * 16 * 65536, MP / 256, MS / 256, (L == DEPTH - 1) ? 1 : KS_FFN}); }
    GBAR();
}

__global__ void __launch_bounds__(512, 2) mega10(MegaArgs a) {
    LDSP unsigned char* lds = (LDSP unsigned char*)dynlds;
    if (threadIdx.x < 4) ((LDSP unsigned*)(lds + LDS_XB))[threadIdx.x] = 0u;
    __syncthreads();
    XcdBarrier bar = xcd_barrier_post(a.bar, (volatile LAS unsigned*)(lds + LDS_XB));
    const Ctx& c = a.c; const Fast& f = a.f; const FastMla& fm = a.fm; const FastRw& fr = a.fr; const FastMb& fb = a.fb;
    using namespace cfg;
    DUP(10, {
        LDSP float* scr = (LDSP float*)(lds + LDS_STAGE) + (tid_now() >> 6) * (64 * 33);
        for (int l = 0; l < DEPTH; ++l) {
            tr_weight(c.in[I_FW1] + (size_t)l * D * FFN, D, FFN, FFN, f.w1t + (size_t)l * FFN * D, nullptr, scr, GW_NOW(), NGW_NOW(), LANE_NOW());
            tr_weight(c.in[I_FW2] + (size_t)l * FFN * D, FFN, D, D, f.w2t + (size_t)l * D * FFN, nullptr, scr, GW_NOW(), NGW_NOW(), LANE_NOW());
        }
        tr_weight(c.in[I_MWIN], D, MLA_IN, 1024, fm.wint, nullptr, scr, GW_NOW(), NGW_NOW(), LANE_NOW());
        tr_weight(c.in[I_WUQ], QL, MH * QD, MH * QD, fm.wuqt, nullptr, scr, GW_NOW(), NGW_NOW(), LANE_NOW());
        tr_weight(c.in[I_WUK], KVL, MH * NOPE, MH * NOPE, fm.wukvt, nullptr, scr, GW_NOW(), NGW_NOW(), LANE_NOW());
        tr_weight(c.in[I_WUV], KVL, MH * VD, MH * VD, fm.wukvt + (size_t)1024 * KVL, nullptr, scr, GW_NOW(), NGW_NOW(), LANE_NOW());
        tr_weight(c.in[I_MWO], MH * VD, D, D, fm.wot, nullptr, scr, GW_NOW(), NGW_NOW(), LANE_NOW());
        for (int j = 0; j < N_RWKV; ++j) {
            bf16_t* wt = fr.wrkvt + (size_t)j * 4096 * D;
            for (int p = 0; p < 3; ++p) tr_weight(c.in[I_WRKV] + ((size_t)j * 3 + p) * D * D, D, D, D, wt + (size_t)p * D * D, nullptr, scr, GW_NOW(), NGW_NOW(), LANE_NOW());
            tr_weight(c.in[I_W1] + (size_t)j * D * RW_DL, D, RW_DL, 256, wt + (size_t)3072 * D, nullptr, scr, GW_NOW(), NGW_NOW(), LANE_NOW());
            tr_weight(c.in[I_A1] + (size_t)j * D * RW_AL, D, RW_AL, 256, wt + (size_t)3328 * D, nullptr, scr, GW_NOW(), NGW_NOW(), LANE_NOW());
            tr_weight(c.in[I_G1] + (size_t)j * D * RW_GL, D, RW_GL, 256, wt + (size_t)3584 * D, nullptr, scr, GW_NOW(), NGW_NOW(), LANE_NOW());
            tr_weight(j > 0 ? c.in[I_V1] + (size_t)(j - 1) * D * RW_VL : c.in[I_W1], D, j > 0 ? RW_VL : 0, 256, wt + (size_t)3840 * D, nullptr, scr, GW_NOW(), NGW_NOW(), LANE_NOW());
            tr_weight(c.in[I_RWO] + (size_t)j * D * D, D, D, D, fr.wot + (size_t)j * D * D, nullptr, scr, GW_NOW(), NGW_NOW(), LANE_NOW());
            rw_build_lorat(c, fr.lorat + (size_t)j * 4096 * 384, j, GTID_NOW(), GSZ_NOW());
        }
        tr_weight(c.in[I_BWIN], D, MB_IN, 5376, fb.wbint, nullptr, scr, GW_NOW(), NGW_NOW(), LANE_NOW());
        tr_weight(c.in[I_BWO], MB_INNER, D, D, fb.wbot, nullptr, scr, GW_NOW(), NGW_NOW(), LANE_NOW());
        ph_copy_x(c, 0, GTID_NOW(), GSZ_NOW());
    });
    GBAR();
    layer_rwkv_fast<0>(c, f, fr, bar, lds); layer_ffn_fast<0>(c, f, bar, lds);
    layer_mla_fast(c, f, fm, bar, lds); layer_ffn_fast<1>(c, f, bar, lds);
    layer_mamba_fast(c, f, fb, bar, lds); layer_ffn_fast<2>(c, f, bar, lds);
    layer_rwkv_fast<3>(c, f, fr, bar, lds); layer_ffn_fast<3>(c, f, bar, lds);
}

extern "C" void kernel_launch(void* const* d_in, const int* in_sizes, int n_in, void* d_out, int out_size, void* d_ws, size_t ws_size, hipStream_t stream) {
    using namespace cfg;
    MegaArgs a{};
    size_t used = setup_ctx(a.c, d_in, d_out, d_ws);
    { Bump b{(char*)d_ws, (size_t)((char*)a.c.xm[0] - (char*)d_ws)}; FastRw& r = a.fr;
      r.xm = (bf16_t*)b.f((size_t)6 * MTOT * D / 2); r.rkv = (bf16_t*)b.f((size_t)MTOT * 3072 / 2); r.hb = (bf16_t*)b.f((size_t)MTOT * 384 / 2); r.lu = (bf16_t*)b.f((size_t)MTOT * 4096 / 2);
      r.ops = b.f((size_t)MTOT * RHEADS * RW_REC + 4096); r.yo = (bf16_t*)b.f((size_t)MTOT * D / 2); r.vf = a.c.vf;
      if (b.off > (size_t)((char*)a.c.hmid - (char*)d_ws) + (size_t)MTOT * FFN * 4) { fprintf(stderr, "RWKV overlay too large\n"); return; } }
    { Bump b{(char*)d_ws, used};
      a.f.xnb = (bf16_t*)b.f((size_t)MTOT * D / 2); a.f.hmidb = (bf16_t*)b.f((size_t)MTOT * FFN / 2);
      a.f.w1t = (bf16_t*)b.f((size_t)DEPTH * FFN * D / 2); a.f.w2t = (bf16_t*)b.f((size_t)DEPTH * FFN * D / 2); a.f.slab = b.f((size_t)2 * 16 * 16 * 65536);
      FastMla& m = a.fm;
      m.mh = b.f((size_t)MTOT * 1024); m.qan = (bf16_t*)b.f((size_t)MTOT * QL / 2); m.cb = (bf16_t*)b.f((size_t)MTOT * KVL / 2); m.kpb = (bf16_t*)b.f((size_t)MTOT * ROPE / 2);
      m.qraw = (bf16_t*)b.f((size_t)MTOT * 1536 / 2); m.kvraw = (bf16_t*)b.f((size_t)MTOT * 2048 / 2); m.qf = (bf16_t*)b.f((size_t)MTOT * 1536 / 2); m.knb = (bf16_t*)b.f((size_t)MTOT * 1024 / 2);
      m.aob = (bf16_t*)b.f((size_t)MTOT * 1024 / 2); m.vT = (bf16_t*)b.f((size_t)MTOT * 1024 / 2); m.qs = (bf16_t*)b.f((size_t)MS * 1536 / 2);
      m.opart = b.f((size_t)2 * DB * 128 * 256); m.lpart = b.f((size_t)2 * DB * 128);
      m.wint = (bf16_t*)b.f((size_t)1024 * 1024 / 2); m.wuqt = (bf16_t*)b.f((size_t)1536 * 512 / 2); m.wukvt = (bf16_t*)b.f((size_t)2048 * 256 / 2); m.wot = (bf16_t*)b.f((size_t)1024 * 1024 / 2);
      { FastMb& q = a.fb; q.zb = (bf16_t*)b.f((size_t)MTOT * 2048 / 2); q.xbcr = (bf16_t*)b.f((size_t)MTOT * 3072 / 2); q.dtraw = b.f((size_t)MTOT * 32); q.xbcb = (bf16_t*)b.f((size_t)MTOT * 3072 / 2);
        q.dt = b.f((size_t)MTOT * 32); q.y = a.c.my; q.yzn = (bf16_t*)b.f((size_t)MTOT * 2048 / 2); q.wbint = (bf16_t*)b.f((size_t)5376 * 1024 / 2); q.wbot = (bf16_t*)b.f((size_t)1024 * 2048 / 2); }
      a.fr.wrkvt = (bf16_t*)b.f((size_t)N_RWKV * 4096 * D / 2); a.fr.lorat = (bf16_t*)b.f((size_t)N_RWKV * 4096 * 384 / 2); a.fr.wot = (bf16_t*)b.f((size_t)N_RWKV * D * D / 2);
      used = b.off; }
    if (used > ws_size || n_in != 51) { fprintf(stderr, "workspace too small: need %zu have %zu (n_in %d)\n", used, ws_size, n_in); return; }
    a.bar = (unsigned*)d_ws;
    static int grid = 0;
    if (!grid) {
        int dev = 0, cus = 0, per_cu = 0;
        (void)hipGetDevice(&dev); (void)hipDeviceGetAttribute(&cus, hipDeviceAttributeMultiprocessorCount, dev);
        if (hipFuncSetAttribute((const void*)mega10, hipFuncAttributeMaxDynamicSharedMemorySize, LDS_BYTES) != hipSuccess) { fprintf(stderr, "hipFuncSetAttribute failed\n"); grid = -1; return; }
        (void)hipOccupancyMaxActiveBlocksPerMultiprocessor(&per_cu, (const void*)mega10, 512, LDS_BYTES);
        (void)hipGetLastError();
        grid = per_cu >= 1 ? (cus < 256 ? cus : 256) : -1;
    }
    if (grid <= 0) { fprintf(stderr, "kernel does not fit one workgroup per CU\n"); return; }
    (void)hipMemsetAsync(a.bar, 0, XCD_BAR_WORDS * sizeof(unsigned), stream);
    hipLaunchKernelGGL(mega10, dim3(grid), dim3(512), LDS_BYTES, stream, a);
}
```

```cpp
#include <hip/hip_runtime.h>
#include <cstdio>
#include <math.h>
#include <stdint.h>
#include <stddef.h>
#ifdef CPU_EMU
#define DEV inline
#else
#define DEV __device__ __forceinline__
#endif

namespace cfg {
#ifdef CFG_SMALL
constexpr int D = 128, BATCH = 2, SEQ = 32, DEPTH = 4, DB = 3, DS = 8, PAST = 64, PAGE = 16;
constexpr int RW_DL = 16, RW_AL = 16, RW_VL = 8, RW_GL = 24;
constexpr int MH = 2, QL = 64, KVL = 32;
constexpr int MB_GROUPS = 2;
#else
constexpr int D = 1024, BATCH = 16, SEQ = 2048, DEPTH = 4, DB = 128, DS = 8, PAST = 8192, PAGE = 128;
constexpr int RW_DL = 64, RW_AL = 64, RW_VL = 32, RW_GL = 160;
constexpr int MH = 16, QL = 512, KVL = 256;
constexpr int MB_GROUPS = 4;
#endif
constexpr int N_RWKV = (DEPTH + 2) / 3, N_MLA = (DEPTH + 1) / 3, N_MAMBA = DEPTH / 3;
constexpr int RH = 64, RHEADS = D / RH;
constexpr int NOPE = 64, ROPE = 32, VD = 64, QD = NOPE + ROPE;
constexpr int MLA_IN = QL + KVL + ROPE;
constexpr int MB_INNER = 2 * D, MB_HEAD = 64, MB_HEADS = MB_INNER / MB_HEAD, MB_STATE = 128, MB_CONV = 4;
constexpr int MB_GN = MB_GROUPS * MB_STATE;
constexpr int MB_CD = MB_INNER + 2 * MB_GN, MB_IN = MB_INNER + MB_CD + MB_HEADS;
constexpr int FFN = 4 * D;
constexpr int NPAGES = PAST / PAGE, NPOOL = (DB * NPAGES * 5) / 4;
constexpr int MP = BATCH * SEQ, MS = DB * DS, MTOT = MP + MS, NSEQ = BATCH + DB;
constexpr int KTOT = PAST + DS;
constexpr float NORM_EPS = 1e-6f, LNX_EPS = 64e-5f;
constexpr size_t O_YP = 0;
constexpr size_t O_YS = O_YP + (size_t)MP * D;
constexpr size_t O_CKVP = O_YS + (size_t)MS * D;
constexpr size_t O_KPEP = O_CKVP + (size_t)N_MLA * MP * KVL;
constexpr size_t O_CKVS = O_KPEP + (size_t)N_MLA * MP * ROPE;
constexpr size_t O_KPES = O_CKVS + (size_t)N_MLA * MS * KVL;
constexpr size_t O_WKVP = O_KPES + (size_t)N_MLA * MS * ROPE;
constexpr size_t O_SHP = O_WKVP + (size_t)N_RWKV * BATCH * RHEADS * RH * RH;
constexpr size_t O_WKVS = O_SHP + (size_t)N_RWKV * BATCH * D;
constexpr size_t O_SHS = O_WKVS + (size_t)N_RWKV * DB * RHEADS * RH * RH;
constexpr size_t O_SSMP = O_SHS + (size_t)N_RWKV * DB * D;
constexpr size_t O_CONVP = O_SSMP + (size_t)N_MAMBA * BATCH * MB_HEADS * MB_HEAD * MB_STATE;
constexpr size_t O_SSMS = O_CONVP + (size_t)N_MAMBA * BATCH * (MB_CONV - 1) * MB_CD;
constexpr size_t O_CONVS = O_SSMS + (size_t)N_MAMBA * DB * MB_HEADS * MB_HEAD * MB_STATE;
constexpr size_t O_END = O_CONVS + (size_t)N_MAMBA * DB * (MB_CONV - 1) * MB_CD;
}

struct Ctx {
    const float* in[51];
    const int* page_table;
    float* out;
    float *x, *xn, *vf;
    float* xm[6];
    float *r, *k, *v, *wpre, *apre, *vpre, *g, *hw, *ha, *hv, *hg, *ka, *kb, *y, *yo;
    float *hmid;
    float *mh, *qan, *q, *c, *kp, *knr, *vv, *ao, *sc, *olat;
    float *zx, *xbc, *dt, *my, *yzn;
};

DEV int row_t(int m) { return m < cfg::MP ? m % cfg::SEQ : (m - cfg::MP) % cfg::DS; }
DEV int row_seq(int m) { return m < cfg::MP ? m / cfg::SEQ : cfg::BATCH + (m - cfg::MP) / cfg::DS; }
DEV int seq_row0(int sq) { return sq < cfg::BATCH ? sq * cfg::SEQ : cfg::MP + (sq - cfg::BATCH) * cfg::DS; }
DEV int seq_len(int sq) { return sq < cfg::BATCH ? cfg::SEQ : cfg::DS; }
DEV float sigmoidf_(float x) { return 1.0f / (1.0f + expf(-x)); }
DEV float softplusf_(float x) { return x > 20.f ? x : log1pf(expf(x)); }
DEV float siluf_(float x) { return x * sigmoidf_(x); }

enum { I_XP = 0, I_XS, I_CKV, I_KPE, I_WKV, I_SHIFT, I_SSM, I_CONV, I_PT, I_NMIX, I_NFFN, I_FW1, I_FW2, I_MU, I_WRKV, I_W0, I_W1, I_W2, I_A0, I_A1, I_A2,
       I_V0, I_V1, I_V2, I_G1, I_G2, I_KK, I_KA, I_RK, I_LNW, I_LNB, I_RWO, I_MWIN, I_QNORM, I_KVNORM, I_WUQ, I_WUK, I_WUV, I_QNN, I_QRN, I_KNN, I_KRN, I_MWO,
       I_BWIN, I_CONVW, I_CONVB, I_DTB, I_ALOG, I_BD, I_BNORM, I_BWO };

#define UNROLL _Pragma("unroll")
#define GSL(i, n) for (size_t i = gtid; i < (size_t)(n); i += gsz)

DEV void ph_copy_x(const Ctx& c, int, size_t gtid, size_t gsz) {
    using namespace cfg;
    GSL(i, (size_t)MTOT * D) c.x[i] = i < (size_t)MP * D ? c.in[I_XP][i] : c.in[I_XS][i - (size_t)MP * D];
}
DEV void rmsnorm_rows(const float* x, const float* gain, float* xn, size_t gtid, size_t gsz) {
    using namespace cfg;
    GSL(m, MTOT) {
        const float* xr = x + m * D; float ss = 0.f;
        for (int i = 0; i < D; ++i) ss += xr[i] * xr[i];
        const float rs = 1.0f / sqrtf(ss / D + NORM_EPS);
        for (int i = 0; i < D; ++i) xn[m * D + i] = xr[i] * rs * gain[i];
    }
}
DEV void ph_norm_mix(const Ctx& c, int l, size_t gtid, size_t gsz) { rmsnorm_rows(c.x, c.in[I_NMIX] + l * cfg::D, c.xn, gtid, gsz); }
DEV void ph_norm_ffn(const Ctx& c, int l, size_t gtid, size_t gsz) { rmsnorm_rows(c.x, c.in[I_NFFN] + l * cfg::D, c.xn, gtid, gsz); }

DEV void ph_rw_mix(const Ctx& c, int l, size_t gtid, size_t gsz) {
    using namespace cfg; const int j = l / 3;
    GSL(i, (size_t)MTOT * D) {
        const int m = (int)(i / D), ch = (int)(i % D), t = row_t(m), sq = row_seq(m);
        const float xc = c.xn[i];
        float xp;
        if (t > 0) xp = c.xn[i - D];
        else xp = sq < BATCH ? 0.f : c.in[I_SHIFT][((size_t)j * DB + (sq - BATCH)) * D + ch];
        for (int p = 0; p < 6; ++p) c.xm[p][i] = xc + (xp - xc) * c.in[I_MU][((size_t)j * 6 + p) * D + ch];
        if (t == seq_len(sq) - 1) {
            if (sq < BATCH) c.out[O_SHP + ((size_t)j * BATCH + sq) * D + ch] = xc;
            else c.out[O_SHS + ((size_t)j * DB + (sq - BATCH)) * D + ch] = xc;
        }
    }
}
DEV void ph_rw_prep(const Ctx& c, int l, size_t gtid, size_t gsz) {
    using namespace cfg; const int j = l / 3;
    GSL(i, (size_t)MTOT * RHEADS) {
        const int m = (int)(i / RHEADS), h = (int)(i % RHEADS);
        const size_t o = (size_t)m * D + h * RH;
        float nn = 0.f;
        for (int e = 0; e < RH; ++e) { const float kk = c.k[o + e] * c.in[I_KK][j * D + h * RH + e]; nn += kk * kk; }
        const float inv = 1.0f / fmaxf(sqrtf(nn), 1e-12f);
        for (int e = 0; e < RH; ++e) {
            const int ch = h * RH + e;
            const float wl = -softplusf_(-(c.in[I_W0][j * D + ch] + c.wpre[o + e])) - 0.5f;
            const float decay = expf(-expf(wl));
            float vv = c.v[o + e];
            if (j == 0) c.vf[o + e] = vv;
            else vv = vv + (c.vf[o + e] - vv) * sigmoidf_(c.in[I_V0][(j - 1) * D + ch] + c.vpre[o + e]);
            const float a = sigmoidf_(c.in[I_A0][j * D + ch] + c.apre[o + e]);
            const float k0 = c.k[o + e];
            const float kk = k0 * c.in[I_KK][j * D + ch] * inv;
            c.k[o + e] = k0 * (1.0f + (a - 1.0f) * c.in[I_KA][j * D + ch]);
            c.v[o + e] = vv;
            c.wpre[o + e] = decay;
            c.ka[o + e] = -kk;
            c.kb[o + e] = kk * a;
        }
    }
}
DEV void ph_rw_scan(const Ctx& c, int l, size_t gtid, size_t gsz) {
    using namespace cfg; const int j = l / 3;
    GSL(i, (size_t)NSEQ * RHEADS * RH) {
        const int sq = (int)(i / (RHEADS * RH)), h = (int)(i / RH) % RHEADS, vi = (int)(i % RH);
        float S[RH];
        if (sq < BATCH) { UNROLL for (int e = 0; e < RH; ++e) S[e] = 0.f; }
        else { const float* s0 = c.in[I_WKV] + ((((size_t)j * DB + (sq - BATCH)) * RHEADS + h) * RH + vi) * RH; UNROLL for (int e = 0; e < RH; ++e) S[e] = s0[e]; }
        const int m0 = seq_row0(sq), T = seq_len(sq);
        for (int t = 0; t < T; ++t) {
            const size_t o = (size_t)(m0 + t) * D + h * RH;
            float sa = 0.f;
            UNROLL for (int e = 0; e < RH; ++e) sa += S[e] * c.ka[o + e];
            const float vt = c.v[o + vi]; float yy = 0.f;
            UNROLL for (int e = 0; e < RH; ++e) { S[e] = S[e] * c.wpre[o + e] + sa * c.kb[o + e] + vt * c.k[o + e]; yy += S[e] * c.r[o + e]; }
            c.y[o + vi] = yy;
        }
        float* so = sq < BATCH ? c.out + O_WKVP + ((((size_t)j * BATCH + sq) * RHEADS + h) * RH + vi) * RH
                               : c.out + O_WKVS + ((((size_t)j * DB + (sq - BATCH)) * RHEADS + h) * RH + vi) * RH;
        UNROLL for (int e = 0; e < RH; ++e) so[e] = S[e];
    }
}
DEV void ph_rw_post(const Ctx& c, int l, size_t gtid, size_t gsz) {
    using namespace cfg; const int j = l / 3;
    GSL(i, (size_t)MTOT * RHEADS) {
        const int m = (int)(i / RHEADS), h = (int)(i % RHEADS);
        const size_t o = (size_t)m * D + h * RH;
        float mean = 0.f; for (int e = 0; e < RH; ++e) mean += c.y[o + e]; mean /= RH;
        float var = 0.f; for (int e = 0; e < RH; ++e) { const float d = c.y[o + e] - mean; var += d * d; } var /= RH;
        const float rs = 1.0f / sqrtf(var + LNX_EPS);
        float bonus = 0.f; for (int e = 0; e < RH; ++e) bonus += c.r[o + e] * c.k[o + e] * c.in[I_RK][(size_t)j * D + h * RH + e];
        for (int e = 0; e < RH; ++e) {
            const int ch = h * RH + e;
            const float yn = (c.y[o + e] - mean) * rs * c.in[I_LNW][j * D + ch] + c.in[I_LNB][j * D + ch];
            c.yo[o + e] = (yn + bonus * c.v[o + e]) * c.g[o + e];
        }
    }
}

DEV void rope_apply(const float* xin, float* xout, int pos) {
    using namespace cfg; const int half = ROPE / 2;
    UNROLL for (int i = 0; i < half; ++i) {
        const float inv = exp2f(-(float)i * (13.287712379549449f / half));
        const float ang = (float)pos * inv;
        const float kq = rintf(ang * 0.15915494309189535f);
        float rr = fmaf(-kq, 6.28125f, ang); rr = fmaf(-kq, 1.9353071795864769e-3f, rr);
        const float cs = __cosf(rr), sn = __sinf(rr);
        const float x1 = xin[i], x2 = xin[i + half];
        xout[i] = x1 * cs - x2 * sn; xout[i + half] = x2 * cs + x1 * sn;
    }
}
DEV int row_pos(int m) { return m < cfg::MP ? m % cfg::SEQ : cfg::PAST + (m - cfg::MP) % cfg::DS; }
DEV void ph_mla_norm1(const Ctx& c, int l, size_t gtid, size_t gsz) {
    using namespace cfg; const int j = l / 3;
    GSL(m, MTOT) {
        const float* h = c.mh + m * MLA_IN;
        float ss = 0.f; for (int i = 0; i < QL; ++i) ss += h[i] * h[i];
        float rs = 1.0f / sqrtf(ss / QL + NORM_EPS);
        for (int i = 0; i < QL; ++i) c.qan[m * QL + i] = h[i] * rs * c.in[I_QNORM][j * QL + i];
        ss = 0.f; for (int i = 0; i < KVL; ++i) ss += h[QL + i] * h[QL + i];
        rs = 1.0f / sqrtf(ss / KVL + NORM_EPS);
        float* co = m < (size_t)MP ? c.out + O_CKVP + ((size_t)j * MP + m) * KVL : c.out + O_CKVS + ((size_t)j * MS + (m - MP)) * KVL;
        for (int i = 0; i < KVL; ++i) { const float v = h[QL + i] * rs * c.in[I_KVNORM][j * KVL + i]; c.c[m * KVL + i] = v; co[i] = v; }
        ss = 0.f; UNROLL for (int i = 0; i < ROPE; ++i) ss += h[QL + KVL + i] * h[QL + KVL + i];
        rs = 1.0f / sqrtf(ss / ROPE + NORM_EPS);
        float tmp[ROPE], ro[ROPE];
        UNROLL for (int i = 0; i < ROPE; ++i) tmp[i] = h[QL + KVL + i] * rs * c.in[I_KRN][j * ROPE + i];
        rope_apply(tmp, ro, row_pos((int)m));
        float* ko = m < (size_t)MP ? c.out + O_KPEP + ((size_t)j * MP + m) * ROPE : c.out + O_KPES + ((size_t)j * MS + (m - MP)) * ROPE;
        UNROLL for (int i = 0; i < ROPE; ++i) { c.kp[m * ROPE + i] = ro[i]; ko[i] = ro[i]; }
    }
}
DEV void ph_mla_norm2(const Ctx& c, int l, size_t gtid, size_t gsz) {
    using namespace cfg; const int j = l / 3;
    GSL(i, (size_t)MTOT * MH) {
        const int m = (int)(i / MH), h = (int)(i % MH);
        float* q = c.q + (size_t)m * MH * QD + h * QD;
        float ss = 0.f; UNROLL for (int e = 0; e < NOPE; ++e) ss += q[e] * q[e];
        float rs = 1.0f / sqrtf(ss / NOPE + NORM_EPS);
        UNROLL for (int e = 0; e < NOPE; ++e) q[e] = q[e] * rs * c.in[I_QNN][j * NOPE + e];
        ss = 0.f; UNROLL for (int e = 0; e < ROPE; ++e) ss += q[NOPE + e] * q[NOPE + e];
        rs = 1.0f / sqrtf(ss / ROPE + NORM_EPS);
        float tmp[ROPE], ro[ROPE];
        UNROLL for (int e = 0; e < ROPE; ++e) tmp[e] = q[NOPE + e] * rs * c.in[I_QRN][j * ROPE + e];
        rope_apply(tmp, ro, row_pos(m));
        UNROLL for (int e = 0; e < ROPE; ++e) q[NOPE + e] = ro[e];
        float* kn = c.knr + (size_t)m * MH * NOPE + h * NOPE;
        ss = 0.f; UNROLL for (int e = 0; e < NOPE; ++e) ss += kn[e] * kn[e];
        rs = 1.0f / sqrtf(ss / NOPE + NORM_EPS);
        UNROLL for (int e = 0; e < NOPE; ++e) kn[e] = kn[e] * rs * c.in[I_KNN][j * NOPE + e];
    }
}
DEV void ph_mla_attn_prompt(const Ctx& c, int, size_t gtid, size_t gsz) {
    using namespace cfg; const float scale = 1.0f / sqrtf((float)QD);
    GSL(i, (size_t)MP * MH) {
        const int m = (int)(i / MH), h = (int)(i % MH), t = m % SEQ, m0 = m - t;
        const float* q = c.q + (size_t)m * MH * QD + h * QD;
        float mx = -INFINITY, den = 0.f, acc[VD];
        UNROLL for (int e = 0; e < VD; ++e) acc[e] = 0.f;
        for (int kx = 0; kx <= t; ++kx) {
            const int mk = m0 + kx;
            const float* kn = c.knr + (size_t)mk * MH * NOPE + h * NOPE; const float* kp = c.kp + (size_t)mk * ROPE;
            float s = 0.f;
            UNROLL for (int e = 0; e < NOPE; ++e) s += q[e] * kn[e];
            UNROLL for (int e = 0; e < ROPE; ++e) s += q[NOPE + e] * kp[e];
            s *= scale;
            const float nm = fmaxf(mx, s), corr = expf(mx - nm), p = expf(s - nm);
            den = den * corr + p;
            const float* v = c.vv + (size_t)mk * MH * VD + h * VD;
            UNROLL for (int e = 0; e < VD; ++e) acc[e] = acc[e] * corr + p * v[e];
            mx = nm;
        }
        UNROLL for (int e = 0; e < VD; ++e) c.ao[(size_t)m * MH * VD + h * VD + e] = acc[e] / den;
    }
}
DEV const float* smp_c(const Ctx& c, int j, int s, int pos) {
    using namespace cfg;
    if (pos < PAST) { const int pg = c.page_table[s * NPAGES + pos / PAGE]; return c.in[I_CKV] + (((size_t)j * NPOOL + pg) * PAGE + pos % PAGE) * KVL; }
    return c.c + (size_t)(MP + s * DS + (pos - PAST)) * KVL;
}
DEV const float* smp_kp(const Ctx& c, int j, int s, int pos) {
    using namespace cfg;
    if (pos < PAST) { const int pg = c.page_table[s * NPAGES + pos / PAGE]; return c.in[I_KPE] + (((size_t)j * NPOOL + pg) * PAGE + pos % PAGE) * ROPE; }
    return c.kp + (size_t)(MP + s * DS + (pos - PAST)) * ROPE;
}
DEV void ph_mla_score_sample(const Ctx& c, int l, size_t gtid, size_t gsz) {
    using namespace cfg; const int j = l / 3; const float scale = 1.0f / sqrtf((float)QD);
    GSL(i, (size_t)DB * KTOT * MH) {
        const int pos = (int)(i % KTOT), h = (int)((i / KTOT) % MH), s = (int)(i / ((size_t)MH * KTOT));
        const float* cl = smp_c(c, j, s, pos); const float* kp = smp_kp(c, j, s, pos);
        float kn[NOPE];
        UNROLL for (int e = 0; e < NOPE; ++e) kn[e] = 0.f;
        const float* wuk = c.in[I_WUK] + (size_t)j * KVL * MH * NOPE;
        for (int r = 0; r < KVL; ++r) { const float cv = cl[r]; const float* w = wuk + ((size_t)r * MH + h) * NOPE; UNROLL for (int e = 0; e < NOPE; ++e) kn[e] += cv * w[e]; }
        float ss = 0.f; UNROLL for (int e = 0; e < NOPE; ++e) ss += kn[e] * kn[e];
        const float rs = 1.0f / sqrtf(ss / NOPE + NORM_EPS);
        UNROLL for (int e = 0; e < NOPE; ++e) kn[e] = kn[e] * rs * c.in[I_KNN][j * NOPE + e];
        for (int qi = 0; qi < DS; ++qi) {
            const float* q = c.q + (size_t)(MP + s * DS + qi) * MH * QD + h * QD;
            float sc = 0.f;
            UNROLL for (int e = 0; e < NOPE; ++e) sc += q[e] * kn[e];
            UNROLL for (int e = 0; e < ROPE; ++e) sc += q[NOPE + e] * kp[e];
            const bool ok = pos < PAST || (pos - PAST) <= qi;
            c.sc[(((size_t)s * MH + h) * DS + qi) * KTOT + pos] = ok ? sc * scale : -INFINITY;
        }
    }
}
DEV void ph_mla_softmax_sample(const Ctx& c, int, size_t gtid, size_t gsz) {
    using namespace cfg;
    GSL(i, (size_t)DB * MH * DS) {
        float* sc = c.sc + i * KTOT;
        float mx = -INFINITY; for (int p = 0; p < KTOT; ++p) mx = fmaxf(mx, sc[p]);
        float den = 0.f; for (int p = 0; p < KTOT; ++p) den += expf(sc[p] - mx);
        const float inv = 1.0f / den;
        for (int p = 0; p < KTOT; ++p) sc[p] = expf(sc[p] - mx) * inv;
    }
}
DEV void ph_mla_pv_sample(const Ctx& c, int l, size_t gtid, size_t gsz) {
    using namespace cfg; const int j = l / 3;
    GSL(i, (size_t)DB * MH * DS * KVL) {
        const int r = (int)(i % KVL); const size_t row = i / KVL; const int s = (int)(row / (MH * DS));
        const float* p = c.sc + row * KTOT; float acc = 0.f;
        for (int pos = 0; pos < KTOT; ++pos) acc += p[pos] * smp_c(c, j, s, pos)[r];
        c.olat[i] = acc;
    }
}
DEV void ph_mla_out_sample(const Ctx& c, int l, size_t gtid, size_t gsz) {
    using namespace cfg; const int j = l / 3;
    GSL(i, (size_t)MS * MH * VD) {
        const int e = (int)(i % VD), h = (int)((i / VD) % MH), ms = (int)(i / (MH * VD)), s = ms / DS, qi = ms % DS;
        const float* ol = c.olat + (((size_t)s * MH + h) * DS + qi) * KVL;
        const float* wuv = c.in[I_WUV] + (size_t)j * KVL * MH * VD;
        float acc = 0.f;
        for (int r = 0; r < KVL; ++r) acc += ol[r] * wuv[((size_t)r * MH + h) * VD + e];
        c.ao[(size_t)(MP + ms) * MH * VD + h * VD + e] = acc;
    }
}

DEV float mb_xpad(const Ctx& c, int j, int m, int sq, int tt, int ch) {
    using namespace cfg;
    if (tt < MB_CONV - 1) return sq < BATCH ? 0.f : c.in[I_CONV][(((size_t)j * DB + (sq - BATCH)) * (MB_CONV - 1) + tt) * MB_CD + ch];
    (void)m; return c.zx[(size_t)(seq_row0(sq) + tt - (MB_CONV - 1)) * MB_IN + MB_INNER + ch];
}
DEV void ph_mb_conv(const Ctx& c, int l, size_t gtid, size_t gsz) {
    using namespace cfg; const int j = l / 3;
    GSL(i, (size_t)MTOT * MB_CD) {
        const int m = (int)(i / MB_CD), ch = (int)(i % MB_CD), t = row_t(m), sq = row_seq(m), T = seq_len(sq);
        float acc = c.in[I_CONVB][j * MB_CD + ch];
        for (int jj = 0; jj < MB_CONV; ++jj) acc += mb_xpad(c, j, m, sq, t + jj, ch) * c.in[I_CONVW][((size_t)j * MB_CONV + jj) * MB_CD + ch];
        c.xbc[i] = siluf_(acc);
        if (t < MB_CONV - 1) {
            const float v = mb_xpad(c, j, m, sq, T + t, ch);
            if (sq < BATCH) c.out[O_CONVP + (((size_t)j * BATCH + sq) * (MB_CONV - 1) + t) * MB_CD + ch] = v;
            else c.out[O_CONVS + (((size_t)j * DB + (sq - BATCH)) * (MB_CONV - 1) + t) * MB_CD + ch] = v;
        }
    }
}
DEV void ph_mb_dt(const Ctx& c, int l, size_t gtid, size_t gsz) {
    using namespace cfg; const int j = l / 3;
    GSL(i, (size_t)MTOT * MB_HEADS) {
        const int m = (int)(i / MB_HEADS), h = (int)(i % MB_HEADS);
        c.dt[i] = softplusf_(c.zx[(size_t)m * MB_IN + MB_INNER + MB_CD + h] + c.in[I_DTB][j * MB_HEADS + h]);
    }
}
DEV void ph_mb_scan(const Ctx& c, int l, size_t gtid, size_t gsz) {
    using namespace cfg; const int j = l / 3;
    GSL(i, (size_t)NSEQ * MB_HEADS * MB_HEAD) {
        const int p = (int)(i % MB_HEAD), h = (int)((i / MB_HEAD) % MB_HEADS), sq = (int)(i / (MB_HEADS * MB_HEAD));
        const int g = h / (MB_HEADS / MB_GROUPS);
        float hs[MB_STATE];
        if (sq < BATCH) { UNROLL for (int n = 0; n < MB_STATE; ++n) hs[n] = 0.f; }
        else { const float* s0 = c.in[I_SSM] + ((((size_t)j * DB + (sq - BATCH)) * MB_HEADS + h) * MB_HEAD + p) * MB_STATE; UNROLL for (int n = 0; n < MB_STATE; ++n) hs[n] = s0[n]; }
        const float A = -expf(c.in[I_ALOG][j * MB_HEADS + h]), dsk = c.in[I_BD][j * MB_HEADS + h];
        const int m0 = seq_row0(sq), T = seq_len(sq);
        for (int t = 0; t < T; ++t) {
            const size_t m = (size_t)(m0 + t);
            const float dtv = c.dt[m * MB_HEADS + h], dA = expf(dtv * A);
            const float xv = c.xbc[m * MB_CD + h * MB_HEAD + p], xdt = xv * dtv;
            const float* Bm = c.xbc + m * MB_CD + MB_INNER + g * MB_STATE; const float* Cm = Bm + MB_GN;
            float yy = 0.f;
            UNROLL for (int n = 0; n < MB_STATE; ++n) { hs[n] = hs[n] * dA + xdt * Bm[n]; yy += Cm[n] * hs[n]; }
            c.my[m * MB_INNER + h * MB_HEAD + p] = yy + dsk * xv;
        }
        float* so = sq < BATCH ? c.out + O_SSMP + ((((size_t)j * BATCH + sq) * MB_HEADS + h) * MB_HEAD + p) * MB_STATE
                               : c.out + O_SSMS + ((((size_t)j * DB + (sq - BATCH)) * MB_HEADS + h) * MB_HEAD + p) * MB_STATE;
        UNROLL for (int n = 0; n < MB_STATE; ++n) so[n] = hs[n];
    }
}
DEV void ph_mb_gate(const Ctx& c, int l, size_t gtid, size_t gsz) {
    using namespace cfg; const int j = l / 3; constexpr int GW = MB_INNER / MB_GROUPS;
    GSL(i, (size_t)MTOT * MB_GROUPS) {
        const int m = (int)(i / MB_GROUPS), g = (int)(i % MB_GROUPS);
        float ss = 0.f;
        for (int e = 0; e < GW; ++e) { const float v = c.my[(size_t)m * MB_INNER + g * GW + e] * siluf_(c.zx[(size_t)m * MB_IN + g * GW + e]); ss += v * v; }
        const float rs = 1.0f / sqrtf(ss / GW + NORM_EPS);
        for (int e = 0; e < GW; ++e) {
            const float v = c.my[(size_t)m * MB_INNER + g * GW + e] * siluf_(c.zx[(size_t)m * MB_IN + g * GW + e]);
            c.yzn[(size_t)m * MB_INNER + g * GW + e] = v * rs * c.in[I_BNORM][j * MB_INNER + g * GW + e];
        }
    }
}
typedef short bf16x8_t __attribute__((ext_vector_type(8)));
typedef float f32x4_t __attribute__((ext_vector_type(4)));
__device__ __forceinline__ unsigned short f2bf(float f) { unsigned u = __float_as_uint(f); u += 0x7fffu + ((u >> 16) & 1u); return (unsigned short)(u >> 16); }
#define XB_TMO      128
#define XB_XCNT(j)  (256  + 64 * (j))
#define XB_XSUB(j)  (1280 + 64 * (j))
#define XB_XGEN(j)  (2304 + 64 * (j))
#define XB_TOP      3328
#define XB_TOPGEN   3392
#define XCD_BAR_WORDS 3456
#define XB_SPIN_CAP (1u << 25)
#define LAS __attribute__((address_space(3)))

__device__ __forceinline__ unsigned xb_ld(unsigned* p)              { return __hip_atomic_load(p, __ATOMIC_RELAXED, __HIP_MEMORY_SCOPE_AGENT); }
__device__ __forceinline__ unsigned xb_add(unsigned* p, unsigned v) { return __hip_atomic_fetch_add(p, v, __ATOMIC_RELAXED, __HIP_MEMORY_SCOPE_AGENT); }
__device__ __forceinline__ unsigned xb_xcc_id() { return (unsigned)__builtin_amdgcn_s_getreg((3 << 11) | 20) & 0xFu; }
#define XB_SPIN(cond, bar) do { unsigned _sp = 0; while (cond) { __builtin_amdgcn_s_sleep(1); \
    if ((++_sp & 255u) == 0u) { if (xb_ld(&(bar)[XB_TMO])) break; if (_sp > XB_SPIN_CAP) { atomicAdd(&(bar)[XB_TMO], 1u); break; } } } } while (0)

struct XcdBarrier {
    unsigned* bar; unsigned x;
    volatile LAS unsigned* st;
};

__device__ __forceinline__ XcdBarrier xcd_barrier_post(unsigned* bar, volatile LAS unsigned* st) {
    XcdBarrier b; b.bar = bar; b.x = xb_xcc_id(); b.st = st;
    if (threadIdx.x == 0) (void)xb_add(&bar[XB_XCNT(b.x)], 1u);
    return b;
}
__device__ __forceinline__ void xcd_barrier_complete(unsigned* bar, unsigned x, unsigned& nloc, unsigned& nx) {
    const unsigned G = gridDim.x * gridDim.y * gridDim.z;
    unsigned sum, cnt, mine, sp = 0u;
    for (;;) {
        sum = 0u; cnt = 0u; mine = 0u;
#pragma unroll
        for (unsigned j = 0; j < 16; ++j) { const unsigned c = xb_ld(&bar[XB_XCNT(j)]); sum += c; cnt += (c > 0u) ? 1u : 0u; mine = (j == x) ? c : mine; }
        if (sum == G) break;
        __builtin_amdgcn_s_sleep(1);
        if ((++sp & 255u) == 0u) { if (xb_ld(&bar[XB_TMO])) break; if (sp > XB_SPIN_CAP) { atomicAdd(&bar[XB_TMO], 1u); break; } }
    }
    nloc = mine > 0u ? mine : 1u; nx = cnt > 0u ? cnt : 1u;
}

__device__ __forceinline__ void xcd_barrier(const XcdBarrier& b) {
    asm volatile("s_waitcnt vmcnt(0)" ::: "memory");
    __syncthreads();
    if (threadIdx.x == 0) {
        unsigned* bar = b.bar;
        __builtin_amdgcn_s_waitcnt(0);
        unsigned nloc = b.st[0], nx = b.st[1];
        if (nloc == 0u) { xcd_barrier_complete(bar, b.x, nloc, nx); b.st[0] = nloc; b.st[1] = nx; }
        const unsigned old = xb_add(&bar[XB_XSUB(b.x)], 1u);
        const unsigned gen = old / nloc;
        if (old + 1u == (gen + 1u) * nloc) {
            __builtin_amdgcn_fence(__ATOMIC_RELEASE, "agent");
            asm volatile("s_waitcnt vmcnt(0)" ::: "memory");
            const unsigned og = xb_add(&bar[XB_TOP], 1u);
            const unsigned tg = og / nx;
            if (og + 1u == (tg + 1u) * nx) xb_add(&bar[XB_TOPGEN], 1u);
            else XB_SPIN(xb_ld(&bar[XB_TOPGEN]) == tg, bar);
            __builtin_amdgcn_fence(__ATOMIC_ACQUIRE, "agent");
            xb_add(&bar[XB_XGEN(b.x)], 1u);
            asm volatile("s_waitcnt vmcnt(0)" ::: "memory");
        } else {
            XB_SPIN(xb_ld(&bar[XB_XGEN(b.x)]) == gen, bar);
            __builtin_amdgcn_fence(__ATOMIC_ACQUIRE, "agent");
            asm volatile("s_waitcnt vmcnt(0)" ::: "memory");
        }
    }
    __syncthreads();
}

struct Bump { char* p; size_t off; float* f(size_t n) { float* r = (float*)(p + off); off += ((n * 4 + 255) / 256) * 256; return r; } };

static size_t setup_ctx(Ctx& c, void* const* d_in, void* d_out, void* d_ws) {
    using namespace cfg;
    for (int i = 0; i < 51; ++i) c.in[i] = (const float*)d_in[i];
    c.page_table = (const int*)d_in[I_PT];
    c.out = (float*)d_out; c.x = c.out;
    Bump b{(char*)d_ws, 4096 * 4};
    const size_t MD = (size_t)MTOT * D;
    c.xn = b.f(MD); c.vf = b.f(MD);
    const size_t base = b.off;
    for (int p = 0; p < 6; ++p) c.xm[p] = b.f(MD);
    c.r = b.f(MD); c.k = b.f(MD); c.v = b.f(MD); c.wpre = b.f(MD); c.apre = b.f(MD); c.vpre = b.f(MD); c.g = b.f(MD);
    c.hw = b.f((size_t)MTOT * RW_DL); c.ha = b.f((size_t)MTOT * RW_AL); c.hv = b.f((size_t)MTOT * RW_VL); c.hg = b.f((size_t)MTOT * RW_GL);
    c.ka = b.f(MD); c.kb = b.f(MD); c.y = c.xm[0]; c.yo = c.xm[1];
    size_t hi = b.off;
    b.off = base;
    c.mh = b.f((size_t)MTOT * MLA_IN); c.qan = b.f((size_t)MTOT * QL); c.q = b.f((size_t)MTOT * MH * QD); c.c = b.f((size_t)MTOT * KVL); c.kp = b.f((size_t)MTOT * ROPE);
    c.knr = b.f((size_t)MTOT * MH * NOPE); c.vv = b.f((size_t)MTOT * MH * VD); c.ao = b.f((size_t)MTOT * MH * VD);
    c.sc = b.f((size_t)DB * MH * DS * KTOT); c.olat = b.f((size_t)DB * MH * DS * KVL);
    if (b.off > hi) hi = b.off;
    b.off = base;
    c.zx = b.f((size_t)MTOT * MB_IN); c.xbc = b.f((size_t)MTOT * MB_CD); c.dt = b.f((size_t)MTOT * MB_HEADS); c.my = b.f((size_t)MTOT * MB_INNER); c.yzn = b.f((size_t)MTOT * MB_INNER);
    if (b.off > hi) hi = b.off;
    b.off = hi;
    c.hmid = b.f((size_t)MTOT * FFN);
    return b.off;
}

__device__ __forceinline__ unsigned tid_now() { unsigned t = threadIdx.x; asm volatile("" : "+v"(t)); return t; }
namespace pg8 {
#define PG8_LAS __attribute__((address_space(3)))
typedef unsigned short bf16_t;
typedef short bf16x8 __attribute__((ext_vector_type(8)));
typedef float f32x4 __attribute__((ext_vector_type(4)));
typedef float f32x2 __attribute__((ext_vector_type(2)));
typedef unsigned u32x4 __attribute__((ext_vector_type(4)));
typedef unsigned u32x2 __attribute__((ext_vector_type(2)));
constexpr int BM = 256, BK = 64, HALF = 128, HTB = HALF * BK * 2  , STAGE_BYTES = 8 * HTB, NXCD = 8, WGM = 8;

__host__ __device__ __forceinline__ int lds_byte(int r, int c) { const int st = (r >> 4) * 2 + (c >> 5), rr = r & 15, cc = c & 31, ob = rr * 64 + cc * 2; return st * 1024 + (ob ^ (((ob >> 9) & 1) << 5)); }
__host__ __device__ __forceinline__ void stage_rc(int b, int& R, int& C) { const int st = b / 1024, sb = b % 1024, swz = sb ^ (((sb >> 9) & 1) << 5); R = (st >> 1) * 16 + swz / 64; C = (st & 1) * 32 + (swz % 64) / 2; }
__host__ __device__ __forceinline__ int perm32(int rho) { const int n = rho >> 4, i = rho & 15; return 8 * (i >> 2) + 4 * n + (i & 3); }
__device__ __forceinline__ unsigned cvt_pk_bf16(float lo, float hi) { unsigned r; asm volatile("v_cvt_pk_bf16_f32 %0, %1, %2" : "=v"(r) : "v"(lo), "v"(hi)); return r; }

struct Unit { int pm, pn, k0, nt, asel, part; };
struct Gemm { const bf16_t* A; const bf16_t* Bt; int lda, ldb; size_t asel_stride; };

struct NoSel { __device__ static __forceinline__ int sel(int) { return 0; } };
template <class ASEL = NoSel>
struct Order {
    int nMp, nMs, nN, nwgP, nwgS, G, c, K, ksplit;
    __device__ __forceinline__ void init(int nMp_, int nMs_, int nN_, int K_, int ksplit_, int G_, int c_) { nMp = nMp_; nMs = nMs_; nN = nN_; nwgP = nMp * nN; K = K_; ksplit = ksplit_; nwgS = nMs * nN * ksplit; G = G_; c = c_; }
    __device__ __forceinline__ bool next(int i, Unit& u) const {
        const long L = (long)i * G + c;
        if (L < nwgP) {
            int wgid = (int)L; { const int q = nwgP / NXCD, r = nwgP % NXCD, xcd = wgid % NXCD, off = wgid / NXCD; wgid = (xcd < r ? xcd * (q + 1) : r * (q + 1) + (xcd - r) * q) + off; }
            const int nig = WGM * nN, gid = wgid / nig, fm = gid * WGM, gsz = (nMp - fm) < WGM ? (nMp - fm) : WGM;
            u.pm = fm + ((wgid % nig) % gsz); u.pn = (wgid % nig) / gsz; u.k0 = 0; u.nt = K / BK; u.part = 0; u.asel = ASEL::sel(u.pn); return true;
        }
        const long Ls = L - nwgP; if (Ls >= nwgS) return false;
        const int sub = (int)(Ls % ksplit), t = (int)(Ls / ksplit);
        u.pm = nMp + t % nMs; u.pn = t / nMs; u.nt = K / BK / ksplit; u.k0 = sub * u.nt * BK; u.part = ksplit > 1 ? 1 : 0; u.asel = ASEL::sel(u.pn); return true;
    }
};

template <class Epi, class Sched>
__device__ __forceinline__ void gemm_phase(PG8_LAS unsigned char* lds, const Gemm g, const Sched& S, const Epi& E) {
    const int tid = (int)tid_now(), wid = __builtin_amdgcn_readfirstlane(tid >> 6), lane = tid & 63, wr = wid >> 2, wc = wid & 3, fr = lane & 15, fq = lane >> 4;
    unsigned voffA[2], voffB[2];
#pragma unroll
    for (int i = 0; i < 2; ++i) { int R, C; stage_rc(tid * 16 + i * 8192, R, C); const int Rb = Epi::PERM ? ((R & ~31) + perm32(R & 31)) : R;
        voffA[i] = (unsigned)(R * g.lda + C) * 2u; voffB[i] = (unsigned)(Rb * g.ldb + C) * 2u; }
    const size_t kstep = (size_t)(BK * 2);
    const size_t hstepA = (size_t)HALF * g.lda * 2, hstepB = (size_t)HALF * g.ldb * 2;
    const unsigned ldsw = (unsigned)wid * 1024u;
    const int aoff = lds_byte(wr * 64 + fr, fq * 8), boff = lds_byte(wc * 32 + fr, fq * 8);
#define PG8_SA(b, h) (((b) * 2 + (h)) * HTB)
#define PG8_SB(b, h) ((4 + (b) * 2 + (h)) * HTB)
#define PG8_STAGE(bufoff, gbase, voff) do { _Pragma("unroll") for (int _i = 0; _i < 2; ++_i) \
        __builtin_amdgcn_global_load_lds((const unsigned*)((const char*)(gbase) + (voff)[_i]), (PG8_LAS unsigned*)(lds + (bufoff) + ldsw + _i * 8192), 16, 0, 0); } while (0)
#define PG8_LDA(dst, b, h) do { _Pragma("unroll") for (int m = 0; m < 4; ++m) _Pragma("unroll") for (int k = 0; k < 2; ++k) dst[m][k] = *(const PG8_LAS bf16x8*)(lds + PG8_SA(b, h) + aoff + m * 2048 + k * 1024); } while (0)
#define PG8_LDB(dst, b, h) do { _Pragma("unroll") for (int n = 0; n < 2; ++n) _Pragma("unroll") for (int k = 0; k < 2; ++k) dst[n][k] = *(const PG8_LAS bf16x8*)(lds + PG8_SB(b, h) + boff + n * 2048 + k * 1024); } while (0)
#define PG8_MMA(ai, bj, At, Bt) do { __builtin_amdgcn_s_setprio(1); _Pragma("unroll") for (int m = 0; m < 4; ++m) _Pragma("unroll") for (int n = 0; n < 2; ++n) _Pragma("unroll") for (int k = 0; k < 2; ++k) \
        acc[ai][bj][m][n] = __builtin_amdgcn_mfma_f32_16x16x32_bf16(Bt[n][k], At[m][k], acc[ai][bj][m][n], 0, 0, 0); __builtin_amdgcn_s_setprio(0); } while (0)
#define PG8_WAIT_V(n) asm volatile("s_waitcnt vmcnt(" #n ")" ::: "memory")
#define PG8_WAIT_L(n) asm volatile("s_waitcnt lgkmcnt(" #n ")" ::: "memory")
#define PG8_BAR __builtin_amdgcn_s_barrier()
#define PG8_SCHED __builtin_amdgcn_sched_barrier(0)
#define PG8_ABASE(u) ((const char*)g.A + ((size_t)(u).asel * g.asel_stride + (size_t)(u).pm * BM * g.lda + (u).k0) * 2)
#define PG8_BBASE(u) ((const char*)g.Bt + ((size_t)(u).pn * BM * g.ldb + (u).k0) * 2)
    Unit cur, nxt; int ui = 0;
    if (!S.next(0, cur)) return;
    f32x4 acc[2][2][4][2];
#pragma unroll
    for (int a = 0; a < 2; ++a)
#pragma unroll
        for (int b = 0; b < 2; ++b)
#pragma unroll
            for (int m = 0; m < 4; ++m)
#pragma unroll
                for (int n = 0; n < 2; ++n) acc[a][b][m][n] = (f32x4){0.f, 0.f, 0.f, 0.f};
    bf16x8 At[4][2], B0[2][2], B1[2][2];
    const char* cA = PG8_ABASE(cur); const char* cB = PG8_BBASE(cur);
    PG8_STAGE(PG8_SB(0, 0), cB, voffB); PG8_STAGE(PG8_SA(0, 0), cA, voffA); PG8_STAGE(PG8_SB(0, 1), cB + hstepB, voffB); PG8_STAGE(PG8_SA(0, 1), cA + hstepA, voffA);
    if (wr == 1) PG8_BAR;
    PG8_WAIT_V(4); PG8_BAR;
    PG8_STAGE(PG8_SB(1, 0), cB + kstep, voffB); PG8_STAGE(PG8_SA(1, 0), cA + kstep, voffA); PG8_STAGE(PG8_SB(1, 1), cB + hstepB + kstep, voffB);
    PG8_WAIT_V(6); PG8_BAR;
    for (;;) {
        const bool has_next = S.next(ui + 1, nxt);
        const char* nA = has_next ? PG8_ABASE(nxt) : cA; const char* nB = has_next ? PG8_BBASE(nxt) : cB;
        const int nt = cur.nt;
        for (int t = 0; t < nt; t += 2) {
            const bool last = (t == nt - 2);
            const char* a1 = cA + (size_t)(t + 1) * kstep;
            const char* a2 = last ? nA : cA + (size_t)(t + 2) * kstep; const char* b2 = last ? nB : cB + (size_t)(t + 2) * kstep;
            const char* a3 = a2 + kstep; const char* b3 = b2 + kstep;
            PG8_LDB(B0, 0, 0); PG8_SCHED; PG8_LDA(At, 0, 0); PG8_STAGE(PG8_SA(1, 1), a1 + hstepA, voffA);
            PG8_WAIT_L(8); PG8_BAR; PG8_WAIT_L(0); PG8_MMA(0, 0, At, B0); PG8_BAR; PG8_SCHED;
            PG8_LDB(B1, 0, 1); PG8_STAGE(PG8_SB(0, 0), b2, voffB);
            PG8_BAR; PG8_WAIT_L(0); PG8_MMA(0, 1, At, B1); PG8_BAR;
            PG8_LDA(At, 0, 1); PG8_STAGE(PG8_SA(0, 0), a2, voffA);
            PG8_BAR; PG8_WAIT_L(0); PG8_MMA(1, 0, At, B0); PG8_BAR; PG8_SCHED;
            PG8_STAGE(PG8_SB(0, 1), b2 + hstepB, voffB);
            PG8_WAIT_V(6); PG8_BAR; PG8_MMA(1, 1, At, B1); PG8_BAR;
            PG8_LDB(B0, 1, 0); PG8_SCHED; PG8_LDA(At, 1, 0); PG8_STAGE(PG8_SA(0, 1), a2 + hstepA, voffA);
            PG8_WAIT_L(8); PG8_BAR; PG8_WAIT_L(0); PG8_MMA(0, 0, At, B0); PG8_BAR; PG8_SCHED;
            PG8_LDB(B1, 1, 1); PG8_STAGE(PG8_SB(1, 0), b3, voffB);
            PG8_BAR; PG8_WAIT_L(0); PG8_MMA(0, 1, At, B1); PG8_BAR;
            PG8_LDA(At, 1, 1); PG8_STAGE(PG8_SA(1, 0), a3, voffA);
            PG8_BAR; PG8_WAIT_L(0); PG8_MMA(1, 0, At, B0); PG8_BAR; PG8_SCHED;
            PG8_STAGE(PG8_SB(1, 1), b3 + hstepB, voffB);
            PG8_WAIT_V(6); PG8_BAR; PG8_MMA(1, 1, At, B1); PG8_BAR;
        }
        E(acc, cur, wr, wc, fr, fq);
        if (!has_next) break;
#pragma unroll
        for (int a = 0; a < 2; ++a)
#pragma unroll
            for (int b = 0; b < 2; ++b)
#pragma unroll
                for (int m = 0; m < 4; ++m)
#pragma unroll
                    for (int n = 0; n < 2; ++n) acc[a][b][m][n] = (f32x4){0.f, 0.f, 0.f, 0.f};
        cur = nxt; cA = nA; cB = nB; ++ui;
    }
    PG8_WAIT_V(0);
    if (wr == 0) PG8_BAR;
    PG8_BAR;
#undef PG8_SA
#undef PG8_SB
#undef PG8_STAGE
#undef PG8_LDA
#undef PG8_LDB
#undef PG8_MMA
#undef PG8_WAIT_V
#undef PG8_WAIT_L
#undef PG8_BAR
#undef PG8_SCHED
#undef PG8_ABASE
#undef PG8_BBASE
}

struct EpiAccF32 {
    static constexpr bool PERM = false;
    float* C; int ldc; float* slab; int pm0, nMs, ksplit;
    __device__ __forceinline__ void operator()(const f32x4 (&acc)[2][2][4][2], const Unit& u, int wr, int wc, int fr, int fq) const {
        if (u.part) {
            float* sl = slab + ((size_t)((u.pn * nMs + (u.pm - pm0)) * ksplit + u.k0 / (u.nt * BK)) * BM + wr * 64 + fr) * BM + wc * 32 + 4 * fq;
#pragma unroll
            for (int ai = 0; ai < 2; ++ai)
#pragma unroll
                for (int m = 0; m < 4; ++m) { float* rowp = sl + (size_t)(ai * HALF + m * 16) * BM;
#pragma unroll
                    for (int bj = 0; bj < 2; ++bj)
#pragma unroll
                        for (int n = 0; n < 2; ++n) *(f32x4*)(rowp + bj * HALF + n * 16) = acc[ai][bj][m][n]; }
        } else {
            const int row0 = u.pm * BM + wr * 64 + fr, col0 = u.pn * BM + wc * 32 + 4 * fq;
#pragma unroll
            for (int ai = 0; ai < 2; ++ai)
#pragma unroll
                for (int m2 = 0; m2 < 4; m2 += 2) {
                    f32x4 t[2][2][2];
#pragma unroll
                    for (int mm = 0; mm < 2; ++mm) { const float* rowp = C + (size_t)(row0 + ai * HALF + (m2 + mm) * 16) * ldc + col0;
#pragma unroll
                        for (int bj = 0; bj < 2; ++bj)
#pragma unroll
                            for (int n = 0; n < 2; ++n) t[mm][bj][n] = *(const f32x4*)(rowp + bj * HALF + n * 16); }
#pragma unroll
                    for (int mm = 0; mm < 2; ++mm) { float* rowp = C + (size_t)(row0 + ai * HALF + (m2 + mm) * 16) * ldc + col0;
#pragma unroll
                        for (int bj = 0; bj < 2; ++bj)
#pragma unroll
                            for (int n = 0; n < 2; ++n) *(f32x4*)(rowp + bj * HALF + n * 16) = t[mm][bj][n] + acc[ai][bj][m2 + mm][n]; }
                }
        }
    }
};
struct EpiF32 {
    static constexpr bool PERM = false;
    float* C; int ldc; int ncols;
    __device__ __forceinline__ void operator()(const f32x4 (&acc)[2][2][4][2], const Unit& u, int wr, int wc, int fr, int fq) const {
        const int row0 = u.pm * BM + wr * 64 + fr, col0 = u.pn * BM + wc * 32 + 4 * fq;
#pragma unroll
        for (int ai = 0; ai < 2; ++ai)
#pragma unroll
            for (int m = 0; m < 4; ++m) { float* rowp = C + (size_t)(row0 + ai * HALF + m * 16) * ldc + col0;
#pragma unroll
                for (int bj = 0; bj < 2; ++bj)
#pragma unroll
                    for (int n = 0; n < 2; ++n) if (col0 + bj * HALF + n * 16 < ncols) *(f32x4*)(rowp + bj * HALF + n * 16) = acc[ai][bj][m][n]; }
    }
};
template <int ACT> struct EpiBf16 {
    static constexpr bool PERM = true;
    bf16_t* O; int ldc;
    __device__ __forceinline__ void operator()(const f32x4 (&acc)[2][2][4][2], const Unit& u, int wr, int wc, int fr, int fq) const {
        const int row0 = u.pm * BM + wr * 64 + fr, col0 = u.pn * BM + wc * 32 + 8 * fq;
#pragma unroll
        for (int ai = 0; ai < 2; ++ai)
#pragma unroll
            for (int m = 0; m < 4; ++m) { bf16_t* rowp = O + (size_t)(row0 + ai * HALF + m * 16) * ldc + col0;
#pragma unroll
                for (int bj = 0; bj < 2; ++bj) { f32x4 v0 = acc[ai][bj][m][0], v1 = acc[ai][bj][m][1];
                    if (ACT == 3) {
#pragma unroll
                        for (int j = 0; j < 4; ++j) { const float a = fmaxf(v0[j], 0.f), b = fmaxf(v1[j], 0.f); v0[j] = a * a; v1[j] = b * b; } }
                    u32x4 w; w.x = cvt_pk_bf16(v0[0], v0[1]); w.y = cvt_pk_bf16(v0[2], v0[3]); w.z = cvt_pk_bf16(v1[0], v1[1]); w.w = cvt_pk_bf16(v1[2], v1[3]);
                    *(u32x4*)(rowp + bj * HALF) = w; } }
    }
};
}
typedef pg8::bf16_t bf16_t;
#define LDSP __attribute__((address_space(3)))
struct Fast {
    bf16_t *xnb, *hmidb;
    bf16_t *w1t, *w2t;
    float* slab;
};
__device__ __forceinline__ unsigned pk2bf(float lo, float hi) { return pg8::cvt_pk_bf16(lo, hi); }
__device__ __forceinline__ float wave_sum64(float v) {
#pragma unroll
    for (int o = 1; o < 64; o <<= 1) v += __shfl_xor(v, o);
    return v;
}
__device__ __forceinline__ void tr_item(const float* __restrict__ W, int ldw, int K, bf16_t* WT, int nvalid, const float* __restrict__ kscale, LDSP float* scr, int item, int nblk, int lane) {
    const int kb = item / nblk, nb = item % nblk, k0 = 64 * kb, n0 = 32 * nb;
    const bool ok = n0 < nvalid;
#pragma unroll
    for (int i = 0; i < 8; ++i) { const int kk = 8 * i + (lane >> 3), nn = 4 * (lane & 7); pg8::f32x4 v = ok ? *(const pg8::f32x4*)(W + (size_t)(k0 + kk) * ldw + n0 + nn) : (pg8::f32x4){0.f, 0.f, 0.f, 0.f};
        if (kscale) v = v * kscale[k0 + kk];
        scr[kk * 33 + nn] = v[0]; scr[kk * 33 + nn + 1] = v[1]; scr[kk * 33 + nn + 2] = v[2]; scr[kk * 33 + nn + 3] = v[3]; }
    asm volatile("s_waitcnt lgkmcnt(0)" ::: "memory");
    const int c = lane & 7;
#pragma unroll
    for (int j = 0; j < 4; ++j) { const int n = (lane >> 3) + 8 * j; const LDSP float* s = scr + (8 * c) * 33 + n;
        pg8::u32x4 o; o.x = pk2bf(s[0 * 33], s[1 * 33]); o.y = pk2bf(s[2 * 33], s[3 * 33]); o.z = pk2bf(s[4 * 33], s[5 * 33]); o.w = pk2bf(s[6 * 33], s[7 * 33]);
        *(pg8::u32x4*)(WT + (size_t)(n0 + n) * K + k0 + 8 * c) = o; }
    asm volatile("s_waitcnt lgkmcnt(0)" ::: "memory");
}
__device__ __forceinline__ void tr_weight(const float* W, int K, int N, int npad, bf16_t* WT, const float* kscale, LDSP float* scr, int gw, int ngw, int lane) {
    const int nblk = npad / 32, items = (K / 64) * nblk;
    for (int it = gw; it < items; it += ngw) tr_item(W, N, K, WT, N, kscale, scr, it, nblk, lane);
}
__device__ __forceinline__ pg8::f32x4 slab_sum(const float* __restrict__ slab, int ksplit, int m, int q, int lane) {
    using namespace cfg; const int rs = m - MP, pms = rs >> 8, row = rs & 255;
    const float* p = slab + ((size_t)((q * (MS / 256) + pms) * ksplit) * 256 + row) * 256 + 4 * lane;
    pg8::f32x4 s = {0.f, 0.f, 0.f, 0.f};
    for (int k = 0; k < ksplit; ++k) s = s + *(const pg8::f32x4*)(p + (size_t)k * 65536);
    return s;
}
__device__ __forceinline__ void norm_rows_bf16(float* __restrict__ x, const float* __restrict__ gain, bf16_t* xn, const float* __restrict__ slab, int ksplit, int gw, int ngw, int lane) {
    using namespace cfg;
    pg8::f32x4 gv[4];
#pragma unroll
    for (int j = 0; j < 4; ++j) gv[j] = *(const pg8::f32x4*)(gain + 4 * lane + 256 * j);
    for (int m = gw; m < MTOT; m += ngw) {
        float* xr = x + (size_t)m * D; pg8::f32x4 v[4]; float s = 0.f;
#pragma unroll
        for (int j = 0; j < 4; ++j) { v[j] = *(const pg8::f32x4*)(xr + 4 * lane + 256 * j);
            if (ksplit > 1 && m >= MP) { v[j] = v[j] + slab_sum(slab, ksplit, m, j, lane); *(pg8::f32x4*)(xr + 4 * lane + 256 * j) = v[j]; }
            s += (v[j][0] * v[j][0] + v[j][1] * v[j][1]) + (v[j][2] * v[j][2] + v[j][3] * v[j][3]); }
        const float rs = 1.0f / sqrtf(wave_sum64(s) * (1.0f / D) + NORM_EPS);
#pragma unroll
        for (int j = 0; j < 4; ++j) { pg8::u32x2 o; o.x = pk2bf(v[j][0] * rs * gv[j][0], v[j][1] * rs * gv[j][1]); o.y = pk2bf(v[j][2] * rs * gv[j][2], v[j][3] * rs * gv[j][3]);
            *(pg8::u32x2*)(xn + (size_t)m * D + 4 * lane + 256 * j) = o; }
    }
}

__device__ __forceinline__ void fold_sample_rows(float* __restrict__ x, const float* __restrict__ slab, int ksplit, int gw, int ngw, int lane) {
    using namespace cfg;
    for (int m = MP + gw; m < MTOT; m += ngw) {
#pragma unroll
        for (int j = 0; j < 4; ++j) { float* p = x + (size_t)m * D + 4 * lane + 256 * j; *(pg8::f32x4*)p = *(const pg8::f32x4*)p + slab_sum(slab, ksplit, m, j, lane); }
    }
}
struct FastMla {
    float* mh;
    bf16_t *qan, *cb, *kpb;
    bf16_t *qraw, *kvraw;
    bf16_t *qf, *knb, *aob, *vT, *qs;
    float *opart, *lpart;
    bf16_t *wint, *wuqt, *wukvt, *wot;
};
__device__ __forceinline__ void rope_cs(int pos, int i, float& cs, float& sn) {
    const float inv = exp2f(-(float)i * (13.287712379549449f / 16.0f));
    const float ang = (float)pos * inv, kq = rintf(ang * 0.15915494309189535f);
    float rr = fmaf(-kq, 6.28125f, ang); rr = fmaf(-kq, 1.9353071795864769e-3f, rr);
    cs = __cosf(rr); sn = __sinf(rr);
}
__device__ __forceinline__ float bf2f(unsigned short b) { return __uint_as_float(((unsigned)b) << 16); }
__device__ __forceinline__ void mla_norm1_fast(const Ctx& c, const FastMla& fm, int j, int gw, int ngw, int lane) {
    using namespace cfg;
    for (int m = gw; m < MTOT; m += ngw) {
        const float* h = fm.mh + (size_t)m * 1024;
        pg8::f32x4 qv[2]; float s = 0.f;
#pragma unroll
        for (int t = 0; t < 2; ++t) { qv[t] = *(const pg8::f32x4*)(h + 4 * lane + 256 * t); s += (qv[t][0] * qv[t][0] + qv[t][1] * qv[t][1]) + (qv[t][2] * qv[t][2] + qv[t][3] * qv[t][3]); }
        const float rq = 1.0f / sqrtf(wave_sum64(s) * (1.0f / QL) + NORM_EPS);
#pragma unroll
        for (int t = 0; t < 2; ++t) { const pg8::f32x4 g = *(const pg8::f32x4*)(c.in[I_QNORM] + j * QL + 4 * lane + 256 * t);
            pg8::u32x2 o; o.x = pk2bf(qv[t][0] * rq * g[0], qv[t][1] * rq * g[1]); o.y = pk2bf(qv[t][2] * rq * g[2], qv[t][3] * rq * g[3]);
            *(pg8::u32x2*)(fm.qan + (size_t)m * QL + 4 * lane + 256 * t) = o; }
        const pg8::f32x4 cv = *(const pg8::f32x4*)(h + QL + 4 * lane);
        const float rc = 1.0f / sqrtf(wave_sum64((cv[0] * cv[0] + cv[1] * cv[1]) + (cv[2] * cv[2] + cv[3] * cv[3])) * (1.0f / KVL) + NORM_EPS);
        const pg8::f32x4 gc = *(const pg8::f32x4*)(c.in[I_KVNORM] + j * KVL + 4 * lane);
        const pg8::f32x4 cn = {cv[0] * rc * gc[0], cv[1] * rc * gc[1], cv[2] * rc * gc[2], cv[3] * rc * gc[3]};
        float* co = m < MP ? c.out + O_CKVP + ((size_t)j * MP + m) * KVL : c.out + O_CKVS + ((size_t)j * MS + (m - MP)) * KVL;
        *(pg8::f32x4*)(co + 4 * lane) = cn; *(pg8::f32x4*)(c.c + (size_t)m * KVL + 4 * lane) = cn;
        { pg8::u32x2 o; o.x = pk2bf(cn[0], cn[1]); o.y = pk2bf(cn[2], cn[3]); *(pg8::u32x2*)(fm.cb + (size_t)m * KVL + 4 * lane) = o; }
        const float kv = lane < ROPE ? h[QL + KVL + lane] : 0.f;
        const float rk = 1.0f / sqrtf(wave_sum64(kv * kv) * (1.0f / ROPE) + NORM_EPS);
        const float kn = kv * rk * (lane < ROPE ? c.in[I_KRN][j * ROPE + lane] : 0.f);
        const float other = __shfl_xor(kn, 16);
        float cs, sn; rope_cs(row_pos(m), lane & 15, cs, sn);
        const float ro = lane < 16 ? kn * cs - other * sn : kn * cs + other * sn;
        if (lane < ROPE) {
            float* ko = m < MP ? c.out + O_KPEP + ((size_t)j * MP + m) * ROPE : c.out + O_KPES + ((size_t)j * MS + (m - MP)) * ROPE;
            ko[lane] = ro; c.kp[(size_t)m * ROPE + lane] = ro;
            fm.kpb[(size_t)m * ROPE + lane] = (bf16_t)(pk2bf(ro, 0.f) & 0xffffu);
        }
    }
}
__device__ __forceinline__ void mla_norm2_fast(const Ctx& c, const FastMla& fm, int j, int gw, int ngw, int lane) {
    using namespace cfg;
    const int hd = lane >> 2, qt = lane & 3;
    const float QSC = 0.10206207261596575f * 1.4426950408889634f;
    for (int m = gw; m < MTOT; m += ngw) {
        const bf16_t* qr = fm.qraw + (size_t)m * (MH * QD) + hd * QD;
        float v[16]; float s = 0.f;
        { const pg8::u32x4 a = *(const pg8::u32x4*)(qr + 16 * qt), b = *(const pg8::u32x4*)(qr + 16 * qt + 8); const unsigned w[8] = {a.x, a.y, a.z, a.w, b.x, b.y, b.z, b.w};
#pragma unroll
          for (int i = 0; i < 8; ++i) { v[2 * i] = __uint_as_float(w[i] << 16); v[2 * i + 1] = __uint_as_float(w[i] & 0xffff0000u); } }
#pragma unroll
        for (int i = 0; i < 16; ++i) s += v[i] * v[i];
        s += __shfl_xor(s, 1); s += __shfl_xor(s, 2);
        float rs = 1.0f / sqrtf(s * (1.0f / NOPE) + NORM_EPS);
        bf16_t* qo = fm.qf + (size_t)m * (MH * QD) + hd * QD; float* qo32 = c.q + (size_t)m * (MH * QD) + hd * QD;
        { unsigned w[8], w2[8];
#pragma unroll
          for (int i = 0; i < 8; ++i) { const float a = v[2 * i] * rs * c.in[I_QNN][j * NOPE + 16 * qt + 2 * i], b = v[2 * i + 1] * rs * c.in[I_QNN][j * NOPE + 16 * qt + 2 * i + 1];
              w[i] = pk2bf(a * QSC, b * QSC); qo32[16 * qt + 2 * i] = a; qo32[16 * qt + 2 * i + 1] = b;
              w2[i] = pk2bf(a * QSC * c.in[I_KNN][j * NOPE + 16 * qt + 2 * i], b * QSC * c.in[I_KNN][j * NOPE + 16 * qt + 2 * i + 1]); }
          *(pg8::u32x4*)(qo + 16 * qt) = (pg8::u32x4){w[0], w[1], w[2], w[3]}; *(pg8::u32x4*)(qo + 16 * qt + 8) = (pg8::u32x4){w[4], w[5], w[6], w[7]};
          if (m >= MP) { bf16_t* q2 = fm.qs + (size_t)(m - MP) * (MH * QD) + hd * QD;
              *(pg8::u32x4*)(q2 + 16 * qt) = (pg8::u32x4){w2[0], w2[1], w2[2], w2[3]}; *(pg8::u32x4*)(q2 + 16 * qt + 8) = (pg8::u32x4){w2[4], w2[5], w2[6], w2[7]}; } }
        float r8[8]; s = 0.f;
        { const pg8::u32x4 a = *(const pg8::u32x4*)(qr + NOPE + 8 * qt); const unsigned w[4] = {a.x, a.y, a.z, a.w};
#pragma unroll
          for (int i = 0; i < 4; ++i) { r8[2 * i] = __uint_as_float(w[i] << 16); r8[2 * i + 1] = __uint_as_float(w[i] & 0xffff0000u); } }
#pragma unroll
        for (int i = 0; i < 8; ++i) s += r8[i] * r8[i];
        s += __shfl_xor(s, 1); s += __shfl_xor(s, 2);
        rs = 1.0f / sqrtf(s * (1.0f / ROPE) + NORM_EPS);
        { unsigned w[4]; float o8[8];
#pragma unroll
          for (int i = 0; i < 8; ++i) { const float mine = r8[i] * rs * c.in[I_QRN][j * ROPE + 8 * qt + i]; const float oth = __shfl_xor(mine, 2);
              float cs, sn; rope_cs(row_pos(m), (8 * qt + i) & 15, cs, sn);
              o8[i] = qt < 2 ? mine * cs - oth * sn : mine * cs + oth * sn; qo32[NOPE + 8 * qt + i] = o8[i]; }
#pragma unroll
          for (int i = 0; i < 4; ++i) w[i] = pk2bf(o8[2 * i] * QSC, o8[2 * i + 1] * QSC);
          *(pg8::u32x4*)(qo + NOPE + 8 * qt) = (pg8::u32x4){w[0], w[1], w[2], w[3]};
          if (m >= MP) *(pg8::u32x4*)(fm.qs + (size_t)(m - MP) * (MH * QD) + hd * QD + NOPE + 8 * qt) = (pg8::u32x4){w[0], w[1], w[2], w[3]}; }
        const bf16_t* kr = fm.kvraw + (size_t)m * 2048 + hd * NOPE; s = 0.f;
        { const pg8::u32x4 a = *(const pg8::u32x4*)(kr + 16 * qt), b = *(const pg8::u32x4*)(kr + 16 * qt + 8); const unsigned w[8] = {a.x, a.y, a.z, a.w, b.x, b.y, b.z, b.w};
#pragma unroll
          for (int i = 0; i < 8; ++i) { v[2 * i] = __uint_as_float(w[i] << 16); v[2 * i + 1] = __uint_as_float(w[i] & 0xffff0000u); } }
#pragma unroll
        for (int i = 0; i < 16; ++i) s += v[i] * v[i];
        s += __shfl_xor(s, 1); s += __shfl_xor(s, 2);
        rs = 1.0f / sqrtf(s * (1.0f / NOPE) + NORM_EPS);
        bf16_t* ko = fm.knb + (size_t)m * (MH * NOPE) + hd * NOPE;
        { unsigned w[8];
#pragma unroll
          for (int i = 0; i < 8; ++i) { const float a = v[2 * i] * rs * c.in[I_KNN][j * NOPE + 16 * qt + 2 * i], b = v[2 * i + 1] * rs * c.in[I_KNN][j * NOPE + 16 * qt + 2 * i + 1];
              w[i] = pk2bf(a, b); }
          *(pg8::u32x4*)(ko + 16 * qt) = (pg8::u32x4){w[0], w[1], w[2], w[3]}; *(pg8::u32x4*)(ko + 16 * qt + 8) = (pg8::u32x4){w[4], w[5], w[6], w[7]}; }
    }
}
__device__ __forceinline__ void cvt_f32_bf16(const float* __restrict__ s, bf16_t* d, size_t n, size_t gtid, size_t gsz) {
    for (size_t i = gtid * 4; i < n; i += gsz * 4) { const pg8::f32x4 v = *(const pg8::f32x4*)(s + i); pg8::u32x2 o; o.x = pk2bf(v[0], v[1]); o.y = pk2bf(v[2], v[3]); *(pg8::u32x2*)(d + i) = o; }
}
typedef float f32x16_t __attribute__((ext_vector_type(16)));
typedef pg8::bf16x8 bf16x8v;
constexpr int AT_KROW = 208, AT_VROW = 136, AT_KBUF = 64 * AT_KROW, AT_VBUF = 64 * AT_VROW, AT_LDS = 2 * AT_KBUF + 2 * AT_VBUF;
__device__ __forceinline__ void attn_prompt_fast(const bf16_t* __restrict__ qf, const bf16_t* __restrict__ knb, const bf16_t* __restrict__ kpb, const bf16_t* __restrict__ vT, bf16_t* aob, LDSP unsigned char* lds) {
    using namespace cfg;
    const int tid = (int)tid_now(), w = __builtin_amdgcn_readfirstlane(tid >> 6), lane = tid & 63, l31 = lane & 31, h5 = lane >> 5;
    for (int it = blockIdx.x; it < BATCH * MH * 4; it += gridDim.x) {
        const int bh = it >> 2, pr = it & 3, b = bh / MH, h = bh % MH;
        for (int half = 0; half < 2; ++half) {
            const int qb = half ? 7 - pr : pr, q0 = 256 * qb, nt = 4 * qb + 4;
            const int qg = q0 + 32 * w + l31;
            const size_t mrow = (size_t)b * SEQ + qg;
            bf16x8v qfr[6];
#pragma unroll
            for (int s = 0; s < 6; ++s) qfr[s] = *(const bf16x8v*)(qf + mrow * (MH * QD) + h * QD + 16 * s + 8 * h5);
            f32x16_t O[2];
#pragma unroll
            for (int db = 0; db < 2; ++db)
#pragma unroll
                for (int r = 0; r < 16; ++r) O[db][r] = 0.f;
            float mrun = -1e30f, lrun = 0.f;
            pg8::u32x4 rk, rp, rv;
            const int kkey = tid >> 3, kc8 = tid & 7, pkey = tid >> 2, pc4 = tid & 3;
#define AT_LOAD(t) do { const size_t mk = (size_t)b * SEQ + 64 * (t); \
                rk = *(const pg8::u32x4*)(knb + (mk + kkey) * (MH * NOPE) + h * NOPE + kc8 * 8); \
                if (tid < 256) rp = *(const pg8::u32x4*)(kpb + (mk + pkey) * ROPE + pc4 * 8); \
                rv = *(const pg8::u32x4*)(vT + (size_t)(h * VD + kkey) * MTOT + mk + kc8 * 8); } while (0)
#define AT_STORE(buf) do { LDSP unsigned char* kb_ = lds + (buf) * AT_KBUF; LDSP unsigned char* vb_ = lds + 2 * AT_KBUF + (buf) * AT_VBUF; \
                *(LDSP pg8::u32x4*)(kb_ + kkey * AT_KROW + kc8 * 16) = rk; \
                if (tid < 256) *(LDSP pg8::u32x4*)(kb_ + pkey * AT_KROW + 128 + pc4 * 16) = rp; \
                *(LDSP pg8::u32x2*)(vb_ + kkey * AT_VROW + kc8 * 16) = (pg8::u32x2){rv.x, rv.y}; *(LDSP pg8::u32x2*)(vb_ + kkey * AT_VROW + kc8 * 16 + 8) = (pg8::u32x2){rv.z, rv.w}; } while (0)
            AT_LOAD(0); AT_STORE(0);
            __syncthreads();
            for (int t = 0; t < nt; ++t) {
                if (t + 1 < nt) AT_LOAD(t + 1);
                if (64 * t <= q0 + 32 * w + 31) {
                    const LDSP unsigned char* kb_ = lds + (t & 1) * AT_KBUF; const LDSP unsigned char* vb_ = lds + 2 * AT_KBUF + (t & 1) * AT_VBUF;
                    f32x16_t S[2];
#pragma unroll
                    for (int kb = 0; kb < 2; ++kb)
#pragma unroll
                        for (int r = 0; r < 16; ++r) S[kb][r] = 0.f;
#pragma unroll
                    for (int s = 0; s < 6; ++s)
#pragma unroll
                        for (int kb = 0; kb < 2; ++kb) {
                            const bf16x8v a = *(const LDSP bf16x8v*)(kb_ + (32 * kb + l31) * AT_KROW + (16 * s + 8 * h5) * 2);
                            S[kb] = __builtin_amdgcn_mfma_f32_32x32x16_bf16(a, qfr[s], S[kb], 0, 0, 0);
                        }
                    if (64 * t + 63 > q0 + 32 * w) {
#pragma unroll
                        for (int kb = 0; kb < 2; ++kb)
#pragma unroll
                            for (int r = 0; r < 16; ++r) { const int key = 64 * t + 32 * kb + (r & 3) + 8 * (r >> 2) + 4 * h5; if (key > qg) S[kb][r] = -1e30f; }
                    }
                    float mt = -1e30f;
#pragma unroll
                    for (int kb = 0; kb < 2; ++kb)
#pragma unroll
                        for (int r = 0; r < 16; ++r) mt = fmaxf(mt, S[kb][r]);
                    mt = fmaxf(mt, __shfl_xor(mt, 32));
                    const float mnew = fmaxf(mrun, mt), alpha = exp2f(mrun - mnew);
                    float ls = 0.f;
#pragma unroll
                    for (int kb = 0; kb < 2; ++kb)
#pragma unroll
                        for (int r = 0; r < 16; ++r) { const float p = exp2f(S[kb][r] - mnew); S[kb][r] = p; ls += p; }
                    lrun = lrun * alpha + ls; mrun = mnew;
#pragma unroll
                    for (int db = 0; db < 2; ++db)
#pragma unroll
                        for (int r = 0; r < 16; ++r) O[db][r] *= alpha;
#pragma unroll
                    for (int kb = 0; kb < 2; ++kb)
#pragma unroll
                        for (int s = 0; s < 2; ++s) {
                            pg8::u32x4 pw; pw.x = pk2bf(S[kb][8 * s + 0], S[kb][8 * s + 1]); pw.y = pk2bf(S[kb][8 * s + 2], S[kb][8 * s + 3]); pw.z = pk2bf(S[kb][8 * s + 4], S[kb][8 * s + 5]); pw.w = pk2bf(S[kb][8 * s + 6], S[kb][8 * s + 7]);
                            const bf16x8v pf = __builtin_bit_cast(bf16x8v, pw);
#pragma unroll
                            for (int db = 0; db < 2; ++db) {
                                const LDSP unsigned char* vp = vb_ + (32 * db + l31) * AT_VROW + (32 * kb + 16 * s + 4 * h5) * 2;
                                const pg8::u32x2 v0 = *(const LDSP pg8::u32x2*)vp, v1 = *(const LDSP pg8::u32x2*)(vp + 16);
                                const bf16x8v a = __builtin_bit_cast(bf16x8v, (pg8::u32x4){v0.x, v0.y, v1.x, v1.y});
                                O[db] = __builtin_amdgcn_mfma_f32_32x32x16_bf16(a, pf, O[db], 0, 0, 0);
                            }
                        }
                }
                if (t + 1 < nt) AT_STORE((t + 1) & 1);
                __syncthreads();
            }
#undef AT_LOAD
#undef AT_STORE
            const float inv = 1.0f / (lrun + __shfl_xor(lrun, 32));
            bf16_t* orow = aob + mrow * (MH * VD) + h * VD;
#pragma unroll
            for (int db = 0; db < 2; ++db)
#pragma unroll
                for (int g = 0; g < 4; ++g) { pg8::u32x2 o; o.x = pk2bf(O[db][4 * g] * inv, O[db][4 * g + 1] * inv); o.y = pk2bf(O[db][4 * g + 2] * inv, O[db][4 * g + 3] * inv);
                    *(pg8::u32x2*)(orow + 32 * db + 8 * g + 4 * h5) = o; }
        }
    }
}
constexpr int SD_CROW = 528, SD_WROW = 528, SD_PROW = 272;
constexpr int SD_CIMG = 0, SD_CIMG_SZ = 128 * SD_CROW;
constexpr int SD_WBUF = SD_CIMG + SD_CIMG_SZ, SD_WBUF_SZ = 32 * 1040;
constexpr int SD_XCH = SD_WBUF + 2 * SD_WBUF_SZ, SD_XCH_SZ = 4 * 5 * 64 * 4;
constexpr int SD_PIMG = SD_XCH + 2 * SD_XCH_SZ, SD_PIMG_SZ = 32 * SD_PROW;
constexpr int SD_END = SD_PIMG + 2 * SD_PIMG_SZ;
typedef short s16x4 __attribute__((ext_vector_type(4)));
#define MFMA32(a, b, c) __builtin_amdgcn_mfma_f32_32x32x16_bf16(a, b, c, 0, 0, 0)

__device__ __forceinline__ float mla_b2_bound(const Ctx& c, int j, int lane) {
    using namespace cfg;
    float gq = fabsf(c.in[I_QNN][j * NOPE + lane]), gk = fabsf(c.in[I_KNN][j * NOPE + lane]), gqr = fabsf(c.in[I_QRN][j * ROPE + (lane & 31)]), gkr = fabsf(c.in[I_KRN][j * ROPE + (lane & 31)]);
#pragma unroll
    for (int o = 1; o < 64; o <<= 1) { gq = fmaxf(gq, __shfl_xor(gq, o)); gk = fmaxf(gk, __shfl_xor(gk, o)); gqr = fmaxf(gqr, __shfl_xor(gqr, o)); gkr = fmaxf(gkr, __shfl_xor(gkr, o)); }
    return (64.f * gq * gk + 32.f * gqr * gkr) * (0.10206207261596575f * 1.4426950408889634f);
}

__device__ __forceinline__ void sd_pv_core(const int G, f32x16_t& Og, f32x16_t& Lacc, LDSP unsigned char* lds, int w, int lane, int l31, int h5) {
    asm volatile("" : "+v"(lane)); l31 = lane & 31; h5 = lane >> 5;
    const LDSP unsigned char* pimg = lds + SD_PIMG + (G & 1) * SD_PIMG_SZ;
    const unsigned onesw = (l31 == G) ? 0x3F803F80u : 0u;
    const bf16x8v onesv = __builtin_bit_cast(bf16x8v, (pg8::u32x4){onesw, onesw, onesw, onesw});
#pragma unroll
    for (int sp = 0; sp < 8; ++sp) {
        const bf16x8v a = *(const LDSP bf16x8v*)(pimg + l31 * SD_PROW + (16 * sp + 8 * h5) * 2);
        const int key0 = 16 * sp + 8 * h5 + ((lane & 15) >> 2), col = 32 * w + 16 * ((lane >> 4) & 1) + 4 * (lane & 3);
        const s16x4 t0 = __builtin_amdgcn_ds_read_tr16_b64_v4i16((LDSP s16x4*)(lds + SD_CIMG + key0 * SD_CROW + col * 2));
        const s16x4 t1 = __builtin_amdgcn_ds_read_tr16_b64_v4i16((LDSP s16x4*)(lds + SD_CIMG + (key0 + 4) * SD_CROW + col * 2));
        const bf16x8v b = (bf16x8v){t0[0], t0[1], t0[2], t0[3], t1[0], t1[1], t1[2], t1[3]};
        Og = MFMA32(a, b, Og);
        if (sp == w) Lacc = MFMA32(a, onesv, Lacc);
        if (sp & 1) __builtin_amdgcn_sched_barrier(0);
    }
}

__device__ __forceinline__ void sd_pv(const int G, f32x16_t& Og, f32x16_t& Lacc, LDSP unsigned char* lds, int w, int lane, int l31, int h5) {
    sd_pv_core(G, Og, Lacc, lds, w, lane, l31, h5);
#if defined(PROBE_DUP) && (PROBE_DUP & (1 << 21))
    f32x16_t D0, D1;
#pragma unroll
    for (int r = 0; r < 16; ++r) { D0[r] = 0.f; D1[r] = 0.f; }
    sd_pv_core(G, D0, D1, lds, w, lane, l31, h5); asm volatile("" :: "v"(D0), "v"(D1));
#endif
}
#define SD_WLOAD(h, buf) do { if (w >= 4) { const char* wsrc_ = (const char*)(fm.wukvt + (size_t)(h) * NOPE * KVL); int ln_ = lane; asm volatile("" : "+v"(ln_)); _Pragma("unroll") for (int k = 0; k < 8; ++k) { \
        const unsigned voff_ = (unsigned)(((8 * (w - 4) + k) + 32 * (ln_ >> 5)) * KVL + (ln_ & 31) * 8) * 2u; \
        __builtin_amdgcn_global_load_lds((const unsigned*)(wsrc_ + voff_), (LDSP unsigned*)(lds + SD_WBUF + (buf) * SD_WBUF_SZ + (8 * (w - 4) + k) * 1040), 16, 0, 0); } } } while (0)
template <int G>
__device__ __forceinline__ void sd_group(const FastMla& fm, const bf16_t* __restrict__ qs, const int s, LDSP unsigned char* lds, const int w, const int lane, const int l31_, const int h5_, const int kb, const int dh,
                                         const bf16x8v (&cfr)[16], const bf16x8v (&kpfr)[2], bf16x8v (&qn)[2], bf16x8v (&qp)[2], f32x16_t (&O)[4], f32x16_t& Lacc, const float B2) {
    using namespace cfg;
        _Pragma("unroll 1") for (int hh = 0; hh < 4; ++hh) {
            const int h = 4 * G + hh;
            int lane_ = lane; asm volatile("" : "+v"(lane_)); const int l31 = lane_ & 31, h5 = lane_ >> 5;
            if (h + 1 < MH) SD_WLOAD(h + 1, (h + 1) & 1);
#if defined(PROBE_DUP) && (PROBE_DUP & (1 << 22))
            if (h + 1 < MH) SD_WLOAD(h + 1, (h + 1) & 1);
#endif
            const bf16x8v qn0 = qn[0], qn1 = qn[1], qp0 = qp[0], qp1 = qp[1];
            { const int hn = (h + 1) & (MH - 1); const bf16_t* qrow = qs + ((size_t)(s * DS + (l31 & 7)) * MH + hn) * QD;
#pragma unroll
              for (int s_ = 0; s_ < 2; ++s_) { const int d0 = 32 * dh + 16 * s_ + 4 * h5; pg8::u32x2 a = *(const pg8::u32x2*)(qrow + d0), b = *(const pg8::u32x2*)(qrow + d0 + 8);
                  if (l31 >= 8) { a = (pg8::u32x2){0u, 0u}; b = a; }
                  qn[s_] = __builtin_bit_cast(bf16x8v, (pg8::u32x4){a.x, a.y, b.x, b.y});
                  pg8::u32x4 e = *(const pg8::u32x4*)(qrow + NOPE + 16 * s_ + 8 * h5); if (l31 >= 8) e = (pg8::u32x4){0u, 0u, 0u, 0u};
                  qp[s_] = __builtin_bit_cast(bf16x8v, e); } }
            f32x16_t KN;
#pragma unroll
            for (int r = 0; r < 16; ++r) KN[r] = 0.f;
            { const LDSP unsigned char* wb = lds + SD_WBUF + (h & 1) * SD_WBUF_SZ + l31 * 1040 + dh * 512 + h5 * 16;
#pragma unroll
              for (int s_ = 0; s_ < 16; ++s_) { const bf16x8v a = *(const LDSP bf16x8v*)(wb + 32 * s_); KN = MFMA32(a, cfr[s_], KN); if ((s_ & 3) == 3) __builtin_amdgcn_sched_barrier(0); } }
#if defined(PROBE_DUP) && (PROBE_DUP & (1 << 19))
            { const LDSP unsigned char* wb = lds + SD_WBUF + (h & 1) * SD_WBUF_SZ + l31 * 1040 + dh * 512 + h5 * 16;
#pragma unroll
              for (int s_ = 0; s_ < 16; ++s_) { const bf16x8v a = *(const LDSP bf16x8v*)(wb + 32 * s_); KN = MFMA32(a, cfr[s_], KN); if ((s_ & 3) == 3) __builtin_amdgcn_sched_barrier(0); }
#pragma unroll
              for (int r = 0; r < 16; ++r) KN[r] *= 0.5f; }
#endif
            float ssq = 0.f;
#pragma unroll
            for (int r = 0; r < 16; ++r) ssq += KN[r] * KN[r];
            ssq += __shfl_xor(ssq, 32);
            {
            f32x16_t S;
#pragma unroll
            for (int r = 0; r < 16; ++r) S[r] = 0.f;
#pragma unroll
            for (int s_ = 0; s_ < 2; ++s_) { const bf16x8v kf = __builtin_bit_cast(bf16x8v, (pg8::u32x4){pk2bf(KN[8 * s_], KN[8 * s_ + 1]), pk2bf(KN[8 * s_ + 2], KN[8 * s_ + 3]), pk2bf(KN[8 * s_ + 4], KN[8 * s_ + 5]), pk2bf(KN[8 * s_ + 6], KN[8 * s_ + 7])});
                S = MFMA32(s_ == 0 ? qn0 : qn1, kf, S); }
            LDSP float* xch = (LDSP float*)(lds + SD_XCH + (h & 1) * SD_XCH_SZ) + kb * 320;
            if (dh == 1) { xch[lane_] = S[0]; xch[64 + lane_] = S[1]; xch[128 + lane_] = S[2]; xch[192 + lane_] = S[3]; xch[256 + lane_] = ssq; }
            asm volatile("s_waitcnt vmcnt(0)" ::: "memory");
            __syncthreads();
            if (dh == 0) {
                const float rstd = __builtin_amdgcn_rsqf((ssq + xch[256 + lane_]) * (1.0f / NOPE) + NORM_EPS);
                f32x16_t T;
#pragma unroll
                for (int r = 0; r < 16; ++r) T[r] = 0.f;
                T[0] = (S[0] + xch[lane_]) * rstd; T[1] = (S[1] + xch[64 + lane_]) * rstd; T[2] = (S[2] + xch[128 + lane_]) * rstd; T[3] = (S[3] + xch[192 + lane_]) * rstd;
                T = MFMA32(qp0, kpfr[0], T); T = MFMA32(qp1, kpfr[1], T);
                LDSP bf16_t* prow = (LDSP bf16_t*)(lds + SD_PIMG + (G & 1) * SD_PIMG_SZ + (hh * 8 + 4 * h5) * SD_PROW) + 32 * kb + l31;
#pragma unroll
                for (int q = 0; q < 4; ++q) prow[q * (SD_PROW / 2)] = (bf16_t)(pk2bf(exp2f(T[q] - B2), 0.f) & 0xffffu);
            }
            }
        }
        if (G > 0) sd_pv(G > 0 ? G - 1 : 0, O[G > 0 ? G - 1 : 0], Lacc, lds, w, lane, l31_, h5_);
}

__device__ __forceinline__ void mla_sample_decode(const Ctx& c, const FastMla& fm, const bf16_t* __restrict__ qs, float* opart, float* lpart, int j, LDSP unsigned char* lds) {
    using namespace cfg;
    const int tid = (int)tid_now(), tid_ = tid, w = __builtin_amdgcn_readfirstlane(tid >> 6), lane = tid & 63, l31 = lane & 31, h5 = lane >> 5, kb = w & 3, dh = w >> 2;
    const float* ckv = c.in[I_CKV] + (size_t)j * NPOOL * PAGE * KVL; const float* kpe = c.in[I_KPE] + (size_t)j * NPOOL * PAGE * ROPE;
    const float B2 = mla_b2_bound(c, j, lane);
    for (int it = blockIdx.x; it < DB * 2; it += gridDim.x) {
        const int s = it >> 1, hf = it & 1;
        f32x16_t O[4], Lacc;
#pragma unroll
        for (int r = 0; r < 16; ++r) { O[0][r] = 0.f; O[1][r] = 0.f; O[2][r] = 0.f; O[3][r] = 0.f; Lacc[r] = 0.f; }
        bf16x8v qn[2], qp[2];
        { const bf16_t* qrow = qs + ((size_t)(s * DS + (l31 & 7)) * MH + 0) * QD;
#pragma unroll
          for (int s_ = 0; s_ < 2; ++s_) { const int d0 = 32 * dh + 16 * s_ + 4 * h5; pg8::u32x2 a = *(const pg8::u32x2*)(qrow + d0), b = *(const pg8::u32x2*)(qrow + d0 + 8);
              if (l31 >= 8) { a = (pg8::u32x2){0u, 0u}; b = a; }
              qn[s_] = __builtin_bit_cast(bf16x8v, (pg8::u32x4){a.x, a.y, b.x, b.y});
              pg8::u32x4 e = *(const pg8::u32x4*)(qrow + NOPE + 16 * s_ + 8 * h5); if (l31 >= 8) e = (pg8::u32x4){0u, 0u, 0u, 0u};
              qp[s_] = __builtin_bit_cast(bf16x8v, e); } }
        for (int pi = 0; pi < NPAGES / 2; ++pi) {
            const int pg = __builtin_amdgcn_readfirstlane(c.page_table[s * NPAGES + hf * (NPAGES / 2) + pi]);
            __syncthreads();
            { const char* src = (const char*)(ckv + (size_t)pg * PAGE * KVL); int tid = tid_; asm volatile("" : "+v"(tid));
              pg8::f32x4 v[16];
#pragma unroll
              for (int k = 0; k < 16; ++k) v[k] = *(const pg8::f32x4*)(src + (size_t)k * 8192 + (unsigned)tid * 16u);
#pragma unroll
              for (int k = 0; k < 16; ++k) { pg8::u32x2 o; o.x = pk2bf(v[k][0], v[k][1]); o.y = pk2bf(v[k][2], v[k][3]);
                  *(LDSP pg8::u32x2*)(lds + SD_CIMG + ((tid >> 6) + 8 * k) * SD_CROW + (tid & 63) * 8) = o; } }
#if defined(PROBE_DUP) && (PROBE_DUP & (1 << 20))
            { const char* src = (const char*)(ckv + (size_t)pg * PAGE * KVL); int tid = tid_; asm volatile("" : "+v"(tid));
              pg8::f32x4 v[16];
#pragma unroll
              for (int k = 0; k < 16; ++k) v[k] = *(const pg8::f32x4*)(src + (size_t)k * 8192 + (unsigned)tid * 16u);
#pragma unroll
              for (int k = 0; k < 16; ++k) { pg8::u32x2 o; o.x = pk2bf(v[k][0], v[k][1]); o.y = pk2bf(v[k][2], v[k][3]);
                  *(LDSP pg8::u32x2*)(lds + SD_CIMG + ((tid >> 6) + 8 * k) * SD_CROW + (tid & 63) * 8) = o; } }
#endif
            SD_WLOAD(0, 0);
            bf16x8v kpfr[2];
            if (dh == 0) {
#pragma unroll
                for (int s_ = 0; s_ < 2; ++s_) { const float* kp = kpe + ((size_t)pg * PAGE + 32 * kb + l31) * ROPE + 16 * s_ + 8 * h5; const pg8::f32x4 a = *(const pg8::f32x4*)kp, b = *(const pg8::f32x4*)(kp + 4);
                    kpfr[s_] = __builtin_bit_cast(bf16x8v, (pg8::u32x4){pk2bf(a[0], a[1]), pk2bf(a[2], a[3]), pk2bf(b[0], b[1]), pk2bf(b[2], b[3])}); }
            }
            asm volatile("s_waitcnt vmcnt(0)" ::: "memory");
            __syncthreads();
            bf16x8v cfr[16];
#pragma unroll
            for (int s_ = 0; s_ < 16; ++s_) cfr[s_] = *(const LDSP bf16x8v*)(lds + SD_CIMG + (32 * kb + l31) * SD_CROW + (16 * s_ + 8 * h5) * 2);
            sd_group<0>(fm, qs, s, lds, w, lane, l31, h5, kb, dh, cfr, kpfr, qn, qp, O, Lacc, B2);
            sd_group<1>(fm, qs, s, lds, w, lane, l31, h5, kb, dh, cfr, kpfr, qn, qp, O, Lacc, B2);
            sd_group<2>(fm, qs, s, lds, w, lane, l31, h5, kb, dh, cfr, kpfr, qn, qp, O, Lacc, B2);
            sd_group<3>(fm, qs, s, lds, w, lane, l31, h5, kb, dh, cfr, kpfr, qn, qp, O, Lacc, B2);
            __syncthreads();
            sd_pv(3, O[3], Lacc, lds, w, lane, l31, h5);
        }
        {float* op = opart + (size_t)it * (MH * DS) * KVL; int lo_ = lane; asm volatile("" : "+v"(lo_)); const int l31 = lo_ & 31, h5 = lo_ >> 5;
#pragma unroll
        for (int g = 0; g < 4; ++g)
#pragma unroll
            for (int r = 0; r < 16; ++r) op[(size_t)(32 * g + (r & 3) + 8 * (r >> 2) + 4 * h5) * KVL + 32 * w + l31] = O[g][r];
        __syncthreads();
        LDSP float* ltab = (LDSP float*)(lds + SD_XCH);
        if (l31 < 4) {
#pragma unroll
            for (int r = 0; r < 16; ++r) ltab[w * 128 + l31 * 32 + (r & 3) + 8 * (r >> 2) + 4 * h5] = Lacc[r];
        }
        __syncthreads();
        if (tid < 128) { float a = 0.f;
#pragma unroll
            for (int ww = 0; ww < 8; ++ww) a += ltab[ww * 128 + tid];
            lpart[(size_t)it * 128 + tid] = a; }
        }
    }
}

__device__ __forceinline__ void mla_sample_combine(const Ctx& c, const FastMla& fm, const float* __restrict__ opart, const float* __restrict__ lpart, int j, LDSP unsigned char* lds) {
    using namespace cfg;
    const int tid = (int)tid_now(), w = tid >> 6, lane = tid & 63, gw = blockIdx.x * 8 + w, ngw = gridDim.x * 8;
    const float B2 = mla_b2_bound(c, j, lane);
    LDSP float* ol = (LDSP float*)(lds + w * 8704); LDSP float* ptab = ol + 8 * KVL; LDSP float* lt = ptab + 64;
    const float* wuv = c.in[I_WUV] + (size_t)j * KVL * MH * VD;
    for (int item = gw; item < DB * MH; item += ngw) {
        const int s = item / MH, h = item % MH, q = lane >> 3, jn = lane & 7;
        const size_t rq = (size_t)MP + s * DS + q, rk = (size_t)MP + s * DS + jn;
        const bf16_t* qv = fm.qf + rq * (MH * QD) + h * QD; const bf16_t* kn = fm.knb + rk * (MH * NOPE) + h * NOPE; const bf16_t* kp = fm.kpb + rk * ROPE;
        float sc = 0.f;
#pragma unroll
        for (int d8 = 0; d8 < QD / 8; ++d8) { const pg8::u32x4 a = *(const pg8::u32x4*)(qv + 8 * d8), b = d8 < NOPE / 8 ? *(const pg8::u32x4*)(kn + 8 * d8) : *(const pg8::u32x4*)(kp + 8 * (d8 - NOPE / 8));
            const unsigned aw[4] = {a.x, a.y, a.z, a.w}, bw[4] = {b.x, b.y, b.z, b.w};
#pragma unroll
            for (int e = 0; e < 4; ++e) sc += __uint_as_float(aw[e] << 16) * __uint_as_float(bw[e] << 16) + __uint_as_float(aw[e] & 0xffff0000u) * __uint_as_float(bw[e] & 0xffff0000u); }
        const float p = jn <= q ? exp2f(sc - B2) : 0.f;
        float ls = p; ls += __shfl_xor(ls, 1); ls += __shfl_xor(ls, 2); ls += __shfl_xor(ls, 4);
        ptab[lane] = p;
        if (jn == 0) lt[q] = ls + lpart[(size_t)(2 * s) * 128 + h * DS + q] + lpart[(size_t)(2 * s + 1) * 128 + h * DS + q];
        asm volatile("s_waitcnt lgkmcnt(0)" ::: "memory");
        float cn[DS][4];
#pragma unroll
        for (int jj = 0; jj < DS; ++jj)
#pragma unroll
            for (int k = 0; k < 4; ++k) cn[jj][k] = bf2f(fm.cb[((size_t)MP + s * DS + jj) * KVL + lane + 64 * k]);
#pragma unroll
        for (int qq = 0; qq < DS; ++qq)
#pragma unroll
            for (int k = 0; k < 4; ++k) { const int r = lane + 64 * k;
                float a = opart[((size_t)(2 * s) * 128 + h * DS + qq) * KVL + r] + opart[((size_t)(2 * s + 1) * 128 + h * DS + qq) * KVL + r];
#pragma unroll
                for (int jj = 0; jj < DS; ++jj) a += ptab[qq * 8 + jj] * cn[jj][k];
                ol[qq * KVL + r] = a; }
        asm volatile("s_waitcnt lgkmcnt(0)" ::: "memory");
        float acc[DS];
#pragma unroll
        for (int qq = 0; qq < DS; ++qq) acc[qq] = 0.f;
        for (int r = 0; r < KVL; ++r) { const float wv = wuv[((size_t)r * MH + h) * VD + lane];
#pragma unroll
            for (int qq = 0; qq < DS; ++qq) acc[qq] += ol[qq * KVL + r] * wv; }
#pragma unroll
        for (int qq = 0; qq < DS; ++qq) fm.aob[((size_t)MP + s * DS + qq) * (MH * VD) + h * VD + lane] = (bf16_t)(pk2bf(acc[qq] / lt[qq], 0.f) & 0xffffu);
        asm volatile("s_waitcnt lgkmcnt(0)" ::: "memory");
    }
}
struct FastRw {
    bf16_t* xm;
    bf16_t* rkv;
    bf16_t* hb;
    bf16_t* lu;
    float* vf;
    float* ops;
    bf16_t* yo;
    bf16_t *wrkvt, *lorat, *wot;
};
constexpr int RW_REC = 464;
constexpr int RW_CH = 32;
constexpr int RW_BUF = RW_CH * RW_REC * 4;
struct RwSel { __device__ static __forceinline__ int sel(int pn) { return pn < 12 ? (pn >> 2) : (pn == 15 ? 2 : pn - 9); } };

__device__ __forceinline__ void rw_mix_fast(const Ctx& c, const FastRw& fr, int l, int gw, int ngw, int lane) {
    using namespace cfg; const int j = l / 3;
    const float* gain = c.in[I_NMIX] + l * D;
    for (int m = gw; m < MTOT; m += ngw) {
        const int t = row_t(m), sq = row_seq(m);
        pg8::f32x4 xc[4], xp[4], gv[4]; float s = 0.f, sp = 0.f;
#pragma unroll
        for (int q = 0; q < 4; ++q) { gv[q] = *(const pg8::f32x4*)(gain + 4 * lane + 256 * q); xc[q] = *(const pg8::f32x4*)(c.x + (size_t)m * D + 4 * lane + 256 * q);
            s += (xc[q][0] * xc[q][0] + xc[q][1] * xc[q][1]) + (xc[q][2] * xc[q][2] + xc[q][3] * xc[q][3]); }
        if (t > 0) {
#pragma unroll
            for (int q = 0; q < 4; ++q) { xp[q] = *(const pg8::f32x4*)(c.x + (size_t)(m - 1) * D + 4 * lane + 256 * q); sp += (xp[q][0] * xp[q][0] + xp[q][1] * xp[q][1]) + (xp[q][2] * xp[q][2] + xp[q][3] * xp[q][3]); }
        }
        const float rs = 1.0f / sqrtf(wave_sum64(s) * (1.0f / D) + NORM_EPS), rsp = 1.0f / sqrtf(wave_sum64(sp) * (1.0f / D) + NORM_EPS);
#pragma unroll
        for (int q = 0; q < 4; ++q) {
#pragma unroll
            for (int e = 0; e < 4; ++e) xc[q][e] = xc[q][e] * rs * gv[q][e];
            if (t > 0) {
#pragma unroll
                for (int e = 0; e < 4; ++e) xp[q][e] = xp[q][e] * rsp * gv[q][e];
            } else if (sq < BATCH) xp[q] = (pg8::f32x4){0.f, 0.f, 0.f, 0.f};
            else xp[q] = *(const pg8::f32x4*)(c.in[I_SHIFT] + ((size_t)j * DB + (sq - BATCH)) * D + 4 * lane + 256 * q);
        }
        if (t == seq_len(sq) - 1) {
            float* so = sq < BATCH ? c.out + O_SHP + ((size_t)j * BATCH + sq) * D : c.out + O_SHS + ((size_t)j * DB + (sq - BATCH)) * D;
#pragma unroll
            for (int q = 0; q < 4; ++q) *(pg8::f32x4*)(so + 4 * lane + 256 * q) = xc[q];
        }
#pragma unroll
        for (int p = 0; p < 6; ++p)
#pragma unroll
            for (int q = 0; q < 4; ++q) { const pg8::f32x4 mu = *(const pg8::f32x4*)(c.in[I_MU] + ((size_t)j * 6 + p) * D + 4 * lane + 256 * q);
                pg8::u32x2 o; o.x = pk2bf(xc[q][0] + (xp[q][0] - xc[q][0]) * mu[0], xc[q][1] + (xp[q][1] - xc[q][1]) * mu[1]); o.y = pk2bf(xc[q][2] + (xp[q][2] - xc[q][2]) * mu[2], xc[q][3] + (xp[q][3] - xc[q][3]) * mu[3]);
                *(pg8::u32x2*)(fr.xm + ((size_t)p * MTOT + m) * D + 4 * lane + 256 * q) = o; }
        if (lane < 32) *(unsigned*)(fr.hb + (size_t)m * 384 + 320 + 2 * lane) = 0u;
    }
}
struct EpiRwkv {
    static constexpr bool PERM = true;
    bf16_t* rkv; bf16_t* hb;
    __device__ __forceinline__ void operator()(const pg8::f32x4 (&acc)[2][2][4][2], const pg8::Unit& u, int wr, int wc, int fr, int fq) const {
        using namespace pg8;
        const int row0 = u.pm * BM + wr * 64 + fr, cl0 = wc * 32 + 8 * fq;
        const int pn = u.pn;
        bf16_t* base; int ldc, coff, nvalid, act = 0;
        if (pn < 12) { base = rkv; ldc = 3072; coff = pn * 256; nvalid = 256; }
        else { base = hb; ldc = 384; if (pn == 12) { coff = 0; nvalid = 64; act = 1; } else if (pn == 13) { coff = 64; nvalid = 64; } else if (pn == 14) { coff = 128; nvalid = 160; act = 2; } else { coff = 288; nvalid = 32; } }
#pragma unroll
        for (int ai = 0; ai < 2; ++ai)
#pragma unroll
            for (int m = 0; m < 4; ++m) { bf16_t* rowp = base + (size_t)(row0 + ai * HALF + m * 16) * ldc + coff;
#pragma unroll
                for (int bj = 0; bj < 2; ++bj) { const int cl = cl0 + bj * HALF; if (cl >= nvalid) continue;
                    f32x4 v0 = acc[ai][bj][m][0], v1 = acc[ai][bj][m][1];
                    if (act == 1) {
#pragma unroll
                        for (int e = 0; e < 4; ++e) { v0[e] = tanhf(v0[e]); v1[e] = tanhf(v1[e]); } }
                    else if (act == 2) {
#pragma unroll
                        for (int e = 0; e < 4; ++e) { v0[e] = 1.0f / (1.0f + __expf(-v0[e])); v1[e] = 1.0f / (1.0f + __expf(-v1[e])); } }
                    u32x4 w; w.x = cvt_pk_bf16(v0[0], v0[1]); w.y = cvt_pk_bf16(v0[2], v0[3]); w.z = cvt_pk_bf16(v1[0], v1[1]); w.w = cvt_pk_bf16(v1[2], v1[3]);
                    *(u32x4*)(rowp + cl) = w; } }
    }
};
__device__ __forceinline__ void rw_build_lorat(const Ctx& c, bf16_t* lorat, int j, size_t gtid, size_t gsz) {
    using namespace cfg;
    for (size_t i = gtid; i < (size_t)4096 * 384; i += gsz) {
        const int n = (int)(i / 384), k = (int)(i % 384), grp = n >> 10, ch = n & 1023; float v = 0.f;
        if (grp == 0 && k < 64) v = c.in[I_W2][((size_t)j * RW_DL + k) * D + ch];
        else if (grp == 1 && k >= 64 && k < 128) v = c.in[I_A2][((size_t)j * RW_AL + (k - 64)) * D + ch];
        else if (grp == 2 && k >= 128 && k < 288) v = c.in[I_G2][((size_t)j * RW_GL + (k - 128)) * D + ch];
        else if (grp == 3 && k >= 288 && k < 320 && j > 0) v = c.in[I_V2][((size_t)(j - 1) * RW_VL + (k - 288)) * D + ch];
        lorat[i] = (bf16_t)(pk2bf(v, 0.f) & 0xffffu);
    }
}
__device__ __forceinline__ size_t rw_rec_base(int sq, int h) {
    using namespace cfg;
    return sq < BATCH ? ((size_t)sq * RHEADS + h) * SEQ : (size_t)MP * RHEADS + ((size_t)(sq - BATCH) * RHEADS + h) * DS;
}
__device__ __forceinline__ void rw_prep_fast(const Ctx& c, const FastRw& fr, int l, int gw, int ngw, int lane) {
    using namespace cfg; const int j = l / 3;
    for (int it = gw; it < MTOT * RHEADS; it += ngw) {
        const int m = it / RHEADS, h = it % RHEADS, ch = h * RH + lane;
        const bf16_t* rk = fr.rkv + (size_t)m * 3072 + ch; const bf16_t* lu = fr.lu + (size_t)m * 4096 + ch;
        const float r = bf2f(rk[0]), k0 = bf2f(rk[1024]); float v = bf2f(rk[2048]);
        const float wpre = bf2f(lu[0]), apre = bf2f(lu[1024]), gg = bf2f(lu[2048]), vpre = bf2f(lu[3072]);
        const float wl = -softplusf_(-(c.in[I_W0][j * D + ch] + wpre)) - 0.5f;
        const float w = expf(-expf(wl));
        if (j == 0) fr.vf[(size_t)m * D + ch] = v;
        else v = v + (fr.vf[(size_t)m * D + ch] - v) * sigmoidf_(c.in[I_V0][(j - 1) * D + ch] + vpre);
        const float a = sigmoidf_(c.in[I_A0][j * D + ch] + apre);
        float kk = k0 * c.in[I_KK][j * D + ch];
        const float nn = wave_sum64(kk * kk);
        kk *= 1.0f / fmaxf(sqrtf(nn), 1e-12f);
        const float k2 = k0 * (1.0f + (a - 1.0f) * c.in[I_KA][j * D + ch]);
        const float bo = kk * a;
        const float br = wave_sum64(bo * r), kr = wave_sum64(k2 * r), bonus = wave_sum64(r * k2 * c.in[I_RK][(size_t)j * D + ch]);
        const int sq = row_seq(m), t = row_t(m);
        float* rec = fr.ops + (rw_rec_base(sq, h) + t) * RW_REC;
        rec[lane] = -kk; rec[64 + lane] = w * r; rec[128 + lane] = w; rec[192 + lane] = bo; rec[256 + lane] = k2; rec[320 + lane] = v; rec[384 + lane] = gg;
        if (lane == 0) { rec[448] = br; rec[449] = kr; rec[450] = bonus; }
    }
}
template <int CTRL> __device__ __forceinline__ float dppf(float v) { return __int_as_float(__builtin_amdgcn_update_dpp(0, __float_as_int(v), CTRL, 0xF, 0xF, true)); }
__device__ __forceinline__ float red16(float x) { x += dppf<0xB1>(x); x += dppf<0x4E>(x); x += dppf<0x124>(x); x += dppf<0x128>(x); return x; }
__device__ __forceinline__ void rw_scan_fast(const Ctx& c, const FastRw& fr, int l, LDSP unsigned char* lds) {
    using namespace cfg; const int j = l / 3;
    const int tid = (int)tid_now(), w = __builtin_amdgcn_readfirstlane(tid >> 6), lane = tid & 63, cs = lane & 15, rp = 4 * w + (lane >> 4);
    LDSP float* ybuf = (LDSP float*)(lds + 2 * RW_BUF);
    for (int chain = blockIdx.x; chain < NSEQ * RHEADS; chain += gridDim.x) {
        const int sq = chain / RHEADS, h = chain % RHEADS, T = seq_len(sq), m0 = seq_row0(sq);
        const char* src = (const char*)(fr.ops + rw_rec_base(sq, h) * RW_REC);
        pg8::f32x4 S0, S1;
        if (sq < BATCH) { S0 = (pg8::f32x4){0.f, 0.f, 0.f, 0.f}; S1 = S0; }
        else { const float* s0 = c.in[I_WKV] + ((((size_t)j * DB + (sq - BATCH)) * RHEADS + h) * RH + 2 * rp) * RH + 4 * cs; S0 = *(const pg8::f32x4*)s0; S1 = *(const pg8::f32x4*)(s0 + RH); }
        const int nch = (T + RW_CH - 1) / RW_CH;
#define RW_DMA(n, buf) do { const int nb_ = ((T - (n) * RW_CH < RW_CH ? T - (n) * RW_CH : RW_CH) * RW_REC * 4 + 1023) >> 10; \
            for (int q_ = w; q_ < nb_; q_ += 8) __builtin_amdgcn_global_load_lds((const unsigned*)(src + (size_t)(n) * RW_BUF + (size_t)q_ * 1024 + (unsigned)lane * 16u), (LDSP unsigned*)(lds + (buf) * RW_BUF + q_ * 1024), 16, 0, 0); } while (0)
        __syncthreads();
        RW_DMA(0, 0);
        asm volatile("s_waitcnt vmcnt(0)" ::: "memory");
        __syncthreads();
        for (int n = 0; n < nch; ++n) {
            if (n + 1 < nch) RW_DMA(n + 1, (n + 1) & 1);
            const int tn = T - n * RW_CH < RW_CH ? T - n * RW_CH : RW_CH;
            const LDSP unsigned char* bufp = lds + (n & 1) * RW_BUF;
            for (int t = 0; t < tn; ++t) {
                const LDSP unsigned char* rec = bufp + t * (RW_REC * 4);
                const pg8::f32x4 A = *(const LDSP pg8::f32x4*)(rec + cs * 16), WR = *(const LDSP pg8::f32x4*)(rec + 256 + cs * 16), W = *(const LDSP pg8::f32x4*)(rec + 512 + cs * 16),
                                 B = *(const LDSP pg8::f32x4*)(rec + 768 + cs * 16), K = *(const LDSP pg8::f32x4*)(rec + 1024 + cs * 16);
                const pg8::f32x2 V2 = *(const LDSP pg8::f32x2*)(rec + 1280 + rp * 8), SC = *(const LDSP pg8::f32x2*)(rec + 1792);
                float sa0 = (S0[0] * A[0] + S0[1] * A[1]) + (S0[2] * A[2] + S0[3] * A[3]), y0 = (S0[0] * WR[0] + S0[1] * WR[1]) + (S0[2] * WR[2] + S0[3] * WR[3]);
                float sa1 = (S1[0] * A[0] + S1[1] * A[1]) + (S1[2] * A[2] + S1[3] * A[3]), y1 = (S1[0] * WR[0] + S1[1] * WR[1]) + (S1[2] * WR[2] + S1[3] * WR[3]);
                sa0 = red16(sa0); sa1 = red16(sa1); y0 = red16(y0); y1 = red16(y1);
                S0 = S0 * W + sa0 * B + V2[0] * K; S1 = S1 * W + sa1 * B + V2[1] * K;
                if (cs == 0) *(LDSP pg8::f32x2*)(ybuf + t * RH + 2 * rp) = (pg8::f32x2){y0 + sa0 * SC[0] + V2[0] * SC[1], y1 + sa1 * SC[0] + V2[1] * SC[1]};
            }
            asm volatile("s_waitcnt vmcnt(0)" ::: "memory");
            __syncthreads();
            for (int t = w; t < tn; t += 8) {
                const LDSP float* rec = (const LDSP float*)(bufp + t * (RW_REC * 4));
                const float y = ybuf[t * RH + lane], mean = wave_sum64(y) * (1.0f / RH), d = y - mean, var = wave_sum64(d * d) * (1.0f / RH);
                const int ch = h * RH + lane;
                const float yn = d * (1.0f / sqrtf(var + LNX_EPS)) * c.in[I_LNW][j * D + ch] + c.in[I_LNB][j * D + ch];
                const float o = (yn + rec[450] * rec[320 + lane]) * rec[384 + lane];
                fr.yo[(size_t)(m0 + n * RW_CH + t) * D + ch] = (bf16_t)(pk2bf(o, 0.f) & 0xffffu);
            }
            __syncthreads();
        }
#undef RW_DMA
        float* so = (sq < BATCH ? c.out + O_WKVP + (((size_t)j * BATCH + sq) * RHEADS + h) * RH * RH : c.out + O_WKVS + (((size_t)j * DB + (sq - BATCH)) * RHEADS + h) * RH * RH) + (size_t)(2 * rp) * RH + 4 * cs;
        *(pg8::f32x4*)so = S0; *(pg8::f32x4*)(so + RH) = S1;
    }
}
__device__ __forceinline__ float fsigmoid(float x) { return __builtin_amdgcn_rcpf(1.0f + __expf(-x)); }
__device__ __forceinline__ float fsoftplus(float x) { return x > 20.f ? x : __logf(1.0f + __expf(x)); }
__device__ __forceinline__ float rdl(float v, int l) { return __int_as_float(__builtin_amdgcn_readlane(__float_as_int(v), l)); }
__device__ __forceinline__ float wsum_dpp(float x) {
    x = red16(x);
    return (rdl(x, 0) + rdl(x, 16)) + (rdl(x, 32) + rdl(x, 48));
}

__device__ __forceinline__ void red16x4(float& a, float& b, float& c, float& d) {
    asm volatile("s_nop 1\n"
        "v_add_f32_dpp %0, %0, %0 quad_perm:[1,0,3,2] row_mask:0xf bank_mask:0xf\n" "v_add_f32_dpp %1, %1, %1 quad_perm:[1,0,3,2] row_mask:0xf bank_mask:0xf\n"
        "v_add_f32_dpp %2, %2, %2 quad_perm:[1,0,3,2] row_mask:0xf bank_mask:0xf\n" "v_add_f32_dpp %3, %3, %3 quad_perm:[1,0,3,2] row_mask:0xf bank_mask:0xf\n"
        "v_add_f32_dpp %0, %0, %0 quad_perm:[2,3,0,1] row_mask:0xf bank_mask:0xf\n" "v_add_f32_dpp %1, %1, %1 quad_perm:[2,3,0,1] row_mask:0xf bank_mask:0xf\n"
        "v_add_f32_dpp %2, %2, %2 quad_perm:[2,3,0,1] row_mask:0xf bank_mask:0xf\n" "v_add_f32_dpp %3, %3, %3 quad_perm:[2,3,0,1] row_mask:0xf bank_mask:0xf\n"
        "v_add_f32_dpp %0, %0, %0 row_ror:4 row_mask:0xf bank_mask:0xf\n" "v_add_f32_dpp %1, %1, %1 row_ror:4 row_mask:0xf bank_mask:0xf\n"
        "v_add_f32_dpp %2, %2, %2 row_ror:4 row_mask:0xf bank_mask:0xf\n" "v_add_f32_dpp %3, %3, %3 row_ror:4 row_mask:0xf bank_mask:0xf\n"
        "v_add_f32_dpp %0, %0, %0 row_ror:8 row_mask:0xf bank_mask:0xf\n" "v_add_f32_dpp %1, %1, %1 row_ror:8 row_mask:0xf bank_mask:0xf\n"
        "v_add_f32_dpp %2, %2, %2 row_ror:8 row_mask:0xf bank_mask:0xf\n" "v_add_f32_dpp %3, %3, %3 row_ror:8 row_mask:0xf bank_mask:0xf\n"
        "s_nop 1"
        : "+v"(a), "+v"(b), "+v"(c), "+v"(d));
}
struct RwOp { pg8::f32x4 A, WR, W, B, K; pg8::f32x2 V2, SC; };
__device__ __forceinline__ void rw_ldop(RwOp& o, const LDSP unsigned char* rec, int cs, int rp) {
    o.A = *(const LDSP pg8::f32x4*)(rec + cs * 16); o.WR = *(const LDSP pg8::f32x4*)(rec + 256 + cs * 16); o.W = *(const LDSP pg8::f32x4*)(rec + 512 + cs * 16);
    o.B = *(const LDSP pg8::f32x4*)(rec + 768 + cs * 16); o.K = *(const LDSP pg8::f32x4*)(rec + 1024 + cs * 16);
    o.V2 = *(const LDSP pg8::f32x2*)(rec + 1280 + rp * 8); o.SC = *(const LDSP pg8::f32x2*)(rec + 1792);
}
__device__ __forceinline__ float fma_s(float a, float b, float c) { float d; asm("v_fma_f32 %0, %1, %2, %3" : "=v"(d) : "v"(a), "v"(b), "v"(c)); return d; }
__device__ __forceinline__ float mul_s(float a, float b) { float d; asm("v_mul_f32 %0, %1, %2" : "=v"(d) : "v"(a), "v"(b)); return d; }
__device__ __forceinline__ void rw_step(pg8::f32x4& S0, pg8::f32x4& S1, const RwOp& o, LDSP float* yrow, bool wr) {
    float sa0 = fma_s(S0[3], o.A[3], fma_s(S0[2], o.A[2], fma_s(S0[1], o.A[1], mul_s(S0[0], o.A[0]))));
    float sa1 = fma_s(S1[3], o.A[3], fma_s(S1[2], o.A[2], fma_s(S1[1], o.A[1], mul_s(S1[0], o.A[0]))));
    float y0 = fma_s(S0[3], o.WR[3], fma_s(S0[2], o.WR[2], fma_s(S0[1], o.WR[1], mul_s(S0[0], o.WR[0]))));
    float y1 = fma_s(S1[3], o.WR[3], fma_s(S1[2], o.WR[2], fma_s(S1[1], o.WR[1], mul_s(S1[0], o.WR[0]))));
    float t0[4], t1[4];
#pragma unroll
    for (int e = 0; e < 4; ++e) { t0[e] = fma_s(o.K[e], o.V2[0], mul_s(S0[e], o.W[e])); t1[e] = fma_s(o.K[e], o.V2[1], mul_s(S1[e], o.W[e])); }
    red16x4(sa0, sa1, y0, y1);
#pragma unroll
    for (int e = 0; e < 4; ++e) { S0[e] = fma_s(o.B[e], sa0, t0[e]); S1[e] = fma_s(o.B[e], sa1, t1[e]); }
    if (wr) *(LDSP pg8::f32x2*)yrow = (pg8::f32x2){fma_s(o.V2[0], o.SC[1], fma_s(sa0, o.SC[0], y0)), fma_s(o.V2[1], o.SC[1], fma_s(sa1, o.SC[0], y1))};
}
struct RwIn { unsigned short r, k, v, wp, ap, g, vp; float vf; };
template <int J>
__device__ __forceinline__ void rw_scan_fused(const Ctx& c, const FastRw& fr, LDSP unsigned char* lds) {
    using namespace cfg; constexpr int j = J;
    const int tid = (int)tid_now(), w = __builtin_amdgcn_readfirstlane(tid >> 6), lane = tid & 63, cs = lane & 15, rp = 4 * w + (lane >> 4);
    LDSP float* ybuf = (LDSP float*)(lds + 2 * RW_BUF);
    for (int chain = blockIdx.x; chain < NSEQ * RHEADS; chain += gridDim.x) {
        const int sq = chain / RHEADS, h = chain % RHEADS, T = seq_len(sq), m0 = seq_row0(sq), ch = h * RH + lane;
        const float p_w0 = c.in[I_W0][j * D + ch], p_a0 = c.in[I_A0][j * D + ch], p_kk = c.in[I_KK][j * D + ch], p_ka = c.in[I_KA][j * D + ch], p_rk = c.in[I_RK][(size_t)j * D + ch],
                    p_lnw = c.in[I_LNW][j * D + ch], p_lnb = c.in[I_LNB][j * D + ch], p_v0 = j > 0 ? c.in[I_V0][(j - 1) * D + ch] : 0.f;
        pg8::f32x4 S0, S1;
        if (sq < BATCH) { S0 = (pg8::f32x4){0.f, 0.f, 0.f, 0.f}; S1 = S0; }
        else { const float* s0 = c.in[I_WKV] + ((((size_t)j * DB + (sq - BATCH)) * RHEADS + h) * RH + 2 * rp) * RH + 4 * cs; S0 = *(const pg8::f32x4*)s0; S1 = *(const pg8::f32x4*)(s0 + RH); }
        const int nch = (T + RW_CH - 1) / RW_CH;
        RwIn in[4];
#define RW_LOADIN(n) do { _Pragma("unroll") for (int q = 0; q < 4; ++q) { const int t_ = (n) * RW_CH + 4 * w + q; if (t_ < T) { const size_t m_ = (size_t)(m0 + t_); \
                const bf16_t* rk_ = fr.rkv + m_ * 3072 + ch; const bf16_t* lu_ = fr.lu + m_ * 4096 + ch; \
                in[q].r = rk_[0]; in[q].k = rk_[1024]; in[q].v = rk_[2048]; in[q].wp = lu_[0]; in[q].ap = lu_[1024]; in[q].g = lu_[2048]; in[q].vp = lu_[3072]; \
                in[q].vf = j > 0 ? fr.vf[m_ * D + ch] : 0.f; } } } while (0)
#define RW_PREP(n, buf) do { _Pragma("unroll") for (int q = 0; q < 4; ++q) { const int tl_ = 4 * w + q, t_ = (n) * RW_CH + tl_; if (t_ < T) { \
                const float r_ = bf2f(in[q].r), k0_ = bf2f(in[q].k); float v_ = bf2f(in[q].v); \
                const float wl_ = -fsoftplus(-(p_w0 + bf2f(in[q].wp))) - 0.5f, w_ = __expf(-__expf(wl_)); \
                if (j == 0) fr.vf[(size_t)(m0 + t_) * D + ch] = v_; else v_ = v_ + (in[q].vf - v_) * fsigmoid(p_v0 + bf2f(in[q].vp)); \
                const float a_ = fsigmoid(p_a0 + bf2f(in[q].ap)); float kk_ = k0_ * p_kk; \
                const float k2_ = k0_ * (1.0f + (a_ - 1.0f) * p_ka); \
                float n_ = red16(kk_ * kk_), e1_ = red16(r_ * k2_ * p_rk), e2_ = red16(k2_ * r_); \
                n_ = (rdl(n_, 0) + rdl(n_, 16)) + (rdl(n_, 32) + rdl(n_, 48)); e1_ = (rdl(e1_, 0) + rdl(e1_, 16)) + (rdl(e1_, 32) + rdl(e1_, 48)); e2_ = (rdl(e2_, 0) + rdl(e2_, 16)) + (rdl(e2_, 32) + rdl(e2_, 48)); \
                kk_ *= __builtin_amdgcn_rcpf(fmaxf(__builtin_amdgcn_sqrtf(n_), 1e-12f)); const float bo_ = kk_ * a_; const float e3_ = wsum_dpp(bo_ * r_); \
                LDSP float* rec_ = (LDSP float*)(lds + (buf) * RW_BUF + tl_ * (RW_REC * 4)); \
                rec_[lane] = -kk_; rec_[64 + lane] = w_ * r_; rec_[128 + lane] = w_; rec_[192 + lane] = bo_; rec_[256 + lane] = k2_; rec_[320 + lane] = v_; rec_[384 + lane] = bf2f(in[q].g); \
                if (lane == 0) { rec_[448] = e3_; rec_[449] = e2_; rec_[450] = e1_; } } } } while (0)
        __syncthreads();
        RW_LOADIN(0); RW_PREP(0, 0);
        __syncthreads();
        for (int n = 0; n < nch; ++n) {
            if (n + 1 < nch) RW_LOADIN(n + 1);
            const int tn = T - n * RW_CH < RW_CH ? T - n * RW_CH : RW_CH;
            const LDSP unsigned char* bufp = lds + (n & 1) * RW_BUF;
#if defined(PROBE_DUP) && (PROBE_DUP & (1 << 17))
            { RwOp o0, o1; rw_ldop(o0, bufp, cs, rp); pg8::f32x4 T0 = S0, T1 = S1;
              for (int t = 0; t < tn; t += 2) {
                  rw_ldop(o1, bufp + (t + 1) * (RW_REC * 4), cs, rp);
                  rw_step(T0, T1, o0, ybuf + t * RH + 2 * rp, cs == 0);
                  rw_ldop(o0, bufp + (t + 2 < tn ? t + 2 : t) * (RW_REC * 4), cs, rp);
                  rw_step(T0, T1, o1, ybuf + (t + 1) * RH + 2 * rp, cs == 0);
              } asm volatile("" :: "v"(T0), "v"(T1)); }
#endif
            { RwOp o0, o1; rw_ldop(o0, bufp, cs, rp);
              for (int t = 0; t < tn; t += 2) {
                  rw_ldop(o1, bufp + (t + 1) * (RW_REC * 4), cs, rp);
                  rw_step(S0, S1, o0, ybuf + t * RH + 2 * rp, cs == 0);
                  rw_ldop(o0, bufp + (t + 2 < tn ? t + 2 : t) * (RW_REC * 4), cs, rp);
                  rw_step(S0, S1, o1, ybuf + (t + 1) * RH + 2 * rp, cs == 0);
              } }
            if (n + 1 < nch) RW_PREP(n + 1, (n + 1) & 1);
#if defined(PROBE_DUP) && (PROBE_DUP & (1 << 18))
            if (n + 1 < nch) RW_PREP(n + 1, (n + 1) & 1);
#endif
            __syncthreads();
            for (int t = w; t < tn; t += 8) {
                const LDSP float* rec = (const LDSP float*)(bufp + t * (RW_REC * 4));
                const float y = ybuf[t * RH + lane], mean = wsum_dpp(y) * (1.0f / RH), d = y - mean, var = wsum_dpp(d * d) * (1.0f / RH);
                const float yn = d * __builtin_amdgcn_rsqf(var + LNX_EPS) * p_lnw + p_lnb;
                const float o = (yn + rec[450] * rec[320 + lane]) * rec[384 + lane];
                fr.yo[(size_t)(m0 + n * RW_CH + t) * D + ch] = (bf16_t)(pk2bf(o, 0.f) & 0xffffu);
            }
            __syncthreads();
        }
#undef RW_LOADIN
#undef RW_PREP
        float* so = (sq < BATCH ? c.out + O_WKVP + (((size_t)j * BATCH + sq) * RHEADS + h) * RH * RH : c.out + O_WKVS + (((size_t)j * DB + (sq - BATCH)) * RHEADS + h) * RH * RH) + (size_t)(2 * rp) * RH + 4 * cs;
        *(pg8::f32x4*)so = S0; *(pg8::f32x4*)(so + RH) = S1;
    }
}
struct FastMb {
    bf16_t* zb;
    bf16_t* xbcr;
    float* dtraw;
    bf16_t* xbcb;
    float* dt;
    float* y;
    bf16_t* yzn;
    bf16_t *wbint, *wbot;
};
struct EpiMamba {
    static constexpr bool PERM = true;
    bf16_t* zb; bf16_t* xbcr; float* dtraw;
    __device__ __forceinline__ void operator()(const pg8::f32x4 (&acc)[2][2][4][2], const pg8::Unit& u, int wr, int wc, int fr, int fq) const {
        using namespace pg8;
        const int row0 = u.pm * BM + wr * 64 + fr, cl0 = wc * 32 + 8 * fq, pn = u.pn;
        if (pn < 20) {
            bf16_t* base = pn < 8 ? zb : xbcr; const int ldc = pn < 8 ? 2048 : 3072, coff = pn < 8 ? pn * 256 : (pn - 8) * 256;
#pragma unroll
            for (int ai = 0; ai < 2; ++ai)
#pragma unroll
                for (int m = 0; m < 4; ++m) { bf16_t* rowp = base + (size_t)(row0 + ai * HALF + m * 16) * ldc + coff + cl0;
#pragma unroll
                    for (int bj = 0; bj < 2; ++bj) { const f32x4 v0 = acc[ai][bj][m][0], v1 = acc[ai][bj][m][1];
                        u32x4 w; w.x = cvt_pk_bf16(v0[0], v0[1]); w.y = cvt_pk_bf16(v0[2], v0[3]); w.z = cvt_pk_bf16(v1[0], v1[1]); w.w = cvt_pk_bf16(v1[2], v1[3]);
                        *(u32x4*)(rowp + bj * HALF) = w; } }
        } else if (cl0 < 32) {
#pragma unroll
            for (int ai = 0; ai < 2; ++ai)
#pragma unroll
                for (int m = 0; m < 4; ++m) { float* rowp = dtraw + (size_t)(row0 + ai * HALF + m * 16) * 32 + cl0;
                    *(f32x4*)rowp = acc[ai][0][m][0]; *(f32x4*)(rowp + 4) = acc[ai][0][m][1]; }
        }
    }
};
__device__ __forceinline__ void mb_conv_fast(const Ctx& c, const FastMb& fb, int l, size_t gtid, size_t gsz, bool write_f32) {
    using namespace cfg; const int j = l / 3; constexpr int NB = MB_CD / 8, TB = 8;
    for (size_t i = gtid; i < (size_t)(MTOT / TB) * NB; i += gsz) {
        const int mb = (int)(i / NB) * TB, cb = (int)(i % NB) * 8, t0 = row_t(mb), sq = row_seq(mb), T = seq_len(sq);
        float wt[MB_CONV][8], bias[8], win[MB_CONV][8];
#pragma unroll
        for (int e = 0; e < 8; ++e) bias[e] = c.in[I_CONVB][j * MB_CD + cb + e];
#pragma unroll
        for (int jj = 0; jj < MB_CONV; ++jj)
#pragma unroll
            for (int e = 0; e < 8; ++e) wt[jj][e] = c.in[I_CONVW][((size_t)j * MB_CONV + jj) * MB_CD + cb + e];
#pragma unroll
        for (int jj = 0; jj < MB_CONV - 1; ++jj) {
            const int tt = t0 + jj - (MB_CONV - 1);
            if (tt >= 0) { const pg8::u32x4 raw = *(const pg8::u32x4*)(fb.xbcr + (size_t)(mb + jj - (MB_CONV - 1)) * MB_CD + cb); const unsigned wv[4] = {raw.x, raw.y, raw.z, raw.w};
#pragma unroll
                for (int q = 0; q < 4; ++q) { win[jj][2 * q] = __uint_as_float(wv[q] << 16); win[jj][2 * q + 1] = __uint_as_float(wv[q] & 0xffff0000u); } }
            else if (sq >= BATCH) { const float* st = c.in[I_CONV] + (((size_t)j * DB + (sq - BATCH)) * (MB_CONV - 1) + (tt + MB_CONV - 1)) * MB_CD + cb;
#pragma unroll
                for (int e = 0; e < 8; ++e) win[jj][e] = st[e]; }
            else {
#pragma unroll
                for (int e = 0; e < 8; ++e) win[jj][e] = 0.f; }
        }
#pragma unroll
        for (int tb = 0; tb < TB; ++tb) {
            const int m = mb + tb, t = t0 + tb;
            { const pg8::u32x4 raw = *(const pg8::u32x4*)(fb.xbcr + (size_t)m * MB_CD + cb); const unsigned wv[4] = {raw.x, raw.y, raw.z, raw.w};
#pragma unroll
              for (int q = 0; q < 4; ++q) { win[3][2 * q] = __uint_as_float(wv[q] << 16); win[3][2 * q + 1] = __uint_as_float(wv[q] & 0xffff0000u); } }
            if (t >= T - (MB_CONV - 1)) {
                float* so = (sq < BATCH ? c.out + O_CONVP + (((size_t)j * BATCH + sq) * (MB_CONV - 1) + (t - (T - (MB_CONV - 1)))) * MB_CD
                                        : c.out + O_CONVS + (((size_t)j * DB + (sq - BATCH)) * (MB_CONV - 1) + (t - (T - (MB_CONV - 1)))) * MB_CD) + cb;
#pragma unroll
                for (int e = 0; e < 8; ++e) so[e] = win[3][e];
            }
            unsigned w[4];
#pragma unroll
            for (int q = 0; q < 4; ++q) {
                float a0 = bias[2 * q], a1 = bias[2 * q + 1];
#pragma unroll
                for (int jj = 0; jj < MB_CONV; ++jj) { a0 += win[jj][2 * q] * wt[jj][2 * q]; a1 += win[jj][2 * q + 1] * wt[jj][2 * q + 1]; }
                a0 = a0 * __builtin_amdgcn_rcpf(1.0f + __expf(-a0)); a1 = a1 * __builtin_amdgcn_rcpf(1.0f + __expf(-a1));
                w[q] = pk2bf(a0, a1); if (write_f32) { c.xbc[(size_t)m * MB_CD + cb + 2 * q] = a0; c.xbc[(size_t)m * MB_CD + cb + 2 * q + 1] = a1; } }
            *(pg8::u32x4*)(fb.xbcb + (size_t)m * MB_CD + cb) = (pg8::u32x4){w[0], w[1], w[2], w[3]};
#pragma unroll
            for (int jj = 0; jj < MB_CONV - 1; ++jj)
#pragma unroll
                for (int e = 0; e < 8; ++e) win[jj][e] = win[jj + 1][e];
        }
    }
    for (size_t i = gtid; i < (size_t)MTOT * MB_HEADS; i += gsz) {
        const float v = softplusf_(fb.dtraw[i] + c.in[I_DTB][j * MB_HEADS + (int)(i % MB_HEADS)]);
        fb.dt[i] = v; if (write_f32) c.dt[i] = v;
    }
}
__device__ __forceinline__ void mb_gate_fast(const Ctx& c, const FastMb& fb, const float* __restrict__ y, int l, int gw, int ngw, int lane) {
    using namespace cfg; const int j = l / 3; constexpr int GW_ = MB_INNER / MB_GROUPS;
    for (int it = gw; it < MTOT * MB_GROUPS; it += ngw) {
        const int m = it / MB_GROUPS, g = it % MB_GROUPS; const size_t o = (size_t)m * MB_INNER + g * GW_ + 8 * lane;
        const pg8::f32x4 y0 = *(const pg8::f32x4*)(y + o), y1 = *(const pg8::f32x4*)(y + o + 4); const pg8::u32x4 zr = *(const pg8::u32x4*)(fb.zb + o);
        const unsigned zw[4] = {zr.x, zr.y, zr.z, zr.w}; float v[8]; float s = 0.f;
#pragma unroll
        for (int q = 0; q < 4; ++q) { const float z0 = __uint_as_float(zw[q] << 16), z1 = __uint_as_float(zw[q] & 0xffff0000u);
            v[2 * q] = (q < 2 ? y0[2 * q] : y1[2 * q - 4]) * siluf_(z0); v[2 * q + 1] = (q < 2 ? y0[2 * q + 1] : y1[2 * q - 3]) * siluf_(z1); s += v[2 * q] * v[2 * q] + v[2 * q + 1] * v[2 * q + 1]; }
        const float rs = 1.0f / sqrtf(wave_sum64(s) * (1.0f / GW_) + NORM_EPS);
        const float* nw = c.in[I_BNORM] + j * MB_INNER + g * GW_ + 8 * lane; unsigned w[4];
#pragma unroll
        for (int q = 0; q < 4; ++q) w[q] = pk2bf(v[2 * q] * rs * nw[2 * q], v[2 * q + 1] * rs * nw[2 * q + 1]);
        *(pg8::u32x4*)(fb.yzn + o) = (pg8::u32x4){w[0], w[1], w[2], w[3]};
    }
}
constexpr int SS_XR = 144, SS_BR = 272;
constexpr int SS_XIM = 0, SS_XSM = SS_XIM + 128 * SS_XR, SS_BIM = SS_XSM + 128 * SS_XR, SS_CIM = SS_BIM + 128 * SS_BR, SS_MTM = SS_CIM + 128 * SS_BR, SS_HBM = SS_MTM + 128 * SS_BR, SS_TAB = SS_HBM + 128 * SS_XR, SS_END = SS_TAB + 2048;
__device__ __forceinline__ bf16x8v ss_trfrag(const LDSP unsigned char* img, int rowstride, int k0, int col0, int lane) {
    const int r0 = k0 + 8 * (lane >> 5) + ((lane & 15) >> 2), cc = col0 + 16 * ((lane >> 4) & 1) + 4 * (lane & 3);
    const s16x4 t0 = __builtin_amdgcn_ds_read_tr16_b64_v4i16((LDSP s16x4*)(img + r0 * rowstride + cc * 2));
    const s16x4 t1 = __builtin_amdgcn_ds_read_tr16_b64_v4i16((LDSP s16x4*)(img + (r0 + 4) * rowstride + cc * 2));
    return (bf16x8v){t0[0], t0[1], t0[2], t0[3], t1[0], t1[1], t1[2], t1[3]};
}
__device__ __forceinline__ void mb_ssd_prompt(const Ctx& c, const FastMb& fb, int l, LDSP unsigned char* lds) {
    using namespace cfg; const int j = l / 3;
    const int tid = (int)tid_now(), w = __builtin_amdgcn_readfirstlane(tid >> 6), lane = tid & 63, l31 = lane & 31, h5 = lane >> 5;
    LDSP float* tab = (LDSP float*)(lds + SS_TAB);
    for (int chain = blockIdx.x; chain < BATCH * MB_HEADS; chain += gridDim.x) {
        const int b = chain / MB_HEADS, hd = chain % MB_HEADS, g = hd / (MB_HEADS / MB_GROUPS);
        const float Ah = -expf(c.in[I_ALOG][j * MB_HEADS + hd]), Dh = c.in[I_BD][j * MB_HEADS + hd];
        f32x16_t H;
#pragma unroll
        for (int r = 0; r < 16; ++r) H[r] = 0.f;
        pg8::u32x4 nx[2], nB[4], nC[4]; float ndt = 0.f;
#define SS_LOAD(ck_) do { const size_t mm_ = (size_t)b * SEQ + 128 * (ck_); int tq_ = tid; asm volatile("" : "+v"(tq_)); \
            _Pragma("unroll") for (int q = 0; q < 2; ++q) { const int ci = tq_ + 512 * q; nx[q] = *(const pg8::u32x4*)(fb.xbcb + (mm_ + (ci >> 3)) * MB_CD + hd * MB_HEAD + (ci & 7) * 8); } \
            _Pragma("unroll") for (int q = 0; q < 4; ++q) { const int ci = tq_ + 512 * q; const bf16_t* rowp = fb.xbcb + (mm_ + (ci >> 4)) * MB_CD + MB_INNER + g * MB_STATE + (ci & 15) * 8; \
                nB[q] = *(const pg8::u32x4*)rowp; nC[q] = *(const pg8::u32x4*)(rowp + MB_GN); } \
            if (tq_ < 128) ndt = fb.dt[(mm_ + tq_) * MB_HEADS + hd]; } while (0)
        SS_LOAD(0);
        for (int ck = 0; ck < SEQ / 128; ++ck) {
            const size_t m0 = (size_t)b * SEQ + 128 * ck;
            int tl = tid; asm volatile("" : "+v"(tl));
            pg8::u32x4 xr[2];
#pragma unroll
            for (int q = 0; q < 2; ++q) { const int ci = tl + 512 * q; xr[q] = nx[q];
                *(LDSP pg8::u32x2*)(lds + SS_XIM + (ci >> 3) * SS_XR + (ci & 7) * 16) = (pg8::u32x2){xr[q].x, xr[q].y}; *(LDSP pg8::u32x2*)(lds + SS_XIM + (ci >> 3) * SS_XR + (ci & 7) * 16 + 8) = (pg8::u32x2){xr[q].z, xr[q].w}; }
#pragma unroll
            for (int q = 0; q < 4; ++q) { const int ci = tl + 512 * q;
                *(LDSP pg8::u32x4*)(lds + SS_BIM + (ci >> 4) * SS_BR + (ci & 15) * 16) = nB[q];
                *(LDSP pg8::u32x4*)(lds + SS_CIM + (ci >> 4) * SS_BR + (ci & 15) * 16) = nC[q]; }
            if (tl < 128) { tab[128 + tl] = ndt; tab[384 + tl] = ndt * Ah; }
            if (ck + 1 < SEQ / 128) SS_LOAD(ck + 1);
            __syncthreads();
            if (w == 0) {
                const float v0 = tab[384 + 2 * lane], v1 = tab[384 + 2 * lane + 1]; float s = v0 + v1;
#pragma unroll
                for (int o = 1; o < 64; o <<= 1) { const float u = __shfl_up(s, o); if (lane >= o) s += u; }
                tab[2 * lane] = s - v1; tab[2 * lane + 1] = s;
            }
            __syncthreads();
            const float alast = tab[127];
#pragma unroll
            for (int q = 0; q < 2; ++q) { const int ci = tl + 512 * q, row = ci >> 3; const float sc = __expf(alast - tab[row]) * tab[128 + row]; const unsigned xw[4] = {xr[q].x, xr[q].y, xr[q].z, xr[q].w}; unsigned ow[4];
#pragma unroll
                for (int e = 0; e < 4; ++e) ow[e] = pk2bf(__uint_as_float(xw[e] << 16) * sc, __uint_as_float(xw[e] & 0xffff0000u) * sc);
                *(LDSP pg8::u32x2*)(lds + SS_XSM + row * SS_XR + (ci & 7) * 16) = (pg8::u32x2){ow[0], ow[1]}; *(LDSP pg8::u32x2*)(lds + SS_XSM + row * SS_XR + (ci & 7) * 16 + 8) = (pg8::u32x2){ow[2], ow[3]}; }
            { int ln = lane; asm volatile("" : "+v"(ln)); const int a31 = ln & 31, a5 = ln >> 5;
              for (int tt = w; tt < 10; tt += 8) {
                int ib = tt < 1 ? 0 : (tt < 3 ? 1 : (tt < 6 ? 2 : 3)); const int jb = tt - (ib * (ib + 1)) / 2;
                f32x16_t ST;
#pragma unroll
                for (int r = 0; r < 16; ++r) ST[r] = 0.f;
#pragma unroll
                for (int s = 0; s < 8; ++s) { const bf16x8v a = *(const LDSP bf16x8v*)(lds + SS_BIM + (32 * jb + a31) * SS_BR + (16 * s + 8 * a5) * 2), bb = *(const LDSP bf16x8v*)(lds + SS_CIM + (32 * ib + a31) * SS_BR + (16 * s + 8 * a5) * 2);
                    ST = MFMA32(a, bb, ST); }
                const float ai = tab[32 * ib + a31];
#pragma unroll
                for (int g4 = 0; g4 < 4; ++g4) { const int jr = 32 * jb + 8 * g4 + 4 * a5; const pg8::f32x4 aj = *(const LDSP pg8::f32x4*)(tab + jr), dj = *(const LDSP pg8::f32x4*)(tab + 128 + jr);
#pragma unroll
                    for (int e = 0; e < 4; ++e) { const int jj = jr + e, ii = 32 * ib + a31; const float mv = jj <= ii ? ST[4 * g4 + e] * __expf(ai - aj[e]) * dj[e] : 0.f;
                        *(LDSP bf16_t*)(lds + SS_MTM + jj * SS_BR + ii * 2) = (bf16_t)(pk2bf(mv, 0.f) & 0xffffu); } }
              }
              const int nb = w >> 1, pb = w & 1;
#pragma unroll
              for (int r = 0; r < 16; ++r) *(LDSP bf16_t*)(lds + SS_HBM + (32 * nb + (r & 3) + 8 * (r >> 2) + 4 * a5) * SS_XR + (32 * pb + a31) * 2) = (bf16_t)(pk2bf(H[r], 0.f) & 0xffffu);
            }
            __syncthreads();
            { int ln = lane; asm volatile("" : "+v"(ln)); const int a31 = ln & 31, a5 = ln >> 5;
              const int pb = w & 1, ib = w >> 1, nb = w >> 1;
              f32x16_t Y;
#pragma unroll
              for (int r = 0; r < 16; ++r) Y[r] = 0.f;
#pragma unroll
              for (int s = 0; s < 8; ++s) { const bf16x8v a = ss_trfrag(lds + SS_HBM, SS_XR, 16 * s, 32 * pb, ln), bb = *(const LDSP bf16x8v*)(lds + SS_CIM + (32 * ib + a31) * SS_BR + (16 * s + 8 * a5) * 2);
                  Y = MFMA32(a, bb, Y); if (s & 1) __builtin_amdgcn_sched_barrier(0); }
              const float ei = __expf(tab[32 * ib + a31]);
#pragma unroll
              for (int r = 0; r < 16; ++r) Y[r] *= ei;
              for (int s = 0; s < 2 * (ib + 1); ++s) { const bf16x8v a = ss_trfrag(lds + SS_XIM, SS_XR, 16 * s, 32 * pb, ln), bb = ss_trfrag(lds + SS_MTM, SS_BR, 16 * s, 32 * ib, ln);
                  Y = MFMA32(a, bb, Y); }
              { const size_t mrow = m0 + 32 * ib + a31; float* yrow = fb.y + mrow * MB_INNER + hd * MB_HEAD + 32 * pb + 4 * a5;
#pragma unroll
                for (int g4 = 0; g4 < 4; ++g4) { const pg8::u32x2 xv = *(const LDSP pg8::u32x2*)(lds + SS_XIM + (32 * ib + a31) * SS_XR + (32 * pb + 8 * g4 + 4 * a5) * 2);
                    pg8::f32x4 o; o[0] = Y[4 * g4] + Dh * __uint_as_float(xv.x << 16); o[1] = Y[4 * g4 + 1] + Dh * __uint_as_float(xv.x & 0xffff0000u); o[2] = Y[4 * g4 + 2] + Dh * __uint_as_float(xv.y << 16); o[3] = Y[4 * g4 + 3] + Dh * __uint_as_float(xv.y & 0xffff0000u);
                    *(pg8::f32x4*)(yrow + 8 * g4) = o; } }
              const float dec = __expf(tab[127]);
#pragma unroll
              for (int r = 0; r < 16; ++r) H[r] *= dec;
#pragma unroll
              for (int s = 0; s < 8; ++s) { const bf16x8v a = ss_trfrag(lds + SS_BIM, SS_BR, 16 * s, 32 * nb, ln), bb = ss_trfrag(lds + SS_XSM, SS_XR, 16 * s, 32 * pb, ln);
                  H = MFMA32(a, bb, H); if (s & 1) __builtin_amdgcn_sched_barrier(0); }
            }
            __syncthreads();
        }
#undef SS_LOAD
        { const int nb = w >> 1, pb = w & 1; float* so = c.out + O_SSMP + (((size_t)j * BATCH + b) * MB_HEADS + hd) * MB_HEAD * MB_STATE;
#pragma unroll
          for (int r = 0; r < 16; ++r) so[(size_t)(32 * pb + l31) * MB_STATE + 32 * nb + (r & 3) + 8 * (r >> 2) + 4 * h5] = H[r]; }
    }
}
__device__ __forceinline__ void mb_scan_sample(const Ctx& c, const FastMb& fb, int l) {
    using namespace cfg; const int j = l / 3;
    const int tid = (int)tid_now(), p = tid >> 3, ns = tid & 7;
    pg8::f32x4 hn[4];
    { const int chain = blockIdx.x; if (chain < DB * MB_HEADS) { const size_t so = ((((size_t)j * DB + chain / MB_HEADS) * MB_HEADS + chain % MB_HEADS) * MB_HEAD + p) * MB_STATE + 16 * ns;
#pragma unroll
        for (int q = 0; q < 4; ++q) hn[q] = *(const pg8::f32x4*)(c.in[I_SSM] + so + 4 * q); } }
    for (int chain = blockIdx.x; chain < DB * MB_HEADS; chain += gridDim.x) {
        const int s = chain / MB_HEADS, hd = chain % MB_HEADS, g = hd / (MB_HEADS / MB_GROUPS);
        const float Ah = -expf(c.in[I_ALOG][j * MB_HEADS + hd]), Dh = c.in[I_BD][j * MB_HEADS + hd];
        const size_t so = ((((size_t)j * DB + s) * MB_HEADS + hd) * MB_HEAD + p) * MB_STATE + 16 * ns;
        float hs[16];
#pragma unroll
        for (int q = 0; q < 4; ++q) { hs[4 * q] = hn[q][0]; hs[4 * q + 1] = hn[q][1]; hs[4 * q + 2] = hn[q][2]; hs[4 * q + 3] = hn[q][3]; }
        { const int cn = chain + gridDim.x; if (cn < DB * MB_HEADS) { const size_t sn = ((((size_t)j * DB + cn / MB_HEADS) * MB_HEADS + cn % MB_HEADS) * MB_HEAD + p) * MB_STATE + 16 * ns;
#pragma unroll
            for (int q = 0; q < 4; ++q) hn[q] = *(const pg8::f32x4*)(c.in[I_SSM] + sn + 4 * q); } }
        float dtv[DS]; unsigned short xr[DS]; pg8::u32x4 Bq[DS][2], Cq[DS][2];
#pragma unroll
        for (int t = 0; t < DS; ++t) { const size_t m = (size_t)MP + s * DS + t; dtv[t] = fb.dt[m * MB_HEADS + hd]; xr[t] = fb.xbcb[m * MB_CD + hd * MB_HEAD + p];
            const bf16_t* Bp = fb.xbcb + m * MB_CD + MB_INNER + g * MB_STATE + 16 * ns; Bq[t][0] = *(const pg8::u32x4*)Bp; Bq[t][1] = *(const pg8::u32x4*)(Bp + 8);
            Cq[t][0] = *(const pg8::u32x4*)(Bp + MB_GN); Cq[t][1] = *(const pg8::u32x4*)(Bp + MB_GN + 8); }
#pragma unroll
        for (int t = 0; t < DS; ++t) {
            const size_t m = (size_t)MP + s * DS + t;
            const float dA = __expf(dtv[t] * Ah), xv = bf2f(xr[t]), xdt = xv * dtv[t];
            const unsigned bw[8] = {Bq[t][0].x, Bq[t][0].y, Bq[t][0].z, Bq[t][0].w, Bq[t][1].x, Bq[t][1].y, Bq[t][1].z, Bq[t][1].w};
            const unsigned cw[8] = {Cq[t][0].x, Cq[t][0].y, Cq[t][0].z, Cq[t][0].w, Cq[t][1].x, Cq[t][1].y, Cq[t][1].z, Cq[t][1].w};
            float yy = 0.f;
#pragma unroll
            for (int k = 0; k < 8; ++k) { hs[2 * k] = hs[2 * k] * dA + xdt * __uint_as_float(bw[k] << 16); hs[2 * k + 1] = hs[2 * k + 1] * dA + xdt * __uint_as_float(bw[k] & 0xffff0000u);
                yy += __uint_as_float(cw[k] << 16) * hs[2 * k] + __uint_as_float(cw[k] & 0xffff0000u) * hs[2 * k + 1]; }
            yy += __shfl_xor(yy, 1); yy += __shfl_xor(yy, 2); yy += __shfl_xor(yy, 4);
            if (ns == 0) fb.y[m * MB_INNER + hd * MB_HEAD + p] = yy + Dh * xv;
        }
        float* oo = c.out + O_SSMS + so;
#pragma unroll
        for (int q = 0; q < 4; ++q) *(pg8::f32x4*)(oo + 4 * q) = (pg8::f32x4){hs[4 * q], hs[4 * q + 1], hs[4 * q + 2], hs[4 * q + 3]};
    }
}
constexpr int RC_RS = 144;
constexpr int RC_AT = 0, RC_RT = 4608, RC_BB = 9216, RC_KB = 13824, RC_BH = 18432, RC_KH = 23040, RC_VV = 27648, RC_UT = 32256, RC_GG = 36864;
constexpr int RC_SB = 41472;
constexpr int RC_NAK = 50688, RC_MRB = 53248, RC_MRK = 55808, RC_NS = 80;
constexpr int RC_NAB = 58368;
constexpr int RC_E = 62464;
constexpr int RC_YB = 70656;
constexpr int RC_GL = 78848, RC_BON = 79104, RC_VV2 = 79360, RC_GG2 = RC_VV2 + 4608, RC_END0 = RC_GG2 + 4608;
constexpr int RC_WW = RC_END0, RC_WA = RC_WW + 64 * 144, RC_WG = RC_WA + 64 * 144, RC_WV = RC_WG + 64 * 336, RC_LUO = RC_WV + 64 * 80, RC_END = RC_LUO + 4 * 4608;
constexpr int RC_HB = RC_AT, RC_HBS = 784;
__device__ __forceinline__ bf16x8v rc_nat(const LDSP unsigned char* img, int stride, int row, int kofs) { return *(const LDSP bf16x8v*)(img + row * stride + kofs * 2); }
__device__ __forceinline__ int rc_row(int r, int h5) { return (r & 3) + 8 * (r >> 2) + 4 * h5; }
__device__ __forceinline__ void rc_st16(LDSP unsigned char* p, float v) { *(LDSP bf16_t*)p = (bf16_t)(pk2bf(v, 0.f) & 0xffffu); }


template <int S>
struct RcSub {
    static __device__ __forceinline__ void run(float (&acc)[32], const LDSP float* NAB, LDSP unsigned char* lds, int lane) {
        const float us = acc[S]; rc_st16(lds + RC_UT + S * RC_RS + lane * 2, us);
#pragma unroll
        for (int g4 = 0; g4 < 8; ++g4) { if (4 * g4 + 3 > S) { const pg8::f32x4 nv = *(const LDSP pg8::f32x4*)(NAB + S * 32 + 4 * g4);
#pragma unroll
            for (int e = 0; e < 4; ++e) { if (4 * g4 + e > S) acc[4 * g4 + e] = fmaf(nv[e], us, acc[4 * g4 + e]); } } }
        RcSub<S + 1>::run(acc, NAB, lds, lane);
    }
};
template <> struct RcSub<32> { static __device__ __forceinline__ void run(float (&)[32], const LDSP float*, LDSP unsigned char*, int) {} };

template <int J>
__device__ __forceinline__ void rw_scan_chunked(const Ctx& c, const FastRw& fr, LDSP unsigned char* lds) {
    using namespace cfg; constexpr int j = J;
    const int tid = (int)tid_now(), w = __builtin_amdgcn_readfirstlane(tid >> 6), lane = tid & 63, l31 = lane & 31, h5 = lane >> 5;
    LDSP float* Ef = (LDSP float*)(lds + RC_E); LDSP float* YB = (LDSP float*)(lds + RC_YB); LDSP float* GL = (LDSP float*)(lds + RC_GL); LDSP float* BON = (LDSP float*)(lds + RC_BON);
    LDSP float* NAB = (LDSP float*)(lds + RC_NAB);
    int hcur = -1;
    for (int chain = blockIdx.x; chain < NSEQ * RHEADS; chain += gridDim.x) {
        const int sq = chain / RHEADS, h = chain % RHEADS, T = seq_len(sq), m0 = seq_row0(sq), ch = h * RH + lane;
        const float p_w0 = c.in[I_W0][j * D + ch], p_a0 = c.in[I_A0][j * D + ch], p_kk = c.in[I_KK][j * D + ch], p_ka = c.in[I_KA][j * D + ch], p_rk = c.in[I_RK][(size_t)j * D + ch],
                    p_lnw = c.in[I_LNW][j * D + ch], p_lnb = c.in[I_LNB][j * D + ch], p_v0 = j > 0 ? c.in[I_V0][(j - 1) * D + ch] : 0.f;
        const int ib = (w >> 1) & 1, jb = w & 1;
        f32x16_t ST;
#pragma unroll
        for (int r = 0; r < 16; ++r) ST[r] = 0.f;
        if (w < 4 && sq >= BATCH) { const float* s0 = c.in[I_WKV] + (((size_t)j * DB + (sq - BATCH)) * RHEADS + h) * RH * RH;
#pragma unroll
            for (int r = 0; r < 16; ++r) ST[r] = s0[(size_t)(32 * ib + rc_row(r, h5)) * RH + 32 * jb + l31]; }
        const int nch = (T + 31) / 32;
        if (h != hcur) {
            __syncthreads();
            const bf16_t* lw = fr.lorat + (size_t)j * 4096 * 384;
            for (int ci = tid; ci < 64 * 8; ci += 512) { const int row = ci >> 3, c8 = ci & 7;
                *(LDSP pg8::u32x4*)(lds + RC_WW + row * 144 + c8 * 16) = *(const pg8::u32x4*)(lw + (size_t)(0 * 1024 + h * 64 + row) * 384 + 0 + c8 * 8);
                *(LDSP pg8::u32x4*)(lds + RC_WA + row * 144 + c8 * 16) = *(const pg8::u32x4*)(lw + (size_t)(1 * 1024 + h * 64 + row) * 384 + 64 + c8 * 8); }
            for (int ci = tid; ci < 64 * 20; ci += 512) { const int row = ci / 20, c20 = ci % 20;
                *(LDSP pg8::u32x4*)(lds + RC_WG + row * 336 + c20 * 16) = *(const pg8::u32x4*)(lw + (size_t)(2 * 1024 + h * 64 + row) * 384 + 128 + c20 * 8); }
            for (int ci = tid; ci < 64 * 4; ci += 512) { const int row = ci >> 2, c4 = ci & 3;
                *(LDSP pg8::u32x4*)(lds + RC_WV + row * 80 + c4 * 16) = *(const pg8::u32x4*)(lw + (size_t)(3 * 1024 + h * 64 + row) * 384 + 288 + c4 * 8); }
            hcur = h;
        }
        RwIn in[4]; pg8::u32x4 hbr[3];
#define RC_LOADIN(n) do { _Pragma("unroll") for (int q = 0; q < 4; ++q) { const int t_ = (n) * 32 + 4 * w + q; if (t_ < T) { const size_t m_ = (size_t)(m0 + t_); \
                const bf16_t* rk_ = fr.rkv + m_ * 3072 + ch; in[q].r = rk_[0]; in[q].k = rk_[1024]; in[q].v = rk_[2048]; \
                in[q].vf = j > 0 ? fr.vf[m_ * D + ch] : 0.f; } } \
            _Pragma("unroll") for (int k3 = 0; k3 < 3; ++k3) { const int ci_ = tid + 512 * k3, tk_ = ci_ / 48, t_ = (n) * 32 + tk_; \
                hbr[k3] = t_ < T ? *(const pg8::u32x4*)(fr.hb + (size_t)(m0 + t_) * 384 + (ci_ % 48) * 8) : (pg8::u32x4){0u, 0u, 0u, 0u}; } } while (0)
#define RC_EPI_TOKEN(nn, tl) do { const int vv_ = ((nn) & 1) ? RC_VV2 : RC_VV, gg_ = ((nn) & 1) ? RC_GG2 : RC_GG, bn_ = ((nn) & 1) ? 32 : 0; \
                const float y_ = YB[(tl) * 64 + lane], mean_ = wsum_dpp(y_) * (1.0f / RH), d_ = y_ - mean_, var_ = wsum_dpp(d_ * d_) * (1.0f / RH); \
                const float yn_ = d_ * __builtin_amdgcn_rsqf(var_ + LNX_EPS) * p_lnw + p_lnb; \
                const float o_ = (yn_ + BON[bn_ + (tl)] * bf2f(*(const LDSP bf16_t*)(lds + vv_ + (tl) * RC_RS + lane * 2))) * bf2f(*(const LDSP bf16_t*)(lds + gg_ + (tl) * RC_RS + lane * 2)); \
                fr.yo[(size_t)(m0 + (nn) * 32 + (tl)) * D + ch] = (bf16_t)(pk2bf(o_, 0.f) & 0xffffu); } while (0)
        __syncthreads();
        RC_LOADIN(0);
        for (int n = 0; n < nch; ++n) {
            const int tn = T - n * 32 < 32 ? T - n * 32 : 32;
            const int vvo = (n & 1) ? RC_VV2 : RC_VV, ggo = (n & 1) ? RC_GG2 : RC_GG, bno = (n & 1) ? 32 : 0;
#pragma unroll
            for (int k3 = 0; k3 < 3; ++k3) { const int ci_ = tid + 512 * k3; *(LDSP pg8::u32x4*)(lds + RC_HB + (ci_ / 48) * RC_HBS + (ci_ % 48) * 16) = hbr[k3]; }
            __syncthreads();
            { int ln = lane; asm volatile("" : "+v"(ln)); const int a31 = ln & 31, a5 = ln >> 5; const int grp = w >> 1, nb = w & 1;
              const int koff = grp == 0 ? 0 : (grp == 1 ? 64 : (grp == 2 ? 128 : 288)), nks = grp == 2 ? 10 : (grp == 3 ? 2 : 4);
              const int wof = grp == 0 ? RC_WW : (grp == 1 ? RC_WA : (grp == 2 ? RC_WG : RC_WV)), wst = grp == 2 ? 336 : (grp == 3 ? 80 : 144);
              f32x16_t LA;
#pragma unroll
              for (int r = 0; r < 16; ++r) LA[r] = 0.f;
              for (int ks = 0; ks < nks; ++ks) LA = MFMA32(rc_nat(lds + RC_HB, RC_HBS, a31, koff + 16 * ks + 8 * a5), rc_nat(lds + wof, wst, 32 * nb + a31, 16 * ks + 8 * a5), LA);
#pragma unroll
              for (int r = 0; r < 16; ++r) rc_st16(lds + RC_LUO + grp * 4608 + rc_row(r, a5) * RC_RS + (32 * nb + a31) * 2, LA[r]); }
            __syncthreads();
            float q_r[4], q_k[4], q_a[4], q_b[4], q_e[4];
#pragma unroll
            for (int q = 0; q < 4; ++q) {
                const int tl = 4 * w + q, tg = n * 32 + tl;
                float r_ = 0.f, k2_ = 0.f, v_ = 0.f, a_ = 0.f, b_ = 0.f, e_ = 0.f, g_ = 0.f, bon_ = 0.f;
                if (tg < T) {
                    r_ = bf2f(in[q].r); const float k0_ = bf2f(in[q].k); v_ = bf2f(in[q].v);
                    e_ = 0.6065306597126334f * fsigmoid(p_w0 + bf2f(*(const LDSP bf16_t*)(lds + RC_LUO + 0 * 4608 + tl * RC_RS + lane * 2)));
                    if (j == 0) fr.vf[(size_t)(m0 + tg) * D + ch] = v_; else v_ = v_ + (in[q].vf - v_) * fsigmoid(p_v0 + bf2f(*(const LDSP bf16_t*)(lds + RC_LUO + 3 * 4608 + tl * RC_RS + lane * 2)));
                    const float as_ = fsigmoid(p_a0 + bf2f(*(const LDSP bf16_t*)(lds + RC_LUO + 1 * 4608 + tl * RC_RS + lane * 2))); float kk_ = k0_ * p_kk;
                    k2_ = k0_ * (1.0f + (as_ - 1.0f) * p_ka);
                    float n_ = red16(kk_ * kk_), e1_ = red16(r_ * k2_ * p_rk);
                    n_ = (rdl(n_, 0) + rdl(n_, 16)) + (rdl(n_, 32) + rdl(n_, 48)); bon_ = (rdl(e1_, 0) + rdl(e1_, 16)) + (rdl(e1_, 32) + rdl(e1_, 48));
                    kk_ *= __builtin_amdgcn_rcpf(fmaxf(__builtin_amdgcn_sqrtf(n_), 1e-12f));
                    a_ = -kk_; b_ = kk_ * as_; g_ = bf2f(*(const LDSP bf16_t*)(lds + RC_LUO + 2 * 4608 + tl * RC_RS + lane * 2));
                }
                q_r[q] = r_; q_k[q] = k2_; q_a[q] = a_; q_b[q] = b_; q_e[q] = e_;
                Ef[tl * 64 + lane] = e_;
                rc_st16(lds + vvo + tl * RC_RS + lane * 2, v_); rc_st16(lds + ggo + tl * RC_RS + lane * 2, g_);
                if (lane == 0) BON[bno + tl] = bon_;
            }
            if (n + 1 < nch) RC_LOADIN(n + 1);
            if (w < 4) {
#pragma unroll
                for (int r = 0; r < 16; ++r) rc_st16(lds + RC_SB + (32 * ib + rc_row(r, h5)) * RC_RS + (32 * jb + l31) * 2, ST[r]);
            }
            __syncthreads();
            { float run = 0.f, base = 0.f;
#pragma unroll
              for (int s = 0; s < 32; ++s) { const float ev = Ef[s * 64 + lane]; if (s == 4 * w) base = run; run += ev; }
              const float cumL = run; float cum = base;
#pragma unroll
              for (int q = 0; q < 4; ++q) { const int tl = 4 * w + q; const float cprev = cum; cum += q_e[q];
                  const float gam = __expf(-cum), gamp = __expf(-cprev), ginv = __expf(cum), glr = __expf(cum - cumL);
                  rc_st16(lds + RC_AT + tl * RC_RS + lane * 2, q_a[q] * gamp); rc_st16(lds + RC_RT + tl * RC_RS + lane * 2, q_r[q] * gam);
                  rc_st16(lds + RC_BB + tl * RC_RS + lane * 2, q_b[q] * ginv); rc_st16(lds + RC_KB + tl * RC_RS + lane * 2, q_k[q] * ginv);
                  rc_st16(lds + RC_BH + tl * RC_RS + lane * 2, q_b[q] * glr); rc_st16(lds + RC_KH + tl * RC_RS + lane * 2, q_k[q] * glr); }
              if (w == 0) GL[lane] = __expf(-cumL); }
            __syncthreads();
            f32x16_t R1;
#pragma unroll
            for (int r = 0; r < 16; ++r) R1[r] = 0.f;
            { int ln = lane; asm volatile("" : "+v"(ln)); const int a31 = ln & 31, a5 = ln >> 5;
              if (w < 4) {
                  const int aoff = (w == 0) ? RC_BB : ((w < 2) ? RC_AT : RC_RT), boff = (w == 0) ? RC_AT : ((w & 1) ? RC_KB : RC_BB);
#pragma unroll
                  for (int ks = 0; ks < 4; ++ks) R1 = MFMA32(rc_nat(lds + aoff, RC_RS, a31, 16 * ks + 8 * a5), rc_nat(lds + boff, RC_RS, a31, 16 * ks + 8 * a5), R1);
#pragma unroll
                  for (int r = 0; r < 16; ++r) { const int rr = rc_row(r, a5), cc = a31;
                      if (w == 0) NAB[rr * 32 + cc] = (rr < cc) ? R1[r] : 0.f;
                      else { const bool keep = (w < 2) ? (cc < rr) : (cc <= rr); rc_st16(lds + (w == 1 ? RC_NAK : (w == 2 ? RC_MRB : RC_MRK)) + rr * RC_NS + cc * 2, keep ? R1[r] : 0.f); } }
              } else {
                  const int aoff = (w < 6) ? RC_AT : RC_RT, ibk = w & 1;
#pragma unroll
                  for (int ks = 0; ks < 4; ++ks) R1 = MFMA32(rc_nat(lds + aoff, RC_RS, a31, 16 * ks + 8 * a5), rc_nat(lds + RC_SB, RC_RS, 32 * ibk + a31, 16 * ks + 8 * a5), R1);
              } }
            __syncthreads();
            if (w == 4 || w == 5) { int ln = lane; asm volatile("" : "+v"(ln)); const int a31 = ln & 31, a5 = ln >> 5, ibk = w & 1;
#pragma unroll
                for (int ks = 0; ks < 2; ++ks) R1 = MFMA32(rc_nat(lds + RC_NAK, RC_NS, a31, 16 * ks + 8 * a5), ss_trfrag(lds + vvo, RC_RS, 16 * ks, 32 * ibk, ln), R1);
#pragma unroll
                for (int r = 0; r < 16; ++r) Ef[rc_row(r, a5) * 64 + 32 * ibk + a31] = R1[r]; }
            __syncthreads();
            if (w > 0 && n > 0) { for (int tl = w - 1; tl < 32; tl += 7) RC_EPI_TOKEN(n - 1, tl); }
            if (w == 0) { float acc[32];
#pragma unroll
                for (int t = 0; t < 32; ++t) acc[t] = Ef[t * 64 + lane];
                RcSub<0>::run(acc, NAB, lds, lane); }
            __syncthreads();
            { int ln = lane; asm volatile("" : "+v"(ln)); const int a31 = ln & 31, a5 = ln >> 5;
              if (w >= 6) { const int ibk = w & 1;
#pragma unroll
                  for (int ks = 0; ks < 2; ++ks) { R1 = MFMA32(rc_nat(lds + RC_MRB, RC_NS, a31, 16 * ks + 8 * a5), ss_trfrag(lds + RC_UT, RC_RS, 16 * ks, 32 * ibk, ln), R1);
                                                   R1 = MFMA32(rc_nat(lds + RC_MRK, RC_NS, a31, 16 * ks + 8 * a5), ss_trfrag(lds + vvo, RC_RS, 16 * ks, 32 * ibk, ln), R1); }
#pragma unroll
                  for (int r = 0; r < 16; ++r) YB[rc_row(r, a5) * 64 + 32 * ibk + a31] = R1[r];
              } else if (w < 4) { const float gl = GL[32 * jb + a31];
#pragma unroll
                  for (int r = 0; r < 16; ++r) ST[r] *= gl;
#pragma unroll
                  for (int ks = 0; ks < 2; ++ks) { ST = MFMA32(ss_trfrag(lds + RC_UT, RC_RS, 16 * ks, 32 * ib, ln), ss_trfrag(lds + RC_BH, RC_RS, 16 * ks, 32 * jb, ln), ST);
                                                   ST = MFMA32(ss_trfrag(lds + vvo, RC_RS, 16 * ks, 32 * ib, ln), ss_trfrag(lds + RC_KH, RC_RS, 16 * ks, 32 * jb, ln), ST); } } }
            __syncthreads();
        }
        { const int nl = nch - 1, tnl = T - nl * 32 < 32 ? T - nl * 32 : 32; for (int tl = w; tl < tnl; tl += 8) RC_EPI_TOKEN(nl, tl); }
#undef RC_EPI_TOKEN
#undef RC_LOADIN
        if (w < 4) { float* so = (sq < BATCH ? c.out + O_WKVP + (((size_t)j * BATCH + sq) * RHEADS + h) * RH * RH : c.out + O_WKVS + (((size_t)j * DB + (sq - BATCH)) * RHEADS + h) * RH * RH);
#pragma unroll
            for (int r = 0; r < 16; ++r) so[(size_t)(32 * ib + rc_row(r, h5)) * RH + 32 * jb + l31] = ST[r]; }
    }
}
template <int ACT, bool ACC>
__device__ __forceinline__ void gemm_dev(const float* __restrict__ A, int lda, const float* __restrict__ B, int ldb, float* C, int ldc, int M, int N, int K, unsigned short (*As)[40], unsigned short (*Bs)[40]) {
    const int tid = threadIdx.x, wave = tid >> 6, lane = tid & 63, wr = wave >> 1, wc = wave & 1, fr = lane & 15, fq = lane >> 4;
    const int ntn = (N + 127) / 128, ntm = (M + 127) / 128;
    for (int tile = blockIdx.x; tile < ntm * ntn; tile += gridDim.x) {
        const int bm = (tile / ntn) * 128, bn = (tile % ntn) * 128;
        f32x4_t acc[2][4];
#pragma unroll
        for (int i = 0; i < 2; ++i)
#pragma unroll
            for (int j = 0; j < 4; ++j) acc[i][j] = (f32x4_t){0.f, 0.f, 0.f, 0.f};
        for (int k0 = 0; k0 < K; k0 += 32) {
#pragma unroll
            for (int it = 0; it < 2; ++it) {
                const int idx = tid + it * 512, row = idx >> 3, c4 = idx & 7, gm = bm + row;
                float4 v = make_float4(0.f, 0.f, 0.f, 0.f);
                if (gm < M) v = *(const float4*)(A + (size_t)gm * lda + k0 + c4 * 4);
                uint2 w; w.x = (unsigned)f2bf(v.x) | ((unsigned)f2bf(v.y) << 16); w.y = (unsigned)f2bf(v.z) | ((unsigned)f2bf(v.w) << 16);
                *(uint2*)&As[row][c4 * 4] = w;
            }
#pragma unroll
            for (int it = 0; it < 2; ++it) {
                const int idx = tid + it * 512, kr = idx >> 5, n4 = idx & 31, gn = bn + n4 * 4;
                float4 v = make_float4(0.f, 0.f, 0.f, 0.f);
                if (gn < N) v = *(const float4*)(B + (size_t)(k0 + kr) * ldb + gn);
                Bs[n4 * 4 + 0][kr] = f2bf(v.x); Bs[n4 * 4 + 1][kr] = f2bf(v.y); Bs[n4 * 4 + 2][kr] = f2bf(v.z); Bs[n4 * 4 + 3][kr] = f2bf(v.w);
            }
            __syncthreads();
            bf16x8_t a[2], b[4];
#pragma unroll
            for (int i = 0; i < 2; ++i) a[i] = *(const bf16x8_t*)&As[wr * 32 + i * 16 + fr][fq * 8];
#pragma unroll
            for (int j = 0; j < 4; ++j) b[j] = *(const bf16x8_t*)&Bs[wc * 64 + j * 16 + fr][fq * 8];
#pragma unroll
            for (int i = 0; i < 2; ++i)
#pragma unroll
                for (int j = 0; j < 4; ++j) acc[i][j] = __builtin_amdgcn_mfma_f32_16x16x32_bf16(a[i], b[j], acc[i][j], 0, 0, 0);
            __syncthreads();
        }
#pragma unroll
        for (int i = 0; i < 2; ++i)
#pragma unroll
            for (int j = 0; j < 4; ++j)
#pragma unroll
                for (int e = 0; e < 4; ++e) {
                    const int row = bm + wr * 32 + i * 16 + fq * 4 + e, col = bn + wc * 64 + j * 16 + fr;
                    if (row < M && col < N) {
                        float v = acc[i][j][e];
                        if (ACT == 1) v = tanhf(v); else if (ACT == 2) v = 1.0f / (1.0f + expf(-v)); else if (ACT == 3) v = v > 0.f ? v * v : 0.f;
                        float* cp = C + (size_t)row * ldc + col; *cp = ACC ? *cp + v : v;
                    }
                }
    }
}

#define MRUN(ph, l) do { ph(c, l, gtid, gsz); xcd_barrier(bar); } while (0)
#define MGEMM(ACT, ACC, A, lda, B, ldb, C, ldc, M, N, K) do { gemm_dev<ACT, ACC>(A, lda, B, ldb, C, ldc, M, N, K, As, Bs); xcd_barrier(bar); } while (0)
#define KS_FFN 16
#define KS_1K 4
#define KS_MB 8
#ifndef ACC_KSPLIT
#define ACC_KSPLIT 1
#endif
#ifndef FFN_DOWN_KSPLIT
#define FFN_DOWN_KSPLIT 1
#endif
#define GBAR() xcd_barrier(bar)
#ifndef PROBE_DUP
#define PROBE_DUP 0
#endif
#define DUP(bit, ...) do { __VA_ARGS__; if (PROBE_DUP & (1 << (bit))) { GBAR(); __VA_ARGS__; } } while (0)
#define GTID_NOW() ((size_t)blockIdx.x * 512 + tid_now())
#define GSZ_NOW() ((size_t)gridDim.x * 512)
#define GW_NOW() ((int)(blockIdx.x * 8 + (tid_now() >> 6)))
#define NGW_NOW() ((int)(gridDim.x * 8))
#define LANE_NOW() ((int)(tid_now() & 63))
#undef MRUN
#undef MGEMM
#define MRUN(ph, l) do { ph(c, l, GTID_NOW(), GSZ_NOW()); xcd_barrier(bar); } while (0)
#define MGEMM(ACT, ACC, A, lda, B, ldb, C, ldc, M, N, K) do { gemm_dev<ACT, ACC>(A, lda, B, ldb, C, ldc, M, N, K, (unsigned short (*)[40])dynlds, (unsigned short (*)[40])(dynlds + 128 * 40 * 2)); xcd_barrier(bar); } while (0)
extern __shared__ __attribute__((aligned(16))) unsigned char dynlds[];

struct MegaArgs { Ctx c; Fast f; FastMla fm; FastRw fr; FastMb fb; unsigned* bar; };
constexpr int LDS_STAGE = 0, LDS_XB = 163840 - 64, LDS_BYTES = 163840;
static_assert(SD_END <= LDS_XB && SS_END <= LDS_XB && RC_END <= LDS_XB, "LDS map");

template <int L>
__device__ __forceinline__ void layer_mix_naive(const Ctx& c, const XcdBarrier& bar) {
    using namespace cfg;
    constexpr int l = L, kind = L % 3, j = L / 3;
    MRUN(ph_norm_mix, l);
    if constexpr (kind == 0) {
        MRUN(ph_rw_mix, l);
        const float* W = c.in[I_WRKV] + (size_t)j * 3 * D * D;
        MGEMM(0, false, c.xm[0], D, W, D, c.r, D, MTOT, D, D);
        MGEMM(0, false, c.xm[1], D, W + (size_t)D * D, D, c.k, D, MTOT, D, D);
        MGEMM(0, false, c.xm[2], D, W + (size_t)2 * D * D, D, c.v, D, MTOT, D, D);
        MGEMM(1, false, c.xm[3], D, c.in[I_W1] + (size_t)j * D * RW_DL, RW_DL, c.hw, RW_DL, MTOT, RW_DL, D);
        MGEMM(0, false, c.hw, RW_DL, c.in[I_W2] + (size_t)j * RW_DL * D, D, c.wpre, D, MTOT, D, RW_DL);
        MGEMM(0, false, c.xm[4], D, c.in[I_A1] + (size_t)j * D * RW_AL, RW_AL, c.ha, RW_AL, MTOT, RW_AL, D);
        MGEMM(0, false, c.ha, RW_AL, c.in[I_A2] + (size_t)j * RW_AL * D, D, c.apre, D, MTOT, D, RW_AL);
        if constexpr (j > 0) {
            MGEMM(0, false, c.xm[2], D, c.in[I_V1] + (size_t)(j - 1) * D * RW_VL, RW_VL, c.hv, RW_VL, MTOT, RW_VL, D);
            MGEMM(0, false, c.hv, RW_VL, c.in[I_V2] + (size_t)(j - 1) * RW_VL * D, D, c.vpre, D, MTOT, D, RW_VL);
        }
        MGEMM(2, false, c.xm[5], D, c.in[I_G1] + (size_t)j * D * RW_GL, RW_GL, c.hg, RW_GL, MTOT, RW_GL, D);
        MGEMM(0, false, c.hg, RW_GL, c.in[I_G2] + (size_t)j * RW_GL * D, D, c.g, D, MTOT, D, RW_GL);
        MRUN(ph_rw_prep, l); MRUN(ph_rw_scan, l); MRUN(ph_rw_post, l);
        MGEMM(0, true, c.yo, D, c.in[I_RWO] + (size_t)j * D * D, D, c.x, D, MTOT, D, D);
    } else if constexpr (kind == 1) {
        MGEMM(0, false, c.xn, D, c.in[I_MWIN] + (size_t)j * D * MLA_IN, MLA_IN, c.mh, MLA_IN, MTOT, MLA_IN, D);
        MRUN(ph_mla_norm1, l);
        MGEMM(0, false, c.qan, QL, c.in[I_WUQ] + (size_t)j * QL * MH * QD, MH * QD, c.q, MH * QD, MTOT, MH * QD, QL);
        MGEMM(0, false, c.c, KVL, c.in[I_WUK] + (size_t)j * KVL * MH * NOPE, MH * NOPE, c.knr, MH * NOPE, MTOT, MH * NOPE, KVL);
        MGEMM(0, false, c.c, KVL, c.in[I_WUV] + (size_t)j * KVL * MH * VD, MH * VD, c.vv, MH * VD, MTOT, MH * VD, KVL);
        MRUN(ph_mla_norm2, l); MRUN(ph_mla_attn_prompt, l); MRUN(ph_mla_score_sample, l); MRUN(ph_mla_softmax_sample, l); MRUN(ph_mla_pv_sample, l); MRUN(ph_mla_out_sample, l);
        MGEMM(0, true, c.ao, MH * VD, c.in[I_MWO] + (size_t)j * MH * VD * D, D, c.x, D, MTOT, D, MH * VD);
    } else {
        MGEMM(0, false, c.xn, D, c.in[I_BWIN] + (size_t)j * D * MB_IN, MB_IN, c.zx, MB_IN, MTOT, MB_IN, D);
        MRUN(ph_mb_conv, l); MRUN(ph_mb_dt, l); MRUN(ph_mb_scan, l); MRUN(ph_mb_gate, l);
        MGEMM(0, true, c.yzn, MB_INNER, c.in[I_BWO] + (size_t)j * MB_INNER * D, D, c.x, D, MTOT, D, MB_INNER);
    }
}


template <int L>
__device__ __forceinline__ void layer_rwkv_fast(const Ctx& c, const Fast& f, const FastRw& fr, const XcdBarrier& bar, LDSP unsigned char* lds) {
    using namespace cfg;
    constexpr int l = L, j = L / 3;
    if (L > 0) { fold_sample_rows(c.x, f.slab, KS_FFN, GW_NOW(), NGW_NOW(), LANE_NOW()); GBAR(); }
    DUP(9, rw_mix_fast(c, fr, l, GW_NOW(), NGW_NOW(), LANE_NOW()));
    GBAR();
    DUP(7, { pg8::Order<RwSel> S; S.init(MP / 256, MS / 256, 16, D, 1, gridDim.x, blockIdx.x);
      pg8::gemm_phase(lds, pg8::Gemm{fr.xm, fr.wrkvt + (size_t)j * 4096 * D, D, D, (size_t)MTOT * D}, S, EpiRwkv{fr.rkv, fr.hb}); });
    GBAR();
    DUP(2, rw_scan_chunked<j>(c, fr, lds));
    GBAR();
    { pg8::Order<> S; S.init(MP / 256, MS / 256, 4, D, KS_1K, gridDim.x, blockIdx.x);
      pg8::gemm_phase(lds, pg8::Gemm{fr.yo, fr.wot + (size_t)j * D * D, D, D, 0}, S, pg8::EpiAccF32{c.x, D, f.slab, MP / 256, MS / 256, KS_1K}); }
    if (PROBE_DUP & (1 << 26)) { GBAR(); pg8::Order<> S; S.init(MP / 256, MS / 256, 4, D, KS_1K, gridDim.x, blockIdx.x);
      pg8::gemm_phase(lds, pg8::Gemm{fr.yo, fr.wot + (size_t)j * D * D, D, D, 0}, S, pg8::EpiAccF32{c.hmid, D, f.slab + (size_t)16 * 16 * 65536, MP / 256, MS / 256, KS_1K}); }
    GBAR();
}

__device__ __forceinline__ void layer_mamba_fast(const Ctx& c, const Fast& f, const FastMb& fb, const XcdBarrier& bar, LDSP unsigned char* lds) {
    using namespace cfg;
    constexpr int l = 2, j = 0;
    norm_rows_bf16(c.x, c.in[I_NMIX] + l * D, f.xnb, f.slab, KS_FFN, GW_NOW(), NGW_NOW(), LANE_NOW());
    GBAR();
    DUP(8, { pg8::Order<> S; S.init(MP / 256, MS / 256, 21, D, 1, gridDim.x, blockIdx.x);
      pg8::gemm_phase(lds, pg8::Gemm{f.xnb, fb.wbint, D, D, 0}, S, EpiMamba{fb.zb, fb.xbcr, fb.dtraw}); });
    GBAR();
    DUP(12, mb_conv_fast(c, fb, l, GTID_NOW(), GSZ_NOW(), false));
    GBAR();
    DUP(6, mb_ssd_prompt(c, fb, l, lds); mb_scan_sample(c, fb, l));
    GBAR();
    DUP(13, mb_gate_fast(c, fb, fb.y, l, GW_NOW(), NGW_NOW(), LANE_NOW()));
    GBAR();
    { pg8::Order<> S; S.init(MP / 256, MS / 256, 4, MB_INNER, KS_MB, gridDim.x, blockIdx.x);
      pg8::gemm_phase(lds, pg8::Gemm{fb.yzn, fb.wbot, MB_INNER, MB_INNER, 0}, S, pg8::EpiAccF32{c.x, D, f.slab, MP / 256, MS / 256, KS_MB}); }
    if (PROBE_DUP & (1 << 28)) { GBAR(); pg8::Order<> S; S.init(MP / 256, MS / 256, 4, MB_INNER, KS_MB, gridDim.x, blockIdx.x);
      pg8::gemm_phase(lds, pg8::Gemm{fb.yzn, fb.wbot, MB_INNER, MB_INNER, 0}, S, pg8::EpiAccF32{c.hmid, D, f.slab + (size_t)16 * 16 * 65536, MP / 256, MS / 256, KS_MB}); }
    GBAR();
}

__device__ __forceinline__ void layer_mla_fast(const Ctx& c, const Fast& f, const FastMla& fm, const XcdBarrier& bar, LDSP unsigned char* lds) {
    using namespace cfg;
    constexpr int l = 1, j = 0;
    norm_rows_bf16(c.x, c.in[I_NMIX] + l * D, f.xnb, f.slab, KS_FFN, GW_NOW(), NGW_NOW(), LANE_NOW());
    GBAR();
    DUP(27, { pg8::Order<> S; S.init(MP / 256, MS / 256, 4, D, 1, gridDim.x, blockIdx.x);
      pg8::gemm_phase(lds, pg8::Gemm{f.xnb, fm.wint, D, D, 0}, S, pg8::EpiF32{fm.mh, 1024, 1024}); });
    GBAR();
    DUP(14, mla_norm1_fast(c, fm, j, GW_NOW(), NGW_NOW(), LANE_NOW()));
    GBAR();
    DUP(27, { pg8::Order<> S; S.init(MP / 256, MS / 256, (MH * QD) / 256, QL, 1, gridDim.x, blockIdx.x);
      pg8::gemm_phase(lds, pg8::Gemm{fm.qan, fm.wuqt, QL, QL, 0}, S, pg8::EpiBf16<0>{fm.qraw, MH * QD}); }
    { pg8::Order<> S; S.init(MP / 256, MS / 256, 4, KVL, 1, gridDim.x, blockIdx.x);
      pg8::gemm_phase(lds, pg8::Gemm{fm.cb, fm.wukvt, KVL, KVL, 0}, S, pg8::EpiBf16<0>{fm.kvraw, 2048}); }
    { pg8::Order<> S; S.init(4, 0, MTOT / 256, KVL, 1, gridDim.x, blockIdx.x);
      pg8::gemm_phase(lds, pg8::Gemm{fm.wukvt + (size_t)1024 * KVL, fm.cb, KVL, KVL, 0}, S, pg8::EpiBf16<0>{fm.vT, MTOT}); });
    GBAR();
    DUP(15, mla_norm2_fast(c, fm, j, GW_NOW(), NGW_NOW(), LANE_NOW()));
    GBAR();
    DUP(5, attn_prompt_fast(fm.qf, fm.knb, fm.kpb, fm.vT, fm.aob, lds));
    __syncthreads();
    DUP(4, mla_sample_decode(c, fm, fm.qs, fm.opart, fm.lpart, j, lds));
    GBAR();
    DUP(16, mla_sample_combine(c, fm, fm.opart, fm.lpart, j, lds));
    GBAR();
    { pg8::Order<> S; S.init(MP / 256, MS / 256, 4, D, KS_1K, gridDim.x, blockIdx.x);
      pg8::gemm_phase(lds, pg8::Gemm{fm.aob, fm.wot, D, D, 0}, S, pg8::EpiAccF32{c.x, D, f.slab, MP / 256, MS / 256, KS_1K}); }
    if (PROBE_DUP & (1 << 27)) { GBAR(); pg8::Order<> S; S.init(MP / 256, MS / 256, 4, D, KS_1K, gridDim.x, blockIdx.x);
      pg8::gemm_phase(lds, pg8::Gemm{fm.aob, fm.wot, D, D, 0}, S, pg8::EpiAccF32{c.hmid, D, f.slab + (size_t)16 * 16 * 65536, MP / 256, MS / 256, KS_1K}); }
    GBAR();
}

template <int L>
__device__ __forceinline__ void layer_ffn_fast(const Ctx& c, const Fast& f, const XcdBarrier& bar, LDSP unsigned char* lds) {
    using namespace cfg;
    norm_rows_bf16(c.x, c.in[I_NFFN] + L * D, f.xnb, f.slab, (L % 3 == 2) ? KS_MB : KS_1K, GW_NOW(), NGW_NOW(), LANE_NOW());
    GBAR();
    DUP(0, { pg8::Order<> S; S.init(MP / 256, MS / 256, FFN / 256, D, 1, gridDim.x, blockIdx.x);
      pg8::gemm_phase(lds, pg8::Gemm{f.xnb, f.w1t + (size_t)L * FFN * D, D, D, 0}, S, pg8::EpiBf16<3>{f.hmidb, FFN}); });
    GBAR();
    { pg8::Order<> S; S.init(MP / 256, MS / 256, D / 256, FFN, (L == DEPTH - 1) ? 1 : KS_FFN, gridDim.x, blockIdx.x);
      pg8::gemm_phase(lds, pg8::Gemm{f.hmidb, f.w2t + (size_t)L * D * FFN, FFN, FFN, 0}, S, pg8::EpiAccF32{c.x, D, f.slab, MP / 256, MS / 256, (L == DEPTH - 1) ? 1 : KS_FFN}); }
    if (PROBE_DUP & (1 << 25)) { GBAR(); pg8::Order<> S; S.init(MP / 256, MS / 256, D / 256, FFN, (L == DEPTH - 1) ? 1 : KS_FFN, gridDim.x, blockIdx.x);
      pg8::gemm_phase(lds, pg8::Gemm{f.hmidb, f.w2t + (size_t)L * D * FFN, FFN, FFN, 0}, S, pg8::EpiAccF32{c.hmid, D, f.slab + (size_t)16 * 16 * 65536, MP / 256, MS / 256, (L == DEPTH - 1) ? 1 : KS_FFN}); }
    GBAR();
}

__global__ void __launch_bounds__(512, 2) mega10(MegaArgs a) {
    LDSP unsigned char* lds = (LDSP unsigned char*)dynlds;
    if (threadIdx.x < 4) ((LDSP unsigned*)(lds + LDS_XB))[threadIdx.x] = 0u;
    __syncthreads();
    XcdBarrier bar = xcd_barrier_post(a.bar, (volatile LAS unsigned*)(lds + LDS_XB));
    const Ctx& c = a.c; const Fast& f = a.f; const FastMla& fm = a.fm; const FastRw& fr = a.fr; const FastMb& fb = a.fb;
    using namespace cfg;
    DUP(10, {
        LDSP float* scr = (LDSP float*)(lds + LDS_STAGE) + (tid_now() >> 6) * (64 * 33);
        for (int l = 0; l < DEPTH; ++l) {
            tr_weight(c.in[I_FW1] + (size_t)l * D * FFN, D, FFN, FFN, f.w1t + (size_t)l * FFN * D, nullptr, scr, GW_NOW(), NGW_NOW(), LANE_NOW());
            tr_weight(c.in[I_FW2] + (size_t)l * FFN * D, FFN, D, D, f.w2t + (size_t)l * D * FFN, nullptr, scr, GW_NOW(), NGW_NOW(), LANE_NOW());
        }
        tr_weight(c.in[I_MWIN], D, MLA_IN, 1024, fm.wint, nullptr, scr, GW_NOW(), NGW_NOW(), LANE_NOW());
        tr_weight(c.in[I_WUQ], QL, MH * QD, MH * QD, fm.wuqt, nullptr, scr, GW_NOW(), NGW_NOW(), LANE_NOW());
        tr_weight(c.in[I_WUK], KVL, MH * NOPE, MH * NOPE, fm.wukvt, nullptr, scr, GW_NOW(), NGW_NOW(), LANE_NOW());
        tr_weight(c.in[I_WUV], KVL, MH * VD, MH * VD, fm.wukvt + (size_t)1024 * KVL, nullptr, scr, GW_NOW(), NGW_NOW(), LANE_NOW());
        tr_weight(c.in[I_MWO], MH * VD, D, D, fm.wot, nullptr, scr, GW_NOW(), NGW_NOW(), LANE_NOW());
        for (int j = 0; j < N_RWKV; ++j) {
            bf16_t* wt = fr.wrkvt + (size_t)j * 4096 * D;
            for (int p = 0; p < 3; ++p) tr_weight(c.in[I_WRKV] + ((size_t)j * 3 + p) * D * D, D, D, D, wt + (size_t)p * D * D, nullptr, scr, GW_NOW(), NGW_NOW(), LANE_NOW());
            tr_weight(c.in[I_W1] + (size_t)j * D * RW_DL, D, RW_DL, 256, wt + (size_t)3072 * D, nullptr, scr, GW_NOW(), NGW_NOW(), LANE_NOW());
            tr_weight(c.in[I_A1] + (size_t)j * D * RW_AL, D, RW_AL, 256, wt + (size_t)3328 * D, nullptr, scr, GW_NOW(), NGW_NOW(), LANE_NOW());
            tr_weight(c.in[I_G1] + (size_t)j * D * RW_GL, D, RW_GL, 256, wt + (size_t)3584 * D, nullptr, scr, GW_NOW(), NGW_NOW(), LANE_NOW());
            tr_weight(j > 0 ? c.in[I_V1] + (size_t)(j - 1) * D * RW_VL : c.in[I_W1], D, j > 0 ? RW_VL : 0, 256, wt + (size_t)3840 * D, nullptr, scr, GW_NOW(), NGW_NOW(), LANE_NOW());
            tr_weight(c.in[I_RWO] + (size_t)j * D * D, D, D, D, fr.wot + (size_t)j * D * D, nullptr, scr, GW_NOW(), NGW_NOW(), LANE_NOW());
            rw_build_lorat(c, fr.lorat + (size_t)j * 4096 * 384, j, GTID_NOW(), GSZ_NOW());
        }
        tr_weight(c.in[I_BWIN], D, MB_IN, 5376, fb.wbint, nullptr, scr, GW_NOW(), NGW_NOW(), LANE_NOW());
        tr_weight(c.in[I_BWO], MB_INNER, D, D, fb.wbot, nullptr, scr, GW_NOW(), NGW_NOW(), LANE_NOW());
        ph_copy_x(c, 0, GTID_NOW(), GSZ_NOW());
    });
    GBAR();
    layer_rwkv_fast<0>(c, f, fr, bar, lds); layer_ffn_fast<0>(c, f, bar, lds);
    layer_mla_fast(c, f, fm, bar, lds); layer_ffn_fast<1>(c, f, bar, lds);
    layer_mamba_fast(c, f, fb, bar, lds); layer_ffn_fast<2>(c, f, bar, lds);
    layer_rwkv_fast<3>(c, f, fr, bar, lds); layer_ffn_fast<3>(c, f, bar, lds);
}

extern "C" void kernel_launch(void* const* d_in, const int* in_sizes, int n_in, void* d_out, int out_size, void* d_ws, size_t ws_size, hipStream_t stream) {
    using namespace cfg;
    MegaArgs a{};
    size_t used = setup_ctx(a.c, d_in, d_out, d_ws);
    { Bump b{(char*)d_ws, (size_t)((char*)a.c.xm[0] - (char*)d_ws)}; FastRw& r = a.fr;
      r.xm = (bf16_t*)b.f((size_t)6 * MTOT * D / 2); r.rkv = (bf16_t*)b.f((size_t)MTOT * 3072 / 2); r.hb = (bf16_t*)b.f((size_t)MTOT * 384 / 2); r.lu = (bf16_t*)b.f((size_t)MTOT * 4096 / 2);
      r.ops = b.f((size_t)MTOT * RHEADS * RW_REC + 4096); r.yo = (bf16_t*)b.f((size_t)MTOT * D / 2); r.vf = a.c.vf;
      if (b.off > (size_t)((char*)a.c.hmid - (char*)d_ws) + (size_t)MTOT * FFN * 4) { fprintf(stderr, "RWKV overlay too large\n"); return; } }
    { Bump b{(char*)d_ws, used};
      a.f.xnb = (bf16_t*)b.f((size_t)MTOT * D / 2); a.f.hmidb = (bf16_t*)b.f((size_t)MTOT * FFN / 2);
      a.f.w1t = (bf16_t*)b.f((size_t)DEPTH * FFN * D / 2); a.f.w2t = (bf16_t*)b.f((size_t)DEPTH * FFN * D / 2); a.f.slab = b.f((size_t)2 * 16 * 16 * 65536);
      FastMla& m = a.fm;
      m.mh = b.f((size_t)MTOT * 1024); m.qan = (bf16_t*)b.f((size_t)MTOT * QL / 2); m.cb = (bf16_t*)b.f((size_t)MTOT * KVL / 2); m.kpb = (bf16_t*)b.f((size_t)MTOT * ROPE / 2);
      m.qraw = (bf16_t*)b.f((size_t)MTOT * 1536 / 2); m.kvraw = (bf16_t*)b.f((size_t)MTOT * 2048 / 2); m.qf = (bf16_t*)b.f((size_t)MTOT * 1536 / 2); m.knb = (bf16_t*)b.f((size_t)MTOT * 1024 / 2);
      m.aob = (bf16_t*)b.f((size_t)MTOT * 1024 / 2); m.vT = (bf16_t*)b.f((size_t)MTOT * 1024 / 2); m.qs = (bf16_t*)b.f((size_t)MS * 1536 / 2);
      m.opart = b.f((size_t)2 * DB * 128 * 256); m.lpart = b.f((size_t)2 * DB * 128);
      m.wint = (bf16_t*)b.f((size_t)1024 * 1024 / 2); m.wuqt = (bf16_t*)b.f((size_t)1536 * 512 / 2); m.wukvt = (bf16_t*)b.f((size_t)2048 * 256 / 2); m.wot = (bf16_t*)b.f((size_t)1024 * 1024 / 2);
      { FastMb& q = a.fb; q.zb = (bf16_t*)b.f((size_t)MTOT * 2048 / 2); q.xbcr = (bf16_t*)b.f((size_t)MTOT * 3072 / 2); q.dtraw = b.f((size_t)MTOT * 32); q.xbcb = (bf16_t*)b.f((size_t)MTOT * 3072 / 2);
        q.dt = b.f((size_t)MTOT * 32); q.y = a.c.my; q.yzn = (bf16_t*)b.f((size_t)MTOT * 2048 / 2); q.wbint = (bf16_t*)b.f((size_t)5376 * 1024 / 2); q.wbot = (bf16_t*)b.f((size_t)1024 * 2048 / 2); }
      a.fr.wrkvt = (bf16_t*)b.f((size_t)N_RWKV * 4096 * D / 2); a.fr.lorat = (bf16_t*)b.f((size_t)N_RWKV * 4096 * 384 / 2); a.fr.wot = (bf16_t*)b.f((size_t)N_RWKV * D * D / 2);
      used = b.off; }
    if (used > ws_size || n_in != 51) { fprintf(stderr, "workspace too small: need %zu have %zu (n_in %d)\n", used, ws_size, n_in); return; }
    a.bar = (unsigned*)d_ws;
    static int grid = 0;
    if (!grid) {
        int dev = 0, cus = 0, per_cu = 0;
        (void)hipGetDevice(&dev); (void)hipDeviceGetAttribute(&cus, hipDeviceAttributeMultiprocessorCount, dev);
        if (hipFuncSetAttribute((const void*)mega10, hipFuncAttributeMaxDynamicSharedMemorySize, LDS_BYTES) != hipSuccess) { fprintf(stderr, "hipFuncSetAttribute failed\n"); grid = -1; return; }
        (void)hipOccupancyMaxActiveBlocksPerMultiprocessor(&per_cu, (const void*)mega10, 512, LDS_BYTES);
        (void)hipGetLastError();
        grid = per_cu >= 1 ? (cus < 256 ? cus : 256) : -1;
    }
    if (grid <= 0) { fprintf(stderr, "kernel does not fit one workgroup per CU\n"); return; }
    (void)hipMemsetAsync(a.bar, 0, XCD_BAR_WORDS * sizeof(unsigned), stream);
    hipLaunchKernelGGL(mega10, dim3(grid), dim3(512), LDS_BYTES, stream, a);
}
```

```cpp
#include <hip/hip_runtime.h>
#include <cstdio>
#include <math.h>
#include <stdint.h>
#include <stddef.h>
#ifdef CPU_EMU
#define DEV inline
#else
#define DEV __device__ __forceinline__
#endif

namespace cfg {
#ifdef CFG_SMALL
constexpr int D = 128, BATCH = 2, SEQ = 32, DEPTH = 4, DB = 3, DS = 8, PAST = 64, PAGE = 16;
constexpr int RW_DL = 16, RW_AL = 16, RW_VL = 8, RW_GL = 24;
constexpr int MH = 2, QL = 64, KVL = 32;
constexpr int MB_GROUPS = 2;
#else
constexpr int D = 1024, BATCH = 16, SEQ = 2048, DEPTH = 4, DB = 128, DS = 8, PAST = 8192, PAGE = 128;
constexpr int RW_DL = 64, RW_AL = 64, RW_VL = 32, RW_GL = 160;
constexpr int MH = 16, QL = 512, KVL = 256;
constexpr int MB_GROUPS = 4;
#endif
constexpr int N_RWKV = (DEPTH + 2) / 3, N_MLA = (DEPTH + 1) / 3, N_MAMBA = DEPTH / 3;
constexpr int RH = 64, RHEADS = D / RH;
constexpr int NOPE = 64, ROPE = 32, VD = 64, QD = NOPE + ROPE;
constexpr int MLA_IN = QL + KVL + ROPE;
constexpr int MB_INNER = 2 * D, MB_HEAD = 64, MB_HEADS = MB_INNER / MB_HEAD, MB_STATE = 128, MB_CONV = 4;
constexpr int MB_GN = MB_GROUPS * MB_STATE;
constexpr int MB_CD = MB_INNER + 2 * MB_GN, MB_IN = MB_INNER + MB_CD + MB_HEADS;
constexpr int FFN = 4 * D;
constexpr int NPAGES = PAST / PAGE, NPOOL = (DB * NPAGES * 5) / 4;
constexpr int MP = BATCH * SEQ, MS = DB * DS, MTOT = MP + MS, NSEQ = BATCH + DB;
constexpr int KTOT = PAST + DS;
constexpr float NORM_EPS = 1e-6f, LNX_EPS = 64e-5f;
constexpr size_t O_YP = 0;
constexpr size_t O_YS = O_YP + (size_t)MP * D;
constexpr size_t O_CKVP = O_YS + (size_t)MS * D;
constexpr size_t O_KPEP = O_CKVP + (size_t)N_MLA * MP * KVL;
constexpr size_t O_CKVS = O_KPEP + (size_t)N_MLA * MP * ROPE;
constexpr size_t O_KPES = O_CKVS + (size_t)N_MLA * MS * KVL;
constexpr size_t O_WKVP = O_KPES + (size_t)N_MLA * MS * ROPE;
constexpr size_t O_SHP = O_WKVP + (size_t)N_RWKV * BATCH * RHEADS * RH * RH;
constexpr size_t O_WKVS = O_SHP + (size_t)N_RWKV * BATCH * D;
constexpr size_t O_SHS = O_WKVS + (size_t)N_RWKV * DB * RHEADS * RH * RH;
constexpr size_t O_SSMP = O_SHS + (size_t)N_RWKV * DB * D;
constexpr size_t O_CONVP = O_SSMP + (size_t)N_MAMBA * BATCH * MB_HEADS * MB_HEAD * MB_STATE;
constexpr size_t O_SSMS = O_CONVP + (size_t)N_MAMBA * BATCH * (MB_CONV - 1) * MB_CD;
constexpr size_t O_CONVS = O_SSMS + (size_t)N_MAMBA * DB * MB_HEADS * MB_HEAD * MB_STATE;
constexpr size_t O_END = O_CONVS + (size_t)N_MAMBA * DB * (MB_CONV - 1) * MB_CD;
}

struct Ctx {
    const float* in[51];
    const int* page_table;
    float* out;
    float *x, *xn, *vf;
    float* xm[6];
    float *r, *k, *v, *wpre, *apre, *vpre, *g, *hw, *ha, *hv, *hg, *ka, *kb, *y, *yo;
    float *hmid;
    float *mh, *qan, *q, *c, *kp, *knr, *vv, *ao, *sc, *olat;
    float *zx, *xbc, *dt, *my, *yzn;
};

DEV int row_t(int m) { return m < cfg::MP ? m % cfg::SEQ : (m - cfg::MP) % cfg::DS; }
DEV int row_seq(int m) { return m < cfg::MP ? m / cfg::SEQ : cfg::BATCH + (m - cfg::MP) / cfg::DS; }
DEV int seq_row0(int sq) { return sq < cfg::BATCH ? sq * cfg::SEQ : cfg::MP + (sq - cfg::BATCH) * cfg::DS; }
DEV int seq_len(int sq) { return sq < cfg::BATCH ? cfg::SEQ : cfg::DS; }
DEV float sigmoidf_(float x) { return 1.0f / (1.0f + expf(-x)); }
DEV float softplusf_(float x) { return x > 20.f ? x : log1pf(expf(x)); }
DEV float siluf_(float x) { return x * sigmoidf_(x); }

enum { I_XP = 0, I_XS, I_CKV, I_KPE, I_WKV, I_SHIFT, I_SSM, I_CONV, I_PT, I_NMIX, I_NFFN, I_FW1, I_FW2, I_MU, I_WRKV, I_W0, I_W1, I_W2, I_A0, I_A1, I_A2,
       I_V0, I_V1, I_V2, I_G1, I_G2, I_KK, I_KA, I_RK, I_LNW, I_LNB, I_RWO, I_MWIN, I_QNORM, I_KVNORM, I_WUQ, I_WUK, I_WUV, I_QNN, I_QRN, I_KNN, I_KRN, I_MWO,
       I_BWIN, I_CONVW, I_CONVB, I_DTB, I_ALOG, I_BD, I_BNORM, I_BWO };

#define UNROLL _Pragma("unroll")
#define GSL(i, n) for (size_t i = gtid; i < (size_t)(n); i += gsz)

DEV void ph_copy_x(const Ctx& c, int, size_t gtid, size_t gsz) {
    using namespace cfg;
    GSL(i, (size_t)MTOT * D) c.x[i] = i < (size_t)MP * D ? c.in[I_XP][i] : c.in[I_XS][i - (size_t)MP * D];
}
DEV void rmsnorm_rows(const float* x, const float* gain, float* xn, size_t gtid, size_t gsz) {
    using namespace cfg;
    GSL(m, MTOT) {
        const float* xr = x + m * D; float ss = 0.f;
        for (int i = 0; i < D; ++i) ss += xr[i] * xr[i];
        const float rs = 1.0f / sqrtf(ss / D + NORM_EPS);
        for (int i = 0; i < D; ++i) xn[m * D + i] = xr[i] * rs * gain[i];
    }
}
DEV void ph_norm_mix(const Ctx& c, int l, size_t gtid, size_t gsz) { rmsnorm_rows(c.x, c.in[I_NMIX] + l * cfg::D, c.xn, gtid, gsz); }
DEV void ph_norm_ffn(const Ctx& c, int l, size_t gtid, size_t gsz) { rmsnorm_rows(c.x, c.in[I_NFFN] + l * cfg::D, c.xn, gtid, gsz); }

DEV void ph_rw_mix(const Ctx& c, int l, size_t gtid, size_t gsz) {
    using namespace cfg; const int j = l / 3;
    GSL(i, (size_t)MTOT * D) {
        const int m = (int)(i / D), ch = (int)(i % D), t = row_t(m), sq = row_seq(m);
        const float xc = c.xn[i];
        float xp;
        if (t > 0) xp = c.xn[i - D];
        else xp = sq < BATCH ? 0.f : c.in[I_SHIFT][((size_t)j * DB + (sq - BATCH)) * D + ch];
        for (int p = 0; p < 6; ++p) c.xm[p][i] = xc + (xp - xc) * c.in[I_MU][((size_t)j * 6 + p) * D + ch];
        if (t == seq_len(sq) - 1) {
            if (sq < BATCH) c.out[O_SHP + ((size_t)j * BATCH + sq) * D + ch] = xc;
            else c.out[O_SHS + ((size_t)j * DB + (sq - BATCH)) * D + ch] = xc;
        }
    }
}
DEV void ph_rw_prep(const Ctx& c, int l, size_t gtid, size_t gsz) {
    using namespace cfg; const int j = l / 3;
    GSL(i, (size_t)MTOT * RHEADS) {
        const int m = (int)(i / RHEADS), h = (int)(i % RHEADS);
        const size_t o = (size_t)m * D + h * RH;
        float nn = 0.f;
        for (int e = 0; e < RH; ++e) { const float kk = c.k[o + e] * c.in[I_KK][j * D + h * RH + e]; nn += kk * kk; }
        const float inv = 1.0f / fmaxf(sqrtf(nn), 1e-12f);
        for (int e = 0; e < RH; ++e) {
            const int ch = h * RH + e;
            const float wl = -softplusf_(-(c.in[I_W0][j * D + ch] + c.wpre[o + e])) - 0.5f;
            const float decay = expf(-expf(wl));
            float vv = c.v[o + e];
            if (j == 0) c.vf[o + e] = vv;
            else vv = vv + (c.vf[o + e] - vv) * sigmoidf_(c.in[I_V0][(j - 1) * D + ch] + c.vpre[o + e]);
            const float a = sigmoidf_(c.in[I_A0][j * D + ch] + c.apre[o + e]);
            const float k0 = c.k[o + e];
            const float kk = k0 * c.in[I_KK][j * D + ch] * inv;
            c.k[o + e] = k0 * (1.0f + (a - 1.0f) * c.in[I_KA][j * D + ch]);
            c.v[o + e] = vv;
            c.wpre[o + e] = decay;
            c.ka[o + e] = -kk;
            c.kb[o + e] = kk * a;
        }
    }
}
DEV void ph_rw_scan(const Ctx& c, int l, size_t gtid, size_t gsz) {
    using namespace cfg; const int j = l / 3;
    GSL(i, (size_t)NSEQ * RHEADS * RH) {
        const int sq = (int)(i / (RHEADS * RH)), h = (int)(i / RH) % RHEADS, vi = (int)(i % RH);
        float S[RH];
        if (sq < BATCH) { UNROLL for (int e = 0; e < RH; ++e) S[e] = 0.f; }
        else { const float* s0 = c.in[I_WKV] + ((((size_t)j * DB + (sq - BATCH)) * RHEADS + h) * RH + vi) * RH; UNROLL for (int e = 0; e < RH; ++e) S[e] = s0[e]; }
        const int m0 = seq_row0(sq), T = seq_len(sq);
        for (int t = 0; t < T; ++t) {
            const size_t o = (size_t)(m0 + t) * D + h * RH;
            float sa = 0.f;
            UNROLL for (int e = 0; e < RH; ++e) sa += S[e] * c.ka[o + e];
            const float vt = c.v[o + vi]; float yy = 0.f;
            UNROLL for (int e = 0; e < RH; ++e) { S[e] = S[e] * c.wpre[o + e] + sa * c.kb[o + e] + vt * c.k[o + e]; yy += S[e] * c.r[o + e]; }
            c.y[o + vi] = yy;
        }
        float* so = sq < BATCH ? c.out + O_WKVP + ((((size_t)j * BATCH + sq) * RHEADS + h) * RH + vi) * RH
                               : c.out + O_WKVS + ((((size_t)j * DB + (sq - BATCH)) * RHEADS + h) * RH + vi) * RH;
        UNROLL for (int e = 0; e < RH; ++e) so[e] = S[e];
    }
}
DEV void ph_rw_post(const Ctx& c, int l, size_t gtid, size_t gsz) {
    using namespace cfg; const int j = l / 3;
    GSL(i, (size_t)MTOT * RHEADS) {
        const int m = (int)(i / RHEADS), h = (int)(i % RHEADS);
        const size_t o = (size_t)m * D + h * RH;
        float mean = 0.f; for (int e = 0; e < RH; ++e) mean += c.y[o + e]; mean /= RH;
        float var = 0.f; for (int e = 0; e < RH; ++e) { const float d = c.y[o + e] - mean; var += d * d; } var /= RH;
        const float rs = 1.0f / sqrtf(var + LNX_EPS);
        float bonus = 0.f; for (int e = 0; e < RH; ++e) bonus += c.r[o + e] * c.k[o + e] * c.in[I_RK][(size_t)j * D + h * RH + e];
        for (int e = 0; e < RH; ++e) {
            const int ch = h * RH + e;
            const float yn = (c.y[o + e] - mean) * rs * c.in[I_LNW][j * D + ch] + c.in[I_LNB][j * D + ch];
            c.yo[o + e] = (yn + bonus * c.v[o + e]) * c.g[o + e];
        }
    }
}

DEV void rope_apply(const float* xin, float* xout, int pos) {
    using namespace cfg; const int half = ROPE / 2;
    UNROLL for (int i = 0; i < half; ++i) {
        const float inv = exp2f(-(float)i * (13.287712379549449f / half));
        const float ang = (float)pos * inv;
        const float kq = rintf(ang * 0.15915494309189535f);
        float rr = fmaf(-kq, 6.28125f, ang); rr = fmaf(-kq, 1.9353071795864769e-3f, rr);
        const float cs = __cosf(rr), sn = __sinf(rr);
        const float x1 = xin[i], x2 = xin[i + half];
        xout[i] = x1 * cs - x2 * sn; xout[i + half] = x2 * cs + x1 * sn;
    }
}
DEV int row_pos(int m) { return m < cfg::MP ? m % cfg::SEQ : cfg::PAST + (m - cfg::MP) % cfg::DS; }
DEV void ph_mla_norm1(const Ctx& c, int l, size_t gtid, size_t gsz) {
    using namespace cfg; const int j = l / 3;
    GSL(m, MTOT) {
        const float* h = c.mh + m * MLA_IN;
        float ss = 0.f; for (int i = 0; i < QL; ++i) ss += h[i] * h[i];
        float rs = 1.0f / sqrtf(ss / QL + NORM_EPS);
        for (int i = 0; i < QL; ++i) c.qan[m * QL + i] = h[i] * rs * c.in[I_QNORM][j * QL + i];
        ss = 0.f; for (int i = 0; i < KVL; ++i) ss += h[QL + i] * h[QL + i];
        rs = 1.0f / sqrtf(ss / KVL + NORM_EPS);
        float* co = m < (size_t)MP ? c.out + O_CKVP + ((size_t)j * MP + m) * KVL : c.out + O_CKVS + ((size_t)j * MS + (m - MP)) * KVL;
        for (int i = 0; i < KVL; ++i) { const float v = h[QL + i] * rs * c.in[I_KVNORM][j * KVL + i]; c.c[m * KVL + i] = v; co[i] = v; }
        ss = 0.f; UNROLL for (int i = 0; i < ROPE; ++i) ss += h[QL + KVL + i] * h[QL + KVL + i];
        rs = 1.0f / sqrtf(ss / ROPE + NORM_EPS);
        float tmp[ROPE], ro[ROPE];
        UNROLL for (int i = 0; i < ROPE; ++i) tmp[i] = h[QL + KVL + i] * rs * c.in[I_KRN][j * ROPE + i];
        rope_apply(tmp, ro, row_pos((int)m));
        float* ko = m < (size_t)MP ? c.out + O_KPEP + ((size_t)j * MP + m) * ROPE : c.out + O_KPES + ((size_t)j * MS + (m - MP)) * ROPE;
        UNROLL for (int i = 0; i < ROPE; ++i) { c.kp[m * ROPE + i] = ro[i]; ko[i] = ro[i]; }
    }
}
DEV void ph_mla_norm2(const Ctx& c, int l, size_t gtid, size_t gsz) {
    using namespace cfg; const int j = l / 3;
    GSL(i, (size_t)MTOT * MH) {
        const int m = (int)(i / MH), h = (int)(i % MH);
        float* q = c.q + (size_t)m * MH * QD + h * QD;
        float ss = 0.f; UNROLL for (int e = 0; e < NOPE; ++e) ss += q[e] * q[e];
        float rs = 1.0f / sqrtf(ss / NOPE + NORM_EPS);
        UNROLL for (int e = 0; e < NOPE; ++e) q[e] = q[e] * rs * c.in[I_QNN][j * NOPE + e];
        ss = 0.f; UNROLL for (int e = 0; e < ROPE; ++e) ss += q[NOPE + e] * q[NOPE + e];
        rs = 1.0f / sqrtf(ss / ROPE + NORM_EPS);
        float tmp[ROPE], ro[ROPE];
        UNROLL for (int e = 0; e < ROPE; ++e) tmp[e] = q[NOPE + e] * rs * c.in[I_QRN][j * ROPE + e];
        rope_apply(tmp, ro, row_pos(m));
        UNROLL for (int e = 0; e < ROPE; ++e) q[NOPE + e] = ro[e];
        float* kn = c.knr + (size_t)m * MH * NOPE + h * NOPE;
        ss = 0.f; UNROLL for (int e = 0; e < NOPE; ++e) ss += kn[e] * kn[e];
        rs = 1.0f / sqrtf(ss / NOPE + NORM_EPS);
        UNROLL for (int e = 0; e < NOPE; ++e) kn[e] = kn[e] * rs * c.in[I_KNN][j * NOPE + e];
    }
}
DEV void ph_mla_attn_prompt(const Ctx& c, int, size_t gtid, size_t gsz) {
    using namespace cfg; const float scale = 1.0f / sqrtf((float)QD);
    GSL(i, (size_t)MP * MH) {
        const int m = (int)(i / MH), h = (int)(i % MH), t = m % SEQ, m0 = m - t;
        const float* q = c.q + (size_t)m * MH * QD + h * QD;
        float mx = -INFINITY, den = 0.f, acc[VD];
        UNROLL for (int e = 0; e < VD; ++e) acc[e] = 0.f;
        for (int kx = 0; kx <= t; ++kx) {
            const int mk = m0 + kx;
            const float* kn = c.knr + (size_t)mk * MH * NOPE + h * NOPE; const float* kp = c.kp + (size_t)mk * ROPE;
            float s = 0.f;
            UNROLL for (int e = 0; e < NOPE; ++e) s += q[e] * kn[e];
            UNROLL for (int e = 0; e < ROPE; ++e) s += q[NOPE + e] * kp[e];
            s *= scale;
            const float nm = fmaxf(mx, s), corr = expf(mx - nm), p = expf(s - nm);
            den = den * corr + p;
            const float* v = c.vv + (size_t)mk * MH * VD + h * VD;
            UNROLL for (int e = 0; e < VD; ++e) acc[e] = acc[e] * corr + p * v[e];
            mx = nm;
        }
        UNROLL for (int e = 0; e < VD; ++e) c.ao[(size_t)m * MH * VD + h * VD + e] = acc[e] / den;
    }
}
DEV const float* smp_c(const Ctx& c, int j, int s, int pos) {
    using namespace cfg;
    if (pos < PAST) { const int pg = c.page_table[s * NPAGES + pos / PAGE]; return c.in[I_CKV] + (((size_t)j * NPOOL + pg) * PAGE + pos % PAGE) * KVL; }
    return c.c + (size_t)(MP + s * DS + (pos - PAST)) * KVL;
}
DEV const float* smp_kp(const Ctx& c, int j, int s, int pos) {
    using namespace cfg;
    if (pos < PAST) { const int pg = c.page_table[s * NPAGES + pos / PAGE]; return c.in[I_KPE] + (((size_t)j * NPOOL + pg) * PAGE + pos % PAGE) * ROPE; }
    return c.kp + (size_t)(MP + s * DS + (pos - PAST)) * ROPE;
}
DEV void ph_mla_score_sample(const Ctx& c, int l, size_t gtid, size_t gsz) {
    using namespace cfg; const int j = l / 3; const float scale = 1.0f / sqrtf((float)QD);
    GSL(i, (size_t)DB * KTOT * MH) {
        const int pos = (int)(i % KTOT), h = (int)((i / KTOT) % MH), s = (int)(i / ((size_t)MH * KTOT));
        const float* cl = smp_c(c, j, s, pos); const float* kp = smp_kp(c, j, s, pos);
        float kn[NOPE];
        UNROLL for (int e = 0; e < NOPE; ++e) kn[e] = 0.f;
        const float* wuk = c.in[I_WUK] + (size_t)j * KVL * MH * NOPE;
        for (int r = 0; r < KVL; ++r) { const float cv = cl[r]; const float* w = wuk + ((size_t)r * MH + h) * NOPE; UNROLL for (int e = 0; e < NOPE; ++e) kn[e] += cv * w[e]; }
        float ss = 0.f; UNROLL for (int e = 0; e < NOPE; ++e) ss += kn[e] * kn[e];
        const float rs = 1.0f / sqrtf(ss / NOPE + NORM_EPS);
        UNROLL for (int e = 0; e < NOPE; ++e) kn[e] = kn[e] * rs * c.in[I_KNN][j * NOPE + e];
        for (int qi = 0; qi < DS; ++qi) {
            const float* q = c.q + (size_t)(MP + s * DS + qi) * MH * QD + h * QD;
            float sc = 0.f;
            UNROLL for (int e = 0; e < NOPE; ++e) sc += q[e] * kn[e];
            UNROLL for (int e = 0; e < ROPE; ++e) sc += q[NOPE + e] * kp[e];
            const bool ok = pos < PAST || (pos - PAST) <= qi;
            c.sc[(((size_t)s * MH + h) * DS + qi) * KTOT + pos] = ok ? sc * scale : -INFINITY;
        }
    }
}
DEV void ph_mla_softmax_sample(const Ctx& c, int, size_t gtid, size_t gsz) {
    using namespace cfg;
    GSL(i, (size_t)DB * MH * DS) {
        float* sc = c.sc + i * KTOT;
        float mx = -INFINITY; for (int p = 0; p < KTOT; ++p) mx = fmaxf(mx, sc[p]);
        float den = 0.f; for (int p = 0; p < KTOT; ++p) den += expf(sc[p] - mx);
        const float inv = 1.0f / den;
        for (int p = 0; p < KTOT; ++p) sc[p] = expf(sc[p] - mx) * inv;
    }
}
DEV void ph_mla_pv_sample(const Ctx& c, int l, size_t gtid, size_t gsz) {
    using namespace cfg; const int j = l / 3;
    GSL(i, (size_t)DB * MH * DS * KVL) {
        const int r = (int)(i % KVL); const size_t row = i / KVL; const int s = (int)(row / (MH * DS));
        const float* p = c.sc + row * KTOT; float acc = 0.f;
        for (int pos = 0; pos < KTOT; ++pos) acc += p[pos] * smp_c(c, j, s, pos)[r];
        c.olat[i] = acc;
    }
}
DEV void ph_mla_out_sample(const Ctx& c, int l, size_t gtid, size_t gsz) {
    using namespace cfg; const int j = l / 3;
    GSL(i, (size_t)MS * MH * VD) {
        const int e = (int)(i % VD), h = (int)((i / VD) % MH), ms = (int)(i / (MH * VD)), s = ms / DS, qi = ms % DS;
        const float* ol = c.olat + (((size_t)s * MH + h) * DS + qi) * KVL;
        const float* wuv = c.in[I_WUV] + (size_t)j * KVL * MH * VD;
        float acc = 0.f;
        for (int r = 0; r < KVL; ++r) acc += ol[r] * wuv[((size_t)r * MH + h) * VD + e];
        c.ao[(size_t)(MP + ms) * MH * VD + h * VD + e] = acc;
    }
}

DEV float mb_xpad(const Ctx& c, int j, int m, int sq, int tt, int ch) {
    using namespace cfg;
    if (tt < MB_CONV - 1) return sq < BATCH ? 0.f : c.in[I_CONV][(((size_t)j * DB + (sq - BATCH)) * (MB_CONV - 1) + tt) * MB_CD + ch];
    (void)m; return c.zx[(size_t)(seq_row0(sq) + tt - (MB_CONV - 1)) * MB_IN + MB_INNER + ch];
}
DEV void ph_mb_conv(const Ctx& c, int l, size_t gtid, size_t gsz) {
    using namespace cfg; const int j = l / 3;
    GSL(i, (size_t)MTOT * MB_CD) {
        const int m = (int)(i / MB_CD), ch = (int)(i % MB_CD), t = row_t(m), sq = row_seq(m), T = seq_len(sq);
        float acc = c.in[I_CONVB][j * MB_CD + ch];
        for (int jj = 0; jj < MB_CONV; ++jj) acc += mb_xpad(c, j, m, sq, t + jj, ch) * c.in[I_CONVW][((size_t)j * MB_CONV + jj) * MB_CD + ch];
        c.xbc[i] = siluf_(acc);
        if (t < MB_CONV - 1) {
            const float v = mb_xpad(c, j, m, sq, T + t, ch);
            if (sq < BATCH) c.out[O_CONVP + (((size_t)j * BATCH + sq) * (MB_CONV - 1) + t) * MB_CD + ch] = v;
            else c.out[O_CONVS + (((size_t)j * DB + (sq - BATCH)) * (MB_CONV - 1) + t) * MB_CD + ch] = v;
        }
    }
}
DEV void ph_mb_dt(const Ctx& c, int l, size_t gtid, size_t gsz) {
    using namespace cfg; const int j = l / 3;
    GSL(i, (size_t)MTOT * MB_HEADS) {
        const int m = (int)(i / MB_HEADS), h = (int)(i % MB_HEADS);
        c.dt[i] = softplusf_(c.zx[(size_t)m * MB_IN + MB_INNER + MB_CD + h] + c.in[I_DTB][j * MB_HEADS + h]);
    }
}
DEV void ph_mb_scan(const Ctx& c, int l, size_t gtid, size_t gsz) {
    using namespace cfg; const int j = l / 3;
    GSL(i, (size_t)NSEQ * MB_HEADS * MB_HEAD) {
        const int p = (int)(i % MB_HEAD), h = (int)((i / MB_HEAD) % MB_HEADS), sq = (int)(i / (MB_HEADS * MB_HEAD));
        const int g = h / (MB_HEADS / MB_GROUPS);
        float hs[MB_STATE];
        if (sq < BATCH) { UNROLL for (int n = 0; n < MB_STATE; ++n) hs[n] = 0.f; }
        else { const float* s0 = c.in[I_SSM] + ((((size_t)j * DB + (sq - BATCH)) * MB_HEADS + h) * MB_HEAD + p) * MB_STATE; UNROLL for (int n = 0; n < MB_STATE; ++n) hs[n] = s0[n]; }
        const float A = -expf(c.in[I_ALOG][j * MB_HEADS + h]), dsk = c.in[I_BD][j * MB_HEADS + h];
        const int m0 = seq_row0(sq), T = seq_len(sq);
        for (int t = 0; t < T; ++t) {
            const size_t m = (size_t)(m0 + t);
            const float dtv = c.dt[m * MB_HEADS + h], dA = expf(dtv * A);
            const float xv = c.xbc[m * MB_CD + h * MB_HEAD + p], xdt = xv * dtv;
            const float* Bm = c.xbc + m * MB_CD + MB_INNER + g * MB_STATE; const float* Cm = Bm + MB_GN;
            float yy = 0.f;
            UNROLL for (int n = 0; n < MB_STATE; ++n) { hs[n] = hs[n] * dA + xdt * Bm[n]; yy += Cm[n] * hs[n]; }
            c.my[m * MB_INNER + h * MB_HEAD + p] = yy + dsk * xv;
        }
        float* so = sq < BATCH ? c.out + O_SSMP + ((((size_t)j * BATCH + sq) * MB_HEADS + h) * MB_HEAD + p) * MB_STATE
                               : c.out + O_SSMS + ((((size_t)j * DB + (sq - BATCH)) * MB_HEADS + h) * MB_HEAD + p) * MB_STATE;
        UNROLL for (int n = 0; n < MB_STATE; ++n) so[n] = hs[n];
    }
}
DEV void ph_mb_gate(const Ctx& c, int l, size_t gtid, size_t gsz) {
    using namespace cfg; const int j = l / 3; constexpr int GW = MB_INNER / MB_GROUPS;
    GSL(i, (size_t)MTOT * MB_GROUPS) {
        const int m = (int)(i / MB_GROUPS), g = (int)(i % MB_GROUPS);
        float ss = 0.f;
        for (int e = 0; e < GW; ++e) { const float v = c.my[(size_t)m * MB_INNER + g * GW + e] * siluf_(c.zx[(size_t)m * MB_IN + g * GW + e]); ss += v * v; }
        const float rs = 1.0f / sqrtf(ss / GW + NORM_EPS);
        for (int e = 0; e < GW; ++e) {
            const float v = c.my[(size_t)m * MB_INNER + g * GW + e] * siluf_(c.zx[(size_t)m * MB_IN + g * GW + e]);
            c.yzn[(size_t)m * MB_INNER + g * GW + e] = v * rs * c.in[I_BNORM][j * MB_INNER + g * GW + e];
        }
    }
}
typedef short bf16x8_t __attribute__((ext_vector_type(8)));
typedef float f32x4_t __attribute__((ext_vector_type(4)));
__device__ __forceinline__ unsigned short f2bf(float f) { unsigned u = __float_as_uint(f); u += 0x7fffu + ((u >> 16) & 1u); return (unsigned short)(u >> 16); }
#define XB_TMO      128
#define XB_XCNT(j)  (256  + 64 * (j))
#define XB_XSUB(j)  (1280 + 64 * (j))
#define XB_XGEN(j)  (2304 + 64 * (j))
#define XB_TOP      3328
#define XB_TOPGEN   3392
#define XCD_BAR_WORDS 3456
#define XB_SPIN_CAP (1u << 25)
#define LAS __attribute__((address_space(3)))

__device__ __forceinline__ unsigned xb_ld(unsigned* p)              { return __hip_atomic_load(p, __ATOMIC_RELAXED, __HIP_MEMORY_SCOPE_AGENT); }
__device__ __forceinline__ unsigned xb_add(unsigned* p, unsigned v) { return __hip_atomic_fetch_add(p, v, __ATOMIC_RELAXED, __HIP_MEMORY_SCOPE_AGENT); }
__device__ __forceinline__ unsigned xb_xcc_id() { return (unsigned)__builtin_amdgcn_s_getreg((3 << 11) | 20) & 0xFu; }
#define XB_SPIN(cond, bar) do { unsigned _sp = 0; while (cond) { __builtin_amdgcn_s_sleep(1); \
    if ((++_sp & 255u) == 0u) { if (xb_ld(&(bar)[XB_TMO])) break; if (_sp > XB_SPIN_CAP) { atomicAdd(&(bar)[XB_TMO], 1u); break; } } } } while (0)

struct XcdBarrier {
    unsigned* bar; unsigned x;
    volatile LAS unsigned* st;
};

__device__ __forceinline__ XcdBarrier xcd_barrier_post(unsigned* bar, volatile LAS unsigned* st) {
    XcdBarrier b; b.bar = bar; b.x = xb_xcc_id(); b.st = st;
    if (threadIdx.x == 0) (void)xb_add(&bar[XB_XCNT(b.x)], 1u);
    return b;
}
__device__ __forceinline__ void xcd_barrier_complete(unsigned* bar, unsigned x, unsigned& nloc, unsigned& nx) {
    const unsigned G = gridDim.x * gridDim.y * gridDim.z;
    unsigned sum, cnt, mine, sp = 0u;
    for (;;) {
        sum = 0u; cnt = 0u; mine = 0u;
#pragma unroll
        for (unsigned j = 0; j < 16; ++j) { const unsigned c = xb_ld(&bar[XB_XCNT(j)]); sum += c; cnt += (c > 0u) ? 1u : 0u; mine = (j == x) ? c : mine; }
        if (sum == G) break;
        __builtin_amdgcn_s_sleep(1);
        if ((++sp & 255u) == 0u) { if (xb_ld(&bar[XB_TMO])) break; if (sp > XB_SPIN_CAP) { atomicAdd(&bar[XB_TMO], 1u); break; } }
    }
    nloc = mine > 0u ? mine : 1u; nx = cnt > 0u ? cnt : 1u;
}

__device__ __forceinline__ void xcd_barrier(const XcdBarrier& b) {
    asm volatile("s_waitcnt vmcnt(0)" ::: "memory");
    __syncthreads();
    if (threadIdx.x == 0) {
        unsigned* bar = b.bar;
        __builtin_amdgcn_s_waitcnt(0);
        unsigned nloc = b.st[0], nx = b.st[1];
        if (nloc == 0u) { xcd_barrier_complete(bar, b.x, nloc, nx); b.st[0] = nloc; b.st[1] = nx; }
        const unsigned old = xb_add(&bar[XB_XSUB(b.x)], 1u);
        const unsigned gen = old / nloc;
        if (old + 1u == (gen + 1u) * nloc) {
            __builtin_amdgcn_fence(__ATOMIC_RELEASE, "agent");
            asm volatile("s_waitcnt vmcnt(0)" ::: "memory");
            const unsigned og = xb_add(&bar[XB_TOP], 1u);
            const unsigned tg = og / nx;
            if (og + 1u == (tg + 1u) * nx) xb_add(&bar[XB_TOPGEN], 1u);
            else XB_SPIN(xb_ld(&bar[XB_TOPGEN]) == tg, bar);
            __builtin_amdgcn_fence(__ATOMIC_ACQUIRE, "agent");
            xb_add(&bar[XB_XGEN(b.x)], 1u);
            asm volatile("s_waitcnt vmcnt(0)" ::: "memory");
        } else {
            XB_SPIN(xb_ld(&bar[XB_XGEN(b.x)]) == gen, bar);
            __builtin_amdgcn_fence(__ATOMIC_ACQUIRE, "agent");
            asm volatile("s_waitcnt vmcnt(0)" ::: "memory");
        }
    }
    __syncthreads();
}

struct Bump { char* p; size_t off; float* f(size_t n) { float* r = (float*)(p + off); off += ((n * 4 + 255) / 256) * 256; return r; } };

static size_t setup_ctx(Ctx& c, void* const* d_in, void* d_out, void* d_ws) {
    using namespace cfg;
    for (int i = 0; i < 51; ++i) c.in[i] = (const float*)d_in[i];
    c.page_table = (const int*)d_in[I_PT];
    c.out = (float*)d_out; c.x = c.out;
    Bump b{(char*)d_ws, 4096 * 4};
    const size_t MD = (size_t)MTOT * D;
    c.xn = b.f(MD); c.vf = b.f(MD);
    const size_t base = b.off;
    for (int p = 0; p < 6; ++p) c.xm[p] = b.f(MD);
    c.r = b.f(MD); c.k = b.f(MD); c.v = b.f(MD); c.wpre = b.f(MD); c.apre = b.f(MD); c.vpre = b.f(MD); c.g = b.f(MD);
    c.hw = b.f((size_t)MTOT * RW_DL); c.ha = b.f((size_t)MTOT * RW_AL); c.hv = b.f((size_t)MTOT * RW_VL); c.hg = b.f((size_t)MTOT * RW_GL);
    c.ka = b.f(MD); c.kb = b.f(MD); c.y = c.xm[0]; c.yo = c.xm[1];
    size_t hi = b.off;
    b.off = base;
    c.mh = b.f((size_t)MTOT * MLA_IN); c.qan = b.f((size_t)MTOT * QL); c.q = b.f((size_t)MTOT * MH * QD); c.c = b.f((size_t)MTOT * KVL); c.kp = b.f((size_t)MTOT * ROPE);
    c.knr = b.f((size_t)MTOT * MH * NOPE); c.vv = b.f((size_t)MTOT * MH * VD); c.ao = b.f((size_t)MTOT * MH * VD);
    c.sc = b.f((size_t)DB * MH * DS * KTOT); c.olat = b.f((size_t)DB * MH * DS * KVL);
    if (b.off > hi) hi = b.off;
    b.off = base;
    c.zx = b.f((size_t)MTOT * MB_IN); c.xbc = b.f((size_t)MTOT * MB_CD); c.dt = b.f((size_t)MTOT * MB_HEADS); c.my = b.f((size_t)MTOT * MB_INNER); c.yzn = b.f((size_t)MTOT * MB_INNER);
    if (b.off > hi) hi = b.off;
    b.off = hi;
    c.hmid = b.f((size_t)MTOT * FFN);
    return b.off;
}

__device__ __forceinline__ unsigned tid_now() { unsigned t = threadIdx.x; asm volatile("" : "+v"(t)); return t; }
namespace pg8 {
#define PG8_LAS __attribute__((address_space(3)))
typedef unsigned short bf16_t;
typedef short bf16x8 __attribute__((ext_vector_type(8)));
typedef float f32x4 __attribute__((ext_vector_type(4)));
typedef float f32x2 __attribute__((ext_vector_type(2)));
typedef unsigned u32x4 __attribute__((ext_vector_type(4)));
typedef unsigned u32x2 __attribute__((ext_vector_type(2)));
constexpr int BM = 256, BK = 64, HALF = 128, HTB = HALF * BK * 2  , STAGE_BYTES = 8 * HTB, NXCD = 8, WGM = 8;

__host__ __device__ __forceinline__ int lds_byte(int r, int c) { const int st = (r >> 4) * 2 + (c >> 5), rr = r & 15, cc = c & 31, ob = rr * 64 + cc * 2; return st * 1024 + (ob ^ (((ob >> 9) & 1) << 5)); }
__host__ __device__ __forceinline__ void stage_rc(int b, int& R, int& C) { const int st = b / 1024, sb = b % 1024, swz = sb ^ (((sb >> 9) & 1) << 5); R = (st >> 1) * 16 + swz / 64; C = (st & 1) * 32 + (swz % 64) / 2; }
__host__ __device__ __forceinline__ int perm32(int rho) { const int n = rho >> 4, i = rho & 15; return 8 * (i >> 2) + 4 * n + (i & 3); }
__device__ __forceinline__ unsigned cvt_pk_bf16(float lo, float hi) { unsigned r; asm volatile("v_cvt_pk_bf16_f32 %0, %1, %2" : "=v"(r) : "v"(lo), "v"(hi)); return r; }

struct Unit { int pm, pn, k0, nt, asel, part; };
struct Gemm { const bf16_t* A; const bf16_t* Bt; int lda, ldb; size_t asel_stride; };

struct NoSel { __device__ static __forceinline__ int sel(int) { return 0; } };
template <class ASEL = NoSel>
struct Order {
    int nMp, nMs, nN, nwgP, nwgS, G, c, K, ksplit;
    __device__ __forceinline__ void init(int nMp_, int nMs_, int nN_, int K_, int ksplit_, int G_, int c_) { nMp = nMp_; nMs = nMs_; nN = nN_; nwgP = nMp * nN; K = K_; ksplit = ksplit_; nwgS = nMs * nN * ksplit; G = G_; c = c_; }
    __device__ __forceinline__ bool next(int i, Unit& u) const {
        const long L = (long)i * G + c;
        if (L < nwgP) {
            int wgid = (int)L; { const int q = nwgP / NXCD, r = nwgP % NXCD, xcd = wgid % NXCD, off = wgid / NXCD; wgid = (xcd < r ? xcd * (q + 1) : r * (q + 1) + (xcd - r) * q) + off; }
            const int nig = WGM * nN, gid = wgid / nig, fm = gid * WGM, gsz = (nMp - fm) < WGM ? (nMp - fm) : WGM;
            u.pm = fm + ((wgid % nig) % gsz); u.pn = (wgid % nig) / gsz; u.k0 = 0; u.nt = K / BK; u.part = 0; u.asel = ASEL::sel(u.pn); return true;
        }
        const long Ls = L - nwgP; if (Ls >= nwgS) return false;
        const int sub = (int)(Ls % ksplit), t = (int)(Ls / ksplit);
        u.pm = nMp + t % nMs; u.pn = t / nMs; u.nt = K / BK / ksplit; u.k0 = sub * u.nt * BK; u.part = ksplit > 1 ? 1 : 0; u.asel = ASEL::sel(u.pn); return true;
    }
};

template <class Epi, class Sched>
__device__ __forceinline__ void gemm_phase(PG8_LAS unsigned char* lds, const Gemm g, const Sched& S, const Epi& E) {
    const int tid = (int)tid_now(), wid = __builtin_amdgcn_readfirstlane(tid >> 6), lane = tid & 63, wr = wid >> 2, wc = wid & 3, fr = lane & 15, fq = lane >> 4;
    unsigned voffA[2], voffB[2];
#pragma unroll
    for (int i = 0; i < 2; ++i) { int R, C; stage_rc(tid * 16 + i * 8192, R, C); const int Rb = Epi::PERM ? ((R & ~31) + perm32(R & 31)) : R;
        voffA[i] = (unsigned)(R * g.lda + C) * 2u; voffB[i] = (unsigned)(Rb * g.ldb + C) * 2u; }
    const size_t kstep = (size_t)(BK * 2);
    const size_t hstepA = (size_t)HALF * g.lda * 2, hstepB = (size_t)HALF * g.ldb * 2;
    const unsigned ldsw = (unsigned)wid * 1024u;
    const int aoff = lds_byte(wr * 64 + fr, fq * 8), boff = lds_byte(wc * 32 + fr, fq * 8);
#define PG8_SA(b, h) (((b) * 2 + (h)) * HTB)
#define PG8_SB(b, h) ((4 + (b) * 2 + (h)) * HTB)
#define PG8_STAGE(bufoff, gbase, voff) do { _Pragma("unroll") for (int _i = 0; _i < 2; ++_i) \
        __builtin_amdgcn_global_load_lds((const unsigned*)((const char*)(gbase) + (voff)[_i]), (PG8_LAS unsigned*)(lds + (bufoff) + ldsw + _i * 8192), 16, 0, 0); } while (0)
#define PG8_LDA(dst, b, h) do { _Pragma("unroll") for (int m = 0; m < 4; ++m) _Pragma("unroll") for (int k = 0; k < 2; ++k) dst[m][k] = *(const PG8_LAS bf16x8*)(lds + PG8_SA(b, h) + aoff + m * 2048 + k * 1024); } while (0)
#define PG8_LDB(dst, b, h) do { _Pragma("unroll") for (int n = 0; n < 2; ++n) _Pragma("unroll") for (int k = 0; k < 2; ++k) dst[n][k] = *(const PG8_LAS bf16x8*)(lds + PG8_SB(b, h) + boff + n * 2048 + k * 1024); } while (0)
#define PG8_MMA(ai, bj, At, Bt) do { __builtin_amdgcn_s_setprio(1); _Pragma("unroll") for (int m = 0; m < 4; ++m) _Pragma("unroll") for (int n = 0; n < 2; ++n) _Pragma("unroll") for (int k = 0; k < 2; ++k) \
        acc[ai][bj][m][n] = __builtin_amdgcn_mfma_f32_16x16x32_bf16(Bt[n][k], At[m][k], acc[ai][bj][m][n], 0, 0, 0); __builtin_amdgcn_s_setprio(0); } while (0)
#define PG8_WAIT_V(n) asm volatile("s_waitcnt vmcnt(" #n ")" ::: "memory")
#define PG8_WAIT_L(n) asm volatile("s_waitcnt lgkmcnt(" #n ")" ::: "memory")
#define PG8_BAR __builtin_amdgcn_s_barrier()
#define PG8_SCHED __builtin_amdgcn_sched_barrier(0)
#define PG8_ABASE(u) ((const char*)g.A + ((size_t)(u).asel * g.asel_stride + (size_t)(u).pm * BM * g.lda + (u).k0) * 2)
#define PG8_BBASE(u) ((const char*)g.Bt + ((size_t)(u).pn * BM * g.ldb + (u).k0) * 2)
    Unit cur, nxt; int ui = 0;
    if (!S.next(0, cur)) return;
    f32x4 acc[2][2][4][2];
#pragma unroll
    for (int a = 0; a < 2; ++a)
#pragma unroll
        for (int b = 0; b < 2; ++b)
#pragma unroll
            for (int m = 0; m < 4; ++m)
#pragma unroll
                for (int n = 0; n < 2; ++n) acc[a][b][m][n] = (f32x4){0.f, 0.f, 0.f, 0.f};
    bf16x8 At[4][2], B0[2][2], B1[2][2];
    const char* cA = PG8_ABASE(cur); const char* cB = PG8_BBASE(cur);
    PG8_STAGE(PG8_SB(0, 0), cB, voffB); PG8_STAGE(PG8_SA(0, 0), cA, voffA); PG8_STAGE(PG8_SB(0, 1), cB + hstepB, voffB); PG8_STAGE(PG8_SA(0, 1), cA + hstepA, voffA);
    if (wr == 1) PG8_BAR;
    PG8_WAIT_V(4); PG8_BAR;
    PG8_STAGE(PG8_SB(1, 0), cB + kstep, voffB); PG8_STAGE(PG8_SA(1, 0), cA + kstep, voffA); PG8_STAGE(PG8_SB(1, 1), cB + hstepB + kstep, voffB);
    PG8_WAIT_V(6); PG8_BAR;
    for (;;) {
        const bool has_next = S.next(ui + 1, nxt);
        const char* nA = has_next ? PG8_ABASE(nxt) : cA; const char* nB = has_next ? PG8_BBASE(nxt) : cB;
        const int nt = cur.nt;
        for (int t = 0; t < nt; t += 2) {
            const bool last = (t == nt - 2);
            const char* a1 = cA + (size_t)(t + 1) * kstep;
            const char* a2 = last ? nA : cA + (size_t)(t + 2) * kstep; const char* b2 = last ? nB : cB + (size_t)(t + 2) * kstep;
            const char* a3 = a2 + kstep; const char* b3 = b2 + kstep;
            PG8_LDB(B0, 0, 0); PG8_SCHED; PG8_LDA(At, 0, 0); PG8_STAGE(PG8_SA(1, 1), a1 + hstepA, voffA);
            PG8_WAIT_L(8); PG8_BAR; PG8_WAIT_L(0); PG8_MMA(0, 0, At, B0); PG8_BAR; PG8_SCHED;
            PG8_LDB(B1, 0, 1); PG8_STAGE(PG8_SB(0, 0), b2, voffB);
            PG8_BAR; PG8_WAIT_L(0); PG8_MMA(0, 1, At, B1); PG8_BAR;
            PG8_LDA(At, 0, 1); PG8_STAGE(PG8_SA(0, 0), a2, voffA);
            PG8_BAR; PG8_WAIT_L(0); PG8_MMA(1, 0, At, B0); PG8_BAR; PG8_SCHED;
            PG8_STAGE(PG8_SB(0, 1), b2 + hstepB, voffB);
            PG8_WAIT_V(6); PG8_BAR; PG8_MMA(1, 1, At, B1); PG8_BAR;
            PG8_LDB(B0, 1, 0); PG8_SCHED; PG8_LDA(At, 1, 0); PG8_STAGE(PG8_SA(0, 1), a2 + hstepA, voffA);
            PG8_WAIT_L(8); PG8_BAR; PG8_WAIT_L(0); PG8_MMA(0, 0, At, B0); PG8_BAR; PG8_SCHED;
            PG8_LDB(B1, 1, 1); PG8_STAGE(PG8_SB(1, 0), b3, voffB);
            PG8_BAR; PG8_WAIT_L(0); PG8_MMA(0, 1, At, B1); PG8_BAR;
            PG8_LDA(At, 1, 1); PG8_STAGE(PG8_SA(1, 0), a3, voffA);
            PG8_BAR; PG8_WAIT_L(0); PG8_MMA(1, 0, At, B0); PG8_BAR; PG8_SCHED;
            PG8_STAGE(PG8_SB(1, 1), b3 + hstepB, voffB);
            PG8_WAIT_V(6); PG8_BAR; PG8_MMA(1, 1, At, B1); PG8_BAR;
        }
        E(acc, cur, wr, wc, fr, fq);
        if (!has_next) break;
#pragma unroll
        for (int a = 0; a < 2; ++a)
#pragma unroll
            for (int b = 0; b < 2; ++b)
#pragma unroll
                for (int m = 0; m < 4; ++m)
#pragma unroll
                    for (int n = 0; n < 2; ++n) acc[a][b][m][n] = (f32x4){0.f, 0.f, 0.f, 0.f};
        cur = nxt; cA = nA; cB = nB; ++ui;
    }
    PG8_WAIT_V(0);
    if (wr == 0) PG8_BAR;
    PG8_BAR;
#undef PG8_SA
#undef PG8_SB
#undef PG8_STAGE
#undef PG8_LDA
#undef PG8_LDB
#undef PG8_MMA
#undef PG8_WAIT_V
#undef PG8_WAIT_L
#undef PG8_BAR
#undef PG8_SCHED
#undef PG8_ABASE
#undef PG8_BBASE
}

struct EpiAccF32 {
    static constexpr bool PERM = false;
    float* C; int ldc; float* slab; int pm0, nMs, ksplit;
    __device__ __forceinline__ void operator()(const f32x4 (&acc)[2][2][4][2], const Unit& u, int wr, int wc, int fr, int fq) const {
        if (u.part) {
            float* sl = slab + ((size_t)((u.pn * nMs + (u.pm - pm0)) * ksplit + u.k0 / (u.nt * BK)) * BM + wr * 64 + fr) * BM + wc * 32 + 4 * fq;
#pragma unroll
            for (int ai = 0; ai < 2; ++ai)
#pragma unroll
                for (int m = 0; m < 4; ++m) { float* rowp = sl + (size_t)(ai * HALF + m * 16) * BM;
#pragma unroll
                    for (int bj = 0; bj < 2; ++bj)
#pragma unroll
                        for (int n = 0; n < 2; ++n) *(f32x4*)(rowp + bj * HALF + n * 16) = acc[ai][bj][m][n]; }
        } else {
            const int row0 = u.pm * BM + wr * 64 + fr, col0 = u.pn * BM + wc * 32 + 4 * fq;
#pragma unroll
            for (int ai = 0; ai < 2; ++ai)
#pragma unroll
                for (int m2 = 0; m2 < 4; m2 += 2) {
                    f32x4 t[2][2][2];
#pragma unroll
                    for (int mm = 0; mm < 2; ++mm) { const float* rowp = C + (size_t)(row0 + ai * HALF + (m2 + mm) * 16) * ldc + col0;
#pragma unroll
                        for (int bj = 0; bj < 2; ++bj)
#pragma unroll
                            for (int n = 0; n < 2; ++n) t[mm][bj][n] = *(const f32x4*)(rowp + bj * HALF + n * 16); }
#pragma unroll
                    for (int mm = 0; mm < 2; ++mm) { float* rowp = C + (size_t)(row0 + ai * HALF + (m2 + mm) * 16) * ldc + col0;
#pragma unroll
                        for (int bj = 0; bj < 2; ++bj)
#pragma unroll
                            for (int n = 0; n < 2; ++n) *(f32x4*)(rowp + bj * HALF + n * 16) = t[mm][bj][n] + acc[ai][bj][m2 + mm][n]; }
                }
        }
    }
};
struct EpiF32 {
    static constexpr bool PERM = false;
    float* C; int ldc; int ncols;
    __device__ __forceinline__ void operator()(const f32x4 (&acc)[2][2][4][2], const Unit& u, int wr, int wc, int fr, int fq) const {
        const int row0 = u.pm * BM + wr * 64 + fr, col0 = u.pn * BM + wc * 32 + 4 * fq;
#pragma unroll
        for (int ai = 0; ai < 2; ++ai)
#pragma unroll
            for (int m = 0; m < 4; ++m) { float* rowp = C + (size_t)(row0 + ai * HALF + m * 16) * ldc + col0;
#pragma unroll
                for (int bj = 0; bj < 2; ++bj)
#pragma unroll
                    for (int n = 0; n < 2; ++n) if (col0 + bj * HALF + n * 16 < ncols) *(f32x4*)(rowp + bj * HALF + n * 16) = acc[ai][bj][m][n]; }
    }
};
template <int ACT> struct EpiBf16 {
    static constexpr bool PERM = true;
    bf16_t* O; int ldc;
    __device__ __forceinline__ void operator()(const f32x4 (&acc)[2][2][4][2], const Unit& u, int wr, int wc, int fr, int fq) const {
        const int row0 = u.pm * BM + wr * 64 + fr, col0 = u.pn * BM + wc * 32 + 8 * fq;
#pragma unroll
        for (int ai = 0; ai < 2; ++ai)
#pragma unroll
            for (int m = 0; m < 4; ++m) { bf16_t* rowp = O + (size_t)(row0 + ai * HALF + m * 16) * ldc + col0;
#pragma unroll
                for (int bj = 0; bj < 2; ++bj) { f32x4 v0 = acc[ai][bj][m][0], v1 = acc[ai][bj][m][1];
                    if (ACT == 3) {
#pragma unroll
                        for (int j = 0; j < 4; ++j) { const float a = fmaxf(v0[j], 0.f), b = fmaxf(v1[j], 0.f); v0[j] = a * a; v1[j] = b * b; } }
                    u32x4 w; w.x = cvt_pk_bf16(v0[0], v0[1]); w.y = cvt_pk_bf16(v0[2], v0[3]); w.z = cvt_pk_bf16(v1[0], v1[1]); w.w = cvt_pk_bf16(v1[2], v1[3]);
                    *(u32x4*)(rowp + bj * HALF) = w; } }
    }
};
}
typedef pg8::bf16_t bf16_t;
#define LDSP __attribute__((address_space(3)))
struct Fast {
    bf16_t *xnb, *hmidb;
    bf16_t *w1t, *w2t;
    float* slab;
};
__device__ __forceinline__ unsigned pk2bf(float lo, float hi) { return pg8::cvt_pk_bf16(lo, hi); }
__device__ __forceinline__ float wave_sum64(float v) {
#pragma unroll
    for (int o = 1; o < 64; o <<= 1) v += __shfl_xor(v, o);
    return v;
}
__device__ __forceinline__ void red16x4(float& a, float& b, float& c, float& d) {
    asm volatile("s_nop 1\n"
        "v_add_f32_dpp %0, %0, %0 quad_perm:[1,0,3,2] row_mask:0xf bank_mask:0xf\n" "v_add_f32_dpp %1, %1, %1 quad_perm:[1,0,3,2] row_mask:0xf bank_mask:0xf\n"
        "v_add_f32_dpp %2, %2, %2 quad_perm:[1,0,3,2] row_mask:0xf bank_mask:0xf\n" "v_add_f32_dpp %3, %3, %3 quad_perm:[1,0,3,2] row_mask:0xf bank_mask:0xf\n"
        "v_add_f32_dpp %0, %0, %0 quad_perm:[2,3,0,1] row_mask:0xf bank_mask:0xf\n" "v_add_f32_dpp %1, %1, %1 quad_perm:[2,3,0,1] row_mask:0xf bank_mask:0xf\n"
        "v_add_f32_dpp %2, %2, %2 quad_perm:[2,3,0,1] row_mask:0xf bank_mask:0xf\n" "v_add_f32_dpp %3, %3, %3 quad_perm:[2,3,0,1] row_mask:0xf bank_mask:0xf\n"
        "v_add_f32_dpp %0, %0, %0 row_ror:4 row_mask:0xf bank_mask:0xf\n" "v_add_f32_dpp %1, %1, %1 row_ror:4 row_mask:0xf bank_mask:0xf\n"
        "v_add_f32_dpp %2, %2, %2 row_ror:4 row_mask:0xf bank_mask:0xf\n" "v_add_f32_dpp %3, %3, %3 row_ror:4 row_mask:0xf bank_mask:0xf\n"
        "v_add_f32_dpp %0, %0, %0 row_ror:8 row_mask:0xf bank_mask:0xf\n" "v_add_f32_dpp %1, %1, %1 row_ror:8 row_mask:0xf bank_mask:0xf\n"
        "v_add_f32_dpp %2, %2, %2 row_ror:8 row_mask:0xf bank_mask:0xf\n" "v_add_f32_dpp %3, %3, %3 row_ror:8 row_mask:0xf bank_mask:0xf\n"
        "s_nop 1"
        : "+v"(a), "+v"(b), "+v"(c), "+v"(d));
}
__device__ __forceinline__ void tr_item(const float* __restrict__ W, int ldw, int K, bf16_t* WT, int nvalid, const float* __restrict__ kscale, LDSP float* scr, int item, int nblk, int lane) {
    const int kb = item / nblk, nb = item % nblk, k0 = 64 * kb, n0 = 32 * nb;
    const bool ok = n0 < nvalid;
#pragma unroll
    for (int i = 0; i < 8; ++i) { const int kk = 8 * i + (lane >> 3), nn = 4 * (lane & 7); pg8::f32x4 v = ok ? *(const pg8::f32x4*)(W + (size_t)(k0 + kk) * ldw + n0 + nn) : (pg8::f32x4){0.f, 0.f, 0.f, 0.f};
        if (kscale) v = v * kscale[k0 + kk];
        scr[kk * 33 + nn] = v[0]; scr[kk * 33 + nn + 1] = v[1]; scr[kk * 33 + nn + 2] = v[2]; scr[kk * 33 + nn + 3] = v[3]; }
    asm volatile("s_waitcnt lgkmcnt(0)" ::: "memory");
    const int c = lane & 7;
#pragma unroll
    for (int j = 0; j < 4; ++j) { const int n = (lane >> 3) + 8 * j; const LDSP float* s = scr + (8 * c) * 33 + n;
        pg8::u32x4 o; o.x = pk2bf(s[0 * 33], s[1 * 33]); o.y = pk2bf(s[2 * 33], s[3 * 33]); o.z = pk2bf(s[4 * 33], s[5 * 33]); o.w = pk2bf(s[6 * 33], s[7 * 33]);
        *(pg8::u32x4*)(WT + (size_t)(n0 + n) * K + k0 + 8 * c) = o; }
    asm volatile("s_waitcnt lgkmcnt(0)" ::: "memory");
}
__device__ __forceinline__ void tr_weight(const float* W, int K, int N, int npad, bf16_t* WT, const float* kscale, LDSP float* scr, int gw, int ngw, int lane) {
    const int nblk = npad / 32, items = (K / 64) * nblk;
    for (int it = gw; it < items; it += ngw) tr_item(W, N, K, WT, N, kscale, scr, it, nblk, lane);
}
constexpr int TRJ_W = 12;
struct TrTab { LDSP int* t; int n; int total; };
__device__ __forceinline__ void trj_put(TrTab& tb, const float* W, int K, int N, int npad, bf16_t* WT) {
    LDSP int* e = tb.t + tb.n * TRJ_W; const unsigned long long w = (unsigned long long)(size_t)W, o = (unsigned long long)(size_t)WT;
    const int nblk = npad / 32, items = (K / 64) * nblk;
    e[0] = (int)(unsigned)w; e[1] = (int)(unsigned)(w >> 32); e[2] = (int)(unsigned)o; e[3] = (int)(unsigned)(o >> 32); e[4] = N; e[5] = K; e[6] = N; e[7] = nblk; e[8] = tb.total; e[9] = tb.total + items;
    tb.total += items; ++tb.n;
}
struct TrCur { bf16_t* wt; int K, k0, n0; };
__device__ __forceinline__ bool trj_issue(LDSP const int* tab, int njobs, int idx, int& j, pg8::f32x4 (&v)[8], TrCur& t, int lane) {
    while (j < njobs && idx >= __builtin_amdgcn_readfirstlane(tab[j * TRJ_W + 9])) ++j;
    if (j >= njobs) return false;
    LDSP const int* e = tab + j * TRJ_W;
    const unsigned wl = __builtin_amdgcn_readfirstlane(e[0]), wh = __builtin_amdgcn_readfirstlane(e[1]), ol = __builtin_amdgcn_readfirstlane(e[2]), oh = __builtin_amdgcn_readfirstlane(e[3]);
    const int ldw = __builtin_amdgcn_readfirstlane(e[4]), K = __builtin_amdgcn_readfirstlane(e[5]), nvalid = __builtin_amdgcn_readfirstlane(e[6]), nblk = __builtin_amdgcn_readfirstlane(e[7]), it = idx - __builtin_amdgcn_readfirstlane(e[8]);
    const float* W = (const float*)(size_t)(((unsigned long long)wh << 32) | wl);
    const int kb = it / nblk, nb = it - kb * nblk, k0 = 64 * kb, n0 = 32 * nb;
    t.wt = (bf16_t*)(size_t)(((unsigned long long)oh << 32) | ol); t.K = K; t.k0 = k0; t.n0 = n0;
    const bool ok = n0 < nvalid;
#pragma unroll
    for (int i = 0; i < 8; ++i) { const int kk = 8 * i + (lane >> 3), nn = 4 * (lane & 7); v[i] = ok ? *(const pg8::f32x4*)(W + (size_t)(k0 + kk) * ldw + n0 + nn) : (pg8::f32x4){0.f, 0.f, 0.f, 0.f}; }
    return true;
}
__device__ __forceinline__ void trj_finish(const pg8::f32x4 (&v)[8], const TrCur& t, LDSP float* scr, int lane) {
#pragma unroll
    for (int i = 0; i < 8; ++i) { const int kk = 8 * i + (lane >> 3), nn = 4 * (lane & 7);
        scr[kk * 33 + nn] = v[i][0]; scr[kk * 33 + nn + 1] = v[i][1]; scr[kk * 33 + nn + 2] = v[i][2]; scr[kk * 33 + nn + 3] = v[i][3]; }
    asm volatile("s_waitcnt lgkmcnt(0)" ::: "memory");
    const int c = lane & 7;
#pragma unroll
    for (int j = 0; j < 4; ++j) { const int n = (lane >> 3) + 8 * j; const LDSP float* s = scr + (8 * c) * 33 + n;
        pg8::u32x4 o; o.x = pk2bf(s[0 * 33], s[1 * 33]); o.y = pk2bf(s[2 * 33], s[3 * 33]); o.z = pk2bf(s[4 * 33], s[5 * 33]); o.w = pk2bf(s[6 * 33], s[7 * 33]);
        *(pg8::u32x4*)(t.wt + (size_t)(t.n0 + n) * t.K + t.k0 + 8 * c) = o; }
    asm volatile("s_waitcnt lgkmcnt(0)" ::: "memory");
}
__device__ __forceinline__ void trj_run(LDSP const int* tab, int njobs, int total, LDSP float* scr, int gw, int ngw, int lane) {
    int j = 0; pg8::f32x4 va[8], vb[8]; TrCur ta, tb;
    int idx = gw;
    bool have = idx < total && trj_issue(tab, njobs, idx, j, va, ta, lane);
    while (have) {
        idx += ngw; const bool hb = idx < total && trj_issue(tab, njobs, idx, j, vb, tb, lane);
        trj_finish(va, ta, scr, lane);
        if (!hb) break;
        idx += ngw; have = idx < total && trj_issue(tab, njobs, idx, j, va, ta, lane);
        trj_finish(vb, tb, scr, lane);
    }
}
__device__ __forceinline__ pg8::f32x4 slab_sum(const float* __restrict__ slab, int ksplit, int m, int q, int lane) {
    using namespace cfg; const int rs = m - MP, pms = rs >> 8, row = rs & 255;
    const float* p = slab + ((size_t)((q * (MS / 256) + pms) * ksplit) * 256 + row) * 256 + 4 * lane;
    pg8::f32x4 s = {0.f, 0.f, 0.f, 0.f};
    for (int k = 0; k < ksplit; ++k) s = s + *(const pg8::f32x4*)(p + (size_t)k * 65536);
    return s;
}
__device__ __forceinline__ void norm_rows_bf16(float* __restrict__ x, const float* __restrict__ gain, bf16_t* xn, const float* __restrict__ slab, int ksplit, int gw, int ngw, int lane) {
    using namespace cfg;
    pg8::f32x4 gv[4];
#pragma unroll
    for (int j = 0; j < 4; ++j) gv[j] = *(const pg8::f32x4*)(gain + 4 * lane + 256 * j);
    for (int m = gw; m < MTOT; m += ngw) {
        float* xr = x + (size_t)m * D; pg8::f32x4 v[4]; float s = 0.f;
#pragma unroll
        for (int j = 0; j < 4; ++j) { v[j] = *(const pg8::f32x4*)(xr + 4 * lane + 256 * j);
            if (ksplit > 1 && m >= MP) { v[j] = v[j] + slab_sum(slab, ksplit, m, j, lane); *(pg8::f32x4*)(xr + 4 * lane + 256 * j) = v[j]; }
            s += (v[j][0] * v[j][0] + v[j][1] * v[j][1]) + (v[j][2] * v[j][2] + v[j][3] * v[j][3]); }
        const float rs = 1.0f / sqrtf(wave_sum64(s) * (1.0f / D) + NORM_EPS);
#pragma unroll
        for (int j = 0; j < 4; ++j) { pg8::u32x2 o; o.x = pk2bf(v[j][0] * rs * gv[j][0], v[j][1] * rs * gv[j][1]); o.y = pk2bf(v[j][2] * rs * gv[j][2], v[j][3] * rs * gv[j][3]);
            *(pg8::u32x2*)(xn + (size_t)m * D + 4 * lane + 256 * j) = o; }
    }
}

__device__ __forceinline__ void fold_sample_rows(float* __restrict__ x, const float* __restrict__ slab, int ksplit, int gw, int ngw, int lane) {
    using namespace cfg;
    for (int m = MP + gw; m < MTOT; m += ngw) {
#pragma unroll
        for (int j = 0; j < 4; ++j) { float* p = x + (size_t)m * D + 4 * lane + 256 * j; *(pg8::f32x4*)p = *(const pg8::f32x4*)p + slab_sum(slab, ksplit, m, j, lane); }
    }
}
struct FastMla {
    float* mh;
    bf16_t *qan, *cb, *kpb;
    bf16_t *qraw, *kvraw;
    bf16_t *qf, *knb, *aob, *vT, *qs;
    float *opart, *lpart;
    bf16_t *wint, *wuqt, *wukvt, *wot;
};
__device__ __forceinline__ void rope_cs(int pos, int i, float& cs, float& sn) {
    const float inv = exp2f(-(float)i * (13.287712379549449f / 16.0f));
    const float ang = (float)pos * inv, kq = rintf(ang * 0.15915494309189535f);
    float rr = fmaf(-kq, 6.28125f, ang); rr = fmaf(-kq, 1.9353071795864769e-3f, rr);
    cs = __cosf(rr); sn = __sinf(rr);
}
__device__ __forceinline__ float bf2f(unsigned short b) { return __uint_as_float(((unsigned)b) << 16); }
__device__ __forceinline__ void mla_norm1_fast(const Ctx& c, const FastMla& fm, int j, int gw, int ngw, int lane) {
    using namespace cfg;
    for (int m = gw; m < MTOT; m += ngw) {
        const float* h = fm.mh + (size_t)m * 1024;
        pg8::f32x4 qv[2]; float s = 0.f;
#pragma unroll
        for (int t = 0; t < 2; ++t) { qv[t] = *(const pg8::f32x4*)(h + 4 * lane + 256 * t); s += (qv[t][0] * qv[t][0] + qv[t][1] * qv[t][1]) + (qv[t][2] * qv[t][2] + qv[t][3] * qv[t][3]); }
        const float rq = 1.0f / sqrtf(wave_sum64(s) * (1.0f / QL) + NORM_EPS);
#pragma unroll
        for (int t = 0; t < 2; ++t) { const pg8::f32x4 g = *(const pg8::f32x4*)(c.in[I_QNORM] + j * QL + 4 * lane + 256 * t);
            pg8::u32x2 o; o.x = pk2bf(qv[t][0] * rq * g[0], qv[t][1] * rq * g[1]); o.y = pk2bf(qv[t][2] * rq * g[2], qv[t][3] * rq * g[3]);
            *(pg8::u32x2*)(fm.qan + (size_t)m * QL + 4 * lane + 256 * t) = o; }
        const pg8::f32x4 cv = *(const pg8::f32x4*)(h + QL + 4 * lane);
        const float rc = 1.0f / sqrtf(wave_sum64((cv[0] * cv[0] + cv[1] * cv[1]) + (cv[2] * cv[2] + cv[3] * cv[3])) * (1.0f / KVL) + NORM_EPS);
        const pg8::f32x4 gc = *(const pg8::f32x4*)(c.in[I_KVNORM] + j * KVL + 4 * lane);
        const pg8::f32x4 cn = {cv[0] * rc * gc[0], cv[1] * rc * gc[1], cv[2] * rc * gc[2], cv[3] * rc * gc[3]};
        float* co = m < MP ? c.out + O_CKVP + ((size_t)j * MP + m) * KVL : c.out + O_CKVS + ((size_t)j * MS + (m - MP)) * KVL;
        *(pg8::f32x4*)(co + 4 * lane) = cn; *(pg8::f32x4*)(c.c + (size_t)m * KVL + 4 * lane) = cn;
        { pg8::u32x2 o; o.x = pk2bf(cn[0], cn[1]); o.y = pk2bf(cn[2], cn[3]); *(pg8::u32x2*)(fm.cb + (size_t)m * KVL + 4 * lane) = o; }
        const float kv = lane < ROPE ? h[QL + KVL + lane] : 0.f;
        const float rk = 1.0f / sqrtf(wave_sum64(kv * kv) * (1.0f / ROPE) + NORM_EPS);
        const float kn = kv * rk * (lane < ROPE ? c.in[I_KRN][j * ROPE + lane] : 0.f);
        const float other = __shfl_xor(kn, 16);
        float cs, sn; rope_cs(row_pos(m), lane & 15, cs, sn);
        const float ro = lane < 16 ? kn * cs - other * sn : kn * cs + other * sn;
        if (lane < ROPE) {
            float* ko = m < MP ? c.out + O_KPEP + ((size_t)j * MP + m) * ROPE : c.out + O_KPES + ((size_t)j * MS + (m - MP)) * ROPE;
            ko[lane] = ro; c.kp[(size_t)m * ROPE + lane] = ro;
            fm.kpb[(size_t)m * ROPE + lane] = (bf16_t)(pk2bf(ro, 0.f) & 0xffffu);
        }
    }
}
__device__ __forceinline__ void mla_norm2_fast(const Ctx& c, const FastMla& fm, int j, int gw, int ngw, int lane) {
    using namespace cfg;
    const int hd = lane >> 2, qt = lane & 3;
    const float QSC = 0.10206207261596575f * 1.4426950408889634f;
    for (int m = gw; m < MTOT; m += ngw) {
        const bf16_t* qr = fm.qraw + (size_t)m * (MH * QD) + hd * QD;
        float v[16]; float s = 0.f;
        { const pg8::u32x4 a = *(const pg8::u32x4*)(qr + 16 * qt), b = *(const pg8::u32x4*)(qr + 16 * qt + 8); const unsigned w[8] = {a.x, a.y, a.z, a.w, b.x, b.y, b.z, b.w};
#pragma unroll
          for (int i = 0; i < 8; ++i) { v[2 * i] = __uint_as_float(w[i] << 16); v[2 * i + 1] = __uint_as_float(w[i] & 0xffff0000u); } }
#pragma unroll
        for (int i = 0; i < 16; ++i) s += v[i] * v[i];
        s += __shfl_xor(s, 1); s += __shfl_xor(s, 2);
        float rs = 1.0f / sqrtf(s * (1.0f / NOPE) + NORM_EPS);
        bf16_t* qo = fm.qf + (size_t)m * (MH * QD) + hd * QD; float* qo32 = c.q + (size_t)m * (MH * QD) + hd * QD;
        { unsigned w[8], w2[8];
#pragma unroll
          for (int i = 0; i < 8; ++i) { const float a = v[2 * i] * rs * c.in[I_QNN][j * NOPE + 16 * qt + 2 * i], b = v[2 * i + 1] * rs * c.in[I_QNN][j * NOPE + 16 * qt + 2 * i + 1];
              w[i] = pk2bf(a * QSC, b * QSC); qo32[16 * qt + 2 * i] = a; qo32[16 * qt + 2 * i + 1] = b;
              w2[i] = pk2bf(a * QSC * c.in[I_KNN][j * NOPE + 16 * qt + 2 * i], b * QSC * c.in[I_KNN][j * NOPE + 16 * qt + 2 * i + 1]); }
          *(pg8::u32x4*)(qo + 16 * qt) = (pg8::u32x4){w[0], w[1], w[2], w[3]}; *(pg8::u32x4*)(qo + 16 * qt + 8) = (pg8::u32x4){w[4], w[5], w[6], w[7]};
          if (m >= MP) { bf16_t* q2 = fm.qs + ((size_t)(((m - MP) >> 3) * MH + hd) * 6 + qt) * 128 + ((m - MP) & 7) * 8;
              *(pg8::u32x4*)(q2) = (pg8::u32x4){w2[0], w2[1], w2[4], w2[5]}; *(pg8::u32x4*)(q2 + 64) = (pg8::u32x4){w2[2], w2[3], w2[6], w2[7]}; } }
        float r8[8]; s = 0.f;
        { const pg8::u32x4 a = *(const pg8::u32x4*)(qr + NOPE + 8 * qt); const unsigned w[4] = {a.x, a.y, a.z, a.w};
#pragma unroll
          for (int i = 0; i < 4; ++i) { r8[2 * i] = __uint_as_float(w[i] << 16); r8[2 * i + 1] = __uint_as_float(w[i] & 0xffff0000u); } }
#pragma unroll
        for (int i = 0; i < 8; ++i) s += r8[i] * r8[i];
        s += __shfl_xor(s, 1); s += __shfl_xor(s, 2);
        rs = 1.0f / sqrtf(s * (1.0f / ROPE) + NORM_EPS);
        { unsigned w[4]; float o8[8];
#pragma unroll
          for (int i = 0; i < 8; ++i) { const float mine = r8[i] * rs * c.in[I_QRN][j * ROPE + 8 * qt + i]; const float oth = __shfl_xor(mine, 2);
              float cs, sn; rope_cs(row_pos(m), (8 * qt + i) & 15, cs, sn);
              o8[i] = qt < 2 ? mine * cs - oth * sn : mine * cs + oth * sn; qo32[NOPE + 8 * qt + i] = o8[i]; }
#pragma unroll
          for (int i = 0; i < 4; ++i) w[i] = pk2bf(o8[2 * i] * QSC, o8[2 * i + 1] * QSC);
          *(pg8::u32x4*)(qo + NOPE + 8 * qt) = (pg8::u32x4){w[0], w[1], w[2], w[3]};
          if (m >= MP) *(pg8::u32x4*)(fm.qs + ((size_t)(((m - MP) >> 3) * MH + hd) * 6 + 4 + (qt >> 1)) * 128 + (qt & 1) * 64 + ((m - MP) & 7) * 8) = (pg8::u32x4){w[0], w[1], w[2], w[3]}; }
        const bf16_t* kr = fm.kvraw + (size_t)m * 2048 + hd * NOPE; s = 0.f;
        { const pg8::u32x4 a = *(const pg8::u32x4*)(kr + 16 * qt), b = *(const pg8::u32x4*)(kr + 16 * qt + 8); const unsigned w[8] = {a.x, a.y, a.z, a.w, b.x, b.y, b.z, b.w};
#pragma unroll
          for (int i = 0; i < 8; ++i) { v[2 * i] = __uint_as_float(w[i] << 16); v[2 * i + 1] = __uint_as_float(w[i] & 0xffff0000u); } }
#pragma unroll
        for (int i = 0; i < 16; ++i) s += v[i] * v[i];
        s += __shfl_xor(s, 1); s += __shfl_xor(s, 2);
        rs = 1.0f / sqrtf(s * (1.0f / NOPE) + NORM_EPS);
        bf16_t* ko = fm.knb + (size_t)m * (MH * NOPE) + hd * NOPE;
        { unsigned w[8];
#pragma unroll
          for (int i = 0; i < 8; ++i) { const float a = v[2 * i] * rs * c.in[I_KNN][j * NOPE + 16 * qt + 2 * i], b = v[2 * i + 1] * rs * c.in[I_KNN][j * NOPE + 16 * qt + 2 * i + 1];
              w[i] = pk2bf(a, b); }
          *(pg8::u32x4*)(ko + 16 * qt) = (pg8::u32x4){w[0], w[1], w[2], w[3]}; *(pg8::u32x4*)(ko + 16 * qt + 8) = (pg8::u32x4){w[4], w[5], w[6], w[7]}; }
    }
}
__device__ __forceinline__ void cvt_f32_bf16(const float* __restrict__ s, bf16_t* d, size_t n, size_t gtid, size_t gsz) {
    for (size_t i = gtid * 4; i < n; i += gsz * 4) { const pg8::f32x4 v = *(const pg8::f32x4*)(s + i); pg8::u32x2 o; o.x = pk2bf(v[0], v[1]); o.y = pk2bf(v[2], v[3]); *(pg8::u32x2*)(d + i) = o; }
}
typedef float f32x16_t __attribute__((ext_vector_type(16)));
typedef pg8::bf16x8 bf16x8v;
constexpr int AT_KROW = 208, AT_VROW = 136, AT_KBUF = 64 * AT_KROW, AT_VBUF = 64 * AT_VROW, AT_LDS = 2 * AT_KBUF + 2 * AT_VBUF;
__device__ __forceinline__ void attn_prompt_fast(const bf16_t* __restrict__ qf, const bf16_t* __restrict__ knb, const bf16_t* __restrict__ kpb, const bf16_t* __restrict__ vT, bf16_t* aob, LDSP unsigned char* lds) {
    using namespace cfg;
    const int tid = (int)tid_now(), w = __builtin_amdgcn_readfirstlane(tid >> 6), lane = tid & 63, l31 = lane & 31, h5 = lane >> 5;
    for (int it = blockIdx.x; it < BATCH * MH * 4; it += gridDim.x) {
        const int bh = it >> 2, pr = it & 3, b = bh / MH, h = bh % MH;
        for (int half = 0; half < 2; ++half) {
            const int qb = half ? 7 - pr : pr, q0 = 256 * qb, nt = 4 * qb + 4;
            const int qg = q0 + 32 * w + l31;
            const size_t mrow = (size_t)b * SEQ + qg;
            bf16x8v qfr[6];
#pragma unroll
            for (int s = 0; s < 6; ++s) qfr[s] = *(const bf16x8v*)(qf + mrow * (MH * QD) + h * QD + 16 * s + 8 * h5);
            f32x16_t O[2];
#pragma unroll
            for (int db = 0; db < 2; ++db)
#pragma unroll
                for (int r = 0; r < 16; ++r) O[db][r] = 0.f;
            float mrun = -1e30f, lrun = 0.f;
            pg8::u32x4 rk, rp, rv;
            const int kkey = tid >> 3, kc8 = tid & 7, pkey = tid >> 2, pc4 = tid & 3;
#define AT_LOAD(t) do { const size_t mk = (size_t)b * SEQ + 64 * (t); \
                rk = *(const pg8::u32x4*)(knb + (mk + kkey) * (MH * NOPE) + h * NOPE + kc8 * 8); \
                if (tid < 256) rp = *(const pg8::u32x4*)(kpb + (mk + pkey) * ROPE + pc4 * 8); \
                rv = *(const pg8::u32x4*)(vT + (size_t)(h * VD + kkey) * MTOT + mk + kc8 * 8); } while (0)
#define AT_STORE(buf) do { LDSP unsigned char* kb_ = lds + (buf) * AT_KBUF; LDSP unsigned char* vb_ = lds + 2 * AT_KBUF + (buf) * AT_VBUF; \
                *(LDSP pg8::u32x4*)(kb_ + kkey * AT_KROW + kc8 * 16) = rk; \
                if (tid < 256) *(LDSP pg8::u32x4*)(kb_ + pkey * AT_KROW + 128 + pc4 * 16) = rp; \
                *(LDSP pg8::u32x2*)(vb_ + kkey * AT_VROW + kc8 * 16) = (pg8::u32x2){rv.x, rv.y}; *(LDSP pg8::u32x2*)(vb_ + kkey * AT_VROW + kc8 * 16 + 8) = (pg8::u32x2){rv.z, rv.w}; } while (0)
            AT_LOAD(0); AT_STORE(0);
            __syncthreads();
            for (int t = 0; t < nt; ++t) {
                if (t + 1 < nt) AT_LOAD(t + 1);
                if (64 * t <= q0 + 32 * w + 31) {
                    const LDSP unsigned char* kb_ = lds + (t & 1) * AT_KBUF; const LDSP unsigned char* vb_ = lds + 2 * AT_KBUF + (t & 1) * AT_VBUF;
                    f32x16_t S[2];
#pragma unroll
                    for (int kb = 0; kb < 2; ++kb)
#pragma unroll
                        for (int r = 0; r < 16; ++r) S[kb][r] = 0.f;
#pragma unroll
                    for (int s = 0; s < 6; ++s)
#pragma unroll
                        for (int kb = 0; kb < 2; ++kb) {
                            const bf16x8v a = *(const LDSP bf16x8v*)(kb_ + (32 * kb + l31) * AT_KROW + (16 * s + 8 * h5) * 2);
                            S[kb] = __builtin_amdgcn_mfma_f32_32x32x16_bf16(a, qfr[s], S[kb], 0, 0, 0);
                        }
                    if (64 * t + 63 > q0 + 32 * w) {
#pragma unroll
                        for (int kb = 0; kb < 2; ++kb)
#pragma unroll
                            for (int r = 0; r < 16; ++r) { const int key = 64 * t + 32 * kb + (r & 3) + 8 * (r >> 2) + 4 * h5; if (key > qg) S[kb][r] = -1e30f; }
                    }
                    float mt = -1e30f;
#pragma unroll
                    for (int kb = 0; kb < 2; ++kb)
#pragma unroll
                        for (int r = 0; r < 16; ++r) mt = fmaxf(mt, S[kb][r]);
                    mt = fmaxf(mt, __shfl_xor(mt, 32));
                    const float mnew = fmaxf(mrun, mt), alpha = exp2f(mrun - mnew);
                    float ls = 0.f;
#pragma unroll
                    for (int kb = 0; kb < 2; ++kb)
#pragma unroll
                        for (int r = 0; r < 16; ++r) { const float p = exp2f(S[kb][r] - mnew); S[kb][r] = p; ls += p; }
                    lrun = lrun * alpha + ls; mrun = mnew;
#pragma unroll
                    for (int db = 0; db < 2; ++db)
#pragma unroll
                        for (int r = 0; r < 16; ++r) O[db][r] *= alpha;
#pragma unroll
                    for (int kb = 0; kb < 2; ++kb)
#pragma unroll
                        for (int s = 0; s < 2; ++s) {
                            pg8::u32x4 pw; pw.x = pk2bf(S[kb][8 * s + 0], S[kb][8 * s + 1]); pw.y = pk2bf(S[kb][8 * s + 2], S[kb][8 * s + 3]); pw.z = pk2bf(S[kb][8 * s + 4], S[kb][8 * s + 5]); pw.w = pk2bf(S[kb][8 * s + 6], S[kb][8 * s + 7]);
                            const bf16x8v pf = __builtin_bit_cast(bf16x8v, pw);
#pragma unroll
                            for (int db = 0; db < 2; ++db) {
                                const LDSP unsigned char* vp = vb_ + (32 * db + l31) * AT_VROW + (32 * kb + 16 * s + 4 * h5) * 2;
                                const pg8::u32x2 v0 = *(const LDSP pg8::u32x2*)vp, v1 = *(const LDSP pg8::u32x2*)(vp + 16);
                                const bf16x8v a = __builtin_bit_cast(bf16x8v, (pg8::u32x4){v0.x, v0.y, v1.x, v1.y});
                                O[db] = __builtin_amdgcn_mfma_f32_32x32x16_bf16(a, pf, O[db], 0, 0, 0);
                            }
                        }
                }
                if (t + 1 < nt) AT_STORE((t + 1) & 1);
                __syncthreads();
            }
#undef AT_LOAD
#undef AT_STORE
            const float inv = 1.0f / (lrun + __shfl_xor(lrun, 32));
            bf16_t* orow = aob + mrow * (MH * VD) + h * VD;
#pragma unroll
            for (int db = 0; db < 2; ++db)
#pragma unroll
                for (int g = 0; g < 4; ++g) { pg8::u32x2 o; o.x = pk2bf(O[db][4 * g] * inv, O[db][4 * g + 1] * inv); o.y = pk2bf(O[db][4 * g + 2] * inv, O[db][4 * g + 3] * inv);
                    *(pg8::u32x2*)(orow + 32 * db + 8 * g + 4 * h5) = o; }
        }
    }
}
constexpr int SD_CROW = 528, SD_WROW = 528, SD_PROW = 272;
constexpr int SD_CIMG = 0, SD_CIMG_SZ = 128 * SD_CROW;
constexpr int SD_WBUF = SD_CIMG + SD_CIMG_SZ, SD_WBUF_SZ = 32 * 1040;
constexpr int SD_XCH = SD_WBUF + 2 * SD_WBUF_SZ, SD_XCH_SZ = 4 * 5 * 64 * 4;
constexpr int SD_PIMG = SD_XCH + 2 * SD_XCH_SZ, SD_PIMG_SZ = 32 * SD_PROW;
constexpr int SD_END = SD_PIMG + 2 * SD_PIMG_SZ;
typedef short s16x4 __attribute__((ext_vector_type(4)));
#define MFMA32(a, b, c) __builtin_amdgcn_mfma_f32_32x32x16_bf16(a, b, c, 0, 0, 0)

__device__ __forceinline__ float mla_b2_bound(const Ctx& c, int j, int lane) {
    using namespace cfg;
    float gq = fabsf(c.in[I_QNN][j * NOPE + lane]), gk = fabsf(c.in[I_KNN][j * NOPE + lane]), gqr = fabsf(c.in[I_QRN][j * ROPE + (lane & 31)]), gkr = fabsf(c.in[I_KRN][j * ROPE + (lane & 31)]);
#pragma unroll
    for (int o = 1; o < 64; o <<= 1) { gq = fmaxf(gq, __shfl_xor(gq, o)); gk = fmaxf(gk, __shfl_xor(gk, o)); gqr = fmaxf(gqr, __shfl_xor(gqr, o)); gkr = fmaxf(gkr, __shfl_xor(gkr, o)); }
    return (64.f * gq * gk + 32.f * gqr * gkr) * (0.10206207261596575f * 1.4426950408889634f);
}

__device__ __forceinline__ void sd_pv_core(const int G, f32x16_t& Og, f32x16_t& Lacc, LDSP unsigned char* lds, int w, int lane, int l31, int h5) {
    asm volatile("" : "+v"(lane)); l31 = lane & 31; h5 = lane >> 5;
    const LDSP unsigned char* pimg = lds + SD_PIMG + (G & 1) * SD_PIMG_SZ;
    const unsigned onesw = (l31 == G) ? 0x3F803F80u : 0u;
    const bf16x8v onesv = __builtin_bit_cast(bf16x8v, (pg8::u32x4){onesw, onesw, onesw, onesw});
#pragma unroll
    for (int sp = 0; sp < 8; ++sp) {
        const bf16x8v a = *(const LDSP bf16x8v*)(pimg + l31 * SD_PROW + (16 * sp + 8 * h5) * 2);
        const int key0 = 16 * sp + 8 * h5 + ((lane & 15) >> 2), col = 32 * w + 16 * ((lane >> 4) & 1) + 4 * (lane & 3);
        const s16x4 t0 = __builtin_amdgcn_ds_read_tr16_b64_v4i16((LDSP s16x4*)(lds + SD_CIMG + key0 * SD_CROW + col * 2));
        const s16x4 t1 = __builtin_amdgcn_ds_read_tr16_b64_v4i16((LDSP s16x4*)(lds + SD_CIMG + (key0 + 4) * SD_CROW + col * 2));
        const bf16x8v b = (bf16x8v){t0[0], t0[1], t0[2], t0[3], t1[0], t1[1], t1[2], t1[3]};
        Og = MFMA32(a, b, Og);
        if (sp == w) Lacc = MFMA32(a, onesv, Lacc);
        if (sp & 1) __builtin_amdgcn_sched_barrier(0);
    }
}

__device__ __forceinline__ void sd_pv(const int G, f32x16_t& Og, f32x16_t& Lacc, LDSP unsigned char* lds, int w, int lane, int l31, int h5) {
    sd_pv_core(G, Og, Lacc, lds, w, lane, l31, h5);
#if defined(PROBE_DUP) && (PROBE_DUP & (1 << 21))
    f32x16_t D0, D1;
#pragma unroll
    for (int r = 0; r < 16; ++r) { D0[r] = 0.f; D1[r] = 0.f; }
    sd_pv_core(G, D0, D1, lds, w, lane, l31, h5); asm volatile("" :: "v"(D0), "v"(D1));
#endif
}
__device__ __forceinline__ void sd_glds16(const void* gsrc, unsigned lds_dst) {
    unsigned keep;
    asm volatile("s_mov_b32 %0, m0\n\ts_mov_b32 m0, %2\n\ts_nop 0\n\tglobal_load_lds_dwordx4 %1, off\n\ts_mov_b32 m0, %0" : "=&s"(keep) : "v"(gsrc), "s"(lds_dst) : "memory");
}
#define SD_WLOAD(h, buf) do { if (w >= 4) { const char* wsrc_ = (const char*)(fm.wukvt + (size_t)(h) * NOPE * KVL); int ln_ = lane; asm volatile("" : "+v"(ln_)); \
        const unsigned ldsb_ = __builtin_amdgcn_readfirstlane((unsigned)(size_t)(lds + SD_WBUF + (buf) * SD_WBUF_SZ)) + (unsigned)(8 * (w - 4)) * 1040u; \
        _Pragma("unroll") for (int k = 0; k < 8; ++k) { \
        const unsigned voff_ = (unsigned)(((8 * (w - 4) + k) + 32 * (ln_ >> 5)) * KVL + (ln_ & 31) * 8) * 2u; \
        sd_glds16(wsrc_ + voff_, ldsb_ + (unsigned)k * 1040u); } } } while (0)
template <int G, bool DOPV = true>
__device__ __forceinline__ void sd_group(const FastMla& fm, const bf16_t* __restrict__ qs, const int s, LDSP unsigned char* lds, const int w, const int lane, const int l31_, const int h5_, const int kb, const int dh, const int rot,
                                         const bf16x8v (&cfr)[16], const bf16x8v (&kpfr)[2], pg8::u32x4 (&wr)[4], f32x16_t (&O)[4], f32x16_t& Lacc, const float B2) {
    using namespace cfg;
        _Pragma("unroll 1") for (int hh = 0; hh < 4; ++hh) {
            const int h = (4 * G + hh + rot) & (MH - 1);
            int lane_ = lane; asm volatile("" : "+v"(lane_)); const int l31 = lane_ & 31, h5 = lane_ >> 5;
            { LDSP unsigned char* wdst = lds + SD_WBUF + ((h + 1) & 1) * SD_WBUF_SZ + (2 * w + h5) * 1040 + l31 * 16;
              *(LDSP pg8::u32x4*)(wdst) = wr[0]; *(LDSP pg8::u32x4*)(wdst + 16640) = wr[1]; *(LDSP pg8::u32x4*)(wdst + 512) = wr[2]; *(LDSP pg8::u32x4*)(wdst + 17152) = wr[3]; }
            const char* qb = (const char*)qs + (size_t)(s * MH + h) * 1536;
            const unsigned zoff = (unsigned)((DB * MH - (s * MH + h)) * 1536);
            const unsigned qlo = l31 < 8 ? (unsigned)(h5 * 128 + l31 * 16) : zoff;
            const bf16x8v qn0 = *(const bf16x8v*)(qb + dh * 512 + qlo), qn1 = *(const bf16x8v*)(qb + dh * 512 + 256 + qlo), qp0 = *(const bf16x8v*)(qb + 1024 + qlo), qp1 = *(const bf16x8v*)(qb + 1280 + qlo);
            { const char* wsrc = (const char*)(fm.wukvt + (size_t)((h + 2) & (MH - 1)) * NOPE * KVL) + (unsigned)(64 * w + lane_) * 16u;
#pragma unroll
              for (int k = 0; k < 4; ++k) wr[k] = *(const pg8::u32x4*)(wsrc + k * 8192); }
            f32x16_t KN;
#pragma unroll
            for (int r = 0; r < 16; ++r) KN[r] = 0.f;
            { const LDSP unsigned char* wb = lds + SD_WBUF + (h & 1) * SD_WBUF_SZ + l31 * 1040 + dh * 512 + h5 * 16;
#pragma unroll
              for (int s_ = 0; s_ < 16; ++s_) { const bf16x8v a = *(const LDSP bf16x8v*)(wb + 32 * s_); KN = MFMA32(a, cfr[s_], KN); if ((s_ & 3) == 3) __builtin_amdgcn_sched_barrier(0); } }
#if defined(PROBE_DUP) && (PROBE_DUP & (1 << 19))
            { const LDSP unsigned char* wb = lds + SD_WBUF + (h & 1) * SD_WBUF_SZ + l31 * 1040 + dh * 512 + h5 * 16;
#pragma unroll
              for (int s_ = 0; s_ < 16; ++s_) { const bf16x8v a = *(const LDSP bf16x8v*)(wb + 32 * s_); KN = MFMA32(a, cfr[s_], KN); if ((s_ & 3) == 3) __builtin_amdgcn_sched_barrier(0); }
#pragma unroll
              for (int r = 0; r < 16; ++r) KN[r] *= 0.5f; }
#endif
#if defined(PROBE_DUP) && (PROBE_DUP & (1 << 23))
            _Pragma("unroll 1") for (int rep_ = 0; rep_ < 2; ++rep_) {
            asm volatile("" : "+v"(KN));
#else
            {
#endif
            float ssq = 0.f;
#pragma unroll
            for (int r = 0; r < 16; ++r) ssq += KN[r] * KN[r];
            ssq += __shfl_xor(ssq, 32);
            {
            f32x16_t S;
#pragma unroll
            for (int r = 0; r < 16; ++r) S[r] = 0.f;
#pragma unroll
            for (int s_ = 0; s_ < 2; ++s_) { const bf16x8v kf = __builtin_bit_cast(bf16x8v, (pg8::u32x4){pk2bf(KN[8 * s_], KN[8 * s_ + 1]), pk2bf(KN[8 * s_ + 2], KN[8 * s_ + 3]), pk2bf(KN[8 * s_ + 4], KN[8 * s_ + 5]), pk2bf(KN[8 * s_ + 6], KN[8 * s_ + 7])});
                S = MFMA32(s_ == 0 ? qn0 : qn1, kf, S); }
            LDSP float* xch = (LDSP float*)(lds + SD_XCH + (h & 1) * SD_XCH_SZ) + kb * 320;
            if (dh == 1) { xch[lane_] = S[0]; xch[64 + lane_] = S[1]; xch[128 + lane_] = S[2]; xch[192 + lane_] = S[3]; xch[256 + lane_] = ssq; }
            asm volatile("s_waitcnt lgkmcnt(0)" ::: "memory");
            __builtin_amdgcn_s_barrier();
            asm volatile("" ::: "memory");
            if (dh == 0) {
                const float rstd = __builtin_amdgcn_rsqf((ssq + xch[256 + lane_]) * (1.0f / NOPE) + NORM_EPS);
                f32x16_t T;
#pragma unroll
                for (int r = 0; r < 16; ++r) T[r] = 0.f;
                T[0] = (S[0] + xch[lane_]) * rstd; T[1] = (S[1] + xch[64 + lane_]) * rstd; T[2] = (S[2] + xch[128 + lane_]) * rstd; T[3] = (S[3] + xch[192 + lane_]) * rstd;
                T = MFMA32(qp0, kpfr[0], T); T = MFMA32(qp1, kpfr[1], T);
                LDSP bf16_t* prow = (LDSP bf16_t*)(lds + SD_PIMG + (G & 1) * SD_PIMG_SZ + (hh * 8 + 4 * h5) * SD_PROW) + 32 * kb + l31;
#pragma unroll
                for (int q = 0; q < 4; ++q) prow[q * (SD_PROW / 2)] = (bf16_t)(pk2bf(exp2f(T[q] - B2), 0.f) & 0xffffu);
            }
            }
            }
        }
        if (G > 0 && DOPV) sd_pv(G > 0 ? G - 1 : 0, O[G > 0 ? G - 1 : 0], Lacc, lds, w, lane, l31_, h5_);
}

__device__ __forceinline__ void mla_sample_decode(const Ctx& c, const FastMla& fm, const bf16_t* __restrict__ qs, float* opart, float* lpart, int j, LDSP unsigned char* lds) {
    using namespace cfg;
    const int tid = (int)tid_now(), tid_ = tid, w = __builtin_amdgcn_readfirstlane(tid >> 6), lane = tid & 63, l31 = lane & 31, h5 = lane >> 5, kb = w & 3, dh = w >> 2;
    const float* ckv = c.in[I_CKV] + (size_t)j * NPOOL * PAGE * KVL; const float* kpe = c.in[I_KPE] + (size_t)j * NPOOL * PAGE * ROPE;
    const float B2 = __builtin_bit_cast(float, __builtin_amdgcn_readfirstlane(__builtin_bit_cast(int, mla_b2_bound(c, j, lane))));
    for (int it = blockIdx.x; it < DB * 2; it += gridDim.x) {
        const int s = it >> 1, hf = it & 1, rot = 2 * ((blockIdx.x >> 3) & 7);
        f32x16_t O[4], Lacc;
#pragma unroll
        for (int r = 0; r < 16; ++r) { O[0][r] = 0.f; O[1][r] = 0.f; O[2][r] = 0.f; O[3][r] = 0.f; Lacc[r] = 0.f; }
        pg8::u32x4 wr[4];
        __syncthreads();
        {
            int t_ = tid_; asm volatile("" : "+v"(t_));
            const char* wsrc = (const char*)(fm.wukvt + (size_t)rot * NOPE * KVL); const unsigned vo = (unsigned)t_ * 16u; LDSP unsigned char* wdst = lds + SD_WBUF + (t_ >> 5) * 1040 + (t_ & 31) * 16;
            pg8::u32x4 t0 = *(const pg8::u32x4*)(wsrc + vo), t1 = *(const pg8::u32x4*)(wsrc + 8192 + vo), t2 = *(const pg8::u32x4*)(wsrc + 16384 + vo), t3 = *(const pg8::u32x4*)(wsrc + 24576 + vo);
            *(LDSP pg8::u32x4*)(wdst) = t0; *(LDSP pg8::u32x4*)(wdst + 16640) = t1; *(LDSP pg8::u32x4*)(wdst + 512) = t2; *(LDSP pg8::u32x4*)(wdst + 17152) = t3;
#pragma unroll
            for (int k = 0; k < 4; ++k) wr[k] = *(const pg8::u32x4*)(wsrc + NOPE * KVL * 2 + k * 8192 + vo);
        }
        for (int pi = 0; pi < NPAGES / 2; ++pi) {
            const int pg = __builtin_amdgcn_readfirstlane(c.page_table[s * NPAGES + hf * (NPAGES / 2) + pi]);
            __syncthreads();
            { const char* src = (const char*)(ckv + (size_t)pg * PAGE * KVL); int tid = tid_; asm volatile("" : "+v"(tid));
              pg8::f32x4 v[16];
#pragma unroll
              for (int k = 0; k < 16; ++k) v[k] = __builtin_nontemporal_load((const pg8::f32x4*)(src + (size_t)k * 8192 + (unsigned)tid * 16u));
#pragma unroll
              for (int k = 0; k < 16; ++k) { pg8::u32x2 o; o.x = pk2bf(v[k][0], v[k][1]); o.y = pk2bf(v[k][2], v[k][3]);
                  *(LDSP pg8::u32x2*)(lds + SD_CIMG + ((tid >> 6) + 8 * k) * SD_CROW + (tid & 63) * 8) = o; } }
#if defined(PROBE_DUP) && (PROBE_DUP & (1 << 20))
            { const char* src = (const char*)(ckv + (size_t)pg * PAGE * KVL); int tid = tid_; asm volatile("" : "+v"(tid));
              pg8::f32x4 v[16];
#pragma unroll
              for (int k = 0; k < 16; ++k) v[k] = *(const pg8::f32x4*)(src + (size_t)k * 8192 + (unsigned)tid * 16u);
#pragma unroll
              for (int k = 0; k < 16; ++k) { pg8::u32x2 o; o.x = pk2bf(v[k][0], v[k][1]); o.y = pk2bf(v[k][2], v[k][3]);
                  *(LDSP pg8::u32x2*)(lds + SD_CIMG + ((tid >> 6) + 8 * k) * SD_CROW + (tid & 63) * 8) = o; } }
#endif
            bf16x8v kpfr[2];
            if (dh == 0) {
#pragma unroll
                for (int s_ = 0; s_ < 2; ++s_) { const float* kp = kpe + ((size_t)pg * PAGE + 32 * kb + l31) * ROPE + 16 * s_ + 8 * h5; const pg8::f32x4 a = *(const pg8::f32x4*)kp, b = *(const pg8::f32x4*)(kp + 4);
                    kpfr[s_] = __builtin_bit_cast(bf16x8v, (pg8::u32x4){pk2bf(a[0], a[1]), pk2bf(a[2], a[3]), pk2bf(b[0], b[1]), pk2bf(b[2], b[3])}); }
            }
            asm volatile("s_waitcnt vmcnt(0)" ::: "memory");
            __syncthreads();
            bf16x8v cfr[16];
#pragma unroll
            for (int s_ = 0; s_ < 16; ++s_) cfr[s_] = *(const LDSP bf16x8v*)(lds + SD_CIMG + (32 * kb + l31) * SD_CROW + (16 * s_ + 8 * h5) * 2);
            sd_group<0>(fm, qs, s, lds, w, lane, l31, h5, kb, dh, rot, cfr, kpfr, wr, O, Lacc, B2);
            sd_group<1>(fm, qs, s, lds, w, lane, l31, h5, kb, dh, rot, cfr, kpfr, wr, O, Lacc, B2);
            sd_group<2>(fm, qs, s, lds, w, lane, l31, h5, kb, dh, rot, cfr, kpfr, wr, O, Lacc, B2);
            sd_group<3>(fm, qs, s, lds, w, lane, l31, h5, kb, dh, rot, cfr, kpfr, wr, O, Lacc, B2);
#if defined(PROBE_DUP) && (PROBE_DUP & (1 << 29))
            __syncthreads();
            sd_group<0, false>(fm, qs, s, lds, w, lane, l31, h5, kb, dh, rot, cfr, kpfr, wr, O, Lacc, B2);
            sd_group<1, false>(fm, qs, s, lds, w, lane, l31, h5, kb, dh, rot, cfr, kpfr, wr, O, Lacc, B2);
            sd_group<2, false>(fm, qs, s, lds, w, lane, l31, h5, kb, dh, rot, cfr, kpfr, wr, O, Lacc, B2);
            sd_group<3, false>(fm, qs, s, lds, w, lane, l31, h5, kb, dh, rot, cfr, kpfr, wr, O, Lacc, B2);
#endif
            __syncthreads();
            sd_pv(3, O[3], Lacc, lds, w, lane, l31, h5);
        }
        {float* op = opart + (size_t)it * (MH * DS) * KVL; int lo_ = lane; asm volatile("" : "+v"(lo_)); const int l31 = lo_ & 31, h5 = lo_ >> 5;
#pragma unroll
        for (int g = 0; g < 4; ++g)
#pragma unroll
            for (int r = 0; r < 16; ++r) op[(size_t)((((4 * g + (r >> 2) + rot) & (MH - 1)) << 3) + (r & 3) + 4 * h5) * KVL + 32 * w + l31] = O[g][r];
        __syncthreads();
        LDSP float* ltab = (LDSP float*)(lds + SD_XCH);
        if (l31 < 4) {
#pragma unroll
            for (int r = 0; r < 16; ++r) ltab[w * 128 + l31 * 32 + (r & 3) + 8 * (r >> 2) + 4 * h5] = Lacc[r];
        }
        __syncthreads();
        { const int t2 = (int)tid_now();
        if (t2 < 128) { float a = 0.f;
#pragma unroll
            for (int ww = 0; ww < 8; ++ww) a += ltab[ww * 128 + t2];
            lpart[(size_t)it * 128 + ((((t2 >> 3) + rot) & (MH - 1)) << 3) + (t2 & 7)] = a; } }
        }
    }
}

__device__ __forceinline__ void mla_sample_combine(const Ctx& c, const FastMla& fm, const float* __restrict__ opart, const float* __restrict__ lpart, int j, LDSP unsigned char* lds) {
    using namespace cfg;
    const int tid = (int)tid_now(), w = tid >> 6, lane = tid & 63, gw = blockIdx.x * 8 + w, ngw = gridDim.x * 8;
    const float B2 = mla_b2_bound(c, j, lane);
    LDSP float* ol = (LDSP float*)(lds + w * 8704); LDSP float* ptab = ol + 8 * KVL; LDSP float* lt = ptab + 64;
    const float* wuv = c.in[I_WUV] + (size_t)j * KVL * MH * VD;
    for (int item = gw; item < DB * MH; item += ngw) {
        const int s = item / MH, h = item % MH, q = lane >> 3, jn = lane & 7;
        const size_t rq = (size_t)MP + s * DS + q, rk = (size_t)MP + s * DS + jn;
        const bf16_t* qv = fm.qf + rq * (MH * QD) + h * QD; const bf16_t* kn = fm.knb + rk * (MH * NOPE) + h * NOPE; const bf16_t* kp = fm.kpb + rk * ROPE;
        float sc = 0.f;
#pragma unroll
        for (int d8 = 0; d8 < QD / 8; ++d8) { const pg8::u32x4 a = *(const pg8::u32x4*)(qv + 8 * d8), b = d8 < NOPE / 8 ? *(const pg8::u32x4*)(kn + 8 * d8) : *(const pg8::u32x4*)(kp + 8 * (d8 - NOPE / 8));
            const unsigned aw[4] = {a.x, a.y, a.z, a.w}, bw[4] = {b.x, b.y, b.z, b.w};
#pragma unroll
            for (int e = 0; e < 4; ++e) sc += __uint_as_float(aw[e] << 16) * __uint_as_float(bw[e] << 16) + __uint_as_float(aw[e] & 0xffff0000u) * __uint_as_float(bw[e] & 0xffff0000u); }
        const float p = jn <= q ? exp2f(sc - B2) : 0.f;
        float ls = p; ls += __shfl_xor(ls, 1); ls += __shfl_xor(ls, 2); ls += __shfl_xor(ls, 4);
        ptab[lane] = p;
        if (jn == 0) lt[q] = ls + lpart[(size_t)(2 * s) * 128 + h * DS + q] + lpart[(size_t)(2 * s + 1) * 128 + h * DS + q];
        asm volatile("s_waitcnt lgkmcnt(0)" ::: "memory");
        float cn[DS][4];
#pragma unroll
        for (int jj = 0; jj < DS; ++jj)
#pragma unroll
            for (int k = 0; k < 4; ++k) cn[jj][k] = bf2f(fm.cb[((size_t)MP + s * DS + jj) * KVL + lane + 64 * k]);
#pragma unroll
        for (int qq = 0; qq < DS; ++qq)
#pragma unroll
            for (int k = 0; k < 4; ++k) { const int r = lane + 64 * k;
                float a = opart[((size_t)(2 * s) * 128 + h * DS + qq) * KVL + r] + opart[((size_t)(2 * s + 1) * 128 + h * DS + qq) * KVL + r];
#pragma unroll
                for (int jj = 0; jj < DS; ++jj) a += ptab[qq * 8 + jj] * cn[jj][k];
                ol[qq * KVL + r] = a; }
        asm volatile("s_waitcnt lgkmcnt(0)" ::: "memory");
        float acc[DS];
#pragma unroll
        for (int qq = 0; qq < DS; ++qq) acc[qq] = 0.f;
        for (int r = 0; r < KVL; ++r) { const float wv = wuv[((size_t)r * MH + h) * VD + lane];
#pragma unroll
            for (int qq = 0; qq < DS; ++qq) acc[qq] += ol[qq * KVL + r] * wv; }
#pragma unroll
        for (int qq = 0; qq < DS; ++qq) fm.aob[((size_t)MP + s * DS + qq) * (MH * VD) + h * VD + lane] = (bf16_t)(pk2bf(acc[qq] / lt[qq], 0.f) & 0xffffu);
        asm volatile("s_waitcnt lgkmcnt(0)" ::: "memory");
    }
}

struct FastRw {
    bf16_t* xm;
    bf16_t* rkv;
    bf16_t* hb;
    bf16_t* lu;
    float* vf;
    float* ops;
    bf16_t* yo;
    bf16_t *wrkvt, *lorat, *wot;
};
constexpr int RW_REC = 464;
constexpr int RW_CH = 32;
constexpr int RW_BUF = RW_CH * RW_REC * 4;
struct RwSel { __device__ static __forceinline__ int sel(int pn) { return pn < 12 ? (pn >> 2) : (pn == 15 ? 2 : pn - 9); } };

__device__ __forceinline__ void rw_mix_fast(const Ctx& c, const FastRw& fr, int l, int gw, int ngw, int lane) {
    using namespace cfg; const int j = l / 3;
    const float* gain = c.in[I_NMIX] + l * D;
    for (int m = gw; m < MTOT; m += ngw) {
        const int t = row_t(m), sq = row_seq(m);
        pg8::f32x4 xc[4], xp[4], gv[4]; float s = 0.f, sp = 0.f;
#pragma unroll
        for (int q = 0; q < 4; ++q) { gv[q] = *(const pg8::f32x4*)(gain + 4 * lane + 256 * q); xc[q] = *(const pg8::f32x4*)(c.x + (size_t)m * D + 4 * lane + 256 * q);
            s += (xc[q][0] * xc[q][0] + xc[q][1] * xc[q][1]) + (xc[q][2] * xc[q][2] + xc[q][3] * xc[q][3]); }
        if (t > 0) {
#pragma unroll
            for (int q = 0; q < 4; ++q) { xp[q] = *(const pg8::f32x4*)(c.x + (size_t)(m - 1) * D + 4 * lane + 256 * q); sp += (xp[q][0] * xp[q][0] + xp[q][1] * xp[q][1]) + (xp[q][2] * xp[q][2] + xp[q][3] * xp[q][3]); }
        }
        const float rs = 1.0f / sqrtf(wave_sum64(s) * (1.0f / D) + NORM_EPS), rsp = 1.0f / sqrtf(wave_sum64(sp) * (1.0f / D) + NORM_EPS);
#pragma unroll
        for (int q = 0; q < 4; ++q) {
#pragma unroll
            for (int e = 0; e < 4; ++e) xc[q][e] = xc[q][e] * rs * gv[q][e];
            if (t > 0) {
#pragma unroll
                for (int e = 0; e < 4; ++e) xp[q][e] = xp[q][e] * rsp * gv[q][e];
            } else if (sq < BATCH) xp[q] = (pg8::f32x4){0.f, 0.f, 0.f, 0.f};
            else xp[q] = *(const pg8::f32x4*)(c.in[I_SHIFT] + ((size_t)j * DB + (sq - BATCH)) * D + 4 * lane + 256 * q);
        }
        if (t == seq_len(sq) - 1) {
            float* so = sq < BATCH ? c.out + O_SHP + ((size_t)j * BATCH + sq) * D : c.out + O_SHS + ((size_t)j * DB + (sq - BATCH)) * D;
#pragma unroll
            for (int q = 0; q < 4; ++q) *(pg8::f32x4*)(so + 4 * lane + 256 * q) = xc[q];
        }
#pragma unroll
        for (int p = 0; p < 6; ++p)
#pragma unroll
            for (int q = 0; q < 4; ++q) { const pg8::f32x4 mu = *(const pg8::f32x4*)(c.in[I_MU] + ((size_t)j * 6 + p) * D + 4 * lane + 256 * q);
                pg8::u32x2 o; o.x = pk2bf(xc[q][0] + (xp[q][0] - xc[q][0]) * mu[0], xc[q][1] + (xp[q][1] - xc[q][1]) * mu[1]); o.y = pk2bf(xc[q][2] + (xp[q][2] - xc[q][2]) * mu[2], xc[q][3] + (xp[q][3] - xc[q][3]) * mu[3]);
                *(pg8::u32x2*)(fr.xm + ((size_t)p * MTOT + m) * D + 4 * lane + 256 * q) = o; }
        if (lane < 32) *(unsigned*)(fr.hb + (size_t)m * 384 + 320 + 2 * lane) = 0u;
    }
}
struct EpiRwkv {
    static constexpr bool PERM = true;
    bf16_t* rkv; bf16_t* hb;
    __device__ __forceinline__ void operator()(const pg8::f32x4 (&acc)[2][2][4][2], const pg8::Unit& u, int wr, int wc, int fr, int fq) const {
        using namespace pg8;
        const int row0 = u.pm * BM + wr * 64 + fr, cl0 = wc * 32 + 8 * fq;
        const int pn = u.pn;
        bf16_t* base; int ldc, coff, nvalid, act = 0;
        if (pn < 12) { base = rkv; ldc = 3072; coff = pn * 256; nvalid = 256; }
        else { base = hb; ldc = 384; if (pn == 12) { coff = 0; nvalid = 64; act = 1; } else if (pn == 13) { coff = 64; nvalid = 64; } else if (pn == 14) { coff = 128; nvalid = 160; act = 2; } else { coff = 288; nvalid = 32; } }
#pragma unroll
        for (int ai = 0; ai < 2; ++ai)
#pragma unroll
            for (int m = 0; m < 4; ++m) { bf16_t* rowp = base + (size_t)(row0 + ai * HALF + m * 16) * ldc + coff;
#pragma unroll
                for (int bj = 0; bj < 2; ++bj) { const int cl = cl0 + bj * HALF; if (cl >= nvalid) continue;
                    f32x4 v0 = acc[ai][bj][m][0], v1 = acc[ai][bj][m][1];
                    if (act == 1) {
#pragma unroll
                        for (int e = 0; e < 4; ++e) { v0[e] = tanhf(v0[e]); v1[e] = tanhf(v1[e]); } }
                    else if (act == 2) {
#pragma unroll
                        for (int e = 0; e < 4; ++e) { v0[e] = 1.0f / (1.0f + __expf(-v0[e])); v1[e] = 1.0f / (1.0f + __expf(-v1[e])); } }
                    u32x4 w; w.x = cvt_pk_bf16(v0[0], v0[1]); w.y = cvt_pk_bf16(v0[2], v0[3]); w.z = cvt_pk_bf16(v1[0], v1[1]); w.w = cvt_pk_bf16(v1[2], v1[3]);
                    *(u32x4*)(rowp + cl) = w; } }
    }
};
__device__ __forceinline__ void rw_build_lorat(const Ctx& c, bf16_t* lorat, int j, size_t gtid, size_t gsz) {
    using namespace cfg;
    for (size_t i = gtid; i < (size_t)4096 * 384; i += gsz) {
        const int n = (int)(i / 384), k = (int)(i % 384), grp = n >> 10, ch = n & 1023; float v = 0.f;
        if (grp == 0 && k < 64) v = c.in[I_W2][((size_t)j * RW_DL + k) * D + ch];
        else if (grp == 1 && k >= 64 && k < 128) v = c.in[I_A2][((size_t)j * RW_AL + (k - 64)) * D + ch];
        else if (grp == 2 && k >= 128 && k < 288) v = c.in[I_G2][((size_t)j * RW_GL + (k - 128)) * D + ch];
        else if (grp == 3 && k >= 288 && k < 320 && j > 0) v = c.in[I_V2][((size_t)(j - 1) * RW_VL + (k - 288)) * D + ch];
        lorat[i] = (bf16_t)(pk2bf(v, 0.f) & 0xffffu);
    }
}
__device__ __forceinline__ size_t rw_rec_base(int sq, int h) {
    using namespace cfg;
    return sq < BATCH ? ((size_t)sq * RHEADS + h) * SEQ : (size_t)MP * RHEADS + ((size_t)(sq - BATCH) * RHEADS + h) * DS;
}
__device__ __forceinline__ void rw_prep_fast(const Ctx& c, const FastRw& fr, int l, int gw, int ngw, int lane) {
    using namespace cfg; const int j = l / 3;
    for (int it = gw; it < MTOT * RHEADS; it += ngw) {
        const int m = it / RHEADS, h = it % RHEADS, ch = h * RH + lane;
        const bf16_t* rk = fr.rkv + (size_t)m * 3072 + ch; const bf16_t* lu = fr.lu + (size_t)m * 4096 + ch;
        const float r = bf2f(rk[0]), k0 = bf2f(rk[1024]); float v = bf2f(rk[2048]);
        const float wpre = bf2f(lu[0]), apre = bf2f(lu[1024]), gg = bf2f(lu[2048]), vpre = bf2f(lu[3072]);
        const float wl = -softplusf_(-(c.in[I_W0][j * D + ch] + wpre)) - 0.5f;
        const float w = expf(-expf(wl));
        if (j == 0) fr.vf[(size_t)m * D + ch] = v;
        else v = v + (fr.vf[(size_t)m * D + ch] - v) * sigmoidf_(c.in[I_V0][(j - 1) * D + ch] + vpre);
        const float a = sigmoidf_(c.in[I_A0][j * D + ch] + apre);
        float kk = k0 * c.in[I_KK][j * D + ch];
        const float nn = wave_sum64(kk * kk);
        kk *= 1.0f / fmaxf(sqrtf(nn), 1e-12f);
        const float k2 = k0 * (1.0f + (a - 1.0f) * c.in[I_KA][j * D + ch]);
        const float bo = kk * a;
        const float br = wave_sum64(bo * r), kr = wave_sum64(k2 * r), bonus = wave_sum64(r * k2 * c.in[I_RK][(size_t)j * D + ch]);
        const int sq = row_seq(m), t = row_t(m);
        float* rec = fr.ops + (rw_rec_base(sq, h) + t) * RW_REC;
        rec[lane] = -kk; rec[64 + lane] = w * r; rec[128 + lane] = w; rec[192 + lane] = bo; rec[256 + lane] = k2; rec[320 + lane] = v; rec[384 + lane] = gg;
        if (lane == 0) { rec[448] = br; rec[449] = kr; rec[450] = bonus; }
    }
}
template <int CTRL> __device__ __forceinline__ float dppf(float v) { return __int_as_float(__builtin_amdgcn_update_dpp(0, __float_as_int(v), CTRL, 0xF, 0xF, true)); }
__device__ __forceinline__ float red16(float x) { x += dppf<0xB1>(x); x += dppf<0x4E>(x); x += dppf<0x124>(x); x += dppf<0x128>(x); return x; }
__device__ __forceinline__ void rw_scan_fast(const Ctx& c, const FastRw& fr, int l, LDSP unsigned char* lds) {
    using namespace cfg; const int j = l / 3;
    const int tid = (int)tid_now(), w = __builtin_amdgcn_readfirstlane(tid >> 6), lane = tid & 63, cs = lane & 15, rp = 4 * w + (lane >> 4);
    LDSP float* ybuf = (LDSP float*)(lds + 2 * RW_BUF);
    for (int chain = blockIdx.x; chain < NSEQ * RHEADS; chain += gridDim.x) {
        const int sq = chain / RHEADS, h = chain % RHEADS, T = seq_len(sq), m0 = seq_row0(sq);
        const char* src = (const char*)(fr.ops + rw_rec_base(sq, h) * RW_REC);
        pg8::f32x4 S0, S1;
        if (sq < BATCH) { S0 = (pg8::f32x4){0.f, 0.f, 0.f, 0.f}; S1 = S0; }
        else { const float* s0 = c.in[I_WKV] + ((((size_t)j * DB + (sq - BATCH)) * RHEADS + h) * RH + 2 * rp) * RH + 4 * cs; S0 = *(const pg8::f32x4*)s0; S1 = *(const pg8::f32x4*)(s0 + RH); }
        const int nch = (T + RW_CH - 1) / RW_CH;
#define RW_DMA(n, buf) do { const int nb_ = ((T - (n) * RW_CH < RW_CH ? T - (n) * RW_CH : RW_CH) * RW_REC * 4 + 1023) >> 10; \
            for (int q_ = w; q_ < nb_; q_ += 8) __builtin_amdgcn_global_load_lds((const unsigned*)(src + (size_t)(n) * RW_BUF + (size_t)q_ * 1024 + (unsigned)lane * 16u), (LDSP unsigned*)(lds + (buf) * RW_BUF + q_ * 1024), 16, 0, 0); } while (0)
        __syncthreads();
        RW_DMA(0, 0);
        asm volatile("s_waitcnt vmcnt(0)" ::: "memory");
        __syncthreads();
        for (int n = 0; n < nch; ++n) {
            if (n + 1 < nch) RW_DMA(n + 1, (n + 1) & 1);
            const int tn = T - n * RW_CH < RW_CH ? T - n * RW_CH : RW_CH;
            const LDSP unsigned char* bufp = lds + (n & 1) * RW_BUF;
            for (int t = 0; t < tn; ++t) {
                const LDSP unsigned char* rec = bufp + t * (RW_REC * 4);
                const pg8::f32x4 A = *(const LDSP pg8::f32x4*)(rec + cs * 16), WR = *(const LDSP pg8::f32x4*)(rec + 256 + cs * 16), W = *(const LDSP pg8::f32x4*)(rec + 512 + cs * 16),
                                 B = *(const LDSP pg8::f32x4*)(rec + 768 + cs * 16), K = *(const LDSP pg8::f32x4*)(rec + 1024 + cs * 16);
                const pg8::f32x2 V2 = *(const LDSP pg8::f32x2*)(rec + 1280 + rp * 8), SC = *(const LDSP pg8::f32x2*)(rec + 1792);
                float sa0 = (S0[0] * A[0] + S0[1] * A[1]) + (S0[2] * A[2] + S0[3] * A[3]), y0 = (S0[0] * WR[0] + S0[1] * WR[1]) + (S0[2] * WR[2] + S0[3] * WR[3]);
                float sa1 = (S1[0] * A[0] + S1[1] * A[1]) + (S1[2] * A[2] + S1[3] * A[3]), y1 = (S1[0] * WR[0] + S1[1] * WR[1]) + (S1[2] * WR[2] + S1[3] * WR[3]);
                sa0 = red16(sa0); sa1 = red16(sa1); y0 = red16(y0); y1 = red16(y1);
                S0 = S0 * W + sa0 * B + V2[0] * K; S1 = S1 * W + sa1 * B + V2[1] * K;
                if (cs == 0) *(LDSP pg8::f32x2*)(ybuf + t * RH + 2 * rp) = (pg8::f32x2){y0 + sa0 * SC[0] + V2[0] * SC[1], y1 + sa1 * SC[0] + V2[1] * SC[1]};
            }
            asm volatile("s_waitcnt vmcnt(0)" ::: "memory");
            __syncthreads();
            for (int t = w; t < tn; t += 8) {
                const LDSP float* rec = (const LDSP float*)(bufp + t * (RW_REC * 4));
                const float y = ybuf[t * RH + lane], mean = wave_sum64(y) * (1.0f / RH), d = y - mean, var = wave_sum64(d * d) * (1.0f / RH);
                const int ch = h * RH + lane;
                const float yn = d * (1.0f / sqrtf(var + LNX_EPS)) * c.in[I_LNW][j * D + ch] + c.in[I_LNB][j * D + ch];
                const float o = (yn + rec[450] * rec[320 + lane]) * rec[384 + lane];
                fr.yo[(size_t)(m0 + n * RW_CH + t) * D + ch] = (bf16_t)(pk2bf(o, 0.f) & 0xffffu);
            }
            __syncthreads();
        }
#undef RW_DMA
        float* so = (sq < BATCH ? c.out + O_WKVP + (((size_t)j * BATCH + sq) * RHEADS + h) * RH * RH : c.out + O_WKVS + (((size_t)j * DB + (sq - BATCH)) * RHEADS + h) * RH * RH) + (size_t)(2 * rp) * RH + 4 * cs;
        *(pg8::f32x4*)so = S0; *(pg8::f32x4*)(so + RH) = S1;
    }
}
__device__ __forceinline__ float fsigmoid(float x) { return __builtin_amdgcn_rcpf(1.0f + __expf(-x)); }
__device__ __forceinline__ float fsoftplus(float x) { return x > 20.f ? x : __logf(1.0f + __expf(x)); }
__device__ __forceinline__ float rdl(float v, int l) { return __int_as_float(__builtin_amdgcn_readlane(__float_as_int(v), l)); }
__device__ __forceinline__ float wsum_dpp(float x) {
    x = red16(x);
    return (rdl(x, 0) + rdl(x, 16)) + (rdl(x, 32) + rdl(x, 48));
}

struct RwOp { pg8::f32x4 A, WR, W, B, K; pg8::f32x2 V2, SC; };
__device__ __forceinline__ void rw_ldop(RwOp& o, const LDSP unsigned char* rec, int cs, int rp) {
    o.A = *(const LDSP pg8::f32x4*)(rec + cs * 16); o.WR = *(const LDSP pg8::f32x4*)(rec + 256 + cs * 16); o.W = *(const LDSP pg8::f32x4*)(rec + 512 + cs * 16);
    o.B = *(const LDSP pg8::f32x4*)(rec + 768 + cs * 16); o.K = *(const LDSP pg8::f32x4*)(rec + 1024 + cs * 16);
    o.V2 = *(const LDSP pg8::f32x2*)(rec + 1280 + rp * 8); o.SC = *(const LDSP pg8::f32x2*)(rec + 1792);
}
__device__ __forceinline__ float fma_s(float a, float b, float c) { float d; asm("v_fma_f32 %0, %1, %2, %3" : "=v"(d) : "v"(a), "v"(b), "v"(c)); return d; }
__device__ __forceinline__ float mul_s(float a, float b) { float d; asm("v_mul_f32 %0, %1, %2" : "=v"(d) : "v"(a), "v"(b)); return d; }
__device__ __forceinline__ void rw_step(pg8::f32x4& S0, pg8::f32x4& S1, const RwOp& o, LDSP float* yrow, bool wr) {
    float sa0 = fma_s(S0[3], o.A[3], fma_s(S0[2], o.A[2], fma_s(S0[1], o.A[1], mul_s(S0[0], o.A[0]))));
    float sa1 = fma_s(S1[3], o.A[3], fma_s(S1[2], o.A[2], fma_s(S1[1], o.A[1], mul_s(S1[0], o.A[0]))));
    float y0 = fma_s(S0[3], o.WR[3], fma_s(S0[2], o.WR[2], fma_s(S0[1], o.WR[1], mul_s(S0[0], o.WR[0]))));
    float y1 = fma_s(S1[3], o.WR[3], fma_s(S1[2], o.WR[2], fma_s(S1[1], o.WR[1], mul_s(S1[0], o.WR[0]))));
    float t0[4], t1[4];
#pragma unroll
    for (int e = 0; e < 4; ++e) { t0[e] = fma_s(o.K[e], o.V2[0], mul_s(S0[e], o.W[e])); t1[e] = fma_s(o.K[e], o.V2[1], mul_s(S1[e], o.W[e])); }
    red16x4(sa0, sa1, y0, y1);
#pragma unroll
    for (int e = 0; e < 4; ++e) { S0[e] = fma_s(o.B[e], sa0, t0[e]); S1[e] = fma_s(o.B[e], sa1, t1[e]); }
    if (wr) *(LDSP pg8::f32x2*)yrow = (pg8::f32x2){fma_s(o.V2[0], o.SC[1], fma_s(sa0, o.SC[0], y0)), fma_s(o.V2[1], o.SC[1], fma_s(sa1, o.SC[0], y1))};
}
struct RwIn { unsigned short r, k, v, wp, ap, g, vp; float vf; };
template <int J>
__device__ __forceinline__ void rw_scan_fused(const Ctx& c, const FastRw& fr, LDSP unsigned char* lds) {
    using namespace cfg; constexpr int j = J;
    const int tid = (int)tid_now(), w = __builtin_amdgcn_readfirstlane(tid >> 6), lane = tid & 63, cs = lane & 15, rp = 4 * w + (lane >> 4);
    LDSP float* ybuf = (LDSP float*)(lds + 2 * RW_BUF);
    for (int chain = blockIdx.x; chain < NSEQ * RHEADS; chain += gridDim.x) {
        const int sq = chain / RHEADS, h = chain % RHEADS, T = seq_len(sq), m0 = seq_row0(sq), ch = h * RH + lane;
        const float p_w0 = c.in[I_W0][j * D + ch], p_a0 = c.in[I_A0][j * D + ch], p_kk = c.in[I_KK][j * D + ch], p_ka = c.in[I_KA][j * D + ch], p_rk = c.in[I_RK][(size_t)j * D + ch],
                    p_lnw = c.in[I_LNW][j * D + ch], p_lnb = c.in[I_LNB][j * D + ch], p_v0 = j > 0 ? c.in[I_V0][(j - 1) * D + ch] : 0.f;
        pg8::f32x4 S0, S1;
        if (sq < BATCH) { S0 = (pg8::f32x4){0.f, 0.f, 0.f, 0.f}; S1 = S0; }
        else { const float* s0 = c.in[I_WKV] + ((((size_t)j * DB + (sq - BATCH)) * RHEADS + h) * RH + 2 * rp) * RH + 4 * cs; S0 = *(const pg8::f32x4*)s0; S1 = *(const pg8::f32x4*)(s0 + RH); }
        const int nch = (T + RW_CH - 1) / RW_CH;
        RwIn in[4];
#define RW_LOADIN(n) do { _Pragma("unroll") for (int q = 0; q < 4; ++q) { const int t_ = (n) * RW_CH + 4 * w + q; if (t_ < T) { const size_t m_ = (size_t)(m0 + t_); \
                const bf16_t* rk_ = fr.rkv + m_ * 3072 + ch; const bf16_t* lu_ = fr.lu + m_ * 4096 + ch; \
                in[q].r = rk_[0]; in[q].k = rk_[1024]; in[q].v = rk_[2048]; in[q].wp = lu_[0]; in[q].ap = lu_[1024]; in[q].g = lu_[2048]; in[q].vp = lu_[3072]; \
                in[q].vf = j > 0 ? fr.vf[m_ * D + ch] : 0.f; } } } while (0)
#define RW_PREP(n, buf) do { _Pragma("unroll") for (int q = 0; q < 4; ++q) { const int tl_ = 4 * w + q, t_ = (n) * RW_CH + tl_; if (t_ < T) { \
                const float r_ = bf2f(in[q].r), k0_ = bf2f(in[q].k); float v_ = bf2f(in[q].v); \
                const float wl_ = -fsoftplus(-(p_w0 + bf2f(in[q].wp))) - 0.5f, w_ = __expf(-__expf(wl_)); \
                if (j == 0) fr.vf[(size_t)(m0 + t_) * D + ch] = v_; else v_ = v_ + (in[q].vf - v_) * fsigmoid(p_v0 + bf2f(in[q].vp)); \
                const float a_ = fsigmoid(p_a0 + bf2f(in[q].ap)); float kk_ = k0_ * p_kk; \
                const float k2_ = k0_ * (1.0f + (a_ - 1.0f) * p_ka); \
                float n_ = red16(kk_ * kk_), e1_ = red16(r_ * k2_ * p_rk), e2_ = red16(k2_ * r_); \
                n_ = (rdl(n_, 0) + rdl(n_, 16)) + (rdl(n_, 32) + rdl(n_, 48)); e1_ = (rdl(e1_, 0) + rdl(e1_, 16)) + (rdl(e1_, 32) + rdl(e1_, 48)); e2_ = (rdl(e2_, 0) + rdl(e2_, 16)) + (rdl(e2_, 32) + rdl(e2_, 48)); \
                kk_ *= __builtin_amdgcn_rcpf(fmaxf(__builtin_amdgcn_sqrtf(n_), 1e-12f)); const float bo_ = kk_ * a_; const float e3_ = wsum_dpp(bo_ * r_); \
                LDSP float* rec_ = (LDSP float*)(lds + (buf) * RW_BUF + tl_ * (RW_REC * 4)); \
                rec_[lane] = -kk_; rec_[64 + lane] = w_ * r_; rec_[128 + lane] = w_; rec_[192 + lane] = bo_; rec_[256 + lane] = k2_; rec_[320 + lane] = v_; rec_[384 + lane] = bf2f(in[q].g); \
                if (lane == 0) { rec_[448] = e3_; rec_[449] = e2_; rec_[450] = e1_; } } } } while (0)
        __syncthreads();
        RW_LOADIN(0); RW_PREP(0, 0);
        __syncthreads();
        for (int n = 0; n < nch; ++n) {
            if (n + 1 < nch) RW_LOADIN(n + 1);
            const int tn = T - n * RW_CH < RW_CH ? T - n * RW_CH : RW_CH;
            const LDSP unsigned char* bufp = lds + (n & 1) * RW_BUF;
#if defined(PROBE_DUP) && (PROBE_DUP & (1 << 17))
            { RwOp o0, o1; rw_ldop(o0, bufp, cs, rp); pg8::f32x4 T0 = S0, T1 = S1;
              for (int t = 0; t < tn; t += 2) {
                  rw_ldop(o1, bufp + (t + 1) * (RW_REC * 4), cs, rp);
                  rw_step(T0, T1, o0, ybuf + t * RH + 2 * rp, cs == 0);
                  rw_ldop(o0, bufp + (t + 2 < tn ? t + 2 : t) * (RW_REC * 4), cs, rp);
                  rw_step(T0, T1, o1, ybuf + (t + 1) * RH + 2 * rp, cs == 0);
              } asm volatile("" :: "v"(T0), "v"(T1)); }
#endif
            { RwOp o0, o1; rw_ldop(o0, bufp, cs, rp);
              for (int t = 0; t < tn; t += 2) {
                  rw_ldop(o1, bufp + (t + 1) * (RW_REC * 4), cs, rp);
                  rw_step(S0, S1, o0, ybuf + t * RH + 2 * rp, cs == 0);
                  rw_ldop(o0, bufp + (t + 2 < tn ? t + 2 : t) * (RW_REC * 4), cs, rp);
                  rw_step(S0, S1, o1, ybuf + (t + 1) * RH + 2 * rp, cs == 0);
              } }
            if (n + 1 < nch) RW_PREP(n + 1, (n + 1) & 1);
#if defined(PROBE_DUP) && (PROBE_DUP & (1 << 18))
            if (n + 1 < nch) RW_PREP(n + 1, (n + 1) & 1);
#endif
            __syncthreads();
            for (int t = w; t < tn; t += 8) {
                const LDSP float* rec = (const LDSP float*)(bufp + t * (RW_REC * 4));
                const float y = ybuf[t * RH + lane], mean = wsum_dpp(y) * (1.0f / RH), d = y - mean, var = wsum_dpp(d * d) * (1.0f / RH);
                const float yn = d * __builtin_amdgcn_rsqf(var + LNX_EPS) * p_lnw + p_lnb;
                const float o = (yn + rec[450] * rec[320 + lane]) * rec[384 + lane];
                fr.yo[(size_t)(m0 + n * RW_CH + t) * D + ch] = (bf16_t)(pk2bf(o, 0.f) & 0xffffu);
            }
            __syncthreads();
        }
#undef RW_LOADIN
#undef RW_PREP
        float* so = (sq < BATCH ? c.out + O_WKVP + (((size_t)j * BATCH + sq) * RHEADS + h) * RH * RH : c.out + O_WKVS + (((size_t)j * DB + (sq - BATCH)) * RHEADS + h) * RH * RH) + (size_t)(2 * rp) * RH + 4 * cs;
        *(pg8::f32x4*)so = S0; *(pg8::f32x4*)(so + RH) = S1;
    }
}
struct FastMb {
    bf16_t* zb;
    bf16_t* xbcr;
    float* dtraw;
    bf16_t* xbcb;
    float* dt;
    float* y;
    bf16_t* yzn;
    bf16_t *wbint, *wbot;
};
struct EpiMamba {
    static constexpr bool PERM = true;
    bf16_t* zb; bf16_t* xbcr; float* dtraw;
    __device__ __forceinline__ void operator()(const pg8::f32x4 (&acc)[2][2][4][2], const pg8::Unit& u, int wr, int wc, int fr, int fq) const {
        using namespace pg8;
        const int row0 = u.pm * BM + wr * 64 + fr, cl0 = wc * 32 + 8 * fq, pn = u.pn;
        if (pn < 20) {
            bf16_t* base = pn < 8 ? zb : xbcr; const int ldc = pn < 8 ? 2048 : 3072, coff = pn < 8 ? pn * 256 : (pn - 8) * 256;
#pragma unroll
            for (int ai = 0; ai < 2; ++ai)
#pragma unroll
                for (int m = 0; m < 4; ++m) { bf16_t* rowp = base + (size_t)(row0 + ai * HALF + m * 16) * ldc + coff + cl0;
#pragma unroll
                    for (int bj = 0; bj < 2; ++bj) { const f32x4 v0 = acc[ai][bj][m][0], v1 = acc[ai][bj][m][1];
                        u32x4 w; w.x = cvt_pk_bf16(v0[0], v0[1]); w.y = cvt_pk_bf16(v0[2], v0[3]); w.z = cvt_pk_bf16(v1[0], v1[1]); w.w = cvt_pk_bf16(v1[2], v1[3]);
                        *(u32x4*)(rowp + bj * HALF) = w; } }
        } else if (cl0 < 32) {
#pragma unroll
            for (int ai = 0; ai < 2; ++ai)
#pragma unroll
                for (int m = 0; m < 4; ++m) { float* rowp = dtraw + (size_t)(row0 + ai * HALF + m * 16) * 32 + cl0;
                    *(f32x4*)rowp = acc[ai][0][m][0]; *(f32x4*)(rowp + 4) = acc[ai][0][m][1]; }
        }
    }
};
__device__ __forceinline__ void mb_conv_fast(const Ctx& c, const FastMb& fb, int l, size_t gtid, size_t gsz, bool write_f32) {
    using namespace cfg; const int j = l / 3; constexpr int NB = MB_CD / 8, TB = 8;
    for (size_t i = gtid; i < (size_t)(MTOT / TB) * NB; i += gsz) {
        const int mb = (int)(i / NB) * TB, cb = (int)(i % NB) * 8, t0 = row_t(mb), sq = row_seq(mb), T = seq_len(sq);
        float wt[MB_CONV][8], bias[8], win[MB_CONV][8];
#pragma unroll
        for (int e = 0; e < 8; ++e) bias[e] = c.in[I_CONVB][j * MB_CD + cb + e];
#pragma unroll
        for (int jj = 0; jj < MB_CONV; ++jj)
#pragma unroll
            for (int e = 0; e < 8; ++e) wt[jj][e] = c.in[I_CONVW][((size_t)j * MB_CONV + jj) * MB_CD + cb + e];
#pragma unroll
        for (int jj = 0; jj < MB_CONV - 1; ++jj) {
            const int tt = t0 + jj - (MB_CONV - 1);
            if (tt >= 0) { const pg8::u32x4 raw = *(const pg8::u32x4*)(fb.xbcr + (size_t)(mb + jj - (MB_CONV - 1)) * MB_CD + cb); const unsigned wv[4] = {raw.x, raw.y, raw.z, raw.w};
#pragma unroll
                for (int q = 0; q < 4; ++q) { win[jj][2 * q] = __uint_as_float(wv[q] << 16); win[jj][2 * q + 1] = __uint_as_float(wv[q] & 0xffff0000u); } }
            else if (sq >= BATCH) { const float* st = c.in[I_CONV] + (((size_t)j * DB + (sq - BATCH)) * (MB_CONV - 1) + (tt + MB_CONV - 1)) * MB_CD + cb;
#pragma unroll
                for (int e = 0; e < 8; ++e) win[jj][e] = st[e]; }
            else {
#pragma unroll
                for (int e = 0; e < 8; ++e) win[jj][e] = 0.f; }
        }
#pragma unroll
        for (int tb = 0; tb < TB; ++tb) {
            const int m = mb + tb, t = t0 + tb;
            { const pg8::u32x4 raw = *(const pg8::u32x4*)(fb.xbcr + (size_t)m * MB_CD + cb); const unsigned wv[4] = {raw.x, raw.y, raw.z, raw.w};
#pragma unroll
              for (int q = 0; q < 4; ++q) { win[3][2 * q] = __uint_as_float(wv[q] << 16); win[3][2 * q + 1] = __uint_as_float(wv[q] & 0xffff0000u); } }
            if (t >= T - (MB_CONV - 1)) {
                float* so = (sq < BATCH ? c.out + O_CONVP + (((size_t)j * BATCH + sq) * (MB_CONV - 1) + (t - (T - (MB_CONV - 1)))) * MB_CD
                                        : c.out + O_CONVS + (((size_t)j * DB + (sq - BATCH)) * (MB_CONV - 1) + (t - (T - (MB_CONV - 1)))) * MB_CD) + cb;
#pragma unroll
                for (int e = 0; e < 8; ++e) so[e] = win[3][e];
            }
            unsigned w[4];
#pragma unroll
            for (int q = 0; q < 4; ++q) {
                float a0 = bias[2 * q], a1 = bias[2 * q + 1];
#pragma unroll
                for (int jj = 0; jj < MB_CONV; ++jj) { a0 += win[jj][2 * q] * wt[jj][2 * q]; a1 += win[jj][2 * q + 1] * wt[jj][2 * q + 1]; }
                a0 = a0 * __builtin_amdgcn_rcpf(1.0f + __expf(-a0)); a1 = a1 * __builtin_amdgcn_rcpf(1.0f + __expf(-a1));
                w[q] = pk2bf(a0, a1); if (write_f32) { c.xbc[(size_t)m * MB_CD + cb + 2 * q] = a0; c.xbc[(size_t)m * MB_CD + cb + 2 * q + 1] = a1; } }
            *(pg8::u32x4*)(fb.xbcb + (size_t)m * MB_CD + cb) = (pg8::u32x4){w[0], w[1], w[2], w[3]};
#pragma unroll
            for (int jj = 0; jj < MB_CONV - 1; ++jj)
#pragma unroll
                for (int e = 0; e < 8; ++e) win[jj][e] = win[jj + 1][e];
        }
    }
    for (size_t i = gtid; i < (size_t)MTOT * MB_HEADS; i += gsz) {
        const float v = softplusf_(fb.dtraw[i] + c.in[I_DTB][j * MB_HEADS + (int)(i % MB_HEADS)]);
        fb.dt[i] = v; if (write_f32) c.dt[i] = v;
    }
}
__device__ __forceinline__ void mb_gate_fast(const Ctx& c, const FastMb& fb, const float* __restrict__ y, int l, int gw, int ngw, int lane) {
    using namespace cfg; const int j = l / 3; constexpr int GW_ = MB_INNER / MB_GROUPS;
    for (int it = gw; it < MTOT * MB_GROUPS; it += ngw) {
        const int m = it / MB_GROUPS, g = it % MB_GROUPS; const size_t o = (size_t)m * MB_INNER + g * GW_ + 8 * lane;
        const pg8::f32x4 y0 = *(const pg8::f32x4*)(y + o), y1 = *(const pg8::f32x4*)(y + o + 4); const pg8::u32x4 zr = *(const pg8::u32x4*)(fb.zb + o);
        const unsigned zw[4] = {zr.x, zr.y, zr.z, zr.w}; float v[8]; float s = 0.f;
#pragma unroll
        for (int q = 0; q < 4; ++q) { const float z0 = __uint_as_float(zw[q] << 16), z1 = __uint_as_float(zw[q] & 0xffff0000u);
            v[2 * q] = (q < 2 ? y0[2 * q] : y1[2 * q - 4]) * siluf_(z0); v[2 * q + 1] = (q < 2 ? y0[2 * q + 1] : y1[2 * q - 3]) * siluf_(z1); s += v[2 * q] * v[2 * q] + v[2 * q + 1] * v[2 * q + 1]; }
        const float rs = 1.0f / sqrtf(wave_sum64(s) * (1.0f / GW_) + NORM_EPS);
        const float* nw = c.in[I_BNORM] + j * MB_INNER + g * GW_ + 8 * lane; unsigned w[4];
#pragma unroll
        for (int q = 0; q < 4; ++q) w[q] = pk2bf(v[2 * q] * rs * nw[2 * q], v[2 * q + 1] * rs * nw[2 * q + 1]);
        *(pg8::u32x4*)(fb.yzn + o) = (pg8::u32x4){w[0], w[1], w[2], w[3]};
    }
}
constexpr int SS_XR = 144, SS_BR = 272;
constexpr int SS_XIM = 0, SS_XSM = SS_XIM + 128 * SS_XR, SS_BIM = SS_XSM + 128 * SS_XR, SS_CIM = SS_BIM + 128 * SS_BR, SS_MTM = SS_CIM + 128 * SS_BR, SS_HBM = SS_MTM + 128 * SS_BR, SS_TAB = SS_HBM + 128 * SS_XR, SS_END = SS_TAB + 2048;
__device__ __forceinline__ bf16x8v ss_trfrag(const LDSP unsigned char* img, int rowstride, int k0, int col0, int lane) {
    const int r0 = k0 + 8 * (lane >> 5) + ((lane & 15) >> 2), cc = col0 + 16 * ((lane >> 4) & 1) + 4 * (lane & 3);
    const s16x4 t0 = __builtin_amdgcn_ds_read_tr16_b64_v4i16((LDSP s16x4*)(img + r0 * rowstride + cc * 2));
    const s16x4 t1 = __builtin_amdgcn_ds_read_tr16_b64_v4i16((LDSP s16x4*)(img + (r0 + 4) * rowstride + cc * 2));
    return (bf16x8v){t0[0], t0[1], t0[2], t0[3], t1[0], t1[1], t1[2], t1[3]};
}
__device__ __forceinline__ void mb_ssd_prompt(const Ctx& c, const FastMb& fb, int l, LDSP unsigned char* lds) {
    using namespace cfg; const int j = l / 3;
    const int tid = (int)tid_now(), w = __builtin_amdgcn_readfirstlane(tid >> 6), lane = tid & 63, l31 = lane & 31, h5 = lane >> 5;
    LDSP float* tab = (LDSP float*)(lds + SS_TAB);
    for (int chain = blockIdx.x; chain < BATCH * MB_HEADS; chain += gridDim.x) {
        const int b = chain / MB_HEADS, hd = chain % MB_HEADS, g = hd / (MB_HEADS / MB_GROUPS);
        const float Ah = -expf(c.in[I_ALOG][j * MB_HEADS + hd]), Dh = c.in[I_BD][j * MB_HEADS + hd];
        f32x16_t H;
#pragma unroll
        for (int r = 0; r < 16; ++r) H[r] = 0.f;
        pg8::u32x4 nx[2], nB[4], nC[4]; float ndt0 = 0.f, ndt1 = 0.f;
#define SS_LOAD(ck_) do { const size_t mm_ = (size_t)b * SEQ + 128 * (ck_); int tq_ = tid; asm volatile("" : "+v"(tq_)); \
            _Pragma("unroll") for (int q = 0; q < 2; ++q) { const int ci = tq_ + 512 * q; nx[q] = *(const pg8::u32x4*)(fb.xbcb + (mm_ + (ci >> 3)) * MB_CD + hd * MB_HEAD + (ci & 7) * 8); } \
            _Pragma("unroll") for (int q = 0; q < 4; ++q) { const int ci = tq_ + 512 * q; const bf16_t* rowp = fb.xbcb + (mm_ + (ci >> 4)) * MB_CD + MB_INNER + g * MB_STATE + (ci & 15) * 8; \
                nB[q] = *(const pg8::u32x4*)rowp; nC[q] = *(const pg8::u32x4*)(rowp + MB_GN); } \
            ndt0 = fb.dt[(mm_ + 2 * (tq_ & 63)) * MB_HEADS + hd]; ndt1 = fb.dt[(mm_ + 2 * (tq_ & 63) + 1) * MB_HEADS + hd]; } while (0)
        SS_LOAD(0);
        for (int ck = 0; ck < SEQ / 128; ++ck) {
            const size_t m0 = (size_t)b * SEQ + 128 * ck;
            int tl = tid; asm volatile("" : "+v"(tl));
            pg8::u32x4 xr[2];
#pragma unroll
            for (int q = 0; q < 2; ++q) { const int ci = tl + 512 * q; xr[q] = nx[q];
                *(LDSP pg8::u32x2*)(lds + SS_XIM + (ci >> 3) * SS_XR + (ci & 7) * 16) = (pg8::u32x2){xr[q].x, xr[q].y}; *(LDSP pg8::u32x2*)(lds + SS_XIM + (ci >> 3) * SS_XR + (ci & 7) * 16 + 8) = (pg8::u32x2){xr[q].z, xr[q].w}; }
#pragma unroll
            for (int q = 0; q < 4; ++q) { const int ci = tl + 512 * q;
                *(LDSP pg8::u32x4*)(lds + SS_BIM + (ci >> 4) * SS_BR + (ci & 15) * 16) = nB[q];
                *(LDSP pg8::u32x4*)(lds + SS_CIM + (ci >> 4) * SS_BR + (ci & 15) * 16) = nC[q]; }
            float alast;
            { const float v0 = ndt0 * Ah, v1 = ndt1 * Ah; float sacc = v0 + v1;
#pragma unroll
              for (int o = 1; o < 64; o <<= 1) { const float u = __shfl_up(sacc, o); if (lane >= o) sacc += u; }
              tab[2 * lane] = sacc - v1; tab[2 * lane + 1] = sacc; tab[128 + 2 * lane] = ndt0; tab[128 + 2 * lane + 1] = ndt1;
              alast = __int_as_float(__builtin_amdgcn_readlane(__float_as_int(sacc), 63)); }
            if (ck + 1 < SEQ / 128) SS_LOAD(ck + 1);
            asm volatile("s_waitcnt lgkmcnt(0)" ::: "memory");
#pragma unroll
            for (int q = 0; q < 2; ++q) { const int ci = tl + 512 * q, row = ci >> 3; const float sc = __expf(alast - tab[row]) * tab[128 + row]; const unsigned xw[4] = {xr[q].x, xr[q].y, xr[q].z, xr[q].w}; unsigned ow[4];
#pragma unroll
                for (int e = 0; e < 4; ++e) ow[e] = pk2bf(__uint_as_float(xw[e] << 16) * sc, __uint_as_float(xw[e] & 0xffff0000u) * sc);
                *(LDSP pg8::u32x2*)(lds + SS_XSM + row * SS_XR + (ci & 7) * 16) = (pg8::u32x2){ow[0], ow[1]}; *(LDSP pg8::u32x2*)(lds + SS_XSM + row * SS_XR + (ci & 7) * 16 + 8) = (pg8::u32x2){ow[2], ow[3]}; }
            __syncthreads();
            { int ln = lane; asm volatile("" : "+v"(ln)); const int a31 = ln & 31, a5 = ln >> 5;
              for (int tt = w; tt < 10; tt += 8) {
                int ib = tt < 1 ? 0 : (tt < 3 ? 1 : (tt < 6 ? 2 : 3)); const int jb = tt - (ib * (ib + 1)) / 2;
                f32x16_t ST;
#pragma unroll
                for (int r = 0; r < 16; ++r) ST[r] = 0.f;
#pragma unroll
                for (int s = 0; s < 8; ++s) { const bf16x8v a = *(const LDSP bf16x8v*)(lds + SS_BIM + (32 * jb + a31) * SS_BR + (16 * s + 8 * a5) * 2), bb = *(const LDSP bf16x8v*)(lds + SS_CIM + (32 * ib + a31) * SS_BR + (16 * s + 8 * a5) * 2);
                    ST = MFMA32(a, bb, ST); }
                const float ai = tab[32 * ib + a31];
#pragma unroll
                for (int g4 = 0; g4 < 4; ++g4) { const int jr = 32 * jb + 8 * g4 + 4 * a5; const pg8::f32x4 aj = *(const LDSP pg8::f32x4*)(tab + jr), dj = *(const LDSP pg8::f32x4*)(tab + 128 + jr);
#pragma unroll
                    for (int e = 0; e < 4; ++e) { const int jj = jr + e, ii = 32 * ib + a31; const float mv = jj <= ii ? ST[4 * g4 + e] * __expf(ai - aj[e]) * dj[e] : 0.f;
                        *(LDSP bf16_t*)(lds + SS_MTM + jj * SS_BR + ii * 2) = (bf16_t)(pk2bf(mv, 0.f) & 0xffffu); } }
              }
              const int nb = w >> 1, pb = w & 1;
#pragma unroll
              for (int r = 0; r < 16; ++r) *(LDSP bf16_t*)(lds + SS_HBM + (32 * nb + (r & 3) + 8 * (r >> 2) + 4 * a5) * SS_XR + (32 * pb + a31) * 2) = (bf16_t)(pk2bf(H[r], 0.f) & 0xffffu);
            }
            __syncthreads();
            { int ln = lane; asm volatile("" : "+v"(ln)); const int a31 = ln & 31, a5 = ln >> 5;
              const int pb = w & 1, ib = w >> 1, nb = w >> 1;
              f32x16_t Y;
#pragma unroll
              for (int r = 0; r < 16; ++r) Y[r] = 0.f;
#pragma unroll
              for (int s = 0; s < 8; ++s) { const bf16x8v a = ss_trfrag(lds + SS_HBM, SS_XR, 16 * s, 32 * pb, ln), bb = *(const LDSP bf16x8v*)(lds + SS_CIM + (32 * ib + a31) * SS_BR + (16 * s + 8 * a5) * 2);
                  Y = MFMA32(a, bb, Y); if (s & 1) __builtin_amdgcn_sched_barrier(0); }
              const float ei = __expf(tab[32 * ib + a31]);
#pragma unroll
              for (int r = 0; r < 16; ++r) Y[r] *= ei;
              for (int s = 0; s < 2 * (ib + 1); ++s) { const bf16x8v a = ss_trfrag(lds + SS_XIM, SS_XR, 16 * s, 32 * pb, ln), bb = ss_trfrag(lds + SS_MTM, SS_BR, 16 * s, 32 * ib, ln);
                  Y = MFMA32(a, bb, Y); }
              { const size_t mrow = m0 + 32 * ib + a31; float* yrow = fb.y + mrow * MB_INNER + hd * MB_HEAD + 32 * pb + 4 * a5;
#pragma unroll
                for (int g4 = 0; g4 < 4; ++g4) { const pg8::u32x2 xv = *(const LDSP pg8::u32x2*)(lds + SS_XIM + (32 * ib + a31) * SS_XR + (32 * pb + 8 * g4 + 4 * a5) * 2);
                    pg8::f32x4 o; o[0] = Y[4 * g4] + Dh * __uint_as_float(xv.x << 16); o[1] = Y[4 * g4 + 1] + Dh * __uint_as_float(xv.x & 0xffff0000u); o[2] = Y[4 * g4 + 2] + Dh * __uint_as_float(xv.y << 16); o[3] = Y[4 * g4 + 3] + Dh * __uint_as_float(xv.y & 0xffff0000u);
                    *(pg8::f32x4*)(yrow + 8 * g4) = o; } }
              const float dec = __expf(tab[127]);
#pragma unroll
              for (int r = 0; r < 16; ++r) H[r] *= dec;
#pragma unroll
              for (int s = 0; s < 8; ++s) { const bf16x8v a = ss_trfrag(lds + SS_BIM, SS_BR, 16 * s, 32 * nb, ln), bb = ss_trfrag(lds + SS_XSM, SS_XR, 16 * s, 32 * pb, ln);
                  H = MFMA32(a, bb, H); if (s & 1) __builtin_amdgcn_sched_barrier(0); }
            }
            __syncthreads();
        }
#undef SS_LOAD
        { const int nb = w >> 1, pb = w & 1; float* so = c.out + O_SSMP + (((size_t)j * BATCH + b) * MB_HEADS + hd) * MB_HEAD * MB_STATE;
#pragma unroll
          for (int r = 0; r < 16; ++r) so[(size_t)(32 * pb + l31) * MB_STATE + 32 * nb + (r & 3) + 8 * (r >> 2) + 4 * h5] = H[r]; }
    }
}
__device__ __forceinline__ void mb_scan_sample(const Ctx& c, const FastMb& fb, int l) {
    using namespace cfg; const int j = l / 3;
    const int tid = (int)tid_now(), p = tid >> 3, ns = tid & 7;
    pg8::f32x4 hn[4];
    { const int chain = blockIdx.x; if (chain < DB * MB_HEADS) { const size_t so = ((((size_t)j * DB + chain / MB_HEADS) * MB_HEADS + chain % MB_HEADS) * MB_HEAD + p) * MB_STATE + 16 * ns;
#pragma unroll
        for (int q = 0; q < 4; ++q) hn[q] = *(const pg8::f32x4*)(c.in[I_SSM] + so + 4 * q); } }
    for (int chain = blockIdx.x; chain < DB * MB_HEADS; chain += gridDim.x) {
        const int s = chain / MB_HEADS, hd = chain % MB_HEADS, g = hd / (MB_HEADS / MB_GROUPS);
        const float Ah = -expf(c.in[I_ALOG][j * MB_HEADS + hd]), Dh = c.in[I_BD][j * MB_HEADS + hd];
        const size_t so = ((((size_t)j * DB + s) * MB_HEADS + hd) * MB_HEAD + p) * MB_STATE + 16 * ns;
        float hs[16];
#pragma unroll
        for (int q = 0; q < 4; ++q) { hs[4 * q] = hn[q][0]; hs[4 * q + 1] = hn[q][1]; hs[4 * q + 2] = hn[q][2]; hs[4 * q + 3] = hn[q][3]; }
        { const int cn = chain + gridDim.x; if (cn < DB * MB_HEADS) { const size_t sn = ((((size_t)j * DB + cn / MB_HEADS) * MB_HEADS + cn % MB_HEADS) * MB_HEAD + p) * MB_STATE + 16 * ns;
#pragma unroll
            for (int q = 0; q < 4; ++q) hn[q] = *(const pg8::f32x4*)(c.in[I_SSM] + sn + 4 * q); } }
        float dtv[DS]; unsigned short xr[DS]; pg8::u32x4 Bq[DS][2], Cq[DS][2];
#pragma unroll
        for (int t = 0; t < DS; ++t) { const size_t m = (size_t)MP + s * DS + t; dtv[t] = fb.dt[m * MB_HEADS + hd]; xr[t] = fb.xbcb[m * MB_CD + hd * MB_HEAD + p];
            const bf16_t* Bp = fb.xbcb + m * MB_CD + MB_INNER + g * MB_STATE + 16 * ns; Bq[t][0] = *(const pg8::u32x4*)Bp; Bq[t][1] = *(const pg8::u32x4*)(Bp + 8);
            Cq[t][0] = *(const pg8::u32x4*)(Bp + MB_GN); Cq[t][1] = *(const pg8::u32x4*)(Bp + MB_GN + 8); }
#pragma unroll
        for (int t = 0; t < DS; ++t) {
            const size_t m = (size_t)MP + s * DS + t;
            const float dA = __expf(dtv[t] * Ah), xv = bf2f(xr[t]), xdt = xv * dtv[t];
            const unsigned bw[8] = {Bq[t][0].x, Bq[t][0].y, Bq[t][0].z, Bq[t][0].w, Bq[t][1].x, Bq[t][1].y, Bq[t][1].z, Bq[t][1].w};
            const unsigned cw[8] = {Cq[t][0].x, Cq[t][0].y, Cq[t][0].z, Cq[t][0].w, Cq[t][1].x, Cq[t][1].y, Cq[t][1].z, Cq[t][1].w};
            float yy = 0.f;
#pragma unroll
            for (int k = 0; k < 8; ++k) { hs[2 * k] = hs[2 * k] * dA + xdt * __uint_as_float(bw[k] << 16); hs[2 * k + 1] = hs[2 * k + 1] * dA + xdt * __uint_as_float(bw[k] & 0xffff0000u);
                yy += __uint_as_float(cw[k] << 16) * hs[2 * k] + __uint_as_float(cw[k] & 0xffff0000u) * hs[2 * k + 1]; }
            yy += __shfl_xor(yy, 1); yy += __shfl_xor(yy, 2); yy += __shfl_xor(yy, 4);
            if (ns == 0) fb.y[m * MB_INNER + hd * MB_HEAD + p] = yy + Dh * xv;
        }
        float* oo = c.out + O_SSMS + so;
#pragma unroll
        for (int q = 0; q < 4; ++q) *(pg8::f32x4*)(oo + 4 * q) = (pg8::f32x4){hs[4 * q], hs[4 * q + 1], hs[4 * q + 2], hs[4 * q + 3]};
    }
}
constexpr int RC_RS = 144;
constexpr int RC_AT = 0, RC_RT = 4608, RC_BB = 9216, RC_KB = 13824, RC_BH = 18432, RC_KH = 23040, RC_VV = 27648, RC_UT = 32256, RC_GG = 36864;
constexpr int RC_SB = 41472;
constexpr int RC_NAK = 50688, RC_MRB = 53248, RC_MRK = 55808, RC_NS = 80;
constexpr int RC_NAB = 58368;
constexpr int RC_E = 62464;
constexpr int RC_YB = 70656;
constexpr int RC_GL = 78848, RC_BON = 79104, RC_VV2 = 79360, RC_GG2 = RC_VV2 + 4608, RC_END0 = RC_GG2 + 4608;
constexpr int RC_WW = RC_END0, RC_WA = RC_WW + 64 * 144, RC_WG = RC_WA + 64 * 144, RC_WV = RC_WG + 64 * 336, RC_LUO = RC_WV + 64 * 80, RC_END = RC_LUO + 4 * 4608;
constexpr int RC_HB = RC_AT, RC_HBS = 784;
__device__ __forceinline__ bf16x8v rc_nat(const LDSP unsigned char* img, int stride, int row, int kofs) { return *(const LDSP bf16x8v*)(img + row * stride + kofs * 2); }
__device__ __forceinline__ int rc_row(int r, int h5) { return (r & 3) + 8 * (r >> 2) + 4 * h5; }
__device__ __forceinline__ void rc_st16(LDSP unsigned char* p, float v) { *(LDSP bf16_t*)p = (bf16_t)(pk2bf(v, 0.f) & 0xffffu); }


template <int S>
struct RcSub {
    static __device__ __forceinline__ void run(float (&acc)[32], const LDSP float* NAB, LDSP unsigned char* lds, int lane) {
        const float us = acc[S]; rc_st16(lds + RC_UT + S * RC_RS + lane * 2, us);
#pragma unroll
        for (int g4 = 0; g4 < 8; ++g4) { if (4 * g4 + 3 > S) { const pg8::f32x4 nv = *(const LDSP pg8::f32x4*)(NAB + S * 32 + 4 * g4);
#pragma unroll
            for (int e = 0; e < 4; ++e) { if (4 * g4 + e > S) acc[4 * g4 + e] = fmaf(nv[e], us, acc[4 * g4 + e]); } } }
        RcSub<S + 1>::run(acc, NAB, lds, lane);
    }
};
template <> struct RcSub<32> { static __device__ __forceinline__ void run(float (&)[32], const LDSP float*, LDSP unsigned char*, int) {} };

template <int J>
__device__ __forceinline__ void rw_scan_chunked(const Ctx& c, const FastRw& fr, LDSP unsigned char* lds) {
    using namespace cfg; constexpr int j = J;
    const int tid = (int)tid_now(), w = __builtin_amdgcn_readfirstlane(tid >> 6), lane = tid & 63, l31 = lane & 31, h5 = lane >> 5;
    LDSP float* Ef = (LDSP float*)(lds + RC_E); LDSP float* YB = (LDSP float*)(lds + RC_YB); LDSP float* GL = (LDSP float*)(lds + RC_GL); LDSP float* BON = (LDSP float*)(lds + RC_BON);
    LDSP float* NAB = (LDSP float*)(lds + RC_NAB);
    int hcur = -1;
    for (int chain = blockIdx.x; chain < NSEQ * RHEADS; chain += gridDim.x) {
        const int sq = chain / RHEADS, h = chain % RHEADS, T = seq_len(sq), m0 = seq_row0(sq), ch = h * RH + lane;
        const float p_w0 = c.in[I_W0][j * D + ch], p_a0 = c.in[I_A0][j * D + ch], p_kk = c.in[I_KK][j * D + ch], p_ka = c.in[I_KA][j * D + ch], p_rk = c.in[I_RK][(size_t)j * D + ch],
                    p_lnw = c.in[I_LNW][j * D + ch], p_lnb = c.in[I_LNB][j * D + ch], p_v0 = j > 0 ? c.in[I_V0][(j - 1) * D + ch] : 0.f;
        const int ib = (w >> 1) & 1, jb = w & 1;
        f32x16_t ST;
#pragma unroll
        for (int r = 0; r < 16; ++r) ST[r] = 0.f;
        if (w < 4 && sq >= BATCH) { const float* s0 = c.in[I_WKV] + (((size_t)j * DB + (sq - BATCH)) * RHEADS + h) * RH * RH;
#pragma unroll
            for (int r = 0; r < 16; ++r) ST[r] = s0[(size_t)(32 * ib + rc_row(r, h5)) * RH + 32 * jb + l31]; }
        const int nch = (T + 31) / 32;
        if (h != hcur) {
            __syncthreads();
            const bf16_t* lw = fr.lorat + (size_t)j * 4096 * 384;
            for (int ci = tid; ci < 64 * 8; ci += 512) { const int row = ci >> 3, c8 = ci & 7;
                *(LDSP pg8::u32x4*)(lds + RC_WW + row * 144 + c8 * 16) = *(const pg8::u32x4*)(lw + (size_t)(0 * 1024 + h * 64 + row) * 384 + 0 + c8 * 8);
                *(LDSP pg8::u32x4*)(lds + RC_WA + row * 144 + c8 * 16) = *(const pg8::u32x4*)(lw + (size_t)(1 * 1024 + h * 64 + row) * 384 + 64 + c8 * 8); }
            for (int ci = tid; ci < 64 * 20; ci += 512) { const int row = ci / 20, c20 = ci % 20;
                *(LDSP pg8::u32x4*)(lds + RC_WG + row * 336 + c20 * 16) = *(const pg8::u32x4*)(lw + (size_t)(2 * 1024 + h * 64 + row) * 384 + 128 + c20 * 8); }
            for (int ci = tid; ci < 64 * 4; ci += 512) { const int row = ci >> 2, c4 = ci & 3;
                *(LDSP pg8::u32x4*)(lds + RC_WV + row * 80 + c4 * 16) = *(const pg8::u32x4*)(lw + (size_t)(3 * 1024 + h * 64 + row) * 384 + 288 + c4 * 8); }
            hcur = h;
        }
        RwIn in[4]; pg8::u32x4 hbr[3];
#define RC_LOADIN(n) do { _Pragma("unroll") for (int q = 0; q < 4; ++q) { const int t_ = (n) * 32 + 4 * w + q; if (t_ < T) { const size_t m_ = (size_t)(m0 + t_); \
                const bf16_t* rk_ = fr.rkv + m_ * 3072 + ch; in[q].r = rk_[0]; in[q].k = rk_[1024]; in[q].v = rk_[2048]; \
                in[q].vf = j > 0 ? fr.vf[m_ * D + ch] : 0.f; } } \
            _Pragma("unroll") for (int k3 = 0; k3 < 3; ++k3) { const int ci_ = tid + 512 * k3, tk_ = ci_ / 48, t_ = (n) * 32 + tk_; \
                hbr[k3] = t_ < T ? *(const pg8::u32x4*)(fr.hb + (size_t)(m0 + t_) * 384 + (ci_ % 48) * 8) : (pg8::u32x4){0u, 0u, 0u, 0u}; } } while (0)
#define RC_EPI_TOKEN(nn, tl) do { const int vv_ = ((nn) & 1) ? RC_VV2 : RC_VV, gg_ = ((nn) & 1) ? RC_GG2 : RC_GG, bn_ = ((nn) & 1) ? 32 : 0; \
                const float y_ = YB[(tl) * 64 + lane], mean_ = wsum_dpp(y_) * (1.0f / RH), d_ = y_ - mean_, var_ = wsum_dpp(d_ * d_) * (1.0f / RH); \
                const float yn_ = d_ * __builtin_amdgcn_rsqf(var_ + LNX_EPS) * p_lnw + p_lnb; \
                const float o_ = (yn_ + BON[bn_ + (tl)] * bf2f(*(const LDSP bf16_t*)(lds + vv_ + (tl) * RC_RS + lane * 2))) * bf2f(*(const LDSP bf16_t*)(lds + gg_ + (tl) * RC_RS + lane * 2)); \
                fr.yo[(size_t)(m0 + (nn) * 32 + (tl)) * D + ch] = (bf16_t)(pk2bf(o_, 0.f) & 0xffffu); } while (0)
        __syncthreads();
        RC_LOADIN(0);
        for (int n = 0; n < nch; ++n) {
            const int tn = T - n * 32 < 32 ? T - n * 32 : 32;
            const int vvo = (n & 1) ? RC_VV2 : RC_VV, ggo = (n & 1) ? RC_GG2 : RC_GG, bno = (n & 1) ? 32 : 0;
#pragma unroll
            for (int k3 = 0; k3 < 3; ++k3) { const int ci_ = tid + 512 * k3; *(LDSP pg8::u32x4*)(lds + RC_HB + (ci_ / 48) * RC_HBS + (ci_ % 48) * 16) = hbr[k3]; }
            __syncthreads();
            { int ln = lane; asm volatile("" : "+v"(ln)); const int a31 = ln & 31, a5 = ln >> 5; const int grp = w >> 1, nb = w & 1;
              const int koff = grp == 0 ? 0 : (grp == 1 ? 64 : (grp == 2 ? 128 : 288)), nks = grp == 2 ? 10 : (grp == 3 ? 2 : 4);
              const int wof = grp == 0 ? RC_WW : (grp == 1 ? RC_WA : (grp == 2 ? RC_WG : RC_WV)), wst = grp == 2 ? 336 : (grp == 3 ? 80 : 144);
              f32x16_t LA;
#pragma unroll
              for (int r = 0; r < 16; ++r) LA[r] = 0.f;
              for (int ks = 0; ks < nks; ++ks) LA = MFMA32(rc_nat(lds + RC_HB, RC_HBS, a31, koff + 16 * ks + 8 * a5), rc_nat(lds + wof, wst, 32 * nb + a31, 16 * ks + 8 * a5), LA);
#pragma unroll
              for (int r = 0; r < 16; ++r) rc_st16(lds + RC_LUO + grp * 4608 + rc_row(r, a5) * RC_RS + (32 * nb + a31) * 2, LA[r]); }
            __syncthreads();
            float q_r[4], q_k[4], q_a[4], q_b[4], q_e[4];
#pragma unroll
            for (int q = 0; q < 4; ++q) {
                const int tl = 4 * w + q, tg = n * 32 + tl;
                float r_ = 0.f, k2_ = 0.f, v_ = 0.f, a_ = 0.f, b_ = 0.f, e_ = 0.f, g_ = 0.f, bon_ = 0.f;
                if (tg < T) {
                    r_ = bf2f(in[q].r); const float k0_ = bf2f(in[q].k); v_ = bf2f(in[q].v);
                    e_ = 0.6065306597126334f * fsigmoid(p_w0 + bf2f(*(const LDSP bf16_t*)(lds + RC_LUO + 0 * 4608 + tl * RC_RS + lane * 2)));
                    if (j == 0) fr.vf[(size_t)(m0 + tg) * D + ch] = v_; else v_ = v_ + (in[q].vf - v_) * fsigmoid(p_v0 + bf2f(*(const LDSP bf16_t*)(lds + RC_LUO + 3 * 4608 + tl * RC_RS + lane * 2)));
                    const float as_ = fsigmoid(p_a0 + bf2f(*(const LDSP bf16_t*)(lds + RC_LUO + 1 * 4608 + tl * RC_RS + lane * 2))); float kk_ = k0_ * p_kk;
                    k2_ = k0_ * (1.0f + (as_ - 1.0f) * p_ka);
                    float n_ = red16(kk_ * kk_), e1_ = red16(r_ * k2_ * p_rk);
                    n_ = (rdl(n_, 0) + rdl(n_, 16)) + (rdl(n_, 32) + rdl(n_, 48)); bon_ = (rdl(e1_, 0) + rdl(e1_, 16)) + (rdl(e1_, 32) + rdl(e1_, 48));
                    kk_ *= __builtin_amdgcn_rcpf(fmaxf(__builtin_amdgcn_sqrtf(n_), 1e-12f));
                    a_ = -kk_; b_ = kk_ * as_; g_ = bf2f(*(const LDSP bf16_t*)(lds + RC_LUO + 2 * 4608 + tl * RC_RS + lane * 2));
                }
                q_r[q] = r_; q_k[q] = k2_; q_a[q] = a_; q_b[q] = b_; q_e[q] = e_;
                Ef[tl * 64 + lane] = e_;
                rc_st16(lds + vvo + tl * RC_RS + lane * 2, v_); rc_st16(lds + ggo + tl * RC_RS + lane * 2, g_);
                if (lane == 0) BON[bno + tl] = bon_;
            }
            if (n + 1 < nch) RC_LOADIN(n + 1);
            if (w < 4) {
#pragma unroll
                for (int r = 0; r < 16; ++r) rc_st16(lds + RC_SB + (32 * ib + rc_row(r, h5)) * RC_RS + (32 * jb + l31) * 2, ST[r]);
            }
            __syncthreads();
            { float run = 0.f, base = 0.f;
#pragma unroll
              for (int s = 0; s < 32; ++s) { const float ev = Ef[s * 64 + lane]; if (s == 4 * w) base = run; run += ev; }
              const float cumL = run; float cum = base;
#pragma unroll
              for (int q = 0; q < 4; ++q) { const int tl = 4 * w + q; const float cprev = cum; cum += q_e[q];
                  const float gam = __expf(-cum), gamp = __expf(-cprev), ginv = __expf(cum), glr = __expf(cum - cumL);
                  rc_st16(lds + RC_AT + tl * RC_RS + lane * 2, q_a[q] * gamp); rc_st16(lds + RC_RT + tl * RC_RS + lane * 2, q_r[q] * gam);
                  rc_st16(lds + RC_BB + tl * RC_RS + lane * 2, q_b[q] * ginv); rc_st16(lds + RC_KB + tl * RC_RS + lane * 2, q_k[q] * ginv);
                  rc_st16(lds + RC_BH + tl * RC_RS + lane * 2, q_b[q] * glr); rc_st16(lds + RC_KH + tl * RC_RS + lane * 2, q_k[q] * glr); }
              if (w == 0) GL[lane] = __expf(-cumL); }
            __syncthreads();
            f32x16_t R1;
#pragma unroll
            for (int r = 0; r < 16; ++r) R1[r] = 0.f;
            { int ln = lane; asm volatile("" : "+v"(ln)); const int a31 = ln & 31, a5 = ln >> 5;
              if (w < 4) {
                  const int aoff = (w == 0) ? RC_BB : ((w < 2) ? RC_AT : RC_RT), boff = (w == 0) ? RC_AT : ((w & 1) ? RC_KB : RC_BB);
#pragma unroll
                  for (int ks = 0; ks < 4; ++ks) R1 = MFMA32(rc_nat(lds + aoff, RC_RS, a31, 16 * ks + 8 * a5), rc_nat(lds + boff, RC_RS, a31, 16 * ks + 8 * a5), R1);
#pragma unroll
                  for (int r = 0; r < 16; ++r) { const int rr = rc_row(r, a5), cc = a31;
                      if (w == 0) NAB[rr * 32 + cc] = (rr < cc) ? R1[r] : 0.f;
                      else { const bool keep = (w < 2) ? (cc < rr) : (cc <= rr); rc_st16(lds + (w == 1 ? RC_NAK : (w == 2 ? RC_MRB : RC_MRK)) + rr * RC_NS + cc * 2, keep ? R1[r] : 0.f); } }
              } else {
                  const int aoff = (w < 6) ? RC_AT : RC_RT, ibk = w & 1;
#pragma unroll
                  for (int ks = 0; ks < 4; ++ks) R1 = MFMA32(rc_nat(lds + aoff, RC_RS, a31, 16 * ks + 8 * a5), rc_nat(lds + RC_SB, RC_RS, 32 * ibk + a31, 16 * ks + 8 * a5), R1);
              } }
            __syncthreads();
            if (w == 4 || w == 5) { int ln = lane; asm volatile("" : "+v"(ln)); const int a31 = ln & 31, a5 = ln >> 5, ibk = w & 1;
#pragma unroll
                for (int ks = 0; ks < 2; ++ks) R1 = MFMA32(rc_nat(lds + RC_NAK, RC_NS, a31, 16 * ks + 8 * a5), ss_trfrag(lds + vvo, RC_RS, 16 * ks, 32 * ibk, ln), R1);
#pragma unroll
                for (int r = 0; r < 16; ++r) Ef[rc_row(r, a5) * 64 + 32 * ibk + a31] = R1[r]; }
            __syncthreads();
            if (w > 0 && n > 0) { for (int tl = w - 1; tl < 32; tl += 7) RC_EPI_TOKEN(n - 1, tl); }
            if (w == 0) { float acc[32];
#pragma unroll
                for (int t = 0; t < 32; ++t) acc[t] = Ef[t * 64 + lane];
                RcSub<0>::run(acc, NAB, lds, lane); }
            __syncthreads();
            { int ln = lane; asm volatile("" : "+v"(ln)); const int a31 = ln & 31, a5 = ln >> 5;
              if (w >= 6) { const int ibk = w & 1;
#pragma unroll
                  for (int ks = 0; ks < 2; ++ks) { R1 = MFMA32(rc_nat(lds + RC_MRB, RC_NS, a31, 16 * ks + 8 * a5), ss_trfrag(lds + RC_UT, RC_RS, 16 * ks, 32 * ibk, ln), R1);
                                                   R1 = MFMA32(rc_nat(lds + RC_MRK, RC_NS, a31, 16 * ks + 8 * a5), ss_trfrag(lds + vvo, RC_RS, 16 * ks, 32 * ibk, ln), R1); }
#pragma unroll
                  for (int r = 0; r < 16; ++r) YB[rc_row(r, a5) * 64 + 32 * ibk + a31] = R1[r];
              } else if (w < 4) { const float gl = GL[32 * jb + a31];
#pragma unroll
                  for (int r = 0; r < 16; ++r) ST[r] *= gl;
#pragma unroll
                  for (int ks = 0; ks < 2; ++ks) { ST = MFMA32(ss_trfrag(lds + RC_UT, RC_RS, 16 * ks, 32 * ib, ln), ss_trfrag(lds + RC_BH, RC_RS, 16 * ks, 32 * jb, ln), ST);
                                                   ST = MFMA32(ss_trfrag(lds + vvo, RC_RS, 16 * ks, 32 * ib, ln), ss_trfrag(lds + RC_KH, RC_RS, 16 * ks, 32 * jb, ln), ST); } } }
            __syncthreads();
        }
        { const int nl = nch - 1, tnl = T - nl * 32 < 32 ? T - nl * 32 : 32; for (int tl = w; tl < tnl; tl += 8) RC_EPI_TOKEN(nl, tl); }
#undef RC_EPI_TOKEN
#undef RC_LOADIN
        if (w < 4) { float* so = (sq < BATCH ? c.out + O_WKVP + (((size_t)j * BATCH + sq) * RHEADS + h) * RH * RH : c.out + O_WKVS + (((size_t)j * DB + (sq - BATCH)) * RHEADS + h) * RH * RH);
#pragma unroll
            for (int r = 0; r < 16; ++r) so[(size_t)(32 * ib + rc_row(r, h5)) * RH + 32 * jb + l31] = ST[r]; }
    }
}
template <int ACT, bool ACC>
__device__ __forceinline__ void gemm_dev(const float* __restrict__ A, int lda, const float* __restrict__ B, int ldb, float* C, int ldc, int M, int N, int K, unsigned short (*As)[40], unsigned short (*Bs)[40]) {
    const int tid = threadIdx.x, wave = tid >> 6, lane = tid & 63, wr = wave >> 1, wc = wave & 1, fr = lane & 15, fq = lane >> 4;
    const int ntn = (N + 127) / 128, ntm = (M + 127) / 128;
    for (int tile = blockIdx.x; tile < ntm * ntn; tile += gridDim.x) {
        const int bm = (tile / ntn) * 128, bn = (tile % ntn) * 128;
        f32x4_t acc[2][4];
#pragma unroll
        for (int i = 0; i < 2; ++i)
#pragma unroll
            for (int j = 0; j < 4; ++j) acc[i][j] = (f32x4_t){0.f, 0.f, 0.f, 0.f};
        for (int k0 = 0; k0 < K; k0 += 32) {
#pragma unroll
            for (int it = 0; it < 2; ++it) {
                const int idx = tid + it * 512, row = idx >> 3, c4 = idx & 7, gm = bm + row;
                float4 v = make_float4(0.f, 0.f, 0.f, 0.f);
                if (gm < M) v = *(const float4*)(A + (size_t)gm * lda + k0 + c4 * 4);
                uint2 w; w.x = (unsigned)f2bf(v.x) | ((unsigned)f2bf(v.y) << 16); w.y = (unsigned)f2bf(v.z) | ((unsigned)f2bf(v.w) << 16);
                *(uint2*)&As[row][c4 * 4] = w;
            }
#pragma unroll
            for (int it = 0; it < 2; ++it) {
                const int idx = tid + it * 512, kr = idx >> 5, n4 = idx & 31, gn = bn + n4 * 4;
                float4 v = make_float4(0.f, 0.f, 0.f, 0.f);
                if (gn < N) v = *(const float4*)(B + (size_t)(k0 + kr) * ldb + gn);
                Bs[n4 * 4 + 0][kr] = f2bf(v.x); Bs[n4 * 4 + 1][kr] = f2bf(v.y); Bs[n4 * 4 + 2][kr] = f2bf(v.z); Bs[n4 * 4 + 3][kr] = f2bf(v.w);
            }
            __syncthreads();
            bf16x8_t a[2], b[4];
#pragma unroll
            for (int i = 0; i < 2; ++i) a[i] = *(const bf16x8_t*)&As[wr * 32 + i * 16 + fr][fq * 8];
#pragma unroll
            for (int j = 0; j < 4; ++j) b[j] = *(const bf16x8_t*)&Bs[wc * 64 + j * 16 + fr][fq * 8];
#pragma unroll
            for (int i = 0; i < 2; ++i)
#pragma unroll
                for (int j = 0; j < 4; ++j) acc[i][j] = __builtin_amdgcn_mfma_f32_16x16x32_bf16(a[i], b[j], acc[i][j], 0, 0, 0);
            __syncthreads();
        }
#pragma unroll
        for (int i = 0; i < 2; ++i)
#pragma unroll
            for (int j = 0; j < 4; ++j)
#pragma unroll
                for (int e = 0; e < 4; ++e) {
                    const int row = bm + wr * 32 + i * 16 + fq * 4 + e, col = bn + wc * 64 + j * 16 + fr;
                    if (row < M && col < N) {
                        float v = acc[i][j][e];
                        if (ACT == 1) v = tanhf(v); else if (ACT == 2) v = 1.0f / (1.0f + expf(-v)); else if (ACT == 3) v = v > 0.f ? v * v : 0.f;
                        float* cp = C + (size_t)row * ldc + col; *cp = ACC ? *cp + v : v;
                    }
                }
    }
}

#define MRUN(ph, l) do { ph(c, l, gtid, gsz); xcd_barrier(bar); } while (0)
#define MGEMM(ACT, ACC, A, lda, B, ldb, C, ldc, M, N, K) do { gemm_dev<ACT, ACC>(A, lda, B, ldb, C, ldc, M, N, K, As, Bs); xcd_barrier(bar); } while (0)
#define KS_FFN 16
#define KS_1K 4
#define KS_MB 8
#ifndef ACC_KSPLIT
#define ACC_KSPLIT 1
#endif
#ifndef FFN_DOWN_KSPLIT
#define FFN_DOWN_KSPLIT 1
#endif
#define GBAR() xcd_barrier(bar)
#ifndef PROBE_DUP
#define PROBE_DUP 0
#endif
#define DUP(bit, ...) do { __VA_ARGS__; if (PROBE_DUP & (1 << (bit))) { GBAR(); __VA_ARGS__; } } while (0)
#define GTID_NOW() ((size_t)blockIdx.x * 512 + tid_now())
#define GSZ_NOW() ((size_t)gridDim.x * 512)
#define GW_NOW() ((int)(blockIdx.x * 8 + (tid_now() >> 6)))
#define NGW_NOW() ((int)(gridDim.x * 8))
#define LANE_NOW() ((int)(tid_now() & 63))
#undef MRUN
#undef MGEMM
#define MRUN(ph, l) do { ph(c, l, GTID_NOW(), GSZ_NOW()); xcd_barrier(bar); } while (0)
#define MGEMM(ACT, ACC, A, lda, B, ldb, C, ldc, M, N, K) do { gemm_dev<ACT, ACC>(A, lda, B, ldb, C, ldc, M, N, K, (unsigned short (*)[40])dynlds, (unsigned short (*)[40])(dynlds + 128 * 40 * 2)); xcd_barrier(bar); } while (0)
extern __shared__ __attribute__((aligned(16))) unsigned char dynlds[];

struct MegaArgs { Ctx c; Fast f; FastMla fm; FastRw fr; FastMb fb; unsigned* bar; };
constexpr int LDS_STAGE = 0, LDS_XB = 163840 - 64, LDS_BYTES = 163840;
static_assert(SD_END <= LDS_XB && SS_END <= LDS_XB && RC_END <= LDS_XB, "LDS map");

template <int L>
__device__ __forceinline__ void layer_mix_naive(const Ctx& c, const XcdBarrier& bar) {
    using namespace cfg;
    constexpr int l = L, kind = L % 3, j = L / 3;
    MRUN(ph_norm_mix, l);
    if constexpr (kind == 0) {
        MRUN(ph_rw_mix, l);
        const float* W = c.in[I_WRKV] + (size_t)j * 3 * D * D;
        MGEMM(0, false, c.xm[0], D, W, D, c.r, D, MTOT, D, D);
        MGEMM(0, false, c.xm[1], D, W + (size_t)D * D, D, c.k, D, MTOT, D, D);
        MGEMM(0, false, c.xm[2], D, W + (size_t)2 * D * D, D, c.v, D, MTOT, D, D);
        MGEMM(1, false, c.xm[3], D, c.in[I_W1] + (size_t)j * D * RW_DL, RW_DL, c.hw, RW_DL, MTOT, RW_DL, D);
        MGEMM(0, false, c.hw, RW_DL, c.in[I_W2] + (size_t)j * RW_DL * D, D, c.wpre, D, MTOT, D, RW_DL);
        MGEMM(0, false, c.xm[4], D, c.in[I_A1] + (size_t)j * D * RW_AL, RW_AL, c.ha, RW_AL, MTOT, RW_AL, D);
        MGEMM(0, false, c.ha, RW_AL, c.in[I_A2] + (size_t)j * RW_AL * D, D, c.apre, D, MTOT, D, RW_AL);
        if constexpr (j > 0) {
            MGEMM(0, false, c.xm[2], D, c.in[I_V1] + (size_t)(j - 1) * D * RW_VL, RW_VL, c.hv, RW_VL, MTOT, RW_VL, D);
            MGEMM(0, false, c.hv, RW_VL, c.in[I_V2] + (size_t)(j - 1) * RW_VL * D, D, c.vpre, D, MTOT, D, RW_VL);
        }
        MGEMM(2, false, c.xm[5], D, c.in[I_G1] + (size_t)j * D * RW_GL, RW_GL, c.hg, RW_GL, MTOT, RW_GL, D);
        MGEMM(0, false, c.hg, RW_GL, c.in[I_G2] + (size_t)j * RW_GL * D, D, c.g, D, MTOT, D, RW_GL);
        MRUN(ph_rw_prep, l); MRUN(ph_rw_scan, l); MRUN(ph_rw_post, l);
        MGEMM(0, true, c.yo, D, c.in[I_RWO] + (size_t)j * D * D, D, c.x, D, MTOT, D, D);
    } else if constexpr (kind == 1) {
        MGEMM(0, false, c.xn, D, c.in[I_MWIN] + (size_t)j * D * MLA_IN, MLA_IN, c.mh, MLA_IN, MTOT, MLA_IN, D);
        MRUN(ph_mla_norm1, l);
        MGEMM(0, false, c.qan, QL, c.in[I_WUQ] + (size_t)j * QL * MH * QD, MH * QD, c.q, MH * QD, MTOT, MH * QD, QL);
        MGEMM(0, false, c.c, KVL, c.in[I_WUK] + (size_t)j * KVL * MH * NOPE, MH * NOPE, c.knr, MH * NOPE, MTOT, MH * NOPE, KVL);
        MGEMM(0, false, c.c, KVL, c.in[I_WUV] + (size_t)j * KVL * MH * VD, MH * VD, c.vv, MH * VD, MTOT, MH * VD, KVL);
        MRUN(ph_mla_norm2, l); MRUN(ph_mla_attn_prompt, l); MRUN(ph_mla_score_sample, l); MRUN(ph_mla_softmax_sample, l); MRUN(ph_mla_pv_sample, l); MRUN(ph_mla_out_sample, l);
        MGEMM(0, true, c.ao, MH * VD, c.in[I_MWO] + (size_t)j * MH * VD * D, D, c.x, D, MTOT, D, MH * VD);
    } else {
        MGEMM(0, false, c.xn, D, c.in[I_BWIN] + (size_t)j * D * MB_IN, MB_IN, c.zx, MB_IN, MTOT, MB_IN, D);
        MRUN(ph_mb_conv, l); MRUN(ph_mb_dt, l); MRUN(ph_mb_scan, l); MRUN(ph_mb_gate, l);
        MGEMM(0, true, c.yzn, MB_INNER, c.in[I_BWO] + (size_t)j * MB_INNER * D, D, c.x, D, MTOT, D, MB_INNER);
    }
}


template <int L>
__device__ __forceinline__ void layer_rwkv_fast(const Ctx& c, const Fast& f, const FastRw& fr, const XcdBarrier& bar, LDSP unsigned char* lds) {
    using namespace cfg;
    constexpr int l = L, j = L / 3;
    if (L > 0) { fold_sample_rows(c.x, f.slab, KS_FFN, GW_NOW(), NGW_NOW(), LANE_NOW()); GBAR(); }
    DUP(9, rw_mix_fast(c, fr, l, GW_NOW(), NGW_NOW(), LANE_NOW()));
    GBAR();
    DUP(7, { pg8::Order<RwSel> S; S.init(MP / 256, MS / 256, 16, D, 1, gridDim.x, blockIdx.x);
      pg8::gemm_phase(lds, pg8::Gemm{fr.xm, fr.wrkvt + (size_t)j * 4096 * D, D, D, (size_t)MTOT * D}, S, EpiRwkv{fr.rkv, fr.hb}); });
    GBAR();
    DUP(2, rw_scan_chunked<j>(c, fr, lds));
    GBAR();
    { pg8::Order<> S; S.init(MP / 256, MS / 256, 4, D, KS_1K, gridDim.x, blockIdx.x);
      pg8::gemm_phase(lds, pg8::Gemm{fr.yo, fr.wot + (size_t)j * D * D, D, D, 0}, S, pg8::EpiAccF32{c.x, D, f.slab, MP / 256, MS / 256, KS_1K}); }
    if (PROBE_DUP & (1 << 26)) { GBAR(); pg8::Order<> S; S.init(MP / 256, MS / 256, 4, D, KS_1K, gridDim.x, blockIdx.x);
      pg8::gemm_phase(lds, pg8::Gemm{fr.yo, fr.wot + (size_t)j * D * D, D, D, 0}, S, pg8::EpiAccF32{c.hmid, D, f.slab + (size_t)16 * 16 * 65536, MP / 256, MS / 256, KS_1K}); }
    GBAR();
}

__device__ __forceinline__ void layer_mamba_fast(const Ctx& c, const Fast& f, const FastMb& fb, const XcdBarrier& bar, LDSP unsigned char* lds) {
    using namespace cfg;
    constexpr int l = 2, j = 0;
    norm_rows_bf16(c.x, c.in[I_NMIX] + l * D, f.xnb, f.slab, KS_FFN, GW_NOW(), NGW_NOW(), LANE_NOW());
    GBAR();
    DUP(8, { pg8::Order<> S; S.init(MP / 256, MS / 256, 21, D, 1, gridDim.x, blockIdx.x);
      pg8::gemm_phase(lds, pg8::Gemm{f.xnb, fb.wbint, D, D, 0}, S, EpiMamba{fb.zb, fb.xbcr, fb.dtraw}); });
    GBAR();
    DUP(12, mb_conv_fast(c, fb, l, GTID_NOW(), GSZ_NOW(), false));
    GBAR();
    DUP(6, mb_ssd_prompt(c, fb, l, lds); mb_scan_sample(c, fb, l));
    GBAR();
    DUP(13, mb_gate_fast(c, fb, fb.y, l, GW_NOW(), NGW_NOW(), LANE_NOW()));
    GBAR();
    { pg8::Order<> S; S.init(MP / 256, MS / 256, 4, MB_INNER, KS_MB, gridDim.x, blockIdx.x);
      pg8::gemm_phase(lds, pg8::Gemm{fb.yzn, fb.wbot, MB_INNER, MB_INNER, 0}, S, pg8::EpiAccF32{c.x, D, f.slab, MP / 256, MS / 256, KS_MB}); }
    if (PROBE_DUP & (1 << 28)) { GBAR(); pg8::Order<> S; S.init(MP / 256, MS / 256, 4, MB_INNER, KS_MB, gridDim.x, blockIdx.x);
      pg8::gemm_phase(lds, pg8::Gemm{fb.yzn, fb.wbot, MB_INNER, MB_INNER, 0}, S, pg8::EpiAccF32{c.hmid, D, f.slab + (size_t)16 * 16 * 65536, MP / 256, MS / 256, KS_MB}); }
    GBAR();
}

__device__ __forceinline__ void layer_mla_fast(const Ctx& c, const Fast& f, const FastMla& fm, const XcdBarrier& bar, LDSP unsigned char* lds) {
    using namespace cfg;
    constexpr int l = 1, j = 0;
    norm_rows_bf16(c.x, c.in[I_NMIX] + l * D, f.xnb, f.slab, KS_FFN, GW_NOW(), NGW_NOW(), LANE_NOW());
    GBAR();
    DUP(27, { pg8::Order<> S; S.init(MP / 256, MS / 256, 4, D, 1, gridDim.x, blockIdx.x);
      pg8::gemm_phase(lds, pg8::Gemm{f.xnb, fm.wint, D, D, 0}, S, pg8::EpiF32{fm.mh, 1024, 1024}); });
    GBAR();
    DUP(14, mla_norm1_fast(c, fm, j, GW_NOW(), NGW_NOW(), LANE_NOW()));
    GBAR();
    DUP(27, { pg8::Order<> S; S.init(MP / 256, MS / 256, (MH * QD) / 256, QL, 1, gridDim.x, blockIdx.x);
      pg8::gemm_phase(lds, pg8::Gemm{fm.qan, fm.wuqt, QL, QL, 0}, S, pg8::EpiBf16<0>{fm.qraw, MH * QD}); }
    { pg8::Order<> S; S.init(MP / 256, MS / 256, 4, KVL, 1, gridDim.x, blockIdx.x);
      pg8::gemm_phase(lds, pg8::Gemm{fm.cb, fm.wukvt, KVL, KVL, 0}, S, pg8::EpiBf16<0>{fm.kvraw, 2048}); }
    { pg8::Order<> S; S.init(4, 0, MTOT / 256, KVL, 1, gridDim.x, blockIdx.x);
      pg8::gemm_phase(lds, pg8::Gemm{fm.wukvt + (size_t)1024 * KVL, fm.cb, KVL, KVL, 0}, S, pg8::EpiBf16<0>{fm.vT, MTOT}); });
    GBAR();
    DUP(15, mla_norm2_fast(c, fm, j, GW_NOW(), NGW_NOW(), LANE_NOW()));
    { const unsigned t_ = (unsigned)GTID_NOW(); if (t_ < 96) *(pg8::u32x4*)(fm.qs + (size_t)MS * 1536 + t_ * 8) = (pg8::u32x4){0u, 0u, 0u, 0u}; }
    GBAR();
    DUP(5, attn_prompt_fast(fm.qf, fm.knb, fm.kpb, fm.vT, fm.aob, lds));
    __syncthreads();
    DUP(4, mla_sample_decode(c, fm, fm.qs, fm.opart, fm.lpart, j, lds));
    GBAR();
    DUP(16, mla_sample_combine(c, fm, fm.opart, fm.lpart, j, lds));
    GBAR();
    { pg8::Order<> S; S.init(MP / 256, MS / 256, 4, D, KS_1K, gridDim.x, blockIdx.x);
      pg8::gemm_phase(lds, pg8::Gemm{fm.aob, fm.wot, D, D, 0}, S, pg8::EpiAccF32{c.x, D, f.slab, MP / 256, MS / 256, KS_1K}); }
    if (PROBE_DUP & (1 << 27)) { GBAR(); pg8::Order<> S; S.init(MP / 256, MS / 256, 4, D, KS_1K, gridDim.x, blockIdx.x);
      pg8::gemm_phase(lds, pg8::Gemm{fm.aob, fm.wot, D, D, 0}, S, pg8::EpiAccF32{c.hmid, D, f.slab + (size_t)16 * 16 * 65536, MP / 256, MS / 256, KS_1K}); }
    GBAR();
}

template <int L>
__device__ __forceinline__ void layer_ffn_fast(const Ctx& c, const Fast& f, const XcdBarrier& bar, LDSP unsigned char* lds) {
    using namespace cfg;
    norm_rows_bf16(c.x, c.in[I_NFFN] + L * D, f.xnb, f.slab, (L % 3 == 2) ? KS_MB : KS_1K, GW_NOW(), NGW_NOW(), LANE_NOW());
    GBAR();
    DUP(0, { pg8::Order<> S; S.init(MP / 256, MS / 256, FFN / 256, D, 1, gridDim.x, blockIdx.x);
      pg8::gemm_phase(lds, pg8::Gemm{f.xnb, f.w1t + (size_t)L * FFN * D, D, D, 0}, S, pg8::EpiBf16<3>{f.hmidb, FFN}); });
    GBAR();
    { pg8::Order<> S; S.init(MP / 256, MS / 256, D / 256, FFN, (L == DEPTH - 1) ? 1 : KS_FFN, gridDim.x, blockIdx.x);
      pg8::gemm_phase(lds, pg8::Gemm{f.hmidb, f.w2t + (size_t)L * D * FFN, FFN, FFN, 0}, S, pg8::EpiAccF32{c.x, D, f.slab, MP / 256, MS / 256, (L == DEPTH - 1) ? 1 : KS_FFN}); }
    if (PROBE_DUP & (1 << 25)) { GBAR(); pg8::Order<> S; S.init(MP / 256, MS / 256, D / 256, FFN, (L == DEPTH - 1) ? 1 : KS_FFN, gridDim.x, blockIdx.x);
      pg8::gemm_phase(lds, pg8::Gemm{f.hmidb, f.w2t + (size_t)L * D * FFN, FFN, FFN, 0}, S, pg8::EpiAccF32{c.hmid, D, f.slab + (size_t)16 * 16 * 65536, MP / 256, MS / 256, (L == DEPTH - 1) ? 1 : KS_FFN}); }
    GBAR();
}

__global__ void __launch_bounds__(512, 2) mega10(MegaArgs a) {
    LDSP unsigned char* lds = (LDSP unsigned char*)dynlds;
    if (threadIdx.x < 4) ((LDSP unsigned*)(lds + LDS_XB))[threadIdx.x] = 0u;
    __syncthreads();
    XcdBarrier bar = xcd_barrier_post(a.bar, (volatile LAS unsigned*)(lds + LDS_XB));
    const Ctx& c = a.c; const Fast& f = a.f; const FastMla& fm = a.fm; const FastRw& fr = a.fr; const FastMb& fb = a.fb;
    using namespace cfg;
    DUP(10, {
        LDSP float* scr = (LDSP float*)(lds + LDS_STAGE) + (tid_now() >> 6) * (64 * 33);
        for (int l = 0; l < DEPTH; ++l) {
            tr_weight(c.in[I_FW1] + (size_t)l * D * FFN, D, FFN, FFN, f.w1t + (size_t)l * FFN * D, nullptr, scr, GW_NOW(), NGW_NOW(), LANE_NOW());
            tr_weight(c.in[I_FW2] + (size_t)l * FFN * D, FFN, D, D, f.w2t + (size_t)l * D * FFN, nullptr, scr, GW_NOW(), NGW_NOW(), LANE_NOW());
        }
        tr_weight(c.in[I_MWIN], D, MLA_IN, 1024, fm.wint, nullptr, scr, GW_NOW(), NGW_NOW(), LANE_NOW());
        tr_weight(c.in[I_WUQ], QL, MH * QD, MH * QD, fm.wuqt, nullptr, scr, GW_NOW(), NGW_NOW(), LANE_NOW());
        tr_weight(c.in[I_WUK], KVL, MH * NOPE, MH * NOPE, fm.wukvt, nullptr, scr, GW_NOW(), NGW_NOW(), LANE_NOW());
        tr_weight(c.in[I_WUV], KVL, MH * VD, MH * VD, fm.wukvt + (size_t)1024 * KVL, nullptr, scr, GW_NOW(), NGW_NOW(), LANE_NOW());
        tr_weight(c.in[I_MWO], MH * VD, D, D, fm.wot, nullptr, scr, GW_NOW(), NGW_NOW(), LANE_NOW());
        for (int j = 0; j < N_RWKV; ++j) {
            bf16_t* wt = fr.wrkvt + (size_t)j * 4096 * D;
            for (int p = 0; p < 3; ++p) tr_weight(c.in[I_WRKV] + ((size_t)j * 3 + p) * D * D, D, D, D, wt + (size_t)p * D * D, nullptr, scr, GW_NOW(), NGW_NOW(), LANE_NOW());
            tr_weight(c.in[I_W1] + (size_t)j * D * RW_DL, D, RW_DL, 256, wt + (size_t)3072 * D, nullptr, scr, GW_NOW(), NGW_NOW(), LANE_NOW());
            tr_weight(c.in[I_A1] + (size_t)j * D * RW_AL, D, RW_AL, 256, wt + (size_t)3328 * D, nullptr, scr, GW_NOW(), NGW_NOW(), LANE_NOW());
            tr_weight(c.in[I_G1] + (size_t)j * D * RW_GL, D, RW_GL, 256, wt + (size_t)3584 * D, nullptr, scr, GW_NOW(), NGW_NOW(), LANE_NOW());
            tr_weight(j > 0 ? c.in[I_V1] + (size_t)(j - 1) * D * RW_VL : c.in[I_W1], D, j > 0 ? RW_VL : 0, 256, wt + (size_t)3840 * D, nullptr, scr, GW_NOW(), NGW_NOW(), LANE_NOW());
            tr_weight(c.in[I_RWO] + (size_t)j * D * D, D, D, D, fr.wot + (size_t)j * D * D, nullptr, scr, GW_NOW(), NGW_NOW(), LANE_NOW());
            rw_build_lorat(c, fr.lorat + (size_t)j * 4096 * 384, j, GTID_NOW(), GSZ_NOW());
        }
        tr_weight(c.in[I_BWIN], D, MB_IN, 5376, fb.wbint, nullptr, scr, GW_NOW(), NGW_NOW(), LANE_NOW());
        tr_weight(c.in[I_BWO], MB_INNER, D, D, fb.wbot, nullptr, scr, GW_NOW(), NGW_NOW(), LANE_NOW());
        ph_copy_x(c, 0, GTID_NOW(), GSZ_NOW());
    });
    GBAR();
    layer_rwkv_fast<0>(c, f, fr, bar, lds); layer_ffn_fast<0>(c, f, bar, lds);
    layer_mla_fast(c, f, fm, bar, lds); layer_ffn_fast<1>(c, f, bar, lds);
    layer_mamba_fast(c, f, fb, bar, lds); layer_ffn_fast<2>(c, f, bar, lds);
    layer_rwkv_fast<3>(c, f, fr, bar, lds); layer_ffn_fast<3>(c, f, bar, lds);
}

extern "C" void kernel_launch(void* const* d_in, const int* in_sizes, int n_in, void* d_out, int out_size, void* d_ws, size_t ws_size, hipStream_t stream) {
    using namespace cfg;
    MegaArgs a{};
    size_t used = setup_ctx(a.c, d_in, d_out, d_ws);
    { Bump b{(char*)d_ws, (size_t)((char*)a.c.xm[0] - (char*)d_ws)}; FastRw& r = a.fr;
      r.xm = (bf16_t*)b.f((size_t)6 * MTOT * D / 2); r.rkv = (bf16_t*)b.f((size_t)MTOT * 3072 / 2); r.hb = (bf16_t*)b.f((size_t)MTOT * 384 / 2); r.lu = (bf16_t*)b.f((size_t)MTOT * 4096 / 2);
      r.ops = b.f((size_t)MTOT * RHEADS * RW_REC + 4096); r.yo = (bf16_t*)b.f((size_t)MTOT * D / 2); r.vf = a.c.vf;
      if (b.off > (size_t)((char*)a.c.hmid - (char*)d_ws) + (size_t)MTOT * FFN * 4) { fprintf(stderr, "RWKV overlay too large\n"); return; } }
    { Bump b{(char*)d_ws, used};
      a.f.xnb = (bf16_t*)b.f((size_t)MTOT * D / 2); a.f.hmidb = (bf16_t*)b.f((size_t)MTOT * FFN / 2);
      a.f.w1t = (bf16_t*)b.f((size_t)DEPTH * FFN * D / 2); a.f.w2t = (bf16_t*)b.f((size_t)DEPTH * FFN * D / 2); a.f.slab = b.f((size_t)2 * 16 * 16 * 65536);
      FastMla& m = a.fm;
      m.mh = b.f((size_t)MTOT * 1024); m.qan = (bf16_t*)b.f((size_t)MTOT * QL / 2); m.cb = (bf16_t*)b.f((size_t)MTOT * KVL / 2); m.kpb = (bf16_t*)b.f((size_t)MTOT * ROPE / 2);
      m.qraw = (bf16_t*)b.f((size_t)MTOT * 1536 / 2); m.kvraw = (bf16_t*)b.f((size_t)MTOT * 2048 / 2); m.qf = (bf16_t*)b.f((size_t)MTOT * 1536 / 2); m.knb = (bf16_t*)b.f((size_t)MTOT * 1024 / 2);
      m.aob = (bf16_t*)b.f((size_t)MTOT * 1024 / 2); m.vT = (bf16_t*)b.f((size_t)MTOT * 1024 / 2); m.qs = (bf16_t*)b.f((size_t)MS * 1536 / 2 + 1024);
      m.opart = b.f((size_t)2 * DB * 128 * 256); m.lpart = b.f((size_t)2 * DB * 128);
      m.wint = (bf16_t*)b.f((size_t)1024 * 1024 / 2); m.wuqt = (bf16_t*)b.f((size_t)1536 * 512 / 2); m.wukvt = (bf16_t*)b.f((size_t)2048 * 256 / 2); m.wot = (bf16_t*)b.f((size_t)1024 * 1024 / 2);
      { FastMb& q = a.fb; q.zb = (bf16_t*)b.f((size_t)MTOT * 2048 / 2); q.xbcr = (bf16_t*)b.f((size_t)MTOT * 3072 / 2); q.dtraw = b.f((size_t)MTOT * 32); q.xbcb = (bf16_t*)b.f((size_t)MTOT * 3072 / 2);
        q.dt = b.f((size_t)MTOT * 32); q.y = a.c.my; q.yzn = (bf16_t*)b.f((size_t)MTOT * 2048 / 2); q.wbint = (bf16_t*)b.f((size_t)5376 * 1024 / 2); q.wbot = (bf16_t*)b.f((size_t)1024 * 2048 / 2); }
      a.fr.wrkvt = (bf16_t*)b.f((size_t)N_RWKV * 4096 * D / 2); a.fr.lorat = (bf16_t*)b.f((size_t)N_RWKV * 4096 * 384 / 2); a.fr.wot = (bf16_t*)b.f((size_t)N_RWKV * D * D / 2);
      used = b.off; }
    if (used > ws_size || n_in != 51) { fprintf(stderr, "workspace too small: need %zu have %zu (n_in %d)\n", used, ws_size, n_in); return; }
    a.bar = (unsigned*)d_ws;
    static int grid = 0;
    if (!grid) {
        int dev = 0, cus = 0, per_cu = 0;
        (void)hipGetDevice(&dev); (void)hipDeviceGetAttribute(&cus, hipDeviceAttributeMultiprocessorCount, dev);
        if (hipFuncSetAttribute((const void*)mega10, hipFuncAttributeMaxDynamicSharedMemorySize, LDS_BYTES) != hipSuccess) { fprintf(stderr, "hipFuncSetAttribute failed\n"); grid = -1; return; }
        (void)hipOccupancyMaxActiveBlocksPerMultiprocessor(&per_cu, (const void*)mega10, 512, LDS_BYTES);
        (void)hipGetLastError();
        grid = per_cu >= 1 ? (cus < 256 ? cus : 256) : -1;
    }
    if (grid <= 0) { fprintf(stderr, "kernel does not fit one workgroup per CU\n"); return; }
    (void)hipMemsetAsync(a.bar, 0, XCD_BAR_WORDS * sizeof(unsigned), stream);
    hipLaunchKernelGGL(mega10, dim3(grid), dim3(512), LDS_BYTES, stream, a);
}
```

```cpp
#include <hip/hip_runtime.h>
#include <cstdio>
#include <math.h>
#include <stdint.h>
#include <stddef.h>
#ifdef CPU_EMU
#define DEV inline
#else
#define DEV __device__ __forceinline__
#endif

namespace cfg {
#ifdef CFG_SMALL
constexpr int D = 128, BATCH = 2, SEQ = 32, DEPTH = 4, DB = 3, DS = 8, PAST = 64, PAGE = 16;
constexpr int RW_DL = 16, RW_AL = 16, RW_VL = 8, RW_GL = 24;
constexpr int MH = 2, QL = 64, KVL = 32;
constexpr int MB_GROUPS = 2;
#else
constexpr int D = 1024, BATCH = 16, SEQ = 2048, DEPTH = 4, DB = 128, DS = 8, PAST = 8192, PAGE = 128;
constexpr int RW_DL = 64, RW_AL = 64, RW_VL = 32, RW_GL = 160;
constexpr int MH = 16, QL = 512, KVL = 256;
constexpr int MB_GROUPS = 4;
#endif
constexpr int N_RWKV = (DEPTH + 2) / 3, N_MLA = (DEPTH + 1) / 3, N_MAMBA = DEPTH / 3;
constexpr int RH = 64, RHEADS = D / RH;
constexpr int NOPE = 64, ROPE = 32, VD = 64, QD = NOPE + ROPE;
constexpr int MLA_IN = QL + KVL + ROPE;
constexpr int MB_INNER = 2 * D, MB_HEAD = 64, MB_HEADS = MB_INNER / MB_HEAD, MB_STATE = 128, MB_CONV = 4;
constexpr int MB_GN = MB_GROUPS * MB_STATE;
constexpr int MB_CD = MB_INNER + 2 * MB_GN, MB_IN = MB_INNER + MB_CD + MB_HEADS;
constexpr int FFN = 4 * D;
constexpr int NPAGES = PAST / PAGE, NPOOL = (DB * NPAGES * 5) / 4;
constexpr int MP = BATCH * SEQ, MS = DB * DS, MTOT = MP + MS, NSEQ = BATCH + DB;
constexpr int KTOT = PAST + DS;
constexpr float NORM_EPS = 1e-6f, LNX_EPS = 64e-5f;
constexpr size_t O_YP = 0;
constexpr size_t O_YS = O_YP + (size_t)MP * D;
constexpr size_t O_CKVP = O_YS + (size_t)MS * D;
constexpr size_t O_KPEP = O_CKVP + (size_t)N_MLA * MP * KVL;
constexpr size_t O_CKVS = O_KPEP + (size_t)N_MLA * MP * ROPE;
constexpr size_t O_KPES = O_CKVS + (size_t)N_MLA * MS * KVL;
constexpr size_t O_WKVP = O_KPES + (size_t)N_MLA * MS * ROPE;
constexpr size_t O_SHP = O_WKVP + (size_t)N_RWKV * BATCH * RHEADS * RH * RH;
constexpr size_t O_WKVS = O_SHP + (size_t)N_RWKV * BATCH * D;
constexpr size_t O_SHS = O_WKVS + (size_t)N_RWKV * DB * RHEADS * RH * RH;
constexpr size_t O_SSMP = O_SHS + (size_t)N_RWKV * DB * D;
constexpr size_t O_CONVP = O_SSMP + (size_t)N_MAMBA * BATCH * MB_HEADS * MB_HEAD * MB_STATE;
constexpr size_t O_SSMS = O_CONVP + (size_t)N_MAMBA * BATCH * (MB_CONV - 1) * MB_CD;
constexpr size_t O_CONVS = O_SSMS + (size_t)N_MAMBA * DB * MB_HEADS * MB_HEAD * MB_STATE;
constexpr size_t O_END = O_CONVS + (size_t)N_MAMBA * DB * (MB_CONV - 1) * MB_CD;
}

struct Ctx {
    const float* in[51];
    const int* page_table;
    float* out;
    float *x, *xn, *vf;
    float* xm[6];
    float *r, *k, *v, *wpre, *apre, *vpre, *g, *hw, *ha, *hv, *hg, *ka, *kb, *y, *yo;
    float *hmid;
    float *mh, *qan, *q, *c, *kp, *knr, *vv, *ao, *sc, *olat;
    float *zx, *xbc, *dt, *my, *yzn;
};

DEV int row_t(int m) { return m < cfg::MP ? m % cfg::SEQ : (m - cfg::MP) % cfg::DS; }
DEV int row_seq(int m) { return m < cfg::MP ? m / cfg::SEQ : cfg::BATCH + (m - cfg::MP) / cfg::DS; }
DEV int seq_row0(int sq) { return sq < cfg::BATCH ? sq * cfg::SEQ : cfg::MP + (sq - cfg::BATCH) * cfg::DS; }
DEV int seq_len(int sq) { return sq < cfg::BATCH ? cfg::SEQ : cfg::DS; }
DEV float sigmoidf_(float x) { return 1.0f / (1.0f + expf(-x)); }
DEV float softplusf_(float x) { return x > 20.f ? x : log1pf(expf(x)); }
DEV float siluf_(float x) { return x * sigmoidf_(x); }

enum { I_XP = 0, I_XS, I_CKV, I_KPE, I_WKV, I_SHIFT, I_SSM, I_CONV, I_PT, I_NMIX, I_NFFN, I_FW1, I_FW2, I_MU, I_WRKV, I_W0, I_W1, I_W2, I_A0, I_A1, I_A2,
       I_V0, I_V1, I_V2, I_G1, I_G2, I_KK, I_KA, I_RK, I_LNW, I_LNB, I_RWO, I_MWIN, I_QNORM, I_KVNORM, I_WUQ, I_WUK, I_WUV, I_QNN, I_QRN, I_KNN, I_KRN, I_MWO,
       I_BWIN, I_CONVW, I_CONVB, I_DTB, I_ALOG, I_BD, I_BNORM, I_BWO };

#define UNROLL _Pragma("unroll")
#define GSL(i, n) for (size_t i = gtid; i < (size_t)(n); i += gsz)

DEV void ph_copy_x(const Ctx& c, int, size_t gtid, size_t gsz) {
    using namespace cfg;
    GSL(i, (size_t)MTOT * D) c.x[i] = i < (size_t)MP * D ? c.in[I_XP][i] : c.in[I_XS][i - (size_t)MP * D];
}
DEV void rmsnorm_rows(const float* x, const float* gain, float* xn, size_t gtid, size_t gsz) {
    using namespace cfg;
    GSL(m, MTOT) {
        const float* xr = x + m * D; float ss = 0.f;
        for (int i = 0; i < D; ++i) ss += xr[i] * xr[i];
        const float rs = 1.0f / sqrtf(ss / D + NORM_EPS);
        for (int i = 0; i < D; ++i) xn[m * D + i] = xr[i] * rs * gain[i];
    }
}
DEV void ph_norm_mix(const Ctx& c, int l, size_t gtid, size_t gsz) { rmsnorm_rows(c.x, c.in[I_NMIX] + l * cfg::D, c.xn, gtid, gsz); }
DEV void ph_norm_ffn(const Ctx& c, int l, size_t gtid, size_t gsz) { rmsnorm_rows(c.x, c.in[I_NFFN] + l * cfg::D, c.xn, gtid, gsz); }

DEV void ph_rw_mix(const Ctx& c, int l, size_t gtid, size_t gsz) {
    using namespace cfg; const int j = l / 3;
    GSL(i, (size_t)MTOT * D) {
        const int m = (int)(i / D), ch = (int)(i % D), t = row_t(m), sq = row_seq(m);
        const float xc = c.xn[i];
        float xp;
        if (t > 0) xp = c.xn[i - D];
        else xp = sq < BATCH ? 0.f : c.in[I_SHIFT][((size_t)j * DB + (sq - BATCH)) * D + ch];
        for (int p = 0; p < 6; ++p) c.xm[p][i] = xc + (xp - xc) * c.in[I_MU][((size_t)j * 6 + p) * D + ch];
        if (t == seq_len(sq) - 1) {
            if (sq < BATCH) c.out[O_SHP + ((size_t)j * BATCH + sq) * D + ch] = xc;
            else c.out[O_SHS + ((size_t)j * DB + (sq - BATCH)) * D + ch] = xc;
        }
    }
}
DEV void ph_rw_prep(const Ctx& c, int l, size_t gtid, size_t gsz) {
    using namespace cfg; const int j = l / 3;
    GSL(i, (size_t)MTOT * RHEADS) {
        const int m = (int)(i / RHEADS), h = (int)(i % RHEADS);
        const size_t o = (size_t)m * D + h * RH;
        float nn = 0.f;
        for (int e = 0; e < RH; ++e) { const float kk = c.k[o + e] * c.in[I_KK][j * D + h * RH + e]; nn += kk * kk; }
        const float inv = 1.0f / fmaxf(sqrtf(nn), 1e-12f);
        for (int e = 0; e < RH; ++e) {
            const int ch = h * RH + e;
            const float wl = -softplusf_(-(c.in[I_W0][j * D + ch] + c.wpre[o + e])) - 0.5f;
            const float decay = expf(-expf(wl));
            float vv = c.v[o + e];
            if (j == 0) c.vf[o + e] = vv;
            else vv = vv + (c.vf[o + e] - vv) * sigmoidf_(c.in[I_V0][(j - 1) * D + ch] + c.vpre[o + e]);
            const float a = sigmoidf_(c.in[I_A0][j * D + ch] + c.apre[o + e]);
            const float k0 = c.k[o + e];
            const float kk = k0 * c.in[I_KK][j * D + ch] * inv;
            c.k[o + e] = k0 * (1.0f + (a - 1.0f) * c.in[I_KA][j * D + ch]);
            c.v[o + e] = vv;
            c.wpre[o + e] = decay;
            c.ka[o + e] = -kk;
            c.kb[o + e] = kk * a;
        }
    }
}
DEV void ph_rw_scan(const Ctx& c, int l, size_t gtid, size_t gsz) {
    using namespace cfg; const int j = l / 3;
    GSL(i, (size_t)NSEQ * RHEADS * RH) {
        const int sq = (int)(i / (RHEADS * RH)), h = (int)(i / RH) % RHEADS, vi = (int)(i % RH);
        float S[RH];
        if (sq < BATCH) { UNROLL for (int e = 0; e < RH; ++e) S[e] = 0.f; }
        else { const float* s0 = c.in[I_WKV] + ((((size_t)j * DB + (sq - BATCH)) * RHEADS + h) * RH + vi) * RH; UNROLL for (int e = 0; e < RH; ++e) S[e] = s0[e]; }
        const int m0 = seq_row0(sq), T = seq_len(sq);
        for (int t = 0; t < T; ++t) {
            const size_t o = (size_t)(m0 + t) * D + h * RH;
            float sa = 0.f;
            UNROLL for (int e = 0; e < RH; ++e) sa += S[e] * c.ka[o + e];
            const float vt = c.v[o + vi]; float yy = 0.f;
            UNROLL for (int e = 0; e < RH; ++e) { S[e] = S[e] * c.wpre[o + e] + sa * c.kb[o + e] + vt * c.k[o + e]; yy += S[e] * c.r[o + e]; }
            c.y[o + vi] = yy;
        }
        float* so = sq < BATCH ? c.out + O_WKVP + ((((size_t)j * BATCH + sq) * RHEADS + h) * RH + vi) * RH
                               : c.out + O_WKVS + ((((size_t)j * DB + (sq - BATCH)) * RHEADS + h) * RH + vi) * RH;
        UNROLL for (int e = 0; e < RH; ++e) so[e] = S[e];
    }
}
DEV void ph_rw_post(const Ctx& c, int l, size_t gtid, size_t gsz) {
    using namespace cfg; const int j = l / 3;
    GSL(i, (size_t)MTOT * RHEADS) {
        const int m = (int)(i / RHEADS), h = (int)(i % RHEADS);
        const size_t o = (size_t)m * D + h * RH;
        float mean = 0.f; for (int e = 0; e < RH; ++e) mean += c.y[o + e]; mean /= RH;
        float var = 0.f; for (int e = 0; e < RH; ++e) { const float d = c.y[o + e] - mean; var += d * d; } var /= RH;
        const float rs = 1.0f / sqrtf(var + LNX_EPS);
        float bonus = 0.f; for (int e = 0; e < RH; ++e) bonus += c.r[o + e] * c.k[o + e] * c.in[I_RK][(size_t)j * D + h * RH + e];
        for (int e = 0; e < RH; ++e) {
            const int ch = h * RH + e;
            const float yn = (c.y[o + e] - mean) * rs * c.in[I_LNW][j * D + ch] + c.in[I_LNB][j * D + ch];
            c.yo[o + e] = (yn + bonus * c.v[o + e]) * c.g[o + e];
        }
    }
}

DEV void rope_apply(const float* xin, float* xout, int pos) {
    using namespace cfg; const int half = ROPE / 2;
    UNROLL for (int i = 0; i < half; ++i) {
        const float inv = exp2f(-(float)i * (13.287712379549449f / half));
        const float ang = (float)pos * inv;
        const float kq = rintf(ang * 0.15915494309189535f);
        float rr = fmaf(-kq, 6.28125f, ang); rr = fmaf(-kq, 1.9353071795864769e-3f, rr);
        const float cs = __cosf(rr), sn = __sinf(rr);
        const float x1 = xin[i], x2 = xin[i + half];
        xout[i] = x1 * cs - x2 * sn; xout[i + half] = x2 * cs + x1 * sn;
    }
}
DEV int row_pos(int m) { return m < cfg::MP ? m % cfg::SEQ : cfg::PAST + (m - cfg::MP) % cfg::DS; }
DEV void ph_mla_norm1(const Ctx& c, int l, size_t gtid, size_t gsz) {
    using namespace cfg; const int j = l / 3;
    GSL(m, MTOT) {
        const float* h = c.mh + m * MLA_IN;
        float ss = 0.f; for (int i = 0; i < QL; ++i) ss += h[i] * h[i];
        float rs = 1.0f / sqrtf(ss / QL + NORM_EPS);
        for (int i = 0; i < QL; ++i) c.qan[m * QL + i] = h[i] * rs * c.in[I_QNORM][j * QL + i];
        ss = 0.f; for (int i = 0; i < KVL; ++i) ss += h[QL + i] * h[QL + i];
        rs = 1.0f / sqrtf(ss / KVL + NORM_EPS);
        float* co = m < (size_t)MP ? c.out + O_CKVP + ((size_t)j * MP + m) * KVL : c.out + O_CKVS + ((size_t)j * MS + (m - MP)) * KVL;
        for (int i = 0; i < KVL; ++i) { const float v = h[QL + i] * rs * c.in[I_KVNORM][j * KVL + i]; c.c[m * KVL + i] = v; co[i] = v; }
        ss = 0.f; UNROLL for (int i = 0; i < ROPE; ++i) ss += h[QL + KVL + i] * h[QL + KVL + i];
        rs = 1.0f / sqrtf(ss / ROPE + NORM_EPS);
        float tmp[ROPE], ro[ROPE];
        UNROLL for (int i = 0; i < ROPE; ++i) tmp[i] = h[QL + KVL + i] * rs * c.in[I_KRN][j * ROPE + i];
        rope_apply(tmp, ro, row_pos((int)m));
        float* ko = m < (size_t)MP ? c.out + O_KPEP + ((size_t)j * MP + m) * ROPE : c.out + O_KPES + ((size_t)j * MS + (m - MP)) * ROPE;
        UNROLL for (int i = 0; i < ROPE; ++i) { c.kp[m * ROPE + i] = ro[i]; ko[i] = ro[i]; }
    }
}
DEV void ph_mla_norm2(const Ctx& c, int l, size_t gtid, size_t gsz) {
    using namespace cfg; const int j = l / 3;
    GSL(i, (size_t)MTOT * MH) {
        const int m = (int)(i / MH), h = (int)(i % MH);
        float* q = c.q + (size_t)m * MH * QD + h * QD;
        float ss = 0.f; UNROLL for (int e = 0; e < NOPE; ++e) ss += q[e] * q[e];
        float rs = 1.0f / sqrtf(ss / NOPE + NORM_EPS);
        UNROLL for (int e = 0; e < NOPE; ++e) q[e] = q[e] * rs * c.in[I_QNN][j * NOPE + e];
        ss = 0.f; UNROLL for (int e = 0; e < ROPE; ++e) ss += q[NOPE + e] * q[NOPE + e];
        rs = 1.0f / sqrtf(ss / ROPE + NORM_EPS);
        float tmp[ROPE], ro[ROPE];
        UNROLL for (int e = 0; e < ROPE; ++e) tmp[e] = q[NOPE + e] * rs * c.in[I_QRN][j * ROPE + e];
        rope_apply(tmp, ro, row_pos(m));
        UNROLL for (int e = 0; e < ROPE; ++e) q[NOPE + e] = ro[e];
        float* kn = c.knr + (size_t)m * MH * NOPE + h * NOPE;
        ss = 0.f; UNROLL for (int e = 0; e < NOPE; ++e) ss += kn[e] * kn[e];
        rs = 1.0f / sqrtf(ss / NOPE + NORM_EPS);
        UNROLL for (int e = 0; e < NOPE; ++e) kn[e] = kn[e] * rs * c.in[I_KNN][j * NOPE + e];
    }
}
DEV void ph_mla_attn_prompt(const Ctx& c, int, size_t gtid, size_t gsz) {
    using namespace cfg; const float scale = 1.0f / sqrtf((float)QD);
    GSL(i, (size_t)MP * MH) {
        const int m = (int)(i / MH), h = (int)(i % MH), t = m % SEQ, m0 = m - t;
        const float* q = c.q + (size_t)m * MH * QD + h * QD;
        float mx = -INFINITY, den = 0.f, acc[VD];
        UNROLL for (int e = 0; e < VD; ++e) acc[e] = 0.f;
        for (int kx = 0; kx <= t; ++kx) {
            const int mk = m0 + kx;
            const float* kn = c.knr + (size_t)mk * MH * NOPE + h * NOPE; const float* kp = c.kp + (size_t)mk * ROPE;
            float s = 0.f;
            UNROLL for (int e = 0; e < NOPE; ++e) s += q[e] * kn[e];
            UNROLL for (int e = 0; e < ROPE; ++e) s += q[NOPE + e] * kp[e];
            s *= scale;
            const float nm = fmaxf(mx, s), corr = expf(mx - nm), p = expf(s - nm);
            den = den * corr + p;
            const float* v = c.vv + (size_t)mk * MH * VD + h * VD;
            UNROLL for (int e = 0; e < VD; ++e) acc[e] = acc[e] * corr + p * v[e];
            mx = nm;
        }
        UNROLL for (int e = 0; e < VD; ++e) c.ao[(size_t)m * MH * VD + h * VD + e] = acc[e] / den;
    }
}
DEV const float* smp_c(const Ctx& c, int j, int s, int pos) {
    using namespace cfg;
    if (pos < PAST) { const int pg = c.page_table[s * NPAGES + pos / PAGE]; return c.in[I_CKV] + (((size_t)j * NPOOL + pg) * PAGE + pos % PAGE) * KVL; }
    return c.c + (size_t)(MP + s * DS + (pos - PAST)) * KVL;
}
DEV const float* smp_kp(const Ctx& c, int j, int s, int pos) {
    using namespace cfg;
    if (pos < PAST) { const int pg = c.page_table[s * NPAGES + pos / PAGE]; return c.in[I_KPE] + (((size_t)j * NPOOL + pg) * PAGE + pos % PAGE) * ROPE; }
    return c.kp + (size_t)(MP + s * DS + (pos - PAST)) * ROPE;
}
DEV void ph_mla_score_sample(const Ctx& c, int l, size_t gtid, size_t gsz) {
    using namespace cfg; const int j = l / 3; const float scale = 1.0f / sqrtf((float)QD);
    GSL(i, (size_t)DB * KTOT * MH) {
        const int pos = (int)(i % KTOT), h = (int)((i / KTOT) % MH), s = (int)(i / ((size_t)MH * KTOT));
        const float* cl = smp_c(c, j, s, pos); const float* kp = smp_kp(c, j, s, pos);
        float kn[NOPE];
        UNROLL for (int e = 0; e < NOPE; ++e) kn[e] = 0.f;
        const float* wuk = c.in[I_WUK] + (size_t)j * KVL * MH * NOPE;
        for (int r = 0; r < KVL; ++r) { const float cv = cl[r]; const float* w = wuk + ((size_t)r * MH + h) * NOPE; UNROLL for (int e = 0; e < NOPE; ++e) kn[e] += cv * w[e]; }
        float ss = 0.f; UNROLL for (int e = 0; e < NOPE; ++e) ss += kn[e] * kn[e];
        const float rs = 1.0f / sqrtf(ss / NOPE + NORM_EPS);
        UNROLL for (int e = 0; e < NOPE; ++e) kn[e] = kn[e] * rs * c.in[I_KNN][j * NOPE + e];
        for (int qi = 0; qi < DS; ++qi) {
            const float* q = c.q + (size_t)(MP + s * DS + qi) * MH * QD + h * QD;
            float sc = 0.f;
            UNROLL for (int e = 0; e < NOPE; ++e) sc += q[e] * kn[e];
            UNROLL for (int e = 0; e < ROPE; ++e) sc += q[NOPE + e] * kp[e];
            const bool ok = pos < PAST || (pos - PAST) <= qi;
            c.sc[(((size_t)s * MH + h) * DS + qi) * KTOT + pos] = ok ? sc * scale : -INFINITY;
        }
    }
}
DEV void ph_mla_softmax_sample(const Ctx& c, int, size_t gtid, size_t gsz) {
    using namespace cfg;
    GSL(i, (size_t)DB * MH * DS) {
        float* sc = c.sc + i * KTOT;
        float mx = -INFINITY; for (int p = 0; p < KTOT; ++p) mx = fmaxf(mx, sc[p]);
        float den = 0.f; for (int p = 0; p < KTOT; ++p) den += expf(sc[p] - mx);
        const float inv = 1.0f / den;
        for (int p = 0; p < KTOT; ++p) sc[p] = expf(sc[p] - mx) * inv;
    }
}
DEV void ph_mla_pv_sample(const Ctx& c, int l, size_t gtid, size_t gsz) {
    using namespace cfg; const int j = l / 3;
    GSL(i, (size_t)DB * MH * DS * KVL) {
        const int r = (int)(i % KVL); const size_t row = i / KVL; const int s = (int)(row / (MH * DS));
        const float* p = c.sc + row * KTOT; float acc = 0.f;
        for (int pos = 0; pos < KTOT; ++pos) acc += p[pos] * smp_c(c, j, s, pos)[r];
        c.olat[i] = acc;
    }
}
DEV void ph_mla_out_sample(const Ctx& c, int l, size_t gtid, size_t gsz) {
    using namespace cfg; const int j = l / 3;
    GSL(i, (size_t)MS * MH * VD) {
        const int e = (int)(i % VD), h = (int)((i / VD) % MH), ms = (int)(i / (MH * VD)), s = ms / DS, qi = ms % DS;
        const float* ol = c.olat + (((size_t)s * MH + h) * DS + qi) * KVL;
        const float* wuv = c.in[I_WUV] + (size_t)j * KVL * MH * VD;
        float acc = 0.f;
        for (int r = 0; r < KVL; ++r) acc += ol[r] * wuv[((size_t)r * MH + h) * VD + e];
        c.ao[(size_t)(MP + ms) * MH * VD + h * VD + e] = acc;
    }
}

DEV float mb_xpad(const Ctx& c, int j, int m, int sq, int tt, int ch) {
    using namespace cfg;
    if (tt < MB_CONV - 1) return sq < BATCH ? 0.f : c.in[I_CONV][(((size_t)j * DB + (sq - BATCH)) * (MB_CONV - 1) + tt) * MB_CD + ch];
    (void)m; return c.zx[(size_t)(seq_row0(sq) + tt - (MB_CONV - 1)) * MB_IN + MB_INNER + ch];
}
DEV void ph_mb_conv(const Ctx& c, int l, size_t gtid, size_t gsz) {
    using namespace cfg; const int j = l / 3;
    GSL(i, (size_t)MTOT * MB_CD) {
        const int m = (int)(i / MB_CD), ch = (int)(i % MB_CD), t = row_t(m), sq = row_seq(m), T = seq_len(sq);
        float acc = c.in[I_CONVB][j * MB_CD + ch];
        for (int jj = 0; jj < MB_CONV; ++jj) acc += mb_xpad(c, j, m, sq, t + jj, ch) * c.in[I_CONVW][((size_t)j * MB_CONV + jj) * MB_CD + ch];
        c.xbc[i] = siluf_(acc);
        if (t < MB_CONV - 1) {
            const float v = mb_xpad(c, j, m, sq, T + t, ch);
            if (sq < BATCH) c.out[O_CONVP + (((size_t)j * BATCH + sq) * (MB_CONV - 1) + t) * MB_CD + ch] = v;
            else c.out[O_CONVS + (((size_t)j * DB + (sq - BATCH)) * (MB_CONV - 1) + t) * MB_CD + ch] = v;
        }
    }
}
DEV void ph_mb_dt(const Ctx& c, int l, size_t gtid, size_t gsz) {
    using namespace cfg; const int j = l / 3;
    GSL(i, (size_t)MTOT * MB_HEADS) {
        const int m = (int)(i / MB_HEADS), h = (int)(i % MB_HEADS);
        c.dt[i] = softplusf_(c.zx[(size_t)m * MB_IN + MB_INNER + MB_CD + h] + c.in[I_DTB][j * MB_HEADS + h]);
    }
}
DEV void ph_mb_scan(const Ctx& c, int l, size_t gtid, size_t gsz) {
    using namespace cfg; const int j = l / 3;
    GSL(i, (size_t)NSEQ * MB_HEADS * MB_HEAD) {
        const int p = (int)(i % MB_HEAD), h = (int)((i / MB_HEAD) % MB_HEADS), sq = (int)(i / (MB_HEADS * MB_HEAD));
        const int g = h / (MB_HEADS / MB_GROUPS);
        float hs[MB_STATE];
        if (sq < BATCH) { UNROLL for (int n = 0; n < MB_STATE; ++n) hs[n] = 0.f; }
        else { const float* s0 = c.in[I_SSM] + ((((size_t)j * DB + (sq - BATCH)) * MB_HEADS + h) * MB_HEAD + p) * MB_STATE; UNROLL for (int n = 0; n < MB_STATE; ++n) hs[n] = s0[n]; }
        const float A = -expf(c.in[I_ALOG][j * MB_HEADS + h]), dsk = c.in[I_BD][j * MB_HEADS + h];
        const int m0 = seq_row0(sq), T = seq_len(sq);
        for (int t = 0; t < T; ++t) {
            const size_t m = (size_t)(m0 + t);
            const float dtv = c.dt[m * MB_HEADS + h], dA = expf(dtv * A);
            const float xv = c.xbc[m * MB_CD + h * MB_HEAD + p], xdt = xv * dtv;
            const float* Bm = c.xbc + m * MB_CD + MB_INNER + g * MB_STATE; const float* Cm = Bm + MB_GN;
            float yy = 0.f;
            UNROLL for (int n = 0; n < MB_STATE; ++n) { hs[n] = hs[n] * dA + xdt * Bm[n]; yy += Cm[n] * hs[n]; }
            c.my[m * MB_INNER + h * MB_HEAD + p] = yy + dsk * xv;
        }
        float* so = sq < BATCH ? c.out + O_SSMP + ((((size_t)j * BATCH + sq) * MB_HEADS + h) * MB_HEAD + p) * MB_STATE
                               : c.out + O_SSMS + ((((size_t)j * DB + (sq - BATCH)) * MB_HEADS + h) * MB_HEAD + p) * MB_STATE;
        UNROLL for (int n = 0; n < MB_STATE; ++n) so[n] = hs[n];
    }
}
DEV void ph_mb_gate(const Ctx& c, int l, size_t gtid, size_t gsz) {
    using namespace cfg; const int j = l / 3; constexpr int GW = MB_INNER / MB_GROUPS;
    GSL(i, (size_t)MTOT * MB_GROUPS) {
        const int m = (int)(i / MB_GROUPS), g = (int)(i % MB_GROUPS);
        float ss = 0.f;
        for (int e = 0; e < GW; ++e) { const float v = c.my[(size_t)m * MB_INNER + g * GW + e] * siluf_(c.zx[(size_t)m * MB_IN + g * GW + e]); ss += v * v; }
        const float rs = 1.0f / sqrtf(ss / GW + NORM_EPS);
        for (int e = 0; e < GW; ++e) {
            const float v = c.my[(size_t)m * MB_INNER + g * GW + e] * siluf_(c.zx[(size_t)m * MB_IN + g * GW + e]);
            c.yzn[(size_t)m * MB_INNER + g * GW + e] = v * rs * c.in[I_BNORM][j * MB_INNER + g * GW + e];
        }
    }
}
typedef short bf16x8_t __attribute__((ext_vector_type(8)));
typedef float f32x4_t __attribute__((ext_vector_type(4)));
__device__ __forceinline__ unsigned short f2bf(float f) { unsigned u = __float_as_uint(f); u += 0x7fffu + ((u >> 16) & 1u); return (unsigned short)(u >> 16); }
#define XB_TMO      128
#define XB_XCNT(j)  (256  + 64 * (j))
#define XB_XSUB(j)  (1280 + 64 * (j))
#define XB_XGEN(j)  (2304 + 64 * (j))
#define XB_TOP      3328
#define XB_TOPGEN   3392
#define XCD_BAR_WORDS 3456
#define XB_SPIN_CAP (1u << 25)
#define LAS __attribute__((address_space(3)))

__device__ __forceinline__ unsigned xb_ld(unsigned* p)              { return __hip_atomic_load(p, __ATOMIC_RELAXED, __HIP_MEMORY_SCOPE_AGENT); }
__device__ __forceinline__ unsigned xb_add(unsigned* p, unsigned v) { return __hip_atomic_fetch_add(p, v, __ATOMIC_RELAXED, __HIP_MEMORY_SCOPE_AGENT); }
__device__ __forceinline__ unsigned xb_xcc_id() { return (unsigned)__builtin_amdgcn_s_getreg((3 << 11) | 20) & 0xFu; }
#define XB_SPIN(cond, bar) do { unsigned _sp = 0; while (cond) { __builtin_amdgcn_s_sleep(1); \
    if ((++_sp & 255u) == 0u) { if (xb_ld(&(bar)[XB_TMO])) break; if (_sp > XB_SPIN_CAP) { atomicAdd(&(bar)[XB_TMO], 1u); break; } } } } while (0)

struct XcdBarrier {
    unsigned* bar; unsigned x;
    volatile LAS unsigned* st;
};

__device__ __forceinline__ XcdBarrier xcd_barrier_post(unsigned* bar, volatile LAS unsigned* st) {
    XcdBarrier b; b.bar = bar; b.x = xb_xcc_id(); b.st = st;
    if (threadIdx.x == 0) (void)xb_add(&bar[XB_XCNT(b.x)], 1u);
    return b;
}
__device__ __forceinline__ void xcd_barrier_complete(unsigned* bar, unsigned x, unsigned& nloc, unsigned& nx) {
    const unsigned G = gridDim.x * gridDim.y * gridDim.z;
    unsigned sum, cnt, mine, sp = 0u;
    for (;;) {
        sum = 0u; cnt = 0u; mine = 0u;
#pragma unroll
        for (unsigned j = 0; j < 16; ++j) { const unsigned c = xb_ld(&bar[XB_XCNT(j)]); sum += c; cnt += (c > 0u) ? 1u : 0u; mine = (j == x) ? c : mine; }
        if (sum == G) break;
        __builtin_amdgcn_s_sleep(1);
        if ((++sp & 255u) == 0u) { if (xb_ld(&bar[XB_TMO])) break; if (sp > XB_SPIN_CAP) { atomicAdd(&bar[XB_TMO], 1u); break; } }
    }
    nloc = mine > 0u ? mine : 1u; nx = cnt > 0u ? cnt : 1u;
}

__device__ __forceinline__ void xcd_barrier(const XcdBarrier& b) {
    asm volatile("s_waitcnt vmcnt(0)" ::: "memory");
    __syncthreads();
    if (threadIdx.x == 0) {
        unsigned* bar = b.bar;
        __builtin_amdgcn_s_waitcnt(0);
        unsigned nloc = b.st[0], nx = b.st[1];
        if (nloc == 0u) { xcd_barrier_complete(bar, b.x, nloc, nx); b.st[0] = nloc; b.st[1] = nx; }
        const unsigned old = xb_add(&bar[XB_XSUB(b.x)], 1u);
        const unsigned gen = old / nloc;
        if (old + 1u == (gen + 1u) * nloc) {
            __builtin_amdgcn_fence(__ATOMIC_RELEASE, "agent");
            asm volatile("s_waitcnt vmcnt(0)" ::: "memory");
            const unsigned og = xb_add(&bar[XB_TOP], 1u);
            const unsigned tg = og / nx;
            if (og + 1u == (tg + 1u) * nx) xb_add(&bar[XB_TOPGEN], 1u);
            else XB_SPIN(xb_ld(&bar[XB_TOPGEN]) == tg, bar);
            __builtin_amdgcn_fence(__ATOMIC_ACQUIRE, "agent");
            xb_add(&bar[XB_XGEN(b.x)], 1u);
            asm volatile("s_waitcnt vmcnt(0)" ::: "memory");
        } else {
            XB_SPIN(xb_ld(&bar[XB_XGEN(b.x)]) == gen, bar);
            __builtin_amdgcn_fence(__ATOMIC_ACQUIRE, "agent");
            asm volatile("s_waitcnt vmcnt(0)" ::: "memory");
        }
    }
    __syncthreads();
}

struct Bump { char* p; size_t off; float* f(size_t n) { float* r = (float*)(p + off); off += ((n * 4 + 255) / 256) * 256; return r; } };

static size_t setup_ctx(Ctx& c, void* const* d_in, void* d_out, void* d_ws) {
    using namespace cfg;
    for (int i = 0; i < 51; ++i) c.in[i] = (const float*)d_in[i];
    c.page_table = (const int*)d_in[I_PT];
    c.out = (float*)d_out; c.x = c.out;
    Bump b{(char*)d_ws, 4096 * 4};
    const size_t MD = (size_t)MTOT * D;
    c.xn = b.f(MD); c.vf = b.f(MD);
    const size_t base = b.off;
    for (int p = 0; p < 6; ++p) c.xm[p] = b.f(MD);
    c.r = b.f(MD); c.k = b.f(MD); c.v = b.f(MD); c.wpre = b.f(MD); c.apre = b.f(MD); c.vpre = b.f(MD); c.g = b.f(MD);
    c.hw = b.f((size_t)MTOT * RW_DL); c.ha = b.f((size_t)MTOT * RW_AL); c.hv = b.f((size_t)MTOT * RW_VL); c.hg = b.f((size_t)MTOT * RW_GL);
    c.ka = b.f(MD); c.kb = b.f(MD); c.y = c.xm[0]; c.yo = c.xm[1];
    size_t hi = b.off;
    b.off = base;
    c.mh = b.f((size_t)MTOT * MLA_IN); c.qan = b.f((size_t)MTOT * QL); c.q = b.f((size_t)MTOT * MH * QD); c.c = b.f((size_t)MTOT * KVL); c.kp = b.f((size_t)MTOT * ROPE);
    c.knr = b.f((size_t)MTOT * MH * NOPE); c.vv = b.f((size_t)MTOT * MH * VD); c.ao = b.f((size_t)MTOT * MH * VD);
    c.sc = b.f((size_t)DB * MH * DS * KTOT); c.olat = b.f((size_t)DB * MH * DS * KVL);
    if (b.off > hi) hi = b.off;
    b.off = base;
    c.zx = b.f((size_t)MTOT * MB_IN); c.xbc = b.f((size_t)MTOT * MB_CD); c.dt = b.f((size_t)MTOT * MB_HEADS); c.my = b.f((size_t)MTOT * MB_INNER); c.yzn = b.f((size_t)MTOT * MB_INNER);
    if (b.off > hi) hi = b.off;
    b.off = hi;
    c.hmid = b.f((size_t)MTOT * FFN);
    return b.off;
}

__device__ __forceinline__ unsigned tid_now() { unsigned t = threadIdx.x; asm volatile("" : "+v"(t)); return t; }
namespace pg8 {
#define PG8_LAS __attribute__((address_space(3)))
typedef unsigned short bf16_t;
typedef short bf16x8 __attribute__((ext_vector_type(8)));
typedef float f32x4 __attribute__((ext_vector_type(4)));
typedef float f32x2 __attribute__((ext_vector_type(2)));
typedef unsigned u32x4 __attribute__((ext_vector_type(4)));
typedef unsigned u32x2 __attribute__((ext_vector_type(2)));
constexpr int BM = 256, BK = 64, HALF = 128, HTB = HALF * BK * 2  , STAGE_BYTES = 8 * HTB, NXCD = 8, WGM = 8;

__host__ __device__ __forceinline__ int lds_byte(int r, int c) { const int st = (r >> 4) * 2 + (c >> 5), rr = r & 15, cc = c & 31, ob = rr * 64 + cc * 2; return st * 1024 + (ob ^ (((ob >> 9) & 1) << 5)); }
__host__ __device__ __forceinline__ void stage_rc(int b, int& R, int& C) { const int st = b / 1024, sb = b % 1024, swz = sb ^ (((sb >> 9) & 1) << 5); R = (st >> 1) * 16 + swz / 64; C = (st & 1) * 32 + (swz % 64) / 2; }
__host__ __device__ __forceinline__ int perm32(int rho) { const int n = rho >> 4, i = rho & 15; return 8 * (i >> 2) + 4 * n + (i & 3); }
__device__ __forceinline__ unsigned cvt_pk_bf16(float lo, float hi) { unsigned r; asm volatile("v_cvt_pk_bf16_f32 %0, %1, %2" : "=v"(r) : "v"(lo), "v"(hi)); return r; }

struct Unit { int pm, pn, k0, nt, asel, part; };
struct Gemm { const bf16_t* A; const bf16_t* Bt; int lda, ldb; size_t asel_stride; };

struct NoSel { __device__ static __forceinline__ int sel(int) { return 0; } };
template <class ASEL = NoSel>
struct Order {
    int nMp, nMs, nN, nwgP, nwgS, G, c, K, ksplit;
    __device__ __forceinline__ void init(int nMp_, int nMs_, int nN_, int K_, int ksplit_, int G_, int c_) { nMp = nMp_; nMs = nMs_; nN = nN_; nwgP = nMp * nN; K = K_; ksplit = ksplit_; nwgS = nMs * nN * ksplit; G = G_; c = c_; }
    __device__ __forceinline__ bool next(int i, Unit& u) const {
        const long L = (long)i * G + c;
        if (L < nwgP) {
            int wgid = (int)L; { const int q = nwgP / NXCD, r = nwgP % NXCD, xcd = wgid % NXCD, off = wgid / NXCD; wgid = (xcd < r ? xcd * (q + 1) : r * (q + 1) + (xcd - r) * q) + off; }
            const int nig = WGM * nN, gid = wgid / nig, fm = gid * WGM, gsz = (nMp - fm) < WGM ? (nMp - fm) : WGM;
            u.pm = fm + ((wgid % nig) % gsz); u.pn = (wgid % nig) / gsz; u.k0 = 0; u.nt = K / BK; u.part = 0; u.asel = ASEL::sel(u.pn); return true;
        }
        const long Ls = L - nwgP; if (Ls >= nwgS) return false;
        const int sub = (int)(Ls % ksplit), t = (int)(Ls / ksplit);
        u.pm = nMp + t % nMs; u.pn = t / nMs; u.nt = K / BK / ksplit; u.k0 = sub * u.nt * BK; u.part = ksplit > 1 ? 1 : 0; u.asel = ASEL::sel(u.pn); return true;
    }
};

template <class Epi, class Sched>
__device__ __forceinline__ void gemm_phase(PG8_LAS unsigned char* lds, const Gemm g, const Sched& S, const Epi& E) {
    const int tid = (int)tid_now(), wid = __builtin_amdgcn_readfirstlane(tid >> 6), lane = tid & 63, wr = wid >> 2, wc = wid & 3, fr = lane & 15, fq = lane >> 4;
    unsigned voffA[2], voffB[2];
#pragma unroll
    for (int i = 0; i < 2; ++i) { int R, C; stage_rc(tid * 16 + i * 8192, R, C); const int Rb = Epi::PERM ? ((R & ~31) + perm32(R & 31)) : R;
        voffA[i] = (unsigned)(R * g.lda + C) * 2u; voffB[i] = (unsigned)(Rb * g.ldb + C) * 2u; }
    const size_t kstep = (size_t)(BK * 2);
    const size_t hstepA = (size_t)HALF * g.lda * 2, hstepB = (size_t)HALF * g.ldb * 2;
    const unsigned ldsw = (unsigned)wid * 1024u;
    const int aoff = lds_byte(wr * 64 + fr, fq * 8), boff = lds_byte(wc * 32 + fr, fq * 8);
#define PG8_SA(b, h) (((b) * 2 + (h)) * HTB)
#define PG8_SB(b, h) ((4 + (b) * 2 + (h)) * HTB)
#define PG8_STAGE(bufoff, gbase, voff) do { _Pragma("unroll") for (int _i = 0; _i < 2; ++_i) \
        __builtin_amdgcn_global_load_lds((const unsigned*)((const char*)(gbase) + (voff)[_i]), (PG8_LAS unsigned*)(lds + (bufoff) + ldsw + _i * 8192), 16, 0, 0); } while (0)
#define PG8_LDA(dst, b, h) do { _Pragma("unroll") for (int m = 0; m < 4; ++m) _Pragma("unroll") for (int k = 0; k < 2; ++k) dst[m][k] = *(const PG8_LAS bf16x8*)(lds + PG8_SA(b, h) + aoff + m * 2048 + k * 1024); } while (0)
#define PG8_LDB(dst, b, h) do { _Pragma("unroll") for (int n = 0; n < 2; ++n) _Pragma("unroll") for (int k = 0; k < 2; ++k) dst[n][k] = *(const PG8_LAS bf16x8*)(lds + PG8_SB(b, h) + boff + n * 2048 + k * 1024); } while (0)
#define PG8_MMA(ai, bj, At, Bt) do { __builtin_amdgcn_s_setprio(1); _Pragma("unroll") for (int m = 0; m < 4; ++m) _Pragma("unroll") for (int n = 0; n < 2; ++n) _Pragma("unroll") for (int k = 0; k < 2; ++k) \
        acc[ai][bj][m][n] = __builtin_amdgcn_mfma_f32_16x16x32_bf16(Bt[n][k], At[m][k], acc[ai][bj][m][n], 0, 0, 0); __builtin_amdgcn_s_setprio(0); } while (0)
#define PG8_WAIT_V(n) asm volatile("s_waitcnt vmcnt(" #n ")" ::: "memory")
#define PG8_WAIT_L(n) asm volatile("s_waitcnt lgkmcnt(" #n ")" ::: "memory")
#define PG8_BAR __builtin_amdgcn_s_barrier()
#define PG8_SCHED __builtin_amdgcn_sched_barrier(0)
#define PG8_ABASE(u) ((const char*)g.A + ((size_t)(u).asel * g.asel_stride + (size_t)(u).pm * BM * g.lda + (u).k0) * 2)
#define PG8_BBASE(u) ((const char*)g.Bt + ((size_t)(u).pn * BM * g.ldb + (u).k0) * 2)
    Unit cur, nxt; int ui = 0;
    if (!S.next(0, cur)) return;
    f32x4 acc[2][2][4][2];
#pragma unroll
    for (int a = 0; a < 2; ++a)
#pragma unroll
        for (int b = 0; b < 2; ++b)
#pragma unroll
            for (int m = 0; m < 4; ++m)
#pragma unroll
                for (int n = 0; n < 2; ++n) acc[a][b][m][n] = (f32x4){0.f, 0.f, 0.f, 0.f};
    bf16x8 At[4][2], B0[2][2], B1[2][2];
    const char* cA = PG8_ABASE(cur); const char* cB = PG8_BBASE(cur);
    PG8_STAGE(PG8_SB(0, 0), cB, voffB); PG8_STAGE(PG8_SA(0, 0), cA, voffA); PG8_STAGE(PG8_SB(0, 1), cB + hstepB, voffB); PG8_STAGE(PG8_SA(0, 1), cA + hstepA, voffA);
    if (wr == 1) PG8_BAR;
    PG8_WAIT_V(4); PG8_BAR;
    PG8_STAGE(PG8_SB(1, 0), cB + kstep, voffB); PG8_STAGE(PG8_SA(1, 0), cA + kstep, voffA); PG8_STAGE(PG8_SB(1, 1), cB + hstepB + kstep, voffB);
    PG8_WAIT_V(6); PG8_BAR;
    for (;;) {
        const bool has_next = S.next(ui + 1, nxt);
        const char* nA = has_next ? PG8_ABASE(nxt) : cA; const char* nB = has_next ? PG8_BBASE(nxt) : cB;
        const int nt = cur.nt;
        for (int t = 0; t < nt; t += 2) {
            const bool last = (t == nt - 2);
            const char* a1 = cA + (size_t)(t + 1) * kstep;
            const char* a2 = last ? nA : cA + (size_t)(t + 2) * kstep; const char* b2 = last ? nB : cB + (size_t)(t + 2) * kstep;
            const char* a3 = a2 + kstep; const char* b3 = b2 + kstep;
            PG8_LDB(B0, 0, 0); PG8_SCHED; PG8_LDA(At, 0, 0); PG8_STAGE(PG8_SA(1, 1), a1 + hstepA, voffA);
            PG8_WAIT_L(8); PG8_BAR; PG8_WAIT_L(0); PG8_MMA(0, 0, At, B0); PG8_BAR; PG8_SCHED;
            PG8_LDB(B1, 0, 1); PG8_STAGE(PG8_SB(0, 0), b2, voffB);
            PG8_BAR; PG8_WAIT_L(0); PG8_MMA(0, 1, At, B1); PG8_BAR;
            PG8_LDA(At, 0, 1); PG8_STAGE(PG8_SA(0, 0), a2, voffA);
            PG8_BAR; PG8_WAIT_L(0); PG8_MMA(1, 0, At, B0); PG8_BAR; PG8_SCHED;
            PG8_STAGE(PG8_SB(0, 1), b2 + hstepB, voffB);
            PG8_WAIT_V(6); PG8_BAR; PG8_MMA(1, 1, At, B1); PG8_BAR;
            PG8_LDB(B0, 1, 0); PG8_SCHED; PG8_LDA(At, 1, 0); PG8_STAGE(PG8_SA(0, 1), a2 + hstepA, voffA);
            PG8_WAIT_L(8); PG8_BAR; PG8_WAIT_L(0); PG8_MMA(0, 0, At, B0); PG8_BAR; PG8_SCHED;
            PG8_LDB(B1, 1, 1); PG8_STAGE(PG8_SB(1, 0), b3, voffB);
            PG8_BAR; PG8_WAIT_L(0); PG8_MMA(0, 1, At, B1); PG8_BAR;
            PG8_LDA(At, 1, 1); PG8_STAGE(PG8_SA(1, 0), a3, voffA);
            PG8_BAR; PG8_WAIT_L(0); PG8_MMA(1, 0, At, B0); PG8_BAR; PG8_SCHED;
            PG8_STAGE(PG8_SB(1, 1), b3 + hstepB, voffB);
            PG8_WAIT_V(6); PG8_BAR; PG8_MMA(1, 1, At, B1); PG8_BAR;
        }
        E(acc, cur, wr, wc, fr, fq);
        if (!has_next) break;
#pragma unroll
        for (int a = 0; a < 2; ++a)
#pragma unroll
            for (int b = 0; b < 2; ++b)
#pragma unroll
                for (int m = 0; m < 4; ++m)
#pragma unroll
                    for (int n = 0; n < 2; ++n) acc[a][b][m][n] = (f32x4){0.f, 0.f, 0.f, 0.f};
        cur = nxt; cA = nA; cB = nB; ++ui;
    }
    PG8_WAIT_V(0);
    if (wr == 0) PG8_BAR;
    PG8_BAR;
#undef PG8_SA
#undef PG8_SB
#undef PG8_STAGE
#undef PG8_LDA
#undef PG8_LDB
#undef PG8_MMA
#undef PG8_WAIT_V
#undef PG8_WAIT_L
#undef PG8_BAR
#undef PG8_SCHED
#undef PG8_ABASE
#undef PG8_BBASE
}

struct EpiAccF32 {
    static constexpr bool PERM = false;
    float* C; int ldc; float* slab; int pm0, nMs, ksplit;
    __device__ __forceinline__ void operator()(const f32x4 (&acc)[2][2][4][2], const Unit& u, int wr, int wc, int fr, int fq) const {
        if (u.part) {
            float* sl = slab + ((size_t)((u.pn * nMs + (u.pm - pm0)) * ksplit + u.k0 / (u.nt * BK)) * BM + wr * 64 + fr) * BM + wc * 32 + 4 * fq;
#pragma unroll
            for (int ai = 0; ai < 2; ++ai)
#pragma unroll
                for (int m = 0; m < 4; ++m) { float* rowp = sl + (size_t)(ai * HALF + m * 16) * BM;
#pragma unroll
                    for (int bj = 0; bj < 2; ++bj)
#pragma unroll
                        for (int n = 0; n < 2; ++n) *(f32x4*)(rowp + bj * HALF + n * 16) = acc[ai][bj][m][n]; }
        } else {
            const int row0 = u.pm * BM + wr * 64 + fr, col0 = u.pn * BM + wc * 32 + 4 * fq;
#pragma unroll
            for (int ai = 0; ai < 2; ++ai)
#pragma unroll
                for (int m2 = 0; m2 < 4; m2 += 2) {
                    f32x4 t[2][2][2];
#pragma unroll
                    for (int mm = 0; mm < 2; ++mm) { const float* rowp = C + (size_t)(row0 + ai * HALF + (m2 + mm) * 16) * ldc + col0;
#pragma unroll
                        for (int bj = 0; bj < 2; ++bj)
#pragma unroll
                            for (int n = 0; n < 2; ++n) t[mm][bj][n] = *(const f32x4*)(rowp + bj * HALF + n * 16); }
#pragma unroll
                    for (int mm = 0; mm < 2; ++mm) { float* rowp = C + (size_t)(row0 + ai * HALF + (m2 + mm) * 16) * ldc + col0;
#pragma unroll
                        for (int bj = 0; bj < 2; ++bj)
#pragma unroll
                            for (int n = 0; n < 2; ++n) *(f32x4*)(rowp + bj * HALF + n * 16) = t[mm][bj][n] + acc[ai][bj][m2 + mm][n]; }
                }
        }
    }
};
struct EpiF32 {
    static constexpr bool PERM = false;
    float* C; int ldc; int ncols;
    __device__ __forceinline__ void operator()(const f32x4 (&acc)[2][2][4][2], const Unit& u, int wr, int wc, int fr, int fq) const {
        const int row0 = u.pm * BM + wr * 64 + fr, col0 = u.pn * BM + wc * 32 + 4 * fq;
#pragma unroll
        for (int ai = 0; ai < 2; ++ai)
#pragma unroll
            for (int m = 0; m < 4; ++m) { float* rowp = C + (size_t)(row0 + ai * HALF + m * 16) * ldc + col0;
#pragma unroll
                for (int bj = 0; bj < 2; ++bj)
#pragma unroll
                    for (int n = 0; n < 2; ++n) if (col0 + bj * HALF + n * 16 < ncols) *(f32x4*)(rowp + bj * HALF + n * 16) = acc[ai][bj][m][n]; }
    }
};
template <int ACT> struct EpiBf16 {
    static constexpr bool PERM = true;
    bf16_t* O; int ldc;
    __device__ __forceinline__ void operator()(const f32x4 (&acc)[2][2][4][2], const Unit& u, int wr, int wc, int fr, int fq) const {
        const int row0 = u.pm * BM + wr * 64 + fr, col0 = u.pn * BM + wc * 32 + 8 * fq;
#pragma unroll
        for (int ai = 0; ai < 2; ++ai)
#pragma unroll
            for (int m = 0; m < 4; ++m) { bf16_t* rowp = O + (size_t)(row0 + ai * HALF + m * 16) * ldc + col0;
#pragma unroll
                for (int bj = 0; bj < 2; ++bj) { f32x4 v0 = acc[ai][bj][m][0], v1 = acc[ai][bj][m][1];
                    if (ACT == 3) {
#pragma unroll
                        for (int j = 0; j < 4; ++j) { const float a = fmaxf(v0[j], 0.f), b = fmaxf(v1[j], 0.f); v0[j] = a * a; v1[j] = b * b; } }
                    u32x4 w; w.x = cvt_pk_bf16(v0[0], v0[1]); w.y = cvt_pk_bf16(v0[2], v0[3]); w.z = cvt_pk_bf16(v1[0], v1[1]); w.w = cvt_pk_bf16(v1[2], v1[3]);
                    *(u32x4*)(rowp + bj * HALF) = w; } }
    }
};
}
typedef pg8::bf16_t bf16_t;
#define LDSP __attribute__((address_space(3)))
struct Fast {
    bf16_t *xnb, *hmidb;
    bf16_t *w1t, *w2t;
    float* slab;
};
__device__ __forceinline__ unsigned pk2bf(float lo, float hi) { return pg8::cvt_pk_bf16(lo, hi); }
__device__ __forceinline__ float wave_sum64(float v) {
#pragma unroll
    for (int o = 1; o < 64; o <<= 1) v += __shfl_xor(v, o);
    return v;
}
__device__ __forceinline__ void red16x4(float& a, float& b, float& c, float& d) {
    asm volatile("s_nop 1\n"
        "v_add_f32_dpp %0, %0, %0 quad_perm:[1,0,3,2] row_mask:0xf bank_mask:0xf\n" "v_add_f32_dpp %1, %1, %1 quad_perm:[1,0,3,2] row_mask:0xf bank_mask:0xf\n"
        "v_add_f32_dpp %2, %2, %2 quad_perm:[1,0,3,2] row_mask:0xf bank_mask:0xf\n" "v_add_f32_dpp %3, %3, %3 quad_perm:[1,0,3,2] row_mask:0xf bank_mask:0xf\n"
        "v_add_f32_dpp %0, %0, %0 quad_perm:[2,3,0,1] row_mask:0xf bank_mask:0xf\n" "v_add_f32_dpp %1, %1, %1 quad_perm:[2,3,0,1] row_mask:0xf bank_mask:0xf\n"
        "v_add_f32_dpp %2, %2, %2 quad_perm:[2,3,0,1] row_mask:0xf bank_mask:0xf\n" "v_add_f32_dpp %3, %3, %3 quad_perm:[2,3,0,1] row_mask:0xf bank_mask:0xf\n"
        "v_add_f32_dpp %0, %0, %0 row_ror:4 row_mask:0xf bank_mask:0xf\n" "v_add_f32_dpp %1, %1, %1 row_ror:4 row_mask:0xf bank_mask:0xf\n"
        "v_add_f32_dpp %2, %2, %2 row_ror:4 row_mask:0xf bank_mask:0xf\n" "v_add_f32_dpp %3, %3, %3 row_ror:4 row_mask:0xf bank_mask:0xf\n"
        "v_add_f32_dpp %0, %0, %0 row_ror:8 row_mask:0xf bank_mask:0xf\n" "v_add_f32_dpp %1, %1, %1 row_ror:8 row_mask:0xf bank_mask:0xf\n"
        "v_add_f32_dpp %2, %2, %2 row_ror:8 row_mask:0xf bank_mask:0xf\n" "v_add_f32_dpp %3, %3, %3 row_ror:8 row_mask:0xf bank_mask:0xf\n"
        "s_nop 1"
        : "+v"(a), "+v"(b), "+v"(c), "+v"(d));
}
__device__ __forceinline__ void tr_item(const float* __restrict__ W, int ldw, int K, bf16_t* WT, int nvalid, const float* __restrict__ kscale, LDSP float* scr, int item, int nblk, int lane) {
    const int kb = item / nblk, nb = item % nblk, k0 = 64 * kb, n0 = 32 * nb;
    const bool ok = n0 < nvalid;
#pragma unroll
    for (int i = 0; i < 8; ++i) { const int kk = 8 * i + (lane >> 3), nn = 4 * (lane & 7); pg8::f32x4 v = ok ? *(const pg8::f32x4*)(W + (size_t)(k0 + kk) * ldw + n0 + nn) : (pg8::f32x4){0.f, 0.f, 0.f, 0.f};
        if (kscale) v = v * kscale[k0 + kk];
        scr[kk * 33 + nn] = v[0]; scr[kk * 33 + nn + 1] = v[1]; scr[kk * 33 + nn + 2] = v[2]; scr[kk * 33 + nn + 3] = v[3]; }
    asm volatile("s_waitcnt lgkmcnt(0)" ::: "memory");
    const int c = lane & 7;
#pragma unroll
    for (int j = 0; j < 4; ++j) { const int n = (lane >> 3) + 8 * j; const LDSP float* s = scr + (8 * c) * 33 + n;
        pg8::u32x4 o; o.x = pk2bf(s[0 * 33], s[1 * 33]); o.y = pk2bf(s[2 * 33], s[3 * 33]); o.z = pk2bf(s[4 * 33], s[5 * 33]); o.w = pk2bf(s[6 * 33], s[7 * 33]);
        *(pg8::u32x4*)(WT + (size_t)(n0 + n) * K + k0 + 8 * c) = o; }
    asm volatile("s_waitcnt lgkmcnt(0)" ::: "memory");
}
__device__ __forceinline__ void tr_weight(const float* W, int K, int N, int npad, bf16_t* WT, const float* kscale, LDSP float* scr, int gw, int ngw, int lane) {
    const int nblk = npad / 32, items = (K / 64) * nblk;
    for (int it = gw; it < items; it += ngw) tr_item(W, N, K, WT, N, kscale, scr, it, nblk, lane);
}
constexpr int TRJ_W = 12;
struct TrTab { LDSP int* t; int n; int total; };
__device__ __forceinline__ void trj_put(TrTab& tb, const float* W, int K, int N, int npad, bf16_t* WT) {
    LDSP int* e = tb.t + tb.n * TRJ_W; const unsigned long long w = (unsigned long long)(size_t)W, o = (unsigned long long)(size_t)WT;
    const int nblk = npad / 32, items = (K / 64) * nblk;
    e[0] = (int)(unsigned)w; e[1] = (int)(unsigned)(w >> 32); e[2] = (int)(unsigned)o; e[3] = (int)(unsigned)(o >> 32); e[4] = N; e[5] = K; e[6] = N; e[7] = nblk; e[8] = tb.total; e[9] = tb.total + items;
    tb.total += items; ++tb.n;
}
struct TrCur { bf16_t* wt; int K, k0, n0; };
__device__ __forceinline__ bool trj_issue(LDSP const int* tab, int njobs, int idx, int& j, pg8::f32x4 (&v)[8], TrCur& t, int lane) {
    while (j < njobs && idx >= __builtin_amdgcn_readfirstlane(tab[j * TRJ_W + 9])) ++j;
    if (j >= njobs) return false;
    LDSP const int* e = tab + j * TRJ_W;
    const unsigned wl = __builtin_amdgcn_readfirstlane(e[0]), wh = __builtin_amdgcn_readfirstlane(e[1]), ol = __builtin_amdgcn_readfirstlane(e[2]), oh = __builtin_amdgcn_readfirstlane(e[3]);
    const int ldw = __builtin_amdgcn_readfirstlane(e[4]), K = __builtin_amdgcn_readfirstlane(e[5]), nvalid = __builtin_amdgcn_readfirstlane(e[6]), nblk = __builtin_amdgcn_readfirstlane(e[7]), it = idx - __builtin_amdgcn_readfirstlane(e[8]);
    const float* W = (const float*)(size_t)(((unsigned long long)wh << 32) | wl);
    const int kb = it / nblk, nb = it - kb * nblk, k0 = 64 * kb, n0 = 32 * nb;
    t.wt = (bf16_t*)(size_t)(((unsigned long long)oh << 32) | ol); t.K = K; t.k0 = k0; t.n0 = n0;
    const bool ok = n0 < nvalid;
#pragma unroll
    for (int i = 0; i < 8; ++i) { const int kk = 8 * i + (lane >> 3), nn = 4 * (lane & 7); v[i] = ok ? *(const pg8::f32x4*)(W + (size_t)(k0 + kk) * ldw + n0 + nn) : (pg8::f32x4){0.f, 0.f, 0.f, 0.f}; }
    return true;
}
__device__ __forceinline__ void trj_finish(const pg8::f32x4 (&v)[8], const TrCur& t, LDSP float* scr, int lane) {
#pragma unroll
    for (int i = 0; i < 8; ++i) { const int kk = 8 * i + (lane >> 3), nn = 4 * (lane & 7);
        scr[kk * 33 + nn] = v[i][0]; scr[kk * 33 + nn + 1] = v[i][1]; scr[kk * 33 + nn + 2] = v[i][2]; scr[kk * 33 + nn + 3] = v[i][3]; }
    asm volatile("s_waitcnt lgkmcnt(0)" ::: "memory");
    const int c = lane & 7;
#pragma unroll
    for (int j = 0; j < 4; ++j) { const int n = (lane >> 3) + 8 * j; const LDSP float* s = scr + (8 * c) * 33 + n;
        pg8::u32x4 o; o.x = pk2bf(s[0 * 33], s[1 * 33]); o.y = pk2bf(s[2 * 33], s[3 * 33]); o.z = pk2bf(s[4 * 33], s[5 * 33]); o.w = pk2bf(s[6 * 33], s[7 * 33]);
        *(pg8::u32x4*)(t.wt + (size_t)(t.n0 + n) * t.K + t.k0 + 8 * c) = o; }
    asm volatile("s_waitcnt lgkmcnt(0)" ::: "memory");
}
__device__ __forceinline__ void trj_run(LDSP const int* tab, int njobs, int total, LDSP float* scr, int gw, int ngw, int lane) {
    int j = 0; pg8::f32x4 va[8], vb[8]; TrCur ta, tb;
    int idx = gw;
    bool have = idx < total && trj_issue(tab, njobs, idx, j, va, ta, lane);
    while (have) {
        idx += ngw; const bool hb = idx < total && trj_issue(tab, njobs, idx, j, vb, tb, lane);
        trj_finish(va, ta, scr, lane);
        if (!hb) break;
        idx += ngw; have = idx < total && trj_issue(tab, njobs, idx, j, va, ta, lane);
        trj_finish(vb, tb, scr, lane);
    }
}
__device__ __forceinline__ pg8::f32x4 slab_sum(const float* __restrict__ slab, int ksplit, int m, int q, int lane) {
    using namespace cfg; const int rs = m - MP, pms = rs >> 8, row = rs & 255;
    const float* p = slab + ((size_t)((q * (MS / 256) + pms) * ksplit) * 256 + row) * 256 + 4 * lane;
    pg8::f32x4 s = {0.f, 0.f, 0.f, 0.f};
    for (int k = 0; k < ksplit; ++k) s = s + *(const pg8::f32x4*)(p + (size_t)k * 65536);
    return s;
}
__device__ __forceinline__ void norm_rows_bf16(float* __restrict__ x, const float* __restrict__ gain, bf16_t* xn, const float* __restrict__ slab, int ksplit, int gw, int ngw, int lane) {
    using namespace cfg;
    pg8::f32x4 gv[4];
#pragma unroll
    for (int j = 0; j < 4; ++j) gv[j] = *(const pg8::f32x4*)(gain + 4 * lane + 256 * j);
    for (int m = gw; m < MTOT; m += ngw) {
        float* xr = x + (size_t)m * D; pg8::f32x4 v[4]; float s = 0.f;
#pragma unroll
        for (int j = 0; j < 4; ++j) { v[j] = *(const pg8::f32x4*)(xr + 4 * lane + 256 * j);
            if (ksplit > 1 && m >= MP) { v[j] = v[j] + slab_sum(slab, ksplit, m, j, lane); *(pg8::f32x4*)(xr + 4 * lane + 256 * j) = v[j]; }
            s += (v[j][0] * v[j][0] + v[j][1] * v[j][1]) + (v[j][2] * v[j][2] + v[j][3] * v[j][3]); }
        const float rs = 1.0f / sqrtf(wave_sum64(s) * (1.0f / D) + NORM_EPS);
#pragma unroll
        for (int j = 0; j < 4; ++j) { pg8::u32x2 o; o.x = pk2bf(v[j][0] * rs * gv[j][0], v[j][1] * rs * gv[j][1]); o.y = pk2bf(v[j][2] * rs * gv[j][2], v[j][3] * rs * gv[j][3]);
            *(pg8::u32x2*)(xn + (size_t)m * D + 4 * lane + 256 * j) = o; }
    }
}

__device__ __forceinline__ void fold_sample_rows(float* __restrict__ x, const float* __restrict__ slab, int ksplit, int gw, int ngw, int lane) {
    using namespace cfg;
    for (int m = MP + gw; m < MTOT; m += ngw) {
#pragma unroll
        for (int j = 0; j < 4; ++j) { float* p = x + (size_t)m * D + 4 * lane + 256 * j; *(pg8::f32x4*)p = *(const pg8::f32x4*)p + slab_sum(slab, ksplit, m, j, lane); }
    }
}
struct FastMla {
    float* mh;
    bf16_t *qan, *cb, *kpb;
    bf16_t *qraw, *kvraw;
    bf16_t *qf, *knb, *aob, *vT, *qs;
    float *opart, *lpart;
    bf16_t *wint, *wuqt, *wukvt, *wot;
};
__device__ __forceinline__ void rope_cs(int pos, int i, float& cs, float& sn) {
    const float inv = exp2f(-(float)i * (13.287712379549449f / 16.0f));
    const float ang = (float)pos * inv, kq = rintf(ang * 0.15915494309189535f);
    float rr = fmaf(-kq, 6.28125f, ang); rr = fmaf(-kq, 1.9353071795864769e-3f, rr);
    cs = __cosf(rr); sn = __sinf(rr);
}
__device__ __forceinline__ float bf2f(unsigned short b) { return __uint_as_float(((unsigned)b) << 16); }
__device__ __forceinline__ void mla_norm1_fast(const Ctx& c, const FastMla& fm, int j, int gw, int ngw, int lane) {
    using namespace cfg;
    for (int m = gw; m < MTOT; m += ngw) {
        const float* h = fm.mh + (size_t)m * 1024;
        pg8::f32x4 qv[2]; float s = 0.f;
#pragma unroll
        for (int t = 0; t < 2; ++t) { qv[t] = *(const pg8::f32x4*)(h + 4 * lane + 256 * t); s += (qv[t][0] * qv[t][0] + qv[t][1] * qv[t][1]) + (qv[t][2] * qv[t][2] + qv[t][3] * qv[t][3]); }
        const float rq = 1.0f / sqrtf(wave_sum64(s) * (1.0f / QL) + NORM_EPS);
#pragma unroll
        for (int t = 0; t < 2; ++t) { const pg8::f32x4 g = *(const pg8::f32x4*)(c.in[I_QNORM] + j * QL + 4 * lane + 256 * t);
            pg8::u32x2 o; o.x = pk2bf(qv[t][0] * rq * g[0], qv[t][1] * rq * g[1]); o.y = pk2bf(qv[t][2] * rq * g[2], qv[t][3] * rq * g[3]);
            *(pg8::u32x2*)(fm.qan + (size_t)m * QL + 4 * lane + 256 * t) = o; }
        const pg8::f32x4 cv = *(const pg8::f32x4*)(h + QL + 4 * lane);
        const float rc = 1.0f / sqrtf(wave_sum64((cv[0] * cv[0] + cv[1] * cv[1]) + (cv[2] * cv[2] + cv[3] * cv[3])) * (1.0f / KVL) + NORM_EPS);
        const pg8::f32x4 gc = *(const pg8::f32x4*)(c.in[I_KVNORM] + j * KVL + 4 * lane);
        const pg8::f32x4 cn = {cv[0] * rc * gc[0], cv[1] * rc * gc[1], cv[2] * rc * gc[2], cv[3] * rc * gc[3]};
        float* co = m < MP ? c.out + O_CKVP + ((size_t)j * MP + m) * KVL : c.out + O_CKVS + ((size_t)j * MS + (m - MP)) * KVL;
        *(pg8::f32x4*)(co + 4 * lane) = cn; *(pg8::f32x4*)(c.c + (size_t)m * KVL + 4 * lane) = cn;
        { pg8::u32x2 o; o.x = pk2bf(cn[0], cn[1]); o.y = pk2bf(cn[2], cn[3]); *(pg8::u32x2*)(fm.cb + (size_t)m * KVL + 4 * lane) = o; }
        const float kv = lane < ROPE ? h[QL + KVL + lane] : 0.f;
        const float rk = 1.0f / sqrtf(wave_sum64(kv * kv) * (1.0f / ROPE) + NORM_EPS);
        const float kn = kv * rk * (lane < ROPE ? c.in[I_KRN][j * ROPE + lane] : 0.f);
        const float other = __shfl_xor(kn, 16);
        float cs, sn; rope_cs(row_pos(m), lane & 15, cs, sn);
        const float ro = lane < 16 ? kn * cs - other * sn : kn * cs + other * sn;
        if (lane < ROPE) {
            float* ko = m < MP ? c.out + O_KPEP + ((size_t)j * MP + m) * ROPE : c.out + O_KPES + ((size_t)j * MS + (m - MP)) * ROPE;
            ko[lane] = ro; c.kp[(size_t)m * ROPE + lane] = ro;
            fm.kpb[(size_t)m * ROPE + lane] = (bf16_t)(pk2bf(ro, 0.f) & 0xffffu);
        }
    }
}
__device__ __forceinline__ void mla_norm2_fast(const Ctx& c, const FastMla& fm, int j, int gw, int ngw, int lane) {
    using namespace cfg;
    const int hd = lane >> 2, qt = lane & 3;
    const float QSC = 0.10206207261596575f * 1.4426950408889634f;
    for (int m = gw; m < MTOT; m += ngw) {
        const bf16_t* qr = fm.qraw + (size_t)m * (MH * QD) + hd * QD;
        float v[16]; float s = 0.f;
        { const pg8::u32x4 a = *(const pg8::u32x4*)(qr + 16 * qt), b = *(const pg8::u32x4*)(qr + 16 * qt + 8); const unsigned w[8] = {a.x, a.y, a.z, a.w, b.x, b.y, b.z, b.w};
#pragma unroll
          for (int i = 0; i < 8; ++i) { v[2 * i] = __uint_as_float(w[i] << 16); v[2 * i + 1] = __uint_as_float(w[i] & 0xffff0000u); } }
#pragma unroll
        for (int i = 0; i < 16; ++i) s += v[i] * v[i];
        s += __shfl_xor(s, 1); s += __shfl_xor(s, 2);
        float rs = 1.0f / sqrtf(s * (1.0f / NOPE) + NORM_EPS);
        bf16_t* qo = fm.qf + (size_t)m * (MH * QD) + hd * QD; float* qo32 = c.q + (size_t)m * (MH * QD) + hd * QD;
        { unsigned w[8], w2[8];
#pragma unroll
          for (int i = 0; i < 8; ++i) { const float a = v[2 * i] * rs * c.in[I_QNN][j * NOPE + 16 * qt + 2 * i], b = v[2 * i + 1] * rs * c.in[I_QNN][j * NOPE + 16 * qt + 2 * i + 1];
              w[i] = pk2bf(a * QSC, b * QSC); qo32[16 * qt + 2 * i] = a; qo32[16 * qt + 2 * i + 1] = b;
              w2[i] = pk2bf(a * QSC * c.in[I_KNN][j * NOPE + 16 * qt + 2 * i], b * QSC * c.in[I_KNN][j * NOPE + 16 * qt + 2 * i + 1]); }
          *(pg8::u32x4*)(qo + 16 * qt) = (pg8::u32x4){w[0], w[1], w[2], w[3]}; *(pg8::u32x4*)(qo + 16 * qt + 8) = (pg8::u32x4){w[4], w[5], w[6], w[7]};
          if (m >= MP) { bf16_t* q2 = fm.qs + ((size_t)(((m - MP) >> 3) * MH + hd) * 6 + qt) * 128 + ((m - MP) & 7) * 8;
              *(pg8::u32x4*)(q2) = (pg8::u32x4){w2[0], w2[1], w2[4], w2[5]}; *(pg8::u32x4*)(q2 + 64) = (pg8::u32x4){w2[2], w2[3], w2[6], w2[7]}; } }
        float r8[8]; s = 0.f;
        { const pg8::u32x4 a = *(const pg8::u32x4*)(qr + NOPE + 8 * qt); const unsigned w[4] = {a.x, a.y, a.z, a.w};
#pragma unroll
          for (int i = 0; i < 4; ++i) { r8[2 * i] = __uint_as_float(w[i] << 16); r8[2 * i + 1] = __uint_as_float(w[i] & 0xffff0000u); } }
#pragma unroll
        for (int i = 0; i < 8; ++i) s += r8[i] * r8[i];
        s += __shfl_xor(s, 1); s += __shfl_xor(s, 2);
        rs = 1.0f / sqrtf(s * (1.0f / ROPE) + NORM_EPS);
        { unsigned w[4]; float o8[8];
#pragma unroll
          for (int i = 0; i < 8; ++i) { const float mine = r8[i] * rs * c.in[I_QRN][j * ROPE + 8 * qt + i]; const float oth = __shfl_xor(mine, 2);
              float cs, sn; rope_cs(row_pos(m), (8 * qt + i) & 15, cs, sn);
              o8[i] = qt < 2 ? mine * cs - oth * sn : mine * cs + oth * sn; qo32[NOPE + 8 * qt + i] = o8[i]; }
#pragma unroll
          for (int i = 0; i < 4; ++i) w[i] = pk2bf(o8[2 * i] * QSC, o8[2 * i + 1] * QSC);
          *(pg8::u32x4*)(qo + NOPE + 8 * qt) = (pg8::u32x4){w[0], w[1], w[2], w[3]};
          if (m >= MP) *(pg8::u32x4*)(fm.qs + ((size_t)(((m - MP) >> 3) * MH + hd) * 6 + 4 + (qt >> 1)) * 128 + (qt & 1) * 64 + ((m - MP) & 7) * 8) = (pg8::u32x4){w[0], w[1], w[2], w[3]}; }
        const bf16_t* kr = fm.kvraw + (size_t)m * 2048 + hd * NOPE; s = 0.f;
        { const pg8::u32x4 a = *(const pg8::u32x4*)(kr + 16 * qt), b = *(const pg8::u32x4*)(kr + 16 * qt + 8); const unsigned w[8] = {a.x, a.y, a.z, a.w, b.x, b.y, b.z, b.w};
#pragma unroll
          for (int i = 0; i < 8; ++i) { v[2 * i] = __uint_as_float(w[i] << 16); v[2 * i + 1] = __uint_as_float(w[i] & 0xffff0000u); } }
#pragma unroll
        for (int i = 0; i < 16; ++i) s += v[i] * v[i];
        s += __shfl_xor(s, 1); s += __shfl_xor(s, 2);
        rs = 1.0f / sqrtf(s * (1.0f / NOPE) + NORM_EPS);
        bf16_t* ko = fm.knb + (size_t)m * (MH * NOPE) + hd * NOPE;
        { unsigned w[8];
#pragma unroll
          for (int i = 0; i < 8; ++i) { const float a = v[2 * i] * rs * c.in[I_KNN][j * NOPE + 16 * qt + 2 * i], b = v[2 * i + 1] * rs * c.in[I_KNN][j * NOPE + 16 * qt + 2 * i + 1];
              w[i] = pk2bf(a, b); }
          *(pg8::u32x4*)(ko + 16 * qt) = (pg8::u32x4){w[0], w[1], w[2], w[3]}; *(pg8::u32x4*)(ko + 16 * qt + 8) = (pg8::u32x4){w[4], w[5], w[6], w[7]}; }
    }
}
__device__ __forceinline__ void cvt_f32_bf16(const float* __restrict__ s, bf16_t* d, size_t n, size_t gtid, size_t gsz) {
    for (size_t i = gtid * 4; i < n; i += gsz * 4) { const pg8::f32x4 v = *(const pg8::f32x4*)(s + i); pg8::u32x2 o; o.x = pk2bf(v[0], v[1]); o.y = pk2bf(v[2], v[3]); *(pg8::u32x2*)(d + i) = o; }
}
typedef float f32x16_t __attribute__((ext_vector_type(16)));
typedef pg8::bf16x8 bf16x8v;
constexpr int AT_KROW = 208, AT_VROW = 136, AT_KBUF = 64 * AT_KROW, AT_VBUF = 64 * AT_VROW, AT_LDS = 2 * AT_KBUF + 2 * AT_VBUF;
__device__ __forceinline__ void attn_prompt_fast(const bf16_t* __restrict__ qf, const bf16_t* __restrict__ knb, const bf16_t* __restrict__ kpb, const bf16_t* __restrict__ vT, bf16_t* aob, LDSP unsigned char* lds) {
    using namespace cfg;
    const int tid = (int)tid_now(), w = __builtin_amdgcn_readfirstlane(tid >> 6), lane = tid & 63, l31 = lane & 31, h5 = lane >> 5;
    for (int it = blockIdx.x; it < BATCH * MH * 4; it += gridDim.x) {
        const int bh = it >> 2, pr = it & 3, b = bh / MH, h = bh % MH;
        for (int half = 0; half < 2; ++half) {
            const int qb = half ? 7 - pr : pr, q0 = 256 * qb, nt = 4 * qb + 4;
            const int qg = q0 + 32 * w + l31;
            const size_t mrow = (size_t)b * SEQ + qg;
            bf16x8v qfr[6];
#pragma unroll
            for (int s = 0; s < 6; ++s) qfr[s] = *(const bf16x8v*)(qf + mrow * (MH * QD) + h * QD + 16 * s + 8 * h5);
            f32x16_t O[2];
#pragma unroll
            for (int db = 0; db < 2; ++db)
#pragma unroll
                for (int r = 0; r < 16; ++r) O[db][r] = 0.f;
            float mrun = -1e30f, lrun = 0.f;
            pg8::u32x4 rk, rp, rv;
            const int kkey = tid >> 3, kc8 = tid & 7, pkey = tid >> 2, pc4 = tid & 3;
#define AT_LOAD(t) do { const size_t mk = (size_t)b * SEQ + 64 * (t); \
                rk = *(const pg8::u32x4*)(knb + (mk + kkey) * (MH * NOPE) + h * NOPE + kc8 * 8); \
                if (tid < 256) rp = *(const pg8::u32x4*)(kpb + (mk + pkey) * ROPE + pc4 * 8); \
                rv = *(const pg8::u32x4*)(vT + (size_t)(h * VD + kkey) * MTOT + mk + kc8 * 8); } while (0)
#define AT_STORE(buf) do { LDSP unsigned char* kb_ = lds + (buf) * AT_KBUF; LDSP unsigned char* vb_ = lds + 2 * AT_KBUF + (buf) * AT_VBUF; \
                *(LDSP pg8::u32x4*)(kb_ + kkey * AT_KROW + kc8 * 16) = rk; \
                if (tid < 256) *(LDSP pg8::u32x4*)(kb_ + pkey * AT_KROW + 128 + pc4 * 16) = rp; \
                *(LDSP pg8::u32x2*)(vb_ + kkey * AT_VROW + kc8 * 16) = (pg8::u32x2){rv.x, rv.y}; *(LDSP pg8::u32x2*)(vb_ + kkey * AT_VROW + kc8 * 16 + 8) = (pg8::u32x2){rv.z, rv.w}; } while (0)
            AT_LOAD(0); AT_STORE(0);
            __syncthreads();
            for (int t = 0; t < nt; ++t) {
                if (t + 1 < nt) AT_LOAD(t + 1);
                if (64 * t <= q0 + 32 * w + 31) {
                    const LDSP unsigned char* kb_ = lds + (t & 1) * AT_KBUF; const LDSP unsigned char* vb_ = lds + 2 * AT_KBUF + (t & 1) * AT_VBUF;
                    f32x16_t S[2];
#pragma unroll
                    for (int kb = 0; kb < 2; ++kb)
#pragma unroll
                        for (int r = 0; r < 16; ++r) S[kb][r] = 0.f;
#pragma unroll
                    for (int s = 0; s < 6; ++s)
#pragma unroll
                        for (int kb = 0; kb < 2; ++kb) {
                            const bf16x8v a = *(const LDSP bf16x8v*)(kb_ + (32 * kb + l31) * AT_KROW + (16 * s + 8 * h5) * 2);
                            S[kb] = __builtin_amdgcn_mfma_f32_32x32x16_bf16(a, qfr[s], S[kb], 0, 0, 0);
                        }
                    if (64 * t + 63 > q0 + 32 * w) {
#pragma unroll
                        for (int kb = 0; kb < 2; ++kb)
#pragma unroll
                            for (int r = 0; r < 16; ++r) { const int key = 64 * t + 32 * kb + (r & 3) + 8 * (r >> 2) + 4 * h5; if (key > qg) S[kb][r] = -1e30f; }
                    }
                    float mt = -1e30f;
#pragma unroll
                    for (int kb = 0; kb < 2; ++kb)
#pragma unroll
                        for (int r = 0; r < 16; ++r) mt = fmaxf(mt, S[kb][r]);
                    mt = fmaxf(mt, __shfl_xor(mt, 32));
                    const float mnew = fmaxf(mrun, mt), alpha = __builtin_amdgcn_exp2f(mrun - mnew);
                    float ls = 0.f;
#pragma unroll
                    for (int kb = 0; kb < 2; ++kb)
#pragma unroll
                        for (int r = 0; r < 16; ++r) { const float p = __builtin_amdgcn_exp2f(S[kb][r] - mnew); S[kb][r] = p; ls += p; }
                    lrun = lrun * alpha + ls; mrun = mnew;
#pragma unroll
                    for (int db = 0; db < 2; ++db)
#pragma unroll
                        for (int r = 0; r < 16; ++r) O[db][r] *= alpha;
#pragma unroll
                    for (int kb = 0; kb < 2; ++kb)
#pragma unroll
                        for (int s = 0; s < 2; ++s) {
                            pg8::u32x4 pw; pw.x = pk2bf(S[kb][8 * s + 0], S[kb][8 * s + 1]); pw.y = pk2bf(S[kb][8 * s + 2], S[kb][8 * s + 3]); pw.z = pk2bf(S[kb][8 * s + 4], S[kb][8 * s + 5]); pw.w = pk2bf(S[kb][8 * s + 6], S[kb][8 * s + 7]);
                            const bf16x8v pf = __builtin_bit_cast(bf16x8v, pw);
#pragma unroll
                            for (int db = 0; db < 2; ++db) {
                                const LDSP unsigned char* vp = vb_ + (32 * db + l31) * AT_VROW + (32 * kb + 16 * s + 4 * h5) * 2;
                                const pg8::u32x2 v0 = *(const LDSP pg8::u32x2*)vp, v1 = *(const LDSP pg8::u32x2*)(vp + 16);
                                const bf16x8v a = __builtin_bit_cast(bf16x8v, (pg8::u32x4){v0.x, v0.y, v1.x, v1.y});
                                O[db] = __builtin_amdgcn_mfma_f32_32x32x16_bf16(a, pf, O[db], 0, 0, 0);
                            }
                        }
                }
                if (t + 1 < nt) AT_STORE((t + 1) & 1);
                __syncthreads();
            }
#undef AT_LOAD
#undef AT_STORE
            const float inv = 1.0f / (lrun + __shfl_xor(lrun, 32));
            bf16_t* orow = aob + mrow * (MH * VD) + h * VD;
#pragma unroll
            for (int db = 0; db < 2; ++db)
#pragma unroll
                for (int g = 0; g < 4; ++g) { pg8::u32x2 o; o.x = pk2bf(O[db][4 * g] * inv, O[db][4 * g + 1] * inv); o.y = pk2bf(O[db][4 * g + 2] * inv, O[db][4 * g + 3] * inv);
                    *(pg8::u32x2*)(orow + 32 * db + 8 * g + 4 * h5) = o; }
        }
    }
}
constexpr int SD_CROW = 528, SD_WROW = 528, SD_PROW = 272;
constexpr int SD_CIMG = 0, SD_CIMG_SZ = 128 * SD_CROW;
constexpr int SD_WBUF = SD_CIMG + SD_CIMG_SZ, SD_WBUF_SZ = 32 * 1040;
constexpr int SD_XCH = SD_WBUF + 2 * SD_WBUF_SZ, SD_XCH_SZ = 4 * 5 * 64 * 4;
constexpr int SD_PIMG = SD_XCH + 2 * SD_XCH_SZ, SD_PIMG_SZ = 32 * SD_PROW;
constexpr int SD_END = SD_PIMG + 2 * SD_PIMG_SZ;
typedef short s16x4 __attribute__((ext_vector_type(4)));
#define MFMA32(a, b, c) __builtin_amdgcn_mfma_f32_32x32x16_bf16(a, b, c, 0, 0, 0)

__device__ __forceinline__ float mla_b2_bound(const Ctx& c, int j, int lane) {
    using namespace cfg;
    float gq = fabsf(c.in[I_QNN][j * NOPE + lane]), gk = fabsf(c.in[I_KNN][j * NOPE + lane]), gqr = fabsf(c.in[I_QRN][j * ROPE + (lane & 31)]), gkr = fabsf(c.in[I_KRN][j * ROPE + (lane & 31)]);
#pragma unroll
    for (int o = 1; o < 64; o <<= 1) { gq = fmaxf(gq, __shfl_xor(gq, o)); gk = fmaxf(gk, __shfl_xor(gk, o)); gqr = fmaxf(gqr, __shfl_xor(gqr, o)); gkr = fmaxf(gkr, __shfl_xor(gkr, o)); }
    return (64.f * gq * gk + 32.f * gqr * gkr) * (0.10206207261596575f * 1.4426950408889634f);
}

__device__ __forceinline__ void sd_pv_core(const int G, f32x16_t& Og, f32x16_t& Lacc, LDSP unsigned char* lds, int w, int lane, int l31, int h5) {
    asm volatile("" : "+v"(lane)); l31 = lane & 31; h5 = lane >> 5;
    const LDSP unsigned char* pimg = lds + SD_PIMG + (G & 1) * SD_PIMG_SZ;
    const unsigned onesw = (l31 == G) ? 0x3F803F80u : 0u;
    const bf16x8v onesv = __builtin_bit_cast(bf16x8v, (pg8::u32x4){onesw, onesw, onesw, onesw});
#pragma unroll
    for (int sp = 0; sp < 8; ++sp) {
        const bf16x8v a = *(const LDSP bf16x8v*)(pimg + l31 * SD_PROW + (16 * sp + 8 * h5) * 2);
        const int key0 = 16 * sp + 8 * h5 + ((lane & 15) >> 2), col = 32 * w + 16 * ((lane >> 4) & 1) + 4 * (lane & 3);
        const s16x4 t0 = __builtin_amdgcn_ds_read_tr16_b64_v4i16((LDSP s16x4*)(lds + SD_CIMG + key0 * SD_CROW + col * 2));
        const s16x4 t1 = __builtin_amdgcn_ds_read_tr16_b64_v4i16((LDSP s16x4*)(lds + SD_CIMG + (key0 + 4) * SD_CROW + col * 2));
        const bf16x8v b = (bf16x8v){t0[0], t0[1], t0[2], t0[3], t1[0], t1[1], t1[2], t1[3]};
        Og = MFMA32(a, b, Og);
        if (sp == w) Lacc = MFMA32(a, onesv, Lacc);
        if (sp & 1) __builtin_amdgcn_sched_barrier(0);
    }
}

__device__ __forceinline__ void sd_pv(const int G, f32x16_t& Og, f32x16_t& Lacc, LDSP unsigned char* lds, int w, int lane, int l31, int h5) {
    sd_pv_core(G, Og, Lacc, lds, w, lane, l31, h5);
#if defined(PROBE_DUP) && (PROBE_DUP & (1 << 21))
    f32x16_t D0, D1;
#pragma unroll
    for (int r = 0; r < 16; ++r) { D0[r] = 0.f; D1[r] = 0.f; }
    sd_pv_core(G, D0, D1, lds, w, lane, l31, h5); asm volatile("" :: "v"(D0), "v"(D1));
#endif
}
__device__ __forceinline__ void sd_glds16(const void* gsrc, unsigned lds_dst) {
    unsigned keep;
    asm volatile("s_mov_b32 %0, m0\n\ts_mov_b32 m0, %2\n\ts_nop 0\n\tglobal_load_lds_dwordx4 %1, off\n\ts_mov_b32 m0, %0" : "=&s"(keep) : "v"(gsrc), "s"(lds_dst) : "memory");
}
#define SD_WLOAD(h, buf) do { if (w >= 4) { const char* wsrc_ = (const char*)(fm.wukvt + (size_t)(h) * NOPE * KVL); int ln_ = lane; asm volatile("" : "+v"(ln_)); \
        const unsigned ldsb_ = __builtin_amdgcn_readfirstlane((unsigned)(size_t)(lds + SD_WBUF + (buf) * SD_WBUF_SZ)) + (unsigned)(8 * (w - 4)) * 1040u; \
        _Pragma("unroll") for (int k = 0; k < 8; ++k) { \
        const unsigned voff_ = (unsigned)(((8 * (w - 4) + k) + 32 * (ln_ >> 5)) * KVL + (ln_ & 31) * 8) * 2u; \
        sd_glds16(wsrc_ + voff_, ldsb_ + (unsigned)k * 1040u); } } } while (0)
template <int G, bool DOPV = true>
__device__ __forceinline__ void sd_group(const FastMla& fm, const bf16_t* __restrict__ qs, const int s, LDSP unsigned char* lds, const int w, const int lane, const int l31_, const int h5_, const int kb, const int dh, const int rot,
                                         const bf16x8v (&cfr)[16], const bf16x8v (&kpfr)[2], pg8::u32x4 (&wr)[4], f32x16_t (&O)[4], f32x16_t& Lacc, const float B2) {
    using namespace cfg;
        _Pragma("unroll 1") for (int hh = 0; hh < 4; ++hh) {
            const int h = (4 * G + hh + rot) & (MH - 1);
            int lane_ = lane; asm volatile("" : "+v"(lane_)); const int l31 = lane_ & 31, h5 = lane_ >> 5;
            { LDSP unsigned char* wdst = lds + SD_WBUF + ((h + 1) & 1) * SD_WBUF_SZ + (2 * w + h5) * 1040 + l31 * 16;
              *(LDSP pg8::u32x4*)(wdst) = wr[0]; *(LDSP pg8::u32x4*)(wdst + 16640) = wr[1]; *(LDSP pg8::u32x4*)(wdst + 512) = wr[2]; *(LDSP pg8::u32x4*)(wdst + 17152) = wr[3]; }
            const char* qb = (const char*)qs + (size_t)(s * MH + h) * 1536;
            const unsigned zoff = (unsigned)((DB * MH - (s * MH + h)) * 1536);
            const unsigned qlo = l31 < 8 ? (unsigned)(h5 * 128 + l31 * 16) : zoff;
            const bf16x8v qn0 = *(const bf16x8v*)(qb + dh * 512 + qlo), qn1 = *(const bf16x8v*)(qb + dh * 512 + 256 + qlo), qp0 = *(const bf16x8v*)(qb + 1024 + qlo), qp1 = *(const bf16x8v*)(qb + 1280 + qlo);
            { const char* wsrc = (const char*)(fm.wukvt + (size_t)((h + 2) & (MH - 1)) * NOPE * KVL) + (unsigned)(64 * w + lane_) * 16u;
#pragma unroll
              for (int k = 0; k < 4; ++k) wr[k] = *(const pg8::u32x4*)(wsrc + k * 8192); }
            f32x16_t KN;
#pragma unroll
            for (int r = 0; r < 16; ++r) KN[r] = 0.f;
            { const LDSP unsigned char* wb = lds + SD_WBUF + (h & 1) * SD_WBUF_SZ + l31 * 1040 + dh * 512 + h5 * 16;
#pragma unroll
              for (int s_ = 0; s_ < 16; ++s_) { const bf16x8v a = *(const LDSP bf16x8v*)(wb + 32 * s_); KN = MFMA32(a, cfr[s_], KN); if ((s_ & 3) == 3) __builtin_amdgcn_sched_barrier(0); } }
#if defined(PROBE_DUP) && (PROBE_DUP & (1 << 19))
            { const LDSP unsigned char* wb = lds + SD_WBUF + (h & 1) * SD_WBUF_SZ + l31 * 1040 + dh * 512 + h5 * 16;
#pragma unroll
              for (int s_ = 0; s_ < 16; ++s_) { const bf16x8v a = *(const LDSP bf16x8v*)(wb + 32 * s_); KN = MFMA32(a, cfr[s_], KN); if ((s_ & 3) == 3) __builtin_amdgcn_sched_barrier(0); }
#pragma unroll
              for (int r = 0; r < 16; ++r) KN[r] *= 0.5f; }
#endif
#if defined(PROBE_DUP) && (PROBE_DUP & (1 << 23))
            _Pragma("unroll 1") for (int rep_ = 0; rep_ < 2; ++rep_) {
            asm volatile("" : "+v"(KN));
#else
            {
#endif
            float ssq = 0.f;
#pragma unroll
            for (int r = 0; r < 16; ++r) ssq += KN[r] * KN[r];
            ssq += __shfl_xor(ssq, 32);
            {
            f32x16_t S;
#pragma unroll
            for (int r = 0; r < 16; ++r) S[r] = 0.f;
#pragma unroll
            for (int s_ = 0; s_ < 2; ++s_) { const bf16x8v kf = __builtin_bit_cast(bf16x8v, (pg8::u32x4){pk2bf(KN[8 * s_], KN[8 * s_ + 1]), pk2bf(KN[8 * s_ + 2], KN[8 * s_ + 3]), pk2bf(KN[8 * s_ + 4], KN[8 * s_ + 5]), pk2bf(KN[8 * s_ + 6], KN[8 * s_ + 7])});
                S = MFMA32(s_ == 0 ? qn0 : qn1, kf, S); }
            LDSP float* xch = (LDSP float*)(lds + SD_XCH + (h & 1) * SD_XCH_SZ) + kb * 320;
            if (dh == 1) { xch[lane_] = S[0]; xch[64 + lane_] = S[1]; xch[128 + lane_] = S[2]; xch[192 + lane_] = S[3]; xch[256 + lane_] = ssq; }
            asm volatile("s_waitcnt lgkmcnt(0)" ::: "memory");
            __builtin_amdgcn_s_barrier();
            asm volatile("" ::: "memory");
            if (dh == 0) {
                const float rstd = __builtin_amdgcn_rsqf((ssq + xch[256 + lane_]) * (1.0f / NOPE) + NORM_EPS);
                f32x16_t T;
#pragma unroll
                for (int r = 0; r < 16; ++r) T[r] = 0.f;
                T[0] = (S[0] + xch[lane_]) * rstd; T[1] = (S[1] + xch[64 + lane_]) * rstd; T[2] = (S[2] + xch[128 + lane_]) * rstd; T[3] = (S[3] + xch[192 + lane_]) * rstd;
                T = MFMA32(qp0, kpfr[0], T); T = MFMA32(qp1, kpfr[1], T);
                LDSP bf16_t* prow = (LDSP bf16_t*)(lds + SD_PIMG + (G & 1) * SD_PIMG_SZ + (hh * 8 + 4 * h5) * SD_PROW) + 32 * kb + l31;
#pragma unroll
                for (int q = 0; q < 4; ++q) prow[q * (SD_PROW / 2)] = (bf16_t)(pk2bf(exp2f(T[q] - B2), 0.f) & 0xffffu);
            }
            }
            }
        }
        if (G > 0 && DOPV) sd_pv(G > 0 ? G - 1 : 0, O[G > 0 ? G - 1 : 0], Lacc, lds, w, lane, l31_, h5_);
}

__device__ __forceinline__ void mla_sample_decode(const Ctx& c, const FastMla& fm, const bf16_t* __restrict__ qs, float* opart, float* lpart, int j, LDSP unsigned char* lds) {
    using namespace cfg;
    const int tid = (int)tid_now(), tid_ = tid, w = __builtin_amdgcn_readfirstlane(tid >> 6), lane = tid & 63, l31 = lane & 31, h5 = lane >> 5, kb = w & 3, dh = w >> 2;
    const float* ckv = c.in[I_CKV] + (size_t)j * NPOOL * PAGE * KVL; const float* kpe = c.in[I_KPE] + (size_t)j * NPOOL * PAGE * ROPE;
    const float B2 = __builtin_bit_cast(float, __builtin_amdgcn_readfirstlane(__builtin_bit_cast(int, mla_b2_bound(c, j, lane))));
    for (int it = blockIdx.x; it < DB * 2; it += gridDim.x) {
        const int s = it >> 1, hf = it & 1, rot = 2 * ((blockIdx.x >> 3) & 7);
        f32x16_t O[4], Lacc;
#pragma unroll
        for (int r = 0; r < 16; ++r) { O[0][r] = 0.f; O[1][r] = 0.f; O[2][r] = 0.f; O[3][r] = 0.f; Lacc[r] = 0.f; }
        pg8::u32x4 wr[4];
        __syncthreads();
        {
            int t_ = tid_; asm volatile("" : "+v"(t_));
            const char* wsrc = (const char*)(fm.wukvt + (size_t)rot * NOPE * KVL); const unsigned vo = (unsigned)t_ * 16u; LDSP unsigned char* wdst = lds + SD_WBUF + (t_ >> 5) * 1040 + (t_ & 31) * 16;
            pg8::u32x4 t0 = *(const pg8::u32x4*)(wsrc + vo), t1 = *(const pg8::u32x4*)(wsrc + 8192 + vo), t2 = *(const pg8::u32x4*)(wsrc + 16384 + vo), t3 = *(const pg8::u32x4*)(wsrc + 24576 + vo);
            *(LDSP pg8::u32x4*)(wdst) = t0; *(LDSP pg8::u32x4*)(wdst + 16640) = t1; *(LDSP pg8::u32x4*)(wdst + 512) = t2; *(LDSP pg8::u32x4*)(wdst + 17152) = t3;
#pragma unroll
            for (int k = 0; k < 4; ++k) wr[k] = *(const pg8::u32x4*)(wsrc + NOPE * KVL * 2 + k * 8192 + vo);
        }
        for (int pi = 0; pi < NPAGES / 2; ++pi) {
            const int pg = __builtin_amdgcn_readfirstlane(c.page_table[s * NPAGES + hf * (NPAGES / 2) + pi]);
            __syncthreads();
            { const char* src = (const char*)(ckv + (size_t)pg * PAGE * KVL); int tid = tid_; asm volatile("" : "+v"(tid));
              pg8::f32x4 v[16];
#pragma unroll
              for (int k = 0; k < 16; ++k) v[k] = __builtin_nontemporal_load((const pg8::f32x4*)(src + (size_t)k * 8192 + (unsigned)tid * 16u));
#pragma unroll
              for (int k = 0; k < 16; ++k) { pg8::u32x2 o; o.x = pk2bf(v[k][0], v[k][1]); o.y = pk2bf(v[k][2], v[k][3]);
                  *(LDSP pg8::u32x2*)(lds + SD_CIMG + ((tid >> 6) + 8 * k) * SD_CROW + (tid & 63) * 8) = o; } }
#if defined(PROBE_DUP) && (PROBE_DUP & (1 << 20))
            { const char* src = (const char*)(ckv + (size_t)pg * PAGE * KVL); int tid = tid_; asm volatile("" : "+v"(tid));
              pg8::f32x4 v[16];
#pragma unroll
              for (int k = 0; k < 16; ++k) v[k] = *(const pg8::f32x4*)(src + (size_t)k * 8192 + (unsigned)tid * 16u);
#pragma unroll
              for (int k = 0; k < 16; ++k) { pg8::u32x2 o; o.x = pk2bf(v[k][0], v[k][1]); o.y = pk2bf(v[k][2], v[k][3]);
                  *(LDSP pg8::u32x2*)(lds + SD_CIMG + ((tid >> 6) + 8 * k) * SD_CROW + (tid & 63) * 8) = o; } }
#endif
            bf16x8v kpfr[2];
            if (dh == 0) {
#pragma unroll
                for (int s_ = 0; s_ < 2; ++s_) { const float* kp = kpe + ((size_t)pg * PAGE + 32 * kb + l31) * ROPE + 16 * s_ + 8 * h5; const pg8::f32x4 a = *(const pg8::f32x4*)kp, b = *(const pg8::f32x4*)(kp + 4);
                    kpfr[s_] = __builtin_bit_cast(bf16x8v, (pg8::u32x4){pk2bf(a[0], a[1]), pk2bf(a[2], a[3]), pk2bf(b[0], b[1]), pk2bf(b[2], b[3])}); }
            }
            asm volatile("s_waitcnt vmcnt(0)" ::: "memory");
            __syncthreads();
            bf16x8v cfr[16];
#pragma unroll
            for (int s_ = 0; s_ < 16; ++s_) cfr[s_] = *(const LDSP bf16x8v*)(lds + SD_CIMG + (32 * kb + l31) * SD_CROW + (16 * s_ + 8 * h5) * 2);
            sd_group<0>(fm, qs, s, lds, w, lane, l31, h5, kb, dh, rot, cfr, kpfr, wr, O, Lacc, B2);
            sd_group<1>(fm, qs, s, lds, w, lane, l31, h5, kb, dh, rot, cfr, kpfr, wr, O, Lacc, B2);
            sd_group<2>(fm, qs, s, lds, w, lane, l31, h5, kb, dh, rot, cfr, kpfr, wr, O, Lacc, B2);
            sd_group<3>(fm, qs, s, lds, w, lane, l31, h5, kb, dh, rot, cfr, kpfr, wr, O, Lacc, B2);
#if defined(PROBE_DUP) && (PROBE_DUP & (1 << 29))
            __syncthreads();
            sd_group<0, false>(fm, qs, s, lds, w, lane, l31, h5, kb, dh, rot, cfr, kpfr, wr, O, Lacc, B2);
            sd_group<1, false>(fm, qs, s, lds, w, lane, l31, h5, kb, dh, rot, cfr, kpfr, wr, O, Lacc, B2);
            sd_group<2, false>(fm, qs, s, lds, w, lane, l31, h5, kb, dh, rot, cfr, kpfr, wr, O, Lacc, B2);
            sd_group<3, false>(fm, qs, s, lds, w, lane, l31, h5, kb, dh, rot, cfr, kpfr, wr, O, Lacc, B2);
#endif
            __syncthreads();
            sd_pv(3, O[3], Lacc, lds, w, lane, l31, h5);
        }
        {float* op = opart + (size_t)it * (MH * DS) * KVL; int lo_ = lane; asm volatile("" : "+v"(lo_)); const int l31 = lo_ & 31, h5 = lo_ >> 5;
#pragma unroll
        for (int g = 0; g < 4; ++g)
#pragma unroll
            for (int r = 0; r < 16; ++r) op[(size_t)((((4 * g + (r >> 2) + rot) & (MH - 1)) << 3) + (r & 3) + 4 * h5) * KVL + 32 * w + l31] = O[g][r];
        __syncthreads();
        LDSP float* ltab = (LDSP float*)(lds + SD_XCH);
        if (l31 < 4) {
#pragma unroll
            for (int r = 0; r < 16; ++r) ltab[w * 128 + l31 * 32 + (r & 3) + 8 * (r >> 2) + 4 * h5] = Lacc[r];
        }
        __syncthreads();
        { const int t2 = (int)tid_now();
        if (t2 < 128) { float a = 0.f;
#pragma unroll
            for (int ww = 0; ww < 8; ++ww) a += ltab[ww * 128 + t2];
            lpart[(size_t)it * 128 + ((((t2 >> 3) + rot) & (MH - 1)) << 3) + (t2 & 7)] = a; } }
        }
    }
}

__device__ __forceinline__ void mla_sample_combine(const Ctx& c, const FastMla& fm, const float* __restrict__ opart, const float* __restrict__ lpart, int j, LDSP unsigned char* lds) {
    using namespace cfg;
    const int tid = (int)tid_now(), w = tid >> 6, lane = tid & 63, gw = blockIdx.x * 8 + w, ngw = gridDim.x * 8;
    const float B2 = mla_b2_bound(c, j, lane);
    LDSP float* ol = (LDSP float*)(lds + w * 8704); LDSP float* ptab = ol + 8 * KVL; LDSP float* lt = ptab + 64;
    const float* wuv = c.in[I_WUV] + (size_t)j * KVL * MH * VD;
    for (int item = gw; item < DB * MH; item += ngw) {
        const int s = item / MH, h = item % MH, q = lane >> 3, jn = lane & 7;
        const size_t rq = (size_t)MP + s * DS + q, rk = (size_t)MP + s * DS + jn;
        const bf16_t* qv = fm.qf + rq * (MH * QD) + h * QD; const bf16_t* kn = fm.knb + rk * (MH * NOPE) + h * NOPE; const bf16_t* kp = fm.kpb + rk * ROPE;
        float sc = 0.f;
#pragma unroll
        for (int d8 = 0; d8 < QD / 8; ++d8) { const pg8::u32x4 a = *(const pg8::u32x4*)(qv + 8 * d8), b = d8 < NOPE / 8 ? *(const pg8::u32x4*)(kn + 8 * d8) : *(const pg8::u32x4*)(kp + 8 * (d8 - NOPE / 8));
            const unsigned aw[4] = {a.x, a.y, a.z, a.w}, bw[4] = {b.x, b.y, b.z, b.w};
#pragma unroll
            for (int e = 0; e < 4; ++e) sc += __uint_as_float(aw[e] << 16) * __uint_as_float(bw[e] << 16) + __uint_as_float(aw[e] & 0xffff0000u) * __uint_as_float(bw[e] & 0xffff0000u); }
        const float p = jn <= q ? exp2f(sc - B2) : 0.f;
        float ls = p; ls += __shfl_xor(ls, 1); ls += __shfl_xor(ls, 2); ls += __shfl_xor(ls, 4);
        ptab[lane] = p;
        if (jn == 0) lt[q] = ls + lpart[(size_t)(2 * s) * 128 + h * DS + q] + lpart[(size_t)(2 * s + 1) * 128 + h * DS + q];
        asm volatile("s_waitcnt lgkmcnt(0)" ::: "memory");
        float cn[DS][4];
#pragma unroll
        for (int jj = 0; jj < DS; ++jj)
#pragma unroll
            for (int k = 0; k < 4; ++k) cn[jj][k] = bf2f(fm.cb[((size_t)MP + s * DS + jj) * KVL + lane + 64 * k]);
#pragma unroll
        for (int qq = 0; qq < DS; ++qq)
#pragma unroll
            for (int k = 0; k < 4; ++k) { const int r = lane + 64 * k;
                float a = opart[((size_t)(2 * s) * 128 + h * DS + qq) * KVL + r] + opart[((size_t)(2 * s + 1) * 128 + h * DS + qq) * KVL + r];
#pragma unroll
                for (int jj = 0; jj < DS; ++jj) a += ptab[qq * 8 + jj] * cn[jj][k];
                ol[qq * KVL + r] = a; }
        asm volatile("s_waitcnt lgkmcnt(0)" ::: "memory");
        float acc[DS];
#pragma unroll
        for (int qq = 0; qq < DS; ++qq) acc[qq] = 0.f;
        for (int r = 0; r < KVL; ++r) { const float wv = wuv[((size_t)r * MH + h) * VD + lane];
#pragma unroll
            for (int qq = 0; qq < DS; ++qq) acc[qq] += ol[qq * KVL + r] * wv; }
#pragma unroll
        for (int qq = 0; qq < DS; ++qq) fm.aob[((size_t)MP + s * DS + qq) * (MH * VD) + h * VD + lane] = (bf16_t)(pk2bf(acc[qq] / lt[qq], 0.f) & 0xffffu);
        asm volatile("s_waitcnt lgkmcnt(0)" ::: "memory");
    }
}

struct FastRw {
    bf16_t* xm;
    bf16_t* rkv;
    bf16_t* hb;
    bf16_t* lu;
    float* vf;
    float* ops;
    bf16_t* yo;
    bf16_t *wrkvt, *lorat, *wot;
};
constexpr int RW_REC = 464;
constexpr int RW_CH = 32;
constexpr int RW_BUF = RW_CH * RW_REC * 4;
struct RwSel { __device__ static __forceinline__ int sel(int pn) { return pn < 12 ? (pn >> 2) : (pn == 15 ? 2 : pn - 9); } };

__device__ __forceinline__ void rw_mix_fast(const Ctx& c, const FastRw& fr, int l, int gw, int ngw, int lane) {
    using namespace cfg; const int j = l / 3;
    const float* gain = c.in[I_NMIX] + l * D;
    for (int m = gw; m < MTOT; m += ngw) {
        const int t = row_t(m), sq = row_seq(m);
        pg8::f32x4 xc[4], xp[4], gv[4]; float s = 0.f, sp = 0.f;
#pragma unroll
        for (int q = 0; q < 4; ++q) { gv[q] = *(const pg8::f32x4*)(gain + 4 * lane + 256 * q); xc[q] = *(const pg8::f32x4*)(c.x + (size_t)m * D + 4 * lane + 256 * q);
            s += (xc[q][0] * xc[q][0] + xc[q][1] * xc[q][1]) + (xc[q][2] * xc[q][2] + xc[q][3] * xc[q][3]); }
        if (t > 0) {
#pragma unroll
            for (int q = 0; q < 4; ++q) { xp[q] = *(const pg8::f32x4*)(c.x + (size_t)(m - 1) * D + 4 * lane + 256 * q); sp += (xp[q][0] * xp[q][0] + xp[q][1] * xp[q][1]) + (xp[q][2] * xp[q][2] + xp[q][3] * xp[q][3]); }
        }
        const float rs = 1.0f / sqrtf(wave_sum64(s) * (1.0f / D) + NORM_EPS), rsp = 1.0f / sqrtf(wave_sum64(sp) * (1.0f / D) + NORM_EPS);
#pragma unroll
        for (int q = 0; q < 4; ++q) {
#pragma unroll
            for (int e = 0; e < 4; ++e) xc[q][e] = xc[q][e] * rs * gv[q][e];
            if (t > 0) {
#pragma unroll
                for (int e = 0; e < 4; ++e) xp[q][e] = xp[q][e] * rsp * gv[q][e];
            } else if (sq < BATCH) xp[q] = (pg8::f32x4){0.f, 0.f, 0.f, 0.f};
            else xp[q] = *(const pg8::f32x4*)(c.in[I_SHIFT] + ((size_t)j * DB + (sq - BATCH)) * D + 4 * lane + 256 * q);
        }
        if (t == seq_len(sq) - 1) {
            float* so = sq < BATCH ? c.out + O_SHP + ((size_t)j * BATCH + sq) * D : c.out + O_SHS + ((size_t)j * DB + (sq - BATCH)) * D;
#pragma unroll
            for (int q = 0; q < 4; ++q) *(pg8::f32x4*)(so + 4 * lane + 256 * q) = xc[q];
        }
#pragma unroll
        for (int p = 0; p < 6; ++p)
#pragma unroll
            for (int q = 0; q < 4; ++q) { const pg8::f32x4 mu = *(const pg8::f32x4*)(c.in[I_MU] + ((size_t)j * 6 + p) * D + 4 * lane + 256 * q);
                pg8::u32x2 o; o.x = pk2bf(xc[q][0] + (xp[q][0] - xc[q][0]) * mu[0], xc[q][1] + (xp[q][1] - xc[q][1]) * mu[1]); o.y = pk2bf(xc[q][2] + (xp[q][2] - xc[q][2]) * mu[2], xc[q][3] + (xp[q][3] - xc[q][3]) * mu[3]);
                *(pg8::u32x2*)(fr.xm + ((size_t)p * MTOT + m) * D + 4 * lane + 256 * q) = o; }
        if (lane < 32) *(unsigned*)(fr.hb + (size_t)m * 384 + 320 + 2 * lane) = 0u;
    }
}
struct EpiRwkv {
    static constexpr bool PERM = true;
    bf16_t* rkv; bf16_t* hb;
    __device__ __forceinline__ void operator()(const pg8::f32x4 (&acc)[2][2][4][2], const pg8::Unit& u, int wr, int wc, int fr, int fq) const {
        using namespace pg8;
        const int row0 = u.pm * BM + wr * 64 + fr, cl0 = wc * 32 + 8 * fq;
        const int pn = u.pn;
        bf16_t* base; int ldc, coff, nvalid, act = 0;
        if (pn < 12) { base = rkv; ldc = 3072; coff = pn * 256; nvalid = 256; }
        else { base = hb; ldc = 384; if (pn == 12) { coff = 0; nvalid = 64; act = 1; } else if (pn == 13) { coff = 64; nvalid = 64; } else if (pn == 14) { coff = 128; nvalid = 160; act = 2; } else { coff = 288; nvalid = 32; } }
#pragma unroll
        for (int ai = 0; ai < 2; ++ai)
#pragma unroll
            for (int m = 0; m < 4; ++m) { bf16_t* rowp = base + (size_t)(row0 + ai * HALF + m * 16) * ldc + coff;
#pragma unroll
                for (int bj = 0; bj < 2; ++bj) { const int cl = cl0 + bj * HALF; if (cl >= nvalid) continue;
                    f32x4 v0 = acc[ai][bj][m][0], v1 = acc[ai][bj][m][1];
                    if (act == 1) {
#pragma unroll
                        for (int e = 0; e < 4; ++e) { v0[e] = tanhf(v0[e]); v1[e] = tanhf(v1[e]); } }
                    else if (act == 2) {
#pragma unroll
                        for (int e = 0; e < 4; ++e) { v0[e] = 1.0f / (1.0f + __expf(-v0[e])); v1[e] = 1.0f / (1.0f + __expf(-v1[e])); } }
                    u32x4 w; w.x = cvt_pk_bf16(v0[0], v0[1]); w.y = cvt_pk_bf16(v0[2], v0[3]); w.z = cvt_pk_bf16(v1[0], v1[1]); w.w = cvt_pk_bf16(v1[2], v1[3]);
                    *(u32x4*)(rowp + cl) = w; } }
    }
};
__device__ __forceinline__ void rw_build_lorat(const Ctx& c, bf16_t* lorat, int j, size_t gtid, size_t gsz) {
    using namespace cfg;
    for (size_t i = gtid; i < (size_t)4096 * 384; i += gsz) {
        const int n = (int)(i / 384), k = (int)(i % 384), grp = n >> 10, ch = n & 1023; float v = 0.f;
        if (grp == 0 && k < 64) v = c.in[I_W2][((size_t)j * RW_DL + k) * D + ch];
        else if (grp == 1 && k >= 64 && k < 128) v = c.in[I_A2][((size_t)j * RW_AL + (k - 64)) * D + ch];
        else if (grp == 2 && k >= 128 && k < 288) v = c.in[I_G2][((size_t)j * RW_GL + (k - 128)) * D + ch];
        else if (grp == 3 && k >= 288 && k < 320 && j > 0) v = c.in[I_V2][((size_t)(j - 1) * RW_VL + (k - 288)) * D + ch];
        lorat[i] = (bf16_t)(pk2bf(v, 0.f) & 0xffffu);
    }
}
__device__ __forceinline__ size_t rw_rec_base(int sq, int h) {
    using namespace cfg;
    return sq < BATCH ? ((size_t)sq * RHEADS + h) * SEQ : (size_t)MP * RHEADS + ((size_t)(sq - BATCH) * RHEADS + h) * DS;
}
__device__ __forceinline__ void rw_prep_fast(const Ctx& c, const FastRw& fr, int l, int gw, int ngw, int lane) {
    using namespace cfg; const int j = l / 3;
    for (int it = gw; it < MTOT * RHEADS; it += ngw) {
        const int m = it / RHEADS, h = it % RHEADS, ch = h * RH + lane;
        const bf16_t* rk = fr.rkv + (size_t)m * 3072 + ch; const bf16_t* lu = fr.lu + (size_t)m * 4096 + ch;
        const float r = bf2f(rk[0]), k0 = bf2f(rk[1024]); float v = bf2f(rk[2048]);
        const float wpre = bf2f(lu[0]), apre = bf2f(lu[1024]), gg = bf2f(lu[2048]), vpre = bf2f(lu[3072]);
        const float wl = -softplusf_(-(c.in[I_W0][j * D + ch] + wpre)) - 0.5f;
        const float w = expf(-expf(wl));
        if (j == 0) fr.vf[(size_t)m * D + ch] = v;
        else v = v + (fr.vf[(size_t)m * D + ch] - v) * sigmoidf_(c.in[I_V0][(j - 1) * D + ch] + vpre);
        const float a = sigmoidf_(c.in[I_A0][j * D + ch] + apre);
        float kk = k0 * c.in[I_KK][j * D + ch];
        const float nn = wave_sum64(kk * kk);
        kk *= 1.0f / fmaxf(sqrtf(nn), 1e-12f);
        const float k2 = k0 * (1.0f + (a - 1.0f) * c.in[I_KA][j * D + ch]);
        const float bo = kk * a;
        const float br = wave_sum64(bo * r), kr = wave_sum64(k2 * r), bonus = wave_sum64(r * k2 * c.in[I_RK][(size_t)j * D + ch]);
        const int sq = row_seq(m), t = row_t(m);
        float* rec = fr.ops + (rw_rec_base(sq, h) + t) * RW_REC;
        rec[lane] = -kk; rec[64 + lane] = w * r; rec[128 + lane] = w; rec[192 + lane] = bo; rec[256 + lane] = k2; rec[320 + lane] = v; rec[384 + lane] = gg;
        if (lane == 0) { rec[448] = br; rec[449] = kr; rec[450] = bonus; }
    }
}
template <int CTRL> __device__ __forceinline__ float dppf(float v) { return __int_as_float(__builtin_amdgcn_update_dpp(0, __float_as_int(v), CTRL, 0xF, 0xF, true)); }
__device__ __forceinline__ float red16(float x) { x += dppf<0xB1>(x); x += dppf<0x4E>(x); x += dppf<0x124>(x); x += dppf<0x128>(x); return x; }
__device__ __forceinline__ void rw_scan_fast(const Ctx& c, const FastRw& fr, int l, LDSP unsigned char* lds) {
    using namespace cfg; const int j = l / 3;
    const int tid = (int)tid_now(), w = __builtin_amdgcn_readfirstlane(tid >> 6), lane = tid & 63, cs = lane & 15, rp = 4 * w + (lane >> 4);
    LDSP float* ybuf = (LDSP float*)(lds + 2 * RW_BUF);
    for (int chain = blockIdx.x; chain < NSEQ * RHEADS; chain += gridDim.x) {
        const int sq = chain / RHEADS, h = chain % RHEADS, T = seq_len(sq), m0 = seq_row0(sq);
        const char* src = (const char*)(fr.ops + rw_rec_base(sq, h) * RW_REC);
        pg8::f32x4 S0, S1;
        if (sq < BATCH) { S0 = (pg8::f32x4){0.f, 0.f, 0.f, 0.f}; S1 = S0; }
        else { const float* s0 = c.in[I_WKV] + ((((size_t)j * DB + (sq - BATCH)) * RHEADS + h) * RH + 2 * rp) * RH + 4 * cs; S0 = *(const pg8::f32x4*)s0; S1 = *(const pg8::f32x4*)(s0 + RH); }
        const int nch = (T + RW_CH - 1) / RW_CH;
#define RW_DMA(n, buf) do { const int nb_ = ((T - (n) * RW_CH < RW_CH ? T - (n) * RW_CH : RW_CH) * RW_REC * 4 + 1023) >> 10; \
            for (int q_ = w; q_ < nb_; q_ += 8) __builtin_amdgcn_global_load_lds((const unsigned*)(src + (size_t)(n) * RW_BUF + (size_t)q_ * 1024 + (unsigned)lane * 16u), (LDSP unsigned*)(lds + (buf) * RW_BUF + q_ * 1024), 16, 0, 0); } while (0)
        __syncthreads();
        RW_DMA(0, 0);
        asm volatile("s_waitcnt vmcnt(0)" ::: "memory");
        __syncthreads();
        for (int n = 0; n < nch; ++n) {
            if (n + 1 < nch) RW_DMA(n + 1, (n + 1) & 1);
            const int tn = T - n * RW_CH < RW_CH ? T - n * RW_CH : RW_CH;
            const LDSP unsigned char* bufp = lds + (n & 1) * RW_BUF;
            for (int t = 0; t < tn; ++t) {
                const LDSP unsigned char* rec = bufp + t * (RW_REC * 4);
                const pg8::f32x4 A = *(const LDSP pg8::f32x4*)(rec + cs * 16), WR = *(const LDSP pg8::f32x4*)(rec + 256 + cs * 16), W = *(const LDSP pg8::f32x4*)(rec + 512 + cs * 16),
                                 B = *(const LDSP pg8::f32x4*)(rec + 768 + cs * 16), K = *(const LDSP pg8::f32x4*)(rec + 1024 + cs * 16);
                const pg8::f32x2 V2 = *(const LDSP pg8::f32x2*)(rec + 1280 + rp * 8), SC = *(const LDSP pg8::f32x2*)(rec + 1792);
                float sa0 = (S0[0] * A[0] + S0[1] * A[1]) + (S0[2] * A[2] + S0[3] * A[3]), y0 = (S0[0] * WR[0] + S0[1] * WR[1]) + (S0[2] * WR[2] + S0[3] * WR[3]);
                float sa1 = (S1[0] * A[0] + S1[1] * A[1]) + (S1[2] * A[2] + S1[3] * A[3]), y1 = (S1[0] * WR[0] + S1[1] * WR[1]) + (S1[2] * WR[2] + S1[3] * WR[3]);
                sa0 = red16(sa0); sa1 = red16(sa1); y0 = red16(y0); y1 = red16(y1);
                S0 = S0 * W + sa0 * B + V2[0] * K; S1 = S1 * W + sa1 * B + V2[1] * K;
                if (cs == 0) *(LDSP pg8::f32x2*)(ybuf + t * RH + 2 * rp) = (pg8::f32x2){y0 + sa0 * SC[0] + V2[0] * SC[1], y1 + sa1 * SC[0] + V2[1] * SC[1]};
            }
            asm volatile("s_waitcnt vmcnt(0)" ::: "memory");
            __syncthreads();
            for (int t = w; t < tn; t += 8) {
                const LDSP float* rec = (const LDSP float*)(bufp + t * (RW_REC * 4));
                const float y = ybuf[t * RH + lane], mean = wave_sum64(y) * (1.0f / RH), d = y - mean, var = wave_sum64(d * d) * (1.0f / RH);
                const int ch = h * RH + lane;
                const float yn = d * (1.0f / sqrtf(var + LNX_EPS)) * c.in[I_LNW][j * D + ch] + c.in[I_LNB][j * D + ch];
                const float o = (yn + rec[450] * rec[320 + lane]) * rec[384 + lane];
                fr.yo[(size_t)(m0 + n * RW_CH + t) * D + ch] = (bf16_t)(pk2bf(o, 0.f) & 0xffffu);
            }
            __syncthreads();
        }
#undef RW_DMA
        float* so = (sq < BATCH ? c.out + O_WKVP + (((size_t)j * BATCH + sq) * RHEADS + h) * RH * RH : c.out + O_WKVS + (((size_t)j * DB + (sq - BATCH)) * RHEADS + h) * RH * RH) + (size_t)(2 * rp) * RH + 4 * cs;
        *(pg8::f32x4*)so = S0; *(pg8::f32x4*)(so + RH) = S1;
    }
}
__device__ __forceinline__ float fsigmoid(float x) { return __builtin_amdgcn_rcpf(1.0f + __expf(-x)); }
__device__ __forceinline__ float fsoftplus(float x) { return x > 20.f ? x : __logf(1.0f + __expf(x)); }
__device__ __forceinline__ float rdl(float v, int l) { return __int_as_float(__builtin_amdgcn_readlane(__float_as_int(v), l)); }
__device__ __forceinline__ float wsum_dpp(float x) {
    x = red16(x);
    return (rdl(x, 0) + rdl(x, 16)) + (rdl(x, 32) + rdl(x, 48));
}

struct RwOp { pg8::f32x4 A, WR, W, B, K; pg8::f32x2 V2, SC; };
__device__ __forceinline__ void rw_ldop(RwOp& o, const LDSP unsigned char* rec, int cs, int rp) {
    o.A = *(const LDSP pg8::f32x4*)(rec + cs * 16); o.WR = *(const LDSP pg8::f32x4*)(rec + 256 + cs * 16); o.W = *(const LDSP pg8::f32x4*)(rec + 512 + cs * 16);
    o.B = *(const LDSP pg8::f32x4*)(rec + 768 + cs * 16); o.K = *(const LDSP pg8::f32x4*)(rec + 1024 + cs * 16);
    o.V2 = *(const LDSP pg8::f32x2*)(rec + 1280 + rp * 8); o.SC = *(const LDSP pg8::f32x2*)(rec + 1792);
}
__device__ __forceinline__ float fma_s(float a, float b, float c) { float d; asm("v_fma_f32 %0, %1, %2, %3" : "=v"(d) : "v"(a), "v"(b), "v"(c)); return d; }
__device__ __forceinline__ float mul_s(float a, float b) { float d; asm("v_mul_f32 %0, %1, %2" : "=v"(d) : "v"(a), "v"(b)); return d; }
__device__ __forceinline__ void rw_step(pg8::f32x4& S0, pg8::f32x4& S1, const RwOp& o, LDSP float* yrow, bool wr) {
    float sa0 = fma_s(S0[3], o.A[3], fma_s(S0[2], o.A[2], fma_s(S0[1], o.A[1], mul_s(S0[0], o.A[0]))));
    float sa1 = fma_s(S1[3], o.A[3], fma_s(S1[2], o.A[2], fma_s(S1[1], o.A[1], mul_s(S1[0], o.A[0]))));
    float y0 = fma_s(S0[3], o.WR[3], fma_s(S0[2], o.WR[2], fma_s(S0[1], o.WR[1], mul_s(S0[0], o.WR[0]))));
    float y1 = fma_s(S1[3], o.WR[3], fma_s(S1[2], o.WR[2], fma_s(S1[1], o.WR[1], mul_s(S1[0], o.WR[0]))));
    float t0[4], t1[4];
#pragma unroll
    for (int e = 0; e < 4; ++e) { t0[e] = fma_s(o.K[e], o.V2[0], mul_s(S0[e], o.W[e])); t1[e] = fma_s(o.K[e], o.V2[1], mul_s(S1[e], o.W[e])); }
    red16x4(sa0, sa1, y0, y1);
#pragma unroll
    for (int e = 0; e < 4; ++e) { S0[e] = fma_s(o.B[e], sa0, t0[e]); S1[e] = fma_s(o.B[e], sa1, t1[e]); }
    if (wr) *(LDSP pg8::f32x2*)yrow = (pg8::f32x2){fma_s(o.V2[0], o.SC[1], fma_s(sa0, o.SC[0], y0)), fma_s(o.V2[1], o.SC[1], fma_s(sa1, o.SC[0], y1))};
}
struct RwIn { unsigned short r, k, v, wp, ap, g, vp; float vf; };
template <int J>
__device__ __forceinline__ void rw_scan_fused(const Ctx& c, const FastRw& fr, LDSP unsigned char* lds) {
    using namespace cfg; constexpr int j = J;
    const int tid = (int)tid_now(), w = __builtin_amdgcn_readfirstlane(tid >> 6), lane = tid & 63, cs = lane & 15, rp = 4 * w + (lane >> 4);
    LDSP float* ybuf = (LDSP float*)(lds + 2 * RW_BUF);
    for (int chain = blockIdx.x; chain < NSEQ * RHEADS; chain += gridDim.x) {
        const int sq = chain / RHEADS, h = chain % RHEADS, T = seq_len(sq), m0 = seq_row0(sq), ch = h * RH + lane;
        const float p_w0 = c.in[I_W0][j * D + ch], p_a0 = c.in[I_A0][j * D + ch], p_kk = c.in[I_KK][j * D + ch], p_ka = c.in[I_KA][j * D + ch], p_rk = c.in[I_RK][(size_t)j * D + ch],
                    p_lnw = c.in[I_LNW][j * D + ch], p_lnb = c.in[I_LNB][j * D + ch], p_v0 = j > 0 ? c.in[I_V0][(j - 1) * D + ch] : 0.f;
        pg8::f32x4 S0, S1;
        if (sq < BATCH) { S0 = (pg8::f32x4){0.f, 0.f, 0.f, 0.f}; S1 = S0; }
        else { const float* s0 = c.in[I_WKV] + ((((size_t)j * DB + (sq - BATCH)) * RHEADS + h) * RH + 2 * rp) * RH + 4 * cs; S0 = *(const pg8::f32x4*)s0; S1 = *(const pg8::f32x4*)(s0 + RH); }
        const int nch = (T + RW_CH - 1) / RW_CH;
        RwIn in[4];
#define RW_LOADIN(n) do { _Pragma("unroll") for (int q = 0; q < 4; ++q) { const int t_ = (n) * RW_CH + 4 * w + q; if (t_ < T) { const size_t m_ = (size_t)(m0 + t_); \
                const bf16_t* rk_ = fr.rkv + m_ * 3072 + ch; const bf16_t* lu_ = fr.lu + m_ * 4096 + ch; \
                in[q].r = rk_[0]; in[q].k = rk_[1024]; in[q].v = rk_[2048]; in[q].wp = lu_[0]; in[q].ap = lu_[1024]; in[q].g = lu_[2048]; in[q].vp = lu_[3072]; \
                in[q].vf = j > 0 ? fr.vf[m_ * D + ch] : 0.f; } } } while (0)
#define RW_PREP(n, buf) do { _Pragma("unroll") for (int q = 0; q < 4; ++q) { const int tl_ = 4 * w + q, t_ = (n) * RW_CH + tl_; if (t_ < T) { \
                const float r_ = bf2f(in[q].r), k0_ = bf2f(in[q].k); float v_ = bf2f(in[q].v); \
                const float wl_ = -fsoftplus(-(p_w0 + bf2f(in[q].wp))) - 0.5f, w_ = __expf(-__expf(wl_)); \
                if (j == 0) fr.vf[(size_t)(m0 + t_) * D + ch] = v_; else v_ = v_ + (in[q].vf - v_) * fsigmoid(p_v0 + bf2f(in[q].vp)); \
                const float a_ = fsigmoid(p_a0 + bf2f(in[q].ap)); float kk_ = k0_ * p_kk; \
                const float k2_ = k0_ * (1.0f + (a_ - 1.0f) * p_ka); \
                float n_ = red16(kk_ * kk_), e1_ = red16(r_ * k2_ * p_rk), e2_ = red16(k2_ * r_); \
                n_ = (rdl(n_, 0) + rdl(n_, 16)) + (rdl(n_, 32) + rdl(n_, 48)); e1_ = (rdl(e1_, 0) + rdl(e1_, 16)) + (rdl(e1_, 32) + rdl(e1_, 48)); e2_ = (rdl(e2_, 0) + rdl(e2_, 16)) + (rdl(e2_, 32) + rdl(e2_, 48)); \
                kk_ *= __builtin_amdgcn_rcpf(fmaxf(__builtin_amdgcn_sqrtf(n_), 1e-12f)); const float bo_ = kk_ * a_; const float e3_ = wsum_dpp(bo_ * r_); \
                LDSP float* rec_ = (LDSP float*)(lds + (buf) * RW_BUF + tl_ * (RW_REC * 4)); \
                rec_[lane] = -kk_; rec_[64 + lane] = w_ * r_; rec_[128 + lane] = w_; rec_[192 + lane] = bo_; rec_[256 + lane] = k2_; rec_[320 + lane] = v_; rec_[384 + lane] = bf2f(in[q].g); \
                if (lane == 0) { rec_[448] = e3_; rec_[449] = e2_; rec_[450] = e1_; } } } } while (0)
        __syncthreads();
        RW_LOADIN(0); RW_PREP(0, 0);
        __syncthreads();
        for (int n = 0; n < nch; ++n) {
            if (n + 1 < nch) RW_LOADIN(n + 1);
            const int tn = T - n * RW_CH < RW_CH ? T - n * RW_CH : RW_CH;
            const LDSP unsigned char* bufp = lds + (n & 1) * RW_BUF;
#if defined(PROBE_DUP) && (PROBE_DUP & (1 << 17))
            { RwOp o0, o1; rw_ldop(o0, bufp, cs, rp); pg8::f32x4 T0 = S0, T1 = S1;
              for (int t = 0; t < tn; t += 2) {
                  rw_ldop(o1, bufp + (t + 1) * (RW_REC * 4), cs, rp);
                  rw_step(T0, T1, o0, ybuf + t * RH + 2 * rp, cs == 0);
                  rw_ldop(o0, bufp + (t + 2 < tn ? t + 2 : t) * (RW_REC * 4), cs, rp);
                  rw_step(T0, T1, o1, ybuf + (t + 1) * RH + 2 * rp, cs == 0);
              } asm volatile("" :: "v"(T0), "v"(T1)); }
#endif
            { RwOp o0, o1; rw_ldop(o0, bufp, cs, rp);
              for (int t = 0; t < tn; t += 2) {
                  rw_ldop(o1, bufp + (t + 1) * (RW_REC * 4), cs, rp);
                  rw_step(S0, S1, o0, ybuf + t * RH + 2 * rp, cs == 0);
                  rw_ldop(o0, bufp + (t + 2 < tn ? t + 2 : t) * (RW_REC * 4), cs, rp);
                  rw_step(S0, S1, o1, ybuf + (t + 1) * RH + 2 * rp, cs == 0);
              } }
            if (n + 1 < nch) RW_PREP(n + 1, (n + 1) & 1);
#if defined(PROBE_DUP) && (PROBE_DUP & (1 << 18))
            if (n + 1 < nch) RW_PREP(n + 1, (n + 1) & 1);
#endif
            __syncthreads();
            for (int t = w; t < tn; t += 8) {
                const LDSP float* rec = (const LDSP float*)(bufp + t * (RW_REC * 4));
                const float y = ybuf[t * RH + lane], mean = wsum_dpp(y) * (1.0f / RH), d = y - mean, var = wsum_dpp(d * d) * (1.0f / RH);
                const float yn = d * __builtin_amdgcn_rsqf(var + LNX_EPS) * p_lnw + p_lnb;
                const float o = (yn + rec[450] * rec[320 + lane]) * rec[384 + lane];
                fr.yo[(size_t)(m0 + n * RW_CH + t) * D + ch] = (bf16_t)(pk2bf(o, 0.f) & 0xffffu);
            }
            __syncthreads();
        }
#undef RW_LOADIN
#undef RW_PREP
        float* so = (sq < BATCH ? c.out + O_WKVP + (((size_t)j * BATCH + sq) * RHEADS + h) * RH * RH : c.out + O_WKVS + (((size_t)j * DB + (sq - BATCH)) * RHEADS + h) * RH * RH) + (size_t)(2 * rp) * RH + 4 * cs;
        *(pg8::f32x4*)so = S0; *(pg8::f32x4*)(so + RH) = S1;
    }
}
struct FastMb {
    bf16_t* zb;
    bf16_t* xbcr;
    float* dtraw;
    bf16_t* xbcb;
    float* dt;
    float* y;
    bf16_t* yzn;
    bf16_t *wbint, *wbot;
};
struct EpiMamba {
    static constexpr bool PERM = true;
    bf16_t* zb; bf16_t* xbcr; float* dtraw;
    __device__ __forceinline__ void operator()(const pg8::f32x4 (&acc)[2][2][4][2], const pg8::Unit& u, int wr, int wc, int fr, int fq) const {
        using namespace pg8;
        const int row0 = u.pm * BM + wr * 64 + fr, cl0 = wc * 32 + 8 * fq, pn = u.pn;
        if (pn < 20) {
            bf16_t* base = pn < 8 ? zb : xbcr; const int ldc = pn < 8 ? 2048 : 3072, coff = pn < 8 ? pn * 256 : (pn - 8) * 256;
#pragma unroll
            for (int ai = 0; ai < 2; ++ai)
#pragma unroll
                for (int m = 0; m < 4; ++m) { bf16_t* rowp = base + (size_t)(row0 + ai * HALF + m * 16) * ldc + coff + cl0;
#pragma unroll
                    for (int bj = 0; bj < 2; ++bj) { const f32x4 v0 = acc[ai][bj][m][0], v1 = acc[ai][bj][m][1];
                        u32x4 w; w.x = cvt_pk_bf16(v0[0], v0[1]); w.y = cvt_pk_bf16(v0[2], v0[3]); w.z = cvt_pk_bf16(v1[0], v1[1]); w.w = cvt_pk_bf16(v1[2], v1[3]);
                        *(u32x4*)(rowp + bj * HALF) = w; } }
        } else if (cl0 < 32) {
#pragma unroll
            for (int ai = 0; ai < 2; ++ai)
#pragma unroll
                for (int m = 0; m < 4; ++m) { float* rowp = dtraw + (size_t)(row0 + ai * HALF + m * 16) * 32 + cl0;
                    *(f32x4*)rowp = acc[ai][0][m][0]; *(f32x4*)(rowp + 4) = acc[ai][0][m][1]; }
        }
    }
};
__device__ __forceinline__ void mb_conv_fast(const Ctx& c, const FastMb& fb, int l, size_t gtid, size_t gsz, bool write_f32) {
    using namespace cfg; const int j = l / 3; constexpr int NB = MB_CD / 8, TB = 8;
    for (size_t i = gtid; i < (size_t)(MTOT / TB) * NB; i += gsz) {
        const int mb = (int)(i / NB) * TB, cb = (int)(i % NB) * 8, t0 = row_t(mb), sq = row_seq(mb), T = seq_len(sq);
        float wt[MB_CONV][8], bias[8], win[MB_CONV][8];
#pragma unroll
        for (int e = 0; e < 8; ++e) bias[e] = c.in[I_CONVB][j * MB_CD + cb + e];
#pragma unroll
        for (int jj = 0; jj < MB_CONV; ++jj)
#pragma unroll
            for (int e = 0; e < 8; ++e) wt[jj][e] = c.in[I_CONVW][((size_t)j * MB_CONV + jj) * MB_CD + cb + e];
#pragma unroll
        for (int jj = 0; jj < MB_CONV - 1; ++jj) {
            const int tt = t0 + jj - (MB_CONV - 1);
            if (tt >= 0) { const pg8::u32x4 raw = *(const pg8::u32x4*)(fb.xbcr + (size_t)(mb + jj - (MB_CONV - 1)) * MB_CD + cb); const unsigned wv[4] = {raw.x, raw.y, raw.z, raw.w};
#pragma unroll
                for (int q = 0; q < 4; ++q) { win[jj][2 * q] = __uint_as_float(wv[q] << 16); win[jj][2 * q + 1] = __uint_as_float(wv[q] & 0xffff0000u); } }
            else if (sq >= BATCH) { const float* st = c.in[I_CONV] + (((size_t)j * DB + (sq - BATCH)) * (MB_CONV - 1) + (tt + MB_CONV - 1)) * MB_CD + cb;
#pragma unroll
                for (int e = 0; e < 8; ++e) win[jj][e] = st[e]; }
            else {
#pragma unroll
                for (int e = 0; e < 8; ++e) win[jj][e] = 0.f; }
        }
#pragma unroll
        for (int tb = 0; tb < TB; ++tb) {
            const int m = mb + tb, t = t0 + tb;
            { const pg8::u32x4 raw = *(const pg8::u32x4*)(fb.xbcr + (size_t)m * MB_CD + cb); const unsigned wv[4] = {raw.x, raw.y, raw.z, raw.w};
#pragma unroll
              for (int q = 0; q < 4; ++q) { win[3][2 * q] = __uint_as_float(wv[q] << 16); win[3][2 * q + 1] = __uint_as_float(wv[q] & 0xffff0000u); } }
            if (t >= T - (MB_CONV - 1)) {
                float* so = (sq < BATCH ? c.out + O_CONVP + (((size_t)j * BATCH + sq) * (MB_CONV - 1) + (t - (T - (MB_CONV - 1)))) * MB_CD
                                        : c.out + O_CONVS + (((size_t)j * DB + (sq - BATCH)) * (MB_CONV - 1) + (t - (T - (MB_CONV - 1)))) * MB_CD) + cb;
#pragma unroll
                for (int e = 0; e < 8; ++e) so[e] = win[3][e];
            }
            unsigned w[4];
#pragma unroll
            for (int q = 0; q < 4; ++q) {
                float a0 = bias[2 * q], a1 = bias[2 * q + 1];
#pragma unroll
                for (int jj = 0; jj < MB_CONV; ++jj) { a0 += win[jj][2 * q] * wt[jj][2 * q]; a1 += win[jj][2 * q + 1] * wt[jj][2 * q + 1]; }
                a0 = a0 * __builtin_amdgcn_rcpf(1.0f + __expf(-a0)); a1 = a1 * __builtin_amdgcn_rcpf(1.0f + __expf(-a1));
                w[q] = pk2bf(a0, a1); if (write_f32) { c.xbc[(size_t)m * MB_CD + cb + 2 * q] = a0; c.xbc[(size_t)m * MB_CD + cb + 2 * q + 1] = a1; } }
            *(pg8::u32x4*)(fb.xbcb + (size_t)m * MB_CD + cb) = (pg8::u32x4){w[0], w[1], w[2], w[3]};
#pragma unroll
            for (int jj = 0; jj < MB_CONV - 1; ++jj)
#pragma unroll
                for (int e = 0; e < 8; ++e) win[jj][e] = win[jj + 1][e];
        }
    }
    for (size_t i = gtid; i < (size_t)MTOT * MB_HEADS; i += gsz) {
        const float v = softplusf_(fb.dtraw[i] + c.in[I_DTB][j * MB_HEADS + (int)(i % MB_HEADS)]);
        fb.dt[i] = v; if (write_f32) c.dt[i] = v;
    }
}
__device__ __forceinline__ void mb_gate_fast(const Ctx& c, const FastMb& fb, const float* __restrict__ y, int l, int gw, int ngw, int lane) {
    using namespace cfg; const int j = l / 3; constexpr int GW_ = MB_INNER / MB_GROUPS;
    for (int it = gw; it < MTOT * MB_GROUPS; it += ngw) {
        const int m = it / MB_GROUPS, g = it % MB_GROUPS; const size_t o = (size_t)m * MB_INNER + g * GW_ + 8 * lane;
        const pg8::f32x4 y0 = *(const pg8::f32x4*)(y + o), y1 = *(const pg8::f32x4*)(y + o + 4); const pg8::u32x4 zr = *(const pg8::u32x4*)(fb.zb + o);
        const unsigned zw[4] = {zr.x, zr.y, zr.z, zr.w}; float v[8]; float s = 0.f;
#pragma unroll
        for (int q = 0; q < 4; ++q) { const float z0 = __uint_as_float(zw[q] << 16), z1 = __uint_as_float(zw[q] & 0xffff0000u);
            v[2 * q] = (q < 2 ? y0[2 * q] : y1[2 * q - 4]) * siluf_(z0); v[2 * q + 1] = (q < 2 ? y0[2 * q + 1] : y1[2 * q - 3]) * siluf_(z1); s += v[2 * q] * v[2 * q] + v[2 * q + 1] * v[2 * q + 1]; }
        const float rs = 1.0f / sqrtf(wave_sum64(s) * (1.0f / GW_) + NORM_EPS);
        const float* nw = c.in[I_BNORM] + j * MB_INNER + g * GW_ + 8 * lane; unsigned w[4];
#pragma unroll
        for (int q = 0; q < 4; ++q) w[q] = pk2bf(v[2 * q] * rs * nw[2 * q], v[2 * q + 1] * rs * nw[2 * q + 1]);
        *(pg8::u32x4*)(fb.yzn + o) = (pg8::u32x4){w[0], w[1], w[2], w[3]};
    }
}
constexpr int SS_XR = 144, SS_BR = 272;
constexpr int SS_XIM = 0, SS_XSM = SS_XIM + 128 * SS_XR, SS_BIM = SS_XSM + 128 * SS_XR, SS_CIM = SS_BIM + 128 * SS_BR, SS_MTM = SS_CIM + 128 * SS_BR, SS_HBM = SS_MTM + 128 * SS_BR, SS_TAB = SS_HBM + 128 * SS_XR, SS_END = SS_TAB + 2048;
__device__ __forceinline__ bf16x8v ss_trfrag(const LDSP unsigned char* img, int rowstride, int k0, int col0, int lane) {
    const int r0 = k0 + 8 * (lane >> 5) + ((lane & 15) >> 2), cc = col0 + 16 * ((lane >> 4) & 1) + 4 * (lane & 3);
    const s16x4 t0 = __builtin_amdgcn_ds_read_tr16_b64_v4i16((LDSP s16x4*)(img + r0 * rowstride + cc * 2));
    const s16x4 t1 = __builtin_amdgcn_ds_read_tr16_b64_v4i16((LDSP s16x4*)(img + (r0 + 4) * rowstride + cc * 2));
    return (bf16x8v){t0[0], t0[1], t0[2], t0[3], t1[0], t1[1], t1[2], t1[3]};
}
__device__ __forceinline__ void mb_ssd_prompt(const Ctx& c, const FastMb& fb, int l, LDSP unsigned char* lds) {
    using namespace cfg; const int j = l / 3;
    const int tid = (int)tid_now(), w = __builtin_amdgcn_readfirstlane(tid >> 6), lane = tid & 63, l31 = lane & 31, h5 = lane >> 5;
    LDSP float* tab = (LDSP float*)(lds + SS_TAB);
    for (int chain = blockIdx.x; chain < BATCH * MB_HEADS; chain += gridDim.x) {
        const int b = chain / MB_HEADS, hd = chain % MB_HEADS, g = hd / (MB_HEADS / MB_GROUPS);
        const float Ah = -expf(c.in[I_ALOG][j * MB_HEADS + hd]), Dh = c.in[I_BD][j * MB_HEADS + hd];
        f32x16_t H;
#pragma unroll
        for (int r = 0; r < 16; ++r) H[r] = 0.f;
        pg8::u32x4 nx[2], nB[4], nC[4]; float ndt0 = 0.f, ndt1 = 0.f;
#define SS_LOAD(ck_) do { const size_t mm_ = (size_t)b * SEQ + 128 * (ck_); int tq_ = tid; asm volatile("" : "+v"(tq_)); \
            _Pragma("unroll") for (int q = 0; q < 2; ++q) { const int ci = tq_ + 512 * q; nx[q] = *(const pg8::u32x4*)(fb.xbcb + (mm_ + (ci >> 3)) * MB_CD + hd * MB_HEAD + (ci & 7) * 8); } \
            _Pragma("unroll") for (int q = 0; q < 4; ++q) { const int ci = tq_ + 512 * q; const bf16_t* rowp = fb.xbcb + (mm_ + (ci >> 4)) * MB_CD + MB_INNER + g * MB_STATE + (ci & 15) * 8; \
                nB[q] = *(const pg8::u32x4*)rowp; nC[q] = *(const pg8::u32x4*)(rowp + MB_GN); } \
            ndt0 = fb.dt[(mm_ + 2 * (tq_ & 63)) * MB_HEADS + hd]; ndt1 = fb.dt[(mm_ + 2 * (tq_ & 63) + 1) * MB_HEADS + hd]; } while (0)
        SS_LOAD(0);
        for (int ck = 0; ck < SEQ / 128; ++ck) {
            const size_t m0 = (size_t)b * SEQ + 128 * ck;
            int tl = tid; asm volatile("" : "+v"(tl));
            pg8::u32x4 xr[2];
#pragma unroll
            for (int q = 0; q < 2; ++q) { const int ci = tl + 512 * q; xr[q] = nx[q];
                *(LDSP pg8::u32x2*)(lds + SS_XIM + (ci >> 3) * SS_XR + (ci & 7) * 16) = (pg8::u32x2){xr[q].x, xr[q].y}; *(LDSP pg8::u32x2*)(lds + SS_XIM + (ci >> 3) * SS_XR + (ci & 7) * 16 + 8) = (pg8::u32x2){xr[q].z, xr[q].w}; }
#pragma unroll
            for (int q = 0; q < 4; ++q) { const int ci = tl + 512 * q;
                *(LDSP pg8::u32x4*)(lds + SS_BIM + (ci >> 4) * SS_BR + (ci & 15) * 16) = nB[q];
                *(LDSP pg8::u32x4*)(lds + SS_CIM + (ci >> 4) * SS_BR + (ci & 15) * 16) = nC[q]; }
            float alast;
            { const float v0 = ndt0 * Ah, v1 = ndt1 * Ah; float sacc = v0 + v1;
#pragma unroll
              for (int o = 1; o < 64; o <<= 1) { const float u = __shfl_up(sacc, o); if (lane >= o) sacc += u; }
              tab[2 * lane] = sacc - v1; tab[2 * lane + 1] = sacc; tab[128 + 2 * lane] = ndt0; tab[128 + 2 * lane + 1] = ndt1;
              alast = __int_as_float(__builtin_amdgcn_readlane(__float_as_int(sacc), 63)); }
            if (ck + 1 < SEQ / 128) SS_LOAD(ck + 1);
            asm volatile("s_waitcnt lgkmcnt(0)" ::: "memory");
#pragma unroll
            for (int q = 0; q < 2; ++q) { const int ci = tl + 512 * q, row = ci >> 3; const float sc = __expf(alast - tab[row]) * tab[128 + row]; const unsigned xw[4] = {xr[q].x, xr[q].y, xr[q].z, xr[q].w}; unsigned ow[4];
#pragma unroll
                for (int e = 0; e < 4; ++e) ow[e] = pk2bf(__uint_as_float(xw[e] << 16) * sc, __uint_as_float(xw[e] & 0xffff0000u) * sc);
                *(LDSP pg8::u32x2*)(lds + SS_XSM + row * SS_XR + (ci & 7) * 16) = (pg8::u32x2){ow[0], ow[1]}; *(LDSP pg8::u32x2*)(lds + SS_XSM + row * SS_XR + (ci & 7) * 16 + 8) = (pg8::u32x2){ow[2], ow[3]}; }
            __syncthreads();
            { int ln = lane; asm volatile("" : "+v"(ln)); const int a31 = ln & 31, a5 = ln >> 5;
              for (int tt = w; tt < 10; tt += 8) {
                int ib = tt < 1 ? 0 : (tt < 3 ? 1 : (tt < 6 ? 2 : 3)); const int jb = tt - (ib * (ib + 1)) / 2;
                f32x16_t ST;
#pragma unroll
                for (int r = 0; r < 16; ++r) ST[r] = 0.f;
#pragma unroll
                for (int s = 0; s < 8; ++s) { const bf16x8v a = *(const LDSP bf16x8v*)(lds + SS_BIM + (32 * jb + a31) * SS_BR + (16 * s + 8 * a5) * 2), bb = *(const LDSP bf16x8v*)(lds + SS_CIM + (32 * ib + a31) * SS_BR + (16 * s + 8 * a5) * 2);
                    ST = MFMA32(a, bb, ST); }
                const float ai = tab[32 * ib + a31];
#pragma unroll
                for (int g4 = 0; g4 < 4; ++g4) { const int jr = 32 * jb + 8 * g4 + 4 * a5; const pg8::f32x4 aj = *(const LDSP pg8::f32x4*)(tab + jr), dj = *(const LDSP pg8::f32x4*)(tab + 128 + jr);
#pragma unroll
                    for (int e = 0; e < 4; ++e) { const int jj = jr + e, ii = 32 * ib + a31; const float mv = jj <= ii ? ST[4 * g4 + e] * __expf(ai - aj[e]) * dj[e] : 0.f;
                        *(LDSP bf16_t*)(lds + SS_MTM + jj * SS_BR + ii * 2) = (bf16_t)(pk2bf(mv, 0.f) & 0xffffu); } }
              }
              const int nb = w >> 1, pb = w & 1;
#pragma unroll
              for (int r = 0; r < 16; ++r) *(LDSP bf16_t*)(lds + SS_HBM + (32 * nb + (r & 3) + 8 * (r >> 2) + 4 * a5) * SS_XR + (32 * pb + a31) * 2) = (bf16_t)(pk2bf(H[r], 0.f) & 0xffffu);
            }
            __syncthreads();
            { int ln = lane; asm volatile("" : "+v"(ln)); const int a31 = ln & 31, a5 = ln >> 5;
              const int pb = w & 1, ib = w >> 1, nb = w >> 1;
              f32x16_t Y;
#pragma unroll
              for (int r = 0; r < 16; ++r) Y[r] = 0.f;
#pragma unroll
              for (int s = 0; s < 8; ++s) { const bf16x8v a = ss_trfrag(lds + SS_HBM, SS_XR, 16 * s, 32 * pb, ln), bb = *(const LDSP bf16x8v*)(lds + SS_CIM + (32 * ib + a31) * SS_BR + (16 * s + 8 * a5) * 2);
                  Y = MFMA32(a, bb, Y); if (s & 1) __builtin_amdgcn_sched_barrier(0); }
              const float ei = __expf(tab[32 * ib + a31]);
#pragma unroll
              for (int r = 0; r < 16; ++r) Y[r] *= ei;
              for (int s = 0; s < 2 * (ib + 1); ++s) { const bf16x8v a = ss_trfrag(lds + SS_XIM, SS_XR, 16 * s, 32 * pb, ln), bb = ss_trfrag(lds + SS_MTM, SS_BR, 16 * s, 32 * ib, ln);
                  Y = MFMA32(a, bb, Y); }
              { const size_t mrow = m0 + 32 * ib + a31; float* yrow = fb.y + mrow * MB_INNER + hd * MB_HEAD + 32 * pb + 4 * a5;
#pragma unroll
                for (int g4 = 0; g4 < 4; ++g4) { const pg8::u32x2 xv = *(const LDSP pg8::u32x2*)(lds + SS_XIM + (32 * ib + a31) * SS_XR + (32 * pb + 8 * g4 + 4 * a5) * 2);
                    pg8::f32x4 o; o[0] = Y[4 * g4] + Dh * __uint_as_float(xv.x << 16); o[1] = Y[4 * g4 + 1] + Dh * __uint_as_float(xv.x & 0xffff0000u); o[2] = Y[4 * g4 + 2] + Dh * __uint_as_float(xv.y << 16); o[3] = Y[4 * g4 + 3] + Dh * __uint_as_float(xv.y & 0xffff0000u);
                    *(pg8::f32x4*)(yrow + 8 * g4) = o; } }
              const float dec = __expf(tab[127]);
#pragma unroll
              for (int r = 0; r < 16; ++r) H[r] *= dec;
#pragma unroll
              for (int s = 0; s < 8; ++s) { const bf16x8v a = ss_trfrag(lds + SS_BIM, SS_BR, 16 * s, 32 * nb, ln), bb = ss_trfrag(lds + SS_XSM, SS_XR, 16 * s, 32 * pb, ln);
                  H = MFMA32(a, bb, H); if (s & 1) __builtin_amdgcn_sched_barrier(0); }
            }
            __syncthreads();
        }
#undef SS_LOAD
        { const int nb = w >> 1, pb = w & 1; float* so = c.out + O_SSMP + (((size_t)j * BATCH + b) * MB_HEADS + hd) * MB_HEAD * MB_STATE;
#pragma unroll
          for (int r = 0; r < 16; ++r) so[(size_t)(32 * pb + l31) * MB_STATE + 32 * nb + (r & 3) + 8 * (r >> 2) + 4 * h5] = H[r]; }
    }
}
__device__ __forceinline__ void mb_scan_sample(const Ctx& c, const FastMb& fb, int l) {
    using namespace cfg; const int j = l / 3;
    const int tid = (int)tid_now(), p = tid >> 3, ns = tid & 7;
    pg8::f32x4 hn[4];
    { const int chain = blockIdx.x; if (chain < DB * MB_HEADS) { const size_t so = ((((size_t)j * DB + chain / MB_HEADS) * MB_HEADS + chain % MB_HEADS) * MB_HEAD + p) * MB_STATE + 16 * ns;
#pragma unroll
        for (int q = 0; q < 4; ++q) hn[q] = *(const pg8::f32x4*)(c.in[I_SSM] + so + 4 * q); } }
    for (int chain = blockIdx.x; chain < DB * MB_HEADS; chain += gridDim.x) {
        const int s = chain / MB_HEADS, hd = chain % MB_HEADS, g = hd / (MB_HEADS / MB_GROUPS);
        const float Ah = -expf(c.in[I_ALOG][j * MB_HEADS + hd]), Dh = c.in[I_BD][j * MB_HEADS + hd];
        const size_t so = ((((size_t)j * DB + s) * MB_HEADS + hd) * MB_HEAD + p) * MB_STATE + 16 * ns;
        float hs[16];
#pragma unroll
        for (int q = 0; q < 4; ++q) { hs[4 * q] = hn[q][0]; hs[4 * q + 1] = hn[q][1]; hs[4 * q + 2] = hn[q][2]; hs[4 * q + 3] = hn[q][3]; }
        { const int cn = chain + gridDim.x; if (cn < DB * MB_HEADS) { const size_t sn = ((((size_t)j * DB + cn / MB_HEADS) * MB_HEADS + cn % MB_HEADS) * MB_HEAD + p) * MB_STATE + 16 * ns;
#pragma unroll
            for (int q = 0; q < 4; ++q) hn[q] = *(const pg8::f32x4*)(c.in[I_SSM] + sn + 4 * q); } }
        float dtv[DS]; unsigned short xr[DS]; pg8::u32x4 Bq[DS][2], Cq[DS][2];
#pragma unroll
        for (int t = 0; t < DS; ++t) { const size_t m = (size_t)MP + s * DS + t; dtv[t] = fb.dt[m * MB_HEADS + hd]; xr[t] = fb.xbcb[m * MB_CD + hd * MB_HEAD + p];
            const bf16_t* Bp = fb.xbcb + m * MB_CD + MB_INNER + g * MB_STATE + 16 * ns; Bq[t][0] = *(const pg8::u32x4*)Bp; Bq[t][1] = *(const pg8::u32x4*)(Bp + 8);
            Cq[t][0] = *(const pg8::u32x4*)(Bp + MB_GN); Cq[t][1] = *(const pg8::u32x4*)(Bp + MB_GN + 8); }
#pragma unroll
        for (int t = 0; t < DS; ++t) {
            const size_t m = (size_t)MP + s * DS + t;
            const float dA = __expf(dtv[t] * Ah), xv = bf2f(xr[t]), xdt = xv * dtv[t];
            const unsigned bw[8] = {Bq[t][0].x, Bq[t][0].y, Bq[t][0].z, Bq[t][0].w, Bq[t][1].x, Bq[t][1].y, Bq[t][1].z, Bq[t][1].w};
            const unsigned cw[8] = {Cq[t][0].x, Cq[t][0].y, Cq[t][0].z, Cq[t][0].w, Cq[t][1].x, Cq[t][1].y, Cq[t][1].z, Cq[t][1].w};
            float yy = 0.f;
#pragma unroll
            for (int k = 0; k < 8; ++k) { hs[2 * k] = hs[2 * k] * dA + xdt * __uint_as_float(bw[k] << 16); hs[2 * k + 1] = hs[2 * k + 1] * dA + xdt * __uint_as_float(bw[k] & 0xffff0000u);
                yy += __uint_as_float(cw[k] << 16) * hs[2 * k] + __uint_as_float(cw[k] & 0xffff0000u) * hs[2 * k + 1]; }
            yy += __shfl_xor(yy, 1); yy += __shfl_xor(yy, 2); yy += __shfl_xor(yy, 4);
            if (ns == 0) fb.y[m * MB_INNER + hd * MB_HEAD + p] = yy + Dh * xv;
        }
        float* oo = c.out + O_SSMS + so;
#pragma unroll
        for (int q = 0; q < 4; ++q) *(pg8::f32x4*)(oo + 4 * q) = (pg8::f32x4){hs[4 * q], hs[4 * q + 1], hs[4 * q + 2], hs[4 * q + 3]};
    }
}
constexpr int RC_RS = 144;
constexpr int RC_AT = 0, RC_RT = 4608, RC_BB = 9216, RC_KB = 13824, RC_BH = 18432, RC_KH = 23040, RC_VV = 27648, RC_UT = 32256, RC_GG = 36864;
constexpr int RC_SB = 41472;
constexpr int RC_NAK = 50688, RC_MRB = 53248, RC_MRK = 55808, RC_NS = 80;
constexpr int RC_NAB = 58368;
constexpr int RC_E = 62464;
constexpr int RC_YB = 70656;
constexpr int RC_GL = 78848, RC_BON = 79104, RC_VV2 = 79360, RC_GG2 = RC_VV2 + 4608, RC_END0 = RC_GG2 + 4608;
constexpr int RC_WW = RC_END0, RC_WA = RC_WW + 64 * 144, RC_WG = RC_WA + 64 * 144, RC_WV = RC_WG + 64 * 336, RC_LUO = RC_WV + 64 * 80, RC_END = RC_LUO + 4 * 4608;
constexpr int RC_HB = RC_AT, RC_HBS = 784;
__device__ __forceinline__ bf16x8v rc_nat(const LDSP unsigned char* img, int stride, int row, int kofs) { return *(const LDSP bf16x8v*)(img + row * stride + kofs * 2); }
__device__ __forceinline__ int rc_row(int r, int h5) { return (r & 3) + 8 * (r >> 2) + 4 * h5; }
__device__ __forceinline__ void rc_st16(LDSP unsigned char* p, float v) { *(LDSP bf16_t*)p = (bf16_t)(pk2bf(v, 0.f) & 0xffffu); }


template <int S>
struct RcSub {
    static __device__ __forceinline__ void run(float (&acc)[32], const LDSP float* NAB, LDSP unsigned char* lds, int lane) {
        const float us = acc[S]; rc_st16(lds + RC_UT + S * RC_RS + lane * 2, us);
#pragma unroll
        for (int g4 = 0; g4 < 8; ++g4) { if (4 * g4 + 3 > S) { const pg8::f32x4 nv = *(const LDSP pg8::f32x4*)(NAB + S * 32 + 4 * g4);
#pragma unroll
            for (int e = 0; e < 4; ++e) { if (4 * g4 + e > S) acc[4 * g4 + e] = fmaf(nv[e], us, acc[4 * g4 + e]); } } }
        RcSub<S + 1>::run(acc, NAB, lds, lane);
    }
};
template <> struct RcSub<32> { static __device__ __forceinline__ void run(float (&)[32], const LDSP float*, LDSP unsigned char*, int) {} };

template <int J>
__device__ __forceinline__ void rw_scan_chunked(const Ctx& c, const FastRw& fr, LDSP unsigned char* lds) {
    using namespace cfg; constexpr int j = J;
    const int tid = (int)tid_now(), w = __builtin_amdgcn_readfirstlane(tid >> 6), lane = tid & 63, l31 = lane & 31, h5 = lane >> 5;
    LDSP float* Ef = (LDSP float*)(lds + RC_E); LDSP float* YB = (LDSP float*)(lds + RC_YB); LDSP float* GL = (LDSP float*)(lds + RC_GL); LDSP float* BON = (LDSP float*)(lds + RC_BON);
    LDSP float* NAB = (LDSP float*)(lds + RC_NAB);
    int hcur = -1;
    for (int chain = blockIdx.x; chain < NSEQ * RHEADS; chain += gridDim.x) {
        const int sq = chain / RHEADS, h = chain % RHEADS, T = seq_len(sq), m0 = seq_row0(sq), ch = h * RH + lane;
        const float p_w0 = c.in[I_W0][j * D + ch], p_a0 = c.in[I_A0][j * D + ch], p_kk = c.in[I_KK][j * D + ch], p_ka = c.in[I_KA][j * D + ch], p_rk = c.in[I_RK][(size_t)j * D + ch],
                    p_lnw = c.in[I_LNW][j * D + ch], p_lnb = c.in[I_LNB][j * D + ch], p_v0 = j > 0 ? c.in[I_V0][(j - 1) * D + ch] : 0.f;
        const int ib = (w >> 1) & 1, jb = w & 1;
        f32x16_t ST;
#pragma unroll
        for (int r = 0; r < 16; ++r) ST[r] = 0.f;
        if (w < 4 && sq >= BATCH) { const float* s0 = c.in[I_WKV] + (((size_t)j * DB + (sq - BATCH)) * RHEADS + h) * RH * RH;
#pragma unroll
            for (int r = 0; r < 16; ++r) ST[r] = s0[(size_t)(32 * ib + rc_row(r, h5)) * RH + 32 * jb + l31]; }
        const int nch = (T + 31) / 32;
        if (h != hcur) {
            __syncthreads();
            const bf16_t* lw = fr.lorat + (size_t)j * 4096 * 384;
            for (int ci = tid; ci < 64 * 8; ci += 512) { const int row = ci >> 3, c8 = ci & 7;
                *(LDSP pg8::u32x4*)(lds + RC_WW + row * 144 + c8 * 16) = *(const pg8::u32x4*)(lw + (size_t)(0 * 1024 + h * 64 + row) * 384 + 0 + c8 * 8);
                *(LDSP pg8::u32x4*)(lds + RC_WA + row * 144 + c8 * 16) = *(const pg8::u32x4*)(lw + (size_t)(1 * 1024 + h * 64 + row) * 384 + 64 + c8 * 8); }
            for (int ci = tid; ci < 64 * 20; ci += 512) { const int row = ci / 20, c20 = ci % 20;
                *(LDSP pg8::u32x4*)(lds + RC_WG + row * 336 + c20 * 16) = *(const pg8::u32x4*)(lw + (size_t)(2 * 1024 + h * 64 + row) * 384 + 128 + c20 * 8); }
            for (int ci = tid; ci < 64 * 4; ci += 512) { const int row = ci >> 2, c4 = ci & 3;
                *(LDSP pg8::u32x4*)(lds + RC_WV + row * 80 + c4 * 16) = *(const pg8::u32x4*)(lw + (size_t)(3 * 1024 + h * 64 + row) * 384 + 288 + c4 * 8); }
            hcur = h;
        }
        RwIn in[4]; pg8::u32x4 hbr[3];
#define RC_LOADIN(n) do { _Pragma("unroll") for (int q = 0; q < 4; ++q) { const int t_ = (n) * 32 + 4 * w + q; if (t_ < T) { const size_t m_ = (size_t)(m0 + t_); \
                const bf16_t* rk_ = fr.rkv + m_ * 3072 + ch; in[q].r = rk_[0]; in[q].k = rk_[1024]; in[q].v = rk_[2048]; \
                in[q].vf = j > 0 ? fr.vf[m_ * D + ch] : 0.f; } } \
            _Pragma("unroll") for (int k3 = 0; k3 < 3; ++k3) { const int ci_ = tid + 512 * k3, tk_ = ci_ / 48, t_ = (n) * 32 + tk_; \
                hbr[k3] = t_ < T ? *(const pg8::u32x4*)(fr.hb + (size_t)(m0 + t_) * 384 + (ci_ % 48) * 8) : (pg8::u32x4){0u, 0u, 0u, 0u}; } } while (0)
#define RC_EPI_TOKEN(nn, tl) do { const int vv_ = ((nn) & 1) ? RC_VV2 : RC_VV, gg_ = ((nn) & 1) ? RC_GG2 : RC_GG, bn_ = ((nn) & 1) ? 32 : 0; \
                const float y_ = YB[(tl) * 64 + lane], mean_ = wsum_dpp(y_) * (1.0f / RH), d_ = y_ - mean_, var_ = wsum_dpp(d_ * d_) * (1.0f / RH); \
                const float yn_ = d_ * __builtin_amdgcn_rsqf(var_ + LNX_EPS) * p_lnw + p_lnb; \
                const float o_ = (yn_ + BON[bn_ + (tl)] * bf2f(*(const LDSP bf16_t*)(lds + vv_ + (tl) * RC_RS + lane * 2))) * bf2f(*(const LDSP bf16_t*)(lds + gg_ + (tl) * RC_RS + lane * 2)); \
                fr.yo[(size_t)(m0 + (nn) * 32 + (tl)) * D + ch] = (bf16_t)(pk2bf(o_, 0.f) & 0xffffu); } while (0)
        __syncthreads();
        RC_LOADIN(0);
        for (int n = 0; n < nch; ++n) {
            const int tn = T - n * 32 < 32 ? T - n * 32 : 32;
            const int vvo = (n & 1) ? RC_VV2 : RC_VV, ggo = (n & 1) ? RC_GG2 : RC_GG, bno = (n & 1) ? 32 : 0;
#pragma unroll
            for (int k3 = 0; k3 < 3; ++k3) { const int ci_ = tid + 512 * k3; *(LDSP pg8::u32x4*)(lds + RC_HB + (ci_ / 48) * RC_HBS + (ci_ % 48) * 16) = hbr[k3]; }
            __syncthreads();
            { int ln = lane; asm volatile("" : "+v"(ln)); const int a31 = ln & 31, a5 = ln >> 5; const int grp = w >> 1, nb = w & 1;
              const int koff = grp == 0 ? 0 : (grp == 1 ? 64 : (grp == 2 ? 128 : 288)), nks = grp == 2 ? 10 : (grp == 3 ? 2 : 4);
              const int wof = grp == 0 ? RC_WW : (grp == 1 ? RC_WA : (grp == 2 ? RC_WG : RC_WV)), wst = grp == 2 ? 336 : (grp == 3 ? 80 : 144);
              f32x16_t LA;
#pragma unroll
              for (int r = 0; r < 16; ++r) LA[r] = 0.f;
              for (int ks = 0; ks < nks; ++ks) LA = MFMA32(rc_nat(lds + RC_HB, RC_HBS, a31, koff + 16 * ks + 8 * a5), rc_nat(lds + wof, wst, 32 * nb + a31, 16 * ks + 8 * a5), LA);
#pragma unroll
              for (int r = 0; r < 16; ++r) rc_st16(lds + RC_LUO + grp * 4608 + rc_row(r, a5) * RC_RS + (32 * nb + a31) * 2, LA[r]); }
            __syncthreads();
            float q_r[4], q_k[4], q_a[4], q_b[4], q_e[4];
#pragma unroll
            for (int q = 0; q < 4; ++q) {
                const int tl = 4 * w + q, tg = n * 32 + tl;
                float r_ = 0.f, k2_ = 0.f, v_ = 0.f, a_ = 0.f, b_ = 0.f, e_ = 0.f, g_ = 0.f, bon_ = 0.f;
                if (tg < T) {
                    r_ = bf2f(in[q].r); const float k0_ = bf2f(in[q].k); v_ = bf2f(in[q].v);
                    e_ = 0.6065306597126334f * fsigmoid(p_w0 + bf2f(*(const LDSP bf16_t*)(lds + RC_LUO + 0 * 4608 + tl * RC_RS + lane * 2)));
                    if (j == 0) fr.vf[(size_t)(m0 + tg) * D + ch] = v_; else v_ = v_ + (in[q].vf - v_) * fsigmoid(p_v0 + bf2f(*(const LDSP bf16_t*)(lds + RC_LUO + 3 * 4608 + tl * RC_RS + lane * 2)));
                    const float as_ = fsigmoid(p_a0 + bf2f(*(const LDSP bf16_t*)(lds + RC_LUO + 1 * 4608 + tl * RC_RS + lane * 2))); float kk_ = k0_ * p_kk;
                    k2_ = k0_ * (1.0f + (as_ - 1.0f) * p_ka);
                    float n_ = red16(kk_ * kk_), e1_ = red16(r_ * k2_ * p_rk);
                    n_ = (rdl(n_, 0) + rdl(n_, 16)) + (rdl(n_, 32) + rdl(n_, 48)); bon_ = (rdl(e1_, 0) + rdl(e1_, 16)) + (rdl(e1_, 32) + rdl(e1_, 48));
                    kk_ *= __builtin_amdgcn_rcpf(fmaxf(__builtin_amdgcn_sqrtf(n_), 1e-12f));
                    a_ = -kk_; b_ = kk_ * as_; g_ = bf2f(*(const LDSP bf16_t*)(lds + RC_LUO + 2 * 4608 + tl * RC_RS + lane * 2));
                }
                q_r[q] = r_; q_k[q] = k2_; q_a[q] = a_; q_b[q] = b_; q_e[q] = e_;
                Ef[tl * 64 + lane] = e_;
                rc_st16(lds + vvo + tl * RC_RS + lane * 2, v_); rc_st16(lds + ggo + tl * RC_RS + lane * 2, g_);
                if (lane == 0) BON[bno + tl] = bon_;
            }
            if (n + 1 < nch) RC_LOADIN(n + 1);
            if (w < 4) {
#pragma unroll
                for (int r = 0; r < 16; ++r) rc_st16(lds + RC_SB + (32 * ib + rc_row(r, h5)) * RC_RS + (32 * jb + l31) * 2, ST[r]);
            }
            __syncthreads();
            { float run = 0.f, base = 0.f;
#pragma unroll
              for (int s = 0; s < 32; ++s) { const float ev = Ef[s * 64 + lane]; if (s == 4 * w) base = run; run += ev; }
              const float cumL = run; float cum = base;
#pragma unroll
              for (int q = 0; q < 4; ++q) { const int tl = 4 * w + q; const float cprev = cum; cum += q_e[q];
                  const float gam = __expf(-cum), gamp = __expf(-cprev), ginv = __expf(cum), glr = __expf(cum - cumL);
                  rc_st16(lds + RC_AT + tl * RC_RS + lane * 2, q_a[q] * gamp); rc_st16(lds + RC_RT + tl * RC_RS + lane * 2, q_r[q] * gam);
                  rc_st16(lds + RC_BB + tl * RC_RS + lane * 2, q_b[q] * ginv); rc_st16(lds + RC_KB + tl * RC_RS + lane * 2, q_k[q] * ginv);
                  rc_st16(lds + RC_BH + tl * RC_RS + lane * 2, q_b[q] * glr); rc_st16(lds + RC_KH + tl * RC_RS + lane * 2, q_k[q] * glr); }
              if (w == 0) GL[lane] = __expf(-cumL); }
            __syncthreads();
            f32x16_t R1;
#pragma unroll
            for (int r = 0; r < 16; ++r) R1[r] = 0.f;
            { int ln = lane; asm volatile("" : "+v"(ln)); const int a31 = ln & 31, a5 = ln >> 5;
              if (w < 4) {
                  const int aoff = (w == 0) ? RC_BB : ((w < 2) ? RC_AT : RC_RT), boff = (w == 0) ? RC_AT : ((w & 1) ? RC_KB : RC_BB);
#pragma unroll
                  for (int ks = 0; ks < 4; ++ks) R1 = MFMA32(rc_nat(lds + aoff, RC_RS, a31, 16 * ks + 8 * a5), rc_nat(lds + boff, RC_RS, a31, 16 * ks + 8 * a5), R1);
#pragma unroll
                  for (int r = 0; r < 16; ++r) { const int rr = rc_row(r, a5), cc = a31;
                      if (w == 0) NAB[rr * 32 + cc] = (rr < cc) ? R1[r] : 0.f;
                      else { const bool keep = (w < 2) ? (cc < rr) : (cc <= rr); rc_st16(lds + (w == 1 ? RC_NAK : (w == 2 ? RC_MRB : RC_MRK)) + rr * RC_NS + cc * 2, keep ? R1[r] : 0.f); } }
              } else {
                  const int aoff = (w < 6) ? RC_AT : RC_RT, ibk = w & 1;
#pragma unroll
                  for (int ks = 0; ks < 4; ++ks) R1 = MFMA32(rc_nat(lds + aoff, RC_RS, a31, 16 * ks + 8 * a5), rc_nat(lds + RC_SB, RC_RS, 32 * ibk + a31, 16 * ks + 8 * a5), R1);
              } }
            __syncthreads();
            if (w == 4 || w == 5) { int ln = lane; asm volatile("" : "+v"(ln)); const int a31 = ln & 31, a5 = ln >> 5, ibk = w & 1;
#pragma unroll
                for (int ks = 0; ks < 2; ++ks) R1 = MFMA32(rc_nat(lds + RC_NAK, RC_NS, a31, 16 * ks + 8 * a5), ss_trfrag(lds + vvo, RC_RS, 16 * ks, 32 * ibk, ln), R1);
#pragma unroll
                for (int r = 0; r < 16; ++r) Ef[rc_row(r, a5) * 64 + 32 * ibk + a31] = R1[r]; }
            __syncthreads();
            if (w > 0 && n > 0) { for (int tl = w - 1; tl < 32; tl += 7) RC_EPI_TOKEN(n - 1, tl); }
            if (w == 0) { float acc[32];
#pragma unroll
                for (int t = 0; t < 32; ++t) acc[t] = Ef[t * 64 + lane];
                RcSub<0>::run(acc, NAB, lds, lane); }
            __syncthreads();
            { int ln = lane; asm volatile("" : "+v"(ln)); const int a31 = ln & 31, a5 = ln >> 5;
              if (w >= 6) { const int ibk = w & 1;
#pragma unroll
                  for (int ks = 0; ks < 2; ++ks) { R1 = MFMA32(rc_nat(lds + RC_MRB, RC_NS, a31, 16 * ks + 8 * a5), ss_trfrag(lds + RC_UT, RC_RS, 16 * ks, 32 * ibk, ln), R1);
                                                   R1 = MFMA32(rc_nat(lds + RC_MRK, RC_NS, a31, 16 * ks + 8 * a5), ss_trfrag(lds + vvo, RC_RS, 16 * ks, 32 * ibk, ln), R1); }
#pragma unroll
                  for (int r = 0; r < 16; ++r) YB[rc_row(r, a5) * 64 + 32 * ibk + a31] = R1[r];
              } else if (w < 4) { const float gl = GL[32 * jb + a31];
#pragma unroll
                  for (int r = 0; r < 16; ++r) ST[r] *= gl;
#pragma unroll
                  for (int ks = 0; ks < 2; ++ks) { ST = MFMA32(ss_trfrag(lds + RC_UT, RC_RS, 16 * ks, 32 * ib, ln), ss_trfrag(lds + RC_BH, RC_RS, 16 * ks, 32 * jb, ln), ST);
                                                   ST = MFMA32(ss_trfrag(lds + vvo, RC_RS, 16 * ks, 32 * ib, ln), ss_trfrag(lds + RC_KH, RC_RS, 16 * ks, 32 * jb, ln), ST); } } }
            __syncthreads();
        }
        { const int nl = nch - 1, tnl = T - nl * 32 < 32 ? T - nl * 32 : 32; for (int tl = w; tl < tnl; tl += 8) RC_EPI_TOKEN(nl, tl); }
#undef RC_EPI_TOKEN
#undef RC_LOADIN
        if (w < 4) { float* so = (sq < BATCH ? c.out + O_WKVP + (((size_t)j * BATCH + sq) * RHEADS + h) * RH * RH : c.out + O_WKVS + (((size_t)j * DB + (sq - BATCH)) * RHEADS + h) * RH * RH);
#pragma unroll
            for (int r = 0; r < 16; ++r) so[(size_t)(32 * ib + rc_row(r, h5)) * RH + 32 * jb + l31] = ST[r]; }
    }
}
template <int ACT, bool ACC>
__device__ __forceinline__ void gemm_dev(const float* __restrict__ A, int lda, const float* __restrict__ B, int ldb, float* C, int ldc, int M, int N, int K, unsigned short (*As)[40], unsigned short (*Bs)[40]) {
    const int tid = threadIdx.x, wave = tid >> 6, lane = tid & 63, wr = wave >> 1, wc = wave & 1, fr = lane & 15, fq = lane >> 4;
    const int ntn = (N + 127) / 128, ntm = (M + 127) / 128;
    for (int tile = blockIdx.x; tile < ntm * ntn; tile += gridDim.x) {
        const int bm = (tile / ntn) * 128, bn = (tile % ntn) * 128;
        f32x4_t acc[2][4];
#pragma unroll
        for (int i = 0; i < 2; ++i)
#pragma unroll
            for (int j = 0; j < 4; ++j) acc[i][j] = (f32x4_t){0.f, 0.f, 0.f, 0.f};
        for (int k0 = 0; k0 < K; k0 += 32) {
#pragma unroll
            for (int it = 0; it < 2; ++it) {
                const int idx = tid + it * 512, row = idx >> 3, c4 = idx & 7, gm = bm + row;
                float4 v = make_float4(0.f, 0.f, 0.f, 0.f);
                if (gm < M) v = *(const float4*)(A + (size_t)gm * lda + k0 + c4 * 4);
                uint2 w; w.x = (unsigned)f2bf(v.x) | ((unsigned)f2bf(v.y) << 16); w.y = (unsigned)f2bf(v.z) | ((unsigned)f2bf(v.w) << 16);
                *(uint2*)&As[row][c4 * 4] = w;
            }
#pragma unroll
            for (int it = 0; it < 2; ++it) {
                const int idx = tid + it * 512, kr = idx >> 5, n4 = idx & 31, gn = bn + n4 * 4;
                float4 v = make_float4(0.f, 0.f, 0.f, 0.f);
                if (gn < N) v = *(const float4*)(B + (size_t)(k0 + kr) * ldb + gn);
                Bs[n4 * 4 + 0][kr] = f2bf(v.x); Bs[n4 * 4 + 1][kr] = f2bf(v.y); Bs[n4 * 4 + 2][kr] = f2bf(v.z); Bs[n4 * 4 + 3][kr] = f2bf(v.w);
            }
            __syncthreads();
            bf16x8_t a[2], b[4];
#pragma unroll
            for (int i = 0; i < 2; ++i) a[i] = *(const bf16x8_t*)&As[wr * 32 + i * 16 + fr][fq * 8];
#pragma unroll
            for (int j = 0; j < 4; ++j) b[j] = *(const bf16x8_t*)&Bs[wc * 64 + j * 16 + fr][fq * 8];
#pragma unroll
            for (int i = 0; i < 2; ++i)
#pragma unroll
                for (int j = 0; j < 4; ++j) acc[i][j] = __builtin_amdgcn_mfma_f32_16x16x32_bf16(a[i], b[j], acc[i][j], 0, 0, 0);
            __syncthreads();
        }
#pragma unroll
        for (int i = 0; i < 2; ++i)
#pragma unroll
            for (int j = 0; j < 4; ++j)
#pragma unroll
                for (int e = 0; e < 4; ++e) {
                    const int row = bm + wr * 32 + i * 16 + fq * 4 + e, col = bn + wc * 64 + j * 16 + fr;
                    if (row < M && col < N) {
                        float v = acc[i][j][e];
                        if (ACT == 1) v = tanhf(v); else if (ACT == 2) v = 1.0f / (1.0f + expf(-v)); else if (ACT == 3) v = v > 0.f ? v * v : 0.f;
                        float* cp = C + (size_t)row * ldc + col; *cp = ACC ? *cp + v : v;
                    }
                }
    }
}

#define MRUN(ph, l) do { ph(c, l, gtid, gsz); xcd_barrier(bar); } while (0)
#define MGEMM(ACT, ACC, A, lda, B, ldb, C, ldc, M, N, K) do { gemm_dev<ACT, ACC>(A, lda, B, ldb, C, ldc, M, N, K, As, Bs); xcd_barrier(bar); } while (0)
#define KS_FFN 16
#define KS_1K 4
#define KS_MB 8
#ifndef ACC_KSPLIT
#define ACC_KSPLIT 1
#endif
#ifndef FFN_DOWN_KSPLIT
#define FFN_DOWN_KSPLIT 1
#endif
#define GBAR() xcd_barrier(bar)
#ifndef PROBE_DUP
#define PROBE_DUP 0
#endif
#define DUP(bit, ...) do { __VA_ARGS__; if (PROBE_DUP & (1 << (bit))) { GBAR(); __VA_ARGS__; } } while (0)
#define GTID_NOW() ((size_t)blockIdx.x * 512 + tid_now())
#define GSZ_NOW() ((size_t)gridDim.x * 512)
#define GW_NOW() ((int)(blockIdx.x * 8 + (tid_now() >> 6)))
#define NGW_NOW() ((int)(gridDim.x * 8))
#define LANE_NOW() ((int)(tid_now() & 63))
#undef MRUN
#undef MGEMM
#define MRUN(ph, l) do { ph(c, l, GTID_NOW(), GSZ_NOW()); xcd_barrier(bar); } while (0)
#define MGEMM(ACT, ACC, A, lda, B, ldb, C, ldc, M, N, K) do { gemm_dev<ACT, ACC>(A, lda, B, ldb, C, ldc, M, N, K, (unsigned short (*)[40])dynlds, (unsigned short (*)[40])(dynlds + 128 * 40 * 2)); xcd_barrier(bar); } while (0)
extern __shared__ __attribute__((aligned(16))) unsigned char dynlds[];

struct MegaArgs { Ctx c; Fast f; FastMla fm; FastRw fr; FastMb fb; unsigned* bar; };
constexpr int LDS_STAGE = 0, LDS_XB = 163840 - 64, LDS_BYTES = 163840;
static_assert(SD_END <= LDS_XB && SS_END <= LDS_XB && RC_END <= LDS_XB, "LDS map");

template <int L>
__device__ __forceinline__ void layer_mix_naive(const Ctx& c, const XcdBarrier& bar) {
    using namespace cfg;
    constexpr int l = L, kind = L % 3, j = L / 3;
    MRUN(ph_norm_mix, l);
    if constexpr (kind == 0) {
        MRUN(ph_rw_mix, l);
        const float* W = c.in[I_WRKV] + (size_t)j * 3 * D * D;
        MGEMM(0, false, c.xm[0], D, W, D, c.r, D, MTOT, D, D);
        MGEMM(0, false, c.xm[1], D, W + (size_t)D * D, D, c.k, D, MTOT, D, D);
        MGEMM(0, false, c.xm[2], D, W + (size_t)2 * D * D, D, c.v, D, MTOT, D, D);
        MGEMM(1, false, c.xm[3], D, c.in[I_W1] + (size_t)j * D * RW_DL, RW_DL, c.hw, RW_DL, MTOT, RW_DL, D);
        MGEMM(0, false, c.hw, RW_DL, c.in[I_W2] + (size_t)j * RW_DL * D, D, c.wpre, D, MTOT, D, RW_DL);
        MGEMM(0, false, c.xm[4], D, c.in[I_A1] + (size_t)j * D * RW_AL, RW_AL, c.ha, RW_AL, MTOT, RW_AL, D);
        MGEMM(0, false, c.ha, RW_AL, c.in[I_A2] + (size_t)j * RW_AL * D, D, c.apre, D, MTOT, D, RW_AL);
        if constexpr (j > 0) {
            MGEMM(0, false, c.xm[2], D, c.in[I_V1] + (size_t)(j - 1) * D * RW_VL, RW_VL, c.hv, RW_VL, MTOT, RW_VL, D);
            MGEMM(0, false, c.hv, RW_VL, c.in[I_V2] + (size_t)(j - 1) * RW_VL * D, D, c.vpre, D, MTOT, D, RW_VL);
        }
        MGEMM(2, false, c.xm[5], D, c.in[I_G1] + (size_t)j * D * RW_GL, RW_GL, c.hg, RW_GL, MTOT, RW_GL, D);
        MGEMM(0, false, c.hg, RW_GL, c.in[I_G2] + (size_t)j * RW_GL * D, D, c.g, D, MTOT, D, RW_GL);
        MRUN(ph_rw_prep, l); MRUN(ph_rw_scan, l); MRUN(ph_rw_post, l);
        MGEMM(0, true, c.yo, D, c.in[I_RWO] + (size_t)j * D * D, D, c.x, D, MTOT, D, D);
    } else if constexpr (kind == 1) {
        MGEMM(0, false, c.xn, D, c.in[I_MWIN] + (size_t)j * D * MLA_IN, MLA_IN, c.mh, MLA_IN, MTOT, MLA_IN, D);
        MRUN(ph_mla_norm1, l);
        MGEMM(0, false, c.qan, QL, c.in[I_WUQ] + (size_t)j * QL * MH * QD, MH * QD, c.q, MH * QD, MTOT, MH * QD, QL);
        MGEMM(0, false, c.c, KVL, c.in[I_WUK] + (size_t)j * KVL * MH * NOPE, MH * NOPE, c.knr, MH * NOPE, MTOT, MH * NOPE, KVL);
        MGEMM(0, false, c.c, KVL, c.in[I_WUV] + (size_t)j * KVL * MH * VD, MH * VD, c.vv, MH * VD, MTOT, MH * VD, KVL);
        MRUN(ph_mla_norm2, l); MRUN(ph_mla_attn_prompt, l); MRUN(ph_mla_score_sample, l); MRUN(ph_mla_softmax_sample, l); MRUN(ph_mla_pv_sample, l); MRUN(ph_mla_out_sample, l);
        MGEMM(0, true, c.ao, MH * VD, c.in[I_MWO] + (size_t)j * MH * VD * D, D, c.x, D, MTOT, D, MH * VD);
    } else {
        MGEMM(0, false, c.xn, D, c.in[I_BWIN] + (size_t)j * D * MB_IN, MB_IN, c.zx, MB_IN, MTOT, MB_IN, D);
        MRUN(ph_mb_conv, l); MRUN(ph_mb_dt, l); MRUN(ph_mb_scan, l); MRUN(ph_mb_gate, l);
        MGEMM(0, true, c.yzn, MB_INNER, c.in[I_BWO] + (size_t)j * MB_INNER * D, D, c.x, D, MTOT, D, MB_INNER);
    }
}


template <int L>
__device__ __forceinline__ void layer_rwkv_fast(const Ctx& c, const Fast& f, const FastRw& fr, const XcdBarrier& bar, LDSP unsigned char* lds) {
    using namespace cfg;
    constexpr int l = L, j = L / 3;
    if (L > 0) { fold_sample_rows(c.x, f.slab, KS_FFN, GW_NOW(), NGW_NOW(), LANE_NOW()); GBAR(); }
    DUP(9, rw_mix_fast(c, fr, l, GW_NOW(), NGW_NOW(), LANE_NOW()));
    GBAR();
    DUP(7, { pg8::Order<RwSel> S; S.init(MP / 256, MS / 256, 16, D, 1, gridDim.x, blockIdx.x);
      pg8::gemm_phase(lds, pg8::Gemm{fr.xm, fr.wrkvt + (size_t)j * 4096 * D, D, D, (size_t)MTOT * D}, S, EpiRwkv{fr.rkv, fr.hb}); });
    GBAR();
    DUP(2, rw_scan_chunked<j>(c, fr, lds));
    GBAR();
    { pg8::Order<> S; S.init(MP / 256, MS / 256, 4, D, KS_1K, gridDim.x, blockIdx.x);
      pg8::gemm_phase(lds, pg8::Gemm{fr.yo, fr.wot + (size_t)j * D * D, D, D, 0}, S, pg8::EpiAccF32{c.x, D, f.slab, MP / 256, MS / 256, KS_1K}); }
    if (PROBE_DUP & (1 << 26)) { GBAR(); pg8::Order<> S; S.init(MP / 256, MS / 256, 4, D, KS_1K, gridDim.x, blockIdx.x);
      pg8::gemm_phase(lds, pg8::Gemm{fr.yo, fr.wot + (size_t)j * D * D, D, D, 0}, S, pg8::EpiAccF32{c.hmid, D, f.slab + (size_t)16 * 16 * 65536, MP / 256, MS / 256, KS_1K}); }
    GBAR();
}

__device__ __forceinline__ void layer_mamba_fast(const Ctx& c, const Fast& f, const FastMb& fb, const XcdBarrier& bar, LDSP unsigned char* lds) {
    using namespace cfg;
    constexpr int l = 2, j = 0;
    norm_rows_bf16(c.x, c.in[I_NMIX] + l * D, f.xnb, f.slab, KS_FFN, GW_NOW(), NGW_NOW(), LANE_NOW());
    GBAR();
    DUP(8, { pg8::Order<> S; S.init(MP / 256, MS / 256, 21, D, 1, gridDim.x, blockIdx.x);
      pg8::gemm_phase(lds, pg8::Gemm{f.xnb, fb.wbint, D, D, 0}, S, EpiMamba{fb.zb, fb.xbcr, fb.dtraw}); });
    GBAR();
    DUP(12, mb_conv_fast(c, fb, l, GTID_NOW(), GSZ_NOW(), false));
    GBAR();
    DUP(6, mb_ssd_prompt(c, fb, l, lds); mb_scan_sample(c, fb, l));
    GBAR();
    DUP(13, mb_gate_fast(c, fb, fb.y, l, GW_NOW(), NGW_NOW(), LANE_NOW()));
    GBAR();
    { pg8::Order<> S; S.init(MP / 256, MS / 256, 4, MB_INNER, KS_MB, gridDim.x, blockIdx.x);
      pg8::gemm_phase(lds, pg8::Gemm{fb.yzn, fb.wbot, MB_INNER, MB_INNER, 0}, S, pg8::EpiAccF32{c.x, D, f.slab, MP / 256, MS / 256, KS_MB}); }
    if (PROBE_DUP & (1 << 28)) { GBAR(); pg8::Order<> S; S.init(MP / 256, MS / 256, 4, MB_INNER, KS_MB, gridDim.x, blockIdx.x);
      pg8::gemm_phase(lds, pg8::Gemm{fb.yzn, fb.wbot, MB_INNER, MB_INNER, 0}, S, pg8::EpiAccF32{c.hmid, D, f.slab + (size_t)16 * 16 * 65536, MP / 256, MS / 256, KS_MB}); }
    GBAR();
}

__device__ __forceinline__ void layer_mla_fast(const Ctx& c, const Fast& f, const FastMla& fm, const XcdBarrier& bar, LDSP unsigned char* lds) {
    using namespace cfg;
    constexpr int l = 1, j = 0;
    norm_rows_bf16(c.x, c.in[I_NMIX] + l * D, f.xnb, f.slab, KS_FFN, GW_NOW(), NGW_NOW(), LANE_NOW());
    GBAR();
    DUP(27, { pg8::Order<> S; S.init(MP / 256, MS / 256, 4, D, 1, gridDim.x, blockIdx.x);
      pg8::gemm_phase(lds, pg8::Gemm{f.xnb, fm.wint, D, D, 0}, S, pg8::EpiF32{fm.mh, 1024, 1024}); });
    GBAR();
    DUP(14, mla_norm1_fast(c, fm, j, GW_NOW(), NGW_NOW(), LANE_NOW()));
    GBAR();
    DUP(27, { pg8::Order<> S; S.init(MP / 256, MS / 256, (MH * QD) / 256, QL, 1, gridDim.x, blockIdx.x);
      pg8::gemm_phase(lds, pg8::Gemm{fm.qan, fm.wuqt, QL, QL, 0}, S, pg8::EpiBf16<0>{fm.qraw, MH * QD}); }
    { pg8::Order<> S; S.init(MP / 256, MS / 256, 4, KVL, 1, gridDim.x, blockIdx.x);
      pg8::gemm_phase(lds, pg8::Gemm{fm.cb, fm.wukvt, KVL, KVL, 0}, S, pg8::EpiBf16<0>{fm.kvraw, 2048}); }
    { pg8::Order<> S; S.init(4, 0, MTOT / 256, KVL, 1, gridDim.x, blockIdx.x);
      pg8::gemm_phase(lds, pg8::Gemm{fm.wukvt + (size_t)1024 * KVL, fm.cb, KVL, KVL, 0}, S, pg8::EpiBf16<0>{fm.vT, MTOT}); });
    GBAR();
    DUP(15, mla_norm2_fast(c, fm, j, GW_NOW(), NGW_NOW(), LANE_NOW()));
    { const unsigned t_ = (unsigned)GTID_NOW(); if (t_ < 96) *(pg8::u32x4*)(fm.qs + (size_t)MS * 1536 + t_ * 8) = (pg8::u32x4){0u, 0u, 0u, 0u}; }
    GBAR();
    DUP(5, attn_prompt_fast(fm.qf, fm.knb, fm.kpb, fm.vT, fm.aob, lds));
    __syncthreads();
    DUP(4, mla_sample_decode(c, fm, fm.qs, fm.opart, fm.lpart, j, lds));
    GBAR();
    DUP(16, mla_sample_combine(c, fm, fm.opart, fm.lpart, j, lds));
    GBAR();
    { pg8::Order<> S; S.init(MP / 256, MS / 256, 4, D, KS_1K, gridDim.x, blockIdx.x);
      pg8::gemm_phase(lds, pg8::Gemm{fm.aob, fm.wot, D, D, 0}, S, pg8::EpiAccF32{c.x, D, f.slab, MP / 256, MS / 256, KS_1K}); }
    if (PROBE_DUP & (1 << 27)) { GBAR(); pg8::Order<> S; S.init(MP / 256, MS / 256, 4, D, KS_1K, gridDim.x, blockIdx.x);
      pg8::gemm_phase(lds, pg8::Gemm{fm.aob, fm.wot, D, D, 0}, S, pg8::EpiAccF32{c.hmid, D, f.slab + (size_t)16 * 16 * 65536, MP / 256, MS / 256, KS_1K}); }
    GBAR();
}

template <int L>
__device__ __forceinline__ void layer_ffn_fast(const Ctx& c, const Fast& f, const XcdBarrier& bar, LDSP unsigned char* lds) {
    using namespace cfg;
    norm_rows_bf16(c.x, c.in[I_NFFN] + L * D, f.xnb, f.slab, (L % 3 == 2) ? KS_MB : KS_1K, GW_NOW(), NGW_NOW(), LANE_NOW());
    GBAR();
    DUP(0, { pg8::Order<> S; S.init(MP / 256, MS / 256, FFN / 256, D, 1, gridDim.x, blockIdx.x);
      pg8::gemm_phase(lds, pg8::Gemm{f.xnb, f.w1t + (size_t)L * FFN * D, D, D, 0}, S, pg8::EpiBf16<3>{f.hmidb, FFN}); });
    GBAR();
    { pg8::Order<> S; S.init(MP / 256, MS / 256, D / 256, FFN, (L == DEPTH - 1) ? 1 : KS_FFN, gridDim.x, blockIdx.x);
      pg8::gemm_phase(lds, pg8::Gemm{f.hmidb, f.w2t + (size_t)L * D * FFN, FFN, FFN, 0}, S, pg8::EpiAccF32{c.x, D, f.slab, MP / 256, MS / 256, (L == DEPTH - 1) ? 1 : KS_FFN}); }
    if (PROBE_DUP & (1 << 25)) { GBAR(); pg8::Order<> S; S.init(MP / 256, MS / 256, D / 256, FFN, (L == DEPTH - 1) ? 1 : KS_FFN, gridDim.x, blockIdx.x);
      pg8::gemm_phase(lds, pg8::Gemm{f.hmidb, f.w2t + (size_t)L * D * FFN, FFN, FFN, 0}, S, pg8::EpiAccF32{c.hmid, D, f.slab + (size_t)16 * 16 * 65536, MP / 256, MS / 256, (L == DEPTH - 1) ? 1 : KS_FFN}); }
    GBAR();
}

__global__ void __launch_bounds__(512, 2) mega10(MegaArgs a) {
    LDSP unsigned char* lds = (LDSP unsigned char*)dynlds;
    if (threadIdx.x < 4) ((LDSP unsigned*)(lds + LDS_XB))[threadIdx.x] = 0u;
    __syncthreads();
    XcdBarrier bar = xcd_barrier_post(a.bar, (volatile LAS unsigned*)(lds + LDS_XB));
    const Ctx& c = a.c; const Fast& f = a.f; const FastMla& fm = a.fm; const FastRw& fr = a.fr; const FastMb& fb = a.fb;
    using namespace cfg;
    DUP(10, {
        LDSP float* scr = (LDSP float*)(lds + LDS_STAGE) + (tid_now() >> 6) * (64 * 33);
        for (int l = 0; l < DEPTH; ++l) {
            tr_weight(c.in[I_FW1] + (size_t)l * D * FFN, D, FFN, FFN, f.w1t + (size_t)l * FFN * D, nullptr, scr, GW_NOW(), NGW_NOW(), LANE_NOW());
            tr_weight(c.in[I_FW2] + (size_t)l * FFN * D, FFN, D, D, f.w2t + (size_t)l * D * FFN, nullptr, scr, GW_NOW(), NGW_NOW(), LANE_NOW());
        }
        tr_weight(c.in[I_MWIN], D, MLA_IN, 1024, fm.wint, nullptr, scr, GW_NOW(), NGW_NOW(), LANE_NOW());
        tr_weight(c.in[I_WUQ], QL, MH * QD, MH * QD, fm.wuqt, nullptr, scr, GW_NOW(), NGW_NOW(), LANE_NOW());
        tr_weight(c.in[I_WUK], KVL, MH * NOPE, MH * NOPE, fm.wukvt, nullptr, scr, GW_NOW(), NGW_NOW(), LANE_NOW());
        tr_weight(c.in[I_WUV], KVL, MH * VD, MH * VD, fm.wukvt + (size_t)1024 * KVL, nullptr, scr, GW_NOW(), NGW_NOW(), LANE_NOW());
        tr_weight(c.in[I_MWO], MH * VD, D, D, fm.wot, nullptr, scr, GW_NOW(), NGW_NOW(), LANE_NOW());
        for (int j = 0; j < N_RWKV; ++j) {
            bf16_t* wt = fr.wrkvt + (size_t)j * 4096 * D;
            for (int p = 0; p < 3; ++p) tr_weight(c.in[I_WRKV] + ((size_t)j * 3 + p) * D * D, D, D, D, wt + (size_t)p * D * D, nullptr, scr, GW_NOW(), NGW_NOW(), LANE_NOW());
            tr_weight(c.in[I_W1] + (size_t)j * D * RW_DL, D, RW_DL, 256, wt + (size_t)3072 * D, nullptr, scr, GW_NOW(), NGW_NOW(), LANE_NOW());
            tr_weight(c.in[I_A1] + (size_t)j * D * RW_AL, D, RW_AL, 256, wt + (size_t)3328 * D, nullptr, scr, GW_NOW(), NGW_NOW(), LANE_NOW());
            tr_weight(c.in[I_G1] + (size_t)j * D * RW_GL, D, RW_GL, 256, wt + (size_t)3584 * D, nullptr, scr, GW_NOW(), NGW_NOW(), LANE_NOW());
            tr_weight(j > 0 ? c.in[I_V1] + (size_t)(j - 1) * D * RW_VL : c.in[I_W1], D, j > 0 ? RW_VL : 0, 256, wt + (size_t)3840 * D, nullptr, scr, GW_NOW(), NGW_NOW(), LANE_NOW());
            tr_weight(c.in[I_RWO] + (size_t)j * D * D, D, D, D, fr.wot + (size_t)j * D * D, nullptr, scr, GW_NOW(), NGW_NOW(), LANE_NOW());
            rw_build_lorat(c, fr.lorat + (size_t)j * 4096 * 384, j, GTID_NOW(), GSZ_NOW());
        }
        tr_weight(c.in[I_BWIN], D, MB_IN, 5376, fb.wbint, nullptr, scr, GW_NOW(), NGW_NOW(), LANE_NOW());
        tr_weight(c.in[I_BWO], MB_INNER, D, D, fb.wbot, nullptr, scr, GW_NOW(), NGW_NOW(), LANE_NOW());
        ph_copy_x(c, 0, GTID_NOW(), GSZ_NOW());
    });
    GBAR();
    layer_rwkv_fast<0>(c, f, fr, bar, lds); layer_ffn_fast<0>(c, f, bar, lds);
    layer_mla_fast(c, f, fm, bar, lds); layer_ffn_fast<1>(c, f, bar, lds);
    layer_mamba_fast(c, f, fb, bar, lds); layer_ffn_fast<2>(c, f, bar, lds);
    layer_rwkv_fast<3>(c, f, fr, bar, lds); layer_ffn_fast<3>(c, f, bar, lds);
}

extern "C" void kernel_launch(void* const* d_in, const int* in_sizes, int n_in, void* d_out, int out_size, void* d_ws, size_t ws_size, hipStream_t stream) {
    using namespace cfg;
    MegaArgs a{};
    size_t used = setup_ctx(a.c, d_in, d_out, d_ws);
    { Bump b{(char*)d_ws, (size_t)((char*)a.c.xm[0] - (char*)d_ws)}; FastRw& r = a.fr;
      r.xm = (bf16_t*)b.f((size_t)6 * MTOT * D / 2); r.rkv = (bf16_t*)b.f((size_t)MTOT * 3072 / 2); r.hb = (bf16_t*)b.f((size_t)MTOT * 384 / 2); r.lu = (bf16_t*)b.f((size_t)MTOT * 4096 / 2);
      r.ops = b.f((size_t)MTOT * RHEADS * RW_REC + 4096); r.yo = (bf16_t*)b.f((size_t)MTOT * D / 2); r.vf = a.c.vf;
      if (b.off > (size_t)((char*)a.c.hmid - (char*)d_ws) + (size_t)MTOT * FFN * 4) { fprintf(stderr, "RWKV overlay too large\n"); return; } }
    { Bump b{(char*)d_ws, used};
      a.f.xnb = (bf16_t*)b.f((size_t)MTOT * D / 2); a.f.hmidb = (bf16_t*)b.f((size_t)MTOT * FFN / 2);
      a.f.w1t = (bf16_t*)b.f((size_t)DEPTH * FFN * D / 2); a.f.w2t = (bf16_t*)b.f((size_t)DEPTH * FFN * D / 2); a.f.slab = b.f((size_t)2 * 16 * 16 * 65536);
      FastMla& m = a.fm;
      m.mh = b.f((size_t)MTOT * 1024); m.qan = (bf16_t*)b.f((size_t)MTOT * QL / 2); m.cb = (bf16_t*)b.f((size_t)MTOT * KVL / 2); m.kpb = (bf16_t*)b.f((size_t)MTOT * ROPE / 2);
      m.qraw = (bf16_t*)b.f((size_t)MTOT * 1536 / 2); m.kvraw = (bf16_t*)b.f((size_t)MTOT * 2048 / 2); m.qf = (bf16_t*)b.f((size_t)MTOT * 1536 / 2); m.knb = (bf16_t*)b.f((size_t)MTOT * 1024 / 2);
      m.aob = (bf16_t*)b.f((size_t)MTOT * 1024 / 2); m.vT = (bf16_t*)b.f((size_t)MTOT * 1024 / 2); m.qs = (bf16_t*)b.f((size_t)MS * 1536 / 2 + 1024);
      m.opart = b.f((size_t)2 * DB * 128 * 256); m.lpart = b.f((size_t)2 * DB * 128);
      m.wint = (bf16_t*)b.f((size_t)1024 * 1024 / 2); m.wuqt = (bf16_t*)b.f((size_t)1536 * 512 / 2); m.wukvt = (bf16_t*)b.f((size_t)2048 * 256 / 2); m.wot = (bf16_t*)b.f((size_t)1024 * 1024 / 2);
      { FastMb& q = a.fb; q.zb = (bf16_t*)b.f((size_t)MTOT * 2048 / 2); q.xbcr = (bf16_t*)b.f((size_t)MTOT * 3072 / 2); q.dtraw = b.f((size_t)MTOT * 32); q.xbcb = (bf16_t*)b.f((size_t)MTOT * 3072 / 2);
        q.dt = b.f((size_t)MTOT * 32); q.y = a.c.my; q.yzn = (bf16_t*)b.f((size_t)MTOT * 2048 / 2); q.wbint = (bf16_t*)b.f((size_t)5376 * 1024 / 2); q.wbot = (bf16_t*)b.f((size_t)1024 * 2048 / 2); }
      a.fr.wrkvt = (bf16_t*)b.f((size_t)N_RWKV * 4096 * D / 2); a.fr.lorat = (bf16_t*)b.f((size_t)N_RWKV * 4096 * 384 / 2); a.fr.wot = (bf16_t*)b.f((size_t)N_RWKV * D * D / 2);
      used = b.off; }
    if (used > ws_size || n_in != 51) { fprintf(stderr, "workspace too small: need %zu have %zu (n_in %d)\n", used, ws_size, n_in); return; }
    a.bar = (unsigned*)d_ws;
    static int grid = 0;
    if (!grid) {
        int dev = 0, cus = 0, per_cu = 0;
        (void)hipGetDevice(&dev); (void)hipDeviceGetAttribute(&cus, hipDeviceAttributeMultiprocessorCount, dev);
        if (hipFuncSetAttribute((const void*)mega10, hipFuncAttributeMaxDynamicSharedMemorySize, LDS_BYTES) != hipSuccess) { fprintf(stderr, "hipFuncSetAttribute failed\n"); grid = -1; return; }
        (void)hipOccupancyMaxActiveBlocksPerMultiprocessor(&per_cu, (const void*)mega10, 512, LDS_BYTES);
        (void)hipGetLastError();
        grid = per_cu >= 1 ? (cus < 256 ? cus : 256) : -1;
    }
    if (grid <= 0) { fprintf(stderr, "kernel does not fit one workgroup per CU\n"); return; }
    (void)hipMemsetAsync(a.bar, 0, XCD_BAR_WORDS * sizeof(unsigned), stream);
    hipLaunchKernelGGL(mega10, dim3(grid), dim3(512), LDS_BYTES, stream, a);
}
```

```cpp
#include <hip/hip_runtime.h>
#include <cstdio>
#include <math.h>
#include <stdint.h>
#include <stddef.h>
#ifdef CPU_EMU
#define DEV inline
#else
#define DEV __device__ __forceinline__
#endif

namespace cfg {
#ifdef CFG_SMALL
constexpr int D = 128, BATCH = 2, SEQ = 32, DEPTH = 4, DB = 3, DS = 8, PAST = 64, PAGE = 16;
constexpr int RW_DL = 16, RW_AL = 16, RW_VL = 8, RW_GL = 24;
constexpr int MH = 2, QL = 64, KVL = 32;
constexpr int MB_GROUPS = 2;
#else
constexpr int D = 1024, BATCH = 16, SEQ = 2048, DEPTH = 4, DB = 128, DS = 8, PAST = 8192, PAGE = 128;
constexpr int RW_DL = 64, RW_AL = 64, RW_VL = 32, RW_GL = 160;
constexpr int MH = 16, QL = 512, KVL = 256;
constexpr int MB_GROUPS = 4;
#endif
constexpr int N_RWKV = (DEPTH + 2) / 3, N_MLA = (DEPTH + 1) / 3, N_MAMBA = DEPTH / 3;
constexpr int RH = 64, RHEADS = D / RH;
constexpr int NOPE = 64, ROPE = 32, VD = 64, QD = NOPE + ROPE;
constexpr int MLA_IN = QL + KVL + ROPE;
constexpr int MB_INNER = 2 * D, MB_HEAD = 64, MB_HEADS = MB_INNER / MB_HEAD, MB_STATE = 128, MB_CONV = 4;
constexpr int MB_GN = MB_GROUPS * MB_STATE;
constexpr int MB_CD = MB_INNER + 2 * MB_GN, MB_IN = MB_INNER + MB_CD + MB_HEADS;
constexpr int FFN = 4 * D;
constexpr int NPAGES = PAST / PAGE, NPOOL = (DB * NPAGES * 5) / 4;
constexpr int MP = BATCH * SEQ, MS = DB * DS, MTOT = MP + MS, NSEQ = BATCH + DB;
constexpr int KTOT = PAST + DS;
constexpr float NORM_EPS = 1e-6f, LNX_EPS = 64e-5f;
constexpr size_t O_YP = 0;
constexpr size_t O_YS = O_YP + (size_t)MP * D;
constexpr size_t O_CKVP = O_YS + (size_t)MS * D;
constexpr size_t O_KPEP = O_CKVP + (size_t)N_MLA * MP * KVL;
constexpr size_t O_CKVS = O_KPEP + (size_t)N_MLA * MP * ROPE;
constexpr size_t O_KPES = O_CKVS + (size_t)N_MLA * MS * KVL;
constexpr size_t O_WKVP = O_KPES + (size_t)N_MLA * MS * ROPE;
constexpr size_t O_SHP = O_WKVP + (size_t)N_RWKV * BATCH * RHEADS * RH * RH;
constexpr size_t O_WKVS = O_SHP + (size_t)N_RWKV * BATCH * D;
constexpr size_t O_SHS = O_WKVS + (size_t)N_RWKV * DB * RHEADS * RH * RH;
constexpr size_t O_SSMP = O_SHS + (size_t)N_RWKV * DB * D;
constexpr size_t O_CONVP = O_SSMP + (size_t)N_MAMBA * BATCH * MB_HEADS * MB_HEAD * MB_STATE;
constexpr size_t O_SSMS = O_CONVP + (size_t)N_MAMBA * BATCH * (MB_CONV - 1) * MB_CD;
constexpr size_t O_CONVS = O_SSMS + (size_t)N_MAMBA * DB * MB_HEADS * MB_HEAD * MB_STATE;
constexpr size_t O_END = O_CONVS + (size_t)N_MAMBA * DB * (MB_CONV - 1) * MB_CD;
}

struct Ctx {
    const float* in[51];
    const int* page_table;
    float* out;
    float *x, *xn, *vf;
    float* xm[6];
    float *r, *k, *v, *wpre, *apre, *vpre, *g, *hw, *ha, *hv, *hg, *ka, *kb, *y, *yo;
    float *hmid;
    float *mh, *qan, *q, *c, *kp, *knr, *vv, *ao, *sc, *olat;
    float *zx, *xbc, *dt, *my, *yzn;
};

DEV int row_t(int m) { return m < cfg::MP ? m % cfg::SEQ : (m - cfg::MP) % cfg::DS; }
DEV int row_seq(int m) { return m < cfg::MP ? m / cfg::SEQ : cfg::BATCH + (m - cfg::MP) / cfg::DS; }
DEV int seq_row0(int sq) { return sq < cfg::BATCH ? sq * cfg::SEQ : cfg::MP + (sq - cfg::BATCH) * cfg::DS; }
DEV int seq_len(int sq) { return sq < cfg::BATCH ? cfg::SEQ : cfg::DS; }
DEV float sigmoidf_(float x) { return 1.0f / (1.0f + expf(-x)); }
DEV float softplusf_(float x) { return x > 20.f ? x : log1pf(expf(x)); }
DEV float siluf_(float x) { return x * sigmoidf_(x); }

enum { I_XP = 0, I_XS, I_CKV, I_KPE, I_WKV, I_SHIFT, I_SSM, I_CONV, I_PT, I_NMIX, I_NFFN, I_FW1, I_FW2, I_MU, I_WRKV, I_W0, I_W1, I_W2, I_A0, I_A1, I_A2,
       I_V0, I_V1, I_V2, I_G1, I_G2, I_KK, I_KA, I_RK, I_LNW, I_LNB, I_RWO, I_MWIN, I_QNORM, I_KVNORM, I_WUQ, I_WUK, I_WUV, I_QNN, I_QRN, I_KNN, I_KRN, I_MWO,
       I_BWIN, I_CONVW, I_CONVB, I_DTB, I_ALOG, I_BD, I_BNORM, I_BWO };

#define UNROLL _Pragma("unroll")
#define GSL(i, n) for (size_t i = gtid; i < (size_t)(n); i += gsz)

DEV void ph_copy_x(const Ctx& c, int, size_t gtid, size_t gsz) {
    using namespace cfg;
    GSL(i, (size_t)MTOT * D) c.x[i] = i < (size_t)MP * D ? c.in[I_XP][i] : c.in[I_XS][i - (size_t)MP * D];
}
DEV void rmsnorm_rows(const float* x, const float* gain, float* xn, size_t gtid, size_t gsz) {
    using namespace cfg;
    GSL(m, MTOT) {
        const float* xr = x + m * D; float ss = 0.f;
        for (int i = 0; i < D; ++i) ss += xr[i] * xr[i];
        const float rs = 1.0f / sqrtf(ss / D + NORM_EPS);
        for (int i = 0; i < D; ++i) xn[m * D + i] = xr[i] * rs * gain[i];
    }
}
DEV void ph_norm_mix(const Ctx& c, int l, size_t gtid, size_t gsz) { rmsnorm_rows(c.x, c.in[I_NMIX] + l * cfg::D, c.xn, gtid, gsz); }
DEV void ph_norm_ffn(const Ctx& c, int l, size_t gtid, size_t gsz) { rmsnorm_rows(c.x, c.in[I_NFFN] + l * cfg::D, c.xn, gtid, gsz); }

DEV void ph_rw_mix(const Ctx& c, int l, size_t gtid, size_t gsz) {
    using namespace cfg; const int j = l / 3;
    GSL(i, (size_t)MTOT * D) {
        const int m = (int)(i / D), ch = (int)(i % D), t = row_t(m), sq = row_seq(m);
        const float xc = c.xn[i];
        float xp;
        if (t > 0) xp = c.xn[i - D];
        else xp = sq < BATCH ? 0.f : c.in[I_SHIFT][((size_t)j * DB + (sq - BATCH)) * D + ch];
        for (int p = 0; p < 6; ++p) c.xm[p][i] = xc + (xp - xc) * c.in[I_MU][((size_t)j * 6 + p) * D + ch];
        if (t == seq_len(sq) - 1) {
            if (sq < BATCH) c.out[O_SHP + ((size_t)j * BATCH + sq) * D + ch] = xc;
            else c.out[O_SHS + ((size_t)j * DB + (sq - BATCH)) * D + ch] = xc;
        }
    }
}
DEV void ph_rw_prep(const Ctx& c, int l, size_t gtid, size_t gsz) {
    using namespace cfg; const int j = l / 3;
    GSL(i, (size_t)MTOT * RHEADS) {
        const int m = (int)(i / RHEADS), h = (int)(i % RHEADS);
        const size_t o = (size_t)m * D + h * RH;
        float nn = 0.f;
        for (int e = 0; e < RH; ++e) { const float kk = c.k[o + e] * c.in[I_KK][j * D + h * RH + e]; nn += kk * kk; }
        const float inv = 1.0f / fmaxf(sqrtf(nn), 1e-12f);
        for (int e = 0; e < RH; ++e) {
            const int ch = h * RH + e;
            const float wl = -softplusf_(-(c.in[I_W0][j * D + ch] + c.wpre[o + e])) - 0.5f;
            const float decay = expf(-expf(wl));
            float vv = c.v[o + e];
            if (j == 0) c.vf[o + e] = vv;
            else vv = vv + (c.vf[o + e] - vv) * sigmoidf_(c.in[I_V0][(j - 1) * D + ch] + c.vpre[o + e]);
            const float a = sigmoidf_(c.in[I_A0][j * D + ch] + c.apre[o + e]);
            const float k0 = c.k[o + e];
            const float kk = k0 * c.in[I_KK][j * D + ch] * inv;
            c.k[o + e] = k0 * (1.0f + (a - 1.0f) * c.in[I_KA][j * D + ch]);
            c.v[o + e] = vv;
            c.wpre[o + e] = decay;
            c.ka[o + e] = -kk;
            c.kb[o + e] = kk * a;
        }
    }
}
DEV void ph_rw_scan(const Ctx& c, int l, size_t gtid, size_t gsz) {
    using namespace cfg; const int j = l / 3;
    GSL(i, (size_t)NSEQ * RHEADS * RH) {
        const int sq = (int)(i / (RHEADS * RH)), h = (int)(i / RH) % RHEADS, vi = (int)(i % RH);
        float S[RH];
        if (sq < BATCH) { UNROLL for (int e = 0; e < RH; ++e) S[e] = 0.f; }
        else { const float* s0 = c.in[I_WKV] + ((((size_t)j * DB + (sq - BATCH)) * RHEADS + h) * RH + vi) * RH; UNROLL for (int e = 0; e < RH; ++e) S[e] = s0[e]; }
        const int m0 = seq_row0(sq), T = seq_len(sq);
        for (int t = 0; t < T; ++t) {
            const size_t o = (size_t)(m0 + t) * D + h * RH;
            float sa = 0.f;
            UNROLL for (int e = 0; e < RH; ++e) sa += S[e] * c.ka[o + e];
            const float vt = c.v[o + vi]; float yy = 0.f;
            UNROLL for (int e = 0; e < RH; ++e) { S[e] = S[e] * c.wpre[o + e] + sa * c.kb[o + e] + vt * c.k[o + e]; yy += S[e] * c.r[o + e]; }
            c.y[o + vi] = yy;
        }
        float* so = sq < BATCH ? c.out + O_WKVP + ((((size_t)j * BATCH + sq) * RHEADS + h) * RH + vi) * RH
                               : c.out + O_WKVS + ((((size_t)j * DB + (sq - BATCH)) * RHEADS + h) * RH + vi) * RH;
        UNROLL for (int e = 0; e < RH; ++e) so[e] = S[e];
    }
}
DEV void ph_rw_post(const Ctx& c, int l, size_t gtid, size_t gsz) {
    using namespace cfg; const int j = l / 3;
    GSL(i, (size_t)MTOT * RHEADS) {
        const int m = (int)(i / RHEADS), h = (int)(i % RHEADS);
        const size_t o = (size_t)m * D + h * RH;
        float mean = 0.f; for (int e = 0; e < RH; ++e) mean += c.y[o + e]; mean /= RH;
        float var = 0.f; for (int e = 0; e < RH; ++e) { const float d = c.y[o + e] - mean; var += d * d; } var /= RH;
        const float rs = 1.0f / sqrtf(var + LNX_EPS);
        float bonus = 0.f; for (int e = 0; e < RH; ++e) bonus += c.r[o + e] * c.k[o + e] * c.in[I_RK][(size_t)j * D + h * RH + e];
        for (int e = 0; e < RH; ++e) {
            const int ch = h * RH + e;
            const float yn = (c.y[o + e] - mean) * rs * c.in[I_LNW][j * D + ch] + c.in[I_LNB][j * D + ch];
            c.yo[o + e] = (yn + bonus * c.v[o + e]) * c.g[o + e];
        }
    }
}

DEV void rope_apply(const float* xin, float* xout, int pos) {
    using namespace cfg; const int half = ROPE / 2;
    UNROLL for (int i = 0; i < half; ++i) {
        const float inv = exp2f(-(float)i * (13.287712379549449f / half));
        const float ang = (float)pos * inv;
        const float kq = rintf(ang * 0.15915494309189535f);
        float rr = fmaf(-kq, 6.28125f, ang); rr = fmaf(-kq, 1.9353071795864769e-3f, rr);
        const float cs = __cosf(rr), sn = __sinf(rr);
        const float x1 = xin[i], x2 = xin[i + half];
        xout[i] = x1 * cs - x2 * sn; xout[i + half] = x2 * cs + x1 * sn;
    }
}
DEV int row_pos(int m) { return m < cfg::MP ? m % cfg::SEQ : cfg::PAST + (m - cfg::MP) % cfg::DS; }
DEV void ph_mla_norm1(const Ctx& c, int l, size_t gtid, size_t gsz) {
    using namespace cfg; const int j = l / 3;
    GSL(m, MTOT) {
        const float* h = c.mh + m * MLA_IN;
        float ss = 0.f; for (int i = 0; i < QL; ++i) ss += h[i] * h[i];
        float rs = 1.0f / sqrtf(ss / QL + NORM_EPS);
        for (int i = 0; i < QL; ++i) c.qan[m * QL + i] = h[i] * rs * c.in[I_QNORM][j * QL + i];
        ss = 0.f; for (int i = 0; i < KVL; ++i) ss += h[QL + i] * h[QL + i];
        rs = 1.0f / sqrtf(ss / KVL + NORM_EPS);
        float* co = m < (size_t)MP ? c.out + O_CKVP + ((size_t)j * MP + m) * KVL : c.out + O_CKVS + ((size_t)j * MS + (m - MP)) * KVL;
        for (int i = 0; i < KVL; ++i) { const float v = h[QL + i] * rs * c.in[I_KVNORM][j * KVL + i]; c.c[m * KVL + i] = v; co[i] = v; }
        ss = 0.f; UNROLL for (int i = 0; i < ROPE; ++i) ss += h[QL + KVL + i] * h[QL + KVL + i];
        rs = 1.0f / sqrtf(ss / ROPE + NORM_EPS);
        float tmp[ROPE], ro[ROPE];
        UNROLL for (int i = 0; i < ROPE; ++i) tmp[i] = h[QL + KVL + i] * rs * c.in[I_KRN][j * ROPE + i];
        rope_apply(tmp, ro, row_pos((int)m));
        float* ko = m < (size_t)MP ? c.out + O_KPEP + ((size_t)j * MP + m) * ROPE : c.out + O_KPES + ((size_t)j * MS + (m - MP)) * ROPE;
        UNROLL for (int i = 0; i < ROPE; ++i) { c.kp[m * ROPE + i] = ro[i]; ko[i] = ro[i]; }
    }
}
DEV void ph_mla_norm2(const Ctx& c, int l, size_t gtid, size_t gsz) {
    using namespace cfg; const int j = l / 3;
    GSL(i, (size_t)MTOT * MH) {
        const int m = (int)(i / MH), h = (int)(i % MH);
        float* q = c.q + (size_t)m * MH * QD + h * QD;
        float ss = 0.f; UNROLL for (int e = 0; e < NOPE; ++e) ss += q[e] * q[e];
        float rs = 1.0f / sqrtf(ss / NOPE + NORM_EPS);
        UNROLL for (int e = 0; e < NOPE; ++e) q[e] = q[e] * rs * c.in[I_QNN][j * NOPE + e];
        ss = 0.f; UNROLL for (int e = 0; e < ROPE; ++e) ss += q[NOPE + e] * q[NOPE + e];
        rs = 1.0f / sqrtf(ss / ROPE + NORM_EPS);
        float tmp[ROPE], ro[ROPE];
        UNROLL for (int e = 0; e < ROPE; ++e) tmp[e] = q[NOPE + e] * rs * c.in[I_QRN][j * ROPE + e];
        rope_apply(tmp, ro, row_pos(m));
        UNROLL for (int e = 0; e < ROPE; ++e) q[NOPE + e] = ro[e];
        float* kn = c.knr + (size_t)m * MH * NOPE + h * NOPE;
        ss = 0.f; UNROLL for (int e = 0; e < NOPE; ++e) ss += kn[e] * kn[e];
        rs = 1.0f / sqrtf(ss / NOPE + NORM_EPS);
        UNROLL for (int e = 0; e < NOPE; ++e) kn[e] = kn[e] * rs * c.in[I_KNN][j * NOPE + e];
    }
}
DEV void ph_mla_attn_prompt(const Ctx& c, int, size_t gtid, size_t gsz) {
    using namespace cfg; const float scale = 1.0f / sqrtf((float)QD);
    GSL(i, (size_t)MP * MH) {
        const int m = (int)(i / MH), h = (int)(i % MH), t = m % SEQ, m0 = m - t;
        const float* q = c.q + (size_t)m * MH * QD + h * QD;
        float mx = -INFINITY, den = 0.f, acc[VD];
        UNROLL for (int e = 0; e < VD; ++e) acc[e] = 0.f;
        for (int kx = 0; kx <= t; ++kx) {
            const int mk = m0 + kx;
            const float* kn = c.knr + (size_t)mk * MH * NOPE + h * NOPE; const float* kp = c.kp + (size_t)mk * ROPE;
            float s = 0.f;
            UNROLL for (int e = 0; e < NOPE; ++e) s += q[e] * kn[e];
            UNROLL for (int e = 0; e < ROPE; ++e) s += q[NOPE + e] * kp[e];
            s *= scale;
            const float nm = fmaxf(mx, s), corr = expf(mx - nm), p = expf(s - nm);
            den = den * corr + p;
            const float* v = c.vv + (size_t)mk * MH * VD + h * VD;
            UNROLL for (int e = 0; e < VD; ++e) acc[e] = acc[e] * corr + p * v[e];
            mx = nm;
        }
        UNROLL for (int e = 0; e < VD; ++e) c.ao[(size_t)m * MH * VD + h * VD + e] = acc[e] / den;
    }
}
DEV const float* smp_c(const Ctx& c, int j, int s, int pos) {
    using namespace cfg;
    if (pos < PAST) { const int pg = c.page_table[s * NPAGES + pos / PAGE]; return c.in[I_CKV] + (((size_t)j * NPOOL + pg) * PAGE + pos % PAGE) * KVL; }
    return c.c + (size_t)(MP + s * DS + (pos - PAST)) * KVL;
}
DEV const float* smp_kp(const Ctx& c, int j, int s, int pos) {
    using namespace cfg;
    if (pos < PAST) { const int pg = c.page_table[s * NPAGES + pos / PAGE]; return c.in[I_KPE] + (((size_t)j * NPOOL + pg) * PAGE + pos % PAGE) * ROPE; }
    return c.kp + (size_t)(MP + s * DS + (pos - PAST)) * ROPE;
}
DEV void ph_mla_score_sample(const Ctx& c, int l, size_t gtid, size_t gsz) {
    using namespace cfg; const int j = l / 3; const float scale = 1.0f / sqrtf((float)QD);
    GSL(i, (size_t)DB * KTOT * MH) {
        const int pos = (int)(i % KTOT), h = (int)((i / KTOT) % MH), s = (int)(i / ((size_t)MH * KTOT));
        const float* cl = smp_c(c, j, s, pos); const float* kp = smp_kp(c, j, s, pos);
        float kn[NOPE];
        UNROLL for (int e = 0; e < NOPE; ++e) kn[e] = 0.f;
        const float* wuk = c.in[I_WUK] + (size_t)j * KVL * MH * NOPE;
        for (int r = 0; r < KVL; ++r) { const float cv = cl[r]; const float* w = wuk + ((size_t)r * MH + h) * NOPE; UNROLL for (int e = 0; e < NOPE; ++e) kn[e] += cv * w[e]; }
        float ss = 0.f; UNROLL for (int e = 0; e < NOPE; ++e) ss += kn[e] * kn[e];
        const float rs = 1.0f / sqrtf(ss / NOPE + NORM_EPS);
        UNROLL for (int e = 0; e < NOPE; ++e) kn[e] = kn[e] * rs * c.in[I_KNN][j * NOPE + e];
        for (int qi = 0; qi < DS; ++qi) {
            const float* q = c.q + (size_t)(MP + s * DS + qi) * MH * QD + h * QD;
            float sc = 0.f;
            UNROLL for (int e = 0; e < NOPE; ++e) sc += q[e] * kn[e];
            UNROLL for (int e = 0; e < ROPE; ++e) sc += q[NOPE + e] * kp[e];
            const bool ok = pos < PAST || (pos - PAST) <= qi;
            c.sc[(((size_t)s * MH + h) * DS + qi) * KTOT + pos] = ok ? sc * scale : -INFINITY;
        }
    }
}
DEV void ph_mla_softmax_sample(const Ctx& c, int, size_t gtid, size_t gsz) {
    using namespace cfg;
    GSL(i, (size_t)DB * MH * DS) {
        float* sc = c.sc + i * KTOT;
        float mx = -INFINITY; for (int p = 0; p < KTOT; ++p) mx = fmaxf(mx, sc[p]);
        float den = 0.f; for (int p = 0; p < KTOT; ++p) den += expf(sc[p] - mx);
        const float inv = 1.0f / den;
        for (int p = 0; p < KTOT; ++p) sc[p] = expf(sc[p] - mx) * inv;
    }
}
DEV void ph_mla_pv_sample(const Ctx& c, int l, size_t gtid, size_t gsz) {
    using namespace cfg; const int j = l / 3;
    GSL(i, (size_t)DB * MH * DS * KVL) {
        const int r = (int)(i % KVL); const size_t row = i / KVL; const int s = (int)(row / (MH * DS));
        const float* p = c.sc + row * KTOT; float acc = 0.f;
        for (int pos = 0; pos < KTOT; ++pos) acc += p[pos] * smp_c(c, j, s, pos)[r];
        c.olat[i] = acc;
    }
}
DEV void ph_mla_out_sample(const Ctx& c, int l, size_t gtid, size_t gsz) {
    using namespace cfg; const int j = l / 3;
    GSL(i, (size_t)MS * MH * VD) {
        const int e = (int)(i % VD), h = (int)((i / VD) % MH), ms = (int)(i / (MH * VD)), s = ms / DS, qi = ms % DS;
        const float* ol = c.olat + (((size_t)s * MH + h) * DS + qi) * KVL;
        const float* wuv = c.in[I_WUV] + (size_t)j * KVL * MH * VD;
        float acc = 0.f;
        for (int r = 0; r < KVL; ++r) acc += ol[r] * wuv[((size_t)r * MH + h) * VD + e];
        c.ao[(size_t)(MP + ms) * MH * VD + h * VD + e] = acc;
    }
}

DEV float mb_xpad(const Ctx& c, int j, int m, int sq, int tt, int ch) {
    using namespace cfg;
    if (tt < MB_CONV - 1) return sq < BATCH ? 0.f : c.in[I_CONV][(((size_t)j * DB + (sq - BATCH)) * (MB_CONV - 1) + tt) * MB_CD + ch];
    (void)m; return c.zx[(size_t)(seq_row0(sq) + tt - (MB_CONV - 1)) * MB_IN + MB_INNER + ch];
}
DEV void ph_mb_conv(const Ctx& c, int l, size_t gtid, size_t gsz) {
    using namespace cfg; const int j = l / 3;
    GSL(i, (size_t)MTOT * MB_CD) {
        const int m = (int)(i / MB_CD), ch = (int)(i % MB_CD), t = row_t(m), sq = row_seq(m), T = seq_len(sq);
        float acc = c.in[I_CONVB][j * MB_CD + ch];
        for (int jj = 0; jj < MB_CONV; ++jj) acc += mb_xpad(c, j, m, sq, t + jj, ch) * c.in[I_CONVW][((size_t)j * MB_CONV + jj) * MB_CD + ch];
        c.xbc[i] = siluf_(acc);
        if (t < MB_CONV - 1) {
            const float v = mb_xpad(c, j, m, sq, T + t, ch);
            if (sq < BATCH) c.out[O_CONVP + (((size_t)j * BATCH + sq) * (MB_CONV - 1) + t) * MB_CD + ch] = v;
            else c.out[O_CONVS + (((size_t)j * DB + (sq - BATCH)) * (MB_CONV - 1) + t) * MB_CD + ch] = v;
        }
    }
}
DEV void ph_mb_dt(const Ctx& c, int l, size_t gtid, size_t gsz) {
    using namespace cfg; const int j = l / 3;
    GSL(i, (size_t)MTOT * MB_HEADS) {
        const int m = (int)(i / MB_HEADS), h = (int)(i % MB_HEADS);
        c.dt[i] = softplusf_(c.zx[(size_t)m * MB_IN + MB_INNER + MB_CD + h] + c.in[I_DTB][j * MB_HEADS + h]);
    }
}
DEV void ph_mb_scan(const Ctx& c, int l, size_t gtid, size_t gsz) {
    using namespace cfg; const int j = l / 3;
    GSL(i, (size_t)NSEQ * MB_HEADS * MB_HEAD) {
        const int p = (int)(i % MB_HEAD), h = (int)((i / MB_HEAD) % MB_HEADS), sq = (int)(i / (MB_HEADS * MB_HEAD));
        const int g = h / (MB_HEADS / MB_GROUPS);
        float hs[MB_STATE];
        if (sq < BATCH) { UNROLL for (int n = 0; n < MB_STATE; ++n) hs[n] = 0.f; }
        else { const float* s0 = c.in[I_SSM] + ((((size_t)j * DB + (sq - BATCH)) * MB_HEADS + h) * MB_HEAD + p) * MB_STATE; UNROLL for (int n = 0; n < MB_STATE; ++n) hs[n] = s0[n]; }
        const float A = -expf(c.in[I_ALOG][j * MB_HEADS + h]), dsk = c.in[I_BD][j * MB_HEADS + h];
        const int m0 = seq_row0(sq), T = seq_len(sq);
        for (int t = 0; t < T; ++t) {
            const size_t m = (size_t)(m0 + t);
            const float dtv = c.dt[m * MB_HEADS + h], dA = expf(dtv * A);
            const float xv = c.xbc[m * MB_CD + h * MB_HEAD + p], xdt = xv * dtv;
            const float* Bm = c.xbc + m * MB_CD + MB_INNER + g * MB_STATE; const float* Cm = Bm + MB_GN;
            float yy = 0.f;
            UNROLL for (int n = 0; n < MB_STATE; ++n) { hs[n] = hs[n] * dA + xdt * Bm[n]; yy += Cm[n] * hs[n]; }
            c.my[m * MB_INNER + h * MB_HEAD + p] = yy + dsk * xv;
        }
        float* so = sq < BATCH ? c.out + O_SSMP + ((((size_t)j * BATCH + sq) * MB_HEADS + h) * MB_HEAD + p) * MB_STATE
                               : c.out + O_SSMS + ((((size_t)j * DB + (sq - BATCH)) * MB_HEADS + h) * MB_HEAD + p) * MB_STATE;
        UNROLL for (int n = 0; n < MB_STATE; ++n) so[n] = hs[n];
    }
}
DEV void ph_mb_gate(const Ctx& c, int l, size_t gtid, size_t gsz) {
    using namespace cfg; const int j = l / 3; constexpr int GW = MB_INNER / MB_GROUPS;
    GSL(i, (size_t)MTOT * MB_GROUPS) {
        const int m = (int)(i / MB_GROUPS), g = (int)(i % MB_GROUPS);
        float ss = 0.f;
        for (int e = 0; e < GW; ++e) { const float v = c.my[(size_t)m * MB_INNER + g * GW + e] * siluf_(c.zx[(size_t)m * MB_IN + g * GW + e]); ss += v * v; }
        const float rs = 1.0f / sqrtf(ss / GW + NORM_EPS);
        for (int e = 0; e < GW; ++e) {
            const float v = c.my[(size_t)m * MB_INNER + g * GW + e] * siluf_(c.zx[(size_t)m * MB_IN + g * GW + e]);
            c.yzn[(size_t)m * MB_INNER + g * GW + e] = v * rs * c.in[I_BNORM][j * MB_INNER + g * GW + e];
        }
    }
}
typedef short bf16x8_t __attribute__((ext_vector_type(8)));
typedef float f32x4_t __attribute__((ext_vector_type(4)));
__device__ __forceinline__ unsigned short f2bf(float f) { unsigned u = __float_as_uint(f); u += 0x7fffu + ((u >> 16) & 1u); return (unsigned short)(u >> 16); }
#define XB_TMO      128
#define XB_XCNT(j)  (256  + 64 * (j))
#define XB_XSUB(j)  (1280 + 64 * (j))
#define XB_XGEN(j)  (2304 + 64 * (j))
#define XB_TOP      3328
#define XB_TOPGEN   3392
#define XCD_BAR_WORDS 3456
#define XB_SPIN_CAP (1u << 25)
#define LAS __attribute__((address_space(3)))

__device__ __forceinline__ unsigned xb_ld(unsigned* p)              { return __hip_atomic_load(p, __ATOMIC_RELAXED, __HIP_MEMORY_SCOPE_AGENT); }
__device__ __forceinline__ unsigned xb_add(unsigned* p, unsigned v) { return __hip_atomic_fetch_add(p, v, __ATOMIC_RELAXED, __HIP_MEMORY_SCOPE_AGENT); }
__device__ __forceinline__ unsigned xb_xcc_id() { return (unsigned)__builtin_amdgcn_s_getreg((3 << 11) | 20) & 0xFu; }
#define XB_SPIN(cond, bar) do { unsigned _sp = 0; while (cond) { __builtin_amdgcn_s_sleep(1); \
    if ((++_sp & 255u) == 0u) { if (xb_ld(&(bar)[XB_TMO])) break; if (_sp > XB_SPIN_CAP) { atomicAdd(&(bar)[XB_TMO], 1u); break; } } } } while (0)

struct XcdBarrier {
    unsigned* bar; unsigned x;
    volatile LAS unsigned* st;
};

__device__ __forceinline__ XcdBarrier xcd_barrier_post(unsigned* bar, volatile LAS unsigned* st) {
    XcdBarrier b; b.bar = bar; b.x = xb_xcc_id(); b.st = st;
    if (threadIdx.x == 0) (void)xb_add(&bar[XB_XCNT(b.x)], 1u);
    return b;
}
__device__ __forceinline__ void xcd_barrier_complete(unsigned* bar, unsigned x, unsigned& nloc, unsigned& nx) {
    const unsigned G = gridDim.x * gridDim.y * gridDim.z;
    unsigned sum, cnt, mine, sp = 0u;
    for (;;) {
        sum = 0u; cnt = 0u; mine = 0u;
#pragma unroll
        for (unsigned j = 0; j < 16; ++j) { const unsigned c = xb_ld(&bar[XB_XCNT(j)]); sum += c; cnt += (c > 0u) ? 1u : 0u; mine = (j == x) ? c : mine; }
        if (sum == G) break;
        __builtin_amdgcn_s_sleep(1);
        if ((++sp & 255u) == 0u) { if (xb_ld(&bar[XB_TMO])) break; if (sp > XB_SPIN_CAP) { atomicAdd(&bar[XB_TMO], 1u); break; } }
    }
    nloc = mine > 0u ? mine : 1u; nx = cnt > 0u ? cnt : 1u;
}

__device__ __forceinline__ void xcd_barrier(const XcdBarrier& b) {
    asm volatile("s_waitcnt vmcnt(0)" ::: "memory");
    __syncthreads();
    if (threadIdx.x == 0) {
        unsigned* bar = b.bar;
        __builtin_amdgcn_s_waitcnt(0);
        unsigned nloc = b.st[0], nx = b.st[1];
        if (nloc == 0u) { xcd_barrier_complete(bar, b.x, nloc, nx); b.st[0] = nloc; b.st[1] = nx; }
        const unsigned old = xb_add(&bar[XB_XSUB(b.x)], 1u);
        const unsigned gen = old / nloc;
        if (old + 1u == (gen + 1u) * nloc) {
            __builtin_amdgcn_fence(__ATOMIC_RELEASE, "agent");
            asm volatile("s_waitcnt vmcnt(0)" ::: "memory");
            const unsigned og = xb_add(&bar[XB_TOP], 1u);
            const unsigned tg = og / nx;
            if (og + 1u == (tg + 1u) * nx) xb_add(&bar[XB_TOPGEN], 1u);
            else XB_SPIN(xb_ld(&bar[XB_TOPGEN]) == tg, bar);
            __builtin_amdgcn_fence(__ATOMIC_ACQUIRE, "agent");
            xb_add(&bar[XB_XGEN(b.x)], 1u);
            asm volatile("s_waitcnt vmcnt(0)" ::: "memory");
        } else {
            XB_SPIN(xb_ld(&bar[XB_XGEN(b.x)]) == gen, bar);
            __builtin_amdgcn_fence(__ATOMIC_ACQUIRE, "agent");
            asm volatile("s_waitcnt vmcnt(0)" ::: "memory");
        }
    }
    __syncthreads();
}

struct Bump { char* p; size_t off; float* f(size_t n) { float* r = (float*)(p + off); off += ((n * 4 + 255) / 256) * 256; return r; } };

static size_t setup_ctx(Ctx& c, void* const* d_in, void* d_out, void* d_ws) {
    using namespace cfg;
    for (int i = 0; i < 51; ++i) c.in[i] = (const float*)d_in[i];
    c.page_table = (const int*)d_in[I_PT];
    c.out = (float*)d_out; c.x = c.out;
    Bump b{(char*)d_ws, 4096 * 4};
    const size_t MD = (size_t)MTOT * D;
    c.xn = b.f(MD); c.vf = b.f(MD);
    const size_t base = b.off;
    for (int p = 0; p < 6; ++p) c.xm[p] = b.f(MD);
    c.r = b.f(MD); c.k = b.f(MD); c.v = b.f(MD); c.wpre = b.f(MD); c.apre = b.f(MD); c.vpre = b.f(MD); c.g = b.f(MD);
    c.hw = b.f((size_t)MTOT * RW_DL); c.ha = b.f((size_t)MTOT * RW_AL); c.hv = b.f((size_t)MTOT * RW_VL); c.hg = b.f((size_t)MTOT * RW_GL);
    c.ka = b.f(MD); c.kb = b.f(MD); c.y = c.xm[0]; c.yo = c.xm[1];
    size_t hi = b.off;
    b.off = base;
    c.mh = b.f((size_t)MTOT * MLA_IN); c.qan = b.f((size_t)MTOT * QL); c.q = b.f((size_t)MTOT * MH * QD); c.c = b.f((size_t)MTOT * KVL); c.kp = b.f((size_t)MTOT * ROPE);
    c.knr = b.f((size_t)MTOT * MH * NOPE); c.vv = b.f((size_t)MTOT * MH * VD); c.ao = b.f((size_t)MTOT * MH * VD);
    c.sc = b.f((size_t)DB * MH * DS * KTOT); c.olat = b.f((size_t)DB * MH * DS * KVL);
    if (b.off > hi) hi = b.off;
    b.off = base;
    c.zx = b.f((size_t)MTOT * MB_IN); c.xbc = b.f((size_t)MTOT * MB_CD); c.dt = b.f((size_t)MTOT * MB_HEADS); c.my = b.f((size_t)MTOT * MB_INNER); c.yzn = b.f((size_t)MTOT * MB_INNER);
    if (b.off > hi) hi = b.off;
    b.off = hi;
    c.hmid = b.f((size_t)MTOT * FFN);
    return b.off;
}

__device__ __forceinline__ unsigned tid_now() { unsigned t = threadIdx.x; asm volatile("" : "+v"(t)); return t; }
namespace pg8 {
#define PG8_LAS __attribute__((address_space(3)))
typedef unsigned short bf16_t;
typedef short bf16x8 __attribute__((ext_vector_type(8)));
typedef float f32x4 __attribute__((ext_vector_type(4)));
typedef float f32x2 __attribute__((ext_vector_type(2)));
typedef unsigned u32x4 __attribute__((ext_vector_type(4)));
typedef unsigned u32x2 __attribute__((ext_vector_type(2)));
constexpr int BM = 256, BK = 64, HALF = 128, HTB = HALF * BK * 2  , STAGE_BYTES = 8 * HTB, NXCD = 8, WGM = 8;

__host__ __device__ __forceinline__ int lds_byte(int r, int c) { const int st = (r >> 4) * 2 + (c >> 5), rr = r & 15, cc = c & 31, ob = rr * 64 + cc * 2; return st * 1024 + (ob ^ (((ob >> 9) & 1) << 5)); }
__host__ __device__ __forceinline__ void stage_rc(int b, int& R, int& C) { const int st = b / 1024, sb = b % 1024, swz = sb ^ (((sb >> 9) & 1) << 5); R = (st >> 1) * 16 + swz / 64; C = (st & 1) * 32 + (swz % 64) / 2; }
__host__ __device__ __forceinline__ int perm32(int rho) { const int n = rho >> 4, i = rho & 15; return 8 * (i >> 2) + 4 * n + (i & 3); }
__device__ __forceinline__ unsigned cvt_pk_bf16(float lo, float hi) { unsigned r; asm volatile("v_cvt_pk_bf16_f32 %0, %1, %2" : "=v"(r) : "v"(lo), "v"(hi)); return r; }

struct Unit { int pm, pn, k0, nt, asel, part; };
struct Gemm { const bf16_t* A; const bf16_t* Bt; int lda, ldb; size_t asel_stride; };

struct NoSel { __device__ static __forceinline__ int sel(int) { return 0; } };
template <class ASEL = NoSel>
struct Order {
    int nMp, nMs, nN, nwgP, nwgS, G, c, K, ksplit;
    __device__ __forceinline__ void init(int nMp_, int nMs_, int nN_, int K_, int ksplit_, int G_, int c_) { nMp = nMp_; nMs = nMs_; nN = nN_; nwgP = nMp * nN; K = K_; ksplit = ksplit_; nwgS = nMs * nN * ksplit; G = G_; c = c_; }
    __device__ __forceinline__ bool next(int i, Unit& u) const {
        const long L = (long)i * G + c;
        if (L < nwgP) {
            int wgid = (int)L; { const int q = nwgP / NXCD, r = nwgP % NXCD, xcd = wgid % NXCD, off = wgid / NXCD; wgid = (xcd < r ? xcd * (q + 1) : r * (q + 1) + (xcd - r) * q) + off; }
            const int nig = WGM * nN, gid = wgid / nig, fm = gid * WGM, gsz = (nMp - fm) < WGM ? (nMp - fm) : WGM;
            u.pm = fm + ((wgid % nig) % gsz); u.pn = (wgid % nig) / gsz; u.k0 = 0; u.nt = K / BK; u.part = 0; u.asel = ASEL::sel(u.pn); return true;
        }
        const long Ls = L - nwgP; if (Ls >= nwgS) return false;
        const int sub = (int)(Ls % ksplit), t = (int)(Ls / ksplit);
        u.pm = nMp + t % nMs; u.pn = t / nMs; u.nt = K / BK / ksplit; u.k0 = sub * u.nt * BK; u.part = ksplit > 1 ? 1 : 0; u.asel = ASEL::sel(u.pn); return true;
    }
};

template <class Epi, class Sched>
__device__ __forceinline__ void gemm_phase(PG8_LAS unsigned char* lds, const Gemm g, const Sched& S, const Epi& E) {
    const int tid = (int)tid_now(), wid = __builtin_amdgcn_readfirstlane(tid >> 6), lane = tid & 63, wr = wid >> 2, wc = wid & 3, fr = lane & 15, fq = lane >> 4;
    unsigned voffA[2], voffB[2];
#pragma unroll
    for (int i = 0; i < 2; ++i) { int R, C; stage_rc(tid * 16 + i * 8192, R, C); const int Rb = Epi::PERM ? ((R & ~31) + perm32(R & 31)) : R;
        voffA[i] = (unsigned)(R * g.lda + C) * 2u; voffB[i] = (unsigned)(Rb * g.ldb + C) * 2u; }
    const size_t kstep = (size_t)(BK * 2);
    const size_t hstepA = (size_t)HALF * g.lda * 2, hstepB = (size_t)HALF * g.ldb * 2;
    const unsigned ldsw = (unsigned)wid * 1024u;
    const int aoff = lds_byte(wr * 64 + fr, fq * 8), boff = lds_byte(wc * 32 + fr, fq * 8);
#define PG8_SA(b, h) (((b) * 2 + (h)) * HTB)
#define PG8_SB(b, h) ((4 + (b) * 2 + (h)) * HTB)
#define PG8_STAGE(bufoff, gbase, voff) do { _Pragma("unroll") for (int _i = 0; _i < 2; ++_i) \
        __builtin_amdgcn_global_load_lds((const unsigned*)((const char*)(gbase) + (voff)[_i]), (PG8_LAS unsigned*)(lds + (bufoff) + ldsw + _i * 8192), 16, 0, 0); } while (0)
#define PG8_LDA(dst, b, h) do { _Pragma("unroll") for (int m = 0; m < 4; ++m) _Pragma("unroll") for (int k = 0; k < 2; ++k) dst[m][k] = *(const PG8_LAS bf16x8*)(lds + PG8_SA(b, h) + aoff + m * 2048 + k * 1024); } while (0)
#define PG8_LDB(dst, b, h) do { _Pragma("unroll") for (int n = 0; n < 2; ++n) _Pragma("unroll") for (int k = 0; k < 2; ++k) dst[n][k] = *(const PG8_LAS bf16x8*)(lds + PG8_SB(b, h) + boff + n * 2048 + k * 1024); } while (0)
#define PG8_MMA(ai, bj, At, Bt) do { __builtin_amdgcn_s_setprio(1); _Pragma("unroll") for (int m = 0; m < 4; ++m) _Pragma("unroll") for (int n = 0; n < 2; ++n) _Pragma("unroll") for (int k = 0; k < 2; ++k) \
        acc[ai][bj][m][n] = __builtin_amdgcn_mfma_f32_16x16x32_bf16(Bt[n][k], At[m][k], acc[ai][bj][m][n], 0, 0, 0); __builtin_amdgcn_s_setprio(0); } while (0)
#define PG8_WAIT_V(n) asm volatile("s_waitcnt vmcnt(" #n ")" ::: "memory")
#define PG8_WAIT_L(n) asm volatile("s_waitcnt lgkmcnt(" #n ")" ::: "memory")
#define PG8_BAR __builtin_amdgcn_s_barrier()
#define PG8_SCHED __builtin_amdgcn_sched_barrier(0)
#define PG8_ABASE(u) ((const char*)g.A + ((size_t)(u).asel * g.asel_stride + (size_t)(u).pm * BM * g.lda + (u).k0) * 2)
#define PG8_BBASE(u) ((const char*)g.Bt + ((size_t)(u).pn * BM * g.ldb + (u).k0) * 2)
    Unit cur, nxt; int ui = 0;
    if (!S.next(0, cur)) return;
    f32x4 acc[2][2][4][2];
#pragma unroll
    for (int a = 0; a < 2; ++a)
#pragma unroll
        for (int b = 0; b < 2; ++b)
#pragma unroll
            for (int m = 0; m < 4; ++m)
#pragma unroll
                for (int n = 0; n < 2; ++n) acc[a][b][m][n] = (f32x4){0.f, 0.f, 0.f, 0.f};
    bf16x8 At[4][2], B0[2][2], B1[2][2];
    const char* cA = PG8_ABASE(cur); const char* cB = PG8_BBASE(cur);
    PG8_STAGE(PG8_SB(0, 0), cB, voffB); PG8_STAGE(PG8_SA(0, 0), cA, voffA); PG8_STAGE(PG8_SB(0, 1), cB + hstepB, voffB); PG8_STAGE(PG8_SA(0, 1), cA + hstepA, voffA);
    if (wr == 1) PG8_BAR;
    PG8_WAIT_V(4); PG8_BAR;
    PG8_STAGE(PG8_SB(1, 0), cB + kstep, voffB); PG8_STAGE(PG8_SA(1, 0), cA + kstep, voffA); PG8_STAGE(PG8_SB(1, 1), cB + hstepB + kstep, voffB);
    PG8_WAIT_V(6); PG8_BAR;
    for (;;) {
        const bool has_next = S.next(ui + 1, nxt);
        const char* nA = has_next ? PG8_ABASE(nxt) : cA; const char* nB = has_next ? PG8_BBASE(nxt) : cB;
        const int nt = cur.nt;
        for (int t = 0; t < nt; t += 2) {
            const bool last = (t == nt - 2);
            const char* a1 = cA + (size_t)(t + 1) * kstep;
            const char* a2 = last ? nA : cA + (size_t)(t + 2) * kstep; const char* b2 = last ? nB : cB + (size_t)(t + 2) * kstep;
            const char* a3 = a2 + kstep; const char* b3 = b2 + kstep;
            PG8_LDB(B0, 0, 0); PG8_SCHED; PG8_LDA(At, 0, 0); PG8_STAGE(PG8_SA(1, 1), a1 + hstepA, voffA);
            PG8_WAIT_L(8); PG8_BAR; PG8_WAIT_L(0); PG8_MMA(0, 0, At, B0); PG8_BAR; PG8_SCHED;
            PG8_LDB(B1, 0, 1); PG8_STAGE(PG8_SB(0, 0), b2, voffB);
            PG8_BAR; PG8_WAIT_L(0); PG8_MMA(0, 1, At, B1); PG8_BAR;
            PG8_LDA(At, 0, 1); PG8_STAGE(PG8_SA(0, 0), a2, voffA);
            PG8_BAR; PG8_WAIT_L(0); PG8_MMA(1, 0, At, B0); PG8_BAR; PG8_SCHED;
            PG8_STAGE(PG8_SB(0, 1), b2 + hstepB, voffB);
            PG8_WAIT_V(6); PG8_BAR; PG8_MMA(1, 1, At, B1); PG8_BAR;
            PG8_LDB(B0, 1, 0); PG8_SCHED; PG8_LDA(At, 1, 0); PG8_STAGE(PG8_SA(0, 1), a2 + hstepA, voffA);
            PG8_WAIT_L(8); PG8_BAR; PG8_WAIT_L(0); PG8_MMA(0, 0, At, B0); PG8_BAR; PG8_SCHED;
            PG8_LDB(B1, 1, 1); PG8_STAGE(PG8_SB(1, 0), b3, voffB);
            PG8_BAR; PG8_WAIT_L(0); PG8_MMA(0, 1, At, B1); PG8_BAR;
            PG8_LDA(At, 1, 1); PG8_STAGE(PG8_SA(1, 0), a3, voffA);
            PG8_BAR; PG8_WAIT_L(0); PG8_MMA(1, 0, At, B0); PG8_BAR; PG8_SCHED;
            PG8_STAGE(PG8_SB(1, 1), b3 + hstepB, voffB);
            PG8_WAIT_V(6); PG8_BAR; PG8_MMA(1, 1, At, B1); PG8_BAR;
        }
        E(acc, cur, wr, wc, fr, fq);
        if (!has_next) break;
#pragma unroll
        for (int a = 0; a < 2; ++a)
#pragma unroll
            for (int b = 0; b < 2; ++b)
#pragma unroll
                for (int m = 0; m < 4; ++m)
#pragma unroll
                    for (int n = 0; n < 2; ++n) acc[a][b][m][n] = (f32x4){0.f, 0.f, 0.f, 0.f};
        cur = nxt; cA = nA; cB = nB; ++ui;
    }
    PG8_WAIT_V(0);
    if (wr == 0) PG8_BAR;
    PG8_BAR;
#undef PG8_SA
#undef PG8_SB
#undef PG8_STAGE
#undef PG8_LDA
#undef PG8_LDB
#undef PG8_MMA
#undef PG8_WAIT_V
#undef PG8_WAIT_L
#undef PG8_BAR
#undef PG8_SCHED
#undef PG8_ABASE
#undef PG8_BBASE
}

struct EpiAccF32 {
    static constexpr bool PERM = false;
    float* C; int ldc; float* slab; int pm0, nMs, ksplit;
    __device__ __forceinline__ void operator()(const f32x4 (&acc)[2][2][4][2], const Unit& u, int wr, int wc, int fr, int fq) const {
        if (u.part) {
            float* sl = slab + ((size_t)((u.pn * nMs + (u.pm - pm0)) * ksplit + u.k0 / (u.nt * BK)) * BM + wr * 64 + fr) * BM + wc * 32 + 4 * fq;
#pragma unroll
            for (int ai = 0; ai < 2; ++ai)
#pragma unroll
                for (int m = 0; m < 4; ++m) { float* rowp = sl + (size_t)(ai * HALF + m * 16) * BM;
#pragma unroll
                    for (int bj = 0; bj < 2; ++bj)
#pragma unroll
                        for (int n = 0; n < 2; ++n) *(f32x4*)(rowp + bj * HALF + n * 16) = acc[ai][bj][m][n]; }
        } else {
            const int row0 = u.pm * BM + wr * 64 + fr, col0 = u.pn * BM + wc * 32 + 4 * fq;
#pragma unroll
            for (int ai = 0; ai < 2; ++ai)
#pragma unroll
                for (int m2 = 0; m2 < 4; m2 += 2) {
                    f32x4 t[2][2][2];
#pragma unroll
                    for (int mm = 0; mm < 2; ++mm) { const float* rowp = C + (size_t)(row0 + ai * HALF + (m2 + mm) * 16) * ldc + col0;
#pragma unroll
                        for (int bj = 0; bj < 2; ++bj)
#pragma unroll
                            for (int n = 0; n < 2; ++n) t[mm][bj][n] = *(const f32x4*)(rowp + bj * HALF + n * 16); }
#pragma unroll
                    for (int mm = 0; mm < 2; ++mm) { float* rowp = C + (size_t)(row0 + ai * HALF + (m2 + mm) * 16) * ldc + col0;
#pragma unroll
                        for (int bj = 0; bj < 2; ++bj)
#pragma unroll
                            for (int n = 0; n < 2; ++n) *(f32x4*)(rowp + bj * HALF + n * 16) = t[mm][bj][n] + acc[ai][bj][m2 + mm][n]; }
                }
        }
    }
};
struct EpiF32 {
    static constexpr bool PERM = false;
    float* C; int ldc; int ncols;
    __device__ __forceinline__ void operator()(const f32x4 (&acc)[2][2][4][2], const Unit& u, int wr, int wc, int fr, int fq) const {
        const int row0 = u.pm * BM + wr * 64 + fr, col0 = u.pn * BM + wc * 32 + 4 * fq;
#pragma unroll
        for (int ai = 0; ai < 2; ++ai)
#pragma unroll
            for (int m = 0; m < 4; ++m) { float* rowp = C + (size_t)(row0 + ai * HALF + m * 16) * ldc + col0;
#pragma unroll
                for (int bj = 0; bj < 2; ++bj)
#pragma unroll
                    for (int n = 0; n < 2; ++n) if (col0 + bj * HALF + n * 16 < ncols) *(f32x4*)(rowp + bj * HALF + n * 16) = acc[ai][bj][m][n]; }
    }
};
template <int ACT> struct EpiBf16 {
    static constexpr bool PERM = true;
    bf16_t* O; int ldc;
    __device__ __forceinline__ void operator()(const f32x4 (&acc)[2][2][4][2], const Unit& u, int wr, int wc, int fr, int fq) const {
        const int row0 = u.pm * BM + wr * 64 + fr, col0 = u.pn * BM + wc * 32 + 8 * fq;
#pragma unroll
        for (int ai = 0; ai < 2; ++ai)
#pragma unroll
            for (int m = 0; m < 4; ++m) { bf16_t* rowp = O + (size_t)(row0 + ai * HALF + m * 16) * ldc + col0;
#pragma unroll
                for (int bj = 0; bj < 2; ++bj) { f32x4 v0 = acc[ai][bj][m][0], v1 = acc[ai][bj][m][1];
                    if (ACT == 3) {
#pragma unroll
                        for (int j = 0; j < 4; ++j) { const float a = fmaxf(v0[j], 0.f), b = fmaxf(v1[j], 0.f); v0[j] = a * a; v1[j] = b * b; } }
                    u32x4 w; w.x = cvt_pk_bf16(v0[0], v0[1]); w.y = cvt_pk_bf16(v0[2], v0[3]); w.z = cvt_pk_bf16(v1[0], v1[1]); w.w = cvt_pk_bf16(v1[2], v1[3]);
                    *(u32x4*)(rowp + bj * HALF) = w; } }
    }
};
}
typedef pg8::bf16_t bf16_t;
#define LDSP __attribute__((address_space(3)))
struct Fast {
    bf16_t *xnb, *hmidb;
    bf16_t *w1t, *w2t;
    float* slab;
};
__device__ __forceinline__ unsigned pk2bf(float lo, float hi) { return pg8::cvt_pk_bf16(lo, hi); }
__device__ __forceinline__ float wave_sum64(float v) {
#pragma unroll
    for (int o = 1; o < 64; o <<= 1) v += __shfl_xor(v, o);
    return v;
}
__device__ __forceinline__ void red16x4(float& a, float& b, float& c, float& d) {
    asm volatile("s_nop 1\n"
        "v_add_f32_dpp %0, %0, %0 quad_perm:[1,0,3,2] row_mask:0xf bank_mask:0xf\n" "v_add_f32_dpp %1, %1, %1 quad_perm:[1,0,3,2] row_mask:0xf bank_mask:0xf\n"
        "v_add_f32_dpp %2, %2, %2 quad_perm:[1,0,3,2] row_mask:0xf bank_mask:0xf\n" "v_add_f32_dpp %3, %3, %3 quad_perm:[1,0,3,2] row_mask:0xf bank_mask:0xf\n"
        "v_add_f32_dpp %0, %0, %0 quad_perm:[2,3,0,1] row_mask:0xf bank_mask:0xf\n" "v_add_f32_dpp %1, %1, %1 quad_perm:[2,3,0,1] row_mask:0xf bank_mask:0xf\n"
        "v_add_f32_dpp %2, %2, %2 quad_perm:[2,3,0,1] row_mask:0xf bank_mask:0xf\n" "v_add_f32_dpp %3, %3, %3 quad_perm:[2,3,0,1] row_mask:0xf bank_mask:0xf\n"
        "v_add_f32_dpp %0, %0, %0 row_ror:4 row_mask:0xf bank_mask:0xf\n" "v_add_f32_dpp %1, %1, %1 row_ror:4 row_mask:0xf bank_mask:0xf\n"
        "v_add_f32_dpp %2, %2, %2 row_ror:4 row_mask:0xf bank_mask:0xf\n" "v_add_f32_dpp %3, %3, %3 row_ror:4 row_mask:0xf bank_mask:0xf\n"
        "v_add_f32_dpp %0, %0, %0 row_ror:8 row_mask:0xf bank_mask:0xf\n" "v_add_f32_dpp %1, %1, %1 row_ror:8 row_mask:0xf bank_mask:0xf\n"
        "v_add_f32_dpp %2, %2, %2 row_ror:8 row_mask:0xf bank_mask:0xf\n" "v_add_f32_dpp %3, %3, %3 row_ror:8 row_mask:0xf bank_mask:0xf\n"
        "s_nop 1"
        : "+v"(a), "+v"(b), "+v"(c), "+v"(d));
}
__device__ __forceinline__ void tr_item(const float* __restrict__ W, int ldw, int K, bf16_t* WT, int nvalid, const float* __restrict__ kscale, LDSP float* scr, int item, int nblk, int lane) {
    const int kb = item / nblk, nb = item % nblk, k0 = 64 * kb, n0 = 32 * nb;
    const bool ok = n0 < nvalid;
#pragma unroll
    for (int i = 0; i < 8; ++i) { const int kk = 8 * i + (lane >> 3), nn = 4 * (lane & 7); pg8::f32x4 v = ok ? *(const pg8::f32x4*)(W + (size_t)(k0 + kk) * ldw + n0 + nn) : (pg8::f32x4){0.f, 0.f, 0.f, 0.f};
        if (kscale) v = v * kscale[k0 + kk];
        scr[kk * 33 + nn] = v[0]; scr[kk * 33 + nn + 1] = v[1]; scr[kk * 33 + nn + 2] = v[2]; scr[kk * 33 + nn + 3] = v[3]; }
    asm volatile("s_waitcnt lgkmcnt(0)" ::: "memory");
    const int c = lane & 7;
#pragma unroll
    for (int j = 0; j < 4; ++j) { const int n = (lane >> 3) + 8 * j; const LDSP float* s = scr + (8 * c) * 33 + n;
        pg8::u32x4 o; o.x = pk2bf(s[0 * 33], s[1 * 33]); o.y = pk2bf(s[2 * 33], s[3 * 33]); o.z = pk2bf(s[4 * 33], s[5 * 33]); o.w = pk2bf(s[6 * 33], s[7 * 33]);
        *(pg8::u32x4*)(WT + (size_t)(n0 + n) * K + k0 + 8 * c) = o; }
    asm volatile("s_waitcnt lgkmcnt(0)" ::: "memory");
}
__device__ __forceinline__ void tr_weight(const float* W, int K, int N, int npad, bf16_t* WT, const float* kscale, LDSP float* scr, int gw, int ngw, int lane) {
    const int nblk = npad / 32, items = (K / 64) * nblk;
    for (int it = gw; it < items; it += ngw) tr_item(W, N, K, WT, N, kscale, scr, it, nblk, lane);
}
constexpr int TRJ_W = 12;
struct TrTab { LDSP int* t; int n; int total; };
__device__ __forceinline__ void trj_put(TrTab& tb, const float* W, int K, int N, int npad, bf16_t* WT) {
    LDSP int* e = tb.t + tb.n * TRJ_W; const unsigned long long w = (unsigned long long)(size_t)W, o = (unsigned long long)(size_t)WT;
    const int nblk = npad / 32, items = (K / 64) * nblk;
    e[0] = (int)(unsigned)w; e[1] = (int)(unsigned)(w >> 32); e[2] = (int)(unsigned)o; e[3] = (int)(unsigned)(o >> 32); e[4] = N; e[5] = K; e[6] = N; e[7] = nblk; e[8] = tb.total; e[9] = tb.total + items;
    tb.total += items; ++tb.n;
}
struct TrCur { bf16_t* wt; int K, k0, n0; };
__device__ __forceinline__ bool trj_issue(LDSP const int* tab, int njobs, int idx, int& j, pg8::f32x4 (&v)[8], TrCur& t, int lane) {
    while (j < njobs && idx >= __builtin_amdgcn_readfirstlane(tab[j * TRJ_W + 9])) ++j;
    if (j >= njobs) return false;
    LDSP const int* e = tab + j * TRJ_W;
    const unsigned wl = __builtin_amdgcn_readfirstlane(e[0]), wh = __builtin_amdgcn_readfirstlane(e[1]), ol = __builtin_amdgcn_readfirstlane(e[2]), oh = __builtin_amdgcn_readfirstlane(e[3]);
    const int ldw = __builtin_amdgcn_readfirstlane(e[4]), K = __builtin_amdgcn_readfirstlane(e[5]), nvalid = __builtin_amdgcn_readfirstlane(e[6]), nblk = __builtin_amdgcn_readfirstlane(e[7]), it = idx - __builtin_amdgcn_readfirstlane(e[8]);
    const float* W = (const float*)(size_t)(((unsigned long long)wh << 32) | wl);
    const int kb = it / nblk, nb = it - kb * nblk, k0 = 64 * kb, n0 = 32 * nb;
    t.wt = (bf16_t*)(size_t)(((unsigned long long)oh << 32) | ol); t.K = K; t.k0 = k0; t.n0 = n0;
    const bool ok = n0 < nvalid;
#pragma unroll
    for (int i = 0; i < 8; ++i) { const int kk = 8 * i + (lane >> 3), nn = 4 * (lane & 7); v[i] = ok ? *(const pg8::f32x4*)(W + (size_t)(k0 + kk) * ldw + n0 + nn) : (pg8::f32x4){0.f, 0.f, 0.f, 0.f}; }
    return true;
}
__device__ __forceinline__ void trj_finish(const pg8::f32x4 (&v)[8], const TrCur& t, LDSP float* scr, int lane) {
#pragma unroll
    for (int i = 0; i < 8; ++i) { const int kk = 8 * i + (lane >> 3), nn = 4 * (lane & 7);
        scr[kk * 33 + nn] = v[i][0]; scr[kk * 33 + nn + 1] = v[i][1]; scr[kk * 33 + nn + 2] = v[i][2]; scr[kk * 33 + nn + 3] = v[i][3]; }
    asm volatile("s_waitcnt lgkmcnt(0)" ::: "memory");
    const int c = lane & 7;
#pragma unroll
    for (int j = 0; j < 4; ++j) { const int n = (lane >> 3) + 8 * j; const LDSP float* s = scr + (8 * c) * 33 + n;
        pg8::u32x4 o; o.x = pk2bf(s[0 * 33], s[1 * 33]); o.y = pk2bf(s[2 * 33], s[3 * 33]); o.z = pk2bf(s[4 * 33], s[5 * 33]); o.w = pk2bf(s[6 * 33], s[7 * 33]);
        *(pg8::u32x4*)(t.wt + (size_t)(t.n0 + n) * t.K + t.k0 + 8 * c) = o; }
    asm volatile("s_waitcnt lgkmcnt(0)" ::: "memory");
}
__device__ __forceinline__ void trj_run(LDSP const int* tab, int njobs, int total, LDSP float* scr, int gw, int ngw, int lane) {
    int j = 0; pg8::f32x4 va[8], vb[8]; TrCur ta, tb;
    int idx = gw;
    bool have = idx < total && trj_issue(tab, njobs, idx, j, va, ta, lane);
    while (have) {
        idx += ngw; const bool hb = idx < total && trj_issue(tab, njobs, idx, j, vb, tb, lane);
        trj_finish(va, ta, scr, lane);
        if (!hb) break;
        idx += ngw; have = idx < total && trj_issue(tab, njobs, idx, j, va, ta, lane);
        trj_finish(vb, tb, scr, lane);
    }
}
__device__ __forceinline__ pg8::f32x4 slab_sum(const float* __restrict__ slab, int ksplit, int m, int q, int lane) {
    using namespace cfg; const int rs = m - MP, pms = rs >> 8, row = rs & 255;
    const float* p = slab + ((size_t)((q * (MS / 256) + pms) * ksplit) * 256 + row) * 256 + 4 * lane;
    pg8::f32x4 s = {0.f, 0.f, 0.f, 0.f};
    for (int k = 0; k < ksplit; ++k) s = s + *(const pg8::f32x4*)(p + (size_t)k * 65536);
    return s;
}
__device__ __forceinline__ void norm_rows_bf16(float* __restrict__ x, const float* __restrict__ gain, bf16_t* xn, const float* __restrict__ slab, int ksplit, int gw, int ngw, int lane) {
    using namespace cfg;
    pg8::f32x4 gv[4];
#pragma unroll
    for (int j = 0; j < 4; ++j) gv[j] = *(const pg8::f32x4*)(gain + 4 * lane + 256 * j);
    for (int m = gw; m < MTOT; m += ngw) {
        float* xr = x + (size_t)m * D; pg8::f32x4 v[4]; float s = 0.f;
#pragma unroll
        for (int j = 0; j < 4; ++j) { v[j] = *(const pg8::f32x4*)(xr + 4 * lane + 256 * j);
            if (ksplit > 1 && m >= MP) { v[j] = v[j] + slab_sum(slab, ksplit, m, j, lane); *(pg8::f32x4*)(xr + 4 * lane + 256 * j) = v[j]; }
            s += (v[j][0] * v[j][0] + v[j][1] * v[j][1]) + (v[j][2] * v[j][2] + v[j][3] * v[j][3]); }
        const float rs = 1.0f / sqrtf(wave_sum64(s) * (1.0f / D) + NORM_EPS);
#pragma unroll
        for (int j = 0; j < 4; ++j) { pg8::u32x2 o; o.x = pk2bf(v[j][0] * rs * gv[j][0], v[j][1] * rs * gv[j][1]); o.y = pk2bf(v[j][2] * rs * gv[j][2], v[j][3] * rs * gv[j][3]);
            *(pg8::u32x2*)(xn + (size_t)m * D + 4 * lane + 256 * j) = o; }
    }
}

__device__ __forceinline__ void fold_sample_rows(float* __restrict__ x, const float* __restrict__ slab, int ksplit, int gw, int ngw, int lane) {
    using namespace cfg;
    for (int m = MP + gw; m < MTOT; m += ngw) {
#pragma unroll
        for (int j = 0; j < 4; ++j) { float* p = x + (size_t)m * D + 4 * lane + 256 * j; *(pg8::f32x4*)p = *(const pg8::f32x4*)p + slab_sum(slab, ksplit, m, j, lane); }
    }
}
struct FastMla {
    float* mh;
    bf16_t *qan, *cb, *kpb;
    bf16_t *qraw, *kvraw;
    bf16_t *qf, *knb, *aob, *vT, *qs;
    float *opart, *lpart;
    bf16_t *wint, *wuqt, *wukvt, *wot;
};
__device__ __forceinline__ void rope_cs(int pos, int i, float& cs, float& sn) {
    const float inv = exp2f(-(float)i * (13.287712379549449f / 16.0f));
    const float ang = (float)pos * inv, kq = rintf(ang * 0.15915494309189535f);
    float rr = fmaf(-kq, 6.28125f, ang); rr = fmaf(-kq, 1.9353071795864769e-3f, rr);
    cs = __cosf(rr); sn = __sinf(rr);
}
__device__ __forceinline__ float bf2f(unsigned short b) { return __uint_as_float(((unsigned)b) << 16); }
__device__ __forceinline__ void mla_norm1_fast(const Ctx& c, const FastMla& fm, int j, int gw, int ngw, int lane) {
    using namespace cfg;
    for (int m = gw; m < MTOT; m += ngw) {
        const float* h = fm.mh + (size_t)m * 1024;
        pg8::f32x4 qv[2]; float s = 0.f;
#pragma unroll
        for (int t = 0; t < 2; ++t) { qv[t] = *(const pg8::f32x4*)(h + 4 * lane + 256 * t); s += (qv[t][0] * qv[t][0] + qv[t][1] * qv[t][1]) + (qv[t][2] * qv[t][2] + qv[t][3] * qv[t][3]); }
        const float rq = 1.0f / sqrtf(wave_sum64(s) * (1.0f / QL) + NORM_EPS);
#pragma unroll
        for (int t = 0; t < 2; ++t) { const pg8::f32x4 g = *(const pg8::f32x4*)(c.in[I_QNORM] + j * QL + 4 * lane + 256 * t);
            pg8::u32x2 o; o.x = pk2bf(qv[t][0] * rq * g[0], qv[t][1] * rq * g[1]); o.y = pk2bf(qv[t][2] * rq * g[2], qv[t][3] * rq * g[3]);
            *(pg8::u32x2*)(fm.qan + (size_t)m * QL + 4 * lane + 256 * t) = o; }
        const pg8::f32x4 cv = *(const pg8::f32x4*)(h + QL + 4 * lane);
        const float rc = 1.0f / sqrtf(wave_sum64((cv[0] * cv[0] + cv[1] * cv[1]) + (cv[2] * cv[2] + cv[3] * cv[3])) * (1.0f / KVL) + NORM_EPS);
        const pg8::f32x4 gc = *(const pg8::f32x4*)(c.in[I_KVNORM] + j * KVL + 4 * lane);
        const pg8::f32x4 cn = {cv[0] * rc * gc[0], cv[1] * rc * gc[1], cv[2] * rc * gc[2], cv[3] * rc * gc[3]};
        float* co = m < MP ? c.out + O_CKVP + ((size_t)j * MP + m) * KVL : c.out + O_CKVS + ((size_t)j * MS + (m - MP)) * KVL;
        *(pg8::f32x4*)(co + 4 * lane) = cn;
        { pg8::u32x2 o; o.x = pk2bf(cn[0], cn[1]); o.y = pk2bf(cn[2], cn[3]); *(pg8::u32x2*)(fm.cb + (size_t)m * KVL + 4 * lane) = o; }
        const float kv = lane < ROPE ? h[QL + KVL + lane] : 0.f;
        const float rk = 1.0f / sqrtf(wave_sum64(kv * kv) * (1.0f / ROPE) + NORM_EPS);
        const float kn = kv * rk * (lane < ROPE ? c.in[I_KRN][j * ROPE + lane] : 0.f);
        const float other = __shfl_xor(kn, 16);
        float cs, sn; rope_cs(row_pos(m), lane & 15, cs, sn);
        const float ro = lane < 16 ? kn * cs - other * sn : kn * cs + other * sn;
        if (lane < ROPE) {
            float* ko = m < MP ? c.out + O_KPEP + ((size_t)j * MP + m) * ROPE : c.out + O_KPES + ((size_t)j * MS + (m - MP)) * ROPE;
            ko[lane] = ro;
            fm.kpb[(size_t)m * ROPE + lane] = (bf16_t)(pk2bf(ro, 0.f) & 0xffffu);
        }
    }
}
__device__ __forceinline__ void mla_norm2_fast(const Ctx& c, const FastMla& fm, int j, int gw, int ngw, int lane) {
    using namespace cfg;
    const int hd = lane >> 2, qt = lane & 3;
    const float QSC = 0.10206207261596575f * 1.4426950408889634f;
    for (int m = gw; m < MTOT; m += ngw) {
        const bf16_t* qr = fm.qraw + (size_t)m * (MH * QD) + hd * QD;
        float v[16]; float s = 0.f;
        { const pg8::u32x4 a = *(const pg8::u32x4*)(qr + 16 * qt), b = *(const pg8::u32x4*)(qr + 16 * qt + 8); const unsigned w[8] = {a.x, a.y, a.z, a.w, b.x, b.y, b.z, b.w};
#pragma unroll
          for (int i = 0; i < 8; ++i) { v[2 * i] = __uint_as_float(w[i] << 16); v[2 * i + 1] = __uint_as_float(w[i] & 0xffff0000u); } }
#pragma unroll
        for (int i = 0; i < 16; ++i) s += v[i] * v[i];
        s += __shfl_xor(s, 1); s += __shfl_xor(s, 2);
        float rs = 1.0f / sqrtf(s * (1.0f / NOPE) + NORM_EPS);
        bf16_t* qo = fm.qf + (size_t)m * (MH * QD) + hd * QD;
        { unsigned w[8], w2[8];
#pragma unroll
          for (int i = 0; i < 8; ++i) { const float a = v[2 * i] * rs * c.in[I_QNN][j * NOPE + 16 * qt + 2 * i], b = v[2 * i + 1] * rs * c.in[I_QNN][j * NOPE + 16 * qt + 2 * i + 1];
              w[i] = pk2bf(a * QSC, b * QSC);
              w2[i] = pk2bf(a * QSC * c.in[I_KNN][j * NOPE + 16 * qt + 2 * i], b * QSC * c.in[I_KNN][j * NOPE + 16 * qt + 2 * i + 1]); }
          *(pg8::u32x4*)(qo + 16 * qt) = (pg8::u32x4){w[0], w[1], w[2], w[3]}; *(pg8::u32x4*)(qo + 16 * qt + 8) = (pg8::u32x4){w[4], w[5], w[6], w[7]};
          if (m >= MP) { bf16_t* q2 = fm.qs + ((size_t)(((m - MP) >> 3) * MH + hd) * 6 + qt) * 128 + ((m - MP) & 7) * 8;
              *(pg8::u32x4*)(q2) = (pg8::u32x4){w2[0], w2[1], w2[4], w2[5]}; *(pg8::u32x4*)(q2 + 64) = (pg8::u32x4){w2[2], w2[3], w2[6], w2[7]}; } }
        float r8[8]; s = 0.f;
        { const pg8::u32x4 a = *(const pg8::u32x4*)(qr + NOPE + 8 * qt); const unsigned w[4] = {a.x, a.y, a.z, a.w};
#pragma unroll
          for (int i = 0; i < 4; ++i) { r8[2 * i] = __uint_as_float(w[i] << 16); r8[2 * i + 1] = __uint_as_float(w[i] & 0xffff0000u); } }
#pragma unroll
        for (int i = 0; i < 8; ++i) s += r8[i] * r8[i];
        s += __shfl_xor(s, 1); s += __shfl_xor(s, 2);
        rs = 1.0f / sqrtf(s * (1.0f / ROPE) + NORM_EPS);
        { unsigned w[4]; float o8[8];
#pragma unroll
          for (int i = 0; i < 8; ++i) { const float mine = r8[i] * rs * c.in[I_QRN][j * ROPE + 8 * qt + i]; const float oth = __shfl_xor(mine, 2);
              float cs, sn; rope_cs(row_pos(m), (8 * qt + i) & 15, cs, sn);
              o8[i] = qt < 2 ? mine * cs - oth * sn : mine * cs + oth * sn; }
#pragma unroll
          for (int i = 0; i < 4; ++i) w[i] = pk2bf(o8[2 * i] * QSC, o8[2 * i + 1] * QSC);
          *(pg8::u32x4*)(qo + NOPE + 8 * qt) = (pg8::u32x4){w[0], w[1], w[2], w[3]};
          if (m >= MP) *(pg8::u32x4*)(fm.qs + ((size_t)(((m - MP) >> 3) * MH + hd) * 6 + 4 + (qt >> 1)) * 128 + (qt & 1) * 64 + ((m - MP) & 7) * 8) = (pg8::u32x4){w[0], w[1], w[2], w[3]}; }
        const bf16_t* kr = fm.kvraw + (size_t)m * 2048 + hd * NOPE; s = 0.f;
        { const pg8::u32x4 a = *(const pg8::u32x4*)(kr + 16 * qt), b = *(const pg8::u32x4*)(kr + 16 * qt + 8); const unsigned w[8] = {a.x, a.y, a.z, a.w, b.x, b.y, b.z, b.w};
#pragma unroll
          for (int i = 0; i < 8; ++i) { v[2 * i] = __uint_as_float(w[i] << 16); v[2 * i + 1] = __uint_as_float(w[i] & 0xffff0000u); } }
#pragma unroll
        for (int i = 0; i < 16; ++i) s += v[i] * v[i];
        s += __shfl_xor(s, 1); s += __shfl_xor(s, 2);
        rs = 1.0f / sqrtf(s * (1.0f / NOPE) + NORM_EPS);
        bf16_t* ko = fm.knb + (size_t)m * (MH * NOPE) + hd * NOPE;
        { unsigned w[8];
#pragma unroll
          for (int i = 0; i < 8; ++i) { const float a = v[2 * i] * rs * c.in[I_KNN][j * NOPE + 16 * qt + 2 * i], b = v[2 * i + 1] * rs * c.in[I_KNN][j * NOPE + 16 * qt + 2 * i + 1];
              w[i] = pk2bf(a, b); }
          *(pg8::u32x4*)(ko + 16 * qt) = (pg8::u32x4){w[0], w[1], w[2], w[3]}; *(pg8::u32x4*)(ko + 16 * qt + 8) = (pg8::u32x4){w[4], w[5], w[6], w[7]}; }
    }
}
__device__ __forceinline__ void cvt_f32_bf16(const float* __restrict__ s, bf16_t* d, size_t n, size_t gtid, size_t gsz) {
    for (size_t i = gtid * 4; i < n; i += gsz * 4) { const pg8::f32x4 v = *(const pg8::f32x4*)(s + i); pg8::u32x2 o; o.x = pk2bf(v[0], v[1]); o.y = pk2bf(v[2], v[3]); *(pg8::u32x2*)(d + i) = o; }
}
typedef float f32x16_t __attribute__((ext_vector_type(16)));
typedef pg8::bf16x8 bf16x8v;
constexpr int AT_KROW = 208, AT_VROW = 136, AT_KBUF = 64 * AT_KROW, AT_VBUF = 64 * AT_VROW, AT_LDS = 2 * AT_KBUF + 2 * AT_VBUF;
__device__ __forceinline__ void attn_prompt_fast(const bf16_t* __restrict__ qf, const bf16_t* __restrict__ knb, const bf16_t* __restrict__ kpb, const bf16_t* __restrict__ vT, bf16_t* aob, LDSP unsigned char* lds) {
    using namespace cfg;
    const int tid = (int)tid_now(), w = __builtin_amdgcn_readfirstlane(tid >> 6), lane = tid & 63, l31 = lane & 31, h5 = lane >> 5;
    for (int it = blockIdx.x; it < BATCH * MH * 4; it += gridDim.x) {
        const int bh = it >> 2, pr = it & 3, b = bh / MH, h = bh % MH;
        for (int half = 0; half < 2; ++half) {
            const int qb = half ? 7 - pr : pr, q0 = 256 * qb, nt = 4 * qb + 4;
            const int qg = q0 + 32 * w + l31;
            const size_t mrow = (size_t)b * SEQ + qg;
            bf16x8v qfr[6];
#pragma unroll
            for (int s = 0; s < 6; ++s) qfr[s] = *(const bf16x8v*)(qf + mrow * (MH * QD) + h * QD + 16 * s + 8 * h5);
            f32x16_t O[2];
#pragma unroll
            for (int db = 0; db < 2; ++db)
#pragma unroll
                for (int r = 0; r < 16; ++r) O[db][r] = 0.f;
            float mrun = -1e30f, lrun = 0.f;
            pg8::u32x4 rk, rp, rv;
            const int kkey = tid >> 3, kc8 = tid & 7, pkey = tid >> 2, pc4 = tid & 3;
#define AT_LOAD(t) do { const size_t mk = (size_t)b * SEQ + 64 * (t); \
                rk = *(const pg8::u32x4*)(knb + (mk + kkey) * (MH * NOPE) + h * NOPE + kc8 * 8); \
                if (tid < 256) rp = *(const pg8::u32x4*)(kpb + (mk + pkey) * ROPE + pc4 * 8); \
                rv = *(const pg8::u32x4*)(vT + (size_t)(h * VD + kkey) * MTOT + mk + kc8 * 8); } while (0)
#define AT_STORE(buf) do { LDSP unsigned char* kb_ = lds + (buf) * AT_KBUF; LDSP unsigned char* vb_ = lds + 2 * AT_KBUF + (buf) * AT_VBUF; \
                *(LDSP pg8::u32x4*)(kb_ + kkey * AT_KROW + kc8 * 16) = rk; \
                if (tid < 256) *(LDSP pg8::u32x4*)(kb_ + pkey * AT_KROW + 128 + pc4 * 16) = rp; \
                *(LDSP pg8::u32x2*)(vb_ + kkey * AT_VROW + kc8 * 16) = (pg8::u32x2){rv.x, rv.y}; *(LDSP pg8::u32x2*)(vb_ + kkey * AT_VROW + kc8 * 16 + 8) = (pg8::u32x2){rv.z, rv.w}; } while (0)
            AT_LOAD(0); AT_STORE(0);
            __syncthreads();
            for (int t = 0; t < nt; ++t) {
                if (t + 1 < nt) AT_LOAD(t + 1);
                if (64 * t <= q0 + 32 * w + 31) {
                    const LDSP unsigned char* kb_ = lds + (t & 1) * AT_KBUF; const LDSP unsigned char* vb_ = lds + 2 * AT_KBUF + (t & 1) * AT_VBUF;
                    f32x16_t S[2];
#pragma unroll
                    for (int kb = 0; kb < 2; ++kb)
#pragma unroll
                        for (int r = 0; r < 16; ++r) S[kb][r] = 0.f;
#pragma unroll
                    for (int s = 0; s < 6; ++s)
#pragma unroll
                        for (int kb = 0; kb < 2; ++kb) {
                            const bf16x8v a = *(const LDSP bf16x8v*)(kb_ + (32 * kb + l31) * AT_KROW + (16 * s + 8 * h5) * 2);
                            S[kb] = __builtin_amdgcn_mfma_f32_32x32x16_bf16(a, qfr[s], S[kb], 0, 0, 0);
                        }
                    if (64 * t + 63 > q0 + 32 * w) {
#pragma unroll
                        for (int kb = 0; kb < 2; ++kb)
#pragma unroll
                            for (int r = 0; r < 16; ++r) { const int key = 64 * t + 32 * kb + (r & 3) + 8 * (r >> 2) + 4 * h5; if (key > qg) S[kb][r] = -1e30f; }
                    }
                    float mt = -1e30f;
#pragma unroll
                    for (int kb = 0; kb < 2; ++kb)
#pragma unroll
                        for (int r = 0; r < 16; ++r) mt = fmaxf(mt, S[kb][r]);
                    mt = fmaxf(mt, __shfl_xor(mt, 32));
                    const float mnew = fmaxf(mrun, mt), alpha = __builtin_amdgcn_exp2f(mrun - mnew);
                    float ls = 0.f;
#pragma unroll
                    for (int kb = 0; kb < 2; ++kb)
#pragma unroll
                        for (int r = 0; r < 16; ++r) { const float p = __builtin_amdgcn_exp2f(S[kb][r] - mnew); S[kb][r] = p; ls += p; }
                    lrun = lrun * alpha + ls; mrun = mnew;
#pragma unroll
                    for (int db = 0; db < 2; ++db)
#pragma unroll
                        for (int r = 0; r < 16; ++r) O[db][r] *= alpha;
#pragma unroll
                    for (int kb = 0; kb < 2; ++kb)
#pragma unroll
                        for (int s = 0; s < 2; ++s) {
                            pg8::u32x4 pw; pw.x = pk2bf(S[kb][8 * s + 0], S[kb][8 * s + 1]); pw.y = pk2bf(S[kb][8 * s + 2], S[kb][8 * s + 3]); pw.z = pk2bf(S[kb][8 * s + 4], S[kb][8 * s + 5]); pw.w = pk2bf(S[kb][8 * s + 6], S[kb][8 * s + 7]);
                            const bf16x8v pf = __builtin_bit_cast(bf16x8v, pw);
#pragma unroll
                            for (int db = 0; db < 2; ++db) {
                                const LDSP unsigned char* vp = vb_ + (32 * db + l31) * AT_VROW + (32 * kb + 16 * s + 4 * h5) * 2;
                                const pg8::u32x2 v0 = *(const LDSP pg8::u32x2*)vp, v1 = *(const LDSP pg8::u32x2*)(vp + 16);
                                const bf16x8v a = __builtin_bit_cast(bf16x8v, (pg8::u32x4){v0.x, v0.y, v1.x, v1.y});
                                O[db] = __builtin_amdgcn_mfma_f32_32x32x16_bf16(a, pf, O[db], 0, 0, 0);
                            }
                        }
                }
                if (t + 1 < nt) AT_STORE((t + 1) & 1);
                __syncthreads();
            }
#undef AT_LOAD
#undef AT_STORE
            const float inv = 1.0f / (lrun + __shfl_xor(lrun, 32));
            bf16_t* orow = aob + mrow * (MH * VD) + h * VD;
#pragma unroll
            for (int db = 0; db < 2; ++db)
#pragma unroll
                for (int g = 0; g < 4; ++g) { pg8::u32x2 o; o.x = pk2bf(O[db][4 * g] * inv, O[db][4 * g + 1] * inv); o.y = pk2bf(O[db][4 * g + 2] * inv, O[db][4 * g + 3] * inv);
                    *(pg8::u32x2*)(orow + 32 * db + 8 * g + 4 * h5) = o; }
        }
    }
}
constexpr int SD_CROW = 528, SD_WROW = 528, SD_PROW = 272;
constexpr int SD_CIMG = 0, SD_CIMG_SZ = 128 * SD_CROW;
constexpr int SD_WBUF = SD_CIMG + SD_CIMG_SZ, SD_WBUF_SZ = 32 * 1040;
constexpr int SD_XCH = SD_WBUF + 2 * SD_WBUF_SZ, SD_XCH_SZ = 4 * 5 * 64 * 4;
constexpr int SD_PIMG = SD_XCH + 2 * SD_XCH_SZ, SD_PIMG_SZ = 32 * SD_PROW;
constexpr int SD_END = SD_PIMG + 2 * SD_PIMG_SZ;
typedef short s16x4 __attribute__((ext_vector_type(4)));
#define MFMA32(a, b, c) __builtin_amdgcn_mfma_f32_32x32x16_bf16(a, b, c, 0, 0, 0)

__device__ __forceinline__ float mla_b2_bound(const Ctx& c, int j, int lane) {
    using namespace cfg;
    float gq = fabsf(c.in[I_QNN][j * NOPE + lane]), gk = fabsf(c.in[I_KNN][j * NOPE + lane]), gqr = fabsf(c.in[I_QRN][j * ROPE + (lane & 31)]), gkr = fabsf(c.in[I_KRN][j * ROPE + (lane & 31)]);
#pragma unroll
    for (int o = 1; o < 64; o <<= 1) { gq = fmaxf(gq, __shfl_xor(gq, o)); gk = fmaxf(gk, __shfl_xor(gk, o)); gqr = fmaxf(gqr, __shfl_xor(gqr, o)); gkr = fmaxf(gkr, __shfl_xor(gkr, o)); }
    return (64.f * gq * gk + 32.f * gqr * gkr) * (0.10206207261596575f * 1.4426950408889634f);
}

__device__ __forceinline__ void sd_pv_core(const int G, f32x16_t& Og, f32x16_t& Lacc, LDSP unsigned char* lds, int w, int lane, int l31, int h5) {
    asm volatile("" : "+v"(lane)); l31 = lane & 31; h5 = lane >> 5;
    const LDSP unsigned char* pimg = lds + SD_PIMG + (G & 1) * SD_PIMG_SZ;
    const unsigned onesw = (l31 == G) ? 0x3F803F80u : 0u;
    const bf16x8v onesv = __builtin_bit_cast(bf16x8v, (pg8::u32x4){onesw, onesw, onesw, onesw});
#pragma unroll
    for (int sp = 0; sp < 8; ++sp) {
        const bf16x8v a = *(const LDSP bf16x8v*)(pimg + l31 * SD_PROW + (16 * sp + 8 * h5) * 2);
        const int key0 = 16 * sp + 8 * h5 + ((lane & 15) >> 2), col = 32 * w + 16 * ((lane >> 4) & 1) + 4 * (lane & 3);
        const s16x4 t0 = __builtin_amdgcn_ds_read_tr16_b64_v4i16((LDSP s16x4*)(lds + SD_CIMG + key0 * SD_CROW + col * 2));
        const s16x4 t1 = __builtin_amdgcn_ds_read_tr16_b64_v4i16((LDSP s16x4*)(lds + SD_CIMG + (key0 + 4) * SD_CROW + col * 2));
        const bf16x8v b = (bf16x8v){t0[0], t0[1], t0[2], t0[3], t1[0], t1[1], t1[2], t1[3]};
        Og = MFMA32(a, b, Og);
        if (sp == w) Lacc = MFMA32(a, onesv, Lacc);
        if (sp & 1) __builtin_amdgcn_sched_barrier(0);
    }
}

__device__ __forceinline__ void sd_pv(const int G, f32x16_t& Og, f32x16_t& Lacc, LDSP unsigned char* lds, int w, int lane, int l31, int h5) {
    sd_pv_core(G, Og, Lacc, lds, w, lane, l31, h5);
#if defined(PROBE_DUP) && (PROBE_DUP & (1 << 21))
    f32x16_t D0, D1;
#pragma unroll
    for (int r = 0; r < 16; ++r) { D0[r] = 0.f; D1[r] = 0.f; }
    sd_pv_core(G, D0, D1, lds, w, lane, l31, h5); asm volatile("" :: "v"(D0), "v"(D1));
#endif
}
__device__ __forceinline__ void sd_glds16(const void* gsrc, unsigned lds_dst) {
    unsigned keep;
    asm volatile("s_mov_b32 %0, m0\n\ts_mov_b32 m0, %2\n\ts_nop 0\n\tglobal_load_lds_dwordx4 %1, off\n\ts_mov_b32 m0, %0" : "=&s"(keep) : "v"(gsrc), "s"(lds_dst) : "memory");
}
#define SD_WLOAD(h, buf) do { if (w >= 4) { const char* wsrc_ = (const char*)(fm.wukvt + (size_t)(h) * NOPE * KVL); int ln_ = lane; asm volatile("" : "+v"(ln_)); \
        const unsigned ldsb_ = __builtin_amdgcn_readfirstlane((unsigned)(size_t)(lds + SD_WBUF + (buf) * SD_WBUF_SZ)) + (unsigned)(8 * (w - 4)) * 1040u; \
        _Pragma("unroll") for (int k = 0; k < 8; ++k) { \
        const unsigned voff_ = (unsigned)(((8 * (w - 4) + k) + 32 * (ln_ >> 5)) * KVL + (ln_ & 31) * 8) * 2u; \
        sd_glds16(wsrc_ + voff_, ldsb_ + (unsigned)k * 1040u); } } } while (0)
template <int G, bool DOPV = true>
__device__ __forceinline__ void sd_group(const FastMla& fm, const bf16_t* __restrict__ qs, const int s, LDSP unsigned char* lds, const int w, const int lane, const int l31_, const int h5_, const int kb, const int dh, const int rot,
                                         const bf16x8v (&cfr)[16], const bf16x8v (&kpfr)[2], pg8::u32x4 (&wr)[4], f32x16_t (&O)[4], f32x16_t& Lacc, const float B2) {
    using namespace cfg;
        _Pragma("unroll 1") for (int hh = 0; hh < 4; ++hh) {
            const int h = (4 * G + hh + rot) & (MH - 1);
            int lane_ = lane; asm volatile("" : "+v"(lane_)); const int l31 = lane_ & 31, h5 = lane_ >> 5;
            { LDSP unsigned char* wdst = lds + SD_WBUF + ((h + 1) & 1) * SD_WBUF_SZ + (2 * w + h5) * 1040 + l31 * 16;
              *(LDSP pg8::u32x4*)(wdst) = wr[0]; *(LDSP pg8::u32x4*)(wdst + 16640) = wr[1]; *(LDSP pg8::u32x4*)(wdst + 512) = wr[2]; *(LDSP pg8::u32x4*)(wdst + 17152) = wr[3]; }
            const char* qb = (const char*)qs + (size_t)(s * MH + h) * 1536;
            const unsigned zoff = (unsigned)((DB * MH - (s * MH + h)) * 1536);
            const unsigned qlo = l31 < 8 ? (unsigned)(h5 * 128 + l31 * 16) : zoff;
            const bf16x8v qn0 = *(const bf16x8v*)(qb + dh * 512 + qlo), qn1 = *(const bf16x8v*)(qb + dh * 512 + 256 + qlo), qp0 = *(const bf16x8v*)(qb + 1024 + qlo), qp1 = *(const bf16x8v*)(qb + 1280 + qlo);
            { const char* wsrc = (const char*)(fm.wukvt + (size_t)((h + 2) & (MH - 1)) * NOPE * KVL) + (unsigned)(64 * w + lane_) * 16u;
#pragma unroll
              for (int k = 0; k < 4; ++k) wr[k] = *(const pg8::u32x4*)(wsrc + k * 8192); }
            f32x16_t KN;
#pragma unroll
            for (int r = 0; r < 16; ++r) KN[r] = 0.f;
            { const LDSP unsigned char* wb = lds + SD_WBUF + (h & 1) * SD_WBUF_SZ + l31 * 1040 + dh * 512 + h5 * 16;
#pragma unroll
              for (int s_ = 0; s_ < 16; ++s_) { const bf16x8v a = *(const LDSP bf16x8v*)(wb + 32 * s_); KN = MFMA32(a, cfr[s_], KN); if ((s_ & 3) == 3) __builtin_amdgcn_sched_barrier(0); } }
#if defined(PROBE_DUP) && (PROBE_DUP & (1 << 19))
            { const LDSP unsigned char* wb = lds + SD_WBUF + (h & 1) * SD_WBUF_SZ + l31 * 1040 + dh * 512 + h5 * 16;
#pragma unroll
              for (int s_ = 0; s_ < 16; ++s_) { const bf16x8v a = *(const LDSP bf16x8v*)(wb + 32 * s_); KN = MFMA32(a, cfr[s_], KN); if ((s_ & 3) == 3) __builtin_amdgcn_sched_barrier(0); }
#pragma unroll
              for (int r = 0; r < 16; ++r) KN[r] *= 0.5f; }
#endif
#if defined(PROBE_DUP) && (PROBE_DUP & (1 << 23))
            _Pragma("unroll 1") for (int rep_ = 0; rep_ < 2; ++rep_) {
            asm volatile("" : "+v"(KN));
#else
            {
#endif
            float ssq = 0.f;
#pragma unroll
            for (int r = 0; r < 16; ++r) ssq += KN[r] * KN[r];
            ssq += __shfl_xor(ssq, 32);
            {
            f32x16_t S;
#pragma unroll
            for (int r = 0; r < 16; ++r) S[r] = 0.f;
#pragma unroll
            for (int s_ = 0; s_ < 2; ++s_) { const bf16x8v kf = __builtin_bit_cast(bf16x8v, (pg8::u32x4){pk2bf(KN[8 * s_], KN[8 * s_ + 1]), pk2bf(KN[8 * s_ + 2], KN[8 * s_ + 3]), pk2bf(KN[8 * s_ + 4], KN[8 * s_ + 5]), pk2bf(KN[8 * s_ + 6], KN[8 * s_ + 7])});
                S = MFMA32(s_ == 0 ? qn0 : qn1, kf, S); }
            LDSP float* xch = (LDSP float*)(lds + SD_XCH + (h & 1) * SD_XCH_SZ) + kb * 320;
            if (dh == 1) { xch[lane_] = S[0]; xch[64 + lane_] = S[1]; xch[128 + lane_] = S[2]; xch[192 + lane_] = S[3]; xch[256 + lane_] = ssq; }
            asm volatile("s_waitcnt lgkmcnt(0)" ::: "memory");
            __builtin_amdgcn_s_barrier();
            asm volatile("" ::: "memory");
            if (dh == 0) {
                const float rstd = __builtin_amdgcn_rsqf((ssq + xch[256 + lane_]) * (1.0f / NOPE) + NORM_EPS);
                f32x16_t T;
#pragma unroll
                for (int r = 0; r < 16; ++r) T[r] = 0.f;
                T[0] = (S[0] + xch[lane_]) * rstd; T[1] = (S[1] + xch[64 + lane_]) * rstd; T[2] = (S[2] + xch[128 + lane_]) * rstd; T[3] = (S[3] + xch[192 + lane_]) * rstd;
                T = MFMA32(qp0, kpfr[0], T); T = MFMA32(qp1, kpfr[1], T);
                LDSP bf16_t* prow = (LDSP bf16_t*)(lds + SD_PIMG + (G & 1) * SD_PIMG_SZ + (hh * 8 + 4 * h5) * SD_PROW) + 32 * kb + l31;
#pragma unroll
                for (int q = 0; q < 4; ++q) prow[q * (SD_PROW / 2)] = (bf16_t)(pk2bf(exp2f(T[q] - B2), 0.f) & 0xffffu);
            }
            }
            }
        }
        if (G > 0 && DOPV) sd_pv(G > 0 ? G - 1 : 0, O[G > 0 ? G - 1 : 0], Lacc, lds, w, lane, l31_, h5_);
}

__device__ __forceinline__ void mla_sample_decode(const Ctx& c, const FastMla& fm, const bf16_t* __restrict__ qs, float* opart, float* lpart, int j, LDSP unsigned char* lds) {
    using namespace cfg;
    const int tid = (int)tid_now(), tid_ = tid, w = __builtin_amdgcn_readfirstlane(tid >> 6), lane = tid & 63, l31 = lane & 31, h5 = lane >> 5, kb = w & 3, dh = w >> 2;
    const float* ckv = c.in[I_CKV] + (size_t)j * NPOOL * PAGE * KVL; const float* kpe = c.in[I_KPE] + (size_t)j * NPOOL * PAGE * ROPE;
    const float B2 = __builtin_bit_cast(float, __builtin_amdgcn_readfirstlane(__builtin_bit_cast(int, mla_b2_bound(c, j, lane))));
    for (int it = blockIdx.x; it < DB * 2; it += gridDim.x) {
        const int s = it >> 1, hf = it & 1, rot = 2 * ((blockIdx.x >> 3) & 7);
        f32x16_t O[4], Lacc;
#pragma unroll
        for (int r = 0; r < 16; ++r) { O[0][r] = 0.f; O[1][r] = 0.f; O[2][r] = 0.f; O[3][r] = 0.f; Lacc[r] = 0.f; }
        pg8::u32x4 wr[4];
        __syncthreads();
        {
            int t_ = tid_; asm volatile("" : "+v"(t_));
            const char* wsrc = (const char*)(fm.wukvt + (size_t)rot * NOPE * KVL); const unsigned vo = (unsigned)t_ * 16u; LDSP unsigned char* wdst = lds + SD_WBUF + (t_ >> 5) * 1040 + (t_ & 31) * 16;
            pg8::u32x4 t0 = *(const pg8::u32x4*)(wsrc + vo), t1 = *(const pg8::u32x4*)(wsrc + 8192 + vo), t2 = *(const pg8::u32x4*)(wsrc + 16384 + vo), t3 = *(const pg8::u32x4*)(wsrc + 24576 + vo);
            *(LDSP pg8::u32x4*)(wdst) = t0; *(LDSP pg8::u32x4*)(wdst + 16640) = t1; *(LDSP pg8::u32x4*)(wdst + 512) = t2; *(LDSP pg8::u32x4*)(wdst + 17152) = t3;
#pragma unroll
            for (int k = 0; k < 4; ++k) wr[k] = *(const pg8::u32x4*)(wsrc + NOPE * KVL * 2 + k * 8192 + vo);
        }
        for (int pi = 0; pi < NPAGES / 2; ++pi) {
            const int pg = __builtin_amdgcn_readfirstlane(c.page_table[s * NPAGES + hf * (NPAGES / 2) + pi]);
            __syncthreads();
            { const char* src = (const char*)(ckv + (size_t)pg * PAGE * KVL); int tid = tid_; asm volatile("" : "+v"(tid));
              pg8::f32x4 v[16];
#pragma unroll
              for (int k = 0; k < 16; ++k) v[k] = __builtin_nontemporal_load((const pg8::f32x4*)(src + (size_t)k * 8192 + (unsigned)tid * 16u));
#pragma unroll
              for (int k = 0; k < 16; ++k) { pg8::u32x2 o; o.x = pk2bf(v[k][0], v[k][1]); o.y = pk2bf(v[k][2], v[k][3]);
                  *(LDSP pg8::u32x2*)(lds + SD_CIMG + ((tid >> 6) + 8 * k) * SD_CROW + (tid & 63) * 8) = o; } }
#if defined(PROBE_DUP) && (PROBE_DUP & (1 << 20))
            { const char* src = (const char*)(ckv + (size_t)pg * PAGE * KVL); int tid = tid_; asm volatile("" : "+v"(tid));
              pg8::f32x4 v[16];
#pragma unroll
              for (int k = 0; k < 16; ++k) v[k] = *(const pg8::f32x4*)(src + (size_t)k * 8192 + (unsigned)tid * 16u);
#pragma unroll
              for (int k = 0; k < 16; ++k) { pg8::u32x2 o; o.x = pk2bf(v[k][0], v[k][1]); o.y = pk2bf(v[k][2], v[k][3]);
                  *(LDSP pg8::u32x2*)(lds + SD_CIMG + ((tid >> 6) + 8 * k) * SD_CROW + (tid & 63) * 8) = o; } }
#endif
            bf16x8v kpfr[2];
            if (dh == 0) {
#pragma unroll
                for (int s_ = 0; s_ < 2; ++s_) { const float* kp = kpe + ((size_t)pg * PAGE + 32 * kb + l31) * ROPE + 16 * s_ + 8 * h5; const pg8::f32x4 a = *(const pg8::f32x4*)kp, b = *(const pg8::f32x4*)(kp + 4);
                    kpfr[s_] = __builtin_bit_cast(bf16x8v, (pg8::u32x4){pk2bf(a[0], a[1]), pk2bf(a[2], a[3]), pk2bf(b[0], b[1]), pk2bf(b[2], b[3])}); }
            }
            asm volatile("s_waitcnt vmcnt(0)" ::: "memory");
            __syncthreads();
            bf16x8v cfr[16];
#pragma unroll
            for (int s_ = 0; s_ < 16; ++s_) cfr[s_] = *(const LDSP bf16x8v*)(lds + SD_CIMG + (32 * kb + l31) * SD_CROW + (16 * s_ + 8 * h5) * 2);
            sd_group<0>(fm, qs, s, lds, w, lane, l31, h5, kb, dh, rot, cfr, kpfr, wr, O, Lacc, B2);
            sd_group<1>(fm, qs, s, lds, w, lane, l31, h5, kb, dh, rot, cfr, kpfr, wr, O, Lacc, B2);
            sd_group<2>(fm, qs, s, lds, w, lane, l31, h5, kb, dh, rot, cfr, kpfr, wr, O, Lacc, B2);
            sd_group<3>(fm, qs, s, lds, w, lane, l31, h5, kb, dh, rot, cfr, kpfr, wr, O, Lacc, B2);
#if defined(PROBE_DUP) && (PROBE_DUP & (1 << 29))
            __syncthreads();
            sd_group<0, false>(fm, qs, s, lds, w, lane, l31, h5, kb, dh, rot, cfr, kpfr, wr, O, Lacc, B2);
            sd_group<1, false>(fm, qs, s, lds, w, lane, l31, h5, kb, dh, rot, cfr, kpfr, wr, O, Lacc, B2);
            sd_group<2, false>(fm, qs, s, lds, w, lane, l31, h5, kb, dh, rot, cfr, kpfr, wr, O, Lacc, B2);
            sd_group<3, false>(fm, qs, s, lds, w, lane, l31, h5, kb, dh, rot, cfr, kpfr, wr, O, Lacc, B2);
#endif
            __syncthreads();
            sd_pv(3, O[3], Lacc, lds, w, lane, l31, h5);
        }
        {float* op = opart + (size_t)it * (MH * DS) * KVL; int lo_ = lane; asm volatile("" : "+v"(lo_)); const int l31 = lo_ & 31, h5 = lo_ >> 5;
#pragma unroll
        for (int g = 0; g < 4; ++g)
#pragma unroll
            for (int r = 0; r < 16; ++r) op[(size_t)((((4 * g + (r >> 2) + rot) & (MH - 1)) << 3) + (r & 3) + 4 * h5) * KVL + 32 * w + l31] = O[g][r];
        __syncthreads();
        LDSP float* ltab = (LDSP float*)(lds + SD_XCH);
        if (l31 < 4) {
#pragma unroll
            for (int r = 0; r < 16; ++r) ltab[w * 128 + l31 * 32 + (r & 3) + 8 * (r >> 2) + 4 * h5] = Lacc[r];
        }
        __syncthreads();
        { const int t2 = (int)tid_now();
        if (t2 < 128) { float a = 0.f;
#pragma unroll
            for (int ww = 0; ww < 8; ++ww) a += ltab[ww * 128 + t2];
            lpart[(size_t)it * 128 + ((((t2 >> 3) + rot) & (MH - 1)) << 3) + (t2 & 7)] = a; } }
        }
    }
}

__device__ __forceinline__ void mla_sample_combine(const Ctx& c, const FastMla& fm, const float* __restrict__ opart, const float* __restrict__ lpart, int j, LDSP unsigned char* lds) {
    using namespace cfg;
    const int tid = (int)tid_now(), w = tid >> 6, lane = tid & 63, gw = blockIdx.x * 8 + w, ngw = gridDim.x * 8;
    const float B2 = mla_b2_bound(c, j, lane);
    LDSP float* ol = (LDSP float*)(lds + w * 8704); LDSP float* ptab = ol + 8 * KVL; LDSP float* lt = ptab + 64;
    const float* wuv = c.in[I_WUV] + (size_t)j * KVL * MH * VD;
    for (int item = gw; item < DB * MH; item += ngw) {
        const int s = item / MH, h = item % MH, q = lane >> 3, jn = lane & 7;
        const size_t rq = (size_t)MP + s * DS + q, rk = (size_t)MP + s * DS + jn;
        const bf16_t* qv = fm.qf + rq * (MH * QD) + h * QD; const bf16_t* kn = fm.knb + rk * (MH * NOPE) + h * NOPE; const bf16_t* kp = fm.kpb + rk * ROPE;
        const float* wp = wuv + (size_t)h * VD + lane;
        float wa[16];
#pragma unroll
        for (int i = 0; i < 16; ++i) wa[i] = wp[(size_t)i * (MH * VD)];
        float cn[DS][4];
#pragma unroll
        for (int jj = 0; jj < DS; ++jj)
#pragma unroll
            for (int k = 0; k < 4; ++k) cn[jj][k] = bf2f(fm.cb[((size_t)MP + s * DS + jj) * KVL + lane + 64 * k]);
        float sc = 0.f;
#pragma unroll
        for (int d8 = 0; d8 < QD / 8; ++d8) { const pg8::u32x4 a = *(const pg8::u32x4*)(qv + 8 * d8), b = d8 < NOPE / 8 ? *(const pg8::u32x4*)(kn + 8 * d8) : *(const pg8::u32x4*)(kp + 8 * (d8 - NOPE / 8));
            const unsigned aw[4] = {a.x, a.y, a.z, a.w}, bw[4] = {b.x, b.y, b.z, b.w};
#pragma unroll
            for (int e = 0; e < 4; ++e) sc += __uint_as_float(aw[e] << 16) * __uint_as_float(bw[e] << 16) + __uint_as_float(aw[e] & 0xffff0000u) * __uint_as_float(bw[e] & 0xffff0000u); }
        const float p = jn <= q ? exp2f(sc - B2) : 0.f;
        float ls = p; ls += __shfl_xor(ls, 1); ls += __shfl_xor(ls, 2); ls += __shfl_xor(ls, 4);
        ptab[lane] = p;
        if (jn == 0) lt[q] = ls + lpart[(size_t)(2 * s) * 128 + h * DS + q] + lpart[(size_t)(2 * s + 1) * 128 + h * DS + q];
        asm volatile("s_waitcnt lgkmcnt(0)" ::: "memory");
#pragma unroll
        for (int qq = 0; qq < DS; ++qq)
#pragma unroll
            for (int k = 0; k < 4; ++k) { const int r = lane + 64 * k;
                float a = opart[((size_t)(2 * s) * 128 + h * DS + qq) * KVL + r] + opart[((size_t)(2 * s + 1) * 128 + h * DS + qq) * KVL + r];
#pragma unroll
                for (int jj = 0; jj < DS; ++jj) a += ptab[qq * 8 + jj] * cn[jj][k];
                ol[qq * KVL + r] = a; }
        asm volatile("s_waitcnt lgkmcnt(0)" ::: "memory");
        float acc[DS];
#pragma unroll
        for (int qq = 0; qq < DS; ++qq) acc[qq] = 0.f;
        float wb[16];
        for (int r0 = 0; r0 < KVL; r0 += 32) {
#pragma unroll
            for (int i = 0; i < 16; ++i) wb[i] = wp[(size_t)(r0 + 16 + i) * (MH * VD)];
#pragma unroll
            for (int i4 = 0; i4 < 4; ++i4)
#pragma unroll
                for (int qq = 0; qq < DS; ++qq) { const pg8::f32x4 o4 = *(const LDSP pg8::f32x4*)(ol + qq * KVL + r0 + 4 * i4);
                    acc[qq] += o4[0] * wa[4 * i4] + o4[1] * wa[4 * i4 + 1] + o4[2] * wa[4 * i4 + 2] + o4[3] * wa[4 * i4 + 3]; }
            if (r0 + 32 < KVL) {
#pragma unroll
                for (int i = 0; i < 16; ++i) wa[i] = wp[(size_t)(r0 + 32 + i) * (MH * VD)]; }
#pragma unroll
            for (int i4 = 0; i4 < 4; ++i4)
#pragma unroll
                for (int qq = 0; qq < DS; ++qq) { const pg8::f32x4 o4 = *(const LDSP pg8::f32x4*)(ol + qq * KVL + r0 + 16 + 4 * i4);
                    acc[qq] += o4[0] * wb[4 * i4] + o4[1] * wb[4 * i4 + 1] + o4[2] * wb[4 * i4 + 2] + o4[3] * wb[4 * i4 + 3]; }
        }
#pragma unroll
        for (int qq = 0; qq < DS; ++qq) fm.aob[((size_t)MP + s * DS + qq) * (MH * VD) + h * VD + lane] = (bf16_t)(pk2bf(acc[qq] / lt[qq], 0.f) & 0xffffu);
        asm volatile("s_waitcnt lgkmcnt(0)" ::: "memory");
    }
}

struct FastRw {
    bf16_t* xm;
    bf16_t* rkv;
    bf16_t* hb;
    bf16_t* lu;
    float* vf;
    float* ops;
    bf16_t* yo;
    bf16_t *wrkvt, *lorat, *wot;
};
constexpr int RW_REC = 464;
constexpr int RW_CH = 32;
constexpr int RW_BUF = RW_CH * RW_REC * 4;
struct RwSel { __device__ static __forceinline__ int sel(int pn) { return pn < 12 ? (pn >> 2) : (pn == 15 ? 2 : pn - 9); } };

__device__ __forceinline__ void rw_mix_fast(const Ctx& c, const FastRw& fr, int l, int gw, int ngw, int lane) {
    using namespace cfg; const int j = l / 3;
    const float* gain = c.in[I_NMIX] + l * D;
    for (int m = gw; m < MTOT; m += ngw) {
        const int t = row_t(m), sq = row_seq(m);
        pg8::f32x4 xc[4], xp[4], gv[4]; float s = 0.f, sp = 0.f;
#pragma unroll
        for (int q = 0; q < 4; ++q) { gv[q] = *(const pg8::f32x4*)(gain + 4 * lane + 256 * q); xc[q] = *(const pg8::f32x4*)(c.x + (size_t)m * D + 4 * lane + 256 * q);
            s += (xc[q][0] * xc[q][0] + xc[q][1] * xc[q][1]) + (xc[q][2] * xc[q][2] + xc[q][3] * xc[q][3]); }
        if (t > 0) {
#pragma unroll
            for (int q = 0; q < 4; ++q) { xp[q] = *(const pg8::f32x4*)(c.x + (size_t)(m - 1) * D + 4 * lane + 256 * q); sp += (xp[q][0] * xp[q][0] + xp[q][1] * xp[q][1]) + (xp[q][2] * xp[q][2] + xp[q][3] * xp[q][3]); }
        }
        const float rs = 1.0f / sqrtf(wave_sum64(s) * (1.0f / D) + NORM_EPS), rsp = 1.0f / sqrtf(wave_sum64(sp) * (1.0f / D) + NORM_EPS);
#pragma unroll
        for (int q = 0; q < 4; ++q) {
#pragma unroll
            for (int e = 0; e < 4; ++e) xc[q][e] = xc[q][e] * rs * gv[q][e];
            if (t > 0) {
#pragma unroll
                for (int e = 0; e < 4; ++e) xp[q][e] = xp[q][e] * rsp * gv[q][e];
            } else if (sq < BATCH) xp[q] = (pg8::f32x4){0.f, 0.f, 0.f, 0.f};
            else xp[q] = *(const pg8::f32x4*)(c.in[I_SHIFT] + ((size_t)j * DB + (sq - BATCH)) * D + 4 * lane + 256 * q);
        }
        if (t == seq_len(sq) - 1) {
            float* so = sq < BATCH ? c.out + O_SHP + ((size_t)j * BATCH + sq) * D : c.out + O_SHS + ((size_t)j * DB + (sq - BATCH)) * D;
#pragma unroll
            for (int q = 0; q < 4; ++q) *(pg8::f32x4*)(so + 4 * lane + 256 * q) = xc[q];
        }
#pragma unroll
        for (int p = 0; p < 6; ++p)
#pragma unroll
            for (int q = 0; q < 4; ++q) { const pg8::f32x4 mu = *(const pg8::f32x4*)(c.in[I_MU] + ((size_t)j * 6 + p) * D + 4 * lane + 256 * q);
                pg8::u32x2 o; o.x = pk2bf(xc[q][0] + (xp[q][0] - xc[q][0]) * mu[0], xc[q][1] + (xp[q][1] - xc[q][1]) * mu[1]); o.y = pk2bf(xc[q][2] + (xp[q][2] - xc[q][2]) * mu[2], xc[q][3] + (xp[q][3] - xc[q][3]) * mu[3]);
                *(pg8::u32x2*)(fr.xm + ((size_t)p * MTOT + m) * D + 4 * lane + 256 * q) = o; }
        if (lane < 32) *(unsigned*)(fr.hb + (size_t)m * 384 + 320 + 2 * lane) = 0u;
    }
}
struct EpiRwkv {
    static constexpr bool PERM = true;
    bf16_t* rkv; bf16_t* hb;
    __device__ __forceinline__ void operator()(const pg8::f32x4 (&acc)[2][2][4][2], const pg8::Unit& u, int wr, int wc, int fr, int fq) const {
        using namespace pg8;
        const int row0 = u.pm * BM + wr * 64 + fr, cl0 = wc * 32 + 8 * fq;
        const int pn = u.pn;
        bf16_t* base; int ldc, coff, nvalid, act = 0;
        if (pn < 12) { base = rkv; ldc = 3072; coff = pn * 256; nvalid = 256; }
        else { base = hb; ldc = 384; if (pn == 12) { coff = 0; nvalid = 64; act = 1; } else if (pn == 13) { coff = 64; nvalid = 64; } else if (pn == 14) { coff = 128; nvalid = 160; act = 2; } else { coff = 288; nvalid = 32; } }
#pragma unroll
        for (int ai = 0; ai < 2; ++ai)
#pragma unroll
            for (int m = 0; m < 4; ++m) { bf16_t* rowp = base + (size_t)(row0 + ai * HALF + m * 16) * ldc + coff;
#pragma unroll
                for (int bj = 0; bj < 2; ++bj) { const int cl = cl0 + bj * HALF; if (cl >= nvalid) continue;
                    f32x4 v0 = acc[ai][bj][m][0], v1 = acc[ai][bj][m][1];
                    if (act == 1) {
#pragma unroll
                        for (int e = 0; e < 4; ++e) { v0[e] = tanhf(v0[e]); v1[e] = tanhf(v1[e]); } }
                    else if (act == 2) {
#pragma unroll
                        for (int e = 0; e < 4; ++e) { v0[e] = 1.0f / (1.0f + __expf(-v0[e])); v1[e] = 1.0f / (1.0f + __expf(-v1[e])); } }
                    u32x4 w; w.x = cvt_pk_bf16(v0[0], v0[1]); w.y = cvt_pk_bf16(v0[2], v0[3]); w.z = cvt_pk_bf16(v1[0], v1[1]); w.w = cvt_pk_bf16(v1[2], v1[3]);
                    *(u32x4*)(rowp + cl) = w; } }
    }
};
__device__ __forceinline__ void rw_build_lorat(const Ctx& c, bf16_t* lorat, int j, size_t gtid, size_t gsz) {
    using namespace cfg;
    for (size_t i = gtid; i < (size_t)4096 * 384; i += gsz) {
        const int n = (int)(i / 384), k = (int)(i % 384), grp = n >> 10, ch = n & 1023; float v = 0.f;
        if (grp == 0 && k < 64) v = c.in[I_W2][((size_t)j * RW_DL + k) * D + ch];
        else if (grp == 1 && k >= 64 && k < 128) v = c.in[I_A2][((size_t)j * RW_AL + (k - 64)) * D + ch];
        else if (grp == 2 && k >= 128 && k < 288) v = c.in[I_G2][((size_t)j * RW_GL + (k - 128)) * D + ch];
        else if (grp == 3 && k >= 288 && k < 320 && j > 0) v = c.in[I_V2][((size_t)(j - 1) * RW_VL + (k - 288)) * D + ch];
        lorat[i] = (bf16_t)(pk2bf(v, 0.f) & 0xffffu);
    }
}
__device__ __forceinline__ size_t rw_rec_base(int sq, int h) {
    using namespace cfg;
    return sq < BATCH ? ((size_t)sq * RHEADS + h) * SEQ : (size_t)MP * RHEADS + ((size_t)(sq - BATCH) * RHEADS + h) * DS;
}
__device__ __forceinline__ void rw_prep_fast(const Ctx& c, const FastRw& fr, int l, int gw, int ngw, int lane) {
    using namespace cfg; const int j = l / 3;
    for (int it = gw; it < MTOT * RHEADS; it += ngw) {
        const int m = it / RHEADS, h = it % RHEADS, ch = h * RH + lane;
        const bf16_t* rk = fr.rkv + (size_t)m * 3072 + ch; const bf16_t* lu = fr.lu + (size_t)m * 4096 + ch;
        const float r = bf2f(rk[0]), k0 = bf2f(rk[1024]); float v = bf2f(rk[2048]);
        const float wpre = bf2f(lu[0]), apre = bf2f(lu[1024]), gg = bf2f(lu[2048]), vpre = bf2f(lu[3072]);
        const float wl = -softplusf_(-(c.in[I_W0][j * D + ch] + wpre)) - 0.5f;
        const float w = expf(-expf(wl));
        if (j == 0) fr.vf[(size_t)m * D + ch] = v;
        else v = v + (fr.vf[(size_t)m * D + ch] - v) * sigmoidf_(c.in[I_V0][(j - 1) * D + ch] + vpre);
        const float a = sigmoidf_(c.in[I_A0][j * D + ch] + apre);
        float kk = k0 * c.in[I_KK][j * D + ch];
        const float nn = wave_sum64(kk * kk);
        kk *= 1.0f / fmaxf(sqrtf(nn), 1e-12f);
        const float k2 = k0 * (1.0f + (a - 1.0f) * c.in[I_KA][j * D + ch]);
        const float bo = kk * a;
        const float br = wave_sum64(bo * r), kr = wave_sum64(k2 * r), bonus = wave_sum64(r * k2 * c.in[I_RK][(size_t)j * D + ch]);
        const int sq = row_seq(m), t = row_t(m);
        float* rec = fr.ops + (rw_rec_base(sq, h) + t) * RW_REC;
        rec[lane] = -kk; rec[64 + lane] = w * r; rec[128 + lane] = w; rec[192 + lane] = bo; rec[256 + lane] = k2; rec[320 + lane] = v; rec[384 + lane] = gg;
        if (lane == 0) { rec[448] = br; rec[449] = kr; rec[450] = bonus; }
    }
}
template <int CTRL> __device__ __forceinline__ float dppf(float v) { return __int_as_float(__builtin_amdgcn_update_dpp(0, __float_as_int(v), CTRL, 0xF, 0xF, true)); }
__device__ __forceinline__ float red16(float x) { x += dppf<0xB1>(x); x += dppf<0x4E>(x); x += dppf<0x124>(x); x += dppf<0x128>(x); return x; }
__device__ __forceinline__ void rw_scan_fast(const Ctx& c, const FastRw& fr, int l, LDSP unsigned char* lds) {
    using namespace cfg; const int j = l / 3;
    const int tid = (int)tid_now(), w = __builtin_amdgcn_readfirstlane(tid >> 6), lane = tid & 63, cs = lane & 15, rp = 4 * w + (lane >> 4);
    LDSP float* ybuf = (LDSP float*)(lds + 2 * RW_BUF);
    for (int chain = blockIdx.x; chain < NSEQ * RHEADS; chain += gridDim.x) {
        const int sq = chain / RHEADS, h = chain % RHEADS, T = seq_len(sq), m0 = seq_row0(sq);
        const char* src = (const char*)(fr.ops + rw_rec_base(sq, h) * RW_REC);
        pg8::f32x4 S0, S1;
        if (sq < BATCH) { S0 = (pg8::f32x4){0.f, 0.f, 0.f, 0.f}; S1 = S0; }
        else { const float* s0 = c.in[I_WKV] + ((((size_t)j * DB + (sq - BATCH)) * RHEADS + h) * RH + 2 * rp) * RH + 4 * cs; S0 = *(const pg8::f32x4*)s0; S1 = *(const pg8::f32x4*)(s0 + RH); }
        const int nch = (T + RW_CH - 1) / RW_CH;
#define RW_DMA(n, buf) do { const int nb_ = ((T - (n) * RW_CH < RW_CH ? T - (n) * RW_CH : RW_CH) * RW_REC * 4 + 1023) >> 10; \
            for (int q_ = w; q_ < nb_; q_ += 8) __builtin_amdgcn_global_load_lds((const unsigned*)(src + (size_t)(n) * RW_BUF + (size_t)q_ * 1024 + (unsigned)lane * 16u), (LDSP unsigned*)(lds + (buf) * RW_BUF + q_ * 1024), 16, 0, 0); } while (0)
        __syncthreads();
        RW_DMA(0, 0);
        asm volatile("s_waitcnt vmcnt(0)" ::: "memory");
        __syncthreads();
        for (int n = 0; n < nch; ++n) {
            if (n + 1 < nch) RW_DMA(n + 1, (n + 1) & 1);
            const int tn = T - n * RW_CH < RW_CH ? T - n * RW_CH : RW_CH;
            const LDSP unsigned char* bufp = lds + (n & 1) * RW_BUF;
            for (int t = 0; t < tn; ++t) {
                const LDSP unsigned char* rec = bufp + t * (RW_REC * 4);
                const pg8::f32x4 A = *(const LDSP pg8::f32x4*)(rec + cs * 16), WR = *(const LDSP pg8::f32x4*)(rec + 256 + cs * 16), W = *(const LDSP pg8::f32x4*)(rec + 512 + cs * 16),
                                 B = *(const LDSP pg8::f32x4*)(rec + 768 + cs * 16), K = *(const LDSP pg8::f32x4*)(rec + 1024 + cs * 16);
                const pg8::f32x2 V2 = *(const LDSP pg8::f32x2*)(rec + 1280 + rp * 8), SC = *(const LDSP pg8::f32x2*)(rec + 1792);
                float sa0 = (S0[0] * A[0] + S0[1] * A[1]) + (S0[2] * A[2] + S0[3] * A[3]), y0 = (S0[0] * WR[0] + S0[1] * WR[1]) + (S0[2] * WR[2] + S0[3] * WR[3]);
                float sa1 = (S1[0] * A[0] + S1[1] * A[1]) + (S1[2] * A[2] + S1[3] * A[3]), y1 = (S1[0] * WR[0] + S1[1] * WR[1]) + (S1[2] * WR[2] + S1[3] * WR[3]);
                sa0 = red16(sa0); sa1 = red16(sa1); y0 = red16(y0); y1 = red16(y1);
                S0 = S0 * W + sa0 * B + V2[0] * K; S1 = S1 * W + sa1 * B + V2[1] * K;
                if (cs == 0) *(LDSP pg8::f32x2*)(ybuf + t * RH + 2 * rp) = (pg8::f32x2){y0 + sa0 * SC[0] + V2[0] * SC[1], y1 + sa1 * SC[0] + V2[1] * SC[1]};
            }
            asm volatile("s_waitcnt vmcnt(0)" ::: "memory");
            __syncthreads();
            for (int t = w; t < tn; t += 8) {
                const LDSP float* rec = (const LDSP float*)(bufp + t * (RW_REC * 4));
                const float y = ybuf[t * RH + lane], mean = wave_sum64(y) * (1.0f / RH), d = y - mean, var = wave_sum64(d * d) * (1.0f / RH);
                const int ch = h * RH + lane;
                const float yn = d * (1.0f / sqrtf(var + LNX_EPS)) * c.in[I_LNW][j * D + ch] + c.in[I_LNB][j * D + ch];
                const float o = (yn + rec[450] * rec[320 + lane]) * rec[384 + lane];
                fr.yo[(size_t)(m0 + n * RW_CH + t) * D + ch] = (bf16_t)(pk2bf(o, 0.f) & 0xffffu);
            }
            __syncthreads();
        }
#undef RW_DMA
        float* so = (sq < BATCH ? c.out + O_WKVP + (((size_t)j * BATCH + sq) * RHEADS + h) * RH * RH : c.out + O_WKVS + (((size_t)j * DB + (sq - BATCH)) * RHEADS + h) * RH * RH) + (size_t)(2 * rp) * RH + 4 * cs;
        *(pg8::f32x4*)so = S0; *(pg8::f32x4*)(so + RH) = S1;
    }
}
__device__ __forceinline__ float fsigmoid(float x) { return __builtin_amdgcn_rcpf(1.0f + __expf(-x)); }
__device__ __forceinline__ float fsoftplus(float x) { return x > 20.f ? x : __logf(1.0f + __expf(x)); }
__device__ __forceinline__ float rdl(float v, int l) { return __int_as_float(__builtin_amdgcn_readlane(__float_as_int(v), l)); }
__device__ __forceinline__ float wsum_dpp(float x) {
    x = red16(x);
    return (rdl(x, 0) + rdl(x, 16)) + (rdl(x, 32) + rdl(x, 48));
}

struct RwOp { pg8::f32x4 A, WR, W, B, K; pg8::f32x2 V2, SC; };
__device__ __forceinline__ void rw_ldop(RwOp& o, const LDSP unsigned char* rec, int cs, int rp) {
    o.A = *(const LDSP pg8::f32x4*)(rec + cs * 16); o.WR = *(const LDSP pg8::f32x4*)(rec + 256 + cs * 16); o.W = *(const LDSP pg8::f32x4*)(rec + 512 + cs * 16);
    o.B = *(const LDSP pg8::f32x4*)(rec + 768 + cs * 16); o.K = *(const LDSP pg8::f32x4*)(rec + 1024 + cs * 16);
    o.V2 = *(const LDSP pg8::f32x2*)(rec + 1280 + rp * 8); o.SC = *(const LDSP pg8::f32x2*)(rec + 1792);
}
__device__ __forceinline__ float fma_s(float a, float b, float c) { float d; asm("v_fma_f32 %0, %1, %2, %3" : "=v"(d) : "v"(a), "v"(b), "v"(c)); return d; }
__device__ __forceinline__ float mul_s(float a, float b) { float d; asm("v_mul_f32 %0, %1, %2" : "=v"(d) : "v"(a), "v"(b)); return d; }
__device__ __forceinline__ void rw_step(pg8::f32x4& S0, pg8::f32x4& S1, const RwOp& o, LDSP float* yrow, bool wr) {
    float sa0 = fma_s(S0[3], o.A[3], fma_s(S0[2], o.A[2], fma_s(S0[1], o.A[1], mul_s(S0[0], o.A[0]))));
    float sa1 = fma_s(S1[3], o.A[3], fma_s(S1[2], o.A[2], fma_s(S1[1], o.A[1], mul_s(S1[0], o.A[0]))));
    float y0 = fma_s(S0[3], o.WR[3], fma_s(S0[2], o.WR[2], fma_s(S0[1], o.WR[1], mul_s(S0[0], o.WR[0]))));
    float y1 = fma_s(S1[3], o.WR[3], fma_s(S1[2], o.WR[2], fma_s(S1[1], o.WR[1], mul_s(S1[0], o.WR[0]))));
    float t0[4], t1[4];
#pragma unroll
    for (int e = 0; e < 4; ++e) { t0[e] = fma_s(o.K[e], o.V2[0], mul_s(S0[e], o.W[e])); t1[e] = fma_s(o.K[e], o.V2[1], mul_s(S1[e], o.W[e])); }
    red16x4(sa0, sa1, y0, y1);
#pragma unroll
    for (int e = 0; e < 4; ++e) { S0[e] = fma_s(o.B[e], sa0, t0[e]); S1[e] = fma_s(o.B[e], sa1, t1[e]); }
    if (wr) *(LDSP pg8::f32x2*)yrow = (pg8::f32x2){fma_s(o.V2[0], o.SC[1], fma_s(sa0, o.SC[0], y0)), fma_s(o.V2[1], o.SC[1], fma_s(sa1, o.SC[0], y1))};
}
struct RwIn { unsigned short r, k, v, wp, ap, g, vp; float vf; };
template <int J>
__device__ __forceinline__ void rw_scan_fused(const Ctx& c, const FastRw& fr, LDSP unsigned char* lds) {
    using namespace cfg; constexpr int j = J;
    const int tid = (int)tid_now(), w = __builtin_amdgcn_readfirstlane(tid >> 6), lane = tid & 63, cs = lane & 15, rp = 4 * w + (lane >> 4);
    LDSP float* ybuf = (LDSP float*)(lds + 2 * RW_BUF);
    for (int chain = blockIdx.x; chain < NSEQ * RHEADS; chain += gridDim.x) {
        const int sq = chain / RHEADS, h = chain % RHEADS, T = seq_len(sq), m0 = seq_row0(sq), ch = h * RH + lane;
        const float p_w0 = c.in[I_W0][j * D + ch], p_a0 = c.in[I_A0][j * D + ch], p_kk = c.in[I_KK][j * D + ch], p_ka = c.in[I_KA][j * D + ch], p_rk = c.in[I_RK][(size_t)j * D + ch],
                    p_lnw = c.in[I_LNW][j * D + ch], p_lnb = c.in[I_LNB][j * D + ch], p_v0 = j > 0 ? c.in[I_V0][(j - 1) * D + ch] : 0.f;
        pg8::f32x4 S0, S1;
        if (sq < BATCH) { S0 = (pg8::f32x4){0.f, 0.f, 0.f, 0.f}; S1 = S0; }
        else { const float* s0 = c.in[I_WKV] + ((((size_t)j * DB + (sq - BATCH)) * RHEADS + h) * RH + 2 * rp) * RH + 4 * cs; S0 = *(const pg8::f32x4*)s0; S1 = *(const pg8::f32x4*)(s0 + RH); }
        const int nch = (T + RW_CH - 1) / RW_CH;
        RwIn in[4];
#define RW_LOADIN(n) do { _Pragma("unroll") for (int q = 0; q < 4; ++q) { const int t_ = (n) * RW_CH + 4 * w + q; if (t_ < T) { const size_t m_ = (size_t)(m0 + t_); \
                const bf16_t* rk_ = fr.rkv + m_ * 3072 + ch; const bf16_t* lu_ = fr.lu + m_ * 4096 + ch; \
                in[q].r = rk_[0]; in[q].k = rk_[1024]; in[q].v = rk_[2048]; in[q].wp = lu_[0]; in[q].ap = lu_[1024]; in[q].g = lu_[2048]; in[q].vp = lu_[3072]; \
                in[q].vf = j > 0 ? fr.vf[m_ * D + ch] : 0.f; } } } while (0)
#define RW_PREP(n, buf) do { _Pragma("unroll") for (int q = 0; q < 4; ++q) { const int tl_ = 4 * w + q, t_ = (n) * RW_CH + tl_; if (t_ < T) { \
                const float r_ = bf2f(in[q].r), k0_ = bf2f(in[q].k); float v_ = bf2f(in[q].v); \
                const float wl_ = -fsoftplus(-(p_w0 + bf2f(in[q].wp))) - 0.5f, w_ = __expf(-__expf(wl_)); \
                if (j == 0) fr.vf[(size_t)(m0 + t_) * D + ch] = v_; else v_ = v_ + (in[q].vf - v_) * fsigmoid(p_v0 + bf2f(in[q].vp)); \
                const float a_ = fsigmoid(p_a0 + bf2f(in[q].ap)); float kk_ = k0_ * p_kk; \
                const float k2_ = k0_ * (1.0f + (a_ - 1.0f) * p_ka); \
                float n_ = red16(kk_ * kk_), e1_ = red16(r_ * k2_ * p_rk), e2_ = red16(k2_ * r_); \
                n_ = (rdl(n_, 0) + rdl(n_, 16)) + (rdl(n_, 32) + rdl(n_, 48)); e1_ = (rdl(e1_, 0) + rdl(e1_, 16)) + (rdl(e1_, 32) + rdl(e1_, 48)); e2_ = (rdl(e2_, 0) + rdl(e2_, 16)) + (rdl(e2_, 32) + rdl(e2_, 48)); \
                kk_ *= __builtin_amdgcn_rcpf(fmaxf(__builtin_amdgcn_sqrtf(n_), 1e-12f)); const float bo_ = kk_ * a_; const float e3_ = wsum_dpp(bo_ * r_); \
                LDSP float* rec_ = (LDSP float*)(lds + (buf) * RW_BUF + tl_ * (RW_REC * 4)); \
                rec_[lane] = -kk_; rec_[64 + lane] = w_ * r_; rec_[128 + lane] = w_; rec_[192 + lane] = bo_; rec_[256 + lane] = k2_; rec_[320 + lane] = v_; rec_[384 + lane] = bf2f(in[q].g); \
                if (lane == 0) { rec_[448] = e3_; rec_[449] = e2_; rec_[450] = e1_; } } } } while (0)
        __syncthreads();
        RW_LOADIN(0); RW_PREP(0, 0);
        __syncthreads();
        for (int n = 0; n < nch; ++n) {
            if (n + 1 < nch) RW_LOADIN(n + 1);
            const int tn = T - n * RW_CH < RW_CH ? T - n * RW_CH : RW_CH;
            const LDSP unsigned char* bufp = lds + (n & 1) * RW_BUF;
#if defined(PROBE_DUP) && (PROBE_DUP & (1 << 17))
            { RwOp o0, o1; rw_ldop(o0, bufp, cs, rp); pg8::f32x4 T0 = S0, T1 = S1;
              for (int t = 0; t < tn; t += 2) {
                  rw_ldop(o1, bufp + (t + 1) * (RW_REC * 4), cs, rp);
                  rw_step(T0, T1, o0, ybuf + t * RH + 2 * rp, cs == 0);
                  rw_ldop(o0, bufp + (t + 2 < tn ? t + 2 : t) * (RW_REC * 4), cs, rp);
                  rw_step(T0, T1, o1, ybuf + (t + 1) * RH + 2 * rp, cs == 0);
              } asm volatile("" :: "v"(T0), "v"(T1)); }
#endif
            { RwOp o0, o1; rw_ldop(o0, bufp, cs, rp);
              for (int t = 0; t < tn; t += 2) {
                  rw_ldop(o1, bufp + (t + 1) * (RW_REC * 4), cs, rp);
                  rw_step(S0, S1, o0, ybuf + t * RH + 2 * rp, cs == 0);
                  rw_ldop(o0, bufp + (t + 2 < tn ? t + 2 : t) * (RW_REC * 4), cs, rp);
                  rw_step(S0, S1, o1, ybuf + (t + 1) * RH + 2 * rp, cs == 0);
              } }
            if (n + 1 < nch) RW_PREP(n + 1, (n + 1) & 1);
#if defined(PROBE_DUP) && (PROBE_DUP & (1 << 18))
            if (n + 1 < nch) RW_PREP(n + 1, (n + 1) & 1);
#endif
            __syncthreads();
            for (int t = w; t < tn; t += 8) {
                const LDSP float* rec = (const LDSP float*)(bufp + t * (RW_REC * 4));
                const float y = ybuf[t * RH + lane], mean = wsum_dpp(y) * (1.0f / RH), d = y - mean, var = wsum_dpp(d * d) * (1.0f / RH);
                const float yn = d * __builtin_amdgcn_rsqf(var + LNX_EPS) * p_lnw + p_lnb;
                const float o = (yn + rec[450] * rec[320 + lane]) * rec[384 + lane];
                fr.yo[(size_t)(m0 + n * RW_CH + t) * D + ch] = (bf16_t)(pk2bf(o, 0.f) & 0xffffu);
            }
            __syncthreads();
        }
#undef RW_LOADIN
#undef RW_PREP
        float* so = (sq < BATCH ? c.out + O_WKVP + (((size_t)j * BATCH + sq) * RHEADS + h) * RH * RH : c.out + O_WKVS + (((size_t)j * DB + (sq - BATCH)) * RHEADS + h) * RH * RH) + (size_t)(2 * rp) * RH + 4 * cs;
        *(pg8::f32x4*)so = S0; *(pg8::f32x4*)(so + RH) = S1;
    }
}
struct FastMb {
    bf16_t* zb;
    bf16_t* xbcr;
    float* dtraw;
    bf16_t* xbcb;
    float* dt;
    float* y;
    bf16_t* yzn;
    bf16_t *wbint, *wbot;
};
struct EpiMamba {
    static constexpr bool PERM = true;
    bf16_t* zb; bf16_t* xbcr; float* dtraw;
    __device__ __forceinline__ void operator()(const pg8::f32x4 (&acc)[2][2][4][2], const pg8::Unit& u, int wr, int wc, int fr, int fq) const {
        using namespace pg8;
        const int row0 = u.pm * BM + wr * 64 + fr, cl0 = wc * 32 + 8 * fq, pn = u.pn;
        if (pn < 20) {
            bf16_t* base = pn < 8 ? zb : xbcr; const int ldc = pn < 8 ? 2048 : 3072, coff = pn < 8 ? pn * 256 : (pn - 8) * 256;
#pragma unroll
            for (int ai = 0; ai < 2; ++ai)
#pragma unroll
                for (int m = 0; m < 4; ++m) { bf16_t* rowp = base + (size_t)(row0 + ai * HALF + m * 16) * ldc + coff + cl0;
#pragma unroll
                    for (int bj = 0; bj < 2; ++bj) { const f32x4 v0 = acc[ai][bj][m][0], v1 = acc[ai][bj][m][1];
                        u32x4 w; w.x = cvt_pk_bf16(v0[0], v0[1]); w.y = cvt_pk_bf16(v0[2], v0[3]); w.z = cvt_pk_bf16(v1[0], v1[1]); w.w = cvt_pk_bf16(v1[2], v1[3]);
                        *(u32x4*)(rowp + bj * HALF) = w; } }
        } else if (cl0 < 32) {
#pragma unroll
            for (int ai = 0; ai < 2; ++ai)
#pragma unroll
                for (int m = 0; m < 4; ++m) { float* rowp = dtraw + (size_t)(row0 + ai * HALF + m * 16) * 32 + cl0;
                    *(f32x4*)rowp = acc[ai][0][m][0]; *(f32x4*)(rowp + 4) = acc[ai][0][m][1]; }
        }
    }
};
__device__ __forceinline__ void mb_conv_fast(const Ctx& c, const FastMb& fb, int l, size_t gtid, size_t gsz, bool write_f32) {
    using namespace cfg; const int j = l / 3; constexpr int NB = MB_CD / 8, TB = 8;
    for (size_t i = gtid; i < (size_t)(MTOT / TB) * NB; i += gsz) {
        const int mb = (int)(i / NB) * TB, cb = (int)(i % NB) * 8, t0 = row_t(mb), sq = row_seq(mb), T = seq_len(sq);
        float wt[MB_CONV][8], bias[8], win[MB_CONV][8];
#pragma unroll
        for (int e = 0; e < 8; ++e) bias[e] = c.in[I_CONVB][j * MB_CD + cb + e];
#pragma unroll
        for (int jj = 0; jj < MB_CONV; ++jj)
#pragma unroll
            for (int e = 0; e < 8; ++e) wt[jj][e] = c.in[I_CONVW][((size_t)j * MB_CONV + jj) * MB_CD + cb + e];
#pragma unroll
        for (int jj = 0; jj < MB_CONV - 1; ++jj) {
            const int tt = t0 + jj - (MB_CONV - 1);
            if (tt >= 0) { const pg8::u32x4 raw = *(const pg8::u32x4*)(fb.xbcr + (size_t)(mb + jj - (MB_CONV - 1)) * MB_CD + cb); const unsigned wv[4] = {raw.x, raw.y, raw.z, raw.w};
#pragma unroll
                for (int q = 0; q < 4; ++q) { win[jj][2 * q] = __uint_as_float(wv[q] << 16); win[jj][2 * q + 1] = __uint_as_float(wv[q] & 0xffff0000u); } }
            else if (sq >= BATCH) { const float* st = c.in[I_CONV] + (((size_t)j * DB + (sq - BATCH)) * (MB_CONV - 1) + (tt + MB_CONV - 1)) * MB_CD + cb;
#pragma unroll
                for (int e = 0; e < 8; ++e) win[jj][e] = st[e]; }
            else {
#pragma unroll
                for (int e = 0; e < 8; ++e) win[jj][e] = 0.f; }
        }
#pragma unroll
        for (int tb = 0; tb < TB; ++tb) {
            const int m = mb + tb, t = t0 + tb;
            { const pg8::u32x4 raw = *(const pg8::u32x4*)(fb.xbcr + (size_t)m * MB_CD + cb); const unsigned wv[4] = {raw.x, raw.y, raw.z, raw.w};
#pragma unroll
              for (int q = 0; q < 4; ++q) { win[3][2 * q] = __uint_as_float(wv[q] << 16); win[3][2 * q + 1] = __uint_as_float(wv[q] & 0xffff0000u); } }
            if (t >= T - (MB_CONV - 1)) {
                float* so = (sq < BATCH ? c.out + O_CONVP + (((size_t)j * BATCH + sq) * (MB_CONV - 1) + (t - (T - (MB_CONV - 1)))) * MB_CD
                                        : c.out + O_CONVS + (((size_t)j * DB + (sq - BATCH)) * (MB_CONV - 1) + (t - (T - (MB_CONV - 1)))) * MB_CD) + cb;
#pragma unroll
                for (int e = 0; e < 8; ++e) so[e] = win[3][e];
            }
            unsigned w[4];
#pragma unroll
            for (int q = 0; q < 4; ++q) {
                float a0 = bias[2 * q], a1 = bias[2 * q + 1];
#pragma unroll
                for (int jj = 0; jj < MB_CONV; ++jj) { a0 += win[jj][2 * q] * wt[jj][2 * q]; a1 += win[jj][2 * q + 1] * wt[jj][2 * q + 1]; }
                a0 = a0 * __builtin_amdgcn_rcpf(1.0f + __expf(-a0)); a1 = a1 * __builtin_amdgcn_rcpf(1.0f + __expf(-a1));
                w[q] = pk2bf(a0, a1); if (write_f32) { c.xbc[(size_t)m * MB_CD + cb + 2 * q] = a0; c.xbc[(size_t)m * MB_CD + cb + 2 * q + 1] = a1; } }
            *(pg8::u32x4*)(fb.xbcb + (size_t)m * MB_CD + cb) = (pg8::u32x4){w[0], w[1], w[2], w[3]};
#pragma unroll
            for (int jj = 0; jj < MB_CONV - 1; ++jj)
#pragma unroll
                for (int e = 0; e < 8; ++e) win[jj][e] = win[jj + 1][e];
        }
    }
    for (size_t i = gtid; i < (size_t)MTOT * MB_HEADS; i += gsz) {
        const float v = softplusf_(fb.dtraw[i] + c.in[I_DTB][j * MB_HEADS + (int)(i % MB_HEADS)]);
        fb.dt[i] = v; if (write_f32) c.dt[i] = v;
    }
}
__device__ __forceinline__ void mb_gate_fast(const Ctx& c, const FastMb& fb, const float* __restrict__ y, int l, int gw, int ngw, int lane) {
    using namespace cfg; const int j = l / 3; constexpr int GW_ = MB_INNER / MB_GROUPS;
    for (int it = gw; it < MTOT * MB_GROUPS; it += ngw) {
        const int m = it / MB_GROUPS, g = it % MB_GROUPS; const size_t o = (size_t)m * MB_INNER + g * GW_ + 8 * lane;
        const pg8::f32x4 y0 = *(const pg8::f32x4*)(y + o), y1 = *(const pg8::f32x4*)(y + o + 4); const pg8::u32x4 zr = *(const pg8::u32x4*)(fb.zb + o);
        const unsigned zw[4] = {zr.x, zr.y, zr.z, zr.w}; float v[8]; float s = 0.f;
#pragma unroll
        for (int q = 0; q < 4; ++q) { const float z0 = __uint_as_float(zw[q] << 16), z1 = __uint_as_float(zw[q] & 0xffff0000u);
            v[2 * q] = (q < 2 ? y0[2 * q] : y1[2 * q - 4]) * siluf_(z0); v[2 * q + 1] = (q < 2 ? y0[2 * q + 1] : y1[2 * q - 3]) * siluf_(z1); s += v[2 * q] * v[2 * q] + v[2 * q + 1] * v[2 * q + 1]; }
        const float rs = 1.0f / sqrtf(wave_sum64(s) * (1.0f / GW_) + NORM_EPS);
        const float* nw = c.in[I_BNORM] + j * MB_INNER + g * GW_ + 8 * lane; unsigned w[4];
#pragma unroll
        for (int q = 0; q < 4; ++q) w[q] = pk2bf(v[2 * q] * rs * nw[2 * q], v[2 * q + 1] * rs * nw[2 * q + 1]);
        *(pg8::u32x4*)(fb.yzn + o) = (pg8::u32x4){w[0], w[1], w[2], w[3]};
    }
}
constexpr int SS_XR = 144, SS_BR = 272;
constexpr int SS_XIM = 0, SS_XSM = SS_XIM + 128 * SS_XR, SS_BIM = SS_XSM + 128 * SS_XR, SS_CIM = SS_BIM + 128 * SS_BR, SS_MTM = SS_CIM + 128 * SS_BR, SS_HBM = SS_MTM + 128 * SS_BR, SS_TAB = SS_HBM + 128 * SS_XR, SS_END = SS_TAB + 2048;
__device__ __forceinline__ bf16x8v ss_trfrag(const LDSP unsigned char* img, int rowstride, int k0, int col0, int lane) {
    const int r0 = k0 + 8 * (lane >> 5) + ((lane & 15) >> 2), cc = col0 + 16 * ((lane >> 4) & 1) + 4 * (lane & 3);
    const s16x4 t0 = __builtin_amdgcn_ds_read_tr16_b64_v4i16((LDSP s16x4*)(img + r0 * rowstride + cc * 2));
    const s16x4 t1 = __builtin_amdgcn_ds_read_tr16_b64_v4i16((LDSP s16x4*)(img + (r0 + 4) * rowstride + cc * 2));
    return (bf16x8v){t0[0], t0[1], t0[2], t0[3], t1[0], t1[1], t1[2], t1[3]};
}
__device__ __forceinline__ void mb_ssd_prompt(const Ctx& c, const FastMb& fb, int l, LDSP unsigned char* lds) {
    using namespace cfg; const int j = l / 3;
    const int tid = (int)tid_now(), w = __builtin_amdgcn_readfirstlane(tid >> 6), lane = tid & 63, l31 = lane & 31, h5 = lane >> 5;
    LDSP float* tab = (LDSP float*)(lds + SS_TAB);
    for (int chain = blockIdx.x; chain < BATCH * MB_HEADS; chain += gridDim.x) {
        const int b = chain / MB_HEADS, hd = chain % MB_HEADS, g = hd / (MB_HEADS / MB_GROUPS);
        const float Ah = -expf(c.in[I_ALOG][j * MB_HEADS + hd]), Dh = c.in[I_BD][j * MB_HEADS + hd];
        f32x16_t H;
#pragma unroll
        for (int r = 0; r < 16; ++r) H[r] = 0.f;
        pg8::u32x4 nx[2], nB[4], nC[4]; float ndt0 = 0.f, ndt1 = 0.f;
#define SS_LOAD(ck_) do { const size_t mm_ = (size_t)b * SEQ + 128 * (ck_); int tq_ = tid; asm volatile("" : "+v"(tq_)); \
            _Pragma("unroll") for (int q = 0; q < 2; ++q) { const int ci = tq_ + 512 * q; nx[q] = *(const pg8::u32x4*)(fb.xbcb + (mm_ + (ci >> 3)) * MB_CD + hd * MB_HEAD + (ci & 7) * 8); } \
            _Pragma("unroll") for (int q = 0; q < 4; ++q) { const int ci = tq_ + 512 * q; const bf16_t* rowp = fb.xbcb + (mm_ + (ci >> 4)) * MB_CD + MB_INNER + g * MB_STATE + (ci & 15) * 8; \
                nB[q] = *(const pg8::u32x4*)rowp; nC[q] = *(const pg8::u32x4*)(rowp + MB_GN); } \
            ndt0 = fb.dt[(mm_ + 2 * (tq_ & 63)) * MB_HEADS + hd]; ndt1 = fb.dt[(mm_ + 2 * (tq_ & 63) + 1) * MB_HEADS + hd]; } while (0)
        SS_LOAD(0);
        for (int ck = 0; ck < SEQ / 128; ++ck) {
            const size_t m0 = (size_t)b * SEQ + 128 * ck;
            int tl = tid; asm volatile("" : "+v"(tl));
            pg8::u32x4 xr[2];
#pragma unroll
            for (int q = 0; q < 2; ++q) { const int ci = tl + 512 * q; xr[q] = nx[q];
                *(LDSP pg8::u32x2*)(lds + SS_XIM + (ci >> 3) * SS_XR + (ci & 7) * 16) = (pg8::u32x2){xr[q].x, xr[q].y}; *(LDSP pg8::u32x2*)(lds + SS_XIM + (ci >> 3) * SS_XR + (ci & 7) * 16 + 8) = (pg8::u32x2){xr[q].z, xr[q].w}; }
#pragma unroll
            for (int q = 0; q < 4; ++q) { const int ci = tl + 512 * q;
                *(LDSP pg8::u32x4*)(lds + SS_BIM + (ci >> 4) * SS_BR + (ci & 15) * 16) = nB[q];
                *(LDSP pg8::u32x4*)(lds + SS_CIM + (ci >> 4) * SS_BR + (ci & 15) * 16) = nC[q]; }
            float alast;
            { const float v0 = ndt0 * Ah, v1 = ndt1 * Ah; float sacc = v0 + v1;
#pragma unroll
              for (int o = 1; o < 64; o <<= 1) { const float u = __shfl_up(sacc, o); if (lane >= o) sacc += u; }
              tab[2 * lane] = sacc - v1; tab[2 * lane + 1] = sacc; tab[128 + 2 * lane] = ndt0; tab[128 + 2 * lane + 1] = ndt1;
              alast = __int_as_float(__builtin_amdgcn_readlane(__float_as_int(sacc), 63)); }
            if (ck + 1 < SEQ / 128) SS_LOAD(ck + 1);
            asm volatile("s_waitcnt lgkmcnt(0)" ::: "memory");
#pragma unroll
            for (int q = 0; q < 2; ++q) { const int ci = tl + 512 * q, row = ci >> 3; const float sc = __expf(alast - tab[row]) * tab[128 + row]; const unsigned xw[4] = {xr[q].x, xr[q].y, xr[q].z, xr[q].w}; unsigned ow[4];
#pragma unroll
                for (int e = 0; e < 4; ++e) ow[e] = pk2bf(__uint_as_float(xw[e] << 16) * sc, __uint_as_float(xw[e] & 0xffff0000u) * sc);
                *(LDSP pg8::u32x2*)(lds + SS_XSM + row * SS_XR + (ci & 7) * 16) = (pg8::u32x2){ow[0], ow[1]}; *(LDSP pg8::u32x2*)(lds + SS_XSM + row * SS_XR + (ci & 7) * 16 + 8) = (pg8::u32x2){ow[2], ow[3]}; }
            __syncthreads();
            { int ln = lane; asm volatile("" : "+v"(ln)); const int a31 = ln & 31, a5 = ln >> 5;
              for (int tt = w; tt < 10; tt += 8) {
                int ib = tt < 1 ? 0 : (tt < 3 ? 1 : (tt < 6 ? 2 : 3)); const int jb = tt - (ib * (ib + 1)) / 2;
                f32x16_t ST;
#pragma unroll
                for (int r = 0; r < 16; ++r) ST[r] = 0.f;
#pragma unroll
                for (int s = 0; s < 8; ++s) { const bf16x8v a = *(const LDSP bf16x8v*)(lds + SS_BIM + (32 * jb + a31) * SS_BR + (16 * s + 8 * a5) * 2), bb = *(const LDSP bf16x8v*)(lds + SS_CIM + (32 * ib + a31) * SS_BR + (16 * s + 8 * a5) * 2);
                    ST = MFMA32(a, bb, ST); }
                const float ai = tab[32 * ib + a31];
#pragma unroll
                for (int g4 = 0; g4 < 4; ++g4) { const int jr = 32 * jb + 8 * g4 + 4 * a5; const pg8::f32x4 aj = *(const LDSP pg8::f32x4*)(tab + jr), dj = *(const LDSP pg8::f32x4*)(tab + 128 + jr);
#pragma unroll
                    for (int e = 0; e < 4; ++e) { const int jj = jr + e, ii = 32 * ib + a31; const float mv = jj <= ii ? ST[4 * g4 + e] * __expf(ai - aj[e]) * dj[e] : 0.f;
                        *(LDSP bf16_t*)(lds + SS_MTM + jj * SS_BR + ii * 2) = (bf16_t)(pk2bf(mv, 0.f) & 0xffffu); } }
              }
              const int nb = w >> 1, pb = w & 1;
#pragma unroll
              for (int r = 0; r < 16; ++r) *(LDSP bf16_t*)(lds + SS_HBM + (32 * nb + (r & 3) + 8 * (r >> 2) + 4 * a5) * SS_XR + (32 * pb + a31) * 2) = (bf16_t)(pk2bf(H[r], 0.f) & 0xffffu);
            }
            __syncthreads();
            { int ln = lane; asm volatile("" : "+v"(ln)); const int a31 = ln & 31, a5 = ln >> 5;
              const int pb = w & 1, ib = w >> 1, nb = w >> 1;
              f32x16_t Y;
#pragma unroll
              for (int r = 0; r < 16; ++r) Y[r] = 0.f;
#pragma unroll
              for (int s = 0; s < 8; ++s) { const bf16x8v a = ss_trfrag(lds + SS_HBM, SS_XR, 16 * s, 32 * pb, ln), bb = *(const LDSP bf16x8v*)(lds + SS_CIM + (32 * ib + a31) * SS_BR + (16 * s + 8 * a5) * 2);
                  Y = MFMA32(a, bb, Y); if (s & 1) __builtin_amdgcn_sched_barrier(0); }
              const float ei = __expf(tab[32 * ib + a31]);
#pragma unroll
              for (int r = 0; r < 16; ++r) Y[r] *= ei;
              for (int s = 0; s < 2 * (ib + 1); ++s) { const bf16x8v a = ss_trfrag(lds + SS_XIM, SS_XR, 16 * s, 32 * pb, ln), bb = ss_trfrag(lds + SS_MTM, SS_BR, 16 * s, 32 * ib, ln);
                  Y = MFMA32(a, bb, Y); }
              { const size_t mrow = m0 + 32 * ib + a31; float* yrow = fb.y + mrow * MB_INNER + hd * MB_HEAD + 32 * pb + 4 * a5;
#pragma unroll
                for (int g4 = 0; g4 < 4; ++g4) { const pg8::u32x2 xv = *(const LDSP pg8::u32x2*)(lds + SS_XIM + (32 * ib + a31) * SS_XR + (32 * pb + 8 * g4 + 4 * a5) * 2);
                    pg8::f32x4 o; o[0] = Y[4 * g4] + Dh * __uint_as_float(xv.x << 16); o[1] = Y[4 * g4 + 1] + Dh * __uint_as_float(xv.x & 0xffff0000u); o[2] = Y[4 * g4 + 2] + Dh * __uint_as_float(xv.y << 16); o[3] = Y[4 * g4 + 3] + Dh * __uint_as_float(xv.y & 0xffff0000u);
                    *(pg8::f32x4*)(yrow + 8 * g4) = o; } }
              const float dec = __expf(tab[127]);
#pragma unroll
              for (int r = 0; r < 16; ++r) H[r] *= dec;
#pragma unroll
              for (int s = 0; s < 8; ++s) { const bf16x8v a = ss_trfrag(lds + SS_BIM, SS_BR, 16 * s, 32 * nb, ln), bb = ss_trfrag(lds + SS_XSM, SS_XR, 16 * s, 32 * pb, ln);
                  H = MFMA32(a, bb, H); if (s & 1) __builtin_amdgcn_sched_barrier(0); }
            }
            __syncthreads();
        }
#undef SS_LOAD
        { const int nb = w >> 1, pb = w & 1; float* so = c.out + O_SSMP + (((size_t)j * BATCH + b) * MB_HEADS + hd) * MB_HEAD * MB_STATE;
#pragma unroll
          for (int r = 0; r < 16; ++r) so[(size_t)(32 * pb + l31) * MB_STATE + 32 * nb + (r & 3) + 8 * (r >> 2) + 4 * h5] = H[r]; }
    }
}
__device__ __forceinline__ void mb_scan_sample(const Ctx& c, const FastMb& fb, int l) {
    using namespace cfg; const int j = l / 3;
    const int tid = (int)tid_now(), p = tid >> 3, ns = tid & 7;
    pg8::f32x4 hn[4];
    { const int chain = blockIdx.x; if (chain < DB * MB_HEADS) { const size_t so = ((((size_t)j * DB + chain / MB_HEADS) * MB_HEADS + chain % MB_HEADS) * MB_HEAD + p) * MB_STATE + 16 * ns;
#pragma unroll
        for (int q = 0; q < 4; ++q) hn[q] = *(const pg8::f32x4*)(c.in[I_SSM] + so + 4 * q); } }
    for (int chain = blockIdx.x; chain < DB * MB_HEADS; chain += gridDim.x) {
        const int s = chain / MB_HEADS, hd = chain % MB_HEADS, g = hd / (MB_HEADS / MB_GROUPS);
        const float Ah = -expf(c.in[I_ALOG][j * MB_HEADS + hd]), Dh = c.in[I_BD][j * MB_HEADS + hd];
        const size_t so = ((((size_t)j * DB + s) * MB_HEADS + hd) * MB_HEAD + p) * MB_STATE + 16 * ns;
        float hs[16];
#pragma unroll
        for (int q = 0; q < 4; ++q) { hs[4 * q] = hn[q][0]; hs[4 * q + 1] = hn[q][1]; hs[4 * q + 2] = hn[q][2]; hs[4 * q + 3] = hn[q][3]; }
        { const int cn = chain + gridDim.x; if (cn < DB * MB_HEADS) { const size_t sn = ((((size_t)j * DB + cn / MB_HEADS) * MB_HEADS + cn % MB_HEADS) * MB_HEAD + p) * MB_STATE + 16 * ns;
#pragma unroll
            for (int q = 0; q < 4; ++q) hn[q] = *(const pg8::f32x4*)(c.in[I_SSM] + sn + 4 * q); } }
        float dtv[DS]; unsigned short xr[DS]; pg8::u32x4 Bq[DS][2], Cq[DS][2];
#pragma unroll
        for (int t = 0; t < DS; ++t) { const size_t m = (size_t)MP + s * DS + t; dtv[t] = fb.dt[m * MB_HEADS + hd]; xr[t] = fb.xbcb[m * MB_CD + hd * MB_HEAD + p];
            const bf16_t* Bp = fb.xbcb + m * MB_CD + MB_INNER + g * MB_STATE + 16 * ns; Bq[t][0] = *(const pg8::u32x4*)Bp; Bq[t][1] = *(const pg8::u32x4*)(Bp + 8);
            Cq[t][0] = *(const pg8::u32x4*)(Bp + MB_GN); Cq[t][1] = *(const pg8::u32x4*)(Bp + MB_GN + 8); }
#pragma unroll
        for (int t = 0; t < DS; ++t) {
            const size_t m = (size_t)MP + s * DS + t;
            const float dA = __expf(dtv[t] * Ah), xv = bf2f(xr[t]), xdt = xv * dtv[t];
            const unsigned bw[8] = {Bq[t][0].x, Bq[t][0].y, Bq[t][0].z, Bq[t][0].w, Bq[t][1].x, Bq[t][1].y, Bq[t][1].z, Bq[t][1].w};
            const unsigned cw[8] = {Cq[t][0].x, Cq[t][0].y, Cq[t][0].z, Cq[t][0].w, Cq[t][1].x, Cq[t][1].y, Cq[t][1].z, Cq[t][1].w};
            float yy = 0.f;
#pragma unroll
            for (int k = 0; k < 8; ++k) { hs[2 * k] = hs[2 * k] * dA + xdt * __uint_as_float(bw[k] << 16); hs[2 * k + 1] = hs[2 * k + 1] * dA + xdt * __uint_as_float(bw[k] & 0xffff0000u);
                yy += __uint_as_float(cw[k] << 16) * hs[2 * k] + __uint_as_float(cw[k] & 0xffff0000u) * hs[2 * k + 1]; }
            yy += __shfl_xor(yy, 1); yy += __shfl_xor(yy, 2); yy += __shfl_xor(yy, 4);
            if (ns == 0) fb.y[m * MB_INNER + hd * MB_HEAD + p] = yy + Dh * xv;
        }
        float* oo = c.out + O_SSMS + so;
#pragma unroll
        for (int q = 0; q < 4; ++q) *(pg8::f32x4*)(oo + 4 * q) = (pg8::f32x4){hs[4 * q], hs[4 * q + 1], hs[4 * q + 2], hs[4 * q + 3]};
    }
}
constexpr int RC_RS = 144;
constexpr int RC_AT = 0, RC_RT = 4608, RC_BB = 9216, RC_KB = 13824, RC_BH = 18432, RC_KH = 23040, RC_VV = 27648, RC_UT = 32256, RC_GG = 36864;
constexpr int RC_SB = 41472;
constexpr int RC_NAK = 50688, RC_MRB = 53248, RC_MRK = 55808, RC_NS = 80;
constexpr int RC_NAB = 58368;
constexpr int RC_E = 62464;
constexpr int RC_YB = 70656;
constexpr int RC_GL = 78848, RC_BON = 79104, RC_VV2 = 79360, RC_GG2 = RC_VV2 + 4608, RC_END0 = RC_GG2 + 4608;
constexpr int RC_WW = RC_END0, RC_WA = RC_WW + 64 * 144, RC_WG = RC_WA + 64 * 144, RC_WV = RC_WG + 64 * 336, RC_LUO = RC_WV + 64 * 80, RC_END = RC_LUO + 4 * 4608;
constexpr int RC_HB = RC_AT, RC_HBS = 784;
__device__ __forceinline__ bf16x8v rc_nat(const LDSP unsigned char* img, int stride, int row, int kofs) { return *(const LDSP bf16x8v*)(img + row * stride + kofs * 2); }
__device__ __forceinline__ int rc_row(int r, int h5) { return (r & 3) + 8 * (r >> 2) + 4 * h5; }
__device__ __forceinline__ void rc_st16(LDSP unsigned char* p, float v) { *(LDSP bf16_t*)p = (bf16_t)(pk2bf(v, 0.f) & 0xffffu); }


template <int S>
struct RcSub {
    static __device__ __forceinline__ void run(float (&acc)[32], const LDSP float* NAB, LDSP unsigned char* lds, int lane) {
        const float us = acc[S]; rc_st16(lds + RC_UT + S * RC_RS + lane * 2, us);
#pragma unroll
        for (int g4 = 0; g4 < 8; ++g4) { if (4 * g4 + 3 > S) { const pg8::f32x4 nv = *(const LDSP pg8::f32x4*)(NAB + S * 32 + 4 * g4);
#pragma unroll
            for (int e = 0; e < 4; ++e) { if (4 * g4 + e > S) acc[4 * g4 + e] = fmaf(nv[e], us, acc[4 * g4 + e]); } } }
        RcSub<S + 1>::run(acc, NAB, lds, lane);
    }
};
template <> struct RcSub<32> { static __device__ __forceinline__ void run(float (&)[32], const LDSP float*, LDSP unsigned char*, int) {} };

template <int J>
__device__ __forceinline__ void rw_scan_chunked(const Ctx& c, const FastRw& fr, LDSP unsigned char* lds) {
    using namespace cfg; constexpr int j = J;
    const int tid = (int)tid_now(), w = __builtin_amdgcn_readfirstlane(tid >> 6), lane = tid & 63, l31 = lane & 31, h5 = lane >> 5;
    LDSP float* Ef = (LDSP float*)(lds + RC_E); LDSP float* YB = (LDSP float*)(lds + RC_YB); LDSP float* GL = (LDSP float*)(lds + RC_GL); LDSP float* BON = (LDSP float*)(lds + RC_BON);
    LDSP float* NAB = (LDSP float*)(lds + RC_NAB);
    int hcur = -1;
    for (int chain = blockIdx.x; chain < NSEQ * RHEADS; chain += gridDim.x) {
        const int sq = chain / RHEADS, h = chain % RHEADS, T = seq_len(sq), m0 = seq_row0(sq), ch = h * RH + lane;
        const float p_w0 = c.in[I_W0][j * D + ch], p_a0 = c.in[I_A0][j * D + ch], p_kk = c.in[I_KK][j * D + ch], p_ka = c.in[I_KA][j * D + ch], p_rk = c.in[I_RK][(size_t)j * D + ch],
                    p_lnw = c.in[I_LNW][j * D + ch], p_lnb = c.in[I_LNB][j * D + ch], p_v0 = j > 0 ? c.in[I_V0][(j - 1) * D + ch] : 0.f;
        const int ib = (w >> 1) & 1, jb = w & 1;
        f32x16_t ST;
#pragma unroll
        for (int r = 0; r < 16; ++r) ST[r] = 0.f;
        if (w < 4 && sq >= BATCH) { const float* s0 = c.in[I_WKV] + (((size_t)j * DB + (sq - BATCH)) * RHEADS + h) * RH * RH;
#pragma unroll
            for (int r = 0; r < 16; ++r) ST[r] = s0[(size_t)(32 * ib + rc_row(r, h5)) * RH + 32 * jb + l31]; }
        const int nch = (T + 31) / 32;
        if (h != hcur) {
            __syncthreads();
            const bf16_t* lw = fr.lorat + (size_t)j * 4096 * 384;
            for (int ci = tid; ci < 64 * 8; ci += 512) { const int row = ci >> 3, c8 = ci & 7;
                *(LDSP pg8::u32x4*)(lds + RC_WW + row * 144 + c8 * 16) = *(const pg8::u32x4*)(lw + (size_t)(0 * 1024 + h * 64 + row) * 384 + 0 + c8 * 8);
                *(LDSP pg8::u32x4*)(lds + RC_WA + row * 144 + c8 * 16) = *(const pg8::u32x4*)(lw + (size_t)(1 * 1024 + h * 64 + row) * 384 + 64 + c8 * 8); }
            for (int ci = tid; ci < 64 * 20; ci += 512) { const int row = ci / 20, c20 = ci % 20;
                *(LDSP pg8::u32x4*)(lds + RC_WG + row * 336 + c20 * 16) = *(const pg8::u32x4*)(lw + (size_t)(2 * 1024 + h * 64 + row) * 384 + 128 + c20 * 8); }
            for (int ci = tid; ci < 64 * 4; ci += 512) { const int row = ci >> 2, c4 = ci & 3;
                *(LDSP pg8::u32x4*)(lds + RC_WV + row * 80 + c4 * 16) = *(const pg8::u32x4*)(lw + (size_t)(3 * 1024 + h * 64 + row) * 384 + 288 + c4 * 8); }
            hcur = h;
        }
        RwIn in[4]; pg8::u32x4 hbr[3];
#define RC_LOADIN(n) do { _Pragma("unroll") for (int q = 0; q < 4; ++q) { const int t_ = (n) * 32 + 4 * w + q; if (t_ < T) { const size_t m_ = (size_t)(m0 + t_); \
                const bf16_t* rk_ = fr.rkv + m_ * 3072 + ch; in[q].r = rk_[0]; in[q].k = rk_[1024]; in[q].v = rk_[2048]; \
                in[q].vf = j > 0 ? fr.vf[m_ * D + ch] : 0.f; } } \
            _Pragma("unroll") for (int k3 = 0; k3 < 3; ++k3) { const int ci_ = tid + 512 * k3, tk_ = ci_ / 48, t_ = (n) * 32 + tk_; \
                hbr[k3] = t_ < T ? *(const pg8::u32x4*)(fr.hb + (size_t)(m0 + t_) * 384 + (ci_ % 48) * 8) : (pg8::u32x4){0u, 0u, 0u, 0u}; } } while (0)
#define RC_EPI_TOKEN(nn, tl) do { const int vv_ = ((nn) & 1) ? RC_VV2 : RC_VV, gg_ = ((nn) & 1) ? RC_GG2 : RC_GG, bn_ = ((nn) & 1) ? 32 : 0; \
                const float y_ = YB[(tl) * 64 + lane], mean_ = wsum_dpp(y_) * (1.0f / RH), d_ = y_ - mean_, var_ = wsum_dpp(d_ * d_) * (1.0f / RH); \
                const float yn_ = d_ * __builtin_amdgcn_rsqf(var_ + LNX_EPS) * p_lnw + p_lnb; \
                const float o_ = (yn_ + BON[bn_ + (tl)] * bf2f(*(const LDSP bf16_t*)(lds + vv_ + (tl) * RC_RS + lane * 2))) * bf2f(*(const LDSP bf16_t*)(lds + gg_ + (tl) * RC_RS + lane * 2)); \
                fr.yo[(size_t)(m0 + (nn) * 32 + (tl)) * D + ch] = (bf16_t)(pk2bf(o_, 0.f) & 0xffffu); } while (0)
        __syncthreads();
        RC_LOADIN(0);
        for (int n = 0; n < nch; ++n) {
            const int tn = T - n * 32 < 32 ? T - n * 32 : 32;
            const int vvo = (n & 1) ? RC_VV2 : RC_VV, ggo = (n & 1) ? RC_GG2 : RC_GG, bno = (n & 1) ? 32 : 0;
#pragma unroll
            for (int k3 = 0; k3 < 3; ++k3) { const int ci_ = tid + 512 * k3; *(LDSP pg8::u32x4*)(lds + RC_HB + (ci_ / 48) * RC_HBS + (ci_ % 48) * 16) = hbr[k3]; }
            __syncthreads();
            { int ln = lane; asm volatile("" : "+v"(ln)); const int a31 = ln & 31, a5 = ln >> 5; const int grp = w >> 1, nb = w & 1;
              const int koff = grp == 0 ? 0 : (grp == 1 ? 64 : (grp == 2 ? 128 : 288)), nks = grp == 2 ? 10 : (grp == 3 ? 2 : 4);
              const int wof = grp == 0 ? RC_WW : (grp == 1 ? RC_WA : (grp == 2 ? RC_WG : RC_WV)), wst = grp == 2 ? 336 : (grp == 3 ? 80 : 144);
              f32x16_t LA;
#pragma unroll
              for (int r = 0; r < 16; ++r) LA[r] = 0.f;
              for (int ks = 0; ks < nks; ++ks) LA = MFMA32(rc_nat(lds + RC_HB, RC_HBS, a31, koff + 16 * ks + 8 * a5), rc_nat(lds + wof, wst, 32 * nb + a31, 16 * ks + 8 * a5), LA);
#pragma unroll
              for (int r = 0; r < 16; ++r) rc_st16(lds + RC_LUO + grp * 4608 + rc_row(r, a5) * RC_RS + (32 * nb + a31) * 2, LA[r]); }
            __syncthreads();
            float q_r[4], q_k[4], q_a[4], q_b[4], q_e[4];
#pragma unroll
            for (int q = 0; q < 4; ++q) {
                const int tl = 4 * w + q, tg = n * 32 + tl;
                float r_ = 0.f, k2_ = 0.f, v_ = 0.f, a_ = 0.f, b_ = 0.f, e_ = 0.f, g_ = 0.f, bon_ = 0.f;
                if (tg < T) {
                    r_ = bf2f(in[q].r); const float k0_ = bf2f(in[q].k); v_ = bf2f(in[q].v);
                    e_ = 0.6065306597126334f * fsigmoid(p_w0 + bf2f(*(const LDSP bf16_t*)(lds + RC_LUO + 0 * 4608 + tl * RC_RS + lane * 2)));
                    if (j == 0) fr.vf[(size_t)(m0 + tg) * D + ch] = v_; else v_ = v_ + (in[q].vf - v_) * fsigmoid(p_v0 + bf2f(*(const LDSP bf16_t*)(lds + RC_LUO + 3 * 4608 + tl * RC_RS + lane * 2)));
                    const float as_ = fsigmoid(p_a0 + bf2f(*(const LDSP bf16_t*)(lds + RC_LUO + 1 * 4608 + tl * RC_RS + lane * 2))); float kk_ = k0_ * p_kk;
                    k2_ = k0_ * (1.0f + (as_ - 1.0f) * p_ka);
                    float n_ = red16(kk_ * kk_), e1_ = red16(r_ * k2_ * p_rk);
                    n_ = (rdl(n_, 0) + rdl(n_, 16)) + (rdl(n_, 32) + rdl(n_, 48)); bon_ = (rdl(e1_, 0) + rdl(e1_, 16)) + (rdl(e1_, 32) + rdl(e1_, 48));
                    kk_ *= __builtin_amdgcn_rcpf(fmaxf(__builtin_amdgcn_sqrtf(n_), 1e-12f));
                    a_ = -kk_; b_ = kk_ * as_; g_ = bf2f(*(const LDSP bf16_t*)(lds + RC_LUO + 2 * 4608 + tl * RC_RS + lane * 2));
                }
                q_r[q] = r_; q_k[q] = k2_; q_a[q] = a_; q_b[q] = b_; q_e[q] = e_;
                Ef[tl * 64 + lane] = e_;
                rc_st16(lds + vvo + tl * RC_RS + lane * 2, v_); rc_st16(lds + ggo + tl * RC_RS + lane * 2, g_);
                if (lane == 0) BON[bno + tl] = bon_;
            }
            if (n + 1 < nch) RC_LOADIN(n + 1);
            if (w < 4) {
#pragma unroll
                for (int r = 0; r < 16; ++r) rc_st16(lds + RC_SB + (32 * ib + rc_row(r, h5)) * RC_RS + (32 * jb + l31) * 2, ST[r]);
            }
            __syncthreads();
            { float run = 0.f, base = 0.f;
#pragma unroll
              for (int s = 0; s < 32; ++s) { const float ev = Ef[s * 64 + lane]; if (s == 4 * w) base = run; run += ev; }
              const float cumL = run; float cum = base;
#pragma unroll
              for (int q = 0; q < 4; ++q) { const int tl = 4 * w + q; const float cprev = cum; cum += q_e[q];
                  const float gam = __expf(-cum), gamp = __expf(-cprev), ginv = __expf(cum), glr = __expf(cum - cumL);
                  rc_st16(lds + RC_AT + tl * RC_RS + lane * 2, q_a[q] * gamp); rc_st16(lds + RC_RT + tl * RC_RS + lane * 2, q_r[q] * gam);
                  rc_st16(lds + RC_BB + tl * RC_RS + lane * 2, q_b[q] * ginv); rc_st16(lds + RC_KB + tl * RC_RS + lane * 2, q_k[q] * ginv);
                  rc_st16(lds + RC_BH + tl * RC_RS + lane * 2, q_b[q] * glr); rc_st16(lds + RC_KH + tl * RC_RS + lane * 2, q_k[q] * glr); }
              if (w == 0) GL[lane] = __expf(-cumL); }
            __syncthreads();
            f32x16_t R1;
#pragma unroll
            for (int r = 0; r < 16; ++r) R1[r] = 0.f;
            { int ln = lane; asm volatile("" : "+v"(ln)); const int a31 = ln & 31, a5 = ln >> 5;
              if (w < 4) {
                  const int aoff = (w == 0) ? RC_BB : ((w < 2) ? RC_AT : RC_RT), boff = (w == 0) ? RC_AT : ((w & 1) ? RC_KB : RC_BB);
#pragma unroll
                  for (int ks = 0; ks < 4; ++ks) R1 = MFMA32(rc_nat(lds + aoff, RC_RS, a31, 16 * ks + 8 * a5), rc_nat(lds + boff, RC_RS, a31, 16 * ks + 8 * a5), R1);
#pragma unroll
                  for (int r = 0; r < 16; ++r) { const int rr = rc_row(r, a5), cc = a31;
                      if (w == 0) NAB[rr * 32 + cc] = (rr < cc) ? R1[r] : 0.f;
                      else { const bool keep = (w < 2) ? (cc < rr) : (cc <= rr); rc_st16(lds + (w == 1 ? RC_NAK : (w == 2 ? RC_MRB : RC_MRK)) + rr * RC_NS + cc * 2, keep ? R1[r] : 0.f); } }
              } else {
                  const int aoff = (w < 6) ? RC_AT : RC_RT, ibk = w & 1;
#pragma unroll
                  for (int ks = 0; ks < 4; ++ks) R1 = MFMA32(rc_nat(lds + aoff, RC_RS, a31, 16 * ks + 8 * a5), rc_nat(lds + RC_SB, RC_RS, 32 * ibk + a31, 16 * ks + 8 * a5), R1);
              } }
            __syncthreads();
            if (w == 4 || w == 5) { int ln = lane; asm volatile("" : "+v"(ln)); const int a31 = ln & 31, a5 = ln >> 5, ibk = w & 1;
#pragma unroll
                for (int ks = 0; ks < 2; ++ks) R1 = MFMA32(rc_nat(lds + RC_NAK, RC_NS, a31, 16 * ks + 8 * a5), ss_trfrag(lds + vvo, RC_RS, 16 * ks, 32 * ibk, ln), R1);
#pragma unroll
                for (int r = 0; r < 16; ++r) Ef[rc_row(r, a5) * 64 + 32 * ibk + a31] = R1[r]; }
            __syncthreads();
            if (w > 0 && n > 0) { for (int tl = w - 1; tl < 32; tl += 7) RC_EPI_TOKEN(n - 1, tl); }
            if (w == 0) { float acc[32];
#pragma unroll
                for (int t = 0; t < 32; ++t) acc[t] = Ef[t * 64 + lane];
                RcSub<0>::run(acc, NAB, lds, lane); }
            __syncthreads();
            { int ln = lane; asm volatile("" : "+v"(ln)); const int a31 = ln & 31, a5 = ln >> 5;
              if (w >= 6) { const int ibk = w & 1;
#pragma unroll
                  for (int ks = 0; ks < 2; ++ks) { R1 = MFMA32(rc_nat(lds + RC_MRB, RC_NS, a31, 16 * ks + 8 * a5), ss_trfrag(lds + RC_UT, RC_RS, 16 * ks, 32 * ibk, ln), R1);
                                                   R1 = MFMA32(rc_nat(lds + RC_MRK, RC_NS, a31, 16 * ks + 8 * a5), ss_trfrag(lds + vvo, RC_RS, 16 * ks, 32 * ibk, ln), R1); }
#pragma unroll
                  for (int r = 0; r < 16; ++r) YB[rc_row(r, a5) * 64 + 32 * ibk + a31] = R1[r];
              } else if (w < 4) { const float gl = GL[32 * jb + a31];
#pragma unroll
                  for (int r = 0; r < 16; ++r) ST[r] *= gl;
#pragma unroll
                  for (int ks = 0; ks < 2; ++ks) { ST = MFMA32(ss_trfrag(lds + RC_UT, RC_RS, 16 * ks, 32 * ib, ln), ss_trfrag(lds + RC_BH, RC_RS, 16 * ks, 32 * jb, ln), ST);
                                                   ST = MFMA32(ss_trfrag(lds + vvo, RC_RS, 16 * ks, 32 * ib, ln), ss_trfrag(lds + RC_KH, RC_RS, 16 * ks, 32 * jb, ln), ST); } } }
            __syncthreads();
        }
        { const int nl = nch - 1, tnl = T - nl * 32 < 32 ? T - nl * 32 : 32; for (int tl = w; tl < tnl; tl += 8) RC_EPI_TOKEN(nl, tl); }
#undef RC_EPI_TOKEN
#undef RC_LOADIN
        if (w < 4) { float* so = (sq < BATCH ? c.out + O_WKVP + (((size_t)j * BATCH + sq) * RHEADS + h) * RH * RH : c.out + O_WKVS + (((size_t)j * DB + (sq - BATCH)) * RHEADS + h) * RH * RH);
#pragma unroll
            for (int r = 0; r < 16; ++r) so[(size_t)(32 * ib + rc_row(r, h5)) * RH + 32 * jb + l31] = ST[r]; }
    }
}
template <int ACT, bool ACC>
__device__ __forceinline__ void gemm_dev(const float* __restrict__ A, int lda, const float* __restrict__ B, int ldb, float* C, int ldc, int M, int N, int K, unsigned short (*As)[40], unsigned short (*Bs)[40]) {
    const int tid = threadIdx.x, wave = tid >> 6, lane = tid & 63, wr = wave >> 1, wc = wave & 1, fr = lane & 15, fq = lane >> 4;
    const int ntn = (N + 127) / 128, ntm = (M + 127) / 128;
    for (int tile = blockIdx.x; tile < ntm * ntn; tile += gridDim.x) {
        const int bm = (tile / ntn) * 128, bn = (tile % ntn) * 128;
        f32x4_t acc[2][4];
#pragma unroll
        for (int i = 0; i < 2; ++i)
#pragma unroll
            for (int j = 0; j < 4; ++j) acc[i][j] = (f32x4_t){0.f, 0.f, 0.f, 0.f};
        for (int k0 = 0; k0 < K; k0 += 32) {
#pragma unroll
            for (int it = 0; it < 2; ++it) {
                const int idx = tid + it * 512, row = idx >> 3, c4 = idx & 7, gm = bm + row;
                float4 v = make_float4(0.f, 0.f, 0.f, 0.f);
                if (gm < M) v = *(const float4*)(A + (size_t)gm * lda + k0 + c4 * 4);
                uint2 w; w.x = (unsigned)f2bf(v.x) | ((unsigned)f2bf(v.y) << 16); w.y = (unsigned)f2bf(v.z) | ((unsigned)f2bf(v.w) << 16);
                *(uint2*)&As[row][c4 * 4] = w;
            }
#pragma unroll
            for (int it = 0; it < 2; ++it) {
                const int idx = tid + it * 512, kr = idx >> 5, n4 = idx & 31, gn = bn + n4 * 4;
                float4 v = make_float4(0.f, 0.f, 0.f, 0.f);
                if (gn < N) v = *(const float4*)(B + (size_t)(k0 + kr) * ldb + gn);
                Bs[n4 * 4 + 0][kr] = f2bf(v.x); Bs[n4 * 4 + 1][kr] = f2bf(v.y); Bs[n4 * 4 + 2][kr] = f2bf(v.z); Bs[n4 * 4 + 3][kr] = f2bf(v.w);
            }
            __syncthreads();
            bf16x8_t a[2], b[4];
#pragma unroll
            for (int i = 0; i < 2; ++i) a[i] = *(const bf16x8_t*)&As[wr * 32 + i * 16 + fr][fq * 8];
#pragma unroll
            for (int j = 0; j < 4; ++j) b[j] = *(const bf16x8_t*)&Bs[wc * 64 + j * 16 + fr][fq * 8];
#pragma unroll
            for (int i = 0; i < 2; ++i)
#pragma unroll
                for (int j = 0; j < 4; ++j) acc[i][j] = __builtin_amdgcn_mfma_f32_16x16x32_bf16(a[i], b[j], acc[i][j], 0, 0, 0);
            __syncthreads();
        }
#pragma unroll
        for (int i = 0; i < 2; ++i)
#pragma unroll
            for (int j = 0; j < 4; ++j)
#pragma unroll
                for (int e = 0; e < 4; ++e) {
                    const int row = bm + wr * 32 + i * 16 + fq * 4 + e, col = bn + wc * 64 + j * 16 + fr;
                    if (row < M && col < N) {
                        float v = acc[i][j][e];
                        if (ACT == 1) v = tanhf(v); else if (ACT == 2) v = 1.0f / (1.0f + expf(-v)); else if (ACT == 3) v = v > 0.f ? v * v : 0.f;
                        float* cp = C + (size_t)row * ldc + col; *cp = ACC ? *cp + v : v;
                    }
                }
    }
}

#define MRUN(ph, l) do { ph(c, l, gtid, gsz); xcd_barrier(bar); } while (0)
#define MGEMM(ACT, ACC, A, lda, B, ldb, C, ldc, M, N, K) do { gemm_dev<ACT, ACC>(A, lda, B, ldb, C, ldc, M, N, K, As, Bs); xcd_barrier(bar); } while (0)
#define KS_FFN 16
#define KS_1K 4
#define KS_MB 8
#ifndef ACC_KSPLIT
#define ACC_KSPLIT 1
#endif
#ifndef FFN_DOWN_KSPLIT
#define FFN_DOWN_KSPLIT 1
#endif
#define GBAR() xcd_barrier(bar)
#ifndef PROBE_DUP
#define PROBE_DUP 0
#endif
#define DUP(bit, ...) do { __VA_ARGS__; if (PROBE_DUP & (1 << (bit))) { GBAR(); __VA_ARGS__; } } while (0)
#define GTID_NOW() ((size_t)blockIdx.x * 512 + tid_now())
#define GSZ_NOW() ((size_t)gridDim.x * 512)
#define GW_NOW() ((int)(blockIdx.x * 8 + (tid_now() >> 6)))
#define NGW_NOW() ((int)(gridDim.x * 8))
#define LANE_NOW() ((int)(tid_now() & 63))
#undef MRUN
#undef MGEMM
#define MRUN(ph, l) do { ph(c, l, GTID_NOW(), GSZ_NOW()); xcd_barrier(bar); } while (0)
#define MGEMM(ACT, ACC, A, lda, B, ldb, C, ldc, M, N, K) do { gemm_dev<ACT, ACC>(A, lda, B, ldb, C, ldc, M, N, K, (unsigned short (*)[40])dynlds, (unsigned short (*)[40])(dynlds + 128 * 40 * 2)); xcd_barrier(bar); } while (0)
extern __shared__ __attribute__((aligned(16))) unsigned char dynlds[];

struct MegaArgs { Ctx c; Fast f; FastMla fm; FastRw fr; FastMb fb; unsigned* bar; };
constexpr int LDS_STAGE = 0, LDS_XB = 163840 - 64, LDS_BYTES = 163840;
static_assert(SD_END <= LDS_XB && SS_END <= LDS_XB && RC_END <= LDS_XB, "LDS map");

template <int L>
__device__ __forceinline__ void layer_mix_naive(const Ctx& c, const XcdBarrier& bar) {
    using namespace cfg;
    constexpr int l = L, kind = L % 3, j = L / 3;
    MRUN(ph_norm_mix, l);
    if constexpr (kind == 0) {
        MRUN(ph_rw_mix, l);
        const float* W = c.in[I_WRKV] + (size_t)j * 3 * D * D;
        MGEMM(0, false, c.xm[0], D, W, D, c.r, D, MTOT, D, D);
        MGEMM(0, false, c.xm[1], D, W + (size_t)D * D, D, c.k, D, MTOT, D, D);
        MGEMM(0, false, c.xm[2], D, W + (size_t)2 * D * D, D, c.v, D, MTOT, D, D);
        MGEMM(1, false, c.xm[3], D, c.in[I_W1] + (size_t)j * D * RW_DL, RW_DL, c.hw, RW_DL, MTOT, RW_DL, D);
        MGEMM(0, false, c.hw, RW_DL, c.in[I_W2] + (size_t)j * RW_DL * D, D, c.wpre, D, MTOT, D, RW_DL);
        MGEMM(0, false, c.xm[4], D, c.in[I_A1] + (size_t)j * D * RW_AL, RW_AL, c.ha, RW_AL, MTOT, RW_AL, D);
        MGEMM(0, false, c.ha, RW_AL, c.in[I_A2] + (size_t)j * RW_AL * D, D, c.apre, D, MTOT, D, RW_AL);
        if constexpr (j > 0) {
            MGEMM(0, false, c.xm[2], D, c.in[I_V1] + (size_t)(j - 1) * D * RW_VL, RW_VL, c.hv, RW_VL, MTOT, RW_VL, D);
            MGEMM(0, false, c.hv, RW_VL, c.in[I_V2] + (size_t)(j - 1) * RW_VL * D, D, c.vpre, D, MTOT, D, RW_VL);
        }
        MGEMM(2, false, c.xm[5], D, c.in[I_G1] + (size_t)j * D * RW_GL, RW_GL, c.hg, RW_GL, MTOT, RW_GL, D);
        MGEMM(0, false, c.hg, RW_GL, c.in[I_G2] + (size_t)j * RW_GL * D, D, c.g, D, MTOT, D, RW_GL);
        MRUN(ph_rw_prep, l); MRUN(ph_rw_scan, l); MRUN(ph_rw_post, l);
        MGEMM(0, true, c.yo, D, c.in[I_RWO] + (size_t)j * D * D, D, c.x, D, MTOT, D, D);
    } else if constexpr (kind == 1) {
        MGEMM(0, false, c.xn, D, c.in[I_MWIN] + (size_t)j * D * MLA_IN, MLA_IN, c.mh, MLA_IN, MTOT, MLA_IN, D);
        MRUN(ph_mla_norm1, l);
        MGEMM(0, false, c.qan, QL, c.in[I_WUQ] + (size_t)j * QL * MH * QD, MH * QD, c.q, MH * QD, MTOT, MH * QD, QL);
        MGEMM(0, false, c.c, KVL, c.in[I_WUK] + (size_t)j * KVL * MH * NOPE, MH * NOPE, c.knr, MH * NOPE, MTOT, MH * NOPE, KVL);
        MGEMM(0, false, c.c, KVL, c.in[I_WUV] + (size_t)j * KVL * MH * VD, MH * VD, c.vv, MH * VD, MTOT, MH * VD, KVL);
        MRUN(ph_mla_norm2, l); MRUN(ph_mla_attn_prompt, l); MRUN(ph_mla_score_sample, l); MRUN(ph_mla_softmax_sample, l); MRUN(ph_mla_pv_sample, l); MRUN(ph_mla_out_sample, l);
        MGEMM(0, true, c.ao, MH * VD, c.in[I_MWO] + (size_t)j * MH * VD * D, D, c.x, D, MTOT, D, MH * VD);
    } else {
        MGEMM(0, false, c.xn, D, c.in[I_BWIN] + (size_t)j * D * MB_IN, MB_IN, c.zx, MB_IN, MTOT, MB_IN, D);
        MRUN(ph_mb_conv, l); MRUN(ph_mb_dt, l); MRUN(ph_mb_scan, l); MRUN(ph_mb_gate, l);
        MGEMM(0, true, c.yzn, MB_INNER, c.in[I_BWO] + (size_t)j * MB_INNER * D, D, c.x, D, MTOT, D, MB_INNER);
    }
}


template <int L>
__device__ __forceinline__ void layer_rwkv_fast(const Ctx& c, const Fast& f, const FastRw& fr, const XcdBarrier& bar, LDSP unsigned char* lds) {
    using namespace cfg;
    constexpr int l = L, j = L / 3;
    if (L > 0) { fold_sample_rows(c.x, f.slab, KS_FFN, GW_NOW(), NGW_NOW(), LANE_NOW()); GBAR(); }
    DUP(9, rw_mix_fast(c, fr, l, GW_NOW(), NGW_NOW(), LANE_NOW()));
    GBAR();
    DUP(7, { pg8::Order<RwSel> S; S.init(MP / 256, MS / 256, 16, D, 1, gridDim.x, blockIdx.x);
      pg8::gemm_phase(lds, pg8::Gemm{fr.xm, fr.wrkvt + (size_t)j * 4096 * D, D, D, (size_t)MTOT * D}, S, EpiRwkv{fr.rkv, fr.hb}); });
    GBAR();
    DUP(2, rw_scan_chunked<j>(c, fr, lds));
    GBAR();
    { pg8::Order<> S; S.init(MP / 256, MS / 256, 4, D, KS_1K, gridDim.x, blockIdx.x);
      pg8::gemm_phase(lds, pg8::Gemm{fr.yo, fr.wot + (size_t)j * D * D, D, D, 0}, S, pg8::EpiAccF32{c.x, D, f.slab, MP / 256, MS / 256, KS_1K}); }
    if (PROBE_DUP & (1 << 26)) { GBAR(); pg8::Order<> S; S.init(MP / 256, MS / 256, 4, D, KS_1K, gridDim.x, blockIdx.x);
      pg8::gemm_phase(lds, pg8::Gemm{fr.yo, fr.wot + (size_t)j * D * D, D, D, 0}, S, pg8::EpiAccF32{c.hmid, D, f.slab + (size_t)16 * 16 * 65536, MP / 256, MS / 256, KS_1K}); }
    GBAR();
}

__device__ __forceinline__ void layer_mamba_fast(const Ctx& c, const Fast& f, const FastMb& fb, const XcdBarrier& bar, LDSP unsigned char* lds) {
    using namespace cfg;
    constexpr int l = 2, j = 0;
    norm_rows_bf16(c.x, c.in[I_NMIX] + l * D, f.xnb, f.slab, KS_FFN, GW_NOW(), NGW_NOW(), LANE_NOW());
    GBAR();
    DUP(8, { pg8::Order<> S; S.init(MP / 256, MS / 256, 21, D, 1, gridDim.x, blockIdx.x);
      pg8::gemm_phase(lds, pg8::Gemm{f.xnb, fb.wbint, D, D, 0}, S, EpiMamba{fb.zb, fb.xbcr, fb.dtraw}); });
    GBAR();
    DUP(12, mb_conv_fast(c, fb, l, GTID_NOW(), GSZ_NOW(), false));
    GBAR();
    DUP(6, mb_ssd_prompt(c, fb, l, lds); mb_scan_sample(c, fb, l));
    GBAR();
    DUP(13, mb_gate_fast(c, fb, fb.y, l, GW_NOW(), NGW_NOW(), LANE_NOW()));
    GBAR();
    { pg8::Order<> S; S.init(MP / 256, MS / 256, 4, MB_INNER, KS_MB, gridDim.x, blockIdx.x);
      pg8::gemm_phase(lds, pg8::Gemm{fb.yzn, fb.wbot, MB_INNER, MB_INNER, 0}, S, pg8::EpiAccF32{c.x, D, f.slab, MP / 256, MS / 256, KS_MB}); }
    if (PROBE_DUP & (1 << 28)) { GBAR(); pg8::Order<> S; S.init(MP / 256, MS / 256, 4, MB_INNER, KS_MB, gridDim.x, blockIdx.x);
      pg8::gemm_phase(lds, pg8::Gemm{fb.yzn, fb.wbot, MB_INNER, MB_INNER, 0}, S, pg8::EpiAccF32{c.hmid, D, f.slab + (size_t)16 * 16 * 65536, MP / 256, MS / 256, KS_MB}); }
    GBAR();
}

__device__ __forceinline__ void layer_mla_fast(const Ctx& c, const Fast& f, const FastMla& fm, const XcdBarrier& bar, LDSP unsigned char* lds) {
    using namespace cfg;
    constexpr int l = 1, j = 0;
    norm_rows_bf16(c.x, c.in[I_NMIX] + l * D, f.xnb, f.slab, KS_FFN, GW_NOW(), NGW_NOW(), LANE_NOW());
    GBAR();
    DUP(27, { pg8::Order<> S; S.init(MP / 256, MS / 256, 4, D, 1, gridDim.x, blockIdx.x);
      pg8::gemm_phase(lds, pg8::Gemm{f.xnb, fm.wint, D, D, 0}, S, pg8::EpiF32{fm.mh, 1024, 1024}); });
    GBAR();
    DUP(14, mla_norm1_fast(c, fm, j, GW_NOW(), NGW_NOW(), LANE_NOW()));
    GBAR();
    DUP(27, { pg8::Order<> S; S.init(MP / 256, MS / 256, (MH * QD) / 256, QL, 1, gridDim.x, blockIdx.x);
      pg8::gemm_phase(lds, pg8::Gemm{fm.qan, fm.wuqt, QL, QL, 0}, S, pg8::EpiBf16<0>{fm.qraw, MH * QD}); }
    { pg8::Order<> S; S.init(MP / 256, MS / 256, 4, KVL, 1, gridDim.x, blockIdx.x);
      pg8::gemm_phase(lds, pg8::Gemm{fm.cb, fm.wukvt, KVL, KVL, 0}, S, pg8::EpiBf16<0>{fm.kvraw, 2048}); }
    { pg8::Order<> S; S.init(4, 0, MTOT / 256, KVL, 1, gridDim.x, blockIdx.x);
      pg8::gemm_phase(lds, pg8::Gemm{fm.wukvt + (size_t)1024 * KVL, fm.cb, KVL, KVL, 0}, S, pg8::EpiBf16<0>{fm.vT, MTOT}); });
    GBAR();
    DUP(15, mla_norm2_fast(c, fm, j, GW_NOW(), NGW_NOW(), LANE_NOW()));
    { const unsigned t_ = (unsigned)GTID_NOW(); if (t_ < 96) *(pg8::u32x4*)(fm.qs + (size_t)MS * 1536 + t_ * 8) = (pg8::u32x4){0u, 0u, 0u, 0u}; }
    GBAR();
    DUP(5, attn_prompt_fast(fm.qf, fm.knb, fm.kpb, fm.vT, fm.aob, lds));
    __syncthreads();
    DUP(4, mla_sample_decode(c, fm, fm.qs, fm.opart, fm.lpart, j, lds));
    GBAR();
    DUP(16, mla_sample_combine(c, fm, fm.opart, fm.lpart, j, lds));
    GBAR();
    { pg8::Order<> S; S.init(MP / 256, MS / 256, 4, D, KS_1K, gridDim.x, blockIdx.x);
      pg8::gemm_phase(lds, pg8::Gemm{fm.aob, fm.wot, D, D, 0}, S, pg8::EpiAccF32{c.x, D, f.slab, MP / 256, MS / 256, KS_1K}); }
    if (PROBE_DUP & (1 << 27)) { GBAR(); pg8::Order<> S; S.init(MP / 256, MS / 256, 4, D, KS_1K, gridDim.x, blockIdx.x);
      pg8::gemm_phase(lds, pg8::Gemm{fm.aob, fm.wot, D, D, 0}, S, pg8::EpiAccF32{c.hmid, D, f.slab + (size_t)16 * 16 * 65536, MP / 256, MS / 256, KS_1K}); }
    GBAR();
}

template <int L>
__device__ __forceinline__ void layer_ffn_fast(const Ctx& c, const Fast& f, const XcdBarrier& bar, LDSP unsigned char* lds) {
    using namespace cfg;
    norm_rows_bf16(c.x, c.in[I_NFFN] + L * D, f.xnb, f.slab, (L % 3 == 2) ? KS_MB : KS_1K, GW_NOW(), NGW_NOW(), LANE_NOW());
    GBAR();
    DUP(0, { pg8::Order<> S; S.init(MP / 256, MS / 256, FFN / 256, D, 1, gridDim.x, blockIdx.x);
      pg8::gemm_phase(lds, pg8::Gemm{f.xnb, f.w1t + (size_t)L * FFN * D, D, D, 0}, S, pg8::EpiBf16<3>{f.hmidb, FFN}); });
    GBAR();
    { pg8::Order<> S; S.init(MP / 256, MS / 256, D / 256, FFN, (L == DEPTH - 1) ? 1 : KS_FFN, gridDim.x, blockIdx.x);
      pg8::gemm_phase(lds, pg8::Gemm{f.hmidb, f.w2t + (size_t)L * D * FFN, FFN, FFN, 0}, S, pg8::EpiAccF32{c.x, D, f.slab, MP / 256, MS / 256, (L == DEPTH - 1) ? 1 : KS_FFN}); }
    if (PROBE_DUP & (1 << 25)) { GBAR(); pg8::Order<> S; S.init(MP / 256, MS / 256, D / 256, FFN, (L == DEPTH - 1) ? 1 : KS_FFN, gridDim.x, blockIdx.x);
      pg8::gemm_phase(lds, pg8::Gemm{f.hmidb, f.w2t + (size_t)L * D * FFN, FFN, FFN, 0}, S, pg8::EpiAccF32{c.hmid, D, f.slab + (size_t)16 * 16 * 65536, MP / 256, MS / 256, (L == DEPTH - 1) ? 1 : KS_FFN}); }
    GBAR();
}

__global__ void __launch_bounds__(512, 2) mega10(MegaArgs a) {
    LDSP unsigned char* lds = (LDSP unsigned char*)dynlds;
    if (threadIdx.x < 4) ((LDSP unsigned*)(lds + LDS_XB))[threadIdx.x] = 0u;
    __syncthreads();
    XcdBarrier bar = xcd_barrier_post(a.bar, (volatile LAS unsigned*)(lds + LDS_XB));
    const Ctx& c = a.c; const Fast& f = a.f; const FastMla& fm = a.fm; const FastRw& fr = a.fr; const FastMb& fb = a.fb;
    using namespace cfg;
    DUP(10, {
        LDSP float* scr = (LDSP float*)(lds + LDS_STAGE) + (tid_now() >> 6) * (64 * 33);
        for (int l = 0; l < DEPTH; ++l) {
            tr_weight(c.in[I_FW1] + (size_t)l * D * FFN, D, FFN, FFN, f.w1t + (size_t)l * FFN * D, nullptr, scr, GW_NOW(), NGW_NOW(), LANE_NOW());
            tr_weight(c.in[I_FW2] + (size_t)l * FFN * D, FFN, D, D, f.w2t + (size_t)l * D * FFN, nullptr, scr, GW_NOW(), NGW_NOW(), LANE_NOW());
        }
        tr_weight(c.in[I_MWIN], D, MLA_IN, 1024, fm.wint, nullptr, scr, GW_NOW(), NGW_NOW(), LANE_NOW());
        tr_weight(c.in[I_WUQ], QL, MH * QD, MH * QD, fm.wuqt, nullptr, scr, GW_NOW(), NGW_NOW(), LANE_NOW());
        tr_weight(c.in[I_WUK], KVL, MH * NOPE, MH * NOPE, fm.wukvt, nullptr, scr, GW_NOW(), NGW_NOW(), LANE_NOW());
        tr_weight(c.in[I_WUV], KVL, MH * VD, MH * VD, fm.wukvt + (size_t)1024 * KVL, nullptr, scr, GW_NOW(), NGW_NOW(), LANE_NOW());
        tr_weight(c.in[I_MWO], MH * VD, D, D, fm.wot, nullptr, scr, GW_NOW(), NGW_NOW(), LANE_NOW());
        for (int j = 0; j < N_RWKV; ++j) {
            bf16_t* wt = fr.wrkvt + (size_t)j * 4096 * D;
            for (int p = 0; p < 3; ++p) tr_weight(c.in[I_WRKV] + ((size_t)j * 3 + p) * D * D, D, D, D, wt + (size_t)p * D * D, nullptr, scr, GW_NOW(), NGW_NOW(), LANE_NOW());
            tr_weight(c.in[I_W1] + (size_t)j * D * RW_DL, D, RW_DL, 256, wt + (size_t)3072 * D, nullptr, scr, GW_NOW(), NGW_NOW(), LANE_NOW());
            tr_weight(c.in[I_A1] + (size_t)j * D * RW_AL, D, RW_AL, 256, wt + (size_t)3328 * D, nullptr, scr, GW_NOW(), NGW_NOW(), LANE_NOW());
            tr_weight(c.in[I_G1] + (size_t)j * D * RW_GL, D, RW_GL, 256, wt + (size_t)3584 * D, nullptr, scr, GW_NOW(), NGW_NOW(), LANE_NOW());
            tr_weight(j > 0 ? c.in[I_V1] + (size_t)(j - 1) * D * RW_VL : c.in[I_W1], D, j > 0 ? RW_VL : 0, 256, wt + (size_t)3840 * D, nullptr, scr, GW_NOW(), NGW_NOW(), LANE_NOW());
            tr_weight(c.in[I_RWO] + (size_t)j * D * D, D, D, D, fr.wot + (size_t)j * D * D, nullptr, scr, GW_NOW(), NGW_NOW(), LANE_NOW());
            rw_build_lorat(c, fr.lorat + (size_t)j * 4096 * 384, j, GTID_NOW(), GSZ_NOW());
        }
        tr_weight(c.in[I_BWIN], D, MB_IN, 5376, fb.wbint, nullptr, scr, GW_NOW(), NGW_NOW(), LANE_NOW());
        tr_weight(c.in[I_BWO], MB_INNER, D, D, fb.wbot, nullptr, scr, GW_NOW(), NGW_NOW(), LANE_NOW());
        ph_copy_x(c, 0, GTID_NOW(), GSZ_NOW());
    });
    GBAR();
    layer_rwkv_fast<0>(c, f, fr, bar, lds); layer_ffn_fast<0>(c, f, bar, lds);
    layer_mla_fast(c, f, fm, bar, lds); layer_ffn_fast<1>(c, f, bar, lds);
    layer_mamba_fast(c, f, fb, bar, lds); layer_ffn_fast<2>(c, f, bar, lds);
    layer_rwkv_fast<3>(c, f, fr, bar, lds); layer_ffn_fast<3>(c, f, bar, lds);
}

extern "C" void kernel_launch(void* const* d_in, const int* in_sizes, int n_in, void* d_out, int out_size, void* d_ws, size_t ws_size, hipStream_t stream) {
    using namespace cfg;
    MegaArgs a{};
    size_t used = setup_ctx(a.c, d_in, d_out, d_ws);
    { Bump b{(char*)d_ws, (size_t)((char*)a.c.xm[0] - (char*)d_ws)}; FastRw& r = a.fr;
      r.xm = (bf16_t*)b.f((size_t)6 * MTOT * D / 2); r.rkv = (bf16_t*)b.f((size_t)MTOT * 3072 / 2); r.hb = (bf16_t*)b.f((size_t)MTOT * 384 / 2); r.lu = (bf16_t*)b.f((size_t)MTOT * 4096 / 2);
      r.ops = b.f((size_t)MTOT * RHEADS * RW_REC + 4096); r.yo = (bf16_t*)b.f((size_t)MTOT * D / 2); r.vf = a.c.vf;
      if (b.off > (size_t)((char*)a.c.hmid - (char*)d_ws) + (size_t)MTOT * FFN * 4) { fprintf(stderr, "RWKV overlay too large\n"); return; } }
    { Bump b{(char*)d_ws, used};
      a.f.xnb = (bf16_t*)b.f((size_t)MTOT * D / 2); a.f.hmidb = (bf16_t*)b.f((size_t)MTOT * FFN / 2);
      a.f.w1t = (bf16_t*)b.f((size_t)DEPTH * FFN * D / 2); a.f.w2t = (bf16_t*)b.f((size_t)DEPTH * FFN * D / 2); a.f.slab = b.f((size_t)2 * 16 * 16 * 65536);
      FastMla& m = a.fm;
      m.mh = b.f((size_t)MTOT * 1024); m.qan = (bf16_t*)b.f((size_t)MTOT * QL / 2); m.cb = (bf16_t*)b.f((size_t)MTOT * KVL / 2); m.kpb = (bf16_t*)b.f((size_t)MTOT * ROPE / 2);
      m.qraw = (bf16_t*)b.f((size_t)MTOT * 1536 / 2); m.kvraw = (bf16_t*)b.f((size_t)MTOT * 2048 / 2); m.qf = (bf16_t*)b.f((size_t)MTOT * 1536 / 2); m.knb = (bf16_t*)b.f((size_t)MTOT * 1024 / 2);
      m.aob = (bf16_t*)b.f((size_t)MTOT * 1024 / 2); m.vT = (bf16_t*)b.f((size_t)MTOT * 1024 / 2); m.qs = (bf16_t*)b.f((size_t)MS * 1536 / 2 + 1024);
      m.opart = b.f((size_t)2 * DB * 128 * 256); m.lpart = b.f((size_t)2 * DB * 128);
      m.wint = (bf16_t*)b.f((size_t)1024 * 1024 / 2); m.wuqt = (bf16_t*)b.f((size_t)1536 * 512 / 2); m.wukvt = (bf16_t*)b.f((size_t)2048 * 256 / 2); m.wot = (bf16_t*)b.f((size_t)1024 * 1024 / 2);
      { FastMb& q = a.fb; q.zb = (bf16_t*)b.f((size_t)MTOT * 2048 / 2); q.xbcr = (bf16_t*)b.f((size_t)MTOT * 3072 / 2); q.dtraw = b.f((size_t)MTOT * 32); q.xbcb = (bf16_t*)b.f((size_t)MTOT * 3072 / 2);
        q.dt = b.f((size_t)MTOT * 32); q.y = a.c.my; q.yzn = (bf16_t*)b.f((size_t)MTOT * 2048 / 2); q.wbint = (bf16_t*)b.f((size_t)5376 * 1024 / 2); q.wbot = (bf16_t*)b.f((size_t)1024 * 2048 / 2); }
      a.fr.wrkvt = (bf16_t*)b.f((size_t)N_RWKV * 4096 * D / 2); a.fr.lorat = (bf16_t*)b.f((size_t)N_RWKV * 4096 * 384 / 2); a.fr.wot = (bf16_t*)b.f((size_t)N_RWKV * D * D / 2);
      used = b.off; }
    if (used > ws_size || n_in != 51) { fprintf(stderr, "workspace too small: need %zu have %zu (n_in %d)\n", used, ws_size, n_in); return; }
    a.bar = (unsigned*)d_ws;
    static int grid = 0;
    if (!grid) {
        int dev = 0, cus = 0, per_cu = 0;
        (void)hipGetDevice(&dev); (void)hipDeviceGetAttribute(&cus, hipDeviceAttributeMultiprocessorCount, dev);
        if (hipFuncSetAttribute((const void*)mega10, hipFuncAttributeMaxDynamicSharedMemorySize, LDS_BYTES) != hipSuccess) { fprintf(stderr, "hipFuncSetAttribute failed\n"); grid = -1; return; }
        (void)hipOccupancyMaxActiveBlocksPerMultiprocessor(&per_cu, (const void*)mega10, 512, LDS_BYTES);
        (void)hipGetLastError();
        grid = per_cu >= 1 ? (cus < 256 ? cus : 256) : -1;
    }
    if (grid <= 0) { fprintf(stderr, "kernel does not fit one workgroup per CU\n"); return; }
    (void)hipMemsetAsync(a.bar, 0, XCD_BAR_WORDS * sizeof(unsigned), stream);
    hipLaunchKernelGGL(mega10, dim3(grid), dim3(512), LDS_BYTES, stream, a);
}
```

```cpp
#include <hip/hip_runtime.h>
#include <cstdio>
#include <math.h>
#include <stdint.h>
#include <stddef.h>
#ifdef CPU_EMU
#define DEV inline
#else
#define DEV __device__ __forceinline__
#endif

namespace cfg {
#ifdef CFG_SMALL
constexpr int D = 128, BATCH = 2, SEQ = 32, DEPTH = 4, DB = 3, DS = 8, PAST = 64, PAGE = 16;
constexpr int RW_DL = 16, RW_AL = 16, RW_VL = 8, RW_GL = 24;
constexpr int MH = 2, QL = 64, KVL = 32;
constexpr int MB_GROUPS = 2;
#else
constexpr int D = 1024, BATCH = 16, SEQ = 2048, DEPTH = 4, DB = 128, DS = 8, PAST = 8192, PAGE = 128;
constexpr int RW_DL = 64, RW_AL = 64, RW_VL = 32, RW_GL = 160;
constexpr int MH = 16, QL = 512, KVL = 256;
constexpr int MB_GROUPS = 4;
#endif
constexpr int N_RWKV = (DEPTH + 2) / 3, N_MLA = (DEPTH + 1) / 3, N_MAMBA = DEPTH / 3;
constexpr int RH = 64, RHEADS = D / RH;
constexpr int NOPE = 64, ROPE = 32, VD = 64, QD = NOPE + ROPE;
constexpr int MLA_IN = QL + KVL + ROPE;
constexpr int MB_INNER = 2 * D, MB_HEAD = 64, MB_HEADS = MB_INNER / MB_HEAD, MB_STATE = 128, MB_CONV = 4;
constexpr int MB_GN = MB_GROUPS * MB_STATE;
constexpr int MB_CD = MB_INNER + 2 * MB_GN, MB_IN = MB_INNER + MB_CD + MB_HEADS;
constexpr int FFN = 4 * D;
constexpr int NPAGES = PAST / PAGE, NPOOL = (DB * NPAGES * 5) / 4;
constexpr int MP = BATCH * SEQ, MS = DB * DS, MTOT = MP + MS, NSEQ = BATCH + DB;
constexpr int KTOT = PAST + DS;
constexpr float NORM_EPS = 1e-6f, LNX_EPS = 64e-5f;
constexpr size_t O_YP = 0;
constexpr size_t O_YS = O_YP + (size_t)MP * D;
constexpr size_t O_CKVP = O_YS + (size_t)MS * D;
constexpr size_t O_KPEP = O_CKVP + (size_t)N_MLA * MP * KVL;
constexpr size_t O_CKVS = O_KPEP + (size_t)N_MLA * MP * ROPE;
constexpr size_t O_KPES = O_CKVS + (size_t)N_MLA * MS * KVL;
constexpr size_t O_WKVP = O_KPES + (size_t)N_MLA * MS * ROPE;
constexpr size_t O_SHP = O_WKVP + (size_t)N_RWKV * BATCH * RHEADS * RH * RH;
constexpr size_t O_WKVS = O_SHP + (size_t)N_RWKV * BATCH * D;
constexpr size_t O_SHS = O_WKVS + (size_t)N_RWKV * DB * RHEADS * RH * RH;
constexpr size_t O_SSMP = O_SHS + (size_t)N_RWKV * DB * D;
constexpr size_t O_CONVP = O_SSMP + (size_t)N_MAMBA * BATCH * MB_HEADS * MB_HEAD * MB_STATE;
constexpr size_t O_SSMS = O_CONVP + (size_t)N_MAMBA * BATCH * (MB_CONV - 1) * MB_CD;
constexpr size_t O_CONVS = O_SSMS + (size_t)N_MAMBA * DB * MB_HEADS * MB_HEAD * MB_STATE;
constexpr size_t O_END = O_CONVS + (size_t)N_MAMBA * DB * (MB_CONV - 1) * MB_CD;
}

struct Ctx {
    const float* in[51];
    const int* page_table;
    float* out;
    float *x, *xn, *vf;
    float* xm[6];
    float *r, *k, *v, *wpre, *apre, *vpre, *g, *hw, *ha, *hv, *hg, *ka, *kb, *y, *yo;
    float *hmid;
    float *mh, *qan, *q, *c, *kp, *knr, *vv, *ao, *sc, *olat;
    float *zx, *xbc, *dt, *my, *yzn;
};

DEV int row_t(int m) { return m < cfg::MP ? m % cfg::SEQ : (m - cfg::MP) % cfg::DS; }
DEV int row_seq(int m) { return m < cfg::MP ? m / cfg::SEQ : cfg::BATCH + (m - cfg::MP) / cfg::DS; }
DEV int seq_row0(int sq) { return sq < cfg::BATCH ? sq * cfg::SEQ : cfg::MP + (sq - cfg::BATCH) * cfg::DS; }
DEV int seq_len(int sq) { return sq < cfg::BATCH ? cfg::SEQ : cfg::DS; }
DEV float sigmoidf_(float x) { return 1.0f / (1.0f + expf(-x)); }
DEV float softplusf_(float x) { return x > 20.f ? x : log1pf(expf(x)); }
DEV float siluf_(float x) { return x * sigmoidf_(x); }

enum { I_XP = 0, I_XS, I_CKV, I_KPE, I_WKV, I_SHIFT, I_SSM, I_CONV, I_PT, I_NMIX, I_NFFN, I_FW1, I_FW2, I_MU, I_WRKV, I_W0, I_W1, I_W2, I_A0, I_A1, I_A2,
       I_V0, I_V1, I_V2, I_G1, I_G2, I_KK, I_KA, I_RK, I_LNW, I_LNB, I_RWO, I_MWIN, I_QNORM, I_KVNORM, I_WUQ, I_WUK, I_WUV, I_QNN, I_QRN, I_KNN, I_KRN, I_MWO,
       I_BWIN, I_CONVW, I_CONVB, I_DTB, I_ALOG, I_BD, I_BNORM, I_BWO };

#define UNROLL _Pragma("unroll")
#define GSL(i, n) for (size_t i = gtid; i < (size_t)(n); i += gsz)

DEV void ph_copy_x(const Ctx& c, int, size_t gtid, size_t gsz) {
    using namespace cfg;
    GSL(i, (size_t)MTOT * D) c.x[i] = i < (size_t)MP * D ? c.in[I_XP][i] : c.in[I_XS][i - (size_t)MP * D];
}
DEV void rmsnorm_rows(const float* x, const float* gain, float* xn, size_t gtid, size_t gsz) {
    using namespace cfg;
    GSL(m, MTOT) {
        const float* xr = x + m * D; float ss = 0.f;
        for (int i = 0; i < D; ++i) ss += xr[i] * xr[i];
        const float rs = 1.0f / sqrtf(ss / D + NORM_EPS);
        for (int i = 0; i < D; ++i) xn[m * D + i] = xr[i] * rs * gain[i];
    }
}
DEV void ph_norm_mix(const Ctx& c, int l, size_t gtid, size_t gsz) { rmsnorm_rows(c.x, c.in[I_NMIX] + l * cfg::D, c.xn, gtid, gsz); }
DEV void ph_norm_ffn(const Ctx& c, int l, size_t gtid, size_t gsz) { rmsnorm_rows(c.x, c.in[I_NFFN] + l * cfg::D, c.xn, gtid, gsz); }

DEV void ph_rw_mix(const Ctx& c, int l, size_t gtid, size_t gsz) {
    using namespace cfg; const int j = l / 3;
    GSL(i, (size_t)MTOT * D) {
        const int m = (int)(i / D), ch = (int)(i % D), t = row_t(m), sq = row_seq(m);
        const float xc = c.xn[i];
        float xp;
        if (t > 0) xp = c.xn[i - D];
        else xp = sq < BATCH ? 0.f : c.in[I_SHIFT][((size_t)j * DB + (sq - BATCH)) * D + ch];
        for (int p = 0; p < 6; ++p) c.xm[p][i] = xc + (xp - xc) * c.in[I_MU][((size_t)j * 6 + p) * D + ch];
        if (t == seq_len(sq) - 1) {
            if (sq < BATCH) c.out[O_SHP + ((size_t)j * BATCH + sq) * D + ch] = xc;
            else c.out[O_SHS + ((size_t)j * DB + (sq - BATCH)) * D + ch] = xc;
        }
    }
}
DEV void ph_rw_prep(const Ctx& c, int l, size_t gtid, size_t gsz) {
    using namespace cfg; const int j = l / 3;
    GSL(i, (size_t)MTOT * RHEADS) {
        const int m = (int)(i / RHEADS), h = (int)(i % RHEADS);
        const size_t o = (size_t)m * D + h * RH;
        float nn = 0.f;
        for (int e = 0; e < RH; ++e) { const float kk = c.k[o + e] * c.in[I_KK][j * D + h * RH + e]; nn += kk * kk; }
        const float inv = 1.0f / fmaxf(sqrtf(nn), 1e-12f);
        for (int e = 0; e < RH; ++e) {
            const int ch = h * RH + e;
            const float wl = -softplusf_(-(c.in[I_W0][j * D + ch] + c.wpre[o + e])) - 0.5f;
            const float decay = expf(-expf(wl));
            float vv = c.v[o + e];
            if (j == 0) c.vf[o + e] = vv;
            else vv = vv + (c.vf[o + e] - vv) * sigmoidf_(c.in[I_V0][(j - 1) * D + ch] + c.vpre[o + e]);
            const float a = sigmoidf_(c.in[I_A0][j * D + ch] + c.apre[o + e]);
            const float k0 = c.k[o + e];
            const float kk = k0 * c.in[I_KK][j * D + ch] * inv;
            c.k[o + e] = k0 * (1.0f + (a - 1.0f) * c.in[I_KA][j * D + ch]);
            c.v[o + e] = vv;
            c.wpre[o + e] = decay;
            c.ka[o + e] = -kk;
            c.kb[o + e] = kk * a;
        }
    }
}
DEV void ph_rw_scan(const Ctx& c, int l, size_t gtid, size_t gsz) {
    using namespace cfg; const int j = l / 3;
    GSL(i, (size_t)NSEQ * RHEADS * RH) {
        const int sq = (int)(i / (RHEADS * RH)), h = (int)(i / RH) % RHEADS, vi = (int)(i % RH);
        float S[RH];
        if (sq < BATCH) { UNROLL for (int e = 0; e < RH; ++e) S[e] = 0.f; }
        else { const float* s0 = c.in[I_WKV] + ((((size_t)j * DB + (sq - BATCH)) * RHEADS + h) * RH + vi) * RH; UNROLL for (int e = 0; e < RH; ++e) S[e] = s0[e]; }
        const int m0 = seq_row0(sq), T = seq_len(sq);
        for (int t = 0; t < T; ++t) {
            const size_t o = (size_t)(m0 + t) * D + h * RH;
            float sa = 0.f;
            UNROLL for (int e = 0; e < RH; ++e) sa += S[e] * c.ka[o + e];
            const float vt = c.v[o + vi]; float yy = 0.f;
            UNROLL for (int e = 0; e < RH; ++e) { S[e] = S[e] * c.wpre[o + e] + sa * c.kb[o + e] + vt * c.k[o + e]; yy += S[e] * c.r[o + e]; }
            c.y[o + vi] = yy;
        }
        float* so = sq < BATCH ? c.out + O_WKVP + ((((size_t)j * BATCH + sq) * RHEADS + h) * RH + vi) * RH
                               : c.out + O_WKVS + ((((size_t)j * DB + (sq - BATCH)) * RHEADS + h) * RH + vi) * RH;
        UNROLL for (int e = 0; e < RH; ++e) so[e] = S[e];
    }
}
DEV void ph_rw_post(const Ctx& c, int l, size_t gtid, size_t gsz) {
    using namespace cfg; const int j = l / 3;
    GSL(i, (size_t)MTOT * RHEADS) {
        const int m = (int)(i / RHEADS), h = (int)(i % RHEADS);
        const size_t o = (size_t)m * D + h * RH;
        float mean = 0.f; for (int e = 0; e < RH; ++e) mean += c.y[o + e]; mean /= RH;
        float var = 0.f; for (int e = 0; e < RH; ++e) { const float d = c.y[o + e] - mean; var += d * d; } var /= RH;
        const float rs = 1.0f / sqrtf(var + LNX_EPS);
        float bonus = 0.f; for (int e = 0; e < RH; ++e) bonus += c.r[o + e] * c.k[o + e] * c.in[I_RK][(size_t)j * D + h * RH + e];
        for (int e = 0; e < RH; ++e) {
            const int ch = h * RH + e;
            const float yn = (c.y[o + e] - mean) * rs * c.in[I_LNW][j * D + ch] + c.in[I_LNB][j * D + ch];
            c.yo[o + e] = (yn + bonus * c.v[o + e]) * c.g[o + e];
        }
    }
}

DEV void rope_apply(const float* xin, float* xout, int pos) {
    using namespace cfg; const int half = ROPE / 2;
    UNROLL for (int i = 0; i < half; ++i) {
        const float inv = exp2f(-(float)i * (13.287712379549449f / half));
        const float ang = (float)pos * inv;
        const float kq = rintf(ang * 0.15915494309189535f);
        float rr = fmaf(-kq, 6.28125f, ang); rr = fmaf(-kq, 1.9353071795864769e-3f, rr);
        const float cs = __cosf(rr), sn = __sinf(rr);
        const float x1 = xin[i], x2 = xin[i + half];
        xout[i] = x1 * cs - x2 * sn; xout[i + half] = x2 * cs + x1 * sn;
    }
}
DEV int row_pos(int m) { return m < cfg::MP ? m % cfg::SEQ : cfg::PAST + (m - cfg::MP) % cfg::DS; }
DEV void ph_mla_norm1(const Ctx& c, int l, size_t gtid, size_t gsz) {
    using namespace cfg; const int j = l / 3;
    GSL(m, MTOT) {
        const float* h = c.mh + m * MLA_IN;
        float ss = 0.f; for (int i = 0; i < QL; ++i) ss += h[i] * h[i];
        float rs = 1.0f / sqrtf(ss / QL + NORM_EPS);
        for (int i = 0; i < QL; ++i) c.qan[m * QL + i] = h[i] * rs * c.in[I_QNORM][j * QL + i];
        ss = 0.f; for (int i = 0; i < KVL; ++i) ss += h[QL + i] * h[QL + i];
        rs = 1.0f / sqrtf(ss / KVL + NORM_EPS);
        float* co = m < (size_t)MP ? c.out + O_CKVP + ((size_t)j * MP + m) * KVL : c.out + O_CKVS + ((size_t)j * MS + (m - MP)) * KVL;
        for (int i = 0; i < KVL; ++i) { const float v = h[QL + i] * rs * c.in[I_KVNORM][j * KVL + i]; c.c[m * KVL + i] = v; co[i] = v; }
        ss = 0.f; UNROLL for (int i = 0; i < ROPE; ++i) ss += h[QL + KVL + i] * h[QL + KVL + i];
        rs = 1.0f / sqrtf(ss / ROPE + NORM_EPS);
        float tmp[ROPE], ro[ROPE];
        UNROLL for (int i = 0; i < ROPE; ++i) tmp[i] = h[QL + KVL + i] * rs * c.in[I_KRN][j * ROPE + i];
        rope_apply(tmp, ro, row_pos((int)m));
        float* ko = m < (size_t)MP ? c.out + O_KPEP + ((size_t)j * MP + m) * ROPE : c.out + O_KPES + ((size_t)j * MS + (m - MP)) * ROPE;
        UNROLL for (int i = 0; i < ROPE; ++i) { c.kp[m * ROPE + i] = ro[i]; ko[i] = ro[i]; }
    }
}
DEV void ph_mla_norm2(const Ctx& c, int l, size_t gtid, size_t gsz) {
    using namespace cfg; const int j = l / 3;
    GSL(i, (size_t)MTOT * MH) {
        const int m = (int)(i / MH), h = (int)(i % MH);
        float* q = c.q + (size_t)m * MH * QD + h * QD;
        float ss = 0.f; UNROLL for (int e = 0; e < NOPE; ++e) ss += q[e] * q[e];
        float rs = 1.0f / sqrtf(ss / NOPE + NORM_EPS);
        UNROLL for (int e = 0; e < NOPE; ++e) q[e] = q[e] * rs * c.in[I_QNN][j * NOPE + e];
        ss = 0.f; UNROLL for (int e = 0; e < ROPE; ++e) ss += q[NOPE + e] * q[NOPE + e];
        rs = 1.0f / sqrtf(ss / ROPE + NORM_EPS);
        float tmp[ROPE], ro[ROPE];
        UNROLL for (int e = 0; e < ROPE; ++e) tmp[e] = q[NOPE + e] * rs * c.in[I_QRN][j * ROPE + e];
        rope_apply(tmp, ro, row_pos(m));
        UNROLL for (int e = 0; e < ROPE; ++e) q[NOPE + e] = ro[e];
        float* kn = c.knr + (size_t)m * MH * NOPE + h * NOPE;
        ss = 0.f; UNROLL for (int e = 0; e < NOPE; ++e) ss += kn[e] * kn[e];
        rs = 1.0f / sqrtf(ss / NOPE + NORM_EPS);
        UNROLL for (int e = 0; e < NOPE; ++e) kn[e] = kn[e] * rs * c.in[I_KNN][j * NOPE + e];
    }
}
DEV void ph_mla_attn_prompt(const Ctx& c, int, size_t gtid, size_t gsz) {
    using namespace cfg; const float scale = 1.0f / sqrtf((float)QD);
    GSL(i, (size_t)MP * MH) {
        const int m = (int)(i / MH), h = (int)(i % MH), t = m % SEQ, m0 = m - t;
        const float* q = c.q + (size_t)m * MH * QD + h * QD;
        float mx = -INFINITY, den = 0.f, acc[VD];
        UNROLL for (int e = 0; e < VD; ++e) acc[e] = 0.f;
        for (int kx = 0; kx <= t; ++kx) {
            const int mk = m0 + kx;
            const float* kn = c.knr + (size_t)mk * MH * NOPE + h * NOPE; const float* kp = c.kp + (size_t)mk * ROPE;
            float s = 0.f;
            UNROLL for (int e = 0; e < NOPE; ++e) s += q[e] * kn[e];
            UNROLL for (int e = 0; e < ROPE; ++e) s += q[NOPE + e] * kp[e];
            s *= scale;
            const float nm = fmaxf(mx, s), corr = expf(mx - nm), p = expf(s - nm);
            den = den * corr + p;
            const float* v = c.vv + (size_t)mk * MH * VD + h * VD;
            UNROLL for (int e = 0; e < VD; ++e) acc[e] = acc[e] * corr + p * v[e];
            mx = nm;
        }
        UNROLL for (int e = 0; e < VD; ++e) c.ao[(size_t)m * MH * VD + h * VD + e] = acc[e] / den;
    }
}
DEV const float* smp_c(const Ctx& c, int j, int s, int pos) {
    using namespace cfg;
    if (pos < PAST) { const int pg = c.page_table[s * NPAGES + pos / PAGE]; return c.in[I_CKV] + (((size_t)j * NPOOL + pg) * PAGE + pos % PAGE) * KVL; }
    return c.c + (size_t)(MP + s * DS + (pos - PAST)) * KVL;
}
DEV const float* smp_kp(const Ctx& c, int j, int s, int pos) {
    using namespace cfg;
    if (pos < PAST) { const int pg = c.page_table[s * NPAGES + pos / PAGE]; return c.in[I_KPE] + (((size_t)j * NPOOL + pg) * PAGE + pos % PAGE) * ROPE; }
    return c.kp + (size_t)(MP + s * DS + (pos - PAST)) * ROPE;
}
DEV void ph_mla_score_sample(const Ctx& c, int l, size_t gtid, size_t gsz) {
    using namespace cfg; const int j = l / 3; const float scale = 1.0f / sqrtf((float)QD);
    GSL(i, (size_t)DB * KTOT * MH) {
        const int pos = (int)(i % KTOT), h = (int)((i / KTOT) % MH), s = (int)(i / ((size_t)MH * KTOT));
        const float* cl = smp_c(c, j, s, pos); const float* kp = smp_kp(c, j, s, pos);
        float kn[NOPE];
        UNROLL for (int e = 0; e < NOPE; ++e) kn[e] = 0.f;
        const float* wuk = c.in[I_WUK] + (size_t)j * KVL * MH * NOPE;
        for (int r = 0; r < KVL; ++r) { const float cv = cl[r]; const float* w = wuk + ((size_t)r * MH + h) * NOPE; UNROLL for (int e = 0; e < NOPE; ++e) kn[e] += cv * w[e]; }
        float ss = 0.f; UNROLL for (int e = 0; e < NOPE; ++e) ss += kn[e] * kn[e];
        const float rs = 1.0f / sqrtf(ss / NOPE + NORM_EPS);
        UNROLL for (int e = 0; e < NOPE; ++e) kn[e] = kn[e] * rs * c.in[I_KNN][j * NOPE + e];
        for (int qi = 0; qi < DS; ++qi) {
            const float* q = c.q + (size_t)(MP + s * DS + qi) * MH * QD + h * QD;
            float sc = 0.f;
            UNROLL for (int e = 0; e < NOPE; ++e) sc += q[e] * kn[e];
            UNROLL for (int e = 0; e < ROPE; ++e) sc += q[NOPE + e] * kp[e];
            const bool ok = pos < PAST || (pos - PAST) <= qi;
            c.sc[(((size_t)s * MH + h) * DS + qi) * KTOT + pos] = ok ? sc * scale : -INFINITY;
        }
    }
}
DEV void ph_mla_softmax_sample(const Ctx& c, int, size_t gtid, size_t gsz) {
    using namespace cfg;
    GSL(i, (size_t)DB * MH * DS) {
        float* sc = c.sc + i * KTOT;
        float mx = -INFINITY; for (int p = 0; p < KTOT; ++p) mx = fmaxf(mx, sc[p]);
        float den = 0.f; for (int p = 0; p < KTOT; ++p) den += expf(sc[p] - mx);
        const float inv = 1.0f / den;
        for (int p = 0; p < KTOT; ++p) sc[p] = expf(sc[p] - mx) * inv;
    }
}
DEV void ph_mla_pv_sample(const Ctx& c, int l, size_t gtid, size_t gsz) {
    using namespace cfg; const int j = l / 3;
    GSL(i, (size_t)DB * MH * DS * KVL) {
        const int r = (int)(i % KVL); const size_t row = i / KVL; const int s = (int)(row / (MH * DS));
        const float* p = c.sc + row * KTOT; float acc = 0.f;
        for (int pos = 0; pos < KTOT; ++pos) acc += p[pos] * smp_c(c, j, s, pos)[r];
        c.olat[i] = acc;
    }
}
DEV void ph_mla_out_sample(const Ctx& c, int l, size_t gtid, size_t gsz) {
    using namespace cfg; const int j = l / 3;
    GSL(i, (size_t)MS * MH * VD) {
        const int e = (int)(i % VD), h = (int)((i / VD) % MH), ms = (int)(i / (MH * VD)), s = ms / DS, qi = ms % DS;
        const float* ol = c.olat + (((size_t)s * MH + h) * DS + qi) * KVL;
        const float* wuv = c.in[I_WUV] + (size_t)j * KVL * MH * VD;
        float acc = 0.f;
        for (int r = 0; r < KVL; ++r) acc += ol[r] * wuv[((size_t)r * MH + h) * VD + e];
        c.ao[(size_t)(MP + ms) * MH * VD + h * VD + e] = acc;
    }
}

DEV float mb_xpad(const Ctx& c, int j, int m, int sq, int tt, int ch) {
    using namespace cfg;
    if (tt < MB_CONV - 1) return sq < BATCH ? 0.f : c.in[I_CONV][(((size_t)j * DB + (sq - BATCH)) * (MB_CONV - 1) + tt) * MB_CD + ch];
    (void)m; return c.zx[(size_t)(seq_row0(sq) + tt - (MB_CONV - 1)) * MB_IN + MB_INNER + ch];
}
DEV void ph_mb_conv(const Ctx& c, int l, size_t gtid, size_t gsz) {
    using namespace cfg; const int j = l / 3;
    GSL(i, (size_t)MTOT * MB_CD) {
        const int m = (int)(i / MB_CD), ch = (int)(i % MB_CD), t = row_t(m), sq = row_seq(m), T = seq_len(sq);
        float acc = c.in[I_CONVB][j * MB_CD + ch];
        for (int jj = 0; jj < MB_CONV; ++jj) acc += mb_xpad(c, j, m, sq, t + jj, ch) * c.in[I_CONVW][((size_t)j * MB_CONV + jj) * MB_CD + ch];
        c.xbc[i] = siluf_(acc);
        if (t < MB_CONV - 1) {
            const float v = mb_xpad(c, j, m, sq, T + t, ch);
            if (sq < BATCH) c.out[O_CONVP + (((size_t)j * BATCH + sq) * (MB_CONV - 1) + t) * MB_CD + ch] = v;
            else c.out[O_CONVS + (((size_t)j * DB + (sq - BATCH)) * (MB_CONV - 1) + t) * MB_CD + ch] = v;
        }
    }
}
DEV void ph_mb_dt(const Ctx& c, int l, size_t gtid, size_t gsz) {
    using namespace cfg; const int j = l / 3;
    GSL(i, (size_t)MTOT * MB_HEADS) {
        const int m = (int)(i / MB_HEADS), h = (int)(i % MB_HEADS);
        c.dt[i] = softplusf_(c.zx[(size_t)m * MB_IN + MB_INNER + MB_CD + h] + c.in[I_DTB][j * MB_HEADS + h]);
    }
}
DEV void ph_mb_scan(const Ctx& c, int l, size_t gtid, size_t gsz) {
    using namespace cfg; const int j = l / 3;
    GSL(i, (size_t)NSEQ * MB_HEADS * MB_HEAD) {
        const int p = (int)(i % MB_HEAD), h = (int)((i / MB_HEAD) % MB_HEADS), sq = (int)(i / (MB_HEADS * MB_HEAD));
        const int g = h / (MB_HEADS / MB_GROUPS);
        float hs[MB_STATE];
        if (sq < BATCH) { UNROLL for (int n = 0; n < MB_STATE; ++n) hs[n] = 0.f; }
        else { const float* s0 = c.in[I_SSM] + ((((size_t)j * DB + (sq - BATCH)) * MB_HEADS + h) * MB_HEAD + p) * MB_STATE; UNROLL for (int n = 0; n < MB_STATE; ++n) hs[n] = s0[n]; }
        const float A = -expf(c.in[I_ALOG][j * MB_HEADS + h]), dsk = c.in[I_BD][j * MB_HEADS + h];
        const int m0 = seq_row0(sq), T = seq_len(sq);
        for (int t = 0; t < T; ++t) {
            const size_t m = (size_t)(m0 + t);
            const float dtv = c.dt[m * MB_HEADS + h], dA = expf(dtv * A);
            const float xv = c.xbc[m * MB_CD + h * MB_HEAD + p], xdt = xv * dtv;
            const float* Bm = c.xbc + m * MB_CD + MB_INNER + g * MB_STATE; const float* Cm = Bm + MB_GN;
            float yy = 0.f;
            UNROLL for (int n = 0; n < MB_STATE; ++n) { hs[n] = hs[n] * dA + xdt * Bm[n]; yy += Cm[n] * hs[n]; }
            c.my[m * MB_INNER + h * MB_HEAD + p] = yy + dsk * xv;
        }
        float* so = sq < BATCH ? c.out + O_SSMP + ((((size_t)j * BATCH + sq) * MB_HEADS + h) * MB_HEAD + p) * MB_STATE
                               : c.out + O_SSMS + ((((size_t)j * DB + (sq - BATCH)) * MB_HEADS + h) * MB_HEAD + p) * MB_STATE;
        UNROLL for (int n = 0; n < MB_STATE; ++n) so[n] = hs[n];
    }
}
DEV void ph_mb_gate(const Ctx& c, int l, size_t gtid, size_t gsz) {
    using namespace cfg; const int j = l / 3; constexpr int GW = MB_INNER / MB_GROUPS;
    GSL(i, (size_t)MTOT * MB_GROUPS) {
        const int m = (int)(i / MB_GROUPS), g = (int)(i % MB_GROUPS);
        float ss = 0.f;
        for (int e = 0; e < GW; ++e) { const float v = c.my[(size_t)m * MB_INNER + g * GW + e] * siluf_(c.zx[(size_t)m * MB_IN + g * GW + e]); ss += v * v; }
        const float rs = 1.0f / sqrtf(ss / GW + NORM_EPS);
        for (int e = 0; e < GW; ++e) {
            const float v = c.my[(size_t)m * MB_INNER + g * GW + e] * siluf_(c.zx[(size_t)m * MB_IN + g * GW + e]);
            c.yzn[(size_t)m * MB_INNER + g * GW + e] = v * rs * c.in[I_BNORM][j * MB_INNER + g * GW + e];
        }
    }
}
typedef short bf16x8_t __attribute__((ext_vector_type(8)));
typedef float f32x4_t __attribute__((ext_vector_type(4)));
__device__ __forceinline__ unsigned short f2bf(float f) { unsigned u = __float_as_uint(f); u += 0x7fffu + ((u >> 16) & 1u); return (unsigned short)(u >> 16); }
#define XB_TMO      128
#define XB_XCNT(j)  (256  + 64 * (j))
#define XB_XSUB(j)  (1280 + 64 * (j))
#define XB_XGEN(j)  (2304 + 64 * (j))
#define XB_TOP      3328
#define XB_TOPGEN   3392
#define XCD_BAR_WORDS 3456
#define XB_SPIN_CAP (1u << 25)
#define LAS __attribute__((address_space(3)))

__device__ __forceinline__ unsigned xb_ld(unsigned* p)              { return __hip_atomic_load(p, __ATOMIC_RELAXED, __HIP_MEMORY_SCOPE_AGENT); }
__device__ __forceinline__ unsigned xb_add(unsigned* p, unsigned v) { return __hip_atomic_fetch_add(p, v, __ATOMIC_RELAXED, __HIP_MEMORY_SCOPE_AGENT); }
__device__ __forceinline__ unsigned xb_xcc_id() { return (unsigned)__builtin_amdgcn_s_getreg((3 << 11) | 20) & 0xFu; }
#define XB_SPIN(cond, bar) do { unsigned _sp = 0; while (cond) { __builtin_amdgcn_s_sleep(1); \
    if ((++_sp & 255u) == 0u) { if (xb_ld(&(bar)[XB_TMO])) break; if (_sp > XB_SPIN_CAP) { atomicAdd(&(bar)[XB_TMO], 1u); break; } } } } while (0)

struct XcdBarrier {
    unsigned* bar; unsigned x;
    volatile LAS unsigned* st;
};

__device__ __forceinline__ XcdBarrier xcd_barrier_post(unsigned* bar, volatile LAS unsigned* st) {
    XcdBarrier b; b.bar = bar; b.x = xb_xcc_id(); b.st = st;
    if (threadIdx.x == 0) (void)xb_add(&bar[XB_XCNT(b.x)], 1u);
    return b;
}
__device__ __forceinline__ void xcd_barrier_complete(unsigned* bar, unsigned x, unsigned& nloc, unsigned& nx) {
    const unsigned G = gridDim.x * gridDim.y * gridDim.z;
    unsigned sum, cnt, mine, sp = 0u;
    for (;;) {
        sum = 0u; cnt = 0u; mine = 0u;
#pragma unroll
        for (unsigned j = 0; j < 16; ++j) { const unsigned c = xb_ld(&bar[XB_XCNT(j)]); sum += c; cnt += (c > 0u) ? 1u : 0u; mine = (j == x) ? c : mine; }
        if (sum == G) break;
        __builtin_amdgcn_s_sleep(1);
        if ((++sp & 255u) == 0u) { if (xb_ld(&bar[XB_TMO])) break; if (sp > XB_SPIN_CAP) { atomicAdd(&bar[XB_TMO], 1u); break; } }
    }
    nloc = mine > 0u ? mine : 1u; nx = cnt > 0u ? cnt : 1u;
}

__device__ __forceinline__ void xcd_barrier(const XcdBarrier& b) {
    asm volatile("s_waitcnt vmcnt(0)" ::: "memory");
    __syncthreads();
    if (threadIdx.x == 0) {
        unsigned* bar = b.bar;
        __builtin_amdgcn_s_waitcnt(0);
        unsigned nloc = b.st[0], nx = b.st[1];
        if (nloc == 0u) { xcd_barrier_complete(bar, b.x, nloc, nx); b.st[0] = nloc; b.st[1] = nx; }
        const unsigned old = xb_add(&bar[XB_XSUB(b.x)], 1u);
        const unsigned gen = old / nloc;
        if (old + 1u == (gen + 1u) * nloc) {
            __builtin_amdgcn_fence(__ATOMIC_RELEASE, "agent");
            asm volatile("s_waitcnt vmcnt(0)" ::: "memory");
            const unsigned og = xb_add(&bar[XB_TOP], 1u);
            const unsigned tg = og / nx;
            if (og + 1u == (tg + 1u) * nx) xb_add(&bar[XB_TOPGEN], 1u);
            else XB_SPIN(xb_ld(&bar[XB_TOPGEN]) == tg, bar);
            __builtin_amdgcn_fence(__ATOMIC_ACQUIRE, "agent");
            xb_add(&bar[XB_XGEN(b.x)], 1u);
            asm volatile("s_waitcnt vmcnt(0)" ::: "memory");
        } else {
            XB_SPIN(xb_ld(&bar[XB_XGEN(b.x)]) == gen, bar);
            __builtin_amdgcn_fence(__ATOMIC_ACQUIRE, "agent");
            asm volatile("s_waitcnt vmcnt(0)" ::: "memory");
        }
    }
    __syncthreads();
}

struct Bump { char* p; size_t off; float* f(size_t n) { float* r = (float*)(p + off); off += ((n * 4 + 255) / 256) * 256; return r; } };

static size_t setup_ctx(Ctx& c, void* const* d_in, void* d_out, void* d_ws) {
    using namespace cfg;
    for (int i = 0; i < 51; ++i) c.in[i] = (const float*)d_in[i];
    c.page_table = (const int*)d_in[I_PT];
    c.out = (float*)d_out; c.x = c.out;
    Bump b{(char*)d_ws, 4096 * 4};
    const size_t MD = (size_t)MTOT * D;
    c.xn = b.f(MD); c.vf = b.f(MD);
    const size_t base = b.off;
    for (int p = 0; p < 6; ++p) c.xm[p] = b.f(MD);
    c.r = b.f(MD); c.k = b.f(MD); c.v = b.f(MD); c.wpre = b.f(MD); c.apre = b.f(MD); c.vpre = b.f(MD); c.g = b.f(MD);
    c.hw = b.f((size_t)MTOT * RW_DL); c.ha = b.f((size_t)MTOT * RW_AL); c.hv = b.f((size_t)MTOT * RW_VL); c.hg = b.f((size_t)MTOT * RW_GL);
    c.ka = b.f(MD); c.kb = b.f(MD); c.y = c.xm[0]; c.yo = c.xm[1];
    size_t hi = b.off;
    b.off = base;
    c.mh = b.f((size_t)MTOT * MLA_IN); c.qan = b.f((size_t)MTOT * QL); c.q = b.f((size_t)MTOT * MH * QD); c.c = b.f((size_t)MTOT * KVL); c.kp = b.f((size_t)MTOT * ROPE);
    c.knr = b.f((size_t)MTOT * MH * NOPE); c.vv = b.f((size_t)MTOT * MH * VD); c.ao = b.f((size_t)MTOT * MH * VD);
    c.sc = b.f((size_t)DB * MH * DS * KTOT); c.olat = b.f((size_t)DB * MH * DS * KVL);
    if (b.off > hi) hi = b.off;
    b.off = base;
    c.zx = b.f((size_t)MTOT * MB_IN); c.xbc = b.f((size_t)MTOT * MB_CD); c.dt = b.f((size_t)MTOT * MB_HEADS); c.my = b.f((size_t)MTOT * MB_INNER); c.yzn = b.f((size_t)MTOT * MB_INNER);
    if (b.off > hi) hi = b.off;
    b.off = hi;
    c.hmid = b.f((size_t)MTOT * FFN);
    return b.off;
}

__device__ __forceinline__ unsigned tid_now() { unsigned t = threadIdx.x; asm volatile("" : "+v"(t)); return t; }
namespace pg8 {
#define PG8_LAS __attribute__((address_space(3)))
typedef unsigned short bf16_t;
typedef short bf16x8 __attribute__((ext_vector_type(8)));
typedef float f32x4 __attribute__((ext_vector_type(4)));
typedef float f32x2 __attribute__((ext_vector_type(2)));
typedef unsigned u32x4 __attribute__((ext_vector_type(4)));
typedef unsigned u32x2 __attribute__((ext_vector_type(2)));
constexpr int BM = 256, BK = 64, HALF = 128, HTB = HALF * BK * 2  , STAGE_BYTES = 8 * HTB, NXCD = 8, WGM = 8;

__host__ __device__ __forceinline__ int lds_byte(int r, int c) { const int st = (r >> 4) * 2 + (c >> 5), rr = r & 15, cc = c & 31, ob = rr * 64 + cc * 2; return st * 1024 + (ob ^ (((ob >> 9) & 1) << 5)); }
__host__ __device__ __forceinline__ void stage_rc(int b, int& R, int& C) { const int st = b / 1024, sb = b % 1024, swz = sb ^ (((sb >> 9) & 1) << 5); R = (st >> 1) * 16 + swz / 64; C = (st & 1) * 32 + (swz % 64) / 2; }
__host__ __device__ __forceinline__ int perm32(int rho) { const int n = rho >> 4, i = rho & 15; return 8 * (i >> 2) + 4 * n + (i & 3); }
__device__ __forceinline__ unsigned cvt_pk_bf16(float lo, float hi) { unsigned r; asm volatile("v_cvt_pk_bf16_f32 %0, %1, %2" : "=v"(r) : "v"(lo), "v"(hi)); return r; }

struct Unit { int pm, pn, k0, nt, asel, part; };
struct Gemm { const bf16_t* A; const bf16_t* Bt; int lda, ldb; size_t asel_stride; };

struct NoSel { __device__ static __forceinline__ int sel(int) { return 0; } };
template <class ASEL = NoSel>
struct Order {
    int nMp, nMs, nN, nwgP, nwgS, G, c, K, ksplit;
    __device__ __forceinline__ void init(int nMp_, int nMs_, int nN_, int K_, int ksplit_, int G_, int c_) { nMp = nMp_; nMs = nMs_; nN = nN_; nwgP = nMp * nN; K = K_; ksplit = ksplit_; nwgS = nMs * nN * ksplit; G = G_; c = c_; }
    __device__ __forceinline__ bool next(int i, Unit& u) const {
        const long L = (long)i * G + c;
        if (L < nwgP) {
            int wgid = (int)L; { const int q = nwgP / NXCD, r = nwgP % NXCD, xcd = wgid % NXCD, off = wgid / NXCD; wgid = (xcd < r ? xcd * (q + 1) : r * (q + 1) + (xcd - r) * q) + off; }
            const int nig = WGM * nN, gid = wgid / nig, fm = gid * WGM, gsz = (nMp - fm) < WGM ? (nMp - fm) : WGM;
            u.pm = fm + ((wgid % nig) % gsz); u.pn = (wgid % nig) / gsz; u.k0 = 0; u.nt = K / BK; u.part = 0; u.asel = ASEL::sel(u.pn); return true;
        }
        const long Ls = L - nwgP; if (Ls >= nwgS) return false;
        const int sub = (int)(Ls % ksplit), t = (int)(Ls / ksplit);
        u.pm = nMp + t % nMs; u.pn = t / nMs; u.nt = K / BK / ksplit; u.k0 = sub * u.nt * BK; u.part = ksplit > 1 ? 1 : 0; u.asel = ASEL::sel(u.pn); return true;
    }
};

template <class Epi, class Sched>
__device__ __forceinline__ void gemm_phase(PG8_LAS unsigned char* lds, const Gemm g, const Sched& S, const Epi& E) {
    const int tid = (int)tid_now(), wid = __builtin_amdgcn_readfirstlane(tid >> 6), lane = tid & 63, wr = wid >> 2, wc = wid & 3, fr = lane & 15, fq = lane >> 4;
    unsigned voffA[2], voffB[2];
#pragma unroll
    for (int i = 0; i < 2; ++i) { int R, C; stage_rc(tid * 16 + i * 8192, R, C); const int Rb = Epi::PERM ? ((R & ~31) + perm32(R & 31)) : R;
        voffA[i] = (unsigned)(R * g.lda + C) * 2u; voffB[i] = (unsigned)(Rb * g.ldb + C) * 2u; }
    const size_t kstep = (size_t)(BK * 2);
    const size_t hstepA = (size_t)HALF * g.lda * 2, hstepB = (size_t)HALF * g.ldb * 2;
    const unsigned ldsw = (unsigned)wid * 1024u;
    const int aoff = lds_byte(wr * 64 + fr, fq * 8), boff = lds_byte(wc * 32 + fr, fq * 8);
#define PG8_SA(b, h) (((b) * 2 + (h)) * HTB)
#define PG8_SB(b, h) ((4 + (b) * 2 + (h)) * HTB)
#define PG8_STAGE(bufoff, gbase, voff) do { _Pragma("unroll") for (int _i = 0; _i < 2; ++_i) \
        __builtin_amdgcn_global_load_lds((const unsigned*)((const char*)(gbase) + (voff)[_i]), (PG8_LAS unsigned*)(lds + (bufoff) + ldsw + _i * 8192), 16, 0, 0); } while (0)
#define PG8_LDA(dst, b, h) do { _Pragma("unroll") for (int m = 0; m < 4; ++m) _Pragma("unroll") for (int k = 0; k < 2; ++k) dst[m][k] = *(const PG8_LAS bf16x8*)(lds + PG8_SA(b, h) + aoff + m * 2048 + k * 1024); } while (0)
#define PG8_LDB(dst, b, h) do { _Pragma("unroll") for (int n = 0; n < 2; ++n) _Pragma("unroll") for (int k = 0; k < 2; ++k) dst[n][k] = *(const PG8_LAS bf16x8*)(lds + PG8_SB(b, h) + boff + n * 2048 + k * 1024); } while (0)
#define PG8_MMA(ai, bj, At, Bt) do { __builtin_amdgcn_s_setprio(1); _Pragma("unroll") for (int m = 0; m < 4; ++m) _Pragma("unroll") for (int n = 0; n < 2; ++n) _Pragma("unroll") for (int k = 0; k < 2; ++k) \
        acc[ai][bj][m][n] = __builtin_amdgcn_mfma_f32_16x16x32_bf16(Bt[n][k], At[m][k], acc[ai][bj][m][n], 0, 0, 0); __builtin_amdgcn_s_setprio(0); } while (0)
#define PG8_WAIT_V(n) asm volatile("s_waitcnt vmcnt(" #n ")" ::: "memory")
#define PG8_WAIT_L(n) asm volatile("s_waitcnt lgkmcnt(" #n ")" ::: "memory")
#define PG8_BAR __builtin_amdgcn_s_barrier()
#define PG8_SCHED __builtin_amdgcn_sched_barrier(0)
#define PG8_ABASE(u) ((const char*)g.A + ((size_t)(u).asel * g.asel_stride + (size_t)(u).pm * BM * g.lda + (u).k0) * 2)
#define PG8_BBASE(u) ((const char*)g.Bt + ((size_t)(u).pn * BM * g.ldb + (u).k0) * 2)
    Unit cur, nxt; int ui = 0;
    if (!S.next(0, cur)) return;
    f32x4 acc[2][2][4][2];
#pragma unroll
    for (int a = 0; a < 2; ++a)
#pragma unroll
        for (int b = 0; b < 2; ++b)
#pragma unroll
            for (int m = 0; m < 4; ++m)
#pragma unroll
                for (int n = 0; n < 2; ++n) acc[a][b][m][n] = (f32x4){0.f, 0.f, 0.f, 0.f};
    bf16x8 At[4][2], B0[2][2], B1[2][2];
    const char* cA = PG8_ABASE(cur); const char* cB = PG8_BBASE(cur);
    PG8_STAGE(PG8_SB(0, 0), cB, voffB); PG8_STAGE(PG8_SA(0, 0), cA, voffA); PG8_STAGE(PG8_SB(0, 1), cB + hstepB, voffB); PG8_STAGE(PG8_SA(0, 1), cA + hstepA, voffA);
    if (wr == 1) PG8_BAR;
    PG8_WAIT_V(4); PG8_BAR;
    PG8_STAGE(PG8_SB(1, 0), cB + kstep, voffB); PG8_STAGE(PG8_SA(1, 0), cA + kstep, voffA); PG8_STAGE(PG8_SB(1, 1), cB + hstepB + kstep, voffB);
    PG8_WAIT_V(6); PG8_BAR;
    for (;;) {
        const bool has_next = S.next(ui + 1, nxt);
        const char* nA = has_next ? PG8_ABASE(nxt) : cA; const char* nB = has_next ? PG8_BBASE(nxt) : cB;
        const int nt = cur.nt;
        for (int t = 0; t < nt; t += 2) {
            const bool last = (t == nt - 2);
            const char* a1 = cA + (size_t)(t + 1) * kstep;
            const char* a2 = last ? nA : cA + (size_t)(t + 2) * kstep; const char* b2 = last ? nB : cB + (size_t)(t + 2) * kstep;
            const char* a3 = a2 + kstep; const char* b3 = b2 + kstep;
            PG8_LDB(B0, 0, 0); PG8_SCHED; PG8_LDA(At, 0, 0); PG8_STAGE(PG8_SA(1, 1), a1 + hstepA, voffA);
            PG8_WAIT_L(8); PG8_BAR; PG8_WAIT_L(0); PG8_MMA(0, 0, At, B0); PG8_BAR; PG8_SCHED;
            PG8_LDB(B1, 0, 1); PG8_STAGE(PG8_SB(0, 0), b2, voffB);
            PG8_BAR; PG8_WAIT_L(0); PG8_MMA(0, 1, At, B1); PG8_BAR;
            PG8_LDA(At, 0, 1); PG8_STAGE(PG8_SA(0, 0), a2, voffA);
            PG8_BAR; PG8_WAIT_L(0); PG8_MMA(1, 0, At, B0); PG8_BAR; PG8_SCHED;
            PG8_STAGE(PG8_SB(0, 1), b2 + hstepB, voffB);
            PG8_WAIT_V(6); PG8_BAR; PG8_MMA(1, 1, At, B1); PG8_BAR;
            PG8_LDB(B0, 1, 0); PG8_SCHED; PG8_LDA(At, 1, 0); PG8_STAGE(PG8_SA(0, 1), a2 + hstepA, voffA);
            PG8_WAIT_L(8); PG8_BAR; PG8_WAIT_L(0); PG8_MMA(0, 0, At, B0); PG8_BAR; PG8_SCHED;
            PG8_LDB(B1, 1, 1); PG8_STAGE(PG8_SB(1, 0), b3, voffB);
            PG8_BAR; PG8_WAIT_L(0); PG8_MMA(0, 1, At, B1); PG8_BAR;
            PG8_LDA(At, 1, 1); PG8_STAGE(PG8_SA(1, 0), a3, voffA);
            PG8_BAR; PG8_WAIT_L(0); PG8_MMA(1, 0, At, B0); PG8_BAR; PG8_SCHED;
            PG8_STAGE(PG8_SB(1, 1), b3 + hstepB, voffB);
            PG8_WAIT_V(6); PG8_BAR; PG8_MMA(1, 1, At, B1); PG8_BAR;
        }
        E(acc, cur, wr, wc, fr, fq);
        if (!has_next) break;
#pragma unroll
        for (int a = 0; a < 2; ++a)
#pragma unroll
            for (int b = 0; b < 2; ++b)
#pragma unroll
                for (int m = 0; m < 4; ++m)
#pragma unroll
                    for (int n = 0; n < 2; ++n) acc[a][b][m][n] = (f32x4){0.f, 0.f, 0.f, 0.f};
        cur = nxt; cA = nA; cB = nB; ++ui;
    }
    PG8_WAIT_V(0);
    if (wr == 0) PG8_BAR;
    PG8_BAR;
#undef PG8_SA
#undef PG8_SB
#undef PG8_STAGE
#undef PG8_LDA
#undef PG8_LDB
#undef PG8_MMA
#undef PG8_WAIT_V
#undef PG8_WAIT_L
#undef PG8_BAR
#undef PG8_SCHED
#undef PG8_ABASE
#undef PG8_BBASE
}

struct EpiAccF32 {
    static constexpr bool PERM = false;
    float* C; int ldc; float* slab; int pm0, nMs, ksplit;
    __device__ __forceinline__ void operator()(const f32x4 (&acc)[2][2][4][2], const Unit& u, int wr, int wc, int fr, int fq) const {
        if (u.part) {
            float* sl = slab + ((size_t)((u.pn * nMs + (u.pm - pm0)) * ksplit + u.k0 / (u.nt * BK)) * BM + wr * 64 + fr) * BM + wc * 32 + 4 * fq;
#pragma unroll
            for (int ai = 0; ai < 2; ++ai)
#pragma unroll
                for (int m = 0; m < 4; ++m) { float* rowp = sl + (size_t)(ai * HALF + m * 16) * BM;
#pragma unroll
                    for (int bj = 0; bj < 2; ++bj)
#pragma unroll
                        for (int n = 0; n < 2; ++n) *(f32x4*)(rowp + bj * HALF + n * 16) = acc[ai][bj][m][n]; }
        } else {
            const int row0 = u.pm * BM + wr * 64 + fr, col0 = u.pn * BM + wc * 32 + 4 * fq;
#pragma unroll
            for (int ai = 0; ai < 2; ++ai)
#pragma unroll
                for (int m2 = 0; m2 < 4; m2 += 2) {
                    f32x4 t[2][2][2];
#pragma unroll
                    for (int mm = 0; mm < 2; ++mm) { const float* rowp = C + (size_t)(row0 + ai * HALF + (m2 + mm) * 16) * ldc + col0;
#pragma unroll
                        for (int bj = 0; bj < 2; ++bj)
#pragma unroll
                            for (int n = 0; n < 2; ++n) t[mm][bj][n] = *(const f32x4*)(rowp + bj * HALF + n * 16); }
#pragma unroll
                    for (int mm = 0; mm < 2; ++mm) { float* rowp = C + (size_t)(row0 + ai * HALF + (m2 + mm) * 16) * ldc + col0;
#pragma unroll
                        for (int bj = 0; bj < 2; ++bj)
#pragma unroll
                            for (int n = 0; n < 2; ++n) *(f32x4*)(rowp + bj * HALF + n * 16) = t[mm][bj][n] + acc[ai][bj][m2 + mm][n]; }
                }
        }
    }
};
struct EpiF32 {
    static constexpr bool PERM = false;
    float* C; int ldc; int ncols;
    __device__ __forceinline__ void operator()(const f32x4 (&acc)[2][2][4][2], const Unit& u, int wr, int wc, int fr, int fq) const {
        const int row0 = u.pm * BM + wr * 64 + fr, col0 = u.pn * BM + wc * 32 + 4 * fq;
#pragma unroll
        for (int ai = 0; ai < 2; ++ai)
#pragma unroll
            for (int m = 0; m < 4; ++m) { float* rowp = C + (size_t)(row0 + ai * HALF + m * 16) * ldc + col0;
#pragma unroll
                for (int bj = 0; bj < 2; ++bj)
#pragma unroll
                    for (int n = 0; n < 2; ++n) if (col0 + bj * HALF + n * 16 < ncols) *(f32x4*)(rowp + bj * HALF + n * 16) = acc[ai][bj][m][n]; }
    }
};
template <int ACT> struct EpiBf16 {
    static constexpr bool PERM = true;
    bf16_t* O; int ldc;
    __device__ __forceinline__ void operator()(const f32x4 (&acc)[2][2][4][2], const Unit& u, int wr, int wc, int fr, int fq) const {
        const int row0 = u.pm * BM + wr * 64 + fr, col0 = u.pn * BM + wc * 32 + 8 * fq;
#pragma unroll
        for (int ai = 0; ai < 2; ++ai)
#pragma unroll
            for (int m = 0; m < 4; ++m) { bf16_t* rowp = O + (size_t)(row0 + ai * HALF + m * 16) * ldc + col0;
#pragma unroll
                for (int bj = 0; bj < 2; ++bj) { f32x4 v0 = acc[ai][bj][m][0], v1 = acc[ai][bj][m][1];
                    if (ACT == 3) {
#pragma unroll
                        for (int j = 0; j < 4; ++j) { const float a = fmaxf(v0[j], 0.f), b = fmaxf(v1[j], 0.f); v0[j] = a * a; v1[j] = b * b; } }
                    u32x4 w; w.x = cvt_pk_bf16(v0[0], v0[1]); w.y = cvt_pk_bf16(v0[2], v0[3]); w.z = cvt_pk_bf16(v1[0], v1[1]); w.w = cvt_pk_bf16(v1[2], v1[3]);
                    *(u32x4*)(rowp + bj * HALF) = w; } }
    }
};
}
typedef pg8::bf16_t bf16_t;
#define LDSP __attribute__((address_space(3)))
struct Fast {
    bf16_t *xnb, *hmidb;
    bf16_t *w1t, *w2t;
    float* slab;
};
__device__ __forceinline__ unsigned pk2bf(float lo, float hi) { return pg8::cvt_pk_bf16(lo, hi); }
__device__ __forceinline__ float wave_sum64(float v) {
#pragma unroll
    for (int o = 1; o < 64; o <<= 1) v += __shfl_xor(v, o);
    return v;
}
__device__ __forceinline__ void red16x4(float& a, float& b, float& c, float& d) {
    asm volatile("s_nop 1\n"
        "v_add_f32_dpp %0, %0, %0 quad_perm:[1,0,3,2] row_mask:0xf bank_mask:0xf\n" "v_add_f32_dpp %1, %1, %1 quad_perm:[1,0,3,2] row_mask:0xf bank_mask:0xf\n"
        "v_add_f32_dpp %2, %2, %2 quad_perm:[1,0,3,2] row_mask:0xf bank_mask:0xf\n" "v_add_f32_dpp %3, %3, %3 quad_perm:[1,0,3,2] row_mask:0xf bank_mask:0xf\n"
        "v_add_f32_dpp %0, %0, %0 quad_perm:[2,3,0,1] row_mask:0xf bank_mask:0xf\n" "v_add_f32_dpp %1, %1, %1 quad_perm:[2,3,0,1] row_mask:0xf bank_mask:0xf\n"
        "v_add_f32_dpp %2, %2, %2 quad_perm:[2,3,0,1] row_mask:0xf bank_mask:0xf\n" "v_add_f32_dpp %3, %3, %3 quad_perm:[2,3,0,1] row_mask:0xf bank_mask:0xf\n"
        "v_add_f32_dpp %0, %0, %0 row_ror:4 row_mask:0xf bank_mask:0xf\n" "v_add_f32_dpp %1, %1, %1 row_ror:4 row_mask:0xf bank_mask:0xf\n"
        "v_add_f32_dpp %2, %2, %2 row_ror:4 row_mask:0xf bank_mask:0xf\n" "v_add_f32_dpp %3, %3, %3 row_ror:4 row_mask:0xf bank_mask:0xf\n"
        "v_add_f32_dpp %0, %0, %0 row_ror:8 row_mask:0xf bank_mask:0xf\n" "v_add_f32_dpp %1, %1, %1 row_ror:8 row_mask:0xf bank_mask:0xf\n"
        "v_add_f32_dpp %2, %2, %2 row_ror:8 row_mask:0xf bank_mask:0xf\n" "v_add_f32_dpp %3, %3, %3 row_ror:8 row_mask:0xf bank_mask:0xf\n"
        "s_nop 1"
        : "+v"(a), "+v"(b), "+v"(c), "+v"(d));
}
__device__ __forceinline__ void tr_item(const float* __restrict__ W, int ldw, int K, bf16_t* WT, int nvalid, const float* __restrict__ kscale, LDSP float* scr, int item, int nblk, int lane) {
    const int kb = item / nblk, nb = item % nblk, k0 = 64 * kb, n0 = 32 * nb;
    const bool ok = n0 < nvalid;
#pragma unroll
    for (int i = 0; i < 8; ++i) { const int kk = 8 * i + (lane >> 3), nn = 4 * (lane & 7); pg8::f32x4 v = ok ? *(const pg8::f32x4*)(W + (size_t)(k0 + kk) * ldw + n0 + nn) : (pg8::f32x4){0.f, 0.f, 0.f, 0.f};
        if (kscale) v = v * kscale[k0 + kk];
        scr[kk * 33 + nn] = v[0]; scr[kk * 33 + nn + 1] = v[1]; scr[kk * 33 + nn + 2] = v[2]; scr[kk * 33 + nn + 3] = v[3]; }
    asm volatile("s_waitcnt lgkmcnt(0)" ::: "memory");
    const int c = lane & 7;
#pragma unroll
    for (int j = 0; j < 4; ++j) { const int n = (lane >> 3) + 8 * j; const LDSP float* s = scr + (8 * c) * 33 + n;
        pg8::u32x4 o; o.x = pk2bf(s[0 * 33], s[1 * 33]); o.y = pk2bf(s[2 * 33], s[3 * 33]); o.z = pk2bf(s[4 * 33], s[5 * 33]); o.w = pk2bf(s[6 * 33], s[7 * 33]);
        *(pg8::u32x4*)(WT + (size_t)(n0 + n) * K + k0 + 8 * c) = o; }
    asm volatile("s_waitcnt lgkmcnt(0)" ::: "memory");
}
__device__ __forceinline__ void tr_weight(const float* W, int K, int N, int npad, bf16_t* WT, const float* kscale, LDSP float* scr, int gw, int ngw, int lane) {
    const int nblk = npad / 32, items = (K / 64) * nblk;
    for (int it = gw; it < items; it += ngw) tr_item(W, N, K, WT, N, kscale, scr, it, nblk, lane);
}
constexpr int TRJ_W = 12;
struct TrTab { LDSP int* t; int n; int total; };
__device__ __forceinline__ void trj_put(TrTab& tb, const float* W, int K, int N, int npad, bf16_t* WT) {
    LDSP int* e = tb.t + tb.n * TRJ_W; const unsigned long long w = (unsigned long long)(size_t)W, o = (unsigned long long)(size_t)WT;
    const int nblk = npad / 32, items = (K / 64) * nblk;
    e[0] = (int)(unsigned)w; e[1] = (int)(unsigned)(w >> 32); e[2] = (int)(unsigned)o; e[3] = (int)(unsigned)(o >> 32); e[4] = N; e[5] = K; e[6] = N; e[7] = nblk; e[8] = tb.total; e[9] = tb.total + items;
    tb.total += items; ++tb.n;
}
struct TrCur { bf16_t* wt; int K, k0, n0; };
__device__ __forceinline__ bool trj_issue(LDSP const int* tab, int njobs, int idx, int& j, pg8::f32x4 (&v)[8], TrCur& t, int lane) {
    while (j < njobs && idx >= __builtin_amdgcn_readfirstlane(tab[j * TRJ_W + 9])) ++j;
    if (j >= njobs) return false;
    LDSP const int* e = tab + j * TRJ_W;
    const unsigned wl = __builtin_amdgcn_readfirstlane(e[0]), wh = __builtin_amdgcn_readfirstlane(e[1]), ol = __builtin_amdgcn_readfirstlane(e[2]), oh = __builtin_amdgcn_readfirstlane(e[3]);
    const int ldw = __builtin_amdgcn_readfirstlane(e[4]), K = __builtin_amdgcn_readfirstlane(e[5]), nvalid = __builtin_amdgcn_readfirstlane(e[6]), nblk = __builtin_amdgcn_readfirstlane(e[7]), it = idx - __builtin_amdgcn_readfirstlane(e[8]);
    const float* W = (const float*)(size_t)(((unsigned long long)wh << 32) | wl);
    const int kb = it / nblk, nb = it - kb * nblk, k0 = 64 * kb, n0 = 32 * nb;
    t.wt = (bf16_t*)(size_t)(((unsigned long long)oh << 32) | ol); t.K = K; t.k0 = k0; t.n0 = n0;
    const bool ok = n0 < nvalid;
#pragma unroll
    for (int i = 0; i < 8; ++i) { const int kk = 8 * i + (lane >> 3), nn = 4 * (lane & 7); v[i] = ok ? *(const pg8::f32x4*)(W + (size_t)(k0 + kk) * ldw + n0 + nn) : (pg8::f32x4){0.f, 0.f, 0.f, 0.f}; }
    return true;
}
__device__ __forceinline__ void trj_finish(const pg8::f32x4 (&v)[8], const TrCur& t, LDSP float* scr, int lane) {
#pragma unroll
    for (int i = 0; i < 8; ++i) { const int kk = 8 * i + (lane >> 3), nn = 4 * (lane & 7);
        scr[kk * 33 + nn] = v[i][0]; scr[kk * 33 + nn + 1] = v[i][1]; scr[kk * 33 + nn + 2] = v[i][2]; scr[kk * 33 + nn + 3] = v[i][3]; }
    asm volatile("s_waitcnt lgkmcnt(0)" ::: "memory");
    const int c = lane & 7;
#pragma unroll
    for (int j = 0; j < 4; ++j) { const int n = (lane >> 3) + 8 * j; const LDSP float* s = scr + (8 * c) * 33 + n;
        pg8::u32x4 o; o.x = pk2bf(s[0 * 33], s[1 * 33]); o.y = pk2bf(s[2 * 33], s[3 * 33]); o.z = pk2bf(s[4 * 33], s[5 * 33]); o.w = pk2bf(s[6 * 33], s[7 * 33]);
        *(pg8::u32x4*)(t.wt + (size_t)(t.n0 + n) * t.K + t.k0 + 8 * c) = o; }
    asm volatile("s_waitcnt lgkmcnt(0)" ::: "memory");
}
__device__ __forceinline__ void trj_run(LDSP const int* tab, int njobs, int total, LDSP float* scr, int gw, int ngw, int lane) {
    int j = 0; pg8::f32x4 va[8], vb[8]; TrCur ta, tb;
    int idx = gw;
    bool have = idx < total && trj_issue(tab, njobs, idx, j, va, ta, lane);
    while (have) {
        idx += ngw; const bool hb = idx < total && trj_issue(tab, njobs, idx, j, vb, tb, lane);
        trj_finish(va, ta, scr, lane);
        if (!hb) break;
        idx += ngw; have = idx < total && trj_issue(tab, njobs, idx, j, va, ta, lane);
        trj_finish(vb, tb, scr, lane);
    }
}
__device__ __forceinline__ pg8::f32x4 slab_sum(const float* __restrict__ slab, int ksplit, int m, int q, int lane) {
    using namespace cfg; const int rs = m - MP, pms = rs >> 8, row = rs & 255;
    const float* p = slab + ((size_t)((q * (MS / 256) + pms) * ksplit) * 256 + row) * 256 + 4 * lane;
    pg8::f32x4 s = {0.f, 0.f, 0.f, 0.f};
    for (int k = 0; k < ksplit; ++k) s = s + *(const pg8::f32x4*)(p + (size_t)k * 65536);
    return s;
}
__device__ __forceinline__ void norm_rows_bf16(float* __restrict__ x, const float* __restrict__ gain, bf16_t* xn, const float* __restrict__ slab, int ksplit, int gw, int ngw, int lane) {
    using namespace cfg;
    pg8::f32x4 gv[4];
#pragma unroll
    for (int j = 0; j < 4; ++j) gv[j] = *(const pg8::f32x4*)(gain + 4 * lane + 256 * j);
    for (int m = gw; m < MTOT; m += ngw) {
        float* xr = x + (size_t)m * D; pg8::f32x4 v[4]; float s = 0.f;
#pragma unroll
        for (int j = 0; j < 4; ++j) { v[j] = *(const pg8::f32x4*)(xr + 4 * lane + 256 * j);
            if (ksplit > 1 && m >= MP) { v[j] = v[j] + slab_sum(slab, ksplit, m, j, lane); *(pg8::f32x4*)(xr + 4 * lane + 256 * j) = v[j]; }
            s += (v[j][0] * v[j][0] + v[j][1] * v[j][1]) + (v[j][2] * v[j][2] + v[j][3] * v[j][3]); }
        const float rs = 1.0f / sqrtf(wave_sum64(s) * (1.0f / D) + NORM_EPS);
#pragma unroll
        for (int j = 0; j < 4; ++j) { pg8::u32x2 o; o.x = pk2bf(v[j][0] * rs * gv[j][0], v[j][1] * rs * gv[j][1]); o.y = pk2bf(v[j][2] * rs * gv[j][2], v[j][3] * rs * gv[j][3]);
            *(pg8::u32x2*)(xn + (size_t)m * D + 4 * lane + 256 * j) = o; }
    }
}

__device__ __forceinline__ void fold_sample_rows(float* __restrict__ x, const float* __restrict__ slab, int ksplit, int gw, int ngw, int lane) {
    using namespace cfg;
    for (int m = MP + gw; m < MTOT; m += ngw) {
#pragma unroll
        for (int j = 0; j < 4; ++j) { float* p = x + (size_t)m * D + 4 * lane + 256 * j; *(pg8::f32x4*)p = *(const pg8::f32x4*)p + slab_sum(slab, ksplit, m, j, lane); }
    }
}
struct FastMla {
    float* mh;
    bf16_t *qan, *cb, *kpb;
    bf16_t *qraw, *kvraw;
    bf16_t *qf, *knb, *aob, *vT, *qs;
    float *opart, *lpart;
    bf16_t *wint, *wuqt, *wukvt, *wot;
};
__device__ __forceinline__ void rope_cs(int pos, int i, float& cs, float& sn) {
    const float inv = exp2f(-(float)i * (13.287712379549449f / 16.0f));
    const float ang = (float)pos * inv, kq = rintf(ang * 0.15915494309189535f);
    float rr = fmaf(-kq, 6.28125f, ang); rr = fmaf(-kq, 1.9353071795864769e-3f, rr);
    cs = __cosf(rr); sn = __sinf(rr);
}
__device__ __forceinline__ float bf2f(unsigned short b) { return __uint_as_float(((unsigned)b) << 16); }
__device__ __forceinline__ void mla_norm1_fast(const Ctx& c, const FastMla& fm, int j, int gw, int ngw, int lane) {
    using namespace cfg;
    const pg8::f32x4 gq0 = *(const pg8::f32x4*)(c.in[I_QNORM] + j * QL + 4 * lane), gq1 = *(const pg8::f32x4*)(c.in[I_QNORM] + j * QL + 4 * lane + 256), gc = *(const pg8::f32x4*)(c.in[I_KVNORM] + j * KVL + 4 * lane);
    const float gkr = lane < ROPE ? c.in[I_KRN][j * ROPE + lane] : 0.f;
    for (int m = gw; m < MTOT; m += ngw) {
        const float* h = fm.mh + (size_t)m * 1024;
        pg8::f32x4 qv[2]; float s = 0.f;
#pragma unroll
        for (int t = 0; t < 2; ++t) { qv[t] = *(const pg8::f32x4*)(h + 4 * lane + 256 * t); s += (qv[t][0] * qv[t][0] + qv[t][1] * qv[t][1]) + (qv[t][2] * qv[t][2] + qv[t][3] * qv[t][3]); }
        const float rq = 1.0f / sqrtf(wave_sum64(s) * (1.0f / QL) + NORM_EPS);
#pragma unroll
        for (int t = 0; t < 2; ++t) { const pg8::f32x4 g = t ? gq1 : gq0;
            pg8::u32x2 o; o.x = pk2bf(qv[t][0] * rq * g[0], qv[t][1] * rq * g[1]); o.y = pk2bf(qv[t][2] * rq * g[2], qv[t][3] * rq * g[3]);
            *(pg8::u32x2*)(fm.qan + (size_t)m * QL + 4 * lane + 256 * t) = o; }
        const pg8::f32x4 cv = *(const pg8::f32x4*)(h + QL + 4 * lane);
        const float rc = 1.0f / sqrtf(wave_sum64((cv[0] * cv[0] + cv[1] * cv[1]) + (cv[2] * cv[2] + cv[3] * cv[3])) * (1.0f / KVL) + NORM_EPS);
        const pg8::f32x4 cn = {cv[0] * rc * gc[0], cv[1] * rc * gc[1], cv[2] * rc * gc[2], cv[3] * rc * gc[3]};
        float* co = m < MP ? c.out + O_CKVP + ((size_t)j * MP + m) * KVL : c.out + O_CKVS + ((size_t)j * MS + (m - MP)) * KVL;
        *(pg8::f32x4*)(co + 4 * lane) = cn;
        { pg8::u32x2 o; o.x = pk2bf(cn[0], cn[1]); o.y = pk2bf(cn[2], cn[3]); *(pg8::u32x2*)(fm.cb + (size_t)m * KVL + 4 * lane) = o; }
        const float kv = lane < ROPE ? h[QL + KVL + lane] : 0.f;
        const float rk = 1.0f / sqrtf(wave_sum64(kv * kv) * (1.0f / ROPE) + NORM_EPS);
        const float kn = kv * rk * gkr;
        const float other = __shfl_xor(kn, 16);
        float cs, sn; rope_cs(row_pos(m), lane & 15, cs, sn);
        const float ro = lane < 16 ? kn * cs - other * sn : kn * cs + other * sn;
        if (lane < ROPE) {
            float* ko = m < MP ? c.out + O_KPEP + ((size_t)j * MP + m) * ROPE : c.out + O_KPES + ((size_t)j * MS + (m - MP)) * ROPE;
            ko[lane] = ro;
            fm.kpb[(size_t)m * ROPE + lane] = (bf16_t)(pk2bf(ro, 0.f) & 0xffffu);
        }
    }
}
__device__ __forceinline__ void mla_norm2_fast(const Ctx& c, const FastMla& fm, int j, int gw, int ngw, int lane) {
    using namespace cfg;
    const int hd = lane >> 2, qt = lane & 3;
    const float QSC = 0.10206207261596575f * 1.4426950408889634f;
    float gqn[16], gkn[16], gqr[8];
    { const float* pq = c.in[I_QNN] + j * NOPE + 16 * qt; const float* pk = c.in[I_KNN] + j * NOPE + 16 * qt; const float* pr = c.in[I_QRN] + j * ROPE + 8 * qt;
#pragma unroll
      for (int i4 = 0; i4 < 4; ++i4) { const pg8::f32x4 a = *(const pg8::f32x4*)(pq + 4 * i4), b = *(const pg8::f32x4*)(pk + 4 * i4);
#pragma unroll
          for (int e = 0; e < 4; ++e) { gqn[4 * i4 + e] = a[e]; gkn[4 * i4 + e] = b[e]; } }
#pragma unroll
      for (int i4 = 0; i4 < 2; ++i4) { const pg8::f32x4 a = *(const pg8::f32x4*)(pr + 4 * i4);
#pragma unroll
          for (int e = 0; e < 4; ++e) gqr[4 * i4 + e] = a[e]; } }
    for (int m = gw; m < MTOT; m += ngw) {
        const bf16_t* qr = fm.qraw + (size_t)m * (MH * QD) + hd * QD;
        float v[16]; float s = 0.f;
        { const pg8::u32x4 a = *(const pg8::u32x4*)(qr + 16 * qt), b = *(const pg8::u32x4*)(qr + 16 * qt + 8); const unsigned w[8] = {a.x, a.y, a.z, a.w, b.x, b.y, b.z, b.w};
#pragma unroll
          for (int i = 0; i < 8; ++i) { v[2 * i] = __uint_as_float(w[i] << 16); v[2 * i + 1] = __uint_as_float(w[i] & 0xffff0000u); } }
#pragma unroll
        for (int i = 0; i < 16; ++i) s += v[i] * v[i];
        s += __shfl_xor(s, 1); s += __shfl_xor(s, 2);
        float rs = 1.0f / sqrtf(s * (1.0f / NOPE) + NORM_EPS);
        bf16_t* qo = fm.qf + (size_t)m * (MH * QD) + hd * QD;
        { unsigned w[8], w2[8];
#pragma unroll
          for (int i = 0; i < 8; ++i) { const float a = v[2 * i] * rs * gqn[2 * i], b = v[2 * i + 1] * rs * gqn[2 * i + 1];
              w[i] = pk2bf(a * QSC, b * QSC);
              w2[i] = pk2bf(a * QSC * gkn[2 * i], b * QSC * gkn[2 * i + 1]); }
          *(pg8::u32x4*)(qo + 16 * qt) = (pg8::u32x4){w[0], w[1], w[2], w[3]}; *(pg8::u32x4*)(qo + 16 * qt + 8) = (pg8::u32x4){w[4], w[5], w[6], w[7]};
          if (m >= MP) { bf16_t* q2 = fm.qs + ((size_t)(((m - MP) >> 3) * MH + hd) * 6 + qt) * 128 + ((m - MP) & 7) * 8;
              *(pg8::u32x4*)(q2) = (pg8::u32x4){w2[0], w2[1], w2[4], w2[5]}; *(pg8::u32x4*)(q2 + 64) = (pg8::u32x4){w2[2], w2[3], w2[6], w2[7]}; } }
        float r8[8]; s = 0.f;
        { const pg8::u32x4 a = *(const pg8::u32x4*)(qr + NOPE + 8 * qt); const unsigned w[4] = {a.x, a.y, a.z, a.w};
#pragma unroll
          for (int i = 0; i < 4; ++i) { r8[2 * i] = __uint_as_float(w[i] << 16); r8[2 * i + 1] = __uint_as_float(w[i] & 0xffff0000u); } }
#pragma unroll
        for (int i = 0; i < 8; ++i) s += r8[i] * r8[i];
        s += __shfl_xor(s, 1); s += __shfl_xor(s, 2);
        rs = 1.0f / sqrtf(s * (1.0f / ROPE) + NORM_EPS);
        { unsigned w[4]; float o8[8];
#pragma unroll
          for (int i = 0; i < 8; ++i) { const float mine = r8[i] * rs * gqr[i]; const float oth = __shfl_xor(mine, 2);
              float cs, sn; rope_cs(row_pos(m), (8 * qt + i) & 15, cs, sn);
              o8[i] = qt < 2 ? mine * cs - oth * sn : mine * cs + oth * sn; }
#pragma unroll
          for (int i = 0; i < 4; ++i) w[i] = pk2bf(o8[2 * i] * QSC, o8[2 * i + 1] * QSC);
          *(pg8::u32x4*)(qo + NOPE + 8 * qt) = (pg8::u32x4){w[0], w[1], w[2], w[3]};
          if (m >= MP) *(pg8::u32x4*)(fm.qs + ((size_t)(((m - MP) >> 3) * MH + hd) * 6 + 4 + (qt >> 1)) * 128 + (qt & 1) * 64 + ((m - MP) & 7) * 8) = (pg8::u32x4){w[0], w[1], w[2], w[3]}; }
        const bf16_t* kr = fm.kvraw + (size_t)m * 2048 + hd * NOPE; s = 0.f;
        { const pg8::u32x4 a = *(const pg8::u32x4*)(kr + 16 * qt), b = *(const pg8::u32x4*)(kr + 16 * qt + 8); const unsigned w[8] = {a.x, a.y, a.z, a.w, b.x, b.y, b.z, b.w};
#pragma unroll
          for (int i = 0; i < 8; ++i) { v[2 * i] = __uint_as_float(w[i] << 16); v[2 * i + 1] = __uint_as_float(w[i] & 0xffff0000u); } }
#pragma unroll
        for (int i = 0; i < 16; ++i) s += v[i] * v[i];
        s += __shfl_xor(s, 1); s += __shfl_xor(s, 2);
        rs = 1.0f / sqrtf(s * (1.0f / NOPE) + NORM_EPS);
        bf16_t* ko = fm.knb + (size_t)m * (MH * NOPE) + hd * NOPE;
        { unsigned w[8];
#pragma unroll
          for (int i = 0; i < 8; ++i) { const float a = v[2 * i] * rs * gkn[2 * i], b = v[2 * i + 1] * rs * gkn[2 * i + 1];
              w[i] = pk2bf(a, b); }
          *(pg8::u32x4*)(ko + 16 * qt) = (pg8::u32x4){w[0], w[1], w[2], w[3]}; *(pg8::u32x4*)(ko + 16 * qt + 8) = (pg8::u32x4){w[4], w[5], w[6], w[7]}; }
    }
}
__device__ __forceinline__ void cvt_f32_bf16(const float* __restrict__ s, bf16_t* d, size_t n, size_t gtid, size_t gsz) {
    for (size_t i = gtid * 4; i < n; i += gsz * 4) { const pg8::f32x4 v = *(const pg8::f32x4*)(s + i); pg8::u32x2 o; o.x = pk2bf(v[0], v[1]); o.y = pk2bf(v[2], v[3]); *(pg8::u32x2*)(d + i) = o; }
}
typedef float f32x16_t __attribute__((ext_vector_type(16)));
typedef pg8::bf16x8 bf16x8v;
constexpr int AT_KROW = 208, AT_VROW = 136, AT_KBUF = 64 * AT_KROW, AT_VBUF = 64 * AT_VROW, AT_LDS = 2 * AT_KBUF + 2 * AT_VBUF;
__device__ __forceinline__ void attn_prompt_fast(const bf16_t* __restrict__ qf, const bf16_t* __restrict__ knb, const bf16_t* __restrict__ kpb, const bf16_t* __restrict__ vT, bf16_t* aob, LDSP unsigned char* lds) {
    using namespace cfg;
    const int tid = (int)tid_now(), w = __builtin_amdgcn_readfirstlane(tid >> 6), lane = tid & 63, l31 = lane & 31, h5 = lane >> 5;
    for (int it = blockIdx.x; it < BATCH * MH * 4; it += gridDim.x) {
        const int bh = it >> 2, pr = it & 3, b = bh / MH, h = bh % MH;
        for (int half = 0; half < 2; ++half) {
            const int qb = half ? 7 - pr : pr, q0 = 256 * qb, nt = 4 * qb + 4;
            const int qg = q0 + 32 * w + l31;
            const size_t mrow = (size_t)b * SEQ + qg;
            bf16x8v qfr[6];
#pragma unroll
            for (int s = 0; s < 6; ++s) qfr[s] = *(const bf16x8v*)(qf + mrow * (MH * QD) + h * QD + 16 * s + 8 * h5);
            f32x16_t O[2];
#pragma unroll
            for (int db = 0; db < 2; ++db)
#pragma unroll
                for (int r = 0; r < 16; ++r) O[db][r] = 0.f;
            float mrun = -1e30f, lrun = 0.f;
            pg8::u32x4 rk, rp, rv;
            const int kkey = tid >> 3, kc8 = tid & 7, pkey = tid >> 2, pc4 = tid & 3;
#define AT_LOAD(t) do { const size_t mk = (size_t)b * SEQ + 64 * (t); \
                rk = *(const pg8::u32x4*)(knb + (mk + kkey) * (MH * NOPE) + h * NOPE + kc8 * 8); \
                if (tid < 256) rp = *(const pg8::u32x4*)(kpb + (mk + pkey) * ROPE + pc4 * 8); \
                rv = *(const pg8::u32x4*)(vT + (size_t)(h * VD + kkey) * MTOT + mk + kc8 * 8); } while (0)
#define AT_STORE(buf) do { LDSP unsigned char* kb_ = lds + (buf) * AT_KBUF; LDSP unsigned char* vb_ = lds + 2 * AT_KBUF + (buf) * AT_VBUF; \
                *(LDSP pg8::u32x4*)(kb_ + kkey * AT_KROW + kc8 * 16) = rk; \
                if (tid < 256) *(LDSP pg8::u32x4*)(kb_ + pkey * AT_KROW + 128 + pc4 * 16) = rp; \
                *(LDSP pg8::u32x2*)(vb_ + kkey * AT_VROW + kc8 * 16) = (pg8::u32x2){rv.x, rv.y}; *(LDSP pg8::u32x2*)(vb_ + kkey * AT_VROW + kc8 * 16 + 8) = (pg8::u32x2){rv.z, rv.w}; } while (0)
            AT_LOAD(0); AT_STORE(0);
            __syncthreads();
            for (int t = 0; t < nt; ++t) {
                if (t + 1 < nt) AT_LOAD(t + 1);
                if (64 * t <= q0 + 32 * w + 31) {
                    const LDSP unsigned char* kb_ = lds + (t & 1) * AT_KBUF; const LDSP unsigned char* vb_ = lds + 2 * AT_KBUF + (t & 1) * AT_VBUF;
                    f32x16_t S[2];
#pragma unroll
                    for (int kb = 0; kb < 2; ++kb)
#pragma unroll
                        for (int r = 0; r < 16; ++r) S[kb][r] = 0.f;
#pragma unroll
                    for (int s = 0; s < 6; ++s)
#pragma unroll
                        for (int kb = 0; kb < 2; ++kb) {
                            const bf16x8v a = *(const LDSP bf16x8v*)(kb_ + (32 * kb + l31) * AT_KROW + (16 * s + 8 * h5) * 2);
                            S[kb] = __builtin_amdgcn_mfma_f32_32x32x16_bf16(a, qfr[s], S[kb], 0, 0, 0);
                        }
                    if (64 * t + 63 > q0 + 32 * w) {
#pragma unroll
                        for (int kb = 0; kb < 2; ++kb)
#pragma unroll
                            for (int r = 0; r < 16; ++r) { const int key = 64 * t + 32 * kb + (r & 3) + 8 * (r >> 2) + 4 * h5; if (key > qg) S[kb][r] = -1e30f; }
                    }
                    float mt = -1e30f;
#pragma unroll
                    for (int kb = 0; kb < 2; ++kb)
#pragma unroll
                        for (int r = 0; r < 16; ++r) mt = fmaxf(mt, S[kb][r]);
                    mt = fmaxf(mt, __shfl_xor(mt, 32));
                    const float mnew = fmaxf(mrun, mt), alpha = __builtin_amdgcn_exp2f(mrun - mnew);
                    float ls = 0.f;
#pragma unroll
                    for (int kb = 0; kb < 2; ++kb)
#pragma unroll
                        for (int r = 0; r < 16; ++r) { const float p = __builtin_amdgcn_exp2f(S[kb][r] - mnew); S[kb][r] = p; ls += p; }
                    lrun = lrun * alpha + ls; mrun = mnew;
#pragma unroll
                    for (int db = 0; db < 2; ++db)
#pragma unroll
                        for (int r = 0; r < 16; ++r) O[db][r] *= alpha;
#pragma unroll
                    for (int kb = 0; kb < 2; ++kb)
#pragma unroll
                        for (int s = 0; s < 2; ++s) {
                            pg8::u32x4 pw; pw.x = pk2bf(S[kb][8 * s + 0], S[kb][8 * s + 1]); pw.y = pk2bf(S[kb][8 * s + 2], S[kb][8 * s + 3]); pw.z = pk2bf(S[kb][8 * s + 4], S[kb][8 * s + 5]); pw.w = pk2bf(S[kb][8 * s + 6], S[kb][8 * s + 7]);
                            const bf16x8v pf = __builtin_bit_cast(bf16x8v, pw);
#pragma unroll
                            for (int db = 0; db < 2; ++db) {
                                const LDSP unsigned char* vp = vb_ + (32 * db + l31) * AT_VROW + (32 * kb + 16 * s + 4 * h5) * 2;
                                const pg8::u32x2 v0 = *(const LDSP pg8::u32x2*)vp, v1 = *(const LDSP pg8::u32x2*)(vp + 16);
                                const bf16x8v a = __builtin_bit_cast(bf16x8v, (pg8::u32x4){v0.x, v0.y, v1.x, v1.y});
                                O[db] = __builtin_amdgcn_mfma_f32_32x32x16_bf16(a, pf, O[db], 0, 0, 0);
                            }
                        }
                }
                if (t + 1 < nt) AT_STORE((t + 1) & 1);
                __syncthreads();
            }
#undef AT_LOAD
#undef AT_STORE
            const float inv = 1.0f / (lrun + __shfl_xor(lrun, 32));
            bf16_t* orow = aob + mrow * (MH * VD) + h * VD;
#pragma unroll
            for (int db = 0; db < 2; ++db)
#pragma unroll
                for (int g = 0; g < 4; ++g) { pg8::u32x2 o; o.x = pk2bf(O[db][4 * g] * inv, O[db][4 * g + 1] * inv); o.y = pk2bf(O[db][4 * g + 2] * inv, O[db][4 * g + 3] * inv);
                    *(pg8::u32x2*)(orow + 32 * db + 8 * g + 4 * h5) = o; }
        }
    }
}
constexpr int SD_CROW = 528, SD_WROW = 528, SD_PROW = 272;
constexpr int SD_CIMG = 0, SD_CIMG_SZ = 128 * SD_CROW;
constexpr int SD_WBUF = SD_CIMG + SD_CIMG_SZ, SD_WBUF_SZ = 32 * 1040;
constexpr int SD_XCH = SD_WBUF + 2 * SD_WBUF_SZ, SD_XCH_SZ = 4 * 5 * 64 * 4;
constexpr int SD_PIMG = SD_XCH + 2 * SD_XCH_SZ, SD_PIMG_SZ = 32 * SD_PROW;
constexpr int SD_END = SD_PIMG + 2 * SD_PIMG_SZ;
typedef short s16x4 __attribute__((ext_vector_type(4)));
#define MFMA32(a, b, c) __builtin_amdgcn_mfma_f32_32x32x16_bf16(a, b, c, 0, 0, 0)

__device__ __forceinline__ float mla_b2_bound(const Ctx& c, int j, int lane) {
    using namespace cfg;
    float gq = fabsf(c.in[I_QNN][j * NOPE + lane]), gk = fabsf(c.in[I_KNN][j * NOPE + lane]), gqr = fabsf(c.in[I_QRN][j * ROPE + (lane & 31)]), gkr = fabsf(c.in[I_KRN][j * ROPE + (lane & 31)]);
#pragma unroll
    for (int o = 1; o < 64; o <<= 1) { gq = fmaxf(gq, __shfl_xor(gq, o)); gk = fmaxf(gk, __shfl_xor(gk, o)); gqr = fmaxf(gqr, __shfl_xor(gqr, o)); gkr = fmaxf(gkr, __shfl_xor(gkr, o)); }
    return (64.f * gq * gk + 32.f * gqr * gkr) * (0.10206207261596575f * 1.4426950408889634f);
}

__device__ __forceinline__ void sd_pv_core(const int G, f32x16_t& Og, f32x16_t& Lacc, LDSP unsigned char* lds, int w, int lane, int l31, int h5) {
    asm volatile("" : "+v"(lane)); l31 = lane & 31; h5 = lane >> 5;
    const LDSP unsigned char* pimg = lds + SD_PIMG + (G & 1) * SD_PIMG_SZ;
    const unsigned onesw = (l31 == G) ? 0x3F803F80u : 0u;
    const bf16x8v onesv = __builtin_bit_cast(bf16x8v, (pg8::u32x4){onesw, onesw, onesw, onesw});
#pragma unroll
    for (int sp = 0; sp < 8; ++sp) {
        const bf16x8v a = *(const LDSP bf16x8v*)(pimg + l31 * SD_PROW + (16 * sp + 8 * h5) * 2);
        const int key0 = 16 * sp + 8 * h5 + ((lane & 15) >> 2), col = 32 * w + 16 * ((lane >> 4) & 1) + 4 * (lane & 3);
        const s16x4 t0 = __builtin_amdgcn_ds_read_tr16_b64_v4i16((LDSP s16x4*)(lds + SD_CIMG + key0 * SD_CROW + col * 2));
        const s16x4 t1 = __builtin_amdgcn_ds_read_tr16_b64_v4i16((LDSP s16x4*)(lds + SD_CIMG + (key0 + 4) * SD_CROW + col * 2));
        const bf16x8v b = (bf16x8v){t0[0], t0[1], t0[2], t0[3], t1[0], t1[1], t1[2], t1[3]};
        Og = MFMA32(a, b, Og);
        if (sp == w) Lacc = MFMA32(a, onesv, Lacc);
        if (sp & 1) __builtin_amdgcn_sched_barrier(0);
    }
}

__device__ __forceinline__ void sd_pv(const int G, f32x16_t& Og, f32x16_t& Lacc, LDSP unsigned char* lds, int w, int lane, int l31, int h5) {
    sd_pv_core(G, Og, Lacc, lds, w, lane, l31, h5);
#if defined(PROBE_DUP) && (PROBE_DUP & (1 << 21))
    f32x16_t D0, D1;
#pragma unroll
    for (int r = 0; r < 16; ++r) { D0[r] = 0.f; D1[r] = 0.f; }
    sd_pv_core(G, D0, D1, lds, w, lane, l31, h5); asm volatile("" :: "v"(D0), "v"(D1));
#endif
}
__device__ __forceinline__ void sd_glds16(const void* gsrc, unsigned lds_dst) {
    unsigned keep;
    asm volatile("s_mov_b32 %0, m0\n\ts_mov_b32 m0, %2\n\ts_nop 0\n\tglobal_load_lds_dwordx4 %1, off\n\ts_mov_b32 m0, %0" : "=&s"(keep) : "v"(gsrc), "s"(lds_dst) : "memory");
}
#define SD_WLOAD(h, buf) do { if (w >= 4) { const char* wsrc_ = (const char*)(fm.wukvt + (size_t)(h) * NOPE * KVL); int ln_ = lane; asm volatile("" : "+v"(ln_)); \
        const unsigned ldsb_ = __builtin_amdgcn_readfirstlane((unsigned)(size_t)(lds + SD_WBUF + (buf) * SD_WBUF_SZ)) + (unsigned)(8 * (w - 4)) * 1040u; \
        _Pragma("unroll") for (int k = 0; k < 8; ++k) { \
        const unsigned voff_ = (unsigned)(((8 * (w - 4) + k) + 32 * (ln_ >> 5)) * KVL + (ln_ & 31) * 8) * 2u; \
        sd_glds16(wsrc_ + voff_, ldsb_ + (unsigned)k * 1040u); } } } while (0)
template <int G, bool DOPV = true>
__device__ __forceinline__ void sd_group(const FastMla& fm, const bf16_t* __restrict__ qs, const int s, LDSP unsigned char* lds, const int w, const int lane, const int l31_, const int h5_, const int kb, const int dh, const int rot,
                                         const bf16x8v (&cfr)[16], const bf16x8v (&kpfr)[2], pg8::u32x4 (&wr)[4], f32x16_t (&O)[4], f32x16_t& Lacc, const float B2) {
    using namespace cfg;
        _Pragma("unroll 1") for (int hh = 0; hh < 4; ++hh) {
            const int h = (4 * G + hh + rot) & (MH - 1);
            int lane_ = lane; asm volatile("" : "+v"(lane_)); const int l31 = lane_ & 31, h5 = lane_ >> 5;
            { LDSP unsigned char* wdst = lds + SD_WBUF + ((h + 1) & 1) * SD_WBUF_SZ + (2 * w + h5) * 1040 + l31 * 16;
              *(LDSP pg8::u32x4*)(wdst) = wr[0]; *(LDSP pg8::u32x4*)(wdst + 16640) = wr[1]; *(LDSP pg8::u32x4*)(wdst + 512) = wr[2]; *(LDSP pg8::u32x4*)(wdst + 17152) = wr[3]; }
            const char* qb = (const char*)qs + (size_t)(s * MH + h) * 1536;
            const unsigned zoff = (unsigned)((DB * MH - (s * MH + h)) * 1536);
            const unsigned qlo = l31 < 8 ? (unsigned)(h5 * 128 + l31 * 16) : zoff;
            const bf16x8v qn0 = *(const bf16x8v*)(qb + dh * 512 + qlo), qn1 = *(const bf16x8v*)(qb + dh * 512 + 256 + qlo), qp0 = *(const bf16x8v*)(qb + 1024 + qlo), qp1 = *(const bf16x8v*)(qb + 1280 + qlo);
            { const char* wsrc = (const char*)(fm.wukvt + (size_t)((h + 2) & (MH - 1)) * NOPE * KVL) + (unsigned)(64 * w + lane_) * 16u;
#pragma unroll
              for (int k = 0; k < 4; ++k) wr[k] = *(const pg8::u32x4*)(wsrc + k * 8192); }
            f32x16_t KN;
#pragma unroll
            for (int r = 0; r < 16; ++r) KN[r] = 0.f;
            { const LDSP unsigned char* wb = lds + SD_WBUF + (h & 1) * SD_WBUF_SZ + l31 * 1040 + dh * 512 + h5 * 16;
#pragma unroll
              for (int s_ = 0; s_ < 16; ++s_) { const bf16x8v a = *(const LDSP bf16x8v*)(wb + 32 * s_); KN = MFMA32(a, cfr[s_], KN); if ((s_ & 3) == 3) __builtin_amdgcn_sched_barrier(0); } }
#if defined(PROBE_DUP) && (PROBE_DUP & (1 << 19))
            { const LDSP unsigned char* wb = lds + SD_WBUF + (h & 1) * SD_WBUF_SZ + l31 * 1040 + dh * 512 + h5 * 16;
#pragma unroll
              for (int s_ = 0; s_ < 16; ++s_) { const bf16x8v a = *(const LDSP bf16x8v*)(wb + 32 * s_); KN = MFMA32(a, cfr[s_], KN); if ((s_ & 3) == 3) __builtin_amdgcn_sched_barrier(0); }
#pragma unroll
              for (int r = 0; r < 16; ++r) KN[r] *= 0.5f; }
#endif
#if defined(PROBE_DUP) && (PROBE_DUP & (1 << 23))
            _Pragma("unroll 1") for (int rep_ = 0; rep_ < 2; ++rep_) {
            asm volatile("" : "+v"(KN));
#else
            {
#endif
            float ssq = 0.f;
#pragma unroll
            for (int r = 0; r < 16; ++r) ssq += KN[r] * KN[r];
            ssq += __shfl_xor(ssq, 32);
            {
            f32x16_t S;
#pragma unroll
            for (int r = 0; r < 16; ++r) S[r] = 0.f;
#pragma unroll
            for (int s_ = 0; s_ < 2; ++s_) { const bf16x8v kf = __builtin_bit_cast(bf16x8v, (pg8::u32x4){pk2bf(KN[8 * s_], KN[8 * s_ + 1]), pk2bf(KN[8 * s_ + 2], KN[8 * s_ + 3]), pk2bf(KN[8 * s_ + 4], KN[8 * s_ + 5]), pk2bf(KN[8 * s_ + 6], KN[8 * s_ + 7])});
                S = MFMA32(s_ == 0 ? qn0 : qn1, kf, S); }
            LDSP float* xch = (LDSP float*)(lds + SD_XCH + (h & 1) * SD_XCH_SZ) + kb * 320;
            if (dh == 1) { xch[lane_] = S[0]; xch[64 + lane_] = S[1]; xch[128 + lane_] = S[2]; xch[192 + lane_] = S[3]; xch[256 + lane_] = ssq; }
            asm volatile("s_waitcnt lgkmcnt(0)" ::: "memory");
            __builtin_amdgcn_s_barrier();
            asm volatile("" ::: "memory");
            if (dh == 0) {
                const float rstd = __builtin_amdgcn_rsqf((ssq + xch[256 + lane_]) * (1.0f / NOPE) + NORM_EPS);
                f32x16_t T;
#pragma unroll
                for (int r = 0; r < 16; ++r) T[r] = 0.f;
                T[0] = (S[0] + xch[lane_]) * rstd; T[1] = (S[1] + xch[64 + lane_]) * rstd; T[2] = (S[2] + xch[128 + lane_]) * rstd; T[3] = (S[3] + xch[192 + lane_]) * rstd;
                T = MFMA32(qp0, kpfr[0], T); T = MFMA32(qp1, kpfr[1], T);
                LDSP bf16_t* prow = (LDSP bf16_t*)(lds + SD_PIMG + (G & 1) * SD_PIMG_SZ + (hh * 8 + 4 * h5) * SD_PROW) + 32 * kb + l31;
#pragma unroll
                for (int q = 0; q < 4; ++q) prow[q * (SD_PROW / 2)] = (bf16_t)(pk2bf(exp2f(T[q] - B2), 0.f) & 0xffffu);
            }
            }
            }
        }
        if (G > 0 && DOPV) sd_pv(G > 0 ? G - 1 : 0, O[G > 0 ? G - 1 : 0], Lacc, lds, w, lane, l31_, h5_);
}

__device__ __forceinline__ void mla_sample_decode(const Ctx& c, const FastMla& fm, const bf16_t* __restrict__ qs, float* opart, float* lpart, int j, LDSP unsigned char* lds) {
    using namespace cfg;
    const int tid = (int)tid_now(), tid_ = tid, w = __builtin_amdgcn_readfirstlane(tid >> 6), lane = tid & 63, l31 = lane & 31, h5 = lane >> 5, kb = w & 3, dh = w >> 2;
    const float* ckv = c.in[I_CKV] + (size_t)j * NPOOL * PAGE * KVL; const float* kpe = c.in[I_KPE] + (size_t)j * NPOOL * PAGE * ROPE;
    const float B2 = __builtin_bit_cast(float, __builtin_amdgcn_readfirstlane(__builtin_bit_cast(int, mla_b2_bound(c, j, lane))));
    for (int it = blockIdx.x; it < DB * 2; it += gridDim.x) {
        const int s = it >> 1, hf = it & 1, rot = 2 * ((blockIdx.x >> 3) & 7);
        f32x16_t O[4], Lacc;
#pragma unroll
        for (int r = 0; r < 16; ++r) { O[0][r] = 0.f; O[1][r] = 0.f; O[2][r] = 0.f; O[3][r] = 0.f; Lacc[r] = 0.f; }
        pg8::u32x4 wr[4];
        __syncthreads();
        {
            int t_ = tid_; asm volatile("" : "+v"(t_));
            const char* wsrc = (const char*)(fm.wukvt + (size_t)rot * NOPE * KVL); const unsigned vo = (unsigned)t_ * 16u; LDSP unsigned char* wdst = lds + SD_WBUF + (t_ >> 5) * 1040 + (t_ & 31) * 16;
            pg8::u32x4 t0 = *(const pg8::u32x4*)(wsrc + vo), t1 = *(const pg8::u32x4*)(wsrc + 8192 + vo), t2 = *(const pg8::u32x4*)(wsrc + 16384 + vo), t3 = *(const pg8::u32x4*)(wsrc + 24576 + vo);
            *(LDSP pg8::u32x4*)(wdst) = t0; *(LDSP pg8::u32x4*)(wdst + 16640) = t1; *(LDSP pg8::u32x4*)(wdst + 512) = t2; *(LDSP pg8::u32x4*)(wdst + 17152) = t3;
#pragma unroll
            for (int k = 0; k < 4; ++k) wr[k] = *(const pg8::u32x4*)(wsrc + NOPE * KVL * 2 + k * 8192 + vo);
        }
        for (int pi = 0; pi < NPAGES / 2; ++pi) {
            const int pg = __builtin_amdgcn_readfirstlane(c.page_table[s * NPAGES + hf * (NPAGES / 2) + pi]);
            __syncthreads();
            { const char* src = (const char*)(ckv + (size_t)pg * PAGE * KVL); int tid = tid_; asm volatile("" : "+v"(tid));
              pg8::f32x4 v[16];
#pragma unroll
              for (int k = 0; k < 16; ++k) v[k] = __builtin_nontemporal_load((const pg8::f32x4*)(src + (size_t)k * 8192 + (unsigned)tid * 16u));
#pragma unroll
              for (int k = 0; k < 16; ++k) { pg8::u32x2 o; o.x = pk2bf(v[k][0], v[k][1]); o.y = pk2bf(v[k][2], v[k][3]);
                  *(LDSP pg8::u32x2*)(lds + SD_CIMG + ((tid >> 6) + 8 * k) * SD_CROW + (tid & 63) * 8) = o; } }
#if defined(PROBE_DUP) && (PROBE_DUP & (1 << 20))
            { const char* src = (const char*)(ckv + (size_t)pg * PAGE * KVL); int tid = tid_; asm volatile("" : "+v"(tid));
              pg8::f32x4 v[16];
#pragma unroll
              for (int k = 0; k < 16; ++k) v[k] = *(const pg8::f32x4*)(src + (size_t)k * 8192 + (unsigned)tid * 16u);
#pragma unroll
              for (int k = 0; k < 16; ++k) { pg8::u32x2 o; o.x = pk2bf(v[k][0], v[k][1]); o.y = pk2bf(v[k][2], v[k][3]);
                  *(LDSP pg8::u32x2*)(lds + SD_CIMG + ((tid >> 6) + 8 * k) * SD_CROW + (tid & 63) * 8) = o; } }
#endif
            bf16x8v kpfr[2];
            if (dh == 0) {
#pragma unroll
                for (int s_ = 0; s_ < 2; ++s_) { const float* kp = kpe + ((size_t)pg * PAGE + 32 * kb + l31) * ROPE + 16 * s_ + 8 * h5; const pg8::f32x4 a = *(const pg8::f32x4*)kp, b = *(const pg8::f32x4*)(kp + 4);
                    kpfr[s_] = __builtin_bit_cast(bf16x8v, (pg8::u32x4){pk2bf(a[0], a[1]), pk2bf(a[2], a[3]), pk2bf(b[0], b[1]), pk2bf(b[2], b[3])}); }
            }
            asm volatile("s_waitcnt vmcnt(0)" ::: "memory");
            __syncthreads();
            bf16x8v cfr[16];
#pragma unroll
            for (int s_ = 0; s_ < 16; ++s_) cfr[s_] = *(const LDSP bf16x8v*)(lds + SD_CIMG + (32 * kb + l31) * SD_CROW + (16 * s_ + 8 * h5) * 2);
            sd_group<0>(fm, qs, s, lds, w, lane, l31, h5, kb, dh, rot, cfr, kpfr, wr, O, Lacc, B2);
            sd_group<1>(fm, qs, s, lds, w, lane, l31, h5, kb, dh, rot, cfr, kpfr, wr, O, Lacc, B2);
            sd_group<2>(fm, qs, s, lds, w, lane, l31, h5, kb, dh, rot, cfr, kpfr, wr, O, Lacc, B2);
            sd_group<3>(fm, qs, s, lds, w, lane, l31, h5, kb, dh, rot, cfr, kpfr, wr, O, Lacc, B2);
#if defined(PROBE_DUP) && (PROBE_DUP & (1 << 29))
            __syncthreads();
            sd_group<0, false>(fm, qs, s, lds, w, lane, l31, h5, kb, dh, rot, cfr, kpfr, wr, O, Lacc, B2);
            sd_group<1, false>(fm, qs, s, lds, w, lane, l31, h5, kb, dh, rot, cfr, kpfr, wr, O, Lacc, B2);
            sd_group<2, false>(fm, qs, s, lds, w, lane, l31, h5, kb, dh, rot, cfr, kpfr, wr, O, Lacc, B2);
            sd_group<3, false>(fm, qs, s, lds, w, lane, l31, h5, kb, dh, rot, cfr, kpfr, wr, O, Lacc, B2);
#endif
            __syncthreads();
            sd_pv(3, O[3], Lacc, lds, w, lane, l31, h5);
        }
        {float* op = opart + (size_t)it * (MH * DS) * KVL; int lo_ = lane; asm volatile("" : "+v"(lo_)); const int l31 = lo_ & 31, h5 = lo_ >> 5;
#pragma unroll
        for (int g = 0; g < 4; ++g)
#pragma unroll
            for (int r = 0; r < 16; ++r) op[(size_t)((((4 * g + (r >> 2) + rot) & (MH - 1)) << 3) + (r & 3) + 4 * h5) * KVL + 32 * w + l31] = O[g][r];
        __syncthreads();
        LDSP float* ltab = (LDSP float*)(lds + SD_XCH);
        if (l31 < 4) {
#pragma unroll
            for (int r = 0; r < 16; ++r) ltab[w * 128 + l31 * 32 + (r & 3) + 8 * (r >> 2) + 4 * h5] = Lacc[r];
        }
        __syncthreads();
        { const int t2 = (int)tid_now();
        if (t2 < 128) { float a = 0.f;
#pragma unroll
            for (int ww = 0; ww < 8; ++ww) a += ltab[ww * 128 + t2];
            lpart[(size_t)it * 128 + ((((t2 >> 3) + rot) & (MH - 1)) << 3) + (t2 & 7)] = a; } }
        }
    }
}

__device__ __forceinline__ void mla_sample_combine(const Ctx& c, const FastMla& fm, const float* __restrict__ opart, const float* __restrict__ lpart, int j, LDSP unsigned char* lds) {
    using namespace cfg;
    const int tid = (int)tid_now(), w = tid >> 6, lane = tid & 63, gw = blockIdx.x * 8 + w, ngw = gridDim.x * 8;
    const float B2 = mla_b2_bound(c, j, lane);
    LDSP float* ol = (LDSP float*)(lds + w * 8704); LDSP float* ptab = ol + 8 * KVL; LDSP float* lt = ptab + 64;
    const float* wuv = c.in[I_WUV] + (size_t)j * KVL * MH * VD;
    for (int item = gw; item < DB * MH; item += ngw) {
        const int s = item / MH, h = item % MH, q = lane >> 3, jn = lane & 7;
        const size_t rq = (size_t)MP + s * DS + q, rk = (size_t)MP + s * DS + jn;
        const bf16_t* qv = fm.qf + rq * (MH * QD) + h * QD; const bf16_t* kn = fm.knb + rk * (MH * NOPE) + h * NOPE; const bf16_t* kp = fm.kpb + rk * ROPE;
        const float* wp = wuv + (size_t)h * VD + lane;
        float wa[16];
#pragma unroll
        for (int i = 0; i < 16; ++i) wa[i] = wp[(size_t)i * (MH * VD)];
        float cn[DS][4];
#pragma unroll
        for (int jj = 0; jj < DS; ++jj)
#pragma unroll
            for (int k = 0; k < 4; ++k) cn[jj][k] = bf2f(fm.cb[((size_t)MP + s * DS + jj) * KVL + lane + 64 * k]);
        float sc = 0.f;
#pragma unroll
        for (int d8 = 0; d8 < QD / 8; ++d8) { const pg8::u32x4 a = *(const pg8::u32x4*)(qv + 8 * d8), b = d8 < NOPE / 8 ? *(const pg8::u32x4*)(kn + 8 * d8) : *(const pg8::u32x4*)(kp + 8 * (d8 - NOPE / 8));
            const unsigned aw[4] = {a.x, a.y, a.z, a.w}, bw[4] = {b.x, b.y, b.z, b.w};
#pragma unroll
            for (int e = 0; e < 4; ++e) sc += __uint_as_float(aw[e] << 16) * __uint_as_float(bw[e] << 16) + __uint_as_float(aw[e] & 0xffff0000u) * __uint_as_float(bw[e] & 0xffff0000u); }
        const float p = jn <= q ? exp2f(sc - B2) : 0.f;
        float ls = p; ls += __shfl_xor(ls, 1); ls += __shfl_xor(ls, 2); ls += __shfl_xor(ls, 4);
        ptab[lane] = p;
        if (jn == 0) lt[q] = ls + lpart[(size_t)(2 * s) * 128 + h * DS + q] + lpart[(size_t)(2 * s + 1) * 128 + h * DS + q];
        asm volatile("s_waitcnt lgkmcnt(0)" ::: "memory");
#pragma unroll
        for (int qq = 0; qq < DS; ++qq)
#pragma unroll
            for (int k = 0; k < 4; ++k) { const int r = lane + 64 * k;
                float a = opart[((size_t)(2 * s) * 128 + h * DS + qq) * KVL + r] + opart[((size_t)(2 * s + 1) * 128 + h * DS + qq) * KVL + r];
#pragma unroll
                for (int jj = 0; jj < DS; ++jj) a += ptab[qq * 8 + jj] * cn[jj][k];
                ol[qq * KVL + r] = a; }
        asm volatile("s_waitcnt lgkmcnt(0)" ::: "memory");
        float acc[DS];
#pragma unroll
        for (int qq = 0; qq < DS; ++qq) acc[qq] = 0.f;
        float wb[16];
        for (int r0 = 0; r0 < KVL; r0 += 32) {
#pragma unroll
            for (int i = 0; i < 16; ++i) wb[i] = wp[(size_t)(r0 + 16 + i) * (MH * VD)];
#pragma unroll
            for (int i4 = 0; i4 < 4; ++i4)
#pragma unroll
                for (int qq = 0; qq < DS; ++qq) { const pg8::f32x4 o4 = *(const LDSP pg8::f32x4*)(ol + qq * KVL + r0 + 4 * i4);
                    acc[qq] += o4[0] * wa[4 * i4] + o4[1] * wa[4 * i4 + 1] + o4[2] * wa[4 * i4 + 2] + o4[3] * wa[4 * i4 + 3]; }
            if (r0 + 32 < KVL) {
#pragma unroll
                for (int i = 0; i < 16; ++i) wa[i] = wp[(size_t)(r0 + 32 + i) * (MH * VD)]; }
#pragma unroll
            for (int i4 = 0; i4 < 4; ++i4)
#pragma unroll
                for (int qq = 0; qq < DS; ++qq) { const pg8::f32x4 o4 = *(const LDSP pg8::f32x4*)(ol + qq * KVL + r0 + 16 + 4 * i4);
                    acc[qq] += o4[0] * wb[4 * i4] + o4[1] * wb[4 * i4 + 1] + o4[2] * wb[4 * i4 + 2] + o4[3] * wb[4 * i4 + 3]; }
        }
#pragma unroll
        for (int qq = 0; qq < DS; ++qq) fm.aob[((size_t)MP + s * DS + qq) * (MH * VD) + h * VD + lane] = (bf16_t)(pk2bf(acc[qq] / lt[qq], 0.f) & 0xffffu);
        asm volatile("s_waitcnt lgkmcnt(0)" ::: "memory");
    }
}

struct FastRw {
    bf16_t* xm;
    bf16_t* rkv;
    bf16_t* hb;
    bf16_t* lu;
    float* vf;
    float* ops;
    bf16_t* yo;
    bf16_t *wrkvt, *lorat, *wot;
};
constexpr int RW_REC = 464;
constexpr int RW_CH = 32;
constexpr int RW_BUF = RW_CH * RW_REC * 4;
struct RwSel { __device__ static __forceinline__ int sel(int pn) { return pn < 12 ? (pn >> 2) : (pn == 15 ? 2 : pn - 9); } };

__device__ __forceinline__ void rw_mix_fast(const Ctx& c, const FastRw& fr, int l, int gw, int ngw, int lane) {
    using namespace cfg; const int j = l / 3;
    const float* gain = c.in[I_NMIX] + l * D;
    pg8::f32x4 gv[4], muv[6][4];
#pragma unroll
    for (int q = 0; q < 4; ++q) { gv[q] = *(const pg8::f32x4*)(gain + 4 * lane + 256 * q);
#pragma unroll
        for (int p = 0; p < 6; ++p) muv[p][q] = *(const pg8::f32x4*)(c.in[I_MU] + ((size_t)j * 6 + p) * D + 4 * lane + 256 * q); }
    for (int m = gw; m < MTOT; m += ngw) {
        const int t = row_t(m), sq = row_seq(m);
        pg8::f32x4 xc[4], xp[4]; float s = 0.f, sp = 0.f;
#pragma unroll
        for (int q = 0; q < 4; ++q) { xc[q] = *(const pg8::f32x4*)(c.x + (size_t)m * D + 4 * lane + 256 * q);
            s += (xc[q][0] * xc[q][0] + xc[q][1] * xc[q][1]) + (xc[q][2] * xc[q][2] + xc[q][3] * xc[q][3]); }
        if (t > 0) {
#pragma unroll
            for (int q = 0; q < 4; ++q) { xp[q] = *(const pg8::f32x4*)(c.x + (size_t)(m - 1) * D + 4 * lane + 256 * q); sp += (xp[q][0] * xp[q][0] + xp[q][1] * xp[q][1]) + (xp[q][2] * xp[q][2] + xp[q][3] * xp[q][3]); }
        }
        const float rs = 1.0f / sqrtf(wave_sum64(s) * (1.0f / D) + NORM_EPS), rsp = 1.0f / sqrtf(wave_sum64(sp) * (1.0f / D) + NORM_EPS);
#pragma unroll
        for (int q = 0; q < 4; ++q) {
#pragma unroll
            for (int e = 0; e < 4; ++e) xc[q][e] = xc[q][e] * rs * gv[q][e];
            if (t > 0) {
#pragma unroll
                for (int e = 0; e < 4; ++e) xp[q][e] = xp[q][e] * rsp * gv[q][e];
            } else if (sq < BATCH) xp[q] = (pg8::f32x4){0.f, 0.f, 0.f, 0.f};
            else xp[q] = *(const pg8::f32x4*)(c.in[I_SHIFT] + ((size_t)j * DB + (sq - BATCH)) * D + 4 * lane + 256 * q);
        }
        if (t == seq_len(sq) - 1) {
            float* so = sq < BATCH ? c.out + O_SHP + ((size_t)j * BATCH + sq) * D : c.out + O_SHS + ((size_t)j * DB + (sq - BATCH)) * D;
#pragma unroll
            for (int q = 0; q < 4; ++q) *(pg8::f32x4*)(so + 4 * lane + 256 * q) = xc[q];
        }
#pragma unroll
        for (int p = 0; p < 6; ++p)
#pragma unroll
            for (int q = 0; q < 4; ++q) { const pg8::f32x4 mu = muv[p][q];
                pg8::u32x2 o; o.x = pk2bf(xc[q][0] + (xp[q][0] - xc[q][0]) * mu[0], xc[q][1] + (xp[q][1] - xc[q][1]) * mu[1]); o.y = pk2bf(xc[q][2] + (xp[q][2] - xc[q][2]) * mu[2], xc[q][3] + (xp[q][3] - xc[q][3]) * mu[3]);
                *(pg8::u32x2*)(fr.xm + ((size_t)p * MTOT + m) * D + 4 * lane + 256 * q) = o; }
        if (lane < 32) *(unsigned*)(fr.hb + (size_t)m * 384 + 320 + 2 * lane) = 0u;
    }
}
struct EpiRwkv {
    static constexpr bool PERM = true;
    bf16_t* rkv; bf16_t* hb;
    __device__ __forceinline__ void operator()(const pg8::f32x4 (&acc)[2][2][4][2], const pg8::Unit& u, int wr, int wc, int fr, int fq) const {
        using namespace pg8;
        const int row0 = u.pm * BM + wr * 64 + fr, cl0 = wc * 32 + 8 * fq;
        const int pn = u.pn;
        bf16_t* base; int ldc, coff, nvalid, act = 0;
        if (pn < 12) { base = rkv; ldc = 3072; coff = pn * 256; nvalid = 256; }
        else { base = hb; ldc = 384; if (pn == 12) { coff = 0; nvalid = 64; act = 1; } else if (pn == 13) { coff = 64; nvalid = 64; } else if (pn == 14) { coff = 128; nvalid = 160; act = 2; } else { coff = 288; nvalid = 32; } }
#pragma unroll
        for (int ai = 0; ai < 2; ++ai)
#pragma unroll
            for (int m = 0; m < 4; ++m) { bf16_t* rowp = base + (size_t)(row0 + ai * HALF + m * 16) * ldc + coff;
#pragma unroll
                for (int bj = 0; bj < 2; ++bj) { const int cl = cl0 + bj * HALF; if (cl >= nvalid) continue;
                    f32x4 v0 = acc[ai][bj][m][0], v1 = acc[ai][bj][m][1];
                    if (act == 1) {
#pragma unroll
                        for (int e = 0; e < 4; ++e) { v0[e] = tanhf(v0[e]); v1[e] = tanhf(v1[e]); } }
                    else if (act == 2) {
#pragma unroll
                        for (int e = 0; e < 4; ++e) { v0[e] = 1.0f / (1.0f + __expf(-v0[e])); v1[e] = 1.0f / (1.0f + __expf(-v1[e])); } }
                    u32x4 w; w.x = cvt_pk_bf16(v0[0], v0[1]); w.y = cvt_pk_bf16(v0[2], v0[3]); w.z = cvt_pk_bf16(v1[0], v1[1]); w.w = cvt_pk_bf16(v1[2], v1[3]);
                    *(u32x4*)(rowp + cl) = w; } }
    }
};
__device__ __forceinline__ void rw_build_lorat(const Ctx& c, bf16_t* lorat, int j, size_t gtid, size_t gsz) {
    using namespace cfg;
    for (size_t i = gtid; i < (size_t)4096 * 384; i += gsz) {
        const int n = (int)(i / 384), k = (int)(i % 384), grp = n >> 10, ch = n & 1023; float v = 0.f;
        if (grp == 0 && k < 64) v = c.in[I_W2][((size_t)j * RW_DL + k) * D + ch];
        else if (grp == 1 && k >= 64 && k < 128) v = c.in[I_A2][((size_t)j * RW_AL + (k - 64)) * D + ch];
        else if (grp == 2 && k >= 128 && k < 288) v = c.in[I_G2][((size_t)j * RW_GL + (k - 128)) * D + ch];
        else if (grp == 3 && k >= 288 && k < 320 && j > 0) v = c.in[I_V2][((size_t)(j - 1) * RW_VL + (k - 288)) * D + ch];
        lorat[i] = (bf16_t)(pk2bf(v, 0.f) & 0xffffu);
    }
}
__device__ __forceinline__ size_t rw_rec_base(int sq, int h) {
    using namespace cfg;
    return sq < BATCH ? ((size_t)sq * RHEADS + h) * SEQ : (size_t)MP * RHEADS + ((size_t)(sq - BATCH) * RHEADS + h) * DS;
}
__device__ __forceinline__ void rw_prep_fast(const Ctx& c, const FastRw& fr, int l, int gw, int ngw, int lane) {
    using namespace cfg; const int j = l / 3;
    for (int it = gw; it < MTOT * RHEADS; it += ngw) {
        const int m = it / RHEADS, h = it % RHEADS, ch = h * RH + lane;
        const bf16_t* rk = fr.rkv + (size_t)m * 3072 + ch; const bf16_t* lu = fr.lu + (size_t)m * 4096 + ch;
        const float r = bf2f(rk[0]), k0 = bf2f(rk[1024]); float v = bf2f(rk[2048]);
        const float wpre = bf2f(lu[0]), apre = bf2f(lu[1024]), gg = bf2f(lu[2048]), vpre = bf2f(lu[3072]);
        const float wl = -softplusf_(-(c.in[I_W0][j * D + ch] + wpre)) - 0.5f;
        const float w = expf(-expf(wl));
        if (j == 0) fr.vf[(size_t)m * D + ch] = v;
        else v = v + (fr.vf[(size_t)m * D + ch] - v) * sigmoidf_(c.in[I_V0][(j - 1) * D + ch] + vpre);
        const float a = sigmoidf_(c.in[I_A0][j * D + ch] + apre);
        float kk = k0 * c.in[I_KK][j * D + ch];
        const float nn = wave_sum64(kk * kk);
        kk *= 1.0f / fmaxf(sqrtf(nn), 1e-12f);
        const float k2 = k0 * (1.0f + (a - 1.0f) * c.in[I_KA][j * D + ch]);
        const float bo = kk * a;
        const float br = wave_sum64(bo * r), kr = wave_sum64(k2 * r), bonus = wave_sum64(r * k2 * c.in[I_RK][(size_t)j * D + ch]);
        const int sq = row_seq(m), t = row_t(m);
        float* rec = fr.ops + (rw_rec_base(sq, h) + t) * RW_REC;
        rec[lane] = -kk; rec[64 + lane] = w * r; rec[128 + lane] = w; rec[192 + lane] = bo; rec[256 + lane] = k2; rec[320 + lane] = v; rec[384 + lane] = gg;
        if (lane == 0) { rec[448] = br; rec[449] = kr; rec[450] = bonus; }
    }
}
template <int CTRL> __device__ __forceinline__ float dppf(float v) { return __int_as_float(__builtin_amdgcn_update_dpp(0, __float_as_int(v), CTRL, 0xF, 0xF, true)); }
__device__ __forceinline__ float red16(float x) { x += dppf<0xB1>(x); x += dppf<0x4E>(x); x += dppf<0x124>(x); x += dppf<0x128>(x); return x; }
__device__ __forceinline__ void rw_scan_fast(const Ctx& c, const FastRw& fr, int l, LDSP unsigned char* lds) {
    using namespace cfg; const int j = l / 3;
    const int tid = (int)tid_now(), w = __builtin_amdgcn_readfirstlane(tid >> 6), lane = tid & 63, cs = lane & 15, rp = 4 * w + (lane >> 4);
    LDSP float* ybuf = (LDSP float*)(lds + 2 * RW_BUF);
    for (int chain = blockIdx.x; chain < NSEQ * RHEADS; chain += gridDim.x) {
        const int sq = chain / RHEADS, h = chain % RHEADS, T = seq_len(sq), m0 = seq_row0(sq);
        const char* src = (const char*)(fr.ops + rw_rec_base(sq, h) * RW_REC);
        pg8::f32x4 S0, S1;
        if (sq < BATCH) { S0 = (pg8::f32x4){0.f, 0.f, 0.f, 0.f}; S1 = S0; }
        else { const float* s0 = c.in[I_WKV] + ((((size_t)j * DB + (sq - BATCH)) * RHEADS + h) * RH + 2 * rp) * RH + 4 * cs; S0 = *(const pg8::f32x4*)s0; S1 = *(const pg8::f32x4*)(s0 + RH); }
        const int nch = (T + RW_CH - 1) / RW_CH;
#define RW_DMA(n, buf) do { const int nb_ = ((T - (n) * RW_CH < RW_CH ? T - (n) * RW_CH : RW_CH) * RW_REC * 4 + 1023) >> 10; \
            for (int q_ = w; q_ < nb_; q_ += 8) __builtin_amdgcn_global_load_lds((const unsigned*)(src + (size_t)(n) * RW_BUF + (size_t)q_ * 1024 + (unsigned)lane * 16u), (LDSP unsigned*)(lds + (buf) * RW_BUF + q_ * 1024), 16, 0, 0); } while (0)
        __syncthreads();
        RW_DMA(0, 0);
        asm volatile("s_waitcnt vmcnt(0)" ::: "memory");
        __syncthreads();
        for (int n = 0; n < nch; ++n) {
            if (n + 1 < nch) RW_DMA(n + 1, (n + 1) & 1);
            const int tn = T - n * RW_CH < RW_CH ? T - n * RW_CH : RW_CH;
            const LDSP unsigned char* bufp = lds + (n & 1) * RW_BUF;
            for (int t = 0; t < tn; ++t) {
                const LDSP unsigned char* rec = bufp + t * (RW_REC * 4);
                const pg8::f32x4 A = *(const LDSP pg8::f32x4*)(rec + cs * 16), WR = *(const LDSP pg8::f32x4*)(rec + 256 + cs * 16), W = *(const LDSP pg8::f32x4*)(rec + 512 + cs * 16),
                                 B = *(const LDSP pg8::f32x4*)(rec + 768 + cs * 16), K = *(const LDSP pg8::f32x4*)(rec + 1024 + cs * 16);
                const pg8::f32x2 V2 = *(const LDSP pg8::f32x2*)(rec + 1280 + rp * 8), SC = *(const LDSP pg8::f32x2*)(rec + 1792);
                float sa0 = (S0[0] * A[0] + S0[1] * A[1]) + (S0[2] * A[2] + S0[3] * A[3]), y0 = (S0[0] * WR[0] + S0[1] * WR[1]) + (S0[2] * WR[2] + S0[3] * WR[3]);
                float sa1 = (S1[0] * A[0] + S1[1] * A[1]) + (S1[2] * A[2] + S1[3] * A[3]), y1 = (S1[0] * WR[0] + S1[1] * WR[1]) + (S1[2] * WR[2] + S1[3] * WR[3]);
                sa0 = red16(sa0); sa1 = red16(sa1); y0 = red16(y0); y1 = red16(y1);
                S0 = S0 * W + sa0 * B + V2[0] * K; S1 = S1 * W + sa1 * B + V2[1] * K;
                if (cs == 0) *(LDSP pg8::f32x2*)(ybuf + t * RH + 2 * rp) = (pg8::f32x2){y0 + sa0 * SC[0] + V2[0] * SC[1], y1 + sa1 * SC[0] + V2[1] * SC[1]};
            }
            asm volatile("s_waitcnt vmcnt(0)" ::: "memory");
            __syncthreads();
            for (int t = w; t < tn; t += 8) {
                const LDSP float* rec = (const LDSP float*)(bufp + t * (RW_REC * 4));
                const float y = ybuf[t * RH + lane], mean = wave_sum64(y) * (1.0f / RH), d = y - mean, var = wave_sum64(d * d) * (1.0f / RH);
                const int ch = h * RH + lane;
                const float yn = d * (1.0f / sqrtf(var + LNX_EPS)) * c.in[I_LNW][j * D + ch] + c.in[I_LNB][j * D + ch];
                const float o = (yn + rec[450] * rec[320 + lane]) * rec[384 + lane];
                fr.yo[(size_t)(m0 + n * RW_CH + t) * D + ch] = (bf16_t)(pk2bf(o, 0.f) & 0xffffu);
            }
            __syncthreads();
        }
#undef RW_DMA
        float* so = (sq < BATCH ? c.out + O_WKVP + (((size_t)j * BATCH + sq) * RHEADS + h) * RH * RH : c.out + O_WKVS + (((size_t)j * DB + (sq - BATCH)) * RHEADS + h) * RH * RH) + (size_t)(2 * rp) * RH + 4 * cs;
        *(pg8::f32x4*)so = S0; *(pg8::f32x4*)(so + RH) = S1;
    }
}
__device__ __forceinline__ float fsigmoid(float x) { return __builtin_amdgcn_rcpf(1.0f + __expf(-x)); }
__device__ __forceinline__ float fsoftplus(float x) { return x > 20.f ? x : __logf(1.0f + __expf(x)); }
__device__ __forceinline__ float rdl(float v, int l) { return __int_as_float(__builtin_amdgcn_readlane(__float_as_int(v), l)); }
__device__ __forceinline__ float wsum_dpp(float x) {
    x = red16(x);
    return (rdl(x, 0) + rdl(x, 16)) + (rdl(x, 32) + rdl(x, 48));
}

struct RwOp { pg8::f32x4 A, WR, W, B, K; pg8::f32x2 V2, SC; };
__device__ __forceinline__ void rw_ldop(RwOp& o, const LDSP unsigned char* rec, int cs, int rp) {
    o.A = *(const LDSP pg8::f32x4*)(rec + cs * 16); o.WR = *(const LDSP pg8::f32x4*)(rec + 256 + cs * 16); o.W = *(const LDSP pg8::f32x4*)(rec + 512 + cs * 16);
    o.B = *(const LDSP pg8::f32x4*)(rec + 768 + cs * 16); o.K = *(const LDSP pg8::f32x4*)(rec + 1024 + cs * 16);
    o.V2 = *(const LDSP pg8::f32x2*)(rec + 1280 + rp * 8); o.SC = *(const LDSP pg8::f32x2*)(rec + 1792);
}
__device__ __forceinline__ float fma_s(float a, float b, float c) { float d; asm("v_fma_f32 %0, %1, %2, %3" : "=v"(d) : "v"(a), "v"(b), "v"(c)); return d; }
__device__ __forceinline__ float mul_s(float a, float b) { float d; asm("v_mul_f32 %0, %1, %2" : "=v"(d) : "v"(a), "v"(b)); return d; }
__device__ __forceinline__ void rw_step(pg8::f32x4& S0, pg8::f32x4& S1, const RwOp& o, LDSP float* yrow, bool wr) {
    float sa0 = fma_s(S0[3], o.A[3], fma_s(S0[2], o.A[2], fma_s(S0[1], o.A[1], mul_s(S0[0], o.A[0]))));
    float sa1 = fma_s(S1[3], o.A[3], fma_s(S1[2], o.A[2], fma_s(S1[1], o.A[1], mul_s(S1[0], o.A[0]))));
    float y0 = fma_s(S0[3], o.WR[3], fma_s(S0[2], o.WR[2], fma_s(S0[1], o.WR[1], mul_s(S0[0], o.WR[0]))));
    float y1 = fma_s(S1[3], o.WR[3], fma_s(S1[2], o.WR[2], fma_s(S1[1], o.WR[1], mul_s(S1[0], o.WR[0]))));
    float t0[4], t1[4];
#pragma unroll
    for (int e = 0; e < 4; ++e) { t0[e] = fma_s(o.K[e], o.V2[0], mul_s(S0[e], o.W[e])); t1[e] = fma_s(o.K[e], o.V2[1], mul_s(S1[e], o.W[e])); }
    red16x4(sa0, sa1, y0, y1);
#pragma unroll
    for (int e = 0; e < 4; ++e) { S0[e] = fma_s(o.B[e], sa0, t0[e]); S1[e] = fma_s(o.B[e], sa1, t1[e]); }
    if (wr) *(LDSP pg8::f32x2*)yrow = (pg8::f32x2){fma_s(o.V2[0], o.SC[1], fma_s(sa0, o.SC[0], y0)), fma_s(o.V2[1], o.SC[1], fma_s(sa1, o.SC[0], y1))};
}
struct RwIn { unsigned short r, k, v, wp, ap, g, vp; float vf; };
template <int J>
__device__ __forceinline__ void rw_scan_fused(const Ctx& c, const FastRw& fr, LDSP unsigned char* lds) {
    using namespace cfg; constexpr int j = J;
    const int tid = (int)tid_now(), w = __builtin_amdgcn_readfirstlane(tid >> 6), lane = tid & 63, cs = lane & 15, rp = 4 * w + (lane >> 4);
    LDSP float* ybuf = (LDSP float*)(lds + 2 * RW_BUF);
    for (int chain = blockIdx.x; chain < NSEQ * RHEADS; chain += gridDim.x) {
        const int sq = chain / RHEADS, h = chain % RHEADS, T = seq_len(sq), m0 = seq_row0(sq), ch = h * RH + lane;
        const float p_w0 = c.in[I_W0][j * D + ch], p_a0 = c.in[I_A0][j * D + ch], p_kk = c.in[I_KK][j * D + ch], p_ka = c.in[I_KA][j * D + ch], p_rk = c.in[I_RK][(size_t)j * D + ch],
                    p_lnw = c.in[I_LNW][j * D + ch], p_lnb = c.in[I_LNB][j * D + ch], p_v0 = j > 0 ? c.in[I_V0][(j - 1) * D + ch] : 0.f;
        pg8::f32x4 S0, S1;
        if (sq < BATCH) { S0 = (pg8::f32x4){0.f, 0.f, 0.f, 0.f}; S1 = S0; }
        else { const float* s0 = c.in[I_WKV] + ((((size_t)j * DB + (sq - BATCH)) * RHEADS + h) * RH + 2 * rp) * RH + 4 * cs; S0 = *(const pg8::f32x4*)s0; S1 = *(const pg8::f32x4*)(s0 + RH); }
        const int nch = (T + RW_CH - 1) / RW_CH;
        RwIn in[4];
#define RW_LOADIN(n) do { _Pragma("unroll") for (int q = 0; q < 4; ++q) { const int t_ = (n) * RW_CH + 4 * w + q; if (t_ < T) { const size_t m_ = (size_t)(m0 + t_); \
                const bf16_t* rk_ = fr.rkv + m_ * 3072 + ch; const bf16_t* lu_ = fr.lu + m_ * 4096 + ch; \
                in[q].r = rk_[0]; in[q].k = rk_[1024]; in[q].v = rk_[2048]; in[q].wp = lu_[0]; in[q].ap = lu_[1024]; in[q].g = lu_[2048]; in[q].vp = lu_[3072]; \
                in[q].vf = j > 0 ? fr.vf[m_ * D + ch] : 0.f; } } } while (0)
#define RW_PREP(n, buf) do { _Pragma("unroll") for (int q = 0; q < 4; ++q) { const int tl_ = 4 * w + q, t_ = (n) * RW_CH + tl_; if (t_ < T) { \
                const float r_ = bf2f(in[q].r), k0_ = bf2f(in[q].k); float v_ = bf2f(in[q].v); \
                const float wl_ = -fsoftplus(-(p_w0 + bf2f(in[q].wp))) - 0.5f, w_ = __expf(-__expf(wl_)); \
                if (j == 0) fr.vf[(size_t)(m0 + t_) * D + ch] = v_; else v_ = v_ + (in[q].vf - v_) * fsigmoid(p_v0 + bf2f(in[q].vp)); \
                const float a_ = fsigmoid(p_a0 + bf2f(in[q].ap)); float kk_ = k0_ * p_kk; \
                const float k2_ = k0_ * (1.0f + (a_ - 1.0f) * p_ka); \
                float n_ = red16(kk_ * kk_), e1_ = red16(r_ * k2_ * p_rk), e2_ = red16(k2_ * r_); \
                n_ = (rdl(n_, 0) + rdl(n_, 16)) + (rdl(n_, 32) + rdl(n_, 48)); e1_ = (rdl(e1_, 0) + rdl(e1_, 16)) + (rdl(e1_, 32) + rdl(e1_, 48)); e2_ = (rdl(e2_, 0) + rdl(e2_, 16)) + (rdl(e2_, 32) + rdl(e2_, 48)); \
                kk_ *= __builtin_amdgcn_rcpf(fmaxf(__builtin_amdgcn_sqrtf(n_), 1e-12f)); const float bo_ = kk_ * a_; const float e3_ = wsum_dpp(bo_ * r_); \
                LDSP float* rec_ = (LDSP float*)(lds + (buf) * RW_BUF + tl_ * (RW_REC * 4)); \
                rec_[lane] = -kk_; rec_[64 + lane] = w_ * r_; rec_[128 + lane] = w_; rec_[192 + lane] = bo_; rec_[256 + lane] = k2_; rec_[320 + lane] = v_; rec_[384 + lane] = bf2f(in[q].g); \
                if (lane == 0) { rec_[448] = e3_; rec_[449] = e2_; rec_[450] = e1_; } } } } while (0)
        __syncthreads();
        RW_LOADIN(0); RW_PREP(0, 0);
        __syncthreads();
        for (int n = 0; n < nch; ++n) {
            if (n + 1 < nch) RW_LOADIN(n + 1);
            const int tn = T - n * RW_CH < RW_CH ? T - n * RW_CH : RW_CH;
            const LDSP unsigned char* bufp = lds + (n & 1) * RW_BUF;
#if defined(PROBE_DUP) && (PROBE_DUP & (1 << 17))
            { RwOp o0, o1; rw_ldop(o0, bufp, cs, rp); pg8::f32x4 T0 = S0, T1 = S1;
              for (int t = 0; t < tn; t += 2) {
                  rw_ldop(o1, bufp + (t + 1) * (RW_REC * 4), cs, rp);
                  rw_step(T0, T1, o0, ybuf + t * RH + 2 * rp, cs == 0);
                  rw_ldop(o0, bufp + (t + 2 < tn ? t + 2 : t) * (RW_REC * 4), cs, rp);
                  rw_step(T0, T1, o1, ybuf + (t + 1) * RH + 2 * rp, cs == 0);
              } asm volatile("" :: "v"(T0), "v"(T1)); }
#endif
            { RwOp o0, o1; rw_ldop(o0, bufp, cs, rp);
              for (int t = 0; t < tn; t += 2) {
                  rw_ldop(o1, bufp + (t + 1) * (RW_REC * 4), cs, rp);
                  rw_step(S0, S1, o0, ybuf + t * RH + 2 * rp, cs == 0);
                  rw_ldop(o0, bufp + (t + 2 < tn ? t + 2 : t) * (RW_REC * 4), cs, rp);
                  rw_step(S0, S1, o1, ybuf + (t + 1) * RH + 2 * rp, cs == 0);
              } }
            if (n + 1 < nch) RW_PREP(n + 1, (n + 1) & 1);
#if defined(PROBE_DUP) && (PROBE_DUP & (1 << 18))
            if (n + 1 < nch) RW_PREP(n + 1, (n + 1) & 1);
#endif
            __syncthreads();
            for (int t = w; t < tn; t += 8) {
                const LDSP float* rec = (const LDSP float*)(bufp + t * (RW_REC * 4));
                const float y = ybuf[t * RH + lane], mean = wsum_dpp(y) * (1.0f / RH), d = y - mean, var = wsum_dpp(d * d) * (1.0f / RH);
                const float yn = d * __builtin_amdgcn_rsqf(var + LNX_EPS) * p_lnw + p_lnb;
                const float o = (yn + rec[450] * rec[320 + lane]) * rec[384 + lane];
                fr.yo[(size_t)(m0 + n * RW_CH + t) * D + ch] = (bf16_t)(pk2bf(o, 0.f) & 0xffffu);
            }
            __syncthreads();
        }
#undef RW_LOADIN
#undef RW_PREP
        float* so = (sq < BATCH ? c.out + O_WKVP + (((size_t)j * BATCH + sq) * RHEADS + h) * RH * RH : c.out + O_WKVS + (((size_t)j * DB + (sq - BATCH)) * RHEADS + h) * RH * RH) + (size_t)(2 * rp) * RH + 4 * cs;
        *(pg8::f32x4*)so = S0; *(pg8::f32x4*)(so + RH) = S1;
    }
}
struct FastMb {
    bf16_t* zb;
    bf16_t* xbcr;
    float* dtraw;
    bf16_t* xbcb;
    float* dt;
    float* y;
    bf16_t* yzn;
    bf16_t *wbint, *wbot;
};
struct EpiMamba {
    static constexpr bool PERM = true;
    bf16_t* zb; bf16_t* xbcr; float* dtraw;
    __device__ __forceinline__ void operator()(const pg8::f32x4 (&acc)[2][2][4][2], const pg8::Unit& u, int wr, int wc, int fr, int fq) const {
        using namespace pg8;
        const int row0 = u.pm * BM + wr * 64 + fr, cl0 = wc * 32 + 8 * fq, pn = u.pn;
        if (pn < 20) {
            bf16_t* base = pn < 8 ? zb : xbcr; const int ldc = pn < 8 ? 2048 : 3072, coff = pn < 8 ? pn * 256 : (pn - 8) * 256;
#pragma unroll
            for (int ai = 0; ai < 2; ++ai)
#pragma unroll
                for (int m = 0; m < 4; ++m) { bf16_t* rowp = base + (size_t)(row0 + ai * HALF + m * 16) * ldc + coff + cl0;
#pragma unroll
                    for (int bj = 0; bj < 2; ++bj) { const f32x4 v0 = acc[ai][bj][m][0], v1 = acc[ai][bj][m][1];
                        u32x4 w; w.x = cvt_pk_bf16(v0[0], v0[1]); w.y = cvt_pk_bf16(v0[2], v0[3]); w.z = cvt_pk_bf16(v1[0], v1[1]); w.w = cvt_pk_bf16(v1[2], v1[3]);
                        *(u32x4*)(rowp + bj * HALF) = w; } }
        } else if (cl0 < 32) {
#pragma unroll
            for (int ai = 0; ai < 2; ++ai)
#pragma unroll
                for (int m = 0; m < 4; ++m) { float* rowp = dtraw + (size_t)(row0 + ai * HALF + m * 16) * 32 + cl0;
                    *(f32x4*)rowp = acc[ai][0][m][0]; *(f32x4*)(rowp + 4) = acc[ai][0][m][1]; }
        }
    }
};
__device__ __forceinline__ void mb_conv_fast(const Ctx& c, const FastMb& fb, int l, size_t gtid, size_t gsz, bool write_f32) {
    using namespace cfg; const int j = l / 3; constexpr int NB = MB_CD / 8, TB = 8;
    const int tstride = (int)(gsz / NB), cbi = (int)(gtid % NB), tb0 = (int)(gtid / NB);
    if (tb0 < tstride) {
    const int cb = cbi * 8;
    float wt[MB_CONV][8], bias[8];
        { const pg8::f32x4 b0 = *(const pg8::f32x4*)(c.in[I_CONVB] + j * MB_CD + cb), b1 = *(const pg8::f32x4*)(c.in[I_CONVB] + j * MB_CD + cb + 4);
#pragma unroll
          for (int e = 0; e < 4; ++e) { bias[e] = b0[e]; bias[4 + e] = b1[e]; } }
#pragma unroll
        for (int jj = 0; jj < MB_CONV; ++jj) { const float* wp_ = c.in[I_CONVW] + ((size_t)j * MB_CONV + jj) * MB_CD + cb; const pg8::f32x4 w0 = *(const pg8::f32x4*)wp_, w1 = *(const pg8::f32x4*)(wp_ + 4);
#pragma unroll
            for (int e = 0; e < 4; ++e) { wt[jj][e] = w0[e]; wt[jj][4 + e] = w1[e]; } }
    for (int tbi = tb0; tbi < MTOT / TB; tbi += tstride) {
        const int mb = tbi * TB, t0 = row_t(mb), sq = row_seq(mb), T = seq_len(sq);
        float win[MB_CONV][8];
#pragma unroll
        for (int jj = 0; jj < MB_CONV - 1; ++jj) {
            const int tt = t0 + jj - (MB_CONV - 1);
            if (tt >= 0) { const pg8::u32x4 raw = *(const pg8::u32x4*)(fb.xbcr + (size_t)(mb + jj - (MB_CONV - 1)) * MB_CD + cb); const unsigned wv[4] = {raw.x, raw.y, raw.z, raw.w};
#pragma unroll
                for (int q = 0; q < 4; ++q) { win[jj][2 * q] = __uint_as_float(wv[q] << 16); win[jj][2 * q + 1] = __uint_as_float(wv[q] & 0xffff0000u); } }
            else if (sq >= BATCH) { const float* st = c.in[I_CONV] + (((size_t)j * DB + (sq - BATCH)) * (MB_CONV - 1) + (tt + MB_CONV - 1)) * MB_CD + cb;
#pragma unroll
                for (int e = 0; e < 8; ++e) win[jj][e] = st[e]; }
            else {
#pragma unroll
                for (int e = 0; e < 8; ++e) win[jj][e] = 0.f; }
        }
#pragma unroll
        for (int tb = 0; tb < TB; ++tb) {
            const int m = mb + tb, t = t0 + tb;
            { const pg8::u32x4 raw = *(const pg8::u32x4*)(fb.xbcr + (size_t)m * MB_CD + cb); const unsigned wv[4] = {raw.x, raw.y, raw.z, raw.w};
#pragma unroll
              for (int q = 0; q < 4; ++q) { win[3][2 * q] = __uint_as_float(wv[q] << 16); win[3][2 * q + 1] = __uint_as_float(wv[q] & 0xffff0000u); } }
            if (t >= T - (MB_CONV - 1)) {
                float* so = (sq < BATCH ? c.out + O_CONVP + (((size_t)j * BATCH + sq) * (MB_CONV - 1) + (t - (T - (MB_CONV - 1)))) * MB_CD
                                        : c.out + O_CONVS + (((size_t)j * DB + (sq - BATCH)) * (MB_CONV - 1) + (t - (T - (MB_CONV - 1)))) * MB_CD) + cb;
#pragma unroll
                for (int e = 0; e < 8; ++e) so[e] = win[3][e];
            }
            unsigned w[4];
#pragma unroll
            for (int q = 0; q < 4; ++q) {
                float a0 = bias[2 * q], a1 = bias[2 * q + 1];
#pragma unroll
                for (int jj = 0; jj < MB_CONV; ++jj) { a0 += win[jj][2 * q] * wt[jj][2 * q]; a1 += win[jj][2 * q + 1] * wt[jj][2 * q + 1]; }
                a0 = a0 * __builtin_amdgcn_rcpf(1.0f + __expf(-a0)); a1 = a1 * __builtin_amdgcn_rcpf(1.0f + __expf(-a1));
                w[q] = pk2bf(a0, a1); if (write_f32) { c.xbc[(size_t)m * MB_CD + cb + 2 * q] = a0; c.xbc[(size_t)m * MB_CD + cb + 2 * q + 1] = a1; } }
            *(pg8::u32x4*)(fb.xbcb + (size_t)m * MB_CD + cb) = (pg8::u32x4){w[0], w[1], w[2], w[3]};
#pragma unroll
            for (int jj = 0; jj < MB_CONV - 1; ++jj)
#pragma unroll
                for (int e = 0; e < 8; ++e) win[jj][e] = win[jj + 1][e];
        }
    }
    }
    for (size_t i = gtid; i < (size_t)MTOT * MB_HEADS; i += gsz) {
        const float v = softplusf_(fb.dtraw[i] + c.in[I_DTB][j * MB_HEADS + (int)(i % MB_HEADS)]);
        fb.dt[i] = v; if (write_f32) c.dt[i] = v;
    }
}
__device__ __forceinline__ void mb_gate_fast(const Ctx& c, const FastMb& fb, const float* __restrict__ y, int l, int gw, int ngw, int lane) {
    using namespace cfg; const int j = l / 3; constexpr int GW_ = MB_INNER / MB_GROUPS;
    const int g0 = gw % MB_GROUPS; const bool gfix = (ngw % MB_GROUPS) == 0;
    const float* nwp0 = c.in[I_BNORM] + j * MB_INNER + g0 * GW_ + 8 * lane; const pg8::f32x4 n0h = *(const pg8::f32x4*)nwp0, n1h = *(const pg8::f32x4*)(nwp0 + 4);
    for (int it = gw; it < MTOT * MB_GROUPS; it += ngw) {
        const int m = it / MB_GROUPS, g = it % MB_GROUPS; const size_t o = (size_t)m * MB_INNER + g * GW_ + 8 * lane;
        const pg8::f32x4 y0 = *(const pg8::f32x4*)(y + o), y1 = *(const pg8::f32x4*)(y + o + 4); const pg8::u32x4 zr = *(const pg8::u32x4*)(fb.zb + o);
        const unsigned zw[4] = {zr.x, zr.y, zr.z, zr.w}; float v[8]; float s = 0.f;
#pragma unroll
        for (int q = 0; q < 4; ++q) { const float z0 = __uint_as_float(zw[q] << 16), z1 = __uint_as_float(zw[q] & 0xffff0000u);
            v[2 * q] = (q < 2 ? y0[2 * q] : y1[2 * q - 4]) * siluf_(z0); v[2 * q + 1] = (q < 2 ? y0[2 * q + 1] : y1[2 * q - 3]) * siluf_(z1); s += v[2 * q] * v[2 * q] + v[2 * q + 1] * v[2 * q + 1]; }
        const float rs = 1.0f / sqrtf(wave_sum64(s) * (1.0f / GW_) + NORM_EPS);
        pg8::f32x4 n0 = n0h, n1 = n1h; if (!gfix) { const float* nwp = c.in[I_BNORM] + j * MB_INNER + g * GW_ + 8 * lane; n0 = *(const pg8::f32x4*)nwp; n1 = *(const pg8::f32x4*)(nwp + 4); }
        const float nw[8] = {n0[0], n0[1], n0[2], n0[3], n1[0], n1[1], n1[2], n1[3]}; unsigned w[4];
#pragma unroll
        for (int q = 0; q < 4; ++q) w[q] = pk2bf(v[2 * q] * rs * nw[2 * q], v[2 * q + 1] * rs * nw[2 * q + 1]);
        *(pg8::u32x4*)(fb.yzn + o) = (pg8::u32x4){w[0], w[1], w[2], w[3]};
    }
}
constexpr int SS_XR = 144, SS_BR = 272;
constexpr int SS_XIM = 0, SS_XSM = SS_XIM + 128 * SS_XR, SS_BIM = SS_XSM + 128 * SS_XR, SS_CIM = SS_BIM + 128 * SS_BR, SS_MTM = SS_CIM + 128 * SS_BR, SS_HBM = SS_MTM + 128 * SS_BR, SS_TAB = SS_HBM + 128 * SS_XR, SS_END = SS_TAB + 2048;
__device__ __forceinline__ bf16x8v ss_trfrag(const LDSP unsigned char* img, int rowstride, int k0, int col0, int lane) {
    const int r0 = k0 + 8 * (lane >> 5) + ((lane & 15) >> 2), cc = col0 + 16 * ((lane >> 4) & 1) + 4 * (lane & 3);
    const s16x4 t0 = __builtin_amdgcn_ds_read_tr16_b64_v4i16((LDSP s16x4*)(img + r0 * rowstride + cc * 2));
    const s16x4 t1 = __builtin_amdgcn_ds_read_tr16_b64_v4i16((LDSP s16x4*)(img + (r0 + 4) * rowstride + cc * 2));
    return (bf16x8v){t0[0], t0[1], t0[2], t0[3], t1[0], t1[1], t1[2], t1[3]};
}
__device__ __forceinline__ void mb_ssd_prompt(const Ctx& c, const FastMb& fb, int l, LDSP unsigned char* lds) {
    using namespace cfg; const int j = l / 3;
    const int tid = (int)tid_now(), w = __builtin_amdgcn_readfirstlane(tid >> 6), lane = tid & 63, l31 = lane & 31, h5 = lane >> 5;
    LDSP float* tab = (LDSP float*)(lds + SS_TAB);
    for (int chain = blockIdx.x; chain < BATCH * MB_HEADS; chain += gridDim.x) {
        const int b = chain / MB_HEADS, hd = chain % MB_HEADS, g = hd / (MB_HEADS / MB_GROUPS);
        const float Ah = -expf(c.in[I_ALOG][j * MB_HEADS + hd]), Dh = c.in[I_BD][j * MB_HEADS + hd];
        f32x16_t H;
#pragma unroll
        for (int r = 0; r < 16; ++r) H[r] = 0.f;
        pg8::u32x4 nx[2], nB[4], nC[4]; float ndt0 = 0.f, ndt1 = 0.f;
#define SS_LOAD(ck_) do { const size_t mm_ = (size_t)b * SEQ + 128 * (ck_); int tq_ = tid; asm volatile("" : "+v"(tq_)); \
            _Pragma("unroll") for (int q = 0; q < 2; ++q) { const int ci = tq_ + 512 * q; nx[q] = *(const pg8::u32x4*)(fb.xbcb + (mm_ + (ci >> 3)) * MB_CD + hd * MB_HEAD + (ci & 7) * 8); } \
            _Pragma("unroll") for (int q = 0; q < 4; ++q) { const int ci = tq_ + 512 * q; const bf16_t* rowp = fb.xbcb + (mm_ + (ci >> 4)) * MB_CD + MB_INNER + g * MB_STATE + (ci & 15) * 8; \
                nB[q] = *(const pg8::u32x4*)rowp; nC[q] = *(const pg8::u32x4*)(rowp + MB_GN); } \
            ndt0 = fb.dt[(mm_ + 2 * (tq_ & 63)) * MB_HEADS + hd]; ndt1 = fb.dt[(mm_ + 2 * (tq_ & 63) + 1) * MB_HEADS + hd]; } while (0)
        SS_LOAD(0);
        for (int ck = 0; ck < SEQ / 128; ++ck) {
            const size_t m0 = (size_t)b * SEQ + 128 * ck;
            int tl = tid; asm volatile("" : "+v"(tl));
            pg8::u32x4 xr[2];
#pragma unroll
            for (int q = 0; q < 2; ++q) { const int ci = tl + 512 * q; xr[q] = nx[q];
                *(LDSP pg8::u32x2*)(lds + SS_XIM + (ci >> 3) * SS_XR + (ci & 7) * 16) = (pg8::u32x2){xr[q].x, xr[q].y}; *(LDSP pg8::u32x2*)(lds + SS_XIM + (ci >> 3) * SS_XR + (ci & 7) * 16 + 8) = (pg8::u32x2){xr[q].z, xr[q].w}; }
#pragma unroll
            for (int q = 0; q < 4; ++q) { const int ci = tl + 512 * q;
                *(LDSP pg8::u32x4*)(lds + SS_BIM + (ci >> 4) * SS_BR + (ci & 15) * 16) = nB[q];
                *(LDSP pg8::u32x4*)(lds + SS_CIM + (ci >> 4) * SS_BR + (ci & 15) * 16) = nC[q]; }
            float alast;
            { const float v0 = ndt0 * Ah, v1 = ndt1 * Ah; float sacc = v0 + v1;
#pragma unroll
              for (int o = 1; o < 64; o <<= 1) { const float u = __shfl_up(sacc, o); if (lane >= o) sacc += u; }
              tab[2 * lane] = sacc - v1; tab[2 * lane + 1] = sacc; tab[128 + 2 * lane] = ndt0; tab[128 + 2 * lane + 1] = ndt1;
              alast = __int_as_float(__builtin_amdgcn_readlane(__float_as_int(sacc), 63)); }
            if (ck + 1 < SEQ / 128) SS_LOAD(ck + 1);
            asm volatile("s_waitcnt lgkmcnt(0)" ::: "memory");
#pragma unroll
            for (int q = 0; q < 2; ++q) { const int ci = tl + 512 * q, row = ci >> 3; const float sc = __expf(alast - tab[row]) * tab[128 + row]; const unsigned xw[4] = {xr[q].x, xr[q].y, xr[q].z, xr[q].w}; unsigned ow[4];
#pragma unroll
                for (int e = 0; e < 4; ++e) ow[e] = pk2bf(__uint_as_float(xw[e] << 16) * sc, __uint_as_float(xw[e] & 0xffff0000u) * sc);
                *(LDSP pg8::u32x2*)(lds + SS_XSM + row * SS_XR + (ci & 7) * 16) = (pg8::u32x2){ow[0], ow[1]}; *(LDSP pg8::u32x2*)(lds + SS_XSM + row * SS_XR + (ci & 7) * 16 + 8) = (pg8::u32x2){ow[2], ow[3]}; }
            __syncthreads();
            { int ln = lane; asm volatile("" : "+v"(ln)); const int a31 = ln & 31, a5 = ln >> 5;
              for (int tt = w; tt < 10; tt += 8) {
                int ib = tt < 1 ? 0 : (tt < 3 ? 1 : (tt < 6 ? 2 : 3)); const int jb = tt - (ib * (ib + 1)) / 2;
                f32x16_t ST;
#pragma unroll
                for (int r = 0; r < 16; ++r) ST[r] = 0.f;
#pragma unroll
                for (int s = 0; s < 8; ++s) { const bf16x8v a = *(const LDSP bf16x8v*)(lds + SS_BIM + (32 * jb + a31) * SS_BR + (16 * s + 8 * a5) * 2), bb = *(const LDSP bf16x8v*)(lds + SS_CIM + (32 * ib + a31) * SS_BR + (16 * s + 8 * a5) * 2);
                    ST = MFMA32(a, bb, ST); }
                const float ai = tab[32 * ib + a31];
#pragma unroll
                for (int g4 = 0; g4 < 4; ++g4) { const int jr = 32 * jb + 8 * g4 + 4 * a5; const pg8::f32x4 aj = *(const LDSP pg8::f32x4*)(tab + jr), dj = *(const LDSP pg8::f32x4*)(tab + 128 + jr);
#pragma unroll
                    for (int e = 0; e < 4; ++e) { const int jj = jr + e, ii = 32 * ib + a31; const float mv = jj <= ii ? ST[4 * g4 + e] * __expf(ai - aj[e]) * dj[e] : 0.f;
                        *(LDSP bf16_t*)(lds + SS_MTM + jj * SS_BR + ii * 2) = (bf16_t)(pk2bf(mv, 0.f) & 0xffffu); } }
              }
              const int nb = w >> 1, pb = w & 1;
#pragma unroll
              for (int r = 0; r < 16; ++r) *(LDSP bf16_t*)(lds + SS_HBM + (32 * nb + (r & 3) + 8 * (r >> 2) + 4 * a5) * SS_XR + (32 * pb + a31) * 2) = (bf16_t)(pk2bf(H[r], 0.f) & 0xffffu);
            }
            __syncthreads();
            { int ln = lane; asm volatile("" : "+v"(ln)); const int a31 = ln & 31, a5 = ln >> 5;
              const int pb = w & 1, ib = w >> 1, nb = w >> 1;
              f32x16_t Y;
#pragma unroll
              for (int r = 0; r < 16; ++r) Y[r] = 0.f;
#pragma unroll
              for (int s = 0; s < 8; ++s) { const bf16x8v a = ss_trfrag(lds + SS_HBM, SS_XR, 16 * s, 32 * pb, ln), bb = *(const LDSP bf16x8v*)(lds + SS_CIM + (32 * ib + a31) * SS_BR + (16 * s + 8 * a5) * 2);
                  Y = MFMA32(a, bb, Y); if (s & 1) __builtin_amdgcn_sched_barrier(0); }
              const float ei = __expf(tab[32 * ib + a31]);
#pragma unroll
              for (int r = 0; r < 16; ++r) Y[r] *= ei;
              for (int s = 0; s < 2 * (ib + 1); ++s) { const bf16x8v a = ss_trfrag(lds + SS_XIM, SS_XR, 16 * s, 32 * pb, ln), bb = ss_trfrag(lds + SS_MTM, SS_BR, 16 * s, 32 * ib, ln);
                  Y = MFMA32(a, bb, Y); }
              { const size_t mrow = m0 + 32 * ib + a31; float* yrow = fb.y + mrow * MB_INNER + hd * MB_HEAD + 32 * pb + 4 * a5;
#pragma unroll
                for (int g4 = 0; g4 < 4; ++g4) { const pg8::u32x2 xv = *(const LDSP pg8::u32x2*)(lds + SS_XIM + (32 * ib + a31) * SS_XR + (32 * pb + 8 * g4 + 4 * a5) * 2);
                    pg8::f32x4 o; o[0] = Y[4 * g4] + Dh * __uint_as_float(xv.x << 16); o[1] = Y[4 * g4 + 1] + Dh * __uint_as_float(xv.x & 0xffff0000u); o[2] = Y[4 * g4 + 2] + Dh * __uint_as_float(xv.y << 16); o[3] = Y[4 * g4 + 3] + Dh * __uint_as_float(xv.y & 0xffff0000u);
                    *(pg8::f32x4*)(yrow + 8 * g4) = o; } }
              const float dec = __expf(tab[127]);
#pragma unroll
              for (int r = 0; r < 16; ++r) H[r] *= dec;
#pragma unroll
              for (int s = 0; s < 8; ++s) { const bf16x8v a = ss_trfrag(lds + SS_BIM, SS_BR, 16 * s, 32 * nb, ln), bb = ss_trfrag(lds + SS_XSM, SS_XR, 16 * s, 32 * pb, ln);
                  H = MFMA32(a, bb, H); if (s & 1) __builtin_amdgcn_sched_barrier(0); }
            }
            __syncthreads();
        }
#undef SS_LOAD
        { const int nb = w >> 1, pb = w & 1; float* so = c.out + O_SSMP + (((size_t)j * BATCH + b) * MB_HEADS + hd) * MB_HEAD * MB_STATE;
#pragma unroll
          for (int r = 0; r < 16; ++r) so[(size_t)(32 * pb + l31) * MB_STATE + 32 * nb + (r & 3) + 8 * (r >> 2) + 4 * h5] = H[r]; }
    }
}
__device__ __forceinline__ void mb_scan_sample(const Ctx& c, const FastMb& fb, int l) {
    using namespace cfg; const int j = l / 3;
    const int tid = (int)tid_now(), p = tid >> 3, ns = tid & 7;
    pg8::f32x4 hn[4];
    { const int chain = blockIdx.x; if (chain < DB * MB_HEADS) { const size_t so = ((((size_t)j * DB + chain / MB_HEADS) * MB_HEADS + chain % MB_HEADS) * MB_HEAD + p) * MB_STATE + 16 * ns;
#pragma unroll
        for (int q = 0; q < 4; ++q) hn[q] = *(const pg8::f32x4*)(c.in[I_SSM] + so + 4 * q); } }
    for (int chain = blockIdx.x; chain < DB * MB_HEADS; chain += gridDim.x) {
        const int s = chain / MB_HEADS, hd = chain % MB_HEADS, g = hd / (MB_HEADS / MB_GROUPS);
        const float Ah = -expf(c.in[I_ALOG][j * MB_HEADS + hd]), Dh = c.in[I_BD][j * MB_HEADS + hd];
        const size_t so = ((((size_t)j * DB + s) * MB_HEADS + hd) * MB_HEAD + p) * MB_STATE + 16 * ns;
        float hs[16];
#pragma unroll
        for (int q = 0; q < 4; ++q) { hs[4 * q] = hn[q][0]; hs[4 * q + 1] = hn[q][1]; hs[4 * q + 2] = hn[q][2]; hs[4 * q + 3] = hn[q][3]; }
        { const int cn = chain + gridDim.x; if (cn < DB * MB_HEADS) { const size_t sn = ((((size_t)j * DB + cn / MB_HEADS) * MB_HEADS + cn % MB_HEADS) * MB_HEAD + p) * MB_STATE + 16 * ns;
#pragma unroll
            for (int q = 0; q < 4; ++q) hn[q] = *(const pg8::f32x4*)(c.in[I_SSM] + sn + 4 * q); } }
        float dtv[DS]; unsigned short xr[DS]; pg8::u32x4 Bq[DS][2], Cq[DS][2];
#pragma unroll
        for (int t = 0; t < DS; ++t) { const size_t m = (size_t)MP + s * DS + t; dtv[t] = fb.dt[m * MB_HEADS + hd]; xr[t] = fb.xbcb[m * MB_CD + hd * MB_HEAD + p];
            const bf16_t* Bp = fb.xbcb + m * MB_CD + MB_INNER + g * MB_STATE + 16 * ns; Bq[t][0] = *(const pg8::u32x4*)Bp; Bq[t][1] = *(const pg8::u32x4*)(Bp + 8);
            Cq[t][0] = *(const pg8::u32x4*)(Bp + MB_GN); Cq[t][1] = *(const pg8::u32x4*)(Bp + MB_GN + 8); }
#pragma unroll
        for (int t = 0; t < DS; ++t) {
            const size_t m = (size_t)MP + s * DS + t;
            const float dA = __expf(dtv[t] * Ah), xv = bf2f(xr[t]), xdt = xv * dtv[t];
            const unsigned bw[8] = {Bq[t][0].x, Bq[t][0].y, Bq[t][0].z, Bq[t][0].w, Bq[t][1].x, Bq[t][1].y, Bq[t][1].z, Bq[t][1].w};
            const unsigned cw[8] = {Cq[t][0].x, Cq[t][0].y, Cq[t][0].z, Cq[t][0].w, Cq[t][1].x, Cq[t][1].y, Cq[t][1].z, Cq[t][1].w};
            float yy = 0.f;
#pragma unroll
            for (int k = 0; k < 8; ++k) { hs[2 * k] = hs[2 * k] * dA + xdt * __uint_as_float(bw[k] << 16); hs[2 * k + 1] = hs[2 * k + 1] * dA + xdt * __uint_as_float(bw[k] & 0xffff0000u);
                yy += __uint_as_float(cw[k] << 16) * hs[2 * k] + __uint_as_float(cw[k] & 0xffff0000u) * hs[2 * k + 1]; }
            yy += __shfl_xor(yy, 1); yy += __shfl_xor(yy, 2); yy += __shfl_xor(yy, 4);
            if (ns == 0) fb.y[m * MB_INNER + hd * MB_HEAD + p] = yy + Dh * xv;
        }
        float* oo = c.out + O_SSMS + so;
#pragma unroll
        for (int q = 0; q < 4; ++q) *(pg8::f32x4*)(oo + 4 * q) = (pg8::f32x4){hs[4 * q], hs[4 * q + 1], hs[4 * q + 2], hs[4 * q + 3]};
    }
}
constexpr int RC_RS = 144;
constexpr int RC_AT = 0, RC_RT = 4608, RC_BB = 9216, RC_KB = 13824, RC_BH = 18432, RC_KH = 23040, RC_VV = 27648, RC_UT = 32256, RC_GG = 36864;
constexpr int RC_SB = 41472;
constexpr int RC_NAK = 50688, RC_MRB = 53248, RC_MRK = 55808, RC_NS = 80;
constexpr int RC_NAB = 58368;
constexpr int RC_E = 62464;
constexpr int RC_YB = 70656;
constexpr int RC_GL = 78848, RC_BON = 79104, RC_VV2 = 79360, RC_GG2 = RC_VV2 + 4608, RC_END0 = RC_GG2 + 4608;
constexpr int RC_WW = RC_END0, RC_WA = RC_WW + 64 * 144, RC_WG = RC_WA + 64 * 144, RC_WV = RC_WG + 64 * 336, RC_LUO = RC_WV + 64 * 80, RC_END = RC_LUO + 4 * 4608;
constexpr int RC_HB = RC_AT, RC_HBS = 784;
__device__ __forceinline__ bf16x8v rc_nat(const LDSP unsigned char* img, int stride, int row, int kofs) { return *(const LDSP bf16x8v*)(img + row * stride + kofs * 2); }
__device__ __forceinline__ int rc_row(int r, int h5) { return (r & 3) + 8 * (r >> 2) + 4 * h5; }
__device__ __forceinline__ void rc_st16(LDSP unsigned char* p, float v) { *(LDSP bf16_t*)p = (bf16_t)(pk2bf(v, 0.f) & 0xffffu); }


template <int S>
struct RcSub {
    static __device__ __forceinline__ void run(float (&acc)[32], const LDSP float* NAB, LDSP unsigned char* lds, int lane) {
        const float us = acc[S]; rc_st16(lds + RC_UT + S * RC_RS + lane * 2, us);
#pragma unroll
        for (int g4 = 0; g4 < 8; ++g4) { if (4 * g4 + 3 > S) { const pg8::f32x4 nv = *(const LDSP pg8::f32x4*)(NAB + S * 32 + 4 * g4);
#pragma unroll
            for (int e = 0; e < 4; ++e) { if (4 * g4 + e > S) acc[4 * g4 + e] = fmaf(nv[e], us, acc[4 * g4 + e]); } } }
        RcSub<S + 1>::run(acc, NAB, lds, lane);
    }
};
template <> struct RcSub<32> { static __device__ __forceinline__ void run(float (&)[32], const LDSP float*, LDSP unsigned char*, int) {} };

template <int J>
__device__ __forceinline__ void rw_scan_chunked(const Ctx& c, const FastRw& fr, LDSP unsigned char* lds) {
    using namespace cfg; constexpr int j = J;
    const int tid = (int)tid_now(), w = __builtin_amdgcn_readfirstlane(tid >> 6), lane = tid & 63, l31 = lane & 31, h5 = lane >> 5;
    LDSP float* Ef = (LDSP float*)(lds + RC_E); LDSP float* YB = (LDSP float*)(lds + RC_YB); LDSP float* GL = (LDSP float*)(lds + RC_GL); LDSP float* BON = (LDSP float*)(lds + RC_BON);
    LDSP float* NAB = (LDSP float*)(lds + RC_NAB);
    int hcur = -1;
    for (int chain = blockIdx.x; chain < NSEQ * RHEADS; chain += gridDim.x) {
        const int sq = chain / RHEADS, h = chain % RHEADS, T = seq_len(sq), m0 = seq_row0(sq), ch = h * RH + lane;
        const float p_w0 = c.in[I_W0][j * D + ch], p_a0 = c.in[I_A0][j * D + ch], p_kk = c.in[I_KK][j * D + ch], p_ka = c.in[I_KA][j * D + ch], p_rk = c.in[I_RK][(size_t)j * D + ch],
                    p_lnw = c.in[I_LNW][j * D + ch], p_lnb = c.in[I_LNB][j * D + ch], p_v0 = j > 0 ? c.in[I_V0][(j - 1) * D + ch] : 0.f;
        const int ib = (w >> 1) & 1, jb = w & 1;
        f32x16_t ST;
#pragma unroll
        for (int r = 0; r < 16; ++r) ST[r] = 0.f;
        if (w < 4 && sq >= BATCH) { const float* s0 = c.in[I_WKV] + (((size_t)j * DB + (sq - BATCH)) * RHEADS + h) * RH * RH;
#pragma unroll
            for (int r = 0; r < 16; ++r) ST[r] = s0[(size_t)(32 * ib + rc_row(r, h5)) * RH + 32 * jb + l31]; }
        const int nch = (T + 31) / 32;
        if (h != hcur) {
            __syncthreads();
            const bf16_t* lw = fr.lorat + (size_t)j * 4096 * 384;
            for (int ci = tid; ci < 64 * 8; ci += 512) { const int row = ci >> 3, c8 = ci & 7;
                *(LDSP pg8::u32x4*)(lds + RC_WW + row * 144 + c8 * 16) = *(const pg8::u32x4*)(lw + (size_t)(0 * 1024 + h * 64 + row) * 384 + 0 + c8 * 8);
                *(LDSP pg8::u32x4*)(lds + RC_WA + row * 144 + c8 * 16) = *(const pg8::u32x4*)(lw + (size_t)(1 * 1024 + h * 64 + row) * 384 + 64 + c8 * 8); }
            for (int ci = tid; ci < 64 * 20; ci += 512) { const int row = ci / 20, c20 = ci % 20;
                *(LDSP pg8::u32x4*)(lds + RC_WG + row * 336 + c20 * 16) = *(const pg8::u32x4*)(lw + (size_t)(2 * 1024 + h * 64 + row) * 384 + 128 + c20 * 8); }
            for (int ci = tid; ci < 64 * 4; ci += 512) { const int row = ci >> 2, c4 = ci & 3;
                *(LDSP pg8::u32x4*)(lds + RC_WV + row * 80 + c4 * 16) = *(const pg8::u32x4*)(lw + (size_t)(3 * 1024 + h * 64 + row) * 384 + 288 + c4 * 8); }
            hcur = h;
        }
        RwIn in[4]; pg8::u32x4 hbr[3];
#define RC_LOADIN(n) do { _Pragma("unroll") for (int q = 0; q < 4; ++q) { const int t_ = (n) * 32 + 4 * w + q; if (t_ < T) { const size_t m_ = (size_t)(m0 + t_); \
                const bf16_t* rk_ = fr.rkv + m_ * 3072 + ch; in[q].r = rk_[0]; in[q].k = rk_[1024]; in[q].v = rk_[2048]; \
                in[q].vf = j > 0 ? fr.vf[m_ * D + ch] : 0.f; } } \
            _Pragma("unroll") for (int k3 = 0; k3 < 3; ++k3) { const int ci_ = tid + 512 * k3, tk_ = ci_ / 48, t_ = (n) * 32 + tk_; \
                hbr[k3] = t_ < T ? *(const pg8::u32x4*)(fr.hb + (size_t)(m0 + t_) * 384 + (ci_ % 48) * 8) : (pg8::u32x4){0u, 0u, 0u, 0u}; } } while (0)
#define RC_EPI_TOKEN(nn, tl) do { const int vv_ = ((nn) & 1) ? RC_VV2 : RC_VV, gg_ = ((nn) & 1) ? RC_GG2 : RC_GG, bn_ = ((nn) & 1) ? 32 : 0; \
                const float y_ = YB[(tl) * 64 + lane], mean_ = wsum_dpp(y_) * (1.0f / RH), d_ = y_ - mean_, var_ = wsum_dpp(d_ * d_) * (1.0f / RH); \
                const float yn_ = d_ * __builtin_amdgcn_rsqf(var_ + LNX_EPS) * p_lnw + p_lnb; \
                const float o_ = (yn_ + BON[bn_ + (tl)] * bf2f(*(const LDSP bf16_t*)(lds + vv_ + (tl) * RC_RS + lane * 2))) * bf2f(*(const LDSP bf16_t*)(lds + gg_ + (tl) * RC_RS + lane * 2)); \
                fr.yo[(size_t)(m0 + (nn) * 32 + (tl)) * D + ch] = (bf16_t)(pk2bf(o_, 0.f) & 0xffffu); } while (0)
        __syncthreads();
        RC_LOADIN(0);
        for (int n = 0; n < nch; ++n) {
            const int tn = T - n * 32 < 32 ? T - n * 32 : 32;
            const int vvo = (n & 1) ? RC_VV2 : RC_VV, ggo = (n & 1) ? RC_GG2 : RC_GG, bno = (n & 1) ? 32 : 0;
#pragma unroll
            for (int k3 = 0; k3 < 3; ++k3) { const int ci_ = tid + 512 * k3; *(LDSP pg8::u32x4*)(lds + RC_HB + (ci_ / 48) * RC_HBS + (ci_ % 48) * 16) = hbr[k3]; }
            __syncthreads();
            { int ln = lane; asm volatile("" : "+v"(ln)); const int a31 = ln & 31, a5 = ln >> 5; const int grp = w >> 1, nb = w & 1;
              const int koff = grp == 0 ? 0 : (grp == 1 ? 64 : (grp == 2 ? 128 : 288)), nks = grp == 2 ? 10 : (grp == 3 ? 2 : 4);
              const int wof = grp == 0 ? RC_WW : (grp == 1 ? RC_WA : (grp == 2 ? RC_WG : RC_WV)), wst = grp == 2 ? 336 : (grp == 3 ? 80 : 144);
              f32x16_t LA;
#pragma unroll
              for (int r = 0; r < 16; ++r) LA[r] = 0.f;
              for (int ks = 0; ks < nks; ++ks) LA = MFMA32(rc_nat(lds + RC_HB, RC_HBS, a31, koff + 16 * ks + 8 * a5), rc_nat(lds + wof, wst, 32 * nb + a31, 16 * ks + 8 * a5), LA);
#pragma unroll
              for (int r = 0; r < 16; ++r) rc_st16(lds + RC_LUO + grp * 4608 + rc_row(r, a5) * RC_RS + (32 * nb + a31) * 2, LA[r]); }
            __syncthreads();
            float q_r[4], q_k[4], q_a[4], q_b[4], q_e[4];
#pragma unroll
            for (int q = 0; q < 4; ++q) {
                const int tl = 4 * w + q, tg = n * 32 + tl;
                float r_ = 0.f, k2_ = 0.f, v_ = 0.f, a_ = 0.f, b_ = 0.f, e_ = 0.f, g_ = 0.f, bon_ = 0.f;
                if (tg < T) {
                    r_ = bf2f(in[q].r); const float k0_ = bf2f(in[q].k); v_ = bf2f(in[q].v);
                    e_ = 0.6065306597126334f * fsigmoid(p_w0 + bf2f(*(const LDSP bf16_t*)(lds + RC_LUO + 0 * 4608 + tl * RC_RS + lane * 2)));
                    if (j == 0) fr.vf[(size_t)(m0 + tg) * D + ch] = v_; else v_ = v_ + (in[q].vf - v_) * fsigmoid(p_v0 + bf2f(*(const LDSP bf16_t*)(lds + RC_LUO + 3 * 4608 + tl * RC_RS + lane * 2)));
                    const float as_ = fsigmoid(p_a0 + bf2f(*(const LDSP bf16_t*)(lds + RC_LUO + 1 * 4608 + tl * RC_RS + lane * 2))); float kk_ = k0_ * p_kk;
                    k2_ = k0_ * (1.0f + (as_ - 1.0f) * p_ka);
                    float n_ = red16(kk_ * kk_), e1_ = red16(r_ * k2_ * p_rk);
                    n_ = (rdl(n_, 0) + rdl(n_, 16)) + (rdl(n_, 32) + rdl(n_, 48)); bon_ = (rdl(e1_, 0) + rdl(e1_, 16)) + (rdl(e1_, 32) + rdl(e1_, 48));
                    kk_ *= __builtin_amdgcn_rcpf(fmaxf(__builtin_amdgcn_sqrtf(n_), 1e-12f));
                    a_ = -kk_; b_ = kk_ * as_; g_ = bf2f(*(const LDSP bf16_t*)(lds + RC_LUO + 2 * 4608 + tl * RC_RS + lane * 2));
                }
                q_r[q] = r_; q_k[q] = k2_; q_a[q] = a_; q_b[q] = b_; q_e[q] = e_;
                Ef[tl * 64 + lane] = e_;
                rc_st16(lds + vvo + tl * RC_RS + lane * 2, v_); rc_st16(lds + ggo + tl * RC_RS + lane * 2, g_);
                if (lane == 0) BON[bno + tl] = bon_;
            }
            if (n + 1 < nch) RC_LOADIN(n + 1);
            if (w < 4) {
#pragma unroll
                for (int r = 0; r < 16; ++r) rc_st16(lds + RC_SB + (32 * ib + rc_row(r, h5)) * RC_RS + (32 * jb + l31) * 2, ST[r]);
            }
            __syncthreads();
            { float run = 0.f, base = 0.f;
#pragma unroll
              for (int s = 0; s < 32; ++s) { const float ev = Ef[s * 64 + lane]; if (s == 4 * w) base = run; run += ev; }
              const float cumL = run; float cum = base;
#pragma unroll
              for (int q = 0; q < 4; ++q) { const int tl = 4 * w + q; const float cprev = cum; cum += q_e[q];
                  const float gam = __expf(-cum), gamp = __expf(-cprev), ginv = __expf(cum), glr = __expf(cum - cumL);
                  rc_st16(lds + RC_AT + tl * RC_RS + lane * 2, q_a[q] * gamp); rc_st16(lds + RC_RT + tl * RC_RS + lane * 2, q_r[q] * gam);
                  rc_st16(lds + RC_BB + tl * RC_RS + lane * 2, q_b[q] * ginv); rc_st16(lds + RC_KB + tl * RC_RS + lane * 2, q_k[q] * ginv);
                  rc_st16(lds + RC_BH + tl * RC_RS + lane * 2, q_b[q] * glr); rc_st16(lds + RC_KH + tl * RC_RS + lane * 2, q_k[q] * glr); }
              if (w == 0) GL[lane] = __expf(-cumL); }
            __syncthreads();
            f32x16_t R1;
#pragma unroll
            for (int r = 0; r < 16; ++r) R1[r] = 0.f;
            { int ln = lane; asm volatile("" : "+v"(ln)); const int a31 = ln & 31, a5 = ln >> 5;
              if (w < 4) {
                  const int aoff = (w == 0) ? RC_BB : ((w < 2) ? RC_AT : RC_RT), boff = (w == 0) ? RC_AT : ((w & 1) ? RC_KB : RC_BB);
#pragma unroll
                  for (int ks = 0; ks < 4; ++ks) R1 = MFMA32(rc_nat(lds + aoff, RC_RS, a31, 16 * ks + 8 * a5), rc_nat(lds + boff, RC_RS, a31, 16 * ks + 8 * a5), R1);
#pragma unroll
                  for (int r = 0; r < 16; ++r) { const int rr = rc_row(r, a5), cc = a31;
                      if (w == 0) NAB[rr * 32 + cc] = (rr < cc) ? R1[r] : 0.f;
                      else { const bool keep = (w < 2) ? (cc < rr) : (cc <= rr); rc_st16(lds + (w == 1 ? RC_NAK : (w == 2 ? RC_MRB : RC_MRK)) + rr * RC_NS + cc * 2, keep ? R1[r] : 0.f); } }
              } else {
                  const int aoff = (w < 6) ? RC_AT : RC_RT, ibk = w & 1;
#pragma unroll
                  for (int ks = 0; ks < 4; ++ks) R1 = MFMA32(rc_nat(lds + aoff, RC_RS, a31, 16 * ks + 8 * a5), rc_nat(lds + RC_SB, RC_RS, 32 * ibk + a31, 16 * ks + 8 * a5), R1);
              } }
            __syncthreads();
            if (w == 4 || w == 5) { int ln = lane; asm volatile("" : "+v"(ln)); const int a31 = ln & 31, a5 = ln >> 5, ibk = w & 1;
#pragma unroll
                for (int ks = 0; ks < 2; ++ks) R1 = MFMA32(rc_nat(lds + RC_NAK, RC_NS, a31, 16 * ks + 8 * a5), ss_trfrag(lds + vvo, RC_RS, 16 * ks, 32 * ibk, ln), R1);
#pragma unroll
                for (int r = 0; r < 16; ++r) Ef[rc_row(r, a5) * 64 + 32 * ibk + a31] = R1[r]; }
            __syncthreads();
            if (w > 0 && n > 0) { for (int tl = w - 1; tl < 32; tl += 7) RC_EPI_TOKEN(n - 1, tl); }
            if (w == 0) { float acc[32];
#pragma unroll
                for (int t = 0; t < 32; ++t) acc[t] = Ef[t * 64 + lane];
                RcSub<0>::run(acc, NAB, lds, lane); }
            __syncthreads();
            { int ln = lane; asm volatile("" : "+v"(ln)); const int a31 = ln & 31, a5 = ln >> 5;
              if (w >= 6) { const int ibk = w & 1;
#pragma unroll
                  for (int ks = 0; ks < 2; ++ks) { R1 = MFMA32(rc_nat(lds + RC_MRB, RC_NS, a31, 16 * ks + 8 * a5), ss_trfrag(lds + RC_UT, RC_RS, 16 * ks, 32 * ibk, ln), R1);
                                                   R1 = MFMA32(rc_nat(lds + RC_MRK, RC_NS, a31, 16 * ks + 8 * a5), ss_trfrag(lds + vvo, RC_RS, 16 * ks, 32 * ibk, ln), R1); }
#pragma unroll
                  for (int r = 0; r < 16; ++r) YB[rc_row(r, a5) * 64 + 32 * ibk + a31] = R1[r];
              } else if (w < 4) { const float gl = GL[32 * jb + a31];
#pragma unroll
                  for (int r = 0; r < 16; ++r) ST[r] *= gl;
#pragma unroll
                  for (int ks = 0; ks < 2; ++ks) { ST = MFMA32(ss_trfrag(lds + RC_UT, RC_RS, 16 * ks, 32 * ib, ln), ss_trfrag(lds + RC_BH, RC_RS, 16 * ks, 32 * jb, ln), ST);
                                                   ST = MFMA32(ss_trfrag(lds + vvo, RC_RS, 16 * ks, 32 * ib, ln), ss_trfrag(lds + RC_KH, RC_RS, 16 * ks, 32 * jb, ln), ST); } } }
            __syncthreads();
        }
        { const int nl = nch - 1, tnl = T - nl * 32 < 32 ? T - nl * 32 : 32; for (int tl = w; tl < tnl; tl += 8) RC_EPI_TOKEN(nl, tl); }
#undef RC_EPI_TOKEN
#undef RC_LOADIN
        if (w < 4) { float* so = (sq < BATCH ? c.out + O_WKVP + (((size_t)j * BATCH + sq) * RHEADS + h) * RH * RH : c.out + O_WKVS + (((size_t)j * DB + (sq - BATCH)) * RHEADS + h) * RH * RH);
#pragma unroll
            for (int r = 0; r < 16; ++r) so[(size_t)(32 * ib + rc_row(r, h5)) * RH + 32 * jb + l31] = ST[r]; }
    }
}
template <int ACT, bool ACC>
__device__ __forceinline__ void gemm_dev(const float* __restrict__ A, int lda, const float* __restrict__ B, int ldb, float* C, int ldc, int M, int N, int K, unsigned short (*As)[40], unsigned short (*Bs)[40]) {
    const int tid = threadIdx.x, wave = tid >> 6, lane = tid & 63, wr = wave >> 1, wc = wave & 1, fr = lane & 15, fq = lane >> 4;
    const int ntn = (N + 127) / 128, ntm = (M + 127) / 128;
    for (int tile = blockIdx.x; tile < ntm * ntn; tile += gridDim.x) {
        const int bm = (tile / ntn) * 128, bn = (tile % ntn) * 128;
        f32x4_t acc[2][4];
#pragma unroll
        for (int i = 0; i < 2; ++i)
#pragma unroll
            for (int j = 0; j < 4; ++j) acc[i][j] = (f32x4_t){0.f, 0.f, 0.f, 0.f};
        for (int k0 = 0; k0 < K; k0 += 32) {
#pragma unroll
            for (int it = 0; it < 2; ++it) {
                const int idx = tid + it * 512, row = idx >> 3, c4 = idx & 7, gm = bm + row;
                float4 v = make_float4(0.f, 0.f, 0.f, 0.f);
                if (gm < M) v = *(const float4*)(A + (size_t)gm * lda + k0 + c4 * 4);
                uint2 w; w.x = (unsigned)f2bf(v.x) | ((unsigned)f2bf(v.y) << 16); w.y = (unsigned)f2bf(v.z) | ((unsigned)f2bf(v.w) << 16);
                *(uint2*)&As[row][c4 * 4] = w;
            }
#pragma unroll
            for (int it = 0; it < 2; ++it) {
                const int idx = tid + it * 512, kr = idx >> 5, n4 = idx & 31, gn = bn + n4 * 4;
                float4 v = make_float4(0.f, 0.f, 0.f, 0.f);
                if (gn < N) v = *(const float4*)(B + (size_t)(k0 + kr) * ldb + gn);
                Bs[n4 * 4 + 0][kr] = f2bf(v.x); Bs[n4 * 4 + 1][kr] = f2bf(v.y); Bs[n4 * 4 + 2][kr] = f2bf(v.z); Bs[n4 * 4 + 3][kr] = f2bf(v.w);
            }
            __syncthreads();
            bf16x8_t a[2], b[4];
#pragma unroll
            for (int i = 0; i < 2; ++i) a[i] = *(const bf16x8_t*)&As[wr * 32 + i * 16 + fr][fq * 8];
#pragma unroll
            for (int j = 0; j < 4; ++j) b[j] = *(const bf16x8_t*)&Bs[wc * 64 + j * 16 + fr][fq * 8];
#pragma unroll
            for (int i = 0; i < 2; ++i)
#pragma unroll
                for (int j = 0; j < 4; ++j) acc[i][j] = __builtin_amdgcn_mfma_f32_16x16x32_bf16(a[i], b[j], acc[i][j], 0, 0, 0);
            __syncthreads();
        }
#pragma unroll
        for (int i = 0; i < 2; ++i)
#pragma unroll
            for (int j = 0; j < 4; ++j)
#pragma unroll
                for (int e = 0; e < 4; ++e) {
                    const int row = bm + wr * 32 + i * 16 + fq * 4 + e, col = bn + wc * 64 + j * 16 + fr;
                    if (row < M && col < N) {
                        float v = acc[i][j][e];
                        if (ACT == 1) v = tanhf(v); else if (ACT == 2) v = 1.0f / (1.0f + expf(-v)); else if (ACT == 3) v = v > 0.f ? v * v : 0.f;
                        float* cp = C + (size_t)row * ldc + col; *cp = ACC ? *cp + v : v;
                    }
                }
    }
}

#define MRUN(ph, l) do { ph(c, l, gtid, gsz); xcd_barrier(bar); } while (0)
#define MGEMM(ACT, ACC, A, lda, B, ldb, C, ldc, M, N, K) do { gemm_dev<ACT, ACC>(A, lda, B, ldb, C, ldc, M, N, K, As, Bs); xcd_barrier(bar); } while (0)
#define KS_FFN 16
#define KS_1K 4
#define KS_MB 8
#ifndef ACC_KSPLIT
#define ACC_KSPLIT 1
#endif
#ifndef FFN_DOWN_KSPLIT
#define FFN_DOWN_KSPLIT 1
#endif
#define GBAR() xcd_barrier(bar)
#ifndef PROBE_DUP
#define PROBE_DUP 0
#endif
#define DUP(bit, ...) do { __VA_ARGS__; if (PROBE_DUP & (1 << (bit))) { GBAR(); __VA_ARGS__; } } while (0)
#define GTID_NOW() ((size_t)blockIdx.x * 512 + tid_now())
#define GSZ_NOW() ((size_t)gridDim.x * 512)
#define GW_NOW() ((int)(blockIdx.x * 8 + (tid_now() >> 6)))
#define NGW_NOW() ((int)(gridDim.x * 8))
#define LANE_NOW() ((int)(tid_now() & 63))
#undef MRUN
#undef MGEMM
#define MRUN(ph, l) do { ph(c, l, GTID_NOW(), GSZ_NOW()); xcd_barrier(bar); } while (0)
#define MGEMM(ACT, ACC, A, lda, B, ldb, C, ldc, M, N, K) do { gemm_dev<ACT, ACC>(A, lda, B, ldb, C, ldc, M, N, K, (unsigned short (*)[40])dynlds, (unsigned short (*)[40])(dynlds + 128 * 40 * 2)); xcd_barrier(bar); } while (0)
extern __shared__ __attribute__((aligned(16))) unsigned char dynlds[];

struct MegaArgs { Ctx c; Fast f; FastMla fm; FastRw fr; FastMb fb; unsigned* bar; };
constexpr int LDS_STAGE = 0, LDS_XB = 163840 - 64, LDS_BYTES = 163840;
static_assert(SD_END <= LDS_XB && SS_END <= LDS_XB && RC_END <= LDS_XB, "LDS map");

template <int L>
__device__ __forceinline__ void layer_mix_naive(const Ctx& c, const XcdBarrier& bar) {
    using namespace cfg;
    constexpr int l = L, kind = L % 3, j = L / 3;
    MRUN(ph_norm_mix, l);
    if constexpr (kind == 0) {
        MRUN(ph_rw_mix, l);
        const float* W = c.in[I_WRKV] + (size_t)j * 3 * D * D;
        MGEMM(0, false, c.xm[0], D, W, D, c.r, D, MTOT, D, D);
        MGEMM(0, false, c.xm[1], D, W + (size_t)D * D, D, c.k, D, MTOT, D, D);
        MGEMM(0, false, c.xm[2], D, W + (size_t)2 * D * D, D, c.v, D, MTOT, D, D);
        MGEMM(1, false, c.xm[3], D, c.in[I_W1] + (size_t)j * D * RW_DL, RW_DL, c.hw, RW_DL, MTOT, RW_DL, D);
        MGEMM(0, false, c.hw, RW_DL, c.in[I_W2] + (size_t)j * RW_DL * D, D, c.wpre, D, MTOT, D, RW_DL);
        MGEMM(0, false, c.xm[4], D, c.in[I_A1] + (size_t)j * D * RW_AL, RW_AL, c.ha, RW_AL, MTOT, RW_AL, D);
        MGEMM(0, false, c.ha, RW_AL, c.in[I_A2] + (size_t)j * RW_AL * D, D, c.apre, D, MTOT, D, RW_AL);
        if constexpr (j > 0) {
            MGEMM(0, false, c.xm[2], D, c.in[I_V1] + (size_t)(j - 1) * D * RW_VL, RW_VL, c.hv, RW_VL, MTOT, RW_VL, D);
            MGEMM(0, false, c.hv, RW_VL, c.in[I_V2] + (size_t)(j - 1) * RW_VL * D, D, c.vpre, D, MTOT, D, RW_VL);
        }
        MGEMM(2, false, c.xm[5], D, c.in[I_G1] + (size_t)j * D * RW_GL, RW_GL, c.hg, RW_GL, MTOT, RW_GL, D);
        MGEMM(0, false, c.hg, RW_GL, c.in[I_G2] + (size_t)j * RW_GL * D, D, c.g, D, MTOT, D, RW_GL);
        MRUN(ph_rw_prep, l); MRUN(ph_rw_scan, l); MRUN(ph_rw_post, l);
        MGEMM(0, true, c.yo, D, c.in[I_RWO] + (size_t)j * D * D, D, c.x, D, MTOT, D, D);
    } else if constexpr (kind == 1) {
        MGEMM(0, false, c.xn, D, c.in[I_MWIN] + (size_t)j * D * MLA_IN, MLA_IN, c.mh, MLA_IN, MTOT, MLA_IN, D);
        MRUN(ph_mla_norm1, l);
        MGEMM(0, false, c.qan, QL, c.in[I_WUQ] + (size_t)j * QL * MH * QD, MH * QD, c.q, MH * QD, MTOT, MH * QD, QL);
        MGEMM(0, false, c.c, KVL, c.in[I_WUK] + (size_t)j * KVL * MH * NOPE, MH * NOPE, c.knr, MH * NOPE, MTOT, MH * NOPE, KVL);
        MGEMM(0, false, c.c, KVL, c.in[I_WUV] + (size_t)j * KVL * MH * VD, MH * VD, c.vv, MH * VD, MTOT, MH * VD, KVL);
        MRUN(ph_mla_norm2, l); MRUN(ph_mla_attn_prompt, l); MRUN(ph_mla_score_sample, l); MRUN(ph_mla_softmax_sample, l); MRUN(ph_mla_pv_sample, l); MRUN(ph_mla_out_sample, l);
        MGEMM(0, true, c.ao, MH * VD, c.in[I_MWO] + (size_t)j * MH * VD * D, D, c.x, D, MTOT, D, MH * VD);
    } else {
        MGEMM(0, false, c.xn, D, c.in[I_BWIN] + (size_t)j * D * MB_IN, MB_IN, c.zx, MB_IN, MTOT, MB_IN, D);
        MRUN(ph_mb_conv, l); MRUN(ph_mb_dt, l); MRUN(ph_mb_scan, l); MRUN(ph_mb_gate, l);
        MGEMM(0, true, c.yzn, MB_INNER, c.in[I_BWO] + (size_t)j * MB_INNER * D, D, c.x, D, MTOT, D, MB_INNER);
    }
}


template <int L>
__device__ __forceinline__ void layer_rwkv_fast(const Ctx& c, const Fast& f, const FastRw& fr, const XcdBarrier& bar, LDSP unsigned char* lds) {
    using namespace cfg;
    constexpr int l = L, j = L / 3;
    if (L > 0) { fold_sample_rows(c.x, f.slab, KS_FFN, GW_NOW(), NGW_NOW(), LANE_NOW()); GBAR(); }
    DUP(9, rw_mix_fast(c, fr, l, GW_NOW(), NGW_NOW(), LANE_NOW()));
    GBAR();
    DUP(7, { pg8::Order<RwSel> S; S.init(MP / 256, MS / 256, 16, D, 1, gridDim.x, blockIdx.x);
      pg8::gemm_phase(lds, pg8::Gemm{fr.xm, fr.wrkvt + (size_t)j * 4096 * D, D, D, (size_t)MTOT * D}, S, EpiRwkv{fr.rkv, fr.hb}); });
    GBAR();
    DUP(2, rw_scan_chunked<j>(c, fr, lds));
    GBAR();
    { pg8::Order<> S; S.init(MP / 256, MS / 256, 4, D, KS_1K, gridDim.x, blockIdx.x);
      pg8::gemm_phase(lds, pg8::Gemm{fr.yo, fr.wot + (size_t)j * D * D, D, D, 0}, S, pg8::EpiAccF32{c.x, D, f.slab, MP / 256, MS / 256, KS_1K}); }
    if (PROBE_DUP & (1 << 26)) { GBAR(); pg8::Order<> S; S.init(MP / 256, MS / 256, 4, D, KS_1K, gridDim.x, blockIdx.x);
      pg8::gemm_phase(lds, pg8::Gemm{fr.yo, fr.wot + (size_t)j * D * D, D, D, 0}, S, pg8::EpiAccF32{c.hmid, D, f.slab + (size_t)16 * 16 * 65536, MP / 256, MS / 256, KS_1K}); }
    GBAR();
}

__device__ __forceinline__ void layer_mamba_fast(const Ctx& c, const Fast& f, const FastMb& fb, const XcdBarrier& bar, LDSP unsigned char* lds) {
    using namespace cfg;
    constexpr int l = 2, j = 0;
    norm_rows_bf16(c.x, c.in[I_NMIX] + l * D, f.xnb, f.slab, KS_FFN, GW_NOW(), NGW_NOW(), LANE_NOW());
    GBAR();
    DUP(8, { pg8::Order<> S; S.init(MP / 256, MS / 256, 21, D, 1, gridDim.x, blockIdx.x);
      pg8::gemm_phase(lds, pg8::Gemm{f.xnb, fb.wbint, D, D, 0}, S, EpiMamba{fb.zb, fb.xbcr, fb.dtraw}); });
    GBAR();
    DUP(12, mb_conv_fast(c, fb, l, GTID_NOW(), GSZ_NOW(), false));
    GBAR();
    DUP(6, mb_ssd_prompt(c, fb, l, lds); mb_scan_sample(c, fb, l));
    GBAR();
    DUP(13, mb_gate_fast(c, fb, fb.y, l, GW_NOW(), NGW_NOW(), LANE_NOW()));
    GBAR();
    { pg8::Order<> S; S.init(MP / 256, MS / 256, 4, MB_INNER, KS_MB, gridDim.x, blockIdx.x);
      pg8::gemm_phase(lds, pg8::Gemm{fb.yzn, fb.wbot, MB_INNER, MB_INNER, 0}, S, pg8::EpiAccF32{c.x, D, f.slab, MP / 256, MS / 256, KS_MB}); }
    if (PROBE_DUP & (1 << 28)) { GBAR(); pg8::Order<> S; S.init(MP / 256, MS / 256, 4, MB_INNER, KS_MB, gridDim.x, blockIdx.x);
      pg8::gemm_phase(lds, pg8::Gemm{fb.yzn, fb.wbot, MB_INNER, MB_INNER, 0}, S, pg8::EpiAccF32{c.hmid, D, f.slab + (size_t)16 * 16 * 65536, MP / 256, MS / 256, KS_MB}); }
    GBAR();
}

__device__ __forceinline__ void layer_mla_fast(const Ctx& c, const Fast& f, const FastMla& fm, const XcdBarrier& bar, LDSP unsigned char* lds) {
    using namespace cfg;
    constexpr int l = 1, j = 0;
    norm_rows_bf16(c.x, c.in[I_NMIX] + l * D, f.xnb, f.slab, KS_FFN, GW_NOW(), NGW_NOW(), LANE_NOW());
    GBAR();
    DUP(27, { pg8::Order<> S; S.init(MP / 256, MS / 256, 4, D, 1, gridDim.x, blockIdx.x);
      pg8::gemm_phase(lds, pg8::Gemm{f.xnb, fm.wint, D, D, 0}, S, pg8::EpiF32{fm.mh, 1024, 1024}); });
    GBAR();
    DUP(14, mla_norm1_fast(c, fm, j, GW_NOW(), NGW_NOW(), LANE_NOW()));
    GBAR();
    DUP(27, { pg8::Order<> S; S.init(MP / 256, MS / 256, (MH * QD) / 256, QL, 1, gridDim.x, blockIdx.x);
      pg8::gemm_phase(lds, pg8::Gemm{fm.qan, fm.wuqt, QL, QL, 0}, S, pg8::EpiBf16<0>{fm.qraw, MH * QD}); }
    { pg8::Order<> S; S.init(MP / 256, MS / 256, 4, KVL, 1, gridDim.x, blockIdx.x);
      pg8::gemm_phase(lds, pg8::Gemm{fm.cb, fm.wukvt, KVL, KVL, 0}, S, pg8::EpiBf16<0>{fm.kvraw, 2048}); }
    { pg8::Order<> S; S.init(4, 0, MTOT / 256, KVL, 1, gridDim.x, blockIdx.x);
      pg8::gemm_phase(lds, pg8::Gemm{fm.wukvt + (size_t)1024 * KVL, fm.cb, KVL, KVL, 0}, S, pg8::EpiBf16<0>{fm.vT, MTOT}); });
    GBAR();
    DUP(15, mla_norm2_fast(c, fm, j, GW_NOW(), NGW_NOW(), LANE_NOW()));
    { const unsigned t_ = (unsigned)GTID_NOW(); if (t_ < 96) *(pg8::u32x4*)(fm.qs + (size_t)MS * 1536 + t_ * 8) = (pg8::u32x4){0u, 0u, 0u, 0u}; }
    GBAR();
    DUP(5, attn_prompt_fast(fm.qf, fm.knb, fm.kpb, fm.vT, fm.aob, lds));
    __syncthreads();
    DUP(4, mla_sample_decode(c, fm, fm.qs, fm.opart, fm.lpart, j, lds));
    GBAR();
    DUP(16, mla_sample_combine(c, fm, fm.opart, fm.lpart, j, lds));
    GBAR();
    { pg8::Order<> S; S.init(MP / 256, MS / 256, 4, D, KS_1K, gridDim.x, blockIdx.x);
      pg8::gemm_phase(lds, pg8::Gemm{fm.aob, fm.wot, D, D, 0}, S, pg8::EpiAccF32{c.x, D, f.slab, MP / 256, MS / 256, KS_1K}); }
    if (PROBE_DUP & (1 << 27)) { GBAR(); pg8::Order<> S; S.init(MP / 256, MS / 256, 4, D, KS_1K, gridDim.x, blockIdx.x);
      pg8::gemm_phase(lds, pg8::Gemm{fm.aob, fm.wot, D, D, 0}, S, pg8::EpiAccF32{c.hmid, D, f.slab + (size_t)16 * 16 * 65536, MP / 256, MS / 256, KS_1K}); }
    GBAR();
}

template <int L>
__device__ __forceinline__ void layer_ffn_fast(const Ctx& c, const Fast& f, const XcdBarrier& bar, LDSP unsigned char* lds) {
    using namespace cfg;
    norm_rows_bf16(c.x, c.in[I_NFFN] + L * D, f.xnb, f.slab, (L % 3 == 2) ? KS_MB : KS_1K, GW_NOW(), NGW_NOW(), LANE_NOW());
    GBAR();
    DUP(0, { pg8::Order<> S; S.init(MP / 256, MS / 256, FFN / 256, D, 1, gridDim.x, blockIdx.x);
      pg8::gemm_phase(lds, pg8::Gemm{f.xnb, f.w1t + (size_t)L * FFN * D, D, D, 0}, S, pg8::EpiBf16<3>{f.hmidb, FFN}); });
    GBAR();
    { pg8::Order<> S; S.init(MP / 256, MS / 256, D / 256, FFN, (L == DEPTH - 1) ? 1 : KS_FFN, gridDim.x, blockIdx.x);
      pg8::gemm_phase(lds, pg8::Gemm{f.hmidb, f.w2t + (size_t)L * D * FFN, FFN, FFN, 0}, S, pg8::EpiAccF32{c.x, D, f.slab, MP / 256, MS / 256, (L == DEPTH - 1) ? 1 : KS_FFN}); }
    if (PROBE_DUP & (1 << 25)) { GBAR(); pg8::Order<> S; S.init(MP / 256, MS / 256, D / 256, FFN, (L == DEPTH - 1) ? 1 : KS_FFN, gridDim.x, blockIdx.x);
      pg8::gemm_phase(lds, pg8::Gemm{f.hmidb, f.w2t + (size_t)L * D * FFN, FFN, FFN, 0}, S, pg8::EpiAccF32{c.hmid, D, f.slab + (size_t)16 * 16 * 65536, MP / 256, MS / 256, (L == DEPTH - 1) ? 1 : KS_FFN}); }
    GBAR();
}

__global__ void __launch_bounds__(512, 2) mega10(MegaArgs a) {
    LDSP unsigned char* lds = (LDSP unsigned char*)dynlds;
    if (threadIdx.x < 4) ((LDSP unsigned*)(lds + LDS_XB))[threadIdx.x] = 0u;
    __syncthreads();
    XcdBarrier bar = xcd_barrier_post(a.bar, (volatile LAS unsigned*)(lds + LDS_XB));
    const Ctx& c = a.c; const Fast& f = a.f; const FastMla& fm = a.fm; const FastRw& fr = a.fr; const FastMb& fb = a.fb;
    using namespace cfg;
    DUP(10, {
        LDSP float* scr = (LDSP float*)(lds + LDS_STAGE) + (tid_now() >> 6) * (64 * 33);
        for (int l = 0; l < DEPTH; ++l) {
            tr_weight(c.in[I_FW1] + (size_t)l * D * FFN, D, FFN, FFN, f.w1t + (size_t)l * FFN * D, nullptr, scr, GW_NOW(), NGW_NOW(), LANE_NOW());
            tr_weight(c.in[I_FW2] + (size_t)l * FFN * D, FFN, D, D, f.w2t + (size_t)l * D * FFN, nullptr, scr, GW_NOW(), NGW_NOW(), LANE_NOW());
        }
        tr_weight(c.in[I_MWIN], D, MLA_IN, 1024, fm.wint, nullptr, scr, GW_NOW(), NGW_NOW(), LANE_NOW());
        tr_weight(c.in[I_WUQ], QL, MH * QD, MH * QD, fm.wuqt, nullptr, scr, GW_NOW(), NGW_NOW(), LANE_NOW());
        tr_weight(c.in[I_WUK], KVL, MH * NOPE, MH * NOPE, fm.wukvt, nullptr, scr, GW_NOW(), NGW_NOW(), LANE_NOW());
        tr_weight(c.in[I_WUV], KVL, MH * VD, MH * VD, fm.wukvt + (size_t)1024 * KVL, nullptr, scr, GW_NOW(), NGW_NOW(), LANE_NOW());
        tr_weight(c.in[I_MWO], MH * VD, D, D, fm.wot, nullptr, scr, GW_NOW(), NGW_NOW(), LANE_NOW());
        for (int j = 0; j < N_RWKV; ++j) {
            bf16_t* wt = fr.wrkvt + (size_t)j * 4096 * D;
            for (int p = 0; p < 3; ++p) tr_weight(c.in[I_WRKV] + ((size_t)j * 3 + p) * D * D, D, D, D, wt + (size_t)p * D * D, nullptr, scr, GW_NOW(), NGW_NOW(), LANE_NOW());
            tr_weight(c.in[I_W1] + (size_t)j * D * RW_DL, D, RW_DL, 256, wt + (size_t)3072 * D, nullptr, scr, GW_NOW(), NGW_NOW(), LANE_NOW());
            tr_weight(c.in[I_A1] + (size_t)j * D * RW_AL, D, RW_AL, 256, wt + (size_t)3328 * D, nullptr, scr, GW_NOW(), NGW_NOW(), LANE_NOW());
            tr_weight(c.in[I_G1] + (size_t)j * D * RW_GL, D, RW_GL, 256, wt + (size_t)3584 * D, nullptr, scr, GW_NOW(), NGW_NOW(), LANE_NOW());
            tr_weight(j > 0 ? c.in[I_V1] + (size_t)(j - 1) * D * RW_VL : c.in[I_W1], D, j > 0 ? RW_VL : 0, 256, wt + (size_t)3840 * D, nullptr, scr, GW_NOW(), NGW_NOW(), LANE_NOW());
            tr_weight(c.in[I_RWO] + (size_t)j * D * D, D, D, D, fr.wot + (size_t)j * D * D, nullptr, scr, GW_NOW(), NGW_NOW(), LANE_NOW());
            rw_build_lorat(c, fr.lorat + (size_t)j * 4096 * 384, j, GTID_NOW(), GSZ_NOW());
        }
        tr_weight(c.in[I_BWIN], D, MB_IN, 5376, fb.wbint, nullptr, scr, GW_NOW(), NGW_NOW(), LANE_NOW());
        tr_weight(c.in[I_BWO], MB_INNER, D, D, fb.wbot, nullptr, scr, GW_NOW(), NGW_NOW(), LANE_NOW());
        ph_copy_x(c, 0, GTID_NOW(), GSZ_NOW());
    });
    GBAR();
    layer_rwkv_fast<0>(c, f, fr, bar, lds); layer_ffn_fast<0>(c, f, bar, lds);
    layer_mla_fast(c, f, fm, bar, lds); layer_ffn_fast<1>(c, f, bar, lds);
    layer_mamba_fast(c, f, fb, bar, lds); layer_ffn_fast<2>(c, f, bar, lds);
    layer_rwkv_fast<3>(c, f, fr, bar, lds); layer_ffn_fast<3>(c, f, bar, lds);
}

extern "C" void kernel_launch(void* const* d_in, const int* in_sizes, int n_in, void* d_out, int out_size, void* d_ws, size_t ws_size, hipStream_t stream) {
    using namespace cfg;
    MegaArgs a{};
    size_t used = setup_ctx(a.c, d_in, d_out, d_ws);
    { Bump b{(char*)d_ws, (size_t)((char*)a.c.xm[0] - (char*)d_ws)}; FastRw& r = a.fr;
      r.xm = (bf16_t*)b.f((size_t)6 * MTOT * D / 2); r.rkv = (bf16_t*)b.f((size_t)MTOT * 3072 / 2); r.hb = (bf16_t*)b.f((size_t)MTOT * 384 / 2); r.lu = (bf16_t*)b.f((size_t)MTOT * 4096 / 2);
      r.ops = b.f((size_t)MTOT * RHEADS * RW_REC + 4096); r.yo = (bf16_t*)b.f((size_t)MTOT * D / 2); r.vf = a.c.vf;
      if (b.off > (size_t)((char*)a.c.hmid - (char*)d_ws) + (size_t)MTOT * FFN * 4) { fprintf(stderr, "RWKV overlay too large\n"); return; } }
    { Bump b{(char*)d_ws, used};
      a.f.xnb = (bf16_t*)b.f((size_t)MTOT * D / 2); a.f.hmidb = (bf16_t*)b.f((size_t)MTOT * FFN / 2);
      a.f.w1t = (bf16_t*)b.f((size_t)DEPTH * FFN * D / 2); a.f.w2t = (bf16_t*)b.f((size_t)DEPTH * FFN * D / 2); a.f.slab = b.f((size_t)2 * 16 * 16 * 65536);
      FastMla& m = a.fm;
      m.mh = b.f((size_t)MTOT * 1024); m.qan = (bf16_t*)b.f((size_t)MTOT * QL / 2); m.cb = (bf16_t*)b.f((size_t)MTOT * KVL / 2); m.kpb = (bf16_t*)b.f((size_t)MTOT * ROPE / 2);
      m.qraw = (bf16_t*)b.f((size_t)MTOT * 1536 / 2); m.kvraw = (bf16_t*)b.f((size_t)MTOT * 2048 / 2); m.qf = (bf16_t*)b.f((size_t)MTOT * 1536 / 2); m.knb = (bf16_t*)b.f((size_t)MTOT * 1024 / 2);
      m.aob = (bf16_t*)b.f((size_t)MTOT * 1024 / 2); m.vT = (bf16_t*)b.f((size_t)MTOT * 1024 / 2); m.qs = (bf16_t*)b.f((size_t)MS * 1536 / 2 + 1024);
      m.opart = b.f((size_t)2 * DB * 128 * 256); m.lpart = b.f((size_t)2 * DB * 128);
      m.wint = (bf16_t*)b.f((size_t)1024 * 1024 / 2); m.wuqt = (bf16_t*)b.f((size_t)1536 * 512 / 2); m.wukvt = (bf16_t*)b.f((size_t)2048 * 256 / 2); m.wot = (bf16_t*)b.f((size_t)1024 * 1024 / 2);
      { FastMb& q = a.fb; q.zb = (bf16_t*)b.f((size_t)MTOT * 2048 / 2); q.xbcr = (bf16_t*)b.f((size_t)MTOT * 3072 / 2); q.dtraw = b.f((size_t)MTOT * 32); q.xbcb = (bf16_t*)b.f((size_t)MTOT * 3072 / 2);
        q.dt = b.f((size_t)MTOT * 32); q.y = a.c.my; q.yzn = (bf16_t*)b.f((size_t)MTOT * 2048 / 2); q.wbint = (bf16_t*)b.f((size_t)5376 * 1024 / 2); q.wbot = (bf16_t*)b.f((size_t)1024 * 2048 / 2); }
      a.fr.wrkvt = (bf16_t*)b.f((size_t)N_RWKV * 4096 * D / 2); a.fr.lorat = (bf16_t*)b.f((size_t)N_RWKV * 4096 * 384 / 2); a.fr.wot = (bf16_t*)b.f((size_t)N_RWKV * D * D / 2);
      used = b.off; }
    if (used > ws_size || n_in != 51) { fprintf(stderr, "workspace too small: need %zu have %zu (n_in %d)\n", used, ws_size, n_in); return; }
    a.bar = (unsigned*)d_ws;
    static int grid = 0;
    if (!grid) {
        int dev = 0, cus = 0, per_cu = 0;
        (void)hipGetDevice(&dev); (void)hipDeviceGetAttribute(&cus, hipDeviceAttributeMultiprocessorCount, dev);
        if (hipFuncSetAttribute((const void*)mega10, hipFuncAttributeMaxDynamicSharedMemorySize, LDS_BYTES) != hipSuccess) { fprintf(stderr, "hipFuncSetAttribute failed\n"); grid = -1; return; }
        (void)hipOccupancyMaxActiveBlocksPerMultiprocessor(&per_cu, (const void*)mega10, 512, LDS_BYTES);
        (void)hipGetLastError();
        grid = per_cu >= 1 ? (cus < 256 ? cus : 256) : -1;
    }
    if (grid <= 0) { fprintf(stderr, "kernel does not fit one workgroup per CU\n"); return; }
    (void)hipMemsetAsync(a.bar, 0, XCD_BAR_WORDS * sizeof(unsigned), stream);
    hipLaunchKernelGGL(mega10, dim3(grid), dim3(512), LDS_BYTES, stream, a);
}
```

```cpp
#include <hip/hip_runtime.h>
#include <cstdio>
#include <math.h>
#include <stdint.h>
#include <stddef.h>
#ifdef CPU_EMU
#define DEV inline
#else
#define DEV __device__ __forceinline__
#endif

namespace cfg {
#ifdef CFG_SMALL
constexpr int D = 128, BATCH = 2, SEQ = 32, DEPTH = 4, DB = 3, DS = 8, PAST = 64, PAGE = 16;
constexpr int RW_DL = 16, RW_AL = 16, RW_VL = 8, RW_GL = 24;
constexpr int MH = 2, QL = 64, KVL = 32;
constexpr int MB_GROUPS = 2;
#else
constexpr int D = 1024, BATCH = 16, SEQ = 2048, DEPTH = 4, DB = 128, DS = 8, PAST = 8192, PAGE = 128;
constexpr int RW_DL = 64, RW_AL = 64, RW_VL = 32, RW_GL = 160;
constexpr int MH = 16, QL = 512, KVL = 256;
constexpr int MB_GROUPS = 4;
#endif
constexpr int N_RWKV = (DEPTH + 2) / 3, N_MLA = (DEPTH + 1) / 3, N_MAMBA = DEPTH / 3;
constexpr int RH = 64, RHEADS = D / RH;
constexpr int NOPE = 64, ROPE = 32, VD = 64, QD = NOPE + ROPE;
constexpr int MLA_IN = QL + KVL + ROPE;
constexpr int MB_INNER = 2 * D, MB_HEAD = 64, MB_HEADS = MB_INNER / MB_HEAD, MB_STATE = 128, MB_CONV = 4;
constexpr int MB_GN = MB_GROUPS * MB_STATE;
constexpr int MB_CD = MB_INNER + 2 * MB_GN, MB_IN = MB_INNER + MB_CD + MB_HEADS;
constexpr int FFN = 4 * D;
constexpr int NPAGES = PAST / PAGE, NPOOL = (DB * NPAGES * 5) / 4;
constexpr int MP = BATCH * SEQ, MS = DB * DS, MTOT = MP + MS, NSEQ = BATCH + DB;
constexpr int KTOT = PAST + DS;
constexpr float NORM_EPS = 1e-6f, LNX_EPS = 64e-5f;
constexpr size_t O_YP = 0;
constexpr size_t O_YS = O_YP + (size_t)MP * D;
constexpr size_t O_CKVP = O_YS + (size_t)MS * D;
constexpr size_t O_KPEP = O_CKVP + (size_t)N_MLA * MP * KVL;
constexpr size_t O_CKVS = O_KPEP + (size_t)N_MLA * MP * ROPE;
constexpr size_t O_KPES = O_CKVS + (size_t)N_MLA * MS * KVL;
constexpr size_t O_WKVP = O_KPES + (size_t)N_MLA * MS * ROPE;
constexpr size_t O_SHP = O_WKVP + (size_t)N_RWKV * BATCH * RHEADS * RH * RH;
constexpr size_t O_WKVS = O_SHP + (size_t)N_RWKV * BATCH * D;
constexpr size_t O_SHS = O_WKVS + (size_t)N_RWKV * DB * RHEADS * RH * RH;
constexpr size_t O_SSMP = O_SHS + (size_t)N_RWKV * DB * D;
constexpr size_t O_CONVP = O_SSMP + (size_t)N_MAMBA * BATCH * MB_HEADS * MB_HEAD * MB_STATE;
constexpr size_t O_SSMS = O_CONVP + (size_t)N_MAMBA * BATCH * (MB_CONV - 1) * MB_CD;
constexpr size_t O_CONVS = O_SSMS + (size_t)N_MAMBA * DB * MB_HEADS * MB_HEAD * MB_STATE;
constexpr size_t O_END = O_CONVS + (size_t)N_MAMBA * DB * (MB_CONV - 1) * MB_CD;
}

struct Ctx {
    const float* in[51];
    const int* page_table;
    float* out;
    float *x, *xn, *vf;
    float* xm[6];
    float *r, *k, *v, *wpre, *apre, *vpre, *g, *hw, *ha, *hv, *hg, *ka, *kb, *y, *yo;
    float *hmid;
    float *mh, *qan, *q, *c, *kp, *knr, *vv, *ao, *sc, *olat;
    float *zx, *xbc, *dt, *my, *yzn;
};

DEV int row_t(int m) { return m < cfg::MP ? m % cfg::SEQ : (m - cfg::MP) % cfg::DS; }
DEV int row_seq(int m) { return m < cfg::MP ? m / cfg::SEQ : cfg::BATCH + (m - cfg::MP) / cfg::DS; }
DEV int seq_row0(int sq) { return sq < cfg::BATCH ? sq * cfg::SEQ : cfg::MP + (sq - cfg::BATCH) * cfg::DS; }
DEV int seq_len(int sq) { return sq < cfg::BATCH ? cfg::SEQ : cfg::DS; }
DEV float sigmoidf_(float x) { return 1.0f / (1.0f + expf(-x)); }
DEV float softplusf_(float x) { return x > 20.f ? x : log1pf(expf(x)); }
DEV float siluf_(float x) { return x * sigmoidf_(x); }

enum { I_XP = 0, I_XS, I_CKV, I_KPE, I_WKV, I_SHIFT, I_SSM, I_CONV, I_PT, I_NMIX, I_NFFN, I_FW1, I_FW2, I_MU, I_WRKV, I_W0, I_W1, I_W2, I_A0, I_A1, I_A2,
       I_V0, I_V1, I_V2, I_G1, I_G2, I_KK, I_KA, I_RK, I_LNW, I_LNB, I_RWO, I_MWIN, I_QNORM, I_KVNORM, I_WUQ, I_WUK, I_WUV, I_QNN, I_QRN, I_KNN, I_KRN, I_MWO,
       I_BWIN, I_CONVW, I_CONVB, I_DTB, I_ALOG, I_BD, I_BNORM, I_BWO };

#define UNROLL _Pragma("unroll")
#define GSL(i, n) for (size_t i = gtid; i < (size_t)(n); i += gsz)

DEV void ph_copy_x(const Ctx& c, int, size_t gtid, size_t gsz) {
    using namespace cfg;
    GSL(i, (size_t)MTOT * D) c.x[i] = i < (size_t)MP * D ? c.in[I_XP][i] : c.in[I_XS][i - (size_t)MP * D];
}
DEV void rmsnorm_rows(const float* x, const float* gain, float* xn, size_t gtid, size_t gsz) {
    using namespace cfg;
    GSL(m, MTOT) {
        const float* xr = x + m * D; float ss = 0.f;
        for (int i = 0; i < D; ++i) ss += xr[i] * xr[i];
        const float rs = 1.0f / sqrtf(ss / D + NORM_EPS);
        for (int i = 0; i < D; ++i) xn[m * D + i] = xr[i] * rs * gain[i];
    }
}
DEV void ph_norm_mix(const Ctx& c, int l, size_t gtid, size_t gsz) { rmsnorm_rows(c.x, c.in[I_NMIX] + l * cfg::D, c.xn, gtid, gsz); }
DEV void ph_norm_ffn(const Ctx& c, int l, size_t gtid, size_t gsz) { rmsnorm_rows(c.x, c.in[I_NFFN] + l * cfg::D, c.xn, gtid, gsz); }

DEV void ph_rw_mix(const Ctx& c, int l, size_t gtid, size_t gsz) {
    using namespace cfg; const int j = l / 3;
    GSL(i, (size_t)MTOT * D) {
        const int m = (int)(i / D), ch = (int)(i % D), t = row_t(m), sq = row_seq(m);
        const float xc = c.xn[i];
        float xp;
        if (t > 0) xp = c.xn[i - D];
        else xp = sq < BATCH ? 0.f : c.in[I_SHIFT][((size_t)j * DB + (sq - BATCH)) * D + ch];
        for (int p = 0; p < 6; ++p) c.xm[p][i] = xc + (xp - xc) * c.in[I_MU][((size_t)j * 6 + p) * D + ch];
        if (t == seq_len(sq) - 1) {
            if (sq < BATCH) c.out[O_SHP + ((size_t)j * BATCH + sq) * D + ch] = xc;
            else c.out[O_SHS + ((size_t)j * DB + (sq - BATCH)) * D + ch] = xc;
        }
    }
}
DEV void ph_rw_prep(const Ctx& c, int l, size_t gtid, size_t gsz) {
    using namespace cfg; const int j = l / 3;
    GSL(i, (size_t)MTOT * RHEADS) {
        const int m = (int)(i / RHEADS), h = (int)(i % RHEADS);
        const size_t o = (size_t)m * D + h * RH;
        float nn = 0.f;
        for (int e = 0; e < RH; ++e) { const float kk = c.k[o + e] * c.in[I_KK][j * D + h * RH + e]; nn += kk * kk; }
        const float inv = 1.0f / fmaxf(sqrtf(nn), 1e-12f);
        for (int e = 0; e < RH; ++e) {
            const int ch = h * RH + e;
            const float wl = -softplusf_(-(c.in[I_W0][j * D + ch] + c.wpre[o + e])) - 0.5f;
            const float decay = expf(-expf(wl));
            float vv = c.v[o + e];
            if (j == 0) c.vf[o + e] = vv;
            else vv = vv + (c.vf[o + e] - vv) * sigmoidf_(c.in[I_V0][(j - 1) * D + ch] + c.vpre[o + e]);
            const float a = sigmoidf_(c.in[I_A0][j * D + ch] + c.apre[o + e]);
            const float k0 = c.k[o + e];
            const float kk = k0 * c.in[I_KK][j * D + ch] * inv;
            c.k[o + e] = k0 * (1.0f + (a - 1.0f) * c.in[I_KA][j * D + ch]);
            c.v[o + e] = vv;
            c.wpre[o + e] = decay;
            c.ka[o + e] = -kk;
            c.kb[o + e] = kk * a;
        }
    }
}
DEV void ph_rw_scan(const Ctx& c, int l, size_t gtid, size_t gsz) {
    using namespace cfg; const int j = l / 3;
    GSL(i, (size_t)NSEQ * RHEADS * RH) {
        const int sq = (int)(i / (RHEADS * RH)), h = (int)(i / RH) % RHEADS, vi = (int)(i % RH);
        float S[RH];
        if (sq < BATCH) { UNROLL for (int e = 0; e < RH; ++e) S[e] = 0.f; }
        else { const float* s0 = c.in[I_WKV] + ((((size_t)j * DB + (sq - BATCH)) * RHEADS + h) * RH + vi) * RH; UNROLL for (int e = 0; e < RH; ++e) S[e] = s0[e]; }
        const int m0 = seq_row0(sq), T = seq_len(sq);
        for (int t = 0; t < T; ++t) {
            const size_t o = (size_t)(m0 + t) * D + h * RH;
            float sa = 0.f;
            UNROLL for (int e = 0; e < RH; ++e) sa += S[e] * c.ka[o + e];
            const float vt = c.v[o + vi]; float yy = 0.f;
            UNROLL for (int e = 0; e < RH; ++e) { S[e] = S[e] * c.wpre[o + e] + sa * c.kb[o + e] + vt * c.k[o + e]; yy += S[e] * c.r[o + e]; }
            c.y[o + vi] = yy;
        }
        float* so = sq < BATCH ? c.out + O_WKVP + ((((size_t)j * BATCH + sq) * RHEADS + h) * RH + vi) * RH
                               : c.out + O_WKVS + ((((size_t)j * DB + (sq - BATCH)) * RHEADS + h) * RH + vi) * RH;
        UNROLL for (int e = 0; e < RH; ++e) so[e] = S[e];
    }
}
DEV void ph_rw_post(const Ctx& c, int l, size_t gtid, size_t gsz) {
    using namespace cfg; const int j = l / 3;
    GSL(i, (size_t)MTOT * RHEADS) {
        const int m = (int)(i / RHEADS), h = (int)(i % RHEADS);
        const size_t o = (size_t)m * D + h * RH;
        float mean = 0.f; for (int e = 0; e < RH; ++e) mean += c.y[o + e]; mean /= RH;
        float var = 0.f; for (int e = 0; e < RH; ++e) { const float d = c.y[o + e] - mean; var += d * d; } var /= RH;
        const float rs = 1.0f / sqrtf(var + LNX_EPS);
        float bonus = 0.f; for (int e = 0; e < RH; ++e) bonus += c.r[o + e] * c.k[o + e] * c.in[I_RK][(size_t)j * D + h * RH + e];
        for (int e = 0; e < RH; ++e) {
            const int ch = h * RH + e;
            const float yn = (c.y[o + e] - mean) * rs * c.in[I_LNW][j * D + ch] + c.in[I_LNB][j * D + ch];
            c.yo[o + e] = (yn + bonus * c.v[o + e]) * c.g[o + e];
        }
    }
}

DEV void rope_apply(const float* xin, float* xout, int pos) {
    using namespace cfg; const int half = ROPE / 2;
    UNROLL for (int i = 0; i < half; ++i) {
        const float inv = exp2f(-(float)i * (13.287712379549449f / half));
        const float ang = (float)pos * inv;
        const float kq = rintf(ang * 0.15915494309189535f);
        float rr = fmaf(-kq, 6.28125f, ang); rr = fmaf(-kq, 1.9353071795864769e-3f, rr);
        const float cs = __cosf(rr), sn = __sinf(rr);
        const float x1 = xin[i], x2 = xin[i + half];
        xout[i] = x1 * cs - x2 * sn; xout[i + half] = x2 * cs + x1 * sn;
    }
}
DEV int row_pos(int m) { return m < cfg::MP ? m % cfg::SEQ : cfg::PAST + (m - cfg::MP) % cfg::DS; }
DEV void ph_mla_norm1(const Ctx& c, int l, size_t gtid, size_t gsz) {
    using namespace cfg; const int j = l / 3;
    GSL(m, MTOT) {
        const float* h = c.mh + m * MLA_IN;
        float ss = 0.f; for (int i = 0; i < QL; ++i) ss += h[i] * h[i];
        float rs = 1.0f / sqrtf(ss / QL + NORM_EPS);
        for (int i = 0; i < QL; ++i) c.qan[m * QL + i] = h[i] * rs * c.in[I_QNORM][j * QL + i];
        ss = 0.f; for (int i = 0; i < KVL; ++i) ss += h[QL + i] * h[QL + i];
        rs = 1.0f / sqrtf(ss / KVL + NORM_EPS);
        float* co = m < (size_t)MP ? c.out + O_CKVP + ((size_t)j * MP + m) * KVL : c.out + O_CKVS + ((size_t)j * MS + (m - MP)) * KVL;
        for (int i = 0; i < KVL; ++i) { const float v = h[QL + i] * rs * c.in[I_KVNORM][j * KVL + i]; c.c[m * KVL + i] = v; co[i] = v; }
        ss = 0.f; UNROLL for (int i = 0; i < ROPE; ++i) ss += h[QL + KVL + i] * h[QL + KVL + i];
        rs = 1.0f / sqrtf(ss / ROPE + NORM_EPS);
        float tmp[ROPE], ro[ROPE];
        UNROLL for (int i = 0; i < ROPE; ++i) tmp[i] = h[QL + KVL + i] * rs * c.in[I_KRN][j * ROPE + i];
        rope_apply(tmp, ro, row_pos((int)m));
        float* ko = m < (size_t)MP ? c.out + O_KPEP + ((size_t)j * MP + m) * ROPE : c.out + O_KPES + ((size_t)j * MS + (m - MP)) * ROPE;
        UNROLL for (int i = 0; i < ROPE; ++i) { c.kp[m * ROPE + i] = ro[i]; ko[i] = ro[i]; }
    }
}
DEV void ph_mla_norm2(const Ctx& c, int l, size_t gtid, size_t gsz) {
    using namespace cfg; const int j = l / 3;
    GSL(i, (size_t)MTOT * MH) {
        const int m = (int)(i / MH), h = (int)(i % MH);
        float* q = c.q + (size_t)m * MH * QD + h * QD;
        float ss = 0.f; UNROLL for (int e = 0; e < NOPE; ++e) ss += q[e] * q[e];
        float rs = 1.0f / sqrtf(ss / NOPE + NORM_EPS);
        UNROLL for (int e = 0; e < NOPE; ++e) q[e] = q[e] * rs * c.in[I_QNN][j * NOPE + e];
        ss = 0.f; UNROLL for (int e = 0; e < ROPE; ++e) ss += q[NOPE + e] * q[NOPE + e];
        rs = 1.0f / sqrtf(ss / ROPE + NORM_EPS);
        float tmp[ROPE], ro[ROPE];
        UNROLL for (int e = 0; e < ROPE; ++e) tmp[e] = q[NOPE + e] * rs * c.in[I_QRN][j * ROPE + e];
        rope_apply(tmp, ro, row_pos(m));
        UNROLL for (int e = 0; e < ROPE; ++e) q[NOPE + e] = ro[e];
        float* kn = c.knr + (size_t)m * MH * NOPE + h * NOPE;
        ss = 0.f; UNROLL for (int e = 0; e < NOPE; ++e) ss += kn[e] * kn[e];
        rs = 1.0f / sqrtf(ss / NOPE + NORM_EPS);
        UNROLL for (int e = 0; e < NOPE; ++e) kn[e] = kn[e] * rs * c.in[I_KNN][j * NOPE + e];
    }
}
DEV void ph_mla_attn_prompt(const Ctx& c, int, size_t gtid, size_t gsz) {
    using namespace cfg; const float scale = 1.0f / sqrtf((float)QD);
    GSL(i, (size_t)MP * MH) {
        const int m = (int)(i / MH), h = (int)(i % MH), t = m % SEQ, m0 = m - t;
        const float* q = c.q + (size_t)m * MH * QD + h * QD;
        float mx = -INFINITY, den = 0.f, acc[VD];
        UNROLL for (int e = 0; e < VD; ++e) acc[e] = 0.f;
        for (int kx = 0; kx <= t; ++kx) {
            const int mk = m0 + kx;
            const float* kn = c.knr + (size_t)mk * MH * NOPE + h * NOPE; const float* kp = c.kp + (size_t)mk * ROPE;
            float s = 0.f;
            UNROLL for (int e = 0; e < NOPE; ++e) s += q[e] * kn[e];
            UNROLL for (int e = 0; e < ROPE; ++e) s += q[NOPE + e] * kp[e];
            s *= scale;
            const float nm = fmaxf(mx, s), corr = expf(mx - nm), p = expf(s - nm);
            den = den * corr + p;
            const float* v = c.vv + (size_t)mk * MH * VD + h * VD;
            UNROLL for (int e = 0; e < VD; ++e) acc[e] = acc[e] * corr + p * v[e];
            mx = nm;
        }
        UNROLL for (int e = 0; e < VD; ++e) c.ao[(size_t)m * MH * VD + h * VD + e] = acc[e] / den;
    }
}
DEV const float* smp_c(const Ctx& c, int j, int s, int pos) {
    using namespace cfg;
    if (pos < PAST) { const int pg = c.page_table[s * NPAGES + pos / PAGE]; return c.in[I_CKV] + (((size_t)j * NPOOL + pg) * PAGE + pos % PAGE) * KVL; }
    return c.c + (size_t)(MP + s * DS + (pos - PAST)) * KVL;
}
DEV const float* smp_kp(const Ctx& c, int j, int s, int pos) {
    using namespace cfg;
    if (pos < PAST) { const int pg = c.page_table[s * NPAGES + pos / PAGE]; return c.in[I_KPE] + (((size_t)j * NPOOL + pg) * PAGE + pos % PAGE) * ROPE; }
    return c.kp + (size_t)(MP + s * DS + (pos - PAST)) * ROPE;
}
DEV void ph_mla_score_sample(const Ctx& c, int l, size_t gtid, size_t gsz) {
    using namespace cfg; const int j = l / 3; const float scale = 1.0f / sqrtf((float)QD);
    GSL(i, (size_t)DB * KTOT * MH) {
        const int pos = (int)(i % KTOT), h = (int)((i / KTOT) % MH), s = (int)(i / ((size_t)MH * KTOT));
        const float* cl = smp_c(c, j, s, pos); const float* kp = smp_kp(c, j, s, pos);
        float kn[NOPE];
        UNROLL for (int e = 0; e < NOPE; ++e) kn[e] = 0.f;
        const float* wuk = c.in[I_WUK] + (size_t)j * KVL * MH * NOPE;
        for (int r = 0; r < KVL; ++r) { const float cv = cl[r]; const float* w = wuk + ((size_t)r * MH + h) * NOPE; UNROLL for (int e = 0; e < NOPE; ++e) kn[e] += cv * w[e]; }
        float ss = 0.f; UNROLL for (int e = 0; e < NOPE; ++e) ss += kn[e] * kn[e];
        const float rs = 1.0f / sqrtf(ss / NOPE + NORM_EPS);
        UNROLL for (int e = 0; e < NOPE; ++e) kn[e] = kn[e] * rs * c.in[I_KNN][j * NOPE + e];
        for (int qi = 0; qi < DS; ++qi) {
            const float* q = c.q + (size_t)(MP + s * DS + qi) * MH * QD + h * QD;
            float sc = 0.f;
            UNROLL for (int e = 0; e < NOPE; ++e) sc += q[e] * kn[e];
            UNROLL for (int e = 0; e < ROPE; ++e) sc += q[NOPE + e] * kp[e];
            const bool ok = pos < PAST || (pos - PAST) <= qi;
            c.sc[(((size_t)s * MH + h) * DS + qi) * KTOT + pos] = ok ? sc * scale : -INFINITY;
        }
    }
}
DEV void ph_mla_softmax_sample(const Ctx& c, int, size_t gtid, size_t gsz) {
    using namespace cfg;
    GSL(i, (size_t)DB * MH * DS) {
        float* sc = c.sc + i * KTOT;
        float mx = -INFINITY; for (int p = 0; p < KTOT; ++p) mx = fmaxf(mx, sc[p]);
        float den = 0.f; for (int p = 0; p < KTOT; ++p) den += expf(sc[p] - mx);
        const float inv = 1.0f / den;
        for (int p = 0; p < KTOT; ++p) sc[p] = expf(sc[p] - mx) * inv;
    }
}
DEV void ph_mla_pv_sample(const Ctx& c, int l, size_t gtid, size_t gsz) {
    using namespace cfg; const int j = l / 3;
    GSL(i, (size_t)DB * MH * DS * KVL) {
        const int r = (int)(i % KVL); const size_t row = i / KVL; const int s = (int)(row / (MH * DS));
        const float* p = c.sc + row * KTOT; float acc = 0.f;
        for (int pos = 0; pos < KTOT; ++pos) acc += p[pos] * smp_c(c, j, s, pos)[r];
        c.olat[i] = acc;
    }
}
DEV void ph_mla_out_sample(const Ctx& c, int l, size_t gtid, size_t gsz) {
    using namespace cfg; const int j = l / 3;
    GSL(i, (size_t)MS * MH * VD) {
        const int e = (int)(i % VD), h = (int)((i / VD) % MH), ms = (int)(i / (MH * VD)), s = ms / DS, qi = ms % DS;
        const float* ol = c.olat + (((size_t)s * MH + h) * DS + qi) * KVL;
        const float* wuv = c.in[I_WUV] + (size_t)j * KVL * MH * VD;
        float acc = 0.f;
        for (int r = 0; r < KVL; ++r) acc += ol[r] * wuv[((size_t)r * MH + h) * VD + e];
        c.ao[(size_t)(MP + ms) * MH * VD + h * VD + e] = acc;
    }
}

DEV float mb_xpad(const Ctx& c, int j, int m, int sq, int tt, int ch) {
    using namespace cfg;
    if (tt < MB_CONV - 1) return sq < BATCH ? 0.f : c.in[I_CONV][(((size_t)j * DB + (sq - BATCH)) * (MB_CONV - 1) + tt) * MB_CD + ch];
    (void)m; return c.zx[(size_t)(seq_row0(sq) + tt - (MB_CONV - 1)) * MB_IN + MB_INNER + ch];
}
DEV void ph_mb_conv(const Ctx& c, int l, size_t gtid, size_t gsz) {
    using namespace cfg; const int j = l / 3;
    GSL(i, (size_t)MTOT * MB_CD) {
        const int m = (int)(i / MB_CD), ch = (int)(i % MB_CD), t = row_t(m), sq = row_seq(m), T = seq_len(sq);
        float acc = c.in[I_CONVB][j * MB_CD + ch];
        for (int jj = 0; jj < MB_CONV; ++jj) acc += mb_xpad(c, j, m, sq, t + jj, ch) * c.in[I_CONVW][((size_t)j * MB_CONV + jj) * MB_CD + ch];
        c.xbc[i] = siluf_(acc);
        if (t < MB_CONV - 1) {
            const float v = mb_xpad(c, j, m, sq, T + t, ch);
            if (sq < BATCH) c.out[O_CONVP + (((size_t)j * BATCH + sq) * (MB_CONV - 1) + t) * MB_CD + ch] = v;
            else c.out[O_CONVS + (((size_t)j * DB + (sq - BATCH)) * (MB_CONV - 1) + t) * MB_CD + ch] = v;
        }
    }
}
DEV void ph_mb_dt(const Ctx& c, int l, size_t gtid, size_t gsz) {
    using namespace cfg; const int j = l / 3;
    GSL(i, (size_t)MTOT * MB_HEADS) {
        const int m = (int)(i / MB_HEADS), h = (int)(i % MB_HEADS);
        c.dt[i] = softplusf_(c.zx[(size_t)m * MB_IN + MB_INNER + MB_CD + h] + c.in[I_DTB][j * MB_HEADS + h]);
    }
}
DEV void ph_mb_scan(const Ctx& c, int l, size_t gtid, size_t gsz) {
    using namespace cfg; const int j = l / 3;
    GSL(i, (size_t)NSEQ * MB_HEADS * MB_HEAD) {
        const int p = (int)(i % MB_HEAD), h = (int)((i / MB_HEAD) % MB_HEADS), sq = (int)(i / (MB_HEADS * MB_HEAD));
        const int g = h / (MB_HEADS / MB_GROUPS);
        float hs[MB_STATE];
        if (sq < BATCH) { UNROLL for (int n = 0; n < MB_STATE; ++n) hs[n] = 0.f; }
        else { const float* s0 = c.in[I_SSM] + ((((size_t)j * DB + (sq - BATCH)) * MB_HEADS + h) * MB_HEAD + p) * MB_STATE; UNROLL for (int n = 0; n < MB_STATE; ++n) hs[n] = s0[n]; }
        const float A = -expf(c.in[I_ALOG][j * MB_HEADS + h]), dsk = c.in[I_BD][j * MB_HEADS + h];
        const int m0 = seq_row0(sq), T = seq_len(sq);
        for (int t = 0; t < T; ++t) {
            const size_t m = (size_t)(m0 + t);
            const float dtv = c.dt[m * MB_HEADS + h], dA = expf(dtv * A);
            const float xv = c.xbc[m * MB_CD + h * MB_HEAD + p], xdt = xv * dtv;
            const float* Bm = c.xbc + m * MB_CD + MB_INNER + g * MB_STATE; const float* Cm = Bm + MB_GN;
            float yy = 0.f;
            UNROLL for (int n = 0; n < MB_STATE; ++n) { hs[n] = hs[n] * dA + xdt * Bm[n]; yy += Cm[n] * hs[n]; }
            c.my[m * MB_INNER + h * MB_HEAD + p] = yy + dsk * xv;
        }
        float* so = sq < BATCH ? c.out + O_SSMP + ((((size_t)j * BATCH + sq) * MB_HEADS + h) * MB_HEAD + p) * MB_STATE
                               : c.out + O_SSMS + ((((size_t)j * DB + (sq - BATCH)) * MB_HEADS + h) * MB_HEAD + p) * MB_STATE;
        UNROLL for (int n = 0; n < MB_STATE; ++n) so[n] = hs[n];
    }
}
DEV void ph_mb_gate(const Ctx& c, int l, size_t gtid, size_t gsz) {
    using namespace cfg; const int j = l / 3; constexpr int GW = MB_INNER / MB_GROUPS;
    GSL(i, (size_t)MTOT * MB_GROUPS) {
        const int m = (int)(i / MB_GROUPS), g = (int)(i % MB_GROUPS);
        float ss = 0.f;
        for (int e = 0; e < GW; ++e) { const float v = c.my[(size_t)m * MB_INNER + g * GW + e] * siluf_(c.zx[(size_t)m * MB_IN + g * GW + e]); ss += v * v; }
        const float rs = 1.0f / sqrtf(ss / GW + NORM_EPS);
        for (int e = 0; e < GW; ++e) {
            const float v = c.my[(size_t)m * MB_INNER + g * GW + e] * siluf_(c.zx[(size_t)m * MB_IN + g * GW + e]);
            c.yzn[(size_t)m * MB_INNER + g * GW + e] = v * rs * c.in[I_BNORM][j * MB_INNER + g * GW + e];
        }
    }
}
typedef short bf16x8_t __attribute__((ext_vector_type(8)));
typedef float f32x4_t __attribute__((ext_vector_type(4)));
__device__ __forceinline__ unsigned short f2bf(float f) { unsigned u = __float_as_uint(f); u += 0x7fffu + ((u >> 16) & 1u); return (unsigned short)(u >> 16); }
#define XB_TMO      128
#define XB_XCNT(j)  (256  + 64 * (j))
#define XB_XSUB(j)  (1280 + 64 * (j))
#define XB_XGEN(j)  (2304 + 64 * (j))
#define XB_TOP      3328
#define XB_TOPGEN   3392
#define XCD_BAR_WORDS 3456
#define XB_SPIN_CAP (1u << 25)
#define LAS __attribute__((address_space(3)))

__device__ __forceinline__ unsigned xb_ld(unsigned* p)              { return __hip_atomic_load(p, __ATOMIC_RELAXED, __HIP_MEMORY_SCOPE_AGENT); }
__device__ __forceinline__ unsigned xb_add(unsigned* p, unsigned v) { return __hip_atomic_fetch_add(p, v, __ATOMIC_RELAXED, __HIP_MEMORY_SCOPE_AGENT); }
__device__ __forceinline__ unsigned xb_xcc_id() { return (unsigned)__builtin_amdgcn_s_getreg((3 << 11) | 20) & 0xFu; }
#define XB_SPIN(cond, bar) do { unsigned _sp = 0; while (cond) { __builtin_amdgcn_s_sleep(1); \
    if ((++_sp & 255u) == 0u) { if (xb_ld(&(bar)[XB_TMO])) break; if (_sp > XB_SPIN_CAP) { atomicAdd(&(bar)[XB_TMO], 1u); break; } } } } while (0)

struct XcdBarrier {
    unsigned* bar; unsigned x;
    volatile LAS unsigned* st;
};

__device__ __forceinline__ XcdBarrier xcd_barrier_post(unsigned* bar, volatile LAS unsigned* st) {
    XcdBarrier b; b.bar = bar; b.x = xb_xcc_id(); b.st = st;
    if (threadIdx.x == 0) (void)xb_add(&bar[XB_XCNT(b.x)], 1u);
    return b;
}
__device__ __forceinline__ void xcd_barrier_complete(unsigned* bar, unsigned x, unsigned& nloc, unsigned& nx) {
    const unsigned G = gridDim.x * gridDim.y * gridDim.z;
    unsigned sum, cnt, mine, sp = 0u;
    for (;;) {
        sum = 0u; cnt = 0u; mine = 0u;
#pragma unroll
        for (unsigned j = 0; j < 16; ++j) { const unsigned c = xb_ld(&bar[XB_XCNT(j)]); sum += c; cnt += (c > 0u) ? 1u : 0u; mine = (j == x) ? c : mine; }
        if (sum == G) break;
        __builtin_amdgcn_s_sleep(1);
        if ((++sp & 255u) == 0u) { if (xb_ld(&bar[XB_TMO])) break; if (sp > XB_SPIN_CAP) { atomicAdd(&bar[XB_TMO], 1u); break; } }
    }
    nloc = mine > 0u ? mine : 1u; nx = cnt > 0u ? cnt : 1u;
}

__device__ __forceinline__ void xcd_barrier(const XcdBarrier& b) {
    asm volatile("s_waitcnt vmcnt(0)" ::: "memory");
    __syncthreads();
    if (threadIdx.x == 0) {
        unsigned* bar = b.bar;
        __builtin_amdgcn_s_waitcnt(0);
        unsigned nloc = b.st[0], nx = b.st[1];
        if (nloc == 0u) { xcd_barrier_complete(bar, b.x, nloc, nx); b.st[0] = nloc; b.st[1] = nx; }
        const unsigned old = xb_add(&bar[XB_XSUB(b.x)], 1u);
        const unsigned gen = old / nloc;
        if (old + 1u == (gen + 1u) * nloc) {
            __builtin_amdgcn_fence(__ATOMIC_RELEASE, "agent");
            asm volatile("s_waitcnt vmcnt(0)" ::: "memory");
            const unsigned og = xb_add(&bar[XB_TOP], 1u);
            const unsigned tg = og / nx;
            if (og + 1u == (tg + 1u) * nx) xb_add(&bar[XB_TOPGEN], 1u);
            else XB_SPIN(xb_ld(&bar[XB_TOPGEN]) == tg, bar);
            __builtin_amdgcn_fence(__ATOMIC_ACQUIRE, "agent");
            xb_add(&bar[XB_XGEN(b.x)], 1u);
            asm volatile("s_waitcnt vmcnt(0)" ::: "memory");
        } else {
            XB_SPIN(xb_ld(&bar[XB_XGEN(b.x)]) == gen, bar);
            __builtin_amdgcn_fence(__ATOMIC_ACQUIRE, "agent");
            asm volatile("s_waitcnt vmcnt(0)" ::: "memory");
        }
    }
    __syncthreads();
}

struct Bump { char* p; size_t off; float* f(size_t n) { float* r = (float*)(p + off); off += ((n * 4 + 255) / 256) * 256; return r; } };

static size_t setup_ctx(Ctx& c, void* const* d_in, void* d_out, void* d_ws) {
    using namespace cfg;
    for (int i = 0; i < 51; ++i) c.in[i] = (const float*)d_in[i];
    c.page_table = (const int*)d_in[I_PT];
    c.out = (float*)d_out; c.x = c.out;
    Bump b{(char*)d_ws, 4096 * 4};
    const size_t MD = (size_t)MTOT * D;
    c.xn = b.f(MD); c.vf = b.f(MD);
    const size_t base = b.off;
    for (int p = 0; p < 6; ++p) c.xm[p] = b.f(MD);
    c.r = b.f(MD); c.k = b.f(MD); c.v = b.f(MD); c.wpre = b.f(MD); c.apre = b.f(MD); c.vpre = b.f(MD); c.g = b.f(MD);
    c.hw = b.f((size_t)MTOT * RW_DL); c.ha = b.f((size_t)MTOT * RW_AL); c.hv = b.f((size_t)MTOT * RW_VL); c.hg = b.f((size_t)MTOT * RW_GL);
    c.ka = b.f(MD); c.kb = b.f(MD); c.y = c.xm[0]; c.yo = c.xm[1];
    size_t hi = b.off;
    b.off = base;
    c.mh = b.f((size_t)MTOT * MLA_IN); c.qan = b.f((size_t)MTOT * QL); c.q = b.f((size_t)MTOT * MH * QD); c.c = b.f((size_t)MTOT * KVL); c.kp = b.f((size_t)MTOT * ROPE);
    c.knr = b.f((size_t)MTOT * MH * NOPE); c.vv = b.f((size_t)MTOT * MH * VD); c.ao = b.f((size_t)MTOT * MH * VD);
    c.sc = b.f((size_t)DB * MH * DS * KTOT); c.olat = b.f((size_t)DB * MH * DS * KVL);
    if (b.off > hi) hi = b.off;
    b.off = base;
    c.zx = b.f((size_t)MTOT * MB_IN); c.xbc = b.f((size_t)MTOT * MB_CD); c.dt = b.f((size_t)MTOT * MB_HEADS); c.my = b.f((size_t)MTOT * MB_INNER); c.yzn = b.f((size_t)MTOT * MB_INNER);
    if (b.off > hi) hi = b.off;
    b.off = hi;
    c.hmid = b.f((size_t)MTOT * FFN);
    return b.off;
}

__device__ __forceinline__ unsigned tid_now() { unsigned t = threadIdx.x; asm volatile("" : "+v"(t)); return t; }
namespace pg8 {
#define PG8_LAS __attribute__((address_space(3)))
typedef unsigned short bf16_t;
typedef short bf16x8 __attribute__((ext_vector_type(8)));
typedef float f32x4 __attribute__((ext_vector_type(4)));
typedef float f32x2 __attribute__((ext_vector_type(2)));
typedef unsigned u32x4 __attribute__((ext_vector_type(4)));
typedef unsigned u32x2 __attribute__((ext_vector_type(2)));
constexpr int BM = 256, BK = 64, HALF = 128, HTB = HALF * BK * 2  , STAGE_BYTES = 8 * HTB, NXCD = 8, WGM = 8;

__host__ __device__ __forceinline__ int lds_byte(int r, int c) { const int st = (r >> 4) * 2 + (c >> 5), rr = r & 15, cc = c & 31, ob = rr * 64 + cc * 2; return st * 1024 + (ob ^ (((ob >> 9) & 1) << 5)); }
__host__ __device__ __forceinline__ void stage_rc(int b, int& R, int& C) { const int st = b / 1024, sb = b % 1024, swz = sb ^ (((sb >> 9) & 1) << 5); R = (st >> 1) * 16 + swz / 64; C = (st & 1) * 32 + (swz % 64) / 2; }
__host__ __device__ __forceinline__ int perm32(int rho) { const int n = rho >> 4, i = rho & 15; return 8 * (i >> 2) + 4 * n + (i & 3); }
__device__ __forceinline__ unsigned cvt_pk_bf16(float lo, float hi) { unsigned r; asm volatile("v_cvt_pk_bf16_f32 %0, %1, %2" : "=v"(r) : "v"(lo), "v"(hi)); return r; }

struct Unit { int pm, pn, k0, nt, asel, part; };
struct Gemm { const bf16_t* A; const bf16_t* Bt; int lda, ldb; size_t asel_stride; };

struct NoSel { __device__ static __forceinline__ int sel(int) { return 0; } };
template <class ASEL = NoSel>
struct Order {
    int nMp, nMs, nN, nwgP, nwgS, G, c, K, ksplit;
    __device__ __forceinline__ void init(int nMp_, int nMs_, int nN_, int K_, int ksplit_, int G_, int c_) { nMp = nMp_; nMs = nMs_; nN = nN_; nwgP = nMp * nN; K = K_; ksplit = ksplit_; nwgS = nMs * nN * ksplit; G = G_; c = c_; }
    __device__ __forceinline__ bool next(int i, Unit& u) const {
        const long L = (long)i * G + c;
        if (L < nwgP) {
            int wgid = (int)L; { const int q = nwgP / NXCD, r = nwgP % NXCD, xcd = wgid % NXCD, off = wgid / NXCD; wgid = (xcd < r ? xcd * (q + 1) : r * (q + 1) + (xcd - r) * q) + off; }
            const int nig = WGM * nN, gid = wgid / nig, fm = gid * WGM, gsz = (nMp - fm) < WGM ? (nMp - fm) : WGM;
            u.pm = fm + ((wgid % nig) % gsz); u.pn = (wgid % nig) / gsz; u.k0 = 0; u.nt = K / BK; u.part = 0; u.asel = ASEL::sel(u.pn); return true;
        }
        const long Ls = L - nwgP; if (Ls >= nwgS) return false;
        const int sub = (int)(Ls % ksplit), t = (int)(Ls / ksplit);
        u.pm = nMp + t % nMs; u.pn = t / nMs; u.nt = K / BK / ksplit; u.k0 = sub * u.nt * BK; u.part = ksplit > 1 ? 1 : 0; u.asel = ASEL::sel(u.pn); return true;
    }
};

template <class Epi, class Sched>
__device__ __forceinline__ void gemm_phase(PG8_LAS unsigned char* lds, const Gemm g, const Sched& S, const Epi& E) {
    const int tid = (int)tid_now(), wid = __builtin_amdgcn_readfirstlane(tid >> 6), lane = tid & 63, wr = wid >> 2, wc = wid & 3, fr = lane & 15, fq = lane >> 4;
    unsigned voffA[2], voffB[2];
#pragma unroll
    for (int i = 0; i < 2; ++i) { int R, C; stage_rc(tid * 16 + i * 8192, R, C); const int Rb = Epi::PERM ? ((R & ~31) + perm32(R & 31)) : R;
        voffA[i] = (unsigned)(R * g.lda + C) * 2u; voffB[i] = (unsigned)(Rb * g.ldb + C) * 2u; }
    const size_t kstep = (size_t)(BK * 2);
    const size_t hstepA = (size_t)HALF * g.lda * 2, hstepB = (size_t)HALF * g.ldb * 2;
    const unsigned ldsw = (unsigned)wid * 1024u;
    const int aoff = lds_byte(wr * 64 + fr, fq * 8), boff = lds_byte(wc * 32 + fr, fq * 8);
#define PG8_SA(b, h) (((b) * 2 + (h)) * HTB)
#define PG8_SB(b, h) ((4 + (b) * 2 + (h)) * HTB)
#define PG8_STAGE(bufoff, gbase, voff) do { _Pragma("unroll") for (int _i = 0; _i < 2; ++_i) \
        __builtin_amdgcn_global_load_lds((const unsigned*)((const char*)(gbase) + (voff)[_i]), (PG8_LAS unsigned*)(lds + (bufoff) + ldsw + _i * 8192), 16, 0, 0); } while (0)
#define PG8_LDA(dst, b, h) do { _Pragma("unroll") for (int m = 0; m < 4; ++m) _Pragma("unroll") for (int k = 0; k < 2; ++k) dst[m][k] = *(const PG8_LAS bf16x8*)(lds + PG8_SA(b, h) + aoff + m * 2048 + k * 1024); } while (0)
#define PG8_LDB(dst, b, h) do { _Pragma("unroll") for (int n = 0; n < 2; ++n) _Pragma("unroll") for (int k = 0; k < 2; ++k) dst[n][k] = *(const PG8_LAS bf16x8*)(lds + PG8_SB(b, h) + boff + n * 2048 + k * 1024); } while (0)
#define PG8_MMA(ai, bj, At, Bt) do { __builtin_amdgcn_s_setprio(1); _Pragma("unroll") for (int m = 0; m < 4; ++m) _Pragma("unroll") for (int n = 0; n < 2; ++n) _Pragma("unroll") for (int k = 0; k < 2; ++k) \
        acc[ai][bj][m][n] = __builtin_amdgcn_mfma_f32_16x16x32_bf16(Bt[n][k], At[m][k], acc[ai][bj][m][n], 0, 0, 0); __builtin_amdgcn_s_setprio(0); } while (0)
#define PG8_WAIT_V(n) asm volatile("s_waitcnt vmcnt(" #n ")" ::: "memory")
#define PG8_WAIT_L(n) asm volatile("s_waitcnt lgkmcnt(" #n ")" ::: "memory")
#define PG8_BAR __builtin_amdgcn_s_barrier()
#define PG8_SCHED __builtin_amdgcn_sched_barrier(0)
#define PG8_ABASE(u) ((const char*)g.A + ((size_t)(u).asel * g.asel_stride + (size_t)(u).pm * BM * g.lda + (u).k0) * 2)
#define PG8_BBASE(u) ((const char*)g.Bt + ((size_t)(u).pn * BM * g.ldb + (u).k0) * 2)
    Unit cur, nxt; int ui = 0;
    if (!S.next(0, cur)) return;
    f32x4 acc[2][2][4][2];
#pragma unroll
    for (int a = 0; a < 2; ++a)
#pragma unroll
        for (int b = 0; b < 2; ++b)
#pragma unroll
            for (int m = 0; m < 4; ++m)
#pragma unroll
                for (int n = 0; n < 2; ++n) acc[a][b][m][n] = (f32x4){0.f, 0.f, 0.f, 0.f};
    bf16x8 At[4][2], B0[2][2], B1[2][2];
    const char* cA = PG8_ABASE(cur); const char* cB = PG8_BBASE(cur);
    PG8_STAGE(PG8_SB(0, 0), cB, voffB); PG8_STAGE(PG8_SA(0, 0), cA, voffA); PG8_STAGE(PG8_SB(0, 1), cB + hstepB, voffB); PG8_STAGE(PG8_SA(0, 1), cA + hstepA, voffA);
    if (wr == 1) PG8_BAR;
    PG8_WAIT_V(4); PG8_BAR;
    PG8_STAGE(PG8_SB(1, 0), cB + kstep, voffB); PG8_STAGE(PG8_SA(1, 0), cA + kstep, voffA); PG8_STAGE(PG8_SB(1, 1), cB + hstepB + kstep, voffB);
    PG8_WAIT_V(6); PG8_BAR;
    for (;;) {
        const bool has_next = S.next(ui + 1, nxt);
        const char* nA = has_next ? PG8_ABASE(nxt) : cA; const char* nB = has_next ? PG8_BBASE(nxt) : cB;
        const int nt = cur.nt;
        for (int t = 0; t < nt; t += 2) {
            const bool last = (t == nt - 2);
            const char* a1 = cA + (size_t)(t + 1) * kstep;
            const char* a2 = last ? nA : cA + (size_t)(t + 2) * kstep; const char* b2 = last ? nB : cB + (size_t)(t + 2) * kstep;
            const char* a3 = a2 + kstep; const char* b3 = b2 + kstep;
            PG8_LDB(B0, 0, 0); PG8_SCHED; PG8_LDA(At, 0, 0); PG8_STAGE(PG8_SA(1, 1), a1 + hstepA, voffA);
            PG8_WAIT_L(8); PG8_BAR; PG8_WAIT_L(0); PG8_MMA(0, 0, At, B0); PG8_BAR; PG8_SCHED;
            PG8_LDB(B1, 0, 1); PG8_STAGE(PG8_SB(0, 0), b2, voffB);
            PG8_BAR; PG8_WAIT_L(0); PG8_MMA(0, 1, At, B1); PG8_BAR;
            PG8_LDA(At, 0, 1); PG8_STAGE(PG8_SA(0, 0), a2, voffA);
            PG8_BAR; PG8_WAIT_L(0); PG8_MMA(1, 0, At, B0); PG8_BAR; PG8_SCHED;
            PG8_STAGE(PG8_SB(0, 1), b2 + hstepB, voffB);
            PG8_WAIT_V(6); PG8_BAR; PG8_MMA(1, 1, At, B1); PG8_BAR;
            PG8_LDB(B0, 1, 0); PG8_SCHED; PG8_LDA(At, 1, 0); PG8_STAGE(PG8_SA(0, 1), a2 + hstepA, voffA);
            PG8_WAIT_L(8); PG8_BAR; PG8_WAIT_L(0); PG8_MMA(0, 0, At, B0); PG8_BAR; PG8_SCHED;
            PG8_LDB(B1, 1, 1); PG8_STAGE(PG8_SB(1, 0), b3, voffB);
            PG8_BAR; PG8_WAIT_L(0); PG8_MMA(0, 1, At, B1); PG8_BAR;
            PG8_LDA(At, 1, 1); PG8_STAGE(PG8_SA(1, 0), a3, voffA);
            PG8_BAR; PG8_WAIT_L(0); PG8_MMA(1, 0, At, B0); PG8_BAR; PG8_SCHED;
            PG8_STAGE(PG8_SB(1, 1), b3 + hstepB, voffB);
            PG8_WAIT_V(6); PG8_BAR; PG8_MMA(1, 1, At, B1); PG8_BAR;
        }
        E(acc, cur, wr, wc, fr, fq);
        if (!has_next) break;
#pragma unroll
        for (int a = 0; a < 2; ++a)
#pragma unroll
            for (int b = 0; b < 2; ++b)
#pragma unroll
                for (int m = 0; m < 4; ++m)
#pragma unroll
                    for (int n = 0; n < 2; ++n) acc[a][b][m][n] = (f32x4){0.f, 0.f, 0.f, 0.f};
        cur = nxt; cA = nA; cB = nB; ++ui;
    }
    PG8_WAIT_V(0);
    if (wr == 0) PG8_BAR;
    PG8_BAR;
#undef PG8_SA
#undef PG8_SB
#undef PG8_STAGE
#undef PG8_LDA
#undef PG8_LDB
#undef PG8_MMA
#undef PG8_WAIT_V
#undef PG8_WAIT_L
#undef PG8_BAR
#undef PG8_SCHED
#undef PG8_ABASE
#undef PG8_BBASE
}

struct EpiAccF32 {
    static constexpr bool PERM = false;
    float* C; int ldc; float* slab; int pm0, nMs, ksplit;
    __device__ __forceinline__ void operator()(const f32x4 (&acc)[2][2][4][2], const Unit& u, int wr, int wc, int fr, int fq) const {
        if (u.part) {
            float* sl = slab + ((size_t)((u.pn * nMs + (u.pm - pm0)) * ksplit + u.k0 / (u.nt * BK)) * BM + wr * 64 + fr) * BM + wc * 32 + 4 * fq;
#pragma unroll
            for (int ai = 0; ai < 2; ++ai)
#pragma unroll
                for (int m = 0; m < 4; ++m) { float* rowp = sl + (size_t)(ai * HALF + m * 16) * BM;
#pragma unroll
                    for (int bj = 0; bj < 2; ++bj)
#pragma unroll
                        for (int n = 0; n < 2; ++n) *(f32x4*)(rowp + bj * HALF + n * 16) = acc[ai][bj][m][n]; }
        } else {
            const int row0 = u.pm * BM + wr * 64 + fr, col0 = u.pn * BM + wc * 32 + 4 * fq;
#pragma unroll
            for (int ai = 0; ai < 2; ++ai)
#pragma unroll
                for (int m2 = 0; m2 < 4; m2 += 2) {
                    f32x4 t[2][2][2];
#pragma unroll
                    for (int mm = 0; mm < 2; ++mm) { const float* rowp = C + (size_t)(row0 + ai * HALF + (m2 + mm) * 16) * ldc + col0;
#pragma unroll
                        for (int bj = 0; bj < 2; ++bj)
#pragma unroll
                            for (int n = 0; n < 2; ++n) t[mm][bj][n] = *(const f32x4*)(rowp + bj * HALF + n * 16); }
#pragma unroll
                    for (int mm = 0; mm < 2; ++mm) { float* rowp = C + (size_t)(row0 + ai * HALF + (m2 + mm) * 16) * ldc + col0;
#pragma unroll
                        for (int bj = 0; bj < 2; ++bj)
#pragma unroll
                            for (int n = 0; n < 2; ++n) *(f32x4*)(rowp + bj * HALF + n * 16) = t[mm][bj][n] + acc[ai][bj][m2 + mm][n]; }
                }
        }
    }
};
struct EpiF32 {
    static constexpr bool PERM = false;
    float* C; int ldc; int ncols;
    __device__ __forceinline__ void operator()(const f32x4 (&acc)[2][2][4][2], const Unit& u, int wr, int wc, int fr, int fq) const {
        const int row0 = u.pm * BM + wr * 64 + fr, col0 = u.pn * BM + wc * 32 + 4 * fq;
#pragma unroll
        for (int ai = 0; ai < 2; ++ai)
#pragma unroll
            for (int m = 0; m < 4; ++m) { float* rowp = C + (size_t)(row0 + ai * HALF + m * 16) * ldc + col0;
#pragma unroll
                for (int bj = 0; bj < 2; ++bj)
#pragma unroll
                    for (int n = 0; n < 2; ++n) if (col0 + bj * HALF + n * 16 < ncols) *(f32x4*)(rowp + bj * HALF + n * 16) = acc[ai][bj][m][n]; }
    }
};
template <int ACT> struct EpiBf16 {
    static constexpr bool PERM = true;
    bf16_t* O; int ldc;
    __device__ __forceinline__ void operator()(const f32x4 (&acc)[2][2][4][2], const Unit& u, int wr, int wc, int fr, int fq) const {
        const int row0 = u.pm * BM + wr * 64 + fr, col0 = u.pn * BM + wc * 32 + 8 * fq;
#pragma unroll
        for (int ai = 0; ai < 2; ++ai)
#pragma unroll
            for (int m = 0; m < 4; ++m) { bf16_t* rowp = O + (size_t)(row0 + ai * HALF + m * 16) * ldc + col0;
#pragma unroll
                for (int bj = 0; bj < 2; ++bj) { f32x4 v0 = acc[ai][bj][m][0], v1 = acc[ai][bj][m][1];
                    if (ACT == 3) {
#pragma unroll
                        for (int j = 0; j < 4; ++j) { const float a = fmaxf(v0[j], 0.f), b = fmaxf(v1[j], 0.f); v0[j] = a * a; v1[j] = b * b; } }
                    u32x4 w; w.x = cvt_pk_bf16(v0[0], v0[1]); w.y = cvt_pk_bf16(v0[2], v0[3]); w.z = cvt_pk_bf16(v1[0], v1[1]); w.w = cvt_pk_bf16(v1[2], v1[3]);
                    *(u32x4*)(rowp + bj * HALF) = w; } }
    }
};
}
typedef pg8::bf16_t bf16_t;
#define LDSP __attribute__((address_space(3)))
struct Fast {
    bf16_t *xnb, *hmidb;
    bf16_t *w1t, *w2t;
    float* slab;
};
__device__ __forceinline__ unsigned pk2bf(float lo, float hi) { return pg8::cvt_pk_bf16(lo, hi); }
__device__ __forceinline__ float wave_sum64(float v) {
#pragma unroll
    for (int o = 1; o < 64; o <<= 1) v += __shfl_xor(v, o);
    return v;
}
__device__ __forceinline__ void red16x4(float& a, float& b, float& c, float& d) {
    asm volatile("s_nop 1\n"
        "v_add_f32_dpp %0, %0, %0 quad_perm:[1,0,3,2] row_mask:0xf bank_mask:0xf\n" "v_add_f32_dpp %1, %1, %1 quad_perm:[1,0,3,2] row_mask:0xf bank_mask:0xf\n"
        "v_add_f32_dpp %2, %2, %2 quad_perm:[1,0,3,2] row_mask:0xf bank_mask:0xf\n" "v_add_f32_dpp %3, %3, %3 quad_perm:[1,0,3,2] row_mask:0xf bank_mask:0xf\n"
        "v_add_f32_dpp %0, %0, %0 quad_perm:[2,3,0,1] row_mask:0xf bank_mask:0xf\n" "v_add_f32_dpp %1, %1, %1 quad_perm:[2,3,0,1] row_mask:0xf bank_mask:0xf\n"
        "v_add_f32_dpp %2, %2, %2 quad_perm:[2,3,0,1] row_mask:0xf bank_mask:0xf\n" "v_add_f32_dpp %3, %3, %3 quad_perm:[2,3,0,1] row_mask:0xf bank_mask:0xf\n"
        "v_add_f32_dpp %0, %0, %0 row_ror:4 row_mask:0xf bank_mask:0xf\n" "v_add_f32_dpp %1, %1, %1 row_ror:4 row_mask:0xf bank_mask:0xf\n"
        "v_add_f32_dpp %2, %2, %2 row_ror:4 row_mask:0xf bank_mask:0xf\n" "v_add_f32_dpp %3, %3, %3 row_ror:4 row_mask:0xf bank_mask:0xf\n"
        "v_add_f32_dpp %0, %0, %0 row_ror:8 row_mask:0xf bank_mask:0xf\n" "v_add_f32_dpp %1, %1, %1 row_ror:8 row_mask:0xf bank_mask:0xf\n"
        "v_add_f32_dpp %2, %2, %2 row_ror:8 row_mask:0xf bank_mask:0xf\n" "v_add_f32_dpp %3, %3, %3 row_ror:8 row_mask:0xf bank_mask:0xf\n"
        "s_nop 1"
        : "+v"(a), "+v"(b), "+v"(c), "+v"(d));
}
__device__ __forceinline__ void tr_item(const float* __restrict__ W, int ldw, int K, bf16_t* WT, int nvalid, const float* __restrict__ kscale, LDSP float* scr, int item, int nblk, int lane) {
    const int kb = item / nblk, nb = item % nblk, k0 = 64 * kb, n0 = 32 * nb;
    const bool ok = n0 < nvalid;
#pragma unroll
    for (int i = 0; i < 8; ++i) { const int kk = 8 * i + (lane >> 3), nn = 4 * (lane & 7); pg8::f32x4 v = ok ? *(const pg8::f32x4*)(W + (size_t)(k0 + kk) * ldw + n0 + nn) : (pg8::f32x4){0.f, 0.f, 0.f, 0.f};
        if (kscale) v = v * kscale[k0 + kk];
        scr[kk * 33 + nn] = v[0]; scr[kk * 33 + nn + 1] = v[1]; scr[kk * 33 + nn + 2] = v[2]; scr[kk * 33 + nn + 3] = v[3]; }
    asm volatile("s_waitcnt lgkmcnt(0)" ::: "memory");
    const int c = lane & 7;
#pragma unroll
    for (int j = 0; j < 4; ++j) { const int n = (lane >> 3) + 8 * j; const LDSP float* s = scr + (8 * c) * 33 + n;
        pg8::u32x4 o; o.x = pk2bf(s[0 * 33], s[1 * 33]); o.y = pk2bf(s[2 * 33], s[3 * 33]); o.z = pk2bf(s[4 * 33], s[5 * 33]); o.w = pk2bf(s[6 * 33], s[7 * 33]);
        *(pg8::u32x4*)(WT + (size_t)(n0 + n) * K + k0 + 8 * c) = o; }
    asm volatile("s_waitcnt lgkmcnt(0)" ::: "memory");
}
__device__ __forceinline__ void tr_weight(const float* W, int K, int N, int npad, bf16_t* WT, const float* kscale, LDSP float* scr, int gw, int ngw, int lane) {
    const int nblk = npad / 32, items = (K / 64) * nblk;
    for (int it = gw; it < items; it += ngw) tr_item(W, N, K, WT, N, kscale, scr, it, nblk, lane);
}
constexpr int TRJ_W = 12;
struct TrTab { LDSP int* t; int n; int total; };
__device__ __forceinline__ void trj_put(TrTab& tb, const float* W, int K, int N, int npad, bf16_t* WT) {
    LDSP int* e = tb.t + tb.n * TRJ_W; const unsigned long long w = (unsigned long long)(size_t)W, o = (unsigned long long)(size_t)WT;
    const int nblk = npad / 32, items = (K / 64) * nblk;
    e[0] = (int)(unsigned)w; e[1] = (int)(unsigned)(w >> 32); e[2] = (int)(unsigned)o; e[3] = (int)(unsigned)(o >> 32); e[4] = N; e[5] = K; e[6] = N; e[7] = nblk; e[8] = tb.total; e[9] = tb.total + items;
    tb.total += items; ++tb.n;
}
struct TrCur { bf16_t* wt; int K, k0, n0; };
__device__ __forceinline__ bool trj_issue(LDSP const int* tab, int njobs, int idx, int& j, pg8::f32x4 (&v)[8], TrCur& t, int lane) {
    while (j < njobs && idx >= __builtin_amdgcn_readfirstlane(tab[j * TRJ_W + 9])) ++j;
    if (j >= njobs) return false;
    LDSP const int* e = tab + j * TRJ_W;
    const unsigned wl = __builtin_amdgcn_readfirstlane(e[0]), wh = __builtin_amdgcn_readfirstlane(e[1]), ol = __builtin_amdgcn_readfirstlane(e[2]), oh = __builtin_amdgcn_readfirstlane(e[3]);
    const int ldw = __builtin_amdgcn_readfirstlane(e[4]), K = __builtin_amdgcn_readfirstlane(e[5]), nvalid = __builtin_amdgcn_readfirstlane(e[6]), nblk = __builtin_amdgcn_readfirstlane(e[7]), it = idx - __builtin_amdgcn_readfirstlane(e[8]);
    const float* W = (const float*)(size_t)(((unsigned long long)wh << 32) | wl);
    const int kb = it / nblk, nb = it - kb * nblk, k0 = 64 * kb, n0 = 32 * nb;
    t.wt = (bf16_t*)(size_t)(((unsigned long long)oh << 32) | ol); t.K = K; t.k0 = k0; t.n0 = n0;
    const bool ok = n0 < nvalid;
#pragma unroll
    for (int i = 0; i < 8; ++i) { const int kk = 8 * i + (lane >> 3), nn = 4 * (lane & 7); v[i] = ok ? *(const pg8::f32x4*)(W + (size_t)(k0 + kk) * ldw + n0 + nn) : (pg8::f32x4){0.f, 0.f, 0.f, 0.f}; }
    return true;
}
__device__ __forceinline__ void trj_finish(const pg8::f32x4 (&v)[8], const TrCur& t, LDSP float* scr, int lane) {
#pragma unroll
    for (int i = 0; i < 8; ++i) { const int kk = 8 * i + (lane >> 3), nn = 4 * (lane & 7);
        scr[kk * 33 + nn] = v[i][0]; scr[kk * 33 + nn + 1] = v[i][1]; scr[kk * 33 + nn + 2] = v[i][2]; scr[kk * 33 + nn + 3] = v[i][3]; }
    asm volatile("s_waitcnt lgkmcnt(0)" ::: "memory");
    const int c = lane & 7;
#pragma unroll
    for (int j = 0; j < 4; ++j) { const int n = (lane >> 3) + 8 * j; const LDSP float* s = scr + (8 * c) * 33 + n;
        pg8::u32x4 o; o.x = pk2bf(s[0 * 33], s[1 * 33]); o.y = pk2bf(s[2 * 33], s[3 * 33]); o.z = pk2bf(s[4 * 33], s[5 * 33]); o.w = pk2bf(s[6 * 33], s[7 * 33]);
        *(pg8::u32x4*)(t.wt + (size_t)(t.n0 + n) * t.K + t.k0 + 8 * c) = o; }
    asm volatile("s_waitcnt lgkmcnt(0)" ::: "memory");
}
__device__ __forceinline__ void trj_run(LDSP const int* tab, int njobs, int total, LDSP float* scr, int gw, int ngw, int lane) {
    int j = 0; pg8::f32x4 va[8], vb[8]; TrCur ta, tb;
    int idx = gw;
    bool have = idx < total && trj_issue(tab, njobs, idx, j, va, ta, lane);
    while (have) {
        idx += ngw; const bool hb = idx < total && trj_issue(tab, njobs, idx, j, vb, tb, lane);
        trj_finish(va, ta, scr, lane);
        if (!hb) break;
        idx += ngw; have = idx < total && trj_issue(tab, njobs, idx, j, va, ta, lane);
        trj_finish(vb, tb, scr, lane);
    }
}
__device__ __forceinline__ pg8::f32x4 slab_sum(const float* __restrict__ slab, int ksplit, int m, int q, int lane) {
    using namespace cfg; const int rs = m - MP, pms = rs >> 8, row = rs & 255;
    const float* p = slab + ((size_t)((q * (MS / 256) + pms) * ksplit) * 256 + row) * 256 + 4 * lane;
    pg8::f32x4 s = {0.f, 0.f, 0.f, 0.f};
    for (int k = 0; k < ksplit; ++k) s = s + *(const pg8::f32x4*)(p + (size_t)k * 65536);
    return s;
}
__device__ __forceinline__ void norm_rows_bf16(float* __restrict__ x, const float* __restrict__ gain, bf16_t* xn, const float* __restrict__ slab, int ksplit, int gw, int ngw, int lane) {
    using namespace cfg;
    pg8::f32x4 gv[4];
#pragma unroll
    for (int j = 0; j < 4; ++j) gv[j] = *(const pg8::f32x4*)(gain + 4 * lane + 256 * j);
    for (int m = gw; m < MTOT; m += ngw) {
        float* xr = x + (size_t)m * D; pg8::f32x4 v[4]; float s = 0.f;
#pragma unroll
        for (int j = 0; j < 4; ++j) { v[j] = *(const pg8::f32x4*)(xr + 4 * lane + 256 * j);
            if (ksplit > 1 && m >= MP) { v[j] = v[j] + slab_sum(slab, ksplit, m, j, lane); *(pg8::f32x4*)(xr + 4 * lane + 256 * j) = v[j]; }
            s += (v[j][0] * v[j][0] + v[j][1] * v[j][1]) + (v[j][2] * v[j][2] + v[j][3] * v[j][3]); }
        const float rs = 1.0f / sqrtf(wave_sum64(s) * (1.0f / D) + NORM_EPS);
#pragma unroll
        for (int j = 0; j < 4; ++j) { pg8::u32x2 o; o.x = pk2bf(v[j][0] * rs * gv[j][0], v[j][1] * rs * gv[j][1]); o.y = pk2bf(v[j][2] * rs * gv[j][2], v[j][3] * rs * gv[j][3]);
            *(pg8::u32x2*)(xn + (size_t)m * D + 4 * lane + 256 * j) = o; }
    }
}

__device__ __forceinline__ void fold_sample_rows(float* __restrict__ x, const float* __restrict__ slab, int ksplit, int gw, int ngw, int lane) {
    using namespace cfg;
    for (int m = MP + gw; m < MTOT; m += ngw) {
#pragma unroll
        for (int j = 0; j < 4; ++j) { float* p = x + (size_t)m * D + 4 * lane + 256 * j; *(pg8::f32x4*)p = *(const pg8::f32x4*)p + slab_sum(slab, ksplit, m, j, lane); }
    }
}
struct FastMla {
    float* mh;
    bf16_t *qan, *cb, *kpb;
    bf16_t *qraw, *kvraw;
    bf16_t *qf, *knb, *aob, *vT, *qs;
    float *opart, *lpart;
    bf16_t *wint, *wuqt, *wukvt, *wot;
};
__device__ __forceinline__ void rope_cs(int pos, int i, float& cs, float& sn) {
    const float inv = exp2f(-(float)i * (13.287712379549449f / 16.0f));
    const float ang = (float)pos * inv, kq = rintf(ang * 0.15915494309189535f);
    float rr = fmaf(-kq, 6.28125f, ang); rr = fmaf(-kq, 1.9353071795864769e-3f, rr);
    cs = __cosf(rr); sn = __sinf(rr);
}
__device__ __forceinline__ float rope_inv(int i) { return exp2f(-(float)i * (13.287712379549449f / 16.0f)); }
__device__ __forceinline__ void rope_cs_inv(int pos, float inv, float& cs, float& sn) {
    const float ang = (float)pos * inv, kq = rintf(ang * 0.15915494309189535f);
    float rr = fmaf(-kq, 6.28125f, ang); rr = fmaf(-kq, 1.9353071795864769e-3f, rr);
    cs = __cosf(rr); sn = __sinf(rr);
}
__device__ __forceinline__ float bf2f(unsigned short b) { return __uint_as_float(((unsigned)b) << 16); }
__device__ __forceinline__ void mla_norm1_fast(const Ctx& c, const FastMla& fm, int j, int gw, int ngw, int lane) {
    using namespace cfg;
    const pg8::f32x4 gq0 = *(const pg8::f32x4*)(c.in[I_QNORM] + j * QL + 4 * lane), gq1 = *(const pg8::f32x4*)(c.in[I_QNORM] + j * QL + 4 * lane + 256), gc = *(const pg8::f32x4*)(c.in[I_KVNORM] + j * KVL + 4 * lane);
    const float gkr = lane < ROPE ? c.in[I_KRN][j * ROPE + lane] : 0.f;
    const float rinv1 = rope_inv(lane & 15);
    for (int m = gw; m < MTOT; m += ngw) {
        const float* h = fm.mh + (size_t)m * 1024;
        pg8::f32x4 qv[2]; float s = 0.f;
#pragma unroll
        for (int t = 0; t < 2; ++t) { qv[t] = *(const pg8::f32x4*)(h + 4 * lane + 256 * t); s += (qv[t][0] * qv[t][0] + qv[t][1] * qv[t][1]) + (qv[t][2] * qv[t][2] + qv[t][3] * qv[t][3]); }
        const float rq = 1.0f / sqrtf(wave_sum64(s) * (1.0f / QL) + NORM_EPS);
#pragma unroll
        for (int t = 0; t < 2; ++t) { const pg8::f32x4 g = t ? gq1 : gq0;
            pg8::u32x2 o; o.x = pk2bf(qv[t][0] * rq * g[0], qv[t][1] * rq * g[1]); o.y = pk2bf(qv[t][2] * rq * g[2], qv[t][3] * rq * g[3]);
            *(pg8::u32x2*)(fm.qan + (size_t)m * QL + 4 * lane + 256 * t) = o; }
        const pg8::f32x4 cv = *(const pg8::f32x4*)(h + QL + 4 * lane);
        const float rc = 1.0f / sqrtf(wave_sum64((cv[0] * cv[0] + cv[1] * cv[1]) + (cv[2] * cv[2] + cv[3] * cv[3])) * (1.0f / KVL) + NORM_EPS);
        const pg8::f32x4 cn = {cv[0] * rc * gc[0], cv[1] * rc * gc[1], cv[2] * rc * gc[2], cv[3] * rc * gc[3]};
        float* co = m < MP ? c.out + O_CKVP + ((size_t)j * MP + m) * KVL : c.out + O_CKVS + ((size_t)j * MS + (m - MP)) * KVL;
        *(pg8::f32x4*)(co + 4 * lane) = cn;
        { pg8::u32x2 o; o.x = pk2bf(cn[0], cn[1]); o.y = pk2bf(cn[2], cn[3]); *(pg8::u32x2*)(fm.cb + (size_t)m * KVL + 4 * lane) = o; }
        const float kv = lane < ROPE ? h[QL + KVL + lane] : 0.f;
        const float rk = 1.0f / sqrtf(wave_sum64(kv * kv) * (1.0f / ROPE) + NORM_EPS);
        const float kn = kv * rk * gkr;
        const float other = __shfl_xor(kn, 16);
        float cs, sn; rope_cs_inv(row_pos(m), rinv1, cs, sn);
        const float ro = lane < 16 ? kn * cs - other * sn : kn * cs + other * sn;
        if (lane < ROPE) {
            float* ko = m < MP ? c.out + O_KPEP + ((size_t)j * MP + m) * ROPE : c.out + O_KPES + ((size_t)j * MS + (m - MP)) * ROPE;
            ko[lane] = ro;
            fm.kpb[(size_t)m * ROPE + lane] = (bf16_t)(pk2bf(ro, 0.f) & 0xffffu);
        }
    }
}
__device__ __forceinline__ void mla_norm2_fast(const Ctx& c, const FastMla& fm, int j, int gw, int ngw, int lane) {
    using namespace cfg;
    const int hd = lane >> 2, qt = lane & 3;
    const float QSC = 0.10206207261596575f * 1.4426950408889634f;
    float gqn[16], gkn[16], gqr[8];
    { const float* pq = c.in[I_QNN] + j * NOPE + 16 * qt; const float* pk = c.in[I_KNN] + j * NOPE + 16 * qt; const float* pr = c.in[I_QRN] + j * ROPE + 8 * qt;
#pragma unroll
      for (int i4 = 0; i4 < 4; ++i4) { const pg8::f32x4 a = *(const pg8::f32x4*)(pq + 4 * i4), b = *(const pg8::f32x4*)(pk + 4 * i4);
#pragma unroll
          for (int e = 0; e < 4; ++e) { gqn[4 * i4 + e] = a[e]; gkn[4 * i4 + e] = b[e]; } }
#pragma unroll
      for (int i4 = 0; i4 < 2; ++i4) { const pg8::f32x4 a = *(const pg8::f32x4*)(pr + 4 * i4);
#pragma unroll
          for (int e = 0; e < 4; ++e) gqr[4 * i4 + e] = a[e]; } }
    float rinv[8];
#pragma unroll
    for (int i = 0; i < 8; ++i) rinv[i] = rope_inv((8 * qt + i) & 15);
    for (int m = gw; m < MTOT; m += ngw) {
        const bf16_t* qr = fm.qraw + (size_t)m * (MH * QD) + hd * QD;
        float v[16]; float s = 0.f;
        { const pg8::u32x4 a = *(const pg8::u32x4*)(qr + 16 * qt), b = *(const pg8::u32x4*)(qr + 16 * qt + 8); const unsigned w[8] = {a.x, a.y, a.z, a.w, b.x, b.y, b.z, b.w};
#pragma unroll
          for (int i = 0; i < 8; ++i) { v[2 * i] = __uint_as_float(w[i] << 16); v[2 * i + 1] = __uint_as_float(w[i] & 0xffff0000u); } }
#pragma unroll
        for (int i = 0; i < 16; ++i) s += v[i] * v[i];
        s += __shfl_xor(s, 1); s += __shfl_xor(s, 2);
        float rs = 1.0f / sqrtf(s * (1.0f / NOPE) + NORM_EPS);
        bf16_t* qo = fm.qf + (size_t)m * (MH * QD) + hd * QD;
        { unsigned w[8], w2[8];
#pragma unroll
          for (int i = 0; i < 8; ++i) { const float a = v[2 * i] * rs * gqn[2 * i], b = v[2 * i + 1] * rs * gqn[2 * i + 1];
              w[i] = pk2bf(a * QSC, b * QSC);
              w2[i] = pk2bf(a * QSC * gkn[2 * i], b * QSC * gkn[2 * i + 1]); }
          *(pg8::u32x4*)(qo + 16 * qt) = (pg8::u32x4){w[0], w[1], w[2], w[3]}; *(pg8::u32x4*)(qo + 16 * qt + 8) = (pg8::u32x4){w[4], w[5], w[6], w[7]};
          if (m >= MP) { bf16_t* q2 = fm.qs + ((size_t)(((m - MP) >> 3) * MH + hd) * 6 + qt) * 128 + ((m - MP) & 7) * 8;
              *(pg8::u32x4*)(q2) = (pg8::u32x4){w2[0], w2[1], w2[4], w2[5]}; *(pg8::u32x4*)(q2 + 64) = (pg8::u32x4){w2[2], w2[3], w2[6], w2[7]}; } }
        float r8[8]; s = 0.f;
        { const pg8::u32x4 a = *(const pg8::u32x4*)(qr + NOPE + 8 * qt); const unsigned w[4] = {a.x, a.y, a.z, a.w};
#pragma unroll
          for (int i = 0; i < 4; ++i) { r8[2 * i] = __uint_as_float(w[i] << 16); r8[2 * i + 1] = __uint_as_float(w[i] & 0xffff0000u); } }
#pragma unroll
        for (int i = 0; i < 8; ++i) s += r8[i] * r8[i];
        s += __shfl_xor(s, 1); s += __shfl_xor(s, 2);
        rs = 1.0f / sqrtf(s * (1.0f / ROPE) + NORM_EPS);
        { unsigned w[4]; float o8[8];
#pragma unroll
          for (int i = 0; i < 8; ++i) { const float mine = r8[i] * rs * gqr[i]; const float oth = __shfl_xor(mine, 2);
              float cs, sn; rope_cs_inv(row_pos(m), rinv[i], cs, sn);
              o8[i] = qt < 2 ? mine * cs - oth * sn : mine * cs + oth * sn; }
#pragma unroll
          for (int i = 0; i < 4; ++i) w[i] = pk2bf(o8[2 * i] * QSC, o8[2 * i + 1] * QSC);
          *(pg8::u32x4*)(qo + NOPE + 8 * qt) = (pg8::u32x4){w[0], w[1], w[2], w[3]};
          if (m >= MP) *(pg8::u32x4*)(fm.qs + ((size_t)(((m - MP) >> 3) * MH + hd) * 6 + 4 + (qt >> 1)) * 128 + (qt & 1) * 64 + ((m - MP) & 7) * 8) = (pg8::u32x4){w[0], w[1], w[2], w[3]}; }
        const bf16_t* kr = fm.kvraw + (size_t)m * 2048 + hd * NOPE; s = 0.f;
        { const pg8::u32x4 a = *(const pg8::u32x4*)(kr + 16 * qt), b = *(const pg8::u32x4*)(kr + 16 * qt + 8); const unsigned w[8] = {a.x, a.y, a.z, a.w, b.x, b.y, b.z, b.w};
#pragma unroll
          for (int i = 0; i < 8; ++i) { v[2 * i] = __uint_as_float(w[i] << 16); v[2 * i + 1] = __uint_as_float(w[i] & 0xffff0000u); } }
#pragma unroll
        for (int i = 0; i < 16; ++i) s += v[i] * v[i];
        s += __shfl_xor(s, 1); s += __shfl_xor(s, 2);
        rs = 1.0f / sqrtf(s * (1.0f / NOPE) + NORM_EPS);
        bf16_t* ko = fm.knb + (size_t)m * (MH * NOPE) + hd * NOPE;
        { unsigned w[8];
#pragma unroll
          for (int i = 0; i < 8; ++i) { const float a = v[2 * i] * rs * gkn[2 * i], b = v[2 * i + 1] * rs * gkn[2 * i + 1];
              w[i] = pk2bf(a, b); }
          *(pg8::u32x4*)(ko + 16 * qt) = (pg8::u32x4){w[0], w[1], w[2], w[3]}; *(pg8::u32x4*)(ko + 16 * qt + 8) = (pg8::u32x4){w[4], w[5], w[6], w[7]}; }
    }
}
__device__ __forceinline__ void cvt_f32_bf16(const float* __restrict__ s, bf16_t* d, size_t n, size_t gtid, size_t gsz) {
    for (size_t i = gtid * 4; i < n; i += gsz * 4) { const pg8::f32x4 v = *(const pg8::f32x4*)(s + i); pg8::u32x2 o; o.x = pk2bf(v[0], v[1]); o.y = pk2bf(v[2], v[3]); *(pg8::u32x2*)(d + i) = o; }
}
typedef float f32x16_t __attribute__((ext_vector_type(16)));
typedef pg8::bf16x8 bf16x8v;
constexpr int AT_KROW = 208, AT_VROW = 136, AT_KBUF = 64 * AT_KROW, AT_VBUF = 64 * AT_VROW, AT_LDS = 2 * AT_KBUF + 2 * AT_VBUF;
__device__ __forceinline__ void attn_prompt_fast(const bf16_t* __restrict__ qf, const bf16_t* __restrict__ knb, const bf16_t* __restrict__ kpb, const bf16_t* __restrict__ vT, bf16_t* aob, LDSP unsigned char* lds) {
    using namespace cfg;
    const int tid = (int)tid_now(), w = __builtin_amdgcn_readfirstlane(tid >> 6), lane = tid & 63, l31 = lane & 31, h5 = lane >> 5;
    for (int it = blockIdx.x; it < BATCH * MH * 4; it += gridDim.x) {
        const int bh = it >> 2, pr = it & 3, b = bh / MH, h = bh % MH;
        for (int half = 0; half < 2; ++half) {
            const int qb = half ? 7 - pr : pr, q0 = 256 * qb, nt = 4 * qb + 4;
            const int qg = q0 + 32 * w + l31;
            const size_t mrow = (size_t)b * SEQ + qg;
            bf16x8v qfr[6];
#pragma unroll
            for (int s = 0; s < 6; ++s) qfr[s] = *(const bf16x8v*)(qf + mrow * (MH * QD) + h * QD + 16 * s + 8 * h5);
            f32x16_t O[2];
#pragma unroll
            for (int db = 0; db < 2; ++db)
#pragma unroll
                for (int r = 0; r < 16; ++r) O[db][r] = 0.f;
            float mrun = -1e30f, lrun = 0.f;
            pg8::u32x4 rk, rp, rv;
            const int kkey = tid >> 3, kc8 = tid & 7, pkey = tid >> 2, pc4 = tid & 3;
#define AT_LOAD(t) do { const size_t mk = (size_t)b * SEQ + 64 * (t); \
                rk = *(const pg8::u32x4*)(knb + (mk + kkey) * (MH * NOPE) + h * NOPE + kc8 * 8); \
                if (tid < 256) rp = *(const pg8::u32x4*)(kpb + (mk + pkey) * ROPE + pc4 * 8); \
                rv = *(const pg8::u32x4*)(vT + (size_t)(h * VD + kkey) * MTOT + mk + kc8 * 8); } while (0)
#define AT_STORE(buf) do { LDSP unsigned char* kb_ = lds + (buf) * AT_KBUF; LDSP unsigned char* vb_ = lds + 2 * AT_KBUF + (buf) * AT_VBUF; \
                *(LDSP pg8::u32x4*)(kb_ + kkey * AT_KROW + kc8 * 16) = rk; \
                if (tid < 256) *(LDSP pg8::u32x4*)(kb_ + pkey * AT_KROW + 128 + pc4 * 16) = rp; \
                *(LDSP pg8::u32x2*)(vb_ + kkey * AT_VROW + kc8 * 16) = (pg8::u32x2){rv.x, rv.y}; *(LDSP pg8::u32x2*)(vb_ + kkey * AT_VROW + kc8 * 16 + 8) = (pg8::u32x2){rv.z, rv.w}; } while (0)
            AT_LOAD(0); AT_STORE(0);
            __syncthreads();
            for (int t = 0; t < nt; ++t) {
                if (t + 1 < nt) AT_LOAD(t + 1);
                if (64 * t <= q0 + 32 * w + 31) {
                    const LDSP unsigned char* kb_ = lds + (t & 1) * AT_KBUF; const LDSP unsigned char* vb_ = lds + 2 * AT_KBUF + (t & 1) * AT_VBUF;
                    f32x16_t S[2];
#pragma unroll
                    for (int kb = 0; kb < 2; ++kb)
#pragma unroll
                        for (int r = 0; r < 16; ++r) S[kb][r] = 0.f;
#pragma unroll
                    for (int s = 0; s < 6; ++s)
#pragma unroll
                        for (int kb = 0; kb < 2; ++kb) {
                            const bf16x8v a = *(const LDSP bf16x8v*)(kb_ + (32 * kb + l31) * AT_KROW + (16 * s + 8 * h5) * 2);
                            S[kb] = __builtin_amdgcn_mfma_f32_32x32x16_bf16(a, qfr[s], S[kb], 0, 0, 0);
                        }
                    if (64 * t + 63 > q0 + 32 * w) {
#pragma unroll
                        for (int kb = 0; kb < 2; ++kb)
#pragma unroll
                            for (int r = 0; r < 16; ++r) { const int key = 64 * t + 32 * kb + (r & 3) + 8 * (r >> 2) + 4 * h5; if (key > qg) S[kb][r] = -1e30f; }
                    }
                    float mt = -1e30f;
#pragma unroll
                    for (int kb = 0; kb < 2; ++kb)
#pragma unroll
                        for (int r = 0; r < 16; ++r) mt = fmaxf(mt, S[kb][r]);
                    mt = fmaxf(mt, __shfl_xor(mt, 32));
                    const float mnew = fmaxf(mrun, mt), alpha = __builtin_amdgcn_exp2f(mrun - mnew);
                    float ls = 0.f;
#pragma unroll
                    for (int kb = 0; kb < 2; ++kb)
#pragma unroll
                        for (int r = 0; r < 16; ++r) { const float p = __builtin_amdgcn_exp2f(S[kb][r] - mnew); S[kb][r] = p; ls += p; }
                    lrun = lrun * alpha + ls; mrun = mnew;
#pragma unroll
                    for (int db = 0; db < 2; ++db)
#pragma unroll
                        for (int r = 0; r < 16; ++r) O[db][r] *= alpha;
#pragma unroll
                    for (int kb = 0; kb < 2; ++kb)
#pragma unroll
                        for (int s = 0; s < 2; ++s) {
                            pg8::u32x4 pw; pw.x = pk2bf(S[kb][8 * s + 0], S[kb][8 * s + 1]); pw.y = pk2bf(S[kb][8 * s + 2], S[kb][8 * s + 3]); pw.z = pk2bf(S[kb][8 * s + 4], S[kb][8 * s + 5]); pw.w = pk2bf(S[kb][8 * s + 6], S[kb][8 * s + 7]);
                            const bf16x8v pf = __builtin_bit_cast(bf16x8v, pw);
#pragma unroll
                            for (int db = 0; db < 2; ++db) {
                                const LDSP unsigned char* vp = vb_ + (32 * db + l31) * AT_VROW + (32 * kb + 16 * s + 4 * h5) * 2;
                                const pg8::u32x2 v0 = *(const LDSP pg8::u32x2*)vp, v1 = *(const LDSP pg8::u32x2*)(vp + 16);
                                const bf16x8v a = __builtin_bit_cast(bf16x8v, (pg8::u32x4){v0.x, v0.y, v1.x, v1.y});
                                O[db] = __builtin_amdgcn_mfma_f32_32x32x16_bf16(a, pf, O[db], 0, 0, 0);
                            }
                        }
                }
                if (t + 1 < nt) AT_STORE((t + 1) & 1);
                __syncthreads();
            }
#undef AT_LOAD
#undef AT_STORE
            const float inv = 1.0f / (lrun + __shfl_xor(lrun, 32));
            bf16_t* orow = aob + mrow * (MH * VD) + h * VD;
#pragma unroll
            for (int db = 0; db < 2; ++db)
#pragma unroll
                for (int g = 0; g < 4; ++g) { pg8::u32x2 o; o.x = pk2bf(O[db][4 * g] * inv, O[db][4 * g + 1] * inv); o.y = pk2bf(O[db][4 * g + 2] * inv, O[db][4 * g + 3] * inv);
                    *(pg8::u32x2*)(orow + 32 * db + 8 * g + 4 * h5) = o; }
        }
    }
}
constexpr int SD_CROW = 528, SD_WROW = 528, SD_PROW = 272;
constexpr int SD_CIMG = 0, SD_CIMG_SZ = 128 * SD_CROW;
constexpr int SD_WBUF = SD_CIMG + SD_CIMG_SZ, SD_WBUF_SZ = 32 * 1040;
constexpr int SD_XCH = SD_WBUF + 2 * SD_WBUF_SZ, SD_XCH_SZ = 4 * 5 * 64 * 4;
constexpr int SD_PIMG = SD_XCH + 2 * SD_XCH_SZ, SD_PIMG_SZ = 32 * SD_PROW;
constexpr int SD_END = SD_PIMG + 2 * SD_PIMG_SZ;
typedef short s16x4 __attribute__((ext_vector_type(4)));
#define MFMA32(a, b, c) __builtin_amdgcn_mfma_f32_32x32x16_bf16(a, b, c, 0, 0, 0)

__device__ __forceinline__ float mla_b2_bound(const Ctx& c, int j, int lane) {
    using namespace cfg;
    float gq = fabsf(c.in[I_QNN][j * NOPE + lane]), gk = fabsf(c.in[I_KNN][j * NOPE + lane]), gqr = fabsf(c.in[I_QRN][j * ROPE + (lane & 31)]), gkr = fabsf(c.in[I_KRN][j * ROPE + (lane & 31)]);
#pragma unroll
    for (int o = 1; o < 64; o <<= 1) { gq = fmaxf(gq, __shfl_xor(gq, o)); gk = fmaxf(gk, __shfl_xor(gk, o)); gqr = fmaxf(gqr, __shfl_xor(gqr, o)); gkr = fmaxf(gkr, __shfl_xor(gkr, o)); }
    return (64.f * gq * gk + 32.f * gqr * gkr) * (0.10206207261596575f * 1.4426950408889634f);
}

__device__ __forceinline__ void sd_pv_core(const int G, f32x16_t& Og, f32x16_t& Lacc, LDSP unsigned char* lds, int w, int lane, int l31, int h5) {
    asm volatile("" : "+v"(lane)); l31 = lane & 31; h5 = lane >> 5;
    const LDSP unsigned char* pimg = lds + SD_PIMG + (G & 1) * SD_PIMG_SZ;
    const unsigned onesw = (l31 == G) ? 0x3F803F80u : 0u;
    const bf16x8v onesv = __builtin_bit_cast(bf16x8v, (pg8::u32x4){onesw, onesw, onesw, onesw});
#pragma unroll
    for (int sp = 0; sp < 8; ++sp) {
        const bf16x8v a = *(const LDSP bf16x8v*)(pimg + l31 * SD_PROW + (16 * sp + 8 * h5) * 2);
        const int key0 = 16 * sp + 8 * h5 + ((lane & 15) >> 2), col = 32 * w + 16 * ((lane >> 4) & 1) + 4 * (lane & 3);
        const s16x4 t0 = __builtin_amdgcn_ds_read_tr16_b64_v4i16((LDSP s16x4*)(lds + SD_CIMG + key0 * SD_CROW + col * 2));
        const s16x4 t1 = __builtin_amdgcn_ds_read_tr16_b64_v4i16((LDSP s16x4*)(lds + SD_CIMG + (key0 + 4) * SD_CROW + col * 2));
        const bf16x8v b = (bf16x8v){t0[0], t0[1], t0[2], t0[3], t1[0], t1[1], t1[2], t1[3]};
        Og = MFMA32(a, b, Og);
        if (sp == w) Lacc = MFMA32(a, onesv, Lacc);
        if (sp & 1) __builtin_amdgcn_sched_barrier(0);
    }
}

__device__ __forceinline__ void sd_pv(const int G, f32x16_t& Og, f32x16_t& Lacc, LDSP unsigned char* lds, int w, int lane, int l31, int h5) {
    sd_pv_core(G, Og, Lacc, lds, w, lane, l31, h5);
#if defined(PROBE_DUP) && (PROBE_DUP & (1 << 21))
    f32x16_t D0, D1;
#pragma unroll
    for (int r = 0; r < 16; ++r) { D0[r] = 0.f; D1[r] = 0.f; }
    sd_pv_core(G, D0, D1, lds, w, lane, l31, h5); asm volatile("" :: "v"(D0), "v"(D1));
#endif
}
__device__ __forceinline__ void sd_glds16(const void* gsrc, unsigned lds_dst) {
    unsigned keep;
    asm volatile("s_mov_b32 %0, m0\n\ts_mov_b32 m0, %2\n\ts_nop 0\n\tglobal_load_lds_dwordx4 %1, off\n\ts_mov_b32 m0, %0" : "=&s"(keep) : "v"(gsrc), "s"(lds_dst) : "memory");
}
#define SD_WLOAD(h, buf) do { if (w >= 4) { const char* wsrc_ = (const char*)(fm.wukvt + (size_t)(h) * NOPE * KVL); int ln_ = lane; asm volatile("" : "+v"(ln_)); \
        const unsigned ldsb_ = __builtin_amdgcn_readfirstlane((unsigned)(size_t)(lds + SD_WBUF + (buf) * SD_WBUF_SZ)) + (unsigned)(8 * (w - 4)) * 1040u; \
        _Pragma("unroll") for (int k = 0; k < 8; ++k) { \
        const unsigned voff_ = (unsigned)(((8 * (w - 4) + k) + 32 * (ln_ >> 5)) * KVL + (ln_ & 31) * 8) * 2u; \
        sd_glds16(wsrc_ + voff_, ldsb_ + (unsigned)k * 1040u); } } } while (0)
template <int G, bool DOPV = true>
__device__ __forceinline__ void sd_group(const FastMla& fm, const bf16_t* __restrict__ qs, const int s, LDSP unsigned char* lds, const int w, const int lane, const int l31_, const int h5_, const int kb, const int dh, const int rot,
                                         const bf16x8v (&cfr)[16], const bf16x8v (&kpfr)[2], pg8::u32x4 (&wr)[4], f32x16_t (&O)[4], f32x16_t& Lacc, const float B2) {
    using namespace cfg;
        _Pragma("unroll 1") for (int hh = 0; hh < 4; ++hh) {
            const int h = (4 * G + hh + rot) & (MH - 1);
            int lane_ = lane; asm volatile("" : "+v"(lane_)); const int l31 = lane_ & 31, h5 = lane_ >> 5;
            { LDSP unsigned char* wdst = lds + SD_WBUF + ((h + 1) & 1) * SD_WBUF_SZ + (2 * w + h5) * 1040 + l31 * 16;
              *(LDSP pg8::u32x4*)(wdst) = wr[0]; *(LDSP pg8::u32x4*)(wdst + 16640) = wr[1]; *(LDSP pg8::u32x4*)(wdst + 512) = wr[2]; *(LDSP pg8::u32x4*)(wdst + 17152) = wr[3]; }
            const char* qb = (const char*)qs + (size_t)(s * MH + h) * 1536;
            const unsigned zoff = (unsigned)((DB * MH - (s * MH + h)) * 1536);
            const unsigned qlo = l31 < 8 ? (unsigned)(h5 * 128 + l31 * 16) : zoff;
            bf16x8v qn0 = (bf16x8v){0, 0, 0, 0, 0, 0, 0, 0}, qn1 = qn0, qp0 = qn0, qp1 = qn0;
            if (l31 < 8) {
                qn0 = *(const bf16x8v*)(qb + dh * 512 + qlo); qn1 = *(const bf16x8v*)(qb + dh * 512 + 256 + qlo);
                if (dh == 0) { qp0 = *(const bf16x8v*)(qb + 1024 + qlo); qp1 = *(const bf16x8v*)(qb + 1280 + qlo); } }
            { const char* wsrc = (const char*)(fm.wukvt + (size_t)((h + 2) & (MH - 1)) * NOPE * KVL) + (unsigned)(64 * w + lane_) * 16u;
#pragma unroll
              for (int k = 0; k < 4; ++k) wr[k] = *(const pg8::u32x4*)(wsrc + k * 8192); }
            f32x16_t KN;
#pragma unroll
            for (int r = 0; r < 16; ++r) KN[r] = 0.f;
            { const LDSP unsigned char* wb = lds + SD_WBUF + (h & 1) * SD_WBUF_SZ + l31 * 1040 + dh * 512 + h5 * 16;
#pragma unroll
              for (int s_ = 0; s_ < 16; ++s_) { const bf16x8v a = *(const LDSP bf16x8v*)(wb + 32 * s_); KN = MFMA32(a, cfr[s_], KN); if ((s_ & 3) == 3) __builtin_amdgcn_sched_barrier(0); } }
#if defined(PROBE_DUP) && (PROBE_DUP & (1 << 19))
            { const LDSP unsigned char* wb = lds + SD_WBUF + (h & 1) * SD_WBUF_SZ + l31 * 1040 + dh * 512 + h5 * 16;
#pragma unroll
              for (int s_ = 0; s_ < 16; ++s_) { const bf16x8v a = *(const LDSP bf16x8v*)(wb + 32 * s_); KN = MFMA32(a, cfr[s_], KN); if ((s_ & 3) == 3) __builtin_amdgcn_sched_barrier(0); }
#pragma unroll
              for (int r = 0; r < 16; ++r) KN[r] *= 0.5f; }
#endif
#if defined(PROBE_DUP) && (PROBE_DUP & (1 << 23))
            _Pragma("unroll 1") for (int rep_ = 0; rep_ < 2; ++rep_) {
            asm volatile("" : "+v"(KN));
#else
            {
#endif
            float ssq = 0.f;
#pragma unroll
            for (int r = 0; r < 16; ++r) ssq += KN[r] * KN[r];
            ssq += __shfl_xor(ssq, 32);
            {
            f32x16_t S;
#pragma unroll
            for (int r = 0; r < 16; ++r) S[r] = 0.f;
#pragma unroll
            for (int s_ = 0; s_ < 2; ++s_) { const bf16x8v kf = __builtin_bit_cast(bf16x8v, (pg8::u32x4){pk2bf(KN[8 * s_], KN[8 * s_ + 1]), pk2bf(KN[8 * s_ + 2], KN[8 * s_ + 3]), pk2bf(KN[8 * s_ + 4], KN[8 * s_ + 5]), pk2bf(KN[8 * s_ + 6], KN[8 * s_ + 7])});
                S = MFMA32(s_ == 0 ? qn0 : qn1, kf, S); }
            LDSP float* xch = (LDSP float*)(lds + SD_XCH + (h & 1) * SD_XCH_SZ) + kb * 320;
            if (dh == 1) { xch[lane_] = S[0]; xch[64 + lane_] = S[1]; xch[128 + lane_] = S[2]; xch[192 + lane_] = S[3]; xch[256 + lane_] = ssq; }
            asm volatile("s_waitcnt lgkmcnt(0)" ::: "memory");
            __builtin_amdgcn_s_barrier();
            asm volatile("" ::: "memory");
            if (dh == 0) {
                const float rstd = __builtin_amdgcn_rsqf((ssq + xch[256 + lane_]) * (1.0f / NOPE) + NORM_EPS);
                f32x16_t T;
#pragma unroll
                for (int r = 0; r < 16; ++r) T[r] = 0.f;
                T[0] = (S[0] + xch[lane_]) * rstd; T[1] = (S[1] + xch[64 + lane_]) * rstd; T[2] = (S[2] + xch[128 + lane_]) * rstd; T[3] = (S[3] + xch[192 + lane_]) * rstd;
                T = MFMA32(qp0, kpfr[0], T); T = MFMA32(qp1, kpfr[1], T);
                LDSP bf16_t* prow = (LDSP bf16_t*)(lds + SD_PIMG + (G & 1) * SD_PIMG_SZ + (hh * 8 + 4 * h5) * SD_PROW) + 32 * kb + l31;
#pragma unroll
                for (int q = 0; q < 4; ++q) prow[q * (SD_PROW / 2)] = (bf16_t)(pk2bf(exp2f(T[q] - B2), 0.f) & 0xffffu);
            }
            }
            }
        }
        if (G > 0 && DOPV) sd_pv(G > 0 ? G - 1 : 0, O[G > 0 ? G - 1 : 0], Lacc, lds, w, lane, l31_, h5_);
}

__device__ __forceinline__ void mla_sample_decode(const Ctx& c, const FastMla& fm, const bf16_t* __restrict__ qs, float* opart, float* lpart, int j, LDSP unsigned char* lds) {
    using namespace cfg;
    const int tid = (int)tid_now(), tid_ = tid, w = __builtin_amdgcn_readfirstlane(tid >> 6), lane = tid & 63, l31 = lane & 31, h5 = lane >> 5, kb = w & 3, dh = w >> 2;
    const float* ckv = c.in[I_CKV] + (size_t)j * NPOOL * PAGE * KVL; const float* kpe = c.in[I_KPE] + (size_t)j * NPOOL * PAGE * ROPE;
    const float B2 = __builtin_bit_cast(float, __builtin_amdgcn_readfirstlane(__builtin_bit_cast(int, mla_b2_bound(c, j, lane))));
    for (int it = blockIdx.x; it < DB * 2; it += gridDim.x) {
        const int s = it >> 1, hf = it & 1, rot = 2 * ((blockIdx.x >> 3) & 7);
        f32x16_t O[4], Lacc;
#pragma unroll
        for (int r = 0; r < 16; ++r) { O[0][r] = 0.f; O[1][r] = 0.f; O[2][r] = 0.f; O[3][r] = 0.f; Lacc[r] = 0.f; }
        pg8::u32x4 wr[4];
        __syncthreads();
        {
            int t_ = tid_; asm volatile("" : "+v"(t_));
            const char* wsrc = (const char*)(fm.wukvt + (size_t)rot * NOPE * KVL); const unsigned vo = (unsigned)t_ * 16u; LDSP unsigned char* wdst = lds + SD_WBUF + (t_ >> 5) * 1040 + (t_ & 31) * 16;
            pg8::u32x4 t0 = *(const pg8::u32x4*)(wsrc + vo), t1 = *(const pg8::u32x4*)(wsrc + 8192 + vo), t2 = *(const pg8::u32x4*)(wsrc + 16384 + vo), t3 = *(const pg8::u32x4*)(wsrc + 24576 + vo);
            *(LDSP pg8::u32x4*)(wdst) = t0; *(LDSP pg8::u32x4*)(wdst + 16640) = t1; *(LDSP pg8::u32x4*)(wdst + 512) = t2; *(LDSP pg8::u32x4*)(wdst + 17152) = t3;
#pragma unroll
            for (int k = 0; k < 4; ++k) wr[k] = *(const pg8::u32x4*)(wsrc + NOPE * KVL * 2 + k * 8192 + vo);
        }
        for (int pi = 0; pi < NPAGES / 2; ++pi) {
            const int pg = __builtin_amdgcn_readfirstlane(c.page_table[s * NPAGES + hf * (NPAGES / 2) + pi]);
            __syncthreads();
            { const char* src = (const char*)(ckv + (size_t)pg * PAGE * KVL); int tid = tid_; asm volatile("" : "+v"(tid));
              pg8::f32x4 v[16];
#pragma unroll
              for (int k = 0; k < 16; ++k) v[k] = __builtin_nontemporal_load((const pg8::f32x4*)(src + (size_t)k * 8192 + (unsigned)tid * 16u));
#pragma unroll
              for (int k = 0; k < 16; ++k) { pg8::u32x2 o; o.x = pk2bf(v[k][0], v[k][1]); o.y = pk2bf(v[k][2], v[k][3]);
                  *(LDSP pg8::u32x2*)(lds + SD_CIMG + ((tid >> 6) + 8 * k) * SD_CROW + (tid & 63) * 8) = o; } }
#if defined(PROBE_DUP) && (PROBE_DUP & (1 << 20))
            { const char* src = (const char*)(ckv + (size_t)pg * PAGE * KVL); int tid = tid_; asm volatile("" : "+v"(tid));
              pg8::f32x4 v[16];
#pragma unroll
              for (int k = 0; k < 16; ++k) v[k] = *(const pg8::f32x4*)(src + (size_t)k * 8192 + (unsigned)tid * 16u);
#pragma unroll
              for (int k = 0; k < 16; ++k) { pg8::u32x2 o; o.x = pk2bf(v[k][0], v[k][1]); o.y = pk2bf(v[k][2], v[k][3]);
                  *(LDSP pg8::u32x2*)(lds + SD_CIMG + ((tid >> 6) + 8 * k) * SD_CROW + (tid & 63) * 8) = o; } }
#endif
            bf16x8v kpfr[2];
            if (dh == 0) {
#pragma unroll
                for (int s_ = 0; s_ < 2; ++s_) { const float* kp = kpe + ((size_t)pg * PAGE + 32 * kb + l31) * ROPE + 16 * s_ + 8 * h5; const pg8::f32x4 a = *(const pg8::f32x4*)kp, b = *(const pg8::f32x4*)(kp + 4);
                    kpfr[s_] = __builtin_bit_cast(bf16x8v, (pg8::u32x4){pk2bf(a[0], a[1]), pk2bf(a[2], a[3]), pk2bf(b[0], b[1]), pk2bf(b[2], b[3])}); }
            }
            asm volatile("s_waitcnt vmcnt(0)" ::: "memory");
            __syncthreads();
            bf16x8v cfr[16];
#pragma unroll
            for (int s_ = 0; s_ < 16; ++s_) cfr[s_] = *(const LDSP bf16x8v*)(lds + SD_CIMG + (32 * kb + l31) * SD_CROW + (16 * s_ + 8 * h5) * 2);
            sd_group<0>(fm, qs, s, lds, w, lane, l31, h5, kb, dh, rot, cfr, kpfr, wr, O, Lacc, B2);
            sd_group<1>(fm, qs, s, lds, w, lane, l31, h5, kb, dh, rot, cfr, kpfr, wr, O, Lacc, B2);
            sd_group<2>(fm, qs, s, lds, w, lane, l31, h5, kb, dh, rot, cfr, kpfr, wr, O, Lacc, B2);
            sd_group<3>(fm, qs, s, lds, w, lane, l31, h5, kb, dh, rot, cfr, kpfr, wr, O, Lacc, B2);
#if defined(PROBE_DUP) && (PROBE_DUP & (1 << 29))
            __syncthreads();
            sd_group<0, false>(fm, qs, s, lds, w, lane, l31, h5, kb, dh, rot, cfr, kpfr, wr, O, Lacc, B2);
            sd_group<1, false>(fm, qs, s, lds, w, lane, l31, h5, kb, dh, rot, cfr, kpfr, wr, O, Lacc, B2);
            sd_group<2, false>(fm, qs, s, lds, w, lane, l31, h5, kb, dh, rot, cfr, kpfr, wr, O, Lacc, B2);
            sd_group<3, false>(fm, qs, s, lds, w, lane, l31, h5, kb, dh, rot, cfr, kpfr, wr, O, Lacc, B2);
#endif
            __syncthreads();
            sd_pv(3, O[3], Lacc, lds, w, lane, l31, h5);
        }
        {float* op = opart + (size_t)it * (MH * DS) * KVL; int lo_ = lane; asm volatile("" : "+v"(lo_)); const int l31 = lo_ & 31, h5 = lo_ >> 5;
#pragma unroll
        for (int g = 0; g < 4; ++g)
#pragma unroll
            for (int r = 0; r < 16; ++r) op[(size_t)((((4 * g + (r >> 2) + rot) & (MH - 1)) << 3) + (r & 3) + 4 * h5) * KVL + 32 * w + l31] = O[g][r];
        __syncthreads();
        LDSP float* ltab = (LDSP float*)(lds + SD_XCH);
        if (l31 < 4) {
#pragma unroll
            for (int r = 0; r < 16; ++r) ltab[w * 128 + l31 * 32 + (r & 3) + 8 * (r >> 2) + 4 * h5] = Lacc[r];
        }
        __syncthreads();
        { const int t2 = (int)tid_now();
        if (t2 < 128) { float a = 0.f;
#pragma unroll
            for (int ww = 0; ww < 8; ++ww) a += ltab[ww * 128 + t2];
            lpart[(size_t)it * 128 + ((((t2 >> 3) + rot) & (MH - 1)) << 3) + (t2 & 7)] = a; } }
        }
    }
}

__device__ __forceinline__ void mla_sample_combine(const Ctx& c, const FastMla& fm, const float* __restrict__ opart, const float* __restrict__ lpart, int j, LDSP unsigned char* lds) {
    using namespace cfg;
    const int tid = (int)tid_now(), w = tid >> 6, lane = tid & 63, gw = blockIdx.x * 8 + w, ngw = gridDim.x * 8;
    const float B2 = mla_b2_bound(c, j, lane);
    LDSP float* ol = (LDSP float*)(lds + w * 8704); LDSP float* ptab = ol + 8 * KVL; LDSP float* lt = ptab + 64;
    const float* wuv = c.in[I_WUV] + (size_t)j * KVL * MH * VD;
    for (int item = gw; item < DB * MH; item += ngw) {
        const int s = item / MH, h = item % MH, q = lane >> 3, jn = lane & 7;
        const size_t rq = (size_t)MP + s * DS + q, rk = (size_t)MP + s * DS + jn;
        const bf16_t* qv = fm.qf + rq * (MH * QD) + h * QD; const bf16_t* kn = fm.knb + rk * (MH * NOPE) + h * NOPE; const bf16_t* kp = fm.kpb + rk * ROPE;
        const float* wp = wuv + (size_t)h * VD + lane;
        float wa[16];
#pragma unroll
        for (int i = 0; i < 16; ++i) wa[i] = wp[(size_t)i * (MH * VD)];
        float cn[DS][4];
#pragma unroll
        for (int jj = 0; jj < DS; ++jj)
#pragma unroll
            for (int k = 0; k < 4; ++k) cn[jj][k] = bf2f(fm.cb[((size_t)MP + s * DS + jj) * KVL + lane + 64 * k]);
        float sc = 0.f;
#pragma unroll
        for (int d8 = 0; d8 < QD / 8; ++d8) { const pg8::u32x4 a = *(const pg8::u32x4*)(qv + 8 * d8), b = d8 < NOPE / 8 ? *(const pg8::u32x4*)(kn + 8 * d8) : *(const pg8::u32x4*)(kp + 8 * (d8 - NOPE / 8));
            const unsigned aw[4] = {a.x, a.y, a.z, a.w}, bw[4] = {b.x, b.y, b.z, b.w};
#pragma unroll
            for (int e = 0; e < 4; ++e) sc += __uint_as_float(aw[e] << 16) * __uint_as_float(bw[e] << 16) + __uint_as_float(aw[e] & 0xffff0000u) * __uint_as_float(bw[e] & 0xffff0000u); }
        const float p = jn <= q ? exp2f(sc - B2) : 0.f;
        float ls = p; ls += __shfl_xor(ls, 1); ls += __shfl_xor(ls, 2); ls += __shfl_xor(ls, 4);
        ptab[lane] = p;
        if (jn == 0) lt[q] = ls + lpart[(size_t)(2 * s) * 128 + h * DS + q] + lpart[(size_t)(2 * s + 1) * 128 + h * DS + q];
        asm volatile("s_waitcnt lgkmcnt(0)" ::: "memory");
#pragma unroll
        for (int qq = 0; qq < DS; ++qq)
#pragma unroll
            for (int k = 0; k < 4; ++k) { const int r = lane + 64 * k;
                float a = opart[((size_t)(2 * s) * 128 + h * DS + qq) * KVL + r] + opart[((size_t)(2 * s + 1) * 128 + h * DS + qq) * KVL + r];
#pragma unroll
                for (int jj = 0; jj < DS; ++jj) a += ptab[qq * 8 + jj] * cn[jj][k];
                ol[qq * KVL + r] = a; }
        asm volatile("s_waitcnt lgkmcnt(0)" ::: "memory");
        float acc[DS];
#pragma unroll
        for (int qq = 0; qq < DS; ++qq) acc[qq] = 0.f;
        float wb[16];
        for (int r0 = 0; r0 < KVL; r0 += 32) {
#pragma unroll
            for (int i = 0; i < 16; ++i) wb[i] = wp[(size_t)(r0 + 16 + i) * (MH * VD)];
#pragma unroll
            for (int i4 = 0; i4 < 4; ++i4)
#pragma unroll
                for (int qq = 0; qq < DS; ++qq) { const pg8::f32x4 o4 = *(const LDSP pg8::f32x4*)(ol + qq * KVL + r0 + 4 * i4);
                    acc[qq] += o4[0] * wa[4 * i4] + o4[1] * wa[4 * i4 + 1] + o4[2] * wa[4 * i4 + 2] + o4[3] * wa[4 * i4 + 3]; }
            if (r0 + 32 < KVL) {
#pragma unroll
                for (int i = 0; i < 16; ++i) wa[i] = wp[(size_t)(r0 + 32 + i) * (MH * VD)]; }
#pragma unroll
            for (int i4 = 0; i4 < 4; ++i4)
#pragma unroll
                for (int qq = 0; qq < DS; ++qq) { const pg8::f32x4 o4 = *(const LDSP pg8::f32x4*)(ol + qq * KVL + r0 + 16 + 4 * i4);
                    acc[qq] += o4[0] * wb[4 * i4] + o4[1] * wb[4 * i4 + 1] + o4[2] * wb[4 * i4 + 2] + o4[3] * wb[4 * i4 + 3]; }
        }
#pragma unroll
        for (int qq = 0; qq < DS; ++qq) fm.aob[((size_t)MP + s * DS + qq) * (MH * VD) + h * VD + lane] = (bf16_t)(pk2bf(acc[qq] / lt[qq], 0.f) & 0xffffu);
        asm volatile("s_waitcnt lgkmcnt(0)" ::: "memory");
    }
}

struct FastRw {
    bf16_t* xm;
    bf16_t* rkv;
    bf16_t* hb;
    bf16_t* lu;
    float* vf;
    float* ops;
    bf16_t* yo;
    bf16_t *wrkvt, *lorat, *wot;
};
constexpr int RW_REC = 464;
constexpr int RW_CH = 32;
constexpr int RW_BUF = RW_CH * RW_REC * 4;
struct RwSel { __device__ static __forceinline__ int sel(int pn) { return pn < 12 ? (pn >> 2) : (pn == 15 ? 2 : pn - 9); } };

__device__ __forceinline__ void rw_mix_fast(const Ctx& c, const FastRw& fr, int l, int gw, int ngw, int lane) {
    using namespace cfg; const int j = l / 3;
    const float* gain = c.in[I_NMIX] + l * D;
    pg8::f32x4 gv[4], muv[6][4];
#pragma unroll
    for (int q = 0; q < 4; ++q) { gv[q] = *(const pg8::f32x4*)(gain + 4 * lane + 256 * q);
#pragma unroll
        for (int p = 0; p < 6; ++p) muv[p][q] = *(const pg8::f32x4*)(c.in[I_MU] + ((size_t)j * 6 + p) * D + 4 * lane + 256 * q); }
    for (int m = gw; m < MTOT; m += ngw) {
        const int t = row_t(m), sq = row_seq(m);
        pg8::f32x4 xc[4], xp[4]; float s = 0.f, sp = 0.f;
#pragma unroll
        for (int q = 0; q < 4; ++q) { xc[q] = *(const pg8::f32x4*)(c.x + (size_t)m * D + 4 * lane + 256 * q);
            s += (xc[q][0] * xc[q][0] + xc[q][1] * xc[q][1]) + (xc[q][2] * xc[q][2] + xc[q][3] * xc[q][3]); }
        if (t > 0) {
#pragma unroll
            for (int q = 0; q < 4; ++q) { xp[q] = *(const pg8::f32x4*)(c.x + (size_t)(m - 1) * D + 4 * lane + 256 * q); sp += (xp[q][0] * xp[q][0] + xp[q][1] * xp[q][1]) + (xp[q][2] * xp[q][2] + xp[q][3] * xp[q][3]); }
        }
        const float rs = 1.0f / sqrtf(wave_sum64(s) * (1.0f / D) + NORM_EPS), rsp = 1.0f / sqrtf(wave_sum64(sp) * (1.0f / D) + NORM_EPS);
#pragma unroll
        for (int q = 0; q < 4; ++q) {
#pragma unroll
            for (int e = 0; e < 4; ++e) xc[q][e] = xc[q][e] * rs * gv[q][e];
            if (t > 0) {
#pragma unroll
                for (int e = 0; e < 4; ++e) xp[q][e] = xp[q][e] * rsp * gv[q][e];
            } else if (sq < BATCH) xp[q] = (pg8::f32x4){0.f, 0.f, 0.f, 0.f};
            else xp[q] = *(const pg8::f32x4*)(c.in[I_SHIFT] + ((size_t)j * DB + (sq - BATCH)) * D + 4 * lane + 256 * q);
        }
        if (t == seq_len(sq) - 1) {
            float* so = sq < BATCH ? c.out + O_SHP + ((size_t)j * BATCH + sq) * D : c.out + O_SHS + ((size_t)j * DB + (sq - BATCH)) * D;
#pragma unroll
            for (int q = 0; q < 4; ++q) *(pg8::f32x4*)(so + 4 * lane + 256 * q) = xc[q];
        }
#pragma unroll
        for (int p = 0; p < 6; ++p)
#pragma unroll
            for (int q = 0; q < 4; ++q) { const pg8::f32x4 mu = muv[p][q];
                pg8::u32x2 o; o.x = pk2bf(xc[q][0] + (xp[q][0] - xc[q][0]) * mu[0], xc[q][1] + (xp[q][1] - xc[q][1]) * mu[1]); o.y = pk2bf(xc[q][2] + (xp[q][2] - xc[q][2]) * mu[2], xc[q][3] + (xp[q][3] - xc[q][3]) * mu[3]);
                *(pg8::u32x2*)(fr.xm + ((size_t)p * MTOT + m) * D + 4 * lane + 256 * q) = o; }
        if (lane < 32) *(unsigned*)(fr.hb + (size_t)m * 384 + 320 + 2 * lane) = 0u;
    }
}
struct EpiRwkv {
    static constexpr bool PERM = true;
    bf16_t* rkv; bf16_t* hb;
    __device__ __forceinline__ void operator()(const pg8::f32x4 (&acc)[2][2][4][2], const pg8::Unit& u, int wr, int wc, int fr, int fq) const {
        using namespace pg8;
        const int row0 = u.pm * BM + wr * 64 + fr, cl0 = wc * 32 + 8 * fq;
        const int pn = u.pn;
        bf16_t* base; int ldc, coff, nvalid, act = 0;
        if (pn < 12) { base = rkv; ldc = 3072; coff = pn * 256; nvalid = 256; }
        else { base = hb; ldc = 384; if (pn == 12) { coff = 0; nvalid = 64; act = 1; } else if (pn == 13) { coff = 64; nvalid = 64; } else if (pn == 14) { coff = 128; nvalid = 160; act = 2; } else { coff = 288; nvalid = 32; } }
#pragma unroll
        for (int ai = 0; ai < 2; ++ai)
#pragma unroll
            for (int m = 0; m < 4; ++m) { bf16_t* rowp = base + (size_t)(row0 + ai * HALF + m * 16) * ldc + coff;
#pragma unroll
                for (int bj = 0; bj < 2; ++bj) { const int cl = cl0 + bj * HALF; if (cl >= nvalid) continue;
                    f32x4 v0 = acc[ai][bj][m][0], v1 = acc[ai][bj][m][1];
                    if (act == 1) {
#pragma unroll
                        for (int e = 0; e < 4; ++e) { v0[e] = tanhf(v0[e]); v1[e] = tanhf(v1[e]); } }
                    else if (act == 2) {
#pragma unroll
                        for (int e = 0; e < 4; ++e) { v0[e] = 1.0f / (1.0f + __expf(-v0[e])); v1[e] = 1.0f / (1.0f + __expf(-v1[e])); } }
                    u32x4 w; w.x = cvt_pk_bf16(v0[0], v0[1]); w.y = cvt_pk_bf16(v0[2], v0[3]); w.z = cvt_pk_bf16(v1[0], v1[1]); w.w = cvt_pk_bf16(v1[2], v1[3]);
                    *(u32x4*)(rowp + cl) = w; } }
    }
};
__device__ __forceinline__ void rw_build_lorat(const Ctx& c, bf16_t* lorat, int j, size_t gtid, size_t gsz) {
    using namespace cfg;
    for (size_t i = gtid; i < (size_t)4096 * 384; i += gsz) {
        const int n = (int)(i / 384), k = (int)(i % 384), grp = n >> 10, ch = n & 1023; float v = 0.f;
        if (grp == 0 && k < 64) v = c.in[I_W2][((size_t)j * RW_DL + k) * D + ch];
        else if (grp == 1 && k >= 64 && k < 128) v = c.in[I_A2][((size_t)j * RW_AL + (k - 64)) * D + ch];
        else if (grp == 2 && k >= 128 && k < 288) v = c.in[I_G2][((size_t)j * RW_GL + (k - 128)) * D + ch];
        else if (grp == 3 && k >= 288 && k < 320 && j > 0) v = c.in[I_V2][((size_t)(j - 1) * RW_VL + (k - 288)) * D + ch];
        lorat[i] = (bf16_t)(pk2bf(v, 0.f) & 0xffffu);
    }
}
__device__ __forceinline__ size_t rw_rec_base(int sq, int h) {
    using namespace cfg;
    return sq < BATCH ? ((size_t)sq * RHEADS + h) * SEQ : (size_t)MP * RHEADS + ((size_t)(sq - BATCH) * RHEADS + h) * DS;
}
__device__ __forceinline__ void rw_prep_fast(const Ctx& c, const FastRw& fr, int l, int gw, int ngw, int lane) {
    using namespace cfg; const int j = l / 3;
    for (int it = gw; it < MTOT * RHEADS; it += ngw) {
        const int m = it / RHEADS, h = it % RHEADS, ch = h * RH + lane;
        const bf16_t* rk = fr.rkv + (size_t)m * 3072 + ch; const bf16_t* lu = fr.lu + (size_t)m * 4096 + ch;
        const float r = bf2f(rk[0]), k0 = bf2f(rk[1024]); float v = bf2f(rk[2048]);
        const float wpre = bf2f(lu[0]), apre = bf2f(lu[1024]), gg = bf2f(lu[2048]), vpre = bf2f(lu[3072]);
        const float wl = -softplusf_(-(c.in[I_W0][j * D + ch] + wpre)) - 0.5f;
        const float w = expf(-expf(wl));
        if (j == 0) fr.vf[(size_t)m * D + ch] = v;
        else v = v + (fr.vf[(size_t)m * D + ch] - v) * sigmoidf_(c.in[I_V0][(j - 1) * D + ch] + vpre);
        const float a = sigmoidf_(c.in[I_A0][j * D + ch] + apre);
        float kk = k0 * c.in[I_KK][j * D + ch];
        const float nn = wave_sum64(kk * kk);
        kk *= 1.0f / fmaxf(sqrtf(nn), 1e-12f);
        const float k2 = k0 * (1.0f + (a - 1.0f) * c.in[I_KA][j * D + ch]);
        const float bo = kk * a;
        const float br = wave_sum64(bo * r), kr = wave_sum64(k2 * r), bonus = wave_sum64(r * k2 * c.in[I_RK][(size_t)j * D + ch]);
        const int sq = row_seq(m), t = row_t(m);
        float* rec = fr.ops + (rw_rec_base(sq, h) + t) * RW_REC;
        rec[lane] = -kk; rec[64 + lane] = w * r; rec[128 + lane] = w; rec[192 + lane] = bo; rec[256 + lane] = k2; rec[320 + lane] = v; rec[384 + lane] = gg;
        if (lane == 0) { rec[448] = br; rec[449] = kr; rec[450] = bonus; }
    }
}
template <int CTRL> __device__ __forceinline__ float dppf(float v) { return __int_as_float(__builtin_amdgcn_update_dpp(0, __float_as_int(v), CTRL, 0xF, 0xF, true)); }
__device__ __forceinline__ float red16(float x) { x += dppf<0xB1>(x); x += dppf<0x4E>(x); x += dppf<0x124>(x); x += dppf<0x128>(x); return x; }
__device__ __forceinline__ void rw_scan_fast(const Ctx& c, const FastRw& fr, int l, LDSP unsigned char* lds) {
    using namespace cfg; const int j = l / 3;
    const int tid = (int)tid_now(), w = __builtin_amdgcn_readfirstlane(tid >> 6), lane = tid & 63, cs = lane & 15, rp = 4 * w + (lane >> 4);
    LDSP float* ybuf = (LDSP float*)(lds + 2 * RW_BUF);
    for (int chain = blockIdx.x; chain < NSEQ * RHEADS; chain += gridDim.x) {
        const int sq = chain / RHEADS, h = chain % RHEADS, T = seq_len(sq), m0 = seq_row0(sq);
        const char* src = (const char*)(fr.ops + rw_rec_base(sq, h) * RW_REC);
        pg8::f32x4 S0, S1;
        if (sq < BATCH) { S0 = (pg8::f32x4){0.f, 0.f, 0.f, 0.f}; S1 = S0; }
        else { const float* s0 = c.in[I_WKV] + ((((size_t)j * DB + (sq - BATCH)) * RHEADS + h) * RH + 2 * rp) * RH + 4 * cs; S0 = *(const pg8::f32x4*)s0; S1 = *(const pg8::f32x4*)(s0 + RH); }
        const int nch = (T + RW_CH - 1) / RW_CH;
#define RW_DMA(n, buf) do { const int nb_ = ((T - (n) * RW_CH < RW_CH ? T - (n) * RW_CH : RW_CH) * RW_REC * 4 + 1023) >> 10; \
            for (int q_ = w; q_ < nb_; q_ += 8) __builtin_amdgcn_global_load_lds((const unsigned*)(src + (size_t)(n) * RW_BUF + (size_t)q_ * 1024 + (unsigned)lane * 16u), (LDSP unsigned*)(lds + (buf) * RW_BUF + q_ * 1024), 16, 0, 0); } while (0)
        __syncthreads();
        RW_DMA(0, 0);
        asm volatile("s_waitcnt vmcnt(0)" ::: "memory");
        __syncthreads();
        for (int n = 0; n < nch; ++n) {
            if (n + 1 < nch) RW_DMA(n + 1, (n + 1) & 1);
            const int tn = T - n * RW_CH < RW_CH ? T - n * RW_CH : RW_CH;
            const LDSP unsigned char* bufp = lds + (n & 1) * RW_BUF;
            for (int t = 0; t < tn; ++t) {
                const LDSP unsigned char* rec = bufp + t * (RW_REC * 4);
                const pg8::f32x4 A = *(const LDSP pg8::f32x4*)(rec + cs * 16), WR = *(const LDSP pg8::f32x4*)(rec + 256 + cs * 16), W = *(const LDSP pg8::f32x4*)(rec + 512 + cs * 16),
                                 B = *(const LDSP pg8::f32x4*)(rec + 768 + cs * 16), K = *(const LDSP pg8::f32x4*)(rec + 1024 + cs * 16);
                const pg8::f32x2 V2 = *(const LDSP pg8::f32x2*)(rec + 1280 + rp * 8), SC = *(const LDSP pg8::f32x2*)(rec + 1792);
                float sa0 = (S0[0] * A[0] + S0[1] * A[1]) + (S0[2] * A[2] + S0[3] * A[3]), y0 = (S0[0] * WR[0] + S0[1] * WR[1]) + (S0[2] * WR[2] + S0[3] * WR[3]);
                float sa1 = (S1[0] * A[0] + S1[1] * A[1]) + (S1[2] * A[2] + S1[3] * A[3]), y1 = (S1[0] * WR[0] + S1[1] * WR[1]) + (S1[2] * WR[2] + S1[3] * WR[3]);
                sa0 = red16(sa0); sa1 = red16(sa1); y0 = red16(y0); y1 = red16(y1);
                S0 = S0 * W + sa0 * B + V2[0] * K; S1 = S1 * W + sa1 * B + V2[1] * K;
                if (cs == 0) *(LDSP pg8::f32x2*)(ybuf + t * RH + 2 * rp) = (pg8::f32x2){y0 + sa0 * SC[0] + V2[0] * SC[1], y1 + sa1 * SC[0] + V2[1] * SC[1]};
            }
            asm volatile("s_waitcnt vmcnt(0)" ::: "memory");
            __syncthreads();
            for (int t = w; t < tn; t += 8) {
                const LDSP float* rec = (const LDSP float*)(bufp + t * (RW_REC * 4));
                const float y = ybuf[t * RH + lane], mean = wave_sum64(y) * (1.0f / RH), d = y - mean, var = wave_sum64(d * d) * (1.0f / RH);
                const int ch = h * RH + lane;
                const float yn = d * (1.0f / sqrtf(var + LNX_EPS)) * c.in[I_LNW][j * D + ch] + c.in[I_LNB][j * D + ch];
                const float o = (yn + rec[450] * rec[320 + lane]) * rec[384 + lane];
                fr.yo[(size_t)(m0 + n * RW_CH + t) * D + ch] = (bf16_t)(pk2bf(o, 0.f) & 0xffffu);
            }
            __syncthreads();
        }
#undef RW_DMA
        float* so = (sq < BATCH ? c.out + O_WKVP + (((size_t)j * BATCH + sq) * RHEADS + h) * RH * RH : c.out + O_WKVS + (((size_t)j * DB + (sq - BATCH)) * RHEADS + h) * RH * RH) + (size_t)(2 * rp) * RH + 4 * cs;
        *(pg8::f32x4*)so = S0; *(pg8::f32x4*)(so + RH) = S1;
    }
}
__device__ __forceinline__ float fsigmoid(float x) { return __builtin_amdgcn_rcpf(1.0f + __expf(-x)); }
__device__ __forceinline__ float fsoftplus(float x) { return x > 20.f ? x : __logf(1.0f + __expf(x)); }
__device__ __forceinline__ float rdl(float v, int l) { return __int_as_float(__builtin_amdgcn_readlane(__float_as_int(v), l)); }
__device__ __forceinline__ float wsum_dpp(float x) {
    x = red16(x);
    return (rdl(x, 0) + rdl(x, 16)) + (rdl(x, 32) + rdl(x, 48));
}

struct RwOp { pg8::f32x4 A, WR, W, B, K; pg8::f32x2 V2, SC; };
__device__ __forceinline__ void rw_ldop(RwOp& o, const LDSP unsigned char* rec, int cs, int rp) {
    o.A = *(const LDSP pg8::f32x4*)(rec + cs * 16); o.WR = *(const LDSP pg8::f32x4*)(rec + 256 + cs * 16); o.W = *(const LDSP pg8::f32x4*)(rec + 512 + cs * 16);
    o.B = *(const LDSP pg8::f32x4*)(rec + 768 + cs * 16); o.K = *(const LDSP pg8::f32x4*)(rec + 1024 + cs * 16);
    o.V2 = *(const LDSP pg8::f32x2*)(rec + 1280 + rp * 8); o.SC = *(const LDSP pg8::f32x2*)(rec + 1792);
}
__device__ __forceinline__ float fma_s(float a, float b, float c) { float d; asm("v_fma_f32 %0, %1, %2, %3" : "=v"(d) : "v"(a), "v"(b), "v"(c)); return d; }
__device__ __forceinline__ float mul_s(float a, float b) { float d; asm("v_mul_f32 %0, %1, %2" : "=v"(d) : "v"(a), "v"(b)); return d; }
__device__ __forceinline__ void rw_step(pg8::f32x4& S0, pg8::f32x4& S1, const RwOp& o, LDSP float* yrow, bool wr) {
    float sa0 = fma_s(S0[3], o.A[3], fma_s(S0[2], o.A[2], fma_s(S0[1], o.A[1], mul_s(S0[0], o.A[0]))));
    float sa1 = fma_s(S1[3], o.A[3], fma_s(S1[2], o.A[2], fma_s(S1[1], o.A[1], mul_s(S1[0], o.A[0]))));
    float y0 = fma_s(S0[3], o.WR[3], fma_s(S0[2], o.WR[2], fma_s(S0[1], o.WR[1], mul_s(S0[0], o.WR[0]))));
    float y1 = fma_s(S1[3], o.WR[3], fma_s(S1[2], o.WR[2], fma_s(S1[1], o.WR[1], mul_s(S1[0], o.WR[0]))));
    float t0[4], t1[4];
#pragma unroll
    for (int e = 0; e < 4; ++e) { t0[e] = fma_s(o.K[e], o.V2[0], mul_s(S0[e], o.W[e])); t1[e] = fma_s(o.K[e], o.V2[1], mul_s(S1[e], o.W[e])); }
    red16x4(sa0, sa1, y0, y1);
#pragma unroll
    for (int e = 0; e < 4; ++e) { S0[e] = fma_s(o.B[e], sa0, t0[e]); S1[e] = fma_s(o.B[e], sa1, t1[e]); }
    if (wr) *(LDSP pg8::f32x2*)yrow = (pg8::f32x2){fma_s(o.V2[0], o.SC[1], fma_s(sa0, o.SC[0], y0)), fma_s(o.V2[1], o.SC[1], fma_s(sa1, o.SC[0], y1))};
}
struct RwIn { unsigned short r, k, v, wp, ap, g, vp; float vf; };
template <int J>
__device__ __forceinline__ void rw_scan_fused(const Ctx& c, const FastRw& fr, LDSP unsigned char* lds) {
    using namespace cfg; constexpr int j = J;
    const int tid = (int)tid_now(), w = __builtin_amdgcn_readfirstlane(tid >> 6), lane = tid & 63, cs = lane & 15, rp = 4 * w + (lane >> 4);
    LDSP float* ybuf = (LDSP float*)(lds + 2 * RW_BUF);
    for (int chain = blockIdx.x; chain < NSEQ * RHEADS; chain += gridDim.x) {
        const int sq = chain / RHEADS, h = chain % RHEADS, T = seq_len(sq), m0 = seq_row0(sq), ch = h * RH + lane;
        const float p_w0 = c.in[I_W0][j * D + ch], p_a0 = c.in[I_A0][j * D + ch], p_kk = c.in[I_KK][j * D + ch], p_ka = c.in[I_KA][j * D + ch], p_rk = c.in[I_RK][(size_t)j * D + ch],
                    p_lnw = c.in[I_LNW][j * D + ch], p_lnb = c.in[I_LNB][j * D + ch], p_v0 = j > 0 ? c.in[I_V0][(j - 1) * D + ch] : 0.f;
        pg8::f32x4 S0, S1;
        if (sq < BATCH) { S0 = (pg8::f32x4){0.f, 0.f, 0.f, 0.f}; S1 = S0; }
        else { const float* s0 = c.in[I_WKV] + ((((size_t)j * DB + (sq - BATCH)) * RHEADS + h) * RH + 2 * rp) * RH + 4 * cs; S0 = *(const pg8::f32x4*)s0; S1 = *(const pg8::f32x4*)(s0 + RH); }
        const int nch = (T + RW_CH - 1) / RW_CH;
        RwIn in[4];
#define RW_LOADIN(n) do { _Pragma("unroll") for (int q = 0; q < 4; ++q) { const int t_ = (n) * RW_CH + 4 * w + q; if (t_ < T) { const size_t m_ = (size_t)(m0 + t_); \
                const bf16_t* rk_ = fr.rkv + m_ * 3072 + ch; const bf16_t* lu_ = fr.lu + m_ * 4096 + ch; \
                in[q].r = rk_[0]; in[q].k = rk_[1024]; in[q].v = rk_[2048]; in[q].wp = lu_[0]; in[q].ap = lu_[1024]; in[q].g = lu_[2048]; in[q].vp = lu_[3072]; \
                in[q].vf = j > 0 ? fr.vf[m_ * D + ch] : 0.f; } } } while (0)
#define RW_PREP(n, buf) do { _Pragma("unroll") for (int q = 0; q < 4; ++q) { const int tl_ = 4 * w + q, t_ = (n) * RW_CH + tl_; if (t_ < T) { \
                const float r_ = bf2f(in[q].r), k0_ = bf2f(in[q].k); float v_ = bf2f(in[q].v); \
                const float wl_ = -fsoftplus(-(p_w0 + bf2f(in[q].wp))) - 0.5f, w_ = __expf(-__expf(wl_)); \
                if (j == 0) fr.vf[(size_t)(m0 + t_) * D + ch] = v_; else v_ = v_ + (in[q].vf - v_) * fsigmoid(p_v0 + bf2f(in[q].vp)); \
                const float a_ = fsigmoid(p_a0 + bf2f(in[q].ap)); float kk_ = k0_ * p_kk; \
                const float k2_ = k0_ * (1.0f + (a_ - 1.0f) * p_ka); \
                float n_ = red16(kk_ * kk_), e1_ = red16(r_ * k2_ * p_rk), e2_ = red16(k2_ * r_); \
                n_ = (rdl(n_, 0) + rdl(n_, 16)) + (rdl(n_, 32) + rdl(n_, 48)); e1_ = (rdl(e1_, 0) + rdl(e1_, 16)) + (rdl(e1_, 32) + rdl(e1_, 48)); e2_ = (rdl(e2_, 0) + rdl(e2_, 16)) + (rdl(e2_, 32) + rdl(e2_, 48)); \
                kk_ *= __builtin_amdgcn_rcpf(fmaxf(__builtin_amdgcn_sqrtf(n_), 1e-12f)); const float bo_ = kk_ * a_; const float e3_ = wsum_dpp(bo_ * r_); \
                LDSP float* rec_ = (LDSP float*)(lds + (buf) * RW_BUF + tl_ * (RW_REC * 4)); \
                rec_[lane] = -kk_; rec_[64 + lane] = w_ * r_; rec_[128 + lane] = w_; rec_[192 + lane] = bo_; rec_[256 + lane] = k2_; rec_[320 + lane] = v_; rec_[384 + lane] = bf2f(in[q].g); \
                if (lane == 0) { rec_[448] = e3_; rec_[449] = e2_; rec_[450] = e1_; } } } } while (0)
        __syncthreads();
        RW_LOADIN(0); RW_PREP(0, 0);
        __syncthreads();
        for (int n = 0; n < nch; ++n) {
            if (n + 1 < nch) RW_LOADIN(n + 1);
            const int tn = T - n * RW_CH < RW_CH ? T - n * RW_CH : RW_CH;
            const LDSP unsigned char* bufp = lds + (n & 1) * RW_BUF;
#if defined(PROBE_DUP) && (PROBE_DUP & (1 << 17))
            { RwOp o0, o1; rw_ldop(o0, bufp, cs, rp); pg8::f32x4 T0 = S0, T1 = S1;
              for (int t = 0; t < tn; t += 2) {
                  rw_ldop(o1, bufp + (t + 1) * (RW_REC * 4), cs, rp);
                  rw_step(T0, T1, o0, ybuf + t * RH + 2 * rp, cs == 0);
                  rw_ldop(o0, bufp + (t + 2 < tn ? t + 2 : t) * (RW_REC * 4), cs, rp);
                  rw_step(T0, T1, o1, ybuf + (t + 1) * RH + 2 * rp, cs == 0);
              } asm volatile("" :: "v"(T0), "v"(T1)); }
#endif
            { RwOp o0, o1; rw_ldop(o0, bufp, cs, rp);
              for (int t = 0; t < tn; t += 2) {
                  rw_ldop(o1, bufp + (t + 1) * (RW_REC * 4), cs, rp);
                  rw_step(S0, S1, o0, ybuf + t * RH + 2 * rp, cs == 0);
                  rw_ldop(o0, bufp + (t + 2 < tn ? t + 2 : t) * (RW_REC * 4), cs, rp);
                  rw_step(S0, S1, o1, ybuf + (t + 1) * RH + 2 * rp, cs == 0);
              } }
            if (n + 1 < nch) RW_PREP(n + 1, (n + 1) & 1);
#if defined(PROBE_DUP) && (PROBE_DUP & (1 << 18))
            if (n + 1 < nch) RW_PREP(n + 1, (n + 1) & 1);
#endif
            __syncthreads();
            for (int t = w; t < tn; t += 8) {
                const LDSP float* rec = (const LDSP float*)(bufp + t * (RW_REC * 4));
                const float y = ybuf[t * RH + lane], mean = wsum_dpp(y) * (1.0f / RH), d = y - mean, var = wsum_dpp(d * d) * (1.0f / RH);
                const float yn = d * __builtin_amdgcn_rsqf(var + LNX_EPS) * p_lnw + p_lnb;
                const float o = (yn + rec[450] * rec[320 + lane]) * rec[384 + lane];
                fr.yo[(size_t)(m0 + n * RW_CH + t) * D + ch] = (bf16_t)(pk2bf(o, 0.f) & 0xffffu);
            }
            __syncthreads();
        }
#undef RW_LOADIN
#undef RW_PREP
        float* so = (sq < BATCH ? c.out + O_WKVP + (((size_t)j * BATCH + sq) * RHEADS + h) * RH * RH : c.out + O_WKVS + (((size_t)j * DB + (sq - BATCH)) * RHEADS + h) * RH * RH) + (size_t)(2 * rp) * RH + 4 * cs;
        *(pg8::f32x4*)so = S0; *(pg8::f32x4*)(so + RH) = S1;
    }
}
struct FastMb {
    bf16_t* zb;
    bf16_t* xbcr;
    float* dtraw;
    bf16_t* xbcb;
    float* dt;
    float* y;
    bf16_t* yzn;
    bf16_t *wbint, *wbot;
};
struct EpiMamba {
    static constexpr bool PERM = true;
    bf16_t* zb; bf16_t* xbcr; float* dtraw;
    __device__ __forceinline__ void operator()(const pg8::f32x4 (&acc)[2][2][4][2], const pg8::Unit& u, int wr, int wc, int fr, int fq) const {
        using namespace pg8;
        const int row0 = u.pm * BM + wr * 64 + fr, cl0 = wc * 32 + 8 * fq, pn = u.pn;
        if (pn < 20) {
            bf16_t* base = pn < 8 ? zb : xbcr; const int ldc = pn < 8 ? 2048 : 3072, coff = pn < 8 ? pn * 256 : (pn - 8) * 256;
#pragma unroll
            for (int ai = 0; ai < 2; ++ai)
#pragma unroll
                for (int m = 0; m < 4; ++m) { bf16_t* rowp = base + (size_t)(row0 + ai * HALF + m * 16) * ldc + coff + cl0;
#pragma unroll
                    for (int bj = 0; bj < 2; ++bj) { const f32x4 v0 = acc[ai][bj][m][0], v1 = acc[ai][bj][m][1];
                        u32x4 w; w.x = cvt_pk_bf16(v0[0], v0[1]); w.y = cvt_pk_bf16(v0[2], v0[3]); w.z = cvt_pk_bf16(v1[0], v1[1]); w.w = cvt_pk_bf16(v1[2], v1[3]);
                        *(u32x4*)(rowp + bj * HALF) = w; } }
        } else if (cl0 < 32) {
#pragma unroll
            for (int ai = 0; ai < 2; ++ai)
#pragma unroll
                for (int m = 0; m < 4; ++m) { float* rowp = dtraw + (size_t)(row0 + ai * HALF + m * 16) * 32 + cl0;
                    *(f32x4*)rowp = acc[ai][0][m][0]; *(f32x4*)(rowp + 4) = acc[ai][0][m][1]; }
        }
    }
};
__device__ __forceinline__ void mb_conv_fast(const Ctx& c, const FastMb& fb, int l, size_t gtid, size_t gsz, bool write_f32) {
    using namespace cfg; const int j = l / 3; constexpr int NB = MB_CD / 8, TB = 8;
    const int tstride = (int)(gsz / NB), cbi = (int)(gtid % NB), tb0 = (int)(gtid / NB);
    if (tb0 < tstride) {
    const int cb = cbi * 8;
    float wt[MB_CONV][8], bias[8];
        { const pg8::f32x4 b0 = *(const pg8::f32x4*)(c.in[I_CONVB] + j * MB_CD + cb), b1 = *(const pg8::f32x4*)(c.in[I_CONVB] + j * MB_CD + cb + 4);
#pragma unroll
          for (int e = 0; e < 4; ++e) { bias[e] = b0[e]; bias[4 + e] = b1[e]; } }
#pragma unroll
        for (int jj = 0; jj < MB_CONV; ++jj) { const float* wp_ = c.in[I_CONVW] + ((size_t)j * MB_CONV + jj) * MB_CD + cb; const pg8::f32x4 w0 = *(const pg8::f32x4*)wp_, w1 = *(const pg8::f32x4*)(wp_ + 4);
#pragma unroll
            for (int e = 0; e < 4; ++e) { wt[jj][e] = w0[e]; wt[jj][4 + e] = w1[e]; } }
    for (int tbi = tb0; tbi < MTOT / TB; tbi += tstride) {
        const int mb = tbi * TB, t0 = row_t(mb), sq = row_seq(mb), T = seq_len(sq);
        float win[MB_CONV][8];
#pragma unroll
        for (int jj = 0; jj < MB_CONV - 1; ++jj) {
            const int tt = t0 + jj - (MB_CONV - 1);
            if (tt >= 0) { const pg8::u32x4 raw = *(const pg8::u32x4*)(fb.xbcr + (size_t)(mb + jj - (MB_CONV - 1)) * MB_CD + cb); const unsigned wv[4] = {raw.x, raw.y, raw.z, raw.w};
#pragma unroll
                for (int q = 0; q < 4; ++q) { win[jj][2 * q] = __uint_as_float(wv[q] << 16); win[jj][2 * q + 1] = __uint_as_float(wv[q] & 0xffff0000u); } }
            else if (sq >= BATCH) { const float* st = c.in[I_CONV] + (((size_t)j * DB + (sq - BATCH)) * (MB_CONV - 1) + (tt + MB_CONV - 1)) * MB_CD + cb;
#pragma unroll
                for (int e = 0; e < 8; ++e) win[jj][e] = st[e]; }
            else {
#pragma unroll
                for (int e = 0; e < 8; ++e) win[jj][e] = 0.f; }
        }
#pragma unroll
        for (int tb = 0; tb < TB; ++tb) {
            const int m = mb + tb, t = t0 + tb;
            { const pg8::u32x4 raw = *(const pg8::u32x4*)(fb.xbcr + (size_t)m * MB_CD + cb); const unsigned wv[4] = {raw.x, raw.y, raw.z, raw.w};
#pragma unroll
              for (int q = 0; q < 4; ++q) { win[3][2 * q] = __uint_as_float(wv[q] << 16); win[3][2 * q + 1] = __uint_as_float(wv[q] & 0xffff0000u); } }
            if (t >= T - (MB_CONV - 1)) {
                float* so = (sq < BATCH ? c.out + O_CONVP + (((size_t)j * BATCH + sq) * (MB_CONV - 1) + (t - (T - (MB_CONV - 1)))) * MB_CD
                                        : c.out + O_CONVS + (((size_t)j * DB + (sq - BATCH)) * (MB_CONV - 1) + (t - (T - (MB_CONV - 1)))) * MB_CD) + cb;
#pragma unroll
                for (int e = 0; e < 8; ++e) so[e] = win[3][e];
            }
            unsigned w[4];
#pragma unroll
            for (int q = 0; q < 4; ++q) {
                float a0 = bias[2 * q], a1 = bias[2 * q + 1];
#pragma unroll
                for (int jj = 0; jj < MB_CONV; ++jj) { a0 += win[jj][2 * q] * wt[jj][2 * q]; a1 += win[jj][2 * q + 1] * wt[jj][2 * q + 1]; }
                a0 = a0 * __builtin_amdgcn_rcpf(1.0f + __expf(-a0)); a1 = a1 * __builtin_amdgcn_rcpf(1.0f + __expf(-a1));
                w[q] = pk2bf(a0, a1); if (write_f32) { c.xbc[(size_t)m * MB_CD + cb + 2 * q] = a0; c.xbc[(size_t)m * MB_CD + cb + 2 * q + 1] = a1; } }
            *(pg8::u32x4*)(fb.xbcb + (size_t)m * MB_CD + cb) = (pg8::u32x4){w[0], w[1], w[2], w[3]};
#pragma unroll
            for (int jj = 0; jj < MB_CONV - 1; ++jj)
#pragma unroll
                for (int e = 0; e < 8; ++e) win[jj][e] = win[jj + 1][e];
        }
    }
    }
    for (size_t i = gtid; i < (size_t)MTOT * MB_HEADS; i += gsz) {
        const float v = softplusf_(fb.dtraw[i] + c.in[I_DTB][j * MB_HEADS + (int)(i % MB_HEADS)]);
        fb.dt[i] = v; if (write_f32) c.dt[i] = v;
    }
}
__device__ __forceinline__ void mb_gate_fast(const Ctx& c, const FastMb& fb, const float* __restrict__ y, int l, int gw, int ngw, int lane) {
    using namespace cfg; const int j = l / 3; constexpr int GW_ = MB_INNER / MB_GROUPS;
    const int g0 = gw % MB_GROUPS; const bool gfix = (ngw % MB_GROUPS) == 0;
    const float* nwp0 = c.in[I_BNORM] + j * MB_INNER + g0 * GW_ + 8 * lane; const pg8::f32x4 n0h = *(const pg8::f32x4*)nwp0, n1h = *(const pg8::f32x4*)(nwp0 + 4);
    for (int it = gw; it < MTOT * MB_GROUPS; it += ngw) {
        const int m = it / MB_GROUPS, g = it % MB_GROUPS; const size_t o = (size_t)m * MB_INNER + g * GW_ + 8 * lane;
        const pg8::f32x4 y0 = *(const pg8::f32x4*)(y + o), y1 = *(const pg8::f32x4*)(y + o + 4); const pg8::u32x4 zr = *(const pg8::u32x4*)(fb.zb + o);
        const unsigned zw[4] = {zr.x, zr.y, zr.z, zr.w}; float v[8]; float s = 0.f;
#pragma unroll
        for (int q = 0; q < 4; ++q) { const float z0 = __uint_as_float(zw[q] << 16), z1 = __uint_as_float(zw[q] & 0xffff0000u);
            v[2 * q] = (q < 2 ? y0[2 * q] : y1[2 * q - 4]) * siluf_(z0); v[2 * q + 1] = (q < 2 ? y0[2 * q + 1] : y1[2 * q - 3]) * siluf_(z1); s += v[2 * q] * v[2 * q] + v[2 * q + 1] * v[2 * q + 1]; }
        const float rs = 1.0f / sqrtf(wave_sum64(s) * (1.0f / GW_) + NORM_EPS);
        pg8::f32x4 n0 = n0h, n1 = n1h; if (!gfix) { const float* nwp = c.in[I_BNORM] + j * MB_INNER + g * GW_ + 8 * lane; n0 = *(const pg8::f32x4*)nwp; n1 = *(const pg8::f32x4*)(nwp + 4); }
        const float nw[8] = {n0[0], n0[1], n0[2], n0[3], n1[0], n1[1], n1[2], n1[3]}; unsigned w[4];
#pragma unroll
        for (int q = 0; q < 4; ++q) w[q] = pk2bf(v[2 * q] * rs * nw[2 * q], v[2 * q + 1] * rs * nw[2 * q + 1]);
        *(pg8::u32x4*)(fb.yzn + o) = (pg8::u32x4){w[0], w[1], w[2], w[3]};
    }
}
constexpr int SS_XR = 144, SS_BR = 272;
constexpr int SS_XIM = 0, SS_XSM = SS_XIM + 128 * SS_XR, SS_BIM = SS_XSM + 128 * SS_XR, SS_CIM = SS_BIM + 128 * SS_BR, SS_MTM = SS_CIM + 128 * SS_BR, SS_HBM = SS_MTM + 128 * SS_BR, SS_TAB = SS_HBM + 128 * SS_XR, SS_END = SS_TAB + 2048;
__device__ __forceinline__ bf16x8v ss_trfrag(const LDSP unsigned char* img, int rowstride, int k0, int col0, int lane) {
    const int r0 = k0 + 8 * (lane >> 5) + ((lane & 15) >> 2), cc = col0 + 16 * ((lane >> 4) & 1) + 4 * (lane & 3);
    const s16x4 t0 = __builtin_amdgcn_ds_read_tr16_b64_v4i16((LDSP s16x4*)(img + r0 * rowstride + cc * 2));
    const s16x4 t1 = __builtin_amdgcn_ds_read_tr16_b64_v4i16((LDSP s16x4*)(img + (r0 + 4) * rowstride + cc * 2));
    return (bf16x8v){t0[0], t0[1], t0[2], t0[3], t1[0], t1[1], t1[2], t1[3]};
}
__device__ __forceinline__ void mb_ssd_prompt(const Ctx& c, const FastMb& fb, int l, LDSP unsigned char* lds) {
    using namespace cfg; const int j = l / 3;
    const int tid = (int)tid_now(), w = __builtin_amdgcn_readfirstlane(tid >> 6), lane = tid & 63, l31 = lane & 31, h5 = lane >> 5;
    LDSP float* tab = (LDSP float*)(lds + SS_TAB);
    for (int chain = blockIdx.x; chain < BATCH * MB_HEADS; chain += gridDim.x) {
        const int b = chain / MB_HEADS, hd = chain % MB_HEADS, g = hd / (MB_HEADS / MB_GROUPS);
        const float Ah = -expf(c.in[I_ALOG][j * MB_HEADS + hd]), Dh = c.in[I_BD][j * MB_HEADS + hd];
        f32x16_t H;
#pragma unroll
        for (int r = 0; r < 16; ++r) H[r] = 0.f;
        pg8::u32x4 nx[2], nB[4], nC[4]; float ndt0 = 0.f, ndt1 = 0.f;
#define SS_LOAD(ck_) do { const size_t mm_ = (size_t)b * SEQ + 128 * (ck_); int tq_ = tid; asm volatile("" : "+v"(tq_)); \
            _Pragma("unroll") for (int q = 0; q < 2; ++q) { const int ci = tq_ + 512 * q; nx[q] = *(const pg8::u32x4*)(fb.xbcb + (mm_ + (ci >> 3)) * MB_CD + hd * MB_HEAD + (ci & 7) * 8); } \
            _Pragma("unroll") for (int q = 0; q < 4; ++q) { const int ci = tq_ + 512 * q; const bf16_t* rowp = fb.xbcb + (mm_ + (ci >> 4)) * MB_CD + MB_INNER + g * MB_STATE + (ci & 15) * 8; \
                nB[q] = *(const pg8::u32x4*)rowp; nC[q] = *(const pg8::u32x4*)(rowp + MB_GN); } \
            ndt0 = fb.dt[(mm_ + 2 * (tq_ & 63)) * MB_HEADS + hd]; ndt1 = fb.dt[(mm_ + 2 * (tq_ & 63) + 1) * MB_HEADS + hd]; } while (0)
        SS_LOAD(0);
        for (int ck = 0; ck < SEQ / 128; ++ck) {
            const size_t m0 = (size_t)b * SEQ + 128 * ck;
            int tl = tid; asm volatile("" : "+v"(tl));
            pg8::u32x4 xr[2];
#pragma unroll
            for (int q = 0; q < 2; ++q) { const int ci = tl + 512 * q; xr[q] = nx[q];
                *(LDSP pg8::u32x2*)(lds + SS_XIM + (ci >> 3) * SS_XR + (ci & 7) * 16) = (pg8::u32x2){xr[q].x, xr[q].y}; *(LDSP pg8::u32x2*)(lds + SS_XIM + (ci >> 3) * SS_XR + (ci & 7) * 16 + 8) = (pg8::u32x2){xr[q].z, xr[q].w}; }
#pragma unroll
            for (int q = 0; q < 4; ++q) { const int ci = tl + 512 * q;
                *(LDSP pg8::u32x4*)(lds + SS_BIM + (ci >> 4) * SS_BR + (ci & 15) * 16) = nB[q];
                *(LDSP pg8::u32x4*)(lds + SS_CIM + (ci >> 4) * SS_BR + (ci & 15) * 16) = nC[q]; }
            float alast;
            { const float v0 = ndt0 * Ah, v1 = ndt1 * Ah; float sacc = v0 + v1;
#pragma unroll
              for (int o = 1; o < 64; o <<= 1) { const float u = __shfl_up(sacc, o); if (lane >= o) sacc += u; }
              tab[2 * lane] = sacc - v1; tab[2 * lane + 1] = sacc; tab[128 + 2 * lane] = ndt0; tab[128 + 2 * lane + 1] = ndt1;
              alast = __int_as_float(__builtin_amdgcn_readlane(__float_as_int(sacc), 63)); }
            if (ck + 1 < SEQ / 128) SS_LOAD(ck + 1);
            asm volatile("s_waitcnt lgkmcnt(0)" ::: "memory");
#pragma unroll
            for (int q = 0; q < 2; ++q) { const int ci = tl + 512 * q, row = ci >> 3; const float sc = __expf(alast - tab[row]) * tab[128 + row]; const unsigned xw[4] = {xr[q].x, xr[q].y, xr[q].z, xr[q].w}; unsigned ow[4];
#pragma unroll
                for (int e = 0; e < 4; ++e) ow[e] = pk2bf(__uint_as_float(xw[e] << 16) * sc, __uint_as_float(xw[e] & 0xffff0000u) * sc);
                *(LDSP pg8::u32x2*)(lds + SS_XSM + row * SS_XR + (ci & 7) * 16) = (pg8::u32x2){ow[0], ow[1]}; *(LDSP pg8::u32x2*)(lds + SS_XSM + row * SS_XR + (ci & 7) * 16 + 8) = (pg8::u32x2){ow[2], ow[3]}; }
            __syncthreads();
            { int ln = lane; asm volatile("" : "+v"(ln)); const int a31 = ln & 31, a5 = ln >> 5;
              for (int tt = w; tt < 10; tt += 8) {
                int ib = tt < 1 ? 0 : (tt < 3 ? 1 : (tt < 6 ? 2 : 3)); const int jb = tt - (ib * (ib + 1)) / 2;
                f32x16_t ST;
#pragma unroll
                for (int r = 0; r < 16; ++r) ST[r] = 0.f;
#pragma unroll
                for (int s = 0; s < 8; ++s) { const bf16x8v a = *(const LDSP bf16x8v*)(lds + SS_BIM + (32 * jb + a31) * SS_BR + (16 * s + 8 * a5) * 2), bb = *(const LDSP bf16x8v*)(lds + SS_CIM + (32 * ib + a31) * SS_BR + (16 * s + 8 * a5) * 2);
                    ST = MFMA32(a, bb, ST); }
                const float ai = tab[32 * ib + a31];
#pragma unroll
                for (int g4 = 0; g4 < 4; ++g4) { const int jr = 32 * jb + 8 * g4 + 4 * a5; const pg8::f32x4 aj = *(const LDSP pg8::f32x4*)(tab + jr), dj = *(const LDSP pg8::f32x4*)(tab + 128 + jr);
#pragma unroll
                    for (int e = 0; e < 4; ++e) { const int jj = jr + e, ii = 32 * ib + a31; const float mv = jj <= ii ? ST[4 * g4 + e] * __expf(ai - aj[e]) * dj[e] : 0.f;
                        *(LDSP bf16_t*)(lds + SS_MTM + jj * SS_BR + ii * 2) = (bf16_t)(pk2bf(mv, 0.f) & 0xffffu); } }
              }
              const int nb = w >> 1, pb = w & 1;
#pragma unroll
              for (int r = 0; r < 16; ++r) *(LDSP bf16_t*)(lds + SS_HBM + (32 * nb + (r & 3) + 8 * (r >> 2) + 4 * a5) * SS_XR + (32 * pb + a31) * 2) = (bf16_t)(pk2bf(H[r], 0.f) & 0xffffu);
            }
            __syncthreads();
            { int ln = lane; asm volatile("" : "+v"(ln)); const int a31 = ln & 31, a5 = ln >> 5;
              const int pb = w & 1, ib = w >> 1, nb = w >> 1;
              f32x16_t Y;
#pragma unroll
              for (int r = 0; r < 16; ++r) Y[r] = 0.f;
#pragma unroll
              for (int s = 0; s < 8; ++s) { const bf16x8v a = ss_trfrag(lds + SS_HBM, SS_XR, 16 * s, 32 * pb, ln), bb = *(const LDSP bf16x8v*)(lds + SS_CIM + (32 * ib + a31) * SS_BR + (16 * s + 8 * a5) * 2);
                  Y = MFMA32(a, bb, Y); if (s & 1) __builtin_amdgcn_sched_barrier(0); }
              const float ei = __expf(tab[32 * ib + a31]);
#pragma unroll
              for (int r = 0; r < 16; ++r) Y[r] *= ei;
              for (int s = 0; s < 2 * (ib + 1); ++s) { const bf16x8v a = ss_trfrag(lds + SS_XIM, SS_XR, 16 * s, 32 * pb, ln), bb = ss_trfrag(lds + SS_MTM, SS_BR, 16 * s, 32 * ib, ln);
                  Y = MFMA32(a, bb, Y); }
              { const size_t mrow = m0 + 32 * ib + a31; float* yrow = fb.y + mrow * MB_INNER + hd * MB_HEAD + 32 * pb + 4 * a5;
#pragma unroll
                for (int g4 = 0; g4 < 4; ++g4) { const pg8::u32x2 xv = *(const LDSP pg8::u32x2*)(lds + SS_XIM + (32 * ib + a31) * SS_XR + (32 * pb + 8 * g4 + 4 * a5) * 2);
                    pg8::f32x4 o; o[0] = Y[4 * g4] + Dh * __uint_as_float(xv.x << 16); o[1] = Y[4 * g4 + 1] + Dh * __uint_as_float(xv.x & 0xffff0000u); o[2] = Y[4 * g4 + 2] + Dh * __uint_as_float(xv.y << 16); o[3] = Y[4 * g4 + 3] + Dh * __uint_as_float(xv.y & 0xffff0000u);
                    *(pg8::f32x4*)(yrow + 8 * g4) = o; } }
              const float dec = __expf(tab[127]);
#pragma unroll
              for (int r = 0; r < 16; ++r) H[r] *= dec;
#pragma unroll
              for (int s = 0; s < 8; ++s) { const bf16x8v a = ss_trfrag(lds + SS_BIM, SS_BR, 16 * s, 32 * nb, ln), bb = ss_trfrag(lds + SS_XSM, SS_XR, 16 * s, 32 * pb, ln);
                  H = MFMA32(a, bb, H); if (s & 1) __builtin_amdgcn_sched_barrier(0); }
            }
            __syncthreads();
        }
#undef SS_LOAD
        { const int nb = w >> 1, pb = w & 1; float* so = c.out + O_SSMP + (((size_t)j * BATCH + b) * MB_HEADS + hd) * MB_HEAD * MB_STATE;
#pragma unroll
          for (int r = 0; r < 16; ++r) so[(size_t)(32 * pb + l31) * MB_STATE + 32 * nb + (r & 3) + 8 * (r >> 2) + 4 * h5] = H[r]; }
    }
}
__device__ __forceinline__ void mb_scan_sample(const Ctx& c, const FastMb& fb, int l) {
    using namespace cfg; const int j = l / 3;
    const int tid = (int)tid_now(), p = tid >> 3, ns = tid & 7;
    pg8::f32x4 hn[4];
    { const int chain = blockIdx.x; if (chain < DB * MB_HEADS) { const size_t so = ((((size_t)j * DB + chain / MB_HEADS) * MB_HEADS + chain % MB_HEADS) * MB_HEAD + p) * MB_STATE + 16 * ns;
#pragma unroll
        for (int q = 0; q < 4; ++q) hn[q] = *(const pg8::f32x4*)(c.in[I_SSM] + so + 4 * q); } }
    for (int chain = blockIdx.x; chain < DB * MB_HEADS; chain += gridDim.x) {
        const int s = chain / MB_HEADS, hd = chain % MB_HEADS, g = hd / (MB_HEADS / MB_GROUPS);
        const float Ah = -expf(c.in[I_ALOG][j * MB_HEADS + hd]), Dh = c.in[I_BD][j * MB_HEADS + hd];
        const size_t so = ((((size_t)j * DB + s) * MB_HEADS + hd) * MB_HEAD + p) * MB_STATE + 16 * ns;
        float hs[16];
#pragma unroll
        for (int q = 0; q < 4; ++q) { hs[4 * q] = hn[q][0]; hs[4 * q + 1] = hn[q][1]; hs[4 * q + 2] = hn[q][2]; hs[4 * q + 3] = hn[q][3]; }
        { const int cn = chain + gridDim.x; if (cn < DB * MB_HEADS) { const size_t sn = ((((size_t)j * DB + cn / MB_HEADS) * MB_HEADS + cn % MB_HEADS) * MB_HEAD + p) * MB_STATE + 16 * ns;
#pragma unroll
            for (int q = 0; q < 4; ++q) hn[q] = *(const pg8::f32x4*)(c.in[I_SSM] + sn + 4 * q); } }
        float dtv[DS]; unsigned short xr[DS]; pg8::u32x4 Bq[DS][2], Cq[DS][2];
#pragma unroll
        for (int t = 0; t < DS; ++t) { const size_t m = (size_t)MP + s * DS + t; dtv[t] = fb.dt[m * MB_HEADS + hd]; xr[t] = fb.xbcb[m * MB_CD + hd * MB_HEAD + p];
            const bf16_t* Bp = fb.xbcb + m * MB_CD + MB_INNER + g * MB_STATE + 16 * ns; Bq[t][0] = *(const pg8::u32x4*)Bp; Bq[t][1] = *(const pg8::u32x4*)(Bp + 8);
            Cq[t][0] = *(const pg8::u32x4*)(Bp + MB_GN); Cq[t][1] = *(const pg8::u32x4*)(Bp + MB_GN + 8); }
#pragma unroll
        for (int t = 0; t < DS; ++t) {
            const size_t m = (size_t)MP + s * DS + t;
            const float dA = __expf(dtv[t] * Ah), xv = bf2f(xr[t]), xdt = xv * dtv[t];
            const unsigned bw[8] = {Bq[t][0].x, Bq[t][0].y, Bq[t][0].z, Bq[t][0].w, Bq[t][1].x, Bq[t][1].y, Bq[t][1].z, Bq[t][1].w};
            const unsigned cw[8] = {Cq[t][0].x, Cq[t][0].y, Cq[t][0].z, Cq[t][0].w, Cq[t][1].x, Cq[t][1].y, Cq[t][1].z, Cq[t][1].w};
            float yy = 0.f;
#pragma unroll
            for (int k = 0; k < 8; ++k) { hs[2 * k] = hs[2 * k] * dA + xdt * __uint_as_float(bw[k] << 16); hs[2 * k + 1] = hs[2 * k + 1] * dA + xdt * __uint_as_float(bw[k] & 0xffff0000u);
                yy += __uint_as_float(cw[k] << 16) * hs[2 * k] + __uint_as_float(cw[k] & 0xffff0000u) * hs[2 * k + 1]; }
            yy += __shfl_xor(yy, 1); yy += __shfl_xor(yy, 2); yy += __shfl_xor(yy, 4);
            if (ns == 0) fb.y[m * MB_INNER + hd * MB_HEAD + p] = yy + Dh * xv;
        }
        float* oo = c.out + O_SSMS + so;
#pragma unroll
        for (int q = 0; q < 4; ++q) *(pg8::f32x4*)(oo + 4 * q) = (pg8::f32x4){hs[4 * q], hs[4 * q + 1], hs[4 * q + 2], hs[4 * q + 3]};
    }
}
constexpr int RC_RS = 144;
constexpr int RC_AT = 0, RC_RT = 4608, RC_BB = 9216, RC_KB = 13824, RC_BH = 18432, RC_KH = 23040, RC_VV = 27648, RC_UT = 32256, RC_GG = 36864;
constexpr int RC_SB = 41472;
constexpr int RC_NAK = 50688, RC_MRB = 53248, RC_MRK = 55808, RC_NS = 80;
constexpr int RC_NAB = 58368;
constexpr int RC_E = 62464;
constexpr int RC_YB = 70656;
constexpr int RC_GL = 78848, RC_BON = 79104, RC_VV2 = 79360, RC_GG2 = RC_VV2 + 4608, RC_END0 = RC_GG2 + 4608;
constexpr int RC_WW = RC_END0, RC_WA = RC_WW + 64 * 144, RC_WG = RC_WA + 64 * 144, RC_WV = RC_WG + 64 * 336, RC_LUO = RC_WV + 64 * 80, RC_END = RC_LUO + 4 * 4608;
constexpr int RC_HB = RC_AT, RC_HBS = 784;
__device__ __forceinline__ bf16x8v rc_nat(const LDSP unsigned char* img, int stride, int row, int kofs) { return *(const LDSP bf16x8v*)(img + row * stride + kofs * 2); }
__device__ __forceinline__ int rc_row(int r, int h5) { return (r & 3) + 8 * (r >> 2) + 4 * h5; }
__device__ __forceinline__ void rc_st16(LDSP unsigned char* p, float v) { *(LDSP bf16_t*)p = (bf16_t)(pk2bf(v, 0.f) & 0xffffu); }


template <int S>
struct RcSub {
    static __device__ __forceinline__ void run(float (&acc)[32], const LDSP float* NAB, LDSP unsigned char* lds, int lane) {
        const float us = acc[S]; rc_st16(lds + RC_UT + S * RC_RS + lane * 2, us);
#pragma unroll
        for (int g4 = 0; g4 < 8; ++g4) { if (4 * g4 + 3 > S) { const pg8::f32x4 nv = *(const LDSP pg8::f32x4*)(NAB + S * 32 + 4 * g4);
#pragma unroll
            for (int e = 0; e < 4; ++e) { if (4 * g4 + e > S) acc[4 * g4 + e] = fmaf(nv[e], us, acc[4 * g4 + e]); } } }
        RcSub<S + 1>::run(acc, NAB, lds, lane);
    }
};
template <> struct RcSub<32> { static __device__ __forceinline__ void run(float (&)[32], const LDSP float*, LDSP unsigned char*, int) {} };

template <int J>
__device__ __forceinline__ void rw_scan_chunked(const Ctx& c, const FastRw& fr, LDSP unsigned char* lds) {
    using namespace cfg; constexpr int j = J;
    const int tid = (int)tid_now(), w = __builtin_amdgcn_readfirstlane(tid >> 6), lane = tid & 63, l31 = lane & 31, h5 = lane >> 5;
    LDSP float* Ef = (LDSP float*)(lds + RC_E); LDSP float* YB = (LDSP float*)(lds + RC_YB); LDSP float* GL = (LDSP float*)(lds + RC_GL); LDSP float* BON = (LDSP float*)(lds + RC_BON);
    LDSP float* NAB = (LDSP float*)(lds + RC_NAB);
    int hcur = -1;
    for (int chain = blockIdx.x; chain < NSEQ * RHEADS; chain += gridDim.x) {
        const int sq = chain / RHEADS, h = chain % RHEADS, T = seq_len(sq), m0 = seq_row0(sq), ch = h * RH + lane;
        const float p_w0 = c.in[I_W0][j * D + ch], p_a0 = c.in[I_A0][j * D + ch], p_kk = c.in[I_KK][j * D + ch], p_ka = c.in[I_KA][j * D + ch], p_rk = c.in[I_RK][(size_t)j * D + ch],
                    p_lnw = c.in[I_LNW][j * D + ch], p_lnb = c.in[I_LNB][j * D + ch], p_v0 = j > 0 ? c.in[I_V0][(j - 1) * D + ch] : 0.f;
        const int ib = (w >> 1) & 1, jb = w & 1;
        f32x16_t ST;
#pragma unroll
        for (int r = 0; r < 16; ++r) ST[r] = 0.f;
        if (w < 4 && sq >= BATCH) { const float* s0 = c.in[I_WKV] + (((size_t)j * DB + (sq - BATCH)) * RHEADS + h) * RH * RH;
#pragma unroll
            for (int r = 0; r < 16; ++r) ST[r] = s0[(size_t)(32 * ib + rc_row(r, h5)) * RH + 32 * jb + l31]; }
        const int nch = (T + 31) / 32;
        if (h != hcur) {
            __syncthreads();
            const bf16_t* lw = fr.lorat + (size_t)j * 4096 * 384;
            for (int ci = tid; ci < 64 * 8; ci += 512) { const int row = ci >> 3, c8 = ci & 7;
                *(LDSP pg8::u32x4*)(lds + RC_WW + row * 144 + c8 * 16) = *(const pg8::u32x4*)(lw + (size_t)(0 * 1024 + h * 64 + row) * 384 + 0 + c8 * 8);
                *(LDSP pg8::u32x4*)(lds + RC_WA + row * 144 + c8 * 16) = *(const pg8::u32x4*)(lw + (size_t)(1 * 1024 + h * 64 + row) * 384 + 64 + c8 * 8); }
            for (int ci = tid; ci < 64 * 20; ci += 512) { const int row = ci / 20, c20 = ci % 20;
                *(LDSP pg8::u32x4*)(lds + RC_WG + row * 336 + c20 * 16) = *(const pg8::u32x4*)(lw + (size_t)(2 * 1024 + h * 64 + row) * 384 + 128 + c20 * 8); }
            for (int ci = tid; ci < 64 * 4; ci += 512) { const int row = ci >> 2, c4 = ci & 3;
                *(LDSP pg8::u32x4*)(lds + RC_WV + row * 80 + c4 * 16) = *(const pg8::u32x4*)(lw + (size_t)(3 * 1024 + h * 64 + row) * 384 + 288 + c4 * 8); }
            hcur = h;
        }
        RwIn in[4]; pg8::u32x4 hbr[3];
#define RC_LOADIN(n) do { _Pragma("unroll") for (int q = 0; q < 4; ++q) { const int t_ = (n) * 32 + 4 * w + q; if (t_ < T) { const size_t m_ = (size_t)(m0 + t_); \
                const bf16_t* rk_ = fr.rkv + m_ * 3072 + ch; in[q].r = rk_[0]; in[q].k = rk_[1024]; in[q].v = rk_[2048]; \
                in[q].vf = j > 0 ? fr.vf[m_ * D + ch] : 0.f; } } \
            _Pragma("unroll") for (int k3 = 0; k3 < 3; ++k3) { const int ci_ = tid + 512 * k3, tk_ = ci_ / 48, t_ = (n) * 32 + tk_; \
                hbr[k3] = t_ < T ? *(const pg8::u32x4*)(fr.hb + (size_t)(m0 + t_) * 384 + (ci_ % 48) * 8) : (pg8::u32x4){0u, 0u, 0u, 0u}; } } while (0)
#define RC_EPI_TOKEN(nn, tl) do { const int vv_ = ((nn) & 1) ? RC_VV2 : RC_VV, gg_ = ((nn) & 1) ? RC_GG2 : RC_GG, bn_ = ((nn) & 1) ? 32 : 0; \
                const float y_ = YB[(tl) * 64 + lane], mean_ = wsum_dpp(y_) * (1.0f / RH), d_ = y_ - mean_, var_ = wsum_dpp(d_ * d_) * (1.0f / RH); \
                const float yn_ = d_ * __builtin_amdgcn_rsqf(var_ + LNX_EPS) * p_lnw + p_lnb; \
                const float o_ = (yn_ + BON[bn_ + (tl)] * bf2f(*(const LDSP bf16_t*)(lds + vv_ + (tl) * RC_RS + lane * 2))) * bf2f(*(const LDSP bf16_t*)(lds + gg_ + (tl) * RC_RS + lane * 2)); \
                fr.yo[(size_t)(m0 + (nn) * 32 + (tl)) * D + ch] = (bf16_t)(pk2bf(o_, 0.f) & 0xffffu); } while (0)
        __syncthreads();
        RC_LOADIN(0);
        for (int n = 0; n < nch; ++n) {
            const int tn = T - n * 32 < 32 ? T - n * 32 : 32;
            const int vvo = (n & 1) ? RC_VV2 : RC_VV, ggo = (n & 1) ? RC_GG2 : RC_GG, bno = (n & 1) ? 32 : 0;
#pragma unroll
            for (int k3 = 0; k3 < 3; ++k3) { const int ci_ = tid + 512 * k3; *(LDSP pg8::u32x4*)(lds + RC_HB + (ci_ / 48) * RC_HBS + (ci_ % 48) * 16) = hbr[k3]; }
            __syncthreads();
            { int ln = lane; asm volatile("" : "+v"(ln)); const int a31 = ln & 31, a5 = ln >> 5; const int grp = w >> 1, nb = w & 1;
              const int koff = grp == 0 ? 0 : (grp == 1 ? 64 : (grp == 2 ? 128 : 288)), nks = grp == 2 ? 10 : (grp == 3 ? 2 : 4);
              const int wof = grp == 0 ? RC_WW : (grp == 1 ? RC_WA : (grp == 2 ? RC_WG : RC_WV)), wst = grp == 2 ? 336 : (grp == 3 ? 80 : 144);
              f32x16_t LA;
#pragma unroll
              for (int r = 0; r < 16; ++r) LA[r] = 0.f;
              for (int ks = 0; ks < nks; ++ks) LA = MFMA32(rc_nat(lds + RC_HB, RC_HBS, a31, koff + 16 * ks + 8 * a5), rc_nat(lds + wof, wst, 32 * nb + a31, 16 * ks + 8 * a5), LA);
#pragma unroll
              for (int r = 0; r < 16; ++r) rc_st16(lds + RC_LUO + grp * 4608 + rc_row(r, a5) * RC_RS + (32 * nb + a31) * 2, LA[r]); }
            __syncthreads();
            float q_r[4], q_k[4], q_a[4], q_b[4], q_e[4];
#pragma unroll
            for (int q = 0; q < 4; ++q) {
                const int tl = 4 * w + q, tg = n * 32 + tl;
                float r_ = 0.f, k2_ = 0.f, v_ = 0.f, a_ = 0.f, b_ = 0.f, e_ = 0.f, g_ = 0.f, bon_ = 0.f;
                if (tg < T) {
                    r_ = bf2f(in[q].r); const float k0_ = bf2f(in[q].k); v_ = bf2f(in[q].v);
                    e_ = 0.6065306597126334f * fsigmoid(p_w0 + bf2f(*(const LDSP bf16_t*)(lds + RC_LUO + 0 * 4608 + tl * RC_RS + lane * 2)));
                    if (j == 0) fr.vf[(size_t)(m0 + tg) * D + ch] = v_; else v_ = v_ + (in[q].vf - v_) * fsigmoid(p_v0 + bf2f(*(const LDSP bf16_t*)(lds + RC_LUO + 3 * 4608 + tl * RC_RS + lane * 2)));
                    const float as_ = fsigmoid(p_a0 + bf2f(*(const LDSP bf16_t*)(lds + RC_LUO + 1 * 4608 + tl * RC_RS + lane * 2))); float kk_ = k0_ * p_kk;
                    k2_ = k0_ * (1.0f + (as_ - 1.0f) * p_ka);
                    float n_ = red16(kk_ * kk_), e1_ = red16(r_ * k2_ * p_rk);
                    n_ = (rdl(n_, 0) + rdl(n_, 16)) + (rdl(n_, 32) + rdl(n_, 48)); bon_ = (rdl(e1_, 0) + rdl(e1_, 16)) + (rdl(e1_, 32) + rdl(e1_, 48));
                    kk_ *= __builtin_amdgcn_rcpf(fmaxf(__builtin_amdgcn_sqrtf(n_), 1e-12f));
                    a_ = -kk_; b_ = kk_ * as_; g_ = bf2f(*(const LDSP bf16_t*)(lds + RC_LUO + 2 * 4608 + tl * RC_RS + lane * 2));
                }
                q_r[q] = r_; q_k[q] = k2_; q_a[q] = a_; q_b[q] = b_; q_e[q] = e_;
                Ef[tl * 64 + lane] = e_;
                rc_st16(lds + vvo + tl * RC_RS + lane * 2, v_); rc_st16(lds + ggo + tl * RC_RS + lane * 2, g_);
                if (lane == 0) BON[bno + tl] = bon_;
            }
            if (n + 1 < nch) RC_LOADIN(n + 1);
            if (w < 4) {
#pragma unroll
                for (int r = 0; r < 16; ++r) rc_st16(lds + RC_SB + (32 * ib + rc_row(r, h5)) * RC_RS + (32 * jb + l31) * 2, ST[r]);
            }
            __syncthreads();
            { float run = 0.f, base = 0.f;
#pragma unroll
              for (int s = 0; s < 32; ++s) { const float ev = Ef[s * 64 + lane]; if (s == 4 * w) base = run; run += ev; }
              const float cumL = run; float cum = base;
#pragma unroll
              for (int q = 0; q < 4; ++q) { const int tl = 4 * w + q; const float cprev = cum; cum += q_e[q];
                  const float gam = __expf(-cum), gamp = __expf(-cprev), ginv = __expf(cum), glr = __expf(cum - cumL);
                  rc_st16(lds + RC_AT + tl * RC_RS + lane * 2, q_a[q] * gamp); rc_st16(lds + RC_RT + tl * RC_RS + lane * 2, q_r[q] * gam);
                  rc_st16(lds + RC_BB + tl * RC_RS + lane * 2, q_b[q] * ginv); rc_st16(lds + RC_KB + tl * RC_RS + lane * 2, q_k[q] * ginv);
                  rc_st16(lds + RC_BH + tl * RC_RS + lane * 2, q_b[q] * glr); rc_st16(lds + RC_KH + tl * RC_RS + lane * 2, q_k[q] * glr); }
              if (w == 0) GL[lane] = __expf(-cumL); }
            __syncthreads();
            f32x16_t R1;
#pragma unroll
            for (int r = 0; r < 16; ++r) R1[r] = 0.f;
            { int ln = lane; asm volatile("" : "+v"(ln)); const int a31 = ln & 31, a5 = ln >> 5;
              if (w < 4) {
                  const int aoff = (w == 0) ? RC_BB : ((w < 2) ? RC_AT : RC_RT), boff = (w == 0) ? RC_AT : ((w & 1) ? RC_KB : RC_BB);
#pragma unroll
                  for (int ks = 0; ks < 4; ++ks) R1 = MFMA32(rc_nat(lds + aoff, RC_RS, a31, 16 * ks + 8 * a5), rc_nat(lds + boff, RC_RS, a31, 16 * ks + 8 * a5), R1);
#pragma unroll
                  for (int r = 0; r < 16; ++r) { const int rr = rc_row(r, a5), cc = a31;
                      if (w == 0) NAB[rr * 32 + cc] = (rr < cc) ? R1[r] : 0.f;
                      else { const bool keep = (w < 2) ? (cc < rr) : (cc <= rr); rc_st16(lds + (w == 1 ? RC_NAK : (w == 2 ? RC_MRB : RC_MRK)) + rr * RC_NS + cc * 2, keep ? R1[r] : 0.f); } }
              } else {
                  const int aoff = (w < 6) ? RC_AT : RC_RT, ibk = w & 1;
#pragma unroll
                  for (int ks = 0; ks < 4; ++ks) R1 = MFMA32(rc_nat(lds + aoff, RC_RS, a31, 16 * ks + 8 * a5), rc_nat(lds + RC_SB, RC_RS, 32 * ibk + a31, 16 * ks + 8 * a5), R1);
              } }
            __syncthreads();
            if (w == 4 || w == 5) { int ln = lane; asm volatile("" : "+v"(ln)); const int a31 = ln & 31, a5 = ln >> 5, ibk = w & 1;
#pragma unroll
                for (int ks = 0; ks < 2; ++ks) R1 = MFMA32(rc_nat(lds + RC_NAK, RC_NS, a31, 16 * ks + 8 * a5), ss_trfrag(lds + vvo, RC_RS, 16 * ks, 32 * ibk, ln), R1);
#pragma unroll
                for (int r = 0; r < 16; ++r) Ef[rc_row(r, a5) * 64 + 32 * ibk + a31] = R1[r]; }
            __syncthreads();
            if (w > 0 && n > 0) { for (int tl = w - 1; tl < 32; tl += 7) RC_EPI_TOKEN(n - 1, tl); }
            if (w == 0) { float acc[32];
#pragma unroll
                for (int t = 0; t < 32; ++t) acc[t] = Ef[t * 64 + lane];
                RcSub<0>::run(acc, NAB, lds, lane); }
            __syncthreads();
            { int ln = lane; asm volatile("" : "+v"(ln)); const int a31 = ln & 31, a5 = ln >> 5;
              if (w >= 6) { const int ibk = w & 1;
#pragma unroll
                  for (int ks = 0; ks < 2; ++ks) { R1 = MFMA32(rc_nat(lds + RC_MRB, RC_NS, a31, 16 * ks + 8 * a5), ss_trfrag(lds + RC_UT, RC_RS, 16 * ks, 32 * ibk, ln), R1);
                                                   R1 = MFMA32(rc_nat(lds + RC_MRK, RC_NS, a31, 16 * ks + 8 * a5), ss_trfrag(lds + vvo, RC_RS, 16 * ks, 32 * ibk, ln), R1); }
#pragma unroll
                  for (int r = 0; r < 16; ++r) YB[rc_row(r, a5) * 64 + 32 * ibk + a31] = R1[r];
              } else if (w < 4) { const float gl = GL[32 * jb + a31];
#pragma unroll
                  for (int r = 0; r < 16; ++r) ST[r] *= gl;
#pragma unroll
                  for (int ks = 0; ks < 2; ++ks) { ST = MFMA32(ss_trfrag(lds + RC_UT, RC_RS, 16 * ks, 32 * ib, ln), ss_trfrag(lds + RC_BH, RC_RS, 16 * ks, 32 * jb, ln), ST);
                                                   ST = MFMA32(ss_trfrag(lds + vvo, RC_RS, 16 * ks, 32 * ib, ln), ss_trfrag(lds + RC_KH, RC_RS, 16 * ks, 32 * jb, ln), ST); } } }
            __syncthreads();
        }
        { const int nl = nch - 1, tnl = T - nl * 32 < 32 ? T - nl * 32 : 32; for (int tl = w; tl < tnl; tl += 8) RC_EPI_TOKEN(nl, tl); }
#undef RC_EPI_TOKEN
#undef RC_LOADIN
        if (w < 4) { float* so = (sq < BATCH ? c.out + O_WKVP + (((size_t)j * BATCH + sq) * RHEADS + h) * RH * RH : c.out + O_WKVS + (((size_t)j * DB + (sq - BATCH)) * RHEADS + h) * RH * RH);
#pragma unroll
            for (int r = 0; r < 16; ++r) so[(size_t)(32 * ib + rc_row(r, h5)) * RH + 32 * jb + l31] = ST[r]; }
    }
}
template <int ACT, bool ACC>
__device__ __forceinline__ void gemm_dev(const float* __restrict__ A, int lda, const float* __restrict__ B, int ldb, float* C, int ldc, int M, int N, int K, unsigned short (*As)[40], unsigned short (*Bs)[40]) {
    const int tid = threadIdx.x, wave = tid >> 6, lane = tid & 63, wr = wave >> 1, wc = wave & 1, fr = lane & 15, fq = lane >> 4;
    const int ntn = (N + 127) / 128, ntm = (M + 127) / 128;
    for (int tile = blockIdx.x; tile < ntm * ntn; tile += gridDim.x) {
        const int bm = (tile / ntn) * 128, bn = (tile % ntn) * 128;
        f32x4_t acc[2][4];
#pragma unroll
        for (int i = 0; i < 2; ++i)
#pragma unroll
            for (int j = 0; j < 4; ++j) acc[i][j] = (f32x4_t){0.f, 0.f, 0.f, 0.f};
        for (int k0 = 0; k0 < K; k0 += 32) {
#pragma unroll
            for (int it = 0; it < 2; ++it) {
                const int idx = tid + it * 512, row = idx >> 3, c4 = idx & 7, gm = bm + row;
                float4 v = make_float4(0.f, 0.f, 0.f, 0.f);
                if (gm < M) v = *(const float4*)(A + (size_t)gm * lda + k0 + c4 * 4);
                uint2 w; w.x = (unsigned)f2bf(v.x) | ((unsigned)f2bf(v.y) << 16); w.y = (unsigned)f2bf(v.z) | ((unsigned)f2bf(v.w) << 16);
                *(uint2*)&As[row][c4 * 4] = w;
            }
#pragma unroll
            for (int it = 0; it < 2; ++it) {
                const int idx = tid + it * 512, kr = idx >> 5, n4 = idx & 31, gn = bn + n4 * 4;
                float4 v = make_float4(0.f, 0.f, 0.f, 0.f);
                if (gn < N) v = *(const float4*)(B + (size_t)(k0 + kr) * ldb + gn);
                Bs[n4 * 4 + 0][kr] = f2bf(v.x); Bs[n4 * 4 + 1][kr] = f2bf(v.y); Bs[n4 * 4 + 2][kr] = f2bf(v.z); Bs[n4 * 4 + 3][kr] = f2bf(v.w);
            }
            __syncthreads();
            bf16x8_t a[2], b[4];
#pragma unroll
            for (int i = 0; i < 2; ++i) a[i] = *(const bf16x8_t*)&As[wr * 32 + i * 16 + fr][fq * 8];
#pragma unroll
            for (int j = 0; j < 4; ++j) b[j] = *(const bf16x8_t*)&Bs[wc * 64 + j * 16 + fr][fq * 8];
#pragma unroll
            for (int i = 0; i < 2; ++i)
#pragma unroll
                for (int j = 0; j < 4; ++j) acc[i][j] = __builtin_amdgcn_mfma_f32_16x16x32_bf16(a[i], b[j], acc[i][j], 0, 0, 0);
            __syncthreads();
        }
#pragma unroll
        for (int i = 0; i < 2; ++i)
#pragma unroll
            for (int j = 0; j < 4; ++j)
#pragma unroll
                for (int e = 0; e < 4; ++e) {
                    const int row = bm + wr * 32 + i * 16 + fq * 4 + e, col = bn + wc * 64 + j * 16 + fr;
                    if (row < M && col < N) {
                        float v = acc[i][j][e];
                        if (ACT == 1) v = tanhf(v); else if (ACT == 2) v = 1.0f / (1.0f + expf(-v)); else if (ACT == 3) v = v > 0.f ? v * v : 0.f;
                        float* cp = C + (size_t)row * ldc + col; *cp = ACC ? *cp + v : v;
                    }
                }
    }
}

#define MRUN(ph, l) do { ph(c, l, gtid, gsz); xcd_barrier(bar); } while (0)
#define MGEMM(ACT, ACC, A, lda, B, ldb, C, ldc, M, N, K) do { gemm_dev<ACT, ACC>(A, lda, B, ldb, C, ldc, M, N, K, As, Bs); xcd_barrier(bar); } while (0)
#define KS_FFN 16
#define KS_1K 4
#define KS_MB 8
#ifndef ACC_KSPLIT
#define ACC_KSPLIT 1
#endif
#ifndef FFN_DOWN_KSPLIT
#define FFN_DOWN_KSPLIT 1
#endif
#define GBAR() xcd_barrier(bar)
#ifndef PROBE_DUP
#define PROBE_DUP 0
#endif
#define DUP(bit, ...) do { __VA_ARGS__; if (PROBE_DUP & (1 << (bit))) { GBAR(); __VA_ARGS__; } } while (0)
#define GTID_NOW() ((size_t)blockIdx.x * 512 + tid_now())
#define GSZ_NOW() ((size_t)gridDim.x * 512)
#define GW_NOW() ((int)(blockIdx.x * 8 + (tid_now() >> 6)))
#define NGW_NOW() ((int)(gridDim.x * 8))
#define LANE_NOW() ((int)(tid_now() & 63))
#undef MRUN
#undef MGEMM
#define MRUN(ph, l) do { ph(c, l, GTID_NOW(), GSZ_NOW()); xcd_barrier(bar); } while (0)
#define MGEMM(ACT, ACC, A, lda, B, ldb, C, ldc, M, N, K) do { gemm_dev<ACT, ACC>(A, lda, B, ldb, C, ldc, M, N, K, (unsigned short (*)[40])dynlds, (unsigned short (*)[40])(dynlds + 128 * 40 * 2)); xcd_barrier(bar); } while (0)
extern __shared__ __attribute__((aligned(16))) unsigned char dynlds[];

struct MegaArgs { Ctx c; Fast f; FastMla fm; FastRw fr; FastMb fb; unsigned* bar; };
constexpr int LDS_STAGE = 0, LDS_XB = 163840 - 64, LDS_BYTES = 163840;
static_assert(SD_END <= LDS_XB && SS_END <= LDS_XB && RC_END <= LDS_XB, "LDS map");

template <int L>
__device__ __forceinline__ void layer_mix_naive(const Ctx& c, const XcdBarrier& bar) {
    using namespace cfg;
    constexpr int l = L, kind = L % 3, j = L / 3;
    MRUN(ph_norm_mix, l);
    if constexpr (kind == 0) {
        MRUN(ph_rw_mix, l);
        const float* W = c.in[I_WRKV] + (size_t)j * 3 * D * D;
        MGEMM(0, false, c.xm[0], D, W, D, c.r, D, MTOT, D, D);
        MGEMM(0, false, c.xm[1], D, W + (size_t)D * D, D, c.k, D, MTOT, D, D);
        MGEMM(0, false, c.xm[2], D, W + (size_t)2 * D * D, D, c.v, D, MTOT, D, D);
        MGEMM(1, false, c.xm[3], D, c.in[I_W1] + (size_t)j * D * RW_DL, RW_DL, c.hw, RW_DL, MTOT, RW_DL, D);
        MGEMM(0, false, c.hw, RW_DL, c.in[I_W2] + (size_t)j * RW_DL * D, D, c.wpre, D, MTOT, D, RW_DL);
        MGEMM(0, false, c.xm[4], D, c.in[I_A1] + (size_t)j * D * RW_AL, RW_AL, c.ha, RW_AL, MTOT, RW_AL, D);
        MGEMM(0, false, c.ha, RW_AL, c.in[I_A2] + (size_t)j * RW_AL * D, D, c.apre, D, MTOT, D, RW_AL);
        if constexpr (j > 0) {
            MGEMM(0, false, c.xm[2], D, c.in[I_V1] + (size_t)(j - 1) * D * RW_VL, RW_VL, c.hv, RW_VL, MTOT, RW_VL, D);
            MGEMM(0, false, c.hv, RW_VL, c.in[I_V2] + (size_t)(j - 1) * RW_VL * D, D, c.vpre, D, MTOT, D, RW_VL);
        }
        MGEMM(2, false, c.xm[5], D, c.in[I_G1] + (size_t)j * D * RW_GL, RW_GL, c.hg, RW_GL, MTOT, RW_GL, D);
        MGEMM(0, false, c.hg, RW_GL, c.in[I_G2] + (size_t)j * RW_GL * D, D, c.g, D, MTOT, D, RW_GL);
        MRUN(ph_rw_prep, l); MRUN(ph_rw_scan, l); MRUN(ph_rw_post, l);
        MGEMM(0, true, c.yo, D, c.in[I_RWO] + (size_t)j * D * D, D, c.x, D, MTOT, D, D);
    } else if constexpr (kind == 1) {
        MGEMM(0, false, c.xn, D, c.in[I_MWIN] + (size_t)j * D * MLA_IN, MLA_IN, c.mh, MLA_IN, MTOT, MLA_IN, D);
        MRUN(ph_mla_norm1, l);
        MGEMM(0, false, c.qan, QL, c.in[I_WUQ] + (size_t)j * QL * MH * QD, MH * QD, c.q, MH * QD, MTOT, MH * QD, QL);
        MGEMM(0, false, c.c, KVL, c.in[I_WUK] + (size_t)j * KVL * MH * NOPE, MH * NOPE, c.knr, MH * NOPE, MTOT, MH * NOPE, KVL);
        MGEMM(0, false, c.c, KVL, c.in[I_WUV] + (size_t)j * KVL * MH * VD, MH * VD, c.vv, MH * VD, MTOT, MH * VD, KVL);
        MRUN(ph_mla_norm2, l); MRUN(ph_mla_attn_prompt, l); MRUN(ph_mla_score_sample, l); MRUN(ph_mla_softmax_sample, l); MRUN(ph_mla_pv_sample, l); MRUN(ph_mla_out_sample, l);
        MGEMM(0, true, c.ao, MH * VD, c.in[I_MWO] + (size_t)j * MH * VD * D, D, c.x, D, MTOT, D, MH * VD);
    } else {
        MGEMM(0, false, c.xn, D, c.in[I_BWIN] + (size_t)j * D * MB_IN, MB_IN, c.zx, MB_IN, MTOT, MB_IN, D);
        MRUN(ph_mb_conv, l); MRUN(ph_mb_dt, l); MRUN(ph_mb_scan, l); MRUN(ph_mb_gate, l);
        MGEMM(0, true, c.yzn, MB_INNER, c.in[I_BWO] + (size_t)j * MB_INNER * D, D, c.x, D, MTOT, D, MB_INNER);
    }
}


template <int L>
__device__ __forceinline__ void layer_rwkv_fast(const Ctx& c, const Fast& f, const FastRw& fr, const XcdBarrier& bar, LDSP unsigned char* lds) {
    using namespace cfg;
    constexpr int l = L, j = L / 3;
    if (L > 0) { fold_sample_rows(c.x, f.slab, KS_FFN, GW_NOW(), NGW_NOW(), LANE_NOW()); GBAR(); }
    DUP(9, rw_mix_fast(c, fr, l, GW_NOW(), NGW_NOW(), LANE_NOW()));
    GBAR();
    DUP(7, { pg8::Order<RwSel> S; S.init(MP / 256, MS / 256, 16, D, 1, gridDim.x, blockIdx.x);
      pg8::gemm_phase(lds, pg8::Gemm{fr.xm, fr.wrkvt + (size_t)j * 4096 * D, D, D, (size_t)MTOT * D}, S, EpiRwkv{fr.rkv, fr.hb}); });
    GBAR();
    DUP(2, rw_scan_chunked<j>(c, fr, lds));
    GBAR();
    { pg8::Order<> S; S.init(MP / 256, MS / 256, 4, D, KS_1K, gridDim.x, blockIdx.x);
      pg8::gemm_phase(lds, pg8::Gemm{fr.yo, fr.wot + (size_t)j * D * D, D, D, 0}, S, pg8::EpiAccF32{c.x, D, f.slab, MP / 256, MS / 256, KS_1K}); }
    if (PROBE_DUP & (1 << 26)) { GBAR(); pg8::Order<> S; S.init(MP / 256, MS / 256, 4, D, KS_1K, gridDim.x, blockIdx.x);
      pg8::gemm_phase(lds, pg8::Gemm{fr.yo, fr.wot + (size_t)j * D * D, D, D, 0}, S, pg8::EpiAccF32{c.hmid, D, f.slab + (size_t)16 * 16 * 65536, MP / 256, MS / 256, KS_1K}); }
    GBAR();
}

__device__ __forceinline__ void layer_mamba_fast(const Ctx& c, const Fast& f, const FastMb& fb, const XcdBarrier& bar, LDSP unsigned char* lds) {
    using namespace cfg;
    constexpr int l = 2, j = 0;
    norm_rows_bf16(c.x, c.in[I_NMIX] + l * D, f.xnb, f.slab, KS_FFN, GW_NOW(), NGW_NOW(), LANE_NOW());
    GBAR();
    DUP(8, { pg8::Order<> S; S.init(MP / 256, MS / 256, 21, D, 1, gridDim.x, blockIdx.x);
      pg8::gemm_phase(lds, pg8::Gemm{f.xnb, fb.wbint, D, D, 0}, S, EpiMamba{fb.zb, fb.xbcr, fb.dtraw}); });
    GBAR();
    DUP(12, mb_conv_fast(c, fb, l, GTID_NOW(), GSZ_NOW(), false));
    GBAR();
    DUP(6, mb_ssd_prompt(c, fb, l, lds); mb_scan_sample(c, fb, l));
    GBAR();
    DUP(13, mb_gate_fast(c, fb, fb.y, l, GW_NOW(), NGW_NOW(), LANE_NOW()));
    GBAR();
    { pg8::Order<> S; S.init(MP / 256, MS / 256, 4, MB_INNER, KS_MB, gridDim.x, blockIdx.x);
      pg8::gemm_phase(lds, pg8::Gemm{fb.yzn, fb.wbot, MB_INNER, MB_INNER, 0}, S, pg8::EpiAccF32{c.x, D, f.slab, MP / 256, MS / 256, KS_MB}); }
    if (PROBE_DUP & (1 << 28)) { GBAR(); pg8::Order<> S; S.init(MP / 256, MS / 256, 4, MB_INNER, KS_MB, gridDim.x, blockIdx.x);
      pg8::gemm_phase(lds, pg8::Gemm{fb.yzn, fb.wbot, MB_INNER, MB_INNER, 0}, S, pg8::EpiAccF32{c.hmid, D, f.slab + (size_t)16 * 16 * 65536, MP / 256, MS / 256, KS_MB}); }
    GBAR();
}

__device__ __forceinline__ void layer_mla_fast(const Ctx& c, const Fast& f, const FastMla& fm, const XcdBarrier& bar, LDSP unsigned char* lds) {
    using namespace cfg;
    constexpr int l = 1, j = 0;
    norm_rows_bf16(c.x, c.in[I_NMIX] + l * D, f.xnb, f.slab, KS_FFN, GW_NOW(), NGW_NOW(), LANE_NOW());
    GBAR();
    DUP(27, { pg8::Order<> S; S.init(MP / 256, MS / 256, 4, D, 1, gridDim.x, blockIdx.x);
      pg8::gemm_phase(lds, pg8::Gemm{f.xnb, fm.wint, D, D, 0}, S, pg8::EpiF32{fm.mh, 1024, 1024}); });
    GBAR();
    DUP(14, mla_norm1_fast(c, fm, j, GW_NOW(), NGW_NOW(), LANE_NOW()));
    GBAR();
    DUP(27, { pg8::Order<> S; S.init(MP / 256, MS / 256, (MH * QD) / 256, QL, 1, gridDim.x, blockIdx.x);
      pg8::gemm_phase(lds, pg8::Gemm{fm.qan, fm.wuqt, QL, QL, 0}, S, pg8::EpiBf16<0>{fm.qraw, MH * QD}); }
    { pg8::Order<> S; S.init(MP / 256, MS / 256, 4, KVL, 1, gridDim.x, blockIdx.x);
      pg8::gemm_phase(lds, pg8::Gemm{fm.cb, fm.wukvt, KVL, KVL, 0}, S, pg8::EpiBf16<0>{fm.kvraw, 2048}); }
    { pg8::Order<> S; S.init(4, 0, MTOT / 256, KVL, 1, gridDim.x, blockIdx.x);
      pg8::gemm_phase(lds, pg8::Gemm{fm.wukvt + (size_t)1024 * KVL, fm.cb, KVL, KVL, 0}, S, pg8::EpiBf16<0>{fm.vT, MTOT}); });
    GBAR();
    DUP(15, mla_norm2_fast(c, fm, j, GW_NOW(), NGW_NOW(), LANE_NOW()));
    { const unsigned t_ = (unsigned)GTID_NOW(); if (t_ < 96) *(pg8::u32x4*)(fm.qs + (size_t)MS * 1536 + t_ * 8) = (pg8::u32x4){0u, 0u, 0u, 0u}; }
    GBAR();
    DUP(5, attn_prompt_fast(fm.qf, fm.knb, fm.kpb, fm.vT, fm.aob, lds));
    __syncthreads();
    DUP(4, mla_sample_decode(c, fm, fm.qs, fm.opart, fm.lpart, j, lds));
    GBAR();
    DUP(16, mla_sample_combine(c, fm, fm.opart, fm.lpart, j, lds));
    GBAR();
    { pg8::Order<> S; S.init(MP / 256, MS / 256, 4, D, KS_1K, gridDim.x, blockIdx.x);
      pg8::gemm_phase(lds, pg8::Gemm{fm.aob, fm.wot, D, D, 0}, S, pg8::EpiAccF32{c.x, D, f.slab, MP / 256, MS / 256, KS_1K}); }
    if (PROBE_DUP & (1 << 27)) { GBAR(); pg8::Order<> S; S.init(MP / 256, MS / 256, 4, D, KS_1K, gridDim.x, blockIdx.x);
      pg8::gemm_phase(lds, pg8::Gemm{fm.aob, fm.wot, D, D, 0}, S, pg8::EpiAccF32{c.hmid, D, f.slab + (size_t)16 * 16 * 65536, MP / 256, MS / 256, KS_1K}); }
    GBAR();
}

template <int L>
__device__ __forceinline__ void layer_ffn_fast(const Ctx& c, const Fast& f, const XcdBarrier& bar, LDSP unsigned char* lds) {
    using namespace cfg;
    norm_rows_bf16(c.x, c.in[I_NFFN] + L * D, f.xnb, f.slab, (L % 3 == 2) ? KS_MB : KS_1K, GW_NOW(), NGW_NOW(), LANE_NOW());
    GBAR();
    DUP(0, { pg8::Order<> S; S.init(MP / 256, MS / 256, FFN / 256, D, 1, gridDim.x, blockIdx.x);
      pg8::gemm_phase(lds, pg8::Gemm{f.xnb, f.w1t + (size_t)L * FFN * D, D, D, 0}, S, pg8::EpiBf16<3>{f.hmidb, FFN}); });
    GBAR();
    { pg8::Order<> S; S.init(MP / 256, MS / 256, D / 256, FFN, (L == DEPTH - 1) ? 1 : KS_FFN, gridDim.x, blockIdx.x);
      pg8::gemm_phase(lds, pg8::Gemm{f.hmidb, f.w2t + (size_t)L * D * FFN, FFN, FFN, 0}, S, pg8::EpiAccF32{c.x, D, f.slab, MP / 256, MS / 256, (L == DEPTH - 1) ? 1 : KS_FFN}); }
    if (PROBE_DUP & (1 << 25)) { GBAR(); pg8::Order<> S; S.init(MP / 256, MS / 256, D / 256, FFN, (L == DEPTH - 1) ? 1 : KS_FFN, gridDim.x, blockIdx.x);
      pg8::gemm_phase(lds, pg8::Gemm{f.hmidb, f.w2t + (size_t)L * D * FFN, FFN, FFN, 0}, S, pg8::EpiAccF32{c.hmid, D, f.slab + (size_t)16 * 16 * 65536, MP / 256, MS / 256, (L == DEPTH - 1) ? 1 : KS_FFN}); }
    GBAR();
}

__global__ void __launch_bounds__(512, 2) mega10(MegaArgs a) {
    LDSP unsigned char* lds = (LDSP unsigned char*)dynlds;
    if (threadIdx.x < 4) ((LDSP unsigned*)(lds + LDS_XB))[threadIdx.x] = 0u;
    __syncthreads();
    XcdBarrier bar = xcd_barrier_post(a.bar, (volatile LAS unsigned*)(lds + LDS_XB));
    const Ctx& c = a.c; const Fast& f = a.f; const FastMla& fm = a.fm; const FastRw& fr = a.fr; const FastMb& fb = a.fb;
    using namespace cfg;
    DUP(10, {
        LDSP float* scr = (LDSP float*)(lds + LDS_STAGE) + (tid_now() >> 6) * (64 * 33);
        for (int l = 0; l < DEPTH; ++l) {
            tr_weight(c.in[I_FW1] + (size_t)l * D * FFN, D, FFN, FFN, f.w1t + (size_t)l * FFN * D, nullptr, scr, GW_NOW(), NGW_NOW(), LANE_NOW());
            tr_weight(c.in[I_FW2] + (size_t)l * FFN * D, FFN, D, D, f.w2t + (size_t)l * D * FFN, nullptr, scr, GW_NOW(), NGW_NOW(), LANE_NOW());
        }
        tr_weight(c.in[I_MWIN], D, MLA_IN, 1024, fm.wint, nullptr, scr, GW_NOW(), NGW_NOW(), LANE_NOW());
        tr_weight(c.in[I_WUQ], QL, MH * QD, MH * QD, fm.wuqt, nullptr, scr, GW_NOW(), NGW_NOW(), LANE_NOW());
        tr_weight(c.in[I_WUK], KVL, MH * NOPE, MH * NOPE, fm.wukvt, nullptr, scr, GW_NOW(), NGW_NOW(), LANE_NOW());
        tr_weight(c.in[I_WUV], KVL, MH * VD, MH * VD, fm.wukvt + (size_t)1024 * KVL, nullptr, scr, GW_NOW(), NGW_NOW(), LANE_NOW());
        tr_weight(c.in[I_MWO], MH * VD, D, D, fm.wot, nullptr, scr, GW_NOW(), NGW_NOW(), LANE_NOW());
        for (int j = 0; j < N_RWKV; ++j) {
            bf16_t* wt = fr.wrkvt + (size_t)j * 4096 * D;
            for (int p = 0; p < 3; ++p) tr_weight(c.in[I_WRKV] + ((size_t)j * 3 + p) * D * D, D, D, D, wt + (size_t)p * D * D, nullptr, scr, GW_NOW(), NGW_NOW(), LANE_NOW());
            tr_weight(c.in[I_W1] + (size_t)j * D * RW_DL, D, RW_DL, 256, wt + (size_t)3072 * D, nullptr, scr, GW_NOW(), NGW_NOW(), LANE_NOW());
            tr_weight(c.in[I_A1] + (size_t)j * D * RW_AL, D, RW_AL, 256, wt + (size_t)3328 * D, nullptr, scr, GW_NOW(), NGW_NOW(), LANE_NOW());
            tr_weight(c.in[I_G1] + (size_t)j * D * RW_GL, D, RW_GL, 256, wt + (size_t)3584 * D, nullptr, scr, GW_NOW(), NGW_NOW(), LANE_NOW());
            tr_weight(j > 0 ? c.in[I_V1] + (size_t)(j - 1) * D * RW_VL : c.in[I_W1], D, j > 0 ? RW_VL : 0, 256, wt + (size_t)3840 * D, nullptr, scr, GW_NOW(), NGW_NOW(), LANE_NOW());
            tr_weight(c.in[I_RWO] + (size_t)j * D * D, D, D, D, fr.wot + (size_t)j * D * D, nullptr, scr, GW_NOW(), NGW_NOW(), LANE_NOW());
            rw_build_lorat(c, fr.lorat + (size_t)j * 4096 * 384, j, GTID_NOW(), GSZ_NOW());
        }
        tr_weight(c.in[I_BWIN], D, MB_IN, 5376, fb.wbint, nullptr, scr, GW_NOW(), NGW_NOW(), LANE_NOW());
        tr_weight(c.in[I_BWO], MB_INNER, D, D, fb.wbot, nullptr, scr, GW_NOW(), NGW_NOW(), LANE_NOW());
        { const size_t np4 = (size_t)MP * D / 4, nt4 = (size_t)MTOT * D / 4;
          for (size_t i = GTID_NOW(); i < nt4; i += GSZ_NOW()) ((pg8::f32x4*)c.x)[i] = i < np4 ? ((const pg8::f32x4*)c.in[I_XP])[i] : ((const pg8::f32x4*)c.in[I_XS])[i - np4]; }
    });
    GBAR();
    layer_rwkv_fast<0>(c, f, fr, bar, lds); layer_ffn_fast<0>(c, f, bar, lds);
    layer_mla_fast(c, f, fm, bar, lds); layer_ffn_fast<1>(c, f, bar, lds);
    layer_mamba_fast(c, f, fb, bar, lds); layer_ffn_fast<2>(c, f, bar, lds);
    layer_rwkv_fast<3>(c, f, fr, bar, lds); layer_ffn_fast<3>(c, f, bar, lds);
}

extern "C" void kernel_launch(void* const* d_in, const int* in_sizes, int n_in, void* d_out, int out_size, void* d_ws, size_t ws_size, hipStream_t stream) {
    using namespace cfg;
    MegaArgs a{};
    size_t used = setup_ctx(a.c, d_in, d_out, d_ws);
    { Bump b{(char*)d_ws, (size_t)((char*)a.c.xm[0] - (char*)d_ws)}; FastRw& r = a.fr;
      r.xm = (bf16_t*)b.f((size_t)6 * MTOT * D / 2); r.rkv = (bf16_t*)b.f((size_t)MTOT * 3072 / 2); r.hb = (bf16_t*)b.f((size_t)MTOT * 384 / 2); r.lu = (bf16_t*)b.f((size_t)MTOT * 4096 / 2);
      r.ops = b.f((size_t)MTOT * RHEADS * RW_REC + 4096); r.yo = (bf16_t*)b.f((size_t)MTOT * D / 2); r.vf = a.c.vf;
      if (b.off > (size_t)((char*)a.c.hmid - (char*)d_ws) + (size_t)MTOT * FFN * 4) { fprintf(stderr, "RWKV overlay too large\n"); return; } }
    { Bump b{(char*)d_ws, used};
      a.f.xnb = (bf16_t*)b.f((size_t)MTOT * D / 2); a.f.hmidb = (bf16_t*)b.f((size_t)MTOT * FFN / 2);
      a.f.w1t = (bf16_t*)b.f((size_t)DEPTH * FFN * D / 2); a.f.w2t = (bf16_t*)b.f((size_t)DEPTH * FFN * D / 2); a.f.slab = b.f((size_t)2 * 16 * 16 * 65536);
      FastMla& m = a.fm;
      m.mh = b.f((size_t)MTOT * 1024); m.qan = (bf16_t*)b.f((size_t)MTOT * QL / 2); m.cb = (bf16_t*)b.f((size_t)MTOT * KVL / 2); m.kpb = (bf16_t*)b.f((size_t)MTOT * ROPE / 2);
      m.qraw = (bf16_t*)b.f((size_t)MTOT * 1536 / 2); m.kvraw = (bf16_t*)b.f((size_t)MTOT * 2048 / 2); m.qf = (bf16_t*)b.f((size_t)MTOT * 1536 / 2); m.knb = (bf16_t*)b.f((size_t)MTOT * 1024 / 2);
      m.aob = (bf16_t*)b.f((size_t)MTOT * 1024 / 2); m.vT = (bf16_t*)b.f((size_t)MTOT * 1024 / 2); m.qs = (bf16_t*)b.f((size_t)MS * 1536 / 2 + 1024);
      m.opart = b.f((size_t)2 * DB * 128 * 256); m.lpart = b.f((size_t)2 * DB * 128);
      m.wint = (bf16_t*)b.f((size_t)1024 * 1024 / 2); m.wuqt = (bf16_t*)b.f((size_t)1536 * 512 / 2); m.wukvt = (bf16_t*)b.f((size_t)2048 * 256 / 2); m.wot = (bf16_t*)b.f((size_t)1024 * 1024 / 2);
      { FastMb& q = a.fb; q.zb = (bf16_t*)b.f((size_t)MTOT * 2048 / 2); q.xbcr = (bf16_t*)b.f((size_t)MTOT * 3072 / 2); q.dtraw = b.f((size_t)MTOT * 32); q.xbcb = (bf16_t*)b.f((size_t)MTOT * 3072 / 2);
        q.dt = b.f((size_t)MTOT * 32); q.y = a.c.my; q.yzn = (bf16_t*)b.f((size_t)MTOT * 2048 / 2); q.wbint = (bf16_t*)b.f((size_t)5376 * 1024 / 2); q.wbot = (bf16_t*)b.f((size_t)1024 * 2048 / 2); }
      a.fr.wrkvt = (bf16_t*)b.f((size_t)N_RWKV * 4096 * D / 2); a.fr.lorat = (bf16_t*)b.f((size_t)N_RWKV * 4096 * 384 / 2); a.fr.wot = (bf16_t*)b.f((size_t)N_RWKV * D * D / 2);
      used = b.off; }
    if (used > ws_size || n_in != 51) { fprintf(stderr, "workspace too small: need %zu have %zu (n_in %d)\n", used, ws_size, n_in); return; }
    a.bar = (unsigned*)d_ws;
    static int grid = 0;
    if (!grid) {
        int dev = 0, cus = 0, per_cu = 0;
        (void)hipGetDevice(&dev); (void)hipDeviceGetAttribute(&cus, hipDeviceAttributeMultiprocessorCount, dev);
        if (hipFuncSetAttribute((const void*)mega10, hipFuncAttributeMaxDynamicSharedMemorySize, LDS_BYTES) != hipSuccess) { fprintf(stderr, "hipFuncSetAttribute failed\n"); grid = -1; return; }
        (void)hipOccupancyMaxActiveBlocksPerMultiprocessor(&per_cu, (const void*)mega10, 512, LDS_BYTES);
        (void)hipGetLastError();
        grid = per_cu >= 1 ? (cus < 256 ? cus : 256) : -1;
    }
    if (grid <= 0) { fprintf(stderr, "kernel does not fit one workgroup per CU\n"); return; }
    (void)hipMemsetAsync(a.bar, 0, XCD_BAR_WORDS * sizeof(unsigned), stream);
    hipLaunchKernelGGL(mega10, dim3(grid), dim3(512), LDS_BYTES, stream, a);
}
```

```cpp
#include <hip/hip_runtime.h>
#include <cstdio>
#include <math.h>
#include <stdint.h>
#include <stddef.h>
#ifdef CPU_EMU
#define DEV inline
#else
#define DEV __device__ __forceinline__
#endif

namespace cfg {
#ifdef CFG_SMALL
constexpr int D = 128, BATCH = 2, SEQ = 32, DEPTH = 4, DB = 3, DS = 8, PAST = 64, PAGE = 16;
constexpr int RW_DL = 16, RW_AL = 16, RW_VL = 8, RW_GL = 24;
constexpr int MH = 2, QL = 64, KVL = 32;
constexpr int MB_GROUPS = 2;
#else
constexpr int D = 1024, BATCH = 16, SEQ = 2048, DEPTH = 4, DB = 128, DS = 8, PAST = 8192, PAGE = 128;
constexpr int RW_DL = 64, RW_AL = 64, RW_VL = 32, RW_GL = 160;
constexpr int MH = 16, QL = 512, KVL = 256;
constexpr int MB_GROUPS = 4;
#endif
constexpr int N_RWKV = (DEPTH + 2) / 3, N_MLA = (DEPTH + 1) / 3, N_MAMBA = DEPTH / 3;
constexpr int RH = 64, RHEADS = D / RH;
constexpr int NOPE = 64, ROPE = 32, VD = 64, QD = NOPE + ROPE;
constexpr int MLA_IN = QL + KVL + ROPE;
constexpr int MB_INNER = 2 * D, MB_HEAD = 64, MB_HEADS = MB_INNER / MB_HEAD, MB_STATE = 128, MB_CONV = 4;
constexpr int MB_GN = MB_GROUPS * MB_STATE;
constexpr int MB_CD = MB_INNER + 2 * MB_GN, MB_IN = MB_INNER + MB_CD + MB_HEADS;
constexpr int FFN = 4 * D;
constexpr int NPAGES = PAST / PAGE, NPOOL = (DB * NPAGES * 5) / 4;
constexpr int MP = BATCH * SEQ, MS = DB * DS, MTOT = MP + MS, NSEQ = BATCH + DB;
constexpr int KTOT = PAST + DS;
constexpr float NORM_EPS = 1e-6f, LNX_EPS = 64e-5f;
constexpr size_t O_YP = 0;
constexpr size_t O_YS = O_YP + (size_t)MP * D;
constexpr size_t O_CKVP = O_YS + (size_t)MS * D;
constexpr size_t O_KPEP = O_CKVP + (size_t)N_MLA * MP * KVL;
constexpr size_t O_CKVS = O_KPEP + (size_t)N_MLA * MP * ROPE;
constexpr size_t O_KPES = O_CKVS + (size_t)N_MLA * MS * KVL;
constexpr size_t O_WKVP = O_KPES + (size_t)N_MLA * MS * ROPE;
constexpr size_t O_SHP = O_WKVP + (size_t)N_RWKV * BATCH * RHEADS * RH * RH;
constexpr size_t O_WKVS = O_SHP + (size_t)N_RWKV * BATCH * D;
constexpr size_t O_SHS = O_WKVS + (size_t)N_RWKV * DB * RHEADS * RH * RH;
constexpr size_t O_SSMP = O_SHS + (size_t)N_RWKV * DB * D;
constexpr size_t O_CONVP = O_SSMP + (size_t)N_MAMBA * BATCH * MB_HEADS * MB_HEAD * MB_STATE;
constexpr size_t O_SSMS = O_CONVP + (size_t)N_MAMBA * BATCH * (MB_CONV - 1) * MB_CD;
constexpr size_t O_CONVS = O_SSMS + (size_t)N_MAMBA * DB * MB_HEADS * MB_HEAD * MB_STATE;
constexpr size_t O_END = O_CONVS + (size_t)N_MAMBA * DB * (MB_CONV - 1) * MB_CD;
}

struct Ctx {
    const float* in[51];
    const int* page_table;
    float* out;
    float *x, *xn, *vf;
    float* xm[6];
    float *r, *k, *v, *wpre, *apre, *vpre, *g, *hw, *ha, *hv, *hg, *ka, *kb, *y, *yo;
    float *hmid;
    float *mh, *qan, *q, *c, *kp, *knr, *vv, *ao, *sc, *olat;
    float *zx, *xbc, *dt, *my, *yzn;
};

DEV int row_t(int m) { return m < cfg::MP ? m % cfg::SEQ : (m - cfg::MP) % cfg::DS; }
DEV int row_seq(int m) { return m < cfg::MP ? m / cfg::SEQ : cfg::BATCH + (m - cfg::MP) / cfg::DS; }
DEV int seq_row0(int sq) { return sq < cfg::BATCH ? sq * cfg::SEQ : cfg::MP + (sq - cfg::BATCH) * cfg::DS; }
DEV int seq_len(int sq) { return sq < cfg::BATCH ? cfg::SEQ : cfg::DS; }
DEV float sigmoidf_(float x) { return 1.0f / (1.0f + expf(-x)); }
DEV float softplusf_(float x) { return x > 20.f ? x : log1pf(expf(x)); }
DEV float siluf_(float x) { return x * sigmoidf_(x); }

enum { I_XP = 0, I_XS, I_CKV, I_KPE, I_WKV, I_SHIFT, I_SSM, I_CONV, I_PT, I_NMIX, I_NFFN, I_FW1, I_FW2, I_MU, I_WRKV, I_W0, I_W1, I_W2, I_A0, I_A1, I_A2,
       I_V0, I_V1, I_V2, I_G1, I_G2, I_KK, I_KA, I_RK, I_LNW, I_LNB, I_RWO, I_MWIN, I_QNORM, I_KVNORM, I_WUQ, I_WUK, I_WUV, I_QNN, I_QRN, I_KNN, I_KRN, I_MWO,
       I_BWIN, I_CONVW, I_CONVB, I_DTB, I_ALOG, I_BD, I_BNORM, I_BWO };

#define UNROLL _Pragma("unroll")
#define GSL(i, n) for (size_t i = gtid; i < (size_t)(n); i += gsz)

DEV void ph_copy_x(const Ctx& c, int, size_t gtid, size_t gsz) {
    using namespace cfg;
    GSL(i, (size_t)MTOT * D) c.x[i] = i < (size_t)MP * D ? c.in[I_XP][i] : c.in[I_XS][i - (size_t)MP * D];
}
DEV void rmsnorm_rows(const float* x, const float* gain, float* xn, size_t gtid, size_t gsz) {
    using namespace cfg;
    GSL(m, MTOT) {
        const float* xr = x + m * D; float ss = 0.f;
        for (int i = 0; i < D; ++i) ss += xr[i] * xr[i];
        const float rs = 1.0f / sqrtf(ss / D + NORM_EPS);
        for (int i = 0; i < D; ++i) xn[m * D + i] = xr[i] * rs * gain[i];
    }
}
DEV void ph_norm_mix(const Ctx& c, int l, size_t gtid, size_t gsz) { rmsnorm_rows(c.x, c.in[I_NMIX] + l * cfg::D, c.xn, gtid, gsz); }
DEV void ph_norm_ffn(const Ctx& c, int l, size_t gtid, size_t gsz) { rmsnorm_rows(c.x, c.in[I_NFFN] + l * cfg::D, c.xn, gtid, gsz); }

DEV void ph_rw_mix(const Ctx& c, int l, size_t gtid, size_t gsz) {
    using namespace cfg; const int j = l / 3;
    GSL(i, (size_t)MTOT * D) {
        const int m = (int)(i / D), ch = (int)(i % D), t = row_t(m), sq = row_seq(m);
        const float xc = c.xn[i];
        float xp;
        if (t > 0) xp = c.xn[i - D];
        else xp = sq < BATCH ? 0.f : c.in[I_SHIFT][((size_t)j * DB + (sq - BATCH)) * D + ch];
        for (int p = 0; p < 6; ++p) c.xm[p][i] = xc + (xp - xc) * c.in[I_MU][((size_t)j * 6 + p) * D + ch];
        if (t == seq_len(sq) - 1) {
            if (sq < BATCH) c.out[O_SHP + ((size_t)j * BATCH + sq) * D + ch] = xc;
            else c.out[O_SHS + ((size_t)j * DB + (sq - BATCH)) * D + ch] = xc;
        }
    }
}
DEV void ph_rw_prep(const Ctx& c, int l, size_t gtid, size_t gsz) {
    using namespace cfg; const int j = l / 3;
    GSL(i, (size_t)MTOT * RHEADS) {
        const int m = (int)(i / RHEADS), h = (int)(i % RHEADS);
        const size_t o = (size_t)m * D + h * RH;
        float nn = 0.f;
        for (int e = 0; e < RH; ++e) { const float kk = c.k[o + e] * c.in[I_KK][j * D + h * RH + e]; nn += kk * kk; }
        const float inv = 1.0f / fmaxf(sqrtf(nn), 1e-12f);
        for (int e = 0; e < RH; ++e) {
            const int ch = h * RH + e;
            const float wl = -softplusf_(-(c.in[I_W0][j * D + ch] + c.wpre[o + e])) - 0.5f;
            const float decay = expf(-expf(wl));
            float vv = c.v[o + e];
            if (j == 0) c.vf[o + e] = vv;
            else vv = vv + (c.vf[o + e] - vv) * sigmoidf_(c.in[I_V0][(j - 1) * D + ch] + c.vpre[o + e]);
            const float a = sigmoidf_(c.in[I_A0][j * D + ch] + c.apre[o + e]);
            const float k0 = c.k[o + e];
            const float kk = k0 * c.in[I_KK][j * D + ch] * inv;
            c.k[o + e] = k0 * (1.0f + (a - 1.0f) * c.in[I_KA][j * D + ch]);
            c.v[o + e] = vv;
            c.wpre[o + e] = decay;
            c.ka[o + e] = -kk;
            c.kb[o + e] = kk * a;
        }
    }
}
DEV void ph_rw_scan(const Ctx& c, int l, size_t gtid, size_t gsz) {
    using namespace cfg; const int j = l / 3;
    GSL(i, (size_t)NSEQ * RHEADS * RH) {
        const int sq = (int)(i / (RHEADS * RH)), h = (int)(i / RH) % RHEADS, vi = (int)(i % RH);
        float S[RH];
        if (sq < BATCH) { UNROLL for (int e = 0; e < RH; ++e) S[e] = 0.f; }
        else { const float* s0 = c.in[I_WKV] + ((((size_t)j * DB + (sq - BATCH)) * RHEADS + h) * RH + vi) * RH; UNROLL for (int e = 0; e < RH; ++e) S[e] = s0[e]; }
        const int m0 = seq_row0(sq), T = seq_len(sq);
        for (int t = 0; t < T; ++t) {
            const size_t o = (size_t)(m0 + t) * D + h * RH;
            float sa = 0.f;
            UNROLL for (int e = 0; e < RH; ++e) sa += S[e] * c.ka[o + e];
            const float vt = c.v[o + vi]; float yy = 0.f;
            UNROLL for (int e = 0; e < RH; ++e) { S[e] = S[e] * c.wpre[o + e] + sa * c.kb[o + e] + vt * c.k[o + e]; yy += S[e] * c.r[o + e]; }
            c.y[o + vi] = yy;
        }
        float* so = sq < BATCH ? c.out + O_WKVP + ((((size_t)j * BATCH + sq) * RHEADS + h) * RH + vi) * RH
                               : c.out + O_WKVS + ((((size_t)j * DB + (sq - BATCH)) * RHEADS + h) * RH + vi) * RH;
        UNROLL for (int e = 0; e < RH; ++e) so[e] = S[e];
    }
}
DEV void ph_rw_post(const Ctx& c, int l, size_t gtid, size_t gsz) {
    using namespace cfg; const int j = l / 3;
    GSL(i, (size_t)MTOT * RHEADS) {
        const int m = (int)(i / RHEADS), h = (int)(i % RHEADS);
        const size_t o = (size_t)m * D + h * RH;
        float mean = 0.f; for (int e = 0; e < RH; ++e) mean += c.y[o + e]; mean /= RH;
        float var = 0.f; for (int e = 0; e < RH; ++e) { const float d = c.y[o + e] - mean; var += d * d; } var /= RH;
        const float rs = 1.0f / sqrtf(var + LNX_EPS);
        float bonus = 0.f; for (int e = 0; e < RH; ++e) bonus += c.r[o + e] * c.k[o + e] * c.in[I_RK][(size_t)j * D + h * RH + e];
        for (int e = 0; e < RH; ++e) {
            const int ch = h * RH + e;
            const float yn = (c.y[o + e] - mean) * rs * c.in[I_LNW][j * D + ch] + c.in[I_LNB][j * D + ch];
            c.yo[o + e] = (yn + bonus * c.v[o + e]) * c.g[o + e];
        }
    }
}

DEV void rope_apply(const float* xin, float* xout, int pos) {
    using namespace cfg; const int half = ROPE / 2;
    UNROLL for (int i = 0; i < half; ++i) {
        const float inv = exp2f(-(float)i * (13.287712379549449f / half));
        const float ang = (float)pos * inv;
        const float kq = rintf(ang * 0.15915494309189535f);
        float rr = fmaf(-kq, 6.28125f, ang); rr = fmaf(-kq, 1.9353071795864769e-3f, rr);
        const float cs = __cosf(rr), sn = __sinf(rr);
        const float x1 = xin[i], x2 = xin[i + half];
        xout[i] = x1 * cs - x2 * sn; xout[i + half] = x2 * cs + x1 * sn;
    }
}
DEV int row_pos(int m) { return m < cfg::MP ? m % cfg::SEQ : cfg::PAST + (m - cfg::MP) % cfg::DS; }
DEV void ph_mla_norm1(const Ctx& c, int l, size_t gtid, size_t gsz) {
    using namespace cfg; const int j = l / 3;
    GSL(m, MTOT) {
        const float* h = c.mh + m * MLA_IN;
        float ss = 0.f; for (int i = 0; i < QL; ++i) ss += h[i] * h[i];
        float rs = 1.0f / sqrtf(ss / QL + NORM_EPS);
        for (int i = 0; i < QL; ++i) c.qan[m * QL + i] = h[i] * rs * c.in[I_QNORM][j * QL + i];
        ss = 0.f; for (int i = 0; i < KVL; ++i) ss += h[QL + i] * h[QL + i];
        rs = 1.0f / sqrtf(ss / KVL + NORM_EPS);
        float* co = m < (size_t)MP ? c.out + O_CKVP + ((size_t)j * MP + m) * KVL : c.out + O_CKVS + ((size_t)j * MS + (m - MP)) * KVL;
        for (int i = 0; i < KVL; ++i) { const float v = h[QL + i] * rs * c.in[I_KVNORM][j * KVL + i]; c.c[m * KVL + i] = v; co[i] = v; }
        ss = 0.f; UNROLL for (int i = 0; i < ROPE; ++i) ss += h[QL + KVL + i] * h[QL + KVL + i];
        rs = 1.0f / sqrtf(ss / ROPE + NORM_EPS);
        float tmp[ROPE], ro[ROPE];
        UNROLL for (int i = 0; i < ROPE; ++i) tmp[i] = h[QL + KVL + i] * rs * c.in[I_KRN][j * ROPE + i];
        rope_apply(tmp, ro, row_pos((int)m));
        float* ko = m < (size_t)MP ? c.out + O_KPEP + ((size_t)j * MP + m) * ROPE : c.out + O_KPES + ((size_t)j * MS + (m - MP)) * ROPE;
        UNROLL for (int i = 0; i < ROPE; ++i) { c.kp[m * ROPE + i] = ro[i]; ko[i] = ro[i]; }
    }
}
DEV void ph_mla_norm2(const Ctx& c, int l, size_t gtid, size_t gsz) {
    using namespace cfg; const int j = l / 3;
    GSL(i, (size_t)MTOT * MH) {
        const int m = (int)(i / MH), h = (int)(i % MH);
        float* q = c.q + (size_t)m * MH * QD + h * QD;
        float ss = 0.f; UNROLL for (int e = 0; e < NOPE; ++e) ss += q[e] * q[e];
        float rs = 1.0f / sqrtf(ss / NOPE + NORM_EPS);
        UNROLL for (int e = 0; e < NOPE; ++e) q[e] = q[e] * rs * c.in[I_QNN][j * NOPE + e];
        ss = 0.f; UNROLL for (int e = 0; e < ROPE; ++e) ss += q[NOPE + e] * q[NOPE + e];
        rs = 1.0f / sqrtf(ss / ROPE + NORM_EPS);
        float tmp[ROPE], ro[ROPE];
        UNROLL for (int e = 0; e < ROPE; ++e) tmp[e] = q[NOPE + e] * rs * c.in[I_QRN][j * ROPE + e];
        rope_apply(tmp, ro, row_pos(m));
        UNROLL for (int e = 0; e < ROPE; ++e) q[NOPE + e] = ro[e];
        float* kn = c.knr + (size_t)m * MH * NOPE + h * NOPE;
        ss = 0.f; UNROLL for (int e = 0; e < NOPE; ++e) ss += kn[e] * kn[e];
        rs = 1.0f / sqrtf(ss / NOPE + NORM_EPS);
        UNROLL for (int e = 0; e < NOPE; ++e) kn[e] = kn[e] * rs * c.in[I_KNN][j * NOPE + e];
    }
}
DEV void ph_mla_attn_prompt(const Ctx& c, int, size_t gtid, size_t gsz) {
    using namespace cfg; const float scale = 1.0f / sqrtf((float)QD);
    GSL(i, (size_t)MP * MH) {
        const int m = (int)(i / MH), h = (int)(i % MH), t = m % SEQ, m0 = m - t;
        const float* q = c.q + (size_t)m * MH * QD + h * QD;
        float mx = -INFINITY, den = 0.f, acc[VD];
        UNROLL for (int e = 0; e < VD; ++e) acc[e] = 0.f;
        for (int kx = 0; kx <= t; ++kx) {
            const int mk = m0 + kx;
            const float* kn = c.knr + (size_t)mk * MH * NOPE + h * NOPE; const float* kp = c.kp + (size_t)mk * ROPE;
            float s = 0.f;
            UNROLL for (int e = 0; e < NOPE; ++e) s += q[e] * kn[e];
            UNROLL for (int e = 0; e < ROPE; ++e) s += q[NOPE + e] * kp[e];
            s *= scale;
            const float nm = fmaxf(mx, s), corr = expf(mx - nm), p = expf(s - nm);
            den = den * corr + p;
            const float* v = c.vv + (size_t)mk * MH * VD + h * VD;
            UNROLL for (int e = 0; e < VD; ++e) acc[e] = acc[e] * corr + p * v[e];
            mx = nm;
        }
        UNROLL for (int e = 0; e < VD; ++e) c.ao[(size_t)m * MH * VD + h * VD + e] = acc[e] / den;
    }
}
DEV const float* smp_c(const Ctx& c, int j, int s, int pos) {
    using namespace cfg;
    if (pos < PAST) { const int pg = c.page_table[s * NPAGES + pos / PAGE]; return c.in[I_CKV] + (((size_t)j * NPOOL + pg) * PAGE + pos % PAGE) * KVL; }
    return c.c + (size_t)(MP + s * DS + (pos - PAST)) * KVL;
}
DEV const float* smp_kp(const Ctx& c, int j, int s, int pos) {
    using namespace cfg;
    if (pos < PAST) { const int pg = c.page_table[s * NPAGES + pos / PAGE]; return c.in[I_KPE] + (((size_t)j * NPOOL + pg) * PAGE + pos % PAGE) * ROPE; }
    return c.kp + (size_t)(MP + s * DS + (pos - PAST)) * ROPE;
}
DEV void ph_mla_score_sample(const Ctx& c, int l, size_t gtid, size_t gsz) {
    using namespace cfg; const int j = l / 3; const float scale = 1.0f / sqrtf((float)QD);
    GSL(i, (size_t)DB * KTOT * MH) {
        const int pos = (int)(i % KTOT), h = (int)((i / KTOT) % MH), s = (int)(i / ((size_t)MH * KTOT));
        const float* cl = smp_c(c, j, s, pos); const float* kp = smp_kp(c, j, s, pos);
        float kn[NOPE];
        UNROLL for (int e = 0; e < NOPE; ++e) kn[e] = 0.f;
        const float* wuk = c.in[I_WUK] + (size_t)j * KVL * MH * NOPE;
        for (int r = 0; r < KVL; ++r) { const float cv = cl[r]; const float* w = wuk + ((size_t)r * MH + h) * NOPE; UNROLL for (int e = 0; e < NOPE; ++e) kn[e] += cv * w[e]; }
        float ss = 0.f; UNROLL for (int e = 0; e < NOPE; ++e) ss += kn[e] * kn[e];
        const float rs = 1.0f / sqrtf(ss / NOPE + NORM_EPS);
        UNROLL for (int e = 0; e < NOPE; ++e) kn[e] = kn[e] * rs * c.in[I_KNN][j * NOPE + e];
        for (int qi = 0; qi < DS; ++qi) {
            const float* q = c.q + (size_t)(MP + s * DS + qi) * MH * QD + h * QD;
            float sc = 0.f;
            UNROLL for (int e = 0; e < NOPE; ++e) sc += q[e] * kn[e];
            UNROLL for (int e = 0; e < ROPE; ++e) sc += q[NOPE + e] * kp[e];
            const bool ok = pos < PAST || (pos - PAST) <= qi;
            c.sc[(((size_t)s * MH + h) * DS + qi) * KTOT + pos] = ok ? sc * scale : -INFINITY;
        }
    }
}
DEV void ph_mla_softmax_sample(const Ctx& c, int, size_t gtid, size_t gsz) {
    using namespace cfg;
    GSL(i, (size_t)DB * MH * DS) {
        float* sc = c.sc + i * KTOT;
        float mx = -INFINITY; for (int p = 0; p < KTOT; ++p) mx = fmaxf(mx, sc[p]);
        float den = 0.f; for (int p = 0; p < KTOT; ++p) den += expf(sc[p] - mx);
        const float inv = 1.0f / den;
        for (int p = 0; p < KTOT; ++p) sc[p] = expf(sc[p] - mx) * inv;
    }
}
DEV void ph_mla_pv_sample(const Ctx& c, int l, size_t gtid, size_t gsz) {
    using namespace cfg; const int j = l / 3;
    GSL(i, (size_t)DB * MH * DS * KVL) {
        const int r = (int)(i % KVL); const size_t row = i / KVL; const int s = (int)(row / (MH * DS));
        const float* p = c.sc + row * KTOT; float acc = 0.f;
        for (int pos = 0; pos < KTOT; ++pos) acc += p[pos] * smp_c(c, j, s, pos)[r];
        c.olat[i] = acc;
    }
}
DEV void ph_mla_out_sample(const Ctx& c, int l, size_t gtid, size_t gsz) {
    using namespace cfg; const int j = l / 3;
    GSL(i, (size_t)MS * MH * VD) {
        const int e = (int)(i % VD), h = (int)((i / VD) % MH), ms = (int)(i / (MH * VD)), s = ms / DS, qi = ms % DS;
        const float* ol = c.olat + (((size_t)s * MH + h) * DS + qi) * KVL;
        const float* wuv = c.in[I_WUV] + (size_t)j * KVL * MH * VD;
        float acc = 0.f;
        for (int r = 0; r < KVL; ++r) acc += ol[r] * wuv[((size_t)r * MH + h) * VD + e];
        c.ao[(size_t)(MP + ms) * MH * VD + h * VD + e] = acc;
    }
}

DEV float mb_xpad(const Ctx& c, int j, int m, int sq, int tt, int ch) {
    using namespace cfg;
    if (tt < MB_CONV - 1) return sq < BATCH ? 0.f : c.in[I_CONV][(((size_t)j * DB + (sq - BATCH)) * (MB_CONV - 1) + tt) * MB_CD + ch];
    (void)m; return c.zx[(size_t)(seq_row0(sq) + tt - (MB_CONV - 1)) * MB_IN + MB_INNER + ch];
}
DEV void ph_mb_conv(const Ctx& c, int l, size_t gtid, size_t gsz) {
    using namespace cfg; const int j = l / 3;
    GSL(i, (size_t)MTOT * MB_CD) {
        const int m = (int)(i / MB_CD), ch = (int)(i % MB_CD), t = row_t(m), sq = row_seq(m), T = seq_len(sq);
        float acc = c.in[I_CONVB][j * MB_CD + ch];
        for (int jj = 0; jj < MB_CONV; ++jj) acc += mb_xpad(c, j, m, sq, t + jj, ch) * c.in[I_CONVW][((size_t)j * MB_CONV + jj) * MB_CD + ch];
        c.xbc[i] = siluf_(acc);
        if (t < MB_CONV - 1) {
            const float v = mb_xpad(c, j, m, sq, T + t, ch);
            if (sq < BATCH) c.out[O_CONVP + (((size_t)j * BATCH + sq) * (MB_CONV - 1) + t) * MB_CD + ch] = v;
            else c.out[O_CONVS + (((size_t)j * DB + (sq - BATCH)) * (MB_CONV - 1) + t) * MB_CD + ch] = v;
        }
    }
}
DEV void ph_mb_dt(const Ctx& c, int l, size_t gtid, size_t gsz) {
    using namespace cfg; const int j = l / 3;
    GSL(i, (size_t)MTOT * MB_HEADS) {
        const int m = (int)(i / MB_HEADS), h = (int)(i % MB_HEADS);
        c.dt[i] = softplusf_(c.zx[(size_t)m * MB_IN + MB_INNER + MB_CD + h] + c.in[I_DTB][j * MB_HEADS + h]);
    }
}
DEV void ph_mb_scan(const Ctx& c, int l, size_t gtid, size_t gsz) {
    using namespace cfg; const int j = l / 3;
    GSL(i, (size_t)NSEQ * MB_HEADS * MB_HEAD) {
        const int p = (int)(i % MB_HEAD), h = (int)((i / MB_HEAD) % MB_HEADS), sq = (int)(i / (MB_HEADS * MB_HEAD));
        const int g = h / (MB_HEADS / MB_GROUPS);
        float hs[MB_STATE];
        if (sq < BATCH) { UNROLL for (int n = 0; n < MB_STATE; ++n) hs[n] = 0.f; }
        else { const float* s0 = c.in[I_SSM] + ((((size_t)j * DB + (sq - BATCH)) * MB_HEADS + h) * MB_HEAD + p) * MB_STATE; UNROLL for (int n = 0; n < MB_STATE; ++n) hs[n] = s0[n]; }
        const float A = -expf(c.in[I_ALOG][j * MB_HEADS + h]), dsk = c.in[I_BD][j * MB_HEADS + h];
        const int m0 = seq_row0(sq), T = seq_len(sq);
        for (int t = 0; t < T; ++t) {
            const size_t m = (size_t)(m0 + t);
            const float dtv = c.dt[m * MB_HEADS + h], dA = expf(dtv * A);
            const float xv = c.xbc[m * MB_CD + h * MB_HEAD + p], xdt = xv * dtv;
            const float* Bm = c.xbc + m * MB_CD + MB_INNER + g * MB_STATE; const float* Cm = Bm + MB_GN;
            float yy = 0.f;
            UNROLL for (int n = 0; n < MB_STATE; ++n) { hs[n] = hs[n] * dA + xdt * Bm[n]; yy += Cm[n] * hs[n]; }
            c.my[m * MB_INNER + h * MB_HEAD + p] = yy + dsk * xv;
        }
        float* so = sq < BATCH ? c.out + O_SSMP + ((((size_t)j * BATCH + sq) * MB_HEADS + h) * MB_HEAD + p) * MB_STATE
                               : c.out + O_SSMS + ((((size_t)j * DB + (sq - BATCH)) * MB_HEADS + h) * MB_HEAD + p) * MB_STATE;
        UNROLL for (int n = 0; n < MB_STATE; ++n) so[n] = hs[n];
    }
}
DEV void ph_mb_gate(const Ctx& c, int l, size_t gtid, size_t gsz) {
    using namespace cfg; const int j = l / 3; constexpr int GW = MB_INNER / MB_GROUPS;
    GSL(i, (size_t)MTOT * MB_GROUPS) {
        const int m = (int)(i / MB_GROUPS), g = (int)(i % MB_GROUPS);
        float ss = 0.f;
        for (int e = 0; e < GW; ++e) { const float v = c.my[(size_t)m * MB_INNER + g * GW + e] * siluf_(c.zx[(size_t)m * MB_IN + g * GW + e]); ss += v * v; }
        const float rs = 1.0f / sqrtf(ss / GW + NORM_EPS);
        for (int e = 0; e < GW; ++e) {
            const float v = c.my[(size_t)m * MB_INNER + g * GW + e] * siluf_(c.zx[(size_t)m * MB_IN + g * GW + e]);
            c.yzn[(size_t)m * MB_INNER + g * GW + e] = v * rs * c.in[I_BNORM][j * MB_INNER + g * GW + e];
        }
    }
}
typedef short bf16x8_t __attribute__((ext_vector_type(8)));
typedef float f32x4_t __attribute__((ext_vector_type(4)));
__device__ __forceinline__ unsigned short f2bf(float f) { unsigned u = __float_as_uint(f); u += 0x7fffu + ((u >> 16) & 1u); return (unsigned short)(u >> 16); }
#define XB_TMO      128
#define XB_XCNT(j)  (256  + 64 * (j))
#define XB_XSUB(j)  (1280 + 64 * (j))
#define XB_XGEN(j)  (2304 + 64 * (j))
#define XB_TOP      3328
#define XB_TOPGEN   3392
#define XCD_BAR_WORDS 3456
#define XB_SPIN_CAP (1u << 25)
#define LAS __attribute__((address_space(3)))

__device__ __forceinline__ unsigned xb_ld(unsigned* p)              { return __hip_atomic_load(p, __ATOMIC_RELAXED, __HIP_MEMORY_SCOPE_AGENT); }
__device__ __forceinline__ unsigned xb_add(unsigned* p, unsigned v) { return __hip_atomic_fetch_add(p, v, __ATOMIC_RELAXED, __HIP_MEMORY_SCOPE_AGENT); }
__device__ __forceinline__ unsigned xb_xcc_id() { return (unsigned)__builtin_amdgcn_s_getreg((3 << 11) | 20) & 0xFu; }
#define XB_SPIN(cond, bar) do { unsigned _sp = 0; while (cond) { __builtin_amdgcn_s_sleep(1); \
    if ((++_sp & 255u) == 0u) { if (xb_ld(&(bar)[XB_TMO])) break; if (_sp > XB_SPIN_CAP) { atomicAdd(&(bar)[XB_TMO], 1u); break; } } } } while (0)

struct XcdBarrier {
    unsigned* bar; unsigned x;
    volatile LAS unsigned* st;
};

__device__ __forceinline__ XcdBarrier xcd_barrier_post(unsigned* bar, volatile LAS unsigned* st) {
    XcdBarrier b; b.bar = bar; b.x = xb_xcc_id(); b.st = st;
    if (threadIdx.x == 0) (void)xb_add(&bar[XB_XCNT(b.x)], 1u);
    return b;
}
__device__ __forceinline__ void xcd_barrier_complete(unsigned* bar, unsigned x, unsigned& nloc, unsigned& nx) {
    const unsigned G = gridDim.x * gridDim.y * gridDim.z;
    unsigned sum, cnt, mine, sp = 0u;
    for (;;) {
        sum = 0u; cnt = 0u; mine = 0u;
#pragma unroll
        for (unsigned j = 0; j < 16; ++j) { const unsigned c = xb_ld(&bar[XB_XCNT(j)]); sum += c; cnt += (c > 0u) ? 1u : 0u; mine = (j == x) ? c : mine; }
        if (sum == G) break;
        __builtin_amdgcn_s_sleep(1);
        if ((++sp & 255u) == 0u) { if (xb_ld(&bar[XB_TMO])) break; if (sp > XB_SPIN_CAP) { atomicAdd(&bar[XB_TMO], 1u); break; } }
    }
    nloc = mine > 0u ? mine : 1u; nx = cnt > 0u ? cnt : 1u;
}

__device__ __forceinline__ void xcd_barrier(const XcdBarrier& b) {
    asm volatile("s_waitcnt vmcnt(0)" ::: "memory");
    __syncthreads();
    if (threadIdx.x == 0) {
        unsigned* bar = b.bar;
        __builtin_amdgcn_s_waitcnt(0);
        unsigned nloc = b.st[0], nx = b.st[1];
        if (nloc == 0u) { xcd_barrier_complete(bar, b.x, nloc, nx); b.st[0] = nloc; b.st[1] = nx; }
        const unsigned old = xb_add(&bar[XB_XSUB(b.x)], 1u);
        const unsigned gen = old / nloc;
        if (old + 1u == (gen + 1u) * nloc) {
            __builtin_amdgcn_fence(__ATOMIC_RELEASE, "agent");
            asm volatile("s_waitcnt vmcnt(0)" ::: "memory");
            const unsigned og = xb_add(&bar[XB_TOP], 1u);
            const unsigned tg = og / nx;
            if (og + 1u == (tg + 1u) * nx) xb_add(&bar[XB_TOPGEN], 1u);
            else XB_SPIN(xb_ld(&bar[XB_TOPGEN]) == tg, bar);
            __builtin_amdgcn_fence(__ATOMIC_ACQUIRE, "agent");
            xb_add(&bar[XB_XGEN(b.x)], 1u);
            asm volatile("s_waitcnt vmcnt(0)" ::: "memory");
        } else {
            XB_SPIN(xb_ld(&bar[XB_XGEN(b.x)]) == gen, bar);
            __builtin_amdgcn_fence(__ATOMIC_ACQUIRE, "agent");
            asm volatile("s_waitcnt vmcnt(0)" ::: "memory");
        }
    }
    __syncthreads();
}

struct Bump { char* p; size_t off; float* f(size_t n) { float* r = (float*)(p + off); off += ((n * 4 + 255) / 256) * 256; return r; } };

static size_t setup_ctx(Ctx& c, void* const* d_in, void* d_out, void* d_ws) {
    using namespace cfg;
    for (int i = 0; i < 51; ++i) c.in[i] = (const float*)d_in[i];
    c.page_table = (const int*)d_in[I_PT];
    c.out = (float*)d_out; c.x = c.out;
    Bump b{(char*)d_ws, 4096 * 4};
    const size_t MD = (size_t)MTOT * D;
    c.xn = b.f(MD); c.vf = b.f(MD);
    const size_t base = b.off;
    for (int p = 0; p < 6; ++p) c.xm[p] = b.f(MD);
    c.r = b.f(MD); c.k = b.f(MD); c.v = b.f(MD); c.wpre = b.f(MD); c.apre = b.f(MD); c.vpre = b.f(MD); c.g = b.f(MD);
    c.hw = b.f((size_t)MTOT * RW_DL); c.ha = b.f((size_t)MTOT * RW_AL); c.hv = b.f((size_t)MTOT * RW_VL); c.hg = b.f((size_t)MTOT * RW_GL);
    c.ka = b.f(MD); c.kb = b.f(MD); c.y = c.xm[0]; c.yo = c.xm[1];
    size_t hi = b.off;
    b.off = base;
    c.mh = b.f((size_t)MTOT * MLA_IN); c.qan = b.f((size_t)MTOT * QL); c.q = b.f((size_t)MTOT * MH * QD); c.c = b.f((size_t)MTOT * KVL); c.kp = b.f((size_t)MTOT * ROPE);
    c.knr = b.f((size_t)MTOT * MH * NOPE); c.vv = b.f((size_t)MTOT * MH * VD); c.ao = b.f((size_t)MTOT * MH * VD);
    c.sc = b.f((size_t)DB * MH * DS * KTOT); c.olat = b.f((size_t)DB * MH * DS * KVL);
    if (b.off > hi) hi = b.off;
    b.off = base;
    c.zx = b.f((size_t)MTOT * MB_IN); c.xbc = b.f((size_t)MTOT * MB_CD); c.dt = b.f((size_t)MTOT * MB_HEADS); c.my = b.f((size_t)MTOT * MB_INNER); c.yzn = b.f((size_t)MTOT * MB_INNER);
    if (b.off > hi) hi = b.off;
    b.off = hi;
    c.hmid = b.f((size_t)MTOT * FFN);
    return b.off;
}

__device__ __forceinline__ unsigned tid_now() { unsigned t = threadIdx.x; asm volatile("" : "+v"(t)); return t; }
namespace pg8 {
#define PG8_LAS __attribute__((address_space(3)))
typedef unsigned short bf16_t;
typedef short bf16x8 __attribute__((ext_vector_type(8)));
typedef float f32x4 __attribute__((ext_vector_type(4)));
typedef float f32x2 __attribute__((ext_vector_type(2)));
typedef unsigned u32x4 __attribute__((ext_vector_type(4)));
typedef unsigned u32x2 __attribute__((ext_vector_type(2)));
constexpr int BM = 256, BK = 64, HALF = 128, HTB = HALF * BK * 2  , STAGE_BYTES = 8 * HTB, NXCD = 8, WGM = 8;

__host__ __device__ __forceinline__ int lds_byte(int r, int c) { const int st = (r >> 4) * 2 + (c >> 5), rr = r & 15, cc = c & 31, ob = rr * 64 + cc * 2; return st * 1024 + (ob ^ (((ob >> 9) & 1) << 5)); }
__host__ __device__ __forceinline__ void stage_rc(int b, int& R, int& C) { const int st = b / 1024, sb = b % 1024, swz = sb ^ (((sb >> 9) & 1) << 5); R = (st >> 1) * 16 + swz / 64; C = (st & 1) * 32 + (swz % 64) / 2; }
__host__ __device__ __forceinline__ int perm32(int rho) { const int n = rho >> 4, i = rho & 15; return 8 * (i >> 2) + 4 * n + (i & 3); }
__device__ __forceinline__ unsigned cvt_pk_bf16(float lo, float hi) { unsigned r; asm volatile("v_cvt_pk_bf16_f32 %0, %1, %2" : "=v"(r) : "v"(lo), "v"(hi)); return r; }

struct Unit { int pm, pn, k0, nt, asel, part; };
struct Gemm { const bf16_t* A; const bf16_t* Bt; int lda, ldb; size_t asel_stride; };

struct NoSel { __device__ static __forceinline__ int sel(int) { return 0; } };
template <class ASEL = NoSel>
struct Order {
    int nMp, nMs, nN, nwgP, nwgS, G, c, K, ksplit;
    __device__ __forceinline__ void init(int nMp_, int nMs_, int nN_, int K_, int ksplit_, int G_, int c_) { nMp = nMp_; nMs = nMs_; nN = nN_; nwgP = nMp * nN; K = K_; ksplit = ksplit_; nwgS = nMs * nN * ksplit; G = G_; c = c_; }
    __device__ __forceinline__ bool next(int i, Unit& u) const {
        const long L = (long)i * G + c;
        if (L < nwgP) {
            int wgid = (int)L; { const int q = nwgP / NXCD, r = nwgP % NXCD, xcd = wgid % NXCD, off = wgid / NXCD; wgid = (xcd < r ? xcd * (q + 1) : r * (q + 1) + (xcd - r) * q) + off; }
            const int nig = WGM * nN, gid = wgid / nig, fm = gid * WGM, gsz = (nMp - fm) < WGM ? (nMp - fm) : WGM;
            u.pm = fm + ((wgid % nig) % gsz); u.pn = (wgid % nig) / gsz; u.k0 = 0; u.nt = K / BK; u.part = 0; u.asel = ASEL::sel(u.pn); return true;
        }
        const long Ls = L - nwgP; if (Ls >= nwgS) return false;
        const int sub = (int)(Ls % ksplit), t = (int)(Ls / ksplit);
        u.pm = nMp + t % nMs; u.pn = t / nMs; u.nt = K / BK / ksplit; u.k0 = sub * u.nt * BK; u.part = ksplit > 1 ? 1 : 0; u.asel = ASEL::sel(u.pn); return true;
    }
};

template <class Epi, class Sched>
__device__ __forceinline__ void gemm_phase(PG8_LAS unsigned char* lds, const Gemm g, const Sched& S, const Epi& E) {
    const int tid = (int)tid_now(), wid = __builtin_amdgcn_readfirstlane(tid >> 6), lane = tid & 63, wr = wid >> 2, wc = wid & 3, fr = lane & 15, fq = lane >> 4;
    unsigned voffA[2], voffB[2];
#pragma unroll
    for (int i = 0; i < 2; ++i) { int R, C; stage_rc(tid * 16 + i * 8192, R, C); const int Rb = Epi::PERM ? ((R & ~31) + perm32(R & 31)) : R;
        voffA[i] = (unsigned)(R * g.lda + C) * 2u; voffB[i] = (unsigned)(Rb * g.ldb + C) * 2u; }
    const size_t kstep = (size_t)(BK * 2);
    const size_t hstepA = (size_t)HALF * g.lda * 2, hstepB = (size_t)HALF * g.ldb * 2;
    const unsigned ldsw = (unsigned)wid * 1024u;
    const int aoff = lds_byte(wr * 64 + fr, fq * 8), boff = lds_byte(wc * 32 + fr, fq * 8);
#define PG8_SA(b, h) (((b) * 2 + (h)) * HTB)
#define PG8_SB(b, h) ((4 + (b) * 2 + (h)) * HTB)
#define PG8_STAGE(bufoff, gbase, voff) do { _Pragma("unroll") for (int _i = 0; _i < 2; ++_i) \
        __builtin_amdgcn_global_load_lds((const unsigned*)((const char*)(gbase) + (voff)[_i]), (PG8_LAS unsigned*)(lds + (bufoff) + ldsw + _i * 8192), 16, 0, 0); } while (0)
#define PG8_LDA(dst, b, h) do { _Pragma("unroll") for (int m = 0; m < 4; ++m) _Pragma("unroll") for (int k = 0; k < 2; ++k) dst[m][k] = *(const PG8_LAS bf16x8*)(lds + PG8_SA(b, h) + aoff + m * 2048 + k * 1024); } while (0)
#define PG8_LDB(dst, b, h) do { _Pragma("unroll") for (int n = 0; n < 2; ++n) _Pragma("unroll") for (int k = 0; k < 2; ++k) dst[n][k] = *(const PG8_LAS bf16x8*)(lds + PG8_SB(b, h) + boff + n * 2048 + k * 1024); } while (0)
#define PG8_MMA(ai, bj, At, Bt) do { __builtin_amdgcn_s_setprio(1); _Pragma("unroll") for (int m = 0; m < 4; ++m) _Pragma("unroll") for (int n = 0; n < 2; ++n) _Pragma("unroll") for (int k = 0; k < 2; ++k) \
        acc[ai][bj][m][n] = __builtin_amdgcn_mfma_f32_16x16x32_bf16(Bt[n][k], At[m][k], acc[ai][bj][m][n], 0, 0, 0); __builtin_amdgcn_s_setprio(0); } while (0)
#define PG8_WAIT_V(n) asm volatile("s_waitcnt vmcnt(" #n ")" ::: "memory")
#define PG8_WAIT_L(n) asm volatile("s_waitcnt lgkmcnt(" #n ")" ::: "memory")
#define PG8_BAR __builtin_amdgcn_s_barrier()
#define PG8_SCHED __builtin_amdgcn_sched_barrier(0)
#define PG8_ABASE(u) ((const char*)g.A + ((size_t)(u).asel * g.asel_stride + (size_t)(u).pm * BM * g.lda + (u).k0) * 2)
#define PG8_BBASE(u) ((const char*)g.Bt + ((size_t)(u).pn * BM * g.ldb + (u).k0) * 2)
    Unit cur, nxt; int ui = 0;
    if (!S.next(0, cur)) return;
    f32x4 acc[2][2][4][2];
#pragma unroll
    for (int a = 0; a < 2; ++a)
#pragma unroll
        for (int b = 0; b < 2; ++b)
#pragma unroll
            for (int m = 0; m < 4; ++m)
#pragma unroll
                for (int n = 0; n < 2; ++n) acc[a][b][m][n] = (f32x4){0.f, 0.f, 0.f, 0.f};
    bf16x8 At[4][2], B0[2][2], B1[2][2];
    const char* cA = PG8_ABASE(cur); const char* cB = PG8_BBASE(cur);
    PG8_STAGE(PG8_SB(0, 0), cB, voffB); PG8_STAGE(PG8_SA(0, 0), cA, voffA); PG8_STAGE(PG8_SB(0, 1), cB + hstepB, voffB); PG8_STAGE(PG8_SA(0, 1), cA + hstepA, voffA);
    if (wr == 1) PG8_BAR;
    PG8_WAIT_V(4); PG8_BAR;
    PG8_STAGE(PG8_SB(1, 0), cB + kstep, voffB); PG8_STAGE(PG8_SA(1, 0), cA + kstep, voffA); PG8_STAGE(PG8_SB(1, 1), cB + hstepB + kstep, voffB);
    PG8_WAIT_V(6); PG8_BAR;
    for (;;) {
        const bool has_next = S.next(ui + 1, nxt);
        const char* nA = has_next ? PG8_ABASE(nxt) : cA; const char* nB = has_next ? PG8_BBASE(nxt) : cB;
        const int nt = cur.nt;
        for (int t = 0; t < nt; t += 2) {
            const bool last = (t == nt - 2);
            const char* a1 = cA + (size_t)(t + 1) * kstep;
            const char* a2 = last ? nA : cA + (size_t)(t + 2) * kstep; const char* b2 = last ? nB : cB + (size_t)(t + 2) * kstep;
            const char* a3 = a2 + kstep; const char* b3 = b2 + kstep;
            PG8_LDB(B0, 0, 0); PG8_SCHED; PG8_LDA(At, 0, 0); PG8_STAGE(PG8_SA(1, 1), a1 + hstepA, voffA);
            PG8_WAIT_L(8); PG8_BAR; PG8_WAIT_L(0); PG8_MMA(0, 0, At, B0); PG8_BAR; PG8_SCHED;
            PG8_LDB(B1, 0, 1); PG8_STAGE(PG8_SB(0, 0), b2, voffB);
            PG8_BAR; PG8_WAIT_L(0); PG8_MMA(0, 1, At, B1); PG8_BAR;
            PG8_LDA(At, 0, 1); PG8_STAGE(PG8_SA(0, 0), a2, voffA);
            PG8_BAR; PG8_WAIT_L(0); PG8_MMA(1, 0, At, B0); PG8_BAR; PG8_SCHED;
            PG8_STAGE(PG8_SB(0, 1), b2 + hstepB, voffB);
            PG8_WAIT_V(6); PG8_BAR; PG8_MMA(1, 1, At, B1); PG8_BAR;
            PG8_LDB(B0, 1, 0); PG8_SCHED; PG8_LDA(At, 1, 0); PG8_STAGE(PG8_SA(0, 1), a2 + hstepA, voffA);
            PG8_WAIT_L(8); PG8_BAR; PG8_WAIT_L(0); PG8_MMA(0, 0, At, B0); PG8_BAR; PG8_SCHED;
            PG8_LDB(B1, 1, 1); PG8_STAGE(PG8_SB(1, 0), b3, voffB);
            PG8_BAR; PG8_WAIT_L(0); PG8_MMA(0, 1, At, B1); PG8_BAR;
            PG8_LDA(At, 1, 1); PG8_STAGE(PG8_SA(1, 0), a3, voffA);
            PG8_BAR; PG8_WAIT_L(0); PG8_MMA(1, 0, At, B0); PG8_BAR; PG8_SCHED;
            PG8_STAGE(PG8_SB(1, 1), b3 + hstepB, voffB);
            PG8_WAIT_V(6); PG8_BAR; PG8_MMA(1, 1, At, B1); PG8_BAR;
        }
        E(acc, cur, wr, wc, fr, fq);
        if (!has_next) break;
#pragma unroll
        for (int a = 0; a < 2; ++a)
#pragma unroll
            for (int b = 0; b < 2; ++b)
#pragma unroll
                for (int m = 0; m < 4; ++m)
#pragma unroll
                    for (int n = 0; n < 2; ++n) acc[a][b][m][n] = (f32x4){0.f, 0.f, 0.f, 0.f};
        cur = nxt; cA = nA; cB = nB; ++ui;
    }
    PG8_WAIT_V(0);
    if (wr == 0) PG8_BAR;
    PG8_BAR;
#undef PG8_SA
#undef PG8_SB
#undef PG8_STAGE
#undef PG8_LDA
#undef PG8_LDB
#undef PG8_MMA
#undef PG8_WAIT_V
#undef PG8_WAIT_L
#undef PG8_BAR
#undef PG8_SCHED
#undef PG8_ABASE
#undef PG8_BBASE
}

struct EpiAccF32 {
    static constexpr bool PERM = false;
    float* C; int ldc; float* slab; int pm0, nMs, ksplit; const float* Csrc = nullptr;
    __device__ __forceinline__ void operator()(const f32x4 (&acc)[2][2][4][2], const Unit& u, int wr, int wc, int fr, int fq) const {
        if (u.part) {
            float* sl = slab + ((size_t)((u.pn * nMs + (u.pm - pm0)) * ksplit + u.k0 / (u.nt * BK)) * BM + wr * 64 + fr) * BM + wc * 32 + 4 * fq;
#pragma unroll
            for (int ai = 0; ai < 2; ++ai)
#pragma unroll
                for (int m = 0; m < 4; ++m) { float* rowp = sl + (size_t)(ai * HALF + m * 16) * BM;
#pragma unroll
                    for (int bj = 0; bj < 2; ++bj)
#pragma unroll
                        for (int n = 0; n < 2; ++n) *(f32x4*)(rowp + bj * HALF + n * 16) = acc[ai][bj][m][n]; }
        } else {
            const int row0 = u.pm * BM + wr * 64 + fr, col0 = u.pn * BM + wc * 32 + 4 * fq;
#pragma unroll
            for (int ai = 0; ai < 2; ++ai)
#pragma unroll
                for (int m2 = 0; m2 < 4; m2 += 2) {
                    f32x4 t[2][2][2];
#pragma unroll
                    for (int mm = 0; mm < 2; ++mm) { const float* rowp = (Csrc ? Csrc : C) + (size_t)(row0 + ai * HALF + (m2 + mm) * 16) * ldc + col0;
#pragma unroll
                        for (int bj = 0; bj < 2; ++bj)
#pragma unroll
                            for (int n = 0; n < 2; ++n) t[mm][bj][n] = *(const f32x4*)(rowp + bj * HALF + n * 16); }
#pragma unroll
                    for (int mm = 0; mm < 2; ++mm) { float* rowp = C + (size_t)(row0 + ai * HALF + (m2 + mm) * 16) * ldc + col0;
#pragma unroll
                        for (int bj = 0; bj < 2; ++bj)
#pragma unroll
                            for (int n = 0; n < 2; ++n) *(f32x4*)(rowp + bj * HALF + n * 16) = t[mm][bj][n] + acc[ai][bj][m2 + mm][n]; }
                }
        }
    }
};
struct EpiF32 {
    static constexpr bool PERM = false;
    float* C; int ldc; int ncols;
    __device__ __forceinline__ void operator()(const f32x4 (&acc)[2][2][4][2], const Unit& u, int wr, int wc, int fr, int fq) const {
        const int row0 = u.pm * BM + wr * 64 + fr, col0 = u.pn * BM + wc * 32 + 4 * fq;
#pragma unroll
        for (int ai = 0; ai < 2; ++ai)
#pragma unroll
            for (int m = 0; m < 4; ++m) { float* rowp = C + (size_t)(row0 + ai * HALF + m * 16) * ldc + col0;
#pragma unroll
                for (int bj = 0; bj < 2; ++bj)
#pragma unroll
                    for (int n = 0; n < 2; ++n) if (col0 + bj * HALF + n * 16 < ncols) *(f32x4*)(rowp + bj * HALF + n * 16) = acc[ai][bj][m][n]; }
    }
};
template <int ACT> struct EpiBf16 {
    static constexpr bool PERM = true;
    bf16_t* O; int ldc;
    __device__ __forceinline__ void operator()(const f32x4 (&acc)[2][2][4][2], const Unit& u, int wr, int wc, int fr, int fq) const {
        const int row0 = u.pm * BM + wr * 64 + fr, col0 = u.pn * BM + wc * 32 + 8 * fq;
#pragma unroll
        for (int ai = 0; ai < 2; ++ai)
#pragma unroll
            for (int m = 0; m < 4; ++m) { bf16_t* rowp = O + (size_t)(row0 + ai * HALF + m * 16) * ldc + col0;
#pragma unroll
                for (int bj = 0; bj < 2; ++bj) { f32x4 v0 = acc[ai][bj][m][0], v1 = acc[ai][bj][m][1];
                    if (ACT == 3) {
#pragma unroll
                        for (int j = 0; j < 4; ++j) { const float a = fmaxf(v0[j], 0.f), b = fmaxf(v1[j], 0.f); v0[j] = a * a; v1[j] = b * b; } }
                    u32x4 w; w.x = cvt_pk_bf16(v0[0], v0[1]); w.y = cvt_pk_bf16(v0[2], v0[3]); w.z = cvt_pk_bf16(v1[0], v1[1]); w.w = cvt_pk_bf16(v1[2], v1[3]);
                    *(u32x4*)(rowp + bj * HALF) = w; } }
    }
};
}
typedef pg8::bf16_t bf16_t;
#define LDSP __attribute__((address_space(3)))
struct Fast {
    bf16_t *xnb, *hmidb;
    bf16_t *w1t, *w2t;
    float* slab;
};
__device__ __forceinline__ unsigned pk2bf(float lo, float hi) { return pg8::cvt_pk_bf16(lo, hi); }
__device__ __forceinline__ float wave_sum64(float v) {
#pragma unroll
    for (int o = 1; o < 64; o <<= 1) v += __shfl_xor(v, o);
    return v;
}
__device__ __forceinline__ void red16x4(float& a, float& b, float& c, float& d) {
    asm volatile("s_nop 1\n"
        "v_add_f32_dpp %0, %0, %0 quad_perm:[1,0,3,2] row_mask:0xf bank_mask:0xf\n" "v_add_f32_dpp %1, %1, %1 quad_perm:[1,0,3,2] row_mask:0xf bank_mask:0xf\n"
        "v_add_f32_dpp %2, %2, %2 quad_perm:[1,0,3,2] row_mask:0xf bank_mask:0xf\n" "v_add_f32_dpp %3, %3, %3 quad_perm:[1,0,3,2] row_mask:0xf bank_mask:0xf\n"
        "v_add_f32_dpp %0, %0, %0 quad_perm:[2,3,0,1] row_mask:0xf bank_mask:0xf\n" "v_add_f32_dpp %1, %1, %1 quad_perm:[2,3,0,1] row_mask:0xf bank_mask:0xf\n"
        "v_add_f32_dpp %2, %2, %2 quad_perm:[2,3,0,1] row_mask:0xf bank_mask:0xf\n" "v_add_f32_dpp %3, %3, %3 quad_perm:[2,3,0,1] row_mask:0xf bank_mask:0xf\n"
        "v_add_f32_dpp %0, %0, %0 row_ror:4 row_mask:0xf bank_mask:0xf\n" "v_add_f32_dpp %1, %1, %1 row_ror:4 row_mask:0xf bank_mask:0xf\n"
        "v_add_f32_dpp %2, %2, %2 row_ror:4 row_mask:0xf bank_mask:0xf\n" "v_add_f32_dpp %3, %3, %3 row_ror:4 row_mask:0xf bank_mask:0xf\n"
        "v_add_f32_dpp %0, %0, %0 row_ror:8 row_mask:0xf bank_mask:0xf\n" "v_add_f32_dpp %1, %1, %1 row_ror:8 row_mask:0xf bank_mask:0xf\n"
        "v_add_f32_dpp %2, %2, %2 row_ror:8 row_mask:0xf bank_mask:0xf\n" "v_add_f32_dpp %3, %3, %3 row_ror:8 row_mask:0xf bank_mask:0xf\n"
        "s_nop 1"
        : "+v"(a), "+v"(b), "+v"(c), "+v"(d));
}
__device__ __forceinline__ void tr_item(const float* __restrict__ W, int ldw, int K, bf16_t* WT, int nvalid, const float* __restrict__ kscale, LDSP float* scr, int item, int nblk, int lane) {
    const int kb = item / nblk, nb = item % nblk, k0 = 64 * kb, n0 = 32 * nb;
    const bool ok = n0 < nvalid;
#pragma unroll
    for (int i = 0; i < 8; ++i) { const int kk = 8 * i + (lane >> 3), nn = 4 * (lane & 7); pg8::f32x4 v = ok ? *(const pg8::f32x4*)(W + (size_t)(k0 + kk) * ldw + n0 + nn) : (pg8::f32x4){0.f, 0.f, 0.f, 0.f};
        if (kscale) v = v * kscale[k0 + kk];
        scr[kk * 33 + nn] = v[0]; scr[kk * 33 + nn + 1] = v[1]; scr[kk * 33 + nn + 2] = v[2]; scr[kk * 33 + nn + 3] = v[3]; }
    asm volatile("s_waitcnt lgkmcnt(0)" ::: "memory");
    const int c = lane & 7;
#pragma unroll
    for (int j = 0; j < 4; ++j) { const int n = (lane >> 3) + 8 * j; const LDSP float* s = scr + (8 * c) * 33 + n;
        pg8::u32x4 o; o.x = pk2bf(s[0 * 33], s[1 * 33]); o.y = pk2bf(s[2 * 33], s[3 * 33]); o.z = pk2bf(s[4 * 33], s[5 * 33]); o.w = pk2bf(s[6 * 33], s[7 * 33]);
        *(pg8::u32x4*)(WT + (size_t)(n0 + n) * K + k0 + 8 * c) = o; }
    asm volatile("s_waitcnt lgkmcnt(0)" ::: "memory");
}
__device__ __forceinline__ void tr_weight(const float* W, int K, int N, int npad, bf16_t* WT, const float* kscale, LDSP float* scr, int gw, int ngw, int lane) {
    const int nblk = npad / 32, items = (K / 64) * nblk;
    for (int it = gw; it < items; it += ngw) tr_item(W, N, K, WT, N, kscale, scr, it, nblk, lane);
}
constexpr int TRJ_W = 12;
struct TrTab { LDSP int* t; int n; int total; };
__device__ __forceinline__ void trj_put(TrTab& tb, const float* W, int K, int N, int npad, bf16_t* WT) {
    LDSP int* e = tb.t + tb.n * TRJ_W; const unsigned long long w = (unsigned long long)(size_t)W, o = (unsigned long long)(size_t)WT;
    const int nblk = npad / 32, items = (K / 64) * nblk;
    e[0] = (int)(unsigned)w; e[1] = (int)(unsigned)(w >> 32); e[2] = (int)(unsigned)o; e[3] = (int)(unsigned)(o >> 32); e[4] = N; e[5] = K; e[6] = N; e[7] = nblk; e[8] = tb.total; e[9] = tb.total + items;
    tb.total += items; ++tb.n;
}
struct TrCur { bf16_t* wt; int K, k0, n0; };
__device__ __forceinline__ bool trj_issue(LDSP const int* tab, int njobs, int idx, int& j, pg8::f32x4 (&v)[8], TrCur& t, int lane) {
    while (j < njobs && idx >= __builtin_amdgcn_readfirstlane(tab[j * TRJ_W + 9])) ++j;
    if (j >= njobs) return false;
    LDSP const int* e = tab + j * TRJ_W;
    const unsigned wl = __builtin_amdgcn_readfirstlane(e[0]), wh = __builtin_amdgcn_readfirstlane(e[1]), ol = __builtin_amdgcn_readfirstlane(e[2]), oh = __builtin_amdgcn_readfirstlane(e[3]);
    const int ldw = __builtin_amdgcn_readfirstlane(e[4]), K = __builtin_amdgcn_readfirstlane(e[5]), nvalid = __builtin_amdgcn_readfirstlane(e[6]), nblk = __builtin_amdgcn_readfirstlane(e[7]), it = idx - __builtin_amdgcn_readfirstlane(e[8]);
    const float* W = (const float*)(size_t)(((unsigned long long)wh << 32) | wl);
    const int kb = it / nblk, nb = it - kb * nblk, k0 = 64 * kb, n0 = 32 * nb;
    t.wt = (bf16_t*)(size_t)(((unsigned long long)oh << 32) | ol); t.K = K; t.k0 = k0; t.n0 = n0;
    const bool ok = n0 < nvalid;
#pragma unroll
    for (int i = 0; i < 8; ++i) { const int kk = 8 * i + (lane >> 3), nn = 4 * (lane & 7); v[i] = ok ? *(const pg8::f32x4*)(W + (size_t)(k0 + kk) * ldw + n0 + nn) : (pg8::f32x4){0.f, 0.f, 0.f, 0.f}; }
    return true;
}
__device__ __forceinline__ void trj_finish(const pg8::f32x4 (&v)[8], const TrCur& t, LDSP float* scr, int lane) {
#pragma unroll
    for (int i = 0; i < 8; ++i) { const int kk = 8 * i + (lane >> 3), nn = 4 * (lane & 7);
        scr[kk * 33 + nn] = v[i][0]; scr[kk * 33 + nn + 1] = v[i][1]; scr[kk * 33 + nn + 2] = v[i][2]; scr[kk * 33 + nn + 3] = v[i][3]; }
    asm volatile("s_waitcnt lgkmcnt(0)" ::: "memory");
    const int c = lane & 7;
#pragma unroll
    for (int j = 0; j < 4; ++j) { const int n = (lane >> 3) + 8 * j; const LDSP float* s = scr + (8 * c) * 33 + n;
        pg8::u32x4 o; o.x = pk2bf(s[0 * 33], s[1 * 33]); o.y = pk2bf(s[2 * 33], s[3 * 33]); o.z = pk2bf(s[4 * 33], s[5 * 33]); o.w = pk2bf(s[6 * 33], s[7 * 33]);
        *(pg8::u32x4*)(t.wt + (size_t)(t.n0 + n) * t.K + t.k0 + 8 * c) = o; }
    asm volatile("s_waitcnt lgkmcnt(0)" ::: "memory");
}
__device__ __forceinline__ void trj_run(LDSP const int* tab, int njobs, int total, LDSP float* scr, int gw, int ngw, int lane) {
    int j = 0; pg8::f32x4 va[8], vb[8]; TrCur ta, tb;
    int idx = gw;
    bool have = idx < total && trj_issue(tab, njobs, idx, j, va, ta, lane);
    while (have) {
        idx += ngw; const bool hb = idx < total && trj_issue(tab, njobs, idx, j, vb, tb, lane);
        trj_finish(va, ta, scr, lane);
        if (!hb) break;
        idx += ngw; have = idx < total && trj_issue(tab, njobs, idx, j, va, ta, lane);
        trj_finish(vb, tb, scr, lane);
    }
}
__device__ __forceinline__ pg8::f32x4 slab_sum(const float* __restrict__ slab, int ksplit, int m, int q, int lane) {
    using namespace cfg; const int rs = m - MP, pms = rs >> 8, row = rs & 255;
    const float* p = slab + ((size_t)((q * (MS / 256) + pms) * ksplit) * 256 + row) * 256 + 4 * lane;
    pg8::f32x4 s = {0.f, 0.f, 0.f, 0.f};
    for (int k = 0; k < ksplit; ++k) s = s + *(const pg8::f32x4*)(p + (size_t)k * 65536);
    return s;
}
__device__ __forceinline__ void norm_rows_bf16(float* __restrict__ x, const float* __restrict__ gain, bf16_t* xn, const float* __restrict__ slab, int ksplit, int gw, int ngw, int lane) {
    using namespace cfg;
    pg8::f32x4 gv[4];
#pragma unroll
    for (int j = 0; j < 4; ++j) gv[j] = *(const pg8::f32x4*)(gain + 4 * lane + 256 * j);
    for (int m = gw; m < MTOT; m += ngw) {
        float* xr = x + (size_t)m * D; pg8::f32x4 v[4]; float s = 0.f;
#pragma unroll
        for (int j = 0; j < 4; ++j) { v[j] = *(const pg8::f32x4*)(xr + 4 * lane + 256 * j);
            if (ksplit > 1 && m >= MP) { v[j] = v[j] + slab_sum(slab, ksplit, m, j, lane); *(pg8::f32x4*)(xr + 4 * lane + 256 * j) = v[j]; }
            s += (v[j][0] * v[j][0] + v[j][1] * v[j][1]) + (v[j][2] * v[j][2] + v[j][3] * v[j][3]); }
        const float rs = 1.0f / sqrtf(wave_sum64(s) * (1.0f / D) + NORM_EPS);
#pragma unroll
        for (int j = 0; j < 4; ++j) { pg8::u32x2 o; o.x = pk2bf(v[j][0] * rs * gv[j][0], v[j][1] * rs * gv[j][1]); o.y = pk2bf(v[j][2] * rs * gv[j][2], v[j][3] * rs * gv[j][3]);
            *(pg8::u32x2*)(xn + (size_t)m * D + 4 * lane + 256 * j) = o; }
    }
}

__device__ __forceinline__ void fold_sample_rows(float* __restrict__ x, const float* __restrict__ slab, int ksplit, int gw, int ngw, int lane) {
    using namespace cfg;
    for (int m = MP + gw; m < MTOT; m += ngw) {
#pragma unroll
        for (int j = 0; j < 4; ++j) { float* p = x + (size_t)m * D + 4 * lane + 256 * j; *(pg8::f32x4*)p = *(const pg8::f32x4*)p + slab_sum(slab, ksplit, m, j, lane); }
    }
}
struct FastMla {
    float* mh;
    bf16_t *qan, *cb, *kpb;
    bf16_t *qraw, *kvraw;
    bf16_t *qf, *knb, *aob, *vT, *qs;
    float *opart, *lpart;
    bf16_t *wint, *wuqt, *wukvt, *wot;
};
__device__ __forceinline__ void rope_cs(int pos, int i, float& cs, float& sn) {
    const float inv = exp2f(-(float)i * (13.287712379549449f / 16.0f));
    const float ang = (float)pos * inv, kq = rintf(ang * 0.15915494309189535f);
    float rr = fmaf(-kq, 6.28125f, ang); rr = fmaf(-kq, 1.9353071795864769e-3f, rr);
    cs = __cosf(rr); sn = __sinf(rr);
}
__device__ __forceinline__ float rope_inv(int i) { return exp2f(-(float)i * (13.287712379549449f / 16.0f)); }
__device__ __forceinline__ void rope_cs_inv(int pos, float inv, float& cs, float& sn) {
    const float ang = (float)pos * inv, kq = rintf(ang * 0.15915494309189535f);
    float rr = fmaf(-kq, 6.28125f, ang); rr = fmaf(-kq, 1.9353071795864769e-3f, rr);
    cs = __cosf(rr); sn = __sinf(rr);
}
__device__ __forceinline__ float bf2f(unsigned short b) { return __uint_as_float(((unsigned)b) << 16); }
__device__ __forceinline__ void mla_norm1_fast(const Ctx& c, const FastMla& fm, int j, int gw, int ngw, int lane) {
    using namespace cfg;
    const pg8::f32x4 gq0 = *(const pg8::f32x4*)(c.in[I_QNORM] + j * QL + 4 * lane), gq1 = *(const pg8::f32x4*)(c.in[I_QNORM] + j * QL + 4 * lane + 256), gc = *(const pg8::f32x4*)(c.in[I_KVNORM] + j * KVL + 4 * lane);
    const float gkr = lane < ROPE ? c.in[I_KRN][j * ROPE + lane] : 0.f;
    const float rinv1 = rope_inv(lane & 15);
    for (int m = gw; m < MTOT; m += ngw) {
        const float* h = fm.mh + (size_t)m * 1024;
        pg8::f32x4 qv[2]; float s = 0.f;
#pragma unroll
        for (int t = 0; t < 2; ++t) { qv[t] = *(const pg8::f32x4*)(h + 4 * lane + 256 * t); s += (qv[t][0] * qv[t][0] + qv[t][1] * qv[t][1]) + (qv[t][2] * qv[t][2] + qv[t][3] * qv[t][3]); }
        const float rq = 1.0f / sqrtf(wave_sum64(s) * (1.0f / QL) + NORM_EPS);
#pragma unroll
        for (int t = 0; t < 2; ++t) { const pg8::f32x4 g = t ? gq1 : gq0;
            pg8::u32x2 o; o.x = pk2bf(qv[t][0] * rq * g[0], qv[t][1] * rq * g[1]); o.y = pk2bf(qv[t][2] * rq * g[2], qv[t][3] * rq * g[3]);
            *(pg8::u32x2*)(fm.qan + (size_t)m * QL + 4 * lane + 256 * t) = o; }
        const pg8::f32x4 cv = *(const pg8::f32x4*)(h + QL + 4 * lane);
        const float rc = 1.0f / sqrtf(wave_sum64((cv[0] * cv[0] + cv[1] * cv[1]) + (cv[2] * cv[2] + cv[3] * cv[3])) * (1.0f / KVL) + NORM_EPS);
        const pg8::f32x4 cn = {cv[0] * rc * gc[0], cv[1] * rc * gc[1], cv[2] * rc * gc[2], cv[3] * rc * gc[3]};
        float* co = m < MP ? c.out + O_CKVP + ((size_t)j * MP + m) * KVL : c.out + O_CKVS + ((size_t)j * MS + (m - MP)) * KVL;
        *(pg8::f32x4*)(co + 4 * lane) = cn;
        { pg8::u32x2 o; o.x = pk2bf(cn[0], cn[1]); o.y = pk2bf(cn[2], cn[3]); *(pg8::u32x2*)(fm.cb + (size_t)m * KVL + 4 * lane) = o; }
        const float kv = lane < ROPE ? h[QL + KVL + lane] : 0.f;
        const float rk = 1.0f / sqrtf(wave_sum64(kv * kv) * (1.0f / ROPE) + NORM_EPS);
        const float kn = kv * rk * gkr;
        const float other = __shfl_xor(kn, 16);
        float cs, sn; rope_cs_inv(row_pos(m), rinv1, cs, sn);
        const float ro = lane < 16 ? kn * cs - other * sn : kn * cs + other * sn;
        if (lane < ROPE) {
            float* ko = m < MP ? c.out + O_KPEP + ((size_t)j * MP + m) * ROPE : c.out + O_KPES + ((size_t)j * MS + (m - MP)) * ROPE;
            ko[lane] = ro;
            fm.kpb[(size_t)m * ROPE + lane] = (bf16_t)(pk2bf(ro, 0.f) & 0xffffu);
        }
    }
}
__device__ __forceinline__ void mla_norm2_fast(const Ctx& c, const FastMla& fm, int j, int gw, int ngw, int lane) {
    using namespace cfg;
    const int hd = lane >> 2, qt = lane & 3;
    const float QSC = 0.10206207261596575f * 1.4426950408889634f;
    float gqn[16], gkn[16], gqr[8];
    { const float* pq = c.in[I_QNN] + j * NOPE + 16 * qt; const float* pk = c.in[I_KNN] + j * NOPE + 16 * qt; const float* pr = c.in[I_QRN] + j * ROPE + 8 * qt;
#pragma unroll
      for (int i4 = 0; i4 < 4; ++i4) { const pg8::f32x4 a = *(const pg8::f32x4*)(pq + 4 * i4), b = *(const pg8::f32x4*)(pk + 4 * i4);
#pragma unroll
          for (int e = 0; e < 4; ++e) { gqn[4 * i4 + e] = a[e]; gkn[4 * i4 + e] = b[e]; } }
#pragma unroll
      for (int i4 = 0; i4 < 2; ++i4) { const pg8::f32x4 a = *(const pg8::f32x4*)(pr + 4 * i4);
#pragma unroll
          for (int e = 0; e < 4; ++e) gqr[4 * i4 + e] = a[e]; } }
    float rinv[8];
#pragma unroll
    for (int i = 0; i < 8; ++i) rinv[i] = rope_inv((8 * qt + i) & 15);
    for (int m = gw; m < MTOT; m += ngw) {
        const bf16_t* qr = fm.qraw + (size_t)m * (MH * QD) + hd * QD;
        float v[16]; float s = 0.f;
        { const pg8::u32x4 a = *(const pg8::u32x4*)(qr + 16 * qt), b = *(const pg8::u32x4*)(qr + 16 * qt + 8); const unsigned w[8] = {a.x, a.y, a.z, a.w, b.x, b.y, b.z, b.w};
#pragma unroll
          for (int i = 0; i < 8; ++i) { v[2 * i] = __uint_as_float(w[i] << 16); v[2 * i + 1] = __uint_as_float(w[i] & 0xffff0000u); } }
#pragma unroll
        for (int i = 0; i < 16; ++i) s += v[i] * v[i];
        s += __shfl_xor(s, 1); s += __shfl_xor(s, 2);
        float rs = 1.0f / sqrtf(s * (1.0f / NOPE) + NORM_EPS);
        bf16_t* qo = fm.qf + (size_t)m * (MH * QD) + hd * QD;
        { unsigned w[8], w2[8];
#pragma unroll
          for (int i = 0; i < 8; ++i) { const float a = v[2 * i] * rs * gqn[2 * i], b = v[2 * i + 1] * rs * gqn[2 * i + 1];
              w[i] = pk2bf(a * QSC, b * QSC);
              w2[i] = pk2bf(a * QSC * gkn[2 * i], b * QSC * gkn[2 * i + 1]); }
          *(pg8::u32x4*)(qo + 16 * qt) = (pg8::u32x4){w[0], w[1], w[2], w[3]}; *(pg8::u32x4*)(qo + 16 * qt + 8) = (pg8::u32x4){w[4], w[5], w[6], w[7]};
          if (m >= MP) { bf16_t* q2 = fm.qs + ((size_t)(((m - MP) >> 3) * MH + hd) * 6 + qt) * 128 + ((m - MP) & 7) * 8;
              *(pg8::u32x4*)(q2) = (pg8::u32x4){w2[0], w2[1], w2[4], w2[5]}; *(pg8::u32x4*)(q2 + 64) = (pg8::u32x4){w2[2], w2[3], w2[6], w2[7]}; } }
        float r8[8]; s = 0.f;
        { const pg8::u32x4 a = *(const pg8::u32x4*)(qr + NOPE + 8 * qt); const unsigned w[4] = {a.x, a.y, a.z, a.w};
#pragma unroll
          for (int i = 0; i < 4; ++i) { r8[2 * i] = __uint_as_float(w[i] << 16); r8[2 * i + 1] = __uint_as_float(w[i] & 0xffff0000u); } }
#pragma unroll
        for (int i = 0; i < 8; ++i) s += r8[i] * r8[i];
        s += __shfl_xor(s, 1); s += __shfl_xor(s, 2);
        rs = 1.0f / sqrtf(s * (1.0f / ROPE) + NORM_EPS);
        { unsigned w[4]; float o8[8];
#pragma unroll
          for (int i = 0; i < 8; ++i) { const float mine = r8[i] * rs * gqr[i]; const float oth = __shfl_xor(mine, 2);
              float cs, sn; rope_cs_inv(row_pos(m), rinv[i], cs, sn);
              o8[i] = qt < 2 ? mine * cs - oth * sn : mine * cs + oth * sn; }
#pragma unroll
          for (int i = 0; i < 4; ++i) w[i] = pk2bf(o8[2 * i] * QSC, o8[2 * i + 1] * QSC);
          *(pg8::u32x4*)(qo + NOPE + 8 * qt) = (pg8::u32x4){w[0], w[1], w[2], w[3]};
          if (m >= MP) *(pg8::u32x4*)(fm.qs + ((size_t)(((m - MP) >> 3) * MH + hd) * 6 + 4 + (qt >> 1)) * 128 + (qt & 1) * 64 + ((m - MP) & 7) * 8) = (pg8::u32x4){w[0], w[1], w[2], w[3]}; }
        const bf16_t* kr = fm.kvraw + (size_t)m * 2048 + hd * NOPE; s = 0.f;
        { const pg8::u32x4 a = *(const pg8::u32x4*)(kr + 16 * qt), b = *(const pg8::u32x4*)(kr + 16 * qt + 8); const unsigned w[8] = {a.x, a.y, a.z, a.w, b.x, b.y, b.z, b.w};
#pragma unroll
          for (int i = 0; i < 8; ++i) { v[2 * i] = __uint_as_float(w[i] << 16); v[2 * i + 1] = __uint_as_float(w[i] & 0xffff0000u); } }
#pragma unroll
        for (int i = 0; i < 16; ++i) s += v[i] * v[i];
        s += __shfl_xor(s, 1); s += __shfl_xor(s, 2);
        rs = 1.0f / sqrtf(s * (1.0f / NOPE) + NORM_EPS);
        bf16_t* ko = fm.knb + (size_t)m * (MH * NOPE) + hd * NOPE;
        { unsigned w[8];
#pragma unroll
          for (int i = 0; i < 8; ++i) { const float a = v[2 * i] * rs * gkn[2 * i], b = v[2 * i + 1] * rs * gkn[2 * i + 1];
              w[i] = pk2bf(a, b); }
          *(pg8::u32x4*)(ko + 16 * qt) = (pg8::u32x4){w[0], w[1], w[2], w[3]}; *(pg8::u32x4*)(ko + 16 * qt + 8) = (pg8::u32x4){w[4], w[5], w[6], w[7]}; }
    }
}
__device__ __forceinline__ void cvt_f32_bf16(const float* __restrict__ s, bf16_t* d, size_t n, size_t gtid, size_t gsz) {
    for (size_t i = gtid * 4; i < n; i += gsz * 4) { const pg8::f32x4 v = *(const pg8::f32x4*)(s + i); pg8::u32x2 o; o.x = pk2bf(v[0], v[1]); o.y = pk2bf(v[2], v[3]); *(pg8::u32x2*)(d + i) = o; }
}
typedef float f32x16_t __attribute__((ext_vector_type(16)));
typedef pg8::bf16x8 bf16x8v;
constexpr int AT_KROW = 208, AT_VROW = 136, AT_KBUF = 64 * AT_KROW, AT_VBUF = 64 * AT_VROW, AT_LDS = 2 * AT_KBUF + 2 * AT_VBUF;
__device__ __forceinline__ void attn_prompt_fast(const bf16_t* __restrict__ qf, const bf16_t* __restrict__ knb, const bf16_t* __restrict__ kpb, const bf16_t* __restrict__ vT, bf16_t* aob, LDSP unsigned char* lds) {
    using namespace cfg;
    const int tid = (int)tid_now(), w = __builtin_amdgcn_readfirstlane(tid >> 6), lane = tid & 63, l31 = lane & 31, h5 = lane >> 5;
    for (int it = blockIdx.x; it < BATCH * MH * 4; it += gridDim.x) {
        const int bh = it >> 2, pr = it & 3, b = bh / MH, h = bh % MH;
        for (int half = 0; half < 2; ++half) {
            const int qb = half ? 7 - pr : pr, q0 = 256 * qb, nt = 4 * qb + 4;
            const int qg = q0 + 32 * w + l31;
            const size_t mrow = (size_t)b * SEQ + qg;
            bf16x8v qfr[6];
#pragma unroll
            for (int s = 0; s < 6; ++s) qfr[s] = *(const bf16x8v*)(qf + mrow * (MH * QD) + h * QD + 16 * s + 8 * h5);
            f32x16_t O[2];
#pragma unroll
            for (int db = 0; db < 2; ++db)
#pragma unroll
                for (int r = 0; r < 16; ++r) O[db][r] = 0.f;
            float mrun = -1e30f, lrun = 0.f;
            pg8::u32x4 rk, rp, rv;
            const int kkey = tid >> 3, kc8 = tid & 7, pkey = tid >> 2, pc4 = tid & 3;
#define AT_LOAD(t) do { const size_t mk = (size_t)b * SEQ + 64 * (t); \
                rk = *(const pg8::u32x4*)(knb + (mk + kkey) * (MH * NOPE) + h * NOPE + kc8 * 8); \
                if (tid < 256) rp = *(const pg8::u32x4*)(kpb + (mk + pkey) * ROPE + pc4 * 8); \
                rv = *(const pg8::u32x4*)(vT + (size_t)(h * VD + kkey) * MTOT + mk + kc8 * 8); } while (0)
#define AT_STORE(buf) do { LDSP unsigned char* kb_ = lds + (buf) * AT_KBUF; LDSP unsigned char* vb_ = lds + 2 * AT_KBUF + (buf) * AT_VBUF; \
                *(LDSP pg8::u32x4*)(kb_ + kkey * AT_KROW + kc8 * 16) = rk; \
                if (tid < 256) *(LDSP pg8::u32x4*)(kb_ + pkey * AT_KROW + 128 + pc4 * 16) = rp; \
                *(LDSP pg8::u32x2*)(vb_ + kkey * AT_VROW + kc8 * 16) = (pg8::u32x2){rv.x, rv.y}; *(LDSP pg8::u32x2*)(vb_ + kkey * AT_VROW + kc8 * 16 + 8) = (pg8::u32x2){rv.z, rv.w}; } while (0)
            AT_LOAD(0); AT_STORE(0);
            __syncthreads();
            for (int t = 0; t < nt; ++t) {
                if (t + 1 < nt) AT_LOAD(t + 1);
                if (64 * t <= q0 + 32 * w + 31) {
                    const LDSP unsigned char* kb_ = lds + (t & 1) * AT_KBUF; const LDSP unsigned char* vb_ = lds + 2 * AT_KBUF + (t & 1) * AT_VBUF;
                    f32x16_t S[2];
#pragma unroll
                    for (int kb = 0; kb < 2; ++kb)
#pragma unroll
                        for (int r = 0; r < 16; ++r) S[kb][r] = 0.f;
#pragma unroll
                    for (int s = 0; s < 6; ++s)
#pragma unroll
                        for (int kb = 0; kb < 2; ++kb) {
                            const bf16x8v a = *(const LDSP bf16x8v*)(kb_ + (32 * kb + l31) * AT_KROW + (16 * s + 8 * h5) * 2);
                            S[kb] = __builtin_amdgcn_mfma_f32_32x32x16_bf16(a, qfr[s], S[kb], 0, 0, 0);
                        }
                    if (64 * t + 63 > q0 + 32 * w) {
#pragma unroll
                        for (int kb = 0; kb < 2; ++kb)
#pragma unroll
                            for (int r = 0; r < 16; ++r) { const int key = 64 * t + 32 * kb + (r & 3) + 8 * (r >> 2) + 4 * h5; if (key > qg) S[kb][r] = -1e30f; }
                    }
                    float mt = -1e30f;
#pragma unroll
                    for (int kb = 0; kb < 2; ++kb)
#pragma unroll
                        for (int r = 0; r < 16; ++r) mt = fmaxf(mt, S[kb][r]);
                    mt = fmaxf(mt, __shfl_xor(mt, 32));
                    const float mnew = fmaxf(mrun, mt), alpha = __builtin_amdgcn_exp2f(mrun - mnew);
                    float ls = 0.f;
#pragma unroll
                    for (int kb = 0; kb < 2; ++kb)
#pragma unroll
                        for (int r = 0; r < 16; ++r) { const float p = __builtin_amdgcn_exp2f(S[kb][r] - mnew); S[kb][r] = p; ls += p; }
                    lrun = lrun * alpha + ls; mrun = mnew;
#pragma unroll
                    for (int db = 0; db < 2; ++db)
#pragma unroll
                        for (int r = 0; r < 16; ++r) O[db][r] *= alpha;
#pragma unroll
                    for (int kb = 0; kb < 2; ++kb)
#pragma unroll
                        for (int s = 0; s < 2; ++s) {
                            pg8::u32x4 pw; pw.x = pk2bf(S[kb][8 * s + 0], S[kb][8 * s + 1]); pw.y = pk2bf(S[kb][8 * s + 2], S[kb][8 * s + 3]); pw.z = pk2bf(S[kb][8 * s + 4], S[kb][8 * s + 5]); pw.w = pk2bf(S[kb][8 * s + 6], S[kb][8 * s + 7]);
                            const bf16x8v pf = __builtin_bit_cast(bf16x8v, pw);
#pragma unroll
                            for (int db = 0; db < 2; ++db) {
                                const LDSP unsigned char* vp = vb_ + (32 * db + l31) * AT_VROW + (32 * kb + 16 * s + 4 * h5) * 2;
                                const pg8::u32x2 v0 = *(const LDSP pg8::u32x2*)vp, v1 = *(const LDSP pg8::u32x2*)(vp + 16);
                                const bf16x8v a = __builtin_bit_cast(bf16x8v, (pg8::u32x4){v0.x, v0.y, v1.x, v1.y});
                                O[db] = __builtin_amdgcn_mfma_f32_32x32x16_bf16(a, pf, O[db], 0, 0, 0);
                            }
                        }
                }
                if (t + 1 < nt) AT_STORE((t + 1) & 1);
                __syncthreads();
            }
#undef AT_LOAD
#undef AT_STORE
            const float inv = 1.0f / (lrun + __shfl_xor(lrun, 32));
            bf16_t* orow = aob + mrow * (MH * VD) + h * VD;
#pragma unroll
            for (int db = 0; db < 2; ++db)
#pragma unroll
                for (int g = 0; g < 4; ++g) { pg8::u32x2 o; o.x = pk2bf(O[db][4 * g] * inv, O[db][4 * g + 1] * inv); o.y = pk2bf(O[db][4 * g + 2] * inv, O[db][4 * g + 3] * inv);
                    *(pg8::u32x2*)(orow + 32 * db + 8 * g + 4 * h5) = o; }
        }
    }
}
constexpr int SD_CROW = 528, SD_WROW = 528, SD_PROW = 272;
constexpr int SD_CIMG = 0, SD_CIMG_SZ = 128 * SD_CROW;
constexpr int SD_WBUF = SD_CIMG + SD_CIMG_SZ, SD_WBUF_SZ = 32 * 1040;
constexpr int SD_XCH = SD_WBUF + 2 * SD_WBUF_SZ, SD_XCH_SZ = 4 * 5 * 64 * 4;
constexpr int SD_PIMG = SD_XCH + 2 * SD_XCH_SZ, SD_PIMG_SZ = 32 * SD_PROW;
constexpr int SD_END = SD_PIMG + 2 * SD_PIMG_SZ;
typedef short s16x4 __attribute__((ext_vector_type(4)));
#define MFMA32(a, b, c) __builtin_amdgcn_mfma_f32_32x32x16_bf16(a, b, c, 0, 0, 0)

__device__ __forceinline__ float mla_b2_bound(const Ctx& c, int j, int lane) {
    using namespace cfg;
    float gq = fabsf(c.in[I_QNN][j * NOPE + lane]), gk = fabsf(c.in[I_KNN][j * NOPE + lane]), gqr = fabsf(c.in[I_QRN][j * ROPE + (lane & 31)]), gkr = fabsf(c.in[I_KRN][j * ROPE + (lane & 31)]);
#pragma unroll
    for (int o = 1; o < 64; o <<= 1) { gq = fmaxf(gq, __shfl_xor(gq, o)); gk = fmaxf(gk, __shfl_xor(gk, o)); gqr = fmaxf(gqr, __shfl_xor(gqr, o)); gkr = fmaxf(gkr, __shfl_xor(gkr, o)); }
    return (64.f * gq * gk + 32.f * gqr * gkr) * (0.10206207261596575f * 1.4426950408889634f);
}

__device__ __forceinline__ void sd_pv_core(const int G, f32x16_t& Og, f32x16_t& Lacc, LDSP unsigned char* lds, int w, int lane, int l31, int h5) {
    asm volatile("" : "+v"(lane)); l31 = lane & 31; h5 = lane >> 5;
    const LDSP unsigned char* pimg = lds + SD_PIMG + (G & 1) * SD_PIMG_SZ;
    const unsigned onesw = (l31 == G) ? 0x3F803F80u : 0u;
    const bf16x8v onesv = __builtin_bit_cast(bf16x8v, (pg8::u32x4){onesw, onesw, onesw, onesw});
#pragma unroll
    for (int sp = 0; sp < 8; ++sp) {
        const bf16x8v a = *(const LDSP bf16x8v*)(pimg + l31 * SD_PROW + (16 * sp + 8 * h5) * 2);
        const int key0 = 16 * sp + 8 * h5 + ((lane & 15) >> 2), col = 32 * w + 16 * ((lane >> 4) & 1) + 4 * (lane & 3);
        const s16x4 t0 = __builtin_amdgcn_ds_read_tr16_b64_v4i16((LDSP s16x4*)(lds + SD_CIMG + key0 * SD_CROW + col * 2));
        const s16x4 t1 = __builtin_amdgcn_ds_read_tr16_b64_v4i16((LDSP s16x4*)(lds + SD_CIMG + (key0 + 4) * SD_CROW + col * 2));
        const bf16x8v b = (bf16x8v){t0[0], t0[1], t0[2], t0[3], t1[0], t1[1], t1[2], t1[3]};
        Og = MFMA32(a, b, Og);
        if (sp == w) Lacc = MFMA32(a, onesv, Lacc);
        if (sp & 1) __builtin_amdgcn_sched_barrier(0);
    }
}

__device__ __forceinline__ void sd_pv(const int G, f32x16_t& Og, f32x16_t& Lacc, LDSP unsigned char* lds, int w, int lane, int l31, int h5) {
    sd_pv_core(G, Og, Lacc, lds, w, lane, l31, h5);
#if defined(PROBE_DUP) && (PROBE_DUP & (1 << 21))
    f32x16_t D0, D1;
#pragma unroll
    for (int r = 0; r < 16; ++r) { D0[r] = 0.f; D1[r] = 0.f; }
    sd_pv_core(G, D0, D1, lds, w, lane, l31, h5); asm volatile("" :: "v"(D0), "v"(D1));
#endif
}
__device__ __forceinline__ void sd_glds16(const void* gsrc, unsigned lds_dst) {
    unsigned keep;
    asm volatile("s_mov_b32 %0, m0\n\ts_mov_b32 m0, %2\n\ts_nop 0\n\tglobal_load_lds_dwordx4 %1, off\n\ts_mov_b32 m0, %0" : "=&s"(keep) : "v"(gsrc), "s"(lds_dst) : "memory");
}
#define SD_WLOAD(h, buf) do { if (w >= 4) { const char* wsrc_ = (const char*)(fm.wukvt + (size_t)(h) * NOPE * KVL); int ln_ = lane; asm volatile("" : "+v"(ln_)); \
        const unsigned ldsb_ = __builtin_amdgcn_readfirstlane((unsigned)(size_t)(lds + SD_WBUF + (buf) * SD_WBUF_SZ)) + (unsigned)(8 * (w - 4)) * 1040u; \
        _Pragma("unroll") for (int k = 0; k < 8; ++k) { \
        const unsigned voff_ = (unsigned)(((8 * (w - 4) + k) + 32 * (ln_ >> 5)) * KVL + (ln_ & 31) * 8) * 2u; \
        sd_glds16(wsrc_ + voff_, ldsb_ + (unsigned)k * 1040u); } } } while (0)
template <int G, bool DOPV = true>
__device__ __forceinline__ void sd_group(const FastMla& fm, const bf16_t* __restrict__ qs, const int s, LDSP unsigned char* lds, const int w, const int lane, const int l31_, const int h5_, const int kb, const int dh, const int rot,
                                         const bf16x8v (&cfr)[16], const bf16x8v (&kpfr)[2], pg8::u32x4 (&wr)[4], f32x16_t (&O)[4], f32x16_t& Lacc, const float B2) {
    using namespace cfg;
        _Pragma("unroll 1") for (int hh = 0; hh < 4; ++hh) {
            const int h = (4 * G + hh + rot) & (MH - 1);
            int lane_ = lane; asm volatile("" : "+v"(lane_)); const int l31 = lane_ & 31, h5 = lane_ >> 5;
            { LDSP unsigned char* wdst = lds + SD_WBUF + ((h + 1) & 1) * SD_WBUF_SZ + (2 * w + h5) * 1040 + l31 * 16;
              *(LDSP pg8::u32x4*)(wdst) = wr[0]; *(LDSP pg8::u32x4*)(wdst + 16640) = wr[1]; *(LDSP pg8::u32x4*)(wdst + 512) = wr[2]; *(LDSP pg8::u32x4*)(wdst + 17152) = wr[3]; }
            const char* qb = (const char*)qs + (size_t)(s * MH + h) * 1536;
            const unsigned zoff = (unsigned)((DB * MH - (s * MH + h)) * 1536);
            const unsigned qlo = l31 < 8 ? (unsigned)(h5 * 128 + l31 * 16) : zoff;
            bf16x8v qn0 = (bf16x8v){0, 0, 0, 0, 0, 0, 0, 0}, qn1 = qn0, qp0 = qn0, qp1 = qn0;
            if (l31 < 8) {
                qn0 = *(const bf16x8v*)(qb + dh * 512 + qlo); qn1 = *(const bf16x8v*)(qb + dh * 512 + 256 + qlo);
                if (dh == 0) { qp0 = *(const bf16x8v*)(qb + 1024 + qlo); qp1 = *(const bf16x8v*)(qb + 1280 + qlo); } }
            { const char* wsrc = (const char*)(fm.wukvt + (size_t)((h + 2) & (MH - 1)) * NOPE * KVL) + (unsigned)(64 * w + lane_) * 16u;
#pragma unroll
              for (int k = 0; k < 4; ++k) wr[k] = *(const pg8::u32x4*)(wsrc + k * 8192); }
            f32x16_t KN;
#pragma unroll
            for (int r = 0; r < 16; ++r) KN[r] = 0.f;
            { const LDSP unsigned char* wb = lds + SD_WBUF + (h & 1) * SD_WBUF_SZ + l31 * 1040 + dh * 512 + h5 * 16;
#pragma unroll
              for (int s_ = 0; s_ < 16; ++s_) { const bf16x8v a = *(const LDSP bf16x8v*)(wb + 32 * s_); KN = MFMA32(a, cfr[s_], KN); if ((s_ & 3) == 3) __builtin_amdgcn_sched_barrier(0); } }
#if defined(PROBE_DUP) && (PROBE_DUP & (1 << 19))
            { const LDSP unsigned char* wb = lds + SD_WBUF + (h & 1) * SD_WBUF_SZ + l31 * 1040 + dh * 512 + h5 * 16;
#pragma unroll
              for (int s_ = 0; s_ < 16; ++s_) { const bf16x8v a = *(const LDSP bf16x8v*)(wb + 32 * s_); KN = MFMA32(a, cfr[s_], KN); if ((s_ & 3) == 3) __builtin_amdgcn_sched_barrier(0); }
#pragma unroll
              for (int r = 0; r < 16; ++r) KN[r] *= 0.5f; }
#endif
#if defined(PROBE_DUP) && (PROBE_DUP & (1 << 23))
            _Pragma("unroll 1") for (int rep_ = 0; rep_ < 2; ++rep_) {
            asm volatile("" : "+v"(KN));
#else
            {
#endif
            float ssq = 0.f;
#pragma unroll
            for (int r = 0; r < 16; ++r) ssq += KN[r] * KN[r];
            ssq += __shfl_xor(ssq, 32);
            {
            f32x16_t S;
#pragma unroll
            for (int r = 0; r < 16; ++r) S[r] = 0.f;
#pragma unroll
            for (int s_ = 0; s_ < 2; ++s_) { const bf16x8v kf = __builtin_bit_cast(bf16x8v, (pg8::u32x4){pk2bf(KN[8 * s_], KN[8 * s_ + 1]), pk2bf(KN[8 * s_ + 2], KN[8 * s_ + 3]), pk2bf(KN[8 * s_ + 4], KN[8 * s_ + 5]), pk2bf(KN[8 * s_ + 6], KN[8 * s_ + 7])});
                S = MFMA32(s_ == 0 ? qn0 : qn1, kf, S); }
            LDSP float* xch = (LDSP float*)(lds + SD_XCH + (h & 1) * SD_XCH_SZ) + kb * 320;
            if (dh == 1) { xch[lane_] = S[0]; xch[64 + lane_] = S[1]; xch[128 + lane_] = S[2]; xch[192 + lane_] = S[3]; xch[256 + lane_] = ssq; }
            asm volatile("s_waitcnt lgkmcnt(0)" ::: "memory");
            __builtin_amdgcn_s_barrier();
            asm volatile("" ::: "memory");
            if (dh == 0) {
                const float rstd = __builtin_amdgcn_rsqf((ssq + xch[256 + lane_]) * (1.0f / NOPE) + NORM_EPS);
                f32x16_t T;
#pragma unroll
                for (int r = 0; r < 16; ++r) T[r] = 0.f;
                T[0] = (S[0] + xch[lane_]) * rstd; T[1] = (S[1] + xch[64 + lane_]) * rstd; T[2] = (S[2] + xch[128 + lane_]) * rstd; T[3] = (S[3] + xch[192 + lane_]) * rstd;
                T = MFMA32(qp0, kpfr[0], T); T = MFMA32(qp1, kpfr[1], T);
                LDSP bf16_t* prow = (LDSP bf16_t*)(lds + SD_PIMG + (G & 1) * SD_PIMG_SZ + (hh * 8 + 4 * h5) * SD_PROW) + 32 * kb + l31;
#pragma unroll
                for (int q = 0; q < 4; ++q) prow[q * (SD_PROW / 2)] = (bf16_t)(pk2bf(exp2f(T[q] - B2), 0.f) & 0xffffu);
            }
            }
            }
        }
        if (G > 0 && DOPV) sd_pv(G > 0 ? G - 1 : 0, O[G > 0 ? G - 1 : 0], Lacc, lds, w, lane, l31_, h5_);
}

__device__ __forceinline__ void mla_sample_decode(const Ctx& c, const FastMla& fm, const bf16_t* __restrict__ qs, float* opart, float* lpart, int j, LDSP unsigned char* lds) {
    using namespace cfg;
    const int tid = (int)tid_now(), tid_ = tid, w = __builtin_amdgcn_readfirstlane(tid >> 6), lane = tid & 63, l31 = lane & 31, h5 = lane >> 5, kb = w & 3, dh = w >> 2;
    const float* ckv = c.in[I_CKV] + (size_t)j * NPOOL * PAGE * KVL; const float* kpe = c.in[I_KPE] + (size_t)j * NPOOL * PAGE * ROPE;
    const float B2 = __builtin_bit_cast(float, __builtin_amdgcn_readfirstlane(__builtin_bit_cast(int, mla_b2_bound(c, j, lane))));
    for (int it = blockIdx.x; it < DB * 2; it += gridDim.x) {
        const int s = it >> 1, hf = it & 1, rot = 2 * ((blockIdx.x >> 3) & 7);
        f32x16_t O[4], Lacc;
#pragma unroll
        for (int r = 0; r < 16; ++r) { O[0][r] = 0.f; O[1][r] = 0.f; O[2][r] = 0.f; O[3][r] = 0.f; Lacc[r] = 0.f; }
        pg8::u32x4 wr[4];
        __syncthreads();
        {
            int t_ = tid_; asm volatile("" : "+v"(t_));
            const char* wsrc = (const char*)(fm.wukvt + (size_t)rot * NOPE * KVL); const unsigned vo = (unsigned)t_ * 16u; LDSP unsigned char* wdst = lds + SD_WBUF + (t_ >> 5) * 1040 + (t_ & 31) * 16;
            pg8::u32x4 t0 = *(const pg8::u32x4*)(wsrc + vo), t1 = *(const pg8::u32x4*)(wsrc + 8192 + vo), t2 = *(const pg8::u32x4*)(wsrc + 16384 + vo), t3 = *(const pg8::u32x4*)(wsrc + 24576 + vo);
            *(LDSP pg8::u32x4*)(wdst) = t0; *(LDSP pg8::u32x4*)(wdst + 16640) = t1; *(LDSP pg8::u32x4*)(wdst + 512) = t2; *(LDSP pg8::u32x4*)(wdst + 17152) = t3;
#pragma unroll
            for (int k = 0; k < 4; ++k) wr[k] = *(const pg8::u32x4*)(wsrc + NOPE * KVL * 2 + k * 8192 + vo);
        }
        for (int pi = 0; pi < NPAGES / 2; ++pi) {
            const int pg = __builtin_amdgcn_readfirstlane(c.page_table[s * NPAGES + hf * (NPAGES / 2) + pi]);
            __syncthreads();
            { const char* src = (const char*)(ckv + (size_t)pg * PAGE * KVL); int tid = tid_; asm volatile("" : "+v"(tid));
              pg8::f32x4 v[16];
#pragma unroll
              for (int k = 0; k < 16; ++k) v[k] = __builtin_nontemporal_load((const pg8::f32x4*)(src + (size_t)k * 8192 + (unsigned)tid * 16u));
#pragma unroll
              for (int k = 0; k < 16; ++k) { pg8::u32x2 o; o.x = pk2bf(v[k][0], v[k][1]); o.y = pk2bf(v[k][2], v[k][3]);
                  *(LDSP pg8::u32x2*)(lds + SD_CIMG + ((tid >> 6) + 8 * k) * SD_CROW + (tid & 63) * 8) = o; } }
#if defined(PROBE_DUP) && (PROBE_DUP & (1 << 20))
            { const char* src = (const char*)(ckv + (size_t)pg * PAGE * KVL); int tid = tid_; asm volatile("" : "+v"(tid));
              pg8::f32x4 v[16];
#pragma unroll
              for (int k = 0; k < 16; ++k) v[k] = *(const pg8::f32x4*)(src + (size_t)k * 8192 + (unsigned)tid * 16u);
#pragma unroll
              for (int k = 0; k < 16; ++k) { pg8::u32x2 o; o.x = pk2bf(v[k][0], v[k][1]); o.y = pk2bf(v[k][2], v[k][3]);
                  *(LDSP pg8::u32x2*)(lds + SD_CIMG + ((tid >> 6) + 8 * k) * SD_CROW + (tid & 63) * 8) = o; } }
#endif
            bf16x8v kpfr[2];
            if (dh == 0) {
#pragma unroll
                for (int s_ = 0; s_ < 2; ++s_) { const float* kp = kpe + ((size_t)pg * PAGE + 32 * kb + l31) * ROPE + 16 * s_ + 8 * h5; const pg8::f32x4 a = *(const pg8::f32x4*)kp, b = *(const pg8::f32x4*)(kp + 4);
                    kpfr[s_] = __builtin_bit_cast(bf16x8v, (pg8::u32x4){pk2bf(a[0], a[1]), pk2bf(a[2], a[3]), pk2bf(b[0], b[1]), pk2bf(b[2], b[3])}); }
            }
            asm volatile("s_waitcnt vmcnt(0)" ::: "memory");
            __syncthreads();
            bf16x8v cfr[16];
#pragma unroll
            for (int s_ = 0; s_ < 16; ++s_) cfr[s_] = *(const LDSP bf16x8v*)(lds + SD_CIMG + (32 * kb + l31) * SD_CROW + (16 * s_ + 8 * h5) * 2);
            sd_group<0>(fm, qs, s, lds, w, lane, l31, h5, kb, dh, rot, cfr, kpfr, wr, O, Lacc, B2);
            sd_group<1>(fm, qs, s, lds, w, lane, l31, h5, kb, dh, rot, cfr, kpfr, wr, O, Lacc, B2);
            sd_group<2>(fm, qs, s, lds, w, lane, l31, h5, kb, dh, rot, cfr, kpfr, wr, O, Lacc, B2);
            sd_group<3>(fm, qs, s, lds, w, lane, l31, h5, kb, dh, rot, cfr, kpfr, wr, O, Lacc, B2);
#if defined(PROBE_DUP) && (PROBE_DUP & (1 << 29))
            __syncthreads();
            sd_group<0, false>(fm, qs, s, lds, w, lane, l31, h5, kb, dh, rot, cfr, kpfr, wr, O, Lacc, B2);
            sd_group<1, false>(fm, qs, s, lds, w, lane, l31, h5, kb, dh, rot, cfr, kpfr, wr, O, Lacc, B2);
            sd_group<2, false>(fm, qs, s, lds, w, lane, l31, h5, kb, dh, rot, cfr, kpfr, wr, O, Lacc, B2);
            sd_group<3, false>(fm, qs, s, lds, w, lane, l31, h5, kb, dh, rot, cfr, kpfr, wr, O, Lacc, B2);
#endif
            __syncthreads();
            sd_pv(3, O[3], Lacc, lds, w, lane, l31, h5);
        }
        {float* op = opart + (size_t)it * (MH * DS) * KVL; int lo_ = lane; asm volatile("" : "+v"(lo_)); const int l31 = lo_ & 31, h5 = lo_ >> 5;
#pragma unroll
        for (int g = 0; g < 4; ++g)
#pragma unroll
            for (int r = 0; r < 16; ++r) op[(size_t)((((4 * g + (r >> 2) + rot) & (MH - 1)) << 3) + (r & 3) + 4 * h5) * KVL + 32 * w + l31] = O[g][r];
        __syncthreads();
        LDSP float* ltab = (LDSP float*)(lds + SD_XCH);
        if (l31 < 4) {
#pragma unroll
            for (int r = 0; r < 16; ++r) ltab[w * 128 + l31 * 32 + (r & 3) + 8 * (r >> 2) + 4 * h5] = Lacc[r];
        }
        __syncthreads();
        { const int t2 = (int)tid_now();
        if (t2 < 128) { float a = 0.f;
#pragma unroll
            for (int ww = 0; ww < 8; ++ww) a += ltab[ww * 128 + t2];
            lpart[(size_t)it * 128 + ((((t2 >> 3) + rot) & (MH - 1)) << 3) + (t2 & 7)] = a; } }
        }
    }
}

__device__ __forceinline__ void mla_sample_combine(const Ctx& c, const FastMla& fm, const float* __restrict__ opart, const float* __restrict__ lpart, int j, LDSP unsigned char* lds) {
    using namespace cfg;
    const int tid = (int)tid_now(), w = tid >> 6, lane = tid & 63, gw = blockIdx.x * 8 + w, ngw = gridDim.x * 8;
    const float B2 = mla_b2_bound(c, j, lane);
    LDSP float* ol = (LDSP float*)(lds + w * 8704); LDSP float* ptab = ol + 8 * KVL; LDSP float* lt = ptab + 64;
    const float* wuv = c.in[I_WUV] + (size_t)j * KVL * MH * VD;
    for (int item = gw; item < DB * MH; item += ngw) {
        const int s = item / MH, h = item % MH, q = lane >> 3, jn = lane & 7;
        const size_t rq = (size_t)MP + s * DS + q, rk = (size_t)MP + s * DS + jn;
        const bf16_t* qv = fm.qf + rq * (MH * QD) + h * QD; const bf16_t* kn = fm.knb + rk * (MH * NOPE) + h * NOPE; const bf16_t* kp = fm.kpb + rk * ROPE;
        const float* wp = wuv + (size_t)h * VD + lane;
        float wa[16];
#pragma unroll
        for (int i = 0; i < 16; ++i) wa[i] = wp[(size_t)i * (MH * VD)];
        float cn[DS][4];
#pragma unroll
        for (int jj = 0; jj < DS; ++jj)
#pragma unroll
            for (int k = 0; k < 4; ++k) cn[jj][k] = bf2f(fm.cb[((size_t)MP + s * DS + jj) * KVL + lane + 64 * k]);
        float sc = 0.f;
#pragma unroll
        for (int d8 = 0; d8 < QD / 8; ++d8) { const pg8::u32x4 a = *(const pg8::u32x4*)(qv + 8 * d8), b = d8 < NOPE / 8 ? *(const pg8::u32x4*)(kn + 8 * d8) : *(const pg8::u32x4*)(kp + 8 * (d8 - NOPE / 8));
            const unsigned aw[4] = {a.x, a.y, a.z, a.w}, bw[4] = {b.x, b.y, b.z, b.w};
#pragma unroll
            for (int e = 0; e < 4; ++e) sc += __uint_as_float(aw[e] << 16) * __uint_as_float(bw[e] << 16) + __uint_as_float(aw[e] & 0xffff0000u) * __uint_as_float(bw[e] & 0xffff0000u); }
        const float p = jn <= q ? exp2f(sc - B2) : 0.f;
        float ls = p; ls += __shfl_xor(ls, 1); ls += __shfl_xor(ls, 2); ls += __shfl_xor(ls, 4);
        ptab[lane] = p;
        if (jn == 0) lt[q] = ls + lpart[(size_t)(2 * s) * 128 + h * DS + q] + lpart[(size_t)(2 * s + 1) * 128 + h * DS + q];
        asm volatile("s_waitcnt lgkmcnt(0)" ::: "memory");
#pragma unroll
        for (int qq = 0; qq < DS; ++qq)
#pragma unroll
            for (int k = 0; k < 4; ++k) { const int r = lane + 64 * k;
                float a = opart[((size_t)(2 * s) * 128 + h * DS + qq) * KVL + r] + opart[((size_t)(2 * s + 1) * 128 + h * DS + qq) * KVL + r];
#pragma unroll
                for (int jj = 0; jj < DS; ++jj) a += ptab[qq * 8 + jj] * cn[jj][k];
                ol[qq * KVL + r] = a; }
        asm volatile("s_waitcnt lgkmcnt(0)" ::: "memory");
        float acc[DS];
#pragma unroll
        for (int qq = 0; qq < DS; ++qq) acc[qq] = 0.f;
        float wb[16];
        for (int r0 = 0; r0 < KVL; r0 += 32) {
#pragma unroll
            for (int i = 0; i < 16; ++i) wb[i] = wp[(size_t)(r0 + 16 + i) * (MH * VD)];
#pragma unroll
            for (int i4 = 0; i4 < 4; ++i4)
#pragma unroll
                for (int qq = 0; qq < DS; ++qq) { const pg8::f32x4 o4 = *(const LDSP pg8::f32x4*)(ol + qq * KVL + r0 + 4 * i4);
                    acc[qq] += o4[0] * wa[4 * i4] + o4[1] * wa[4 * i4 + 1] + o4[2] * wa[4 * i4 + 2] + o4[3] * wa[4 * i4 + 3]; }
            if (r0 + 32 < KVL) {
#pragma unroll
                for (int i = 0; i < 16; ++i) wa[i] = wp[(size_t)(r0 + 32 + i) * (MH * VD)]; }
#pragma unroll
            for (int i4 = 0; i4 < 4; ++i4)
#pragma unroll
                for (int qq = 0; qq < DS; ++qq) { const pg8::f32x4 o4 = *(const LDSP pg8::f32x4*)(ol + qq * KVL + r0 + 16 + 4 * i4);
                    acc[qq] += o4[0] * wb[4 * i4] + o4[1] * wb[4 * i4 + 1] + o4[2] * wb[4 * i4 + 2] + o4[3] * wb[4 * i4 + 3]; }
        }
#pragma unroll
        for (int qq = 0; qq < DS; ++qq) fm.aob[((size_t)MP + s * DS + qq) * (MH * VD) + h * VD + lane] = (bf16_t)(pk2bf(acc[qq] / lt[qq], 0.f) & 0xffffu);
        asm volatile("s_waitcnt lgkmcnt(0)" ::: "memory");
    }
}

struct FastRw {
    bf16_t* xm;
    bf16_t* rkv;
    bf16_t* hb;
    bf16_t* lu;
    float* vf;
    float* ops;
    bf16_t* yo;
    bf16_t *wrkvt, *lorat, *wot;
};
constexpr int RW_REC = 464;
constexpr int RW_CH = 32;
constexpr int RW_BUF = RW_CH * RW_REC * 4;
struct RwSel { __device__ static __forceinline__ int sel(int pn) { return pn < 12 ? (pn >> 2) : (pn == 15 ? 2 : pn - 9); } };

__device__ __forceinline__ void rw_mix_fast(const Ctx& c, const FastRw& fr, int l, int gw, int ngw, int lane, const float* xprompt = nullptr) {
    using namespace cfg; const int j = l / 3;
    const float* gain = c.in[I_NMIX] + l * D;
    pg8::f32x4 gv[4], muv[6][4];
#pragma unroll
    for (int q = 0; q < 4; ++q) { gv[q] = *(const pg8::f32x4*)(gain + 4 * lane + 256 * q);
#pragma unroll
        for (int p = 0; p < 6; ++p) muv[p][q] = *(const pg8::f32x4*)(c.in[I_MU] + ((size_t)j * 6 + p) * D + 4 * lane + 256 * q); }
    for (int m = gw; m < MTOT; m += ngw) {
        const int t = row_t(m), sq = row_seq(m);
        const float* xsrc = (xprompt && m < MP) ? xprompt : c.x;
        pg8::f32x4 xc[4], xp[4]; float s = 0.f, sp = 0.f;
#pragma unroll
        for (int q = 0; q < 4; ++q) { xc[q] = *(const pg8::f32x4*)(xsrc + (size_t)m * D + 4 * lane + 256 * q);
            s += (xc[q][0] * xc[q][0] + xc[q][1] * xc[q][1]) + (xc[q][2] * xc[q][2] + xc[q][3] * xc[q][3]); }
        if (t > 0) {
#pragma unroll
            for (int q = 0; q < 4; ++q) { xp[q] = *(const pg8::f32x4*)(xsrc + (size_t)(m - 1) * D + 4 * lane + 256 * q); sp += (xp[q][0] * xp[q][0] + xp[q][1] * xp[q][1]) + (xp[q][2] * xp[q][2] + xp[q][3] * xp[q][3]); }
        }
        const float rs = 1.0f / sqrtf(wave_sum64(s) * (1.0f / D) + NORM_EPS), rsp = 1.0f / sqrtf(wave_sum64(sp) * (1.0f / D) + NORM_EPS);
#pragma unroll
        for (int q = 0; q < 4; ++q) {
#pragma unroll
            for (int e = 0; e < 4; ++e) xc[q][e] = xc[q][e] * rs * gv[q][e];
            if (t > 0) {
#pragma unroll
                for (int e = 0; e < 4; ++e) xp[q][e] = xp[q][e] * rsp * gv[q][e];
            } else if (sq < BATCH) xp[q] = (pg8::f32x4){0.f, 0.f, 0.f, 0.f};
            else xp[q] = *(const pg8::f32x4*)(c.in[I_SHIFT] + ((size_t)j * DB + (sq - BATCH)) * D + 4 * lane + 256 * q);
        }
        if (t == seq_len(sq) - 1) {
            float* so = sq < BATCH ? c.out + O_SHP + ((size_t)j * BATCH + sq) * D : c.out + O_SHS + ((size_t)j * DB + (sq - BATCH)) * D;
#pragma unroll
            for (int q = 0; q < 4; ++q) *(pg8::f32x4*)(so + 4 * lane + 256 * q) = xc[q];
        }
#pragma unroll
        for (int p = 0; p < 6; ++p)
#pragma unroll
            for (int q = 0; q < 4; ++q) { const pg8::f32x4 mu = muv[p][q];
                pg8::u32x2 o; o.x = pk2bf(xc[q][0] + (xp[q][0] - xc[q][0]) * mu[0], xc[q][1] + (xp[q][1] - xc[q][1]) * mu[1]); o.y = pk2bf(xc[q][2] + (xp[q][2] - xc[q][2]) * mu[2], xc[q][3] + (xp[q][3] - xc[q][3]) * mu[3]);
                *(pg8::u32x2*)(fr.xm + ((size_t)p * MTOT + m) * D + 4 * lane + 256 * q) = o; }
        if (lane < 32) *(unsigned*)(fr.hb + (size_t)m * 384 + 320 + 2 * lane) = 0u;
    }
}
struct EpiRwkv {
    static constexpr bool PERM = true;
    bf16_t* rkv; bf16_t* hb;
    __device__ __forceinline__ void operator()(const pg8::f32x4 (&acc)[2][2][4][2], const pg8::Unit& u, int wr, int wc, int fr, int fq) const {
        using namespace pg8;
        const int row0 = u.pm * BM + wr * 64 + fr, cl0 = wc * 32 + 8 * fq;
        const int pn = u.pn;
        bf16_t* base; int ldc, coff, nvalid, act = 0;
        if (pn < 12) { base = rkv; ldc = 3072; coff = pn * 256; nvalid = 256; }
        else { base = hb; ldc = 384; if (pn == 12) { coff = 0; nvalid = 64; act = 1; } else if (pn == 13) { coff = 64; nvalid = 64; } else if (pn == 14) { coff = 128; nvalid = 160; act = 2; } else { coff = 288; nvalid = 32; } }
#pragma unroll
        for (int ai = 0; ai < 2; ++ai)
#pragma unroll
            for (int m = 0; m < 4; ++m) { bf16_t* rowp = base + (size_t)(row0 + ai * HALF + m * 16) * ldc + coff;
#pragma unroll
                for (int bj = 0; bj < 2; ++bj) { const int cl = cl0 + bj * HALF; if (cl >= nvalid) continue;
                    f32x4 v0 = acc[ai][bj][m][0], v1 = acc[ai][bj][m][1];
                    if (act == 1) {
#pragma unroll
                        for (int e = 0; e < 4; ++e) { v0[e] = tanhf(v0[e]); v1[e] = tanhf(v1[e]); } }
                    else if (act == 2) {
#pragma unroll
                        for (int e = 0; e < 4; ++e) { v0[e] = 1.0f / (1.0f + __expf(-v0[e])); v1[e] = 1.0f / (1.0f + __expf(-v1[e])); } }
                    u32x4 w; w.x = cvt_pk_bf16(v0[0], v0[1]); w.y = cvt_pk_bf16(v0[2], v0[3]); w.z = cvt_pk_bf16(v1[0], v1[1]); w.w = cvt_pk_bf16(v1[2], v1[3]);
                    *(u32x4*)(rowp + cl) = w; } }
    }
};
__device__ __forceinline__ void rw_build_lorat(const Ctx& c, bf16_t* lorat, int j, size_t gtid, size_t gsz) {
    using namespace cfg;
    for (size_t i = gtid; i < (size_t)4096 * 384; i += gsz) {
        const int n = (int)(i / 384), k = (int)(i % 384), grp = n >> 10, ch = n & 1023; float v = 0.f;
        if (grp == 0 && k < 64) v = c.in[I_W2][((size_t)j * RW_DL + k) * D + ch];
        else if (grp == 1 && k >= 64 && k < 128) v = c.in[I_A2][((size_t)j * RW_AL + (k - 64)) * D + ch];
        else if (grp == 2 && k >= 128 && k < 288) v = c.in[I_G2][((size_t)j * RW_GL + (k - 128)) * D + ch];
        else if (grp == 3 && k >= 288 && k < 320 && j > 0) v = c.in[I_V2][((size_t)(j - 1) * RW_VL + (k - 288)) * D + ch];
        lorat[i] = (bf16_t)(pk2bf(v, 0.f) & 0xffffu);
    }
}
__device__ __forceinline__ size_t rw_rec_base(int sq, int h) {
    using namespace cfg;
    return sq < BATCH ? ((size_t)sq * RHEADS + h) * SEQ : (size_t)MP * RHEADS + ((size_t)(sq - BATCH) * RHEADS + h) * DS;
}
__device__ __forceinline__ void rw_prep_fast(const Ctx& c, const FastRw& fr, int l, int gw, int ngw, int lane) {
    using namespace cfg; const int j = l / 3;
    for (int it = gw; it < MTOT * RHEADS; it += ngw) {
        const int m = it / RHEADS, h = it % RHEADS, ch = h * RH + lane;
        const bf16_t* rk = fr.rkv + (size_t)m * 3072 + ch; const bf16_t* lu = fr.lu + (size_t)m * 4096 + ch;
        const float r = bf2f(rk[0]), k0 = bf2f(rk[1024]); float v = bf2f(rk[2048]);
        const float wpre = bf2f(lu[0]), apre = bf2f(lu[1024]), gg = bf2f(lu[2048]), vpre = bf2f(lu[3072]);
        const float wl = -softplusf_(-(c.in[I_W0][j * D + ch] + wpre)) - 0.5f;
        const float w = expf(-expf(wl));
        if (j == 0) fr.vf[(size_t)m * D + ch] = v;
        else v = v + (fr.vf[(size_t)m * D + ch] - v) * sigmoidf_(c.in[I_V0][(j - 1) * D + ch] + vpre);
        const float a = sigmoidf_(c.in[I_A0][j * D + ch] + apre);
        float kk = k0 * c.in[I_KK][j * D + ch];
        const float nn = wave_sum64(kk * kk);
        kk *= 1.0f / fmaxf(sqrtf(nn), 1e-12f);
        const float k2 = k0 * (1.0f + (a - 1.0f) * c.in[I_KA][j * D + ch]);
        const float bo = kk * a;
        const float br = wave_sum64(bo * r), kr = wave_sum64(k2 * r), bonus = wave_sum64(r * k2 * c.in[I_RK][(size_t)j * D + ch]);
        const int sq = row_seq(m), t = row_t(m);
        float* rec = fr.ops + (rw_rec_base(sq, h) + t) * RW_REC;
        rec[lane] = -kk; rec[64 + lane] = w * r; rec[128 + lane] = w; rec[192 + lane] = bo; rec[256 + lane] = k2; rec[320 + lane] = v; rec[384 + lane] = gg;
        if (lane == 0) { rec[448] = br; rec[449] = kr; rec[450] = bonus; }
    }
}
template <int CTRL> __device__ __forceinline__ float dppf(float v) { return __int_as_float(__builtin_amdgcn_update_dpp(0, __float_as_int(v), CTRL, 0xF, 0xF, true)); }
__device__ __forceinline__ float red16(float x) { x += dppf<0xB1>(x); x += dppf<0x4E>(x); x += dppf<0x124>(x); x += dppf<0x128>(x); return x; }
__device__ __forceinline__ void rw_scan_fast(const Ctx& c, const FastRw& fr, int l, LDSP unsigned char* lds) {
    using namespace cfg; const int j = l / 3;
    const int tid = (int)tid_now(), w = __builtin_amdgcn_readfirstlane(tid >> 6), lane = tid & 63, cs = lane & 15, rp = 4 * w + (lane >> 4);
    LDSP float* ybuf = (LDSP float*)(lds + 2 * RW_BUF);
    for (int chain = blockIdx.x; chain < NSEQ * RHEADS; chain += gridDim.x) {
        const int sq = chain / RHEADS, h = chain % RHEADS, T = seq_len(sq), m0 = seq_row0(sq);
        const char* src = (const char*)(fr.ops + rw_rec_base(sq, h) * RW_REC);
        pg8::f32x4 S0, S1;
        if (sq < BATCH) { S0 = (pg8::f32x4){0.f, 0.f, 0.f, 0.f}; S1 = S0; }
        else { const float* s0 = c.in[I_WKV] + ((((size_t)j * DB + (sq - BATCH)) * RHEADS + h) * RH + 2 * rp) * RH + 4 * cs; S0 = *(const pg8::f32x4*)s0; S1 = *(const pg8::f32x4*)(s0 + RH); }
        const int nch = (T + RW_CH - 1) / RW_CH;
#define RW_DMA(n, buf) do { const int nb_ = ((T - (n) * RW_CH < RW_CH ? T - (n) * RW_CH : RW_CH) * RW_REC * 4 + 1023) >> 10; \
            for (int q_ = w; q_ < nb_; q_ += 8) __builtin_amdgcn_global_load_lds((const unsigned*)(src + (size_t)(n) * RW_BUF + (size_t)q_ * 1024 + (unsigned)lane * 16u), (LDSP unsigned*)(lds + (buf) * RW_BUF + q_ * 1024), 16, 0, 0); } while (0)
        __syncthreads();
        RW_DMA(0, 0);
        asm volatile("s_waitcnt vmcnt(0)" ::: "memory");
        __syncthreads();
        for (int n = 0; n < nch; ++n) {
            if (n + 1 < nch) RW_DMA(n + 1, (n + 1) & 1);
            const int tn = T - n * RW_CH < RW_CH ? T - n * RW_CH : RW_CH;
            const LDSP unsigned char* bufp = lds + (n & 1) * RW_BUF;
            for (int t = 0; t < tn; ++t) {
                const LDSP unsigned char* rec = bufp + t * (RW_REC * 4);
                const pg8::f32x4 A = *(const LDSP pg8::f32x4*)(rec + cs * 16), WR = *(const LDSP pg8::f32x4*)(rec + 256 + cs * 16), W = *(const LDSP pg8::f32x4*)(rec + 512 + cs * 16),
                                 B = *(const LDSP pg8::f32x4*)(rec + 768 + cs * 16), K = *(const LDSP pg8::f32x4*)(rec + 1024 + cs * 16);
                const pg8::f32x2 V2 = *(const LDSP pg8::f32x2*)(rec + 1280 + rp * 8), SC = *(const LDSP pg8::f32x2*)(rec + 1792);
                float sa0 = (S0[0] * A[0] + S0[1] * A[1]) + (S0[2] * A[2] + S0[3] * A[3]), y0 = (S0[0] * WR[0] + S0[1] * WR[1]) + (S0[2] * WR[2] + S0[3] * WR[3]);
                float sa1 = (S1[0] * A[0] + S1[1] * A[1]) + (S1[2] * A[2] + S1[3] * A[3]), y1 = (S1[0] * WR[0] + S1[1] * WR[1]) + (S1[2] * WR[2] + S1[3] * WR[3]);
                sa0 = red16(sa0); sa1 = red16(sa1); y0 = red16(y0); y1 = red16(y1);
                S0 = S0 * W + sa0 * B + V2[0] * K; S1 = S1 * W + sa1 * B + V2[1] * K;
                if (cs == 0) *(LDSP pg8::f32x2*)(ybuf + t * RH + 2 * rp) = (pg8::f32x2){y0 + sa0 * SC[0] + V2[0] * SC[1], y1 + sa1 * SC[0] + V2[1] * SC[1]};
            }
            asm volatile("s_waitcnt vmcnt(0)" ::: "memory");
            __syncthreads();
            for (int t = w; t < tn; t += 8) {
                const LDSP float* rec = (const LDSP float*)(bufp + t * (RW_REC * 4));
                const float y = ybuf[t * RH + lane], mean = wave_sum64(y) * (1.0f / RH), d = y - mean, var = wave_sum64(d * d) * (1.0f / RH);
                const int ch = h * RH + lane;
                const float yn = d * (1.0f / sqrtf(var + LNX_EPS)) * c.in[I_LNW][j * D + ch] + c.in[I_LNB][j * D + ch];
                const float o = (yn + rec[450] * rec[320 + lane]) * rec[384 + lane];
                fr.yo[(size_t)(m0 + n * RW_CH + t) * D + ch] = (bf16_t)(pk2bf(o, 0.f) & 0xffffu);
            }
            __syncthreads();
        }
#undef RW_DMA
        float* so = (sq < BATCH ? c.out + O_WKVP + (((size_t)j * BATCH + sq) * RHEADS + h) * RH * RH : c.out + O_WKVS + (((size_t)j * DB + (sq - BATCH)) * RHEADS + h) * RH * RH) + (size_t)(2 * rp) * RH + 4 * cs;
        *(pg8::f32x4*)so = S0; *(pg8::f32x4*)(so + RH) = S1;
    }
}
__device__ __forceinline__ float fsigmoid(float x) { return __builtin_amdgcn_rcpf(1.0f + __expf(-x)); }
__device__ __forceinline__ float fsoftplus(float x) { return x > 20.f ? x : __logf(1.0f + __expf(x)); }
__device__ __forceinline__ float rdl(float v, int l) { return __int_as_float(__builtin_amdgcn_readlane(__float_as_int(v), l)); }
__device__ __forceinline__ float wsum_dpp(float x) {
    x = red16(x);
    return (rdl(x, 0) + rdl(x, 16)) + (rdl(x, 32) + rdl(x, 48));
}

struct RwOp { pg8::f32x4 A, WR, W, B, K; pg8::f32x2 V2, SC; };
__device__ __forceinline__ void rw_ldop(RwOp& o, const LDSP unsigned char* rec, int cs, int rp) {
    o.A = *(const LDSP pg8::f32x4*)(rec + cs * 16); o.WR = *(const LDSP pg8::f32x4*)(rec + 256 + cs * 16); o.W = *(const LDSP pg8::f32x4*)(rec + 512 + cs * 16);
    o.B = *(const LDSP pg8::f32x4*)(rec + 768 + cs * 16); o.K = *(const LDSP pg8::f32x4*)(rec + 1024 + cs * 16);
    o.V2 = *(const LDSP pg8::f32x2*)(rec + 1280 + rp * 8); o.SC = *(const LDSP pg8::f32x2*)(rec + 1792);
}
__device__ __forceinline__ float fma_s(float a, float b, float c) { float d; asm("v_fma_f32 %0, %1, %2, %3" : "=v"(d) : "v"(a), "v"(b), "v"(c)); return d; }
__device__ __forceinline__ float mul_s(float a, float b) { float d; asm("v_mul_f32 %0, %1, %2" : "=v"(d) : "v"(a), "v"(b)); return d; }
__device__ __forceinline__ void rw_step(pg8::f32x4& S0, pg8::f32x4& S1, const RwOp& o, LDSP float* yrow, bool wr) {
    float sa0 = fma_s(S0[3], o.A[3], fma_s(S0[2], o.A[2], fma_s(S0[1], o.A[1], mul_s(S0[0], o.A[0]))));
    float sa1 = fma_s(S1[3], o.A[3], fma_s(S1[2], o.A[2], fma_s(S1[1], o.A[1], mul_s(S1[0], o.A[0]))));
    float y0 = fma_s(S0[3], o.WR[3], fma_s(S0[2], o.WR[2], fma_s(S0[1], o.WR[1], mul_s(S0[0], o.WR[0]))));
    float y1 = fma_s(S1[3], o.WR[3], fma_s(S1[2], o.WR[2], fma_s(S1[1], o.WR[1], mul_s(S1[0], o.WR[0]))));
    float t0[4], t1[4];
#pragma unroll
    for (int e = 0; e < 4; ++e) { t0[e] = fma_s(o.K[e], o.V2[0], mul_s(S0[e], o.W[e])); t1[e] = fma_s(o.K[e], o.V2[1], mul_s(S1[e], o.W[e])); }
    red16x4(sa0, sa1, y0, y1);
#pragma unroll
    for (int e = 0; e < 4; ++e) { S0[e] = fma_s(o.B[e], sa0, t0[e]); S1[e] = fma_s(o.B[e], sa1, t1[e]); }
    if (wr) *(LDSP pg8::f32x2*)yrow = (pg8::f32x2){fma_s(o.V2[0], o.SC[1], fma_s(sa0, o.SC[0], y0)), fma_s(o.V2[1], o.SC[1], fma_s(sa1, o.SC[0], y1))};
}
struct RwIn { unsigned short r, k, v, wp, ap, g, vp; float vf; };
template <int J>
__device__ __forceinline__ void rw_scan_fused(const Ctx& c, const FastRw& fr, LDSP unsigned char* lds) {
    using namespace cfg; constexpr int j = J;
    const int tid = (int)tid_now(), w = __builtin_amdgcn_readfirstlane(tid >> 6), lane = tid & 63, cs = lane & 15, rp = 4 * w + (lane >> 4);
    LDSP float* ybuf = (LDSP float*)(lds + 2 * RW_BUF);
    for (int chain = blockIdx.x; chain < NSEQ * RHEADS; chain += gridDim.x) {
        const int sq = chain / RHEADS, h = chain % RHEADS, T = seq_len(sq), m0 = seq_row0(sq), ch = h * RH + lane;
        const float p_w0 = c.in[I_W0][j * D + ch], p_a0 = c.in[I_A0][j * D + ch], p_kk = c.in[I_KK][j * D + ch], p_ka = c.in[I_KA][j * D + ch], p_rk = c.in[I_RK][(size_t)j * D + ch],
                    p_lnw = c.in[I_LNW][j * D + ch], p_lnb = c.in[I_LNB][j * D + ch], p_v0 = j > 0 ? c.in[I_V0][(j - 1) * D + ch] : 0.f;
        pg8::f32x4 S0, S1;
        if (sq < BATCH) { S0 = (pg8::f32x4){0.f, 0.f, 0.f, 0.f}; S1 = S0; }
        else { const float* s0 = c.in[I_WKV] + ((((size_t)j * DB + (sq - BATCH)) * RHEADS + h) * RH + 2 * rp) * RH + 4 * cs; S0 = *(const pg8::f32x4*)s0; S1 = *(const pg8::f32x4*)(s0 + RH); }
        const int nch = (T + RW_CH - 1) / RW_CH;
        RwIn in[4];
#define RW_LOADIN(n) do { _Pragma("unroll") for (int q = 0; q < 4; ++q) { const int t_ = (n) * RW_CH + 4 * w + q; if (t_ < T) { const size_t m_ = (size_t)(m0 + t_); \
                const bf16_t* rk_ = fr.rkv + m_ * 3072 + ch; const bf16_t* lu_ = fr.lu + m_ * 4096 + ch; \
                in[q].r = rk_[0]; in[q].k = rk_[1024]; in[q].v = rk_[2048]; in[q].wp = lu_[0]; in[q].ap = lu_[1024]; in[q].g = lu_[2048]; in[q].vp = lu_[3072]; \
                in[q].vf = j > 0 ? fr.vf[m_ * D + ch] : 0.f; } } } while (0)
#define RW_PREP(n, buf) do { _Pragma("unroll") for (int q = 0; q < 4; ++q) { const int tl_ = 4 * w + q, t_ = (n) * RW_CH + tl_; if (t_ < T) { \
                const float r_ = bf2f(in[q].r), k0_ = bf2f(in[q].k); float v_ = bf2f(in[q].v); \
                const float wl_ = -fsoftplus(-(p_w0 + bf2f(in[q].wp))) - 0.5f, w_ = __expf(-__expf(wl_)); \
                if (j == 0) fr.vf[(size_t)(m0 + t_) * D + ch] = v_; else v_ = v_ + (in[q].vf - v_) * fsigmoid(p_v0 + bf2f(in[q].vp)); \
                const float a_ = fsigmoid(p_a0 + bf2f(in[q].ap)); float kk_ = k0_ * p_kk; \
                const float k2_ = k0_ * (1.0f + (a_ - 1.0f) * p_ka); \
                float n_ = red16(kk_ * kk_), e1_ = red16(r_ * k2_ * p_rk), e2_ = red16(k2_ * r_); \
                n_ = (rdl(n_, 0) + rdl(n_, 16)) + (rdl(n_, 32) + rdl(n_, 48)); e1_ = (rdl(e1_, 0) + rdl(e1_, 16)) + (rdl(e1_, 32) + rdl(e1_, 48)); e2_ = (rdl(e2_, 0) + rdl(e2_, 16)) + (rdl(e2_, 32) + rdl(e2_, 48)); \
                kk_ *= __builtin_amdgcn_rcpf(fmaxf(__builtin_amdgcn_sqrtf(n_), 1e-12f)); const float bo_ = kk_ * a_; const float e3_ = wsum_dpp(bo_ * r_); \
                LDSP float* rec_ = (LDSP float*)(lds + (buf) * RW_BUF + tl_ * (RW_REC * 4)); \
                rec_[lane] = -kk_; rec_[64 + lane] = w_ * r_; rec_[128 + lane] = w_; rec_[192 + lane] = bo_; rec_[256 + lane] = k2_; rec_[320 + lane] = v_; rec_[384 + lane] = bf2f(in[q].g); \
                if (lane == 0) { rec_[448] = e3_; rec_[449] = e2_; rec_[450] = e1_; } } } } while (0)
        __syncthreads();
        RW_LOADIN(0); RW_PREP(0, 0);
        __syncthreads();
        for (int n = 0; n < nch; ++n) {
            if (n + 1 < nch) RW_LOADIN(n + 1);
            const int tn = T - n * RW_CH < RW_CH ? T - n * RW_CH : RW_CH;
            const LDSP unsigned char* bufp = lds + (n & 1) * RW_BUF;
#if defined(PROBE_DUP) && (PROBE_DUP & (1 << 17))
            { RwOp o0, o1; rw_ldop(o0, bufp, cs, rp); pg8::f32x4 T0 = S0, T1 = S1;
              for (int t = 0; t < tn; t += 2) {
                  rw_ldop(o1, bufp + (t + 1) * (RW_REC * 4), cs, rp);
                  rw_step(T0, T1, o0, ybuf + t * RH + 2 * rp, cs == 0);
                  rw_ldop(o0, bufp + (t + 2 < tn ? t + 2 : t) * (RW_REC * 4), cs, rp);
                  rw_step(T0, T1, o1, ybuf + (t + 1) * RH + 2 * rp, cs == 0);
              } asm volatile("" :: "v"(T0), "v"(T1)); }
#endif
            { RwOp o0, o1; rw_ldop(o0, bufp, cs, rp);
              for (int t = 0; t < tn; t += 2) {
                  rw_ldop(o1, bufp + (t + 1) * (RW_REC * 4), cs, rp);
                  rw_step(S0, S1, o0, ybuf + t * RH + 2 * rp, cs == 0);
                  rw_ldop(o0, bufp + (t + 2 < tn ? t + 2 : t) * (RW_REC * 4), cs, rp);
                  rw_step(S0, S1, o1, ybuf + (t + 1) * RH + 2 * rp, cs == 0);
              } }
            if (n + 1 < nch) RW_PREP(n + 1, (n + 1) & 1);
#if defined(PROBE_DUP) && (PROBE_DUP & (1 << 18))
            if (n + 1 < nch) RW_PREP(n + 1, (n + 1) & 1);
#endif
            __syncthreads();
            for (int t = w; t < tn; t += 8) {
                const LDSP float* rec = (const LDSP float*)(bufp + t * (RW_REC * 4));
                const float y = ybuf[t * RH + lane], mean = wsum_dpp(y) * (1.0f / RH), d = y - mean, var = wsum_dpp(d * d) * (1.0f / RH);
                const float yn = d * __builtin_amdgcn_rsqf(var + LNX_EPS) * p_lnw + p_lnb;
                const float o = (yn + rec[450] * rec[320 + lane]) * rec[384 + lane];
                fr.yo[(size_t)(m0 + n * RW_CH + t) * D + ch] = (bf16_t)(pk2bf(o, 0.f) & 0xffffu);
            }
            __syncthreads();
        }
#undef RW_LOADIN
#undef RW_PREP
        float* so = (sq < BATCH ? c.out + O_WKVP + (((size_t)j * BATCH + sq) * RHEADS + h) * RH * RH : c.out + O_WKVS + (((size_t)j * DB + (sq - BATCH)) * RHEADS + h) * RH * RH) + (size_t)(2 * rp) * RH + 4 * cs;
        *(pg8::f32x4*)so = S0; *(pg8::f32x4*)(so + RH) = S1;
    }
}
struct FastMb {
    bf16_t* zb;
    bf16_t* xbcr;
    float* dtraw;
    bf16_t* xbcb;
    float* dt;
    float* y;
    bf16_t* yzn;
    bf16_t *wbint, *wbot;
};
struct EpiMamba {
    static constexpr bool PERM = true;
    bf16_t* zb; bf16_t* xbcr; float* dtraw;
    __device__ __forceinline__ void operator()(const pg8::f32x4 (&acc)[2][2][4][2], const pg8::Unit& u, int wr, int wc, int fr, int fq) const {
        using namespace pg8;
        const int row0 = u.pm * BM + wr * 64 + fr, cl0 = wc * 32 + 8 * fq, pn = u.pn;
        if (pn < 20) {
            bf16_t* base = pn < 8 ? zb : xbcr; const int ldc = pn < 8 ? 2048 : 3072, coff = pn < 8 ? pn * 256 : (pn - 8) * 256;
#pragma unroll
            for (int ai = 0; ai < 2; ++ai)
#pragma unroll
                for (int m = 0; m < 4; ++m) { bf16_t* rowp = base + (size_t)(row0 + ai * HALF + m * 16) * ldc + coff + cl0;
#pragma unroll
                    for (int bj = 0; bj < 2; ++bj) { const f32x4 v0 = acc[ai][bj][m][0], v1 = acc[ai][bj][m][1];
                        u32x4 w; w.x = cvt_pk_bf16(v0[0], v0[1]); w.y = cvt_pk_bf16(v0[2], v0[3]); w.z = cvt_pk_bf16(v1[0], v1[1]); w.w = cvt_pk_bf16(v1[2], v1[3]);
                        *(u32x4*)(rowp + bj * HALF) = w; } }
        } else if (cl0 < 32) {
#pragma unroll
            for (int ai = 0; ai < 2; ++ai)
#pragma unroll
                for (int m = 0; m < 4; ++m) { float* rowp = dtraw + (size_t)(row0 + ai * HALF + m * 16) * 32 + cl0;
                    *(f32x4*)rowp = acc[ai][0][m][0]; *(f32x4*)(rowp + 4) = acc[ai][0][m][1]; }
        }
    }
};
__device__ __forceinline__ void mb_conv_fast(const Ctx& c, const FastMb& fb, int l, size_t gtid, size_t gsz, bool write_f32) {
    using namespace cfg; const int j = l / 3; constexpr int NB = MB_CD / 8, TB = 8;
    const int tstride = (int)(gsz / NB), cbi = (int)(gtid % NB), tb0 = (int)(gtid / NB);
    if (tb0 < tstride) {
    const int cb = cbi * 8;
    float wt[MB_CONV][8], bias[8];
        { const pg8::f32x4 b0 = *(const pg8::f32x4*)(c.in[I_CONVB] + j * MB_CD + cb), b1 = *(const pg8::f32x4*)(c.in[I_CONVB] + j * MB_CD + cb + 4);
#pragma unroll
          for (int e = 0; e < 4; ++e) { bias[e] = b0[e]; bias[4 + e] = b1[e]; } }
#pragma unroll
        for (int jj = 0; jj < MB_CONV; ++jj) { const float* wp_ = c.in[I_CONVW] + ((size_t)j * MB_CONV + jj) * MB_CD + cb; const pg8::f32x4 w0 = *(const pg8::f32x4*)wp_, w1 = *(const pg8::f32x4*)(wp_ + 4);
#pragma unroll
            for (int e = 0; e < 4; ++e) { wt[jj][e] = w0[e]; wt[jj][4 + e] = w1[e]; } }
    for (int tbi = tb0; tbi < MTOT / TB; tbi += tstride) {
        const int mb = tbi * TB, t0 = row_t(mb), sq = row_seq(mb), T = seq_len(sq);
        float win[MB_CONV][8];
#pragma unroll
        for (int jj = 0; jj < MB_CONV - 1; ++jj) {
            const int tt = t0 + jj - (MB_CONV - 1);
            if (tt >= 0) { const pg8::u32x4 raw = *(const pg8::u32x4*)(fb.xbcr + (size_t)(mb + jj - (MB_CONV - 1)) * MB_CD + cb); const unsigned wv[4] = {raw.x, raw.y, raw.z, raw.w};
#pragma unroll
                for (int q = 0; q < 4; ++q) { win[jj][2 * q] = __uint_as_float(wv[q] << 16); win[jj][2 * q + 1] = __uint_as_float(wv[q] & 0xffff0000u); } }
            else if (sq >= BATCH) { const float* st = c.in[I_CONV] + (((size_t)j * DB + (sq - BATCH)) * (MB_CONV - 1) + (tt + MB_CONV - 1)) * MB_CD + cb;
#pragma unroll
                for (int e = 0; e < 8; ++e) win[jj][e] = st[e]; }
            else {
#pragma unroll
                for (int e = 0; e < 8; ++e) win[jj][e] = 0.f; }
        }
#pragma unroll
        for (int tb = 0; tb < TB; ++tb) {
            const int m = mb + tb, t = t0 + tb;
            { const pg8::u32x4 raw = *(const pg8::u32x4*)(fb.xbcr + (size_t)m * MB_CD + cb); const unsigned wv[4] = {raw.x, raw.y, raw.z, raw.w};
#pragma unroll
              for (int q = 0; q < 4; ++q) { win[3][2 * q] = __uint_as_float(wv[q] << 16); win[3][2 * q + 1] = __uint_as_float(wv[q] & 0xffff0000u); } }
            if (t >= T - (MB_CONV - 1)) {
                float* so = (sq < BATCH ? c.out + O_CONVP + (((size_t)j * BATCH + sq) * (MB_CONV - 1) + (t - (T - (MB_CONV - 1)))) * MB_CD
                                        : c.out + O_CONVS + (((size_t)j * DB + (sq - BATCH)) * (MB_CONV - 1) + (t - (T - (MB_CONV - 1)))) * MB_CD) + cb;
#pragma unroll
                for (int e = 0; e < 8; ++e) so[e] = win[3][e];
            }
            unsigned w[4];
#pragma unroll
            for (int q = 0; q < 4; ++q) {
                float a0 = bias[2 * q], a1 = bias[2 * q + 1];
#pragma unroll
                for (int jj = 0; jj < MB_CONV; ++jj) { a0 += win[jj][2 * q] * wt[jj][2 * q]; a1 += win[jj][2 * q + 1] * wt[jj][2 * q + 1]; }
                a0 = a0 * __builtin_amdgcn_rcpf(1.0f + __expf(-a0)); a1 = a1 * __builtin_amdgcn_rcpf(1.0f + __expf(-a1));
                w[q] = pk2bf(a0, a1); if (write_f32) { c.xbc[(size_t)m * MB_CD + cb + 2 * q] = a0; c.xbc[(size_t)m * MB_CD + cb + 2 * q + 1] = a1; } }
            *(pg8::u32x4*)(fb.xbcb + (size_t)m * MB_CD + cb) = (pg8::u32x4){w[0], w[1], w[2], w[3]};
#pragma unroll
            for (int jj = 0; jj < MB_CONV - 1; ++jj)
#pragma unroll
                for (int e = 0; e < 8; ++e) win[jj][e] = win[jj + 1][e];
        }
    }
    }
    for (size_t i = gtid; i < (size_t)MTOT * MB_HEADS; i += gsz) {
        const float v = softplusf_(fb.dtraw[i] + c.in[I_DTB][j * MB_HEADS + (int)(i % MB_HEADS)]);
        fb.dt[i] = v; if (write_f32) c.dt[i] = v;
    }
}
__device__ __forceinline__ void mb_gate_fast(const Ctx& c, const FastMb& fb, const float* __restrict__ y, int l, int gw, int ngw, int lane) {
    using namespace cfg; const int j = l / 3; constexpr int GW_ = MB_INNER / MB_GROUPS;
    const int g0 = gw % MB_GROUPS; const bool gfix = (ngw % MB_GROUPS) == 0;
    const float* nwp0 = c.in[I_BNORM] + j * MB_INNER + g0 * GW_ + 8 * lane; const pg8::f32x4 n0h = *(const pg8::f32x4*)nwp0, n1h = *(const pg8::f32x4*)(nwp0 + 4);
    for (int it = gw; it < MTOT * MB_GROUPS; it += ngw) {
        const int m = it / MB_GROUPS, g = it % MB_GROUPS; const size_t o = (size_t)m * MB_INNER + g * GW_ + 8 * lane;
        const pg8::f32x4 y0 = *(const pg8::f32x4*)(y + o), y1 = *(const pg8::f32x4*)(y + o + 4); const pg8::u32x4 zr = *(const pg8::u32x4*)(fb.zb + o);
        const unsigned zw[4] = {zr.x, zr.y, zr.z, zr.w}; float v[8]; float s = 0.f;
#pragma unroll
        for (int q = 0; q < 4; ++q) { const float z0 = __uint_as_float(zw[q] << 16), z1 = __uint_as_float(zw[q] & 0xffff0000u);
            v[2 * q] = (q < 2 ? y0[2 * q] : y1[2 * q - 4]) * siluf_(z0); v[2 * q + 1] = (q < 2 ? y0[2 * q + 1] : y1[2 * q - 3]) * siluf_(z1); s += v[2 * q] * v[2 * q] + v[2 * q + 1] * v[2 * q + 1]; }
        const float rs = 1.0f / sqrtf(wave_sum64(s) * (1.0f / GW_) + NORM_EPS);
        pg8::f32x4 n0 = n0h, n1 = n1h; if (!gfix) { const float* nwp = c.in[I_BNORM] + j * MB_INNER + g * GW_ + 8 * lane; n0 = *(const pg8::f32x4*)nwp; n1 = *(const pg8::f32x4*)(nwp + 4); }
        const float nw[8] = {n0[0], n0[1], n0[2], n0[3], n1[0], n1[1], n1[2], n1[3]}; unsigned w[4];
#pragma unroll
        for (int q = 0; q < 4; ++q) w[q] = pk2bf(v[2 * q] * rs * nw[2 * q], v[2 * q + 1] * rs * nw[2 * q + 1]);
        *(pg8::u32x4*)(fb.yzn + o) = (pg8::u32x4){w[0], w[1], w[2], w[3]};
    }
}
constexpr int SS_XR = 144, SS_BR = 272;
constexpr int SS_XIM = 0, SS_XSM = SS_XIM + 128 * SS_XR, SS_BIM = SS_XSM + 128 * SS_XR, SS_CIM = SS_BIM + 128 * SS_BR, SS_MTM = SS_CIM + 128 * SS_BR, SS_HBM = SS_MTM + 128 * SS_BR, SS_TAB = SS_HBM + 128 * SS_XR, SS_END = SS_TAB + 2048;
__device__ __forceinline__ bf16x8v ss_trfrag(const LDSP unsigned char* img, int rowstride, int k0, int col0, int lane) {
    const int r0 = k0 + 8 * (lane >> 5) + ((lane & 15) >> 2), cc = col0 + 16 * ((lane >> 4) & 1) + 4 * (lane & 3);
    const s16x4 t0 = __builtin_amdgcn_ds_read_tr16_b64_v4i16((LDSP s16x4*)(img + r0 * rowstride + cc * 2));
    const s16x4 t1 = __builtin_amdgcn_ds_read_tr16_b64_v4i16((LDSP s16x4*)(img + (r0 + 4) * rowstride + cc * 2));
    return (bf16x8v){t0[0], t0[1], t0[2], t0[3], t1[0], t1[1], t1[2], t1[3]};
}
__device__ __forceinline__ void mb_ssd_prompt(const Ctx& c, const FastMb& fb, int l, LDSP unsigned char* lds) {
    using namespace cfg; const int j = l / 3;
    const int tid = (int)tid_now(), w = __builtin_amdgcn_readfirstlane(tid >> 6), lane = tid & 63, l31 = lane & 31, h5 = lane >> 5;
    LDSP float* tab = (LDSP float*)(lds + SS_TAB);
    for (int chain = blockIdx.x; chain < BATCH * MB_HEADS; chain += gridDim.x) {
        const int b = chain / MB_HEADS, hd = chain % MB_HEADS, g = hd / (MB_HEADS / MB_GROUPS);
        const float Ah = -expf(c.in[I_ALOG][j * MB_HEADS + hd]), Dh = c.in[I_BD][j * MB_HEADS + hd];
        f32x16_t H;
#pragma unroll
        for (int r = 0; r < 16; ++r) H[r] = 0.f;
        pg8::u32x4 nx[2], nB[4], nC[4]; float ndt0 = 0.f, ndt1 = 0.f;
#define SS_LOAD(ck_) do { const size_t mm_ = (size_t)b * SEQ + 128 * (ck_); int tq_ = tid; asm volatile("" : "+v"(tq_)); \
            _Pragma("unroll") for (int q = 0; q < 2; ++q) { const int ci = tq_ + 512 * q; nx[q] = *(const pg8::u32x4*)(fb.xbcb + (mm_ + (ci >> 3)) * MB_CD + hd * MB_HEAD + (ci & 7) * 8); } \
            _Pragma("unroll") for (int q = 0; q < 4; ++q) { const int ci = tq_ + 512 * q; const bf16_t* rowp = fb.xbcb + (mm_ + (ci >> 4)) * MB_CD + MB_INNER + g * MB_STATE + (ci & 15) * 8; \
                nB[q] = *(const pg8::u32x4*)rowp; nC[q] = *(const pg8::u32x4*)(rowp + MB_GN); } \
            ndt0 = fb.dt[(mm_ + 2 * (tq_ & 63)) * MB_HEADS + hd]; ndt1 = fb.dt[(mm_ + 2 * (tq_ & 63) + 1) * MB_HEADS + hd]; } while (0)
        SS_LOAD(0);
        for (int ck = 0; ck < SEQ / 128; ++ck) {
            const size_t m0 = (size_t)b * SEQ + 128 * ck;
            int tl = tid; asm volatile("" : "+v"(tl));
            pg8::u32x4 xr[2];
#pragma unroll
            for (int q = 0; q < 2; ++q) { const int ci = tl + 512 * q; xr[q] = nx[q];
                *(LDSP pg8::u32x2*)(lds + SS_XIM + (ci >> 3) * SS_XR + (ci & 7) * 16) = (pg8::u32x2){xr[q].x, xr[q].y}; *(LDSP pg8::u32x2*)(lds + SS_XIM + (ci >> 3) * SS_XR + (ci & 7) * 16 + 8) = (pg8::u32x2){xr[q].z, xr[q].w}; }
#pragma unroll
            for (int q = 0; q < 4; ++q) { const int ci = tl + 512 * q;
                *(LDSP pg8::u32x4*)(lds + SS_BIM + (ci >> 4) * SS_BR + (ci & 15) * 16) = nB[q];
                *(LDSP pg8::u32x4*)(lds + SS_CIM + (ci >> 4) * SS_BR + (ci & 15) * 16) = nC[q]; }
            float alast;
            { const float v0 = ndt0 * Ah, v1 = ndt1 * Ah; float sacc = v0 + v1;
#pragma unroll
              for (int o = 1; o < 64; o <<= 1) { const float u = __shfl_up(sacc, o); if (lane >= o) sacc += u; }
              tab[2 * lane] = sacc - v1; tab[2 * lane + 1] = sacc; tab[128 + 2 * lane] = ndt0; tab[128 + 2 * lane + 1] = ndt1;
              alast = __int_as_float(__builtin_amdgcn_readlane(__float_as_int(sacc), 63)); }
            if (ck + 1 < SEQ / 128) SS_LOAD(ck + 1);
            asm volatile("s_waitcnt lgkmcnt(0)" ::: "memory");
#pragma unroll
            for (int q = 0; q < 2; ++q) { const int ci = tl + 512 * q, row = ci >> 3; const float sc = __expf(alast - tab[row]) * tab[128 + row]; const unsigned xw[4] = {xr[q].x, xr[q].y, xr[q].z, xr[q].w}; unsigned ow[4];
#pragma unroll
                for (int e = 0; e < 4; ++e) ow[e] = pk2bf(__uint_as_float(xw[e] << 16) * sc, __uint_as_float(xw[e] & 0xffff0000u) * sc);
                *(LDSP pg8::u32x2*)(lds + SS_XSM + row * SS_XR + (ci & 7) * 16) = (pg8::u32x2){ow[0], ow[1]}; *(LDSP pg8::u32x2*)(lds + SS_XSM + row * SS_XR + (ci & 7) * 16 + 8) = (pg8::u32x2){ow[2], ow[3]}; }
            __syncthreads();
            { int ln = lane; asm volatile("" : "+v"(ln)); const int a31 = ln & 31, a5 = ln >> 5;
              for (int tt = w; tt < 10; tt += 8) {
                int ib = tt < 1 ? 0 : (tt < 3 ? 1 : (tt < 6 ? 2 : 3)); const int jb = tt - (ib * (ib + 1)) / 2;
                f32x16_t ST;
#pragma unroll
                for (int r = 0; r < 16; ++r) ST[r] = 0.f;
#pragma unroll
                for (int s = 0; s < 8; ++s) { const bf16x8v a = *(const LDSP bf16x8v*)(lds + SS_BIM + (32 * jb + a31) * SS_BR + (16 * s + 8 * a5) * 2), bb = *(const LDSP bf16x8v*)(lds + SS_CIM + (32 * ib + a31) * SS_BR + (16 * s + 8 * a5) * 2);
                    ST = MFMA32(a, bb, ST); }
                const float ai = tab[32 * ib + a31];
#pragma unroll
                for (int g4 = 0; g4 < 4; ++g4) { const int jr = 32 * jb + 8 * g4 + 4 * a5; const pg8::f32x4 aj = *(const LDSP pg8::f32x4*)(tab + jr), dj = *(const LDSP pg8::f32x4*)(tab + 128 + jr);
#pragma unroll
                    for (int e = 0; e < 4; ++e) { const int jj = jr + e, ii = 32 * ib + a31; const float mv = jj <= ii ? ST[4 * g4 + e] * __expf(ai - aj[e]) * dj[e] : 0.f;
                        *(LDSP bf16_t*)(lds + SS_MTM + jj * SS_BR + ii * 2) = (bf16_t)(pk2bf(mv, 0.f) & 0xffffu); } }
              }
              const int nb = w >> 1, pb = w & 1;
#pragma unroll
              for (int r = 0; r < 16; ++r) *(LDSP bf16_t*)(lds + SS_HBM + (32 * nb + (r & 3) + 8 * (r >> 2) + 4 * a5) * SS_XR + (32 * pb + a31) * 2) = (bf16_t)(pk2bf(H[r], 0.f) & 0xffffu);
            }
            __syncthreads();
            { int ln = lane; asm volatile("" : "+v"(ln)); const int a31 = ln & 31, a5 = ln >> 5;
              const int pb = w & 1, ib = w >> 1, nb = w >> 1;
              f32x16_t Y;
#pragma unroll
              for (int r = 0; r < 16; ++r) Y[r] = 0.f;
#pragma unroll
              for (int s = 0; s < 8; ++s) { const bf16x8v a = ss_trfrag(lds + SS_HBM, SS_XR, 16 * s, 32 * pb, ln), bb = *(const LDSP bf16x8v*)(lds + SS_CIM + (32 * ib + a31) * SS_BR + (16 * s + 8 * a5) * 2);
                  Y = MFMA32(a, bb, Y); if (s & 1) __builtin_amdgcn_sched_barrier(0); }
              const float ei = __expf(tab[32 * ib + a31]);
#pragma unroll
              for (int r = 0; r < 16; ++r) Y[r] *= ei;
              for (int s = 0; s < 2 * (ib + 1); ++s) { const bf16x8v a = ss_trfrag(lds + SS_XIM, SS_XR, 16 * s, 32 * pb, ln), bb = ss_trfrag(lds + SS_MTM, SS_BR, 16 * s, 32 * ib, ln);
                  Y = MFMA32(a, bb, Y); }
              { const size_t mrow = m0 + 32 * ib + a31; float* yrow = fb.y + mrow * MB_INNER + hd * MB_HEAD + 32 * pb + 4 * a5;
#pragma unroll
                for (int g4 = 0; g4 < 4; ++g4) { const pg8::u32x2 xv = *(const LDSP pg8::u32x2*)(lds + SS_XIM + (32 * ib + a31) * SS_XR + (32 * pb + 8 * g4 + 4 * a5) * 2);
                    pg8::f32x4 o; o[0] = Y[4 * g4] + Dh * __uint_as_float(xv.x << 16); o[1] = Y[4 * g4 + 1] + Dh * __uint_as_float(xv.x & 0xffff0000u); o[2] = Y[4 * g4 + 2] + Dh * __uint_as_float(xv.y << 16); o[3] = Y[4 * g4 + 3] + Dh * __uint_as_float(xv.y & 0xffff0000u);
                    *(pg8::f32x4*)(yrow + 8 * g4) = o; } }
              const float dec = __expf(tab[127]);
#pragma unroll
              for (int r = 0; r < 16; ++r) H[r] *= dec;
#pragma unroll
              for (int s = 0; s < 8; ++s) { const bf16x8v a = ss_trfrag(lds + SS_BIM, SS_BR, 16 * s, 32 * nb, ln), bb = ss_trfrag(lds + SS_XSM, SS_XR, 16 * s, 32 * pb, ln);
                  H = MFMA32(a, bb, H); if (s & 1) __builtin_amdgcn_sched_barrier(0); }
            }
            __syncthreads();
        }
#undef SS_LOAD
        { const int nb = w >> 1, pb = w & 1; float* so = c.out + O_SSMP + (((size_t)j * BATCH + b) * MB_HEADS + hd) * MB_HEAD * MB_STATE;
#pragma unroll
          for (int r = 0; r < 16; ++r) so[(size_t)(32 * pb + l31) * MB_STATE + 32 * nb + (r & 3) + 8 * (r >> 2) + 4 * h5] = H[r]; }
    }
}
__device__ __forceinline__ void mb_scan_sample(const Ctx& c, const FastMb& fb, int l) {
    using namespace cfg; const int j = l / 3;
    const int tid = (int)tid_now(), p = tid >> 3, ns = tid & 7;
    pg8::f32x4 hn[4];
    { const int chain = blockIdx.x; if (chain < DB * MB_HEADS) { const size_t so = ((((size_t)j * DB + chain / MB_HEADS) * MB_HEADS + chain % MB_HEADS) * MB_HEAD + p) * MB_STATE + 16 * ns;
#pragma unroll
        for (int q = 0; q < 4; ++q) hn[q] = *(const pg8::f32x4*)(c.in[I_SSM] + so + 4 * q); } }
    for (int chain = blockIdx.x; chain < DB * MB_HEADS; chain += gridDim.x) {
        const int s = chain / MB_HEADS, hd = chain % MB_HEADS, g = hd / (MB_HEADS / MB_GROUPS);
        const float Ah = -expf(c.in[I_ALOG][j * MB_HEADS + hd]), Dh = c.in[I_BD][j * MB_HEADS + hd];
        const size_t so = ((((size_t)j * DB + s) * MB_HEADS + hd) * MB_HEAD + p) * MB_STATE + 16 * ns;
        float hs[16];
#pragma unroll
        for (int q = 0; q < 4; ++q) { hs[4 * q] = hn[q][0]; hs[4 * q + 1] = hn[q][1]; hs[4 * q + 2] = hn[q][2]; hs[4 * q + 3] = hn[q][3]; }
        { const int cn = chain + gridDim.x; if (cn < DB * MB_HEADS) { const size_t sn = ((((size_t)j * DB + cn / MB_HEADS) * MB_HEADS + cn % MB_HEADS) * MB_HEAD + p) * MB_STATE + 16 * ns;
#pragma unroll
            for (int q = 0; q < 4; ++q) hn[q] = *(const pg8::f32x4*)(c.in[I_SSM] + sn + 4 * q); } }
        float dtv[DS]; unsigned short xr[DS]; pg8::u32x4 Bq[DS][2], Cq[DS][2];
#pragma unroll
        for (int t = 0; t < DS; ++t) { const size_t m = (size_t)MP + s * DS + t; dtv[t] = fb.dt[m * MB_HEADS + hd]; xr[t] = fb.xbcb[m * MB_CD + hd * MB_HEAD + p];
            const bf16_t* Bp = fb.xbcb + m * MB_CD + MB_INNER + g * MB_STATE + 16 * ns; Bq[t][0] = *(const pg8::u32x4*)Bp; Bq[t][1] = *(const pg8::u32x4*)(Bp + 8);
            Cq[t][0] = *(const pg8::u32x4*)(Bp + MB_GN); Cq[t][1] = *(const pg8::u32x4*)(Bp + MB_GN + 8); }
#pragma unroll
        for (int t = 0; t < DS; ++t) {
            const size_t m = (size_t)MP + s * DS + t;
            const float dA = __expf(dtv[t] * Ah), xv = bf2f(xr[t]), xdt = xv * dtv[t];
            const unsigned bw[8] = {Bq[t][0].x, Bq[t][0].y, Bq[t][0].z, Bq[t][0].w, Bq[t][1].x, Bq[t][1].y, Bq[t][1].z, Bq[t][1].w};
            const unsigned cw[8] = {Cq[t][0].x, Cq[t][0].y, Cq[t][0].z, Cq[t][0].w, Cq[t][1].x, Cq[t][1].y, Cq[t][1].z, Cq[t][1].w};
            float yy = 0.f;
#pragma unroll
            for (int k = 0; k < 8; ++k) { hs[2 * k] = hs[2 * k] * dA + xdt * __uint_as_float(bw[k] << 16); hs[2 * k + 1] = hs[2 * k + 1] * dA + xdt * __uint_as_float(bw[k] & 0xffff0000u);
                yy += __uint_as_float(cw[k] << 16) * hs[2 * k] + __uint_as_float(cw[k] & 0xffff0000u) * hs[2 * k + 1]; }
            yy += __shfl_xor(yy, 1); yy += __shfl_xor(yy, 2); yy += __shfl_xor(yy, 4);
            if (ns == 0) fb.y[m * MB_INNER + hd * MB_HEAD + p] = yy + Dh * xv;
        }
        float* oo = c.out + O_SSMS + so;
#pragma unroll
        for (int q = 0; q < 4; ++q) *(pg8::f32x4*)(oo + 4 * q) = (pg8::f32x4){hs[4 * q], hs[4 * q + 1], hs[4 * q + 2], hs[4 * q + 3]};
    }
}
constexpr int RC_RS = 144;
constexpr int RC_AT = 0, RC_RT = 4608, RC_BB = 9216, RC_KB = 13824, RC_BH = 18432, RC_KH = 23040, RC_VV = 27648, RC_UT = 32256, RC_GG = 36864;
constexpr int RC_SB = 41472;
constexpr int RC_NAK = 50688, RC_MRB = 53248, RC_MRK = 55808, RC_NS = 80;
constexpr int RC_NAB = 58368;
constexpr int RC_E = 62464;
constexpr int RC_YB = 70656;
constexpr int RC_GL = 78848, RC_BON = 79104, RC_VV2 = 79360, RC_GG2 = RC_VV2 + 4608, RC_END0 = RC_GG2 + 4608;
constexpr int RC_WW = RC_END0, RC_WA = RC_WW + 64 * 144, RC_WG = RC_WA + 64 * 144, RC_WV = RC_WG + 64 * 336, RC_LUO = RC_WV + 64 * 80, RC_END = RC_LUO + 4 * 4608;
constexpr int RC_HB = RC_AT, RC_HBS = 784;
__device__ __forceinline__ bf16x8v rc_nat(const LDSP unsigned char* img, int stride, int row, int kofs) { return *(const LDSP bf16x8v*)(img + row * stride + kofs * 2); }
__device__ __forceinline__ int rc_row(int r, int h5) { return (r & 3) + 8 * (r >> 2) + 4 * h5; }
__device__ __forceinline__ void rc_st16(LDSP unsigned char* p, float v) { *(LDSP bf16_t*)p = (bf16_t)(pk2bf(v, 0.f) & 0xffffu); }


template <int S>
struct RcSub {
    static __device__ __forceinline__ void run(float (&acc)[32], const LDSP float* NAB, LDSP unsigned char* lds, int lane) {
        const float us = acc[S]; rc_st16(lds + RC_UT + S * RC_RS + lane * 2, us);
#pragma unroll
        for (int g4 = 0; g4 < 8; ++g4) { if (4 * g4 + 3 > S) { const pg8::f32x4 nv = *(const LDSP pg8::f32x4*)(NAB + S * 32 + 4 * g4);
#pragma unroll
            for (int e = 0; e < 4; ++e) { if (4 * g4 + e > S) acc[4 * g4 + e] = fmaf(nv[e], us, acc[4 * g4 + e]); } } }
        RcSub<S + 1>::run(acc, NAB, lds, lane);
    }
};
template <> struct RcSub<32> { static __device__ __forceinline__ void run(float (&)[32], const LDSP float*, LDSP unsigned char*, int) {} };

template <int J>
__device__ __forceinline__ void rw_scan_chunked(const Ctx& c, const FastRw& fr, LDSP unsigned char* lds) {
    using namespace cfg; constexpr int j = J;
    const int tid = (int)tid_now(), w = __builtin_amdgcn_readfirstlane(tid >> 6), lane = tid & 63, l31 = lane & 31, h5 = lane >> 5;
    LDSP float* Ef = (LDSP float*)(lds + RC_E); LDSP float* YB = (LDSP float*)(lds + RC_YB); LDSP float* GL = (LDSP float*)(lds + RC_GL); LDSP float* BON = (LDSP float*)(lds + RC_BON);
    LDSP float* NAB = (LDSP float*)(lds + RC_NAB);
    int hcur = -1;
    for (int chain = blockIdx.x; chain < NSEQ * RHEADS; chain += gridDim.x) {
        const int sq = chain / RHEADS, h = chain % RHEADS, T = seq_len(sq), m0 = seq_row0(sq), ch = h * RH + lane;
        const float p_w0 = c.in[I_W0][j * D + ch], p_a0 = c.in[I_A0][j * D + ch], p_kk = c.in[I_KK][j * D + ch], p_ka = c.in[I_KA][j * D + ch], p_rk = c.in[I_RK][(size_t)j * D + ch],
                    p_lnw = c.in[I_LNW][j * D + ch], p_lnb = c.in[I_LNB][j * D + ch], p_v0 = j > 0 ? c.in[I_V0][(j - 1) * D + ch] : 0.f;
        const int ib = (w >> 1) & 1, jb = w & 1;
        f32x16_t ST;
#pragma unroll
        for (int r = 0; r < 16; ++r) ST[r] = 0.f;
        if (w < 4 && sq >= BATCH) { const float* s0 = c.in[I_WKV] + (((size_t)j * DB + (sq - BATCH)) * RHEADS + h) * RH * RH;
#pragma unroll
            for (int r = 0; r < 16; ++r) ST[r] = s0[(size_t)(32 * ib + rc_row(r, h5)) * RH + 32 * jb + l31]; }
        const int nch = (T + 31) / 32;
        if (h != hcur) {
            __syncthreads();
            const bf16_t* lw = fr.lorat + (size_t)j * 4096 * 384;
            for (int ci = tid; ci < 64 * 8; ci += 512) { const int row = ci >> 3, c8 = ci & 7;
                *(LDSP pg8::u32x4*)(lds + RC_WW + row * 144 + c8 * 16) = *(const pg8::u32x4*)(lw + (size_t)(0 * 1024 + h * 64 + row) * 384 + 0 + c8 * 8);
                *(LDSP pg8::u32x4*)(lds + RC_WA + row * 144 + c8 * 16) = *(const pg8::u32x4*)(lw + (size_t)(1 * 1024 + h * 64 + row) * 384 + 64 + c8 * 8); }
            for (int ci = tid; ci < 64 * 20; ci += 512) { const int row = ci / 20, c20 = ci % 20;
                *(LDSP pg8::u32x4*)(lds + RC_WG + row * 336 + c20 * 16) = *(const pg8::u32x4*)(lw + (size_t)(2 * 1024 + h * 64 + row) * 384 + 128 + c20 * 8); }
            for (int ci = tid; ci < 64 * 4; ci += 512) { const int row = ci >> 2, c4 = ci & 3;
                *(LDSP pg8::u32x4*)(lds + RC_WV + row * 80 + c4 * 16) = *(const pg8::u32x4*)(lw + (size_t)(3 * 1024 + h * 64 + row) * 384 + 288 + c4 * 8); }
            hcur = h;
        }
        RwIn in[4]; pg8::u32x4 hbr[3];
#define RC_LOADIN(n) do { _Pragma("unroll") for (int q = 0; q < 4; ++q) { const int t_ = (n) * 32 + 4 * w + q; if (t_ < T) { const size_t m_ = (size_t)(m0 + t_); \
                const bf16_t* rk_ = fr.rkv + m_ * 3072 + ch; in[q].r = rk_[0]; in[q].k = rk_[1024]; in[q].v = rk_[2048]; \
                in[q].vf = j > 0 ? fr.vf[m_ * D + ch] : 0.f; } } \
            _Pragma("unroll") for (int k3 = 0; k3 < 3; ++k3) { const int ci_ = tid + 512 * k3, tk_ = ci_ / 48, t_ = (n) * 32 + tk_; \
                hbr[k3] = t_ < T ? *(const pg8::u32x4*)(fr.hb + (size_t)(m0 + t_) * 384 + (ci_ % 48) * 8) : (pg8::u32x4){0u, 0u, 0u, 0u}; } } while (0)
#define RC_EPI_TOKEN(nn, tl) do { const int vv_ = ((nn) & 1) ? RC_VV2 : RC_VV, gg_ = ((nn) & 1) ? RC_GG2 : RC_GG, bn_ = ((nn) & 1) ? 32 : 0; \
                const float y_ = YB[(tl) * 64 + lane], mean_ = wsum_dpp(y_) * (1.0f / RH), d_ = y_ - mean_, var_ = wsum_dpp(d_ * d_) * (1.0f / RH); \
                const float yn_ = d_ * __builtin_amdgcn_rsqf(var_ + LNX_EPS) * p_lnw + p_lnb; \
                const float o_ = (yn_ + BON[bn_ + (tl)] * bf2f(*(const LDSP bf16_t*)(lds + vv_ + (tl) * RC_RS + lane * 2))) * bf2f(*(const LDSP bf16_t*)(lds + gg_ + (tl) * RC_RS + lane * 2)); \
                fr.yo[(size_t)(m0 + (nn) * 32 + (tl)) * D + ch] = (bf16_t)(pk2bf(o_, 0.f) & 0xffffu); } while (0)
        __syncthreads();
        RC_LOADIN(0);
        for (int n = 0; n < nch; ++n) {
            const int tn = T - n * 32 < 32 ? T - n * 32 : 32;
            const int vvo = (n & 1) ? RC_VV2 : RC_VV, ggo = (n & 1) ? RC_GG2 : RC_GG, bno = (n & 1) ? 32 : 0;
#pragma unroll
            for (int k3 = 0; k3 < 3; ++k3) { const int ci_ = tid + 512 * k3; *(LDSP pg8::u32x4*)(lds + RC_HB + (ci_ / 48) * RC_HBS + (ci_ % 48) * 16) = hbr[k3]; }
            __syncthreads();
            { int ln = lane; asm volatile("" : "+v"(ln)); const int a31 = ln & 31, a5 = ln >> 5; const int grp = w >> 1, nb = w & 1;
              const int koff = grp == 0 ? 0 : (grp == 1 ? 64 : (grp == 2 ? 128 : 288)), nks = grp == 2 ? 10 : (grp == 3 ? 2 : 4);
              const int wof = grp == 0 ? RC_WW : (grp == 1 ? RC_WA : (grp == 2 ? RC_WG : RC_WV)), wst = grp == 2 ? 336 : (grp == 3 ? 80 : 144);
              f32x16_t LA;
#pragma unroll
              for (int r = 0; r < 16; ++r) LA[r] = 0.f;
              for (int ks = 0; ks < nks; ++ks) LA = MFMA32(rc_nat(lds + RC_HB, RC_HBS, a31, koff + 16 * ks + 8 * a5), rc_nat(lds + wof, wst, 32 * nb + a31, 16 * ks + 8 * a5), LA);
#pragma unroll
              for (int r = 0; r < 16; ++r) rc_st16(lds + RC_LUO + grp * 4608 + rc_row(r, a5) * RC_RS + (32 * nb + a31) * 2, LA[r]); }
            __syncthreads();
            float q_r[4], q_k[4], q_a[4], q_b[4], q_e[4];
#pragma unroll
            for (int q = 0; q < 4; ++q) {
                const int tl = 4 * w + q, tg = n * 32 + tl;
                float r_ = 0.f, k2_ = 0.f, v_ = 0.f, a_ = 0.f, b_ = 0.f, e_ = 0.f, g_ = 0.f, bon_ = 0.f;
                if (tg < T) {
                    r_ = bf2f(in[q].r); const float k0_ = bf2f(in[q].k); v_ = bf2f(in[q].v);
                    e_ = 0.6065306597126334f * fsigmoid(p_w0 + bf2f(*(const LDSP bf16_t*)(lds + RC_LUO + 0 * 4608 + tl * RC_RS + lane * 2)));
                    if (j == 0) fr.vf[(size_t)(m0 + tg) * D + ch] = v_; else v_ = v_ + (in[q].vf - v_) * fsigmoid(p_v0 + bf2f(*(const LDSP bf16_t*)(lds + RC_LUO + 3 * 4608 + tl * RC_RS + lane * 2)));
                    const float as_ = fsigmoid(p_a0 + bf2f(*(const LDSP bf16_t*)(lds + RC_LUO + 1 * 4608 + tl * RC_RS + lane * 2))); float kk_ = k0_ * p_kk;
                    k2_ = k0_ * (1.0f + (as_ - 1.0f) * p_ka);
                    float n_ = red16(kk_ * kk_), e1_ = red16(r_ * k2_ * p_rk);
                    n_ = (rdl(n_, 0) + rdl(n_, 16)) + (rdl(n_, 32) + rdl(n_, 48)); bon_ = (rdl(e1_, 0) + rdl(e1_, 16)) + (rdl(e1_, 32) + rdl(e1_, 48));
                    kk_ *= __builtin_amdgcn_rcpf(fmaxf(__builtin_amdgcn_sqrtf(n_), 1e-12f));
                    a_ = -kk_; b_ = kk_ * as_; g_ = bf2f(*(const LDSP bf16_t*)(lds + RC_LUO + 2 * 4608 + tl * RC_RS + lane * 2));
                }
                q_r[q] = r_; q_k[q] = k2_; q_a[q] = a_; q_b[q] = b_; q_e[q] = e_;
                Ef[tl * 64 + lane] = e_;
                rc_st16(lds + vvo + tl * RC_RS + lane * 2, v_); rc_st16(lds + ggo + tl * RC_RS + lane * 2, g_);
                if (lane == 0) BON[bno + tl] = bon_;
            }
            if (n + 1 < nch) RC_LOADIN(n + 1);
            if (w < 4) {
#pragma unroll
                for (int r = 0; r < 16; ++r) rc_st16(lds + RC_SB + (32 * ib + rc_row(r, h5)) * RC_RS + (32 * jb + l31) * 2, ST[r]);
            }
            __syncthreads();
            { float run = 0.f, base = 0.f;
#pragma unroll
              for (int s = 0; s < 32; ++s) { const float ev = Ef[s * 64 + lane]; if (s == 4 * w) base = run; run += ev; }
              const float cumL = run; float cum = base;
#pragma unroll
              for (int q = 0; q < 4; ++q) { const int tl = 4 * w + q; const float cprev = cum; cum += q_e[q];
                  const float gam = __expf(-cum), gamp = __expf(-cprev), ginv = __expf(cum), glr = __expf(cum - cumL);
                  rc_st16(lds + RC_AT + tl * RC_RS + lane * 2, q_a[q] * gamp); rc_st16(lds + RC_RT + tl * RC_RS + lane * 2, q_r[q] * gam);
                  rc_st16(lds + RC_BB + tl * RC_RS + lane * 2, q_b[q] * ginv); rc_st16(lds + RC_KB + tl * RC_RS + lane * 2, q_k[q] * ginv);
                  rc_st16(lds + RC_BH + tl * RC_RS + lane * 2, q_b[q] * glr); rc_st16(lds + RC_KH + tl * RC_RS + lane * 2, q_k[q] * glr); }
              if (w == 0) GL[lane] = __expf(-cumL); }
            __syncthreads();
            f32x16_t R1;
#pragma unroll
            for (int r = 0; r < 16; ++r) R1[r] = 0.f;
            { int ln = lane; asm volatile("" : "+v"(ln)); const int a31 = ln & 31, a5 = ln >> 5;
              if (w < 4) {
                  const int aoff = (w == 0) ? RC_BB : ((w < 2) ? RC_AT : RC_RT), boff = (w == 0) ? RC_AT : ((w & 1) ? RC_KB : RC_BB);
#pragma unroll
                  for (int ks = 0; ks < 4; ++ks) R1 = MFMA32(rc_nat(lds + aoff, RC_RS, a31, 16 * ks + 8 * a5), rc_nat(lds + boff, RC_RS, a31, 16 * ks + 8 * a5), R1);
#pragma unroll
                  for (int r = 0; r < 16; ++r) { const int rr = rc_row(r, a5), cc = a31;
                      if (w == 0) NAB[rr * 32 + cc] = (rr < cc) ? R1[r] : 0.f;
                      else { const bool keep = (w < 2) ? (cc < rr) : (cc <= rr); rc_st16(lds + (w == 1 ? RC_NAK : (w == 2 ? RC_MRB : RC_MRK)) + rr * RC_NS + cc * 2, keep ? R1[r] : 0.f); } }
              } else {
                  const int aoff = (w < 6) ? RC_AT : RC_RT, ibk = w & 1;
#pragma unroll
                  for (int ks = 0; ks < 4; ++ks) R1 = MFMA32(rc_nat(lds + aoff, RC_RS, a31, 16 * ks + 8 * a5), rc_nat(lds + RC_SB, RC_RS, 32 * ibk + a31, 16 * ks + 8 * a5), R1);
              } }
            __syncthreads();
            if (w == 4 || w == 5) { int ln = lane; asm volatile("" : "+v"(ln)); const int a31 = ln & 31, a5 = ln >> 5, ibk = w & 1;
#pragma unroll
                for (int ks = 0; ks < 2; ++ks) R1 = MFMA32(rc_nat(lds + RC_NAK, RC_NS, a31, 16 * ks + 8 * a5), ss_trfrag(lds + vvo, RC_RS, 16 * ks, 32 * ibk, ln), R1);
#pragma unroll
                for (int r = 0; r < 16; ++r) Ef[rc_row(r, a5) * 64 + 32 * ibk + a31] = R1[r]; }
            __syncthreads();
            if (w > 0 && n > 0) { for (int tl = w - 1; tl < 32; tl += 7) RC_EPI_TOKEN(n - 1, tl); }
            if (w == 0) { float acc[32];
#pragma unroll
                for (int t = 0; t < 32; ++t) acc[t] = Ef[t * 64 + lane];
                RcSub<0>::run(acc, NAB, lds, lane); }
            __syncthreads();
            { int ln = lane; asm volatile("" : "+v"(ln)); const int a31 = ln & 31, a5 = ln >> 5;
              if (w >= 6) { const int ibk = w & 1;
#pragma unroll
                  for (int ks = 0; ks < 2; ++ks) { R1 = MFMA32(rc_nat(lds + RC_MRB, RC_NS, a31, 16 * ks + 8 * a5), ss_trfrag(lds + RC_UT, RC_RS, 16 * ks, 32 * ibk, ln), R1);
                                                   R1 = MFMA32(rc_nat(lds + RC_MRK, RC_NS, a31, 16 * ks + 8 * a5), ss_trfrag(lds + vvo, RC_RS, 16 * ks, 32 * ibk, ln), R1); }
#pragma unroll
                  for (int r = 0; r < 16; ++r) YB[rc_row(r, a5) * 64 + 32 * ibk + a31] = R1[r];
              } else if (w < 4) { const float gl = GL[32 * jb + a31];
#pragma unroll
                  for (int r = 0; r < 16; ++r) ST[r] *= gl;
#pragma unroll
                  for (int ks = 0; ks < 2; ++ks) { ST = MFMA32(ss_trfrag(lds + RC_UT, RC_RS, 16 * ks, 32 * ib, ln), ss_trfrag(lds + RC_BH, RC_RS, 16 * ks, 32 * jb, ln), ST);
                                                   ST = MFMA32(ss_trfrag(lds + vvo, RC_RS, 16 * ks, 32 * ib, ln), ss_trfrag(lds + RC_KH, RC_RS, 16 * ks, 32 * jb, ln), ST); } } }
            __syncthreads();
        }
        { const int nl = nch - 1, tnl = T - nl * 32 < 32 ? T - nl * 32 : 32; for (int tl = w; tl < tnl; tl += 8) RC_EPI_TOKEN(nl, tl); }
#undef RC_EPI_TOKEN
#undef RC_LOADIN
        if (w < 4) { float* so = (sq < BATCH ? c.out + O_WKVP + (((size_t)j * BATCH + sq) * RHEADS + h) * RH * RH : c.out + O_WKVS + (((size_t)j * DB + (sq - BATCH)) * RHEADS + h) * RH * RH);
#pragma unroll
            for (int r = 0; r < 16; ++r) so[(size_t)(32 * ib + rc_row(r, h5)) * RH + 32 * jb + l31] = ST[r]; }
    }
}
template <int ACT, bool ACC>
__device__ __forceinline__ void gemm_dev(const float* __restrict__ A, int lda, const float* __restrict__ B, int ldb, float* C, int ldc, int M, int N, int K, unsigned short (*As)[40], unsigned short (*Bs)[40]) {
    const int tid = threadIdx.x, wave = tid >> 6, lane = tid & 63, wr = wave >> 1, wc = wave & 1, fr = lane & 15, fq = lane >> 4;
    const int ntn = (N + 127) / 128, ntm = (M + 127) / 128;
    for (int tile = blockIdx.x; tile < ntm * ntn; tile += gridDim.x) {
        const int bm = (tile / ntn) * 128, bn = (tile % ntn) * 128;
        f32x4_t acc[2][4];
#pragma unroll
        for (int i = 0; i < 2; ++i)
#pragma unroll
            for (int j = 0; j < 4; ++j) acc[i][j] = (f32x4_t){0.f, 0.f, 0.f, 0.f};
        for (int k0 = 0; k0 < K; k0 += 32) {
#pragma unroll
            for (int it = 0; it < 2; ++it) {
                const int idx = tid + it * 512, row = idx >> 3, c4 = idx & 7, gm = bm + row;
                float4 v = make_float4(0.f, 0.f, 0.f, 0.f);
                if (gm < M) v = *(const float4*)(A + (size_t)gm * lda + k0 + c4 * 4);
                uint2 w; w.x = (unsigned)f2bf(v.x) | ((unsigned)f2bf(v.y) << 16); w.y = (unsigned)f2bf(v.z) | ((unsigned)f2bf(v.w) << 16);
                *(uint2*)&As[row][c4 * 4] = w;
            }
#pragma unroll
            for (int it = 0; it < 2; ++it) {
                const int idx = tid + it * 512, kr = idx >> 5, n4 = idx & 31, gn = bn + n4 * 4;
                float4 v = make_float4(0.f, 0.f, 0.f, 0.f);
                if (gn < N) v = *(const float4*)(B + (size_t)(k0 + kr) * ldb + gn);
                Bs[n4 * 4 + 0][kr] = f2bf(v.x); Bs[n4 * 4 + 1][kr] = f2bf(v.y); Bs[n4 * 4 + 2][kr] = f2bf(v.z); Bs[n4 * 4 + 3][kr] = f2bf(v.w);
            }
            __syncthreads();
            bf16x8_t a[2], b[4];
#pragma unroll
            for (int i = 0; i < 2; ++i) a[i] = *(const bf16x8_t*)&As[wr * 32 + i * 16 + fr][fq * 8];
#pragma unroll
            for (int j = 0; j < 4; ++j) b[j] = *(const bf16x8_t*)&Bs[wc * 64 + j * 16 + fr][fq * 8];
#pragma unroll
            for (int i = 0; i < 2; ++i)
#pragma unroll
                for (int j = 0; j < 4; ++j) acc[i][j] = __builtin_amdgcn_mfma_f32_16x16x32_bf16(a[i], b[j], acc[i][j], 0, 0, 0);
            __syncthreads();
        }
#pragma unroll
        for (int i = 0; i < 2; ++i)
#pragma unroll
            for (int j = 0; j < 4; ++j)
#pragma unroll
                for (int e = 0; e < 4; ++e) {
                    const int row = bm + wr * 32 + i * 16 + fq * 4 + e, col = bn + wc * 64 + j * 16 + fr;
                    if (row < M && col < N) {
                        float v = acc[i][j][e];
                        if (ACT == 1) v = tanhf(v); else if (ACT == 2) v = 1.0f / (1.0f + expf(-v)); else if (ACT == 3) v = v > 0.f ? v * v : 0.f;
                        float* cp = C + (size_t)row * ldc + col; *cp = ACC ? *cp + v : v;
                    }
                }
    }
}

#define MRUN(ph, l) do { ph(c, l, gtid, gsz); xcd_barrier(bar); } while (0)
#define MGEMM(ACT, ACC, A, lda, B, ldb, C, ldc, M, N, K) do { gemm_dev<ACT, ACC>(A, lda, B, ldb, C, ldc, M, N, K, As, Bs); xcd_barrier(bar); } while (0)
#define KS_FFN 16
#define KS_1K 4
#define KS_MB 8
#ifndef ACC_KSPLIT
#define ACC_KSPLIT 1
#endif
#ifndef FFN_DOWN_KSPLIT
#define FFN_DOWN_KSPLIT 1
#endif
#define GBAR() xcd_barrier(bar)
#ifndef PROBE_DUP
#define PROBE_DUP 0
#endif
#define DUP(bit, ...) do { __VA_ARGS__; if (PROBE_DUP & (1 << (bit))) { GBAR(); __VA_ARGS__; } } while (0)
#define GTID_NOW() ((size_t)blockIdx.x * 512 + tid_now())
#define GSZ_NOW() ((size_t)gridDim.x * 512)
#define GW_NOW() ((int)(blockIdx.x * 8 + (tid_now() >> 6)))
#define NGW_NOW() ((int)(gridDim.x * 8))
#define LANE_NOW() ((int)(tid_now() & 63))
#undef MRUN
#undef MGEMM
#define MRUN(ph, l) do { ph(c, l, GTID_NOW(), GSZ_NOW()); xcd_barrier(bar); } while (0)
#define MGEMM(ACT, ACC, A, lda, B, ldb, C, ldc, M, N, K) do { gemm_dev<ACT, ACC>(A, lda, B, ldb, C, ldc, M, N, K, (unsigned short (*)[40])dynlds, (unsigned short (*)[40])(dynlds + 128 * 40 * 2)); xcd_barrier(bar); } while (0)
extern __shared__ __attribute__((aligned(16))) unsigned char dynlds[];

struct MegaArgs { Ctx c; Fast f; FastMla fm; FastRw fr; FastMb fb; unsigned* bar; };
constexpr int LDS_STAGE = 0, LDS_XB = 163840 - 64, LDS_BYTES = 163840;
static_assert(SD_END <= LDS_XB && SS_END <= LDS_XB && RC_END <= LDS_XB, "LDS map");

template <int L>
__device__ __forceinline__ void layer_mix_naive(const Ctx& c, const XcdBarrier& bar) {
    using namespace cfg;
    constexpr int l = L, kind = L % 3, j = L / 3;
    MRUN(ph_norm_mix, l);
    if constexpr (kind == 0) {
        MRUN(ph_rw_mix, l);
        const float* W = c.in[I_WRKV] + (size_t)j * 3 * D * D;
        MGEMM(0, false, c.xm[0], D, W, D, c.r, D, MTOT, D, D);
        MGEMM(0, false, c.xm[1], D, W + (size_t)D * D, D, c.k, D, MTOT, D, D);
        MGEMM(0, false, c.xm[2], D, W + (size_t)2 * D * D, D, c.v, D, MTOT, D, D);
        MGEMM(1, false, c.xm[3], D, c.in[I_W1] + (size_t)j * D * RW_DL, RW_DL, c.hw, RW_DL, MTOT, RW_DL, D);
        MGEMM(0, false, c.hw, RW_DL, c.in[I_W2] + (size_t)j * RW_DL * D, D, c.wpre, D, MTOT, D, RW_DL);
        MGEMM(0, false, c.xm[4], D, c.in[I_A1] + (size_t)j * D * RW_AL, RW_AL, c.ha, RW_AL, MTOT, RW_AL, D);
        MGEMM(0, false, c.ha, RW_AL, c.in[I_A2] + (size_t)j * RW_AL * D, D, c.apre, D, MTOT, D, RW_AL);
        if constexpr (j > 0) {
            MGEMM(0, false, c.xm[2], D, c.in[I_V1] + (size_t)(j - 1) * D * RW_VL, RW_VL, c.hv, RW_VL, MTOT, RW_VL, D);
            MGEMM(0, false, c.hv, RW_VL, c.in[I_V2] + (size_t)(j - 1) * RW_VL * D, D, c.vpre, D, MTOT, D, RW_VL);
        }
        MGEMM(2, false, c.xm[5], D, c.in[I_G1] + (size_t)j * D * RW_GL, RW_GL, c.hg, RW_GL, MTOT, RW_GL, D);
        MGEMM(0, false, c.hg, RW_GL, c.in[I_G2] + (size_t)j * RW_GL * D, D, c.g, D, MTOT, D, RW_GL);
        MRUN(ph_rw_prep, l); MRUN(ph_rw_scan, l); MRUN(ph_rw_post, l);
        MGEMM(0, true, c.yo, D, c.in[I_RWO] + (size_t)j * D * D, D, c.x, D, MTOT, D, D);
    } else if constexpr (kind == 1) {
        MGEMM(0, false, c.xn, D, c.in[I_MWIN] + (size_t)j * D * MLA_IN, MLA_IN, c.mh, MLA_IN, MTOT, MLA_IN, D);
        MRUN(ph_mla_norm1, l);
        MGEMM(0, false, c.qan, QL, c.in[I_WUQ] + (size_t)j * QL * MH * QD, MH * QD, c.q, MH * QD, MTOT, MH * QD, QL);
        MGEMM(0, false, c.c, KVL, c.in[I_WUK] + (size_t)j * KVL * MH * NOPE, MH * NOPE, c.knr, MH * NOPE, MTOT, MH * NOPE, KVL);
        MGEMM(0, false, c.c, KVL, c.in[I_WUV] + (size_t)j * KVL * MH * VD, MH * VD, c.vv, MH * VD, MTOT, MH * VD, KVL);
        MRUN(ph_mla_norm2, l); MRUN(ph_mla_attn_prompt, l); MRUN(ph_mla_score_sample, l); MRUN(ph_mla_softmax_sample, l); MRUN(ph_mla_pv_sample, l); MRUN(ph_mla_out_sample, l);
        MGEMM(0, true, c.ao, MH * VD, c.in[I_MWO] + (size_t)j * MH * VD * D, D, c.x, D, MTOT, D, MH * VD);
    } else {
        MGEMM(0, false, c.xn, D, c.in[I_BWIN] + (size_t)j * D * MB_IN, MB_IN, c.zx, MB_IN, MTOT, MB_IN, D);
        MRUN(ph_mb_conv, l); MRUN(ph_mb_dt, l); MRUN(ph_mb_scan, l); MRUN(ph_mb_gate, l);
        MGEMM(0, true, c.yzn, MB_INNER, c.in[I_BWO] + (size_t)j * MB_INNER * D, D, c.x, D, MTOT, D, MB_INNER);
    }
}


template <int L>
__device__ __forceinline__ void layer_rwkv_fast(const Ctx& c, const Fast& f, const FastRw& fr, const XcdBarrier& bar, LDSP unsigned char* lds) {
    using namespace cfg;
    constexpr int l = L, j = L / 3;
    if (L > 0) { fold_sample_rows(c.x, f.slab, KS_FFN, GW_NOW(), NGW_NOW(), LANE_NOW()); GBAR(); }
    DUP(9, rw_mix_fast(c, fr, l, GW_NOW(), NGW_NOW(), LANE_NOW(), L == 0 ? c.in[I_XP] : nullptr));
    GBAR();
    DUP(7, { pg8::Order<RwSel> S; S.init(MP / 256, MS / 256, 16, D, 1, gridDim.x, blockIdx.x);
      pg8::gemm_phase(lds, pg8::Gemm{fr.xm, fr.wrkvt + (size_t)j * 4096 * D, D, D, (size_t)MTOT * D}, S, EpiRwkv{fr.rkv, fr.hb}); });
    GBAR();
    DUP(2, rw_scan_chunked<j>(c, fr, lds));
    GBAR();
    { pg8::Order<> S; S.init(MP / 256, MS / 256, 4, D, KS_1K, gridDim.x, blockIdx.x);
      pg8::gemm_phase(lds, pg8::Gemm{fr.yo, fr.wot + (size_t)j * D * D, D, D, 0}, S, pg8::EpiAccF32{c.x, D, f.slab, MP / 256, MS / 256, KS_1K, L == 0 ? c.in[I_XP] : nullptr}); }
    if (PROBE_DUP & (1 << 26)) { GBAR(); pg8::Order<> S; S.init(MP / 256, MS / 256, 4, D, KS_1K, gridDim.x, blockIdx.x);
      pg8::gemm_phase(lds, pg8::Gemm{fr.yo, fr.wot + (size_t)j * D * D, D, D, 0}, S, pg8::EpiAccF32{c.hmid, D, f.slab + (size_t)16 * 16 * 65536, MP / 256, MS / 256, KS_1K}); }
    GBAR();
}

__device__ __forceinline__ void layer_mamba_fast(const Ctx& c, const Fast& f, const FastMb& fb, const XcdBarrier& bar, LDSP unsigned char* lds) {
    using namespace cfg;
    constexpr int l = 2, j = 0;
    norm_rows_bf16(c.x, c.in[I_NMIX] + l * D, f.xnb, f.slab, KS_FFN, GW_NOW(), NGW_NOW(), LANE_NOW());
    GBAR();
    DUP(8, { pg8::Order<> S; S.init(MP / 256, MS / 256, 21, D, 1, gridDim.x, blockIdx.x);
      pg8::gemm_phase(lds, pg8::Gemm{f.xnb, fb.wbint, D, D, 0}, S, EpiMamba{fb.zb, fb.xbcr, fb.dtraw}); });
    GBAR();
    DUP(12, mb_conv_fast(c, fb, l, GTID_NOW(), GSZ_NOW(), false));
    GBAR();
    DUP(6, mb_ssd_prompt(c, fb, l, lds); mb_scan_sample(c, fb, l));
    GBAR();
    DUP(13, mb_gate_fast(c, fb, fb.y, l, GW_NOW(), NGW_NOW(), LANE_NOW()));
    GBAR();
    { pg8::Order<> S; S.init(MP / 256, MS / 256, 4, MB_INNER, KS_MB, gridDim.x, blockIdx.x);
      pg8::gemm_phase(lds, pg8::Gemm{fb.yzn, fb.wbot, MB_INNER, MB_INNER, 0}, S, pg8::EpiAccF32{c.x, D, f.slab, MP / 256, MS / 256, KS_MB}); }
    if (PROBE_DUP & (1 << 28)) { GBAR(); pg8::Order<> S; S.init(MP / 256, MS / 256, 4, MB_INNER, KS_MB, gridDim.x, blockIdx.x);
      pg8::gemm_phase(lds, pg8::Gemm{fb.yzn, fb.wbot, MB_INNER, MB_INNER, 0}, S, pg8::EpiAccF32{c.hmid, D, f.slab + (size_t)16 * 16 * 65536, MP / 256, MS / 256, KS_MB}); }
    GBAR();
}

__device__ __forceinline__ void layer_mla_fast(const Ctx& c, const Fast& f, const FastMla& fm, const XcdBarrier& bar, LDSP unsigned char* lds) {
    using namespace cfg;
    constexpr int l = 1, j = 0;
    norm_rows_bf16(c.x, c.in[I_NMIX] + l * D, f.xnb, f.slab, KS_FFN, GW_NOW(), NGW_NOW(), LANE_NOW());
    GBAR();
    DUP(27, { pg8::Order<> S; S.init(MP / 256, MS / 256, 4, D, 1, gridDim.x, blockIdx.x);
      pg8::gemm_phase(lds, pg8::Gemm{f.xnb, fm.wint, D, D, 0}, S, pg8::EpiF32{fm.mh, 1024, 1024}); });
    GBAR();
    DUP(14, mla_norm1_fast(c, fm, j, GW_NOW(), NGW_NOW(), LANE_NOW()));
    GBAR();
    DUP(27, { pg8::Order<> S; S.init(MP / 256, MS / 256, (MH * QD) / 256, QL, 1, gridDim.x, blockIdx.x);
      pg8::gemm_phase(lds, pg8::Gemm{fm.qan, fm.wuqt, QL, QL, 0}, S, pg8::EpiBf16<0>{fm.qraw, MH * QD}); }
    { pg8::Order<> S; S.init(MP / 256, MS / 256, 4, KVL, 1, gridDim.x, blockIdx.x);
      pg8::gemm_phase(lds, pg8::Gemm{fm.cb, fm.wukvt, KVL, KVL, 0}, S, pg8::EpiBf16<0>{fm.kvraw, 2048}); }
    { pg8::Order<> S; S.init(4, 0, MTOT / 256, KVL, 1, gridDim.x, blockIdx.x);
      pg8::gemm_phase(lds, pg8::Gemm{fm.wukvt + (size_t)1024 * KVL, fm.cb, KVL, KVL, 0}, S, pg8::EpiBf16<0>{fm.vT, MTOT}); });
    GBAR();
    DUP(15, mla_norm2_fast(c, fm, j, GW_NOW(), NGW_NOW(), LANE_NOW()));
    { const unsigned t_ = (unsigned)GTID_NOW(); if (t_ < 96) *(pg8::u32x4*)(fm.qs + (size_t)MS * 1536 + t_ * 8) = (pg8::u32x4){0u, 0u, 0u, 0u}; }
    GBAR();
    DUP(5, attn_prompt_fast(fm.qf, fm.knb, fm.kpb, fm.vT, fm.aob, lds));
    __syncthreads();
    DUP(4, mla_sample_decode(c, fm, fm.qs, fm.opart, fm.lpart, j, lds));
    GBAR();
    DUP(16, mla_sample_combine(c, fm, fm.opart, fm.lpart, j, lds));
    GBAR();
    { pg8::Order<> S; S.init(MP / 256, MS / 256, 4, D, KS_1K, gridDim.x, blockIdx.x);
      pg8::gemm_phase(lds, pg8::Gemm{fm.aob, fm.wot, D, D, 0}, S, pg8::EpiAccF32{c.x, D, f.slab, MP / 256, MS / 256, KS_1K}); }
    if (PROBE_DUP & (1 << 27)) { GBAR(); pg8::Order<> S; S.init(MP / 256, MS / 256, 4, D, KS_1K, gridDim.x, blockIdx.x);
      pg8::gemm_phase(lds, pg8::Gemm{fm.aob, fm.wot, D, D, 0}, S, pg8::EpiAccF32{c.hmid, D, f.slab + (size_t)16 * 16 * 65536, MP / 256, MS / 256, KS_1K}); }
    GBAR();
}

template <int L>
__device__ __forceinline__ void layer_ffn_fast(const Ctx& c, const Fast& f, const XcdBarrier& bar, LDSP unsigned char* lds) {
    using namespace cfg;
    norm_rows_bf16(c.x, c.in[I_NFFN] + L * D, f.xnb, f.slab, (L % 3 == 2) ? KS_MB : KS_1K, GW_NOW(), NGW_NOW(), LANE_NOW());
    GBAR();
    DUP(0, { pg8::Order<> S; S.init(MP / 256, MS / 256, FFN / 256, D, 1, gridDim.x, blockIdx.x);
      pg8::gemm_phase(lds, pg8::Gemm{f.xnb, f.w1t + (size_t)L * FFN * D, D, D, 0}, S, pg8::EpiBf16<3>{f.hmidb, FFN}); });
    GBAR();
    { pg8::Order<> S; S.init(MP / 256, MS / 256, D / 256, FFN, (L == DEPTH - 1) ? 1 : KS_FFN, gridDim.x, blockIdx.x);
      pg8::gemm_phase(lds, pg8::Gemm{f.hmidb, f.w2t + (size_t)L * D * FFN, FFN, FFN, 0}, S, pg8::EpiAccF32{c.x, D, f.slab, MP / 256, MS / 256, (L == DEPTH - 1) ? 1 : KS_FFN}); }
    if (PROBE_DUP & (1 << 25)) { GBAR(); pg8::Order<> S; S.init(MP / 256, MS / 256, D / 256, FFN, (L == DEPTH - 1) ? 1 : KS_FFN, gridDim.x, blockIdx.x);
      pg8::gemm_phase(lds, pg8::Gemm{f.hmidb, f.w2t + (size_t)L * D * FFN, FFN, FFN, 0}, S, pg8::EpiAccF32{c.hmid, D, f.slab + (size_t)16 * 16 * 65536, MP / 256, MS / 256, (L == DEPTH - 1) ? 1 : KS_FFN}); }
    GBAR();
}

__global__ void __launch_bounds__(512, 2) mega10(MegaArgs a) {
    LDSP unsigned char* lds = (LDSP unsigned char*)dynlds;
    if (threadIdx.x < 4) ((LDSP unsigned*)(lds + LDS_XB))[threadIdx.x] = 0u;
    __syncthreads();
    XcdBarrier bar = xcd_barrier_post(a.bar, (volatile LAS unsigned*)(lds + LDS_XB));
    const Ctx& c = a.c; const Fast& f = a.f; const FastMla& fm = a.fm; const FastRw& fr = a.fr; const FastMb& fb = a.fb;
    using namespace cfg;
    DUP(10, {
        LDSP float* scr = (LDSP float*)(lds + LDS_STAGE) + (tid_now() >> 6) * (64 * 33);
        for (int l = 0; l < DEPTH; ++l) {
            tr_weight(c.in[I_FW1] + (size_t)l * D * FFN, D, FFN, FFN, f.w1t + (size_t)l * FFN * D, nullptr, scr, GW_NOW(), NGW_NOW(), LANE_NOW());
            tr_weight(c.in[I_FW2] + (size_t)l * FFN * D, FFN, D, D, f.w2t + (size_t)l * D * FFN, nullptr, scr, GW_NOW(), NGW_NOW(), LANE_NOW());
        }
        tr_weight(c.in[I_MWIN], D, MLA_IN, 1024, fm.wint, nullptr, scr, GW_NOW(), NGW_NOW(), LANE_NOW());
        tr_weight(c.in[I_WUQ], QL, MH * QD, MH * QD, fm.wuqt, nullptr, scr, GW_NOW(), NGW_NOW(), LANE_NOW());
        tr_weight(c.in[I_WUK], KVL, MH * NOPE, MH * NOPE, fm.wukvt, nullptr, scr, GW_NOW(), NGW_NOW(), LANE_NOW());
        tr_weight(c.in[I_WUV], KVL, MH * VD, MH * VD, fm.wukvt + (size_t)1024 * KVL, nullptr, scr, GW_NOW(), NGW_NOW(), LANE_NOW());
        tr_weight(c.in[I_MWO], MH * VD, D, D, fm.wot, nullptr, scr, GW_NOW(), NGW_NOW(), LANE_NOW());
        for (int j = 0; j < N_RWKV; ++j) {
            bf16_t* wt = fr.wrkvt + (size_t)j * 4096 * D;
            for (int p = 0; p < 3; ++p) tr_weight(c.in[I_WRKV] + ((size_t)j * 3 + p) * D * D, D, D, D, wt + (size_t)p * D * D, nullptr, scr, GW_NOW(), NGW_NOW(), LANE_NOW());
            tr_weight(c.in[I_W1] + (size_t)j * D * RW_DL, D, RW_DL, 256, wt + (size_t)3072 * D, nullptr, scr, GW_NOW(), NGW_NOW(), LANE_NOW());
            tr_weight(c.in[I_A1] + (size_t)j * D * RW_AL, D, RW_AL, 256, wt + (size_t)3328 * D, nullptr, scr, GW_NOW(), NGW_NOW(), LANE_NOW());
            tr_weight(c.in[I_G1] + (size_t)j * D * RW_GL, D, RW_GL, 256, wt + (size_t)3584 * D, nullptr, scr, GW_NOW(), NGW_NOW(), LANE_NOW());
            tr_weight(j > 0 ? c.in[I_V1] + (size_t)(j - 1) * D * RW_VL : c.in[I_W1], D, j > 0 ? RW_VL : 0, 256, wt + (size_t)3840 * D, nullptr, scr, GW_NOW(), NGW_NOW(), LANE_NOW());
            tr_weight(c.in[I_RWO] + (size_t)j * D * D, D, D, D, fr.wot + (size_t)j * D * D, nullptr, scr, GW_NOW(), NGW_NOW(), LANE_NOW());
            rw_build_lorat(c, fr.lorat + (size_t)j * 4096 * 384, j, GTID_NOW(), GSZ_NOW());
        }
        tr_weight(c.in[I_BWIN], D, MB_IN, 5376, fb.wbint, nullptr, scr, GW_NOW(), NGW_NOW(), LANE_NOW());
        tr_weight(c.in[I_BWO], MB_INNER, D, D, fb.wbot, nullptr, scr, GW_NOW(), NGW_NOW(), LANE_NOW());
        { const size_t np4 = (size_t)MP * D / 4, nt4 = (size_t)MTOT * D / 4;
          for (size_t i = np4 + GTID_NOW(); i < nt4; i += GSZ_NOW()) ((pg8::f32x4*)c.x)[i] = ((const pg8::f32x4*)c.in[I_XS])[i - np4]; }
    });
    GBAR();
    layer_rwkv_fast<0>(c, f, fr, bar, lds); layer_ffn_fast<0>(c, f, bar, lds);
    layer_mla_fast(c, f, fm, bar, lds); layer_ffn_fast<1>(c, f, bar, lds);
    layer_mamba_fast(c, f, fb, bar, lds); layer_ffn_fast<2>(c, f, bar, lds);
    layer_rwkv_fast<3>(c, f, fr, bar, lds); layer_ffn_fast<3>(c, f, bar, lds);
}

extern "C" void kernel_launch(void* const* d_in, const int* in_sizes, int n_in, void* d_out, int out_size, void* d_ws, size_t ws_size, hipStream_t stream) {
    using namespace cfg;
    MegaArgs a{};
    size_t used = setup_ctx(a.c, d_in, d_out, d_ws);
    { Bump b{(char*)d_ws, (size_t)((char*)a.c.xm[0] - (char*)d_ws)}; FastRw& r = a.fr;
      r.xm = (bf16_t*)b.f((size_t)6 * MTOT * D / 2); r.rkv = (bf16_t*)b.f((size_t)MTOT * 3072 / 2); r.hb = (bf16_t*)b.f((size_t)MTOT * 384 / 2); r.lu = (bf16_t*)b.f((size_t)MTOT * 4096 / 2);
      r.ops = b.f((size_t)MTOT * RHEADS * RW_REC + 4096); r.yo = (bf16_t*)b.f((size_t)MTOT * D / 2); r.vf = a.c.vf;
      if (b.off > (size_t)((char*)a.c.hmid - (char*)d_ws) + (size_t)MTOT * FFN * 4) { fprintf(stderr, "RWKV overlay too large\n"); return; } }
    { Bump b{(char*)d_ws, used};
      a.f.xnb = (bf16_t*)b.f((size_t)MTOT * D / 2); a.f.hmidb = (bf16_t*)b.f((size_t)MTOT * FFN / 2);
      a.f.w1t = (bf16_t*)b.f((size_t)DEPTH * FFN * D / 2); a.f.w2t = (bf16_t*)b.f((size_t)DEPTH * FFN * D / 2); a.f.slab = b.f((size_t)2 * 16 * 16 * 65536);
      FastMla& m = a.fm;
      m.mh = b.f((size_t)MTOT * 1024); m.qan = (bf16_t*)b.f((size_t)MTOT * QL / 2); m.cb = (bf16_t*)b.f((size_t)MTOT * KVL / 2); m.kpb = (bf16_t*)b.f((size_t)MTOT * ROPE / 2);
      m.qraw = (bf16_t*)b.f((size_t)MTOT * 1536 / 2); m.kvraw = (bf16_t*)b.f((size_t)MTOT * 2048 / 2); m.qf = (bf16_t*)b.f((size_t)MTOT * 1536 / 2); m.knb = (bf16_t*)b.f((size_t)MTOT * 1024 / 2);
      m.aob = (bf16_t*)b.f((size_t)MTOT * 1024 / 2); m.vT = (bf16_t*)b.f((size_t)MTOT * 1024 / 2); m.qs = (bf16_t*)b.f((size_t)MS * 1536 / 2 + 1024);
      m.opart = b.f((size_t)2 * DB * 128 * 256); m.lpart = b.f((size_t)2 * DB * 128);
      m.wint = (bf16_t*)b.f((size_t)1024 * 1024 / 2); m.wuqt = (bf16_t*)b.f((size_t)1536 * 512 / 2); m.wukvt = (bf16_t*)b.f((size_t)2048 * 256 / 2); m.wot = (bf16_t*)b.f((size_t)1024 * 1024 / 2);
      { FastMb& q = a.fb; q.zb = (bf16_t*)b.f((size_t)MTOT * 2048 / 2); q.xbcr = (bf16_t*)b.f((size_t)MTOT * 3072 / 2); q.dtraw = b.f((size_t)MTOT * 32); q.xbcb = (bf16_t*)b.f((size_t)MTOT * 3072 / 2);
        q.dt = b.f((size_t)MTOT * 32); q.y = a.c.my; q.yzn = (bf16_t*)b.f((size_t)MTOT * 2048 / 2); q.wbint = (bf16_t*)b.f((size_t)5376 * 1024 / 2); q.wbot = (bf16_t*)b.f((size_t)1024 * 2048 / 2); }
      a.fr.wrkvt = (bf16_t*)b.f((size_t)N_RWKV * 4096 * D / 2); a.fr.lorat = (bf16_t*)b.f((size_t)N_RWKV * 4096 * 384 / 2); a.fr.wot = (bf16_t*)b.f((size_t)N_RWKV * D * D / 2);
      used = b.off; }
    if (used > ws_size || n_in != 51) { fprintf(stderr, "workspace too small: need %zu have %zu (n_in %d)\n", used, ws_size, n_in); return; }
    a.bar = (unsigned*)d_ws;
    static int grid = 0;
    if (!grid) {
        int dev = 0, cus = 0, per_cu = 0;
        (void)hipGetDevice(&dev); (void)hipDeviceGetAttribute(&cus, hipDeviceAttributeMultiprocessorCount, dev);
        if (hipFuncSetAttribute((const void*)mega10, hipFuncAttributeMaxDynamicSharedMemorySize, LDS_BYTES) != hipSuccess) { fprintf(stderr, "hipFuncSetAttribute failed\n"); grid = -1; return; }
        (void)hipOccupancyMaxActiveBlocksPerMultiprocessor(&per_cu, (const void*)mega10, 512, LDS_BYTES);
        (void)hipGetLastError();
        grid = per_cu >= 1 ? (cus < 256 ? cus : 256) : -1;
    }
    if (grid <= 0) { fprintf(stderr, "kernel does not fit one workgroup per CU\n"); return; }
    (void)hipMemsetAsync(a.bar, 0, XCD_BAR_WORDS * sizeof(unsigned), stream);
    hipLaunchKernelGGL(mega10, dim3(grid), dim3(512), LDS_BYTES, stream, a);
}
```

```cpp
#include <hip/hip_runtime.h>
#include <cstdio>
#include <math.h>
#include <stdint.h>
#include <stddef.h>
#ifdef CPU_EMU
#define DEV inline
#else
#define DEV __device__ __forceinline__
#endif

namespace cfg {
#ifdef CFG_SMALL
constexpr int D = 128, BATCH = 2, SEQ = 32, DEPTH = 4, DB = 3, DS = 8, PAST = 64, PAGE = 16;
constexpr int RW_DL = 16, RW_AL = 16, RW_VL = 8, RW_GL = 24;
constexpr int MH = 2, QL = 64, KVL = 32;
constexpr int MB_GROUPS = 2;
#else
constexpr int D = 1024, BATCH = 16, SEQ = 2048, DEPTH = 4, DB = 128, DS = 8, PAST = 8192, PAGE = 128;
constexpr int RW_DL = 64, RW_AL = 64, RW_VL = 32, RW_GL = 160;
constexpr int MH = 16, QL = 512, KVL = 256;
constexpr int MB_GROUPS = 4;
#endif
constexpr int N_RWKV = (DEPTH + 2) / 3, N_MLA = (DEPTH + 1) / 3, N_MAMBA = DEPTH / 3;
constexpr int RH = 64, RHEADS = D / RH;
constexpr int NOPE = 64, ROPE = 32, VD = 64, QD = NOPE + ROPE;
constexpr int MLA_IN = QL + KVL + ROPE;
constexpr int MB_INNER = 2 * D, MB_HEAD = 64, MB_HEADS = MB_INNER / MB_HEAD, MB_STATE = 128, MB_CONV = 4;
constexpr int MB_GN = MB_GROUPS * MB_STATE;
constexpr int MB_CD = MB_INNER + 2 * MB_GN, MB_IN = MB_INNER + MB_CD + MB_HEADS;
constexpr int FFN = 4 * D;
constexpr int NPAGES = PAST / PAGE, NPOOL = (DB * NPAGES * 5) / 4;
constexpr int MP = BATCH * SEQ, MS = DB * DS, MTOT = MP + MS, NSEQ = BATCH + DB;
constexpr int KTOT = PAST + DS;
constexpr float NORM_EPS = 1e-6f, LNX_EPS = 64e-5f;
constexpr size_t O_YP = 0;
constexpr size_t O_YS = O_YP + (size_t)MP * D;
constexpr size_t O_CKVP = O_YS + (size_t)MS * D;
constexpr size_t O_KPEP = O_CKVP + (size_t)N_MLA * MP * KVL;
constexpr size_t O_CKVS = O_KPEP + (size_t)N_MLA * MP * ROPE;
constexpr size_t O_KPES = O_CKVS + (size_t)N_MLA * MS * KVL;
constexpr size_t O_WKVP = O_KPES + (size_t)N_MLA * MS * ROPE;
constexpr size_t O_SHP = O_WKVP + (size_t)N_RWKV * BATCH * RHEADS * RH * RH;
constexpr size_t O_WKVS = O_SHP + (size_t)N_RWKV * BATCH * D;
constexpr size_t O_SHS = O_WKVS + (size_t)N_RWKV * DB * RHEADS * RH * RH;
constexpr size_t O_SSMP = O_SHS + (size_t)N_RWKV * DB * D;
constexpr size_t O_CONVP = O_SSMP + (size_t)N_MAMBA * BATCH * MB_HEADS * MB_HEAD * MB_STATE;
constexpr size_t O_SSMS = O_CONVP + (size_t)N_MAMBA * BATCH * (MB_CONV - 1) * MB_CD;
constexpr size_t O_CONVS = O_SSMS + (size_t)N_MAMBA * DB * MB_HEADS * MB_HEAD * MB_STATE;
constexpr size_t O_END = O_CONVS + (size_t)N_MAMBA * DB * (MB_CONV - 1) * MB_CD;
}

struct Ctx {
    const float* in[51];
    const int* page_table;
    float* out;
    float *x, *xn, *vf;
    float* xm[6];
    float *r, *k, *v, *wpre, *apre, *vpre, *g, *hw, *ha, *hv, *hg, *ka, *kb, *y, *yo;
    float *hmid;
    float *mh, *qan, *q, *c, *kp, *knr, *vv, *ao, *sc, *olat;
    float *zx, *xbc, *dt, *my, *yzn;
};

DEV int row_t(int m) { return m < cfg::MP ? m % cfg::SEQ : (m - cfg::MP) % cfg::DS; }
DEV int row_seq(int m) { return m < cfg::MP ? m / cfg::SEQ : cfg::BATCH + (m - cfg::MP) / cfg::DS; }
DEV int seq_row0(int sq) { return sq < cfg::BATCH ? sq * cfg::SEQ : cfg::MP + (sq - cfg::BATCH) * cfg::DS; }
DEV int seq_len(int sq) { return sq < cfg::BATCH ? cfg::SEQ : cfg::DS; }
DEV float sigmoidf_(float x) { return 1.0f / (1.0f + expf(-x)); }
DEV float softplusf_(float x) { return x > 20.f ? x : log1pf(expf(x)); }
DEV float siluf_(float x) { return x * sigmoidf_(x); }

enum { I_XP = 0, I_XS, I_CKV, I_KPE, I_WKV, I_SHIFT, I_SSM, I_CONV, I_PT, I_NMIX, I_NFFN, I_FW1, I_FW2, I_MU, I_WRKV, I_W0, I_W1, I_W2, I_A0, I_A1, I_A2,
       I_V0, I_V1, I_V2, I_G1, I_G2, I_KK, I_KA, I_RK, I_LNW, I_LNB, I_RWO, I_MWIN, I_QNORM, I_KVNORM, I_WUQ, I_WUK, I_WUV, I_QNN, I_QRN, I_KNN, I_KRN, I_MWO,
       I_BWIN, I_CONVW, I_CONVB, I_DTB, I_ALOG, I_BD, I_BNORM, I_BWO };

#define UNROLL _Pragma("unroll")
#define GSL(i, n) for (size_t i = gtid; i < (size_t)(n); i += gsz)

DEV void ph_copy_x(const Ctx& c, int, size_t gtid, size_t gsz) {
    using namespace cfg;
    GSL(i, (size_t)MTOT * D) c.x[i] = i < (size_t)MP * D ? c.in[I_XP][i] : c.in[I_XS][i - (size_t)MP * D];
}
DEV void rmsnorm_rows(const float* x, const float* gain, float* xn, size_t gtid, size_t gsz) {
    using namespace cfg;
    GSL(m, MTOT) {
        const float* xr = x + m * D; float ss = 0.f;
        for (int i = 0; i < D; ++i) ss += xr[i] * xr[i];
        const float rs = 1.0f / sqrtf(ss / D + NORM_EPS);
        for (int i = 0; i < D; ++i) xn[m * D + i] = xr[i] * rs * gain[i];
    }
}
DEV void ph_norm_mix(const Ctx& c, int l, size_t gtid, size_t gsz) { rmsnorm_rows(c.x, c.in[I_NMIX] + l * cfg::D, c.xn, gtid, gsz); }
DEV void ph_norm_ffn(const Ctx& c, int l, size_t gtid, size_t gsz) { rmsnorm_rows(c.x, c.in[I_NFFN] + l * cfg::D, c.xn, gtid, gsz); }

DEV void ph_rw_mix(const Ctx& c, int l, size_t gtid, size_t gsz) {
    using namespace cfg; const int j = l / 3;
    GSL(i, (size_t)MTOT * D) {
        const int m = (int)(i / D), ch = (int)(i % D), t = row_t(m), sq = row_seq(m);
        const float xc = c.xn[i];
        float xp;
        if (t > 0) xp = c.xn[i - D];
        else xp = sq < BATCH ? 0.f : c.in[I_SHIFT][((size_t)j * DB + (sq - BATCH)) * D + ch];
        for (int p = 0; p < 6; ++p) c.xm[p][i] = xc + (xp - xc) * c.in[I_MU][((size_t)j * 6 + p) * D + ch];
        if (t == seq_len(sq) - 1) {
            if (sq < BATCH) c.out[O_SHP + ((size_t)j * BATCH + sq) * D + ch] = xc;
            else c.out[O_SHS + ((size_t)j * DB + (sq - BATCH)) * D + ch] = xc;
        }
    }
}
DEV void ph_rw_prep(const Ctx& c, int l, size_t gtid, size_t gsz) {
    using namespace cfg; const int j = l / 3;
    GSL(i, (size_t)MTOT * RHEADS) {
        const int m = (int)(i / RHEADS), h = (int)(i % RHEADS);
        const size_t o = (size_t)m * D + h * RH;
        float nn = 0.f;
        for (int e = 0; e < RH; ++e) { const float kk = c.k[o + e] * c.in[I_KK][j * D + h * RH + e]; nn += kk * kk; }
        const float inv = 1.0f / fmaxf(sqrtf(nn), 1e-12f);
        for (int e = 0; e < RH; ++e) {
            const int ch = h * RH + e;
            const float wl = -softplusf_(-(c.in[I_W0][j * D + ch] + c.wpre[o + e])) - 0.5f;
            const float decay = expf(-expf(wl));
            float vv = c.v[o + e];
            if (j == 0) c.vf[o + e] = vv;
            else vv = vv + (c.vf[o + e] - vv) * sigmoidf_(c.in[I_V0][(j - 1) * D + ch] + c.vpre[o + e]);
            const float a = sigmoidf_(c.in[I_A0][j * D + ch] + c.apre[o + e]);
            const float k0 = c.k[o + e];
            const float kk = k0 * c.in[I_KK][j * D + ch] * inv;
            c.k[o + e] = k0 * (1.0f + (a - 1.0f) * c.in[I_KA][j * D + ch]);
            c.v[o + e] = vv;
            c.wpre[o + e] = decay;
            c.ka[o + e] = -kk;
            c.kb[o + e] = kk * a;
        }
    }
}
DEV void ph_rw_scan(const Ctx& c, int l, size_t gtid, size_t gsz) {
    using namespace cfg; const int j = l / 3;
    GSL(i, (size_t)NSEQ * RHEADS * RH) {
        const int sq = (int)(i / (RHEADS * RH)), h = (int)(i / RH) % RHEADS, vi = (int)(i % RH);
        float S[RH];
        if (sq < BATCH) { UNROLL for (int e = 0; e < RH; ++e) S[e] = 0.f; }
        else { const float* s0 = c.in[I_WKV] + ((((size_t)j * DB + (sq - BATCH)) * RHEADS + h) * RH + vi) * RH; UNROLL for (int e = 0; e < RH; ++e) S[e] = s0[e]; }
        const int m0 = seq_row0(sq), T = seq_len(sq);
        for (int t = 0; t < T; ++t) {
            const size_t o = (size_t)(m0 + t) * D + h * RH;
            float sa = 0.f;
            UNROLL for (int e = 0; e < RH; ++e) sa += S[e] * c.ka[o + e];
            const float vt = c.v[o + vi]; float yy = 0.f;
            UNROLL for (int e = 0; e < RH; ++e) { S[e] = S[e] * c.wpre[o + e] + sa * c.kb[o + e] + vt * c.k[o + e]; yy += S[e] * c.r[o + e]; }
            c.y[o + vi] = yy;
        }
        float* so = sq < BATCH ? c.out + O_WKVP + ((((size_t)j * BATCH + sq) * RHEADS + h) * RH + vi) * RH
                               : c.out + O_WKVS + ((((size_t)j * DB + (sq - BATCH)) * RHEADS + h) * RH + vi) * RH;
        UNROLL for (int e = 0; e < RH; ++e) so[e] = S[e];
    }
}
DEV void ph_rw_post(const Ctx& c, int l, size_t gtid, size_t gsz) {
    using namespace cfg; const int j = l / 3;
    GSL(i, (size_t)MTOT * RHEADS) {
        const int m = (int)(i / RHEADS), h = (int)(i % RHEADS);
        const size_t o = (size_t)m * D + h * RH;
        float mean = 0.f; for (int e = 0; e < RH; ++e) mean += c.y[o + e]; mean /= RH;
        float var = 0.f; for (int e = 0; e < RH; ++e) { const float d = c.y[o + e] - mean; var += d * d; } var /= RH;
        const float rs = 1.0f / sqrtf(var + LNX_EPS);
        float bonus = 0.f; for (int e = 0; e < RH; ++e) bonus += c.r[o + e] * c.k[o + e] * c.in[I_RK][(size_t)j * D + h * RH + e];
        for (int e = 0; e < RH; ++e) {
            const int ch = h * RH + e;
            const float yn = (c.y[o + e] - mean) * rs * c.in[I_LNW][j * D + ch] + c.in[I_LNB][j * D + ch];
            c.yo[o + e] = (yn + bonus * c.v[o + e]) * c.g[o + e];
        }
    }
}

DEV void rope_apply(const float* xin, float* xout, int pos) {
    using namespace cfg; const int half = ROPE / 2;
    UNROLL for (int i = 0; i < half; ++i) {
        const float inv = exp2f(-(float)i * (13.287712379549449f / half));
        const float ang = (float)pos * inv;
        const float kq = rintf(ang * 0.15915494309189535f);
        float rr = fmaf(-kq, 6.28125f, ang); rr = fmaf(-kq, 1.9353071795864769e-3f, rr);
        const float cs = __cosf(rr), sn = __sinf(rr);
        const float x1 = xin[i], x2 = xin[i + half];
        xout[i] = x1 * cs - x2 * sn; xout[i + half] = x2 * cs + x1 * sn;
    }
}
DEV int row_pos(int m) { return m < cfg::MP ? m % cfg::SEQ : cfg::PAST + (m - cfg::MP) % cfg::DS; }
DEV void ph_mla_norm1(const Ctx& c, int l, size_t gtid, size_t gsz) {
    using namespace cfg; const int j = l / 3;
    GSL(m, MTOT) {
        const float* h = c.mh + m * MLA_IN;
        float ss = 0.f; for (int i = 0; i < QL; ++i) ss += h[i] * h[i];
        float rs = 1.0f / sqrtf(ss / QL + NORM_EPS);
        for (int i = 0; i < QL; ++i) c.qan[m * QL + i] = h[i] * rs * c.in[I_QNORM][j * QL + i];
        ss = 0.f; for (int i = 0; i < KVL; ++i) ss += h[QL + i] * h[QL + i];
        rs = 1.0f / sqrtf(ss / KVL + NORM_EPS);
        float* co = m < (size_t)MP ? c.out + O_CKVP + ((size_t)j * MP + m) * KVL : c.out + O_CKVS + ((size_t)j * MS + (m - MP)) * KVL;
        for (int i = 0; i < KVL; ++i) { const float v = h[QL + i] * rs * c.in[I_KVNORM][j * KVL + i]; c.c[m * KVL + i] = v; co[i] = v; }
        ss = 0.f; UNROLL for (int i = 0; i < ROPE; ++i) ss += h[QL + KVL + i] * h[QL + KVL + i];
        rs = 1.0f / sqrtf(ss / ROPE + NORM_EPS);
        float tmp[ROPE], ro[ROPE];
        UNROLL for (int i = 0; i < ROPE; ++i) tmp[i] = h[QL + KVL + i] * rs * c.in[I_KRN][j * ROPE + i];
        rope_apply(tmp, ro, row_pos((int)m));
        float* ko = m < (size_t)MP ? c.out + O_KPEP + ((size_t)j * MP + m) * ROPE : c.out + O_KPES + ((size_t)j * MS + (m - MP)) * ROPE;
        UNROLL for (int i = 0; i < ROPE; ++i) { c.kp[m * ROPE + i] = ro[i]; ko[i] = ro[i]; }
    }
}
DEV void ph_mla_norm2(const Ctx& c, int l, size_t gtid, size_t gsz) {
    using namespace cfg; const int j = l / 3;
    GSL(i, (size_t)MTOT * MH) {
        const int m = (int)(i / MH), h = (int)(i % MH);
        float* q = c.q + (size_t)m * MH * QD + h * QD;
        float ss = 0.f; UNROLL for (int e = 0; e < NOPE; ++e) ss += q[e] * q[e];
        float rs = 1.0f / sqrtf(ss / NOPE + NORM_EPS);
        UNROLL for (int e = 0; e < NOPE; ++e) q[e] = q[e] * rs * c.in[I_QNN][j * NOPE + e];
        ss = 0.f; UNROLL for (int e = 0; e < ROPE; ++e) ss += q[NOPE + e] * q[NOPE + e];
        rs = 1.0f / sqrtf(ss / ROPE + NORM_EPS);
        float tmp[ROPE], ro[ROPE];
        UNROLL for (int e = 0; e < ROPE; ++e) tmp[e] = q[NOPE + e] * rs * c.in[I_QRN][j * ROPE + e];
        rope_apply(tmp, ro, row_pos(m));
        UNROLL for (int e = 0; e < ROPE; ++e) q[NOPE + e] = ro[e];
        float* kn = c.knr + (size_t)m * MH * NOPE + h * NOPE;
        ss = 0.f; UNROLL for (int e = 0; e < NOPE; ++e) ss += kn[e] * kn[e];
        rs = 1.0f / sqrtf(ss / NOPE + NORM_EPS);
        UNROLL for (int e = 0; e < NOPE; ++e) kn[e] = kn[e] * rs * c.in[I_KNN][j * NOPE + e];
    }
}
DEV void ph_mla_attn_prompt(const Ctx& c, int, size_t gtid, size_t gsz) {
    using namespace cfg; const float scale = 1.0f / sqrtf((float)QD);
    GSL(i, (size_t)MP * MH) {
        const int m = (int)(i / MH), h = (int)(i % MH), t = m % SEQ, m0 = m - t;
        const float* q = c.q + (size_t)m * MH * QD + h * QD;
        float mx = -INFINITY, den = 0.f, acc[VD];
        UNROLL for (int e = 0; e < VD; ++e) acc[e] = 0.f;
        for (int kx = 0; kx <= t; ++kx) {
            const int mk = m0 + kx;
            const float* kn = c.knr + (size_t)mk * MH * NOPE + h * NOPE; const float* kp = c.kp + (size_t)mk * ROPE;
            float s = 0.f;
            UNROLL for (int e = 0; e < NOPE; ++e) s += q[e] * kn[e];
            UNROLL for (int e = 0; e < ROPE; ++e) s += q[NOPE + e] * kp[e];
            s *= scale;
            const float nm = fmaxf(mx, s), corr = expf(mx - nm), p = expf(s - nm);
            den = den * corr + p;
            const float* v = c.vv + (size_t)mk * MH * VD + h * VD;
            UNROLL for (int e = 0; e < VD; ++e) acc[e] = acc[e] * corr + p * v[e];
            mx = nm;
        }
        UNROLL for (int e = 0; e < VD; ++e) c.ao[(size_t)m * MH * VD + h * VD + e] = acc[e] / den;
    }
}
DEV const float* smp_c(const Ctx& c, int j, int s, int pos) {
    using namespace cfg;
    if (pos < PAST) { const int pg = c.page_table[s * NPAGES + pos / PAGE]; return c.in[I_CKV] + (((size_t)j * NPOOL + pg) * PAGE + pos % PAGE) * KVL; }
    return c.c + (size_t)(MP + s * DS + (pos - PAST)) * KVL;
}
DEV const float* smp_kp(const Ctx& c, int j, int s, int pos) {
    using namespace cfg;
    if (pos < PAST) { const int pg = c.page_table[s * NPAGES + pos / PAGE]; return c.in[I_KPE] + (((size_t)j * NPOOL + pg) * PAGE + pos % PAGE) * ROPE; }
    return c.kp + (size_t)(MP + s * DS + (pos - PAST)) * ROPE;
}
DEV void ph_mla_score_sample(const Ctx& c, int l, size_t gtid, size_t gsz) {
    using namespace cfg; const int j = l / 3; const float scale = 1.0f / sqrtf((float)QD);
    GSL(i, (size_t)DB * KTOT * MH) {
        const int pos = (int)(i % KTOT), h = (int)((i / KTOT) % MH), s = (int)(i / ((size_t)MH * KTOT));
        const float* cl = smp_c(c, j, s, pos); const float* kp = smp_kp(c, j, s, pos);
        float kn[NOPE];
        UNROLL for (int e = 0; e < NOPE; ++e) kn[e] = 0.f;
        const float* wuk = c.in[I_WUK] + (size_t)j * KVL * MH * NOPE;
        for (int r = 0; r < KVL; ++r) { const float cv = cl[r]; const float* w = wuk + ((size_t)r * MH + h) * NOPE; UNROLL for (int e = 0; e < NOPE; ++e) kn[e] += cv * w[e]; }
        float ss = 0.f; UNROLL for (int e = 0; e < NOPE; ++e) ss += kn[e] * kn[e];
        const float rs = 1.0f / sqrtf(ss / NOPE + NORM_EPS);
        UNROLL for (int e = 0; e < NOPE; ++e) kn[e] = kn[e] * rs * c.in[I_KNN][j * NOPE + e];
        for (int qi = 0; qi < DS; ++qi) {
            const float* q = c.q + (size_t)(MP + s * DS + qi) * MH * QD + h * QD;
            float sc = 0.f;
            UNROLL for (int e = 0; e < NOPE; ++e) sc += q[e] * kn[e];
            UNROLL for (int e = 0; e < ROPE; ++e) sc += q[NOPE + e] * kp[e];
            const bool ok = pos < PAST || (pos - PAST) <= qi;
            c.sc[(((size_t)s * MH + h) * DS + qi) * KTOT + pos] = ok ? sc * scale : -INFINITY;
        }
    }
}
DEV void ph_mla_softmax_sample(const Ctx& c, int, size_t gtid, size_t gsz) {
    using namespace cfg;
    GSL(i, (size_t)DB * MH * DS) {
        float* sc = c.sc + i * KTOT;
        float mx = -INFINITY; for (int p = 0; p < KTOT; ++p) mx = fmaxf(mx, sc[p]);
        float den = 0.f; for (int p = 0; p < KTOT; ++p) den += expf(sc[p] - mx);
        const float inv = 1.0f / den;
        for (int p = 0; p < KTOT; ++p) sc[p] = expf(sc[p] - mx) * inv;
    }
}
DEV void ph_mla_pv_sample(const Ctx& c, int l, size_t gtid, size_t gsz) {
    using namespace cfg; const int j = l / 3;
    GSL(i, (size_t)DB * MH * DS * KVL) {
        const int r = (int)(i % KVL); const size_t row = i / KVL; const int s = (int)(row / (MH * DS));
        const float* p = c.sc + row * KTOT; float acc = 0.f;
        for (int pos = 0; pos < KTOT; ++pos) acc += p[pos] * smp_c(c, j, s, pos)[r];
        c.olat[i] = acc;
    }
}
DEV void ph_mla_out_sample(const Ctx& c, int l, size_t gtid, size_t gsz) {
    using namespace cfg; const int j = l / 3;
    GSL(i, (size_t)MS * MH * VD) {
        const int e = (int)(i % VD), h = (int)((i / VD) % MH), ms = (int)(i / (MH * VD)), s = ms / DS, qi = ms % DS;
        const float* ol = c.olat + (((size_t)s * MH + h) * DS + qi) * KVL;
        const float* wuv = c.in[I_WUV] + (size_t)j * KVL * MH * VD;
        float acc = 0.f;
        for (int r = 0; r < KVL; ++r) acc += ol[r] * wuv[((size_t)r * MH + h) * VD + e];
        c.ao[(size_t)(MP + ms) * MH * VD + h * VD + e] = acc;
    }
}

DEV float mb_xpad(const Ctx& c, int j, int m, int sq, int tt, int ch) {
    using namespace cfg;
    if (tt < MB_CONV - 1) return sq < BATCH ? 0.f : c.in[I_CONV][(((size_t)j * DB + (sq - BATCH)) * (MB_CONV - 1) + tt) * MB_CD + ch];
    (void)m; return c.zx[(size_t)(seq_row0(sq) + tt - (MB_CONV - 1)) * MB_IN + MB_INNER + ch];
}
DEV void ph_mb_conv(const Ctx& c, int l, size_t gtid, size_t gsz) {
    using namespace cfg; const int j = l / 3;
    GSL(i, (size_t)MTOT * MB_CD) {
        const int m = (int)(i / MB_CD), ch = (int)(i % MB_CD), t = row_t(m), sq = row_seq(m), T = seq_len(sq);
        float acc = c.in[I_CONVB][j * MB_CD + ch];
        for (int jj = 0; jj < MB_CONV; ++jj) acc += mb_xpad(c, j, m, sq, t + jj, ch) * c.in[I_CONVW][((size_t)j * MB_CONV + jj) * MB_CD + ch];
        c.xbc[i] = siluf_(acc);
        if (t < MB_CONV - 1) {
            const float v = mb_xpad(c, j, m, sq, T + t, ch);
            if (sq < BATCH) c.out[O_CONVP + (((size_t)j * BATCH + sq) * (MB_CONV - 1) + t) * MB_CD + ch] = v;
            else c.out[O_CONVS + (((size_t)j * DB + (sq - BATCH)) * (MB_CONV - 1) + t) * MB_CD + ch] = v;
        }
    }
}
DEV void ph_mb_dt(const Ctx& c, int l, size_t gtid, size_t gsz) {
    using namespace cfg; const int j = l / 3;
    GSL(i, (size_t)MTOT * MB_HEADS) {
        const int m = (int)(i / MB_HEADS), h = (int)(i % MB_HEADS);
        c.dt[i] = softplusf_(c.zx[(size_t)m * MB_IN + MB_INNER + MB_CD + h] + c.in[I_DTB][j * MB_HEADS + h]);
    }
}
DEV void ph_mb_scan(const Ctx& c, int l, size_t gtid, size_t gsz) {
    using namespace cfg; const int j = l / 3;
    GSL(i, (size_t)NSEQ * MB_HEADS * MB_HEAD) {
        const int p = (int)(i % MB_HEAD), h = (int)((i / MB_HEAD) % MB_HEADS), sq = (int)(i / (MB_HEADS * MB_HEAD));
        const int g = h / (MB_HEADS / MB_GROUPS);
        float hs[MB_STATE];
        if (sq < BATCH) { UNROLL for (int n = 0; n < MB_STATE; ++n) hs[n] = 0.f; }
        else { const float* s0 = c.in[I_SSM] + ((((size_t)j * DB + (sq - BATCH)) * MB_HEADS + h) * MB_HEAD + p) * MB_STATE; UNROLL for (int n = 0; n < MB_STATE; ++n) hs[n] = s0[n]; }
        const float A = -expf(c.in[I_ALOG][j * MB_HEADS + h]), dsk = c.in[I_BD][j * MB_HEADS + h];
        const int m0 = seq_row0(sq), T = seq_len(sq);
        for (int t = 0; t < T; ++t) {
            const size_t m = (size_t)(m0 + t);
            const float dtv = c.dt[m * MB_HEADS + h], dA = expf(dtv * A);
            const float xv = c.xbc[m * MB_CD + h * MB_HEAD + p], xdt = xv * dtv;
            const float* Bm = c.xbc + m * MB_CD + MB_INNER + g * MB_STATE; const float* Cm = Bm + MB_GN;
            float yy = 0.f;
            UNROLL for (int n = 0; n < MB_STATE; ++n) { hs[n] = hs[n] * dA + xdt * Bm[n]; yy += Cm[n] * hs[n]; }
            c.my[m * MB_INNER + h * MB_HEAD + p] = yy + dsk * xv;
        }
        float* so = sq < BATCH ? c.out + O_SSMP + ((((size_t)j * BATCH + sq) * MB_HEADS + h) * MB_HEAD + p) * MB_STATE
                               : c.out + O_SSMS + ((((size_t)j * DB + (sq - BATCH)) * MB_HEADS + h) * MB_HEAD + p) * MB_STATE;
        UNROLL for (int n = 0; n < MB_STATE; ++n) so[n] = hs[n];
    }
}
DEV void ph_mb_gate(const Ctx& c, int l, size_t gtid, size_t gsz) {
    using namespace cfg; const int j = l / 3; constexpr int GW = MB_INNER / MB_GROUPS;
    GSL(i, (size_t)MTOT * MB_GROUPS) {
        const int m = (int)(i / MB_GROUPS), g = (int)(i % MB_GROUPS);
        float ss = 0.f;
        for (int e = 0; e < GW; ++e) { const float v = c.my[(size_t)m * MB_INNER + g * GW + e] * siluf_(c.zx[(size_t)m * MB_IN + g * GW + e]); ss += v * v; }
        const float rs = 1.0f / sqrtf(ss / GW + NORM_EPS);
        for (int e = 0; e < GW; ++e) {
            const float v = c.my[(size_t)m * MB_INNER + g * GW + e] * siluf_(c.zx[(size_t)m * MB_IN + g * GW + e]);
            c.yzn[(size_t)m * MB_INNER + g * GW + e] = v * rs * c.in[I_BNORM][j * MB_INNER + g * GW + e];
        }
    }
}
typedef short bf16x8_t __attribute__((ext_vector_type(8)));
typedef float f32x4_t __attribute__((ext_vector_type(4)));
__device__ __forceinline__ unsigned short f2bf(float f) { unsigned u = __float_as_uint(f); u += 0x7fffu + ((u >> 16) & 1u); return (unsigned short)(u >> 16); }
#define XB_TMO      128
#define XB_XCNT(j)  (256  + 64 * (j))
#define XB_XSUB(j)  (1280 + 64 * (j))
#define XB_XGEN(j)  (2304 + 64 * (j))
#define XB_TOP      3328
#define XB_TOPGEN   3392
#define XCD_BAR_WORDS 3456
#define XB_SPIN_CAP (1u << 25)
#define LAS __attribute__((address_space(3)))

__device__ __forceinline__ unsigned xb_ld(unsigned* p)              { return __hip_atomic_load(p, __ATOMIC_RELAXED, __HIP_MEMORY_SCOPE_AGENT); }
__device__ __forceinline__ unsigned xb_add(unsigned* p, unsigned v) { return __hip_atomic_fetch_add(p, v, __ATOMIC_RELAXED, __HIP_MEMORY_SCOPE_AGENT); }
__device__ __forceinline__ unsigned xb_xcc_id() { return (unsigned)__builtin_amdgcn_s_getreg((3 << 11) | 20) & 0xFu; }
#define XB_SPIN(cond, bar) do { unsigned _sp = 0; while (cond) { __builtin_amdgcn_s_sleep(1); \
    if ((++_sp & 255u) == 0u) { if (xb_ld(&(bar)[XB_TMO])) break; if (_sp > XB_SPIN_CAP) { atomicAdd(&(bar)[XB_TMO], 1u); break; } } } } while (0)

struct XcdBarrier {
    unsigned* bar; unsigned x;
    volatile LAS unsigned* st;
};

__device__ __forceinline__ XcdBarrier xcd_barrier_post(unsigned* bar, volatile LAS unsigned* st) {
    XcdBarrier b; b.bar = bar; b.x = xb_xcc_id(); b.st = st;
    if (threadIdx.x == 0) (void)xb_add(&bar[XB_XCNT(b.x)], 1u);
    return b;
}
__device__ __forceinline__ void xcd_barrier_complete(unsigned* bar, unsigned x, unsigned& nloc, unsigned& nx) {
    const unsigned G = gridDim.x * gridDim.y * gridDim.z;
    unsigned sum, cnt, mine, sp = 0u;
    for (;;) {
        sum = 0u; cnt = 0u; mine = 0u;
#pragma unroll
        for (unsigned j = 0; j < 16; ++j) { const unsigned c = xb_ld(&bar[XB_XCNT(j)]); sum += c; cnt += (c > 0u) ? 1u : 0u; mine = (j == x) ? c : mine; }
        if (sum == G) break;
        __builtin_amdgcn_s_sleep(1);
        if ((++sp & 255u) == 0u) { if (xb_ld(&bar[XB_TMO])) break; if (sp > XB_SPIN_CAP) { atomicAdd(&bar[XB_TMO], 1u); break; } }
    }
    nloc = mine > 0u ? mine : 1u; nx = cnt > 0u ? cnt : 1u;
}

__device__ __forceinline__ void xcd_barrier(const XcdBarrier& b) {
    asm volatile("s_waitcnt vmcnt(0)" ::: "memory");
    __syncthreads();
    if (threadIdx.x == 0) {
        unsigned* bar = b.bar;
        __builtin_amdgcn_s_waitcnt(0);
        unsigned nloc = b.st[0], nx = b.st[1];
        if (nloc == 0u) { xcd_barrier_complete(bar, b.x, nloc, nx); b.st[0] = nloc; b.st[1] = nx; }
        const unsigned old = xb_add(&bar[XB_XSUB(b.x)], 1u);
        const unsigned gen = old / nloc;
        if (old + 1u == (gen + 1u) * nloc) {
            __builtin_amdgcn_fence(__ATOMIC_RELEASE, "agent");
            asm volatile("s_waitcnt vmcnt(0)" ::: "memory");
            const unsigned og = xb_add(&bar[XB_TOP], 1u);
            const unsigned tg = og / nx;
            if (og + 1u == (tg + 1u) * nx) xb_add(&bar[XB_TOPGEN], 1u);
            else XB_SPIN(xb_ld(&bar[XB_TOPGEN]) == tg, bar);
            __builtin_amdgcn_fence(__ATOMIC_ACQUIRE, "agent");
            xb_add(&bar[XB_XGEN(b.x)], 1u);
            asm volatile("s_waitcnt vmcnt(0)" ::: "memory");
        } else {
            XB_SPIN(xb_ld(&bar[XB_XGEN(b.x)]) == gen, bar);
            __builtin_amdgcn_fence(__ATOMIC_ACQUIRE, "agent");
            asm volatile("s_waitcnt vmcnt(0)" ::: "memory");
        }
    }
    __syncthreads();
}

struct Bump { char* p; size_t off; float* f(size_t n) { float* r = (float*)(p + off); off += ((n * 4 + 255) / 256) * 256; return r; } };

static size_t setup_ctx(Ctx& c, void* const* d_in, void* d_out, void* d_ws) {
    using namespace cfg;
    for (int i = 0; i < 51; ++i) c.in[i] = (const float*)d_in[i];
    c.page_table = (const int*)d_in[I_PT];
    c.out = (float*)d_out; c.x = c.out;
    Bump b{(char*)d_ws, 4096 * 4};
    const size_t MD = (size_t)MTOT * D;
    c.xn = b.f(MD); c.vf = b.f(MD);
    const size_t base = b.off;
    for (int p = 0; p < 6; ++p) c.xm[p] = b.f(MD);
    c.r = b.f(MD); c.k = b.f(MD); c.v = b.f(MD); c.wpre = b.f(MD); c.apre = b.f(MD); c.vpre = b.f(MD); c.g = b.f(MD);
    c.hw = b.f((size_t)MTOT * RW_DL); c.ha = b.f((size_t)MTOT * RW_AL); c.hv = b.f((size_t)MTOT * RW_VL); c.hg = b.f((size_t)MTOT * RW_GL);
    c.ka = b.f(MD); c.kb = b.f(MD); c.y = c.xm[0]; c.yo = c.xm[1];
    size_t hi = b.off;
    b.off = base;
    c.mh = b.f((size_t)MTOT * MLA_IN); c.qan = b.f((size_t)MTOT * QL); c.q = b.f((size_t)MTOT * MH * QD); c.c = b.f((size_t)MTOT * KVL); c.kp = b.f((size_t)MTOT * ROPE);
    c.knr = b.f((size_t)MTOT * MH * NOPE); c.vv = b.f((size_t)MTOT * MH * VD); c.ao = b.f((size_t)MTOT * MH * VD);
    c.sc = b.f((size_t)DB * MH * DS * KTOT); c.olat = b.f((size_t)DB * MH * DS * KVL);
    if (b.off > hi) hi = b.off;
    b.off = base;
    c.zx = b.f((size_t)MTOT * MB_IN); c.xbc = b.f((size_t)MTOT * MB_CD); c.dt = b.f((size_t)MTOT * MB_HEADS); c.my = b.f((size_t)MTOT * MB_INNER); c.yzn = b.f((size_t)MTOT * MB_INNER);
    if (b.off > hi) hi = b.off;
    b.off = hi;
    c.hmid = b.f((size_t)MTOT * FFN);
    return b.off;
}

__device__ __forceinline__ unsigned tid_now() { unsigned t = threadIdx.x; asm volatile("" : "+v"(t)); return t; }
namespace pg8 {
#define PG8_LAS __attribute__((address_space(3)))
typedef unsigned short bf16_t;
typedef short bf16x8 __attribute__((ext_vector_type(8)));
typedef float f32x4 __attribute__((ext_vector_type(4)));
typedef float f32x2 __attribute__((ext_vector_type(2)));
typedef unsigned u32x4 __attribute__((ext_vector_type(4)));
typedef unsigned u32x2 __attribute__((ext_vector_type(2)));
constexpr int BM = 256, BK = 64, HALF = 128, HTB = HALF * BK * 2  , STAGE_BYTES = 8 * HTB, NXCD = 8, WGM = 8;

__host__ __device__ __forceinline__ int lds_byte(int r, int c) { const int st = (r >> 4) * 2 + (c >> 5), rr = r & 15, cc = c & 31, ob = rr * 64 + cc * 2; return st * 1024 + (ob ^ (((ob >> 9) & 1) << 5)); }
__host__ __device__ __forceinline__ void stage_rc(int b, int& R, int& C) { const int st = b / 1024, sb = b % 1024, swz = sb ^ (((sb >> 9) & 1) << 5); R = (st >> 1) * 16 + swz / 64; C = (st & 1) * 32 + (swz % 64) / 2; }
__host__ __device__ __forceinline__ int perm32(int rho) { const int n = rho >> 4, i = rho & 15; return 8 * (i >> 2) + 4 * n + (i & 3); }
__device__ __forceinline__ unsigned cvt_pk_bf16(float lo, float hi) { unsigned r; asm volatile("v_cvt_pk_bf16_f32 %0, %1, %2" : "=v"(r) : "v"(lo), "v"(hi)); return r; }

struct Unit { int pm, pn, k0, nt, asel, part; };
struct Gemm { const bf16_t* A; const bf16_t* Bt; int lda, ldb; size_t asel_stride; };

struct NoSel { __device__ static __forceinline__ int sel(int) { return 0; } };
template <class ASEL = NoSel>
struct Order {
    int nMp, nMs, nN, nwgP, nwgS, G, c, K, ksplit;
    __device__ __forceinline__ void init(int nMp_, int nMs_, int nN_, int K_, int ksplit_, int G_, int c_) { nMp = nMp_; nMs = nMs_; nN = nN_; nwgP = nMp * nN; K = K_; ksplit = ksplit_; nwgS = nMs * nN * ksplit; G = G_; c = c_; }
    __device__ __forceinline__ bool next(int i, Unit& u) const {
        const long L = (long)i * G + c;
        if (L < nwgP) {
            int wgid = (int)L; { const int q = nwgP / NXCD, r = nwgP % NXCD, xcd = wgid % NXCD, off = wgid / NXCD; wgid = (xcd < r ? xcd * (q + 1) : r * (q + 1) + (xcd - r) * q) + off; }
            const int nig = WGM * nN, gid = wgid / nig, fm = gid * WGM, gsz = (nMp - fm) < WGM ? (nMp - fm) : WGM;
            u.pm = fm + ((wgid % nig) % gsz); u.pn = (wgid % nig) / gsz; u.k0 = 0; u.nt = K / BK; u.part = 0; u.asel = ASEL::sel(u.pn); return true;
        }
        const long Ls = L - nwgP; if (Ls >= nwgS) return false;
        const int sub = (int)(Ls % ksplit), t = (int)(Ls / ksplit);
        u.pm = nMp + t % nMs; u.pn = t / nMs; u.nt = K / BK / ksplit; u.k0 = sub * u.nt * BK; u.part = ksplit > 1 ? 1 : 0; u.asel = ASEL::sel(u.pn); return true;
    }
};

template <class Epi, class Sched>
__device__ __forceinline__ void gemm_phase(PG8_LAS unsigned char* lds, const Gemm g, const Sched& S, const Epi& E) {
    const int tid = (int)tid_now(), wid = __builtin_amdgcn_readfirstlane(tid >> 6), lane = tid & 63, wr = wid >> 2, wc = wid & 3, fr = lane & 15, fq = lane >> 4;
    unsigned voffA[2], voffB[2];
#pragma unroll
    for (int i = 0; i < 2; ++i) { int R, C; stage_rc(tid * 16 + i * 8192, R, C); const int Rb = Epi::PERM ? ((R & ~31) + perm32(R & 31)) : R;
        voffA[i] = (unsigned)(R * g.lda + C) * 2u; voffB[i] = (unsigned)(Rb * g.ldb + C) * 2u; }
    const size_t kstep = (size_t)(BK * 2);
    const size_t hstepA = (size_t)HALF * g.lda * 2, hstepB = (size_t)HALF * g.ldb * 2;
    const unsigned ldsw = (unsigned)wid * 1024u;
    const int aoff = lds_byte(wr * 64 + fr, fq * 8), boff = lds_byte(wc * 32 + fr, fq * 8);
#define PG8_SA(b, h) (((b) * 2 + (h)) * HTB)
#define PG8_SB(b, h) ((4 + (b) * 2 + (h)) * HTB)
#define PG8_STAGE(bufoff, gbase, voff) do { _Pragma("unroll") for (int _i = 0; _i < 2; ++_i) \
        __builtin_amdgcn_global_load_lds((const unsigned*)((const char*)(gbase) + (voff)[_i]), (PG8_LAS unsigned*)(lds + (bufoff) + ldsw + _i * 8192), 16, 0, 0); } while (0)
#define PG8_LDA(dst, b, h) do { _Pragma("unroll") for (int m = 0; m < 4; ++m) _Pragma("unroll") for (int k = 0; k < 2; ++k) dst[m][k] = *(const PG8_LAS bf16x8*)(lds + PG8_SA(b, h) + aoff + m * 2048 + k * 1024); } while (0)
#define PG8_LDB(dst, b, h) do { _Pragma("unroll") for (int n = 0; n < 2; ++n) _Pragma("unroll") for (int k = 0; k < 2; ++k) dst[n][k] = *(const PG8_LAS bf16x8*)(lds + PG8_SB(b, h) + boff + n * 2048 + k * 1024); } while (0)
#define PG8_MMA(ai, bj, At, Bt) do { __builtin_amdgcn_s_setprio(1); _Pragma("unroll") for (int m = 0; m < 4; ++m) _Pragma("unroll") for (int n = 0; n < 2; ++n) _Pragma("unroll") for (int k = 0; k < 2; ++k) \
        acc[ai][bj][m][n] = __builtin_amdgcn_mfma_f32_16x16x32_bf16(Bt[n][k], At[m][k], acc[ai][bj][m][n], 0, 0, 0); __builtin_amdgcn_s_setprio(0); } while (0)
#define PG8_WAIT_V(n) asm volatile("s_waitcnt vmcnt(" #n ")" ::: "memory")
#define PG8_WAIT_L(n) asm volatile("s_waitcnt lgkmcnt(" #n ")" ::: "memory")
#define PG8_BAR __builtin_amdgcn_s_barrier()
#define PG8_SCHED __builtin_amdgcn_sched_barrier(0)
#define PG8_ABASE(u) ((const char*)g.A + ((size_t)(u).asel * g.asel_stride + (size_t)(u).pm * BM * g.lda + (u).k0) * 2)
#define PG8_BBASE(u) ((const char*)g.Bt + ((size_t)(u).pn * BM * g.ldb + (u).k0) * 2)
    Unit cur, nxt; int ui = 0;
    if (!S.next(0, cur)) return;
    f32x4 acc[2][2][4][2];
#pragma unroll
    for (int a = 0; a < 2; ++a)
#pragma unroll
        for (int b = 0; b < 2; ++b)
#pragma unroll
            for (int m = 0; m < 4; ++m)
#pragma unroll
                for (int n = 0; n < 2; ++n) acc[a][b][m][n] = (f32x4){0.f, 0.f, 0.f, 0.f};
    bf16x8 At[4][2], B0[2][2], B1[2][2];
    const char* cA = PG8_ABASE(cur); const char* cB = PG8_BBASE(cur);
    PG8_STAGE(PG8_SB(0, 0), cB, voffB); PG8_STAGE(PG8_SA(0, 0), cA, voffA); PG8_STAGE(PG8_SB(0, 1), cB + hstepB, voffB); PG8_STAGE(PG8_SA(0, 1), cA + hstepA, voffA);
    if (wr == 1) PG8_BAR;
    PG8_WAIT_V(4); PG8_BAR;
    PG8_STAGE(PG8_SB(1, 0), cB + kstep, voffB); PG8_STAGE(PG8_SA(1, 0), cA + kstep, voffA); PG8_STAGE(PG8_SB(1, 1), cB + hstepB + kstep, voffB);
    PG8_WAIT_V(6); PG8_BAR;
    for (;;) {
        const bool has_next = S.next(ui + 1, nxt);
        const char* nA = has_next ? PG8_ABASE(nxt) : cA; const char* nB = has_next ? PG8_BBASE(nxt) : cB;
        const int nt = cur.nt;
        for (int t = 0; t < nt; t += 2) {
            const bool last = (t == nt - 2);
            const char* a1 = cA + (size_t)(t + 1) * kstep;
            const char* a2 = last ? nA : cA + (size_t)(t + 2) * kstep; const char* b2 = last ? nB : cB + (size_t)(t + 2) * kstep;
            const char* a3 = a2 + kstep; const char* b3 = b2 + kstep;
            PG8_LDB(B0, 0, 0); PG8_SCHED; PG8_LDA(At, 0, 0); PG8_STAGE(PG8_SA(1, 1), a1 + hstepA, voffA);
            PG8_WAIT_L(8); PG8_BAR; PG8_WAIT_L(0); PG8_MMA(0, 0, At, B0); PG8_BAR; PG8_SCHED;
            PG8_LDB(B1, 0, 1); PG8_STAGE(PG8_SB(0, 0), b2, voffB);
            PG8_BAR; PG8_WAIT_L(0); PG8_MMA(0, 1, At, B1); PG8_BAR;
            PG8_LDA(At, 0, 1); PG8_STAGE(PG8_SA(0, 0), a2, voffA);
            PG8_BAR; PG8_WAIT_L(0); PG8_MMA(1, 0, At, B0); PG8_BAR; PG8_SCHED;
            PG8_STAGE(PG8_SB(0, 1), b2 + hstepB, voffB);
            PG8_WAIT_V(6); PG8_BAR; PG8_MMA(1, 1, At, B1); PG8_BAR;
            PG8_LDB(B0, 1, 0); PG8_SCHED; PG8_LDA(At, 1, 0); PG8_STAGE(PG8_SA(0, 1), a2 + hstepA, voffA);
            PG8_WAIT_L(8); PG8_BAR; PG8_WAIT_L(0); PG8_MMA(0, 0, At, B0); PG8_BAR; PG8_SCHED;
            PG8_LDB(B1, 1, 1); PG8_STAGE(PG8_SB(1, 0), b3, voffB);
            PG8_BAR; PG8_WAIT_L(0); PG8_MMA(0, 1, At, B1); PG8_BAR;
            PG8_LDA(At, 1, 1); PG8_STAGE(PG8_SA(1, 0), a3, voffA);
            PG8_BAR; PG8_WAIT_L(0); PG8_MMA(1, 0, At, B0); PG8_BAR; PG8_SCHED;
            PG8_STAGE(PG8_SB(1, 1), b3 + hstepB, voffB);
            PG8_WAIT_V(6); PG8_BAR; PG8_MMA(1, 1, At, B1); PG8_BAR;
        }
        E(acc, cur, wr, wc, fr, fq);
        if (!has_next) break;
#pragma unroll
        for (int a = 0; a < 2; ++a)
#pragma unroll
            for (int b = 0; b < 2; ++b)
#pragma unroll
                for (int m = 0; m < 4; ++m)
#pragma unroll
                    for (int n = 0; n < 2; ++n) acc[a][b][m][n] = (f32x4){0.f, 0.f, 0.f, 0.f};
        cur = nxt; cA = nA; cB = nB; ++ui;
    }
    PG8_WAIT_V(0);
    if (wr == 0) PG8_BAR;
    PG8_BAR;
#undef PG8_SA
#undef PG8_SB
#undef PG8_STAGE
#undef PG8_LDA
#undef PG8_LDB
#undef PG8_MMA
#undef PG8_WAIT_V
#undef PG8_WAIT_L
#undef PG8_BAR
#undef PG8_SCHED
#undef PG8_ABASE
#undef PG8_BBASE
}

struct EpiAccF32 {
    static constexpr bool PERM = false;
    float* C; int ldc; float* slab; int pm0, nMs, ksplit; const float* Csrc = nullptr;
    __device__ __forceinline__ void operator()(const f32x4 (&acc)[2][2][4][2], const Unit& u, int wr, int wc, int fr, int fq) const {
        if (u.part) {
            float* sl = slab + ((size_t)((u.pn * nMs + (u.pm - pm0)) * ksplit + u.k0 / (u.nt * BK)) * BM + wr * 64 + fr) * BM + wc * 32 + 4 * fq;
#pragma unroll
            for (int ai = 0; ai < 2; ++ai)
#pragma unroll
                for (int m = 0; m < 4; ++m) { float* rowp = sl + (size_t)(ai * HALF + m * 16) * BM;
#pragma unroll
                    for (int bj = 0; bj < 2; ++bj)
#pragma unroll
                        for (int n = 0; n < 2; ++n) *(f32x4*)(rowp + bj * HALF + n * 16) = acc[ai][bj][m][n]; }
        } else {
            const int row0 = u.pm * BM + wr * 64 + fr, col0 = u.pn * BM + wc * 32 + 4 * fq;
#pragma unroll
            for (int ai = 0; ai < 2; ++ai)
#pragma unroll
                for (int m2 = 0; m2 < 4; m2 += 2) {
                    f32x4 t[2][2][2];
#pragma unroll
                    for (int mm = 0; mm < 2; ++mm) { const float* rowp = (Csrc ? Csrc : C) + (size_t)(row0 + ai * HALF + (m2 + mm) * 16) * ldc + col0;
#pragma unroll
                        for (int bj = 0; bj < 2; ++bj)
#pragma unroll
                            for (int n = 0; n < 2; ++n) t[mm][bj][n] = *(const f32x4*)(rowp + bj * HALF + n * 16); }
#pragma unroll
                    for (int mm = 0; mm < 2; ++mm) { float* rowp = C + (size_t)(row0 + ai * HALF + (m2 + mm) * 16) * ldc + col0;
#pragma unroll
                        for (int bj = 0; bj < 2; ++bj)
#pragma unroll
                            for (int n = 0; n < 2; ++n) *(f32x4*)(rowp + bj * HALF + n * 16) = t[mm][bj][n] + acc[ai][bj][m2 + mm][n]; }
                }
        }
    }
};
struct EpiF32 {
    static constexpr bool PERM = false;
    float* C; int ldc; int ncols;
    __device__ __forceinline__ void operator()(const f32x4 (&acc)[2][2][4][2], const Unit& u, int wr, int wc, int fr, int fq) const {
        const int row0 = u.pm * BM + wr * 64 + fr, col0 = u.pn * BM + wc * 32 + 4 * fq;
#pragma unroll
        for (int ai = 0; ai < 2; ++ai)
#pragma unroll
            for (int m = 0; m < 4; ++m) { float* rowp = C + (size_t)(row0 + ai * HALF + m * 16) * ldc + col0;
#pragma unroll
                for (int bj = 0; bj < 2; ++bj)
#pragma unroll
                    for (int n = 0; n < 2; ++n) if (col0 + bj * HALF + n * 16 < ncols) *(f32x4*)(rowp + bj * HALF + n * 16) = acc[ai][bj][m][n]; }
    }
};
template <int ACT> struct EpiBf16 {
    static constexpr bool PERM = true;
    bf16_t* O; int ldc;
    __device__ __forceinline__ void operator()(const f32x4 (&acc)[2][2][4][2], const Unit& u, int wr, int wc, int fr, int fq) const {
        const int row0 = u.pm * BM + wr * 64 + fr, col0 = u.pn * BM + wc * 32 + 8 * fq;
#pragma unroll
        for (int ai = 0; ai < 2; ++ai)
#pragma unroll
            for (int m = 0; m < 4; ++m) { bf16_t* rowp = O + (size_t)(row0 + ai * HALF + m * 16) * ldc + col0;
#pragma unroll
                for (int bj = 0; bj < 2; ++bj) { f32x4 v0 = acc[ai][bj][m][0], v1 = acc[ai][bj][m][1];
                    if (ACT == 3) {
#pragma unroll
                        for (int j = 0; j < 4; ++j) { const float a = fmaxf(v0[j], 0.f), b = fmaxf(v1[j], 0.f); v0[j] = a * a; v1[j] = b * b; } }
                    u32x4 w; w.x = cvt_pk_bf16(v0[0], v0[1]); w.y = cvt_pk_bf16(v0[2], v0[3]); w.z = cvt_pk_bf16(v1[0], v1[1]); w.w = cvt_pk_bf16(v1[2], v1[3]);
                    *(u32x4*)(rowp + bj * HALF) = w; } }
    }
};
}
typedef pg8::bf16_t bf16_t;
#define LDSP __attribute__((address_space(3)))
struct Fast {
    bf16_t *xnb, *hmidb;
    bf16_t *w1t, *w2t;
    float* slab;
};
__device__ __forceinline__ unsigned pk2bf(float lo, float hi) { return pg8::cvt_pk_bf16(lo, hi); }
__device__ __forceinline__ float wave_sum64(float v) {
#pragma unroll
    for (int o = 1; o < 64; o <<= 1) v += __shfl_xor(v, o);
    return v;
}
__device__ __forceinline__ void red16x4(float& a, float& b, float& c, float& d) {
    asm volatile("s_nop 1\n"
        "v_add_f32_dpp %0, %0, %0 quad_perm:[1,0,3,2] row_mask:0xf bank_mask:0xf\n" "v_add_f32_dpp %1, %1, %1 quad_perm:[1,0,3,2] row_mask:0xf bank_mask:0xf\n"
        "v_add_f32_dpp %2, %2, %2 quad_perm:[1,0,3,2] row_mask:0xf bank_mask:0xf\n" "v_add_f32_dpp %3, %3, %3 quad_perm:[1,0,3,2] row_mask:0xf bank_mask:0xf\n"
        "v_add_f32_dpp %0, %0, %0 quad_perm:[2,3,0,1] row_mask:0xf bank_mask:0xf\n" "v_add_f32_dpp %1, %1, %1 quad_perm:[2,3,0,1] row_mask:0xf bank_mask:0xf\n"
        "v_add_f32_dpp %2, %2, %2 quad_perm:[2,3,0,1] row_mask:0xf bank_mask:0xf\n" "v_add_f32_dpp %3, %3, %3 quad_perm:[2,3,0,1] row_mask:0xf bank_mask:0xf\n"
        "v_add_f32_dpp %0, %0, %0 row_ror:4 row_mask:0xf bank_mask:0xf\n" "v_add_f32_dpp %1, %1, %1 row_ror:4 row_mask:0xf bank_mask:0xf\n"
        "v_add_f32_dpp %2, %2, %2 row_ror:4 row_mask:0xf bank_mask:0xf\n" "v_add_f32_dpp %3, %3, %3 row_ror:4 row_mask:0xf bank_mask:0xf\n"
        "v_add_f32_dpp %0, %0, %0 row_ror:8 row_mask:0xf bank_mask:0xf\n" "v_add_f32_dpp %1, %1, %1 row_ror:8 row_mask:0xf bank_mask:0xf\n"
        "v_add_f32_dpp %2, %2, %2 row_ror:8 row_mask:0xf bank_mask:0xf\n" "v_add_f32_dpp %3, %3, %3 row_ror:8 row_mask:0xf bank_mask:0xf\n"
        "s_nop 1"
        : "+v"(a), "+v"(b), "+v"(c), "+v"(d));
}
__device__ __forceinline__ void tr_item(const float* __restrict__ W, int ldw, int K, bf16_t* WT, int nvalid, const float* __restrict__ kscale, LDSP float* scr, int item, int nblk, int lane) {
    const int kb = item / nblk, nb = item % nblk, k0 = 64 * kb, n0 = 32 * nb;
    const bool ok = n0 < nvalid;
#pragma unroll
    for (int i = 0; i < 8; ++i) { const int kk = 8 * i + (lane >> 3), nn = 4 * (lane & 7); pg8::f32x4 v = ok ? *(const pg8::f32x4*)(W + (size_t)(k0 + kk) * ldw + n0 + nn) : (pg8::f32x4){0.f, 0.f, 0.f, 0.f};
        if (kscale) v = v * kscale[k0 + kk];
        scr[kk * 33 + nn] = v[0]; scr[kk * 33 + nn + 1] = v[1]; scr[kk * 33 + nn + 2] = v[2]; scr[kk * 33 + nn + 3] = v[3]; }
    asm volatile("s_waitcnt lgkmcnt(0)" ::: "memory");
    const int c = lane & 7;
#pragma unroll
    for (int j = 0; j < 4; ++j) { const int n = (lane >> 3) + 8 * j; const LDSP float* s = scr + (8 * c) * 33 + n;
        pg8::u32x4 o; o.x = pk2bf(s[0 * 33], s[1 * 33]); o.y = pk2bf(s[2 * 33], s[3 * 33]); o.z = pk2bf(s[4 * 33], s[5 * 33]); o.w = pk2bf(s[6 * 33], s[7 * 33]);
        *(pg8::u32x4*)(WT + (size_t)(n0 + n) * K + k0 + 8 * c) = o; }
    asm volatile("s_waitcnt lgkmcnt(0)" ::: "memory");
}
__device__ __forceinline__ void tr_weight(const float* W, int K, int N, int npad, bf16_t* WT, const float* kscale, LDSP float* scr, int gw, int ngw, int lane) {
    const int nblk = npad / 32, items = (K / 64) * nblk;
    for (int it = gw; it < items; it += ngw) tr_item(W, N, K, WT, N, kscale, scr, it, nblk, lane);
}
constexpr int TRJ_W = 12;
struct TrTab { LDSP int* t; int n; int total; };
__device__ __forceinline__ void trj_put(TrTab& tb, const float* W, int K, int N, int npad, bf16_t* WT) {
    LDSP int* e = tb.t + tb.n * TRJ_W; const unsigned long long w = (unsigned long long)(size_t)W, o = (unsigned long long)(size_t)WT;
    const int nblk = npad / 32, items = (K / 64) * nblk;
    e[0] = (int)(unsigned)w; e[1] = (int)(unsigned)(w >> 32); e[2] = (int)(unsigned)o; e[3] = (int)(unsigned)(o >> 32); e[4] = N; e[5] = K; e[6] = N; e[7] = nblk; e[8] = tb.total; e[9] = tb.total + items;
    tb.total += items; ++tb.n;
}
struct TrCur { bf16_t* wt; int K, k0, n0; };
__device__ __forceinline__ bool trj_issue(LDSP const int* tab, int njobs, int idx, int& j, pg8::f32x4 (&v)[8], TrCur& t, int lane) {
    while (j < njobs && idx >= __builtin_amdgcn_readfirstlane(tab[j * TRJ_W + 9])) ++j;
    if (j >= njobs) return false;
    LDSP const int* e = tab + j * TRJ_W;
    const unsigned wl = __builtin_amdgcn_readfirstlane(e[0]), wh = __builtin_amdgcn_readfirstlane(e[1]), ol = __builtin_amdgcn_readfirstlane(e[2]), oh = __builtin_amdgcn_readfirstlane(e[3]);
    const int ldw = __builtin_amdgcn_readfirstlane(e[4]), K = __builtin_amdgcn_readfirstlane(e[5]), nvalid = __builtin_amdgcn_readfirstlane(e[6]), nblk = __builtin_amdgcn_readfirstlane(e[7]), it = idx - __builtin_amdgcn_readfirstlane(e[8]);
    const float* W = (const float*)(size_t)(((unsigned long long)wh << 32) | wl);
    const int kb = it / nblk, nb = it - kb * nblk, k0 = 64 * kb, n0 = 32 * nb;
    t.wt = (bf16_t*)(size_t)(((unsigned long long)oh << 32) | ol); t.K = K; t.k0 = k0; t.n0 = n0;
    const bool ok = n0 < nvalid;
#pragma unroll
    for (int i = 0; i < 8; ++i) { const int kk = 8 * i + (lane >> 3), nn = 4 * (lane & 7); v[i] = ok ? *(const pg8::f32x4*)(W + (size_t)(k0 + kk) * ldw + n0 + nn) : (pg8::f32x4){0.f, 0.f, 0.f, 0.f}; }
    return true;
}
__device__ __forceinline__ void trj_finish(const pg8::f32x4 (&v)[8], const TrCur& t, LDSP float* scr, int lane) {
#pragma unroll
    for (int i = 0; i < 8; ++i) { const int kk = 8 * i + (lane >> 3), nn = 4 * (lane & 7);
        scr[kk * 33 + nn] = v[i][0]; scr[kk * 33 + nn + 1] = v[i][1]; scr[kk * 33 + nn + 2] = v[i][2]; scr[kk * 33 + nn + 3] = v[i][3]; }
    asm volatile("s_waitcnt lgkmcnt(0)" ::: "memory");
    const int c = lane & 7;
#pragma unroll
    for (int j = 0; j < 4; ++j) { const int n = (lane >> 3) + 8 * j; const LDSP float* s = scr + (8 * c) * 33 + n;
        pg8::u32x4 o; o.x = pk2bf(s[0 * 33], s[1 * 33]); o.y = pk2bf(s[2 * 33], s[3 * 33]); o.z = pk2bf(s[4 * 33], s[5 * 33]); o.w = pk2bf(s[6 * 33], s[7 * 33]);
        *(pg8::u32x4*)(t.wt + (size_t)(t.n0 + n) * t.K + t.k0 + 8 * c) = o; }
    asm volatile("s_waitcnt lgkmcnt(0)" ::: "memory");
}
__device__ __forceinline__ void trj_run(LDSP const int* tab, int njobs, int total, LDSP float* scr, int gw, int ngw, int lane) {
    int j = 0; pg8::f32x4 va[8], vb[8]; TrCur ta, tb;
    int idx = gw;
    bool have = idx < total && trj_issue(tab, njobs, idx, j, va, ta, lane);
    while (have) {
        idx += ngw; const bool hb = idx < total && trj_issue(tab, njobs, idx, j, vb, tb, lane);
        trj_finish(va, ta, scr, lane);
        if (!hb) break;
        idx += ngw; have = idx < total && trj_issue(tab, njobs, idx, j, va, ta, lane);
        trj_finish(vb, tb, scr, lane);
    }
}
__device__ __forceinline__ pg8::f32x4 slab_sum(const float* __restrict__ slab, int ksplit, int m, int q, int lane) {
    using namespace cfg; const int rs = m - MP, pms = rs >> 8, row = rs & 255;
    const float* p = slab + ((size_t)((q * (MS / 256) + pms) * ksplit) * 256 + row) * 256 + 4 * lane;
    pg8::f32x4 s = {0.f, 0.f, 0.f, 0.f};
    for (int k = 0; k < ksplit; ++k) s = s + *(const pg8::f32x4*)(p + (size_t)k * 65536);
    return s;
}
__device__ __forceinline__ void norm_rows_bf16(float* __restrict__ x, const float* __restrict__ gain, bf16_t* xn, const float* __restrict__ slab, int ksplit, int gw, int ngw, int lane) {
    using namespace cfg;
    pg8::f32x4 gv[4];
#pragma unroll
    for (int j = 0; j < 4; ++j) gv[j] = *(const pg8::f32x4*)(gain + 4 * lane + 256 * j);
    for (int m = gw; m < MTOT; m += ngw) {
        float* xr = x + (size_t)m * D; pg8::f32x4 v[4]; float s = 0.f;
#pragma unroll
        for (int j = 0; j < 4; ++j) { v[j] = *(const pg8::f32x4*)(xr + 4 * lane + 256 * j);
            if (ksplit > 1 && m >= MP) { v[j] = v[j] + slab_sum(slab, ksplit, m, j, lane); *(pg8::f32x4*)(xr + 4 * lane + 256 * j) = v[j]; }
            s += (v[j][0] * v[j][0] + v[j][1] * v[j][1]) + (v[j][2] * v[j][2] + v[j][3] * v[j][3]); }
        const float rs = 1.0f / sqrtf(wave_sum64(s) * (1.0f / D) + NORM_EPS);
#pragma unroll
        for (int j = 0; j < 4; ++j) { pg8::u32x2 o; o.x = pk2bf(v[j][0] * rs * gv[j][0], v[j][1] * rs * gv[j][1]); o.y = pk2bf(v[j][2] * rs * gv[j][2], v[j][3] * rs * gv[j][3]);
            *(pg8::u32x2*)(xn + (size_t)m * D + 4 * lane + 256 * j) = o; }
    }
}

__device__ __forceinline__ void fold_sample_rows(float* __restrict__ x, const float* __restrict__ slab, int ksplit, int gw, int ngw, int lane) {
    using namespace cfg;
    for (int m = MP + gw; m < MTOT; m += ngw) {
#pragma unroll
        for (int j = 0; j < 4; ++j) { float* p = x + (size_t)m * D + 4 * lane + 256 * j; *(pg8::f32x4*)p = *(const pg8::f32x4*)p + slab_sum(slab, ksplit, m, j, lane); }
    }
}
struct FastMla {
    float* mh;
    bf16_t *qan, *cb, *kpb;
    bf16_t *qraw, *kvraw;
    bf16_t *qf, *knb, *aob, *vT, *qs;
    float *opart, *lpart;
    bf16_t *wint, *wuqt, *wukvt, *wot;
};
__device__ __forceinline__ void rope_cs(int pos, int i, float& cs, float& sn) {
    const float inv = exp2f(-(float)i * (13.287712379549449f / 16.0f));
    const float ang = (float)pos * inv, kq = rintf(ang * 0.15915494309189535f);
    float rr = fmaf(-kq, 6.28125f, ang); rr = fmaf(-kq, 1.9353071795864769e-3f, rr);
    cs = __cosf(rr); sn = __sinf(rr);
}
__device__ __forceinline__ float rope_inv(int i) { return exp2f(-(float)i * (13.287712379549449f / 16.0f)); }
__device__ __forceinline__ void rope_cs_inv(int pos, float inv, float& cs, float& sn) {
    const float ang = (float)pos * inv, kq = rintf(ang * 0.15915494309189535f);
    float rr = fmaf(-kq, 6.28125f, ang); rr = fmaf(-kq, 1.9353071795864769e-3f, rr);
    cs = __cosf(rr); sn = __sinf(rr);
}
__device__ __forceinline__ float bf2f(unsigned short b) { return __uint_as_float(((unsigned)b) << 16); }
__device__ __forceinline__ void mla_norm1_fast(const Ctx& c, const FastMla& fm, int j, int gw, int ngw, int lane) {
    using namespace cfg;
    const pg8::f32x4 gq0 = *(const pg8::f32x4*)(c.in[I_QNORM] + j * QL + 4 * lane), gq1 = *(const pg8::f32x4*)(c.in[I_QNORM] + j * QL + 4 * lane + 256), gc = *(const pg8::f32x4*)(c.in[I_KVNORM] + j * KVL + 4 * lane);
    const float gkr = lane < ROPE ? c.in[I_KRN][j * ROPE + lane] : 0.f;
    const float rinv1 = rope_inv(lane & 15);
    for (int m = gw; m < MTOT; m += ngw) {
        const float* h = fm.mh + (size_t)m * 1024;
        pg8::f32x4 qv[2]; float s = 0.f;
#pragma unroll
        for (int t = 0; t < 2; ++t) { qv[t] = *(const pg8::f32x4*)(h + 4 * lane + 256 * t); s += (qv[t][0] * qv[t][0] + qv[t][1] * qv[t][1]) + (qv[t][2] * qv[t][2] + qv[t][3] * qv[t][3]); }
        const float rq = 1.0f / sqrtf(wave_sum64(s) * (1.0f / QL) + NORM_EPS);
#pragma unroll
        for (int t = 0; t < 2; ++t) { const pg8::f32x4 g = t ? gq1 : gq0;
            pg8::u32x2 o; o.x = pk2bf(qv[t][0] * rq * g[0], qv[t][1] * rq * g[1]); o.y = pk2bf(qv[t][2] * rq * g[2], qv[t][3] * rq * g[3]);
            *(pg8::u32x2*)(fm.qan + (size_t)m * QL + 4 * lane + 256 * t) = o; }
        const pg8::f32x4 cv = *(const pg8::f32x4*)(h + QL + 4 * lane);
        const float rc = 1.0f / sqrtf(wave_sum64((cv[0] * cv[0] + cv[1] * cv[1]) + (cv[2] * cv[2] + cv[3] * cv[3])) * (1.0f / KVL) + NORM_EPS);
        const pg8::f32x4 cn = {cv[0] * rc * gc[0], cv[1] * rc * gc[1], cv[2] * rc * gc[2], cv[3] * rc * gc[3]};
        float* co = m < MP ? c.out + O_CKVP + ((size_t)j * MP + m) * KVL : c.out + O_CKVS + ((size_t)j * MS + (m - MP)) * KVL;
        *(pg8::f32x4*)(co + 4 * lane) = cn;
        { pg8::u32x2 o; o.x = pk2bf(cn[0], cn[1]); o.y = pk2bf(cn[2], cn[3]); *(pg8::u32x2*)(fm.cb + (size_t)m * KVL + 4 * lane) = o; }
        const float kv = lane < ROPE ? h[QL + KVL + lane] : 0.f;
        const float rk = 1.0f / sqrtf(wave_sum64(kv * kv) * (1.0f / ROPE) + NORM_EPS);
        const float kn = kv * rk * gkr;
        const float other = __shfl_xor(kn, 16);
        float cs, sn; rope_cs_inv(row_pos(m), rinv1, cs, sn);
        const float ro = lane < 16 ? kn * cs - other * sn : kn * cs + other * sn;
        if (lane < ROPE) {
            float* ko = m < MP ? c.out + O_KPEP + ((size_t)j * MP + m) * ROPE : c.out + O_KPES + ((size_t)j * MS + (m - MP)) * ROPE;
            ko[lane] = ro;
            fm.kpb[(size_t)m * ROPE + lane] = (bf16_t)(pk2bf(ro, 0.f) & 0xffffu);
        }
    }
}
__device__ __forceinline__ void mla_norm2_fast(const Ctx& c, const FastMla& fm, int j, int gw, int ngw, int lane) {
    using namespace cfg;
    const int hd = lane >> 2, qt = lane & 3;
    const float QSC = 0.10206207261596575f * 1.4426950408889634f;
    float gqn[16], gkn[16], gqr[8];
    { const float* pq = c.in[I_QNN] + j * NOPE + 16 * qt; const float* pk = c.in[I_KNN] + j * NOPE + 16 * qt; const float* pr = c.in[I_QRN] + j * ROPE + 8 * qt;
#pragma unroll
      for (int i4 = 0; i4 < 4; ++i4) { const pg8::f32x4 a = *(const pg8::f32x4*)(pq + 4 * i4), b = *(const pg8::f32x4*)(pk + 4 * i4);
#pragma unroll
          for (int e = 0; e < 4; ++e) { gqn[4 * i4 + e] = a[e]; gkn[4 * i4 + e] = b[e]; } }
#pragma unroll
      for (int i4 = 0; i4 < 2; ++i4) { const pg8::f32x4 a = *(const pg8::f32x4*)(pr + 4 * i4);
#pragma unroll
          for (int e = 0; e < 4; ++e) gqr[4 * i4 + e] = a[e]; } }
    float rinv[8];
#pragma unroll
    for (int i = 0; i < 8; ++i) rinv[i] = rope_inv((8 * qt + i) & 15);
    for (int m = gw; m < MTOT; m += ngw) {
        const bf16_t* qr = fm.qraw + (size_t)m * (MH * QD) + hd * QD;
        float v[16]; float s = 0.f;
        { const pg8::u32x4 a = *(const pg8::u32x4*)(qr + 16 * qt), b = *(const pg8::u32x4*)(qr + 16 * qt + 8); const unsigned w[8] = {a.x, a.y, a.z, a.w, b.x, b.y, b.z, b.w};
#pragma unroll
          for (int i = 0; i < 8; ++i) { v[2 * i] = __uint_as_float(w[i] << 16); v[2 * i + 1] = __uint_as_float(w[i] & 0xffff0000u); } }
#pragma unroll
        for (int i = 0; i < 16; ++i) s += v[i] * v[i];
        s += __shfl_xor(s, 1); s += __shfl_xor(s, 2);
        float rs = 1.0f / sqrtf(s * (1.0f / NOPE) + NORM_EPS);
        bf16_t* qo = fm.qf + (size_t)m * (MH * QD) + hd * QD;
        { unsigned w[8], w2[8];
#pragma unroll
          for (int i = 0; i < 8; ++i) { const float a = v[2 * i] * rs * gqn[2 * i], b = v[2 * i + 1] * rs * gqn[2 * i + 1];
              w[i] = pk2bf(a * QSC, b * QSC);
              w2[i] = pk2bf(a * QSC * gkn[2 * i], b * QSC * gkn[2 * i + 1]); }
          *(pg8::u32x4*)(qo + 16 * qt) = (pg8::u32x4){w[0], w[1], w[2], w[3]}; *(pg8::u32x4*)(qo + 16 * qt + 8) = (pg8::u32x4){w[4], w[5], w[6], w[7]};
          if (m >= MP) { bf16_t* q2 = fm.qs + ((size_t)(((m - MP) >> 3) * MH + hd) * 6 + qt) * 128 + ((m - MP) & 7) * 8;
              *(pg8::u32x4*)(q2) = (pg8::u32x4){w2[0], w2[1], w2[4], w2[5]}; *(pg8::u32x4*)(q2 + 64) = (pg8::u32x4){w2[2], w2[3], w2[6], w2[7]}; } }
        float r8[8]; s = 0.f;
        { const pg8::u32x4 a = *(const pg8::u32x4*)(qr + NOPE + 8 * qt); const unsigned w[4] = {a.x, a.y, a.z, a.w};
#pragma unroll
          for (int i = 0; i < 4; ++i) { r8[2 * i] = __uint_as_float(w[i] << 16); r8[2 * i + 1] = __uint_as_float(w[i] & 0xffff0000u); } }
#pragma unroll
        for (int i = 0; i < 8; ++i) s += r8[i] * r8[i];
        s += __shfl_xor(s, 1); s += __shfl_xor(s, 2);
        rs = 1.0f / sqrtf(s * (1.0f / ROPE) + NORM_EPS);
        { unsigned w[4]; float o8[8];
#pragma unroll
          for (int i = 0; i < 8; ++i) { const float mine = r8[i] * rs * gqr[i]; const float oth = __shfl_xor(mine, 2);
              float cs, sn; rope_cs_inv(row_pos(m), rinv[i], cs, sn);
              o8[i] = qt < 2 ? mine * cs - oth * sn : mine * cs + oth * sn; }
#pragma unroll
          for (int i = 0; i < 4; ++i) w[i] = pk2bf(o8[2 * i] * QSC, o8[2 * i + 1] * QSC);
          *(pg8::u32x4*)(qo + NOPE + 8 * qt) = (pg8::u32x4){w[0], w[1], w[2], w[3]};
          if (m >= MP) *(pg8::u32x4*)(fm.qs + ((size_t)(((m - MP) >> 3) * MH + hd) * 6 + 4 + (qt >> 1)) * 128 + (qt & 1) * 64 + ((m - MP) & 7) * 8) = (pg8::u32x4){w[0], w[1], w[2], w[3]}; }
        const bf16_t* kr = fm.kvraw + (size_t)m * 2048 + hd * NOPE; s = 0.f;
        { const pg8::u32x4 a = *(const pg8::u32x4*)(kr + 16 * qt), b = *(const pg8::u32x4*)(kr + 16 * qt + 8); const unsigned w[8] = {a.x, a.y, a.z, a.w, b.x, b.y, b.z, b.w};
#pragma unroll
          for (int i = 0; i < 8; ++i) { v[2 * i] = __uint_as_float(w[i] << 16); v[2 * i + 1] = __uint_as_float(w[i] & 0xffff0000u); } }
#pragma unroll
        for (int i = 0; i < 16; ++i) s += v[i] * v[i];
        s += __shfl_xor(s, 1); s += __shfl_xor(s, 2);
        rs = 1.0f / sqrtf(s * (1.0f / NOPE) + NORM_EPS);
        bf16_t* ko = fm.knb + (size_t)m * (MH * NOPE) + hd * NOPE;
        { unsigned w[8];
#pragma unroll
          for (int i = 0; i < 8; ++i) { const float a = v[2 * i] * rs * gkn[2 * i], b = v[2 * i + 1] * rs * gkn[2 * i + 1];
              w[i] = pk2bf(a, b); }
          *(pg8::u32x4*)(ko + 16 * qt) = (pg8::u32x4){w[0], w[1], w[2], w[3]}; *(pg8::u32x4*)(ko + 16 * qt + 8) = (pg8::u32x4){w[4], w[5], w[6], w[7]}; }
    }
}
__device__ __forceinline__ void cvt_f32_bf16(const float* __restrict__ s, bf16_t* d, size_t n, size_t gtid, size_t gsz) {
    for (size_t i = gtid * 4; i < n; i += gsz * 4) { const pg8::f32x4 v = *(const pg8::f32x4*)(s + i); pg8::u32x2 o; o.x = pk2bf(v[0], v[1]); o.y = pk2bf(v[2], v[3]); *(pg8::u32x2*)(d + i) = o; }
}
typedef float f32x16_t __attribute__((ext_vector_type(16)));
typedef pg8::bf16x8 bf16x8v;
constexpr int AT_KROW = 208, AT_VROW = 136, AT_KBUF = 64 * AT_KROW, AT_VBUF = 64 * AT_VROW, AT_LDS = 2 * AT_KBUF + 2 * AT_VBUF;
__device__ __forceinline__ void attn_prompt_fast(const bf16_t* __restrict__ qf, const bf16_t* __restrict__ knb, const bf16_t* __restrict__ kpb, const bf16_t* __restrict__ vT, bf16_t* aob, LDSP unsigned char* lds) {
    using namespace cfg;
    const int tid = (int)tid_now(), w = __builtin_amdgcn_readfirstlane(tid >> 6), lane = tid & 63, l31 = lane & 31, h5 = lane >> 5;
    for (int it = blockIdx.x; it < BATCH * MH * 4; it += gridDim.x) {
        const int bh = it >> 2, pr = it & 3, b = bh / MH, h = bh % MH;
        for (int half = 0; half < 2; ++half) {
            const int qb = half ? 7 - pr : pr, q0 = 256 * qb, nt = 4 * qb + 4;
            const int qg = q0 + 32 * w + l31;
            const size_t mrow = (size_t)b * SEQ + qg;
            bf16x8v qfr[6];
#pragma unroll
            for (int s = 0; s < 6; ++s) qfr[s] = *(const bf16x8v*)(qf + mrow * (MH * QD) + h * QD + 16 * s + 8 * h5);
            f32x16_t O[2];
#pragma unroll
            for (int db = 0; db < 2; ++db)
#pragma unroll
                for (int r = 0; r < 16; ++r) O[db][r] = 0.f;
            float mrun = -1e30f, lrun = 0.f;
            pg8::u32x4 rk, rp, rv;
            const int kkey = tid >> 3, kc8 = tid & 7, pkey = tid >> 2, pc4 = tid & 3;
#define AT_LOAD(t) do { const size_t mk = (size_t)b * SEQ + 64 * (t); \
                rk = *(const pg8::u32x4*)(knb + (mk + kkey) * (MH * NOPE) + h * NOPE + kc8 * 8); \
                if (tid < 256) rp = *(const pg8::u32x4*)(kpb + (mk + pkey) * ROPE + pc4 * 8); \
                rv = *(const pg8::u32x4*)(vT + (size_t)(h * VD + kkey) * MTOT + mk + kc8 * 8); } while (0)
#define AT_STORE(buf) do { LDSP unsigned char* kb_ = lds + (buf) * AT_KBUF; LDSP unsigned char* vb_ = lds + 2 * AT_KBUF + (buf) * AT_VBUF; \
                *(LDSP pg8::u32x4*)(kb_ + kkey * AT_KROW + kc8 * 16) = rk; \
                if (tid < 256) *(LDSP pg8::u32x4*)(kb_ + pkey * AT_KROW + 128 + pc4 * 16) = rp; \
                *(LDSP pg8::u32x2*)(vb_ + kkey * AT_VROW + kc8 * 16) = (pg8::u32x2){rv.x, rv.y}; *(LDSP pg8::u32x2*)(vb_ + kkey * AT_VROW + kc8 * 16 + 8) = (pg8::u32x2){rv.z, rv.w}; } while (0)
            AT_LOAD(0); AT_STORE(0);
            __syncthreads();
            for (int t = 0; t < nt; ++t) {
                if (t + 1 < nt) AT_LOAD(t + 1);
                if (64 * t <= q0 + 32 * w + 31) {
                    const LDSP unsigned char* kb_ = lds + (t & 1) * AT_KBUF; const LDSP unsigned char* vb_ = lds + 2 * AT_KBUF + (t & 1) * AT_VBUF;
                    f32x16_t S[2];
#pragma unroll
                    for (int kb = 0; kb < 2; ++kb)
#pragma unroll
                        for (int r = 0; r < 16; ++r) S[kb][r] = 0.f;
#pragma unroll
                    for (int s = 0; s < 6; ++s)
#pragma unroll
                        for (int kb = 0; kb < 2; ++kb) {
                            const bf16x8v a = *(const LDSP bf16x8v*)(kb_ + (32 * kb + l31) * AT_KROW + (16 * s + 8 * h5) * 2);
                            S[kb] = __builtin_amdgcn_mfma_f32_32x32x16_bf16(a, qfr[s], S[kb], 0, 0, 0);
                        }
                    if (64 * t + 63 > q0 + 32 * w) {
#pragma unroll
                        for (int kb = 0; kb < 2; ++kb)
#pragma unroll
                            for (int r = 0; r < 16; ++r) { const int key = 64 * t + 32 * kb + (r & 3) + 8 * (r >> 2) + 4 * h5; if (key > qg) S[kb][r] = -1e30f; }
                    }
                    float mt = -1e30f;
#pragma unroll
                    for (int kb = 0; kb < 2; ++kb)
#pragma unroll
                        for (int r = 0; r < 16; ++r) mt = fmaxf(mt, S[kb][r]);
                    mt = fmaxf(mt, __shfl_xor(mt, 32));
                    const float mnew = fmaxf(mrun, mt), alpha = __builtin_amdgcn_exp2f(mrun - mnew);
                    float ls = 0.f;
#pragma unroll
                    for (int kb = 0; kb < 2; ++kb)
#pragma unroll
                        for (int r = 0; r < 16; ++r) { const float p = __builtin_amdgcn_exp2f(S[kb][r] - mnew); S[kb][r] = p; ls += p; }
                    lrun = lrun * alpha + ls; mrun = mnew;
#pragma unroll
                    for (int db = 0; db < 2; ++db)
#pragma unroll
                        for (int r = 0; r < 16; ++r) O[db][r] *= alpha;
#pragma unroll
                    for (int kb = 0; kb < 2; ++kb)
#pragma unroll
                        for (int s = 0; s < 2; ++s) {
                            pg8::u32x4 pw; pw.x = pk2bf(S[kb][8 * s + 0], S[kb][8 * s + 1]); pw.y = pk2bf(S[kb][8 * s + 2], S[kb][8 * s + 3]); pw.z = pk2bf(S[kb][8 * s + 4], S[kb][8 * s + 5]); pw.w = pk2bf(S[kb][8 * s + 6], S[kb][8 * s + 7]);
                            const bf16x8v pf = __builtin_bit_cast(bf16x8v, pw);
#pragma unroll
                            for (int db = 0; db < 2; ++db) {
                                const LDSP unsigned char* vp = vb_ + (32 * db + l31) * AT_VROW + (32 * kb + 16 * s + 4 * h5) * 2;
                                const pg8::u32x2 v0 = *(const LDSP pg8::u32x2*)vp, v1 = *(const LDSP pg8::u32x2*)(vp + 16);
                                const bf16x8v a = __builtin_bit_cast(bf16x8v, (pg8::u32x4){v0.x, v0.y, v1.x, v1.y});
                                O[db] = __builtin_amdgcn_mfma_f32_32x32x16_bf16(a, pf, O[db], 0, 0, 0);
                            }
                        }
                }
                if (t + 1 < nt) AT_STORE((t + 1) & 1);
                __syncthreads();
            }
#undef AT_LOAD
#undef AT_STORE
            const float inv = 1.0f / (lrun + __shfl_xor(lrun, 32));
            bf16_t* orow = aob + mrow * (MH * VD) + h * VD;
#pragma unroll
            for (int db = 0; db < 2; ++db)
#pragma unroll
                for (int g = 0; g < 4; ++g) { pg8::u32x2 o; o.x = pk2bf(O[db][4 * g] * inv, O[db][4 * g + 1] * inv); o.y = pk2bf(O[db][4 * g + 2] * inv, O[db][4 * g + 3] * inv);
                    *(pg8::u32x2*)(orow + 32 * db + 8 * g + 4 * h5) = o; }
        }
    }
}
constexpr int SD_CROW = 528, SD_WROW = 528, SD_PROW = 272;
constexpr int SD_CIMG = 0, SD_CIMG_SZ = 128 * SD_CROW;
constexpr int SD_WBUF = SD_CIMG + SD_CIMG_SZ, SD_WBUF_SZ = 32 * 1040;
constexpr int SD_XCH = SD_WBUF + 2 * SD_WBUF_SZ, SD_XCH_SZ = 4 * 5 * 64 * 4;
constexpr int SD_PIMG = SD_XCH + 2 * SD_XCH_SZ, SD_PIMG_SZ = 32 * SD_PROW;
constexpr int SD_END = SD_PIMG + 2 * SD_PIMG_SZ;
typedef short s16x4 __attribute__((ext_vector_type(4)));
#define MFMA32(a, b, c) __builtin_amdgcn_mfma_f32_32x32x16_bf16(a, b, c, 0, 0, 0)

__device__ __forceinline__ float mla_b2_bound(const Ctx& c, int j, int lane) {
    using namespace cfg;
    float gq = fabsf(c.in[I_QNN][j * NOPE + lane]), gk = fabsf(c.in[I_KNN][j * NOPE + lane]), gqr = fabsf(c.in[I_QRN][j * ROPE + (lane & 31)]), gkr = fabsf(c.in[I_KRN][j * ROPE + (lane & 31)]);
#pragma unroll
    for (int o = 1; o < 64; o <<= 1) { gq = fmaxf(gq, __shfl_xor(gq, o)); gk = fmaxf(gk, __shfl_xor(gk, o)); gqr = fmaxf(gqr, __shfl_xor(gqr, o)); gkr = fmaxf(gkr, __shfl_xor(gkr, o)); }
    return (64.f * gq * gk + 32.f * gqr * gkr) * (0.10206207261596575f * 1.4426950408889634f);
}

__device__ __forceinline__ void sd_pv_core(const int G, f32x16_t& Og, f32x16_t& Lacc, LDSP unsigned char* lds, int w, int lane, int l31, int h5) {
    asm volatile("" : "+v"(lane)); l31 = lane & 31; h5 = lane >> 5;
    const LDSP unsigned char* pimg = lds + SD_PIMG + (G & 1) * SD_PIMG_SZ;
    const unsigned onesw = (l31 == G) ? 0x3F803F80u : 0u;
    const bf16x8v onesv = __builtin_bit_cast(bf16x8v, (pg8::u32x4){onesw, onesw, onesw, onesw});
#pragma unroll
    for (int sp = 0; sp < 8; ++sp) {
        const bf16x8v a = *(const LDSP bf16x8v*)(pimg + l31 * SD_PROW + (16 * sp + 8 * h5) * 2);
        const int key0 = 16 * sp + 8 * h5 + ((lane & 15) >> 2), col = 32 * w + 16 * ((lane >> 4) & 1) + 4 * (lane & 3);
        const s16x4 t0 = __builtin_amdgcn_ds_read_tr16_b64_v4i16((LDSP s16x4*)(lds + SD_CIMG + key0 * SD_CROW + col * 2));
        const s16x4 t1 = __builtin_amdgcn_ds_read_tr16_b64_v4i16((LDSP s16x4*)(lds + SD_CIMG + (key0 + 4) * SD_CROW + col * 2));
        const bf16x8v b = (bf16x8v){t0[0], t0[1], t0[2], t0[3], t1[0], t1[1], t1[2], t1[3]};
        Og = MFMA32(a, b, Og);
        if (sp == w) Lacc = MFMA32(a, onesv, Lacc);
        if (sp & 1) __builtin_amdgcn_sched_barrier(0);
    }
}

__device__ __forceinline__ void sd_pv(const int G, f32x16_t& Og, f32x16_t& Lacc, LDSP unsigned char* lds, int w, int lane, int l31, int h5) {
    sd_pv_core(G, Og, Lacc, lds, w, lane, l31, h5);
#if defined(PROBE_DUP) && (PROBE_DUP & (1 << 21))
    f32x16_t D0, D1;
#pragma unroll
    for (int r = 0; r < 16; ++r) { D0[r] = 0.f; D1[r] = 0.f; }
    sd_pv_core(G, D0, D1, lds, w, lane, l31, h5); asm volatile("" :: "v"(D0), "v"(D1));
#endif
}
__device__ __forceinline__ void sd_glds16(const void* gsrc, unsigned lds_dst) {
    unsigned keep;
    asm volatile("s_mov_b32 %0, m0\n\ts_mov_b32 m0, %2\n\ts_nop 0\n\tglobal_load_lds_dwordx4 %1, off\n\ts_mov_b32 m0, %0" : "=&s"(keep) : "v"(gsrc), "s"(lds_dst) : "memory");
}
#define SD_WLOAD(h, buf) do { if (w >= 4) { const char* wsrc_ = (const char*)(fm.wukvt + (size_t)(h) * NOPE * KVL); int ln_ = lane; asm volatile("" : "+v"(ln_)); \
        const unsigned ldsb_ = __builtin_amdgcn_readfirstlane((unsigned)(size_t)(lds + SD_WBUF + (buf) * SD_WBUF_SZ)) + (unsigned)(8 * (w - 4)) * 1040u; \
        _Pragma("unroll") for (int k = 0; k < 8; ++k) { \
        const unsigned voff_ = (unsigned)(((8 * (w - 4) + k) + 32 * (ln_ >> 5)) * KVL + (ln_ & 31) * 8) * 2u; \
        sd_glds16(wsrc_ + voff_, ldsb_ + (unsigned)k * 1040u); } } } while (0)
template <int G, bool DOPV = true>
__device__ __forceinline__ void sd_group(const FastMla& fm, const bf16_t* __restrict__ qs, const int s, LDSP unsigned char* lds, const int w, const int lane, const int l31_, const int h5_, const int kb, const int dh, const int rot,
                                         const bf16x8v (&cfr)[16], const bf16x8v (&kpfr)[2], pg8::u32x4 (&wr)[4], f32x16_t (&O)[4], f32x16_t& Lacc, const float B2) {
    using namespace cfg;
        _Pragma("unroll 1") for (int hh = 0; hh < 4; ++hh) {
            const int h = (4 * G + hh + rot) & (MH - 1);
            int lane_ = lane; asm volatile("" : "+v"(lane_)); const int l31 = lane_ & 31, h5 = lane_ >> 5;
            { LDSP unsigned char* wdst = lds + SD_WBUF + ((h + 1) & 1) * SD_WBUF_SZ + (2 * w + h5) * 1040 + l31 * 16;
              *(LDSP pg8::u32x4*)(wdst) = wr[0]; *(LDSP pg8::u32x4*)(wdst + 16640) = wr[1]; *(LDSP pg8::u32x4*)(wdst + 512) = wr[2]; *(LDSP pg8::u32x4*)(wdst + 17152) = wr[3]; }
            const char* qb = (const char*)qs + (size_t)(s * MH + h) * 1536;
            const unsigned zoff = (unsigned)((DB * MH - (s * MH + h)) * 1536);
            const unsigned qlo = l31 < 8 ? (unsigned)(h5 * 128 + l31 * 16) : zoff;
            bf16x8v qn0 = (bf16x8v){0, 0, 0, 0, 0, 0, 0, 0}, qn1 = qn0, qp0 = qn0, qp1 = qn0;
            if (l31 < 8) {
                qn0 = *(const bf16x8v*)(qb + dh * 512 + qlo); qn1 = *(const bf16x8v*)(qb + dh * 512 + 256 + qlo);
                if (dh == 0) { qp0 = *(const bf16x8v*)(qb + 1024 + qlo); qp1 = *(const bf16x8v*)(qb + 1280 + qlo); } }
            { const char* wsrc = (const char*)(fm.wukvt + (size_t)((h + 2) & (MH - 1)) * NOPE * KVL) + (unsigned)(64 * w + lane_) * 16u;
#pragma unroll
              for (int k = 0; k < 4; ++k) wr[k] = *(const pg8::u32x4*)(wsrc + k * 8192); }
            f32x16_t KN;
#pragma unroll
            for (int r = 0; r < 16; ++r) KN[r] = 0.f;
            { const LDSP unsigned char* wb = lds + SD_WBUF + (h & 1) * SD_WBUF_SZ + l31 * 1040 + dh * 512 + h5 * 16;
#pragma unroll
              for (int s_ = 0; s_ < 16; ++s_) { const bf16x8v a = *(const LDSP bf16x8v*)(wb + 32 * s_); KN = MFMA32(a, cfr[s_], KN); if ((s_ & 3) == 3) __builtin_amdgcn_sched_barrier(0); } }
#if defined(PROBE_DUP) && (PROBE_DUP & (1 << 19))
            { const LDSP unsigned char* wb = lds + SD_WBUF + (h & 1) * SD_WBUF_SZ + l31 * 1040 + dh * 512 + h5 * 16;
#pragma unroll
              for (int s_ = 0; s_ < 16; ++s_) { const bf16x8v a = *(const LDSP bf16x8v*)(wb + 32 * s_); KN = MFMA32(a, cfr[s_], KN); if ((s_ & 3) == 3) __builtin_amdgcn_sched_barrier(0); }
#pragma unroll
              for (int r = 0; r < 16; ++r) KN[r] *= 0.5f; }
#endif
#if defined(PROBE_DUP) && (PROBE_DUP & (1 << 23))
            _Pragma("unroll 1") for (int rep_ = 0; rep_ < 2; ++rep_) {
            asm volatile("" : "+v"(KN));
#else
            {
#endif
            float ssq = 0.f;
#pragma unroll
            for (int r = 0; r < 16; ++r) ssq += KN[r] * KN[r];
            ssq += __shfl_xor(ssq, 32);
            {
            f32x16_t S;
#pragma unroll
            for (int r = 0; r < 16; ++r) S[r] = 0.f;
#pragma unroll
            for (int s_ = 0; s_ < 2; ++s_) { const bf16x8v kf = __builtin_bit_cast(bf16x8v, (pg8::u32x4){pk2bf(KN[8 * s_], KN[8 * s_ + 1]), pk2bf(KN[8 * s_ + 2], KN[8 * s_ + 3]), pk2bf(KN[8 * s_ + 4], KN[8 * s_ + 5]), pk2bf(KN[8 * s_ + 6], KN[8 * s_ + 7])});
                S = MFMA32(s_ == 0 ? qn0 : qn1, kf, S); }
            LDSP float* xch = (LDSP float*)(lds + SD_XCH + (h & 1) * SD_XCH_SZ) + kb * 320;
            if (dh == 1) { xch[lane_] = S[0]; xch[64 + lane_] = S[1]; xch[128 + lane_] = S[2]; xch[192 + lane_] = S[3]; xch[256 + lane_] = ssq; }
            asm volatile("s_waitcnt lgkmcnt(0)" ::: "memory");
            __builtin_amdgcn_s_barrier();
            asm volatile("" ::: "memory");
            if (dh == 0) {
                const float rstd = __builtin_amdgcn_rsqf((ssq + xch[256 + lane_]) * (1.0f / NOPE) + NORM_EPS);
                f32x16_t T;
#pragma unroll
                for (int r = 0; r < 16; ++r) T[r] = 0.f;
                T[0] = (S[0] + xch[lane_]) * rstd; T[1] = (S[1] + xch[64 + lane_]) * rstd; T[2] = (S[2] + xch[128 + lane_]) * rstd; T[3] = (S[3] + xch[192 + lane_]) * rstd;
                T = MFMA32(qp0, kpfr[0], T); T = MFMA32(qp1, kpfr[1], T);
                LDSP bf16_t* prow = (LDSP bf16_t*)(lds + SD_PIMG + (G & 1) * SD_PIMG_SZ + (hh * 8 + 4 * h5) * SD_PROW) + 32 * kb + l31;
#pragma unroll
                for (int q = 0; q < 4; ++q) prow[q * (SD_PROW / 2)] = (bf16_t)(pk2bf(exp2f(T[q] - B2), 0.f) & 0xffffu);
            }
            }
            }
        }
        if (G > 0 && DOPV) sd_pv(G > 0 ? G - 1 : 0, O[G > 0 ? G - 1 : 0], Lacc, lds, w, lane, l31_, h5_);
}

__device__ __forceinline__ void mla_sample_decode(const Ctx& c, const FastMla& fm, const bf16_t* __restrict__ qs, float* opart, float* lpart, int j, LDSP unsigned char* lds) {
    using namespace cfg;
    const int tid = (int)tid_now(), tid_ = tid, w = __builtin_amdgcn_readfirstlane(tid >> 6), lane = tid & 63, l31 = lane & 31, h5 = lane >> 5, kb = w & 3, dh = w >> 2;
    const float* ckv = c.in[I_CKV] + (size_t)j * NPOOL * PAGE * KVL; const float* kpe = c.in[I_KPE] + (size_t)j * NPOOL * PAGE * ROPE;
    const float B2 = __builtin_bit_cast(float, __builtin_amdgcn_readfirstlane(__builtin_bit_cast(int, mla_b2_bound(c, j, lane))));
    for (int it = blockIdx.x; it < DB * 2; it += gridDim.x) {
        const int s = it >> 1, hf = it & 1, rot = 2 * ((blockIdx.x >> 3) & 7);
        f32x16_t O[4], Lacc;
#pragma unroll
        for (int r = 0; r < 16; ++r) { O[0][r] = 0.f; O[1][r] = 0.f; O[2][r] = 0.f; O[3][r] = 0.f; Lacc[r] = 0.f; }
        pg8::u32x4 wr[4];
        __syncthreads();
        {
            int t_ = tid_; asm volatile("" : "+v"(t_));
            const char* wsrc = (const char*)(fm.wukvt + (size_t)rot * NOPE * KVL); const unsigned vo = (unsigned)t_ * 16u; LDSP unsigned char* wdst = lds + SD_WBUF + (t_ >> 5) * 1040 + (t_ & 31) * 16;
            pg8::u32x4 t0 = *(const pg8::u32x4*)(wsrc + vo), t1 = *(const pg8::u32x4*)(wsrc + 8192 + vo), t2 = *(const pg8::u32x4*)(wsrc + 16384 + vo), t3 = *(const pg8::u32x4*)(wsrc + 24576 + vo);
            *(LDSP pg8::u32x4*)(wdst) = t0; *(LDSP pg8::u32x4*)(wdst + 16640) = t1; *(LDSP pg8::u32x4*)(wdst + 512) = t2; *(LDSP pg8::u32x4*)(wdst + 17152) = t3;
#pragma unroll
            for (int k = 0; k < 4; ++k) wr[k] = *(const pg8::u32x4*)(wsrc + NOPE * KVL * 2 + k * 8192 + vo);
        }
        for (int pi = 0; pi < NPAGES / 2; ++pi) {
            const int pg = __builtin_amdgcn_readfirstlane(c.page_table[s * NPAGES + hf * (NPAGES / 2) + pi]);
            __syncthreads();
            { const char* src = (const char*)(ckv + (size_t)pg * PAGE * KVL); int tid = tid_; asm volatile("" : "+v"(tid));
              pg8::f32x4 v[16];
#pragma unroll
              for (int k = 0; k < 16; ++k) v[k] = __builtin_nontemporal_load((const pg8::f32x4*)(src + (size_t)k * 8192 + (unsigned)tid * 16u));
#pragma unroll
              for (int k = 0; k < 16; ++k) { pg8::u32x2 o; o.x = pk2bf(v[k][0], v[k][1]); o.y = pk2bf(v[k][2], v[k][3]);
                  *(LDSP pg8::u32x2*)(lds + SD_CIMG + ((tid >> 6) + 8 * k) * SD_CROW + (tid & 63) * 8) = o; } }
#if defined(PROBE_DUP) && (PROBE_DUP & (1 << 20))
            { const char* src = (const char*)(ckv + (size_t)pg * PAGE * KVL); int tid = tid_; asm volatile("" : "+v"(tid));
              pg8::f32x4 v[16];
#pragma unroll
              for (int k = 0; k < 16; ++k) v[k] = *(const pg8::f32x4*)(src + (size_t)k * 8192 + (unsigned)tid * 16u);
#pragma unroll
              for (int k = 0; k < 16; ++k) { pg8::u32x2 o; o.x = pk2bf(v[k][0], v[k][1]); o.y = pk2bf(v[k][2], v[k][3]);
                  *(LDSP pg8::u32x2*)(lds + SD_CIMG + ((tid >> 6) + 8 * k) * SD_CROW + (tid & 63) * 8) = o; } }
#endif
            bf16x8v kpfr[2];
            if (dh == 0) {
#pragma unroll
                for (int s_ = 0; s_ < 2; ++s_) { const float* kp = kpe + ((size_t)pg * PAGE + 32 * kb + l31) * ROPE + 16 * s_ + 8 * h5; const pg8::f32x4 a = *(const pg8::f32x4*)kp, b = *(const pg8::f32x4*)(kp + 4);
                    kpfr[s_] = __builtin_bit_cast(bf16x8v, (pg8::u32x4){pk2bf(a[0], a[1]), pk2bf(a[2], a[3]), pk2bf(b[0], b[1]), pk2bf(b[2], b[3])}); }
            }
            asm volatile("s_waitcnt vmcnt(0)" ::: "memory");
            __syncthreads();
            bf16x8v cfr[16];
#pragma unroll
            for (int s_ = 0; s_ < 16; ++s_) cfr[s_] = *(const LDSP bf16x8v*)(lds + SD_CIMG + (32 * kb + l31) * SD_CROW + (16 * s_ + 8 * h5) * 2);
            sd_group<0>(fm, qs, s, lds, w, lane, l31, h5, kb, dh, rot, cfr, kpfr, wr, O, Lacc, B2);
            sd_group<1>(fm, qs, s, lds, w, lane, l31, h5, kb, dh, rot, cfr, kpfr, wr, O, Lacc, B2);
            sd_group<2>(fm, qs, s, lds, w, lane, l31, h5, kb, dh, rot, cfr, kpfr, wr, O, Lacc, B2);
            sd_group<3>(fm, qs, s, lds, w, lane, l31, h5, kb, dh, rot, cfr, kpfr, wr, O, Lacc, B2);
#if defined(PROBE_DUP) && (PROBE_DUP & (1 << 29))
            __syncthreads();
            sd_group<0, false>(fm, qs, s, lds, w, lane, l31, h5, kb, dh, rot, cfr, kpfr, wr, O, Lacc, B2);
            sd_group<1, false>(fm, qs, s, lds, w, lane, l31, h5, kb, dh, rot, cfr, kpfr, wr, O, Lacc, B2);
            sd_group<2, false>(fm, qs, s, lds, w, lane, l31, h5, kb, dh, rot, cfr, kpfr, wr, O, Lacc, B2);
            sd_group<3, false>(fm, qs, s, lds, w, lane, l31, h5, kb, dh, rot, cfr, kpfr, wr, O, Lacc, B2);
#endif
            __syncthreads();
            sd_pv(3, O[3], Lacc, lds, w, lane, l31, h5);
        }
        {float* op = opart + (size_t)it * (MH * DS) * KVL; int lo_ = lane; asm volatile("" : "+v"(lo_)); const int l31 = lo_ & 31, h5 = lo_ >> 5;
#pragma unroll
        for (int g = 0; g < 4; ++g)
#pragma unroll
            for (int r = 0; r < 16; ++r) op[(size_t)((((4 * g + (r >> 2) + rot) & (MH - 1)) << 3) + (r & 3) + 4 * h5) * KVL + 32 * w + l31] = O[g][r];
        __syncthreads();
        LDSP float* ltab = (LDSP float*)(lds + SD_XCH);
        if (l31 < 4) {
#pragma unroll
            for (int r = 0; r < 16; ++r) ltab[w * 128 + l31 * 32 + (r & 3) + 8 * (r >> 2) + 4 * h5] = Lacc[r];
        }
        __syncthreads();
        { const int t2 = (int)tid_now();
        if (t2 < 128) { float a = 0.f;
#pragma unroll
            for (int ww = 0; ww < 8; ++ww) a += ltab[ww * 128 + t2];
            lpart[(size_t)it * 128 + ((((t2 >> 3) + rot) & (MH - 1)) << 3) + (t2 & 7)] = a; } }
        }
    }
}

__device__ __forceinline__ void mla_sample_combine(const Ctx& c, const FastMla& fm, const float* __restrict__ opart, const float* __restrict__ lpart, int j, LDSP unsigned char* lds) {
    using namespace cfg;
    const int tid = (int)tid_now(), w = tid >> 6, lane = tid & 63, gw = blockIdx.x * 8 + w, ngw = gridDim.x * 8;
    const float B2 = mla_b2_bound(c, j, lane);
    LDSP float* ol = (LDSP float*)(lds + w * 8704); LDSP float* ptab = ol + 8 * KVL; LDSP float* lt = ptab + 64;
    const float* wuv = c.in[I_WUV] + (size_t)j * KVL * MH * VD;
    for (int item = gw; item < DB * MH; item += ngw) {
        const int s = item / MH, h = item % MH, q = lane >> 3, jn = lane & 7;
        const size_t rq = (size_t)MP + s * DS + q, rk = (size_t)MP + s * DS + jn;
        const bf16_t* qv = fm.qf + rq * (MH * QD) + h * QD; const bf16_t* kn = fm.knb + rk * (MH * NOPE) + h * NOPE; const bf16_t* kp = fm.kpb + rk * ROPE;
        const float* wp = wuv + (size_t)h * VD + lane;
        float wa[16];
#pragma unroll
        for (int i = 0; i < 16; ++i) wa[i] = wp[(size_t)i * (MH * VD)];
        float cn[DS][4];
#pragma unroll
        for (int jj = 0; jj < DS; ++jj)
#pragma unroll
            for (int k = 0; k < 4; ++k) cn[jj][k] = bf2f(fm.cb[((size_t)MP + s * DS + jj) * KVL + lane + 64 * k]);
        float sc = 0.f;
#pragma unroll
        for (int d8 = 0; d8 < QD / 8; ++d8) { const pg8::u32x4 a = *(const pg8::u32x4*)(qv + 8 * d8), b = d8 < NOPE / 8 ? *(const pg8::u32x4*)(kn + 8 * d8) : *(const pg8::u32x4*)(kp + 8 * (d8 - NOPE / 8));
            const unsigned aw[4] = {a.x, a.y, a.z, a.w}, bw[4] = {b.x, b.y, b.z, b.w};
#pragma unroll
            for (int e = 0; e < 4; ++e) sc += __uint_as_float(aw[e] << 16) * __uint_as_float(bw[e] << 16) + __uint_as_float(aw[e] & 0xffff0000u) * __uint_as_float(bw[e] & 0xffff0000u); }
        const float p = jn <= q ? exp2f(sc - B2) : 0.f;
        float ls = p; ls += __shfl_xor(ls, 1); ls += __shfl_xor(ls, 2); ls += __shfl_xor(ls, 4);
        ptab[lane] = p;
        if (jn == 0) lt[q] = ls + lpart[(size_t)(2 * s) * 128 + h * DS + q] + lpart[(size_t)(2 * s + 1) * 128 + h * DS + q];
        asm volatile("s_waitcnt lgkmcnt(0)" ::: "memory");
#pragma unroll
        for (int qq = 0; qq < DS; ++qq)
#pragma unroll
            for (int k = 0; k < 4; ++k) { const int r = lane + 64 * k;
                float a = opart[((size_t)(2 * s) * 128 + h * DS + qq) * KVL + r] + opart[((size_t)(2 * s + 1) * 128 + h * DS + qq) * KVL + r];
#pragma unroll
                for (int jj = 0; jj < DS; ++jj) a += ptab[qq * 8 + jj] * cn[jj][k];
                ol[qq * KVL + r] = a; }
        asm volatile("s_waitcnt lgkmcnt(0)" ::: "memory");
        float acc[DS];
#pragma unroll
        for (int qq = 0; qq < DS; ++qq) acc[qq] = 0.f;
        float wb[16];
        for (int r0 = 0; r0 < KVL; r0 += 32) {
#pragma unroll
            for (int i = 0; i < 16; ++i) wb[i] = wp[(size_t)(r0 + 16 + i) * (MH * VD)];
#pragma unroll
            for (int i4 = 0; i4 < 4; ++i4)
#pragma unroll
                for (int qq = 0; qq < DS; ++qq) { const pg8::f32x4 o4 = *(const LDSP pg8::f32x4*)(ol + qq * KVL + r0 + 4 * i4);
                    acc[qq] += o4[0] * wa[4 * i4] + o4[1] * wa[4 * i4 + 1] + o4[2] * wa[4 * i4 + 2] + o4[3] * wa[4 * i4 + 3]; }
            if (r0 + 32 < KVL) {
#pragma unroll
                for (int i = 0; i < 16; ++i) wa[i] = wp[(size_t)(r0 + 32 + i) * (MH * VD)]; }
#pragma unroll
            for (int i4 = 0; i4 < 4; ++i4)
#pragma unroll
                for (int qq = 0; qq < DS; ++qq) { const pg8::f32x4 o4 = *(const LDSP pg8::f32x4*)(ol + qq * KVL + r0 + 16 + 4 * i4);
                    acc[qq] += o4[0] * wb[4 * i4] + o4[1] * wb[4 * i4 + 1] + o4[2] * wb[4 * i4 + 2] + o4[3] * wb[4 * i4 + 3]; }
        }
#pragma unroll
        for (int qq = 0; qq < DS; ++qq) fm.aob[((size_t)MP + s * DS + qq) * (MH * VD) + h * VD + lane] = (bf16_t)(pk2bf(acc[qq] / lt[qq], 0.f) & 0xffffu);
        asm volatile("s_waitcnt lgkmcnt(0)" ::: "memory");
    }
}

struct FastRw {
    bf16_t* xm;
    bf16_t* rkv;
    bf16_t* hb;
    bf16_t* lu;
    float* vf;
    float* ops;
    bf16_t* yo;
    bf16_t *wrkvt, *lorat, *wot;
};
constexpr int RW_REC = 464;
constexpr int RW_CH = 32;
constexpr int RW_BUF = RW_CH * RW_REC * 4;
struct RwSel { __device__ static __forceinline__ int sel(int pn) { return pn < 12 ? (pn >> 2) : (pn == 15 ? 2 : pn - 9); } };

__device__ __forceinline__ void rw_mix_fast(const Ctx& c, const FastRw& fr, int l, int gw, int ngw, int lane, const float* xprompt = nullptr) {
    using namespace cfg; const int j = l / 3;
    const float* gain = c.in[I_NMIX] + l * D;
    pg8::f32x4 gv[4], muv[6][4];
#pragma unroll
    for (int q = 0; q < 4; ++q) { gv[q] = *(const pg8::f32x4*)(gain + 4 * lane + 256 * q);
#pragma unroll
        for (int p = 0; p < 6; ++p) muv[p][q] = *(const pg8::f32x4*)(c.in[I_MU] + ((size_t)j * 6 + p) * D + 4 * lane + 256 * q); }
    for (int m = gw; m < MTOT; m += ngw) {
        const int t = row_t(m), sq = row_seq(m);
        const float* xsrc = (xprompt && m < MP) ? xprompt : c.x;
        pg8::f32x4 xc[4], xp[4]; float s = 0.f, sp = 0.f;
#pragma unroll
        for (int q = 0; q < 4; ++q) { xc[q] = *(const pg8::f32x4*)(xsrc + (size_t)m * D + 4 * lane + 256 * q);
            s += (xc[q][0] * xc[q][0] + xc[q][1] * xc[q][1]) + (xc[q][2] * xc[q][2] + xc[q][3] * xc[q][3]); }
        if (t > 0) {
#pragma unroll
            for (int q = 0; q < 4; ++q) { xp[q] = *(const pg8::f32x4*)(xsrc + (size_t)(m - 1) * D + 4 * lane + 256 * q); sp += (xp[q][0] * xp[q][0] + xp[q][1] * xp[q][1]) + (xp[q][2] * xp[q][2] + xp[q][3] * xp[q][3]); }
        }
        const float rs = 1.0f / sqrtf(wave_sum64(s) * (1.0f / D) + NORM_EPS), rsp = 1.0f / sqrtf(wave_sum64(sp) * (1.0f / D) + NORM_EPS);
#pragma unroll
        for (int q = 0; q < 4; ++q) {
#pragma unroll
            for (int e = 0; e < 4; ++e) xc[q][e] = xc[q][e] * rs * gv[q][e];
            if (t > 0) {
#pragma unroll
                for (int e = 0; e < 4; ++e) xp[q][e] = xp[q][e] * rsp * gv[q][e];
            } else if (sq < BATCH) xp[q] = (pg8::f32x4){0.f, 0.f, 0.f, 0.f};
            else xp[q] = *(const pg8::f32x4*)(c.in[I_SHIFT] + ((size_t)j * DB + (sq - BATCH)) * D + 4 * lane + 256 * q);
        }
        if (t == seq_len(sq) - 1) {
            float* so = sq < BATCH ? c.out + O_SHP + ((size_t)j * BATCH + sq) * D : c.out + O_SHS + ((size_t)j * DB + (sq - BATCH)) * D;
#pragma unroll
            for (int q = 0; q < 4; ++q) *(pg8::f32x4*)(so + 4 * lane + 256 * q) = xc[q];
        }
#pragma unroll
        for (int p = 0; p < 6; ++p)
#pragma unroll
            for (int q = 0; q < 4; ++q) { const pg8::f32x4 mu = muv[p][q];
                pg8::u32x2 o; o.x = pk2bf(xc[q][0] + (xp[q][0] - xc[q][0]) * mu[0], xc[q][1] + (xp[q][1] - xc[q][1]) * mu[1]); o.y = pk2bf(xc[q][2] + (xp[q][2] - xc[q][2]) * mu[2], xc[q][3] + (xp[q][3] - xc[q][3]) * mu[3]);
                *(pg8::u32x2*)(fr.xm + ((size_t)p * MTOT + m) * D + 4 * lane + 256 * q) = o; }
        if (lane < 32) *(unsigned*)(fr.hb + (size_t)m * 384 + 320 + 2 * lane) = 0u;
    }
}
struct EpiRwkv {
    static constexpr bool PERM = true;
    bf16_t* rkv; bf16_t* hb;
    __device__ __forceinline__ void operator()(const pg8::f32x4 (&acc)[2][2][4][2], const pg8::Unit& u, int wr, int wc, int fr, int fq) const {
        using namespace pg8;
        const int row0 = u.pm * BM + wr * 64 + fr, cl0 = wc * 32 + 8 * fq;
        const int pn = u.pn;
        bf16_t* base; int ldc, coff, nvalid, act = 0;
        if (pn < 12) { base = rkv; ldc = 3072; coff = pn * 256; nvalid = 256; }
        else { base = hb; ldc = 384; if (pn == 12) { coff = 0; nvalid = 64; act = 1; } else if (pn == 13) { coff = 64; nvalid = 64; } else if (pn == 14) { coff = 128; nvalid = 160; act = 2; } else { coff = 288; nvalid = 32; } }
#pragma unroll
        for (int ai = 0; ai < 2; ++ai)
#pragma unroll
            for (int m = 0; m < 4; ++m) { bf16_t* rowp = base + (size_t)(row0 + ai * HALF + m * 16) * ldc + coff;
#pragma unroll
                for (int bj = 0; bj < 2; ++bj) { const int cl = cl0 + bj * HALF; if (cl >= nvalid) continue;
                    f32x4 v0 = acc[ai][bj][m][0], v1 = acc[ai][bj][m][1];
                    if (act == 1) {
#pragma unroll
                        for (int e = 0; e < 4; ++e) { v0[e] = 1.0f - 2.0f * __builtin_amdgcn_rcpf(1.0f + __expf(2.0f * v0[e])); v1[e] = 1.0f - 2.0f * __builtin_amdgcn_rcpf(1.0f + __expf(2.0f * v1[e])); } }
                    else if (act == 2) {
#pragma unroll
                        for (int e = 0; e < 4; ++e) { v0[e] = __builtin_amdgcn_rcpf(1.0f + __expf(-v0[e])); v1[e] = __builtin_amdgcn_rcpf(1.0f + __expf(-v1[e])); } }
                    u32x4 w; w.x = cvt_pk_bf16(v0[0], v0[1]); w.y = cvt_pk_bf16(v0[2], v0[3]); w.z = cvt_pk_bf16(v1[0], v1[1]); w.w = cvt_pk_bf16(v1[2], v1[3]);
                    *(u32x4*)(rowp + cl) = w; } }
    }
};
__device__ __forceinline__ void rw_build_lorat(const Ctx& c, bf16_t* lorat, int j, size_t gtid, size_t gsz) {
    using namespace cfg;
    for (size_t i = gtid; i < (size_t)4096 * 384; i += gsz) {
        const int n = (int)(i / 384), k = (int)(i % 384), grp = n >> 10, ch = n & 1023; float v = 0.f;
        if (grp == 0 && k < 64) v = c.in[I_W2][((size_t)j * RW_DL + k) * D + ch];
        else if (grp == 1 && k >= 64 && k < 128) v = c.in[I_A2][((size_t)j * RW_AL + (k - 64)) * D + ch];
        else if (grp == 2 && k >= 128 && k < 288) v = c.in[I_G2][((size_t)j * RW_GL + (k - 128)) * D + ch];
        else if (grp == 3 && k >= 288 && k < 320 && j > 0) v = c.in[I_V2][((size_t)(j - 1) * RW_VL + (k - 288)) * D + ch];
        lorat[i] = (bf16_t)(pk2bf(v, 0.f) & 0xffffu);
    }
}
__device__ __forceinline__ size_t rw_rec_base(int sq, int h) {
    using namespace cfg;
    return sq < BATCH ? ((size_t)sq * RHEADS + h) * SEQ : (size_t)MP * RHEADS + ((size_t)(sq - BATCH) * RHEADS + h) * DS;
}
__device__ __forceinline__ void rw_prep_fast(const Ctx& c, const FastRw& fr, int l, int gw, int ngw, int lane) {
    using namespace cfg; const int j = l / 3;
    for (int it = gw; it < MTOT * RHEADS; it += ngw) {
        const int m = it / RHEADS, h = it % RHEADS, ch = h * RH + lane;
        const bf16_t* rk = fr.rkv + (size_t)m * 3072 + ch; const bf16_t* lu = fr.lu + (size_t)m * 4096 + ch;
        const float r = bf2f(rk[0]), k0 = bf2f(rk[1024]); float v = bf2f(rk[2048]);
        const float wpre = bf2f(lu[0]), apre = bf2f(lu[1024]), gg = bf2f(lu[2048]), vpre = bf2f(lu[3072]);
        const float wl = -softplusf_(-(c.in[I_W0][j * D + ch] + wpre)) - 0.5f;
        const float w = expf(-expf(wl));
        if (j == 0) fr.vf[(size_t)m * D + ch] = v;
        else v = v + (fr.vf[(size_t)m * D + ch] - v) * sigmoidf_(c.in[I_V0][(j - 1) * D + ch] + vpre);
        const float a = sigmoidf_(c.in[I_A0][j * D + ch] + apre);
        float kk = k0 * c.in[I_KK][j * D + ch];
        const float nn = wave_sum64(kk * kk);
        kk *= 1.0f / fmaxf(sqrtf(nn), 1e-12f);
        const float k2 = k0 * (1.0f + (a - 1.0f) * c.in[I_KA][j * D + ch]);
        const float bo = kk * a;
        const float br = wave_sum64(bo * r), kr = wave_sum64(k2 * r), bonus = wave_sum64(r * k2 * c.in[I_RK][(size_t)j * D + ch]);
        const int sq = row_seq(m), t = row_t(m);
        float* rec = fr.ops + (rw_rec_base(sq, h) + t) * RW_REC;
        rec[lane] = -kk; rec[64 + lane] = w * r; rec[128 + lane] = w; rec[192 + lane] = bo; rec[256 + lane] = k2; rec[320 + lane] = v; rec[384 + lane] = gg;
        if (lane == 0) { rec[448] = br; rec[449] = kr; rec[450] = bonus; }
    }
}
template <int CTRL> __device__ __forceinline__ float dppf(float v) { return __int_as_float(__builtin_amdgcn_update_dpp(0, __float_as_int(v), CTRL, 0xF, 0xF, true)); }
__device__ __forceinline__ float red16(float x) { x += dppf<0xB1>(x); x += dppf<0x4E>(x); x += dppf<0x124>(x); x += dppf<0x128>(x); return x; }
__device__ __forceinline__ void rw_scan_fast(const Ctx& c, const FastRw& fr, int l, LDSP unsigned char* lds) {
    using namespace cfg; const int j = l / 3;
    const int tid = (int)tid_now(), w = __builtin_amdgcn_readfirstlane(tid >> 6), lane = tid & 63, cs = lane & 15, rp = 4 * w + (lane >> 4);
    LDSP float* ybuf = (LDSP float*)(lds + 2 * RW_BUF);
    for (int chain = blockIdx.x; chain < NSEQ * RHEADS; chain += gridDim.x) {
        const int sq = chain / RHEADS, h = chain % RHEADS, T = seq_len(sq), m0 = seq_row0(sq);
        const char* src = (const char*)(fr.ops + rw_rec_base(sq, h) * RW_REC);
        pg8::f32x4 S0, S1;
        if (sq < BATCH) { S0 = (pg8::f32x4){0.f, 0.f, 0.f, 0.f}; S1 = S0; }
        else { const float* s0 = c.in[I_WKV] + ((((size_t)j * DB + (sq - BATCH)) * RHEADS + h) * RH + 2 * rp) * RH + 4 * cs; S0 = *(const pg8::f32x4*)s0; S1 = *(const pg8::f32x4*)(s0 + RH); }
        const int nch = (T + RW_CH - 1) / RW_CH;
#define RW_DMA(n, buf) do { const int nb_ = ((T - (n) * RW_CH < RW_CH ? T - (n) * RW_CH : RW_CH) * RW_REC * 4 + 1023) >> 10; \
            for (int q_ = w; q_ < nb_; q_ += 8) __builtin_amdgcn_global_load_lds((const unsigned*)(src + (size_t)(n) * RW_BUF + (size_t)q_ * 1024 + (unsigned)lane * 16u), (LDSP unsigned*)(lds + (buf) * RW_BUF + q_ * 1024), 16, 0, 0); } while (0)
        __syncthreads();
        RW_DMA(0, 0);
        asm volatile("s_waitcnt vmcnt(0)" ::: "memory");
        __syncthreads();
        for (int n = 0; n < nch; ++n) {
            if (n + 1 < nch) RW_DMA(n + 1, (n + 1) & 1);
            const int tn = T - n * RW_CH < RW_CH ? T - n * RW_CH : RW_CH;
            const LDSP unsigned char* bufp = lds + (n & 1) * RW_BUF;
            for (int t = 0; t < tn; ++t) {
                const LDSP unsigned char* rec = bufp + t * (RW_REC * 4);
                const pg8::f32x4 A = *(const LDSP pg8::f32x4*)(rec + cs * 16), WR = *(const LDSP pg8::f32x4*)(rec + 256 + cs * 16), W = *(const LDSP pg8::f32x4*)(rec + 512 + cs * 16),
                                 B = *(const LDSP pg8::f32x4*)(rec + 768 + cs * 16), K = *(const LDSP pg8::f32x4*)(rec + 1024 + cs * 16);
                const pg8::f32x2 V2 = *(const LDSP pg8::f32x2*)(rec + 1280 + rp * 8), SC = *(const LDSP pg8::f32x2*)(rec + 1792);
                float sa0 = (S0[0] * A[0] + S0[1] * A[1]) + (S0[2] * A[2] + S0[3] * A[3]), y0 = (S0[0] * WR[0] + S0[1] * WR[1]) + (S0[2] * WR[2] + S0[3] * WR[3]);
                float sa1 = (S1[0] * A[0] + S1[1] * A[1]) + (S1[2] * A[2] + S1[3] * A[3]), y1 = (S1[0] * WR[0] + S1[1] * WR[1]) + (S1[2] * WR[2] + S1[3] * WR[3]);
                sa0 = red16(sa0); sa1 = red16(sa1); y0 = red16(y0); y1 = red16(y1);
                S0 = S0 * W + sa0 * B + V2[0] * K; S1 = S1 * W + sa1 * B + V2[1] * K;
                if (cs == 0) *(LDSP pg8::f32x2*)(ybuf + t * RH + 2 * rp) = (pg8::f32x2){y0 + sa0 * SC[0] + V2[0] * SC[1], y1 + sa1 * SC[0] + V2[1] * SC[1]};
            }
            asm volatile("s_waitcnt vmcnt(0)" ::: "memory");
            __syncthreads();
            for (int t = w; t < tn; t += 8) {
                const LDSP float* rec = (const LDSP float*)(bufp + t * (RW_REC * 4));
                const float y = ybuf[t * RH + lane], mean = wave_sum64(y) * (1.0f / RH), d = y - mean, var = wave_sum64(d * d) * (1.0f / RH);
                const int ch = h * RH + lane;
                const float yn = d * (1.0f / sqrtf(var + LNX_EPS)) * c.in[I_LNW][j * D + ch] + c.in[I_LNB][j * D + ch];
                const float o = (yn + rec[450] * rec[320 + lane]) * rec[384 + lane];
                fr.yo[(size_t)(m0 + n * RW_CH + t) * D + ch] = (bf16_t)(pk2bf(o, 0.f) & 0xffffu);
            }
            __syncthreads();
        }
#undef RW_DMA
        float* so = (sq < BATCH ? c.out + O_WKVP + (((size_t)j * BATCH + sq) * RHEADS + h) * RH * RH : c.out + O_WKVS + (((size_t)j * DB + (sq - BATCH)) * RHEADS + h) * RH * RH) + (size_t)(2 * rp) * RH + 4 * cs;
        *(pg8::f32x4*)so = S0; *(pg8::f32x4*)(so + RH) = S1;
    }
}
__device__ __forceinline__ float fsigmoid(float x) { return __builtin_amdgcn_rcpf(1.0f + __expf(-x)); }
__device__ __forceinline__ float fsoftplus(float x) { return x > 20.f ? x : __logf(1.0f + __expf(x)); }
__device__ __forceinline__ float rdl(float v, int l) { return __int_as_float(__builtin_amdgcn_readlane(__float_as_int(v), l)); }
__device__ __forceinline__ float wsum_dpp(float x) {
    x = red16(x);
    return (rdl(x, 0) + rdl(x, 16)) + (rdl(x, 32) + rdl(x, 48));
}

struct RwOp { pg8::f32x4 A, WR, W, B, K; pg8::f32x2 V2, SC; };
__device__ __forceinline__ void rw_ldop(RwOp& o, const LDSP unsigned char* rec, int cs, int rp) {
    o.A = *(const LDSP pg8::f32x4*)(rec + cs * 16); o.WR = *(const LDSP pg8::f32x4*)(rec + 256 + cs * 16); o.W = *(const LDSP pg8::f32x4*)(rec + 512 + cs * 16);
    o.B = *(const LDSP pg8::f32x4*)(rec + 768 + cs * 16); o.K = *(const LDSP pg8::f32x4*)(rec + 1024 + cs * 16);
    o.V2 = *(const LDSP pg8::f32x2*)(rec + 1280 + rp * 8); o.SC = *(const LDSP pg8::f32x2*)(rec + 1792);
}
__device__ __forceinline__ float fma_s(float a, float b, float c) { float d; asm("v_fma_f32 %0, %1, %2, %3" : "=v"(d) : "v"(a), "v"(b), "v"(c)); return d; }
__device__ __forceinline__ float mul_s(float a, float b) { float d; asm("v_mul_f32 %0, %1, %2" : "=v"(d) : "v"(a), "v"(b)); return d; }
__device__ __forceinline__ void rw_step(pg8::f32x4& S0, pg8::f32x4& S1, const RwOp& o, LDSP float* yrow, bool wr) {
    float sa0 = fma_s(S0[3], o.A[3], fma_s(S0[2], o.A[2], fma_s(S0[1], o.A[1], mul_s(S0[0], o.A[0]))));
    float sa1 = fma_s(S1[3], o.A[3], fma_s(S1[2], o.A[2], fma_s(S1[1], o.A[1], mul_s(S1[0], o.A[0]))));
    float y0 = fma_s(S0[3], o.WR[3], fma_s(S0[2], o.WR[2], fma_s(S0[1], o.WR[1], mul_s(S0[0], o.WR[0]))));
    float y1 = fma_s(S1[3], o.WR[3], fma_s(S1[2], o.WR[2], fma_s(S1[1], o.WR[1], mul_s(S1[0], o.WR[0]))));
    float t0[4], t1[4];
#pragma unroll
    for (int e = 0; e < 4; ++e) { t0[e] = fma_s(o.K[e], o.V2[0], mul_s(S0[e], o.W[e])); t1[e] = fma_s(o.K[e], o.V2[1], mul_s(S1[e], o.W[e])); }
    red16x4(sa0, sa1, y0, y1);
#pragma unroll
    for (int e = 0; e < 4; ++e) { S0[e] = fma_s(o.B[e], sa0, t0[e]); S1[e] = fma_s(o.B[e], sa1, t1[e]); }
    if (wr) *(LDSP pg8::f32x2*)yrow = (pg8::f32x2){fma_s(o.V2[0], o.SC[1], fma_s(sa0, o.SC[0], y0)), fma_s(o.V2[1], o.SC[1], fma_s(sa1, o.SC[0], y1))};
}
struct RwIn { unsigned short r, k, v, wp, ap, g, vp; float vf; };
template <int J>
__device__ __forceinline__ void rw_scan_fused(const Ctx& c, const FastRw& fr, LDSP unsigned char* lds) {
    using namespace cfg; constexpr int j = J;
    const int tid = (int)tid_now(), w = __builtin_amdgcn_readfirstlane(tid >> 6), lane = tid & 63, cs = lane & 15, rp = 4 * w + (lane >> 4);
    LDSP float* ybuf = (LDSP float*)(lds + 2 * RW_BUF);
    for (int chain = blockIdx.x; chain < NSEQ * RHEADS; chain += gridDim.x) {
        const int sq = chain / RHEADS, h = chain % RHEADS, T = seq_len(sq), m0 = seq_row0(sq), ch = h * RH + lane;
        const float p_w0 = c.in[I_W0][j * D + ch], p_a0 = c.in[I_A0][j * D + ch], p_kk = c.in[I_KK][j * D + ch], p_ka = c.in[I_KA][j * D + ch], p_rk = c.in[I_RK][(size_t)j * D + ch],
                    p_lnw = c.in[I_LNW][j * D + ch], p_lnb = c.in[I_LNB][j * D + ch], p_v0 = j > 0 ? c.in[I_V0][(j - 1) * D + ch] : 0.f;
        pg8::f32x4 S0, S1;
        if (sq < BATCH) { S0 = (pg8::f32x4){0.f, 0.f, 0.f, 0.f}; S1 = S0; }
        else { const float* s0 = c.in[I_WKV] + ((((size_t)j * DB + (sq - BATCH)) * RHEADS + h) * RH + 2 * rp) * RH + 4 * cs; S0 = *(const pg8::f32x4*)s0; S1 = *(const pg8::f32x4*)(s0 + RH); }
        const int nch = (T + RW_CH - 1) / RW_CH;
        RwIn in[4];
#define RW_LOADIN(n) do { _Pragma("unroll") for (int q = 0; q < 4; ++q) { const int t_ = (n) * RW_CH + 4 * w + q; if (t_ < T) { const size_t m_ = (size_t)(m0 + t_); \
                const bf16_t* rk_ = fr.rkv + m_ * 3072 + ch; const bf16_t* lu_ = fr.lu + m_ * 4096 + ch; \
                in[q].r = rk_[0]; in[q].k = rk_[1024]; in[q].v = rk_[2048]; in[q].wp = lu_[0]; in[q].ap = lu_[1024]; in[q].g = lu_[2048]; in[q].vp = lu_[3072]; \
                in[q].vf = j > 0 ? fr.vf[m_ * D + ch] : 0.f; } } } while (0)
#define RW_PREP(n, buf) do { _Pragma("unroll") for (int q = 0; q < 4; ++q) { const int tl_ = 4 * w + q, t_ = (n) * RW_CH + tl_; if (t_ < T) { \
                const float r_ = bf2f(in[q].r), k0_ = bf2f(in[q].k); float v_ = bf2f(in[q].v); \
                const float wl_ = -fsoftplus(-(p_w0 + bf2f(in[q].wp))) - 0.5f, w_ = __expf(-__expf(wl_)); \
                if (j == 0) fr.vf[(size_t)(m0 + t_) * D + ch] = v_; else v_ = v_ + (in[q].vf - v_) * fsigmoid(p_v0 + bf2f(in[q].vp)); \
                const float a_ = fsigmoid(p_a0 + bf2f(in[q].ap)); float kk_ = k0_ * p_kk; \
                const float k2_ = k0_ * (1.0f + (a_ - 1.0f) * p_ka); \
                float n_ = red16(kk_ * kk_), e1_ = red16(r_ * k2_ * p_rk), e2_ = red16(k2_ * r_); \
                n_ = (rdl(n_, 0) + rdl(n_, 16)) + (rdl(n_, 32) + rdl(n_, 48)); e1_ = (rdl(e1_, 0) + rdl(e1_, 16)) + (rdl(e1_, 32) + rdl(e1_, 48)); e2_ = (rdl(e2_, 0) + rdl(e2_, 16)) + (rdl(e2_, 32) + rdl(e2_, 48)); \
                kk_ *= __builtin_amdgcn_rcpf(fmaxf(__builtin_amdgcn_sqrtf(n_), 1e-12f)); const float bo_ = kk_ * a_; const float e3_ = wsum_dpp(bo_ * r_); \
                LDSP float* rec_ = (LDSP float*)(lds + (buf) * RW_BUF + tl_ * (RW_REC * 4)); \
                rec_[lane] = -kk_; rec_[64 + lane] = w_ * r_; rec_[128 + lane] = w_; rec_[192 + lane] = bo_; rec_[256 + lane] = k2_; rec_[320 + lane] = v_; rec_[384 + lane] = bf2f(in[q].g); \
                if (lane == 0) { rec_[448] = e3_; rec_[449] = e2_; rec_[450] = e1_; } } } } while (0)
        __syncthreads();
        RW_LOADIN(0); RW_PREP(0, 0);
        __syncthreads();
        for (int n = 0; n < nch; ++n) {
            if (n + 1 < nch) RW_LOADIN(n + 1);
            const int tn = T - n * RW_CH < RW_CH ? T - n * RW_CH : RW_CH;
            const LDSP unsigned char* bufp = lds + (n & 1) * RW_BUF;
#if defined(PROBE_DUP) && (PROBE_DUP & (1 << 17))
            { RwOp o0, o1; rw_ldop(o0, bufp, cs, rp); pg8::f32x4 T0 = S0, T1 = S1;
              for (int t = 0; t < tn; t += 2) {
                  rw_ldop(o1, bufp + (t + 1) * (RW_REC * 4), cs, rp);
                  rw_step(T0, T1, o0, ybuf + t * RH + 2 * rp, cs == 0);
                  rw_ldop(o0, bufp + (t + 2 < tn ? t + 2 : t) * (RW_REC * 4), cs, rp);
                  rw_step(T0, T1, o1, ybuf + (t + 1) * RH + 2 * rp, cs == 0);
              } asm volatile("" :: "v"(T0), "v"(T1)); }
#endif
            { RwOp o0, o1; rw_ldop(o0, bufp, cs, rp);
              for (int t = 0; t < tn; t += 2) {
                  rw_ldop(o1, bufp + (t + 1) * (RW_REC * 4), cs, rp);
                  rw_step(S0, S1, o0, ybuf + t * RH + 2 * rp, cs == 0);
                  rw_ldop(o0, bufp + (t + 2 < tn ? t + 2 : t) * (RW_REC * 4), cs, rp);
                  rw_step(S0, S1, o1, ybuf + (t + 1) * RH + 2 * rp, cs == 0);
              } }
            if (n + 1 < nch) RW_PREP(n + 1, (n + 1) & 1);
#if defined(PROBE_DUP) && (PROBE_DUP & (1 << 18))
            if (n + 1 < nch) RW_PREP(n + 1, (n + 1) & 1);
#endif
            __syncthreads();
            for (int t = w; t < tn; t += 8) {
                const LDSP float* rec = (const LDSP float*)(bufp + t * (RW_REC * 4));
                const float y = ybuf[t * RH + lane], mean = wsum_dpp(y) * (1.0f / RH), d = y - mean, var = wsum_dpp(d * d) * (1.0f / RH);
                const float yn = d * __builtin_amdgcn_rsqf(var + LNX_EPS) * p_lnw + p_lnb;
                const float o = (yn + rec[450] * rec[320 + lane]) * rec[384 + lane];
                fr.yo[(size_t)(m0 + n * RW_CH + t) * D + ch] = (bf16_t)(pk2bf(o, 0.f) & 0xffffu);
            }
            __syncthreads();
        }
#undef RW_LOADIN
#undef RW_PREP
        float* so = (sq < BATCH ? c.out + O_WKVP + (((size_t)j * BATCH + sq) * RHEADS + h) * RH * RH : c.out + O_WKVS + (((size_t)j * DB + (sq - BATCH)) * RHEADS + h) * RH * RH) + (size_t)(2 * rp) * RH + 4 * cs;
        *(pg8::f32x4*)so = S0; *(pg8::f32x4*)(so + RH) = S1;
    }
}
struct FastMb {
    bf16_t* zb;
    bf16_t* xbcr;
    float* dtraw;
    bf16_t* xbcb;
    float* dt;
    float* y;
    bf16_t* yzn;
    bf16_t *wbint, *wbot;
};
struct EpiMamba {
    static constexpr bool PERM = true;
    bf16_t* zb; bf16_t* xbcr; float* dtraw;
    __device__ __forceinline__ void operator()(const pg8::f32x4 (&acc)[2][2][4][2], const pg8::Unit& u, int wr, int wc, int fr, int fq) const {
        using namespace pg8;
        const int row0 = u.pm * BM + wr * 64 + fr, cl0 = wc * 32 + 8 * fq, pn = u.pn;
        if (pn < 20) {
            bf16_t* base = pn < 8 ? zb : xbcr; const int ldc = pn < 8 ? 2048 : 3072, coff = pn < 8 ? pn * 256 : (pn - 8) * 256;
#pragma unroll
            for (int ai = 0; ai < 2; ++ai)
#pragma unroll
                for (int m = 0; m < 4; ++m) { bf16_t* rowp = base + (size_t)(row0 + ai * HALF + m * 16) * ldc + coff + cl0;
#pragma unroll
                    for (int bj = 0; bj < 2; ++bj) { const f32x4 v0 = acc[ai][bj][m][0], v1 = acc[ai][bj][m][1];
                        u32x4 w; w.x = cvt_pk_bf16(v0[0], v0[1]); w.y = cvt_pk_bf16(v0[2], v0[3]); w.z = cvt_pk_bf16(v1[0], v1[1]); w.w = cvt_pk_bf16(v1[2], v1[3]);
                        *(u32x4*)(rowp + bj * HALF) = w; } }
        } else if (cl0 < 32) {
#pragma unroll
            for (int ai = 0; ai < 2; ++ai)
#pragma unroll
                for (int m = 0; m < 4; ++m) { float* rowp = dtraw + (size_t)(row0 + ai * HALF + m * 16) * 32 + cl0;
                    *(f32x4*)rowp = acc[ai][0][m][0]; *(f32x4*)(rowp + 4) = acc[ai][0][m][1]; }
        }
    }
};
__device__ __forceinline__ void mb_conv_fast(const Ctx& c, const FastMb& fb, int l, size_t gtid, size_t gsz, bool write_f32) {
    using namespace cfg; const int j = l / 3; constexpr int NB = MB_CD / 8, TB = 8;
    const int tstride = (int)(gsz / NB), cbi = (int)(gtid % NB), tb0 = (int)(gtid / NB);
    if (tb0 < tstride) {
    const int cb = cbi * 8;
    float wt[MB_CONV][8], bias[8];
        { const pg8::f32x4 b0 = *(const pg8::f32x4*)(c.in[I_CONVB] + j * MB_CD + cb), b1 = *(const pg8::f32x4*)(c.in[I_CONVB] + j * MB_CD + cb + 4);
#pragma unroll
          for (int e = 0; e < 4; ++e) { bias[e] = b0[e]; bias[4 + e] = b1[e]; } }
#pragma unroll
        for (int jj = 0; jj < MB_CONV; ++jj) { const float* wp_ = c.in[I_CONVW] + ((size_t)j * MB_CONV + jj) * MB_CD + cb; const pg8::f32x4 w0 = *(const pg8::f32x4*)wp_, w1 = *(const pg8::f32x4*)(wp_ + 4);
#pragma unroll
            for (int e = 0; e < 4; ++e) { wt[jj][e] = w0[e]; wt[jj][4 + e] = w1[e]; } }
    for (int tbi = tb0; tbi < MTOT / TB; tbi += tstride) {
        const int mb = tbi * TB, t0 = row_t(mb), sq = row_seq(mb), T = seq_len(sq);
        float win[MB_CONV][8];
#pragma unroll
        for (int jj = 0; jj < MB_CONV - 1; ++jj) {
            const int tt = t0 + jj - (MB_CONV - 1);
            if (tt >= 0) { const pg8::u32x4 raw = *(const pg8::u32x4*)(fb.xbcr + (size_t)(mb + jj - (MB_CONV - 1)) * MB_CD + cb); const unsigned wv[4] = {raw.x, raw.y, raw.z, raw.w};
#pragma unroll
                for (int q = 0; q < 4; ++q) { win[jj][2 * q] = __uint_as_float(wv[q] << 16); win[jj][2 * q + 1] = __uint_as_float(wv[q] & 0xffff0000u); } }
            else if (sq >= BATCH) { const float* st = c.in[I_CONV] + (((size_t)j * DB + (sq - BATCH)) * (MB_CONV - 1) + (tt + MB_CONV - 1)) * MB_CD + cb;
#pragma unroll
                for (int e = 0; e < 8; ++e) win[jj][e] = st[e]; }
            else {
#pragma unroll
                for (int e = 0; e < 8; ++e) win[jj][e] = 0.f; }
        }
#pragma unroll
        for (int tb = 0; tb < TB; ++tb) {
            const int m = mb + tb, t = t0 + tb;
            { const pg8::u32x4 raw = *(const pg8::u32x4*)(fb.xbcr + (size_t)m * MB_CD + cb); const unsigned wv[4] = {raw.x, raw.y, raw.z, raw.w};
#pragma unroll
              for (int q = 0; q < 4; ++q) { win[3][2 * q] = __uint_as_float(wv[q] << 16); win[3][2 * q + 1] = __uint_as_float(wv[q] & 0xffff0000u); } }
            if (t >= T - (MB_CONV - 1)) {
                float* so = (sq < BATCH ? c.out + O_CONVP + (((size_t)j * BATCH + sq) * (MB_CONV - 1) + (t - (T - (MB_CONV - 1)))) * MB_CD
                                        : c.out + O_CONVS + (((size_t)j * DB + (sq - BATCH)) * (MB_CONV - 1) + (t - (T - (MB_CONV - 1)))) * MB_CD) + cb;
#pragma unroll
                for (int e = 0; e < 8; ++e) so[e] = win[3][e];
            }
            unsigned w[4];
#pragma unroll
            for (int q = 0; q < 4; ++q) {
                float a0 = bias[2 * q], a1 = bias[2 * q + 1];
#pragma unroll
                for (int jj = 0; jj < MB_CONV; ++jj) { a0 += win[jj][2 * q] * wt[jj][2 * q]; a1 += win[jj][2 * q + 1] * wt[jj][2 * q + 1]; }
                a0 = a0 * __builtin_amdgcn_rcpf(1.0f + __expf(-a0)); a1 = a1 * __builtin_amdgcn_rcpf(1.0f + __expf(-a1));
                w[q] = pk2bf(a0, a1); if (write_f32) { c.xbc[(size_t)m * MB_CD + cb + 2 * q] = a0; c.xbc[(size_t)m * MB_CD + cb + 2 * q + 1] = a1; } }
            *(pg8::u32x4*)(fb.xbcb + (size_t)m * MB_CD + cb) = (pg8::u32x4){w[0], w[1], w[2], w[3]};
#pragma unroll
            for (int jj = 0; jj < MB_CONV - 1; ++jj)
#pragma unroll
                for (int e = 0; e < 8; ++e) win[jj][e] = win[jj + 1][e];
        }
    }
    }
    for (size_t i = gtid; i < (size_t)MTOT * MB_HEADS; i += gsz) {
        const float v = softplusf_(fb.dtraw[i] + c.in[I_DTB][j * MB_HEADS + (int)(i % MB_HEADS)]);
        fb.dt[i] = v; if (write_f32) c.dt[i] = v;
    }
}
__device__ __forceinline__ void mb_gate_fast(const Ctx& c, const FastMb& fb, const float* __restrict__ y, int l, int gw, int ngw, int lane) {
    using namespace cfg; const int j = l / 3; constexpr int GW_ = MB_INNER / MB_GROUPS;
    const int g0 = gw % MB_GROUPS; const bool gfix = (ngw % MB_GROUPS) == 0;
    const float* nwp0 = c.in[I_BNORM] + j * MB_INNER + g0 * GW_ + 8 * lane; const pg8::f32x4 n0h = *(const pg8::f32x4*)nwp0, n1h = *(const pg8::f32x4*)(nwp0 + 4);
    for (int it = gw; it < MTOT * MB_GROUPS; it += ngw) {
        const int m = it / MB_GROUPS, g = it % MB_GROUPS; const size_t o = (size_t)m * MB_INNER + g * GW_ + 8 * lane;
        const pg8::f32x4 y0 = *(const pg8::f32x4*)(y + o), y1 = *(const pg8::f32x4*)(y + o + 4); const pg8::u32x4 zr = *(const pg8::u32x4*)(fb.zb + o);
        const unsigned zw[4] = {zr.x, zr.y, zr.z, zr.w}; float v[8]; float s = 0.f;
#pragma unroll
        for (int q = 0; q < 4; ++q) { const float z0 = __uint_as_float(zw[q] << 16), z1 = __uint_as_float(zw[q] & 0xffff0000u);
            v[2 * q] = (q < 2 ? y0[2 * q] : y1[2 * q - 4]) * (z0 * __builtin_amdgcn_rcpf(1.0f + __expf(-z0))); v[2 * q + 1] = (q < 2 ? y0[2 * q + 1] : y1[2 * q - 3]) * (z1 * __builtin_amdgcn_rcpf(1.0f + __expf(-z1))); s += v[2 * q] * v[2 * q] + v[2 * q + 1] * v[2 * q + 1]; }
        const float rs = 1.0f / sqrtf(wave_sum64(s) * (1.0f / GW_) + NORM_EPS);
        pg8::f32x4 n0 = n0h, n1 = n1h; if (!gfix) { const float* nwp = c.in[I_BNORM] + j * MB_INNER + g * GW_ + 8 * lane; n0 = *(const pg8::f32x4*)nwp; n1 = *(const pg8::f32x4*)(nwp + 4); }
        const float nw[8] = {n0[0], n0[1], n0[2], n0[3], n1[0], n1[1], n1[2], n1[3]}; unsigned w[4];
#pragma unroll
        for (int q = 0; q < 4; ++q) w[q] = pk2bf(v[2 * q] * rs * nw[2 * q], v[2 * q + 1] * rs * nw[2 * q + 1]);
        *(pg8::u32x4*)(fb.yzn + o) = (pg8::u32x4){w[0], w[1], w[2], w[3]};
    }
}
constexpr int SS_XR = 144, SS_BR = 272;
constexpr int SS_XIM = 0, SS_XSM = SS_XIM + 128 * SS_XR, SS_BIM = SS_XSM + 128 * SS_XR, SS_CIM = SS_BIM + 128 * SS_BR, SS_MTM = SS_CIM + 128 * SS_BR, SS_HBM = SS_MTM + 128 * SS_BR, SS_TAB = SS_HBM + 128 * SS_XR, SS_END = SS_TAB + 2048;
__device__ __forceinline__ bf16x8v ss_trfrag(const LDSP unsigned char* img, int rowstride, int k0, int col0, int lane) {
    const int r0 = k0 + 8 * (lane >> 5) + ((lane & 15) >> 2), cc = col0 + 16 * ((lane >> 4) & 1) + 4 * (lane & 3);
    const s16x4 t0 = __builtin_amdgcn_ds_read_tr16_b64_v4i16((LDSP s16x4*)(img + r0 * rowstride + cc * 2));
    const s16x4 t1 = __builtin_amdgcn_ds_read_tr16_b64_v4i16((LDSP s16x4*)(img + (r0 + 4) * rowstride + cc * 2));
    return (bf16x8v){t0[0], t0[1], t0[2], t0[3], t1[0], t1[1], t1[2], t1[3]};
}
__device__ __forceinline__ void mb_ssd_prompt(const Ctx& c, const FastMb& fb, int l, LDSP unsigned char* lds) {
    using namespace cfg; const int j = l / 3;
    const int tid = (int)tid_now(), w = __builtin_amdgcn_readfirstlane(tid >> 6), lane = tid & 63, l31 = lane & 31, h5 = lane >> 5;
    LDSP float* tab = (LDSP float*)(lds + SS_TAB);
    for (int chain = blockIdx.x; chain < BATCH * MB_HEADS; chain += gridDim.x) {
        const int b = chain / MB_HEADS, hd = chain % MB_HEADS, g = hd / (MB_HEADS / MB_GROUPS);
        const float Ah = -expf(c.in[I_ALOG][j * MB_HEADS + hd]), Dh = c.in[I_BD][j * MB_HEADS + hd];
        f32x16_t H;
#pragma unroll
        for (int r = 0; r < 16; ++r) H[r] = 0.f;
        pg8::u32x4 nx[2], nB[4], nC[4]; float ndt0 = 0.f, ndt1 = 0.f;
#define SS_LOAD(ck_) do { const size_t mm_ = (size_t)b * SEQ + 128 * (ck_); int tq_ = tid; asm volatile("" : "+v"(tq_)); \
            _Pragma("unroll") for (int q = 0; q < 2; ++q) { const int ci = tq_ + 512 * q; nx[q] = *(const pg8::u32x4*)(fb.xbcb + (mm_ + (ci >> 3)) * MB_CD + hd * MB_HEAD + (ci & 7) * 8); } \
            _Pragma("unroll") for (int q = 0; q < 4; ++q) { const int ci = tq_ + 512 * q; const bf16_t* rowp = fb.xbcb + (mm_ + (ci >> 4)) * MB_CD + MB_INNER + g * MB_STATE + (ci & 15) * 8; \
                nB[q] = *(const pg8::u32x4*)rowp; nC[q] = *(const pg8::u32x4*)(rowp + MB_GN); } \
            ndt0 = fb.dt[(mm_ + 2 * (tq_ & 63)) * MB_HEADS + hd]; ndt1 = fb.dt[(mm_ + 2 * (tq_ & 63) + 1) * MB_HEADS + hd]; } while (0)
        SS_LOAD(0);
        for (int ck = 0; ck < SEQ / 128; ++ck) {
            const size_t m0 = (size_t)b * SEQ + 128 * ck;
            int tl = tid; asm volatile("" : "+v"(tl));
            pg8::u32x4 xr[2];
#pragma unroll
            for (int q = 0; q < 2; ++q) { const int ci = tl + 512 * q; xr[q] = nx[q];
                *(LDSP pg8::u32x2*)(lds + SS_XIM + (ci >> 3) * SS_XR + (ci & 7) * 16) = (pg8::u32x2){xr[q].x, xr[q].y}; *(LDSP pg8::u32x2*)(lds + SS_XIM + (ci >> 3) * SS_XR + (ci & 7) * 16 + 8) = (pg8::u32x2){xr[q].z, xr[q].w}; }
#pragma unroll
            for (int q = 0; q < 4; ++q) { const int ci = tl + 512 * q;
                *(LDSP pg8::u32x4*)(lds + SS_BIM + (ci >> 4) * SS_BR + (ci & 15) * 16) = nB[q];
                *(LDSP pg8::u32x4*)(lds + SS_CIM + (ci >> 4) * SS_BR + (ci & 15) * 16) = nC[q]; }
            float alast;
            { const float v0 = ndt0 * Ah, v1 = ndt1 * Ah; float sacc = v0 + v1;
#pragma unroll
              for (int o = 1; o < 64; o <<= 1) { const float u = __shfl_up(sacc, o); if (lane >= o) sacc += u; }
              tab[2 * lane] = sacc - v1; tab[2 * lane + 1] = sacc; tab[128 + 2 * lane] = ndt0; tab[128 + 2 * lane + 1] = ndt1;
              alast = __int_as_float(__builtin_amdgcn_readlane(__float_as_int(sacc), 63)); }
            if (ck + 1 < SEQ / 128) SS_LOAD(ck + 1);
            asm volatile("s_waitcnt lgkmcnt(0)" ::: "memory");
#pragma unroll
            for (int q = 0; q < 2; ++q) { const int ci = tl + 512 * q, row = ci >> 3; const float sc = __expf(alast - tab[row]) * tab[128 + row]; const unsigned xw[4] = {xr[q].x, xr[q].y, xr[q].z, xr[q].w}; unsigned ow[4];
#pragma unroll
                for (int e = 0; e < 4; ++e) ow[e] = pk2bf(__uint_as_float(xw[e] << 16) * sc, __uint_as_float(xw[e] & 0xffff0000u) * sc);
                *(LDSP pg8::u32x2*)(lds + SS_XSM + row * SS_XR + (ci & 7) * 16) = (pg8::u32x2){ow[0], ow[1]}; *(LDSP pg8::u32x2*)(lds + SS_XSM + row * SS_XR + (ci & 7) * 16 + 8) = (pg8::u32x2){ow[2], ow[3]}; }
            __syncthreads();
            { int ln = lane; asm volatile("" : "+v"(ln)); const int a31 = ln & 31, a5 = ln >> 5;
              for (int tt = w; tt < 10; tt += 8) {
                int ib = tt < 1 ? 0 : (tt < 3 ? 1 : (tt < 6 ? 2 : 3)); const int jb = tt - (ib * (ib + 1)) / 2;
                f32x16_t ST;
#pragma unroll
                for (int r = 0; r < 16; ++r) ST[r] = 0.f;
#pragma unroll
                for (int s = 0; s < 8; ++s) { const bf16x8v a = *(const LDSP bf16x8v*)(lds + SS_BIM + (32 * jb + a31) * SS_BR + (16 * s + 8 * a5) * 2), bb = *(const LDSP bf16x8v*)(lds + SS_CIM + (32 * ib + a31) * SS_BR + (16 * s + 8 * a5) * 2);
                    ST = MFMA32(a, bb, ST); }
                const float ai = tab[32 * ib + a31];
#pragma unroll
                for (int g4 = 0; g4 < 4; ++g4) { const int jr = 32 * jb + 8 * g4 + 4 * a5; const pg8::f32x4 aj = *(const LDSP pg8::f32x4*)(tab + jr), dj = *(const LDSP pg8::f32x4*)(tab + 128 + jr);
#pragma unroll
                    for (int e = 0; e < 4; ++e) { const int jj = jr + e, ii = 32 * ib + a31; const float mv = jj <= ii ? ST[4 * g4 + e] * __expf(ai - aj[e]) * dj[e] : 0.f;
                        *(LDSP bf16_t*)(lds + SS_MTM + jj * SS_BR + ii * 2) = (bf16_t)(pk2bf(mv, 0.f) & 0xffffu); } }
              }
              const int nb = w >> 1, pb = w & 1;
#pragma unroll
              for (int r = 0; r < 16; ++r) *(LDSP bf16_t*)(lds + SS_HBM + (32 * nb + (r & 3) + 8 * (r >> 2) + 4 * a5) * SS_XR + (32 * pb + a31) * 2) = (bf16_t)(pk2bf(H[r], 0.f) & 0xffffu);
            }
            __syncthreads();
            { int ln = lane; asm volatile("" : "+v"(ln)); const int a31 = ln & 31, a5 = ln >> 5;
              const int pb = w & 1, ib = w >> 1, nb = w >> 1;
              f32x16_t Y;
#pragma unroll
              for (int r = 0; r < 16; ++r) Y[r] = 0.f;
#pragma unroll
              for (int s = 0; s < 8; ++s) { const bf16x8v a = ss_trfrag(lds + SS_HBM, SS_XR, 16 * s, 32 * pb, ln), bb = *(const LDSP bf16x8v*)(lds + SS_CIM + (32 * ib + a31) * SS_BR + (16 * s + 8 * a5) * 2);
                  Y = MFMA32(a, bb, Y); if (s & 1) __builtin_amdgcn_sched_barrier(0); }
              const float ei = __expf(tab[32 * ib + a31]);
#pragma unroll
              for (int r = 0; r < 16; ++r) Y[r] *= ei;
              for (int s = 0; s < 2 * (ib + 1); ++s) { const bf16x8v a = ss_trfrag(lds + SS_XIM, SS_XR, 16 * s, 32 * pb, ln), bb = ss_trfrag(lds + SS_MTM, SS_BR, 16 * s, 32 * ib, ln);
                  Y = MFMA32(a, bb, Y); }
              { const size_t mrow = m0 + 32 * ib + a31; float* yrow = fb.y + mrow * MB_INNER + hd * MB_HEAD + 32 * pb + 4 * a5;
#pragma unroll
                for (int g4 = 0; g4 < 4; ++g4) { const pg8::u32x2 xv = *(const LDSP pg8::u32x2*)(lds + SS_XIM + (32 * ib + a31) * SS_XR + (32 * pb + 8 * g4 + 4 * a5) * 2);
                    pg8::f32x4 o; o[0] = Y[4 * g4] + Dh * __uint_as_float(xv.x << 16); o[1] = Y[4 * g4 + 1] + Dh * __uint_as_float(xv.x & 0xffff0000u); o[2] = Y[4 * g4 + 2] + Dh * __uint_as_float(xv.y << 16); o[3] = Y[4 * g4 + 3] + Dh * __uint_as_float(xv.y & 0xffff0000u);
                    *(pg8::f32x4*)(yrow + 8 * g4) = o; } }
              const float dec = __expf(tab[127]);
#pragma unroll
              for (int r = 0; r < 16; ++r) H[r] *= dec;
#pragma unroll
              for (int s = 0; s < 8; ++s) { const bf16x8v a = ss_trfrag(lds + SS_BIM, SS_BR, 16 * s, 32 * nb, ln), bb = ss_trfrag(lds + SS_XSM, SS_XR, 16 * s, 32 * pb, ln);
                  H = MFMA32(a, bb, H); if (s & 1) __builtin_amdgcn_sched_barrier(0); }
            }
            __syncthreads();
        }
#undef SS_LOAD
        { const int nb = w >> 1, pb = w & 1; float* so = c.out + O_SSMP + (((size_t)j * BATCH + b) * MB_HEADS + hd) * MB_HEAD * MB_STATE;
#pragma unroll
          for (int r = 0; r < 16; ++r) so[(size_t)(32 * pb + l31) * MB_STATE + 32 * nb + (r & 3) + 8 * (r >> 2) + 4 * h5] = H[r]; }
    }
}
__device__ __forceinline__ void mb_scan_sample(const Ctx& c, const FastMb& fb, int l) {
    using namespace cfg; const int j = l / 3;
    const int tid = (int)tid_now(), p = tid >> 3, ns = tid & 7;
    pg8::f32x4 hn[4];
    { const int chain = blockIdx.x; if (chain < DB * MB_HEADS) { const size_t so = ((((size_t)j * DB + chain / MB_HEADS) * MB_HEADS + chain % MB_HEADS) * MB_HEAD + p) * MB_STATE + 16 * ns;
#pragma unroll
        for (int q = 0; q < 4; ++q) hn[q] = *(const pg8::f32x4*)(c.in[I_SSM] + so + 4 * q); } }
    for (int chain = blockIdx.x; chain < DB * MB_HEADS; chain += gridDim.x) {
        const int s = chain / MB_HEADS, hd = chain % MB_HEADS, g = hd / (MB_HEADS / MB_GROUPS);
        const float Ah = -expf(c.in[I_ALOG][j * MB_HEADS + hd]), Dh = c.in[I_BD][j * MB_HEADS + hd];
        const size_t so = ((((size_t)j * DB + s) * MB_HEADS + hd) * MB_HEAD + p) * MB_STATE + 16 * ns;
        float hs[16];
#pragma unroll
        for (int q = 0; q < 4; ++q) { hs[4 * q] = hn[q][0]; hs[4 * q + 1] = hn[q][1]; hs[4 * q + 2] = hn[q][2]; hs[4 * q + 3] = hn[q][3]; }
        { const int cn = chain + gridDim.x; if (cn < DB * MB_HEADS) { const size_t sn = ((((size_t)j * DB + cn / MB_HEADS) * MB_HEADS + cn % MB_HEADS) * MB_HEAD + p) * MB_STATE + 16 * ns;
#pragma unroll
            for (int q = 0; q < 4; ++q) hn[q] = *(const pg8::f32x4*)(c.in[I_SSM] + sn + 4 * q); } }
        float dtv[DS]; unsigned short xr[DS]; pg8::u32x4 Bq[DS][2], Cq[DS][2];
#pragma unroll
        for (int t = 0; t < DS; ++t) { const size_t m = (size_t)MP + s * DS + t; dtv[t] = fb.dt[m * MB_HEADS + hd]; xr[t] = fb.xbcb[m * MB_CD + hd * MB_HEAD + p];
            const bf16_t* Bp = fb.xbcb + m * MB_CD + MB_INNER + g * MB_STATE + 16 * ns; Bq[t][0] = *(const pg8::u32x4*)Bp; Bq[t][1] = *(const pg8::u32x4*)(Bp + 8);
            Cq[t][0] = *(const pg8::u32x4*)(Bp + MB_GN); Cq[t][1] = *(const pg8::u32x4*)(Bp + MB_GN + 8); }
#pragma unroll
        for (int t = 0; t < DS; ++t) {
            const size_t m = (size_t)MP + s * DS + t;
            const float dA = __expf(dtv[t] * Ah), xv = bf2f(xr[t]), xdt = xv * dtv[t];
            const unsigned bw[8] = {Bq[t][0].x, Bq[t][0].y, Bq[t][0].z, Bq[t][0].w, Bq[t][1].x, Bq[t][1].y, Bq[t][1].z, Bq[t][1].w};
            const unsigned cw[8] = {Cq[t][0].x, Cq[t][0].y, Cq[t][0].z, Cq[t][0].w, Cq[t][1].x, Cq[t][1].y, Cq[t][1].z, Cq[t][1].w};
            float yy = 0.f;
#pragma unroll
            for (int k = 0; k < 8; ++k) { hs[2 * k] = hs[2 * k] * dA + xdt * __uint_as_float(bw[k] << 16); hs[2 * k + 1] = hs[2 * k + 1] * dA + xdt * __uint_as_float(bw[k] & 0xffff0000u);
                yy += __uint_as_float(cw[k] << 16) * hs[2 * k] + __uint_as_float(cw[k] & 0xffff0000u) * hs[2 * k + 1]; }
            yy += __shfl_xor(yy, 1); yy += __shfl_xor(yy, 2); yy += __shfl_xor(yy, 4);
            if (ns == 0) fb.y[m * MB_INNER + hd * MB_HEAD + p] = yy + Dh * xv;
        }
        float* oo = c.out + O_SSMS + so;
#pragma unroll
        for (int q = 0; q < 4; ++q) *(pg8::f32x4*)(oo + 4 * q) = (pg8::f32x4){hs[4 * q], hs[4 * q + 1], hs[4 * q + 2], hs[4 * q + 3]};
    }
}
constexpr int RC_RS = 144;
constexpr int RC_AT = 0, RC_RT = 4608, RC_BB = 9216, RC_KB = 13824, RC_BH = 18432, RC_KH = 23040, RC_VV = 27648, RC_UT = 32256, RC_GG = 36864;
constexpr int RC_SB = 41472;
constexpr int RC_NAK = 50688, RC_MRB = 53248, RC_MRK = 55808, RC_NS = 80;
constexpr int RC_NAB = 58368;
constexpr int RC_E = 62464;
constexpr int RC_YB = 70656;
constexpr int RC_GL = 78848, RC_BON = 79104, RC_VV2 = 79360, RC_GG2 = RC_VV2 + 4608, RC_END0 = RC_GG2 + 4608;
constexpr int RC_WW = RC_END0, RC_WA = RC_WW + 64 * 144, RC_WG = RC_WA + 64 * 144, RC_WV = RC_WG + 64 * 336, RC_LUO = RC_WV + 64 * 80, RC_END = RC_LUO + 4 * 4608;
constexpr int RC_HB = RC_AT, RC_HBS = 784;
__device__ __forceinline__ bf16x8v rc_nat(const LDSP unsigned char* img, int stride, int row, int kofs) { return *(const LDSP bf16x8v*)(img + row * stride + kofs * 2); }
__device__ __forceinline__ int rc_row(int r, int h5) { return (r & 3) + 8 * (r >> 2) + 4 * h5; }
__device__ __forceinline__ void rc_st16(LDSP unsigned char* p, float v) { *(LDSP bf16_t*)p = (bf16_t)(pk2bf(v, 0.f) & 0xffffu); }


template <int S>
struct RcSub {
    static __device__ __forceinline__ void run(float (&acc)[32], const LDSP float* NAB, LDSP unsigned char* lds, int lane) {
        const float us = acc[S]; rc_st16(lds + RC_UT + S * RC_RS + lane * 2, us);
#pragma unroll
        for (int g4 = 0; g4 < 8; ++g4) { if (4 * g4 + 3 > S) { const pg8::f32x4 nv = *(const LDSP pg8::f32x4*)(NAB + S * 32 + 4 * g4);
#pragma unroll
            for (int e = 0; e < 4; ++e) { if (4 * g4 + e > S) acc[4 * g4 + e] = fmaf(nv[e], us, acc[4 * g4 + e]); } } }
        RcSub<S + 1>::run(acc, NAB, lds, lane);
    }
};
template <> struct RcSub<32> { static __device__ __forceinline__ void run(float (&)[32], const LDSP float*, LDSP unsigned char*, int) {} };

template <int J>
__device__ __forceinline__ void rw_scan_chunked(const Ctx& c, const FastRw& fr, LDSP unsigned char* lds) {
    using namespace cfg; constexpr int j = J;
    const int tid = (int)tid_now(), w = __builtin_amdgcn_readfirstlane(tid >> 6), lane = tid & 63, l31 = lane & 31, h5 = lane >> 5;
    LDSP float* Ef = (LDSP float*)(lds + RC_E); LDSP float* YB = (LDSP float*)(lds + RC_YB); LDSP float* GL = (LDSP float*)(lds + RC_GL); LDSP float* BON = (LDSP float*)(lds + RC_BON);
    LDSP float* NAB = (LDSP float*)(lds + RC_NAB);
    int hcur = -1;
    for (int chain = blockIdx.x; chain < NSEQ * RHEADS; chain += gridDim.x) {
        const int sq = chain / RHEADS, h = chain % RHEADS, T = seq_len(sq), m0 = seq_row0(sq), ch = h * RH + lane;
        const float p_w0 = c.in[I_W0][j * D + ch], p_a0 = c.in[I_A0][j * D + ch], p_kk = c.in[I_KK][j * D + ch], p_ka = c.in[I_KA][j * D + ch], p_rk = c.in[I_RK][(size_t)j * D + ch],
                    p_lnw = c.in[I_LNW][j * D + ch], p_lnb = c.in[I_LNB][j * D + ch], p_v0 = j > 0 ? c.in[I_V0][(j - 1) * D + ch] : 0.f;
        const int ib = (w >> 1) & 1, jb = w & 1;
        f32x16_t ST;
#pragma unroll
        for (int r = 0; r < 16; ++r) ST[r] = 0.f;
        if (w < 4 && sq >= BATCH) { const float* s0 = c.in[I_WKV] + (((size_t)j * DB + (sq - BATCH)) * RHEADS + h) * RH * RH;
#pragma unroll
            for (int r = 0; r < 16; ++r) ST[r] = s0[(size_t)(32 * ib + rc_row(r, h5)) * RH + 32 * jb + l31]; }
        const int nch = (T + 31) / 32;
        if (h != hcur) {
            __syncthreads();
            const bf16_t* lw = fr.lorat + (size_t)j * 4096 * 384;
            for (int ci = tid; ci < 64 * 8; ci += 512) { const int row = ci >> 3, c8 = ci & 7;
                *(LDSP pg8::u32x4*)(lds + RC_WW + row * 144 + c8 * 16) = *(const pg8::u32x4*)(lw + (size_t)(0 * 1024 + h * 64 + row) * 384 + 0 + c8 * 8);
                *(LDSP pg8::u32x4*)(lds + RC_WA + row * 144 + c8 * 16) = *(const pg8::u32x4*)(lw + (size_t)(1 * 1024 + h * 64 + row) * 384 + 64 + c8 * 8); }
            for (int ci = tid; ci < 64 * 20; ci += 512) { const int row = ci / 20, c20 = ci % 20;
                *(LDSP pg8::u32x4*)(lds + RC_WG + row * 336 + c20 * 16) = *(const pg8::u32x4*)(lw + (size_t)(2 * 1024 + h * 64 + row) * 384 + 128 + c20 * 8); }
            for (int ci = tid; ci < 64 * 4; ci += 512) { const int row = ci >> 2, c4 = ci & 3;
                *(LDSP pg8::u32x4*)(lds + RC_WV + row * 80 + c4 * 16) = *(const pg8::u32x4*)(lw + (size_t)(3 * 1024 + h * 64 + row) * 384 + 288 + c4 * 8); }
            hcur = h;
        }
        RwIn in[4]; pg8::u32x4 hbr[3];
#define RC_LOADIN(n) do { _Pragma("unroll") for (int q = 0; q < 4; ++q) { const int t_ = (n) * 32 + 4 * w + q; if (t_ < T) { const size_t m_ = (size_t)(m0 + t_); \
                const bf16_t* rk_ = fr.rkv + m_ * 3072 + ch; in[q].r = rk_[0]; in[q].k = rk_[1024]; in[q].v = rk_[2048]; \
                in[q].vf = j > 0 ? fr.vf[m_ * D + ch] : 0.f; } } \
            _Pragma("unroll") for (int k3 = 0; k3 < 3; ++k3) { const int ci_ = tid + 512 * k3, tk_ = ci_ / 48, t_ = (n) * 32 + tk_; \
                hbr[k3] = t_ < T ? *(const pg8::u32x4*)(fr.hb + (size_t)(m0 + t_) * 384 + (ci_ % 48) * 8) : (pg8::u32x4){0u, 0u, 0u, 0u}; } } while (0)
#define RC_EPI_TOKEN(nn, tl) do { const int vv_ = ((nn) & 1) ? RC_VV2 : RC_VV, gg_ = ((nn) & 1) ? RC_GG2 : RC_GG, bn_ = ((nn) & 1) ? 32 : 0; \
                const float y_ = YB[(tl) * 64 + lane], mean_ = wsum_dpp(y_) * (1.0f / RH), d_ = y_ - mean_, var_ = wsum_dpp(d_ * d_) * (1.0f / RH); \
                const float yn_ = d_ * __builtin_amdgcn_rsqf(var_ + LNX_EPS) * p_lnw + p_lnb; \
                const float o_ = (yn_ + BON[bn_ + (tl)] * bf2f(*(const LDSP bf16_t*)(lds + vv_ + (tl) * RC_RS + lane * 2))) * bf2f(*(const LDSP bf16_t*)(lds + gg_ + (tl) * RC_RS + lane * 2)); \
                fr.yo[(size_t)(m0 + (nn) * 32 + (tl)) * D + ch] = (bf16_t)(pk2bf(o_, 0.f) & 0xffffu); } while (0)
        __syncthreads();
        RC_LOADIN(0);
        for (int n = 0; n < nch; ++n) {
            const int tn = T - n * 32 < 32 ? T - n * 32 : 32;
            const int vvo = (n & 1) ? RC_VV2 : RC_VV, ggo = (n & 1) ? RC_GG2 : RC_GG, bno = (n & 1) ? 32 : 0;
#pragma unroll
            for (int k3 = 0; k3 < 3; ++k3) { const int ci_ = tid + 512 * k3; *(LDSP pg8::u32x4*)(lds + RC_HB + (ci_ / 48) * RC_HBS + (ci_ % 48) * 16) = hbr[k3]; }
            __syncthreads();
            { int ln = lane; asm volatile("" : "+v"(ln)); const int a31 = ln & 31, a5 = ln >> 5; const int grp = w >> 1, nb = w & 1;
              const int koff = grp == 0 ? 0 : (grp == 1 ? 64 : (grp == 2 ? 128 : 288)), nks = grp == 2 ? 10 : (grp == 3 ? 2 : 4);
              const int wof = grp == 0 ? RC_WW : (grp == 1 ? RC_WA : (grp == 2 ? RC_WG : RC_WV)), wst = grp == 2 ? 336 : (grp == 3 ? 80 : 144);
              f32x16_t LA;
#pragma unroll
              for (int r = 0; r < 16; ++r) LA[r] = 0.f;
              for (int ks = 0; ks < nks; ++ks) LA = MFMA32(rc_nat(lds + RC_HB, RC_HBS, a31, koff + 16 * ks + 8 * a5), rc_nat(lds + wof, wst, 32 * nb + a31, 16 * ks + 8 * a5), LA);
#pragma unroll
              for (int r = 0; r < 16; ++r) rc_st16(lds + RC_LUO + grp * 4608 + rc_row(r, a5) * RC_RS + (32 * nb + a31) * 2, LA[r]); }
            __syncthreads();
            float q_r[4], q_k[4], q_a[4], q_b[4], q_e[4];
#pragma unroll
            for (int q = 0; q < 4; ++q) {
                const int tl = 4 * w + q, tg = n * 32 + tl;
                float r_ = 0.f, k2_ = 0.f, v_ = 0.f, a_ = 0.f, b_ = 0.f, e_ = 0.f, g_ = 0.f, bon_ = 0.f;
                if (tg < T) {
                    r_ = bf2f(in[q].r); const float k0_ = bf2f(in[q].k); v_ = bf2f(in[q].v);
                    e_ = 0.6065306597126334f * fsigmoid(p_w0 + bf2f(*(const LDSP bf16_t*)(lds + RC_LUO + 0 * 4608 + tl * RC_RS + lane * 2)));
                    if (j == 0) fr.vf[(size_t)(m0 + tg) * D + ch] = v_; else v_ = v_ + (in[q].vf - v_) * fsigmoid(p_v0 + bf2f(*(const LDSP bf16_t*)(lds + RC_LUO + 3 * 4608 + tl * RC_RS + lane * 2)));
                    const float as_ = fsigmoid(p_a0 + bf2f(*(const LDSP bf16_t*)(lds + RC_LUO + 1 * 4608 + tl * RC_RS + lane * 2))); float kk_ = k0_ * p_kk;
                    k2_ = k0_ * (1.0f + (as_ - 1.0f) * p_ka);
                    float n_ = red16(kk_ * kk_), e1_ = red16(r_ * k2_ * p_rk);
                    n_ = (rdl(n_, 0) + rdl(n_, 16)) + (rdl(n_, 32) + rdl(n_, 48)); bon_ = (rdl(e1_, 0) + rdl(e1_, 16)) + (rdl(e1_, 32) + rdl(e1_, 48));
                    kk_ *= __builtin_amdgcn_rcpf(fmaxf(__builtin_amdgcn_sqrtf(n_), 1e-12f));
                    a_ = -kk_; b_ = kk_ * as_; g_ = bf2f(*(const LDSP bf16_t*)(lds + RC_LUO + 2 * 4608 + tl * RC_RS + lane * 2));
                }
                q_r[q] = r_; q_k[q] = k2_; q_a[q] = a_; q_b[q] = b_; q_e[q] = e_;
                Ef[tl * 64 + lane] = e_;
                rc_st16(lds + vvo + tl * RC_RS + lane * 2, v_); rc_st16(lds + ggo + tl * RC_RS + lane * 2, g_);
                if (lane == 0) BON[bno + tl] = bon_;
            }
            if (n + 1 < nch) RC_LOADIN(n + 1);
            if (w < 4) {
#pragma unroll
                for (int r = 0; r < 16; ++r) rc_st16(lds + RC_SB + (32 * ib + rc_row(r, h5)) * RC_RS + (32 * jb + l31) * 2, ST[r]);
            }
            __syncthreads();
            { float run = 0.f, base = 0.f;
#pragma unroll
              for (int s = 0; s < 32; ++s) { const float ev = Ef[s * 64 + lane]; if (s == 4 * w) base = run; run += ev; }
              const float cumL = run; float cum = base;
#pragma unroll
              for (int q = 0; q < 4; ++q) { const int tl = 4 * w + q; const float cprev = cum; cum += q_e[q];
                  const float gam = __expf(-cum), gamp = __expf(-cprev), ginv = __expf(cum), glr = __expf(cum - cumL);
                  rc_st16(lds + RC_AT + tl * RC_RS + lane * 2, q_a[q] * gamp); rc_st16(lds + RC_RT + tl * RC_RS + lane * 2, q_r[q] * gam);
                  rc_st16(lds + RC_BB + tl * RC_RS + lane * 2, q_b[q] * ginv); rc_st16(lds + RC_KB + tl * RC_RS + lane * 2, q_k[q] * ginv);
                  rc_st16(lds + RC_BH + tl * RC_RS + lane * 2, q_b[q] * glr); rc_st16(lds + RC_KH + tl * RC_RS + lane * 2, q_k[q] * glr); }
              if (w == 0) GL[lane] = __expf(-cumL); }
            __syncthreads();
            f32x16_t R1;
#pragma unroll
            for (int r = 0; r < 16; ++r) R1[r] = 0.f;
            { int ln = lane; asm volatile("" : "+v"(ln)); const int a31 = ln & 31, a5 = ln >> 5;
              if (w < 4) {
                  const int aoff = (w == 0) ? RC_BB : ((w < 2) ? RC_AT : RC_RT), boff = (w == 0) ? RC_AT : ((w & 1) ? RC_KB : RC_BB);
#pragma unroll
                  for (int ks = 0; ks < 4; ++ks) R1 = MFMA32(rc_nat(lds + aoff, RC_RS, a31, 16 * ks + 8 * a5), rc_nat(lds + boff, RC_RS, a31, 16 * ks + 8 * a5), R1);
#pragma unroll
                  for (int r = 0; r < 16; ++r) { const int rr = rc_row(r, a5), cc = a31;
                      if (w == 0) NAB[rr * 32 + cc] = (rr < cc) ? R1[r] : 0.f;
                      else { const bool keep = (w < 2) ? (cc < rr) : (cc <= rr); rc_st16(lds + (w == 1 ? RC_NAK : (w == 2 ? RC_MRB : RC_MRK)) + rr * RC_NS + cc * 2, keep ? R1[r] : 0.f); } }
              } else {
                  const int aoff = (w < 6) ? RC_AT : RC_RT, ibk = w & 1;
#pragma unroll
                  for (int ks = 0; ks < 4; ++ks) R1 = MFMA32(rc_nat(lds + aoff, RC_RS, a31, 16 * ks + 8 * a5), rc_nat(lds + RC_SB, RC_RS, 32 * ibk + a31, 16 * ks + 8 * a5), R1);
              } }
            __syncthreads();
            if (w == 4 || w == 5) { int ln = lane; asm volatile("" : "+v"(ln)); const int a31 = ln & 31, a5 = ln >> 5, ibk = w & 1;
#pragma unroll
                for (int ks = 0; ks < 2; ++ks) R1 = MFMA32(rc_nat(lds + RC_NAK, RC_NS, a31, 16 * ks + 8 * a5), ss_trfrag(lds + vvo, RC_RS, 16 * ks, 32 * ibk, ln), R1);
#pragma unroll
                for (int r = 0; r < 16; ++r) Ef[rc_row(r, a5) * 64 + 32 * ibk + a31] = R1[r]; }
            __syncthreads();
            if (w > 0 && n > 0) { for (int tl = w - 1; tl < 32; tl += 7) RC_EPI_TOKEN(n - 1, tl); }
            if (w == 0) { float acc[32];
#pragma unroll
                for (int t = 0; t < 32; ++t) acc[t] = Ef[t * 64 + lane];
                RcSub<0>::run(acc, NAB, lds, lane); }
            __syncthreads();
            { int ln = lane; asm volatile("" : "+v"(ln)); const int a31 = ln & 31, a5 = ln >> 5;
              if (w >= 6) { const int ibk = w & 1;
#pragma unroll
                  for (int ks = 0; ks < 2; ++ks) { R1 = MFMA32(rc_nat(lds + RC_MRB, RC_NS, a31, 16 * ks + 8 * a5), ss_trfrag(lds + RC_UT, RC_RS, 16 * ks, 32 * ibk, ln), R1);
                                                   R1 = MFMA32(rc_nat(lds + RC_MRK, RC_NS, a31, 16 * ks + 8 * a5), ss_trfrag(lds + vvo, RC_RS, 16 * ks, 32 * ibk, ln), R1); }
#pragma unroll
                  for (int r = 0; r < 16; ++r) YB[rc_row(r, a5) * 64 + 32 * ibk + a31] = R1[r];
              } else if (w < 4) { const float gl = GL[32 * jb + a31];
#pragma unroll
                  for (int r = 0; r < 16; ++r) ST[r] *= gl;
#pragma unroll
                  for (int ks = 0; ks < 2; ++ks) { ST = MFMA32(ss_trfrag(lds + RC_UT, RC_RS, 16 * ks, 32 * ib, ln), ss_trfrag(lds + RC_BH, RC_RS, 16 * ks, 32 * jb, ln), ST);
                                                   ST = MFMA32(ss_trfrag(lds + vvo, RC_RS, 16 * ks, 32 * ib, ln), ss_trfrag(lds + RC_KH, RC_RS, 16 * ks, 32 * jb, ln), ST); } } }
            __syncthreads();
        }
        { const int nl = nch - 1, tnl = T - nl * 32 < 32 ? T - nl * 32 : 32; for (int tl = w; tl < tnl; tl += 8) RC_EPI_TOKEN(nl, tl); }
#undef RC_EPI_TOKEN
#undef RC_LOADIN
        if (w < 4) { float* so = (sq < BATCH ? c.out + O_WKVP + (((size_t)j * BATCH + sq) * RHEADS + h) * RH * RH : c.out + O_WKVS + (((size_t)j * DB + (sq - BATCH)) * RHEADS + h) * RH * RH);
#pragma unroll
            for (int r = 0; r < 16; ++r) so[(size_t)(32 * ib + rc_row(r, h5)) * RH + 32 * jb + l31] = ST[r]; }
    }
}
template <int ACT, bool ACC>
__device__ __forceinline__ void gemm_dev(const float* __restrict__ A, int lda, const float* __restrict__ B, int ldb, float* C, int ldc, int M, int N, int K, unsigned short (*As)[40], unsigned short (*Bs)[40]) {
    const int tid = threadIdx.x, wave = tid >> 6, lane = tid & 63, wr = wave >> 1, wc = wave & 1, fr = lane & 15, fq = lane >> 4;
    const int ntn = (N + 127) / 128, ntm = (M + 127) / 128;
    for (int tile = blockIdx.x; tile < ntm * ntn; tile += gridDim.x) {
        const int bm = (tile / ntn) * 128, bn = (tile % ntn) * 128;
        f32x4_t acc[2][4];
#pragma unroll
        for (int i = 0; i < 2; ++i)
#pragma unroll
            for (int j = 0; j < 4; ++j) acc[i][j] = (f32x4_t){0.f, 0.f, 0.f, 0.f};
        for (int k0 = 0; k0 < K; k0 += 32) {
#pragma unroll
            for (int it = 0; it < 2; ++it) {
                const int idx = tid + it * 512, row = idx >> 3, c4 = idx & 7, gm = bm + row;
                float4 v = make_float4(0.f, 0.f, 0.f, 0.f);
                if (gm < M) v = *(const float4*)(A + (size_t)gm * lda + k0 + c4 * 4);
                uint2 w; w.x = (unsigned)f2bf(v.x) | ((unsigned)f2bf(v.y) << 16); w.y = (unsigned)f2bf(v.z) | ((unsigned)f2bf(v.w) << 16);
                *(uint2*)&As[row][c4 * 4] = w;
            }
#pragma unroll
            for (int it = 0; it < 2; ++it) {
                const int idx = tid + it * 512, kr = idx >> 5, n4 = idx & 31, gn = bn + n4 * 4;
                float4 v = make_float4(0.f, 0.f, 0.f, 0.f);
                if (gn < N) v = *(const float4*)(B + (size_t)(k0 + kr) * ldb + gn);
                Bs[n4 * 4 + 0][kr] = f2bf(v.x); Bs[n4 * 4 + 1][kr] = f2bf(v.y); Bs[n4 * 4 + 2][kr] = f2bf(v.z); Bs[n4 * 4 + 3][kr] = f2bf(v.w);
            }
            __syncthreads();
            bf16x8_t a[2], b[4];
#pragma unroll
            for (int i = 0; i < 2; ++i) a[i] = *(const bf16x8_t*)&As[wr * 32 + i * 16 + fr][fq * 8];
#pragma unroll
            for (int j = 0; j < 4; ++j) b[j] = *(const bf16x8_t*)&Bs[wc * 64 + j * 16 + fr][fq * 8];
#pragma unroll
            for (int i = 0; i < 2; ++i)
#pragma unroll
                for (int j = 0; j < 4; ++j) acc[i][j] = __builtin_amdgcn_mfma_f32_16x16x32_bf16(a[i], b[j], acc[i][j], 0, 0, 0);
            __syncthreads();
        }
#pragma unroll
        for (int i = 0; i < 2; ++i)
#pragma unroll
            for (int j = 0; j < 4; ++j)
#pragma unroll
                for (int e = 0; e < 4; ++e) {
                    const int row = bm + wr * 32 + i * 16 + fq * 4 + e, col = bn + wc * 64 + j * 16 + fr;
                    if (row < M && col < N) {
                        float v = acc[i][j][e];
                        if (ACT == 1) v = tanhf(v); else if (ACT == 2) v = 1.0f / (1.0f + expf(-v)); else if (ACT == 3) v = v > 0.f ? v * v : 0.f;
                        float* cp = C + (size_t)row * ldc + col; *cp = ACC ? *cp + v : v;
                    }
                }
    }
}

#define MRUN(ph, l) do { ph(c, l, gtid, gsz); xcd_barrier(bar); } while (0)
#define MGEMM(ACT, ACC, A, lda, B, ldb, C, ldc, M, N, K) do { gemm_dev<ACT, ACC>(A, lda, B, ldb, C, ldc, M, N, K, As, Bs); xcd_barrier(bar); } while (0)
#define KS_FFN 16
#define KS_1K 4
#define KS_MB 8
#ifndef ACC_KSPLIT
#define ACC_KSPLIT 1
#endif
#ifndef FFN_DOWN_KSPLIT
#define FFN_DOWN_KSPLIT 1
#endif
#define GBAR() xcd_barrier(bar)
#ifndef PROBE_DUP
#define PROBE_DUP 0
#endif
#define DUP(bit, ...) do { __VA_ARGS__; if (PROBE_DUP & (1 << (bit))) { GBAR(); __VA_ARGS__; } } while (0)
#define GTID_NOW() ((size_t)blockIdx.x * 512 + tid_now())
#define GSZ_NOW() ((size_t)gridDim.x * 512)
#define GW_NOW() ((int)(blockIdx.x * 8 + (tid_now() >> 6)))
#define NGW_NOW() ((int)(gridDim.x * 8))
#define LANE_NOW() ((int)(tid_now() & 63))
#undef MRUN
#undef MGEMM
#define MRUN(ph, l) do { ph(c, l, GTID_NOW(), GSZ_NOW()); xcd_barrier(bar); } while (0)
#define MGEMM(ACT, ACC, A, lda, B, ldb, C, ldc, M, N, K) do { gemm_dev<ACT, ACC>(A, lda, B, ldb, C, ldc, M, N, K, (unsigned short (*)[40])dynlds, (unsigned short (*)[40])(dynlds + 128 * 40 * 2)); xcd_barrier(bar); } while (0)
extern __shared__ __attribute__((aligned(16))) unsigned char dynlds[];

struct MegaArgs { Ctx c; Fast f; FastMla fm; FastRw fr; FastMb fb; unsigned* bar; };
constexpr int LDS_STAGE = 0, LDS_XB = 163840 - 64, LDS_BYTES = 163840;
static_assert(SD_END <= LDS_XB && SS_END <= LDS_XB && RC_END <= LDS_XB, "LDS map");

template <int L>
__device__ __forceinline__ void layer_mix_naive(const Ctx& c, const XcdBarrier& bar) {
    using namespace cfg;
    constexpr int l = L, kind = L % 3, j = L / 3;
    MRUN(ph_norm_mix, l);
    if constexpr (kind == 0) {
        MRUN(ph_rw_mix, l);
        const float* W = c.in[I_WRKV] + (size_t)j * 3 * D * D;
        MGEMM(0, false, c.xm[0], D, W, D, c.r, D, MTOT, D, D);
        MGEMM(0, false, c.xm[1], D, W + (size_t)D * D, D, c.k, D, MTOT, D, D);
        MGEMM(0, false, c.xm[2], D, W + (size_t)2 * D * D, D, c.v, D, MTOT, D, D);
        MGEMM(1, false, c.xm[3], D, c.in[I_W1] + (size_t)j * D * RW_DL, RW_DL, c.hw, RW_DL, MTOT, RW_DL, D);
        MGEMM(0, false, c.hw, RW_DL, c.in[I_W2] + (size_t)j * RW_DL * D, D, c.wpre, D, MTOT, D, RW_DL);
        MGEMM(0, false, c.xm[4], D, c.in[I_A1] + (size_t)j * D * RW_AL, RW_AL, c.ha, RW_AL, MTOT, RW_AL, D);
        MGEMM(0, false, c.ha, RW_AL, c.in[I_A2] + (size_t)j * RW_AL * D, D, c.apre, D, MTOT, D, RW_AL);
        if constexpr (j > 0) {
            MGEMM(0, false, c.xm[2], D, c.in[I_V1] + (size_t)(j - 1) * D * RW_VL, RW_VL, c.hv, RW_VL, MTOT, RW_VL, D);
            MGEMM(0, false, c.hv, RW_VL, c.in[I_V2] + (size_t)(j - 1) * RW_VL * D, D, c.vpre, D, MTOT, D, RW_VL);
        }
        MGEMM(2, false, c.xm[5], D, c.in[I_G1] + (size_t)j * D * RW_GL, RW_GL, c.hg, RW_GL, MTOT, RW_GL, D);
        MGEMM(0, false, c.hg, RW_GL, c.in[I_G2] + (size_t)j * RW_GL * D, D, c.g, D, MTOT, D, RW_GL);
        MRUN(ph_rw_prep, l); MRUN(ph_rw_scan, l); MRUN(ph_rw_post, l);
        MGEMM(0, true, c.yo, D, c.in[I_RWO] + (size_t)j * D * D, D, c.x, D, MTOT, D, D);
    } else if constexpr (kind == 1) {
        MGEMM(0, false, c.xn, D, c.in[I_MWIN] + (size_t)j * D * MLA_IN, MLA_IN, c.mh, MLA_IN, MTOT, MLA_IN, D);
        MRUN(ph_mla_norm1, l);
        MGEMM(0, false, c.qan, QL, c.in[I_WUQ] + (size_t)j * QL * MH * QD, MH * QD, c.q, MH * QD, MTOT, MH * QD, QL);
        MGEMM(0, false, c.c, KVL, c.in[I_WUK] + (size_t)j * KVL * MH * NOPE, MH * NOPE, c.knr, MH * NOPE, MTOT, MH * NOPE, KVL);
        MGEMM(0, false, c.c, KVL, c.in[I_WUV] + (size_t)j * KVL * MH * VD, MH * VD, c.vv, MH * VD, MTOT, MH * VD, KVL);
        MRUN(ph_mla_norm2, l); MRUN(ph_mla_attn_prompt, l); MRUN(ph_mla_score_sample, l); MRUN(ph_mla_softmax_sample, l); MRUN(ph_mla_pv_sample, l); MRUN(ph_mla_out_sample, l);
        MGEMM(0, true, c.ao, MH * VD, c.in[I_MWO] + (size_t)j * MH * VD * D, D, c.x, D, MTOT, D, MH * VD);
    } else {
        MGEMM(0, false, c.xn, D, c.in[I_BWIN] + (size_t)j * D * MB_IN, MB_IN, c.zx, MB_IN, MTOT, MB_IN, D);
        MRUN(ph_mb_conv, l); MRUN(ph_mb_dt, l); MRUN(ph_mb_scan, l); MRUN(ph_mb_gate, l);
        MGEMM(0, true, c.yzn, MB_INNER, c.in[I_BWO] + (size_t)j * MB_INNER * D, D, c.x, D, MTOT, D, MB_INNER);
    }
}


template <int L>
__device__ __forceinline__ void layer_rwkv_fast(const Ctx& c, const Fast& f, const FastRw& fr, const XcdBarrier& bar, LDSP unsigned char* lds) {
    using namespace cfg;
    constexpr int l = L, j = L / 3;
    if (L > 0) { fold_sample_rows(c.x, f.slab, KS_FFN, GW_NOW(), NGW_NOW(), LANE_NOW()); GBAR(); }
    DUP(9, rw_mix_fast(c, fr, l, GW_NOW(), NGW_NOW(), LANE_NOW(), L == 0 ? c.in[I_XP] : nullptr));
    GBAR();
    DUP(7, { pg8::Order<RwSel> S; S.init(MP / 256, MS / 256, 16, D, 1, gridDim.x, blockIdx.x);
      pg8::gemm_phase(lds, pg8::Gemm{fr.xm, fr.wrkvt + (size_t)j * 4096 * D, D, D, (size_t)MTOT * D}, S, EpiRwkv{fr.rkv, fr.hb}); });
    GBAR();
    DUP(2, rw_scan_chunked<j>(c, fr, lds));
    GBAR();
    { pg8::Order<> S; S.init(MP / 256, MS / 256, 4, D, KS_1K, gridDim.x, blockIdx.x);
      pg8::gemm_phase(lds, pg8::Gemm{fr.yo, fr.wot + (size_t)j * D * D, D, D, 0}, S, pg8::EpiAccF32{c.x, D, f.slab, MP / 256, MS / 256, KS_1K, L == 0 ? c.in[I_XP] : nullptr}); }
    if (PROBE_DUP & (1 << 26)) { GBAR(); pg8::Order<> S; S.init(MP / 256, MS / 256, 4, D, KS_1K, gridDim.x, blockIdx.x);
      pg8::gemm_phase(lds, pg8::Gemm{fr.yo, fr.wot + (size_t)j * D * D, D, D, 0}, S, pg8::EpiAccF32{c.hmid, D, f.slab + (size_t)16 * 16 * 65536, MP / 256, MS / 256, KS_1K}); }
    GBAR();
}

__device__ __forceinline__ void layer_mamba_fast(const Ctx& c, const Fast& f, const FastMb& fb, const XcdBarrier& bar, LDSP unsigned char* lds) {
    using namespace cfg;
    constexpr int l = 2, j = 0;
    norm_rows_bf16(c.x, c.in[I_NMIX] + l * D, f.xnb, f.slab, KS_FFN, GW_NOW(), NGW_NOW(), LANE_NOW());
    GBAR();
    DUP(8, { pg8::Order<> S; S.init(MP / 256, MS / 256, 21, D, 1, gridDim.x, blockIdx.x);
      pg8::gemm_phase(lds, pg8::Gemm{f.xnb, fb.wbint, D, D, 0}, S, EpiMamba{fb.zb, fb.xbcr, fb.dtraw}); });
    GBAR();
    DUP(12, mb_conv_fast(c, fb, l, GTID_NOW(), GSZ_NOW(), false));
    GBAR();
    DUP(6, mb_ssd_prompt(c, fb, l, lds); mb_scan_sample(c, fb, l));
    GBAR();
    DUP(13, mb_gate_fast(c, fb, fb.y, l, GW_NOW(), NGW_NOW(), LANE_NOW()));
    GBAR();
    { pg8::Order<> S; S.init(MP / 256, MS / 256, 4, MB_INNER, KS_MB, gridDim.x, blockIdx.x);
      pg8::gemm_phase(lds, pg8::Gemm{fb.yzn, fb.wbot, MB_INNER, MB_INNER, 0}, S, pg8::EpiAccF32{c.x, D, f.slab, MP / 256, MS / 256, KS_MB}); }
    if (PROBE_DUP & (1 << 28)) { GBAR(); pg8::Order<> S; S.init(MP / 256, MS / 256, 4, MB_INNER, KS_MB, gridDim.x, blockIdx.x);
      pg8::gemm_phase(lds, pg8::Gemm{fb.yzn, fb.wbot, MB_INNER, MB_INNER, 0}, S, pg8::EpiAccF32{c.hmid, D, f.slab + (size_t)16 * 16 * 65536, MP / 256, MS / 256, KS_MB}); }
    GBAR();
}

__device__ __forceinline__ void layer_mla_fast(const Ctx& c, const Fast& f, const FastMla& fm, const XcdBarrier& bar, LDSP unsigned char* lds) {
    using namespace cfg;
    constexpr int l = 1, j = 0;
    norm_rows_bf16(c.x, c.in[I_NMIX] + l * D, f.xnb, f.slab, KS_FFN, GW_NOW(), NGW_NOW(), LANE_NOW());
    GBAR();
    DUP(27, { pg8::Order<> S; S.init(MP / 256, MS / 256, 4, D, 1, gridDim.x, blockIdx.x);
      pg8::gemm_phase(lds, pg8::Gemm{f.xnb, fm.wint, D, D, 0}, S, pg8::EpiF32{fm.mh, 1024, 1024}); });
    GBAR();
    DUP(14, mla_norm1_fast(c, fm, j, GW_NOW(), NGW_NOW(), LANE_NOW()));
    GBAR();
    DUP(27, { pg8::Order<> S; S.init(MP / 256, MS / 256, (MH * QD) / 256, QL, 1, gridDim.x, blockIdx.x);
      pg8::gemm_phase(lds, pg8::Gemm{fm.qan, fm.wuqt, QL, QL, 0}, S, pg8::EpiBf16<0>{fm.qraw, MH * QD}); }
    { pg8::Order<> S; S.init(MP / 256, MS / 256, 4, KVL, 1, gridDim.x, blockIdx.x);
      pg8::gemm_phase(lds, pg8::Gemm{fm.cb, fm.wukvt, KVL, KVL, 0}, S, pg8::EpiBf16<0>{fm.kvraw, 2048}); }
    { pg8::Order<> S; S.init(4, 0, MTOT / 256, KVL, 1, gridDim.x, blockIdx.x);
      pg8::gemm_phase(lds, pg8::Gemm{fm.wukvt + (size_t)1024 * KVL, fm.cb, KVL, KVL, 0}, S, pg8::EpiBf16<0>{fm.vT, MTOT}); });
    GBAR();
    DUP(15, mla_norm2_fast(c, fm, j, GW_NOW(), NGW_NOW(), LANE_NOW()));
    { const unsigned t_ = (unsigned)GTID_NOW(); if (t_ < 96) *(pg8::u32x4*)(fm.qs + (size_t)MS * 1536 + t_ * 8) = (pg8::u32x4){0u, 0u, 0u, 0u}; }
    GBAR();
    DUP(5, attn_prompt_fast(fm.qf, fm.knb, fm.kpb, fm.vT, fm.aob, lds));
    __syncthreads();
    DUP(4, mla_sample_decode(c, fm, fm.qs, fm.opart, fm.lpart, j, lds));
    GBAR();
    DUP(16, mla_sample_combine(c, fm, fm.opart, fm.lpart, j, lds));
    GBAR();
    { pg8::Order<> S; S.init(MP / 256, MS / 256, 4, D, KS_1K, gridDim.x, blockIdx.x);
      pg8::gemm_phase(lds, pg8::Gemm{fm.aob, fm.wot, D, D, 0}, S, pg8::EpiAccF32{c.x, D, f.slab, MP / 256, MS / 256, KS_1K}); }
    if (PROBE_DUP & (1 << 27)) { GBAR(); pg8::Order<> S; S.init(MP / 256, MS / 256, 4, D, KS_1K, gridDim.x, blockIdx.x);
      pg8::gemm_phase(lds, pg8::Gemm{fm.aob, fm.wot, D, D, 0}, S, pg8::EpiAccF32{c.hmid, D, f.slab + (size_t)16 * 16 * 65536, MP / 256, MS / 256, KS_1K}); }
    GBAR();
}

template <int L>
__device__ __forceinline__ void layer_ffn_fast(const Ctx& c, const Fast& f, const XcdBarrier& bar, LDSP unsigned char* lds) {
    using namespace cfg;
    norm_rows_bf16(c.x, c.in[I_NFFN] + L * D, f.xnb, f.slab, (L % 3 == 2) ? KS_MB : KS_1K, GW_NOW(), NGW_NOW(), LANE_NOW());
    GBAR();
    DUP(0, { pg8::Order<> S; S.init(MP / 256, MS / 256, FFN / 256, D, 1, gridDim.x, blockIdx.x);
      pg8::gemm_phase(lds, pg8::Gemm{f.xnb, f.w1t + (size_t)L * FFN * D, D, D, 0}, S, pg8::EpiBf16<3>{f.hmidb, FFN}); });
    GBAR();
    { pg8::Order<> S; S.init(MP / 256, MS / 256, D / 256, FFN, (L == DEPTH - 1) ? 1 : KS_FFN, gridDim.x, blockIdx.x);
      pg8::gemm_phase(lds, pg8::Gemm{f.hmidb, f.w2t + (size_t)L * D * FFN, FFN, FFN, 0}, S, pg8::EpiAccF32{c.x, D, f.slab, MP / 256, MS / 256, (L == DEPTH - 1) ? 1 : KS_FFN}); }
    if (PROBE_DUP & (1 << 25)) { GBAR(); pg8::Order<> S; S.init(MP / 256, MS / 256, D / 256, FFN, (L == DEPTH - 1) ? 1 : KS_FFN, gridDim.x, blockIdx.x);
      pg8::gemm_phase(lds, pg8::Gemm{f.hmidb, f.w2t + (size_t)L * D * FFN, FFN, FFN, 0}, S, pg8::EpiAccF32{c.hmid, D, f.slab + (size_t)16 * 16 * 65536, MP / 256, MS / 256, (L == DEPTH - 1) ? 1 : KS_FFN}); }
    GBAR();
}

__global__ void __launch_bounds__(512, 2) mega10(MegaArgs a) {
    LDSP unsigned char* lds = (LDSP unsigned char*)dynlds;
    if (threadIdx.x < 4) ((LDSP unsigned*)(lds + LDS_XB))[threadIdx.x] = 0u;
    __syncthreads();
    XcdBarrier bar = xcd_barrier_post(a.bar, (volatile LAS unsigned*)(lds + LDS_XB));
    const Ctx& c = a.c; const Fast& f = a.f; const FastMla& fm = a.fm; const FastRw& fr = a.fr; const FastMb& fb = a.fb;
    using namespace cfg;
    DUP(10, {
        LDSP float* scr = (LDSP float*)(lds + LDS_STAGE) + (tid_now() >> 6) * (64 * 33);
        for (int l = 0; l < DEPTH; ++l) {
            tr_weight(c.in[I_FW1] + (size_t)l * D * FFN, D, FFN, FFN, f.w1t + (size_t)l * FFN * D, nullptr, scr, GW_NOW(), NGW_NOW(), LANE_NOW());
            tr_weight(c.in[I_FW2] + (size_t)l * FFN * D, FFN, D, D, f.w2t + (size_t)l * D * FFN, nullptr, scr, GW_NOW(), NGW_NOW(), LANE_NOW());
        }
        tr_weight(c.in[I_MWIN], D, MLA_IN, 1024, fm.wint, nullptr, scr, GW_NOW(), NGW_NOW(), LANE_NOW());
        tr_weight(c.in[I_WUQ], QL, MH * QD, MH * QD, fm.wuqt, nullptr, scr, GW_NOW(), NGW_NOW(), LANE_NOW());
        tr_weight(c.in[I_WUK], KVL, MH * NOPE, MH * NOPE, fm.wukvt, nullptr, scr, GW_NOW(), NGW_NOW(), LANE_NOW());
        tr_weight(c.in[I_WUV], KVL, MH * VD, MH * VD, fm.wukvt + (size_t)1024 * KVL, nullptr, scr, GW_NOW(), NGW_NOW(), LANE_NOW());
        tr_weight(c.in[I_MWO], MH * VD, D, D, fm.wot, nullptr, scr, GW_NOW(), NGW_NOW(), LANE_NOW());
        for (int j = 0; j < N_RWKV; ++j) {
            bf16_t* wt = fr.wrkvt + (size_t)j * 4096 * D;
            for (int p = 0; p < 3; ++p) tr_weight(c.in[I_WRKV] + ((size_t)j * 3 + p) * D * D, D, D, D, wt + (size_t)p * D * D, nullptr, scr, GW_NOW(), NGW_NOW(), LANE_NOW());
            tr_weight(c.in[I_W1] + (size_t)j * D * RW_DL, D, RW_DL, 256, wt + (size_t)3072 * D, nullptr, scr, GW_NOW(), NGW_NOW(), LANE_NOW());
            tr_weight(c.in[I_A1] + (size_t)j * D * RW_AL, D, RW_AL, 256, wt + (size_t)3328 * D, nullptr, scr, GW_NOW(), NGW_NOW(), LANE_NOW());
            tr_weight(c.in[I_G1] + (size_t)j * D * RW_GL, D, RW_GL, 256, wt + (size_t)3584 * D, nullptr, scr, GW_NOW(), NGW_NOW(), LANE_NOW());
            tr_weight(j > 0 ? c.in[I_V1] + (size_t)(j - 1) * D * RW_VL : c.in[I_W1], D, j > 0 ? RW_VL : 0, 256, wt + (size_t)3840 * D, nullptr, scr, GW_NOW(), NGW_NOW(), LANE_NOW());
            tr_weight(c.in[I_RWO] + (size_t)j * D * D, D, D, D, fr.wot + (size_t)j * D * D, nullptr, scr, GW_NOW(), NGW_NOW(), LANE_NOW());
            rw_build_lorat(c, fr.lorat + (size_t)j * 4096 * 384, j, GTID_NOW(), GSZ_NOW());
        }
        tr_weight(c.in[I_BWIN], D, MB_IN, 5376, fb.wbint, nullptr, scr, GW_NOW(), NGW_NOW(), LANE_NOW());
        tr_weight(c.in[I_BWO], MB_INNER, D, D, fb.wbot, nullptr, scr, GW_NOW(), NGW_NOW(), LANE_NOW());
        { const size_t np4 = (size_t)MP * D / 4, nt4 = (size_t)MTOT * D / 4;
          for (size_t i = np4 + GTID_NOW(); i < nt4; i += GSZ_NOW()) ((pg8::f32x4*)c.x)[i] = ((const pg8::f32x4*)c.in[I_XS])[i - np4]; }
    });
    GBAR();
    layer_rwkv_fast<0>(c, f, fr, bar, lds); layer_ffn_fast<0>(c, f, bar, lds);
    layer_mla_fast(c, f, fm, bar, lds); layer_ffn_fast<1>(c, f, bar, lds);
    layer_mamba_fast(c, f, fb, bar, lds); layer_ffn_fast<2>(c, f, bar, lds);
    layer_rwkv_fast<3>(c, f, fr, bar, lds); layer_ffn_fast<3>(c, f, bar, lds);
}

extern "C" void kernel_launch(void* const* d_in, const int* in_sizes, int n_in, void* d_out, int out_size, void* d_ws, size_t ws_size, hipStream_t stream) {
    using namespace cfg;
    MegaArgs a{};
    size_t used = setup_ctx(a.c, d_in, d_out, d_ws);
    { Bump b{(char*)d_ws, (size_t)((char*)a.c.xm[0] - (char*)d_ws)}; FastRw& r = a.fr;
      r.xm = (bf16_t*)b.f((size_t)6 * MTOT * D / 2); r.rkv = (bf16_t*)b.f((size_t)MTOT * 3072 / 2); r.hb = (bf16_t*)b.f((size_t)MTOT * 384 / 2); r.lu = (bf16_t*)b.f((size_t)MTOT * 4096 / 2);
      r.ops = b.f((size_t)MTOT * RHEADS * RW_REC + 4096); r.yo = (bf16_t*)b.f((size_t)MTOT * D / 2); r.vf = a.c.vf;
      if (b.off > (size_t)((char*)a.c.hmid - (char*)d_ws) + (size_t)MTOT * FFN * 4) { fprintf(stderr, "RWKV overlay too large\n"); return; } }
    { Bump b{(char*)d_ws, used};
      a.f.xnb = (bf16_t*)b.f((size_t)MTOT * D / 2); a.f.hmidb = (bf16_t*)b.f((size_t)MTOT * FFN / 2);
      a.f.w1t = (bf16_t*)b.f((size_t)DEPTH * FFN * D / 2); a.f.w2t = (bf16_t*)b.f((size_t)DEPTH * FFN * D / 2); a.f.slab = b.f((size_t)2 * 16 * 16 * 65536);
      FastMla& m = a.fm;
      m.mh = b.f((size_t)MTOT * 1024); m.qan = (bf16_t*)b.f((size_t)MTOT * QL / 2); m.cb = (bf16_t*)b.f((size_t)MTOT * KVL / 2); m.kpb = (bf16_t*)b.f((size_t)MTOT * ROPE / 2);
      m.qraw = (bf16_t*)b.f((size_t)MTOT * 1536 / 2); m.kvraw = (bf16_t*)b.f((size_t)MTOT * 2048 / 2); m.qf = (bf16_t*)b.f((size_t)MTOT * 1536 / 2); m.knb = (bf16_t*)b.f((size_t)MTOT * 1024 / 2);
      m.aob = (bf16_t*)b.f((size_t)MTOT * 1024 / 2); m.vT = (bf16_t*)b.f((size_t)MTOT * 1024 / 2); m.qs = (bf16_t*)b.f((size_t)MS * 1536 / 2 + 1024);
      m.opart = b.f((size_t)2 * DB * 128 * 256); m.lpart = b.f((size_t)2 * DB * 128);
      m.wint = (bf16_t*)b.f((size_t)1024 * 1024 / 2); m.wuqt = (bf16_t*)b.f((size_t)1536 * 512 / 2); m.wukvt = (bf16_t*)b.f((size_t)2048 * 256 / 2); m.wot = (bf16_t*)b.f((size_t)1024 * 1024 / 2);
      { FastMb& q = a.fb; q.zb = (bf16_t*)b.f((size_t)MTOT * 2048 / 2); q.xbcr = (bf16_t*)b.f((size_t)MTOT * 3072 / 2); q.dtraw = b.f((size_t)MTOT * 32); q.xbcb = (bf16_t*)b.f((size_t)MTOT * 3072 / 2);
        q.dt = b.f((size_t)MTOT * 32); q.y = a.c.my; q.yzn = (bf16_t*)b.f((size_t)MTOT * 2048 / 2); q.wbint = (bf16_t*)b.f((size_t)5376 * 1024 / 2); q.wbot = (bf16_t*)b.f((size_t)1024 * 2048 / 2); }
      a.fr.wrkvt = (bf16_t*)b.f((size_t)N_RWKV * 4096 * D / 2); a.fr.lorat = (bf16_t*)b.f((size_t)N_RWKV * 4096 * 384 / 2); a.fr.wot = (bf16_t*)b.f((size_t)N_RWKV * D * D / 2);
      used = b.off; }
    if (used > ws_size || n_in != 51) { fprintf(stderr, "workspace too small: need %zu have %zu (n_in %d)\n", used, ws_size, n_in); return; }
    a.bar = (unsigned*)d_ws;
    static int grid = 0;
    if (!grid) {
        int dev = 0, cus = 0, per_cu = 0;
        (void)hipGetDevice(&dev); (void)hipDeviceGetAttribute(&cus, hipDeviceAttributeMultiprocessorCount, dev);
        if (hipFuncSetAttribute((const void*)mega10, hipFuncAttributeMaxDynamicSharedMemorySize, LDS_BYTES) != hipSuccess) { fprintf(stderr, "hipFuncSetAttribute failed\n"); grid = -1; return; }
        (void)hipOccupancyMaxActiveBlocksPerMultiprocessor(&per_cu, (const void*)mega10, 512, LDS_BYTES);
        (void)hipGetLastError();
        grid = per_cu >= 1 ? (cus < 256 ? cus : 256) : -1;
    }
    if (grid <= 0) { fprintf(stderr, "kernel does not fit one workgroup per CU\n"); return; }
    (void)hipMemsetAsync(a.bar, 0, XCD_BAR_WORDS * sizeof(unsigned), stream);
    hipLaunchKernelGGL(mega10, dim3(grid), dim3(512), LDS_BYTES, stream, a);
}
```

```cpp
#include <hip/hip_runtime.h>
#include <cstdio>
#include <math.h>
#include <stdint.h>
#include <stddef.h>
#ifdef CPU_EMU
#define DEV inline
#else
#define DEV __device__ __forceinline__
#endif

namespace cfg {
#ifdef CFG_SMALL
constexpr int D = 128, BATCH = 2, SEQ = 32, DEPTH = 4, DB = 3, DS = 8, PAST = 64, PAGE = 16;
constexpr int RW_DL = 16, RW_AL = 16, RW_VL = 8, RW_GL = 24;
constexpr int MH = 2, QL = 64, KVL = 32;
constexpr int MB_GROUPS = 2;
#else
constexpr int D = 1024, BATCH = 16, SEQ = 2048, DEPTH = 4, DB = 128, DS = 8, PAST = 8192, PAGE = 128;
constexpr int RW_DL = 64, RW_AL = 64, RW_VL = 32, RW_GL = 160;
constexpr int MH = 16, QL = 512, KVL = 256;
constexpr int MB_GROUPS = 4;
#endif
constexpr int N_RWKV = (DEPTH + 2) / 3, N_MLA = (DEPTH + 1) / 3, N_MAMBA = DEPTH / 3;
constexpr int RH = 64, RHEADS = D / RH;
constexpr int NOPE = 64, ROPE = 32, VD = 64, QD = NOPE + ROPE;
constexpr int MLA_IN = QL + KVL + ROPE;
constexpr int MB_INNER = 2 * D, MB_HEAD = 64, MB_HEADS = MB_INNER / MB_HEAD, MB_STATE = 128, MB_CONV = 4;
constexpr int MB_GN = MB_GROUPS * MB_STATE;
constexpr int MB_CD = MB_INNER + 2 * MB_GN, MB_IN = MB_INNER + MB_CD + MB_HEADS;
constexpr int FFN = 4 * D;
constexpr int NPAGES = PAST / PAGE, NPOOL = (DB * NPAGES * 5) / 4;
constexpr int MP = BATCH * SEQ, MS = DB * DS, MTOT = MP + MS, NSEQ = BATCH + DB;
constexpr int KTOT = PAST + DS;
constexpr float NORM_EPS = 1e-6f, LNX_EPS = 64e-5f;
constexpr size_t O_YP = 0;
constexpr size_t O_YS = O_YP + (size_t)MP * D;
constexpr size_t O_CKVP = O_YS + (size_t)MS * D;
constexpr size_t O_KPEP = O_CKVP + (size_t)N_MLA * MP * KVL;
constexpr size_t O_CKVS = O_KPEP + (size_t)N_MLA * MP * ROPE;
constexpr size_t O_KPES = O_CKVS + (size_t)N_MLA * MS * KVL;
constexpr size_t O_WKVP = O_KPES + (size_t)N_MLA * MS * ROPE;
constexpr size_t O_SHP = O_WKVP + (size_t)N_RWKV * BATCH * RHEADS * RH * RH;
constexpr size_t O_WKVS = O_SHP + (size_t)N_RWKV * BATCH * D;
constexpr size_t O_SHS = O_WKVS + (size_t)N_RWKV * DB * RHEADS * RH * RH;
constexpr size_t O_SSMP = O_SHS + (size_t)N_RWKV * DB * D;
constexpr size_t O_CONVP = O_SSMP + (size_t)N_MAMBA * BATCH * MB_HEADS * MB_HEAD * MB_STATE;
constexpr size_t O_SSMS = O_CONVP + (size_t)N_MAMBA * BATCH * (MB_CONV - 1) * MB_CD;
constexpr size_t O_CONVS = O_SSMS + (size_t)N_MAMBA * DB * MB_HEADS * MB_HEAD * MB_STATE;
constexpr size_t O_END = O_CONVS + (size_t)N_MAMBA * DB * (MB_CONV - 1) * MB_CD;
}

struct Ctx {
    const float* in[51];
    const int* page_table;
    float* out;
    float *x, *xn, *vf;
    float* xm[6];
    float *r, *k, *v, *wpre, *apre, *vpre, *g, *hw, *ha, *hv, *hg, *ka, *kb, *y, *yo;
    float *hmid;
    float *mh, *qan, *q, *c, *kp, *knr, *vv, *ao, *sc, *olat;
    float *zx, *xbc, *dt, *my, *yzn;
};

DEV int row_t(int m) { return m < cfg::MP ? m % cfg::SEQ : (m - cfg::MP) % cfg::DS; }
DEV int row_seq(int m) { return m < cfg::MP ? m / cfg::SEQ : cfg::BATCH + (m - cfg::MP) / cfg::DS; }
DEV int seq_row0(int sq) { return sq < cfg::BATCH ? sq * cfg::SEQ : cfg::MP + (sq - cfg::BATCH) * cfg::DS; }
DEV int seq_len(int sq) { return sq < cfg::BATCH ? cfg::SEQ : cfg::DS; }
DEV float sigmoidf_(float x) { return 1.0f / (1.0f + expf(-x)); }
DEV float softplusf_(float x) { return x > 20.f ? x : log1pf(expf(x)); }
DEV float siluf_(float x) { return x * sigmoidf_(x); }

enum { I_XP = 0, I_XS, I_CKV, I_KPE, I_WKV, I_SHIFT, I_SSM, I_CONV, I_PT, I_NMIX, I_NFFN, I_FW1, I_FW2, I_MU, I_WRKV, I_W0, I_W1, I_W2, I_A0, I_A1, I_A2,
       I_V0, I_V1, I_V2, I_G1, I_G2, I_KK, I_KA, I_RK, I_LNW, I_LNB, I_RWO, I_MWIN, I_QNORM, I_KVNORM, I_WUQ, I_WUK, I_WUV, I_QNN, I_QRN, I_KNN, I_KRN, I_MWO,
       I_BWIN, I_CONVW, I_CONVB, I_DTB, I_ALOG, I_BD, I_BNORM, I_BWO };

#define UNROLL _Pragma("unroll")
#define GSL(i, n) for (size_t i = gtid; i < (size_t)(n); i += gsz)

DEV void ph_copy_x(const Ctx& c, int, size_t gtid, size_t gsz) {
    using namespace cfg;
    GSL(i, (size_t)MTOT * D) c.x[i] = i < (size_t)MP * D ? c.in[I_XP][i] : c.in[I_XS][i - (size_t)MP * D];
}
DEV void rmsnorm_rows(const float* x, const float* gain, float* xn, size_t gtid, size_t gsz) {
    using namespace cfg;
    GSL(m, MTOT) {
        const float* xr = x + m * D; float ss = 0.f;
        for (int i = 0; i < D; ++i) ss += xr[i] * xr[i];
        const float rs = 1.0f / sqrtf(ss / D + NORM_EPS);
        for (int i = 0; i < D; ++i) xn[m * D + i] = xr[i] * rs * gain[i];
    }
}
DEV void ph_norm_mix(const Ctx& c, int l, size_t gtid, size_t gsz) { rmsnorm_rows(c.x, c.in[I_NMIX] + l * cfg::D, c.xn, gtid, gsz); }
DEV void ph_norm_ffn(const Ctx& c, int l, size_t gtid, size_t gsz) { rmsnorm_rows(c.x, c.in[I_NFFN] + l * cfg::D, c.xn, gtid, gsz); }

DEV void ph_rw_mix(const Ctx& c, int l, size_t gtid, size_t gsz) {
    using namespace cfg; const int j = l / 3;
    GSL(i, (size_t)MTOT * D) {
        const int m = (int)(i / D), ch = (int)(i % D), t = row_t(m), sq = row_seq(m);
        const float xc = c.xn[i];
        float xp;
        if (t > 0) xp = c.xn[i - D];
        else xp = sq < BATCH ? 0.f : c.in[I_SHIFT][((size_t)j * DB + (sq - BATCH)) * D + ch];
        for (int p = 0; p < 6; ++p) c.xm[p][i] = xc + (xp - xc) * c.in[I_MU][((size_t)j * 6 + p) * D + ch];
        if (t == seq_len(sq) - 1) {
            if (sq < BATCH) c.out[O_SHP + ((size_t)j * BATCH + sq) * D + ch] = xc;
            else c.out[O_SHS + ((size_t)j * DB + (sq - BATCH)) * D + ch] = xc;
        }
    }
}
DEV void ph_rw_prep(const Ctx& c, int l, size_t gtid, size_t gsz) {
    using namespace cfg; const int j = l / 3;
    GSL(i, (size_t)MTOT * RHEADS) {
        const int m = (int)(i / RHEADS), h = (int)(i % RHEADS);
        const size_t o = (size_t)m * D + h * RH;
        float nn = 0.f;
        for (int e = 0; e < RH; ++e) { const float kk = c.k[o + e] * c.in[I_KK][j * D + h * RH + e]; nn += kk * kk; }
        const float inv = 1.0f / fmaxf(sqrtf(nn), 1e-12f);
        for (int e = 0; e < RH; ++e) {
            const int ch = h * RH + e;
            const float wl = -softplusf_(-(c.in[I_W0][j * D + ch] + c.wpre[o + e])) - 0.5f;
            const float decay = expf(-expf(wl));
            float vv = c.v[o + e];
            if (j == 0) c.vf[o + e] = vv;
            else vv = vv + (c.vf[o + e] - vv) * sigmoidf_(c.in[I_V0][(j - 1) * D + ch] + c.vpre[o + e]);
            const float a = sigmoidf_(c.in[I_A0][j * D + ch] + c.apre[o + e]);
            const float k0 = c.k[o + e];
            const float kk = k0 * c.in[I_KK][j * D + ch] * inv;
            c.k[o + e] = k0 * (1.0f + (a - 1.0f) * c.in[I_KA][j * D + ch]);
            c.v[o + e] = vv;
            c.wpre[o + e] = decay;
            c.ka[o + e] = -kk;
            c.kb[o + e] = kk * a;
        }
    }
}
DEV void ph_rw_scan(const Ctx& c, int l, size_t gtid, size_t gsz) {
    using namespace cfg; const int j = l / 3;
    GSL(i, (size_t)NSEQ * RHEADS * RH) {
        const int sq = (int)(i / (RHEADS * RH)), h = (int)(i / RH) % RHEADS, vi = (int)(i % RH);
        float S[RH];
        if (sq < BATCH) { UNROLL for (int e = 0; e < RH; ++e) S[e] = 0.f; }
        else { const float* s0 = c.in[I_WKV] + ((((size_t)j * DB + (sq - BATCH)) * RHEADS + h) * RH + vi) * RH; UNROLL for (int e = 0; e < RH; ++e) S[e] = s0[e]; }
        const int m0 = seq_row0(sq), T = seq_len(sq);
        for (int t = 0; t < T; ++t) {
            const size_t o = (size_t)(m0 + t) * D + h * RH;
            float sa = 0.f;
            UNROLL for (int e = 0; e < RH; ++e) sa += S[e] * c.ka[o + e];
            const float vt = c.v[o + vi]; float yy = 0.f;
            UNROLL for (int e = 0; e < RH; ++e) { S[e] = S[e] * c.wpre[o + e] + sa * c.kb[o + e] + vt * c.k[o + e]; yy += S[e] * c.r[o + e]; }
            c.y[o + vi] = yy;
        }
        float* so = sq < BATCH ? c.out + O_WKVP + ((((size_t)j * BATCH + sq) * RHEADS + h) * RH + vi) * RH
                               : c.out + O_WKVS + ((((size_t)j * DB + (sq - BATCH)) * RHEADS + h) * RH + vi) * RH;
        UNROLL for (int e = 0; e < RH; ++e) so[e] = S[e];
    }
}
DEV void ph_rw_post(const Ctx& c, int l, size_t gtid, size_t gsz) {
    using namespace cfg; const int j = l / 3;
    GSL(i, (size_t)MTOT * RHEADS) {
        const int m = (int)(i / RHEADS), h = (int)(i % RHEADS);
        const size_t o = (size_t)m * D + h * RH;
        float mean = 0.f; for (int e = 0; e < RH; ++e) mean += c.y[o + e]; mean /= RH;
        float var = 0.f; for (int e = 0; e < RH; ++e) { const float d = c.y[o + e] - mean; var += d * d; } var /= RH;
        const float rs = 1.0f / sqrtf(var + LNX_EPS);
        float bonus = 0.f; for (int e = 0; e < RH; ++e) bonus += c.r[o + e] * c.k[o + e] * c.in[I_RK][(size_t)j * D + h * RH + e];
        for (int e = 0; e < RH; ++e) {
            const int ch = h * RH + e;
            const float yn = (c.y[o + e] - mean) * rs * c.in[I_LNW][j * D + ch] + c.in[I_LNB][j * D + ch];
            c.yo[o + e] = (yn + bonus * c.v[o + e]) * c.g[o + e];
        }
    }
}

DEV void rope_apply(const float* xin, float* xout, int pos) {
    using namespace cfg; const int half = ROPE / 2;
    UNROLL for (int i = 0; i < half; ++i) {
        const float inv = exp2f(-(float)i * (13.287712379549449f / half));
        const float ang = (float)pos * inv;
        const float kq = rintf(ang * 0.15915494309189535f);
        float rr = fmaf(-kq, 6.28125f, ang); rr = fmaf(-kq, 1.9353071795864769e-3f, rr);
        const float cs = __cosf(rr), sn = __sinf(rr);
        const float x1 = xin[i], x2 = xin[i + half];
        xout[i] = x1 * cs - x2 * sn; xout[i + half] = x2 * cs + x1 * sn;
    }
}
DEV int row_pos(int m) { return m < cfg::MP ? m % cfg::SEQ : cfg::PAST + (m - cfg::MP) % cfg::DS; }
DEV void ph_mla_norm1(const Ctx& c, int l, size_t gtid, size_t gsz) {
    using namespace cfg; const int j = l / 3;
    GSL(m, MTOT) {
        const float* h = c.mh + m * MLA_IN;
        float ss = 0.f; for (int i = 0; i < QL; ++i) ss += h[i] * h[i];
        float rs = 1.0f / sqrtf(ss / QL + NORM_EPS);
        for (int i = 0; i < QL; ++i) c.qan[m * QL + i] = h[i] * rs * c.in[I_QNORM][j * QL + i];
        ss = 0.f; for (int i = 0; i < KVL; ++i) ss += h[QL + i] * h[QL + i];
        rs = 1.0f / sqrtf(ss / KVL + NORM_EPS);
        float* co = m < (size_t)MP ? c.out + O_CKVP + ((size_t)j * MP + m) * KVL : c.out + O_CKVS + ((size_t)j * MS + (m - MP)) * KVL;
        for (int i = 0; i < KVL; ++i) { const float v = h[QL + i] * rs * c.in[I_KVNORM][j * KVL + i]; c.c[m * KVL + i] = v; co[i] = v; }
        ss = 0.f; UNROLL for (int i = 0; i < ROPE; ++i) ss += h[QL + KVL + i] * h[QL + KVL + i];
        rs = 1.0f / sqrtf(ss / ROPE + NORM_EPS);
        float tmp[ROPE], ro[ROPE];
        UNROLL for (int i = 0; i < ROPE; ++i) tmp[i] = h[QL + KVL + i] * rs * c.in[I_KRN][j * ROPE + i];
        rope_apply(tmp, ro, row_pos((int)m));
        float* ko = m < (size_t)MP ? c.out + O_KPEP + ((size_t)j * MP + m) * ROPE : c.out + O_KPES + ((size_t)j * MS + (m - MP)) * ROPE;
        UNROLL for (int i = 0; i < ROPE; ++i) { c.kp[m * ROPE + i] = ro[i]; ko[i] = ro[i]; }
    }
}
DEV void ph_mla_norm2(const Ctx& c, int l, size_t gtid, size_t gsz) {
    using namespace cfg; const int j = l / 3;
    GSL(i, (size_t)MTOT * MH) {
        const int m = (int)(i / MH), h = (int)(i % MH);
        float* q = c.q + (size_t)m * MH * QD + h * QD;
        float ss = 0.f; UNROLL for (int e = 0; e < NOPE; ++e) ss += q[e] * q[e];
        float rs = 1.0f / sqrtf(ss / NOPE + NORM_EPS);
        UNROLL for (int e = 0; e < NOPE; ++e) q[e] = q[e] * rs * c.in[I_QNN][j * NOPE + e];
        ss = 0.f; UNROLL for (int e = 0; e < ROPE; ++e) ss += q[NOPE + e] * q[NOPE + e];
        rs = 1.0f / sqrtf(ss / ROPE + NORM_EPS);
        float tmp[ROPE], ro[ROPE];
        UNROLL for (int e = 0; e < ROPE; ++e) tmp[e] = q[NOPE + e] * rs * c.in[I_QRN][j * ROPE + e];
        rope_apply(tmp, ro, row_pos(m));
        UNROLL for (int e = 0; e < ROPE; ++e) q[NOPE + e] = ro[e];
        float* kn = c.knr + (size_t)m * MH * NOPE + h * NOPE;
        ss = 0.f; UNROLL for (int e = 0; e < NOPE; ++e) ss += kn[e] * kn[e];
        rs = 1.0f / sqrtf(ss / NOPE + NORM_EPS);
        UNROLL for (int e = 0; e < NOPE; ++e) kn[e] = kn[e] * rs * c.in[I_KNN][j * NOPE + e];
    }
}
DEV void ph_mla_attn_prompt(const Ctx& c, int, size_t gtid, size_t gsz) {
    using namespace cfg; const float scale = 1.0f / sqrtf((float)QD);
    GSL(i, (size_t)MP * MH) {
        const int m = (int)(i / MH), h = (int)(i % MH), t = m % SEQ, m0 = m - t;
        const float* q = c.q + (size_t)m * MH * QD + h * QD;
        float mx = -INFINITY, den = 0.f, acc[VD];
        UNROLL for (int e = 0; e < VD; ++e) acc[e] = 0.f;
        for (int kx = 0; kx <= t; ++kx) {
            const int mk = m0 + kx;
            const float* kn = c.knr + (size_t)mk * MH * NOPE + h * NOPE; const float* kp = c.kp + (size_t)mk * ROPE;
            float s = 0.f;
            UNROLL for (int e = 0; e < NOPE; ++e) s += q[e] * kn[e];
            UNROLL for (int e = 0; e < ROPE; ++e) s += q[NOPE + e] * kp[e];
            s *= scale;
            const float nm = fmaxf(mx, s), corr = expf(mx - nm), p = expf(s - nm);
            den = den * corr + p;
            const float* v = c.vv + (size_t)mk * MH * VD + h * VD;
            UNROLL for (int e = 0; e < VD; ++e) acc[e] = acc[e] * corr + p * v[e];
            mx = nm;
        }
        UNROLL for (int e = 0; e < VD; ++e) c.ao[(size_t)m * MH * VD + h * VD + e] = acc[e] / den;
    }
}
DEV const float* smp_c(const Ctx& c, int j, int s, int pos) {
    using namespace cfg;
    if (pos < PAST) { const int pg = c.page_table[s * NPAGES + pos / PAGE]; return c.in[I_CKV] + (((size_t)j * NPOOL + pg) * PAGE + pos % PAGE) * KVL; }
    return c.c + (size_t)(MP + s * DS + (pos - PAST)) * KVL;
}
DEV const float* smp_kp(const Ctx& c, int j, int s, int pos) {
    using namespace cfg;
    if (pos < PAST) { const int pg = c.page_table[s * NPAGES + pos / PAGE]; return c.in[I_KPE] + (((size_t)j * NPOOL + pg) * PAGE + pos % PAGE) * ROPE; }
    return c.kp + (size_t)(MP + s * DS + (pos - PAST)) * ROPE;
}
DEV void ph_mla_score_sample(const Ctx& c, int l, size_t gtid, size_t gsz) {
    using namespace cfg; const int j = l / 3; const float scale = 1.0f / sqrtf((float)QD);
    GSL(i, (size_t)DB * KTOT * MH) {
        const int pos = (int)(i % KTOT), h = (int)((i / KTOT) % MH), s = (int)(i / ((size_t)MH * KTOT));
        const float* cl = smp_c(c, j, s, pos); const float* kp = smp_kp(c, j, s, pos);
        float kn[NOPE];
        UNROLL for (int e = 0; e < NOPE; ++e) kn[e] = 0.f;
        const float* wuk = c.in[I_WUK] + (size_t)j * KVL * MH * NOPE;
        for (int r = 0; r < KVL; ++r) { const float cv = cl[r]; const float* w = wuk + ((size_t)r * MH + h) * NOPE; UNROLL for (int e = 0; e < NOPE; ++e) kn[e] += cv * w[e]; }
        float ss = 0.f; UNROLL for (int e = 0; e < NOPE; ++e) ss += kn[e] * kn[e];
        const float rs = 1.0f / sqrtf(ss / NOPE + NORM_EPS);
        UNROLL for (int e = 0; e < NOPE; ++e) kn[e] = kn[e] * rs * c.in[I_KNN][j * NOPE + e];
        for (int qi = 0; qi < DS; ++qi) {
            const float* q = c.q + (size_t)(MP + s * DS + qi) * MH * QD + h * QD;
            float sc = 0.f;
            UNROLL for (int e = 0; e < NOPE; ++e) sc += q[e] * kn[e];
            UNROLL for (int e = 0; e < ROPE; ++e) sc += q[NOPE + e] * kp[e];
            const bool ok = pos < PAST || (pos - PAST) <= qi;
            c.sc[(((size_t)s * MH + h) * DS + qi) * KTOT + pos] = ok ? sc * scale : -INFINITY;
        }
    }
}
DEV void ph_mla_softmax_sample(const Ctx& c, int, size_t gtid, size_t gsz) {
    using namespace cfg;
    GSL(i, (size_t)DB * MH * DS) {
        float* sc = c.sc + i * KTOT;
        float mx = -INFINITY; for (int p = 0; p < KTOT; ++p) mx = fmaxf(mx, sc[p]);
        float den = 0.f; for (int p = 0; p < KTOT; ++p) den += expf(sc[p] - mx);
        const float inv = 1.0f / den;
        for (int p = 0; p < KTOT; ++p) sc[p] = expf(sc[p] - mx) * inv;
    }
}
DEV void ph_mla_pv_sample(const Ctx& c, int l, size_t gtid, size_t gsz) {
    using namespace cfg; const int j = l / 3;
    GSL(i, (size_t)DB * MH * DS * KVL) {
        const int r = (int)(i % KVL); const size_t row = i / KVL; const int s = (int)(row / (MH * DS));
        const float* p = c.sc + row * KTOT; float acc = 0.f;
        for (int pos = 0; pos < KTOT; ++pos) acc += p[pos] * smp_c(c, j, s, pos)[r];
        c.olat[i] = acc;
    }
}
DEV void ph_mla_out_sample(const Ctx& c, int l, size_t gtid, size_t gsz) {
    using namespace cfg; const int j = l / 3;
    GSL(i, (size_t)MS * MH * VD) {
        const int e = (int)(i % VD), h = (int)((i / VD) % MH), ms = (int)(i / (MH * VD)), s = ms / DS, qi = ms % DS;
        const float* ol = c.olat + (((size_t)s * MH + h) * DS + qi) * KVL;
        const float* wuv = c.in[I_WUV] + (size_t)j * KVL * MH * VD;
        float acc = 0.f;
        for (int r = 0; r < KVL; ++r) acc += ol[r] * wuv[((size_t)r * MH + h) * VD + e];
        c.ao[(size_t)(MP + ms) * MH * VD + h * VD + e] = acc;
    }
}

DEV float mb_xpad(const Ctx& c, int j, int m, int sq, int tt, int ch) {
    using namespace cfg;
    if (tt < MB_CONV - 1) return sq < BATCH ? 0.f : c.in[I_CONV][(((size_t)j * DB + (sq - BATCH)) * (MB_CONV - 1) + tt) * MB_CD + ch];
    (void)m; return c.zx[(size_t)(seq_row0(sq) + tt - (MB_CONV - 1)) * MB_IN + MB_INNER + ch];
}
DEV void ph_mb_conv(const Ctx& c, int l, size_t gtid, size_t gsz) {
    using namespace cfg; const int j = l / 3;
    GSL(i, (size_t)MTOT * MB_CD) {
        const int m = (int)(i / MB_CD), ch = (int)(i % MB_CD), t = row_t(m), sq = row_seq(m), T = seq_len(sq);
        float acc = c.in[I_CONVB][j * MB_CD + ch];
        for (int jj = 0; jj < MB_CONV; ++jj) acc += mb_xpad(c, j, m, sq, t + jj, ch) * c.in[I_CONVW][((size_t)j * MB_CONV + jj) * MB_CD + ch];
        c.xbc[i] = siluf_(acc);
        if (t < MB_CONV - 1) {
            const float v = mb_xpad(c, j, m, sq, T + t, ch);
            if (sq < BATCH) c.out[O_CONVP + (((size_t)j * BATCH + sq) * (MB_CONV - 1) + t) * MB_CD + ch] = v;
            else c.out[O_CONVS + (((size_t)j * DB + (sq - BATCH)) * (MB_CONV - 1) + t) * MB_CD + ch] = v;
        }
    }
}
DEV void ph_mb_dt(const Ctx& c, int l, size_t gtid, size_t gsz) {
    using namespace cfg; const int j = l / 3;
    GSL(i, (size_t)MTOT * MB_HEADS) {
        const int m = (int)(i / MB_HEADS), h = (int)(i % MB_HEADS);
        c.dt[i] = softplusf_(c.zx[(size_t)m * MB_IN + MB_INNER + MB_CD + h] + c.in[I_DTB][j * MB_HEADS + h]);
    }
}
DEV void ph_mb_scan(const Ctx& c, int l, size_t gtid, size_t gsz) {
    using namespace cfg; const int j = l / 3;
    GSL(i, (size_t)NSEQ * MB_HEADS * MB_HEAD) {
        const int p = (int)(i % MB_HEAD), h = (int)((i / MB_HEAD) % MB_HEADS), sq = (int)(i / (MB_HEADS * MB_HEAD));
        const int g = h / (MB_HEADS / MB_GROUPS);
        float hs[MB_STATE];
        if (sq < BATCH) { UNROLL for (int n = 0; n < MB_STATE; ++n) hs[n] = 0.f; }
        else { const float* s0 = c.in[I_SSM] + ((((size_t)j * DB + (sq - BATCH)) * MB_HEADS + h) * MB_HEAD + p) * MB_STATE; UNROLL for (int n = 0; n < MB_STATE; ++n) hs[n] = s0[n]; }
        const float A = -expf(c.in[I_ALOG][j * MB_HEADS + h]), dsk = c.in[I_BD][j * MB_HEADS + h];
        const int m0 = seq_row0(sq), T = seq_len(sq);
        for (int t = 0; t < T; ++t) {
            const size_t m = (size_t)(m0 + t);
            const float dtv = c.dt[m * MB_HEADS + h], dA = expf(dtv * A);
            const float xv = c.xbc[m * MB_CD + h * MB_HEAD + p], xdt = xv * dtv;
            const float* Bm = c.xbc + m * MB_CD + MB_INNER + g * MB_STATE; const float* Cm = Bm + MB_GN;
            float yy = 0.f;
            UNROLL for (int n = 0; n < MB_STATE; ++n) { hs[n] = hs[n] * dA + xdt * Bm[n]; yy += Cm[n] * hs[n]; }
            c.my[m * MB_INNER + h * MB_HEAD + p] = yy + dsk * xv;
        }
        float* so = sq < BATCH ? c.out + O_SSMP + ((((size_t)j * BATCH + sq) * MB_HEADS + h) * MB_HEAD + p) * MB_STATE
                               : c.out + O_SSMS + ((((size_t)j * DB + (sq - BATCH)) * MB_HEADS + h) * MB_HEAD + p) * MB_STATE;
        UNROLL for (int n = 0; n < MB_STATE; ++n) so[n] = hs[n];
    }
}
DEV void ph_mb_gate(const Ctx& c, int l, size_t gtid, size_t gsz) {
    using namespace cfg; const int j = l / 3; constexpr int GW = MB_INNER / MB_GROUPS;
    GSL(i, (size_t)MTOT * MB_GROUPS) {
        const int m = (int)(i / MB_GROUPS), g = (int)(i % MB_GROUPS);
        float ss = 0.f;
        for (int e = 0; e < GW; ++e) { const float v = c.my[(size_t)m * MB_INNER + g * GW + e] * siluf_(c.zx[(size_t)m * MB_IN + g * GW + e]); ss += v * v; }
        const float rs = 1.0f / sqrtf(ss / GW + NORM_EPS);
        for (int e = 0; e < GW; ++e) {
            const float v = c.my[(size_t)m * MB_INNER + g * GW + e] * siluf_(c.zx[(size_t)m * MB_IN + g * GW + e]);
            c.yzn[(size_t)m * MB_INNER + g * GW + e] = v * rs * c.in[I_BNORM][j * MB_INNER + g * GW + e];
        }
    }
}
typedef short bf16x8_t __attribute__((ext_vector_type(8)));
typedef float f32x4_t __attribute__((ext_vector_type(4)));
__device__ __forceinline__ unsigned short f2bf(float f) { unsigned u = __float_as_uint(f); u += 0x7fffu + ((u >> 16) & 1u); return (unsigned short)(u >> 16); }
#define XB_TMO      128
#define XB_XCNT(j)  (256  + 64 * (j))
#define XB_XSUB(j)  (1280 + 64 * (j))
#define XB_XGEN(j)  (2304 + 64 * (j))
#define XB_TOP      3328
#define XB_TOPGEN   3392
#define XCD_BAR_WORDS 3456
#define XB_SPIN_CAP (1u << 25)
#define LAS __attribute__((address_space(3)))

__device__ __forceinline__ unsigned xb_ld(unsigned* p)              { return __hip_atomic_load(p, __ATOMIC_RELAXED, __HIP_MEMORY_SCOPE_AGENT); }
__device__ __forceinline__ unsigned xb_add(unsigned* p, unsigned v) { return __hip_atomic_fetch_add(p, v, __ATOMIC_RELAXED, __HIP_MEMORY_SCOPE_AGENT); }
__device__ __forceinline__ unsigned xb_xcc_id() { return (unsigned)__builtin_amdgcn_s_getreg((3 << 11) | 20) & 0xFu; }
#define XB_SPIN(cond, bar) do { unsigned _sp = 0; while (cond) { __builtin_amdgcn_s_sleep(1); \
    if ((++_sp & 255u) == 0u) { if (xb_ld(&(bar)[XB_TMO])) break; if (_sp > XB_SPIN_CAP) { atomicAdd(&(bar)[XB_TMO], 1u); break; } } } } while (0)

struct XcdBarrier {
    unsigned* bar; unsigned x;
    volatile LAS unsigned* st;
};

__device__ __forceinline__ XcdBarrier xcd_barrier_post(unsigned* bar, volatile LAS unsigned* st) {
    XcdBarrier b; b.bar = bar; b.x = xb_xcc_id(); b.st = st;
    if (threadIdx.x == 0) (void)xb_add(&bar[XB_XCNT(b.x)], 1u);
    return b;
}
__device__ __forceinline__ void xcd_barrier_complete(unsigned* bar, unsigned x, unsigned& nloc, unsigned& nx) {
    const unsigned G = gridDim.x * gridDim.y * gridDim.z;
    unsigned sum, cnt, mine, sp = 0u;
    for (;;) {
        sum = 0u; cnt = 0u; mine = 0u;
#pragma unroll
        for (unsigned j = 0; j < 16; ++j) { const unsigned c = xb_ld(&bar[XB_XCNT(j)]); sum += c; cnt += (c > 0u) ? 1u : 0u; mine = (j == x) ? c : mine; }
        if (sum == G) break;
        __builtin_amdgcn_s_sleep(1);
        if ((++sp & 255u) == 0u) { if (xb_ld(&bar[XB_TMO])) break; if (sp > XB_SPIN_CAP) { atomicAdd(&bar[XB_TMO], 1u); break; } }
    }
    nloc = mine > 0u ? mine : 1u; nx = cnt > 0u ? cnt : 1u;
}

__device__ __forceinline__ void xcd_barrier(const XcdBarrier& b) {
    asm volatile("s_waitcnt vmcnt(0)" ::: "memory");
    __syncthreads();
    if (threadIdx.x == 0) {
        unsigned* bar = b.bar;
        __builtin_amdgcn_s_waitcnt(0);
        unsigned nloc = b.st[0], nx = b.st[1];
        if (nloc == 0u) { xcd_barrier_complete(bar, b.x, nloc, nx); b.st[0] = nloc; b.st[1] = nx; }
        const unsigned old = xb_add(&bar[XB_XSUB(b.x)], 1u);
        const unsigned gen = old / nloc;
        if (old + 1u == (gen + 1u) * nloc) {
            __builtin_amdgcn_fence(__ATOMIC_RELEASE, "agent");
            asm volatile("s_waitcnt vmcnt(0)" ::: "memory");
            const unsigned og = xb_add(&bar[XB_TOP], 1u);
            const unsigned tg = og / nx;
            if (og + 1u == (tg + 1u) * nx) xb_add(&bar[XB_TOPGEN], 1u);
            else XB_SPIN(xb_ld(&bar[XB_TOPGEN]) == tg, bar);
            __builtin_amdgcn_fence(__ATOMIC_ACQUIRE, "agent");
            xb_add(&bar[XB_XGEN(b.x)], 1u);
            asm volatile("s_waitcnt vmcnt(0)" ::: "memory");
        } else {
            XB_SPIN(xb_ld(&bar[XB_XGEN(b.x)]) == gen, bar);
            __builtin_amdgcn_fence(__ATOMIC_ACQUIRE, "agent");
            asm volatile("s_waitcnt vmcnt(0)" ::: "memory");
        }
    }
    __syncthreads();
}

struct Bump { char* p; size_t off; float* f(size_t n) { float* r = (float*)(p + off); off += ((n * 4 + 255) / 256) * 256; return r; } };

static size_t setup_ctx(Ctx& c, void* const* d_in, void* d_out, void* d_ws) {
    using namespace cfg;
    for (int i = 0; i < 51; ++i) c.in[i] = (const float*)d_in[i];
    c.page_table = (const int*)d_in[I_PT];
    c.out = (float*)d_out; c.x = c.out;
    Bump b{(char*)d_ws, 4096 * 4};
    const size_t MD = (size_t)MTOT * D;
    c.xn = b.f(MD); c.vf = b.f(MD);
    const size_t base = b.off;
    for (int p = 0; p < 6; ++p) c.xm[p] = b.f(MD);
    c.r = b.f(MD); c.k = b.f(MD); c.v = b.f(MD); c.wpre = b.f(MD); c.apre = b.f(MD); c.vpre = b.f(MD); c.g = b.f(MD);
    c.hw = b.f((size_t)MTOT * RW_DL); c.ha = b.f((size_t)MTOT * RW_AL); c.hv = b.f((size_t)MTOT * RW_VL); c.hg = b.f((size_t)MTOT * RW_GL);
    c.ka = b.f(MD); c.kb = b.f(MD); c.y = c.xm[0]; c.yo = c.xm[1];
    size_t hi = b.off;
    b.off = base;
    c.mh = b.f((size_t)MTOT * MLA_IN); c.qan = b.f((size_t)MTOT * QL); c.q = b.f((size_t)MTOT * MH * QD); c.c = b.f((size_t)MTOT * KVL); c.kp = b.f((size_t)MTOT * ROPE);
    c.knr = b.f((size_t)MTOT * MH * NOPE); c.vv = b.f((size_t)MTOT * MH * VD); c.ao = b.f((size_t)MTOT * MH * VD);
    c.sc = b.f((size_t)DB * MH * DS * KTOT); c.olat = b.f((size_t)DB * MH * DS * KVL);
    if (b.off > hi) hi = b.off;
    b.off = base;
    c.zx = b.f((size_t)MTOT * MB_IN); c.xbc = b.f((size_t)MTOT * MB_CD); c.dt = b.f((size_t)MTOT * MB_HEADS); c.my = b.f((size_t)MTOT * MB_INNER); c.yzn = b.f((size_t)MTOT * MB_INNER);
    if (b.off > hi) hi = b.off;
    b.off = hi;
    c.hmid = b.f((size_t)MTOT * FFN);
    return b.off;
}

__device__ __forceinline__ unsigned tid_now() { unsigned t = threadIdx.x; asm volatile("" : "+v"(t)); return t; }
namespace pg8 {
#define PG8_LAS __attribute__((address_space(3)))
typedef unsigned short bf16_t;
typedef short bf16x8 __attribute__((ext_vector_type(8)));
typedef float f32x4 __attribute__((ext_vector_type(4)));
typedef float f32x2 __attribute__((ext_vector_type(2)));
typedef unsigned u32x4 __attribute__((ext_vector_type(4)));
typedef unsigned u32x2 __attribute__((ext_vector_type(2)));
constexpr int BM = 256, BK = 64, HALF = 128, HTB = HALF * BK * 2  , STAGE_BYTES = 8 * HTB, NXCD = 8, WGM = 8;

__host__ __device__ __forceinline__ int lds_byte(int r, int c) { const int st = (r >> 4) * 2 + (c >> 5), rr = r & 15, cc = c & 31, ob = rr * 64 + cc * 2; return st * 1024 + (ob ^ (((ob >> 9) & 1) << 5)); }
__host__ __device__ __forceinline__ void stage_rc(int b, int& R, int& C) { const int st = b / 1024, sb = b % 1024, swz = sb ^ (((sb >> 9) & 1) << 5); R = (st >> 1) * 16 + swz / 64; C = (st & 1) * 32 + (swz % 64) / 2; }
__host__ __device__ __forceinline__ int perm32(int rho) { const int n = rho >> 4, i = rho & 15; return 8 * (i >> 2) + 4 * n + (i & 3); }
__device__ __forceinline__ unsigned cvt_pk_bf16(float lo, float hi) { unsigned r; asm volatile("v_cvt_pk_bf16_f32 %0, %1, %2" : "=v"(r) : "v"(lo), "v"(hi)); return r; }

struct Unit { int pm, pn, k0, nt, asel, part; };
struct Gemm { const bf16_t* A; const bf16_t* Bt; int lda, ldb; size_t asel_stride; };

struct NoSel { __device__ static __forceinline__ int sel(int) { return 0; } };
template <class ASEL = NoSel>
struct Order {
    int nMp, nMs, nN, nwgP, nwgS, G, c, K, ksplit;
    __device__ __forceinline__ void init(int nMp_, int nMs_, int nN_, int K_, int ksplit_, int G_, int c_) { nMp = nMp_; nMs = nMs_; nN = nN_; nwgP = nMp * nN; K = K_; ksplit = ksplit_; nwgS = nMs * nN * ksplit; G = G_; c = c_; }
    __device__ __forceinline__ bool next(int i, Unit& u) const {
        const long L = (long)i * G + c;
        if (L < nwgP) {
            int wgid = (int)L; { const int q = nwgP / NXCD, r = nwgP % NXCD, xcd = wgid % NXCD, off = wgid / NXCD; wgid = (xcd < r ? xcd * (q + 1) : r * (q + 1) + (xcd - r) * q) + off; }
            const int nig = WGM * nN, gid = wgid / nig, fm = gid * WGM, gsz = (nMp - fm) < WGM ? (nMp - fm) : WGM;
            u.pm = fm + ((wgid % nig) % gsz); u.pn = (wgid % nig) / gsz; u.k0 = 0; u.nt = K / BK; u.part = 0; u.asel = ASEL::sel(u.pn); return true;
        }
        const long Ls = L - nwgP; if (Ls >= nwgS) return false;
        const int sub = (int)(Ls % ksplit), t = (int)(Ls / ksplit);
        u.pm = nMp + t % nMs; u.pn = t / nMs; u.nt = K / BK / ksplit; u.k0 = sub * u.nt * BK; u.part = ksplit > 1 ? 1 : 0; u.asel = ASEL::sel(u.pn); return true;
    }
};

template <class Epi, class Sched>
__device__ __forceinline__ void gemm_phase(PG8_LAS unsigned char* lds, const Gemm g, const Sched& S, const Epi& E) {
    const int tid = (int)tid_now(), wid = __builtin_amdgcn_readfirstlane(tid >> 6), lane = tid & 63, wr = wid >> 2, wc = wid & 3, fr = lane & 15, fq = lane >> 4;
    unsigned voffA[2], voffB[2];
#pragma unroll
    for (int i = 0; i < 2; ++i) { int R, C; stage_rc(tid * 16 + i * 8192, R, C); const int Rb = Epi::PERM ? ((R & ~31) + perm32(R & 31)) : R;
        voffA[i] = (unsigned)(R * g.lda + C) * 2u; voffB[i] = (unsigned)(Rb * g.ldb + C) * 2u; }
    const size_t kstep = (size_t)(BK * 2);
    const size_t hstepA = (size_t)HALF * g.lda * 2, hstepB = (size_t)HALF * g.ldb * 2;
    const unsigned ldsw = (unsigned)wid * 1024u;
    const int aoff = lds_byte(wr * 64 + fr, fq * 8), boff = lds_byte(wc * 32 + fr, fq * 8);
#define PG8_SA(b, h) (((b) * 2 + (h)) * HTB)
#define PG8_SB(b, h) ((4 + (b) * 2 + (h)) * HTB)
#define PG8_STAGE(bufoff, gbase, voff) do { _Pragma("unroll") for (int _i = 0; _i < 2; ++_i) \
        __builtin_amdgcn_global_load_lds((const unsigned*)((const char*)(gbase) + (voff)[_i]), (PG8_LAS unsigned*)(lds + (bufoff) + ldsw + _i * 8192), 16, 0, 0); } while (0)
#define PG8_LDA(dst, b, h) do { _Pragma("unroll") for (int m = 0; m < 4; ++m) _Pragma("unroll") for (int k = 0; k < 2; ++k) dst[m][k] = *(const PG8_LAS bf16x8*)(lds + PG8_SA(b, h) + aoff + m * 2048 + k * 1024); } while (0)
#define PG8_LDB(dst, b, h) do { _Pragma("unroll") for (int n = 0; n < 2; ++n) _Pragma("unroll") for (int k = 0; k < 2; ++k) dst[n][k] = *(const PG8_LAS bf16x8*)(lds + PG8_SB(b, h) + boff + n * 2048 + k * 1024); } while (0)
#define PG8_MMA(ai, bj, At, Bt) do { __builtin_amdgcn_s_setprio(1); _Pragma("unroll") for (int m = 0; m < 4; ++m) _Pragma("unroll") for (int n = 0; n < 2; ++n) _Pragma("unroll") for (int k = 0; k < 2; ++k) \
        acc[ai][bj][m][n] = __builtin_amdgcn_mfma_f32_16x16x32_bf16(Bt[n][k], At[m][k], acc[ai][bj][m][n], 0, 0, 0); __builtin_amdgcn_s_setprio(0); } while (0)
#define PG8_WAIT_V(n) asm volatile("s_waitcnt vmcnt(" #n ")" ::: "memory")
#define PG8_WAIT_L(n) asm volatile("s_waitcnt lgkmcnt(" #n ")" ::: "memory")
#define PG8_BAR __builtin_amdgcn_s_barrier()
#define PG8_SCHED __builtin_amdgcn_sched_barrier(0)
#define PG8_ABASE(u) ((const char*)g.A + ((size_t)(u).asel * g.asel_stride + (size_t)(u).pm * BM * g.lda + (u).k0) * 2)
#define PG8_BBASE(u) ((const char*)g.Bt + ((size_t)(u).pn * BM * g.ldb + (u).k0) * 2)
    Unit cur, nxt; int ui = 0;
    if (!S.next(0, cur)) return;
    f32x4 acc[2][2][4][2];
#pragma unroll
    for (int a = 0; a < 2; ++a)
#pragma unroll
        for (int b = 0; b < 2; ++b)
#pragma unroll
            for (int m = 0; m < 4; ++m)
#pragma unroll
                for (int n = 0; n < 2; ++n) acc[a][b][m][n] = (f32x4){0.f, 0.f, 0.f, 0.f};
    bf16x8 At[4][2], B0[2][2], B1[2][2];
    const char* cA = PG8_ABASE(cur); const char* cB = PG8_BBASE(cur);
    PG8_STAGE(PG8_SB(0, 0), cB, voffB); PG8_STAGE(PG8_SA(0, 0), cA, voffA); PG8_STAGE(PG8_SB(0, 1), cB + hstepB, voffB); PG8_STAGE(PG8_SA(0, 1), cA + hstepA, voffA);
    if (wr == 1) PG8_BAR;
    PG8_WAIT_V(4); PG8_BAR;
    PG8_STAGE(PG8_SB(1, 0), cB + kstep, voffB); PG8_STAGE(PG8_SA(1, 0), cA + kstep, voffA); PG8_STAGE(PG8_SB(1, 1), cB + hstepB + kstep, voffB);
    PG8_WAIT_V(6); PG8_BAR;
    for (;;) {
        const bool has_next = S.next(ui + 1, nxt);
        const char* nA = has_next ? PG8_ABASE(nxt) : cA; const char* nB = has_next ? PG8_BBASE(nxt) : cB;
        const int nt = cur.nt;
        for (int t = 0; t < nt; t += 2) {
            const bool last = (t == nt - 2);
            const char* a1 = cA + (size_t)(t + 1) * kstep;
            const char* a2 = last ? nA : cA + (size_t)(t + 2) * kstep; const char* b2 = last ? nB : cB + (size_t)(t + 2) * kstep;
            const char* a3 = a2 + kstep; const char* b3 = b2 + kstep;
            PG8_LDB(B0, 0, 0); PG8_SCHED; PG8_LDA(At, 0, 0); PG8_STAGE(PG8_SA(1, 1), a1 + hstepA, voffA);
            PG8_WAIT_L(8); PG8_BAR; PG8_WAIT_L(0); PG8_MMA(0, 0, At, B0); PG8_BAR; PG8_SCHED;
            PG8_LDB(B1, 0, 1); PG8_STAGE(PG8_SB(0, 0), b2, voffB);
            PG8_BAR; PG8_WAIT_L(0); PG8_MMA(0, 1, At, B1); PG8_BAR;
            PG8_LDA(At, 0, 1); PG8_STAGE(PG8_SA(0, 0), a2, voffA);
            PG8_BAR; PG8_WAIT_L(0); PG8_MMA(1, 0, At, B0); PG8_BAR; PG8_SCHED;
            PG8_STAGE(PG8_SB(0, 1), b2 + hstepB, voffB);
            PG8_WAIT_V(6); PG8_BAR; PG8_MMA(1, 1, At, B1); PG8_BAR;
            PG8_LDB(B0, 1, 0); PG8_SCHED; PG8_LDA(At, 1, 0); PG8_STAGE(PG8_SA(0, 1), a2 + hstepA, voffA);
            PG8_WAIT_L(8); PG8_BAR; PG8_WAIT_L(0); PG8_MMA(0, 0, At, B0); PG8_BAR; PG8_SCHED;
            PG8_LDB(B1, 1, 1); PG8_STAGE(PG8_SB(1, 0), b3, voffB);
            PG8_BAR; PG8_WAIT_L(0); PG8_MMA(0, 1, At, B1); PG8_BAR;
            PG8_LDA(At, 1, 1); PG8_STAGE(PG8_SA(1, 0), a3, voffA);
            PG8_BAR; PG8_WAIT_L(0); PG8_MMA(1, 0, At, B0); PG8_BAR; PG8_SCHED;
            PG8_STAGE(PG8_SB(1, 1), b3 + hstepB, voffB);
            PG8_WAIT_V(6); PG8_BAR; PG8_MMA(1, 1, At, B1); PG8_BAR;
        }
        E(acc, cur, wr, wc, fr, fq);
        if (!has_next) break;
#pragma unroll
        for (int a = 0; a < 2; ++a)
#pragma unroll
            for (int b = 0; b < 2; ++b)
#pragma unroll
                for (int m = 0; m < 4; ++m)
#pragma unroll
                    for (int n = 0; n < 2; ++n) acc[a][b][m][n] = (f32x4){0.f, 0.f, 0.f, 0.f};
        cur = nxt; cA = nA; cB = nB; ++ui;
    }
    PG8_WAIT_V(0);
    if (wr == 0) PG8_BAR;
    PG8_BAR;
#undef PG8_SA
#undef PG8_SB
#undef PG8_STAGE
#undef PG8_LDA
#undef PG8_LDB
#undef PG8_MMA
#undef PG8_WAIT_V
#undef PG8_WAIT_L
#undef PG8_BAR
#undef PG8_SCHED
#undef PG8_ABASE
#undef PG8_BBASE
}

struct EpiAccF32 {
    static constexpr bool PERM = false;
    float* C; int ldc; float* slab; int pm0, nMs, ksplit; const float* Csrc = nullptr;
    __device__ __forceinline__ void operator()(const f32x4 (&acc)[2][2][4][2], const Unit& u, int wr, int wc, int fr, int fq) const {
        if (u.part) {
            float* sl = slab + ((size_t)((u.pn * nMs + (u.pm - pm0)) * ksplit + u.k0 / (u.nt * BK)) * BM + wr * 64 + fr) * BM + wc * 32 + 4 * fq;
#pragma unroll
            for (int ai = 0; ai < 2; ++ai)
#pragma unroll
                for (int m = 0; m < 4; ++m) { float* rowp = sl + (size_t)(ai * HALF + m * 16) * BM;
#pragma unroll
                    for (int bj = 0; bj < 2; ++bj)
#pragma unroll
                        for (int n = 0; n < 2; ++n) *(f32x4*)(rowp + bj * HALF + n * 16) = acc[ai][bj][m][n]; }
        } else {
            const int row0 = u.pm * BM + wr * 64 + fr, col0 = u.pn * BM + wc * 32 + 4 * fq;
#pragma unroll
            for (int ai = 0; ai < 2; ++ai)
#pragma unroll
                for (int m2 = 0; m2 < 4; m2 += 2) {
                    f32x4 t[2][2][2];
#pragma unroll
                    for (int mm = 0; mm < 2; ++mm) { const float* rowp = (Csrc ? Csrc : C) + (size_t)(row0 + ai * HALF + (m2 + mm) * 16) * ldc + col0;
#pragma unroll
                        for (int bj = 0; bj < 2; ++bj)
#pragma unroll
                            for (int n = 0; n < 2; ++n) t[mm][bj][n] = *(const f32x4*)(rowp + bj * HALF + n * 16); }
#pragma unroll
                    for (int mm = 0; mm < 2; ++mm) { float* rowp = C + (size_t)(row0 + ai * HALF + (m2 + mm) * 16) * ldc + col0;
#pragma unroll
                        for (int bj = 0; bj < 2; ++bj)
#pragma unroll
                            for (int n = 0; n < 2; ++n) *(f32x4*)(rowp + bj * HALF + n * 16) = t[mm][bj][n] + acc[ai][bj][m2 + mm][n]; }
                }
        }
    }
};
struct EpiF32 {
    static constexpr bool PERM = false;
    float* C; int ldc; int ncols;
    __device__ __forceinline__ void operator()(const f32x4 (&acc)[2][2][4][2], const Unit& u, int wr, int wc, int fr, int fq) const {
        const int row0 = u.pm * BM + wr * 64 + fr, col0 = u.pn * BM + wc * 32 + 4 * fq;
#pragma unroll
        for (int ai = 0; ai < 2; ++ai)
#pragma unroll
            for (int m = 0; m < 4; ++m) { float* rowp = C + (size_t)(row0 + ai * HALF + m * 16) * ldc + col0;
#pragma unroll
                for (int bj = 0; bj < 2; ++bj)
#pragma unroll
                    for (int n = 0; n < 2; ++n) if (col0 + bj * HALF + n * 16 < ncols) *(f32x4*)(rowp + bj * HALF + n * 16) = acc[ai][bj][m][n]; }
    }
};
template <int ACT> struct EpiBf16 {
    static constexpr bool PERM = true;
    bf16_t* O; int ldc;
    __device__ __forceinline__ void operator()(const f32x4 (&acc)[2][2][4][2], const Unit& u, int wr, int wc, int fr, int fq) const {
        const int row0 = u.pm * BM + wr * 64 + fr, col0 = u.pn * BM + wc * 32 + 8 * fq;
#pragma unroll
        for (int ai = 0; ai < 2; ++ai)
#pragma unroll
            for (int m = 0; m < 4; ++m) { bf16_t* rowp = O + (size_t)(row0 + ai * HALF + m * 16) * ldc + col0;
#pragma unroll
                for (int bj = 0; bj < 2; ++bj) { f32x4 v0 = acc[ai][bj][m][0], v1 = acc[ai][bj][m][1];
                    if (ACT == 3) {
#pragma unroll
                        for (int j = 0; j < 4; ++j) { const float a = fmaxf(v0[j], 0.f), b = fmaxf(v1[j], 0.f); v0[j] = a * a; v1[j] = b * b; } }
                    u32x4 w; w.x = cvt_pk_bf16(v0[0], v0[1]); w.y = cvt_pk_bf16(v0[2], v0[3]); w.z = cvt_pk_bf16(v1[0], v1[1]); w.w = cvt_pk_bf16(v1[2], v1[3]);
                    *(u32x4*)(rowp + bj * HALF) = w; } }
    }
};
}
typedef pg8::bf16_t bf16_t;
#define LDSP __attribute__((address_space(3)))
struct Fast {
    bf16_t *xnb, *hmidb;
    bf16_t *w1t, *w2t;
    float* slab;
};
__device__ __forceinline__ unsigned pk2bf(float lo, float hi) { return pg8::cvt_pk_bf16(lo, hi); }
__device__ __forceinline__ float wave_sum64(float v) {
#pragma unroll
    for (int o = 1; o < 64; o <<= 1) v += __shfl_xor(v, o);
    return v;
}
__device__ __forceinline__ void red16x4(float& a, float& b, float& c, float& d) {
    asm volatile("s_nop 1\n"
        "v_add_f32_dpp %0, %0, %0 quad_perm:[1,0,3,2] row_mask:0xf bank_mask:0xf\n" "v_add_f32_dpp %1, %1, %1 quad_perm:[1,0,3,2] row_mask:0xf bank_mask:0xf\n"
        "v_add_f32_dpp %2, %2, %2 quad_perm:[1,0,3,2] row_mask:0xf bank_mask:0xf\n" "v_add_f32_dpp %3, %3, %3 quad_perm:[1,0,3,2] row_mask:0xf bank_mask:0xf\n"
        "v_add_f32_dpp %0, %0, %0 quad_perm:[2,3,0,1] row_mask:0xf bank_mask:0xf\n" "v_add_f32_dpp %1, %1, %1 quad_perm:[2,3,0,1] row_mask:0xf bank_mask:0xf\n"
        "v_add_f32_dpp %2, %2, %2 quad_perm:[2,3,0,1] row_mask:0xf bank_mask:0xf\n" "v_add_f32_dpp %3, %3, %3 quad_perm:[2,3,0,1] row_mask:0xf bank_mask:0xf\n"
        "v_add_f32_dpp %0, %0, %0 row_ror:4 row_mask:0xf bank_mask:0xf\n" "v_add_f32_dpp %1, %1, %1 row_ror:4 row_mask:0xf bank_mask:0xf\n"
        "v_add_f32_dpp %2, %2, %2 row_ror:4 row_mask:0xf bank_mask:0xf\n" "v_add_f32_dpp %3, %3, %3 row_ror:4 row_mask:0xf bank_mask:0xf\n"
        "v_add_f32_dpp %0, %0, %0 row_ror:8 row_mask:0xf bank_mask:0xf\n" "v_add_f32_dpp %1, %1, %1 row_ror:8 row_mask:0xf bank_mask:0xf\n"
        "v_add_f32_dpp %2, %2, %2 row_ror:8 row_mask:0xf bank_mask:0xf\n" "v_add_f32_dpp %3, %3, %3 row_ror:8 row_mask:0xf bank_mask:0xf\n"
        "s_nop 1"
        : "+v"(a), "+v"(b), "+v"(c), "+v"(d));
}
__device__ __forceinline__ void tr_item(const float* __restrict__ W, int ldw, int K, bf16_t* WT, int nvalid, const float* __restrict__ kscale, LDSP float* scr, int item, int nblk, int lane) {
    const int kb = item / nblk, nb = item % nblk, k0 = 64 * kb, n0 = 32 * nb;
    const bool ok = n0 < nvalid;
#pragma unroll
    for (int i = 0; i < 8; ++i) { const int kk = 8 * i + (lane >> 3), nn = 4 * (lane & 7); pg8::f32x4 v = ok ? *(const pg8::f32x4*)(W + (size_t)(k0 + kk) * ldw + n0 + nn) : (pg8::f32x4){0.f, 0.f, 0.f, 0.f};
        if (kscale) v = v * kscale[k0 + kk];
        scr[kk * 33 + nn] = v[0]; scr[kk * 33 + nn + 1] = v[1]; scr[kk * 33 + nn + 2] = v[2]; scr[kk * 33 + nn + 3] = v[3]; }
    asm volatile("s_waitcnt lgkmcnt(0)" ::: "memory");
    const int c = lane & 7;
#pragma unroll
    for (int j = 0; j < 4; ++j) { const int n = (lane >> 3) + 8 * j; const LDSP float* s = scr + (8 * c) * 33 + n;
        pg8::u32x4 o; o.x = pk2bf(s[0 * 33], s[1 * 33]); o.y = pk2bf(s[2 * 33], s[3 * 33]); o.z = pk2bf(s[4 * 33], s[5 * 33]); o.w = pk2bf(s[6 * 33], s[7 * 33]);
        *(pg8::u32x4*)(WT + (size_t)(n0 + n) * K + k0 + 8 * c) = o; }
    asm volatile("s_waitcnt lgkmcnt(0)" ::: "memory");
}
__device__ __forceinline__ void tr_weight(const float* W, int K, int N, int npad, bf16_t* WT, const float* kscale, LDSP float* scr, int gw, int ngw, int lane) {
    const int nblk = npad / 32, items = (K / 64) * nblk;
    for (int it = gw; it < items; it += ngw) tr_item(W, N, K, WT, N, kscale, scr, it, nblk, lane);
}
constexpr int TRJ_W = 12;
struct TrTab { LDSP int* t; int n; int total; };
__device__ __forceinline__ void trj_put(TrTab& tb, const float* W, int K, int N, int npad, bf16_t* WT) {
    LDSP int* e = tb.t + tb.n * TRJ_W; const unsigned long long w = (unsigned long long)(size_t)W, o = (unsigned long long)(size_t)WT;
    const int nblk = npad / 32, items = (K / 64) * nblk;
    e[0] = (int)(unsigned)w; e[1] = (int)(unsigned)(w >> 32); e[2] = (int)(unsigned)o; e[3] = (int)(unsigned)(o >> 32); e[4] = N; e[5] = K; e[6] = N; e[7] = nblk; e[8] = tb.total; e[9] = tb.total + items;
    tb.total += items; ++tb.n;
}
struct TrCur { bf16_t* wt; int K, k0, n0; };
__device__ __forceinline__ bool trj_issue(LDSP const int* tab, int njobs, int idx, int& j, pg8::f32x4 (&v)[8], TrCur& t, int lane) {
    while (j < njobs && idx >= __builtin_amdgcn_readfirstlane(tab[j * TRJ_W + 9])) ++j;
    if (j >= njobs) return false;
    LDSP const int* e = tab + j * TRJ_W;
    const unsigned wl = __builtin_amdgcn_readfirstlane(e[0]), wh = __builtin_amdgcn_readfirstlane(e[1]), ol = __builtin_amdgcn_readfirstlane(e[2]), oh = __builtin_amdgcn_readfirstlane(e[3]);
    const int ldw = __builtin_amdgcn_readfirstlane(e[4]), K = __builtin_amdgcn_readfirstlane(e[5]), nvalid = __builtin_amdgcn_readfirstlane(e[6]), nblk = __builtin_amdgcn_readfirstlane(e[7]), it = idx - __builtin_amdgcn_readfirstlane(e[8]);
    const float* W = (const float*)(size_t)(((unsigned long long)wh << 32) | wl);
    const int kb = it / nblk, nb = it - kb * nblk, k0 = 64 * kb, n0 = 32 * nb;
    t.wt = (bf16_t*)(size_t)(((unsigned long long)oh << 32) | ol); t.K = K; t.k0 = k0; t.n0 = n0;
    const bool ok = n0 < nvalid;
#pragma unroll
    for (int i = 0; i < 8; ++i) { const int kk = 8 * i + (lane >> 3), nn = 4 * (lane & 7); v[i] = ok ? *(const pg8::f32x4*)(W + (size_t)(k0 + kk) * ldw + n0 + nn) : (pg8::f32x4){0.f, 0.f, 0.f, 0.f}; }
    return true;
}
__device__ __forceinline__ void trj_finish(const pg8::f32x4 (&v)[8], const TrCur& t, LDSP float* scr, int lane) {
#pragma unroll
    for (int i = 0; i < 8; ++i) { const int kk = 8 * i + (lane >> 3), nn = 4 * (lane & 7);
        scr[kk * 33 + nn] = v[i][0]; scr[kk * 33 + nn + 1] = v[i][1]; scr[kk * 33 + nn + 2] = v[i][2]; scr[kk * 33 + nn + 3] = v[i][3]; }
    asm volatile("s_waitcnt lgkmcnt(0)" ::: "memory");
    const int c = lane & 7;
#pragma unroll
    for (int j = 0; j < 4; ++j) { const int n = (lane >> 3) + 8 * j; const LDSP float* s = scr + (8 * c) * 33 + n;
        pg8::u32x4 o; o.x = pk2bf(s[0 * 33], s[1 * 33]); o.y = pk2bf(s[2 * 33], s[3 * 33]); o.z = pk2bf(s[4 * 33], s[5 * 33]); o.w = pk2bf(s[6 * 33], s[7 * 33]);
        *(pg8::u32x4*)(t.wt + (size_t)(t.n0 + n) * t.K + t.k0 + 8 * c) = o; }
    asm volatile("s_waitcnt lgkmcnt(0)" ::: "memory");
}
__device__ __forceinline__ void trj_run(LDSP const int* tab, int njobs, int total, LDSP float* scr, int gw, int ngw, int lane) {
    int j = 0; pg8::f32x4 va[8], vb[8]; TrCur ta, tb;
    int idx = gw;
    bool have = idx < total && trj_issue(tab, njobs, idx, j, va, ta, lane);
    while (have) {
        idx += ngw; const bool hb = idx < total && trj_issue(tab, njobs, idx, j, vb, tb, lane);
        trj_finish(va, ta, scr, lane);
        if (!hb) break;
        idx += ngw; have = idx < total && trj_issue(tab, njobs, idx, j, va, ta, lane);
        trj_finish(vb, tb, scr, lane);
    }
}
__device__ __forceinline__ pg8::f32x4 slab_sum(const float* __restrict__ slab, int ksplit, int m, int q, int lane) {
    using namespace cfg; const int rs = m - MP, pms = rs >> 8, row = rs & 255;
    const float* p = slab + ((size_t)((q * (MS / 256) + pms) * ksplit) * 256 + row) * 256 + 4 * lane;
    pg8::f32x4 s = {0.f, 0.f, 0.f, 0.f};
    for (int k = 0; k < ksplit; ++k) s = s + *(const pg8::f32x4*)(p + (size_t)k * 65536);
    return s;
}
__device__ __forceinline__ void norm_rows_bf16(float* __restrict__ x, const float* __restrict__ gain, bf16_t* xn, const float* __restrict__ slab, int ksplit, int gw, int ngw, int lane) {
    using namespace cfg;
    pg8::f32x4 gv[4];
#pragma unroll
    for (int j = 0; j < 4; ++j) gv[j] = *(const pg8::f32x4*)(gain + 4 * lane + 256 * j);
    for (int m = gw; m < MTOT; m += ngw) {
        float* xr = x + (size_t)m * D; pg8::f32x4 v[4]; float s = 0.f;
#pragma unroll
        for (int j = 0; j < 4; ++j) { v[j] = *(const pg8::f32x4*)(xr + 4 * lane + 256 * j);
            if (ksplit > 1 && m >= MP) { v[j] = v[j] + slab_sum(slab, ksplit, m, j, lane); *(pg8::f32x4*)(xr + 4 * lane + 256 * j) = v[j]; }
            s += (v[j][0] * v[j][0] + v[j][1] * v[j][1]) + (v[j][2] * v[j][2] + v[j][3] * v[j][3]); }
        const float rs = 1.0f / sqrtf(wave_sum64(s) * (1.0f / D) + NORM_EPS);
#pragma unroll
        for (int j = 0; j < 4; ++j) { pg8::u32x2 o; o.x = pk2bf(v[j][0] * rs * gv[j][0], v[j][1] * rs * gv[j][1]); o.y = pk2bf(v[j][2] * rs * gv[j][2], v[j][3] * rs * gv[j][3]);
            *(pg8::u32x2*)(xn + (size_t)m * D + 4 * lane + 256 * j) = o; }
    }
}

__device__ __forceinline__ void fold_sample_rows(float* __restrict__ x, const float* __restrict__ slab, int ksplit, int gw, int ngw, int lane) {
    using namespace cfg;
    for (int m = MP + gw; m < MTOT; m += ngw) {
#pragma unroll
        for (int j = 0; j < 4; ++j) { float* p = x + (size_t)m * D + 4 * lane + 256 * j; *(pg8::f32x4*)p = *(const pg8::f32x4*)p + slab_sum(slab, ksplit, m, j, lane); }
    }
}
struct FastMla {
    float* mh;
    bf16_t *qan, *cb, *kpb;
    bf16_t *qraw, *kvraw;
    bf16_t *qf, *knb, *aob, *vT, *qs;
    float *opart, *lpart;
    bf16_t *wint, *wuqt, *wukvt, *wot;
};
__device__ __forceinline__ void rope_cs(int pos, int i, float& cs, float& sn) {
    const float inv = exp2f(-(float)i * (13.287712379549449f / 16.0f));
    const float ang = (float)pos * inv, kq = rintf(ang * 0.15915494309189535f);
    float rr = fmaf(-kq, 6.28125f, ang); rr = fmaf(-kq, 1.9353071795864769e-3f, rr);
    cs = __cosf(rr); sn = __sinf(rr);
}
__device__ __forceinline__ float rope_inv(int i) { return exp2f(-(float)i * (13.287712379549449f / 16.0f)); }
__device__ __forceinline__ void rope_cs_inv(int pos, float inv, float& cs, float& sn) {
    const float ang = (float)pos * inv, kq = rintf(ang * 0.15915494309189535f);
    float rr = fmaf(-kq, 6.28125f, ang); rr = fmaf(-kq, 1.9353071795864769e-3f, rr);
    cs = __cosf(rr); sn = __sinf(rr);
}
__device__ __forceinline__ float bf2f(unsigned short b) { return __uint_as_float(((unsigned)b) << 16); }
__device__ __forceinline__ void mla_norm1_fast(const Ctx& c, const FastMla& fm, int j, int gw, int ngw, int lane) {
    using namespace cfg;
    const pg8::f32x4 gq0 = *(const pg8::f32x4*)(c.in[I_QNORM] + j * QL + 4 * lane), gq1 = *(const pg8::f32x4*)(c.in[I_QNORM] + j * QL + 4 * lane + 256), gc = *(const pg8::f32x4*)(c.in[I_KVNORM] + j * KVL + 4 * lane);
    const float gkr = lane < ROPE ? c.in[I_KRN][j * ROPE + lane] : 0.f;
    const float rinv1 = rope_inv(lane & 15);
    for (int m = gw; m < MTOT; m += ngw) {
        const float* h = fm.mh + (size_t)m * 1024;
        pg8::f32x4 qv[2]; float s = 0.f;
#pragma unroll
        for (int t = 0; t < 2; ++t) { qv[t] = *(const pg8::f32x4*)(h + 4 * lane + 256 * t); s += (qv[t][0] * qv[t][0] + qv[t][1] * qv[t][1]) + (qv[t][2] * qv[t][2] + qv[t][3] * qv[t][3]); }
        const float rq = 1.0f / sqrtf(wave_sum64(s) * (1.0f / QL) + NORM_EPS);
#pragma unroll
        for (int t = 0; t < 2; ++t) { const pg8::f32x4 g = t ? gq1 : gq0;
            pg8::u32x2 o; o.x = pk2bf(qv[t][0] * rq * g[0], qv[t][1] * rq * g[1]); o.y = pk2bf(qv[t][2] * rq * g[2], qv[t][3] * rq * g[3]);
            *(pg8::u32x2*)(fm.qan + (size_t)m * QL + 4 * lane + 256 * t) = o; }
        const pg8::f32x4 cv = *(const pg8::f32x4*)(h + QL + 4 * lane);
        const float rc = 1.0f / sqrtf(wave_sum64((cv[0] * cv[0] + cv[1] * cv[1]) + (cv[2] * cv[2] + cv[3] * cv[3])) * (1.0f / KVL) + NORM_EPS);
        const pg8::f32x4 cn = {cv[0] * rc * gc[0], cv[1] * rc * gc[1], cv[2] * rc * gc[2], cv[3] * rc * gc[3]};
        float* co = m < MP ? c.out + O_CKVP + ((size_t)j * MP + m) * KVL : c.out + O_CKVS + ((size_t)j * MS + (m - MP)) * KVL;
        *(pg8::f32x4*)(co + 4 * lane) = cn;
        { pg8::u32x2 o; o.x = pk2bf(cn[0], cn[1]); o.y = pk2bf(cn[2], cn[3]); *(pg8::u32x2*)(fm.cb + (size_t)m * KVL + 4 * lane) = o; }
        const float kv = lane < ROPE ? h[QL + KVL + lane] : 0.f;
        const float rk = 1.0f / sqrtf(wave_sum64(kv * kv) * (1.0f / ROPE) + NORM_EPS);
        const float kn = kv * rk * gkr;
        const float other = __shfl_xor(kn, 16);
        float cs, sn; rope_cs_inv(row_pos(m), rinv1, cs, sn);
        const float ro = lane < 16 ? kn * cs - other * sn : kn * cs + other * sn;
        if (lane < ROPE) {
            float* ko = m < MP ? c.out + O_KPEP + ((size_t)j * MP + m) * ROPE : c.out + O_KPES + ((size_t)j * MS + (m - MP)) * ROPE;
            ko[lane] = ro;
            fm.kpb[(size_t)m * ROPE + lane] = (bf16_t)(pk2bf(ro, 0.f) & 0xffffu);
        }
    }
}
__device__ __forceinline__ void mla_norm2_fast(const Ctx& c, const FastMla& fm, int j, int gw, int ngw, int lane) {
    using namespace cfg;
    const int hd = lane >> 2, qt = lane & 3;
    const float QSC = 0.10206207261596575f * 1.4426950408889634f;
    float gqn[16], gkn[16], gqr[8];
    { const float* pq = c.in[I_QNN] + j * NOPE + 16 * qt; const float* pk = c.in[I_KNN] + j * NOPE + 16 * qt; const float* pr = c.in[I_QRN] + j * ROPE + 8 * qt;
#pragma unroll
      for (int i4 = 0; i4 < 4; ++i4) { const pg8::f32x4 a = *(const pg8::f32x4*)(pq + 4 * i4), b = *(const pg8::f32x4*)(pk + 4 * i4);
#pragma unroll
          for (int e = 0; e < 4; ++e) { gqn[4 * i4 + e] = a[e]; gkn[4 * i4 + e] = b[e]; } }
#pragma unroll
      for (int i4 = 0; i4 < 2; ++i4) { const pg8::f32x4 a = *(const pg8::f32x4*)(pr + 4 * i4);
#pragma unroll
          for (int e = 0; e < 4; ++e) gqr[4 * i4 + e] = a[e]; } }
    float rinv[8];
#pragma unroll
    for (int i = 0; i < 8; ++i) rinv[i] = rope_inv((8 * qt + i) & 15);
    for (int m = gw; m < MTOT; m += ngw) {
        const bf16_t* qr = fm.qraw + (size_t)m * (MH * QD) + hd * QD;
        float v[16]; float s = 0.f;
        { const pg8::u32x4 a = *(const pg8::u32x4*)(qr + 16 * qt), b = *(const pg8::u32x4*)(qr + 16 * qt + 8); const unsigned w[8] = {a.x, a.y, a.z, a.w, b.x, b.y, b.z, b.w};
#pragma unroll
          for (int i = 0; i < 8; ++i) { v[2 * i] = __uint_as_float(w[i] << 16); v[2 * i + 1] = __uint_as_float(w[i] & 0xffff0000u); } }
#pragma unroll
        for (int i = 0; i < 16; ++i) s += v[i] * v[i];
        s += __shfl_xor(s, 1); s += __shfl_xor(s, 2);
        float rs = 1.0f / sqrtf(s * (1.0f / NOPE) + NORM_EPS);
        bf16_t* qo = fm.qf + (size_t)m * (MH * QD) + hd * QD;
        { unsigned w[8], w2[8];
#pragma unroll
          for (int i = 0; i < 8; ++i) { const float a = v[2 * i] * rs * gqn[2 * i], b = v[2 * i + 1] * rs * gqn[2 * i + 1];
              w[i] = pk2bf(a * QSC, b * QSC);
              w2[i] = pk2bf(a * QSC * gkn[2 * i], b * QSC * gkn[2 * i + 1]); }
          *(pg8::u32x4*)(qo + 16 * qt) = (pg8::u32x4){w[0], w[1], w[2], w[3]}; *(pg8::u32x4*)(qo + 16 * qt + 8) = (pg8::u32x4){w[4], w[5], w[6], w[7]};
          if (m >= MP) { bf16_t* q2 = fm.qs + ((size_t)(((m - MP) >> 3) * MH + hd) * 6 + qt) * 128 + ((m - MP) & 7) * 8;
              *(pg8::u32x4*)(q2) = (pg8::u32x4){w2[0], w2[1], w2[4], w2[5]}; *(pg8::u32x4*)(q2 + 64) = (pg8::u32x4){w2[2], w2[3], w2[6], w2[7]}; } }
        float r8[8]; s = 0.f;
        { const pg8::u32x4 a = *(const pg8::u32x4*)(qr + NOPE + 8 * qt); const unsigned w[4] = {a.x, a.y, a.z, a.w};
#pragma unroll
          for (int i = 0; i < 4; ++i) { r8[2 * i] = __uint_as_float(w[i] << 16); r8[2 * i + 1] = __uint_as_float(w[i] & 0xffff0000u); } }
#pragma unroll
        for (int i = 0; i < 8; ++i) s += r8[i] * r8[i];
        s += __shfl_xor(s, 1); s += __shfl_xor(s, 2);
        rs = 1.0f / sqrtf(s * (1.0f / ROPE) + NORM_EPS);
        { unsigned w[4]; float o8[8];
#pragma unroll
          for (int i = 0; i < 8; ++i) { const float mine = r8[i] * rs * gqr[i]; const float oth = __shfl_xor(mine, 2);
              float cs, sn; rope_cs_inv(row_pos(m), rinv[i], cs, sn);
              o8[i] = qt < 2 ? mine * cs - oth * sn : mine * cs + oth * sn; }
#pragma unroll
          for (int i = 0; i < 4; ++i) w[i] = pk2bf(o8[2 * i] * QSC, o8[2 * i + 1] * QSC);
          *(pg8::u32x4*)(qo + NOPE + 8 * qt) = (pg8::u32x4){w[0], w[1], w[2], w[3]};
          if (m >= MP) *(pg8::u32x4*)(fm.qs + ((size_t)(((m - MP) >> 3) * MH + hd) * 6 + 4 + (qt >> 1)) * 128 + (qt & 1) * 64 + ((m - MP) & 7) * 8) = (pg8::u32x4){w[0], w[1], w[2], w[3]}; }
        const bf16_t* kr = fm.kvraw + (size_t)m * 2048 + hd * NOPE; s = 0.f;
        { const pg8::u32x4 a = *(const pg8::u32x4*)(kr + 16 * qt), b = *(const pg8::u32x4*)(kr + 16 * qt + 8); const unsigned w[8] = {a.x, a.y, a.z, a.w, b.x, b.y, b.z, b.w};
#pragma unroll
          for (int i = 0; i < 8; ++i) { v[2 * i] = __uint_as_float(w[i] << 16); v[2 * i + 1] = __uint_as_float(w[i] & 0xffff0000u); } }
#pragma unroll
        for (int i = 0; i < 16; ++i) s += v[i] * v[i];
        s += __shfl_xor(s, 1); s += __shfl_xor(s, 2);
        rs = 1.0f / sqrtf(s * (1.0f / NOPE) + NORM_EPS);
        bf16_t* ko = fm.knb + (size_t)m * (MH * NOPE) + hd * NOPE;
        { unsigned w[8];
#pragma unroll
          for (int i = 0; i < 8; ++i) { const float a = v[2 * i] * rs * gkn[2 * i], b = v[2 * i + 1] * rs * gkn[2 * i + 1];
              w[i] = pk2bf(a, b); }
          *(pg8::u32x4*)(ko + 16 * qt) = (pg8::u32x4){w[0], w[1], w[2], w[3]}; *(pg8::u32x4*)(ko + 16 * qt + 8) = (pg8::u32x4){w[4], w[5], w[6], w[7]}; }
    }
}
__device__ __forceinline__ void cvt_f32_bf16(const float* __restrict__ s, bf16_t* d, size_t n, size_t gtid, size_t gsz) {
    for (size_t i = gtid * 4; i < n; i += gsz * 4) { const pg8::f32x4 v = *(const pg8::f32x4*)(s + i); pg8::u32x2 o; o.x = pk2bf(v[0], v[1]); o.y = pk2bf(v[2], v[3]); *(pg8::u32x2*)(d + i) = o; }
}
typedef float f32x16_t __attribute__((ext_vector_type(16)));
typedef pg8::bf16x8 bf16x8v;
constexpr int AT_KROW = 208, AT_VROW = 136, AT_KBUF = 64 * AT_KROW, AT_VBUF = 64 * AT_VROW, AT_LDS = 2 * AT_KBUF + 2 * AT_VBUF;
__device__ __forceinline__ void attn_prompt_fast(const bf16_t* __restrict__ qf, const bf16_t* __restrict__ knb, const bf16_t* __restrict__ kpb, const bf16_t* __restrict__ vT, bf16_t* aob, LDSP unsigned char* lds) {
    using namespace cfg;
    const int tid = (int)tid_now(), w = __builtin_amdgcn_readfirstlane(tid >> 6), lane = tid & 63, l31 = lane & 31, h5 = lane >> 5;
    for (int it = blockIdx.x; it < BATCH * MH * 4; it += gridDim.x) {
        const int bh = it >> 2, pr = it & 3, b = bh / MH, h = bh % MH;
        for (int half = 0; half < 2; ++half) {
            const int qb = half ? 7 - pr : pr, q0 = 256 * qb, nt = 4 * qb + 4;
            const int qg = q0 + 32 * w + l31;
            const size_t mrow = (size_t)b * SEQ + qg;
            bf16x8v qfr[6];
#pragma unroll
            for (int s = 0; s < 6; ++s) qfr[s] = *(const bf16x8v*)(qf + mrow * (MH * QD) + h * QD + 16 * s + 8 * h5);
            f32x16_t O[2];
#pragma unroll
            for (int db = 0; db < 2; ++db)
#pragma unroll
                for (int r = 0; r < 16; ++r) O[db][r] = 0.f;
            float mrun = -1e30f, lrun = 0.f;
            pg8::u32x4 rk, rp, rv;
            const int kkey = tid >> 3, kc8 = tid & 7, pkey = tid >> 2, pc4 = tid & 3;
#define AT_LOAD(t) do { const size_t mk = (size_t)b * SEQ + 64 * (t); \
                rk = *(const pg8::u32x4*)(knb + (mk + kkey) * (MH * NOPE) + h * NOPE + kc8 * 8); \
                if (tid < 256) rp = *(const pg8::u32x4*)(kpb + (mk + pkey) * ROPE + pc4 * 8); \
                rv = *(const pg8::u32x4*)(vT + (size_t)(h * VD + kkey) * MTOT + mk + kc8 * 8); } while (0)
#define AT_STORE(buf) do { LDSP unsigned char* kb_ = lds + (buf) * AT_KBUF; LDSP unsigned char* vb_ = lds + 2 * AT_KBUF + (buf) * AT_VBUF; \
                *(LDSP pg8::u32x4*)(kb_ + kkey * AT_KROW + kc8 * 16) = rk; \
                if (tid < 256) *(LDSP pg8::u32x4*)(kb_ + pkey * AT_KROW + 128 + pc4 * 16) = rp; \
                *(LDSP pg8::u32x2*)(vb_ + kkey * AT_VROW + kc8 * 16) = (pg8::u32x2){rv.x, rv.y}; *(LDSP pg8::u32x2*)(vb_ + kkey * AT_VROW + kc8 * 16 + 8) = (pg8::u32x2){rv.z, rv.w}; } while (0)
            AT_LOAD(0); AT_STORE(0);
            __syncthreads();
            for (int t = 0; t < nt; ++t) {
                if (t + 1 < nt) AT_LOAD(t + 1);
                if (64 * t <= q0 + 32 * w + 31) {
                    const LDSP unsigned char* kb_ = lds + (t & 1) * AT_KBUF; const LDSP unsigned char* vb_ = lds + 2 * AT_KBUF + (t & 1) * AT_VBUF;
                    f32x16_t S[2];
#pragma unroll
                    for (int kb = 0; kb < 2; ++kb)
#pragma unroll
                        for (int r = 0; r < 16; ++r) S[kb][r] = 0.f;
#pragma unroll
                    for (int s = 0; s < 6; ++s)
#pragma unroll
                        for (int kb = 0; kb < 2; ++kb) {
                            const bf16x8v a = *(const LDSP bf16x8v*)(kb_ + (32 * kb + l31) * AT_KROW + (16 * s + 8 * h5) * 2);
                            S[kb] = __builtin_amdgcn_mfma_f32_32x32x16_bf16(a, qfr[s], S[kb], 0, 0, 0);
                        }
                    if (64 * t + 63 > q0 + 32 * w) {
#pragma unroll
                        for (int kb = 0; kb < 2; ++kb)
#pragma unroll
                            for (int r = 0; r < 16; ++r) { const int key = 64 * t + 32 * kb + (r & 3) + 8 * (r >> 2) + 4 * h5; if (key > qg) S[kb][r] = -1e30f; }
                    }
                    float mt = -1e30f;
#pragma unroll
                    for (int kb = 0; kb < 2; ++kb)
#pragma unroll
                        for (int r = 0; r < 16; ++r) mt = fmaxf(mt, S[kb][r]);
                    mt = fmaxf(mt, __shfl_xor(mt, 32));
                    const float mnew = fmaxf(mrun, mt), alpha = __builtin_amdgcn_exp2f(mrun - mnew);
                    float ls = 0.f;
#pragma unroll
                    for (int kb = 0; kb < 2; ++kb)
#pragma unroll
                        for (int r = 0; r < 16; ++r) { const float p = __builtin_amdgcn_exp2f(S[kb][r] - mnew); S[kb][r] = p; ls += p; }
                    lrun = lrun * alpha + ls; mrun = mnew;
#pragma unroll
                    for (int db = 0; db < 2; ++db)
#pragma unroll
                        for (int r = 0; r < 16; ++r) O[db][r] *= alpha;
#pragma unroll
                    for (int kb = 0; kb < 2; ++kb)
#pragma unroll
                        for (int s = 0; s < 2; ++s) {
                            pg8::u32x4 pw; pw.x = pk2bf(S[kb][8 * s + 0], S[kb][8 * s + 1]); pw.y = pk2bf(S[kb][8 * s + 2], S[kb][8 * s + 3]); pw.z = pk2bf(S[kb][8 * s + 4], S[kb][8 * s + 5]); pw.w = pk2bf(S[kb][8 * s + 6], S[kb][8 * s + 7]);
                            const bf16x8v pf = __builtin_bit_cast(bf16x8v, pw);
#pragma unroll
                            for (int db = 0; db < 2; ++db) {
                                const LDSP unsigned char* vp = vb_ + (32 * db + l31) * AT_VROW + (32 * kb + 16 * s + 4 * h5) * 2;
                                const pg8::u32x2 v0 = *(const LDSP pg8::u32x2*)vp, v1 = *(const LDSP pg8::u32x2*)(vp + 16);
                                const bf16x8v a = __builtin_bit_cast(bf16x8v, (pg8::u32x4){v0.x, v0.y, v1.x, v1.y});
                                O[db] = __builtin_amdgcn_mfma_f32_32x32x16_bf16(a, pf, O[db], 0, 0, 0);
                            }
                        }
                }
                if (t + 1 < nt) AT_STORE((t + 1) & 1);
                __syncthreads();
            }
#undef AT_LOAD
#undef AT_STORE
            const float inv = 1.0f / (lrun + __shfl_xor(lrun, 32));
            bf16_t* orow = aob + mrow * (MH * VD) + h * VD;
#pragma unroll
            for (int db = 0; db < 2; ++db)
#pragma unroll
                for (int g = 0; g < 4; ++g) { pg8::u32x2 o; o.x = pk2bf(O[db][4 * g] * inv, O[db][4 * g + 1] * inv); o.y = pk2bf(O[db][4 * g + 2] * inv, O[db][4 * g + 3] * inv);
                    *(pg8::u32x2*)(orow + 32 * db + 8 * g + 4 * h5) = o; }
        }
    }
}
constexpr int SD_CROW = 528, SD_WROW = 528, SD_PROW = 272;
constexpr int SD_CIMG = 0, SD_CIMG_SZ = 128 * SD_CROW;
constexpr int SD_WBUF = SD_CIMG + SD_CIMG_SZ, SD_WBUF_SZ = 32 * 1040;
constexpr int SD_XCH = SD_WBUF + 2 * SD_WBUF_SZ, SD_XCH_SZ = 4 * 5 * 64 * 4;
constexpr int SD_PIMG = SD_XCH + 2 * SD_XCH_SZ, SD_PIMG_SZ = 32 * SD_PROW;
constexpr int SD_END = SD_PIMG + 2 * SD_PIMG_SZ;
typedef short s16x4 __attribute__((ext_vector_type(4)));
#define MFMA32(a, b, c) __builtin_amdgcn_mfma_f32_32x32x16_bf16(a, b, c, 0, 0, 0)

__device__ __forceinline__ float mla_b2_bound(const Ctx& c, int j, int lane) {
    using namespace cfg;
    float gq = fabsf(c.in[I_QNN][j * NOPE + lane]), gk = fabsf(c.in[I_KNN][j * NOPE + lane]), gqr = fabsf(c.in[I_QRN][j * ROPE + (lane & 31)]), gkr = fabsf(c.in[I_KRN][j * ROPE + (lane & 31)]);
#pragma unroll
    for (int o = 1; o < 64; o <<= 1) { gq = fmaxf(gq, __shfl_xor(gq, o)); gk = fmaxf(gk, __shfl_xor(gk, o)); gqr = fmaxf(gqr, __shfl_xor(gqr, o)); gkr = fmaxf(gkr, __shfl_xor(gkr, o)); }
    return (64.f * gq * gk + 32.f * gqr * gkr) * (0.10206207261596575f * 1.4426950408889634f);
}

__device__ __forceinline__ void sd_pv_core(const int G, f32x16_t& Og, f32x16_t& Lacc, LDSP unsigned char* lds, int w, int lane, int l31, int h5) {
    asm volatile("" : "+v"(lane)); l31 = lane & 31; h5 = lane >> 5;
    const LDSP unsigned char* pimg = lds + SD_PIMG + (G & 1) * SD_PIMG_SZ;
    const unsigned onesw = (l31 == G) ? 0x3F803F80u : 0u;
    const bf16x8v onesv = __builtin_bit_cast(bf16x8v, (pg8::u32x4){onesw, onesw, onesw, onesw});
#pragma unroll
    for (int sp = 0; sp < 8; ++sp) {
        const bf16x8v a = *(const LDSP bf16x8v*)(pimg + l31 * SD_PROW + (16 * sp + 8 * h5) * 2);
        const int key0 = 16 * sp + 8 * h5 + ((lane & 15) >> 2), col = 32 * w + 16 * ((lane >> 4) & 1) + 4 * (lane & 3);
        const s16x4 t0 = __builtin_amdgcn_ds_read_tr16_b64_v4i16((LDSP s16x4*)(lds + SD_CIMG + key0 * SD_CROW + col * 2));
        const s16x4 t1 = __builtin_amdgcn_ds_read_tr16_b64_v4i16((LDSP s16x4*)(lds + SD_CIMG + (key0 + 4) * SD_CROW + col * 2));
        const bf16x8v b = (bf16x8v){t0[0], t0[1], t0[2], t0[3], t1[0], t1[1], t1[2], t1[3]};
        Og = MFMA32(a, b, Og);
        if (sp == w) Lacc = MFMA32(a, onesv, Lacc);
        if (sp & 1) __builtin_amdgcn_sched_barrier(0);
    }
}

__device__ __forceinline__ void sd_pv(const int G, f32x16_t& Og, f32x16_t& Lacc, LDSP unsigned char* lds, int w, int lane, int l31, int h5) {
    sd_pv_core(G, Og, Lacc, lds, w, lane, l31, h5);
#if defined(PROBE_DUP) && (PROBE_DUP & (1 << 21))
    f32x16_t D0, D1;
#pragma unroll
    for (int r = 0; r < 16; ++r) { D0[r] = 0.f; D1[r] = 0.f; }
    sd_pv_core(G, D0, D1, lds, w, lane, l31, h5); asm volatile("" :: "v"(D0), "v"(D1));
#endif
}
__device__ __forceinline__ void sd_glds16(const void* gsrc, unsigned lds_dst) {
    unsigned keep;
    asm volatile("s_mov_b32 %0, m0\n\ts_mov_b32 m0, %2\n\ts_nop 0\n\tglobal_load_lds_dwordx4 %1, off\n\ts_mov_b32 m0, %0" : "=&s"(keep) : "v"(gsrc), "s"(lds_dst) : "memory");
}
#define SD_WLOAD(h, buf) do { if (w >= 4) { const char* wsrc_ = (const char*)(fm.wukvt + (size_t)(h) * NOPE * KVL); int ln_ = lane; asm volatile("" : "+v"(ln_)); \
        const unsigned ldsb_ = __builtin_amdgcn_readfirstlane((unsigned)(size_t)(lds + SD_WBUF + (buf) * SD_WBUF_SZ)) + (unsigned)(8 * (w - 4)) * 1040u; \
        _Pragma("unroll") for (int k = 0; k < 8; ++k) { \
        const unsigned voff_ = (unsigned)(((8 * (w - 4) + k) + 32 * (ln_ >> 5)) * KVL + (ln_ & 31) * 8) * 2u; \
        sd_glds16(wsrc_ + voff_, ldsb_ + (unsigned)k * 1040u); } } } while (0)
template <int G, bool DOPV = true>
__device__ __forceinline__ void sd_group(const FastMla& fm, const bf16_t* __restrict__ qs, const int s, LDSP unsigned char* lds, const int w, const int lane, const int l31_, const int h5_, const int kb, const int dh, const int rot,
                                         const bf16x8v (&cfr)[16], const bf16x8v (&kpfr)[2], pg8::u32x4 (&wr)[4], f32x16_t (&O)[4], f32x16_t& Lacc, const float B2) {
    using namespace cfg;
        _Pragma("unroll 1") for (int hh = 0; hh < 4; ++hh) {
            const int h = (4 * G + hh + rot) & (MH - 1);
            int lane_ = lane; asm volatile("" : "+v"(lane_)); const int l31 = lane_ & 31, h5 = lane_ >> 5;
            { LDSP unsigned char* wdst = lds + SD_WBUF + ((h + 1) & 1) * SD_WBUF_SZ + (2 * w + h5) * 1040 + l31 * 16;
              *(LDSP pg8::u32x4*)(wdst) = wr[0]; *(LDSP pg8::u32x4*)(wdst + 16640) = wr[1]; *(LDSP pg8::u32x4*)(wdst + 512) = wr[2]; *(LDSP pg8::u32x4*)(wdst + 17152) = wr[3]; }
            const char* qb = (const char*)qs + (size_t)(s * MH + h) * 1536;
            const unsigned zoff = (unsigned)((DB * MH - (s * MH + h)) * 1536);
            const unsigned qlo = l31 < 8 ? (unsigned)(h5 * 128 + l31 * 16) : zoff;
            bf16x8v qn0 = (bf16x8v){0, 0, 0, 0, 0, 0, 0, 0}, qn1 = qn0, qp0 = qn0, qp1 = qn0;
            if (l31 < 8) {
                qn0 = *(const bf16x8v*)(qb + dh * 512 + qlo); qn1 = *(const bf16x8v*)(qb + dh * 512 + 256 + qlo);
                if (dh == 0) { qp0 = *(const bf16x8v*)(qb + 1024 + qlo); qp1 = *(const bf16x8v*)(qb + 1280 + qlo); } }
            { const char* wsrc = (const char*)(fm.wukvt + (size_t)((h + 2) & (MH - 1)) * NOPE * KVL) + (unsigned)(64 * w + lane_) * 16u;
#pragma unroll
              for (int k = 0; k < 4; ++k) wr[k] = *(const pg8::u32x4*)(wsrc + k * 8192); }
            f32x16_t KN;
#pragma unroll
            for (int r = 0; r < 16; ++r) KN[r] = 0.f;
            { const LDSP unsigned char* wb = lds + SD_WBUF + (h & 1) * SD_WBUF_SZ + l31 * 1040 + dh * 512 + h5 * 16;
#pragma unroll
              for (int s_ = 0; s_ < 16; ++s_) { const bf16x8v a = *(const LDSP bf16x8v*)(wb + 32 * s_); KN = MFMA32(a, cfr[s_], KN); if ((s_ & 3) == 3) __builtin_amdgcn_sched_barrier(0); } }
#if defined(PROBE_DUP) && (PROBE_DUP & (1 << 19))
            { const LDSP unsigned char* wb = lds + SD_WBUF + (h & 1) * SD_WBUF_SZ + l31 * 1040 + dh * 512 + h5 * 16;
#pragma unroll
              for (int s_ = 0; s_ < 16; ++s_) { const bf16x8v a = *(const LDSP bf16x8v*)(wb + 32 * s_); KN = MFMA32(a, cfr[s_], KN); if ((s_ & 3) == 3) __builtin_amdgcn_sched_barrier(0); }
#pragma unroll
              for (int r = 0; r < 16; ++r) KN[r] *= 0.5f; }
#endif
#if defined(PROBE_DUP) && (PROBE_DUP & (1 << 23))
            _Pragma("unroll 1") for (int rep_ = 0; rep_ < 2; ++rep_) {
            asm volatile("" : "+v"(KN));
#else
            {
#endif
            float ssq = 0.f;
#pragma unroll
            for (int r = 0; r < 16; ++r) ssq += KN[r] * KN[r];
            ssq += __shfl_xor(ssq, 32);
            {
            f32x16_t S;
#pragma unroll
            for (int r = 0; r < 16; ++r) S[r] = 0.f;
#pragma unroll
            for (int s_ = 0; s_ < 2; ++s_) { const bf16x8v kf = __builtin_bit_cast(bf16x8v, (pg8::u32x4){pk2bf(KN[8 * s_], KN[8 * s_ + 1]), pk2bf(KN[8 * s_ + 2], KN[8 * s_ + 3]), pk2bf(KN[8 * s_ + 4], KN[8 * s_ + 5]), pk2bf(KN[8 * s_ + 6], KN[8 * s_ + 7])});
                S = MFMA32(s_ == 0 ? qn0 : qn1, kf, S); }
            LDSP float* xch = (LDSP float*)(lds + SD_XCH + (h & 1) * SD_XCH_SZ) + kb * 320;
            if (dh == 1) { xch[lane_] = S[0]; xch[64 + lane_] = S[1]; xch[128 + lane_] = S[2]; xch[192 + lane_] = S[3]; xch[256 + lane_] = ssq; }
            asm volatile("s_waitcnt lgkmcnt(0)" ::: "memory");
            __builtin_amdgcn_s_barrier();
            asm volatile("" ::: "memory");
            if (dh == 0) {
                const float rstd = __builtin_amdgcn_rsqf((ssq + xch[256 + lane_]) * (1.0f / NOPE) + NORM_EPS);
                f32x16_t T;
#pragma unroll
                for (int r = 0; r < 16; ++r) T[r] = 0.f;
                T[0] = (S[0] + xch[lane_]) * rstd; T[1] = (S[1] + xch[64 + lane_]) * rstd; T[2] = (S[2] + xch[128 + lane_]) * rstd; T[3] = (S[3] + xch[192 + lane_]) * rstd;
                T = MFMA32(qp0, kpfr[0], T); T = MFMA32(qp1, kpfr[1], T);
                LDSP bf16_t* prow = (LDSP bf16_t*)(lds + SD_PIMG + (G & 1) * SD_PIMG_SZ + (hh * 8 + 4 * h5) * SD_PROW) + 32 * kb + l31;
#pragma unroll
                for (int q = 0; q < 4; ++q) prow[q * (SD_PROW / 2)] = (bf16_t)(pk2bf(exp2f(T[q] - B2), 0.f) & 0xffffu);
            }
            }
            }
        }
        if (G > 0 && DOPV) sd_pv(G > 0 ? G - 1 : 0, O[G > 0 ? G - 1 : 0], Lacc, lds, w, lane, l31_, h5_);
}

__device__ __forceinline__ void mla_sample_decode(const Ctx& c, const FastMla& fm, const bf16_t* __restrict__ qs, float* opart, float* lpart, int j, LDSP unsigned char* lds) {
    using namespace cfg;
    const int tid = (int)tid_now(), tid_ = tid, w = __builtin_amdgcn_readfirstlane(tid >> 6), lane = tid & 63, l31 = lane & 31, h5 = lane >> 5, kb = w & 3, dh = w >> 2;
    const float* ckv = c.in[I_CKV] + (size_t)j * NPOOL * PAGE * KVL; const float* kpe = c.in[I_KPE] + (size_t)j * NPOOL * PAGE * ROPE;
    const float B2 = __builtin_bit_cast(float, __builtin_amdgcn_readfirstlane(__builtin_bit_cast(int, mla_b2_bound(c, j, lane))));
    for (int it = blockIdx.x; it < DB * 2; it += gridDim.x) {
        const int s = it >> 1, hf = it & 1, rot = 2 * ((blockIdx.x >> 3) & 7);
        f32x16_t O[4], Lacc;
#pragma unroll
        for (int r = 0; r < 16; ++r) { O[0][r] = 0.f; O[1][r] = 0.f; O[2][r] = 0.f; O[3][r] = 0.f; Lacc[r] = 0.f; }
        pg8::u32x4 wr[4];
        __syncthreads();
        {
            int t_ = tid_; asm volatile("" : "+v"(t_));
            const char* wsrc = (const char*)(fm.wukvt + (size_t)rot * NOPE * KVL); const unsigned vo = (unsigned)t_ * 16u; LDSP unsigned char* wdst = lds + SD_WBUF + (t_ >> 5) * 1040 + (t_ & 31) * 16;
            pg8::u32x4 t0 = *(const pg8::u32x4*)(wsrc + vo), t1 = *(const pg8::u32x4*)(wsrc + 8192 + vo), t2 = *(const pg8::u32x4*)(wsrc + 16384 + vo), t3 = *(const pg8::u32x4*)(wsrc + 24576 + vo);
            *(LDSP pg8::u32x4*)(wdst) = t0; *(LDSP pg8::u32x4*)(wdst + 16640) = t1; *(LDSP pg8::u32x4*)(wdst + 512) = t2; *(LDSP pg8::u32x4*)(wdst + 17152) = t3;
#pragma unroll
            for (int k = 0; k < 4; ++k) wr[k] = *(const pg8::u32x4*)(wsrc + NOPE * KVL * 2 + k * 8192 + vo);
        }
        for (int pi = 0; pi < NPAGES / 2; ++pi) {
            const int pg = __builtin_amdgcn_readfirstlane(c.page_table[s * NPAGES + hf * (NPAGES / 2) + pi]);
            __syncthreads();
            { const char* src = (const char*)(ckv + (size_t)pg * PAGE * KVL); int tid = tid_; asm volatile("" : "+v"(tid));
              pg8::f32x4 v[16];
#pragma unroll
              for (int k = 0; k < 16; ++k) v[k] = __builtin_nontemporal_load((const pg8::f32x4*)(src + (size_t)k * 8192 + (unsigned)tid * 16u));
#pragma unroll
              for (int k = 0; k < 16; ++k) { pg8::u32x2 o; o.x = pk2bf(v[k][0], v[k][1]); o.y = pk2bf(v[k][2], v[k][3]);
                  *(LDSP pg8::u32x2*)(lds + SD_CIMG + ((tid >> 6) + 8 * k) * SD_CROW + (tid & 63) * 8) = o; } }
#if defined(PROBE_DUP) && (PROBE_DUP & (1 << 20))
            { const char* src = (const char*)(ckv + (size_t)pg * PAGE * KVL); int tid = tid_; asm volatile("" : "+v"(tid));
              pg8::f32x4 v[16];
#pragma unroll
              for (int k = 0; k < 16; ++k) v[k] = *(const pg8::f32x4*)(src + (size_t)k * 8192 + (unsigned)tid * 16u);
#pragma unroll
              for (int k = 0; k < 16; ++k) { pg8::u32x2 o; o.x = pk2bf(v[k][0], v[k][1]); o.y = pk2bf(v[k][2], v[k][3]);
                  *(LDSP pg8::u32x2*)(lds + SD_CIMG + ((tid >> 6) + 8 * k) * SD_CROW + (tid & 63) * 8) = o; } }
#endif
            bf16x8v kpfr[2];
            if (dh == 0) {
#pragma unroll
                for (int s_ = 0; s_ < 2; ++s_) { const float* kp = kpe + ((size_t)pg * PAGE + 32 * kb + l31) * ROPE + 16 * s_ + 8 * h5; const pg8::f32x4 a = *(const pg8::f32x4*)kp, b = *(const pg8::f32x4*)(kp + 4);
                    kpfr[s_] = __builtin_bit_cast(bf16x8v, (pg8::u32x4){pk2bf(a[0], a[1]), pk2bf(a[2], a[3]), pk2bf(b[0], b[1]), pk2bf(b[2], b[3])}); }
            }
            asm volatile("s_waitcnt vmcnt(0)" ::: "memory");
            __syncthreads();
            bf16x8v cfr[16];
#pragma unroll
            for (int s_ = 0; s_ < 16; ++s_) cfr[s_] = *(const LDSP bf16x8v*)(lds + SD_CIMG + (32 * kb + l31) * SD_CROW + (16 * s_ + 8 * h5) * 2);
            sd_group<0>(fm, qs, s, lds, w, lane, l31, h5, kb, dh, rot, cfr, kpfr, wr, O, Lacc, B2);
            sd_group<1>(fm, qs, s, lds, w, lane, l31, h5, kb, dh, rot, cfr, kpfr, wr, O, Lacc, B2);
            sd_group<2>(fm, qs, s, lds, w, lane, l31, h5, kb, dh, rot, cfr, kpfr, wr, O, Lacc, B2);
            sd_group<3>(fm, qs, s, lds, w, lane, l31, h5, kb, dh, rot, cfr, kpfr, wr, O, Lacc, B2);
#if defined(PROBE_DUP) && (PROBE_DUP & (1 << 29))
            __syncthreads();
            sd_group<0, false>(fm, qs, s, lds, w, lane, l31, h5, kb, dh, rot, cfr, kpfr, wr, O, Lacc, B2);
            sd_group<1, false>(fm, qs, s, lds, w, lane, l31, h5, kb, dh, rot, cfr, kpfr, wr, O, Lacc, B2);
            sd_group<2, false>(fm, qs, s, lds, w, lane, l31, h5, kb, dh, rot, cfr, kpfr, wr, O, Lacc, B2);
            sd_group<3, false>(fm, qs, s, lds, w, lane, l31, h5, kb, dh, rot, cfr, kpfr, wr, O, Lacc, B2);
#endif
            __syncthreads();
            sd_pv(3, O[3], Lacc, lds, w, lane, l31, h5);
        }
        {float* op = opart + (size_t)it * (MH * DS) * KVL; int lo_ = lane; asm volatile("" : "+v"(lo_)); const int l31 = lo_ & 31, h5 = lo_ >> 5;
#pragma unroll
        for (int g = 0; g < 4; ++g)
#pragma unroll
            for (int r = 0; r < 16; ++r) op[(size_t)((((4 * g + (r >> 2) + rot) & (MH - 1)) << 3) + (r & 3) + 4 * h5) * KVL + 32 * w + l31] = O[g][r];
        __syncthreads();
        LDSP float* ltab = (LDSP float*)(lds + SD_XCH);
        if (l31 < 4) {
#pragma unroll
            for (int r = 0; r < 16; ++r) ltab[w * 128 + l31 * 32 + (r & 3) + 8 * (r >> 2) + 4 * h5] = Lacc[r];
        }
        __syncthreads();
        { const int t2 = (int)tid_now();
        if (t2 < 128) { float a = 0.f;
#pragma unroll
            for (int ww = 0; ww < 8; ++ww) a += ltab[ww * 128 + t2];
            lpart[(size_t)it * 128 + ((((t2 >> 3) + rot) & (MH - 1)) << 3) + (t2 & 7)] = a; } }
        }
    }
}

__device__ __forceinline__ void mla_sample_combine(const Ctx& c, const FastMla& fm, const float* __restrict__ opart, const float* __restrict__ lpart, int j, LDSP unsigned char* lds) {
    using namespace cfg;
    const int tid = (int)tid_now(), w = tid >> 6, lane = tid & 63, gw = blockIdx.x * 8 + w, ngw = gridDim.x * 8;
    const float B2 = mla_b2_bound(c, j, lane);
    LDSP float* ol = (LDSP float*)(lds + w * 8704); LDSP float* ptab = ol + 8 * KVL; LDSP float* lt = ptab + 64;
    const float* wuv = c.in[I_WUV] + (size_t)j * KVL * MH * VD;
    for (int item = gw; item < DB * MH; item += ngw) {
        const int s = item / MH, h = item % MH, q = lane >> 3, jn = lane & 7;
        const size_t rq = (size_t)MP + s * DS + q, rk = (size_t)MP + s * DS + jn;
        const bf16_t* qv = fm.qf + rq * (MH * QD) + h * QD; const bf16_t* kn = fm.knb + rk * (MH * NOPE) + h * NOPE; const bf16_t* kp = fm.kpb + rk * ROPE;
        const float* wp = wuv + (size_t)h * VD + lane;
        float wa[16];
#pragma unroll
        for (int i = 0; i < 16; ++i) wa[i] = wp[(size_t)i * (MH * VD)];
        float cn[DS][4];
#pragma unroll
        for (int jj = 0; jj < DS; ++jj)
#pragma unroll
            for (int k = 0; k < 4; ++k) cn[jj][k] = bf2f(fm.cb[((size_t)MP + s * DS + jj) * KVL + lane + 64 * k]);
        float sc = 0.f;
#pragma unroll
        for (int d8 = 0; d8 < QD / 8; ++d8) { const pg8::u32x4 a = *(const pg8::u32x4*)(qv + 8 * d8), b = d8 < NOPE / 8 ? *(const pg8::u32x4*)(kn + 8 * d8) : *(const pg8::u32x4*)(kp + 8 * (d8 - NOPE / 8));
            const unsigned aw[4] = {a.x, a.y, a.z, a.w}, bw[4] = {b.x, b.y, b.z, b.w};
#pragma unroll
            for (int e = 0; e < 4; ++e) sc += __uint_as_float(aw[e] << 16) * __uint_as_float(bw[e] << 16) + __uint_as_float(aw[e] & 0xffff0000u) * __uint_as_float(bw[e] & 0xffff0000u); }
        const float p = jn <= q ? exp2f(sc - B2) : 0.f;
        float ls = p; ls += __shfl_xor(ls, 1); ls += __shfl_xor(ls, 2); ls += __shfl_xor(ls, 4);
        ptab[lane] = p;
        if (jn == 0) lt[q] = ls + lpart[(size_t)(2 * s) * 128 + h * DS + q] + lpart[(size_t)(2 * s + 1) * 128 + h * DS + q];
        asm volatile("s_waitcnt lgkmcnt(0)" ::: "memory");
#pragma unroll
        for (int qq = 0; qq < DS; ++qq)
#pragma unroll
            for (int k = 0; k < 4; ++k) { const int r = lane + 64 * k;
                float a = opart[((size_t)(2 * s) * 128 + h * DS + qq) * KVL + r] + opart[((size_t)(2 * s + 1) * 128 + h * DS + qq) * KVL + r];
#pragma unroll
                for (int jj = 0; jj < DS; ++jj) a += ptab[qq * 8 + jj] * cn[jj][k];
                ol[qq * KVL + r] = a; }
        asm volatile("s_waitcnt lgkmcnt(0)" ::: "memory");
        float acc[DS];
#pragma unroll
        for (int qq = 0; qq < DS; ++qq) acc[qq] = 0.f;
        float wb[16];
        for (int r0 = 0; r0 < KVL; r0 += 32) {
#pragma unroll
            for (int i = 0; i < 16; ++i) wb[i] = wp[(size_t)(r0 + 16 + i) * (MH * VD)];
#pragma unroll
            for (int i4 = 0; i4 < 4; ++i4)
#pragma unroll
                for (int qq = 0; qq < DS; ++qq) { const pg8::f32x4 o4 = *(const LDSP pg8::f32x4*)(ol + qq * KVL + r0 + 4 * i4);
                    acc[qq] += o4[0] * wa[4 * i4] + o4[1] * wa[4 * i4 + 1] + o4[2] * wa[4 * i4 + 2] + o4[3] * wa[4 * i4 + 3]; }
            if (r0 + 32 < KVL) {
#pragma unroll
                for (int i = 0; i < 16; ++i) wa[i] = wp[(size_t)(r0 + 32 + i) * (MH * VD)]; }
#pragma unroll
            for (int i4 = 0; i4 < 4; ++i4)
#pragma unroll
                for (int qq = 0; qq < DS; ++qq) { const pg8::f32x4 o4 = *(const LDSP pg8::f32x4*)(ol + qq * KVL + r0 + 16 + 4 * i4);
                    acc[qq] += o4[0] * wb[4 * i4] + o4[1] * wb[4 * i4 + 1] + o4[2] * wb[4 * i4 + 2] + o4[3] * wb[4 * i4 + 3]; }
        }
#pragma unroll
        for (int qq = 0; qq < DS; ++qq) fm.aob[((size_t)MP + s * DS + qq) * (MH * VD) + h * VD + lane] = (bf16_t)(pk2bf(acc[qq] / lt[qq], 0.f) & 0xffffu);
        asm volatile("s_waitcnt lgkmcnt(0)" ::: "memory");
    }
}

struct FastRw {
    bf16_t* xm;
    bf16_t* rkv;
    bf16_t* hb;
    bf16_t* lu;
    float* vf;
    float* ops;
    bf16_t* yo;
    bf16_t *wrkvt, *lorat, *wot;
};
constexpr int RW_REC = 464;
constexpr int RW_CH = 32;
constexpr int RW_BUF = RW_CH * RW_REC * 4;
struct RwSel { __device__ static __forceinline__ int sel(int pn) { return pn < 12 ? (pn >> 2) : (pn == 15 ? 2 : pn - 9); } };

__device__ __forceinline__ void rw_mix_fast(const Ctx& c, const FastRw& fr, int l, int gw, int ngw, int lane, const float* xprompt = nullptr) {
    using namespace cfg; const int j = l / 3;
    const float* gain = c.in[I_NMIX] + l * D;
    pg8::f32x4 gv[4], muv[6][4];
#pragma unroll
    for (int q = 0; q < 4; ++q) { gv[q] = *(const pg8::f32x4*)(gain + 4 * lane + 256 * q);
#pragma unroll
        for (int p = 0; p < 6; ++p) muv[p][q] = *(const pg8::f32x4*)(c.in[I_MU] + ((size_t)j * 6 + p) * D + 4 * lane + 256 * q); }
    for (int m = gw; m < MTOT; m += ngw) {
        const int t = row_t(m), sq = row_seq(m);
        const float* xsrc = (xprompt && m < MP) ? xprompt : c.x;
        pg8::f32x4 xc[4], xp[4]; float s = 0.f, sp = 0.f;
#pragma unroll
        for (int q = 0; q < 4; ++q) { xc[q] = *(const pg8::f32x4*)(xsrc + (size_t)m * D + 4 * lane + 256 * q);
            s += (xc[q][0] * xc[q][0] + xc[q][1] * xc[q][1]) + (xc[q][2] * xc[q][2] + xc[q][3] * xc[q][3]); }
        if (t > 0) {
#pragma unroll
            for (int q = 0; q < 4; ++q) { xp[q] = *(const pg8::f32x4*)(xsrc + (size_t)(m - 1) * D + 4 * lane + 256 * q); sp += (xp[q][0] * xp[q][0] + xp[q][1] * xp[q][1]) + (xp[q][2] * xp[q][2] + xp[q][3] * xp[q][3]); }
        }
        const float rs = 1.0f / sqrtf(wave_sum64(s) * (1.0f / D) + NORM_EPS), rsp = 1.0f / sqrtf(wave_sum64(sp) * (1.0f / D) + NORM_EPS);
#pragma unroll
        for (int q = 0; q < 4; ++q) {
#pragma unroll
            for (int e = 0; e < 4; ++e) xc[q][e] = xc[q][e] * rs * gv[q][e];
            if (t > 0) {
#pragma unroll
                for (int e = 0; e < 4; ++e) xp[q][e] = xp[q][e] * rsp * gv[q][e];
            } else if (sq < BATCH) xp[q] = (pg8::f32x4){0.f, 0.f, 0.f, 0.f};
            else xp[q] = *(const pg8::f32x4*)(c.in[I_SHIFT] + ((size_t)j * DB + (sq - BATCH)) * D + 4 * lane + 256 * q);
        }
        if (t == seq_len(sq) - 1) {
            float* so = sq < BATCH ? c.out + O_SHP + ((size_t)j * BATCH + sq) * D : c.out + O_SHS + ((size_t)j * DB + (sq - BATCH)) * D;
#pragma unroll
            for (int q = 0; q < 4; ++q) *(pg8::f32x4*)(so + 4 * lane + 256 * q) = xc[q];
        }
#pragma unroll
        for (int p = 0; p < 6; ++p)
#pragma unroll
            for (int q = 0; q < 4; ++q) { const pg8::f32x4 mu = muv[p][q];
                pg8::u32x2 o; o.x = pk2bf(xc[q][0] + (xp[q][0] - xc[q][0]) * mu[0], xc[q][1] + (xp[q][1] - xc[q][1]) * mu[1]); o.y = pk2bf(xc[q][2] + (xp[q][2] - xc[q][2]) * mu[2], xc[q][3] + (xp[q][3] - xc[q][3]) * mu[3]);
                *(pg8::u32x2*)(fr.xm + ((size_t)p * MTOT + m) * D + 4 * lane + 256 * q) = o; }
        if (lane < 32) *(unsigned*)(fr.hb + (size_t)m * 384 + 320 + 2 * lane) = 0u;
    }
}
struct EpiRwkv {
    static constexpr bool PERM = true;
    bf16_t* rkv; bf16_t* hb;
    __device__ __forceinline__ void operator()(const pg8::f32x4 (&acc)[2][2][4][2], const pg8::Unit& u, int wr, int wc, int fr, int fq) const {
        using namespace pg8;
        const int row0 = u.pm * BM + wr * 64 + fr, cl0 = wc * 32 + 8 * fq;
        const int pn = u.pn;
        bf16_t* base; int ldc, coff, nvalid, act = 0;
        if (pn < 12) { base = rkv; ldc = 3072; coff = pn * 256; nvalid = 256; }
        else { base = hb; ldc = 384; if (pn == 12) { coff = 0; nvalid = 64; act = 1; } else if (pn == 13) { coff = 64; nvalid = 64; } else if (pn == 14) { coff = 128; nvalid = 160; act = 2; } else { coff = 288; nvalid = 32; } }
#pragma unroll
        for (int ai = 0; ai < 2; ++ai)
#pragma unroll
            for (int m = 0; m < 4; ++m) { bf16_t* rowp = base + (size_t)(row0 + ai * HALF + m * 16) * ldc + coff;
#pragma unroll
                for (int bj = 0; bj < 2; ++bj) { const int cl = cl0 + bj * HALF; if (cl >= nvalid) continue;
                    f32x4 v0 = acc[ai][bj][m][0], v1 = acc[ai][bj][m][1];
                    if (act == 1) {
#pragma unroll
                        for (int e = 0; e < 4; ++e) { v0[e] = 1.0f - 2.0f * __builtin_amdgcn_rcpf(1.0f + __expf(2.0f * v0[e])); v1[e] = 1.0f - 2.0f * __builtin_amdgcn_rcpf(1.0f + __expf(2.0f * v1[e])); } }
                    else if (act == 2) {
#pragma unroll
                        for (int e = 0; e < 4; ++e) { v0[e] = __builtin_amdgcn_rcpf(1.0f + __expf(-v0[e])); v1[e] = __builtin_amdgcn_rcpf(1.0f + __expf(-v1[e])); } }
                    u32x4 w; w.x = cvt_pk_bf16(v0[0], v0[1]); w.y = cvt_pk_bf16(v0[2], v0[3]); w.z = cvt_pk_bf16(v1[0], v1[1]); w.w = cvt_pk_bf16(v1[2], v1[3]);
                    *(u32x4*)(rowp + cl) = w; } }
    }
};
__device__ __forceinline__ void rw_build_lorat(const Ctx& c, bf16_t* lorat, int j, size_t gtid, size_t gsz) {
    using namespace cfg;
    for (size_t i = gtid; i < (size_t)4096 * 384; i += gsz) {
        const int n = (int)(i / 384), k = (int)(i % 384), grp = n >> 10, ch = n & 1023; float v = 0.f;
        if (grp == 0 && k < 64) v = c.in[I_W2][((size_t)j * RW_DL + k) * D + ch];
        else if (grp == 1 && k >= 64 && k < 128) v = c.in[I_A2][((size_t)j * RW_AL + (k - 64)) * D + ch];
        else if (grp == 2 && k >= 128 && k < 288) v = c.in[I_G2][((size_t)j * RW_GL + (k - 128)) * D + ch];
        else if (grp == 3 && k >= 288 && k < 320 && j > 0) v = c.in[I_V2][((size_t)(j - 1) * RW_VL + (k - 288)) * D + ch];
        lorat[i] = (bf16_t)(pk2bf(v, 0.f) & 0xffffu);
    }
}
__device__ __forceinline__ size_t rw_rec_base(int sq, int h) {
    using namespace cfg;
    return sq < BATCH ? ((size_t)sq * RHEADS + h) * SEQ : (size_t)MP * RHEADS + ((size_t)(sq - BATCH) * RHEADS + h) * DS;
}
__device__ __forceinline__ void rw_prep_fast(const Ctx& c, const FastRw& fr, int l, int gw, int ngw, int lane) {
    using namespace cfg; const int j = l / 3;
    for (int it = gw; it < MTOT * RHEADS; it += ngw) {
        const int m = it / RHEADS, h = it % RHEADS, ch = h * RH + lane;
        const bf16_t* rk = fr.rkv + (size_t)m * 3072 + ch; const bf16_t* lu = fr.lu + (size_t)m * 4096 + ch;
        const float r = bf2f(rk[0]), k0 = bf2f(rk[1024]); float v = bf2f(rk[2048]);
        const float wpre = bf2f(lu[0]), apre = bf2f(lu[1024]), gg = bf2f(lu[2048]), vpre = bf2f(lu[3072]);
        const float wl = -softplusf_(-(c.in[I_W0][j * D + ch] + wpre)) - 0.5f;
        const float w = expf(-expf(wl));
        if (j == 0) fr.vf[(size_t)m * D + ch] = v;
        else v = v + (fr.vf[(size_t)m * D + ch] - v) * sigmoidf_(c.in[I_V0][(j - 1) * D + ch] + vpre);
        const float a = sigmoidf_(c.in[I_A0][j * D + ch] + apre);
        float kk = k0 * c.in[I_KK][j * D + ch];
        const float nn = wave_sum64(kk * kk);
        kk *= 1.0f / fmaxf(sqrtf(nn), 1e-12f);
        const float k2 = k0 * (1.0f + (a - 1.0f) * c.in[I_KA][j * D + ch]);
        const float bo = kk * a;
        const float br = wave_sum64(bo * r), kr = wave_sum64(k2 * r), bonus = wave_sum64(r * k2 * c.in[I_RK][(size_t)j * D + ch]);
        const int sq = row_seq(m), t = row_t(m);
        float* rec = fr.ops + (rw_rec_base(sq, h) + t) * RW_REC;
        rec[lane] = -kk; rec[64 + lane] = w * r; rec[128 + lane] = w; rec[192 + lane] = bo; rec[256 + lane] = k2; rec[320 + lane] = v; rec[384 + lane] = gg;
        if (lane == 0) { rec[448] = br; rec[449] = kr; rec[450] = bonus; }
    }
}
template <int CTRL> __device__ __forceinline__ float dppf(float v) { return __int_as_float(__builtin_amdgcn_update_dpp(0, __float_as_int(v), CTRL, 0xF, 0xF, true)); }
__device__ __forceinline__ float red16(float x) { x += dppf<0xB1>(x); x += dppf<0x4E>(x); x += dppf<0x124>(x); x += dppf<0x128>(x); return x; }
__device__ __forceinline__ void rw_scan_fast(const Ctx& c, const FastRw& fr, int l, LDSP unsigned char* lds) {
    using namespace cfg; const int j = l / 3;
    const int tid = (int)tid_now(), w = __builtin_amdgcn_readfirstlane(tid >> 6), lane = tid & 63, cs = lane & 15, rp = 4 * w + (lane >> 4);
    LDSP float* ybuf = (LDSP float*)(lds + 2 * RW_BUF);
    for (int chain = blockIdx.x; chain < NSEQ * RHEADS; chain += gridDim.x) {
        const int sq = chain / RHEADS, h = chain % RHEADS, T = seq_len(sq), m0 = seq_row0(sq);
        const char* src = (const char*)(fr.ops + rw_rec_base(sq, h) * RW_REC);
        pg8::f32x4 S0, S1;
        if (sq < BATCH) { S0 = (pg8::f32x4){0.f, 0.f, 0.f, 0.f}; S1 = S0; }
        else { const float* s0 = c.in[I_WKV] + ((((size_t)j * DB + (sq - BATCH)) * RHEADS + h) * RH + 2 * rp) * RH + 4 * cs; S0 = *(const pg8::f32x4*)s0; S1 = *(const pg8::f32x4*)(s0 + RH); }
        const int nch = (T + RW_CH - 1) / RW_CH;
#define RW_DMA(n, buf) do { const int nb_ = ((T - (n) * RW_CH < RW_CH ? T - (n) * RW_CH : RW_CH) * RW_REC * 4 + 1023) >> 10; \
            for (int q_ = w; q_ < nb_; q_ += 8) __builtin_amdgcn_global_load_lds((const unsigned*)(src + (size_t)(n) * RW_BUF + (size_t)q_ * 1024 + (unsigned)lane * 16u), (LDSP unsigned*)(lds + (buf) * RW_BUF + q_ * 1024), 16, 0, 0); } while (0)
        __syncthreads();
        RW_DMA(0, 0);
        asm volatile("s_waitcnt vmcnt(0)" ::: "memory");
        __syncthreads();
        for (int n = 0; n < nch; ++n) {
            if (n + 1 < nch) RW_DMA(n + 1, (n + 1) & 1);
            const int tn = T - n * RW_CH < RW_CH ? T - n * RW_CH : RW_CH;
            const LDSP unsigned char* bufp = lds + (n & 1) * RW_BUF;
            for (int t = 0; t < tn; ++t) {
                const LDSP unsigned char* rec = bufp + t * (RW_REC * 4);
                const pg8::f32x4 A = *(const LDSP pg8::f32x4*)(rec + cs * 16), WR = *(const LDSP pg8::f32x4*)(rec + 256 + cs * 16), W = *(const LDSP pg8::f32x4*)(rec + 512 + cs * 16),
                                 B = *(const LDSP pg8::f32x4*)(rec + 768 + cs * 16), K = *(const LDSP pg8::f32x4*)(rec + 1024 + cs * 16);
                const pg8::f32x2 V2 = *(const LDSP pg8::f32x2*)(rec + 1280 + rp * 8), SC = *(const LDSP pg8::f32x2*)(rec + 1792);
                float sa0 = (S0[0] * A[0] + S0[1] * A[1]) + (S0[2] * A[2] + S0[3] * A[3]), y0 = (S0[0] * WR[0] + S0[1] * WR[1]) + (S0[2] * WR[2] + S0[3] * WR[3]);
                float sa1 = (S1[0] * A[0] + S1[1] * A[1]) + (S1[2] * A[2] + S1[3] * A[3]), y1 = (S1[0] * WR[0] + S1[1] * WR[1]) + (S1[2] * WR[2] + S1[3] * WR[3]);
                sa0 = red16(sa0); sa1 = red16(sa1); y0 = red16(y0); y1 = red16(y1);
                S0 = S0 * W + sa0 * B + V2[0] * K; S1 = S1 * W + sa1 * B + V2[1] * K;
                if (cs == 0) *(LDSP pg8::f32x2*)(ybuf + t * RH + 2 * rp) = (pg8::f32x2){y0 + sa0 * SC[0] + V2[0] * SC[1], y1 + sa1 * SC[0] + V2[1] * SC[1]};
            }
            asm volatile("s_waitcnt vmcnt(0)" ::: "memory");
            __syncthreads();
            for (int t = w; t < tn; t += 8) {
                const LDSP float* rec = (const LDSP float*)(bufp + t * (RW_REC * 4));
                const float y = ybuf[t * RH + lane], mean = wave_sum64(y) * (1.0f / RH), d = y - mean, var = wave_sum64(d * d) * (1.0f / RH);
                const int ch = h * RH + lane;
                const float yn = d * (1.0f / sqrtf(var + LNX_EPS)) * c.in[I_LNW][j * D + ch] + c.in[I_LNB][j * D + ch];
                const float o = (yn + rec[450] * rec[320 + lane]) * rec[384 + lane];
                fr.yo[(size_t)(m0 + n * RW_CH + t) * D + ch] = (bf16_t)(pk2bf(o, 0.f) & 0xffffu);
            }
            __syncthreads();
        }
#undef RW_DMA
        float* so = (sq < BATCH ? c.out + O_WKVP + (((size_t)j * BATCH + sq) * RHEADS + h) * RH * RH : c.out + O_WKVS + (((size_t)j * DB + (sq - BATCH)) * RHEADS + h) * RH * RH) + (size_t)(2 * rp) * RH + 4 * cs;
        *(pg8::f32x4*)so = S0; *(pg8::f32x4*)(so + RH) = S1;
    }
}
__device__ __forceinline__ float fsigmoid(float x) { return __builtin_amdgcn_rcpf(1.0f + __expf(-x)); }
__device__ __forceinline__ float fsoftplus(float x) { return x > 20.f ? x : __logf(1.0f + __expf(x)); }
__device__ __forceinline__ float rdl(float v, int l) { return __int_as_float(__builtin_amdgcn_readlane(__float_as_int(v), l)); }
__device__ __forceinline__ float wsum_dpp(float x) {
    x = red16(x);
    return (rdl(x, 0) + rdl(x, 16)) + (rdl(x, 32) + rdl(x, 48));
}

struct RwOp { pg8::f32x4 A, WR, W, B, K; pg8::f32x2 V2, SC; };
__device__ __forceinline__ void rw_ldop(RwOp& o, const LDSP unsigned char* rec, int cs, int rp) {
    o.A = *(const LDSP pg8::f32x4*)(rec + cs * 16); o.WR = *(const LDSP pg8::f32x4*)(rec + 256 + cs * 16); o.W = *(const LDSP pg8::f32x4*)(rec + 512 + cs * 16);
    o.B = *(const LDSP pg8::f32x4*)(rec + 768 + cs * 16); o.K = *(const LDSP pg8::f32x4*)(rec + 1024 + cs * 16);
    o.V2 = *(const LDSP pg8::f32x2*)(rec + 1280 + rp * 8); o.SC = *(const LDSP pg8::f32x2*)(rec + 1792);
}
__device__ __forceinline__ float fma_s(float a, float b, float c) { float d; asm("v_fma_f32 %0, %1, %2, %3" : "=v"(d) : "v"(a), "v"(b), "v"(c)); return d; }
__device__ __forceinline__ float mul_s(float a, float b) { float d; asm("v_mul_f32 %0, %1, %2" : "=v"(d) : "v"(a), "v"(b)); return d; }
__device__ __forceinline__ void rw_step(pg8::f32x4& S0, pg8::f32x4& S1, const RwOp& o, LDSP float* yrow, bool wr) {
    float sa0 = fma_s(S0[3], o.A[3], fma_s(S0[2], o.A[2], fma_s(S0[1], o.A[1], mul_s(S0[0], o.A[0]))));
    float sa1 = fma_s(S1[3], o.A[3], fma_s(S1[2], o.A[2], fma_s(S1[1], o.A[1], mul_s(S1[0], o.A[0]))));
    float y0 = fma_s(S0[3], o.WR[3], fma_s(S0[2], o.WR[2], fma_s(S0[1], o.WR[1], mul_s(S0[0], o.WR[0]))));
    float y1 = fma_s(S1[3], o.WR[3], fma_s(S1[2], o.WR[2], fma_s(S1[1], o.WR[1], mul_s(S1[0], o.WR[0]))));
    float t0[4], t1[4];
#pragma unroll
    for (int e = 0; e < 4; ++e) { t0[e] = fma_s(o.K[e], o.V2[0], mul_s(S0[e], o.W[e])); t1[e] = fma_s(o.K[e], o.V2[1], mul_s(S1[e], o.W[e])); }
    red16x4(sa0, sa1, y0, y1);
#pragma unroll
    for (int e = 0; e < 4; ++e) { S0[e] = fma_s(o.B[e], sa0, t0[e]); S1[e] = fma_s(o.B[e], sa1, t1[e]); }
    if (wr) *(LDSP pg8::f32x2*)yrow = (pg8::f32x2){fma_s(o.V2[0], o.SC[1], fma_s(sa0, o.SC[0], y0)), fma_s(o.V2[1], o.SC[1], fma_s(sa1, o.SC[0], y1))};
}
struct RwIn { unsigned short r, k, v, wp, ap, g, vp; float vf; };
template <int J>
__device__ __forceinline__ void rw_scan_fused(const Ctx& c, const FastRw& fr, LDSP unsigned char* lds) {
    using namespace cfg; constexpr int j = J;
    const int tid = (int)tid_now(), w = __builtin_amdgcn_readfirstlane(tid >> 6), lane = tid & 63, cs = lane & 15, rp = 4 * w + (lane >> 4);
    LDSP float* ybuf = (LDSP float*)(lds + 2 * RW_BUF);
    for (int chain = blockIdx.x; chain < NSEQ * RHEADS; chain += gridDim.x) {
        const int sq = chain / RHEADS, h = chain % RHEADS, T = seq_len(sq), m0 = seq_row0(sq), ch = h * RH + lane;
        const float p_w0 = c.in[I_W0][j * D + ch], p_a0 = c.in[I_A0][j * D + ch], p_kk = c.in[I_KK][j * D + ch], p_ka = c.in[I_KA][j * D + ch], p_rk = c.in[I_RK][(size_t)j * D + ch],
                    p_lnw = c.in[I_LNW][j * D + ch], p_lnb = c.in[I_LNB][j * D + ch], p_v0 = j > 0 ? c.in[I_V0][(j - 1) * D + ch] : 0.f;
        pg8::f32x4 S0, S1;
        if (sq < BATCH) { S0 = (pg8::f32x4){0.f, 0.f, 0.f, 0.f}; S1 = S0; }
        else { const float* s0 = c.in[I_WKV] + ((((size_t)j * DB + (sq - BATCH)) * RHEADS + h) * RH + 2 * rp) * RH + 4 * cs; S0 = *(const pg8::f32x4*)s0; S1 = *(const pg8::f32x4*)(s0 + RH); }
        const int nch = (T + RW_CH - 1) / RW_CH;
        RwIn in[4];
#define RW_LOADIN(n) do { _Pragma("unroll") for (int q = 0; q < 4; ++q) { const int t_ = (n) * RW_CH + 4 * w + q; if (t_ < T) { const size_t m_ = (size_t)(m0 + t_); \
                const bf16_t* rk_ = fr.rkv + m_ * 3072 + ch; const bf16_t* lu_ = fr.lu + m_ * 4096 + ch; \
                in[q].r = rk_[0]; in[q].k = rk_[1024]; in[q].v = rk_[2048]; in[q].wp = lu_[0]; in[q].ap = lu_[1024]; in[q].g = lu_[2048]; in[q].vp = lu_[3072]; \
                in[q].vf = j > 0 ? fr.vf[m_ * D + ch] : 0.f; } } } while (0)
#define RW_PREP(n, buf) do { _Pragma("unroll") for (int q = 0; q < 4; ++q) { const int tl_ = 4 * w + q, t_ = (n) * RW_CH + tl_; if (t_ < T) { \
                const float r_ = bf2f(in[q].r), k0_ = bf2f(in[q].k); float v_ = bf2f(in[q].v); \
                const float wl_ = -fsoftplus(-(p_w0 + bf2f(in[q].wp))) - 0.5f, w_ = __expf(-__expf(wl_)); \
                if (j == 0) fr.vf[(size_t)(m0 + t_) * D + ch] = v_; else v_ = v_ + (in[q].vf - v_) * fsigmoid(p_v0 + bf2f(in[q].vp)); \
                const float a_ = fsigmoid(p_a0 + bf2f(in[q].ap)); float kk_ = k0_ * p_kk; \
                const float k2_ = k0_ * (1.0f + (a_ - 1.0f) * p_ka); \
                float n_ = red16(kk_ * kk_), e1_ = red16(r_ * k2_ * p_rk), e2_ = red16(k2_ * r_); \
                n_ = (rdl(n_, 0) + rdl(n_, 16)) + (rdl(n_, 32) + rdl(n_, 48)); e1_ = (rdl(e1_, 0) + rdl(e1_, 16)) + (rdl(e1_, 32) + rdl(e1_, 48)); e2_ = (rdl(e2_, 0) + rdl(e2_, 16)) + (rdl(e2_, 32) + rdl(e2_, 48)); \
                kk_ *= __builtin_amdgcn_rcpf(fmaxf(__builtin_amdgcn_sqrtf(n_), 1e-12f)); const float bo_ = kk_ * a_; const float e3_ = wsum_dpp(bo_ * r_); \
                LDSP float* rec_ = (LDSP float*)(lds + (buf) * RW_BUF + tl_ * (RW_REC * 4)); \
                rec_[lane] = -kk_; rec_[64 + lane] = w_ * r_; rec_[128 + lane] = w_; rec_[192 + lane] = bo_; rec_[256 + lane] = k2_; rec_[320 + lane] = v_; rec_[384 + lane] = bf2f(in[q].g); \
                if (lane == 0) { rec_[448] = e3_; rec_[449] = e2_; rec_[450] = e1_; } } } } while (0)
        __syncthreads();
        RW_LOADIN(0); RW_PREP(0, 0);
        __syncthreads();
        for (int n = 0; n < nch; ++n) {
            if (n + 1 < nch) RW_LOADIN(n + 1);
            const int tn = T - n * RW_CH < RW_CH ? T - n * RW_CH : RW_CH;
            const LDSP unsigned char* bufp = lds + (n & 1) * RW_BUF;
#if defined(PROBE_DUP) && (PROBE_DUP & (1 << 17))
            { RwOp o0, o1; rw_ldop(o0, bufp, cs, rp); pg8::f32x4 T0 = S0, T1 = S1;
              for (int t = 0; t < tn; t += 2) {
                  rw_ldop(o1, bufp + (t + 1) * (RW_REC * 4), cs, rp);
                  rw_step(T0, T1, o0, ybuf + t * RH + 2 * rp, cs == 0);
                  rw_ldop(o0, bufp + (t + 2 < tn ? t + 2 : t) * (RW_REC * 4), cs, rp);
                  rw_step(T0, T1, o1, ybuf + (t + 1) * RH + 2 * rp, cs == 0);
              } asm volatile("" :: "v"(T0), "v"(T1)); }
#endif
            { RwOp o0, o1; rw_ldop(o0, bufp, cs, rp);
              for (int t = 0; t < tn; t += 2) {
                  rw_ldop(o1, bufp + (t + 1) * (RW_REC * 4), cs, rp);
                  rw_step(S0, S1, o0, ybuf + t * RH + 2 * rp, cs == 0);
                  rw_ldop(o0, bufp + (t + 2 < tn ? t + 2 : t) * (RW_REC * 4), cs, rp);
                  rw_step(S0, S1, o1, ybuf + (t + 1) * RH + 2 * rp, cs == 0);
              } }
            if (n + 1 < nch) RW_PREP(n + 1, (n + 1) & 1);
#if defined(PROBE_DUP) && (PROBE_DUP & (1 << 18))
            if (n + 1 < nch) RW_PREP(n + 1, (n + 1) & 1);
#endif
            __syncthreads();
            for (int t = w; t < tn; t += 8) {
                const LDSP float* rec = (const LDSP float*)(bufp + t * (RW_REC * 4));
                const float y = ybuf[t * RH + lane], mean = wsum_dpp(y) * (1.0f / RH), d = y - mean, var = wsum_dpp(d * d) * (1.0f / RH);
                const float yn = d * __builtin_amdgcn_rsqf(var + LNX_EPS) * p_lnw + p_lnb;
                const float o = (yn + rec[450] * rec[320 + lane]) * rec[384 + lane];
                fr.yo[(size_t)(m0 + n * RW_CH + t) * D + ch] = (bf16_t)(pk2bf(o, 0.f) & 0xffffu);
            }
            __syncthreads();
        }
#undef RW_LOADIN
#undef RW_PREP
        float* so = (sq < BATCH ? c.out + O_WKVP + (((size_t)j * BATCH + sq) * RHEADS + h) * RH * RH : c.out + O_WKVS + (((size_t)j * DB + (sq - BATCH)) * RHEADS + h) * RH * RH) + (size_t)(2 * rp) * RH + 4 * cs;
        *(pg8::f32x4*)so = S0; *(pg8::f32x4*)(so + RH) = S1;
    }
}
struct FastMb {
    bf16_t* zb;
    bf16_t* xbcr;
    float* dtraw;
    bf16_t* xbcb;
    float* dt;
    float* y;
    bf16_t* yzn;
    bf16_t *wbint, *wbot;
};
struct EpiMamba {
    static constexpr bool PERM = true;
    bf16_t* zb; bf16_t* xbcr; float* dtraw;
    __device__ __forceinline__ void operator()(const pg8::f32x4 (&acc)[2][2][4][2], const pg8::Unit& u, int wr, int wc, int fr, int fq) const {
        using namespace pg8;
        const int row0 = u.pm * BM + wr * 64 + fr, cl0 = wc * 32 + 8 * fq, pn = u.pn;
        if (pn < 20) {
            bf16_t* base = pn < 8 ? zb : xbcr; const int ldc = pn < 8 ? 2048 : 3072, coff = pn < 8 ? pn * 256 : (pn - 8) * 256;
#pragma unroll
            for (int ai = 0; ai < 2; ++ai)
#pragma unroll
                for (int m = 0; m < 4; ++m) { bf16_t* rowp = base + (size_t)(row0 + ai * HALF + m * 16) * ldc + coff + cl0;
#pragma unroll
                    for (int bj = 0; bj < 2; ++bj) { const f32x4 v0 = acc[ai][bj][m][0], v1 = acc[ai][bj][m][1];
                        u32x4 w; w.x = cvt_pk_bf16(v0[0], v0[1]); w.y = cvt_pk_bf16(v0[2], v0[3]); w.z = cvt_pk_bf16(v1[0], v1[1]); w.w = cvt_pk_bf16(v1[2], v1[3]);
                        *(u32x4*)(rowp + bj * HALF) = w; } }
        } else if (cl0 < 32) {
#pragma unroll
            for (int ai = 0; ai < 2; ++ai)
#pragma unroll
                for (int m = 0; m < 4; ++m) { float* rowp = dtraw + (size_t)(row0 + ai * HALF + m * 16) * 32 + cl0;
                    *(f32x4*)rowp = acc[ai][0][m][0]; *(f32x4*)(rowp + 4) = acc[ai][0][m][1]; }
        }
    }
};
__device__ __forceinline__ void mb_conv_fast(const Ctx& c, const FastMb& fb, int l, size_t gtid, size_t gsz, bool write_f32) {
    using namespace cfg; const int j = l / 3; constexpr int NB = MB_CD / 8, TB = 8;
    const int tstride = (int)(gsz / NB), cbi = (int)(gtid % NB), tb0 = (int)(gtid / NB);
    if (tb0 < tstride) {
    const int cb = cbi * 8;
    float wt[MB_CONV][8], bias[8];
        { const pg8::f32x4 b0 = *(const pg8::f32x4*)(c.in[I_CONVB] + j * MB_CD + cb), b1 = *(const pg8::f32x4*)(c.in[I_CONVB] + j * MB_CD + cb + 4);
#pragma unroll
          for (int e = 0; e < 4; ++e) { bias[e] = b0[e]; bias[4 + e] = b1[e]; } }
#pragma unroll
        for (int jj = 0; jj < MB_CONV; ++jj) { const float* wp_ = c.in[I_CONVW] + ((size_t)j * MB_CONV + jj) * MB_CD + cb; const pg8::f32x4 w0 = *(const pg8::f32x4*)wp_, w1 = *(const pg8::f32x4*)(wp_ + 4);
#pragma unroll
            for (int e = 0; e < 4; ++e) { wt[jj][e] = w0[e]; wt[jj][4 + e] = w1[e]; } }
    for (int tbi = tb0; tbi < MTOT / TB; tbi += tstride) {
        const int mb = tbi * TB, t0 = row_t(mb), sq = row_seq(mb), T = seq_len(sq);
        float win[MB_CONV][8];
#pragma unroll
        for (int jj = 0; jj < MB_CONV - 1; ++jj) {
            const int tt = t0 + jj - (MB_CONV - 1);
            if (tt >= 0) { const pg8::u32x4 raw = *(const pg8::u32x4*)(fb.xbcr + (size_t)(mb + jj - (MB_CONV - 1)) * MB_CD + cb); const unsigned wv[4] = {raw.x, raw.y, raw.z, raw.w};
#pragma unroll
                for (int q = 0; q < 4; ++q) { win[jj][2 * q] = __uint_as_float(wv[q] << 16); win[jj][2 * q + 1] = __uint_as_float(wv[q] & 0xffff0000u); } }
            else if (sq >= BATCH) { const float* st = c.in[I_CONV] + (((size_t)j * DB + (sq - BATCH)) * (MB_CONV - 1) + (tt + MB_CONV - 1)) * MB_CD + cb;
#pragma unroll
                for (int e = 0; e < 8; ++e) win[jj][e] = st[e]; }
            else {
#pragma unroll
                for (int e = 0; e < 8; ++e) win[jj][e] = 0.f; }
        }
#pragma unroll
        for (int tb = 0; tb < TB; ++tb) {
            const int m = mb + tb, t = t0 + tb;
            { const pg8::u32x4 raw = *(const pg8::u32x4*)(fb.xbcr + (size_t)m * MB_CD + cb); const unsigned wv[4] = {raw.x, raw.y, raw.z, raw.w};
#pragma unroll
              for (int q = 0; q < 4; ++q) { win[3][2 * q] = __uint_as_float(wv[q] << 16); win[3][2 * q + 1] = __uint_as_float(wv[q] & 0xffff0000u); } }
            if (t >= T - (MB_CONV - 1)) {
                float* so = (sq < BATCH ? c.out + O_CONVP + (((size_t)j * BATCH + sq) * (MB_CONV - 1) + (t - (T - (MB_CONV - 1)))) * MB_CD
                                        : c.out + O_CONVS + (((size_t)j * DB + (sq - BATCH)) * (MB_CONV - 1) + (t - (T - (MB_CONV - 1)))) * MB_CD) + cb;
#pragma unroll
                for (int e = 0; e < 8; ++e) so[e] = win[3][e];
            }
            unsigned w[4];
#pragma unroll
            for (int q = 0; q < 4; ++q) {
                float a0 = bias[2 * q], a1 = bias[2 * q + 1];
#pragma unroll
                for (int jj = 0; jj < MB_CONV; ++jj) { a0 += win[jj][2 * q] * wt[jj][2 * q]; a1 += win[jj][2 * q + 1] * wt[jj][2 * q + 1]; }
                a0 = a0 * __builtin_amdgcn_rcpf(1.0f + __expf(-a0)); a1 = a1 * __builtin_amdgcn_rcpf(1.0f + __expf(-a1));
                w[q] = pk2bf(a0, a1); if (write_f32) { c.xbc[(size_t)m * MB_CD + cb + 2 * q] = a0; c.xbc[(size_t)m * MB_CD + cb + 2 * q + 1] = a1; } }
            *(pg8::u32x4*)(fb.xbcb + (size_t)m * MB_CD + cb) = (pg8::u32x4){w[0], w[1], w[2], w[3]};
#pragma unroll
            for (int jj = 0; jj < MB_CONV - 1; ++jj)
#pragma unroll
                for (int e = 0; e < 8; ++e) win[jj][e] = win[jj + 1][e];
        }
    }
    }
    for (size_t i = gtid; i < (size_t)MTOT * MB_HEADS; i += gsz) {
        const float v = softplusf_(fb.dtraw[i] + c.in[I_DTB][j * MB_HEADS + (int)(i % MB_HEADS)]);
        fb.dt[i] = v; if (write_f32) c.dt[i] = v;
    }
}
__device__ __forceinline__ void mb_gate_fast(const Ctx& c, const FastMb& fb, const float* __restrict__ y, int l, int gw, int ngw, int lane) {
    using namespace cfg; const int j = l / 3; constexpr int GW_ = MB_INNER / MB_GROUPS;
    const int g0 = gw % MB_GROUPS; const bool gfix = (ngw % MB_GROUPS) == 0;
    const float* nwp0 = c.in[I_BNORM] + j * MB_INNER + g0 * GW_ + 8 * lane; const pg8::f32x4 n0h = *(const pg8::f32x4*)nwp0, n1h = *(const pg8::f32x4*)(nwp0 + 4);
    for (int it = gw; it < MTOT * MB_GROUPS; it += ngw) {
        const int m = it / MB_GROUPS, g = it % MB_GROUPS; const size_t o = (size_t)m * MB_INNER + g * GW_ + 8 * lane;
        const pg8::f32x4 y0 = *(const pg8::f32x4*)(y + o), y1 = *(const pg8::f32x4*)(y + o + 4); const pg8::u32x4 zr = *(const pg8::u32x4*)(fb.zb + o);
        const unsigned zw[4] = {zr.x, zr.y, zr.z, zr.w}; float v[8]; float s = 0.f;
#pragma unroll
        for (int q = 0; q < 4; ++q) { const float z0 = __uint_as_float(zw[q] << 16), z1 = __uint_as_float(zw[q] & 0xffff0000u);
            v[2 * q] = (q < 2 ? y0[2 * q] : y1[2 * q - 4]) * (z0 * __builtin_amdgcn_rcpf(1.0f + __expf(-z0))); v[2 * q + 1] = (q < 2 ? y0[2 * q + 1] : y1[2 * q - 3]) * (z1 * __builtin_amdgcn_rcpf(1.0f + __expf(-z1))); s += v[2 * q] * v[2 * q] + v[2 * q + 1] * v[2 * q + 1]; }
        const float rs = 1.0f / sqrtf(wave_sum64(s) * (1.0f / GW_) + NORM_EPS);
        pg8::f32x4 n0 = n0h, n1 = n1h; if (!gfix) { const float* nwp = c.in[I_BNORM] + j * MB_INNER + g * GW_ + 8 * lane; n0 = *(const pg8::f32x4*)nwp; n1 = *(const pg8::f32x4*)(nwp + 4); }
        const float nw[8] = {n0[0], n0[1], n0[2], n0[3], n1[0], n1[1], n1[2], n1[3]}; unsigned w[4];
#pragma unroll
        for (int q = 0; q < 4; ++q) w[q] = pk2bf(v[2 * q] * rs * nw[2 * q], v[2 * q + 1] * rs * nw[2 * q + 1]);
        *(pg8::u32x4*)(fb.yzn + o) = (pg8::u32x4){w[0], w[1], w[2], w[3]};
    }
}
constexpr int SS_XR = 144, SS_BR = 272;
constexpr int SS_XIM = 0, SS_XSM = SS_XIM + 128 * SS_XR, SS_BIM = SS_XSM + 128 * SS_XR, SS_CIM = SS_BIM + 128 * SS_BR, SS_MTM = SS_CIM + 128 * SS_BR, SS_HBM = SS_MTM + 128 * SS_BR, SS_TAB = SS_HBM + 128 * SS_XR, SS_END = SS_TAB + 2048;
__device__ __forceinline__ bf16x8v ss_trfrag(const LDSP unsigned char* img, int rowstride, int k0, int col0, int lane) {
    const int r0 = k0 + 8 * (lane >> 5) + ((lane & 15) >> 2), cc = col0 + 16 * ((lane >> 4) & 1) + 4 * (lane & 3);
    const s16x4 t0 = __builtin_amdgcn_ds_read_tr16_b64_v4i16((LDSP s16x4*)(img + r0 * rowstride + cc * 2));
    const s16x4 t1 = __builtin_amdgcn_ds_read_tr16_b64_v4i16((LDSP s16x4*)(img + (r0 + 4) * rowstride + cc * 2));
    return (bf16x8v){t0[0], t0[1], t0[2], t0[3], t1[0], t1[1], t1[2], t1[3]};
}
__device__ __forceinline__ void mb_ssd_prompt(const Ctx& c, const FastMb& fb, int l, LDSP unsigned char* lds) {
    using namespace cfg; const int j = l / 3;
    const int tid = (int)tid_now(), w = __builtin_amdgcn_readfirstlane(tid >> 6), lane = tid & 63, l31 = lane & 31, h5 = lane >> 5;
    LDSP float* tab = (LDSP float*)(lds + SS_TAB);
    for (int chain = blockIdx.x; chain < BATCH * MB_HEADS; chain += gridDim.x) {
        const int b = chain / MB_HEADS, hd = chain % MB_HEADS, g = hd / (MB_HEADS / MB_GROUPS);
        const float Ah = -expf(c.in[I_ALOG][j * MB_HEADS + hd]), Dh = c.in[I_BD][j * MB_HEADS + hd];
        f32x16_t H;
#pragma unroll
        for (int r = 0; r < 16; ++r) H[r] = 0.f;
        pg8::u32x4 nx[2], nB[4], nC[4]; float ndt0 = 0.f, ndt1 = 0.f;
#define SS_LOAD(ck_) do { const size_t mm_ = (size_t)b * SEQ + 128 * (ck_); int tq_ = tid; asm volatile("" : "+v"(tq_)); \
            _Pragma("unroll") for (int q = 0; q < 2; ++q) { const int ci = tq_ + 512 * q; nx[q] = *(const pg8::u32x4*)(fb.xbcb + (mm_ + (ci >> 3)) * MB_CD + hd * MB_HEAD + (ci & 7) * 8); } \
            _Pragma("unroll") for (int q = 0; q < 4; ++q) { const int ci = tq_ + 512 * q; const bf16_t* rowp = fb.xbcb + (mm_ + (ci >> 4)) * MB_CD + MB_INNER + g * MB_STATE + (ci & 15) * 8; \
                nB[q] = *(const pg8::u32x4*)rowp; nC[q] = *(const pg8::u32x4*)(rowp + MB_GN); } \
            ndt0 = fb.dt[(mm_ + 2 * (tq_ & 63)) * MB_HEADS + hd]; ndt1 = fb.dt[(mm_ + 2 * (tq_ & 63) + 1) * MB_HEADS + hd]; } while (0)
        SS_LOAD(0);
        for (int ck = 0; ck < SEQ / 128; ++ck) {
            const size_t m0 = (size_t)b * SEQ + 128 * ck;
            int tl = tid; asm volatile("" : "+v"(tl));
            pg8::u32x4 xr[2];
#pragma unroll
            for (int q = 0; q < 2; ++q) { const int ci = tl + 512 * q; xr[q] = nx[q];
                *(LDSP pg8::u32x2*)(lds + SS_XIM + (ci >> 3) * SS_XR + (ci & 7) * 16) = (pg8::u32x2){xr[q].x, xr[q].y}; *(LDSP pg8::u32x2*)(lds + SS_XIM + (ci >> 3) * SS_XR + (ci & 7) * 16 + 8) = (pg8::u32x2){xr[q].z, xr[q].w}; }
#pragma unroll
            for (int q = 0; q < 4; ++q) { const int ci = tl + 512 * q;
                *(LDSP pg8::u32x4*)(lds + SS_BIM + (ci >> 4) * SS_BR + (ci & 15) * 16) = nB[q];
                *(LDSP pg8::u32x4*)(lds + SS_CIM + (ci >> 4) * SS_BR + (ci & 15) * 16) = nC[q]; }
            float alast;
            { const float v0 = ndt0 * Ah, v1 = ndt1 * Ah; float sacc = v0 + v1;
#pragma unroll
              for (int o = 1; o < 64; o <<= 1) { const float u = __shfl_up(sacc, o); if (lane >= o) sacc += u; }
              tab[2 * lane] = sacc - v1; tab[2 * lane + 1] = sacc; tab[128 + 2 * lane] = ndt0; tab[128 + 2 * lane + 1] = ndt1;
              alast = __int_as_float(__builtin_amdgcn_readlane(__float_as_int(sacc), 63)); }
            if (ck + 1 < SEQ / 128) SS_LOAD(ck + 1);
            asm volatile("s_waitcnt lgkmcnt(0)" ::: "memory");
#pragma unroll
            for (int q = 0; q < 2; ++q) { const int ci = tl + 512 * q, row = ci >> 3; const float sc = __expf(alast - tab[row]) * tab[128 + row]; const unsigned xw[4] = {xr[q].x, xr[q].y, xr[q].z, xr[q].w}; unsigned ow[4];
#pragma unroll
                for (int e = 0; e < 4; ++e) ow[e] = pk2bf(__uint_as_float(xw[e] << 16) * sc, __uint_as_float(xw[e] & 0xffff0000u) * sc);
                *(LDSP pg8::u32x2*)(lds + SS_XSM + row * SS_XR + (ci & 7) * 16) = (pg8::u32x2){ow[0], ow[1]}; *(LDSP pg8::u32x2*)(lds + SS_XSM + row * SS_XR + (ci & 7) * 16 + 8) = (pg8::u32x2){ow[2], ow[3]}; }
            __syncthreads();
            { int ln = lane; asm volatile("" : "+v"(ln)); const int a31 = ln & 31, a5 = ln >> 5;
              for (int tt = w; tt < 10; tt += 8) {
                int ib = tt < 1 ? 0 : (tt < 3 ? 1 : (tt < 6 ? 2 : 3)); const int jb = tt - (ib * (ib + 1)) / 2;
                f32x16_t ST;
#pragma unroll
                for (int r = 0; r < 16; ++r) ST[r] = 0.f;
#pragma unroll
                for (int s = 0; s < 8; ++s) { const bf16x8v a = *(const LDSP bf16x8v*)(lds + SS_BIM + (32 * jb + a31) * SS_BR + (16 * s + 8 * a5) * 2), bb = *(const LDSP bf16x8v*)(lds + SS_CIM + (32 * ib + a31) * SS_BR + (16 * s + 8 * a5) * 2);
                    ST = MFMA32(a, bb, ST); }
                const float ai = tab[32 * ib + a31];
#pragma unroll
                for (int g4 = 0; g4 < 4; ++g4) { const int jr = 32 * jb + 8 * g4 + 4 * a5; const pg8::f32x4 aj = *(const LDSP pg8::f32x4*)(tab + jr), dj = *(const LDSP pg8::f32x4*)(tab + 128 + jr);
#pragma unroll
                    for (int e = 0; e < 4; ++e) { const int jj = jr + e, ii = 32 * ib + a31; const float mv = jj <= ii ? ST[4 * g4 + e] * __expf(ai - aj[e]) * dj[e] : 0.f;
                        *(LDSP bf16_t*)(lds + SS_MTM + jj * SS_BR + ii * 2) = (bf16_t)(pk2bf(mv, 0.f) & 0xffffu); } }
              }
              const int nb = w >> 1, pb = w & 1;
#pragma unroll
              for (int r = 0; r < 16; ++r) *(LDSP bf16_t*)(lds + SS_HBM + (32 * nb + (r & 3) + 8 * (r >> 2) + 4 * a5) * SS_XR + (32 * pb + a31) * 2) = (bf16_t)(pk2bf(H[r], 0.f) & 0xffffu);
            }
            __syncthreads();
            { int ln = lane; asm volatile("" : "+v"(ln)); const int a31 = ln & 31, a5 = ln >> 5;
              const int pb = w & 1, ib = w >> 1, nb = w >> 1;
              f32x16_t Y;
#pragma unroll
              for (int r = 0; r < 16; ++r) Y[r] = 0.f;
#pragma unroll
              for (int s = 0; s < 8; ++s) { const bf16x8v a = ss_trfrag(lds + SS_HBM, SS_XR, 16 * s, 32 * pb, ln), bb = *(const LDSP bf16x8v*)(lds + SS_CIM + (32 * ib + a31) * SS_BR + (16 * s + 8 * a5) * 2);
                  Y = MFMA32(a, bb, Y); if (s & 1) __builtin_amdgcn_sched_barrier(0); }
              const float ei = __expf(tab[32 * ib + a31]);
#pragma unroll
              for (int r = 0; r < 16; ++r) Y[r] *= ei;
              for (int s = 0; s < 2 * (ib + 1); ++s) { const bf16x8v a = ss_trfrag(lds + SS_XIM, SS_XR, 16 * s, 32 * pb, ln), bb = ss_trfrag(lds + SS_MTM, SS_BR, 16 * s, 32 * ib, ln);
                  Y = MFMA32(a, bb, Y); }
              { const size_t mrow = m0 + 32 * ib + a31; float* yrow = fb.y + mrow * MB_INNER + hd * MB_HEAD + 32 * pb + 4 * a5;
#pragma unroll
                for (int g4 = 0; g4 < 4; ++g4) { const pg8::u32x2 xv = *(const LDSP pg8::u32x2*)(lds + SS_XIM + (32 * ib + a31) * SS_XR + (32 * pb + 8 * g4 + 4 * a5) * 2);
                    pg8::f32x4 o; o[0] = Y[4 * g4] + Dh * __uint_as_float(xv.x << 16); o[1] = Y[4 * g4 + 1] + Dh * __uint_as_float(xv.x & 0xffff0000u); o[2] = Y[4 * g4 + 2] + Dh * __uint_as_float(xv.y << 16); o[3] = Y[4 * g4 + 3] + Dh * __uint_as_float(xv.y & 0xffff0000u);
                    *(pg8::f32x4*)(yrow + 8 * g4) = o; } }
              const float dec = __expf(tab[127]);
#pragma unroll
              for (int r = 0; r < 16; ++r) H[r] *= dec;
#pragma unroll
              for (int s = 0; s < 8; ++s) { const bf16x8v a = ss_trfrag(lds + SS_BIM, SS_BR, 16 * s, 32 * nb, ln), bb = ss_trfrag(lds + SS_XSM, SS_XR, 16 * s, 32 * pb, ln);
                  H = MFMA32(a, bb, H); if (s & 1) __builtin_amdgcn_sched_barrier(0); }
            }
            __syncthreads();
        }
#undef SS_LOAD
        { const int nb = w >> 1, pb = w & 1; float* so = c.out + O_SSMP + (((size_t)j * BATCH + b) * MB_HEADS + hd) * MB_HEAD * MB_STATE;
#pragma unroll
          for (int r = 0; r < 16; ++r) so[(size_t)(32 * pb + l31) * MB_STATE + 32 * nb + (r & 3) + 8 * (r >> 2) + 4 * h5] = H[r]; }
    }
}
__device__ __forceinline__ void mb_scan_sample(const Ctx& c, const FastMb& fb, int l) {
    using namespace cfg; const int j = l / 3;
    const int tid = (int)tid_now(), p = tid >> 3, ns = tid & 7;
    pg8::f32x4 hn[4];
    { const int chain = blockIdx.x; if (chain < DB * MB_HEADS) { const size_t so = ((((size_t)j * DB + chain / MB_HEADS) * MB_HEADS + chain % MB_HEADS) * MB_HEAD + p) * MB_STATE + 16 * ns;
#pragma unroll
        for (int q = 0; q < 4; ++q) hn[q] = *(const pg8::f32x4*)(c.in[I_SSM] + so + 4 * q); } }
    for (int chain = blockIdx.x; chain < DB * MB_HEADS; chain += gridDim.x) {
        const int s = chain / MB_HEADS, hd = chain % MB_HEADS, g = hd / (MB_HEADS / MB_GROUPS);
        const float Ah = -expf(c.in[I_ALOG][j * MB_HEADS + hd]), Dh = c.in[I_BD][j * MB_HEADS + hd];
        const size_t so = ((((size_t)j * DB + s) * MB_HEADS + hd) * MB_HEAD + p) * MB_STATE + 16 * ns;
        float hs[16];
#pragma unroll
        for (int q = 0; q < 4; ++q) { hs[4 * q] = hn[q][0]; hs[4 * q + 1] = hn[q][1]; hs[4 * q + 2] = hn[q][2]; hs[4 * q + 3] = hn[q][3]; }
        { const int cn = chain + gridDim.x; if (cn < DB * MB_HEADS) { const size_t sn = ((((size_t)j * DB + cn / MB_HEADS) * MB_HEADS + cn % MB_HEADS) * MB_HEAD + p) * MB_STATE + 16 * ns;
#pragma unroll
            for (int q = 0; q < 4; ++q) hn[q] = *(const pg8::f32x4*)(c.in[I_SSM] + sn + 4 * q); } }
        float dtv[DS]; unsigned short xr[DS]; pg8::u32x4 Bq[DS][2], Cq[DS][2];
#pragma unroll
        for (int t = 0; t < DS; ++t) { const size_t m = (size_t)MP + s * DS + t; dtv[t] = fb.dt[m * MB_HEADS + hd]; xr[t] = fb.xbcb[m * MB_CD + hd * MB_HEAD + p];
            const bf16_t* Bp = fb.xbcb + m * MB_CD + MB_INNER + g * MB_STATE + 16 * ns; Bq[t][0] = *(const pg8::u32x4*)Bp; Bq[t][1] = *(const pg8::u32x4*)(Bp + 8);
            Cq[t][0] = *(const pg8::u32x4*)(Bp + MB_GN); Cq[t][1] = *(const pg8::u32x4*)(Bp + MB_GN + 8); }
#pragma unroll
        for (int t = 0; t < DS; ++t) {
            const size_t m = (size_t)MP + s * DS + t;
            const float dA = __expf(dtv[t] * Ah), xv = bf2f(xr[t]), xdt = xv * dtv[t];
            const unsigned bw[8] = {Bq[t][0].x, Bq[t][0].y, Bq[t][0].z, Bq[t][0].w, Bq[t][1].x, Bq[t][1].y, Bq[t][1].z, Bq[t][1].w};
            const unsigned cw[8] = {Cq[t][0].x, Cq[t][0].y, Cq[t][0].z, Cq[t][0].w, Cq[t][1].x, Cq[t][1].y, Cq[t][1].z, Cq[t][1].w};
            float yy = 0.f;
#pragma unroll
            for (int k = 0; k < 8; ++k) { hs[2 * k] = hs[2 * k] * dA + xdt * __uint_as_float(bw[k] << 16); hs[2 * k + 1] = hs[2 * k + 1] * dA + xdt * __uint_as_float(bw[k] & 0xffff0000u);
                yy += __uint_as_float(cw[k] << 16) * hs[2 * k] + __uint_as_float(cw[k] & 0xffff0000u) * hs[2 * k + 1]; }
            yy += __shfl_xor(yy, 1); yy += __shfl_xor(yy, 2); yy += __shfl_xor(yy, 4);
            if (ns == 0) fb.y[m * MB_INNER + hd * MB_HEAD + p] = yy + Dh * xv;
        }
        float* oo = c.out + O_SSMS + so;
#pragma unroll
        for (int q = 0; q < 4; ++q) *(pg8::f32x4*)(oo + 4 * q) = (pg8::f32x4){hs[4 * q], hs[4 * q + 1], hs[4 * q + 2], hs[4 * q + 3]};
    }
}
constexpr int RC_RS = 144;
constexpr int RC_AT = 0, RC_RT = 4608, RC_BB = 9216, RC_KB = 13824, RC_BH = 18432, RC_KH = 23040, RC_VV = 27648, RC_UT = 32256, RC_GG = 36864;
constexpr int RC_SB = 41472;
constexpr int RC_NAK = 50688, RC_MRB = 53248, RC_MRK = 55808, RC_NS = 80;
constexpr int RC_NAB = 58368;
constexpr int RC_E = 62464;
constexpr int RC_YB = 70656;
constexpr int RC_GL = 78848, RC_BON = 79104, RC_VV2 = 79360, RC_GG2 = RC_VV2 + 4608, RC_END0 = RC_GG2 + 4608;
constexpr int RC_WW = RC_END0, RC_WA = RC_WW + 64 * 144, RC_WG = RC_WA + 64 * 144, RC_WV = RC_WG + 64 * 336, RC_LUO = RC_WV + 64 * 80, RC_END = RC_LUO + 4 * 4608;
constexpr int RC_HB = RC_AT, RC_HBS = 784;
__device__ __forceinline__ bf16x8v rc_nat(const LDSP unsigned char* img, int stride, int row, int kofs) { return *(const LDSP bf16x8v*)(img + row * stride + kofs * 2); }
__device__ __forceinline__ int rc_row(int r, int h5) { return (r & 3) + 8 * (r >> 2) + 4 * h5; }
__device__ __forceinline__ void rc_st16(LDSP unsigned char* p, float v) { *(LDSP bf16_t*)p = (bf16_t)(pk2bf(v, 0.f) & 0xffffu); }


template <int S>
struct RcSub {
    static __device__ __forceinline__ void run(float (&acc)[32], const LDSP float* NAB, LDSP unsigned char* lds, int lane) {
        const float us = acc[S]; rc_st16(lds + RC_UT + S * RC_RS + lane * 2, us);
#pragma unroll
        for (int g4 = 0; g4 < 8; ++g4) { if (4 * g4 + 3 > S) { const pg8::f32x4 nv = *(const LDSP pg8::f32x4*)(NAB + S * 32 + 4 * g4);
#pragma unroll
            for (int e = 0; e < 4; ++e) { if (4 * g4 + e > S) acc[4 * g4 + e] = fmaf(nv[e], us, acc[4 * g4 + e]); } } }
        RcSub<S + 1>::run(acc, NAB, lds, lane);
    }
};
template <> struct RcSub<32> { static __device__ __forceinline__ void run(float (&)[32], const LDSP float*, LDSP unsigned char*, int) {} };

template <int J>
__device__ __forceinline__ void rw_scan_chunked(const Ctx& c, const FastRw& fr, LDSP unsigned char* lds) {
    using namespace cfg; constexpr int j = J;
    const int tid = (int)tid_now(), w = __builtin_amdgcn_readfirstlane(tid >> 6), lane = tid & 63, l31 = lane & 31, h5 = lane >> 5;
    LDSP float* Ef = (LDSP float*)(lds + RC_E); LDSP float* YB = (LDSP float*)(lds + RC_YB); LDSP float* GL = (LDSP float*)(lds + RC_GL); LDSP float* BON = (LDSP float*)(lds + RC_BON);
    LDSP float* NAB = (LDSP float*)(lds + RC_NAB);
    int hcur = -1;
    for (int chain = blockIdx.x; chain < NSEQ * RHEADS; chain += gridDim.x) {
        const int sq = chain / RHEADS, h = chain % RHEADS, T = seq_len(sq), m0 = seq_row0(sq), ch = h * RH + lane;
        const float p_w0 = c.in[I_W0][j * D + ch], p_a0 = c.in[I_A0][j * D + ch], p_kk = c.in[I_KK][j * D + ch], p_ka = c.in[I_KA][j * D + ch], p_rk = c.in[I_RK][(size_t)j * D + ch],
                    p_lnw = c.in[I_LNW][j * D + ch], p_lnb = c.in[I_LNB][j * D + ch], p_v0 = j > 0 ? c.in[I_V0][(j - 1) * D + ch] : 0.f;
        const int ib = (w >> 1) & 1, jb = w & 1;
        f32x16_t ST;
#pragma unroll
        for (int r = 0; r < 16; ++r) ST[r] = 0.f;
        if (w < 4 && sq >= BATCH) { const float* s0 = c.in[I_WKV] + (((size_t)j * DB + (sq - BATCH)) * RHEADS + h) * RH * RH;
#pragma unroll
            for (int r = 0; r < 16; ++r) ST[r] = s0[(size_t)(32 * ib + rc_row(r, h5)) * RH + 32 * jb + l31]; }
        const int nch = (T + 31) / 32;
        if (h != hcur) {
            __syncthreads();
            const bf16_t* lw = fr.lorat + (size_t)j * 4096 * 384;
            for (int ci = tid; ci < 64 * 8; ci += 512) { const int row = ci >> 3, c8 = ci & 7;
                *(LDSP pg8::u32x4*)(lds + RC_WW + row * 144 + c8 * 16) = *(const pg8::u32x4*)(lw + (size_t)(0 * 1024 + h * 64 + row) * 384 + 0 + c8 * 8);
                *(LDSP pg8::u32x4*)(lds + RC_WA + row * 144 + c8 * 16) = *(const pg8::u32x4*)(lw + (size_t)(1 * 1024 + h * 64 + row) * 384 + 64 + c8 * 8); }
            for (int ci = tid; ci < 64 * 20; ci += 512) { const int row = ci / 20, c20 = ci % 20;
                *(LDSP pg8::u32x4*)(lds + RC_WG + row * 336 + c20 * 16) = *(const pg8::u32x4*)(lw + (size_t)(2 * 1024 + h * 64 + row) * 384 + 128 + c20 * 8); }
            for (int ci = tid; ci < 64 * 4; ci += 512) { const int row = ci >> 2, c4 = ci & 3;
                *(LDSP pg8::u32x4*)(lds + RC_WV + row * 80 + c4 * 16) = *(const pg8::u32x4*)(lw + (size_t)(3 * 1024 + h * 64 + row) * 384 + 288 + c4 * 8); }
            hcur = h;
        }
        RwIn in[4]; pg8::u32x4 hbr[3];
#define RC_LOADIN(n) do { _Pragma("unroll") for (int q = 0; q < 4; ++q) { const int t_ = (n) * 32 + 4 * w + q; if (t_ < T) { const size_t m_ = (size_t)(m0 + t_); \
                const bf16_t* rk_ = fr.rkv + m_ * 3072 + ch; in[q].r = rk_[0]; in[q].k = rk_[1024]; in[q].v = rk_[2048]; \
                in[q].vf = j > 0 ? fr.vf[m_ * D + ch] : 0.f; } } \
            _Pragma("unroll") for (int k3 = 0; k3 < 3; ++k3) { const int ci_ = tid + 512 * k3, tk_ = ci_ / 48, t_ = (n) * 32 + tk_; \
                hbr[k3] = t_ < T ? *(const pg8::u32x4*)(fr.hb + (size_t)(m0 + t_) * 384 + (ci_ % 48) * 8) : (pg8::u32x4){0u, 0u, 0u, 0u}; } } while (0)
#define RC_EPI_TOKEN(nn, tl) do { const int vv_ = ((nn) & 1) ? RC_VV2 : RC_VV, gg_ = ((nn) & 1) ? RC_GG2 : RC_GG, bn_ = ((nn) & 1) ? 32 : 0; \
                const float y_ = YB[(tl) * 64 + lane], mean_ = wsum_dpp(y_) * (1.0f / RH), d_ = y_ - mean_, var_ = wsum_dpp(d_ * d_) * (1.0f / RH); \
                const float yn_ = d_ * __builtin_amdgcn_rsqf(var_ + LNX_EPS) * p_lnw + p_lnb; \
                const float o_ = (yn_ + BON[bn_ + (tl)] * bf2f(*(const LDSP bf16_t*)(lds + vv_ + (tl) * RC_RS + lane * 2))) * bf2f(*(const LDSP bf16_t*)(lds + gg_ + (tl) * RC_RS + lane * 2)); \
                fr.yo[(size_t)(m0 + (nn) * 32 + (tl)) * D + ch] = (bf16_t)(pk2bf(o_, 0.f) & 0xffffu); } while (0)
        __syncthreads();
        RC_LOADIN(0);
        for (int n = 0; n < nch; ++n) {
            const int tn = T - n * 32 < 32 ? T - n * 32 : 32;
            const int vvo = (n & 1) ? RC_VV2 : RC_VV, ggo = (n & 1) ? RC_GG2 : RC_GG, bno = (n & 1) ? 32 : 0;
#pragma unroll
            for (int k3 = 0; k3 < 3; ++k3) { const int ci_ = tid + 512 * k3; *(LDSP pg8::u32x4*)(lds + RC_HB + (ci_ / 48) * RC_HBS + (ci_ % 48) * 16) = hbr[k3]; }
            __syncthreads();
            { int ln = lane; asm volatile("" : "+v"(ln)); const int a31 = ln & 31, a5 = ln >> 5; const int grp = w >> 1, nb = w & 1;
              const int koff = grp == 0 ? 0 : (grp == 1 ? 64 : (grp == 2 ? 128 : 288)), nks = grp == 2 ? 10 : (grp == 3 ? 2 : 4);
              const int wof = grp == 0 ? RC_WW : (grp == 1 ? RC_WA : (grp == 2 ? RC_WG : RC_WV)), wst = grp == 2 ? 336 : (grp == 3 ? 80 : 144);
              f32x16_t LA;
#pragma unroll
              for (int r = 0; r < 16; ++r) LA[r] = 0.f;
              for (int ks = 0; ks < nks; ++ks) LA = MFMA32(rc_nat(lds + RC_HB, RC_HBS, a31, koff + 16 * ks + 8 * a5), rc_nat(lds + wof, wst, 32 * nb + a31, 16 * ks + 8 * a5), LA);
#pragma unroll
              for (int r = 0; r < 16; ++r) rc_st16(lds + RC_LUO + grp * 4608 + rc_row(r, a5) * RC_RS + (32 * nb + a31) * 2, LA[r]); }
            __syncthreads();
            float q_r[4], q_k[4], q_a[4], q_b[4], q_e[4];
#pragma unroll
            for (int q = 0; q < 4; ++q) {
                const int tl = 4 * w + q, tg = n * 32 + tl;
                float r_ = 0.f, k2_ = 0.f, v_ = 0.f, a_ = 0.f, b_ = 0.f, e_ = 0.f, g_ = 0.f, bon_ = 0.f;
                if (tg < T) {
                    r_ = bf2f(in[q].r); const float k0_ = bf2f(in[q].k); v_ = bf2f(in[q].v);
                    e_ = 0.6065306597126334f * fsigmoid(p_w0 + bf2f(*(const LDSP bf16_t*)(lds + RC_LUO + 0 * 4608 + tl * RC_RS + lane * 2)));
                    if (j == 0) fr.vf[(size_t)(m0 + tg) * D + ch] = v_; else v_ = v_ + (in[q].vf - v_) * fsigmoid(p_v0 + bf2f(*(const LDSP bf16_t*)(lds + RC_LUO + 3 * 4608 + tl * RC_RS + lane * 2)));
                    const float as_ = fsigmoid(p_a0 + bf2f(*(const LDSP bf16_t*)(lds + RC_LUO + 1 * 4608 + tl * RC_RS + lane * 2))); float kk_ = k0_ * p_kk;
                    k2_ = k0_ * (1.0f + (as_ - 1.0f) * p_ka);
                    float n_ = red16(kk_ * kk_), e1_ = red16(r_ * k2_ * p_rk);
                    n_ = (rdl(n_, 0) + rdl(n_, 16)) + (rdl(n_, 32) + rdl(n_, 48)); bon_ = (rdl(e1_, 0) + rdl(e1_, 16)) + (rdl(e1_, 32) + rdl(e1_, 48));
                    kk_ *= __builtin_amdgcn_rcpf(fmaxf(__builtin_amdgcn_sqrtf(n_), 1e-12f));
                    a_ = -kk_; b_ = kk_ * as_; g_ = bf2f(*(const LDSP bf16_t*)(lds + RC_LUO + 2 * 4608 + tl * RC_RS + lane * 2));
                }
                q_r[q] = r_; q_k[q] = k2_; q_a[q] = a_; q_b[q] = b_; q_e[q] = e_;
                Ef[tl * 64 + lane] = e_;
                rc_st16(lds + vvo + tl * RC_RS + lane * 2, v_); rc_st16(lds + ggo + tl * RC_RS + lane * 2, g_);
                if (lane == 0) BON[bno + tl] = bon_;
            }
            if (n + 1 < nch) RC_LOADIN(n + 1);
            if (w < 4) {
#pragma unroll
                for (int r = 0; r < 16; ++r) rc_st16(lds + RC_SB + (32 * ib + rc_row(r, h5)) * RC_RS + (32 * jb + l31) * 2, ST[r]);
            }
            __syncthreads();
            { float run = 0.f, base = 0.f;
#pragma unroll
              for (int s = 0; s < 32; ++s) { const float ev = Ef[s * 64 + lane]; if (s == 4 * w) base = run; run += ev; }
              const float cumL = run; float cum = base;
#pragma unroll
              for (int q = 0; q < 4; ++q) { const int tl = 4 * w + q; const float cprev = cum; cum += q_e[q];
                  const float gam = __expf(-cum), gamp = __expf(-cprev), ginv = __expf(cum), glr = __expf(cum - cumL);
                  rc_st16(lds + RC_AT + tl * RC_RS + lane * 2, q_a[q] * gamp); rc_st16(lds + RC_RT + tl * RC_RS + lane * 2, q_r[q] * gam);
                  rc_st16(lds + RC_BB + tl * RC_RS + lane * 2, q_b[q] * ginv); rc_st16(lds + RC_KB + tl * RC_RS + lane * 2, q_k[q] * ginv);
                  rc_st16(lds + RC_BH + tl * RC_RS + lane * 2, q_b[q] * glr); rc_st16(lds + RC_KH + tl * RC_RS + lane * 2, q_k[q] * glr); }
              if (w == 0) GL[lane] = __expf(-cumL); }
            __syncthreads();
            f32x16_t R1;
#pragma unroll
            for (int r = 0; r < 16; ++r) R1[r] = 0.f;
            { int ln = lane; asm volatile("" : "+v"(ln)); const int a31 = ln & 31, a5 = ln >> 5;
              if (w < 4) {
                  const int aoff = (w == 0) ? RC_BB : ((w < 2) ? RC_AT : RC_RT), boff = (w == 0) ? RC_AT : ((w & 1) ? RC_KB : RC_BB);
#pragma unroll
                  for (int ks = 0; ks < 4; ++ks) R1 = MFMA32(rc_nat(lds + aoff, RC_RS, a31, 16 * ks + 8 * a5), rc_nat(lds + boff, RC_RS, a31, 16 * ks + 8 * a5), R1);
#pragma unroll
                  for (int r = 0; r < 16; ++r) { const int rr = rc_row(r, a5), cc = a31;
                      if (w == 0) NAB[rr * 32 + cc] = (rr < cc) ? R1[r] : 0.f;
                      else { const bool keep = (w < 2) ? (cc < rr) : (cc <= rr); rc_st16(lds + (w == 1 ? RC_NAK : (w == 2 ? RC_MRB : RC_MRK)) + rr * RC_NS + cc * 2, keep ? R1[r] : 0.f); } }
              } else {
                  const int aoff = (w < 6) ? RC_AT : RC_RT, ibk = w & 1;
#pragma unroll
                  for (int ks = 0; ks < 4; ++ks) R1 = MFMA32(rc_nat(lds + aoff, RC_RS, a31, 16 * ks + 8 * a5), rc_nat(lds + RC_SB, RC_RS, 32 * ibk + a31, 16 * ks + 8 * a5), R1);
              } }
            __syncthreads();
            if (w == 4 || w == 5) { int ln = lane; asm volatile("" : "+v"(ln)); const int a31 = ln & 31, a5 = ln >> 5, ibk = w & 1;
#pragma unroll
                for (int ks = 0; ks < 2; ++ks) R1 = MFMA32(rc_nat(lds + RC_NAK, RC_NS, a31, 16 * ks + 8 * a5), ss_trfrag(lds + vvo, RC_RS, 16 * ks, 32 * ibk, ln), R1);
#pragma unroll
                for (int r = 0; r < 16; ++r) Ef[rc_row(r, a5) * 64 + 32 * ibk + a31] = R1[r]; }
            __syncthreads();
            if (w > 0 && n > 0) { for (int tl = w - 1; tl < 32; tl += 7) RC_EPI_TOKEN(n - 1, tl); }
            if (w == 0) { float acc[32];
#pragma unroll
                for (int t = 0; t < 32; ++t) acc[t] = Ef[t * 64 + lane];
                RcSub<0>::run(acc, NAB, lds, lane); }
            __syncthreads();
            { int ln = lane; asm volatile("" : "+v"(ln)); const int a31 = ln & 31, a5 = ln >> 5;
              if (w >= 6) { const int ibk = w & 1;
#pragma unroll
                  for (int ks = 0; ks < 2; ++ks) { R1 = MFMA32(rc_nat(lds + RC_MRB, RC_NS, a31, 16 * ks + 8 * a5), ss_trfrag(lds + RC_UT, RC_RS, 16 * ks, 32 * ibk, ln), R1);
                                                   R1 = MFMA32(rc_nat(lds + RC_MRK, RC_NS, a31, 16 * ks + 8 * a5), ss_trfrag(lds + vvo, RC_RS, 16 * ks, 32 * ibk, ln), R1); }
#pragma unroll
                  for (int r = 0; r < 16; ++r) YB[rc_row(r, a5) * 64 + 32 * ibk + a31] = R1[r];
              } else if (w < 4) { const float gl = GL[32 * jb + a31];
#pragma unroll
                  for (int r = 0; r < 16; ++r) ST[r] *= gl;
#pragma unroll
                  for (int ks = 0; ks < 2; ++ks) { ST = MFMA32(ss_trfrag(lds + RC_UT, RC_RS, 16 * ks, 32 * ib, ln), ss_trfrag(lds + RC_BH, RC_RS, 16 * ks, 32 * jb, ln), ST);
                                                   ST = MFMA32(ss_trfrag(lds + vvo, RC_RS, 16 * ks, 32 * ib, ln), ss_trfrag(lds + RC_KH, RC_RS, 16 * ks, 32 * jb, ln), ST); } } }
            __syncthreads();
        }
        { const int nl = nch - 1, tnl = T - nl * 32 < 32 ? T - nl * 32 : 32; for (int tl = w; tl < tnl; tl += 8) RC_EPI_TOKEN(nl, tl); }
#undef RC_EPI_TOKEN
#undef RC_LOADIN
        if (w < 4) { float* so = (sq < BATCH ? c.out + O_WKVP + (((size_t)j * BATCH + sq) * RHEADS + h) * RH * RH : c.out + O_WKVS + (((size_t)j * DB + (sq - BATCH)) * RHEADS + h) * RH * RH);
#pragma unroll
            for (int r = 0; r < 16; ++r) so[(size_t)(32 * ib + rc_row(r, h5)) * RH + 32 * jb + l31] = ST[r]; }
    }
}
template <int ACT, bool ACC>
__device__ __forceinline__ void gemm_dev(const float* __restrict__ A, int lda, const float* __restrict__ B, int ldb, float* C, int ldc, int M, int N, int K, unsigned short (*As)[40], unsigned short (*Bs)[40]) {
    const int tid = threadIdx.x, wave = tid >> 6, lane = tid & 63, wr = wave >> 1, wc = wave & 1, fr = lane & 15, fq = lane >> 4;
    const int ntn = (N + 127) / 128, ntm = (M + 127) / 128;
    for (int tile = blockIdx.x; tile < ntm * ntn; tile += gridDim.x) {
        const int bm = (tile / ntn) * 128, bn = (tile % ntn) * 128;
        f32x4_t acc[2][4];
#pragma unroll
        for (int i = 0; i < 2; ++i)
#pragma unroll
            for (int j = 0; j < 4; ++j) acc[i][j] = (f32x4_t){0.f, 0.f, 0.f, 0.f};
        for (int k0 = 0; k0 < K; k0 += 32) {
#pragma unroll
            for (int it = 0; it < 2; ++it) {
                const int idx = tid + it * 512, row = idx >> 3, c4 = idx & 7, gm = bm + row;
                float4 v = make_float4(0.f, 0.f, 0.f, 0.f);
                if (gm < M) v = *(const float4*)(A + (size_t)gm * lda + k0 + c4 * 4);
                uint2 w; w.x = (unsigned)f2bf(v.x) | ((unsigned)f2bf(v.y) << 16); w.y = (unsigned)f2bf(v.z) | ((unsigned)f2bf(v.w) << 16);
                *(uint2*)&As[row][c4 * 4] = w;
            }
#pragma unroll
            for (int it = 0; it < 2; ++it) {
                const int idx = tid + it * 512, kr = idx >> 5, n4 = idx & 31, gn = bn + n4 * 4;
                float4 v = make_float4(0.f, 0.f, 0.f, 0.f);
                if (gn < N) v = *(const float4*)(B + (size_t)(k0 + kr) * ldb + gn);
                Bs[n4 * 4 + 0][kr] = f2bf(v.x); Bs[n4 * 4 + 1][kr] = f2bf(v.y); Bs[n4 * 4 + 2][kr] = f2bf(v.z); Bs[n4 * 4 + 3][kr] = f2bf(v.w);
            }
            __syncthreads();
            bf16x8_t a[2], b[4];
#pragma unroll
            for (int i = 0; i < 2; ++i) a[i] = *(const bf16x8_t*)&As[wr * 32 + i * 16 + fr][fq * 8];
#pragma unroll
            for (int j = 0; j < 4; ++j) b[j] = *(const bf16x8_t*)&Bs[wc * 64 + j * 16 + fr][fq * 8];
#pragma unroll
            for (int i = 0; i < 2; ++i)
#pragma unroll
                for (int j = 0; j < 4; ++j) acc[i][j] = __builtin_amdgcn_mfma_f32_16x16x32_bf16(a[i], b[j], acc[i][j], 0, 0, 0);
            __syncthreads();
        }
#pragma unroll
        for (int i = 0; i < 2; ++i)
#pragma unroll
            for (int j = 0; j < 4; ++j)
#pragma unroll
                for (int e = 0; e < 4; ++e) {
                    const int row = bm + wr * 32 + i * 16 + fq * 4 + e, col = bn + wc * 64 + j * 16 + fr;
                    if (row < M && col < N) {
                        float v = acc[i][j][e];
                        if (ACT == 1) v = tanhf(v); else if (ACT == 2) v = 1.0f / (1.0f + expf(-v)); else if (ACT == 3) v = v > 0.f ? v * v : 0.f;
                        float* cp = C + (size_t)row * ldc + col; *cp = ACC ? *cp + v : v;
                    }
                }
    }
}

#define MRUN(ph, l) do { ph(c, l, gtid, gsz); xcd_barrier(bar); } while (0)
#define MGEMM(ACT, ACC, A, lda, B, ldb, C, ldc, M, N, K) do { gemm_dev<ACT, ACC>(A, lda, B, ldb, C, ldc, M, N, K, As, Bs); xcd_barrier(bar); } while (0)
#define KS_FFN 16
#define KS_1K 4
#define KS_MB 8
#ifndef ACC_KSPLIT
#define ACC_KSPLIT 1
#endif
#ifndef FFN_DOWN_KSPLIT
#define FFN_DOWN_KSPLIT 1
#endif
#define GBAR() xcd_barrier(bar)
#define TAIL_IDLE(nunits, body) do { const int G_ = (int)gridDim.x, nbusy_ = (nunits) % G_, me_ = nbusy_ > 0 ? (int)blockIdx.x - nbusy_ : (int)blockIdx.x; \
    if (me_ >= 0) { __syncthreads(); LDSP float* TSCR = (LDSP float*)(lds + LDS_STAGE) + (tid_now() >> 6) * (64 * 33); \
        const int TGW = me_ * 8 + (int)(tid_now() >> 6), TNGW = (nbusy_ > 0 ? G_ - nbusy_ : G_) * 8; (void)TSCR; (void)TGW; (void)TNGW; body } } while (0)
#ifndef PROBE_DUP
#define PROBE_DUP 0
#endif
#define DUP(bit, ...) do { __VA_ARGS__; if (PROBE_DUP & (1 << (bit))) { GBAR(); __VA_ARGS__; } } while (0)
#define GTID_NOW() ((size_t)blockIdx.x * 512 + tid_now())
#define GSZ_NOW() ((size_t)gridDim.x * 512)
#define GW_NOW() ((int)(blockIdx.x * 8 + (tid_now() >> 6)))
#define NGW_NOW() ((int)(gridDim.x * 8))
#define LANE_NOW() ((int)(tid_now() & 63))
#undef MRUN
#undef MGEMM
#define MRUN(ph, l) do { ph(c, l, GTID_NOW(), GSZ_NOW()); xcd_barrier(bar); } while (0)
#define MGEMM(ACT, ACC, A, lda, B, ldb, C, ldc, M, N, K) do { gemm_dev<ACT, ACC>(A, lda, B, ldb, C, ldc, M, N, K, (unsigned short (*)[40])dynlds, (unsigned short (*)[40])(dynlds + 128 * 40 * 2)); xcd_barrier(bar); } while (0)
extern __shared__ __attribute__((aligned(16))) unsigned char dynlds[];

struct MegaArgs { Ctx c; Fast f; FastMla fm; FastRw fr; FastMb fb; unsigned* bar; };
constexpr int LDS_STAGE = 0, LDS_XB = 163840 - 64, LDS_BYTES = 163840;
static_assert(SD_END <= LDS_XB && SS_END <= LDS_XB && RC_END <= LDS_XB, "LDS map");

template <int L>
__device__ __forceinline__ void layer_mix_naive(const Ctx& c, const XcdBarrier& bar) {
    using namespace cfg;
    constexpr int l = L, kind = L % 3, j = L / 3;
    MRUN(ph_norm_mix, l);
    if constexpr (kind == 0) {
        MRUN(ph_rw_mix, l);
        const float* W = c.in[I_WRKV] + (size_t)j * 3 * D * D;
        MGEMM(0, false, c.xm[0], D, W, D, c.r, D, MTOT, D, D);
        MGEMM(0, false, c.xm[1], D, W + (size_t)D * D, D, c.k, D, MTOT, D, D);
        MGEMM(0, false, c.xm[2], D, W + (size_t)2 * D * D, D, c.v, D, MTOT, D, D);
        MGEMM(1, false, c.xm[3], D, c.in[I_W1] + (size_t)j * D * RW_DL, RW_DL, c.hw, RW_DL, MTOT, RW_DL, D);
        MGEMM(0, false, c.hw, RW_DL, c.in[I_W2] + (size_t)j * RW_DL * D, D, c.wpre, D, MTOT, D, RW_DL);
        MGEMM(0, false, c.xm[4], D, c.in[I_A1] + (size_t)j * D * RW_AL, RW_AL, c.ha, RW_AL, MTOT, RW_AL, D);
        MGEMM(0, false, c.ha, RW_AL, c.in[I_A2] + (size_t)j * RW_AL * D, D, c.apre, D, MTOT, D, RW_AL);
        if constexpr (j > 0) {
            MGEMM(0, false, c.xm[2], D, c.in[I_V1] + (size_t)(j - 1) * D * RW_VL, RW_VL, c.hv, RW_VL, MTOT, RW_VL, D);
            MGEMM(0, false, c.hv, RW_VL, c.in[I_V2] + (size_t)(j - 1) * RW_VL * D, D, c.vpre, D, MTOT, D, RW_VL);
        }
        MGEMM(2, false, c.xm[5], D, c.in[I_G1] + (size_t)j * D * RW_GL, RW_GL, c.hg, RW_GL, MTOT, RW_GL, D);
        MGEMM(0, false, c.hg, RW_GL, c.in[I_G2] + (size_t)j * RW_GL * D, D, c.g, D, MTOT, D, RW_GL);
        MRUN(ph_rw_prep, l); MRUN(ph_rw_scan, l); MRUN(ph_rw_post, l);
        MGEMM(0, true, c.yo, D, c.in[I_RWO] + (size_t)j * D * D, D, c.x, D, MTOT, D, D);
    } else if constexpr (kind == 1) {
        MGEMM(0, false, c.xn, D, c.in[I_MWIN] + (size_t)j * D * MLA_IN, MLA_IN, c.mh, MLA_IN, MTOT, MLA_IN, D);
        MRUN(ph_mla_norm1, l);
        MGEMM(0, false, c.qan, QL, c.in[I_WUQ] + (size_t)j * QL * MH * QD, MH * QD, c.q, MH * QD, MTOT, MH * QD, QL);
        MGEMM(0, false, c.c, KVL, c.in[I_WUK] + (size_t)j * KVL * MH * NOPE, MH * NOPE, c.knr, MH * NOPE, MTOT, MH * NOPE, KVL);
        MGEMM(0, false, c.c, KVL, c.in[I_WUV] + (size_t)j * KVL * MH * VD, MH * VD, c.vv, MH * VD, MTOT, MH * VD, KVL);
        MRUN(ph_mla_norm2, l); MRUN(ph_mla_attn_prompt, l); MRUN(ph_mla_score_sample, l); MRUN(ph_mla_softmax_sample, l); MRUN(ph_mla_pv_sample, l); MRUN(ph_mla_out_sample, l);
        MGEMM(0, true, c.ao, MH * VD, c.in[I_MWO] + (size_t)j * MH * VD * D, D, c.x, D, MTOT, D, MH * VD);
    } else {
        MGEMM(0, false, c.xn, D, c.in[I_BWIN] + (size_t)j * D * MB_IN, MB_IN, c.zx, MB_IN, MTOT, MB_IN, D);
        MRUN(ph_mb_conv, l); MRUN(ph_mb_dt, l); MRUN(ph_mb_scan, l); MRUN(ph_mb_gate, l);
        MGEMM(0, true, c.yzn, MB_INNER, c.in[I_BWO] + (size_t)j * MB_INNER * D, D, c.x, D, MTOT, D, MB_INNER);
    }
}


template <int L>
__device__ __forceinline__ void layer_rwkv_fast(const Ctx& c, const Fast& f, const FastRw& fr, const FastMla& fm, const XcdBarrier& bar, LDSP unsigned char* lds) {
    using namespace cfg;
    constexpr int l = L, j = L / 3;
    if (L > 0) { fold_sample_rows(c.x, f.slab, KS_FFN, GW_NOW(), NGW_NOW(), LANE_NOW()); GBAR(); }
    DUP(9, rw_mix_fast(c, fr, l, GW_NOW(), NGW_NOW(), LANE_NOW(), L == 0 ? c.in[I_XP] : nullptr));
    GBAR();
    DUP(7, { pg8::Order<RwSel> S; S.init(MP / 256, MS / 256, 16, D, 1, gridDim.x, blockIdx.x);
      pg8::gemm_phase(lds, pg8::Gemm{fr.xm, fr.wrkvt + (size_t)j * 4096 * D, D, D, (size_t)MTOT * D}, S, EpiRwkv{fr.rkv, fr.hb}); });
    if (L == 0) TAIL_IDLE((MP / 256 + MS / 256) * 16, {
        tr_weight(c.in[I_MWIN], D, MLA_IN, 1024, fm.wint, nullptr, TSCR, TGW, TNGW, LANE_NOW());
        tr_weight(c.in[I_WUQ], QL, MH * QD, MH * QD, fm.wuqt, nullptr, TSCR, TGW, TNGW, LANE_NOW());
        tr_weight(c.in[I_WUK], KVL, MH * NOPE, MH * NOPE, fm.wukvt, nullptr, TSCR, TGW, TNGW, LANE_NOW());
        tr_weight(c.in[I_WUV], KVL, MH * VD, MH * VD, fm.wukvt + (size_t)1024 * KVL, nullptr, TSCR, TGW, TNGW, LANE_NOW());
        tr_weight(c.in[I_MWO], MH * VD, D, D, fm.wot, nullptr, TSCR, TGW, TNGW, LANE_NOW());
    });
    GBAR();
    DUP(2, rw_scan_chunked<j>(c, fr, lds));
    GBAR();
    { pg8::Order<> S; S.init(MP / 256, MS / 256, 4, D, KS_1K, gridDim.x, blockIdx.x);
      pg8::gemm_phase(lds, pg8::Gemm{fr.yo, fr.wot + (size_t)j * D * D, D, D, 0}, S, pg8::EpiAccF32{c.x, D, f.slab, MP / 256, MS / 256, KS_1K, L == 0 ? c.in[I_XP] : nullptr}); }
    if (PROBE_DUP & (1 << 26)) { GBAR(); pg8::Order<> S; S.init(MP / 256, MS / 256, 4, D, KS_1K, gridDim.x, blockIdx.x);
      pg8::gemm_phase(lds, pg8::Gemm{fr.yo, fr.wot + (size_t)j * D * D, D, D, 0}, S, pg8::EpiAccF32{c.hmid, D, f.slab + (size_t)16 * 16 * 65536, MP / 256, MS / 256, KS_1K}); }
    GBAR();
}

__device__ __forceinline__ void layer_mamba_fast(const Ctx& c, const Fast& f, const FastMb& fb, const XcdBarrier& bar, LDSP unsigned char* lds) {
    using namespace cfg;
    constexpr int l = 2, j = 0;
    norm_rows_bf16(c.x, c.in[I_NMIX] + l * D, f.xnb, f.slab, KS_FFN, GW_NOW(), NGW_NOW(), LANE_NOW());
    GBAR();
    DUP(8, { pg8::Order<> S; S.init(MP / 256, MS / 256, 21, D, 1, gridDim.x, blockIdx.x);
      pg8::gemm_phase(lds, pg8::Gemm{f.xnb, fb.wbint, D, D, 0}, S, EpiMamba{fb.zb, fb.xbcr, fb.dtraw}); });
    GBAR();
    DUP(12, mb_conv_fast(c, fb, l, GTID_NOW(), GSZ_NOW(), false));
    GBAR();
    DUP(6, mb_ssd_prompt(c, fb, l, lds); mb_scan_sample(c, fb, l));
    GBAR();
    DUP(13, mb_gate_fast(c, fb, fb.y, l, GW_NOW(), NGW_NOW(), LANE_NOW()));
    GBAR();
    { pg8::Order<> S; S.init(MP / 256, MS / 256, 4, MB_INNER, KS_MB, gridDim.x, blockIdx.x);
      pg8::gemm_phase(lds, pg8::Gemm{fb.yzn, fb.wbot, MB_INNER, MB_INNER, 0}, S, pg8::EpiAccF32{c.x, D, f.slab, MP / 256, MS / 256, KS_MB}); }
    if (PROBE_DUP & (1 << 28)) { GBAR(); pg8::Order<> S; S.init(MP / 256, MS / 256, 4, MB_INNER, KS_MB, gridDim.x, blockIdx.x);
      pg8::gemm_phase(lds, pg8::Gemm{fb.yzn, fb.wbot, MB_INNER, MB_INNER, 0}, S, pg8::EpiAccF32{c.hmid, D, f.slab + (size_t)16 * 16 * 65536, MP / 256, MS / 256, KS_MB}); }
    GBAR();
}

__device__ __forceinline__ void layer_mla_fast(const Ctx& c, const Fast& f, const FastMla& fm, const FastRw& fr, const FastMb& fb, const XcdBarrier& bar, LDSP unsigned char* lds) {
    using namespace cfg;
    constexpr int l = 1, j = 0;
    norm_rows_bf16(c.x, c.in[I_NMIX] + l * D, f.xnb, f.slab, KS_FFN, GW_NOW(), NGW_NOW(), LANE_NOW());
    GBAR();
    DUP(27, { pg8::Order<> S; S.init(MP / 256, MS / 256, 4, D, 1, gridDim.x, blockIdx.x);
      pg8::gemm_phase(lds, pg8::Gemm{f.xnb, fm.wint, D, D, 0}, S, pg8::EpiF32{fm.mh, 1024, 1024}); });
    TAIL_IDLE((MP / 256 + MS / 256) * 4, {
        tr_weight(c.in[I_BWIN], D, MB_IN, 5376, fb.wbint, nullptr, TSCR, TGW, TNGW, LANE_NOW());
        tr_weight(c.in[I_BWO], MB_INNER, D, D, fb.wbot, nullptr, TSCR, TGW, TNGW, LANE_NOW());
        rw_build_lorat(c, fr.lorat + (size_t)1 * 4096 * 384, 1, (size_t)TGW * 64 + LANE_NOW(), (size_t)TNGW * 64);
    });
    GBAR();
    DUP(14, mla_norm1_fast(c, fm, j, GW_NOW(), NGW_NOW(), LANE_NOW()));
    GBAR();
    DUP(27, { pg8::Order<> S; S.init(MP / 256, MS / 256, (MH * QD) / 256, QL, 1, gridDim.x, blockIdx.x);
      pg8::gemm_phase(lds, pg8::Gemm{fm.qan, fm.wuqt, QL, QL, 0}, S, pg8::EpiBf16<0>{fm.qraw, MH * QD}); }
    { pg8::Order<> S; S.init(MP / 256, MS / 256, 4, KVL, 1, gridDim.x, blockIdx.x);
      pg8::gemm_phase(lds, pg8::Gemm{fm.cb, fm.wukvt, KVL, KVL, 0}, S, pg8::EpiBf16<0>{fm.kvraw, 2048}); }
    { pg8::Order<> S; S.init(4, 0, MTOT / 256, KVL, 1, gridDim.x, blockIdx.x);
      pg8::gemm_phase(lds, pg8::Gemm{fm.wukvt + (size_t)1024 * KVL, fm.cb, KVL, KVL, 0}, S, pg8::EpiBf16<0>{fm.vT, MTOT}); });
    GBAR();
    DUP(15, mla_norm2_fast(c, fm, j, GW_NOW(), NGW_NOW(), LANE_NOW()));
    { const unsigned t_ = (unsigned)GTID_NOW(); if (t_ < 96) *(pg8::u32x4*)(fm.qs + (size_t)MS * 1536 + t_ * 8) = (pg8::u32x4){0u, 0u, 0u, 0u}; }
    GBAR();
    DUP(5, attn_prompt_fast(fm.qf, fm.knb, fm.kpb, fm.vT, fm.aob, lds));
    __syncthreads();
    DUP(4, mla_sample_decode(c, fm, fm.qs, fm.opart, fm.lpart, j, lds));
    GBAR();
    DUP(16, mla_sample_combine(c, fm, fm.opart, fm.lpart, j, lds));
    GBAR();
    { pg8::Order<> S; S.init(MP / 256, MS / 256, 4, D, KS_1K, gridDim.x, blockIdx.x);
      pg8::gemm_phase(lds, pg8::Gemm{fm.aob, fm.wot, D, D, 0}, S, pg8::EpiAccF32{c.x, D, f.slab, MP / 256, MS / 256, KS_1K}); }
    if (PROBE_DUP & (1 << 27)) { GBAR(); pg8::Order<> S; S.init(MP / 256, MS / 256, 4, D, KS_1K, gridDim.x, blockIdx.x);
      pg8::gemm_phase(lds, pg8::Gemm{fm.aob, fm.wot, D, D, 0}, S, pg8::EpiAccF32{c.hmid, D, f.slab + (size_t)16 * 16 * 65536, MP / 256, MS / 256, KS_1K}); }
    GBAR();
}

template <int L>
__device__ __forceinline__ void layer_ffn_fast(const Ctx& c, const Fast& f, const FastRw& fr, const XcdBarrier& bar, LDSP unsigned char* lds) {
    using namespace cfg;
    norm_rows_bf16(c.x, c.in[I_NFFN] + L * D, f.xnb, f.slab, (L % 3 == 2) ? KS_MB : KS_1K, GW_NOW(), NGW_NOW(), LANE_NOW());
    GBAR();
    DUP(0, { pg8::Order<> S; S.init(MP / 256, MS / 256, FFN / 256, D, 1, gridDim.x, blockIdx.x);
      pg8::gemm_phase(lds, pg8::Gemm{f.xnb, f.w1t + (size_t)L * FFN * D, D, D, 0}, S, pg8::EpiBf16<3>{f.hmidb, FFN}); });
    if (L + 1 < DEPTH) TAIL_IDLE((MP / 256 + MS / 256) * (FFN / 256), {
        tr_weight(c.in[I_FW1] + (size_t)(L + 1) * D * FFN, D, FFN, FFN, f.w1t + (size_t)(L + 1) * FFN * D, nullptr, TSCR, TGW, TNGW, LANE_NOW());
        tr_weight(c.in[I_FW2] + (size_t)(L + 1) * FFN * D, FFN, D, D, f.w2t + (size_t)(L + 1) * D * FFN, nullptr, TSCR, TGW, TNGW, LANE_NOW());
        if (L == 0) { bf16_t* wt = fr.wrkvt + (size_t)1 * 4096 * D;
            for (int p = 0; p < 3; ++p) tr_weight(c.in[I_WRKV] + ((size_t)1 * 3 + p) * D * D, D, D, D, wt + (size_t)p * D * D, nullptr, TSCR, TGW, TNGW, LANE_NOW()); }
        if (L == 1) { bf16_t* wt = fr.wrkvt + (size_t)1 * 4096 * D;
            tr_weight(c.in[I_W1] + (size_t)1 * D * RW_DL, D, RW_DL, 256, wt + (size_t)3072 * D, nullptr, TSCR, TGW, TNGW, LANE_NOW());
            tr_weight(c.in[I_A1] + (size_t)1 * D * RW_AL, D, RW_AL, 256, wt + (size_t)3328 * D, nullptr, TSCR, TGW, TNGW, LANE_NOW());
            tr_weight(c.in[I_G1] + (size_t)1 * D * RW_GL, D, RW_GL, 256, wt + (size_t)3584 * D, nullptr, TSCR, TGW, TNGW, LANE_NOW());
            tr_weight(c.in[I_V1], D, RW_VL, 256, wt + (size_t)3840 * D, nullptr, TSCR, TGW, TNGW, LANE_NOW());
            tr_weight(c.in[I_RWO] + (size_t)1 * D * D, D, D, D, fr.wot + (size_t)1 * D * D, nullptr, TSCR, TGW, TNGW, LANE_NOW()); }
    });
    GBAR();
    { pg8::Order<> S; S.init(MP / 256, MS / 256, D / 256, FFN, (L == DEPTH - 1) ? 1 : KS_FFN, gridDim.x, blockIdx.x);
      pg8::gemm_phase(lds, pg8::Gemm{f.hmidb, f.w2t + (size_t)L * D * FFN, FFN, FFN, 0}, S, pg8::EpiAccF32{c.x, D, f.slab, MP / 256, MS / 256, (L == DEPTH - 1) ? 1 : KS_FFN}); }
    if (PROBE_DUP & (1 << 25)) { GBAR(); pg8::Order<> S; S.init(MP / 256, MS / 256, D / 256, FFN, (L == DEPTH - 1) ? 1 : KS_FFN, gridDim.x, blockIdx.x);
      pg8::gemm_phase(lds, pg8::Gemm{f.hmidb, f.w2t + (size_t)L * D * FFN, FFN, FFN, 0}, S, pg8::EpiAccF32{c.hmid, D, f.slab + (size_t)16 * 16 * 65536, MP / 256, MS / 256, (L == DEPTH - 1) ? 1 : KS_FFN}); }
    GBAR();
}

__global__ void __launch_bounds__(512, 2) mega10(MegaArgs a) {
    LDSP unsigned char* lds = (LDSP unsigned char*)dynlds;
    if (threadIdx.x < 4) ((LDSP unsigned*)(lds + LDS_XB))[threadIdx.x] = 0u;
    __syncthreads();
    XcdBarrier bar = xcd_barrier_post(a.bar, (volatile LAS unsigned*)(lds + LDS_XB));
    const Ctx& c = a.c; const Fast& f = a.f; const FastMla& fm = a.fm; const FastRw& fr = a.fr; const FastMb& fb = a.fb;
    using namespace cfg;
    DUP(10, {
        LDSP float* scr = (LDSP float*)(lds + LDS_STAGE) + (tid_now() >> 6) * (64 * 33);
        for (int l = 0; l < 1; ++l) {
            tr_weight(c.in[I_FW1] + (size_t)l * D * FFN, D, FFN, FFN, f.w1t + (size_t)l * FFN * D, nullptr, scr, GW_NOW(), NGW_NOW(), LANE_NOW());
            tr_weight(c.in[I_FW2] + (size_t)l * FFN * D, FFN, D, D, f.w2t + (size_t)l * D * FFN, nullptr, scr, GW_NOW(), NGW_NOW(), LANE_NOW());
        }
        for (int j = 0; j < 1; ++j) {
            bf16_t* wt = fr.wrkvt + (size_t)j * 4096 * D;
            for (int p = 0; p < 3; ++p) tr_weight(c.in[I_WRKV] + ((size_t)j * 3 + p) * D * D, D, D, D, wt + (size_t)p * D * D, nullptr, scr, GW_NOW(), NGW_NOW(), LANE_NOW());
            tr_weight(c.in[I_W1] + (size_t)j * D * RW_DL, D, RW_DL, 256, wt + (size_t)3072 * D, nullptr, scr, GW_NOW(), NGW_NOW(), LANE_NOW());
            tr_weight(c.in[I_A1] + (size_t)j * D * RW_AL, D, RW_AL, 256, wt + (size_t)3328 * D, nullptr, scr, GW_NOW(), NGW_NOW(), LANE_NOW());
            tr_weight(c.in[I_G1] + (size_t)j * D * RW_GL, D, RW_GL, 256, wt + (size_t)3584 * D, nullptr, scr, GW_NOW(), NGW_NOW(), LANE_NOW());
            tr_weight(j > 0 ? c.in[I_V1] + (size_t)(j - 1) * D * RW_VL : c.in[I_W1], D, j > 0 ? RW_VL : 0, 256, wt + (size_t)3840 * D, nullptr, scr, GW_NOW(), NGW_NOW(), LANE_NOW());
            tr_weight(c.in[I_RWO] + (size_t)j * D * D, D, D, D, fr.wot + (size_t)j * D * D, nullptr, scr, GW_NOW(), NGW_NOW(), LANE_NOW());
            rw_build_lorat(c, fr.lorat + (size_t)j * 4096 * 384, j, GTID_NOW(), GSZ_NOW());
        }
        { const size_t np4 = (size_t)MP * D / 4, nt4 = (size_t)MTOT * D / 4;
          for (size_t i = np4 + GTID_NOW(); i < nt4; i += GSZ_NOW()) ((pg8::f32x4*)c.x)[i] = ((const pg8::f32x4*)c.in[I_XS])[i - np4]; }
    });
    GBAR();
    layer_rwkv_fast<0>(c, f, fr, fm, bar, lds); layer_ffn_fast<0>(c, f, fr, bar, lds);
    layer_mla_fast(c, f, fm, fr, fb, bar, lds); layer_ffn_fast<1>(c, f, fr, bar, lds);
    layer_mamba_fast(c, f, fb, bar, lds); layer_ffn_fast<2>(c, f, fr, bar, lds);
    layer_rwkv_fast<3>(c, f, fr, fm, bar, lds); layer_ffn_fast<3>(c, f, fr, bar, lds);
}

extern "C" void kernel_launch(void* const* d_in, const int* in_sizes, int n_in, void* d_out, int out_size, void* d_ws, size_t ws_size, hipStream_t stream) {
    using namespace cfg;
    MegaArgs a{};
    size_t used = setup_ctx(a.c, d_in, d_out, d_ws);
    { Bump b{(char*)d_ws, (size_t)((char*)a.c.xm[0] - (char*)d_ws)}; FastRw& r = a.fr;
      r.xm = (bf16_t*)b.f((size_t)6 * MTOT * D / 2); r.rkv = (bf16_t*)b.f((size_t)MTOT * 3072 / 2); r.hb = (bf16_t*)b.f((size_t)MTOT * 384 / 2); r.lu = (bf16_t*)b.f((size_t)MTOT * 4096 / 2);
      r.ops = b.f((size_t)MTOT * RHEADS * RW_REC + 4096); r.yo = (bf16_t*)b.f((size_t)MTOT * D / 2); r.vf = a.c.vf;
      if (b.off > (size_t)((char*)a.c.hmid - (char*)d_ws) + (size_t)MTOT * FFN * 4) { fprintf(stderr, "RWKV overlay too large\n"); return; } }
    { Bump b{(char*)d_ws, used};
      a.f.xnb = (bf16_t*)b.f((size_t)MTOT * D / 2); a.f.hmidb = (bf16_t*)b.f((size_t)MTOT * FFN / 2);
      a.f.w1t = (bf16_t*)b.f((size_t)DEPTH * FFN * D / 2); a.f.w2t = (bf16_t*)b.f((size_t)DEPTH * FFN * D / 2); a.f.slab = b.f((size_t)2 * 16 * 16 * 65536);
      FastMla& m = a.fm;
      m.mh = b.f((size_t)MTOT * 1024); m.qan = (bf16_t*)b.f((size_t)MTOT * QL / 2); m.cb = (bf16_t*)b.f((size_t)MTOT * KVL / 2); m.kpb = (bf16_t*)b.f((size_t)MTOT * ROPE / 2);
      m.qraw = (bf16_t*)b.f((size_t)MTOT * 1536 / 2); m.kvraw = (bf16_t*)b.f((size_t)MTOT * 2048 / 2); m.qf = (bf16_t*)b.f((size_t)MTOT * 1536 / 2); m.knb = (bf16_t*)b.f((size_t)MTOT * 1024 / 2);
      m.aob = (bf16_t*)b.f((size_t)MTOT * 1024 / 2); m.vT = (bf16_t*)b.f((size_t)MTOT * 1024 / 2); m.qs = (bf16_t*)b.f((size_t)MS * 1536 / 2 + 1024);
      m.opart = b.f((size_t)2 * DB * 128 * 256); m.lpart = b.f((size_t)2 * DB * 128);
      m.wint = (bf16_t*)b.f((size_t)1024 * 1024 / 2); m.wuqt = (bf16_t*)b.f((size_t)1536 * 512 / 2); m.wukvt = (bf16_t*)b.f((size_t)2048 * 256 / 2); m.wot = (bf16_t*)b.f((size_t)1024 * 1024 / 2);
      { FastMb& q = a.fb; q.zb = (bf16_t*)b.f((size_t)MTOT * 2048 / 2); q.xbcr = (bf16_t*)b.f((size_t)MTOT * 3072 / 2); q.dtraw = b.f((size_t)MTOT * 32); q.xbcb = (bf16_t*)b.f((size_t)MTOT * 3072 / 2);
        q.dt = b.f((size_t)MTOT * 32); q.y = a.c.my; q.yzn = (bf16_t*)b.f((size_t)MTOT * 2048 / 2); q.wbint = (bf16_t*)b.f((size_t)5376 * 1024 / 2); q.wbot = (bf16_t*)b.f((size_t)1024 * 2048 / 2); }
      a.fr.wrkvt = (bf16_t*)b.f((size_t)N_RWKV * 4096 * D / 2); a.fr.lorat = (bf16_t*)b.f((size_t)N_RWKV * 4096 * 384 / 2); a.fr.wot = (bf16_t*)b.f((size_t)N_RWKV * D * D / 2);
      used = b.off; }
    if (used > ws_size || n_in != 51) { fprintf(stderr, "workspace too small: need %zu have %zu (n_in %d)\n", used, ws_size, n_in); return; }
    a.bar = (unsigned*)d_ws;
    static int grid = 0;
    if (!grid) {
        int dev = 0, cus = 0, per_cu = 0;
        (void)hipGetDevice(&dev); (void)hipDeviceGetAttribute(&cus, hipDeviceAttributeMultiprocessorCount, dev);
        if (hipFuncSetAttribute((const void*)mega10, hipFuncAttributeMaxDynamicSharedMemorySize, LDS_BYTES) != hipSuccess) { fprintf(stderr, "hipFuncSetAttribute failed\n"); grid = -1; return; }
        (void)hipOccupancyMaxActiveBlocksPerMultiprocessor(&per_cu, (const void*)mega10, 512, LDS_BYTES);
        (void)hipGetLastError();
        grid = per_cu >= 1 ? (cus < 256 ? cus : 256) : -1;
    }
    if (grid <= 0) { fprintf(stderr, "kernel does not fit one workgroup per CU\n"); return; }
    (void)hipMemsetAsync(a.bar, 0, XCD_BAR_WORDS * sizeof(unsigned), stream);
    hipLaunchKernelGGL(mega10, dim3(grid), dim3(512), LDS_BYTES, stream, a);
}
```
